# Optimizing an MI355X kernel written in HIP

```python
import jax, jax.numpy as jnp
from jax import lax
import numpy as np

D_MODEL = 1024
BATCH = 4
SEQ = 4096
DEPTH = 1

PLE_DIM = 256
EPS = 1e-6
N_HEADS = 8
QK_NOPE = 64
QK_ROPE = 32
QK_HEAD = QK_NOPE + QK_ROPE
V_HEAD = 64
Q_LORA = 256
KV_LORA = 128
ROPE_THETA = 10000.0
Q_BLOCK = 128
ATTN_WIDTH = N_HEADS * V_HEAD
POOL_WINDOWS = (2, 4, 8, 16)
POOL_GROUPS = 4
POOL_WIDTH = 512
POOL_GROUP_DIM = POOL_WIDTH // POOL_GROUPS
N_EXPERTS = 32
TOP_K = 4
D_EXPERT = 1024
SWIGLU_ALPHA = 1.702
SWIGLU_LIMIT = 7.0
EXPERT_BLOCK = 128
IN_SPLITS = (Q_LORA, Q_LORA + KV_LORA, Q_LORA + KV_LORA + QK_ROPE,
             Q_LORA + KV_LORA + QK_ROPE + POOL_WIDTH)
IN_PROJ_WIDTH = Q_LORA + KV_LORA + QK_ROPE + POOL_WIDTH + 2 * D_MODEL

kernel_name = "hybrid_mla_pool_moe_ple_block"


def rmsnorm(x, g):
    xf = x.astype(jnp.float32)
    y = xf * lax.rsqrt(jnp.mean(xf * xf, axis=-1, keepdims=True) + EPS)
    return (y * g.astype(jnp.float32)).astype(x.dtype)


def rope(x, cos, sin):
    x1, x2 = jnp.split(x.astype(jnp.float32), 2, axis=-1)
    return jnp.concatenate([x1 * cos - x2 * sin, x2 * cos + x1 * sin], axis=-1).astype(x.dtype)


def mla_branch(q_lat, kv_lat, k_rope_in, positions, g_q_lat, w_q_b, g_kv_lat, w_kv_b,
               g_q_head, g_k_nope, g_k_rope):
    B, S, _ = q_lat.shape
    q = (rmsnorm(q_lat, g_q_lat) @ w_q_b).reshape(B, S, N_HEADS, QK_HEAD)
    q = rmsnorm(q, g_q_head)
    kv = (rmsnorm(kv_lat, g_kv_lat) @ w_kv_b).reshape(B, S, N_HEADS, QK_NOPE + V_HEAD)
    k_nope, v = kv[..., :QK_NOPE], kv[..., QK_NOPE:]
    k_nope = rmsnorm(k_nope, g_k_nope)
    k_rope = rmsnorm(k_rope_in, g_k_rope)

    inv_freq = ROPE_THETA ** (-jnp.arange(0, QK_ROPE, 2, dtype=jnp.float32) / QK_ROPE)
    ang = positions.astype(jnp.float32)[..., None] * inv_freq
    cos, sin = jnp.cos(ang), jnp.sin(ang)
    q = jnp.concatenate([q[..., :QK_NOPE], rope(q[..., QK_NOPE:], cos[:, :, None], sin[:, :, None])], axis=-1)
    k_rope = rope(k_rope, cos, sin)
    k = jnp.concatenate([k_nope, jnp.broadcast_to(k_rope[:, :, None, :], (B, S, N_HEADS, QK_ROPE))], axis=-1)

    n_blocks = S // Q_BLOCK
    qb = q.reshape(B, n_blocks, Q_BLOCK, N_HEADS, QK_HEAD).transpose(1, 0, 3, 2, 4)
    kt = k.transpose(0, 2, 1, 3)
    vt = v.transpose(0, 2, 1, 3)
    scale = 1.0 / np.sqrt(QK_HEAD)
    key_idx = jnp.arange(S)

    def attend(args):
        q_blk, blk = args
        s = jnp.einsum('bhqd,bhkd->bhqk', q_blk, kt).astype(jnp.float32) * scale
        q_idx = blk * Q_BLOCK + jnp.arange(Q_BLOCK)
        mask = q_idx[:, None] >= key_idx[None, :]
        s = jnp.where(mask, s, jnp.float32(-1e30))
        pr = jax.nn.softmax(s, axis=-1).astype(vt.dtype)
        return jnp.einsum('bhqk,bhkd->bhqd', pr, vt)

    out = lax.map(attend, (qb, jnp.arange(n_blocks)))
    return out.transpose(1, 0, 3, 2, 4).reshape(B, S, ATTN_WIDTH)


def pool_branch(u, w_pool, pool_scale):
    B, S, _ = u.shape
    uf = u.astype(jnp.float32).reshape(B, S, POOL_GROUPS, POOL_GROUP_DIM)
    c = jnp.concatenate([jnp.zeros((B, 1, POOL_GROUPS, POOL_GROUP_DIM), jnp.float32),
                         jnp.cumsum(uf, axis=1)], axis=1)
    t = jnp.arange(S)
    means = []
    for g, w in enumerate(POOL_WINDOWS):
        lo = jnp.maximum(t + 1 - w, 0)
        window_sum = c[:, 1:, g] - c[:, lo, g]
        count = (t + 1 - lo).astype(jnp.float32)[:, None]
        means.append(window_sum / count)
    pooled = (jnp.stack(means, axis=2) - uf).astype(u.dtype)
    mixed = jnp.einsum('bsgc,gcd->bsgd', pooled, w_pool)
    return mixed.reshape(B, S, POOL_WIDTH) * pool_scale


def moe(h, w_router, b_router, w_gate_up, b_gate_up, w_down, b_down):
    B, S, D = h.shape
    T = B * S
    A = T * TOP_K
    hf = h.reshape(T, D)
    logits = (hf @ w_router).astype(jnp.float32) + b_router.astype(jnp.float32)
    top_val, top_idx = lax.top_k(logits, TOP_K)
    gates = jax.nn.softmax(top_val, axis=-1)

    expert_flat = top_idx.reshape(A)
    token_flat = jnp.repeat(jnp.arange(T, dtype=jnp.int32), TOP_K)
    gate_flat = gates.reshape(A)
    order = jnp.argsort(expert_flat)
    e_sorted = expert_flat[order]
    counts = jax.ops.segment_sum(jnp.ones((A,), jnp.int32), expert_flat, num_segments=N_EXPERTS)
    padded = (counts + EXPERT_BLOCK - 1) // EXPERT_BLOCK * EXPERT_BLOCK
    start = jnp.cumsum(counts) - counts
    pad_end = jnp.cumsum(padded)
    pad_start = pad_end - padded
    dest = pad_start[e_sorted] + jnp.arange(A, dtype=jnp.int32) - start[e_sorted]

    n_blocks = (A + EXPERT_BLOCK - 1) // EXPERT_BLOCK + N_EXPERTS
    M = n_blocks * EXPERT_BLOCK
    tok_buf = jnp.full((M,), T, jnp.int32).at[dest].set(token_flat[order])
    gate_buf = jnp.zeros((M,), jnp.float32).at[dest].set(gate_flat[order])
    block_expert = jnp.minimum(
        jnp.searchsorted(pad_end, jnp.arange(n_blocks, dtype=jnp.int32) * EXPERT_BLOCK, side='right'),
        N_EXPERTS - 1)
    h_pad = jnp.concatenate([hf, jnp.zeros((1, D), hf.dtype)], axis=0)
    x_blocks = h_pad[tok_buf].reshape(n_blocks, EXPERT_BLOCK, D)

    def expert_block(args):
        xb, e = args
        gu = xb @ w_gate_up[e] + b_gate_up[e]
        gate, up = gu[:, :D_EXPERT], gu[:, D_EXPERT:]
        gate = jnp.minimum(gate, SWIGLU_LIMIT)
        up = jnp.clip(up, -SWIGLU_LIMIT, SWIGLU_LIMIT)
        act = (up + 1.0) * gate * jax.nn.sigmoid(SWIGLU_ALPHA * gate)
        return act @ w_down[e] + b_down[e]

    y = lax.map(expert_block, (x_blocks, block_expert)).reshape(M, D)
    y = y * gate_buf[:, None].astype(y.dtype)
    out = jnp.zeros((T + 1, D), y.dtype).at[tok_buf].add(y)[:T]
    return out.reshape(B, S, D)


def setup_inputs(seed: int = 0) -> dict:
    key = jax.random.key(seed)
    ks = jax.random.split(key, 32)

    def dense(k, shape, fan_in):
        return jax.random.normal(k, shape, jnp.float32) * (fan_in ** -0.5)

    def gain(k, shape):
        return 1.0 + 0.05 * jax.random.normal(k, shape, jnp.float32)

    def bias(k, shape):
        return 0.01 * jax.random.normal(k, shape, jnp.float32)

    L = DEPTH
    x = jax.random.normal(ks[0], (BATCH, SEQ, D_MODEL), jnp.float32)
    p = jax.random.normal(ks[1], (DEPTH, BATCH, SEQ, PLE_DIM), jnp.float32)
    offset = jax.random.randint(ks[2], (BATCH, 1), 0, 1024, dtype=jnp.int32)
    positions = offset + jnp.arange(SEQ, dtype=jnp.int32)[None, :]
    return {
        "x": x,
        "p": p,
        "positions": positions,
        "g_mix": gain(ks[3], (L, D_MODEL)),
        "w_in": dense(ks[4], (L, D_MODEL, IN_PROJ_WIDTH), D_MODEL),
        "g_q_lat": gain(ks[5], (L, Q_LORA)),
        "w_q_b": dense(ks[6], (L, Q_LORA, N_HEADS * QK_HEAD), Q_LORA),
        "g_kv_lat": gain(ks[7], (L, KV_LORA)),
        "w_kv_b": dense(ks[8], (L, KV_LORA, N_HEADS * (QK_NOPE + V_HEAD)), KV_LORA),
        "g_q_head": gain(ks[9], (L, QK_HEAD)),
        "g_k_nope": gain(ks[10], (L, QK_NOPE)),
        "g_k_rope": gain(ks[11], (L, QK_ROPE)),
        "w_pool": dense(ks[12], (L, POOL_GROUPS, POOL_GROUP_DIM, POOL_GROUP_DIM), POOL_GROUP_DIM),
        "pool_scale": gain(ks[13], (L, POOL_WIDTH)),
        "w_attn_out": dense(ks[14], (L, ATTN_WIDTH, D_MODEL), ATTN_WIDTH),
        "w_pool_out": dense(ks[15], (L, POOL_WIDTH, D_MODEL), POOL_WIDTH),
        "w_o": dense(ks[16], (L, D_MODEL, D_MODEL), D_MODEL),
        "g_ffn": gain(ks[17], (L, D_MODEL)),
        "w_router": dense(ks[18], (L, D_MODEL, N_EXPERTS), D_MODEL),
        "b_router": bias(ks[19], (L, N_EXPERTS)),
        "w_gate_up": dense(ks[20], (L, N_EXPERTS, D_MODEL, 2 * D_EXPERT), D_MODEL),
        "b_gate_up": bias(ks[21], (L, N_EXPERTS, 2 * D_EXPERT)),
        "w_down": dense(ks[22], (L, N_EXPERTS, D_EXPERT, D_MODEL), D_EXPERT),
        "b_down": bias(ks[23], (L, N_EXPERTS, D_MODEL)),
        "g_ple": gain(ks[24], (L, D_MODEL)),
        "w_ple_gate": dense(ks[25], (L, D_MODEL, D_MODEL), D_MODEL),
        "w_ple": dense(ks[26], (L, PLE_DIM, D_MODEL), PLE_DIM),
    }


def reference(x, p, positions, g_mix, w_in, g_q_lat, w_q_b, g_kv_lat, w_kv_b, g_q_head,
              g_k_nope, g_k_rope, w_pool, pool_scale, w_attn_out, w_pool_out, w_o, g_ffn,
              w_router, b_router, w_gate_up, b_gate_up, w_down, b_down, g_ple, w_ple_gate, w_ple):
    for i in range(DEPTH):
        h = rmsnorm(x, g_mix[i])
        proj = h @ w_in[i]
        q_lat, kv_lat, k_rope_in, pool_in, gate_logits = jnp.split(proj, IN_SPLITS, axis=-1)
        y_attn = mla_branch(q_lat, kv_lat, k_rope_in, positions, g_q_lat[i], w_q_b[i],
                            g_kv_lat[i], w_kv_b[i], g_q_head[i], g_k_nope[i], g_k_rope[i]) @ w_attn_out[i]
        y_pool = pool_branch(pool_in, w_pool[i], pool_scale[i]) @ w_pool_out[i]
        gate_a, gate_p = jnp.split(jax.nn.sigmoid(gate_logits), 2, axis=-1)
        x = x + (gate_a * y_attn + gate_p * y_pool) @ w_o[i]
        x = x + moe(rmsnorm(x, g_ffn[i]), w_router[i], b_router[i], w_gate_up[i], b_gate_up[i],
                    w_down[i], b_down[i])
        ple_gate = jax.nn.sigmoid(rmsnorm(x, g_ple[i]) @ w_ple_gate[i])
        x = x + ple_gate * (p[i] @ w_ple[i])
    return x
```

```cpp
#include <hip/hip_runtime.h>
#include <cstdio>
#include <cstdint>

#define LAS __attribute__((address_space(3)))
#define GAS __attribute__((address_space(1)))
typedef unsigned short bf16_t;
typedef short bf16x8 __attribute__((ext_vector_type(8)));
typedef short s16x4 __attribute__((ext_vector_type(4)));
typedef float f32x4 __attribute__((ext_vector_type(4)));
typedef float f32x2 __attribute__((ext_vector_type(2)));
typedef float f32x16 __attribute__((ext_vector_type(16)));
typedef unsigned u32x4 __attribute__((ext_vector_type(4)));
typedef unsigned u32x2 __attribute__((ext_vector_type(2)));

constexpr int NB = 4, SEQ = 4096, T = NB * SEQ, DM = 1024, NH = 8, DK = 96, DV = 64;
constexpr int NEXP = 32, TOPK = 4, DEXP = 1024, PLE = 256;
constexpr float EPS = 1e-6f;
constexpr int XS_ROWS = T * TOPK + NEXP * 256;

__device__ __forceinline__ unsigned cvt_pk_bf16(float lo, float hi) { unsigned r; asm volatile("v_cvt_pk_bf16_f32 %0, %1, %2" : "=v"(r) : "v"(lo), "v"(hi)); return r; }
__device__ __forceinline__ float bf_lo(unsigned w) { return __uint_as_float(w << 16); }
__device__ __forceinline__ float bf_hi(unsigned w) { return __uint_as_float(w & 0xffff0000u); }
__device__ __forceinline__ float bf1(bf16_t h) { return __uint_as_float(((unsigned)h) << 16); }
__device__ __forceinline__ float fast_sigmoid(float v) { return __builtin_amdgcn_rcpf(1.0f + __builtin_amdgcn_exp2f(-1.4426950408889634f * v)); }
__device__ __forceinline__ float wave_sum(float v) {
#pragma unroll
    for (int o = 1; o < 64; o <<= 1) v += __shfl_xor(v, o);
    return v;
}

namespace pg8 {
constexpr int BM = 256, BK = 64, HALF = 128, HTB = HALF * BK * 2, STAGE_BYTES = 8 * HTB;
__host__ __device__ __forceinline__ int lds_byte(int r, int c) { const int st = (r >> 4) * 2 + (c >> 5), rr = r & 15, cc = c & 31, ob = rr * 64 + cc * 2; return st * 1024 + (ob ^ (((ob >> 9) & 1) << 5)); }
__host__ __device__ __forceinline__ void stage_rc(int b, int& R, int& C) { const int st = b / 1024, sb = b % 1024, swz = sb ^ (((sb >> 9) & 1) << 5); R = (st >> 1) * 16 + swz / 64; C = (st & 1) * 32 + (swz % 64) / 2; }
__host__ __device__ __forceinline__ int perm32(int rho) { const int n = rho >> 4, i = rho & 15; return 8 * (i >> 2) + 4 * n + (i & 3); }

struct Unit { int pm, pn, aux; };
struct Shape { int K, lda, ldb; };

template <class Epi, class Sched, bool ALIGN_EPI, bool SP2>
__device__ __forceinline__ void gemm_phase(LAS unsigned char* lds, const Shape g, const Sched& S, const Epi& E) {
    const int tid = threadIdx.x, wid = __builtin_amdgcn_readfirstlane(tid >> 6), lane = tid & 63, wr = wid >> 2, wc = wid & 3, fr = lane & 15, fq = lane >> 4;
    int nt = g.K / BK; asm volatile("" : "+s"(nt));
    unsigned voffA[2], voffB[2];
#pragma unroll
    for (int i = 0; i < 2; ++i) { int R, C; stage_rc(tid * 16 + i * 8192, R, C); const int Rb = Epi::PERM ? ((R & ~31) + perm32(R & 31)) : R;
        voffA[i] = (unsigned)(R * g.lda + C) * 2u; voffB[i] = (unsigned)(Rb * g.ldb + C) * 2u; }
    const size_t kstep = (size_t)(BK * 2);
    const size_t hstepA = (size_t)HALF * g.lda * 2, hstepB = (size_t)HALF * g.ldb * 2;
    const unsigned ldsw = (unsigned)wid * 1024u;
    const int aoff = lds_byte(wr * 64 + fr, fq * 8), boff = lds_byte(wc * 32 + fr, fq * 8);
#define PG8_SA(b, h) (((b) * 2 + (h)) * HTB)
#define PG8_SB(b, h) ((4 + (b) * 2 + (h)) * HTB)
#define PG8_STAGE(bufoff, gbase, voff) do { _Pragma("unroll") for (int _i = 0; _i < 2; ++_i) \
        __builtin_amdgcn_global_load_lds((const unsigned*)((const char*)(gbase) + (voff)[_i]), (LAS unsigned*)(lds + (bufoff) + ldsw + _i * 8192), 16, 0, 0); } while (0)
#define PG8_LDA(dst, b, h) do { _Pragma("unroll") for (int m = 0; m < 4; ++m) _Pragma("unroll") for (int k = 0; k < 2; ++k) dst[m][k] = *(const LAS bf16x8*)(lds + PG8_SA(b, h) + aoff + m * 2048 + k * 1024); } while (0)
#define PG8_LDB(dst, b, h) do { _Pragma("unroll") for (int n = 0; n < 2; ++n) _Pragma("unroll") for (int k = 0; k < 2; ++k) dst[n][k] = *(const LAS bf16x8*)(lds + PG8_SB(b, h) + boff + n * 2048 + k * 1024); } while (0)
#define PG8_MMA(ai, bj, At, Bt) do { __builtin_amdgcn_s_setprio(1); _Pragma("unroll") for (int m = 0; m < 4; ++m) _Pragma("unroll") for (int n = 0; n < 2; ++n) _Pragma("unroll") for (int k = 0; k < 2; ++k) \
        acc[ai][bj][m][n] = __builtin_amdgcn_mfma_f32_16x16x32_bf16(Bt[n][k], At[m][k], acc[ai][bj][m][n], 0, 0, 0); __builtin_amdgcn_s_setprio(0); } while (0)
#define PG8_WAIT_V(n) asm volatile("s_waitcnt vmcnt(" #n ")" ::: "memory")
#define PG8_WAIT_L(n) asm volatile("s_waitcnt lgkmcnt(" #n ")" ::: "memory")
#define PG8_BAR __builtin_amdgcn_s_barrier()
#define PG8_SCHED __builtin_amdgcn_sched_barrier(0)
    Unit cur, nxt; int ui = 0;
    if (!S.next(0, cur)) return;
    f32x4 acc[2][2][4][2];
#pragma unroll
    for (int a = 0; a < 2; ++a)
#pragma unroll
        for (int b = 0; b < 2; ++b)
#pragma unroll
            for (int m = 0; m < 4; ++m)
#pragma unroll
                for (int n = 0; n < 2; ++n) acc[a][b][m][n] = (f32x4){0.f, 0.f, 0.f, 0.f};
    bf16x8 At[4][2], B0[2][2], B1[2][2];
    const char* cA = S.a_ptr(cur); const char* cB = S.b_ptr(cur);
    if constexpr (SP2) {
        PG8_STAGE(PG8_SB(0, 0), cB, voffB); PG8_STAGE(PG8_SB(0, 1), cB + hstepB, voffB); PG8_STAGE(PG8_SA(0, 0), cA, voffA); PG8_STAGE(PG8_SA(0, 1), cA + hstepA, voffA);
        if (wr == 1) PG8_BAR;
        PG8_WAIT_V(2); PG8_BAR;
        PG8_STAGE(PG8_SB(1, 0), cB + kstep, voffB); PG8_STAGE(PG8_SA(1, 0), cA + kstep, voffA); PG8_STAGE(PG8_SB(1, 1), cB + hstepB + kstep, voffB);
        PG8_WAIT_V(6); PG8_BAR;
    } else {
        PG8_STAGE(PG8_SB(0, 0), cB, voffB); PG8_STAGE(PG8_SA(0, 0), cA, voffA); PG8_STAGE(PG8_SB(0, 1), cB + hstepB, voffB); PG8_STAGE(PG8_SA(0, 1), cA + hstepA, voffA);
        if (wr == 1) PG8_BAR;
        PG8_WAIT_V(4); PG8_BAR;
        PG8_STAGE(PG8_SB(1, 0), cB + kstep, voffB); PG8_STAGE(PG8_SA(1, 0), cA + kstep, voffA); PG8_STAGE(PG8_SB(1, 1), cB + hstepB + kstep, voffB);
        PG8_WAIT_V(6); PG8_BAR;
    }
    for (;;) {
        const bool has_next = S.next(ui + 1, nxt);
        const char* nA = has_next ? S.a_ptr(nxt) : cA; const char* nB = has_next ? S.b_ptr(nxt) : cB;
#pragma nounroll
        for (int t = 0; t < nt; t += 2) {
            const bool last = (t == nt - 2);
            const char* a1 = cA + (size_t)(t + 1) * kstep;
            const char* a2 = last ? nA : cA + (size_t)(t + 2) * kstep; const char* b2 = last ? nB : cB + (size_t)(t + 2) * kstep;
            const char* a3 = a2 + kstep; const char* b3 = b2 + kstep;
            if constexpr (SP2) {
            PG8_LDB(B0, 0, 0); PG8_LDB(B1, 0, 1); PG8_SCHED; PG8_LDA(At, 0, 0); PG8_STAGE(PG8_SA(1, 1), a1 + hstepA, voffA);
            PG8_WAIT_V(8); PG8_WAIT_L(0); PG8_BAR; PG8_MMA(0, 0, At, B0); PG8_MMA(0, 1, At, B1); PG8_BAR; PG8_SCHED;
            PG8_LDA(At, 0, 1); PG8_STAGE(PG8_SB(0, 0), b2, voffB); PG8_STAGE(PG8_SB(0, 1), b2 + hstepB, voffB); PG8_STAGE(PG8_SA(0, 0), a2, voffA);
            PG8_WAIT_V(8); PG8_WAIT_L(0); PG8_BAR; PG8_MMA(1, 0, At, B0); PG8_MMA(1, 1, At, B1); PG8_BAR; PG8_SCHED;
            PG8_LDB(B0, 1, 0); PG8_LDB(B1, 1, 1); PG8_SCHED; PG8_LDA(At, 1, 0); PG8_STAGE(PG8_SA(0, 1), a2 + hstepA, voffA);
            PG8_WAIT_V(8); PG8_WAIT_L(0); PG8_BAR; PG8_MMA(0, 0, At, B0); PG8_MMA(0, 1, At, B1); PG8_BAR; PG8_SCHED;
            PG8_LDA(At, 1, 1); PG8_STAGE(PG8_SB(1, 0), b3, voffB); PG8_STAGE(PG8_SB(1, 1), b3 + hstepB, voffB); PG8_STAGE(PG8_SA(1, 0), a3, voffA);
            PG8_WAIT_V(8); PG8_WAIT_L(0); PG8_BAR; PG8_MMA(1, 0, At, B0); PG8_MMA(1, 1, At, B1); PG8_BAR; PG8_SCHED;
            } else {
            PG8_LDB(B0, 0, 0); PG8_SCHED; PG8_LDA(At, 0, 0); PG8_STAGE(PG8_SA(1, 1), a1 + hstepA, voffA);
            PG8_WAIT_L(8); PG8_BAR; PG8_WAIT_L(0); PG8_MMA(0, 0, At, B0); PG8_BAR; PG8_SCHED;
            PG8_LDB(B1, 0, 1); PG8_STAGE(PG8_SB(0, 0), b2, voffB);
            PG8_BAR; PG8_WAIT_L(0); PG8_MMA(0, 1, At, B1); PG8_BAR;
            PG8_LDA(At, 0, 1); PG8_STAGE(PG8_SA(0, 0), a2, voffA);
            PG8_BAR; PG8_WAIT_L(0); PG8_MMA(1, 0, At, B0); PG8_BAR; PG8_SCHED;
            PG8_STAGE(PG8_SB(0, 1), b2 + hstepB, voffB);
            PG8_WAIT_V(6); PG8_BAR; PG8_MMA(1, 1, At, B1); PG8_BAR;
            PG8_LDB(B0, 1, 0); PG8_SCHED; PG8_LDA(At, 1, 0); PG8_STAGE(PG8_SA(0, 1), a2 + hstepA, voffA);
            PG8_WAIT_L(8); PG8_BAR; PG8_WAIT_L(0); PG8_MMA(0, 0, At, B0); PG8_BAR; PG8_SCHED;
            PG8_LDB(B1, 1, 1); PG8_STAGE(PG8_SB(1, 0), b3, voffB);
            PG8_BAR; PG8_WAIT_L(0); PG8_MMA(0, 1, At, B1); PG8_BAR;
            PG8_LDA(At, 1, 1); PG8_STAGE(PG8_SA(1, 0), a3, voffA);
            PG8_BAR; PG8_WAIT_L(0); PG8_MMA(1, 0, At, B0); PG8_BAR; PG8_SCHED;
            PG8_STAGE(PG8_SB(1, 1), b3 + hstepB, voffB);
            PG8_WAIT_V(6); PG8_BAR; PG8_MMA(1, 1, At, B1); PG8_BAR;
            }
        }
        if constexpr (ALIGN_EPI) { if (wr == 0) PG8_BAR; }
        E(acc, cur, wr, wc, fr, fq);
        if (!has_next) break;
#pragma unroll
        for (int a = 0; a < 2; ++a)
#pragma unroll
            for (int b = 0; b < 2; ++b)
#pragma unroll
                for (int m = 0; m < 4; ++m)
#pragma unroll
                    for (int n = 0; n < 2; ++n) acc[a][b][m][n] = (f32x4){0.f, 0.f, 0.f, 0.f};
        cur = nxt; cA = nA; cB = nB; ++ui;
        if constexpr (ALIGN_EPI) { if (wr == 1) PG8_BAR; }
    }
    PG8_WAIT_V(0);
    if constexpr (!ALIGN_EPI) { if (wr == 0) PG8_BAR; }
    PG8_BAR;
#undef PG8_SA
#undef PG8_SB
#undef PG8_STAGE
#undef PG8_LDA
#undef PG8_LDB
#undef PG8_MMA
#undef PG8_WAIT_V
#undef PG8_WAIT_L
#undef PG8_BAR
#undef PG8_SCHED
}
}
using pg8::Unit;

constexpr size_t MiB = 1u << 20;
constexpr size_t WS_CTL = 0, CTL_ZERO_BYTES = 1 * MiB;
constexpr size_t WS_WIN = 1 * MiB;
constexpr size_t WS_WQ = 7 * MiB;
constexpr size_t WS_WKV = WS_WQ + 512 * 1024;
constexpr size_t WS_WPOOL = 8 * MiB;
constexpr size_t WS_WAO = 9 * MiB;
constexpr size_t WS_WPO = 10 * MiB;
constexpr size_t WS_WO = 11 * MiB;
constexpr size_t WS_WPG = 13 * MiB;
constexpr size_t WS_WPLE = 15 * MiB;
constexpr size_t WS_WGU = 16 * MiB;
constexpr size_t WS_WD = 144 * MiB;
constexpr size_t WS_HN = 208 * MiB;
constexpr size_t WS_PROJ = 240 * MiB;
constexpr size_t WS_GATES = 272 * MiB;
constexpr size_t WS_A2 = 336 * MiB;
constexpr size_t WS_POOLED = 352 * MiB;
constexpr size_t WS_Q = 368 * MiB;
constexpr size_t WS_K = 392 * MiB;
constexpr size_t WS_V = 416 * MiB;
constexpr size_t WS_ATT = 432 * MiB;
constexpr size_t WS_MIXED = 448 * MiB;
constexpr size_t WS_MIX = 464 * MiB;
constexpr size_t WS_PB = 496 * MiB;
constexpr size_t WS_E = 504 * MiB;
constexpr size_t WS_SSQ = 536 * MiB;
constexpr size_t WS_COS = 537 * MiB;
constexpr size_t WS_SIN = 538 * MiB;
constexpr size_t WS_ROUTE = 539 * MiB;
constexpr size_t WS_XS = 544 * MiB;
constexpr size_t WS_ACT = 688 * MiB;
constexpr size_t WS_END = 832 * MiB;
constexpr int CW_BAR = 4096;
constexpr int CW_CNT = 1024;

constexpr int RING_BYTES = 131072;
constexpr int LDS_BYTES = 163840;
constexpr int MISC_OFF = LDS_BYTES - 512;
constexpr int TILE_E_OFF = LDS_BYTES - 4096;
constexpr int NWAVES = 8;

typedef GAS unsigned gu32;
#define RLX_AGENT __ATOMIC_RELAXED, __HIP_MEMORY_SCOPE_AGENT
#define XB_TMO      128
#define XB_XCNT(j)  (256  + 64 * (j))
#define XB_XSUB(j)  (1280 + 64 * (j))
#define XB_XGEN(j)  (2304 + 64 * (j))
#define XB_TOP      3328
#define XB_TOPGEN   3392
#define XCD_BAR_WORDS 3456
#define XB_SPIN_CAP (1u << 18)
__device__ __forceinline__ unsigned xb_ld(unsigned* p)              { return __hip_atomic_load(p, __ATOMIC_RELAXED, __HIP_MEMORY_SCOPE_AGENT); }
__device__ __forceinline__ unsigned xb_add(unsigned* p, unsigned v) { return __hip_atomic_fetch_add(p, v, __ATOMIC_RELAXED, __HIP_MEMORY_SCOPE_AGENT); }
__device__ __forceinline__ unsigned xb_xcc_id() { return (unsigned)__builtin_amdgcn_s_getreg((3 << 11) | 20) & 0xFu; }
#define XB_SPIN(cond, bar) do { unsigned _sp = 0; while (cond) { __builtin_amdgcn_s_sleep(1); \
    if ((++_sp & 255u) == 0u) { if (xb_ld(&(bar)[XB_TMO])) break; if (_sp > XB_SPIN_CAP) { atomicAdd(&(bar)[XB_TMO], 1u); break; } } } } while (0)
struct XcdBarrier { unsigned* bar; unsigned x; volatile LAS unsigned* st; };
__device__ __forceinline__ XcdBarrier xcd_barrier_post(unsigned* bar, volatile LAS unsigned* st) {
    XcdBarrier b; b.bar = bar; b.x = xb_xcc_id(); b.st = st;
    if (threadIdx.x == 0) (void)xb_add(&bar[XB_XCNT(b.x)], 1u);
    return b;
}
__device__ __forceinline__ void xcd_barrier_complete(unsigned* bar, unsigned x, unsigned& nloc, unsigned& nx) {
    const unsigned G = gridDim.x * gridDim.y * gridDim.z;
    unsigned sum, cnt, mine, sp = 0u;
    for (;;) {
        sum = 0u; cnt = 0u; mine = 0u;
#pragma unroll
        for (unsigned j = 0; j < 16; ++j) { const unsigned c = xb_ld(&bar[XB_XCNT(j)]); sum += c; cnt += (c > 0u) ? 1u : 0u; mine = (j == x) ? c : mine; }
        if (sum == G) break;
        __builtin_amdgcn_s_sleep(1);
        if ((++sp & 255u) == 0u) { if (xb_ld(&bar[XB_TMO])) break; if (sp > XB_SPIN_CAP) { atomicAdd(&bar[XB_TMO], 1u); break; } }
    }
    nloc = mine > 0u ? mine : 1u; nx = cnt > 0u ? cnt : 1u;
}
__device__ __forceinline__ void xcd_barrier(const XcdBarrier& b) {
    asm volatile("s_waitcnt vmcnt(0)" ::: "memory");
    __syncthreads();
    if (threadIdx.x == 0) {
        unsigned* bar = b.bar;
        __builtin_amdgcn_s_waitcnt(0);
        unsigned nloc = b.st[0], nx = b.st[1];
        if (nloc == 0u) { xcd_barrier_complete(bar, b.x, nloc, nx); b.st[0] = nloc; b.st[1] = nx; }
        const unsigned old = xb_add(&bar[XB_XSUB(b.x)], 1u);
        const unsigned gen = old / nloc;
        if (old + 1u == (gen + 1u) * nloc) {
            __builtin_amdgcn_fence(__ATOMIC_RELEASE, "agent");
            asm volatile("s_waitcnt vmcnt(0)" ::: "memory");
            const unsigned og = xb_add(&bar[XB_TOP], 1u);
            const unsigned tg = og / nx;
            if (og + 1u == (tg + 1u) * nx) xb_add(&bar[XB_TOPGEN], 1u);
            else XB_SPIN(xb_ld(&bar[XB_TOPGEN]) == tg, bar);
            __builtin_amdgcn_fence(__ATOMIC_ACQUIRE, "agent");
            xb_add(&bar[XB_XGEN(b.x)], 1u);
            asm volatile("s_waitcnt vmcnt(0)" ::: "memory");
        } else {
            XB_SPIN(xb_ld(&bar[XB_XGEN(b.x)]) == gen, bar);
            __builtin_amdgcn_fence(__ATOMIC_ACQUIRE, "agent");
            asm volatile("s_waitcnt vmcnt(0)" ::: "memory");
        }
    }
    __syncthreads();
}

struct Args {
    const float* in[27];
    float* out; unsigned char* ws;
    int ph_lo, ph_hi;
};
enum { I_X = 0, I_P, I_POS, I_GMIX, I_WIN, I_GQLAT, I_WQB, I_GKVLAT, I_WKVB, I_GQHEAD, I_GKNOPE, I_GKROPE, I_WPOOL, I_PSCALE, I_WAO, I_WPO, I_WO, I_GFFN,
       I_WR, I_BR, I_WGU, I_BGU, I_WD, I_BD, I_GPLE, I_WPG, I_WPLE };

enum { MAP_ID = 0, MAP_WIN, MAP_GU, MAP_QB, MAP_KVB };
__device__ __forceinline__ int map_row(int mode, int n) {
    switch (mode) {
    case MAP_WIN: return n < 416 ? n : n + 96;
    case MAP_GU: { const int j = n & 1023, up = n >> 10; return 256 * (j >> 7) + 128 * up + (j & 127); }
    case MAP_QB: { const int h = n / 96, d = n % 96;
        if (d < 64) return (h >> 2) * 256 + 128 * (d >> 5) + 32 * (h & 3) + (d & 31);
        const int dd = d - 64, half = dd >> 4, i = dd & 15; return 512 + 128 * (h & 1) + 32 * (h >> 1) + 8 * (i >> 2) + 4 * half + (i & 3); }
    case MAP_KVB: { const int h = n >> 7, c = n & 127, isv = c >> 6, d = c & 63; return (h >> 1) * 256 + 128 * (d >> 5) + 32 * (2 * isv + (h & 1)) + (d & 31); }
    default: return n;
    }
}
struct TJob { const float* W; int K, N; bf16_t* WT; int ldw, koff, mode, row_off; const float* gk; const float* gn; };
__device__ __forceinline__ void transpose_item(const TJob& J, LAS float* scr, int item, int lane) {
    const int nblk = J.N / 32, kb = item / nblk, nb = item % nblk, k0 = 64 * kb, n0 = 32 * nb;
    const float gnv = J.gn ? J.gn[n0 + (lane & 31)] : 1.f;
#pragma unroll 8
    for (int i = 0; i < 32; ++i) { const int kk = 2 * i + (lane >> 5); float v = J.W[(size_t)(k0 + kk) * J.N + n0 + (lane & 31)] * gnv; if (J.gk) v *= J.gk[k0 + kk]; scr[kk * 33 + (lane & 31)] = v; }
    asm volatile("s_waitcnt lgkmcnt(0)" ::: "memory");
    const int c = lane & 7;
#pragma unroll
    for (int j = 0; j < 4; ++j) { const int n = (lane >> 3) + 8 * j; const LAS float* s = scr + (8 * c) * 33 + n;
        u32x4 o; o.x = cvt_pk_bf16(s[0 * 33], s[1 * 33]); o.y = cvt_pk_bf16(s[2 * 33], s[3 * 33]); o.z = cvt_pk_bf16(s[4 * 33], s[5 * 33]); o.w = cvt_pk_bf16(s[6 * 33], s[7 * 33]);
        *(u32x4*)(J.WT + (size_t)(J.row_off + map_row(J.mode, n0 + n)) * J.ldw + J.koff + k0 + 8 * c) = o; }
    asm volatile("s_waitcnt lgkmcnt(0)" ::: "memory");
}

struct Frame {
    LAS unsigned char* lds; volatile LAS unsigned* MISC; unsigned* ctl;
    int tid, lane, wave, vcu, G;
    float* out; unsigned char* ws;
};

__device__ __forceinline__ void p0_prologue(const Frame& F, const Args& a) {
    LAS float* scr = (LAS float*)(F.lds + F.wave * 16384);
    const int gw = F.vcu * NWAVES + F.wave, NGW = F.G * NWAVES;
    unsigned char* ws = F.ws;
#define RUN_JOB(...) do { const TJob J_ = TJob{__VA_ARGS__}; const int items_ = (J_.K / 64) * (J_.N / 32); for (int it = gw; it < items_; it += NGW) transpose_item(J_, scr, it, F.lane); } while (0)
    RUN_JOB(a.in[I_WIN], 1024, 2976, (bf16_t*)(ws + WS_WIN), 1024, 0, MAP_WIN, 0, nullptr, nullptr);
    RUN_JOB(a.in[I_WQB], 256, 768, (bf16_t*)(ws + WS_WQ), 256, 0, MAP_QB, 0, a.in[I_GQLAT], nullptr);
    RUN_JOB(a.in[I_WKVB], 128, 1024, (bf16_t*)(ws + WS_WKV), 256, 0, MAP_KVB, 0, a.in[I_GKVLAT], nullptr);
    RUN_JOB(a.in[I_WAO], 512, 1024, (bf16_t*)(ws + WS_WAO), 512, 0, MAP_ID, 0, nullptr, nullptr);
    RUN_JOB(a.in[I_WPO], 512, 1024, (bf16_t*)(ws + WS_WPO), 512, 0, MAP_ID, 0, nullptr, nullptr);
    RUN_JOB(a.in[I_WO], 1024, 1024, (bf16_t*)(ws + WS_WO), 1024, 0, MAP_ID, 0, nullptr, nullptr);
    RUN_JOB(a.in[I_WPG], 1024, 1024, (bf16_t*)(ws + WS_WPG), 1024, 0, MAP_ID, 0, nullptr, nullptr);
    RUN_JOB(a.in[I_WPLE], 256, 1024, (bf16_t*)(ws + WS_WPLE), 256, 0, MAP_ID, 0, nullptr, nullptr);
    for (int g = 0; g < 4; ++g)
        RUN_JOB(a.in[I_WPOOL] + (size_t)g * 128 * 128, 128, 128, (bf16_t*)(ws + WS_WPOOL) + (size_t)(g >> 1) * 256 * 256, 256, 128 * (g & 1), MAP_ID, 128 * (g & 1), nullptr, a.in[I_PSCALE] + 128 * g);
    {
        const int gt = (F.vcu * NWAVES + F.wave) * 64 + F.lane, NGT = NGW * 64;
        const u32x4 z = {0u, 0u, 0u, 0u};
        u32x4* w0 = (u32x4*)((bf16_t*)(ws + WS_WIN) + (size_t)416 * 1024);
        for (int i = gt; i < 96 * 128; i += NGT) w0[i] = z;
        for (int i = gt; i < 1024 * 16; i += NGT) { const int r = i >> 4, c = i & 15; *(u32x4*)((bf16_t*)(ws + WS_WKV) + (size_t)r * 256 + 128 + 8 * c) = z; }
        for (int i = gt; i < 2 * 256 * 16; i += NGT) { const int p = i >> 12, r = (i >> 4) & 255, c = i & 15;
            const int k0 = (r < 128) ? 128 : 0; *(u32x4*)((bf16_t*)(ws + WS_WPOOL) + (size_t)p * 65536 + (size_t)r * 256 + k0 + 8 * c) = z; }
    }
    for (int e = 0; e < NEXP; ++e) {
        RUN_JOB(a.in[I_WGU] + (size_t)e * 1024 * 2048, 1024, 2048, (bf16_t*)(ws + WS_WGU) + (size_t)e * 2048 * 1024, 1024, 0, MAP_GU, 0, nullptr, nullptr);
    }
    for (int e = 0; e < NEXP; ++e) {
        RUN_JOB(a.in[I_WD] + (size_t)e * 1024 * 1024, 1024, 1024, (bf16_t*)(ws + WS_WD) + (size_t)e * 1024 * 1024, 1024, 0, MAP_ID, 0, nullptr, nullptr);
    }
    const float* x = a.in[I_X]; const float* gm = a.in[I_GMIX];
    f32x4 gv[4];
#pragma unroll
    for (int j = 0; j < 4; ++j) gv[j] = *(const f32x4*)(gm + 4 * F.lane + 256 * j);
    for (int m = gw; m < T; m += NGW) {
        const f32x4* xr = (const f32x4*)(x + (size_t)m * DM) + F.lane;
        f32x4 v[4]; float s = 0.f;
#pragma unroll
        for (int j = 0; j < 4; ++j) { v[j] = xr[64 * j]; s += (v[j].x * v[j].x + v[j].y * v[j].y) + (v[j].z * v[j].z + v[j].w * v[j].w); }
        const float rstd = 1.0f / sqrtf(wave_sum(s) * (1.f / DM) + EPS);
        u32x2* o8 = (u32x2*)((bf16_t*)(ws + WS_HN) + (size_t)m * DM) + F.lane;
#pragma unroll
        for (int j = 0; j < 4; ++j) { u32x2 w; w.x = cvt_pk_bf16(v[j].x * rstd * gv[j].x, v[j].y * rstd * gv[j].y); w.y = cvt_pk_bf16(v[j].z * rstd * gv[j].z, v[j].w * rstd * gv[j].w); o8[64 * j] = w; }
    }
    {
        const float* p = a.in[I_P];
        for (int m = gw; m < T; m += NGW) { const f32x4 v = *((const f32x4*)(p + (size_t)m * PLE) + F.lane); u32x2 w; w.x = cvt_pk_bf16(v.x, v.y); w.y = cvt_pk_bf16(v.z, v.w);
            *((u32x2*)((bf16_t*)(ws + WS_PB) + (size_t)m * PLE) + F.lane) = w; }
    }
}

struct DenseOrder {
    int nM, nN, nwg, G, c; const char* A; const char* B; size_t tA, tB, aPn;
    __device__ void init(int nM_, int nN_, int G_, int c_, const void* A_, size_t lda, const void* B_, size_t ldb, size_t aPn_ = 0) { nM = nM_; nN = nN_; nwg = nM * nN; G = G_; c = c_; A = (const char*)A_; B = (const char*)B_; tA = 256 * lda * 2; tB = 256 * ldb * 2; aPn = aPn_; }
    __device__ __forceinline__ bool next(int i, Unit& u) const {
        const long L = (long)i * G + c; if (L >= nwg) return false;
        int wgid = (int)L; { const int q = nwg / 8, r = nwg % 8, xcd = wgid % 8, off = wgid / 8; wgid = (xcd < r ? xcd * (q + 1) : r * (q + 1) + (xcd - r) * q) + off; }
        const int WGM = 8; const int nig = WGM * nN, gid = wgid / nig, fm = gid * WGM, gsz = (nM - fm) < WGM ? (nM - fm) : WGM;
        u.pm = fm + ((wgid % nig) % gsz); u.pn = (wgid % nig) / gsz; u.aux = 0; return true;
    }
    __device__ __forceinline__ const char* a_ptr(const Unit& u) const { return A + (size_t)u.pm * tA + (size_t)u.pn * aPn; }
    __device__ __forceinline__ const char* b_ptr(const Unit& u) const { return B + (size_t)u.pn * tB; }
};

struct EpiBf16 {
    static constexpr bool PERM = true;
    bf16_t* O; int ldc;
    __device__ __forceinline__ void operator()(const f32x4 (&acc)[2][2][4][2], const Unit& u, int wr, int wc, int fr, int fq) const {
        const int row0 = u.pm * 256 + wr * 64 + fr, col0 = u.pn * 256 + wc * 32 + 8 * fq;
#pragma unroll
        for (int ai = 0; ai < 2; ++ai)
#pragma unroll
            for (int m = 0; m < 4; ++m) { bf16_t* rowp = O + (size_t)(row0 + ai * 128 + m * 16) * ldc + col0;
#pragma unroll
                for (int bj = 0; bj < 2; ++bj) { const f32x4 v0 = acc[ai][bj][m][0], v1 = acc[ai][bj][m][1];
                    u32x4 w; w.x = cvt_pk_bf16(v0[0], v0[1]); w.y = cvt_pk_bf16(v0[2], v0[3]); w.z = cvt_pk_bf16(v1[0], v1[1]); w.w = cvt_pk_bf16(v1[2], v1[3]);
                    *(u32x4*)(rowp + bj * 128) = w; } }
    }
};
struct EpiProj {
    static constexpr bool PERM = true;
    bf16_t* PROJ; bf16_t* GATES;
    __device__ __forceinline__ void operator()(const f32x4 (&acc)[2][2][4][2], const Unit& u, int wr, int wc, int fr, int fq) const {
        const int row0 = u.pm * 256 + wr * 64 + fr; const bool isg = u.pn >= 4;
        bf16_t* O = isg ? GATES : PROJ; const int ldc = isg ? 2048 : 1024; const int col0 = (isg ? u.pn - 4 : u.pn) * 256 + wc * 32 + 8 * fq;
#pragma unroll
        for (int ai = 0; ai < 2; ++ai)
#pragma unroll
            for (int m = 0; m < 4; ++m) { bf16_t* rowp = O + (size_t)(row0 + ai * 128 + m * 16) * ldc + col0;
#pragma unroll
                for (int bj = 0; bj < 2; ++bj) { f32x4 v0 = acc[ai][bj][m][0], v1 = acc[ai][bj][m][1];
                    if (isg) {
#pragma unroll
                        for (int e = 0; e < 4; ++e) { v0[e] = fast_sigmoid(v0[e]); v1[e] = fast_sigmoid(v1[e]); } }
                    u32x4 w; w.x = cvt_pk_bf16(v0[0], v0[1]); w.y = cvt_pk_bf16(v0[2], v0[3]); w.z = cvt_pk_bf16(v1[0], v1[1]); w.w = cvt_pk_bf16(v1[2], v1[3]);
                    *(u32x4*)(rowp + bj * 128) = w; } asm volatile("" ::: "memory"); }
    }
};

__device__ __forceinline__ void p2_rows(const Frame& F, const Args& a) {
    const int gw = F.vcu * NWAVES + F.wave, NGW = F.G * NWAVES, lane = F.lane;
    unsigned char* ws = F.ws;
    const bf16_t* PROJ = (const bf16_t*)(ws + WS_PROJ);
    bf16_t* A2 = (bf16_t*)(ws + WS_A2); bf16_t* POOLED = (bf16_t*)(ws + WS_POOLED); bf16_t* Kb = (bf16_t*)(ws + WS_K);
    float* COS = (float*)(ws + WS_COS); float* SIN = (float*)(ws + WS_SIN);
    const int* positions = (const int*)a.in[I_POS];
    const float gkr = (lane < 32) ? a.in[I_GKROPE][lane] : 0.f;
    const float inv_freq = __builtin_amdgcn_exp2f(-(float)(lane & 15) * (13.287712379549449f / 16.0f));
    const int w = 2 << (lane >> 4);
    for (int task = gw; task < T / 8; task += NGW) {
        const int t0 = task * 8, b = t0 / SEQ, s0 = t0 % SEQ;
        {
            const bf16_t* base = PROJ + (size_t)(b * SEQ) * 1024 + 512 + 8 * lane;
            float S[8];
#pragma unroll
            for (int j = 0; j < 8; ++j) S[j] = 0.f;
            for (int r = s0 - 15; r < s0; ++r) {
                if (r >= 0 && r >= s0 - w + 1) { const u32x4 v = *(const u32x4*)(base + (size_t)r * 1024);
                    S[0] += bf_lo(v.x); S[1] += bf_hi(v.x); S[2] += bf_lo(v.y); S[3] += bf_hi(v.y); S[4] += bf_lo(v.z); S[5] += bf_hi(v.z); S[6] += bf_lo(v.w); S[7] += bf_hi(v.w); }
            }
#pragma unroll
            for (int i = 0; i < 8; ++i) {
                const int s = s0 + i;
                const u32x4 v = *(const u32x4*)(base + (size_t)s * 1024);
                float uu[8] = {bf_lo(v.x), bf_hi(v.x), bf_lo(v.y), bf_hi(v.y), bf_lo(v.z), bf_hi(v.z), bf_lo(v.w), bf_hi(v.w)};
                const int cnt = (s + 1 < w) ? s + 1 : w; const float ic = 1.0f / (float)cnt;
                float o[8];
#pragma unroll
                for (int j = 0; j < 8; ++j) { S[j] += uu[j]; o[j] = S[j] * ic - uu[j]; }
                u32x4 wv; wv.x = cvt_pk_bf16(o[0], o[1]); wv.y = cvt_pk_bf16(o[2], o[3]); wv.z = cvt_pk_bf16(o[4], o[5]); wv.w = cvt_pk_bf16(o[6], o[7]);
                *(u32x4*)(POOLED + (size_t)(t0 + i) * 512 + 8 * lane) = wv;
                const int rr = s - w + 1;
                if (rr >= 0) { const u32x4 q = *(const u32x4*)(base + (size_t)rr * 1024);
                    S[0] -= bf_lo(q.x); S[1] -= bf_hi(q.x); S[2] -= bf_lo(q.y); S[3] -= bf_hi(q.y); S[4] -= bf_lo(q.z); S[5] -= bf_hi(q.z); S[6] -= bf_lo(q.w); S[7] -= bf_hi(q.w); }
            }
        }
        for (int i = 0; i < 8; ++i) {
            const int t = t0 + i, s = s0 + i;
            const bf16_t* pr = PROJ + (size_t)t * 1024;
            const u32x2 ql = *(const u32x2*)(pr + 4 * lane);
            const unsigned kvl = *(const unsigned*)(pr + 256 + 2 * lane);
            const float krv = (lane < 32) ? bf1(pr[384 + lane]) : 0.f;
            const float q0 = bf_lo(ql.x), q1 = bf_hi(ql.x), q2 = bf_lo(ql.y), q3 = bf_hi(ql.y);
            const float k0 = bf_lo(kvl), k1 = bf_hi(kvl);
            const float sq = wave_sum((q0 * q0 + q1 * q1) + (q2 * q2 + q3 * q3));
            const float sk = wave_sum(k0 * k0 + k1 * k1);
            const float sr = wave_sum(krv * krv);
            const float rq = 1.0f / sqrtf(sq * (1.f / 256.f) + EPS), rk = 1.0f / sqrtf(sk * (1.f / 128.f) + EPS), rr = 1.0f / sqrtf(sr * (1.f / 32.f) + EPS);
            u32x2 wq; wq.x = cvt_pk_bf16(q0 * rq, q1 * rq); wq.y = cvt_pk_bf16(q2 * rq, q3 * rq);
            *(u32x2*)(A2 + (size_t)t * 512 + 4 * lane) = wq;
            *(unsigned*)(A2 + (size_t)t * 512 + 256 + 2 * lane) = cvt_pk_bf16(k0 * rk, k1 * rk);
            *(unsigned*)(A2 + (size_t)t * 512 + 384 + 2 * lane) = 0u;
            const float pos = (float)positions[t];
            const float ang = pos * inv_freq;
            const float rev = ang * 0.15915494309189535f;
            const float fr_ = rev - floorf(rev);
            const float sn = __builtin_amdgcn_sinf(fr_), cs = __builtin_amdgcn_cosf(fr_);
            const float kn = krv * rr * gkr;
            const float other = __shfl_xor(kn, 16);
            const float ro = (lane & 16) ? (kn * cs + other * sn) : (kn * cs - other * sn);
            if (lane < 32) {
                const bf16_t rb = (bf16_t)(cvt_pk_bf16(ro, 0.f) & 0xffffu);
#pragma unroll
                for (int h = 0; h < NH; ++h) Kb[((size_t)(b * NH + h) * SEQ + s) * DK + 64 + lane] = rb;
            }
            if (lane < 16) { COS[(size_t)t * 16 + lane] = cs; SIN[(size_t)t * 16 + lane] = sn; }
        }
    }
}

#define EPI_FENCE() asm volatile("" ::: "memory")
struct EpiQ {
    static constexpr bool PERM = true;
    bf16_t* Q; float* SSQ; const float* COS; const float* SIN; const float* gq;
    __device__ __forceinline__ void operator()(const f32x4 (&acc)[2][2][4][2], const Unit& u, int wr, int wc, int fr, int fq) const {
        const int t0 = u.pm * 256 + wr * 64 + fr, b = (u.pm * 256) / SEQ, s0 = t0 - b * SEQ;
        if (u.pn < 2) {
            const int h = 4 * u.pn + wc;
            bf16_t* dst0 = Q + ((size_t)(b * NH + h) * SEQ + s0) * DK + 8 * fq;
            float* ssq0 = SSQ + ((size_t)t0 * NH + h) * 2;
#pragma unroll
            for (int ai = 0; ai < 2; ++ai)
#pragma unroll
                for (int m = 0; m < 4; ++m) {
                    const int dr = ai * 128 + m * 16;
                    float q = 0.f;
#pragma unroll
                    for (int bj = 0; bj < 2; ++bj)
#pragma unroll
                        for (int n = 0; n < 2; ++n) { const f32x4 v = acc[ai][bj][m][n]; q += (v[0] * v[0] + v[1] * v[1]) + (v[2] * v[2] + v[3] * v[3]); }
                    q += __shfl_xor(q, 16); q += __shfl_xor(q, 32);
                    if (fq == 0) ssq0[dr * NH * 2] = q;
#pragma unroll
                    for (int bj = 0; bj < 2; ++bj) { const f32x4 v0 = acc[ai][bj][m][0] * *(const f32x4*)(gq + 32 * bj + 8 * fq), v1 = acc[ai][bj][m][1] * *(const f32x4*)(gq + 32 * bj + 8 * fq + 4);
                        u32x4 w; w.x = cvt_pk_bf16(v0[0], v0[1]); w.y = cvt_pk_bf16(v0[2], v0[3]); w.z = cvt_pk_bf16(v1[0], v1[1]); w.w = cvt_pk_bf16(v1[2], v1[3]);
                        *(u32x4*)(dst0 + dr * DK + 32 * bj) = w; }
                    EPI_FENCE();
                }
        } else {
            const f32x4 g1 = *(const f32x4*)(gq + 64 + 4 * fq), g2 = *(const f32x4*)(gq + 80 + 4 * fq);
            const float* cs0 = COS + (size_t)t0 * 16 + 4 * fq; const float* sn0 = SIN + (size_t)t0 * 16 + 4 * fq;
            bf16_t* dst0 = Q + ((size_t)(b * NH + 2 * wc) * SEQ + s0) * DK + 64 + 4 * fq;
            float* ssq0 = SSQ + ((size_t)t0 * NH + 2 * wc) * 2 + 1;
#pragma unroll
            for (int ai = 0; ai < 2; ++ai)
#pragma unroll
                for (int m = 0; m < 4; ++m) {
                    const int dr = ai * 128 + m * 16;
                    const f32x4 cs = *(const f32x4*)(cs0 + dr * 16), sn = *(const f32x4*)(sn0 + dr * 16);
#pragma unroll
                    for (int bj = 0; bj < 2; ++bj) {
                        const f32x4 x1 = acc[ai][bj][m][0], x2 = acc[ai][bj][m][1];
                        float q = (x1[0] * x1[0] + x1[1] * x1[1]) + (x1[2] * x1[2] + x1[3] * x1[3]) + (x2[0] * x2[0] + x2[1] * x2[1]) + (x2[2] * x2[2] + x2[3] * x2[3]);
                        q += __shfl_xor(q, 16); q += __shfl_xor(q, 32);
                        if (fq == 0) ssq0[dr * NH * 2 + bj * 2] = q;
                        const f32x4 y1 = x1 * g1, y2 = x2 * g2;
                        const f32x4 o1 = y1 * cs - y2 * sn, o2 = y2 * cs + y1 * sn;
                        bf16_t* dst = dst0 + (size_t)bj * SEQ * DK + dr * DK;
                        u32x2 w1, w2; w1.x = cvt_pk_bf16(o1[0], o1[1]); w1.y = cvt_pk_bf16(o1[2], o1[3]); w2.x = cvt_pk_bf16(o2[0], o2[1]); w2.y = cvt_pk_bf16(o2[2], o2[3]);
                        *(u32x2*)(dst) = w1; *(u32x2*)(dst + 16) = w2;
                    }
                    EPI_FENCE();
                }
        }
    }
};
struct EpiKV {
    static constexpr bool PERM = true;
    bf16_t* K; bf16_t* V; const float* gk;
    __device__ __forceinline__ void operator()(const f32x4 (&acc)[2][2][4][2], const Unit& u, int wr, int wc, int fr, int fq) const {
        const int t0 = u.pm * 256 + wr * 64 + fr, b = (u.pm * 256) / SEQ, s0 = t0 - b * SEQ;
        const int h = 2 * u.pn + (wc & 1); const bool isv = wc >= 2;
        const int pitch = isv ? DV : DK;
        bf16_t* dst0 = (isv ? V : K) + ((size_t)(b * NH + h) * SEQ + s0) * pitch + 8 * fq;
#pragma unroll
        for (int ai = 0; ai < 2; ++ai)
#pragma unroll
            for (int m = 0; m < 4; ++m) {
                const int dr = ai * 128 + m * 16;
                float sc = 1.f;
                if (!isv) { float q = 0.f;
#pragma unroll
                    for (int bj = 0; bj < 2; ++bj)
#pragma unroll
                        for (int n = 0; n < 2; ++n) { const f32x4 v = acc[ai][bj][m][n]; q += (v[0] * v[0] + v[1] * v[1]) + (v[2] * v[2] + v[3] * v[3]); }
                    q += __shfl_xor(q, 16); q += __shfl_xor(q, 32);
                    sc = 1.0f / sqrtf(q * (1.f / 64.f) + EPS); }
#pragma unroll
                for (int bj = 0; bj < 2; ++bj) {
                    f32x4 v0 = acc[ai][bj][m][0] * sc, v1 = acc[ai][bj][m][1] * sc;
                    if (!isv) { v0 = v0 * *(const f32x4*)(gk + 32 * bj + 8 * fq); v1 = v1 * *(const f32x4*)(gk + 32 * bj + 8 * fq + 4); }
                    u32x4 w; w.x = cvt_pk_bf16(v0[0], v0[1]); w.y = cvt_pk_bf16(v0[2], v0[3]); w.z = cvt_pk_bf16(v1[0], v1[1]); w.w = cvt_pk_bf16(v1[2], v1[3]);
                    *(u32x4*)(dst0 + dr * pitch + 32 * bj) = w; }
                EPI_FENCE();
            }
    }
};

namespace att {
constexpr int KROW = 208;
constexpr int KT_BYTES = 64 * KROW, VT_BYTES = 64 * 128, BUF_BYTES = KT_BYTES + VT_BYTES;
constexpr int SCR_OFF = 2 * BUF_BYTES;
__device__ __forceinline__ int crow(int r, int hi) { return (r & 3) + 8 * (r >> 2) + 4 * hi; }
__device__ __forceinline__ s16x4 vtr(const LAS unsigned char* p) { typedef short v4i16_t __attribute__((ext_vector_type(4)));
    return __builtin_bit_cast(s16x4, __builtin_amdgcn_ds_read_tr16_b64_v4i16((LAS v4i16_t*)p)); }

__device__ __forceinline__ void attn_unit(LAS unsigned char* lds, int bh, int qb, const bf16_t* Q, const bf16_t* K, const bf16_t* V, const float* SSQ, bf16_t* O) {
    const int tid = threadIdx.x, lane = tid & 63, r32 = lane & 31, hi = lane >> 5; const int wid = __builtin_amdgcn_readfirstlane(tid >> 6);
    const int b = bh / NH, h = bh % NH, q0 = qb * 256, qw = q0 + 32 * wid;
    const bf16_t* Kh = K + (size_t)bh * SEQ * DK; const bf16_t* Vh = V + (size_t)bh * SEQ * DV;
    LAS float* scr = (LAS float*)(lds + SCR_OFF) + wid * 64;
    bf16x8 qr[6];
    { const bf16_t* qp = Q + ((size_t)bh * SEQ + qw + r32) * DK + 8 * hi;
#pragma unroll
      for (int d0 = 0; d0 < 6; ++d0) qr[d0] = *(const bf16x8*)(qp + 16 * d0); }
    float cq;
    { const float* sp = SSQ + ((size_t)(b * SEQ + qw + r32) * NH + h) * 2; const float ss = sp[0] + sp[1];
      cq = (1.0f / sqrtf(ss * (1.f / 96.f) + EPS)) * 0.10206207261596577f * 1.4426950408889634f; }
    const int NT = (q0 + 256) / 64;
    const int kc0 = tid, kc1 = 512 + tid;
    const int kd0 = (kc0 / 12) * KROW + (kc0 % 12) * 16, kd1 = (kc1 / 12) * KROW + (kc1 % 12) * 16;
    const int vrow = tid >> 3, vd = KT_BYTES + vrow * 128 + (((tid & 7) * 16) ^ (((vrow >> 1) & 1) * 64));
    u32x4 sk0, sk1, sv;
#define ATT_LOAD(j) do { const u32x4* kg = (const u32x4*)(Kh + (size_t)(j) * 64 * DK); sk0 = kg[kc0]; if (tid < 256) sk1 = kg[kc1]; sv = ((const u32x4*)(Vh + (size_t)(j) * 64 * DV))[tid]; } while (0)
#define ATT_WRITE(buf) do { LAS unsigned char* bp = lds + (buf) * BUF_BYTES; *(LAS u32x4*)(bp + kd0) = sk0; if (tid < 256) *(LAS u32x4*)(bp + kd1) = sk1; *(LAS u32x4*)(bp + vd) = sv; } while (0)
    ATT_LOAD(0); ATT_WRITE(0);
    __syncthreads();
    const int kbase = r32 * KROW + hi * 16;
    const int qq = (lane & 15) >> 2, pp = lane & 3, dblk = (lane >> 4) & 1, swz = ((qq >> 1) & 1) * 64;
    const int vrow0 = 4 * hi + qq;
    const int vb0 = KT_BYTES + vrow0 * 128 + ((32 * dblk + 8 * pp) ^ swz);
    const int vb1 = KT_BYTES + vrow0 * 128 + ((64 + 32 * dblk + 8 * pp) ^ swz);
    f32x16 o0 = {}, o1 = {};
    float m_run = -1e30f, l_run = 0.f;
    for (int j = 0; j < NT; ++j) {
        const int buf = j & 1;
        if (j + 1 < NT) ATT_LOAD(j + 1);
        const int kb = 64 * j;
        if (kb <= qw + 31) {
            const LAS unsigned char* kp = lds + buf * BUF_BYTES + kbase;
            f32x16 p0 = {}, p1 = {};
#pragma unroll
            for (int d0 = 0; d0 < 6; ++d0) {
                const bf16x8 ka = *(const LAS bf16x8*)(kp + d0 * 32), kb2 = *(const LAS bf16x8*)(kp + 32 * KROW + d0 * 32);
                p0 = __builtin_amdgcn_mfma_f32_32x32x16_bf16(ka, qr[d0], p0, 0, 0, 0);
                p1 = __builtin_amdgcn_mfma_f32_32x32x16_bf16(kb2, qr[d0], p1, 0, 0, 0);
            }
#pragma unroll
            for (int r = 0; r < 16; ++r) { p0[r] *= cq; p1[r] *= cq; }
            if (kb + 63 > qw) {
                const int qa = qw + r32;
#pragma unroll
                for (int r = 0; r < 16; ++r) { const int ka_ = kb + crow(r, hi); if (ka_ > qa) p0[r] = -__builtin_inff(); if (ka_ + 32 > qa) p1[r] = -__builtin_inff(); }
            }
            float pm = p0[0];
#pragma unroll
            for (int r = 1; r < 16; ++r) pm = fmaxf(pm, p0[r]);
#pragma unroll
            for (int r = 0; r < 16; ++r) pm = fmaxf(pm, p1[r]);
            { auto rr = __builtin_amdgcn_permlane32_swap(__float_as_uint(pm), __float_as_uint(pm), false, false); pm = fmaxf(__uint_as_float(rr[0]), __uint_as_float(rr[1])); }
            if (__any(pm > m_run + 8.0f)) {
                const float mn = fmaxf(m_run, pm); const float al = __builtin_amdgcn_exp2f(m_run - mn); m_run = mn; l_run *= al;
                if (hi == 0) scr[r32] = al;
                asm volatile("s_waitcnt lgkmcnt(0)" ::: "memory");
#pragma unroll
                for (int a4 = 0; a4 < 4; ++a4) { const f32x4 f = *(const LAS f32x4*)(scr + 8 * a4 + 4 * hi);
#pragma unroll
                    for (int e = 0; e < 4; ++e) { o0[4 * a4 + e] *= f[e]; o1[4 * a4 + e] *= f[e]; } }
            }
            float ps = 0.f;
#pragma unroll
            for (int r = 0; r < 16; ++r) { p0[r] = __builtin_amdgcn_exp2f(p0[r] - m_run); p1[r] = __builtin_amdgcn_exp2f(p1[r] - m_run); ps += p0[r] + p1[r]; }
            l_run += ps;
            bf16x8 pa[4];
#pragma unroll
            for (int ks = 0; ks < 4; ++ks) { const f32x16& P = (ks < 2) ? p0 : p1; const int bs = 8 * (ks & 1);
                u32x4 w; w.x = cvt_pk_bf16(P[bs + 0], P[bs + 1]); w.y = cvt_pk_bf16(P[bs + 2], P[bs + 3]); w.z = cvt_pk_bf16(P[bs + 4], P[bs + 5]); w.w = cvt_pk_bf16(P[bs + 6], P[bs + 7]);
                pa[ks] = __builtin_bit_cast(bf16x8, w); }
            const LAS unsigned char* vp0 = lds + buf * BUF_BYTES + vb0; const LAS unsigned char* vp1 = lds + buf * BUF_BYTES + vb1;
#pragma unroll
            for (int ks = 0; ks < 4; ++ks) {
                const s16x4 a0 = vtr(vp0 + ks * 16 * 128), a1 = vtr(vp0 + ks * 16 * 128 + 8 * 128);
                const s16x4 c0 = vtr(vp1 + ks * 16 * 128), c1 = vtr(vp1 + ks * 16 * 128 + 8 * 128);
                const bf16x8 vf0 = {a0[0], a0[1], a0[2], a0[3], a1[0], a1[1], a1[2], a1[3]};
                const bf16x8 vf1 = {c0[0], c0[1], c0[2], c0[3], c1[0], c1[1], c1[2], c1[3]};
                o0 = __builtin_amdgcn_mfma_f32_32x32x16_bf16(pa[ks], vf0, o0, 0, 0, 0);
                o1 = __builtin_amdgcn_mfma_f32_32x32x16_bf16(pa[ks], vf1, o1, 0, 0, 0);
            }
        }
        if (j + 1 < NT) ATT_WRITE(buf ^ 1);
        __syncthreads();
    }
#undef ATT_LOAD
#undef ATT_WRITE
    { auto rr = __builtin_amdgcn_permlane32_swap(__float_as_uint(l_run), __float_as_uint(l_run), false, false); l_run = __uint_as_float(rr[0]) + __uint_as_float(rr[1]); }
    if (hi == 0) scr[32 + r32] = 1.0f / l_run;
    asm volatile("s_waitcnt lgkmcnt(0)" ::: "memory");
    bf16_t* Ow = O + ((size_t)(b * SEQ + qw)) * 512 + h * 64 + r32;
#pragma unroll
    for (int a4 = 0; a4 < 4; ++a4) { const f32x4 f = *(const LAS f32x4*)(scr + 32 + 8 * a4 + 4 * hi);
#pragma unroll
        for (int e = 0; e < 4; ++e) { const int r = 4 * a4 + e; const int row = crow(r, hi);
            Ow[(size_t)row * 512] = (bf16_t)(cvt_pk_bf16(o0[r] * f[e], 0.f) & 0xffffu);
            Ow[(size_t)row * 512 + 32] = (bf16_t)(cvt_pk_bf16(o1[r] * f[e], 0.f) & 0xffffu); } }
    __syncthreads();
}
}

struct MixOrder {
    int G, c; const char* ATT; const char* MIXED; const char* WAO; const char* WPO;
    __device__ __forceinline__ bool next(int i, Unit& u) const {
        const int tile = (i >> 1) * G + c; if (tile >= 256) return false;
        u.pm = tile >> 2; u.pn = tile & 3; u.aux = i & 1; return true;
    }
    __device__ __forceinline__ const char* a_ptr(const Unit& u) const { return (u.aux ? MIXED : ATT) + (size_t)u.pm * 256 * 512 * 2; }
    __device__ __forceinline__ const char* b_ptr(const Unit& u) const { return (u.aux ? WPO : WAO) + (size_t)u.pn * 256 * 512 * 2; }
};
struct EpiMix {
    static constexpr bool PERM = true;
    bf16_t* MIX; const bf16_t* GATES;
    __device__ __forceinline__ void operator()(const f32x4 (&acc)[2][2][4][2], const Unit& u, int wr, int wc, int fr, int fq) const {
        const int row0 = u.pm * 256 + wr * 64 + fr, col0 = u.pn * 256 + wc * 32 + 8 * fq;
#pragma unroll
        for (int ai = 0; ai < 2; ++ai)
#pragma unroll
            for (int m = 0; m < 4; ++m) { const size_t row = (size_t)(row0 + ai * 128 + m * 16);
#pragma unroll
                for (int bj = 0; bj < 2; ++bj) {
                    const u32x4 gw = *(const u32x4*)(GATES + row * 2048 + u.aux * 1024 + col0 + bj * 128);
                    const f32x4 v0 = acc[ai][bj][m][0], v1 = acc[ai][bj][m][1];
                    float r[8] = {v0[0] * bf_lo(gw.x), v0[1] * bf_hi(gw.x), v0[2] * bf_lo(gw.y), v0[3] * bf_hi(gw.y), v1[0] * bf_lo(gw.z), v1[1] * bf_hi(gw.z), v1[2] * bf_lo(gw.w), v1[3] * bf_hi(gw.w)};
                    bf16_t* dst = MIX + row * 1024 + col0 + bj * 128;
                    if (u.aux) { const u32x4 pw = *(const u32x4*)dst;
                        r[0] += bf_lo(pw.x); r[1] += bf_hi(pw.x); r[2] += bf_lo(pw.y); r[3] += bf_hi(pw.y); r[4] += bf_lo(pw.z); r[5] += bf_hi(pw.z); r[6] += bf_lo(pw.w); r[7] += bf_hi(pw.w); }
                    u32x4 w; w.x = cvt_pk_bf16(r[0], r[1]); w.y = cvt_pk_bf16(r[2], r[3]); w.z = cvt_pk_bf16(r[4], r[5]); w.w = cvt_pk_bf16(r[6], r[7]);
                    *(u32x4*)dst = w; } }
    }
};
struct EpiRes {
    static constexpr bool PERM = false;
    const float* base; float* out;
    __device__ __forceinline__ void operator()(const f32x4 (&acc)[2][2][4][2], const Unit& u, int wr, int wc, int fr, int fq) const {
        const int row0 = u.pm * 256 + wr * 64 + fr, col0 = u.pn * 256 + wc * 32 + 4 * fq;
#pragma unroll
        for (int ai = 0; ai < 2; ++ai)
#pragma unroll
            for (int m = 0; m < 4; ++m) { const size_t off = (size_t)(row0 + ai * 128 + m * 16) * DM + col0;
#pragma unroll
                for (int bj = 0; bj < 2; ++bj)
#pragma unroll
                    for (int n = 0; n < 2; ++n) *(f32x4*)(out + off + bj * 128 + n * 16) = *(const f32x4*)(base + off + bj * 128 + n * 16) + acc[ai][bj][m][n]; }
    }
};

constexpr int WR_PITCH = 1028;
constexpr int R_WR_OFF = 0, R_PART_OFF = 32 * WR_PITCH * 4, R_SSQ_OFF = R_PART_OFF + 2 * 64 * 33 * 4, R_CNT_OFF = R_SSQ_OFF + 2 * 64 * 4, R_BASE_OFF = R_CNT_OFF + 128, R_END = R_BASE_OFF + 128;
static_assert(R_END <= TILE_E_OFF, "router LDS map");
__device__ __forceinline__ void p7_router(const Frame& F, const Args& a) {
    LAS float* WR = (LAS float*)(F.lds + R_WR_OFF); LAS float* PART = (LAS float*)(F.lds + R_PART_OFF); LAS float* SSQP = (LAS float*)(F.lds + R_SSQ_OFF);
    LAS int* CNT = (LAS int*)(F.lds + R_CNT_OFF); LAS int* BASE = (LAS int*)(F.lds + R_BASE_OFF);
    const int tid = F.tid, lane = F.lane, wave = F.wave;
    const float* wr = a.in[I_WR]; const float* gf = a.in[I_GFFN];
    for (int i = tid; i < 1024 * 32; i += 512) { const int k = i >> 5, e = i & 31; WR[e * WR_PITCH + k] = wr[i] * gf[k]; }
    if (tid < 32) CNT[tid] = 0;
    __syncthreads();
    int* RE = (int*)(F.ws + WS_ROUTE); int* RP = RE + T * 4; float* RG = (float*)(RP + T * 4); float* RS = RG + T * 4;
    unsigned* gcnt = F.ctl + CW_CNT;
    const float* X1 = F.out;
    for (int blk = F.vcu; blk < T / 64; blk += F.G) {
        const int tb = blk * 64;
        {
            const int tg = wave & 3, kh = wave >> 2, r = lane & 15, kq = lane >> 4;
            const float* xp = X1 + (size_t)(tb + 16 * tg + r) * DM + 512 * kh + 4 * kq;
            const LAS float* w0 = WR + (lane & 15) * WR_PITCH + 512 * kh + 4 * kq; const LAS float* w1 = w0 + 16 * WR_PITCH;
            f32x4 acc0 = {0.f, 0.f, 0.f, 0.f}, acc1 = {0.f, 0.f, 0.f, 0.f}; float ss = 0.f;
#pragma unroll 4
            for (int i = 0; i < 32; ++i) {
                const f32x4 xv = *(const f32x4*)(xp + 16 * i);
                const f32x4 b0 = *(const LAS f32x4*)(w0 + 16 * i), b1 = *(const LAS f32x4*)(w1 + 16 * i);
                ss += (xv[0] * xv[0] + xv[1] * xv[1]) + (xv[2] * xv[2] + xv[3] * xv[3]);
#pragma unroll
                for (int j = 0; j < 4; ++j) { acc0 = __builtin_amdgcn_mfma_f32_16x16x4f32(xv[j], b0[j], acc0, 0, 0, 0); acc1 = __builtin_amdgcn_mfma_f32_16x16x4f32(xv[j], b1[j], acc1, 0, 0, 0); }
            }
            ss += __shfl_xor(ss, 16); ss += __shfl_xor(ss, 32);
            if (kq == 0) SSQP[kh * 64 + 16 * tg + r] = ss;
#pragma unroll
            for (int q = 0; q < 4; ++q) { const int tok = 16 * tg + 4 * kq + q; PART[(kh * 64 + tok) * 33 + (lane & 15)] = acc0[q]; PART[(kh * 64 + tok) * 33 + 16 + (lane & 15)] = acc1[q]; }
        }
        __syncthreads();
        int te[4] = {0, 0, 0, 0}, lp[4] = {0, 0, 0, 0}; float tv[4] = {-3e38f, -3e38f, -3e38f, -3e38f}; float rstd = 0.f;
        if (tid < 64) {
            const float ssq = SSQP[tid] + SSQP[64 + tid]; rstd = 1.0f / sqrtf(ssq * (1.f / DM) + EPS);
            const float* br = a.in[I_BR];
#pragma unroll
            for (int e = 0; e < 32; ++e) {
                float v = (PART[tid * 33 + e] + PART[(64 + tid) * 33 + e]) * rstd + br[e]; int id = e;
#pragma unroll
                for (int s = 0; s < 4; ++s) { const bool gt = v > tv[s]; const float ov = tv[s]; const int oi = te[s]; tv[s] = gt ? v : ov; te[s] = gt ? id : oi; v = gt ? ov : v; id = gt ? oi : id; }
            }
#pragma unroll
            for (int s = 0; s < 4; ++s) lp[s] = __hip_atomic_fetch_add(&CNT[te[s]], 1, __ATOMIC_RELAXED, __HIP_MEMORY_SCOPE_WORKGROUP);
        }
        __syncthreads();
        if (tid < 32) { const int c = CNT[tid]; BASE[tid] = c ? (int)atomicAdd(gcnt + tid, (unsigned)c) : 0; }
        __syncthreads();
        if (tid < 64) {
            const int t = tb + tid;
            const float e1 = __expf(tv[1] - tv[0]), e2 = __expf(tv[2] - tv[0]), e3 = __expf(tv[3] - tv[0]); const float inv = 1.0f / (1.0f + e1 + e2 + e3);
            const float gts[4] = {inv, e1 * inv, e2 * inv, e3 * inv};
#pragma unroll
            for (int s = 0; s < 4; ++s) { RE[t * 4 + s] = te[s]; RP[t * 4 + s] = BASE[te[s]] + lp[s]; RG[t * 4 + s] = gts[s]; }
            RS[t] = rstd;
        }
        __syncthreads();
        if (tid < 32) CNT[tid] = 0;
        __syncthreads();
    }
}

__device__ __forceinline__ int build_tiles(const Frame& F) {
    LAS int* TB = (LAS int*)(F.lds + TILE_E_OFF); LAS int* TE = TB + 64;
    if (F.tid == 0) { int acc = 0; for (int e = 0; e < NEXP; ++e) { TB[e] = acc; const int c = (int)__hip_atomic_load(F.ctl + CW_CNT + e, RLX_AGENT); acc += (c + 255) >> 8; } TB[NEXP] = acc; }
    __syncthreads();
    if (F.tid < NEXP) { for (int t = TB[F.tid]; t < TB[F.tid + 1]; ++t) TE[t] = F.tid; }
    __syncthreads();
    return TB[NEXP];
}

__device__ __forceinline__ void p8_dispatch(const Frame& F, const Args& a) {
    (void)build_tiles(F);
    const LAS int* TB = (const LAS int*)(F.lds + TILE_E_OFF);
    const int gw = F.vcu * NWAVES + F.wave, NGW = F.G * NWAVES, lane = F.lane;
    const int* RE = (const int*)(F.ws + WS_ROUTE); const int* RP = RE + T * 4; const float* RS = (const float*)(RP + T * 4) + T * 4; int* SL = (int*)(RS + T);
    const float* X1 = F.out; const float* gf = a.in[I_GFFN]; bf16_t* XS = (bf16_t*)(F.ws + WS_XS);
    f32x4 g[2][2];
#pragma unroll
    for (int j = 0; j < 2; ++j) { g[j][0] = *(const f32x4*)(gf + 512 * j + 8 * lane); g[j][1] = *(const f32x4*)(gf + 512 * j + 8 * lane + 4); }
    for (int t = gw; t < T; t += NGW) {
        const float rstd = RS[t];
        u32x4 w[2];
#pragma unroll
        for (int j = 0; j < 2; ++j) { const f32x4 v0 = *(const f32x4*)(X1 + (size_t)t * DM + 512 * j + 8 * lane) * g[j][0] * rstd, v1 = *(const f32x4*)(X1 + (size_t)t * DM + 512 * j + 8 * lane + 4) * g[j][1] * rstd;
            w[j].x = cvt_pk_bf16(v0[0], v0[1]); w[j].y = cvt_pk_bf16(v0[2], v0[3]); w[j].z = cvt_pk_bf16(v1[0], v1[1]); w[j].w = cvt_pk_bf16(v1[2], v1[3]); }
#pragma unroll
        for (int s = 0; s < 4; ++s) { const int e = RE[t * 4 + s], slot = TB[e] * 256 + RP[t * 4 + s];
            if (lane == 0) SL[t * 4 + s] = slot;
            bf16_t* dst = XS + (size_t)slot * DM + 8 * lane;
            *(u32x4*)dst = w[0]; *(u32x4*)(dst + 512) = w[1]; }
    }
}

struct MoeOrder {
    int G, c, ntn_shift, total; const LAS int* TE; const char* A; const char* Bw; size_t bexp, btile;
    __device__ __forceinline__ bool next(int i, Unit& u) const {
        const int L = i * G + c; if (L >= total) return false;
        u.pm = L >> ntn_shift; u.pn = L & ((1 << ntn_shift) - 1); u.aux = TE[u.pm]; return true;
    }
    __device__ __forceinline__ const char* a_ptr(const Unit& u) const { return A + (size_t)u.pm * 256 * 1024 * 2; }
    __device__ __forceinline__ const char* b_ptr(const Unit& u) const { return Bw + (size_t)u.aux * bexp + (size_t)u.pn * btile; }
};
struct EpiSwiglu {
    static constexpr bool PERM = true;
    bf16_t* ACT; const float* bgu;
    __device__ __forceinline__ void operator()(const f32x4 (&acc)[2][2][4][2], const Unit& u, int wr, int wc, int fr, int fq) const {
        const int row0 = u.pm * 256 + wr * 64 + fr, j0 = u.pn * 128 + wc * 32 + 8 * fq;
        const float* bb = bgu + (size_t)u.aux * 2048 + j0;
        const f32x4 bg0 = *(const f32x4*)(bb), bg1 = *(const f32x4*)(bb + 4), bu0 = *(const f32x4*)(bb + 1024), bu1 = *(const f32x4*)(bb + 1028);
#pragma unroll
        for (int ai = 0; ai < 2; ++ai)
#pragma unroll
            for (int m = 0; m < 4; ++m) {
                const f32x4 g0 = acc[ai][0][m][0] + bg0, g1 = acc[ai][0][m][1] + bg1, u0 = acc[ai][1][m][0] + bu0, u1 = acc[ai][1][m][1] + bu1;
                float r[8];
#pragma unroll
                for (int e = 0; e < 4; ++e) {
                    { const float gg = fminf(g0[e], 7.0f), uu = fminf(fmaxf(u0[e], -7.0f), 7.0f); r[e] = (uu + 1.0f) * gg * fast_sigmoid(1.702f * gg); }
                    { const float gg = fminf(g1[e], 7.0f), uu = fminf(fmaxf(u1[e], -7.0f), 7.0f); r[4 + e] = (uu + 1.0f) * gg * fast_sigmoid(1.702f * gg); }
                }
                u32x4 w; w.x = cvt_pk_bf16(r[0], r[1]); w.y = cvt_pk_bf16(r[2], r[3]); w.z = cvt_pk_bf16(r[4], r[5]); w.w = cvt_pk_bf16(r[6], r[7]);
                *(u32x4*)(ACT + (size_t)(row0 + ai * 128 + m * 16) * DEXP + j0) = w;
            }
    }
};
struct EpiDown {
    static constexpr bool PERM = true;
    bf16_t* Y; const float* bd;
    __device__ __forceinline__ void operator()(const f32x4 (&acc)[2][2][4][2], const Unit& u, int wr, int wc, int fr, int fq) const {
        const int row0 = u.pm * 256 + wr * 64 + fr, col0 = u.pn * 256 + wc * 32 + 8 * fq;
        const float* bb = bd + (size_t)u.aux * DM + col0;
        f32x4 bv[2][2];
#pragma unroll
        for (int bj = 0; bj < 2; ++bj) { bv[bj][0] = *(const f32x4*)(bb + bj * 128); bv[bj][1] = *(const f32x4*)(bb + bj * 128 + 4); }
#pragma unroll
        for (int ai = 0; ai < 2; ++ai)
#pragma unroll
            for (int m = 0; m < 4; ++m) { bf16_t* rowp = Y + (size_t)(row0 + ai * 128 + m * 16) * DM + col0;
#pragma unroll
                for (int bj = 0; bj < 2; ++bj) { const f32x4 v0 = acc[ai][bj][m][0] + bv[bj][0], v1 = acc[ai][bj][m][1] + bv[bj][1];
                    u32x4 w; w.x = cvt_pk_bf16(v0[0], v0[1]); w.y = cvt_pk_bf16(v0[2], v0[3]); w.z = cvt_pk_bf16(v1[0], v1[1]); w.w = cvt_pk_bf16(v1[2], v1[3]);
                    *(u32x4*)(rowp + bj * 128) = w; } }
    }
};

__device__ __forceinline__ void p11_combine(const Frame& F, const Args& a) {
    const int gw = F.vcu * NWAVES + F.wave, NGW = F.G * NWAVES, lane = F.lane;
    const int* RE = (const int*)(F.ws + WS_ROUTE); const float* RG = (const float*)(RE + T * 8); const int* SL = (const int*)(RG + T * 4 + T);
    const bf16_t* Y = (const bf16_t*)(F.ws + WS_XS); bf16_t* HP = (bf16_t*)(F.ws + WS_HN); float* X = F.out; const float* gp = a.in[I_GPLE];
    f32x4 g[2][2];
#pragma unroll
    for (int j = 0; j < 2; ++j) { g[j][0] = *(const f32x4*)(gp + 512 * j + 8 * lane); g[j][1] = *(const f32x4*)(gp + 512 * j + 8 * lane + 4); }
    for (int t = gw; t < T; t += NGW) {
        f32x4 v[2][2];
#pragma unroll
        for (int j = 0; j < 2; ++j) { v[j][0] = *(const f32x4*)(X + (size_t)t * DM + 512 * j + 8 * lane); v[j][1] = *(const f32x4*)(X + (size_t)t * DM + 512 * j + 8 * lane + 4); }
#pragma unroll
        for (int s = 0; s < 4; ++s) { const int slot = SL[t * 4 + s]; const float gt = RG[t * 4 + s];
#pragma unroll
            for (int j = 0; j < 2; ++j) { const u32x4 y = *(const u32x4*)(Y + (size_t)slot * DM + 512 * j + 8 * lane);
                v[j][0] += (f32x4){bf_lo(y.x), bf_hi(y.x), bf_lo(y.y), bf_hi(y.y)} * gt; v[j][1] += (f32x4){bf_lo(y.z), bf_hi(y.z), bf_lo(y.w), bf_hi(y.w)} * gt; } }
        float ss = 0.f;
#pragma unroll
        for (int j = 0; j < 2; ++j)
#pragma unroll
            for (int n = 0; n < 2; ++n) { const f32x4 q = v[j][n]; ss += (q[0] * q[0] + q[1] * q[1]) + (q[2] * q[2] + q[3] * q[3]); *(f32x4*)(X + (size_t)t * DM + 512 * j + 8 * lane + 4 * n) = q; }
        const float rstd = 1.0f / sqrtf(wave_sum(ss) * (1.f / DM) + EPS);
#pragma unroll
        for (int j = 0; j < 2; ++j) { const f32x4 q0 = v[j][0] * g[j][0] * rstd, q1 = v[j][1] * g[j][1] * rstd;
            u32x4 w; w.x = cvt_pk_bf16(q0[0], q0[1]); w.y = cvt_pk_bf16(q0[2], q0[3]); w.z = cvt_pk_bf16(q1[0], q1[1]); w.w = cvt_pk_bf16(q1[2], q1[3]);
            *(u32x4*)(HP + (size_t)t * DM + 512 * j + 8 * lane) = w; }
    }
}
struct EpiPle {
    static constexpr bool PERM = false;
    float* out; const bf16_t* E;
    __device__ __forceinline__ void operator()(const f32x4 (&acc)[2][2][4][2], const Unit& u, int wr, int wc, int fr, int fq) const {
        const int row0 = u.pm * 256 + wr * 64 + fr, col0 = u.pn * 256 + wc * 32 + 4 * fq;
#pragma unroll
        for (int ai = 0; ai < 2; ++ai)
#pragma unroll
            for (int m = 0; m < 4; ++m) { const size_t off = (size_t)(row0 + ai * 128 + m * 16) * DM + col0;
#pragma unroll
                for (int bj = 0; bj < 2; ++bj)
#pragma unroll
                    for (int n = 0; n < 2; ++n) { const size_t o = off + bj * 128 + n * 16; const u32x2 ev = *(const u32x2*)(E + o); const f32x4 a4 = acc[ai][bj][m][n];
                        f32x4 r = *(const f32x4*)(out + o);
                        r[0] += fast_sigmoid(a4[0]) * bf_lo(ev.x); r[1] += fast_sigmoid(a4[1]) * bf_hi(ev.x); r[2] += fast_sigmoid(a4[2]) * bf_lo(ev.y); r[3] += fast_sigmoid(a4[3]) * bf_hi(ev.y);
                        *(f32x4*)(out + o) = r; } }
    }
};

constexpr int N_PHASES = 13;
__global__ void __launch_bounds__(NWAVES * 64, 2) fwd_kernel(Args args) {
    extern __shared__ __attribute__((aligned(16))) unsigned char lds_raw[];
    Frame F;
    F.lds = (LAS unsigned char*)lds_raw; F.MISC = (volatile LAS unsigned*)(F.lds + MISC_OFF);
    F.tid = threadIdx.x; F.lane = F.tid & 63; F.wave = __builtin_amdgcn_readfirstlane(F.tid >> 6);
    F.G = gridDim.x; { const int bx = blockIdx.x; F.vcu = (F.G % 8 == 0) ? (bx % 8) * (F.G / 8) + bx / 8 : bx; }
    F.out = args.out; F.ws = args.ws; F.ctl = (unsigned*)(args.ws + WS_CTL);
    if (F.tid < 32) F.MISC[F.tid] = 0u;
    __syncthreads();
    const int lo = args.ph_lo, hi = args.ph_hi;
    const bool multi = (hi - lo) > 1;
    XcdBarrier bar; bar.bar = F.ctl + CW_BAR; bar.x = 0; bar.st = nullptr;
    if (multi) bar = xcd_barrier_post(F.ctl + CW_BAR, F.MISC);
#ifndef PH_MASK
#define PH_MASK 0x1fff
#endif
#define IN(k) ((((PH_MASK) >> (k)) & 1) && lo <= (k) && (k) < hi)
#define SEAM(k) do { if (IN(k) && IN((k) + 1)) xcd_barrier(bar); } while (0)
    unsigned char* ws = args.ws;
    LAS unsigned char* ring = F.lds;

    if (IN(0)) { p0_prologue(F, args); } SEAM(0);

    if (IN(1)) {
        { DenseOrder S; S.init(64, 12, F.G, (int)blockIdx.x, ws + WS_HN, 1024, ws + WS_WIN, 1024);
          EpiProj E{(bf16_t*)(ws + WS_PROJ), (bf16_t*)(ws + WS_GATES)};
          pg8::gemm_phase<EpiProj, DenseOrder, true, true>(ring, pg8::Shape{1024, 1024, 1024}, S, E); }
        { DenseOrder S; S.init(64, 4, F.G, (int)blockIdx.x, ws + WS_PB, 256, ws + WS_WPLE, 256);
          EpiBf16 E{(bf16_t*)(ws + WS_E), 1024};
          pg8::gemm_phase<EpiBf16, DenseOrder, true, true>(ring, pg8::Shape{256, 256, 256}, S, E); }
    } SEAM(1);

    if (IN(2)) { p2_rows(F, args); } SEAM(2);

    if (IN(3)) {
#ifndef P3M
#define P3M 7
#endif
        if (P3M & 1) { DenseOrder S; S.init(64, 4, F.G, (int)blockIdx.x, ws + WS_A2 + 512, 512, ws + WS_WKV, 256);
          EpiKV E{(bf16_t*)(ws + WS_K), (bf16_t*)(ws + WS_V), args.in[I_GKNOPE]};
          pg8::gemm_phase<EpiKV, DenseOrder, true, true>(ring, pg8::Shape{256, 512, 256}, S, E); }
        if (P3M & 2) { DenseOrder S; S.init(64, 3, F.G, (int)blockIdx.x, ws + WS_A2, 512, ws + WS_WQ, 256);
          EpiQ E{(bf16_t*)(ws + WS_Q), (float*)(ws + WS_SSQ), (const float*)(ws + WS_COS), (const float*)(ws + WS_SIN), args.in[I_GQHEAD]};
          pg8::gemm_phase<EpiQ, DenseOrder, true, true>(ring, pg8::Shape{256, 512, 256}, S, E); }
        if (P3M & 4) { DenseOrder S; S.init(64, 2, F.G, (int)blockIdx.x, ws + WS_POOLED, 512, ws + WS_WPOOL, 256, 512);
          EpiBf16 E{(bf16_t*)(ws + WS_MIXED), 512};
          pg8::gemm_phase<EpiBf16, DenseOrder, true, true>(ring, pg8::Shape{256, 512, 256}, S, E); }
    } SEAM(3);

    if (IN(4)) {
        for (int it = F.vcu; it < 256; it += F.G) {
            const int bh = it >> 3, pr = it & 7;
            att::attn_unit(ring, bh, 15 - pr, (const bf16_t*)(ws + WS_Q), (const bf16_t*)(ws + WS_K), (const bf16_t*)(ws + WS_V), (const float*)(ws + WS_SSQ), (bf16_t*)(ws + WS_ATT));
            att::attn_unit(ring, bh, pr, (const bf16_t*)(ws + WS_Q), (const bf16_t*)(ws + WS_K), (const bf16_t*)(ws + WS_V), (const float*)(ws + WS_SSQ), (bf16_t*)(ws + WS_ATT));
        }
    } SEAM(4);

    if (IN(5)) {
        MixOrder S{F.G, (int)blockIdx.x, (const char*)(ws + WS_ATT), (const char*)(ws + WS_MIXED), (const char*)(ws + WS_WAO), (const char*)(ws + WS_WPO)};
        EpiMix E{(bf16_t*)(ws + WS_MIX), (const bf16_t*)(ws + WS_GATES)};
        pg8::gemm_phase<EpiMix, MixOrder, true, true>(ring, pg8::Shape{512, 512, 512}, S, E);
    } SEAM(5);

    if (IN(6)) {
        DenseOrder S; S.init(64, 4, F.G, (int)blockIdx.x, ws + WS_MIX, 1024, ws + WS_WO, 1024);
        EpiRes E{args.in[I_X], args.out};
        pg8::gemm_phase<EpiRes, DenseOrder, true, true>(ring, pg8::Shape{1024, 1024, 1024}, S, E);
    } SEAM(6);

    if (IN(7)) { p7_router(F, args); } SEAM(7);

    if (IN(8)) { p8_dispatch(F, args); } SEAM(8);

    if (IN(9)) {
        const int TM = build_tiles(F);
        MoeOrder S{F.G, (int)blockIdx.x, 3, TM * 8, (const LAS int*)(F.lds + TILE_E_OFF) + 64, (const char*)(ws + WS_XS), (const char*)(ws + WS_WGU), (size_t)2048 * 1024 * 2, (size_t)256 * 1024 * 2};
        EpiSwiglu E{(bf16_t*)(ws + WS_ACT), args.in[I_BGU]};
        pg8::gemm_phase<EpiSwiglu, MoeOrder, true, true>(ring, pg8::Shape{1024, 1024, 1024}, S, E);
    } SEAM(9);

    if (IN(10)) {
        const int TM = build_tiles(F);
        MoeOrder S{F.G, (int)blockIdx.x, 2, TM * 4, (const LAS int*)(F.lds + TILE_E_OFF) + 64, (const char*)(ws + WS_ACT), (const char*)(ws + WS_WD), (size_t)1024 * 1024 * 2, (size_t)256 * 1024 * 2};
        EpiDown E{(bf16_t*)(ws + WS_XS), args.in[I_BD]};
        pg8::gemm_phase<EpiDown, MoeOrder, true, true>(ring, pg8::Shape{1024, 1024, 1024}, S, E);
    } SEAM(10);

    if (IN(11)) { p11_combine(F, args); } SEAM(11);

    if (IN(12)) {
        DenseOrder S; S.init(64, 4, F.G, (int)blockIdx.x, ws + WS_HN, 1024, ws + WS_WPG, 1024);
        EpiPle E{args.out, (const bf16_t*)(ws + WS_E)};
        pg8::gemm_phase<EpiPle, DenseOrder, true, true>(ring, pg8::Shape{1024, 1024, 1024}, S, E);
    }
#undef IN
#undef SEAM
}

#ifndef N_LAUNCHES
#define N_LAUNCHES 1
#endif
extern "C" void kernel_launch(void* const* d_in, const int* in_sizes, int n_in, void* d_out, int out_size, void* d_ws, size_t ws_size, hipStream_t stream) {
    static int grid = 0;
    if (grid == 0) {
        if (n_in != 27 || out_size != T * DM || ws_size < WS_END) { fprintf(stderr, "kernel_launch: unexpected shapes (n_in %d, out %d, ws %zu)\n", n_in, out_size, ws_size); grid = -1; return; }
        int dev = 0, cus = 0;
        if (hipGetDevice(&dev) != hipSuccess || hipDeviceGetAttribute(&cus, hipDeviceAttributeMultiprocessorCount, dev) != hipSuccess) { grid = -1; return; }
        if (hipFuncSetAttribute((const void*)fwd_kernel, hipFuncAttributeMaxDynamicSharedMemorySize, LDS_BYTES) != hipSuccess) { fprintf(stderr, "kernel_launch: hipFuncSetAttribute failed\n"); grid = -1; return; }
        int per_cu = 0;
        if (hipOccupancyMaxActiveBlocksPerMultiprocessor(&per_cu, (const void*)fwd_kernel, NWAVES * 64, LDS_BYTES) != hipSuccess || per_cu < 1) fprintf(stderr, "kernel_launch: occupancy query says %d\n", per_cu);
        (void)hipGetLastError();
        grid = cus;
    }
    if (grid < 0) return;
    (void)hipMemsetAsync((char*)d_ws + WS_CTL, 0, CTL_ZERO_BYTES, stream);
    Args a{};
    for (int i = 0; i < 27; ++i) a.in[i] = (const float*)d_in[i];
    a.out = (float*)d_out; a.ws = (unsigned char*)d_ws;
    if (N_LAUNCHES == 1) { a.ph_lo = 0; a.ph_hi = N_PHASES; hipLaunchKernelGGL(fwd_kernel, dim3(grid), dim3(NWAVES * 64), LDS_BYTES, stream, a); }
    else { for (int p = 0; p < N_PHASES; ++p) { a.ph_lo = p; a.ph_hi = p + 1; hipLaunchKernelGGL(fwd_kernel, dim3(grid), dim3(NWAVES * 64), LDS_BYTES, stream, a); } }
}
```

```cpp
#include <hip/hip_runtime.h>
#include <cstdio>
#include <cstdint>

#define LAS __attribute__((address_space(3)))
#define GAS __attribute__((address_space(1)))
typedef unsigned short bf16_t;
typedef short bf16x8 __attribute__((ext_vector_type(8)));
typedef short s16x4 __attribute__((ext_vector_type(4)));
typedef float f32x4 __attribute__((ext_vector_type(4)));
typedef float f32x2 __attribute__((ext_vector_type(2)));
typedef float f32x16 __attribute__((ext_vector_type(16)));
typedef unsigned u32x4 __attribute__((ext_vector_type(4)));
typedef unsigned u32x2 __attribute__((ext_vector_type(2)));

constexpr int NB = 4, SEQ = 4096, T = NB * SEQ, DM = 1024, NH = 8, DK = 96, DV = 64;
constexpr int NEXP = 32, TOPK = 4, DEXP = 1024, PLE = 256;
constexpr float EPS = 1e-6f;
constexpr int XS_ROWS = T * TOPK + NEXP * 256;

__device__ __forceinline__ unsigned cvt_pk_bf16(float lo, float hi) { unsigned r; asm volatile("v_cvt_pk_bf16_f32 %0, %1, %2" : "=v"(r) : "v"(lo), "v"(hi)); return r; }
__device__ __forceinline__ float bf_lo(unsigned w) { return __uint_as_float(w << 16); }
__device__ __forceinline__ float bf_hi(unsigned w) { return __uint_as_float(w & 0xffff0000u); }
__device__ __forceinline__ float bf1(bf16_t h) { return __uint_as_float(((unsigned)h) << 16); }
__device__ __forceinline__ float fast_sigmoid(float v) { return __builtin_amdgcn_rcpf(1.0f + __builtin_amdgcn_exp2f(-1.4426950408889634f * v)); }
__device__ __forceinline__ float wave_sum(float v) {
#pragma unroll
    for (int o = 1; o < 64; o <<= 1) v += __shfl_xor(v, o);
    return v;
}

namespace pg8 {
constexpr int BM = 256, BK = 64, HALF = 128, HTB = HALF * BK * 2, STAGE_BYTES = 8 * HTB;
__host__ __device__ __forceinline__ int lds_byte(int r, int c) { const int st = (r >> 4) * 2 + (c >> 5), rr = r & 15, cc = c & 31, ob = rr * 64 + cc * 2; return st * 1024 + (ob ^ (((ob >> 9) & 1) << 5)); }
__host__ __device__ __forceinline__ void stage_rc(int b, int& R, int& C) { const int st = b / 1024, sb = b % 1024, swz = sb ^ (((sb >> 9) & 1) << 5); R = (st >> 1) * 16 + swz / 64; C = (st & 1) * 32 + (swz % 64) / 2; }
__host__ __device__ __forceinline__ int perm32(int rho) { const int n = rho >> 4, i = rho & 15; return 8 * (i >> 2) + 4 * n + (i & 3); }

struct Unit { int pm, pn, aux; };
struct Shape { int K, lda, ldb; };

template <class Epi, class Sched, bool ALIGN_EPI, bool SP2>
__device__ __forceinline__ void gemm_phase(LAS unsigned char* lds, const Shape g, const Sched& S, const Epi& E) {
    const int tid = threadIdx.x, wid = __builtin_amdgcn_readfirstlane(tid >> 6), lane = tid & 63, wr = wid >> 2, wc = wid & 3, fr = lane & 15, fq = lane >> 4;
    int nt = g.K / BK; asm volatile("" : "+s"(nt));
    unsigned voffA[2], voffB[2];
#pragma unroll
    for (int i = 0; i < 2; ++i) { int R, C; stage_rc(tid * 16 + i * 8192, R, C); const int Rb = Epi::PERM ? ((R & ~31) + perm32(R & 31)) : R;
        voffA[i] = (unsigned)(R * g.lda + C) * 2u; voffB[i] = (unsigned)(Rb * g.ldb + C) * 2u; }
    const size_t kstep = (size_t)(BK * 2);
    const size_t hstepA = (size_t)HALF * g.lda * 2, hstepB = (size_t)HALF * g.ldb * 2;
    const unsigned ldsw = (unsigned)wid * 1024u;
    const int aoff = lds_byte(wr * 64 + fr, fq * 8), boff = lds_byte(wc * 32 + fr, fq * 8);
#define PG8_SA(b, h) (((b) * 2 + (h)) * HTB)
#define PG8_SB(b, h) ((4 + (b) * 2 + (h)) * HTB)
#define PG8_STAGE(bufoff, gbase, voff) do { _Pragma("unroll") for (int _i = 0; _i < 2; ++_i) \
        __builtin_amdgcn_global_load_lds((const unsigned*)((const char*)(gbase) + (voff)[_i]), (LAS unsigned*)(lds + (bufoff) + ldsw + _i * 8192), 16, 0, 0); } while (0)
#define PG8_LDA(dst, b, h) do { _Pragma("unroll") for (int m = 0; m < 4; ++m) _Pragma("unroll") for (int k = 0; k < 2; ++k) dst[m][k] = *(const LAS bf16x8*)(lds + PG8_SA(b, h) + aoff + m * 2048 + k * 1024); } while (0)
#define PG8_LDB(dst, b, h) do { _Pragma("unroll") for (int n = 0; n < 2; ++n) _Pragma("unroll") for (int k = 0; k < 2; ++k) dst[n][k] = *(const LAS bf16x8*)(lds + PG8_SB(b, h) + boff + n * 2048 + k * 1024); } while (0)
#define PG8_MMA(ai, bj, At, Bt) do { __builtin_amdgcn_s_setprio(1); _Pragma("unroll") for (int m = 0; m < 4; ++m) _Pragma("unroll") for (int n = 0; n < 2; ++n) _Pragma("unroll") for (int k = 0; k < 2; ++k) \
        acc[ai][bj][m][n] = __builtin_amdgcn_mfma_f32_16x16x32_bf16(Bt[n][k], At[m][k], acc[ai][bj][m][n], 0, 0, 0); __builtin_amdgcn_s_setprio(0); } while (0)
#define PG8_WAIT_V(n) asm volatile("s_waitcnt vmcnt(" #n ")" ::: "memory")
#define PG8_WAIT_L(n) asm volatile("s_waitcnt lgkmcnt(" #n ")" ::: "memory")
#define PG8_BAR __builtin_amdgcn_s_barrier()
#define PG8_SCHED __builtin_amdgcn_sched_barrier(0)
    Unit cur, nxt; int ui = 0;
    if (!S.next(0, cur)) return;
    f32x4 acc[2][2][4][2];
#pragma unroll
    for (int a = 0; a < 2; ++a)
#pragma unroll
        for (int b = 0; b < 2; ++b)
#pragma unroll
            for (int m = 0; m < 4; ++m)
#pragma unroll
                for (int n = 0; n < 2; ++n) acc[a][b][m][n] = (f32x4){0.f, 0.f, 0.f, 0.f};
    bf16x8 At[4][2], B0[2][2], B1[2][2];
    const char* cA = S.a_ptr(cur); const char* cB = S.b_ptr(cur);
    if constexpr (SP2) {
        PG8_STAGE(PG8_SB(0, 0), cB, voffB); PG8_STAGE(PG8_SB(0, 1), cB + hstepB, voffB); PG8_STAGE(PG8_SA(0, 0), cA, voffA); PG8_STAGE(PG8_SA(0, 1), cA + hstepA, voffA);
        if (wr == 1) PG8_BAR;
        PG8_WAIT_V(2); PG8_BAR;
        PG8_STAGE(PG8_SB(1, 0), cB + kstep, voffB); PG8_STAGE(PG8_SA(1, 0), cA + kstep, voffA); PG8_STAGE(PG8_SB(1, 1), cB + hstepB + kstep, voffB);
        PG8_WAIT_V(6); PG8_BAR;
    } else {
        PG8_STAGE(PG8_SB(0, 0), cB, voffB); PG8_STAGE(PG8_SA(0, 0), cA, voffA); PG8_STAGE(PG8_SB(0, 1), cB + hstepB, voffB); PG8_STAGE(PG8_SA(0, 1), cA + hstepA, voffA);
        if (wr == 1) PG8_BAR;
        PG8_WAIT_V(4); PG8_BAR;
        PG8_STAGE(PG8_SB(1, 0), cB + kstep, voffB); PG8_STAGE(PG8_SA(1, 0), cA + kstep, voffA); PG8_STAGE(PG8_SB(1, 1), cB + hstepB + kstep, voffB);
        PG8_WAIT_V(6); PG8_BAR;
    }
    for (;;) {
        const bool has_next = S.next(ui + 1, nxt);
        const char* nA = has_next ? S.a_ptr(nxt) : cA; const char* nB = has_next ? S.b_ptr(nxt) : cB;
#pragma nounroll
        for (int t = 0; t < nt; t += 2) {
            const bool last = (t == nt - 2);
            const char* a1 = cA + (size_t)(t + 1) * kstep;
            const char* a2 = last ? nA : cA + (size_t)(t + 2) * kstep; const char* b2 = last ? nB : cB + (size_t)(t + 2) * kstep;
            const char* a3 = a2 + kstep; const char* b3 = b2 + kstep;
            if constexpr (SP2) {
            PG8_LDB(B0, 0, 0); PG8_LDB(B1, 0, 1); PG8_SCHED; PG8_LDA(At, 0, 0); PG8_STAGE(PG8_SA(1, 1), a1 + hstepA, voffA);
            PG8_WAIT_V(8); PG8_WAIT_L(0); PG8_BAR; PG8_MMA(0, 0, At, B0); PG8_MMA(0, 1, At, B1); PG8_BAR; PG8_SCHED;
            PG8_LDA(At, 0, 1); PG8_STAGE(PG8_SB(0, 0), b2, voffB); PG8_STAGE(PG8_SB(0, 1), b2 + hstepB, voffB); PG8_STAGE(PG8_SA(0, 0), a2, voffA);
            PG8_WAIT_V(8); PG8_WAIT_L(0); PG8_BAR; PG8_MMA(1, 0, At, B0); PG8_MMA(1, 1, At, B1); PG8_BAR; PG8_SCHED;
            PG8_LDB(B0, 1, 0); PG8_LDB(B1, 1, 1); PG8_SCHED; PG8_LDA(At, 1, 0); PG8_STAGE(PG8_SA(0, 1), a2 + hstepA, voffA);
            PG8_WAIT_V(8); PG8_WAIT_L(0); PG8_BAR; PG8_MMA(0, 0, At, B0); PG8_MMA(0, 1, At, B1); PG8_BAR; PG8_SCHED;
            PG8_LDA(At, 1, 1); PG8_STAGE(PG8_SB(1, 0), b3, voffB); PG8_STAGE(PG8_SB(1, 1), b3 + hstepB, voffB); PG8_STAGE(PG8_SA(1, 0), a3, voffA);
            PG8_WAIT_V(8); PG8_WAIT_L(0); PG8_BAR; PG8_MMA(1, 0, At, B0); PG8_MMA(1, 1, At, B1); PG8_BAR; PG8_SCHED;
            } else {
            PG8_LDB(B0, 0, 0); PG8_SCHED; PG8_LDA(At, 0, 0); PG8_STAGE(PG8_SA(1, 1), a1 + hstepA, voffA);
            PG8_WAIT_L(8); PG8_BAR; PG8_WAIT_L(0); PG8_MMA(0, 0, At, B0); PG8_BAR; PG8_SCHED;
            PG8_LDB(B1, 0, 1); PG8_STAGE(PG8_SB(0, 0), b2, voffB);
            PG8_BAR; PG8_WAIT_L(0); PG8_MMA(0, 1, At, B1); PG8_BAR;
            PG8_LDA(At, 0, 1); PG8_STAGE(PG8_SA(0, 0), a2, voffA);
            PG8_BAR; PG8_WAIT_L(0); PG8_MMA(1, 0, At, B0); PG8_BAR; PG8_SCHED;
            PG8_STAGE(PG8_SB(0, 1), b2 + hstepB, voffB);
            PG8_WAIT_V(6); PG8_BAR; PG8_MMA(1, 1, At, B1); PG8_BAR;
            PG8_LDB(B0, 1, 0); PG8_SCHED; PG8_LDA(At, 1, 0); PG8_STAGE(PG8_SA(0, 1), a2 + hstepA, voffA);
            PG8_WAIT_L(8); PG8_BAR; PG8_WAIT_L(0); PG8_MMA(0, 0, At, B0); PG8_BAR; PG8_SCHED;
            PG8_LDB(B1, 1, 1); PG8_STAGE(PG8_SB(1, 0), b3, voffB);
            PG8_BAR; PG8_WAIT_L(0); PG8_MMA(0, 1, At, B1); PG8_BAR;
            PG8_LDA(At, 1, 1); PG8_STAGE(PG8_SA(1, 0), a3, voffA);
            PG8_BAR; PG8_WAIT_L(0); PG8_MMA(1, 0, At, B0); PG8_BAR; PG8_SCHED;
            PG8_STAGE(PG8_SB(1, 1), b3 + hstepB, voffB);
            PG8_WAIT_V(6); PG8_BAR; PG8_MMA(1, 1, At, B1); PG8_BAR;
            }
        }
        if constexpr (ALIGN_EPI) { if (wr == 0) PG8_BAR; }
        E(acc, cur, wr, wc, fr, fq);
        if (!has_next) break;
#pragma unroll
        for (int a = 0; a < 2; ++a)
#pragma unroll
            for (int b = 0; b < 2; ++b)
#pragma unroll
                for (int m = 0; m < 4; ++m)
#pragma unroll
                    for (int n = 0; n < 2; ++n) acc[a][b][m][n] = (f32x4){0.f, 0.f, 0.f, 0.f};
        cur = nxt; cA = nA; cB = nB; ++ui;
        if constexpr (ALIGN_EPI) { if (wr == 1) PG8_BAR; }
    }
    PG8_WAIT_V(0);
    if constexpr (!ALIGN_EPI) { if (wr == 0) PG8_BAR; }
    PG8_BAR;
#undef PG8_SA
#undef PG8_SB
#undef PG8_STAGE
#undef PG8_LDA
#undef PG8_LDB
#undef PG8_MMA
#undef PG8_WAIT_V
#undef PG8_WAIT_L
#undef PG8_BAR
#undef PG8_SCHED
}
}
using pg8::Unit;

constexpr size_t MiB = 1u << 20;
constexpr size_t WS_CTL = 0, CTL_ZERO_BYTES = 1 * MiB;
constexpr size_t WS_WIN = 1 * MiB;
constexpr size_t WS_WQ = 7 * MiB;
constexpr size_t WS_WKV = WS_WQ + 512 * 1024;
constexpr size_t WS_WPOOL = 8 * MiB;
constexpr size_t WS_WAO = 9 * MiB;
constexpr size_t WS_WPO = 10 * MiB;
constexpr size_t WS_WO = 11 * MiB;
constexpr size_t WS_WPG = 13 * MiB;
constexpr size_t WS_WPLE = 15 * MiB;
constexpr size_t WS_WGU = 16 * MiB;
constexpr size_t WS_WD = 144 * MiB;
constexpr size_t WS_HN = 208 * MiB;
constexpr size_t WS_PROJ = 240 * MiB;
constexpr size_t WS_GATES = 272 * MiB;
constexpr size_t WS_A2 = 336 * MiB;
constexpr size_t WS_POOLED = 352 * MiB;
constexpr size_t WS_Q = 368 * MiB;
constexpr size_t WS_K = 392 * MiB;
constexpr size_t WS_V = 416 * MiB;
constexpr size_t WS_ATT = 432 * MiB;
constexpr size_t WS_MIXED = 448 * MiB;
constexpr size_t WS_MIX = 464 * MiB;
constexpr size_t WS_PB = 496 * MiB;
constexpr size_t WS_E = 504 * MiB;
constexpr size_t WS_SSQ = 536 * MiB;
constexpr size_t WS_COS = 537 * MiB;
constexpr size_t WS_SIN = 538 * MiB;
constexpr size_t WS_ROUTE = 539 * MiB;
constexpr size_t WS_XS = 544 * MiB;
constexpr size_t WS_ACT = 688 * MiB;
constexpr size_t WS_END = 832 * MiB;
constexpr int CW_BAR = 4096;
constexpr int CW_CNT = 1024;

constexpr int RING_BYTES = 131072;
constexpr int LDS_BYTES = 163840;
constexpr int MISC_OFF = LDS_BYTES - 512;
constexpr int TILE_E_OFF = LDS_BYTES - 4096;
constexpr int NWAVES = 8;

typedef GAS unsigned gu32;
#define RLX_AGENT __ATOMIC_RELAXED, __HIP_MEMORY_SCOPE_AGENT
#define XB_TMO      128
#define XB_XCNT(j)  (256  + 64 * (j))
#define XB_XSUB(j)  (1280 + 64 * (j))
#define XB_XGEN(j)  (2304 + 64 * (j))
#define XB_TOP      3328
#define XB_TOPGEN   3392
#define XCD_BAR_WORDS 3456
#define XB_SPIN_CAP (1u << 18)
__device__ __forceinline__ unsigned xb_ld(unsigned* p)              { return __hip_atomic_load(p, __ATOMIC_RELAXED, __HIP_MEMORY_SCOPE_AGENT); }
__device__ __forceinline__ unsigned xb_add(unsigned* p, unsigned v) { return __hip_atomic_fetch_add(p, v, __ATOMIC_RELAXED, __HIP_MEMORY_SCOPE_AGENT); }
__device__ __forceinline__ unsigned xb_xcc_id() { return (unsigned)__builtin_amdgcn_s_getreg((3 << 11) | 20) & 0xFu; }
#define XB_SPIN(cond, bar) do { unsigned _sp = 0; while (cond) { __builtin_amdgcn_s_sleep(1); \
    if ((++_sp & 255u) == 0u) { if (xb_ld(&(bar)[XB_TMO])) break; if (_sp > XB_SPIN_CAP) { atomicAdd(&(bar)[XB_TMO], 1u); break; } } } } while (0)
struct XcdBarrier { unsigned* bar; unsigned x; volatile LAS unsigned* st; };
__device__ __forceinline__ XcdBarrier xcd_barrier_post(unsigned* bar, volatile LAS unsigned* st) {
    XcdBarrier b; b.bar = bar; b.x = xb_xcc_id(); b.st = st;
    if (threadIdx.x == 0) (void)xb_add(&bar[XB_XCNT(b.x)], 1u);
    return b;
}
__device__ __forceinline__ void xcd_barrier_complete(unsigned* bar, unsigned x, unsigned& nloc, unsigned& nx) {
    const unsigned G = gridDim.x * gridDim.y * gridDim.z;
    unsigned sum, cnt, mine, sp = 0u;
    for (;;) {
        sum = 0u; cnt = 0u; mine = 0u;
#pragma unroll
        for (unsigned j = 0; j < 16; ++j) { const unsigned c = xb_ld(&bar[XB_XCNT(j)]); sum += c; cnt += (c > 0u) ? 1u : 0u; mine = (j == x) ? c : mine; }
        if (sum == G) break;
        __builtin_amdgcn_s_sleep(1);
        if ((++sp & 255u) == 0u) { if (xb_ld(&bar[XB_TMO])) break; if (sp > XB_SPIN_CAP) { atomicAdd(&bar[XB_TMO], 1u); break; } }
    }
    nloc = mine > 0u ? mine : 1u; nx = cnt > 0u ? cnt : 1u;
}
__device__ __forceinline__ void xcd_barrier(const XcdBarrier& b) {
    asm volatile("s_waitcnt vmcnt(0)" ::: "memory");
    __syncthreads();
    if (threadIdx.x == 0) {
        unsigned* bar = b.bar;
        __builtin_amdgcn_s_waitcnt(0);
        unsigned nloc = b.st[0], nx = b.st[1];
        if (nloc == 0u) { xcd_barrier_complete(bar, b.x, nloc, nx); b.st[0] = nloc; b.st[1] = nx; }
        const unsigned old = xb_add(&bar[XB_XSUB(b.x)], 1u);
        const unsigned gen = old / nloc;
        if (old + 1u == (gen + 1u) * nloc) {
            __builtin_amdgcn_fence(__ATOMIC_RELEASE, "agent");
            asm volatile("s_waitcnt vmcnt(0)" ::: "memory");
            const unsigned og = xb_add(&bar[XB_TOP], 1u);
            const unsigned tg = og / nx;
            if (og + 1u == (tg + 1u) * nx) xb_add(&bar[XB_TOPGEN], 1u);
            else XB_SPIN(xb_ld(&bar[XB_TOPGEN]) == tg, bar);
            __builtin_amdgcn_fence(__ATOMIC_ACQUIRE, "agent");
            xb_add(&bar[XB_XGEN(b.x)], 1u);
            asm volatile("s_waitcnt vmcnt(0)" ::: "memory");
        } else {
            XB_SPIN(xb_ld(&bar[XB_XGEN(b.x)]) == gen, bar);
            __builtin_amdgcn_fence(__ATOMIC_ACQUIRE, "agent");
            asm volatile("s_waitcnt vmcnt(0)" ::: "memory");
        }
    }
    __syncthreads();
}

struct Args {
    const float* in[27];
    float* out; unsigned char* ws;
    int ph_lo, ph_hi;
};
enum { I_X = 0, I_P, I_POS, I_GMIX, I_WIN, I_GQLAT, I_WQB, I_GKVLAT, I_WKVB, I_GQHEAD, I_GKNOPE, I_GKROPE, I_WPOOL, I_PSCALE, I_WAO, I_WPO, I_WO, I_GFFN,
       I_WR, I_BR, I_WGU, I_BGU, I_WD, I_BD, I_GPLE, I_WPG, I_WPLE };

enum { MAP_ID = 0, MAP_WIN, MAP_GU, MAP_QB, MAP_KVB };
__device__ __forceinline__ int map_row(int mode, int n) {
    switch (mode) {
    case MAP_WIN: return n < 416 ? n : n + 96;
    case MAP_GU: { const int j = n & 1023, up = n >> 10; return 256 * (j >> 7) + 128 * up + (j & 127); }
    case MAP_QB: { const int h = n / 96, d = n % 96;
        if (d < 64) return (h >> 2) * 256 + 128 * (d >> 5) + 32 * (h & 3) + (d & 31);
        const int dd = d - 64, half = dd >> 4, i = dd & 15; return 512 + 128 * (h & 1) + 32 * (h >> 1) + 8 * (i >> 2) + 4 * half + (i & 3); }
    case MAP_KVB: { const int h = n >> 7, c = n & 127, isv = c >> 6, d = c & 63; return (h >> 1) * 256 + 128 * (d >> 5) + 32 * (2 * isv + (h & 1)) + (d & 31); }
    default: return n;
    }
}
struct TJob { const float* W; int K, N; bf16_t* WT; int ldw, koff, mode, row_off; const float* gk; const float* gn; int nmat; size_t wstride, wtstride; };
struct TItem { const float* src; bf16_t* dst; int n0, k0; float gnv; };
__device__ __forceinline__ TItem titem_setup(const TJob& J, int item, int lane) {
    const int nblk = J.N / 32, ipm = (J.K / 64) * nblk, mat = item / ipm, it = item - mat * ipm, kb = it / nblk, nb = it - kb * nblk;
    TItem I; I.k0 = 64 * kb; I.n0 = 32 * nb;
    I.src = J.W + (size_t)mat * J.wstride + (size_t)(I.k0 + (lane >> 5)) * J.N + I.n0 + (lane & 31);
    I.dst = J.WT + (size_t)mat * J.wtstride;
    I.gnv = J.gn ? J.gn[I.n0 + (lane & 31)] : 1.f;
    return I;
}
__device__ __forceinline__ void titem_load(const TJob& J, const TItem& I, float (&v)[32]) {
#pragma unroll
    for (int i = 0; i < 32; ++i) v[i] = I.src[(size_t)(2 * i) * J.N];
}
__device__ __forceinline__ void titem_store(const TJob& J, const TItem& I, float (&v)[32], LAS float* scr, int lane) {
#pragma unroll
    for (int i = 0; i < 32; ++i) { const int kk = 2 * i + (lane >> 5); float x = v[i] * I.gnv; if (J.gk) x *= J.gk[I.k0 + kk]; scr[kk * 33 + (lane & 31)] = x; }
    asm volatile("s_waitcnt lgkmcnt(0)" ::: "memory");
    const int c = lane & 7;
#pragma unroll
    for (int j = 0; j < 4; ++j) { const int n = (lane >> 3) + 8 * j; const LAS float* s = scr + (8 * c) * 33 + n;
        u32x4 o; o.x = cvt_pk_bf16(s[0 * 33], s[1 * 33]); o.y = cvt_pk_bf16(s[2 * 33], s[3 * 33]); o.z = cvt_pk_bf16(s[4 * 33], s[5 * 33]); o.w = cvt_pk_bf16(s[6 * 33], s[7 * 33]);
        *(u32x4*)(I.dst + (size_t)(J.row_off + map_row(J.mode, I.n0 + n)) * J.ldw + J.koff + I.k0 + 8 * c) = o; }
    asm volatile("s_waitcnt lgkmcnt(0)" ::: "memory");
}
__device__ __forceinline__ void run_job(const TJob& J, LAS float* scr, int gw, int NGW, int lane) {
    const int items = J.nmat * (J.K / 64) * (J.N / 32);
    for (int it = gw; it < items; it += 2 * NGW) {
        const bool two = (it + NGW) < items;
        const TItem I0 = titem_setup(J, it, lane); const TItem I1 = titem_setup(J, two ? it + NGW : it, lane);
        float v0[32], v1[32];
        titem_load(J, I0, v0); if (two) titem_load(J, I1, v1);
        titem_store(J, I0, v0, scr, lane); if (two) titem_store(J, I1, v1, scr, lane);
    }
}

struct Frame {
    LAS unsigned char* lds; volatile LAS unsigned* MISC; unsigned* ctl;
    int tid, lane, wave, vcu, G;
    float* out; unsigned char* ws;
};

__device__ __forceinline__ void p0_prologue(const Frame& F, const Args& a) {
    LAS float* scr = (LAS float*)(F.lds + F.wave * 16384);
    const int gw = F.vcu * NWAVES + F.wave, NGW = F.G * NWAVES;
    unsigned char* ws = F.ws;
#define RUN_JOB(...) do { const TJob J_ = TJob{__VA_ARGS__, 1, 0, 0}; run_job(J_, scr, gw, NGW, F.lane); } while (0)
    RUN_JOB(a.in[I_WIN], 1024, 2976, (bf16_t*)(ws + WS_WIN), 1024, 0, MAP_WIN, 0, nullptr, nullptr);
    RUN_JOB(a.in[I_WQB], 256, 768, (bf16_t*)(ws + WS_WQ), 256, 0, MAP_QB, 0, a.in[I_GQLAT], nullptr);
    RUN_JOB(a.in[I_WKVB], 128, 1024, (bf16_t*)(ws + WS_WKV), 256, 0, MAP_KVB, 0, a.in[I_GKVLAT], nullptr);
    RUN_JOB(a.in[I_WAO], 512, 1024, (bf16_t*)(ws + WS_WAO), 512, 0, MAP_ID, 0, nullptr, nullptr);
    RUN_JOB(a.in[I_WPO], 512, 1024, (bf16_t*)(ws + WS_WPO), 512, 0, MAP_ID, 0, nullptr, nullptr);
    RUN_JOB(a.in[I_WO], 1024, 1024, (bf16_t*)(ws + WS_WO), 1024, 0, MAP_ID, 0, nullptr, nullptr);
    RUN_JOB(a.in[I_WPG], 1024, 1024, (bf16_t*)(ws + WS_WPG), 1024, 0, MAP_ID, 0, nullptr, nullptr);
    RUN_JOB(a.in[I_WPLE], 256, 1024, (bf16_t*)(ws + WS_WPLE), 256, 0, MAP_ID, 0, nullptr, nullptr);
    for (int g = 0; g < 4; ++g)
        RUN_JOB(a.in[I_WPOOL] + (size_t)g * 128 * 128, 128, 128, (bf16_t*)(ws + WS_WPOOL) + (size_t)(g >> 1) * 256 * 256, 256, 128 * (g & 1), MAP_ID, 128 * (g & 1), nullptr, a.in[I_PSCALE] + 128 * g);
    {
        const int gt = (F.vcu * NWAVES + F.wave) * 64 + F.lane, NGT = NGW * 64;
        const u32x4 z = {0u, 0u, 0u, 0u};
        u32x4* w0 = (u32x4*)((bf16_t*)(ws + WS_WIN) + (size_t)416 * 1024);
        for (int i = gt; i < 96 * 128; i += NGT) w0[i] = z;
        for (int i = gt; i < 1024 * 16; i += NGT) { const int r = i >> 4, c = i & 15; *(u32x4*)((bf16_t*)(ws + WS_WKV) + (size_t)r * 256 + 128 + 8 * c) = z; }
        for (int i = gt; i < 2 * 256 * 16; i += NGT) { const int p = i >> 12, r = (i >> 4) & 255, c = i & 15;
            const int k0 = (r < 128) ? 128 : 0; *(u32x4*)((bf16_t*)(ws + WS_WPOOL) + (size_t)p * 65536 + (size_t)r * 256 + k0 + 8 * c) = z; }
    }
    { const TJob J{a.in[I_WGU], 1024, 2048, (bf16_t*)(ws + WS_WGU), 1024, 0, MAP_GU, 0, nullptr, nullptr, NEXP, (size_t)1024 * 2048, (size_t)2048 * 1024}; run_job(J, scr, gw, NGW, F.lane); }
    { const TJob J{a.in[I_WD], 1024, 1024, (bf16_t*)(ws + WS_WD), 1024, 0, MAP_ID, 0, nullptr, nullptr, NEXP, (size_t)1024 * 1024, (size_t)1024 * 1024}; run_job(J, scr, gw, NGW, F.lane); }
    const float* x = a.in[I_X]; const float* gm = a.in[I_GMIX];
    f32x4 gv[4];
#pragma unroll
    for (int j = 0; j < 4; ++j) gv[j] = *(const f32x4*)(gm + 4 * F.lane + 256 * j);
    for (int m = gw; m < T; m += NGW) {
        const f32x4* xr = (const f32x4*)(x + (size_t)m * DM) + F.lane;
        f32x4 v[4]; float s = 0.f;
#pragma unroll
        for (int j = 0; j < 4; ++j) { v[j] = xr[64 * j]; s += (v[j].x * v[j].x + v[j].y * v[j].y) + (v[j].z * v[j].z + v[j].w * v[j].w); }
        const float rstd = 1.0f / sqrtf(wave_sum(s) * (1.f / DM) + EPS);
        u32x2* o8 = (u32x2*)((bf16_t*)(ws + WS_HN) + (size_t)m * DM) + F.lane;
#pragma unroll
        for (int j = 0; j < 4; ++j) { u32x2 w; w.x = cvt_pk_bf16(v[j].x * rstd * gv[j].x, v[j].y * rstd * gv[j].y); w.y = cvt_pk_bf16(v[j].z * rstd * gv[j].z, v[j].w * rstd * gv[j].w); o8[64 * j] = w; }
    }
    {
        const float* p = a.in[I_P];
        for (int m = gw; m < T; m += NGW) { const f32x4 v = *((const f32x4*)(p + (size_t)m * PLE) + F.lane); u32x2 w; w.x = cvt_pk_bf16(v.x, v.y); w.y = cvt_pk_bf16(v.z, v.w);
            *((u32x2*)((bf16_t*)(ws + WS_PB) + (size_t)m * PLE) + F.lane) = w; }
    }
}

struct DenseOrder {
    int nM, nN, nwg, G, c; const char* A; const char* B; size_t tA, tB, aPn;
    __device__ void init(int nM_, int nN_, int G_, int c_, const void* A_, size_t lda, const void* B_, size_t ldb, size_t aPn_ = 0) { nM = nM_; nN = nN_; nwg = nM * nN; G = G_; c = c_; A = (const char*)A_; B = (const char*)B_; tA = 256 * lda * 2; tB = 256 * ldb * 2; aPn = aPn_; }
    __device__ __forceinline__ bool next(int i, Unit& u) const {
        const long L = (long)i * G + c; if (L >= nwg) return false;
        int wgid = (int)L; { const int q = nwg / 8, r = nwg % 8, xcd = wgid % 8, off = wgid / 8; wgid = (xcd < r ? xcd * (q + 1) : r * (q + 1) + (xcd - r) * q) + off; }
        const int WGM = 8; const int nig = WGM * nN, gid = wgid / nig, fm = gid * WGM, gsz = (nM - fm) < WGM ? (nM - fm) : WGM;
        u.pm = fm + ((wgid % nig) % gsz); u.pn = (wgid % nig) / gsz; u.aux = 0; return true;
    }
    __device__ __forceinline__ const char* a_ptr(const Unit& u) const { return A + (size_t)u.pm * tA + (size_t)u.pn * aPn; }
    __device__ __forceinline__ const char* b_ptr(const Unit& u) const { return B + (size_t)u.pn * tB; }
};

struct EpiBf16 {
    static constexpr bool PERM = true;
    bf16_t* O; int ldc;
    __device__ __forceinline__ void operator()(const f32x4 (&acc)[2][2][4][2], const Unit& u, int wr, int wc, int fr, int fq) const {
        const int row0 = u.pm * 256 + wr * 64 + fr, col0 = u.pn * 256 + wc * 32 + 8 * fq;
#pragma unroll
        for (int ai = 0; ai < 2; ++ai)
#pragma unroll
            for (int m = 0; m < 4; ++m) { bf16_t* rowp = O + (size_t)(row0 + ai * 128 + m * 16) * ldc + col0;
#pragma unroll
                for (int bj = 0; bj < 2; ++bj) { const f32x4 v0 = acc[ai][bj][m][0], v1 = acc[ai][bj][m][1];
                    u32x4 w; w.x = cvt_pk_bf16(v0[0], v0[1]); w.y = cvt_pk_bf16(v0[2], v0[3]); w.z = cvt_pk_bf16(v1[0], v1[1]); w.w = cvt_pk_bf16(v1[2], v1[3]);
                    *(u32x4*)(rowp + bj * 128) = w; } }
    }
};
struct EpiProj {
    static constexpr bool PERM = true;
    bf16_t* PROJ; bf16_t* GATES;
    __device__ __forceinline__ void operator()(const f32x4 (&acc)[2][2][4][2], const Unit& u, int wr, int wc, int fr, int fq) const {
        const int row0 = u.pm * 256 + wr * 64 + fr; const bool isg = u.pn >= 4;
        bf16_t* O = isg ? GATES : PROJ; const int ldc = isg ? 2048 : 1024; const int col0 = (isg ? u.pn - 4 : u.pn) * 256 + wc * 32 + 8 * fq;
#pragma unroll
        for (int ai = 0; ai < 2; ++ai)
#pragma unroll
            for (int m = 0; m < 4; ++m) { bf16_t* rowp = O + (size_t)(row0 + ai * 128 + m * 16) * ldc + col0;
#pragma unroll
                for (int bj = 0; bj < 2; ++bj) { f32x4 v0 = acc[ai][bj][m][0], v1 = acc[ai][bj][m][1];
                    if (isg) {
#pragma unroll
                        for (int e = 0; e < 4; ++e) { v0[e] = fast_sigmoid(v0[e]); v1[e] = fast_sigmoid(v1[e]); } }
                    u32x4 w; w.x = cvt_pk_bf16(v0[0], v0[1]); w.y = cvt_pk_bf16(v0[2], v0[3]); w.z = cvt_pk_bf16(v1[0], v1[1]); w.w = cvt_pk_bf16(v1[2], v1[3]);
                    *(u32x4*)(rowp + bj * 128) = w; } asm volatile("" ::: "memory"); }
    }
};

__device__ __forceinline__ void p2_rows(const Frame& F, const Args& a) {
    const int gw = F.vcu * NWAVES + F.wave, NGW = F.G * NWAVES, lane = F.lane;
    unsigned char* ws = F.ws;
    const bf16_t* PROJ = (const bf16_t*)(ws + WS_PROJ);
    bf16_t* A2 = (bf16_t*)(ws + WS_A2); bf16_t* POOLED = (bf16_t*)(ws + WS_POOLED); bf16_t* Kb = (bf16_t*)(ws + WS_K);
    float* COS = (float*)(ws + WS_COS); float* SIN = (float*)(ws + WS_SIN);
    const int* positions = (const int*)a.in[I_POS];
    const float gkr = (lane < 32) ? a.in[I_GKROPE][lane] : 0.f;
    const float inv_freq = __builtin_amdgcn_exp2f(-(float)(lane & 15) * (13.287712379549449f / 16.0f));
    const int w = 2 << (lane >> 4);
    for (int task = gw; task < T / 8; task += NGW) {
        const int t0 = task * 8, b = t0 / SEQ, s0 = t0 % SEQ;
        {
            const bf16_t* base = PROJ + (size_t)(b * SEQ) * 1024 + 512 + 8 * lane;
            float S[8];
#pragma unroll
            for (int j = 0; j < 8; ++j) S[j] = 0.f;
            for (int r = s0 - 15; r < s0; ++r) {
                if (r >= 0 && r >= s0 - w + 1) { const u32x4 v = *(const u32x4*)(base + (size_t)r * 1024);
                    S[0] += bf_lo(v.x); S[1] += bf_hi(v.x); S[2] += bf_lo(v.y); S[3] += bf_hi(v.y); S[4] += bf_lo(v.z); S[5] += bf_hi(v.z); S[6] += bf_lo(v.w); S[7] += bf_hi(v.w); }
            }
#pragma unroll
            for (int i = 0; i < 8; ++i) {
                const int s = s0 + i;
                const u32x4 v = *(const u32x4*)(base + (size_t)s * 1024);
                float uu[8] = {bf_lo(v.x), bf_hi(v.x), bf_lo(v.y), bf_hi(v.y), bf_lo(v.z), bf_hi(v.z), bf_lo(v.w), bf_hi(v.w)};
                const int cnt = (s + 1 < w) ? s + 1 : w; const float ic = 1.0f / (float)cnt;
                float o[8];
#pragma unroll
                for (int j = 0; j < 8; ++j) { S[j] += uu[j]; o[j] = S[j] * ic - uu[j]; }
                u32x4 wv; wv.x = cvt_pk_bf16(o[0], o[1]); wv.y = cvt_pk_bf16(o[2], o[3]); wv.z = cvt_pk_bf16(o[4], o[5]); wv.w = cvt_pk_bf16(o[6], o[7]);
                *(u32x4*)(POOLED + (size_t)(t0 + i) * 512 + 8 * lane) = wv;
                const int rr = s - w + 1;
                if (rr >= 0) { const u32x4 q = *(const u32x4*)(base + (size_t)rr * 1024);
                    S[0] -= bf_lo(q.x); S[1] -= bf_hi(q.x); S[2] -= bf_lo(q.y); S[3] -= bf_hi(q.y); S[4] -= bf_lo(q.z); S[5] -= bf_hi(q.z); S[6] -= bf_lo(q.w); S[7] -= bf_hi(q.w); }
            }
        }
        for (int i = 0; i < 8; ++i) {
            const int t = t0 + i, s = s0 + i;
            const bf16_t* pr = PROJ + (size_t)t * 1024;
            const u32x2 ql = *(const u32x2*)(pr + 4 * lane);
            const unsigned kvl = *(const unsigned*)(pr + 256 + 2 * lane);
            const float krv = (lane < 32) ? bf1(pr[384 + lane]) : 0.f;
            const float q0 = bf_lo(ql.x), q1 = bf_hi(ql.x), q2 = bf_lo(ql.y), q3 = bf_hi(ql.y);
            const float k0 = bf_lo(kvl), k1 = bf_hi(kvl);
            const float sq = wave_sum((q0 * q0 + q1 * q1) + (q2 * q2 + q3 * q3));
            const float sk = wave_sum(k0 * k0 + k1 * k1);
            const float sr = wave_sum(krv * krv);
            const float rq = 1.0f / sqrtf(sq * (1.f / 256.f) + EPS), rk = 1.0f / sqrtf(sk * (1.f / 128.f) + EPS), rr = 1.0f / sqrtf(sr * (1.f / 32.f) + EPS);
            u32x2 wq; wq.x = cvt_pk_bf16(q0 * rq, q1 * rq); wq.y = cvt_pk_bf16(q2 * rq, q3 * rq);
            *(u32x2*)(A2 + (size_t)t * 512 + 4 * lane) = wq;
            *(unsigned*)(A2 + (size_t)t * 512 + 256 + 2 * lane) = cvt_pk_bf16(k0 * rk, k1 * rk);
            *(unsigned*)(A2 + (size_t)t * 512 + 384 + 2 * lane) = 0u;
            const float pos = (float)positions[t];
            const float ang = pos * inv_freq;
            const float rev = ang * 0.15915494309189535f;
            const float fr_ = rev - floorf(rev);
            const float sn = __builtin_amdgcn_sinf(fr_), cs = __builtin_amdgcn_cosf(fr_);
            const float kn = krv * rr * gkr;
            const float other = __shfl_xor(kn, 16);
            const float ro = (lane & 16) ? (kn * cs + other * sn) : (kn * cs - other * sn);
            if (lane < 32) {
                const bf16_t rb = (bf16_t)(cvt_pk_bf16(ro, 0.f) & 0xffffu);
#pragma unroll
                for (int h = 0; h < NH; ++h) Kb[((size_t)(b * NH + h) * SEQ + s) * DK + 64 + lane] = rb;
            }
            if (lane < 16) { COS[(size_t)t * 16 + lane] = cs; SIN[(size_t)t * 16 + lane] = sn; }
        }
    }
}

#define EPI_FENCE() asm volatile("" ::: "memory")
struct EpiQ {
    static constexpr bool PERM = true;
    bf16_t* Q; float* SSQ; const float* COS; const float* SIN; const float* gq;
    __device__ __forceinline__ void operator()(const f32x4 (&acc)[2][2][4][2], const Unit& u, int wr, int wc, int fr, int fq) const {
        const int t0 = u.pm * 256 + wr * 64 + fr, b = (u.pm * 256) / SEQ, s0 = t0 - b * SEQ;
        if (u.pn < 2) {
            const int h = 4 * u.pn + wc;
            bf16_t* dst0 = Q + ((size_t)(b * NH + h) * SEQ + s0) * DK + 8 * fq;
            float* ssq0 = SSQ + ((size_t)t0 * NH + h) * 2;
#pragma unroll
            for (int ai = 0; ai < 2; ++ai)
#pragma unroll
                for (int m = 0; m < 4; ++m) {
                    const int dr = ai * 128 + m * 16;
                    float q = 0.f;
#pragma unroll
                    for (int bj = 0; bj < 2; ++bj)
#pragma unroll
                        for (int n = 0; n < 2; ++n) { const f32x4 v = acc[ai][bj][m][n]; q += (v[0] * v[0] + v[1] * v[1]) + (v[2] * v[2] + v[3] * v[3]); }
                    q += __shfl_xor(q, 16); q += __shfl_xor(q, 32);
                    if (fq == 0) ssq0[dr * NH * 2] = q;
#pragma unroll
                    for (int bj = 0; bj < 2; ++bj) { const f32x4 v0 = acc[ai][bj][m][0] * *(const f32x4*)(gq + 32 * bj + 8 * fq), v1 = acc[ai][bj][m][1] * *(const f32x4*)(gq + 32 * bj + 8 * fq + 4);
                        u32x4 w; w.x = cvt_pk_bf16(v0[0], v0[1]); w.y = cvt_pk_bf16(v0[2], v0[3]); w.z = cvt_pk_bf16(v1[0], v1[1]); w.w = cvt_pk_bf16(v1[2], v1[3]);
                        *(u32x4*)(dst0 + dr * DK + 32 * bj) = w; }
                    EPI_FENCE();
                }
        } else {
            const f32x4 g1 = *(const f32x4*)(gq + 64 + 4 * fq), g2 = *(const f32x4*)(gq + 80 + 4 * fq);
            const float* cs0 = COS + (size_t)t0 * 16 + 4 * fq; const float* sn0 = SIN + (size_t)t0 * 16 + 4 * fq;
            bf16_t* dst0 = Q + ((size_t)(b * NH + 2 * wc) * SEQ + s0) * DK + 64 + 4 * fq;
            float* ssq0 = SSQ + ((size_t)t0 * NH + 2 * wc) * 2 + 1;
#pragma unroll
            for (int ai = 0; ai < 2; ++ai)
#pragma unroll
                for (int m = 0; m < 4; ++m) {
                    const int dr = ai * 128 + m * 16;
                    const f32x4 cs = *(const f32x4*)(cs0 + dr * 16), sn = *(const f32x4*)(sn0 + dr * 16);
#pragma unroll
                    for (int bj = 0; bj < 2; ++bj) {
                        const f32x4 x1 = acc[ai][bj][m][0], x2 = acc[ai][bj][m][1];
                        float q = (x1[0] * x1[0] + x1[1] * x1[1]) + (x1[2] * x1[2] + x1[3] * x1[3]) + (x2[0] * x2[0] + x2[1] * x2[1]) + (x2[2] * x2[2] + x2[3] * x2[3]);
                        q += __shfl_xor(q, 16); q += __shfl_xor(q, 32);
                        if (fq == 0) ssq0[dr * NH * 2 + bj * 2] = q;
                        const f32x4 y1 = x1 * g1, y2 = x2 * g2;
                        const f32x4 o1 = y1 * cs - y2 * sn, o2 = y2 * cs + y1 * sn;
                        bf16_t* dst = dst0 + (size_t)bj * SEQ * DK + dr * DK;
                        u32x2 w1, w2; w1.x = cvt_pk_bf16(o1[0], o1[1]); w1.y = cvt_pk_bf16(o1[2], o1[3]); w2.x = cvt_pk_bf16(o2[0], o2[1]); w2.y = cvt_pk_bf16(o2[2], o2[3]);
                        *(u32x2*)(dst) = w1; *(u32x2*)(dst + 16) = w2;
                    }
                    EPI_FENCE();
                }
        }
    }
};
struct EpiKV {
    static constexpr bool PERM = true;
    bf16_t* K; bf16_t* V; const float* gk;
    __device__ __forceinline__ void operator()(const f32x4 (&acc)[2][2][4][2], const Unit& u, int wr, int wc, int fr, int fq) const {
        const int t0 = u.pm * 256 + wr * 64 + fr, b = (u.pm * 256) / SEQ, s0 = t0 - b * SEQ;
        const int h = 2 * u.pn + (wc & 1); const bool isv = wc >= 2;
        const int pitch = isv ? DV : DK;
        bf16_t* dst0 = (isv ? V : K) + ((size_t)(b * NH + h) * SEQ + s0) * pitch + 8 * fq;
#pragma unroll
        for (int ai = 0; ai < 2; ++ai)
#pragma unroll
            for (int m = 0; m < 4; ++m) {
                const int dr = ai * 128 + m * 16;
                float sc = 1.f;
                if (!isv) { float q = 0.f;
#pragma unroll
                    for (int bj = 0; bj < 2; ++bj)
#pragma unroll
                        for (int n = 0; n < 2; ++n) { const f32x4 v = acc[ai][bj][m][n]; q += (v[0] * v[0] + v[1] * v[1]) + (v[2] * v[2] + v[3] * v[3]); }
                    q += __shfl_xor(q, 16); q += __shfl_xor(q, 32);
                    sc = 1.0f / sqrtf(q * (1.f / 64.f) + EPS); }
#pragma unroll
                for (int bj = 0; bj < 2; ++bj) {
                    f32x4 v0 = acc[ai][bj][m][0] * sc, v1 = acc[ai][bj][m][1] * sc;
                    if (!isv) { v0 = v0 * *(const f32x4*)(gk + 32 * bj + 8 * fq); v1 = v1 * *(const f32x4*)(gk + 32 * bj + 8 * fq + 4); }
                    u32x4 w; w.x = cvt_pk_bf16(v0[0], v0[1]); w.y = cvt_pk_bf16(v0[2], v0[3]); w.z = cvt_pk_bf16(v1[0], v1[1]); w.w = cvt_pk_bf16(v1[2], v1[3]);
                    *(u32x4*)(dst0 + dr * pitch + 32 * bj) = w; }
                EPI_FENCE();
            }
    }
};

namespace att {
constexpr int KROW = 208;
constexpr int KT_BYTES = 64 * KROW, VT_BYTES = 64 * 128, BUF_BYTES = KT_BYTES + VT_BYTES;
constexpr int SCR_OFF = 2 * BUF_BYTES;
__device__ __forceinline__ int crow(int r, int hi) { return (r & 3) + 8 * (r >> 2) + 4 * hi; }
__device__ __forceinline__ s16x4 vtr(const LAS unsigned char* p) { typedef short v4i16_t __attribute__((ext_vector_type(4)));
    return __builtin_bit_cast(s16x4, __builtin_amdgcn_ds_read_tr16_b64_v4i16((LAS v4i16_t*)p)); }

__device__ __forceinline__ void attn_unit(LAS unsigned char* lds, int bh, int qb, const bf16_t* Q, const bf16_t* K, const bf16_t* V, const float* SSQ, bf16_t* O) {
    const int tid = threadIdx.x, lane = tid & 63, r32 = lane & 31, hi = lane >> 5; const int wid = __builtin_amdgcn_readfirstlane(tid >> 6);
    const int b = bh / NH, h = bh % NH, q0 = qb * 256, qw = q0 + 32 * wid;
    const bf16_t* Kh = K + (size_t)bh * SEQ * DK; const bf16_t* Vh = V + (size_t)bh * SEQ * DV;
    LAS float* scr = (LAS float*)(lds + SCR_OFF) + wid * 64;
    bf16x8 qr[6];
    { const bf16_t* qp = Q + ((size_t)bh * SEQ + qw + r32) * DK + 8 * hi;
#pragma unroll
      for (int d0 = 0; d0 < 6; ++d0) qr[d0] = *(const bf16x8*)(qp + 16 * d0); }
    float cq;
    { const float* sp = SSQ + ((size_t)(b * SEQ + qw + r32) * NH + h) * 2; const float ss = sp[0] + sp[1];
      cq = (1.0f / sqrtf(ss * (1.f / 96.f) + EPS)) * 0.10206207261596577f * 1.4426950408889634f; }
    const int NT = (q0 + 256) / 64;
    const int kc0 = tid, kc1 = 512 + tid;
    const int kd0 = (kc0 / 12) * KROW + (kc0 % 12) * 16, kd1 = (kc1 / 12) * KROW + (kc1 % 12) * 16;
    const int vrow = tid >> 3, vd = KT_BYTES + vrow * 128 + (((tid & 7) * 16) ^ (((vrow >> 1) & 1) * 64));
    u32x4 sk0, sk1, sv;
#define ATT_LOAD(j) do { const u32x4* kg = (const u32x4*)(Kh + (size_t)(j) * 64 * DK); sk0 = kg[kc0]; if (tid < 256) sk1 = kg[kc1]; sv = ((const u32x4*)(Vh + (size_t)(j) * 64 * DV))[tid]; } while (0)
#define ATT_WRITE(buf) do { LAS unsigned char* bp = lds + (buf) * BUF_BYTES; *(LAS u32x4*)(bp + kd0) = sk0; if (tid < 256) *(LAS u32x4*)(bp + kd1) = sk1; *(LAS u32x4*)(bp + vd) = sv; } while (0)
    ATT_LOAD(0); ATT_WRITE(0);
    __syncthreads();
    const int kbase = r32 * KROW + hi * 16;
    const int qq = (lane & 15) >> 2, pp = lane & 3, dblk = (lane >> 4) & 1, swz = ((qq >> 1) & 1) * 64;
    const int vrow0 = 4 * hi + qq;
    const int vb0 = KT_BYTES + vrow0 * 128 + ((32 * dblk + 8 * pp) ^ swz);
    const int vb1 = KT_BYTES + vrow0 * 128 + ((64 + 32 * dblk + 8 * pp) ^ swz);
    f32x16 o0 = {}, o1 = {};
    float m_run = -1e30f, l_run = 0.f;
    for (int j = 0; j < NT; ++j) {
        const int buf = j & 1;
        if (j + 1 < NT) ATT_LOAD(j + 1);
        const int kb = 64 * j;
        if (kb <= qw + 31) {
            const LAS unsigned char* kp = lds + buf * BUF_BYTES + kbase;
            f32x16 p0 = {}, p1 = {};
#pragma unroll
            for (int d0 = 0; d0 < 6; ++d0) {
                const bf16x8 ka = *(const LAS bf16x8*)(kp + d0 * 32), kb2 = *(const LAS bf16x8*)(kp + 32 * KROW + d0 * 32);
                p0 = __builtin_amdgcn_mfma_f32_32x32x16_bf16(ka, qr[d0], p0, 0, 0, 0);
                p1 = __builtin_amdgcn_mfma_f32_32x32x16_bf16(kb2, qr[d0], p1, 0, 0, 0);
            }
#pragma unroll
            for (int r = 0; r < 16; ++r) { p0[r] *= cq; p1[r] *= cq; }
            if (kb + 63 > qw) {
                const int qa = qw + r32;
#pragma unroll
                for (int r = 0; r < 16; ++r) { const int ka_ = kb + crow(r, hi); if (ka_ > qa) p0[r] = -__builtin_inff(); if (ka_ + 32 > qa) p1[r] = -__builtin_inff(); }
            }
            float pm = p0[0];
#pragma unroll
            for (int r = 1; r < 16; ++r) pm = fmaxf(pm, p0[r]);
#pragma unroll
            for (int r = 0; r < 16; ++r) pm = fmaxf(pm, p1[r]);
            { auto rr = __builtin_amdgcn_permlane32_swap(__float_as_uint(pm), __float_as_uint(pm), false, false); pm = fmaxf(__uint_as_float(rr[0]), __uint_as_float(rr[1])); }
            if (__any(pm > m_run + 8.0f)) {
                const float mn = fmaxf(m_run, pm); const float al = __builtin_amdgcn_exp2f(m_run - mn); m_run = mn; l_run *= al;
                if (hi == 0) scr[r32] = al;
                asm volatile("s_waitcnt lgkmcnt(0)" ::: "memory");
#pragma unroll
                for (int a4 = 0; a4 < 4; ++a4) { const f32x4 f = *(const LAS f32x4*)(scr + 8 * a4 + 4 * hi);
#pragma unroll
                    for (int e = 0; e < 4; ++e) { o0[4 * a4 + e] *= f[e]; o1[4 * a4 + e] *= f[e]; } }
            }
            float ps = 0.f;
#pragma unroll
            for (int r = 0; r < 16; ++r) { p0[r] = __builtin_amdgcn_exp2f(p0[r] - m_run); p1[r] = __builtin_amdgcn_exp2f(p1[r] - m_run); ps += p0[r] + p1[r]; }
            l_run += ps;
            bf16x8 pa[4];
#pragma unroll
            for (int ks = 0; ks < 4; ++ks) { const f32x16& P = (ks < 2) ? p0 : p1; const int bs = 8 * (ks & 1);
                u32x4 w; w.x = cvt_pk_bf16(P[bs + 0], P[bs + 1]); w.y = cvt_pk_bf16(P[bs + 2], P[bs + 3]); w.z = cvt_pk_bf16(P[bs + 4], P[bs + 5]); w.w = cvt_pk_bf16(P[bs + 6], P[bs + 7]);
                pa[ks] = __builtin_bit_cast(bf16x8, w); }
            const LAS unsigned char* vp0 = lds + buf * BUF_BYTES + vb0; const LAS unsigned char* vp1 = lds + buf * BUF_BYTES + vb1;
#pragma unroll
            for (int ks = 0; ks < 4; ++ks) {
                const s16x4 a0 = vtr(vp0 + ks * 16 * 128), a1 = vtr(vp0 + ks * 16 * 128 + 8 * 128);
                const s16x4 c0 = vtr(vp1 + ks * 16 * 128), c1 = vtr(vp1 + ks * 16 * 128 + 8 * 128);
                const bf16x8 vf0 = {a0[0], a0[1], a0[2], a0[3], a1[0], a1[1], a1[2], a1[3]};
                const bf16x8 vf1 = {c0[0], c0[1], c0[2], c0[3], c1[0], c1[1], c1[2], c1[3]};
                o0 = __builtin_amdgcn_mfma_f32_32x32x16_bf16(pa[ks], vf0, o0, 0, 0, 0);
                o1 = __builtin_amdgcn_mfma_f32_32x32x16_bf16(pa[ks], vf1, o1, 0, 0, 0);
            }
        }
        if (j + 1 < NT) ATT_WRITE(buf ^ 1);
        __syncthreads();
    }
#undef ATT_LOAD
#undef ATT_WRITE
    { auto rr = __builtin_amdgcn_permlane32_swap(__float_as_uint(l_run), __float_as_uint(l_run), false, false); l_run = __uint_as_float(rr[0]) + __uint_as_float(rr[1]); }
    if (hi == 0) scr[32 + r32] = 1.0f / l_run;
    asm volatile("s_waitcnt lgkmcnt(0)" ::: "memory");
    bf16_t* Ow = O + ((size_t)(b * SEQ + qw)) * 512 + h * 64 + r32;
#pragma unroll
    for (int a4 = 0; a4 < 4; ++a4) { const f32x4 f = *(const LAS f32x4*)(scr + 32 + 8 * a4 + 4 * hi);
#pragma unroll
        for (int e = 0; e < 4; ++e) { const int r = 4 * a4 + e; const int row = crow(r, hi);
            Ow[(size_t)row * 512] = (bf16_t)(cvt_pk_bf16(o0[r] * f[e], 0.f) & 0xffffu);
            Ow[(size_t)row * 512 + 32] = (bf16_t)(cvt_pk_bf16(o1[r] * f[e], 0.f) & 0xffffu); } }
    __syncthreads();
}
}

struct MixOrder {
    int G, c; const char* ATT; const char* MIXED; const char* WAO; const char* WPO;
    __device__ __forceinline__ bool next(int i, Unit& u) const {
        const int tile = (i >> 1) * G + c; if (tile >= 256) return false;
        u.pm = tile >> 2; u.pn = tile & 3; u.aux = i & 1; return true;
    }
    __device__ __forceinline__ const char* a_ptr(const Unit& u) const { return (u.aux ? MIXED : ATT) + (size_t)u.pm * 256 * 512 * 2; }
    __device__ __forceinline__ const char* b_ptr(const Unit& u) const { return (u.aux ? WPO : WAO) + (size_t)u.pn * 256 * 512 * 2; }
};
struct EpiMix {
    static constexpr bool PERM = true;
    bf16_t* MIX; const bf16_t* GATES;
    __device__ __forceinline__ void operator()(const f32x4 (&acc)[2][2][4][2], const Unit& u, int wr, int wc, int fr, int fq) const {
        const int row0 = u.pm * 256 + wr * 64 + fr, col0 = u.pn * 256 + wc * 32 + 8 * fq;
#pragma unroll
        for (int ai = 0; ai < 2; ++ai)
#pragma unroll
            for (int m = 0; m < 4; ++m) { const size_t row = (size_t)(row0 + ai * 128 + m * 16);
#pragma unroll
                for (int bj = 0; bj < 2; ++bj) {
                    const u32x4 gw = *(const u32x4*)(GATES + row * 2048 + u.aux * 1024 + col0 + bj * 128);
                    const f32x4 v0 = acc[ai][bj][m][0], v1 = acc[ai][bj][m][1];
                    float r[8] = {v0[0] * bf_lo(gw.x), v0[1] * bf_hi(gw.x), v0[2] * bf_lo(gw.y), v0[3] * bf_hi(gw.y), v1[0] * bf_lo(gw.z), v1[1] * bf_hi(gw.z), v1[2] * bf_lo(gw.w), v1[3] * bf_hi(gw.w)};
                    bf16_t* dst = MIX + row * 1024 + col0 + bj * 128;
                    if (u.aux) { const u32x4 pw = *(const u32x4*)dst;
                        r[0] += bf_lo(pw.x); r[1] += bf_hi(pw.x); r[2] += bf_lo(pw.y); r[3] += bf_hi(pw.y); r[4] += bf_lo(pw.z); r[5] += bf_hi(pw.z); r[6] += bf_lo(pw.w); r[7] += bf_hi(pw.w); }
                    u32x4 w; w.x = cvt_pk_bf16(r[0], r[1]); w.y = cvt_pk_bf16(r[2], r[3]); w.z = cvt_pk_bf16(r[4], r[5]); w.w = cvt_pk_bf16(r[6], r[7]);
                    *(u32x4*)dst = w; } }
    }
};
struct EpiRes {
    static constexpr bool PERM = false;
    const float* base; float* out;
    __device__ __forceinline__ void operator()(const f32x4 (&acc)[2][2][4][2], const Unit& u, int wr, int wc, int fr, int fq) const {
        const int row0 = u.pm * 256 + wr * 64 + fr, col0 = u.pn * 256 + wc * 32 + 4 * fq;
#pragma unroll
        for (int ai = 0; ai < 2; ++ai)
#pragma unroll
            for (int m = 0; m < 4; ++m) { const size_t off = (size_t)(row0 + ai * 128 + m * 16) * DM + col0;
#pragma unroll
                for (int bj = 0; bj < 2; ++bj)
#pragma unroll
                    for (int n = 0; n < 2; ++n) *(f32x4*)(out + off + bj * 128 + n * 16) = *(const f32x4*)(base + off + bj * 128 + n * 16) + acc[ai][bj][m][n]; }
    }
};

constexpr int WR_PITCH = 1028;
constexpr int R_WR_OFF = 0, R_PART_OFF = 32 * WR_PITCH * 4, R_SSQ_OFF = R_PART_OFF + 2 * 64 * 33 * 4, R_CNT_OFF = R_SSQ_OFF + 2 * 64 * 4, R_BASE_OFF = R_CNT_OFF + 128, R_END = R_BASE_OFF + 128;
static_assert(R_END <= TILE_E_OFF, "router LDS map");
__device__ __forceinline__ void p7_router(const Frame& F, const Args& a) {
    LAS float* WR = (LAS float*)(F.lds + R_WR_OFF); LAS float* PART = (LAS float*)(F.lds + R_PART_OFF); LAS float* SSQP = (LAS float*)(F.lds + R_SSQ_OFF);
    LAS int* CNT = (LAS int*)(F.lds + R_CNT_OFF); LAS int* BASE = (LAS int*)(F.lds + R_BASE_OFF);
    const int tid = F.tid, lane = F.lane, wave = F.wave;
    const float* wr = a.in[I_WR]; const float* gf = a.in[I_GFFN];
    for (int i = tid; i < 1024 * 32; i += 512) { const int k = i >> 5, e = i & 31; WR[e * WR_PITCH + k] = wr[i] * gf[k]; }
    if (tid < 32) CNT[tid] = 0;
    __syncthreads();
    int* RE = (int*)(F.ws + WS_ROUTE); int* RP = RE + T * 4; float* RG = (float*)(RP + T * 4); float* RS = RG + T * 4;
    unsigned* gcnt = F.ctl + CW_CNT;
    const float* X1 = F.out;
    for (int blk = F.vcu; blk < T / 64; blk += F.G) {
        const int tb = blk * 64;
        {
            const int tg = wave & 3, kh = wave >> 2, r = lane & 15, kq = lane >> 4;
            const float* xp = X1 + (size_t)(tb + 16 * tg + r) * DM + 512 * kh + 4 * kq;
            const LAS float* w0 = WR + (lane & 15) * WR_PITCH + 512 * kh + 4 * kq; const LAS float* w1 = w0 + 16 * WR_PITCH;
            f32x4 acc0 = {0.f, 0.f, 0.f, 0.f}, acc1 = {0.f, 0.f, 0.f, 0.f}; float ss = 0.f;
#pragma unroll 4
            for (int i = 0; i < 32; ++i) {
                const f32x4 xv = *(const f32x4*)(xp + 16 * i);
                const f32x4 b0 = *(const LAS f32x4*)(w0 + 16 * i), b1 = *(const LAS f32x4*)(w1 + 16 * i);
                ss += (xv[0] * xv[0] + xv[1] * xv[1]) + (xv[2] * xv[2] + xv[3] * xv[3]);
#pragma unroll
                for (int j = 0; j < 4; ++j) { acc0 = __builtin_amdgcn_mfma_f32_16x16x4f32(xv[j], b0[j], acc0, 0, 0, 0); acc1 = __builtin_amdgcn_mfma_f32_16x16x4f32(xv[j], b1[j], acc1, 0, 0, 0); }
            }
            ss += __shfl_xor(ss, 16); ss += __shfl_xor(ss, 32);
            if (kq == 0) SSQP[kh * 64 + 16 * tg + r] = ss;
#pragma unroll
            for (int q = 0; q < 4; ++q) { const int tok = 16 * tg + 4 * kq + q; PART[(kh * 64 + tok) * 33 + (lane & 15)] = acc0[q]; PART[(kh * 64 + tok) * 33 + 16 + (lane & 15)] = acc1[q]; }
        }
        __syncthreads();
        int te[4] = {0, 0, 0, 0}, lp[4] = {0, 0, 0, 0}; float tv[4] = {-3e38f, -3e38f, -3e38f, -3e38f}; float rstd = 0.f;
        if (tid < 64) {
            const float ssq = SSQP[tid] + SSQP[64 + tid]; rstd = 1.0f / sqrtf(ssq * (1.f / DM) + EPS);
            const float* br = a.in[I_BR];
#pragma unroll
            for (int e = 0; e < 32; ++e) {
                float v = (PART[tid * 33 + e] + PART[(64 + tid) * 33 + e]) * rstd + br[e]; int id = e;
#pragma unroll
                for (int s = 0; s < 4; ++s) { const bool gt = v > tv[s]; const float ov = tv[s]; const int oi = te[s]; tv[s] = gt ? v : ov; te[s] = gt ? id : oi; v = gt ? ov : v; id = gt ? oi : id; }
            }
#pragma unroll
            for (int s = 0; s < 4; ++s) lp[s] = __hip_atomic_fetch_add(&CNT[te[s]], 1, __ATOMIC_RELAXED, __HIP_MEMORY_SCOPE_WORKGROUP);
        }
        __syncthreads();
        if (tid < 32) { const int c = CNT[tid]; BASE[tid] = c ? (int)atomicAdd(gcnt + tid, (unsigned)c) : 0; }
        __syncthreads();
        if (tid < 64) {
            const int t = tb + tid;
            const float e1 = __expf(tv[1] - tv[0]), e2 = __expf(tv[2] - tv[0]), e3 = __expf(tv[3] - tv[0]); const float inv = 1.0f / (1.0f + e1 + e2 + e3);
            const float gts[4] = {inv, e1 * inv, e2 * inv, e3 * inv};
#pragma unroll
            for (int s = 0; s < 4; ++s) { RE[t * 4 + s] = te[s]; RP[t * 4 + s] = BASE[te[s]] + lp[s]; RG[t * 4 + s] = gts[s]; }
            RS[t] = rstd;
        }
        __syncthreads();
        if (tid < 32) CNT[tid] = 0;
        __syncthreads();
    }
}

__device__ __forceinline__ int build_tiles(const Frame& F) {
    LAS int* TB = (LAS int*)(F.lds + TILE_E_OFF); LAS int* TE = TB + 64;
    if (F.tid == 0) { int acc = 0; for (int e = 0; e < NEXP; ++e) { TB[e] = acc; const int c = (int)__hip_atomic_load(F.ctl + CW_CNT + e, RLX_AGENT); acc += (c + 255) >> 8; } TB[NEXP] = acc; }
    __syncthreads();
    if (F.tid < NEXP) { for (int t = TB[F.tid]; t < TB[F.tid + 1]; ++t) TE[t] = F.tid; }
    __syncthreads();
    return TB[NEXP];
}

__device__ __forceinline__ void p8_dispatch(const Frame& F, const Args& a) {
    (void)build_tiles(F);
    const LAS int* TB = (const LAS int*)(F.lds + TILE_E_OFF);
    const int gw = F.vcu * NWAVES + F.wave, NGW = F.G * NWAVES, lane = F.lane;
    const int* RE = (const int*)(F.ws + WS_ROUTE); const int* RP = RE + T * 4; const float* RS = (const float*)(RP + T * 4) + T * 4; int* SL = (int*)(RS + T);
    const float* X1 = F.out; const float* gf = a.in[I_GFFN]; bf16_t* XS = (bf16_t*)(F.ws + WS_XS);
    f32x4 g[2][2];
#pragma unroll
    for (int j = 0; j < 2; ++j) { g[j][0] = *(const f32x4*)(gf + 512 * j + 8 * lane); g[j][1] = *(const f32x4*)(gf + 512 * j + 8 * lane + 4); }
    for (int t = gw; t < T; t += NGW) {
        const float rstd = RS[t];
        u32x4 w[2];
#pragma unroll
        for (int j = 0; j < 2; ++j) { const f32x4 v0 = *(const f32x4*)(X1 + (size_t)t * DM + 512 * j + 8 * lane) * g[j][0] * rstd, v1 = *(const f32x4*)(X1 + (size_t)t * DM + 512 * j + 8 * lane + 4) * g[j][1] * rstd;
            w[j].x = cvt_pk_bf16(v0[0], v0[1]); w[j].y = cvt_pk_bf16(v0[2], v0[3]); w[j].z = cvt_pk_bf16(v1[0], v1[1]); w[j].w = cvt_pk_bf16(v1[2], v1[3]); }
#pragma unroll
        for (int s = 0; s < 4; ++s) { const int e = RE[t * 4 + s], slot = TB[e] * 256 + RP[t * 4 + s];
            if (lane == 0) SL[t * 4 + s] = slot;
            bf16_t* dst = XS + (size_t)slot * DM + 8 * lane;
            *(u32x4*)dst = w[0]; *(u32x4*)(dst + 512) = w[1]; }
    }
}

struct MoeOrder {
    int G, c, ntn_shift, total; const LAS int* TE; const char* A; const char* Bw; size_t bexp, btile;
    __device__ __forceinline__ bool next(int i, Unit& u) const {
        const int L = i * G + c; if (L >= total) return false;
        u.pm = L >> ntn_shift; u.pn = L & ((1 << ntn_shift) - 1); u.aux = TE[u.pm]; return true;
    }
    __device__ __forceinline__ const char* a_ptr(const Unit& u) const { return A + (size_t)u.pm * 256 * 1024 * 2; }
    __device__ __forceinline__ const char* b_ptr(const Unit& u) const { return Bw + (size_t)u.aux * bexp + (size_t)u.pn * btile; }
};
struct EpiSwiglu {
    static constexpr bool PERM = true;
    bf16_t* ACT; const float* bgu;
    __device__ __forceinline__ void operator()(const f32x4 (&acc)[2][2][4][2], const Unit& u, int wr, int wc, int fr, int fq) const {
        const int row0 = u.pm * 256 + wr * 64 + fr, j0 = u.pn * 128 + wc * 32 + 8 * fq;
        const float* bb = bgu + (size_t)u.aux * 2048 + j0;
        const f32x4 bg0 = *(const f32x4*)(bb), bg1 = *(const f32x4*)(bb + 4), bu0 = *(const f32x4*)(bb + 1024), bu1 = *(const f32x4*)(bb + 1028);
#pragma unroll
        for (int ai = 0; ai < 2; ++ai)
#pragma unroll
            for (int m = 0; m < 4; ++m) {
                const f32x4 g0 = acc[ai][0][m][0] + bg0, g1 = acc[ai][0][m][1] + bg1, u0 = acc[ai][1][m][0] + bu0, u1 = acc[ai][1][m][1] + bu1;
                float r[8];
#pragma unroll
                for (int e = 0; e < 4; ++e) {
                    { const float gg = fminf(g0[e], 7.0f), uu = fminf(fmaxf(u0[e], -7.0f), 7.0f); r[e] = (uu + 1.0f) * gg * fast_sigmoid(1.702f * gg); }
                    { const float gg = fminf(g1[e], 7.0f), uu = fminf(fmaxf(u1[e], -7.0f), 7.0f); r[4 + e] = (uu + 1.0f) * gg * fast_sigmoid(1.702f * gg); }
                }
                u32x4 w; w.x = cvt_pk_bf16(r[0], r[1]); w.y = cvt_pk_bf16(r[2], r[3]); w.z = cvt_pk_bf16(r[4], r[5]); w.w = cvt_pk_bf16(r[6], r[7]);
                *(u32x4*)(ACT + (size_t)(row0 + ai * 128 + m * 16) * DEXP + j0) = w;
            }
    }
};
struct EpiDown {
    static constexpr bool PERM = true;
    bf16_t* Y; const float* bd;
    __device__ __forceinline__ void operator()(const f32x4 (&acc)[2][2][4][2], const Unit& u, int wr, int wc, int fr, int fq) const {
        const int row0 = u.pm * 256 + wr * 64 + fr, col0 = u.pn * 256 + wc * 32 + 8 * fq;
        const float* bb = bd + (size_t)u.aux * DM + col0;
        f32x4 bv[2][2];
#pragma unroll
        for (int bj = 0; bj < 2; ++bj) { bv[bj][0] = *(const f32x4*)(bb + bj * 128); bv[bj][1] = *(const f32x4*)(bb + bj * 128 + 4); }
#pragma unroll
        for (int ai = 0; ai < 2; ++ai)
#pragma unroll
            for (int m = 0; m < 4; ++m) { bf16_t* rowp = Y + (size_t)(row0 + ai * 128 + m * 16) * DM + col0;
#pragma unroll
                for (int bj = 0; bj < 2; ++bj) { const f32x4 v0 = acc[ai][bj][m][0] + bv[bj][0], v1 = acc[ai][bj][m][1] + bv[bj][1];
                    u32x4 w; w.x = cvt_pk_bf16(v0[0], v0[1]); w.y = cvt_pk_bf16(v0[2], v0[3]); w.z = cvt_pk_bf16(v1[0], v1[1]); w.w = cvt_pk_bf16(v1[2], v1[3]);
                    *(u32x4*)(rowp + bj * 128) = w; } }
    }
};

__device__ __forceinline__ void p11_combine(const Frame& F, const Args& a) {
    const int gw = F.vcu * NWAVES + F.wave, NGW = F.G * NWAVES, lane = F.lane;
    const int* RE = (const int*)(F.ws + WS_ROUTE); const float* RG = (const float*)(RE + T * 8); const int* SL = (const int*)(RG + T * 4 + T);
    const bf16_t* Y = (const bf16_t*)(F.ws + WS_XS); bf16_t* HP = (bf16_t*)(F.ws + WS_HN); float* X = F.out; const float* gp = a.in[I_GPLE];
    f32x4 g[2][2];
#pragma unroll
    for (int j = 0; j < 2; ++j) { g[j][0] = *(const f32x4*)(gp + 512 * j + 8 * lane); g[j][1] = *(const f32x4*)(gp + 512 * j + 8 * lane + 4); }
    for (int t = gw; t < T; t += NGW) {
        f32x4 v[2][2];
#pragma unroll
        for (int j = 0; j < 2; ++j) { v[j][0] = *(const f32x4*)(X + (size_t)t * DM + 512 * j + 8 * lane); v[j][1] = *(const f32x4*)(X + (size_t)t * DM + 512 * j + 8 * lane + 4); }
#pragma unroll
        for (int s = 0; s < 4; ++s) { const int slot = SL[t * 4 + s]; const float gt = RG[t * 4 + s];
#pragma unroll
            for (int j = 0; j < 2; ++j) { const u32x4 y = *(const u32x4*)(Y + (size_t)slot * DM + 512 * j + 8 * lane);
                v[j][0] += (f32x4){bf_lo(y.x), bf_hi(y.x), bf_lo(y.y), bf_hi(y.y)} * gt; v[j][1] += (f32x4){bf_lo(y.z), bf_hi(y.z), bf_lo(y.w), bf_hi(y.w)} * gt; } }
        float ss = 0.f;
#pragma unroll
        for (int j = 0; j < 2; ++j)
#pragma unroll
            for (int n = 0; n < 2; ++n) { const f32x4 q = v[j][n]; ss += (q[0] * q[0] + q[1] * q[1]) + (q[2] * q[2] + q[3] * q[3]); *(f32x4*)(X + (size_t)t * DM + 512 * j + 8 * lane + 4 * n) = q; }
        const float rstd = 1.0f / sqrtf(wave_sum(ss) * (1.f / DM) + EPS);
#pragma unroll
        for (int j = 0; j < 2; ++j) { const f32x4 q0 = v[j][0] * g[j][0] * rstd, q1 = v[j][1] * g[j][1] * rstd;
            u32x4 w; w.x = cvt_pk_bf16(q0[0], q0[1]); w.y = cvt_pk_bf16(q0[2], q0[3]); w.z = cvt_pk_bf16(q1[0], q1[1]); w.w = cvt_pk_bf16(q1[2], q1[3]);
            *(u32x4*)(HP + (size_t)t * DM + 512 * j + 8 * lane) = w; }
    }
}
struct EpiPle {
    static constexpr bool PERM = false;
    float* out; const bf16_t* E;
    __device__ __forceinline__ void operator()(const f32x4 (&acc)[2][2][4][2], const Unit& u, int wr, int wc, int fr, int fq) const {
        const int row0 = u.pm * 256 + wr * 64 + fr, col0 = u.pn * 256 + wc * 32 + 4 * fq;
#pragma unroll
        for (int ai = 0; ai < 2; ++ai)
#pragma unroll
            for (int m = 0; m < 4; ++m) { const size_t off = (size_t)(row0 + ai * 128 + m * 16) * DM + col0;
#pragma unroll
                for (int bj = 0; bj < 2; ++bj)
#pragma unroll
                    for (int n = 0; n < 2; ++n) { const size_t o = off + bj * 128 + n * 16; const u32x2 ev = *(const u32x2*)(E + o); const f32x4 a4 = acc[ai][bj][m][n];
                        f32x4 r = *(const f32x4*)(out + o);
                        r[0] += fast_sigmoid(a4[0]) * bf_lo(ev.x); r[1] += fast_sigmoid(a4[1]) * bf_hi(ev.x); r[2] += fast_sigmoid(a4[2]) * bf_lo(ev.y); r[3] += fast_sigmoid(a4[3]) * bf_hi(ev.y);
                        *(f32x4*)(out + o) = r; } }
    }
};

constexpr int N_PHASES = 13;
__global__ void __launch_bounds__(NWAVES * 64, 2) fwd_kernel(Args args) {
    extern __shared__ __attribute__((aligned(16))) unsigned char lds_raw[];
    Frame F;
    F.lds = (LAS unsigned char*)lds_raw; F.MISC = (volatile LAS unsigned*)(F.lds + MISC_OFF);
    F.tid = threadIdx.x; F.lane = F.tid & 63; F.wave = __builtin_amdgcn_readfirstlane(F.tid >> 6);
    F.G = gridDim.x; { const int bx = blockIdx.x; F.vcu = (F.G % 8 == 0) ? (bx % 8) * (F.G / 8) + bx / 8 : bx; }
    F.out = args.out; F.ws = args.ws; F.ctl = (unsigned*)(args.ws + WS_CTL);
    if (F.tid < 32) F.MISC[F.tid] = 0u;
    __syncthreads();
    const int lo = args.ph_lo, hi = args.ph_hi;
    const bool multi = (hi - lo) > 1;
    XcdBarrier bar; bar.bar = F.ctl + CW_BAR; bar.x = 0; bar.st = nullptr;
    if (multi) bar = xcd_barrier_post(F.ctl + CW_BAR, F.MISC);
#ifndef PH_MASK
#define PH_MASK 0x1fff
#endif
#define IN(k) ((((PH_MASK) >> (k)) & 1) && lo <= (k) && (k) < hi)
#define SEAM(k) do { if (IN(k) && IN((k) + 1)) xcd_barrier(bar); } while (0)
    unsigned char* ws = args.ws;
    LAS unsigned char* ring = F.lds;

    if (IN(0)) { p0_prologue(F, args); } SEAM(0);

    if (IN(1)) {
        { DenseOrder S; S.init(64, 12, F.G, (int)blockIdx.x, ws + WS_HN, 1024, ws + WS_WIN, 1024);
          EpiProj E{(bf16_t*)(ws + WS_PROJ), (bf16_t*)(ws + WS_GATES)};
          pg8::gemm_phase<EpiProj, DenseOrder, true, true>(ring, pg8::Shape{1024, 1024, 1024}, S, E); }
        { DenseOrder S; S.init(64, 4, F.G, (int)blockIdx.x, ws + WS_PB, 256, ws + WS_WPLE, 256);
          EpiBf16 E{(bf16_t*)(ws + WS_E), 1024};
          pg8::gemm_phase<EpiBf16, DenseOrder, true, true>(ring, pg8::Shape{256, 256, 256}, S, E); }
    } SEAM(1);

    if (IN(2)) { p2_rows(F, args); } SEAM(2);

    if (IN(3)) {
#ifndef P3M
#define P3M 7
#endif
        if (P3M & 1) { DenseOrder S; S.init(64, 4, F.G, (int)blockIdx.x, ws + WS_A2 + 512, 512, ws + WS_WKV, 256);
          EpiKV E{(bf16_t*)(ws + WS_K), (bf16_t*)(ws + WS_V), args.in[I_GKNOPE]};
          pg8::gemm_phase<EpiKV, DenseOrder, true, true>(ring, pg8::Shape{256, 512, 256}, S, E); }
        if (P3M & 2) { DenseOrder S; S.init(64, 3, F.G, (int)blockIdx.x, ws + WS_A2, 512, ws + WS_WQ, 256);
          EpiQ E{(bf16_t*)(ws + WS_Q), (float*)(ws + WS_SSQ), (const float*)(ws + WS_COS), (const float*)(ws + WS_SIN), args.in[I_GQHEAD]};
          pg8::gemm_phase<EpiQ, DenseOrder, true, true>(ring, pg8::Shape{256, 512, 256}, S, E); }
        if (P3M & 4) { DenseOrder S; S.init(64, 2, F.G, (int)blockIdx.x, ws + WS_POOLED, 512, ws + WS_WPOOL, 256, 512);
          EpiBf16 E{(bf16_t*)(ws + WS_MIXED), 512};
          pg8::gemm_phase<EpiBf16, DenseOrder, true, true>(ring, pg8::Shape{256, 512, 256}, S, E); }
    } SEAM(3);

    if (IN(4)) {
        for (int it = F.vcu; it < 256; it += F.G) {
            const int bh = it >> 3, pr = it & 7;
            att::attn_unit(ring, bh, 15 - pr, (const bf16_t*)(ws + WS_Q), (const bf16_t*)(ws + WS_K), (const bf16_t*)(ws + WS_V), (const float*)(ws + WS_SSQ), (bf16_t*)(ws + WS_ATT));
            att::attn_unit(ring, bh, pr, (const bf16_t*)(ws + WS_Q), (const bf16_t*)(ws + WS_K), (const bf16_t*)(ws + WS_V), (const float*)(ws + WS_SSQ), (bf16_t*)(ws + WS_ATT));
        }
    } SEAM(4);

    if (IN(5)) {
        MixOrder S{F.G, (int)blockIdx.x, (const char*)(ws + WS_ATT), (const char*)(ws + WS_MIXED), (const char*)(ws + WS_WAO), (const char*)(ws + WS_WPO)};
        EpiMix E{(bf16_t*)(ws + WS_MIX), (const bf16_t*)(ws + WS_GATES)};
        pg8::gemm_phase<EpiMix, MixOrder, true, true>(ring, pg8::Shape{512, 512, 512}, S, E);
    } SEAM(5);

    if (IN(6)) {
        DenseOrder S; S.init(64, 4, F.G, (int)blockIdx.x, ws + WS_MIX, 1024, ws + WS_WO, 1024);
        EpiRes E{args.in[I_X], args.out};
        pg8::gemm_phase<EpiRes, DenseOrder, true, true>(ring, pg8::Shape{1024, 1024, 1024}, S, E);
    } SEAM(6);

    if (IN(7)) { p7_router(F, args); } SEAM(7);

    if (IN(8)) { p8_dispatch(F, args); } SEAM(8);

    if (IN(9)) {
        const int TM = build_tiles(F);
        MoeOrder S{F.G, (int)blockIdx.x, 3, TM * 8, (const LAS int*)(F.lds + TILE_E_OFF) + 64, (const char*)(ws + WS_XS), (const char*)(ws + WS_WGU), (size_t)2048 * 1024 * 2, (size_t)256 * 1024 * 2};
        EpiSwiglu E{(bf16_t*)(ws + WS_ACT), args.in[I_BGU]};
        pg8::gemm_phase<EpiSwiglu, MoeOrder, true, true>(ring, pg8::Shape{1024, 1024, 1024}, S, E);
    } SEAM(9);

    if (IN(10)) {
        const int TM = build_tiles(F);
        MoeOrder S{F.G, (int)blockIdx.x, 2, TM * 4, (const LAS int*)(F.lds + TILE_E_OFF) + 64, (const char*)(ws + WS_ACT), (const char*)(ws + WS_WD), (size_t)1024 * 1024 * 2, (size_t)256 * 1024 * 2};
        EpiDown E{(bf16_t*)(ws + WS_XS), args.in[I_BD]};
        pg8::gemm_phase<EpiDown, MoeOrder, true, true>(ring, pg8::Shape{1024, 1024, 1024}, S, E);
    } SEAM(10);

    if (IN(11)) { p11_combine(F, args); } SEAM(11);

    if (IN(12)) {
        DenseOrder S; S.init(64, 4, F.G, (int)blockIdx.x, ws + WS_HN, 1024, ws + WS_WPG, 1024);
        EpiPle E{args.out, (const bf16_t*)(ws + WS_E)};
        pg8::gemm_phase<EpiPle, DenseOrder, true, true>(ring, pg8::Shape{1024, 1024, 1024}, S, E);
    }
#undef IN
#undef SEAM
}

extern "C" void kernel_launch(void* const* d_in, const int* in_sizes, int n_in, void* d_out, int out_size, void* d_ws, size_t ws_size, hipStream_t stream) {
    static int grid = 0;
    if (grid == 0) {
        if (n_in != 27 || out_size != T * DM || ws_size < WS_END) { fprintf(stderr, "kernel_launch: unexpected shapes (n_in %d, out %d, ws %zu)\n", n_in, out_size, ws_size); grid = -1; return; }
        int dev = 0, cus = 0;
        if (hipGetDevice(&dev) != hipSuccess || hipDeviceGetAttribute(&cus, hipDeviceAttributeMultiprocessorCount, dev) != hipSuccess) { grid = -1; return; }
        if (hipFuncSetAttribute((const void*)fwd_kernel, hipFuncAttributeMaxDynamicSharedMemorySize, LDS_BYTES) != hipSuccess) { fprintf(stderr, "kernel_launch: hipFuncSetAttribute failed\n"); grid = -1; return; }
        int per_cu = 0;
        if (hipOccupancyMaxActiveBlocksPerMultiprocessor(&per_cu, (const void*)fwd_kernel, NWAVES * 64, LDS_BYTES) != hipSuccess || per_cu < 1) fprintf(stderr, "kernel_launch: occupancy query says %d\n", per_cu);
        (void)hipGetLastError();
        grid = cus;
    }
    if (grid < 0) return;
    (void)hipMemsetAsync((char*)d_ws + WS_CTL, 0, CTL_ZERO_BYTES, stream);
    Args a{};
    for (int i = 0; i < 27; ++i) a.in[i] = (const float*)d_in[i];
    a.out = (float*)d_out; a.ws = (unsigned char*)d_ws;
#ifndef DUP_PHASE
    a.ph_lo = 0; a.ph_hi = N_PHASES; hipLaunchKernelGGL(fwd_kernel, dim3(grid), dim3(NWAVES * 64), LDS_BYTES, stream, a);
#else
    a.ph_lo = 0; a.ph_hi = DUP_PHASE + 1; hipLaunchKernelGGL(fwd_kernel, dim3(grid), dim3(NWAVES * 64), LDS_BYTES, stream, a);
    (void)hipMemsetAsync((char*)d_ws + WS_CTL + CW_BAR * 4, 0, XCD_BAR_WORDS * 4, stream);
    a.ph_lo = DUP_PHASE; a.ph_hi = N_PHASES; hipLaunchKernelGGL(fwd_kernel, dim3(grid), dim3(NWAVES * 64), LDS_BYTES, stream, a);
#endif
}
```

```cpp
#include <hip/hip_runtime.h>
#include <cstdio>
#include <cstdint>

#define LAS __attribute__((address_space(3)))
#define GAS __attribute__((address_space(1)))
typedef unsigned short bf16_t;
typedef short bf16x8 __attribute__((ext_vector_type(8)));
typedef short s16x4 __attribute__((ext_vector_type(4)));
typedef float f32x4 __attribute__((ext_vector_type(4)));
typedef float f32x2 __attribute__((ext_vector_type(2)));
typedef float f32x16 __attribute__((ext_vector_type(16)));
typedef unsigned u32x4 __attribute__((ext_vector_type(4)));
typedef unsigned u32x2 __attribute__((ext_vector_type(2)));

constexpr int NB = 4, SEQ = 4096, T = NB * SEQ, DM = 1024, NH = 8, DK = 96, DV = 64;
constexpr int NEXP = 32, TOPK = 4, DEXP = 1024, PLE = 256;
constexpr float EPS = 1e-6f;
constexpr int XS_ROWS = T * TOPK + NEXP * 256;

__device__ __forceinline__ unsigned cvt_pk_bf16(float lo, float hi) { unsigned r; asm volatile("v_cvt_pk_bf16_f32 %0, %1, %2" : "=v"(r) : "v"(lo), "v"(hi)); return r; }
__device__ __forceinline__ u32x2 cvt8_fp8(const f32x4 a, const f32x4 b, float sc) {
    int w0 = __builtin_amdgcn_cvt_pk_fp8_f32(a[0] * sc, a[1] * sc, 0, false); w0 = __builtin_amdgcn_cvt_pk_fp8_f32(a[2] * sc, a[3] * sc, w0, true);
    int w1 = __builtin_amdgcn_cvt_pk_fp8_f32(b[0] * sc, b[1] * sc, 0, false); w1 = __builtin_amdgcn_cvt_pk_fp8_f32(b[2] * sc, b[3] * sc, w1, true);
    u32x2 r; r.x = (unsigned)w0; r.y = (unsigned)w1; return r;
}
__device__ __forceinline__ float bf_lo(unsigned w) { return __uint_as_float(w << 16); }
__device__ __forceinline__ float bf_hi(unsigned w) { return __uint_as_float(w & 0xffff0000u); }
__device__ __forceinline__ float bf1(bf16_t h) { return __uint_as_float(((unsigned)h) << 16); }
__device__ __forceinline__ float fast_sigmoid(float v) { return __builtin_amdgcn_rcpf(1.0f + __builtin_amdgcn_exp2f(-1.4426950408889634f * v)); }
__device__ __forceinline__ float wave_sum(float v) {
#pragma unroll
    for (int o = 1; o < 64; o <<= 1) v += __shfl_xor(v, o);
    return v;
}

namespace pg8 {
constexpr int BM = 256, BK = 64, HALF = 128, HTB = HALF * BK * 2, STAGE_BYTES = 8 * HTB;
__host__ __device__ __forceinline__ int lds_byte(int r, int c) { const int st = (r >> 4) * 2 + (c >> 5), rr = r & 15, cc = c & 31, ob = rr * 64 + cc * 2; return st * 1024 + (ob ^ (((ob >> 9) & 1) << 5)); }
__host__ __device__ __forceinline__ void stage_rc(int b, int& R, int& C) { const int st = b / 1024, sb = b % 1024, swz = sb ^ (((sb >> 9) & 1) << 5); R = (st >> 1) * 16 + swz / 64; C = (st & 1) * 32 + (swz % 64) / 2; }
__host__ __device__ __forceinline__ int perm32(int rho) { const int n = rho >> 4, i = rho & 15; return 8 * (i >> 2) + 4 * n + (i & 3); }

struct Unit { int pm, pn, aux; };
struct Shape { int Kb, lda, ldb, sw, sa; };
typedef int v8i_t __attribute__((ext_vector_type(8))); typedef int v4i_t __attribute__((ext_vector_type(4)));

template <class Epi, class Sched, bool ALIGN_EPI, bool SP2, bool MX = false>
__device__ __forceinline__ void gemm_phase(LAS unsigned char* lds, const __amdgpu_buffer_rsrc_t rsrc, const Shape g, const Sched& S, const Epi& E) {
    const int tid = threadIdx.x, wid = __builtin_amdgcn_readfirstlane(tid >> 6), lane = tid & 63, wr = wid >> 2, wc = wid & 3, fr = lane & 15, fq = lane >> 4;
    int nt = g.Kb / 128; asm volatile("" : "+s"(nt));
    unsigned voffA[2], voffB[2];
#pragma unroll
    for (int i = 0; i < 2; ++i) { int R, C; stage_rc(tid * 16 + i * 8192, R, C); const int Rb = Epi::PERM ? ((R & ~31) + perm32(R & 31)) : R;
        voffA[i] = (unsigned)(R * g.lda + C * 2); voffB[i] = (unsigned)(Rb * g.ldb + C * 2); }
    const unsigned kstep = 128u;
    const unsigned hstepA = (unsigned)HALF * g.lda, hstepB = (unsigned)HALF * g.ldb;
    const unsigned ldsw = (unsigned)wid * 1024u;
    const int aoff = lds_byte(wr * 64 + fr, fq * 8), boff = lds_byte(wc * 32 + fr, fq * 8);
#define PG8_SA(b, h) (((b) * 2 + (h)) * HTB)
#define PG8_SB(b, h) ((4 + (b) * 2 + (h)) * HTB)
#define PG8_STAGE(bufoff, gbase, voff) do { _Pragma("unroll") for (int _i = 0; _i < 2; ++_i) \
        __builtin_amdgcn_raw_ptr_buffer_load_lds(rsrc, (LAS void*)(lds + (bufoff) + ldsw + _i * 8192), 16, (voff)[_i], (gbase), 0, 0); } while (0)
#define PG8_LDA(dst, b, h) do { _Pragma("unroll") for (int m = 0; m < 4; ++m) _Pragma("unroll") for (int k = 0; k < 2; ++k) dst[m][k] = *(const LAS bf16x8*)(lds + PG8_SA(b, h) + aoff + m * 2048 + k * 1024); } while (0)
#define PG8_LDB(dst, b, h) do { _Pragma("unroll") for (int n = 0; n < 2; ++n) _Pragma("unroll") for (int k = 0; k < 2; ++k) dst[n][k] = *(const LAS bf16x8*)(lds + PG8_SB(b, h) + boff + n * 2048 + k * 1024); } while (0)
#define PG8_CAT(x, y) __builtin_shufflevector(__builtin_bit_cast(v4i_t, x), __builtin_bit_cast(v4i_t, y), 0, 1, 2, 3, 4, 5, 6, 7)
#define PG8_MMA(ai, bj, At, Bt) do { __builtin_amdgcn_s_setprio(1); if constexpr (MX) { _Pragma("unroll") for (int m = 0; m < 4; ++m) _Pragma("unroll") for (int n = 0; n < 2; ++n) \
        acc[ai][bj][m][n] = __builtin_amdgcn_mfma_scale_f32_16x16x128_f8f6f4(PG8_CAT(Bt[n][0], Bt[n][1]), PG8_CAT(At[m][0], At[m][1]), acc[ai][bj][m][n], 0, 0, 0, g.sw, 0, g.sa); } else { \
        _Pragma("unroll") for (int m = 0; m < 4; ++m) _Pragma("unroll") for (int n = 0; n < 2; ++n) _Pragma("unroll") for (int k = 0; k < 2; ++k) \
        acc[ai][bj][m][n] = __builtin_amdgcn_mfma_f32_16x16x32_bf16(Bt[n][k], At[m][k], acc[ai][bj][m][n], 0, 0, 0); } __builtin_amdgcn_s_setprio(0); } while (0)
#define PG8_WAIT_V(n) asm volatile("s_waitcnt vmcnt(" #n ")" ::: "memory")
#define PG8_WAIT_L(n) asm volatile("s_waitcnt lgkmcnt(" #n ")" ::: "memory")
#define PG8_BAR __builtin_amdgcn_s_barrier()
#define PG8_SCHED __builtin_amdgcn_sched_barrier(0)
    Unit cur, nxt; int ui = 0;
    if (!S.next(0, cur)) return;
    f32x4 acc[2][2][4][2];
#pragma unroll
    for (int a = 0; a < 2; ++a)
#pragma unroll
        for (int b = 0; b < 2; ++b)
#pragma unroll
            for (int m = 0; m < 4; ++m)
#pragma unroll
                for (int n = 0; n < 2; ++n) acc[a][b][m][n] = (f32x4){0.f, 0.f, 0.f, 0.f};
    bf16x8 At[4][2], B0[2][2], B1[2][2];
    unsigned cA = S.a_off(cur), cB = S.b_off(cur);
    if constexpr (SP2) {
        PG8_STAGE(PG8_SB(0, 0), cB, voffB); PG8_STAGE(PG8_SB(0, 1), cB + hstepB, voffB); PG8_STAGE(PG8_SA(0, 0), cA, voffA); PG8_STAGE(PG8_SA(0, 1), cA + hstepA, voffA);
        if (wr == 1) PG8_BAR;
        PG8_WAIT_V(2); PG8_BAR;
        PG8_STAGE(PG8_SB(1, 0), cB + kstep, voffB); PG8_STAGE(PG8_SA(1, 0), cA + kstep, voffA); PG8_STAGE(PG8_SB(1, 1), cB + hstepB + kstep, voffB);
        PG8_WAIT_V(6); PG8_BAR;
    } else {
        PG8_STAGE(PG8_SB(0, 0), cB, voffB); PG8_STAGE(PG8_SA(0, 0), cA, voffA); PG8_STAGE(PG8_SB(0, 1), cB + hstepB, voffB); PG8_STAGE(PG8_SA(0, 1), cA + hstepA, voffA);
        if (wr == 1) PG8_BAR;
        PG8_WAIT_V(4); PG8_BAR;
        PG8_STAGE(PG8_SB(1, 0), cB + kstep, voffB); PG8_STAGE(PG8_SA(1, 0), cA + kstep, voffA); PG8_STAGE(PG8_SB(1, 1), cB + hstepB + kstep, voffB);
        PG8_WAIT_V(6); PG8_BAR;
    }
    for (;;) {
        const bool has_next = S.next(ui + 1, nxt);
        const unsigned nA = has_next ? S.a_off(nxt) : cA, nB = has_next ? S.b_off(nxt) : cB;
#pragma nounroll
        for (int t = 0; t < nt; t += 2) {
            const bool last = (t == nt - 2);
            const unsigned a1 = cA + (unsigned)(t + 1) * kstep;
            const unsigned a2 = last ? nA : cA + (unsigned)(t + 2) * kstep, b2 = last ? nB : cB + (unsigned)(t + 2) * kstep;
            const unsigned a3 = a2 + kstep, b3 = b2 + kstep;
            if constexpr (SP2) {
            PG8_LDB(B0, 0, 0); PG8_LDB(B1, 0, 1); PG8_SCHED; PG8_LDA(At, 0, 0); PG8_STAGE(PG8_SA(1, 1), a1 + hstepA, voffA);
            PG8_WAIT_V(8); PG8_WAIT_L(0); PG8_BAR; PG8_MMA(0, 0, At, B0); PG8_MMA(0, 1, At, B1); PG8_BAR; PG8_SCHED;
            PG8_LDA(At, 0, 1); PG8_STAGE(PG8_SB(0, 0), b2, voffB); PG8_STAGE(PG8_SB(0, 1), b2 + hstepB, voffB); PG8_STAGE(PG8_SA(0, 0), a2, voffA);
            PG8_WAIT_V(8); PG8_WAIT_L(0); PG8_BAR; PG8_MMA(1, 0, At, B0); PG8_MMA(1, 1, At, B1); PG8_BAR; PG8_SCHED;
            PG8_LDB(B0, 1, 0); PG8_LDB(B1, 1, 1); PG8_SCHED; PG8_LDA(At, 1, 0); PG8_STAGE(PG8_SA(0, 1), a2 + hstepA, voffA);
            PG8_WAIT_V(8); PG8_WAIT_L(0); PG8_BAR; PG8_MMA(0, 0, At, B0); PG8_MMA(0, 1, At, B1); PG8_BAR; PG8_SCHED;
            PG8_LDA(At, 1, 1); PG8_STAGE(PG8_SB(1, 0), b3, voffB); PG8_STAGE(PG8_SB(1, 1), b3 + hstepB, voffB); PG8_STAGE(PG8_SA(1, 0), a3, voffA);
            PG8_WAIT_V(8); PG8_WAIT_L(0); PG8_BAR; PG8_MMA(1, 0, At, B0); PG8_MMA(1, 1, At, B1); PG8_BAR; PG8_SCHED;
            } else {
            PG8_LDB(B0, 0, 0); PG8_SCHED; PG8_LDA(At, 0, 0); PG8_STAGE(PG8_SA(1, 1), a1 + hstepA, voffA);
            PG8_WAIT_L(8); PG8_BAR; PG8_WAIT_L(0); PG8_MMA(0, 0, At, B0); PG8_BAR; PG8_SCHED;
            PG8_LDB(B1, 0, 1); PG8_STAGE(PG8_SB(0, 0), b2, voffB);
            PG8_BAR; PG8_WAIT_L(0); PG8_MMA(0, 1, At, B1); PG8_BAR;
            PG8_LDA(At, 0, 1); PG8_STAGE(PG8_SA(0, 0), a2, voffA);
            PG8_BAR; PG8_WAIT_L(0); PG8_MMA(1, 0, At, B0); PG8_BAR; PG8_SCHED;
            PG8_STAGE(PG8_SB(0, 1), b2 + hstepB, voffB);
            PG8_WAIT_V(6); PG8_BAR; PG8_MMA(1, 1, At, B1); PG8_BAR;
            PG8_LDB(B0, 1, 0); PG8_SCHED; PG8_LDA(At, 1, 0); PG8_STAGE(PG8_SA(0, 1), a2 + hstepA, voffA);
            PG8_WAIT_L(8); PG8_BAR; PG8_WAIT_L(0); PG8_MMA(0, 0, At, B0); PG8_BAR; PG8_SCHED;
            PG8_LDB(B1, 1, 1); PG8_STAGE(PG8_SB(1, 0), b3, voffB);
            PG8_BAR; PG8_WAIT_L(0); PG8_MMA(0, 1, At, B1); PG8_BAR;
            PG8_LDA(At, 1, 1); PG8_STAGE(PG8_SA(1, 0), a3, voffA);
            PG8_BAR; PG8_WAIT_L(0); PG8_MMA(1, 0, At, B0); PG8_BAR; PG8_SCHED;
            PG8_STAGE(PG8_SB(1, 1), b3 + hstepB, voffB);
            PG8_WAIT_V(6); PG8_BAR; PG8_MMA(1, 1, At, B1); PG8_BAR;
            }
        }
        if constexpr (ALIGN_EPI) { if (wr == 0) PG8_BAR; }
        { int fr_e = fr, fq_e = fq; asm volatile("" : "+v"(fr_e), "+v"(fq_e));
          E(acc, cur, wr, wc, fr_e, fq_e); }
        if (!has_next) break;
#pragma unroll
        for (int a = 0; a < 2; ++a)
#pragma unroll
            for (int b = 0; b < 2; ++b)
#pragma unroll
                for (int m = 0; m < 4; ++m)
#pragma unroll
                    for (int n = 0; n < 2; ++n) acc[a][b][m][n] = (f32x4){0.f, 0.f, 0.f, 0.f};
        cur = nxt; cA = nA; cB = nB; ++ui;
        if constexpr (ALIGN_EPI) { if (wr == 1) PG8_BAR; }
    }
    PG8_WAIT_V(0);
    if constexpr (!ALIGN_EPI) { if (wr == 0) PG8_BAR; }
    PG8_BAR;
#undef PG8_SA
#undef PG8_SB
#undef PG8_STAGE
#undef PG8_LDA
#undef PG8_LDB
#undef PG8_MMA
#undef PG8_CAT
#undef PG8_WAIT_V
#undef PG8_WAIT_L
#undef PG8_BAR
#undef PG8_SCHED
}
}
using pg8::Unit;

constexpr size_t MiB = 1u << 20;
constexpr size_t WS_CTL = 0, CTL_ZERO_BYTES = 1 * MiB;
constexpr size_t WS_WIN = 1 * MiB;
constexpr size_t WS_WQ = 7 * MiB;
constexpr size_t WS_WKV = WS_WQ + 512 * 1024;
constexpr size_t WS_WPOOL = 8 * MiB;
constexpr size_t WS_WAO = 9 * MiB;
constexpr size_t WS_WPO = 10 * MiB;
constexpr size_t WS_WO = 11 * MiB;
constexpr size_t WS_WPG = 13 * MiB;
constexpr size_t WS_WPLE = 15 * MiB;
constexpr size_t WS_WGU = 16 * MiB;
constexpr size_t WS_WD = 144 * MiB;
constexpr size_t WS_HN = 208 * MiB;
constexpr size_t WS_PROJ = 240 * MiB;
constexpr size_t WS_GATES = 272 * MiB;
constexpr size_t WS_A2 = 336 * MiB;
constexpr size_t WS_POOLED = 352 * MiB;
constexpr size_t WS_Q = 368 * MiB;
constexpr size_t WS_K = 392 * MiB;
constexpr size_t WS_V = 416 * MiB;
constexpr size_t WS_ATT = 432 * MiB;
constexpr size_t WS_MIXED = 448 * MiB;
constexpr size_t WS_MIX = 464 * MiB;
constexpr size_t WS_PB = 496 * MiB;
constexpr size_t WS_E = 504 * MiB;
constexpr size_t WS_SSQ = 536 * MiB;
constexpr size_t WS_COS = 537 * MiB;
constexpr size_t WS_SIN = 538 * MiB;
constexpr size_t WS_ROUTE = 539 * MiB;
constexpr size_t WS_XS = 544 * MiB;
constexpr size_t WS_ACT = 688 * MiB;
constexpr size_t WS_XS2 = 768 * MiB;
constexpr size_t WS_END = 848 * MiB;
constexpr int CW_BAR = 4096;
constexpr int CW_CNT = 1024;

constexpr int RING_BYTES = 131072;
constexpr int LDS_BYTES = 163840;
constexpr int MISC_OFF = LDS_BYTES - 512;
constexpr int TILE_E_OFF = LDS_BYTES - 4096;
constexpr int NWAVES = 8;

typedef GAS unsigned gu32;
#define RLX_AGENT __ATOMIC_RELAXED, __HIP_MEMORY_SCOPE_AGENT
#define XB_TMO      128
#define XB_XCNT(j)  (256  + 64 * (j))
#define XB_XSUB(j)  (1280 + 64 * (j))
#define XB_XGEN(j)  (2304 + 64 * (j))
#define XB_TOP      3328
#define XB_TOPGEN   3392
#define XCD_BAR_WORDS 3456
#define XB_SPIN_CAP (1u << 18)
__device__ __forceinline__ unsigned xb_ld(unsigned* p)              { return __hip_atomic_load(p, __ATOMIC_RELAXED, __HIP_MEMORY_SCOPE_AGENT); }
__device__ __forceinline__ unsigned xb_add(unsigned* p, unsigned v) { return __hip_atomic_fetch_add(p, v, __ATOMIC_RELAXED, __HIP_MEMORY_SCOPE_AGENT); }
__device__ __forceinline__ unsigned xb_xcc_id() { return (unsigned)__builtin_amdgcn_s_getreg((3 << 11) | 20) & 0xFu; }
#define XB_SPIN(cond, bar) do { unsigned _sp = 0; while (cond) { __builtin_amdgcn_s_sleep(1); \
    if ((++_sp & 255u) == 0u) { if (xb_ld(&(bar)[XB_TMO])) break; if (_sp > XB_SPIN_CAP) { atomicAdd(&(bar)[XB_TMO], 1u); break; } } } } while (0)
struct XcdBarrier { unsigned* bar; unsigned x; volatile LAS unsigned* st; };
__device__ __forceinline__ XcdBarrier xcd_barrier_post(unsigned* bar, volatile LAS unsigned* st) {
    XcdBarrier b; b.bar = bar; b.x = xb_xcc_id(); b.st = st;
    if (threadIdx.x == 0) (void)xb_add(&bar[XB_XCNT(b.x)], 1u);
    return b;
}
__device__ __forceinline__ void xcd_barrier_complete(unsigned* bar, unsigned x, unsigned& nloc, unsigned& nx) {
    const unsigned G = gridDim.x * gridDim.y * gridDim.z;
    unsigned sum, cnt, mine, sp = 0u;
    for (;;) {
        sum = 0u; cnt = 0u; mine = 0u;
#pragma unroll
        for (unsigned j = 0; j < 16; ++j) { const unsigned c = xb_ld(&bar[XB_XCNT(j)]); sum += c; cnt += (c > 0u) ? 1u : 0u; mine = (j == x) ? c : mine; }
        if (sum == G) break;
        __builtin_amdgcn_s_sleep(1);
        if ((++sp & 255u) == 0u) { if (xb_ld(&bar[XB_TMO])) break; if (sp > XB_SPIN_CAP) { atomicAdd(&bar[XB_TMO], 1u); break; } }
    }
    nloc = mine > 0u ? mine : 1u; nx = cnt > 0u ? cnt : 1u;
}
__device__ __forceinline__ void xcd_barrier(const XcdBarrier& b) {
    asm volatile("s_waitcnt vmcnt(0)" ::: "memory");
    __syncthreads();
    if (threadIdx.x == 0) {
        unsigned* bar = b.bar;
        __builtin_amdgcn_s_waitcnt(0);
        unsigned nloc = b.st[0], nx = b.st[1];
        if (nloc == 0u) { xcd_barrier_complete(bar, b.x, nloc, nx); b.st[0] = nloc; b.st[1] = nx; }
        const unsigned old = xb_add(&bar[XB_XSUB(b.x)], 1u);
        const unsigned gen = old / nloc;
        if (old + 1u == (gen + 1u) * nloc) {
            __builtin_amdgcn_fence(__ATOMIC_RELEASE, "agent");
            asm volatile("s_waitcnt vmcnt(0)" ::: "memory");
            const unsigned og = xb_add(&bar[XB_TOP], 1u);
            const unsigned tg = og / nx;
            if (og + 1u == (tg + 1u) * nx) xb_add(&bar[XB_TOPGEN], 1u);
            else XB_SPIN(xb_ld(&bar[XB_TOPGEN]) == tg, bar);
            __builtin_amdgcn_fence(__ATOMIC_ACQUIRE, "agent");
            xb_add(&bar[XB_XGEN(b.x)], 1u);
            asm volatile("s_waitcnt vmcnt(0)" ::: "memory");
        } else {
            XB_SPIN(xb_ld(&bar[XB_XGEN(b.x)]) == gen, bar);
            __builtin_amdgcn_fence(__ATOMIC_ACQUIRE, "agent");
            asm volatile("s_waitcnt vmcnt(0)" ::: "memory");
        }
    }
    __syncthreads();
}

struct Args {
    const float* in[27];
    float* out; unsigned char* ws;
    int ph_lo, ph_hi;
};
enum { I_X = 0, I_P, I_POS, I_GMIX, I_WIN, I_GQLAT, I_WQB, I_GKVLAT, I_WKVB, I_GQHEAD, I_GKNOPE, I_GKROPE, I_WPOOL, I_PSCALE, I_WAO, I_WPO, I_WO, I_GFFN,
       I_WR, I_BR, I_WGU, I_BGU, I_WD, I_BD, I_GPLE, I_WPG, I_WPLE };

enum { MAP_ID = 0, MAP_WIN, MAP_GU, MAP_QB, MAP_KVB };
__device__ __forceinline__ int map_row(int mode, int n) {
    switch (mode) {
    case MAP_WIN: return n < 416 ? n : n + 96;
    case MAP_GU: { const int j = n & 1023, up = n >> 10; return 256 * (j >> 7) + 128 * up + (j & 127); }
    case MAP_QB: { const int h = n / 96, d = n % 96;
        if (d < 64) return (h >> 2) * 256 + 128 * (d >> 5) + 32 * (h & 3) + (d & 31);
        const int dd = d - 64, half = dd >> 4, i = dd & 15; return 512 + 128 * (h & 1) + 32 * (h >> 1) + 8 * (i >> 2) + 4 * half + (i & 3); }
    case MAP_KVB: { const int h = n >> 7, c = n & 127, isv = c >> 6, d = c & 63; return (h >> 1) * 256 + 128 * (d >> 5) + 32 * (2 * isv + (h & 1)) + (d & 31); }
    default: return n;
    }
}
struct TJob { const float* W; int K, N; bf16_t* WT; int ldw, koff, mode, row_off; const float* gk; const float* gn; int nmat; size_t wstride, wtstride; int fp8; };
struct TItem { const float* src; bf16_t* dst; int n0, k0; float gnv; };
__device__ __forceinline__ TItem titem_setup(const TJob& J, int item, int lane) {
    const int nblk = J.N / 32, ipm = (J.K / 64) * nblk, mat = item / ipm, it = item - mat * ipm, kb = it / nblk, nb = it - kb * nblk;
    TItem I; I.k0 = 64 * kb; I.n0 = 32 * nb;
    I.src = J.W + (size_t)mat * J.wstride + (size_t)(I.k0 + (lane >> 5)) * J.N + I.n0 + (lane & 31);
    I.dst = (bf16_t*)((unsigned char*)J.WT + (size_t)mat * J.wtstride * (J.fp8 ? 1 : 2));
    I.gnv = J.gn ? J.gn[I.n0 + (lane & 31)] : 1.f;
    return I;
}
__device__ __forceinline__ void titem_load(const TJob& J, const TItem& I, float (&v)[32]) {
#pragma unroll
    for (int i = 0; i < 32; ++i) v[i] = I.src[(size_t)(2 * i) * J.N];
}
__device__ __forceinline__ void titem_store(const TJob& J, const TItem& I, float (&v)[32], LAS float* scr, int lane) {
#pragma unroll
    for (int i = 0; i < 32; ++i) { const int kk = 2 * i + (lane >> 5); float x = v[i] * I.gnv; if (J.gk) x *= J.gk[I.k0 + kk]; scr[kk * 33 + (lane & 31)] = x; }
    asm volatile("s_waitcnt lgkmcnt(0)" ::: "memory");
    const int c = lane & 7;
#pragma unroll
    for (int j = 0; j < 4; ++j) { const int n = (lane >> 3) + 8 * j; const LAS float* s = scr + (8 * c) * 33 + n;
        const size_t eo = (size_t)(J.row_off + map_row(J.mode, I.n0 + n)) * J.ldw + J.koff + I.k0 + 8 * c;
        if (J.fp8) { u32x2 o; int w = __builtin_amdgcn_cvt_pk_fp8_f32(s[0 * 33] * 32.f, s[1 * 33] * 32.f, 0, false); w = __builtin_amdgcn_cvt_pk_fp8_f32(s[2 * 33] * 32.f, s[3 * 33] * 32.f, w, true); o.x = (unsigned)w;
            w = __builtin_amdgcn_cvt_pk_fp8_f32(s[4 * 33] * 32.f, s[5 * 33] * 32.f, 0, false); w = __builtin_amdgcn_cvt_pk_fp8_f32(s[6 * 33] * 32.f, s[7 * 33] * 32.f, w, true); o.y = (unsigned)w;
            *(u32x2*)((unsigned char*)I.dst + eo) = o; }
        else { u32x4 o; o.x = cvt_pk_bf16(s[0 * 33], s[1 * 33]); o.y = cvt_pk_bf16(s[2 * 33], s[3 * 33]); o.z = cvt_pk_bf16(s[4 * 33], s[5 * 33]); o.w = cvt_pk_bf16(s[6 * 33], s[7 * 33]);
            *(u32x4*)(I.dst + eo) = o; } }
    asm volatile("s_waitcnt lgkmcnt(0)" ::: "memory");
}
__device__ __forceinline__ void run_job(const TJob& J, LAS float* scr, int gw, int NGW, int lane) {
    const int items = J.nmat * (J.K / 64) * (J.N / 32);
    for (int it = gw; it < items; it += 2 * NGW) {
        const bool two = (it + NGW) < items;
        const TItem I0 = titem_setup(J, it, lane); const TItem I1 = titem_setup(J, two ? it + NGW : it, lane);
        float v0[32], v1[32];
        titem_load(J, I0, v0); if (two) titem_load(J, I1, v1);
        titem_store(J, I0, v0, scr, lane); if (two) titem_store(J, I1, v1, scr, lane);
    }
}

struct Frame {
    LAS unsigned char* lds; volatile LAS unsigned* MISC; unsigned* ctl;
    int tid, lane, wave, vcu, G;
    float* out; unsigned char* ws;
};

__device__ __forceinline__ void p0_prologue(const Frame& F, const Args& a) {
    LAS float* scr = (LAS float*)(F.lds + F.wave * 16384);
    const int gw = F.vcu * NWAVES + F.wave, NGW = F.G * NWAVES;
    unsigned char* ws = F.ws;
#define RUN_JOB(...) do { const TJob J_ = TJob{__VA_ARGS__, 1, 0, 0, 0}; run_job(J_, scr, gw, NGW, F.lane); } while (0)
    RUN_JOB(a.in[I_WIN], 1024, 2976, (bf16_t*)(ws + WS_WIN), 1024, 0, MAP_WIN, 0, nullptr, nullptr);
    RUN_JOB(a.in[I_WQB], 256, 768, (bf16_t*)(ws + WS_WQ), 256, 0, MAP_QB, 0, a.in[I_GQLAT], nullptr);
    RUN_JOB(a.in[I_WKVB], 128, 1024, (bf16_t*)(ws + WS_WKV), 256, 0, MAP_KVB, 0, a.in[I_GKVLAT], nullptr);
    RUN_JOB(a.in[I_WAO], 512, 1024, (bf16_t*)(ws + WS_WAO), 512, 0, MAP_ID, 0, nullptr, nullptr);
    RUN_JOB(a.in[I_WPO], 512, 1024, (bf16_t*)(ws + WS_WPO), 512, 0, MAP_ID, 0, nullptr, nullptr);
    RUN_JOB(a.in[I_WO], 1024, 1024, (bf16_t*)(ws + WS_WO), 1024, 0, MAP_ID, 0, nullptr, nullptr);
    RUN_JOB(a.in[I_WPG], 1024, 1024, (bf16_t*)(ws + WS_WPG), 1024, 0, MAP_ID, 0, nullptr, nullptr);
    RUN_JOB(a.in[I_WPLE], 256, 1024, (bf16_t*)(ws + WS_WPLE), 256, 0, MAP_ID, 0, nullptr, nullptr);
    for (int g = 0; g < 4; ++g)
        RUN_JOB(a.in[I_WPOOL] + (size_t)g * 128 * 128, 128, 128, (bf16_t*)(ws + WS_WPOOL) + (size_t)(g >> 1) * 256 * 256, 256, 128 * (g & 1), MAP_ID, 128 * (g & 1), nullptr, a.in[I_PSCALE] + 128 * g);
    {
        const int gt = (F.vcu * NWAVES + F.wave) * 64 + F.lane, NGT = NGW * 64;
        const u32x4 z = {0u, 0u, 0u, 0u};
        u32x4* w0 = (u32x4*)((bf16_t*)(ws + WS_WIN) + (size_t)416 * 1024);
        for (int i = gt; i < 96 * 128; i += NGT) w0[i] = z;
        for (int i = gt; i < 1024 * 16; i += NGT) { const int r = i >> 4, c = i & 15; *(u32x4*)((bf16_t*)(ws + WS_WKV) + (size_t)r * 256 + 128 + 8 * c) = z; }
        for (int i = gt; i < 2 * 256 * 16; i += NGT) { const int p = i >> 12, r = (i >> 4) & 255, c = i & 15;
            const int k0 = (r < 128) ? 128 : 0; *(u32x4*)((bf16_t*)(ws + WS_WPOOL) + (size_t)p * 65536 + (size_t)r * 256 + k0 + 8 * c) = z; }
    }
    { const TJob J{a.in[I_WGU], 1024, 2048, (bf16_t*)(ws + WS_WGU), 1024, 0, MAP_GU, 0, nullptr, nullptr, NEXP, (size_t)1024 * 2048, (size_t)2048 * 1024, 1}; run_job(J, scr, gw, NGW, F.lane); }
    { const TJob J{a.in[I_WD], 1024, 1024, (bf16_t*)(ws + WS_WD), 1024, 0, MAP_ID, 0, nullptr, nullptr, NEXP, (size_t)1024 * 1024, (size_t)1024 * 1024, 1}; run_job(J, scr, gw, NGW, F.lane); }
    const float* x = a.in[I_X]; const float* gm = a.in[I_GMIX];
    f32x4 gv[4];
#pragma unroll
    for (int j = 0; j < 4; ++j) gv[j] = *(const f32x4*)(gm + 4 * F.lane + 256 * j);
    for (int m = gw; m < T; m += NGW) {
        const f32x4* xr = (const f32x4*)(x + (size_t)m * DM) + F.lane;
        f32x4 v[4]; float s = 0.f;
#pragma unroll
        for (int j = 0; j < 4; ++j) { v[j] = xr[64 * j]; s += (v[j].x * v[j].x + v[j].y * v[j].y) + (v[j].z * v[j].z + v[j].w * v[j].w); }
        const float rstd = 1.0f / sqrtf(wave_sum(s) * (1.f / DM) + EPS);
        u32x2* o8 = (u32x2*)((bf16_t*)(ws + WS_HN) + (size_t)m * DM) + F.lane;
#pragma unroll
        for (int j = 0; j < 4; ++j) { u32x2 w; w.x = cvt_pk_bf16(v[j].x * rstd * gv[j].x, v[j].y * rstd * gv[j].y); w.y = cvt_pk_bf16(v[j].z * rstd * gv[j].z, v[j].w * rstd * gv[j].w); o8[64 * j] = w; }
    }
    {
        const float* p = a.in[I_P];
        for (int m = gw; m < T; m += NGW) { const f32x4 v = *((const f32x4*)(p + (size_t)m * PLE) + F.lane); u32x2 w; w.x = cvt_pk_bf16(v.x, v.y); w.y = cvt_pk_bf16(v.z, v.w);
            *((u32x2*)((bf16_t*)(ws + WS_PB) + (size_t)m * PLE) + F.lane) = w; }
    }
}

struct DenseOrder {
    int nM, nN, nwg, G, c; unsigned A, B, tA, tB, aPn;
    __device__ void init(int nM_, int nN_, int G_, int c_, size_t A_, size_t lda, size_t B_, size_t ldb, unsigned aPn_ = 0) { nM = nM_; nN = nN_; nwg = nM * nN; G = G_; c = c_; A = (unsigned)A_; B = (unsigned)B_; tA = (unsigned)(256 * lda * 2); tB = (unsigned)(256 * ldb * 2); aPn = aPn_; }
    __device__ __forceinline__ bool next(int i, Unit& u) const {
        const long L = (long)i * G + c; if (L >= nwg) return false;
        int wgid = (int)L; { const int q = nwg / 8, r = nwg % 8, xcd = wgid % 8, off = wgid / 8; wgid = (xcd < r ? xcd * (q + 1) : r * (q + 1) + (xcd - r) * q) + off; }
        const int WGM = 8; const int nig = WGM * nN, gid = wgid / nig, fm = gid * WGM, gsz = (nM - fm) < WGM ? (nM - fm) : WGM;
        u.pm = fm + ((wgid % nig) % gsz); u.pn = (wgid % nig) / gsz; u.aux = 0; return true;
    }
    __device__ __forceinline__ unsigned a_off(const Unit& u) const { return A + (unsigned)u.pm * tA + (unsigned)u.pn * aPn; }
    __device__ __forceinline__ unsigned b_off(const Unit& u) const { return B + (unsigned)u.pn * tB; }
};

struct EpiBf16 {
    static constexpr bool PERM = true;
    bf16_t* O; int ldc;
    __device__ __forceinline__ void operator()(const f32x4 (&acc)[2][2][4][2], const Unit& u, int wr, int wc, int fr, int fq) const {
        const int row0 = u.pm * 256 + wr * 64 + fr, col0 = u.pn * 256 + wc * 32 + 8 * fq;
#pragma unroll
        for (int ai = 0; ai < 2; ++ai)
#pragma unroll
            for (int m = 0; m < 4; ++m) { bf16_t* rowp = O + (size_t)(row0 + ai * 128 + m * 16) * ldc + col0;
#pragma unroll
                for (int bj = 0; bj < 2; ++bj) { const f32x4 v0 = acc[ai][bj][m][0], v1 = acc[ai][bj][m][1];
                    u32x4 w; w.x = cvt_pk_bf16(v0[0], v0[1]); w.y = cvt_pk_bf16(v0[2], v0[3]); w.z = cvt_pk_bf16(v1[0], v1[1]); w.w = cvt_pk_bf16(v1[2], v1[3]);
                    *(u32x4*)(rowp + bj * 128) = w; } }
    }
};
struct EpiProj {
    static constexpr bool PERM = true;
    bf16_t* PROJ; bf16_t* GATES;
    __device__ __forceinline__ void operator()(const f32x4 (&acc)[2][2][4][2], const Unit& u, int wr, int wc, int fr, int fq) const {
        const int row0 = u.pm * 256 + wr * 64 + fr; const bool isg = u.pn >= 4;
        bf16_t* O = isg ? GATES : PROJ; const int ldc = isg ? 2048 : 1024; const int col0 = (isg ? u.pn - 4 : u.pn) * 256 + wc * 32 + 8 * fq;
#pragma unroll
        for (int ai = 0; ai < 2; ++ai)
#pragma unroll
            for (int m = 0; m < 4; ++m) { bf16_t* rowp = O + (size_t)(row0 + ai * 128 + m * 16) * ldc + col0;
#pragma unroll
                for (int bj = 0; bj < 2; ++bj) { f32x4 v0 = acc[ai][bj][m][0], v1 = acc[ai][bj][m][1];
                    if (isg) {
#pragma unroll
                        for (int e = 0; e < 4; ++e) { v0[e] = fast_sigmoid(v0[e]); v1[e] = fast_sigmoid(v1[e]); } }
                    u32x4 w; w.x = cvt_pk_bf16(v0[0], v0[1]); w.y = cvt_pk_bf16(v0[2], v0[3]); w.z = cvt_pk_bf16(v1[0], v1[1]); w.w = cvt_pk_bf16(v1[2], v1[3]);
                    *(u32x4*)(rowp + bj * 128) = w; } asm volatile("" ::: "memory"); }
    }
};

__device__ __forceinline__ void p2_rows(const Frame& F, const Args& a) {
    const int gw = F.vcu * NWAVES + F.wave, NGW = F.G * NWAVES, lane = F.lane;
    unsigned char* ws = F.ws;
    const bf16_t* PROJ = (const bf16_t*)(ws + WS_PROJ);
    bf16_t* A2 = (bf16_t*)(ws + WS_A2); bf16_t* POOLED = (bf16_t*)(ws + WS_POOLED); bf16_t* Kb = (bf16_t*)(ws + WS_K);
    float* COS = (float*)(ws + WS_COS); float* SIN = (float*)(ws + WS_SIN);
    const int* positions = (const int*)a.in[I_POS];
    const float gkr = (lane < 32) ? a.in[I_GKROPE][lane] : 0.f;
    const float inv_freq = __builtin_amdgcn_exp2f(-(float)(lane & 15) * (13.287712379549449f / 16.0f));
    const int w = 2 << (lane >> 4);
    for (int task = gw; task < T / 8; task += NGW) {
        const int t0 = task * 8, b = t0 / SEQ, s0 = t0 % SEQ;
        {
            const bf16_t* base = PROJ + (size_t)(b * SEQ) * 1024 + 512 + 8 * lane;
            float S[8];
#pragma unroll
            for (int j = 0; j < 8; ++j) S[j] = 0.f;
            for (int r = s0 - 15; r < s0; ++r) {
                if (r >= 0 && r >= s0 - w + 1) { const u32x4 v = *(const u32x4*)(base + (size_t)r * 1024);
                    S[0] += bf_lo(v.x); S[1] += bf_hi(v.x); S[2] += bf_lo(v.y); S[3] += bf_hi(v.y); S[4] += bf_lo(v.z); S[5] += bf_hi(v.z); S[6] += bf_lo(v.w); S[7] += bf_hi(v.w); }
            }
#pragma unroll
            for (int i = 0; i < 8; ++i) {
                const int s = s0 + i;
                const u32x4 v = *(const u32x4*)(base + (size_t)s * 1024);
                float uu[8] = {bf_lo(v.x), bf_hi(v.x), bf_lo(v.y), bf_hi(v.y), bf_lo(v.z), bf_hi(v.z), bf_lo(v.w), bf_hi(v.w)};
                const int cnt = (s + 1 < w) ? s + 1 : w; const float ic = 1.0f / (float)cnt;
                float o[8];
#pragma unroll
                for (int j = 0; j < 8; ++j) { S[j] += uu[j]; o[j] = S[j] * ic - uu[j]; }
                u32x4 wv; wv.x = cvt_pk_bf16(o[0], o[1]); wv.y = cvt_pk_bf16(o[2], o[3]); wv.z = cvt_pk_bf16(o[4], o[5]); wv.w = cvt_pk_bf16(o[6], o[7]);
                *(u32x4*)(POOLED + (size_t)(t0 + i) * 512 + 8 * lane) = wv;
                const int rr = s - w + 1;
                if (rr >= 0) { const u32x4 q = *(const u32x4*)(base + (size_t)rr * 1024);
                    S[0] -= bf_lo(q.x); S[1] -= bf_hi(q.x); S[2] -= bf_lo(q.y); S[3] -= bf_hi(q.y); S[4] -= bf_lo(q.z); S[5] -= bf_hi(q.z); S[6] -= bf_lo(q.w); S[7] -= bf_hi(q.w); }
            }
        }
        for (int i = 0; i < 8; ++i) {
            const int t = t0 + i, s = s0 + i;
            const bf16_t* pr = PROJ + (size_t)t * 1024;
            const u32x2 ql = *(const u32x2*)(pr + 4 * lane);
            const unsigned kvl = *(const unsigned*)(pr + 256 + 2 * lane);
            const float krv = (lane < 32) ? bf1(pr[384 + lane]) : 0.f;
            const float q0 = bf_lo(ql.x), q1 = bf_hi(ql.x), q2 = bf_lo(ql.y), q3 = bf_hi(ql.y);
            const float k0 = bf_lo(kvl), k1 = bf_hi(kvl);
            const float sq = wave_sum((q0 * q0 + q1 * q1) + (q2 * q2 + q3 * q3));
            const float sk = wave_sum(k0 * k0 + k1 * k1);
            const float sr = wave_sum(krv * krv);
            const float rq = 1.0f / sqrtf(sq * (1.f / 256.f) + EPS), rk = 1.0f / sqrtf(sk * (1.f / 128.f) + EPS), rr = 1.0f / sqrtf(sr * (1.f / 32.f) + EPS);
            u32x2 wq; wq.x = cvt_pk_bf16(q0 * rq, q1 * rq); wq.y = cvt_pk_bf16(q2 * rq, q3 * rq);
            *(u32x2*)(A2 + (size_t)t * 512 + 4 * lane) = wq;
            *(unsigned*)(A2 + (size_t)t * 512 + 256 + 2 * lane) = cvt_pk_bf16(k0 * rk, k1 * rk);
            *(unsigned*)(A2 + (size_t)t * 512 + 384 + 2 * lane) = 0u;
            const float pos = (float)positions[t];
            const float ang = pos * inv_freq;
            const float rev = ang * 0.15915494309189535f;
            const float fr_ = rev - floorf(rev);
            const float sn = __builtin_amdgcn_sinf(fr_), cs = __builtin_amdgcn_cosf(fr_);
            const float kn = krv * rr * gkr;
            const float other = __shfl_xor(kn, 16);
            const float ro = (lane & 16) ? (kn * cs + other * sn) : (kn * cs - other * sn);
            if (lane < 32) {
                const bf16_t rb = (bf16_t)(cvt_pk_bf16(ro, 0.f) & 0xffffu);
#pragma unroll
                for (int h = 0; h < NH; ++h) Kb[((size_t)(b * NH + h) * SEQ + s) * DK + 64 + lane] = rb;
            }
            if (lane < 16) { COS[(size_t)t * 16 + lane] = cs; SIN[(size_t)t * 16 + lane] = sn; }
        }
    }
}

#define EPI_FENCE() asm volatile("" ::: "memory")
struct EpiQ {
    static constexpr bool PERM = true;
    bf16_t* Q; float* SSQ; const float* COS; const float* SIN; const float* gq;
    __device__ __forceinline__ void operator()(const f32x4 (&acc)[2][2][4][2], const Unit& u, int wr, int wc, int fr, int fq) const {
        const int t0 = u.pm * 256 + wr * 64 + fr, b = (u.pm * 256) / SEQ, s0 = t0 - b * SEQ;
        if (u.pn < 2) {
            const int h = 4 * u.pn + wc;
            bf16_t* dst0 = Q + ((size_t)(b * NH + h) * SEQ + s0) * DK + 8 * fq;
            float* ssq0 = SSQ + ((size_t)t0 * NH + h) * 2;
#pragma unroll
            for (int ai = 0; ai < 2; ++ai)
#pragma unroll
                for (int m = 0; m < 4; ++m) {
                    const int dr = ai * 128 + m * 16;
                    float q = 0.f;
#pragma unroll
                    for (int bj = 0; bj < 2; ++bj)
#pragma unroll
                        for (int n = 0; n < 2; ++n) { const f32x4 v = acc[ai][bj][m][n]; q += (v[0] * v[0] + v[1] * v[1]) + (v[2] * v[2] + v[3] * v[3]); }
                    q += __shfl_xor(q, 16); q += __shfl_xor(q, 32);
                    if (fq == 0) ssq0[dr * NH * 2] = q;
#pragma unroll
                    for (int bj = 0; bj < 2; ++bj) { const f32x4 v0 = acc[ai][bj][m][0] * *(const f32x4*)(gq + 32 * bj + 8 * fq), v1 = acc[ai][bj][m][1] * *(const f32x4*)(gq + 32 * bj + 8 * fq + 4);
                        u32x4 w; w.x = cvt_pk_bf16(v0[0], v0[1]); w.y = cvt_pk_bf16(v0[2], v0[3]); w.z = cvt_pk_bf16(v1[0], v1[1]); w.w = cvt_pk_bf16(v1[2], v1[3]);
                        *(u32x4*)(dst0 + dr * DK + 32 * bj) = w; }
                    EPI_FENCE();
                }
        } else {
            const f32x4 g1 = *(const f32x4*)(gq + 64 + 4 * fq), g2 = *(const f32x4*)(gq + 80 + 4 * fq);
            const float* cs0 = COS + (size_t)t0 * 16 + 4 * fq; const float* sn0 = SIN + (size_t)t0 * 16 + 4 * fq;
            bf16_t* dst0 = Q + ((size_t)(b * NH + 2 * wc) * SEQ + s0) * DK + 64 + 4 * fq;
            float* ssq0 = SSQ + ((size_t)t0 * NH + 2 * wc) * 2 + 1;
#pragma unroll
            for (int ai = 0; ai < 2; ++ai)
#pragma unroll
                for (int m = 0; m < 4; ++m) {
                    const int dr = ai * 128 + m * 16;
                    const f32x4 cs = *(const f32x4*)(cs0 + dr * 16), sn = *(const f32x4*)(sn0 + dr * 16);
#pragma unroll
                    for (int bj = 0; bj < 2; ++bj) {
                        const f32x4 x1 = acc[ai][bj][m][0], x2 = acc[ai][bj][m][1];
                        float q = (x1[0] * x1[0] + x1[1] * x1[1]) + (x1[2] * x1[2] + x1[3] * x1[3]) + (x2[0] * x2[0] + x2[1] * x2[1]) + (x2[2] * x2[2] + x2[3] * x2[3]);
                        q += __shfl_xor(q, 16); q += __shfl_xor(q, 32);
                        if (fq == 0) ssq0[dr * NH * 2 + bj * 2] = q;
                        const f32x4 y1 = x1 * g1, y2 = x2 * g2;
                        const f32x4 o1 = y1 * cs - y2 * sn, o2 = y2 * cs + y1 * sn;
                        bf16_t* dst = dst0 + (size_t)bj * SEQ * DK + dr * DK;
                        u32x2 w1, w2; w1.x = cvt_pk_bf16(o1[0], o1[1]); w1.y = cvt_pk_bf16(o1[2], o1[3]); w2.x = cvt_pk_bf16(o2[0], o2[1]); w2.y = cvt_pk_bf16(o2[2], o2[3]);
                        *(u32x2*)(dst) = w1; *(u32x2*)(dst + 16) = w2;
                    }
                    EPI_FENCE();
                }
        }
    }
};
struct EpiKV {
    static constexpr bool PERM = true;
    bf16_t* K; bf16_t* V; const float* gk;
    __device__ __forceinline__ void operator()(const f32x4 (&acc)[2][2][4][2], const Unit& u, int wr, int wc, int fr, int fq) const {
        const int t0 = u.pm * 256 + wr * 64 + fr, b = (u.pm * 256) / SEQ, s0 = t0 - b * SEQ;
        const int h = 2 * u.pn + (wc & 1); const bool isv = wc >= 2;
        const int pitch = isv ? DV : DK;
        bf16_t* dst0 = (isv ? V : K) + ((size_t)(b * NH + h) * SEQ + s0) * pitch + 8 * fq;
#pragma unroll
        for (int ai = 0; ai < 2; ++ai)
#pragma unroll
            for (int m = 0; m < 4; ++m) {
                const int dr = ai * 128 + m * 16;
                float sc = 1.f;
                if (!isv) { float q = 0.f;
#pragma unroll
                    for (int bj = 0; bj < 2; ++bj)
#pragma unroll
                        for (int n = 0; n < 2; ++n) { const f32x4 v = acc[ai][bj][m][n]; q += (v[0] * v[0] + v[1] * v[1]) + (v[2] * v[2] + v[3] * v[3]); }
                    q += __shfl_xor(q, 16); q += __shfl_xor(q, 32);
                    sc = 1.0f / sqrtf(q * (1.f / 64.f) + EPS); }
#pragma unroll
                for (int bj = 0; bj < 2; ++bj) {
                    f32x4 v0 = acc[ai][bj][m][0] * sc, v1 = acc[ai][bj][m][1] * sc;
                    if (!isv) { v0 = v0 * *(const f32x4*)(gk + 32 * bj + 8 * fq); v1 = v1 * *(const f32x4*)(gk + 32 * bj + 8 * fq + 4); }
                    u32x4 w; w.x = cvt_pk_bf16(v0[0], v0[1]); w.y = cvt_pk_bf16(v0[2], v0[3]); w.z = cvt_pk_bf16(v1[0], v1[1]); w.w = cvt_pk_bf16(v1[2], v1[3]);
                    *(u32x4*)(dst0 + dr * pitch + 32 * bj) = w; }
                EPI_FENCE();
            }
    }
};

namespace att {
constexpr int KROW = 208;
constexpr int KT_BYTES = 64 * KROW, VT_BYTES = 64 * 128, BUF_BYTES = KT_BYTES + VT_BYTES;
constexpr int SCR_OFF = 2 * BUF_BYTES;
__device__ __forceinline__ int crow(int r, int hi) { return (r & 3) + 8 * (r >> 2) + 4 * hi; }
__device__ __forceinline__ s16x4 vtr(const LAS unsigned char* p) { typedef short v4i16_t __attribute__((ext_vector_type(4)));
    return __builtin_bit_cast(s16x4, __builtin_amdgcn_ds_read_tr16_b64_v4i16((LAS v4i16_t*)p)); }

__device__ __forceinline__ void attn_unit(LAS unsigned char* lds, int bh, int qb, const bf16_t* Q, const bf16_t* K, const bf16_t* V, const float* SSQ, bf16_t* O) {
    const int tid = threadIdx.x, lane = tid & 63, r32 = lane & 31, hi = lane >> 5; const int wid = __builtin_amdgcn_readfirstlane(tid >> 6);
    const int b = bh / NH, h = bh % NH, q0 = qb * 256, qw = q0 + 32 * wid;
    const bf16_t* Kh = K + (size_t)bh * SEQ * DK; const bf16_t* Vh = V + (size_t)bh * SEQ * DV;
    LAS float* scr = (LAS float*)(lds + SCR_OFF) + wid * 64;
    bf16x8 qr[6];
    { const bf16_t* qp = Q + ((size_t)bh * SEQ + qw + r32) * DK + 8 * hi;
#pragma unroll
      for (int d0 = 0; d0 < 6; ++d0) qr[d0] = *(const bf16x8*)(qp + 16 * d0); }
    float cq;
    { const float* sp = SSQ + ((size_t)(b * SEQ + qw + r32) * NH + h) * 2; const float ss = sp[0] + sp[1];
      cq = (1.0f / sqrtf(ss * (1.f / 96.f) + EPS)) * 0.10206207261596577f * 1.4426950408889634f; }
    const int NT = (q0 + 256) / 64;
    const int kc0 = tid, kc1 = 512 + tid;
    const int kd0 = (kc0 / 12) * KROW + (kc0 % 12) * 16, kd1 = (kc1 / 12) * KROW + (kc1 % 12) * 16;
    const int vrow = tid >> 3, vd = KT_BYTES + vrow * 128 + (((tid & 7) * 16) ^ (((vrow >> 1) & 1) * 64));
    u32x4 sk0, sk1, sv;
#define ATT_LOAD(j) do { const u32x4* kg = (const u32x4*)(Kh + (size_t)(j) * 64 * DK); sk0 = kg[kc0]; if (tid < 256) sk1 = kg[kc1]; sv = ((const u32x4*)(Vh + (size_t)(j) * 64 * DV))[tid]; } while (0)
#define ATT_WRITE(buf) do { LAS unsigned char* bp = lds + (buf) * BUF_BYTES; *(LAS u32x4*)(bp + kd0) = sk0; if (tid < 256) *(LAS u32x4*)(bp + kd1) = sk1; *(LAS u32x4*)(bp + vd) = sv; } while (0)
    ATT_LOAD(0); ATT_WRITE(0);
    __syncthreads();
    const int kbase = r32 * KROW + hi * 16;
    const int qq = (lane & 15) >> 2, pp = lane & 3, dblk = (lane >> 4) & 1, swz = ((qq >> 1) & 1) * 64;
    const int vrow0 = 4 * hi + qq;
    const int vb0 = KT_BYTES + vrow0 * 128 + ((32 * dblk + 8 * pp) ^ swz);
    const int vb1 = KT_BYTES + vrow0 * 128 + ((64 + 32 * dblk + 8 * pp) ^ swz);
    f32x16 o0 = {}, o1 = {};
    float m_run = -1e30f, l_run = 0.f;
    for (int j = 0; j < NT; ++j) {
        const int buf = j & 1;
        if (j + 1 < NT) ATT_LOAD(j + 1);
        const int kb = 64 * j;
        if (kb <= qw + 31) {
            const LAS unsigned char* kp = lds + buf * BUF_BYTES + kbase;
            f32x16 p0 = {}, p1 = {};
#pragma unroll
            for (int d0 = 0; d0 < 6; ++d0) {
                const bf16x8 ka = *(const LAS bf16x8*)(kp + d0 * 32), kb2 = *(const LAS bf16x8*)(kp + 32 * KROW + d0 * 32);
                p0 = __builtin_amdgcn_mfma_f32_32x32x16_bf16(ka, qr[d0], p0, 0, 0, 0);
                p1 = __builtin_amdgcn_mfma_f32_32x32x16_bf16(kb2, qr[d0], p1, 0, 0, 0);
            }
#pragma unroll
            for (int r = 0; r < 16; ++r) { p0[r] *= cq; p1[r] *= cq; }
            if (kb + 63 > qw) {
                const int qa = qw + r32;
#pragma unroll
                for (int r = 0; r < 16; ++r) { const int ka_ = kb + crow(r, hi); if (ka_ > qa) p0[r] = -__builtin_inff(); if (ka_ + 32 > qa) p1[r] = -__builtin_inff(); }
            }
            float pm = p0[0];
#pragma unroll
            for (int r = 1; r < 16; ++r) pm = fmaxf(pm, p0[r]);
#pragma unroll
            for (int r = 0; r < 16; ++r) pm = fmaxf(pm, p1[r]);
            { auto rr = __builtin_amdgcn_permlane32_swap(__float_as_uint(pm), __float_as_uint(pm), false, false); pm = fmaxf(__uint_as_float(rr[0]), __uint_as_float(rr[1])); }
            if (__any(pm > m_run + 8.0f)) {
                const float mn = fmaxf(m_run, pm); const float al = __builtin_amdgcn_exp2f(m_run - mn); m_run = mn; l_run *= al;
                if (hi == 0) scr[r32] = al;
                asm volatile("s_waitcnt lgkmcnt(0)" ::: "memory");
#pragma unroll
                for (int a4 = 0; a4 < 4; ++a4) { const f32x4 f = *(const LAS f32x4*)(scr + 8 * a4 + 4 * hi);
#pragma unroll
                    for (int e = 0; e < 4; ++e) { o0[4 * a4 + e] *= f[e]; o1[4 * a4 + e] *= f[e]; } }
            }
            float ps = 0.f;
#pragma unroll
            for (int r = 0; r < 16; ++r) { p0[r] = __builtin_amdgcn_exp2f(p0[r] - m_run); p1[r] = __builtin_amdgcn_exp2f(p1[r] - m_run); ps += p0[r] + p1[r]; }
            l_run += ps;
            bf16x8 pa[4];
#pragma unroll
            for (int ks = 0; ks < 4; ++ks) { const f32x16& P = (ks < 2) ? p0 : p1; const int bs = 8 * (ks & 1);
                u32x4 w; w.x = cvt_pk_bf16(P[bs + 0], P[bs + 1]); w.y = cvt_pk_bf16(P[bs + 2], P[bs + 3]); w.z = cvt_pk_bf16(P[bs + 4], P[bs + 5]); w.w = cvt_pk_bf16(P[bs + 6], P[bs + 7]);
                pa[ks] = __builtin_bit_cast(bf16x8, w); }
            const LAS unsigned char* vp0 = lds + buf * BUF_BYTES + vb0; const LAS unsigned char* vp1 = lds + buf * BUF_BYTES + vb1;
#pragma unroll
            for (int ks = 0; ks < 4; ++ks) {
                const s16x4 a0 = vtr(vp0 + ks * 16 * 128), a1 = vtr(vp0 + ks * 16 * 128 + 8 * 128);
                const s16x4 c0 = vtr(vp1 + ks * 16 * 128), c1 = vtr(vp1 + ks * 16 * 128 + 8 * 128);
                const bf16x8 vf0 = {a0[0], a0[1], a0[2], a0[3], a1[0], a1[1], a1[2], a1[3]};
                const bf16x8 vf1 = {c0[0], c0[1], c0[2], c0[3], c1[0], c1[1], c1[2], c1[3]};
                o0 = __builtin_amdgcn_mfma_f32_32x32x16_bf16(pa[ks], vf0, o0, 0, 0, 0);
                o1 = __builtin_amdgcn_mfma_f32_32x32x16_bf16(pa[ks], vf1, o1, 0, 0, 0);
            }
        }
        if (j + 1 < NT) ATT_WRITE(buf ^ 1);
        __syncthreads();
    }
#undef ATT_LOAD
#undef ATT_WRITE
    { auto rr = __builtin_amdgcn_permlane32_swap(__float_as_uint(l_run), __float_as_uint(l_run), false, false); l_run = __uint_as_float(rr[0]) + __uint_as_float(rr[1]); }
    if (hi == 0) scr[32 + r32] = 1.0f / l_run;
    asm volatile("s_waitcnt lgkmcnt(0)" ::: "memory");
    bf16_t* Ow = O + ((size_t)(b * SEQ + qw)) * 512 + h * 64 + r32;
#pragma unroll
    for (int a4 = 0; a4 < 4; ++a4) { const f32x4 f = *(const LAS f32x4*)(scr + 32 + 8 * a4 + 4 * hi);
#pragma unroll
        for (int e = 0; e < 4; ++e) { const int r = 4 * a4 + e; const int row = crow(r, hi);
            Ow[(size_t)row * 512] = (bf16_t)(cvt_pk_bf16(o0[r] * f[e], 0.f) & 0xffffu);
            Ow[(size_t)row * 512 + 32] = (bf16_t)(cvt_pk_bf16(o1[r] * f[e], 0.f) & 0xffffu); } }
    __syncthreads();
}
}

struct MixOrder {
    int G, c; unsigned ATT, MIXED, WAO, WPO;
    __device__ __forceinline__ bool next(int i, Unit& u) const {
        const int tile = (i >> 1) * G + c; if (tile >= 256) return false;
        u.pm = tile >> 2; u.pn = tile & 3; u.aux = i & 1; return true;
    }
    __device__ __forceinline__ unsigned a_off(const Unit& u) const { return (u.aux ? MIXED : ATT) + (unsigned)u.pm * (256 * 512 * 2); }
    __device__ __forceinline__ unsigned b_off(const Unit& u) const { return (u.aux ? WPO : WAO) + (unsigned)u.pn * (256 * 512 * 2); }
};
struct EpiMix {
    static constexpr bool PERM = true;
    bf16_t* MIX; const bf16_t* GATES;
    __device__ __forceinline__ void operator()(const f32x4 (&acc)[2][2][4][2], const Unit& u, int wr, int wc, int fr, int fq) const {
        const int row0 = u.pm * 256 + wr * 64 + fr, col0 = u.pn * 256 + wc * 32 + 8 * fq;
#pragma unroll
        for (int ai = 0; ai < 2; ++ai)
#pragma unroll
            for (int m = 0; m < 4; ++m) { const size_t row = (size_t)(row0 + ai * 128 + m * 16);
#pragma unroll
                for (int bj = 0; bj < 2; ++bj) {
                    const u32x4 gw = *(const u32x4*)(GATES + row * 2048 + u.aux * 1024 + col0 + bj * 128);
                    const f32x4 v0 = acc[ai][bj][m][0], v1 = acc[ai][bj][m][1];
                    float r[8] = {v0[0] * bf_lo(gw.x), v0[1] * bf_hi(gw.x), v0[2] * bf_lo(gw.y), v0[3] * bf_hi(gw.y), v1[0] * bf_lo(gw.z), v1[1] * bf_hi(gw.z), v1[2] * bf_lo(gw.w), v1[3] * bf_hi(gw.w)};
                    bf16_t* dst = MIX + row * 1024 + col0 + bj * 128;
                    if (u.aux) { const u32x4 pw = *(const u32x4*)dst;
                        r[0] += bf_lo(pw.x); r[1] += bf_hi(pw.x); r[2] += bf_lo(pw.y); r[3] += bf_hi(pw.y); r[4] += bf_lo(pw.z); r[5] += bf_hi(pw.z); r[6] += bf_lo(pw.w); r[7] += bf_hi(pw.w); }
                    u32x4 w; w.x = cvt_pk_bf16(r[0], r[1]); w.y = cvt_pk_bf16(r[2], r[3]); w.z = cvt_pk_bf16(r[4], r[5]); w.w = cvt_pk_bf16(r[6], r[7]);
                    *(u32x4*)dst = w; } }
    }
};
struct EpiRes {
    static constexpr bool PERM = false;
    const float* base; float* out;
    __device__ __forceinline__ void operator()(const f32x4 (&acc)[2][2][4][2], const Unit& u, int wr, int wc, int fr, int fq) const {
        const int row0 = u.pm * 256 + wr * 64 + fr, col0 = u.pn * 256 + wc * 32 + 4 * fq;
#pragma unroll
        for (int ai = 0; ai < 2; ++ai)
#pragma unroll
            for (int m = 0; m < 4; ++m) { const size_t off = (size_t)(row0 + ai * 128 + m * 16) * DM + col0;
#pragma unroll
                for (int bj = 0; bj < 2; ++bj)
#pragma unroll
                    for (int n = 0; n < 2; ++n) *(f32x4*)(out + off + bj * 128 + n * 16) = *(const f32x4*)(base + off + bj * 128 + n * 16) + acc[ai][bj][m][n]; }
    }
};

constexpr int WR_PITCH = 1028;
constexpr int R_WR_OFF = 0, R_PART_OFF = 32 * WR_PITCH * 4, R_SSQ_OFF = R_PART_OFF + 2 * 64 * 33 * 4, R_CNT_OFF = R_SSQ_OFF + 2 * 64 * 4, R_BASE_OFF = R_CNT_OFF + 128, R_END = R_BASE_OFF + 128;
static_assert(R_END <= TILE_E_OFF, "router LDS map");
__device__ __forceinline__ void p7_router(const Frame& F, const Args& a) {
    LAS float* WR = (LAS float*)(F.lds + R_WR_OFF); LAS float* PART = (LAS float*)(F.lds + R_PART_OFF); LAS float* SSQP = (LAS float*)(F.lds + R_SSQ_OFF);
    LAS int* CNT = (LAS int*)(F.lds + R_CNT_OFF); LAS int* BASE = (LAS int*)(F.lds + R_BASE_OFF);
    const int tid = F.tid, lane = F.lane, wave = F.wave;
    const float* wr = a.in[I_WR]; const float* gf = a.in[I_GFFN];
    for (int i = tid; i < 1024 * 32; i += 512) { const int k = i >> 5, e = i & 31; WR[e * WR_PITCH + k] = wr[i] * gf[k]; }
    if (tid < 32) CNT[tid] = 0;
    __syncthreads();
    int* RE = (int*)(F.ws + WS_ROUTE); int* RP = RE + T * 4; float* RG = (float*)(RP + T * 4); float* RS = RG + T * 4;
    unsigned* gcnt = F.ctl + CW_CNT;
    const float* X1 = F.out;
    for (int blk = F.vcu; blk < T / 64; blk += F.G) {
        const int tb = blk * 64;
        {
            const int tg = wave & 3, kh = wave >> 2, r = lane & 15, kq = lane >> 4;
            const float* xp = X1 + (size_t)(tb + 16 * tg + r) * DM + 512 * kh + 4 * kq;
            const LAS float* w0 = WR + (lane & 15) * WR_PITCH + 512 * kh + 4 * kq; const LAS float* w1 = w0 + 16 * WR_PITCH;
            f32x4 acc0 = {0.f, 0.f, 0.f, 0.f}, acc1 = {0.f, 0.f, 0.f, 0.f}; float ss = 0.f;
#pragma unroll 4
            for (int i = 0; i < 32; ++i) {
                const f32x4 xv = *(const f32x4*)(xp + 16 * i);
                const f32x4 b0 = *(const LAS f32x4*)(w0 + 16 * i), b1 = *(const LAS f32x4*)(w1 + 16 * i);
                ss += (xv[0] * xv[0] + xv[1] * xv[1]) + (xv[2] * xv[2] + xv[3] * xv[3]);
#pragma unroll
                for (int j = 0; j < 4; ++j) { acc0 = __builtin_amdgcn_mfma_f32_16x16x4f32(xv[j], b0[j], acc0, 0, 0, 0); acc1 = __builtin_amdgcn_mfma_f32_16x16x4f32(xv[j], b1[j], acc1, 0, 0, 0); }
            }
            ss += __shfl_xor(ss, 16); ss += __shfl_xor(ss, 32);
            if (kq == 0) SSQP[kh * 64 + 16 * tg + r] = ss;
#pragma unroll
            for (int q = 0; q < 4; ++q) { const int tok = 16 * tg + 4 * kq + q; PART[(kh * 64 + tok) * 33 + (lane & 15)] = acc0[q]; PART[(kh * 64 + tok) * 33 + 16 + (lane & 15)] = acc1[q]; }
        }
        __syncthreads();
        int te[4] = {0, 0, 0, 0}, lp[4] = {0, 0, 0, 0}; float tv[4] = {-3e38f, -3e38f, -3e38f, -3e38f}; float rstd = 0.f;
        if (tid < 64) {
            const float ssq = SSQP[tid] + SSQP[64 + tid]; rstd = 1.0f / sqrtf(ssq * (1.f / DM) + EPS);
            const float* br = a.in[I_BR];
#pragma unroll
            for (int e = 0; e < 32; ++e) {
                float v = (PART[tid * 33 + e] + PART[(64 + tid) * 33 + e]) * rstd + br[e]; int id = e;
#pragma unroll
                for (int s = 0; s < 4; ++s) { const bool gt = v > tv[s]; const float ov = tv[s]; const int oi = te[s]; tv[s] = gt ? v : ov; te[s] = gt ? id : oi; v = gt ? ov : v; id = gt ? oi : id; }
            }
#pragma unroll
            for (int s = 0; s < 4; ++s) lp[s] = __hip_atomic_fetch_add(&CNT[te[s]], 1, __ATOMIC_RELAXED, __HIP_MEMORY_SCOPE_WORKGROUP);
        }
        __syncthreads();
        if (tid < 32) { const int c = CNT[tid]; BASE[tid] = c ? (int)atomicAdd(gcnt + tid, (unsigned)c) : 0; }
        __syncthreads();
        if (tid < 64) {
            const int t = tb + tid;
            const float e1 = __expf(tv[1] - tv[0]), e2 = __expf(tv[2] - tv[0]), e3 = __expf(tv[3] - tv[0]); const float inv = 1.0f / (1.0f + e1 + e2 + e3);
            const float gts[4] = {inv, e1 * inv, e2 * inv, e3 * inv};
#pragma unroll
            for (int s = 0; s < 4; ++s) { RE[t * 4 + s] = te[s]; RP[t * 4 + s] = BASE[te[s]] + lp[s]; RG[t * 4 + s] = gts[s]; }
            RS[t] = rstd;
        }
        __syncthreads();
        if (tid < 32) CNT[tid] = 0;
        __syncthreads();
    }
}

__device__ __forceinline__ int build_tiles(const Frame& F) {
    LAS int* TB = (LAS int*)(F.lds + TILE_E_OFF); LAS int* TE = TB + 64;
    if (F.tid == 0) { int acc = 0; for (int e = 0; e < NEXP; ++e) { TB[e] = acc; const int c = (int)__hip_atomic_load(F.ctl + CW_CNT + e, RLX_AGENT); acc += (c + 255) >> 8; } TB[NEXP] = acc; }
    __syncthreads();
    if (F.tid < NEXP) { for (int t = TB[F.tid]; t < TB[F.tid + 1]; ++t) TE[t] = F.tid; }
    __syncthreads();
    return TB[NEXP];
}

__device__ __forceinline__ void p8_dispatch(const Frame& F, const Args& a) {
    (void)build_tiles(F);
    const LAS int* TB = (const LAS int*)(F.lds + TILE_E_OFF);
    const int gw = F.vcu * NWAVES + F.wave, NGW = F.G * NWAVES, lane = F.lane;
    const int* RE = (const int*)(F.ws + WS_ROUTE); const int* RP = RE + T * 4; const float* RS = (const float*)(RP + T * 4) + T * 4; int* SL = (int*)(RS + T);
    const float* X1 = F.out; const float* gf = a.in[I_GFFN]; unsigned char* XS = F.ws + WS_XS2;
    f32x4 g[2][2];
#pragma unroll
    for (int j = 0; j < 2; ++j) { g[j][0] = *(const f32x4*)(gf + 512 * j + 8 * lane); g[j][1] = *(const f32x4*)(gf + 512 * j + 8 * lane + 4); }
    for (int t = gw; t < T; t += NGW) {
        const float rstd = RS[t];
        u32x2 w[2];
#pragma unroll
        for (int j = 0; j < 2; ++j) { const f32x4 v0 = *(const f32x4*)(X1 + (size_t)t * DM + 512 * j + 8 * lane) * g[j][0] * rstd, v1 = *(const f32x4*)(X1 + (size_t)t * DM + 512 * j + 8 * lane + 4) * g[j][1] * rstd;
            w[j] = cvt8_fp8(v0, v1, 4.0f); }
#pragma unroll
        for (int s = 0; s < 4; ++s) { const int e = RE[t * 4 + s], slot = TB[e] * 256 + RP[t * 4 + s];
            if (lane == 0) SL[t * 4 + s] = slot;
            unsigned char* dst = XS + (size_t)slot * DM + 8 * lane;
            *(u32x2*)dst = w[0]; *(u32x2*)(dst + 512) = w[1]; }
    }
}

struct MoeOrder {
    int G, c, ntn_shift, total; const LAS int* TE; unsigned A, Bw, bexp, btile;
    __device__ __forceinline__ bool next(int i, Unit& u) const {
        const int L = i * G + c; if (L >= total) return false;
        u.pm = L >> ntn_shift; u.pn = L & ((1 << ntn_shift) - 1); u.aux = __builtin_amdgcn_readfirstlane(TE[u.pm]); return true;
    }
    __device__ __forceinline__ unsigned a_off(const Unit& u) const { return A + (unsigned)u.pm * (256 * 1024); }
    __device__ __forceinline__ unsigned b_off(const Unit& u) const { return Bw + (unsigned)u.aux * bexp + (unsigned)u.pn * btile; }
};
struct EpiSwiglu {
    static constexpr bool PERM = true;
    unsigned char* ACT; const float* bgu;
    __device__ __forceinline__ void operator()(const f32x4 (&acc)[2][2][4][2], const Unit& u, int wr, int wc, int fr, int fq) const {
        const int row0 = u.pm * 256 + wr * 64 + fr, j0 = u.pn * 128 + wc * 32 + 8 * fq;
        const float* bb = bgu + (size_t)u.aux * 2048 + j0;
#pragma unroll
        for (int ai = 0; ai < 2; ++ai)
#pragma unroll
            for (int m = 0; m < 4; ++m) {
                asm volatile("" : "+v"(bb));
                const f32x4 bg0 = *(const f32x4*)(bb), bg1 = *(const f32x4*)(bb + 4), bu0 = *(const f32x4*)(bb + 1024), bu1 = *(const f32x4*)(bb + 1028);
                const f32x4 g0 = acc[ai][0][m][0] + bg0, g1 = acc[ai][0][m][1] + bg1, u0 = acc[ai][1][m][0] + bu0, u1 = acc[ai][1][m][1] + bu1;
                float r[8];
#pragma unroll
                for (int e = 0; e < 4; ++e) {
                    { const float gg = fminf(g0[e], 7.0f), uu = fminf(fmaxf(u0[e], -7.0f), 7.0f); r[e] = (uu + 1.0f) * gg * fast_sigmoid(1.702f * gg); }
                    { const float gg = fminf(g1[e], 7.0f), uu = fminf(fmaxf(u1[e], -7.0f), 7.0f); r[4 + e] = (uu + 1.0f) * gg * fast_sigmoid(1.702f * gg); }
                }
                *(u32x2*)(ACT + (size_t)(row0 + ai * 128 + m * 16) * DEXP + j0) = cvt8_fp8((f32x4){r[0], r[1], r[2], r[3]}, (f32x4){r[4], r[5], r[6], r[7]}, 4.0f);
                asm volatile("" ::: "memory");
            }
    }
};
struct EpiDown {
    static constexpr bool PERM = true;
    bf16_t* Y; const float* bd;
    __device__ __forceinline__ void operator()(const f32x4 (&acc)[2][2][4][2], const Unit& u, int wr, int wc, int fr, int fq) const {
        const int row0 = u.pm * 256 + wr * 64 + fr, col0 = u.pn * 256 + wc * 32 + 8 * fq;
        const float* bb = bd + (size_t)u.aux * DM + col0;
#pragma unroll
        for (int ai = 0; ai < 2; ++ai)
#pragma unroll
            for (int m = 0; m < 4; ++m) { bf16_t* rowp = Y + (size_t)(row0 + ai * 128 + m * 16) * DM + col0;
                asm volatile("" : "+v"(bb));
#pragma unroll
                for (int bj = 0; bj < 2; ++bj) { const f32x4 v0 = acc[ai][bj][m][0] + *(const f32x4*)(bb + bj * 128), v1 = acc[ai][bj][m][1] + *(const f32x4*)(bb + bj * 128 + 4);
                    u32x4 w; w.x = cvt_pk_bf16(v0[0], v0[1]); w.y = cvt_pk_bf16(v0[2], v0[3]); w.z = cvt_pk_bf16(v1[0], v1[1]); w.w = cvt_pk_bf16(v1[2], v1[3]);
                    *(u32x4*)(rowp + bj * 128) = w; } asm volatile("" ::: "memory"); }
    }
};

__device__ __forceinline__ void p11_combine(const Frame& F, const Args& a) {
    const int gw = F.vcu * NWAVES + F.wave, NGW = F.G * NWAVES, lane = F.lane;
    const int* RE = (const int*)(F.ws + WS_ROUTE); const float* RG = (const float*)(RE + T * 8); const int* SL = (const int*)(RG + T * 4 + T);
    const bf16_t* Y = (const bf16_t*)(F.ws + WS_XS); bf16_t* HP = (bf16_t*)(F.ws + WS_HN); float* X = F.out; const float* gp = a.in[I_GPLE];
    f32x4 g[2][2];
#pragma unroll
    for (int j = 0; j < 2; ++j) { g[j][0] = *(const f32x4*)(gp + 512 * j + 8 * lane); g[j][1] = *(const f32x4*)(gp + 512 * j + 8 * lane + 4); }
    for (int t = gw; t < T; t += NGW) {
        f32x4 v[2][2];
#pragma unroll
        for (int j = 0; j < 2; ++j) { v[j][0] = *(const f32x4*)(X + (size_t)t * DM + 512 * j + 8 * lane); v[j][1] = *(const f32x4*)(X + (size_t)t * DM + 512 * j + 8 * lane + 4); }
#pragma unroll
        for (int s = 0; s < 4; ++s) { const int slot = SL[t * 4 + s]; const float gt = RG[t * 4 + s];
#pragma unroll
            for (int j = 0; j < 2; ++j) { const u32x4 y = *(const u32x4*)(Y + (size_t)slot * DM + 512 * j + 8 * lane);
                v[j][0] += (f32x4){bf_lo(y.x), bf_hi(y.x), bf_lo(y.y), bf_hi(y.y)} * gt; v[j][1] += (f32x4){bf_lo(y.z), bf_hi(y.z), bf_lo(y.w), bf_hi(y.w)} * gt; } }
        float ss = 0.f;
#pragma unroll
        for (int j = 0; j < 2; ++j)
#pragma unroll
            for (int n = 0; n < 2; ++n) { const f32x4 q = v[j][n]; ss += (q[0] * q[0] + q[1] * q[1]) + (q[2] * q[2] + q[3] * q[3]); *(f32x4*)(X + (size_t)t * DM + 512 * j + 8 * lane + 4 * n) = q; }
        const float rstd = 1.0f / sqrtf(wave_sum(ss) * (1.f / DM) + EPS);
#pragma unroll
        for (int j = 0; j < 2; ++j) { const f32x4 q0 = v[j][0] * g[j][0] * rstd, q1 = v[j][1] * g[j][1] * rstd;
            u32x4 w; w.x = cvt_pk_bf16(q0[0], q0[1]); w.y = cvt_pk_bf16(q0[2], q0[3]); w.z = cvt_pk_bf16(q1[0], q1[1]); w.w = cvt_pk_bf16(q1[2], q1[3]);
            *(u32x4*)(HP + (size_t)t * DM + 512 * j + 8 * lane) = w; }
    }
}
struct EpiPle {
    static constexpr bool PERM = false;
    float* out; const bf16_t* E;
    __device__ __forceinline__ void operator()(const f32x4 (&acc)[2][2][4][2], const Unit& u, int wr, int wc, int fr, int fq) const {
        const int row0 = u.pm * 256 + wr * 64 + fr, col0 = u.pn * 256 + wc * 32 + 4 * fq;
#pragma unroll
        for (int ai = 0; ai < 2; ++ai)
#pragma unroll
            for (int m = 0; m < 4; ++m) { const size_t off = (size_t)(row0 + ai * 128 + m * 16) * DM + col0;
#pragma unroll
                for (int bj = 0; bj < 2; ++bj)
#pragma unroll
                    for (int n = 0; n < 2; ++n) { const size_t o = off + bj * 128 + n * 16; const u32x2 ev = *(const u32x2*)(E + o); const f32x4 a4 = acc[ai][bj][m][n];
                        f32x4 r = *(const f32x4*)(out + o);
                        r[0] += fast_sigmoid(a4[0]) * bf_lo(ev.x); r[1] += fast_sigmoid(a4[1]) * bf_hi(ev.x); r[2] += fast_sigmoid(a4[2]) * bf_lo(ev.y); r[3] += fast_sigmoid(a4[3]) * bf_hi(ev.y);
                        *(f32x4*)(out + o) = r; } }
    }
};

constexpr int N_PHASES = 13;
__global__ void __launch_bounds__(NWAVES * 64, 2) fwd_kernel(Args args) {
    extern __shared__ __attribute__((aligned(16))) unsigned char lds_raw[];
    Frame F;
    F.lds = (LAS unsigned char*)lds_raw; F.MISC = (volatile LAS unsigned*)(F.lds + MISC_OFF);
    F.tid = threadIdx.x; F.lane = F.tid & 63; F.wave = __builtin_amdgcn_readfirstlane(F.tid >> 6);
    F.G = gridDim.x; { const int bx = blockIdx.x; F.vcu = (F.G % 8 == 0) ? (bx % 8) * (F.G / 8) + bx / 8 : bx; }
    F.out = args.out; F.ws = args.ws; F.ctl = (unsigned*)(args.ws + WS_CTL);
    if (F.tid < 32) F.MISC[F.tid] = 0u;
    __syncthreads();
    const int lo = args.ph_lo, hi = args.ph_hi;
    const bool multi = (hi - lo) > 1;
    XcdBarrier bar; bar.bar = F.ctl + CW_BAR; bar.x = 0; bar.st = nullptr;
    if (multi) bar = xcd_barrier_post(F.ctl + CW_BAR, F.MISC);
#ifndef PH_MASK
#define PH_MASK 0x1fff
#endif
#define IN(k) ((((PH_MASK) >> (k)) & 1) && lo <= (k) && (k) < hi)
#define SEAM(k) do { if (IN(k) && IN((k) + 1)) xcd_barrier(bar); } while (0)
    unsigned char* ws = args.ws;
    LAS unsigned char* ring = F.lds;
    const __amdgpu_buffer_rsrc_t rsrc = __builtin_amdgcn_make_buffer_rsrc((void*)ws, 0, (int)WS_END, 0x00020000);

    if (IN(0)) { p0_prologue(F, args); } SEAM(0);

    if (IN(1)) {
        { DenseOrder S; S.init(64, 12, F.G, (int)blockIdx.x, WS_HN, 1024, WS_WIN, 1024);
          EpiProj E{(bf16_t*)(ws + WS_PROJ), (bf16_t*)(ws + WS_GATES)};
          pg8::gemm_phase<EpiProj, DenseOrder, true, true>(ring, rsrc, pg8::Shape{2048, 2048, 2048, 0, 0}, S, E); }
        { DenseOrder S; S.init(64, 4, F.G, (int)blockIdx.x, WS_PB, 256, WS_WPLE, 256);
          EpiBf16 E{(bf16_t*)(ws + WS_E), 1024};
          pg8::gemm_phase<EpiBf16, DenseOrder, true, true>(ring, rsrc, pg8::Shape{512, 512, 512, 0, 0}, S, E); }
    } SEAM(1);

    if (IN(2)) { p2_rows(F, args); } SEAM(2);

    if (IN(3)) {
#ifndef P3M
#define P3M 7
#endif
        if (P3M & 1) { DenseOrder S; S.init(64, 4, F.G, (int)blockIdx.x, WS_A2 + 512, 512, WS_WKV, 256);
          EpiKV E{(bf16_t*)(ws + WS_K), (bf16_t*)(ws + WS_V), args.in[I_GKNOPE]};
          pg8::gemm_phase<EpiKV, DenseOrder, true, true>(ring, rsrc, pg8::Shape{512, 1024, 512, 0, 0}, S, E); }
        if (P3M & 2) { DenseOrder S; S.init(64, 3, F.G, (int)blockIdx.x, WS_A2, 512, WS_WQ, 256);
          EpiQ E{(bf16_t*)(ws + WS_Q), (float*)(ws + WS_SSQ), (const float*)(ws + WS_COS), (const float*)(ws + WS_SIN), args.in[I_GQHEAD]};
          pg8::gemm_phase<EpiQ, DenseOrder, true, true>(ring, rsrc, pg8::Shape{512, 1024, 512, 0, 0}, S, E); }
        if (P3M & 4) { DenseOrder S; S.init(64, 2, F.G, (int)blockIdx.x, WS_POOLED, 512, WS_WPOOL, 256, 512);
          EpiBf16 E{(bf16_t*)(ws + WS_MIXED), 512};
          pg8::gemm_phase<EpiBf16, DenseOrder, true, true>(ring, rsrc, pg8::Shape{512, 1024, 512, 0, 0}, S, E); }
    } SEAM(3);

    if (IN(4)) {
        for (int it = F.vcu; it < 256; it += F.G) {
            const int bh = it >> 3, pr = it & 7;
            att::attn_unit(ring, bh, 15 - pr, (const bf16_t*)(ws + WS_Q), (const bf16_t*)(ws + WS_K), (const bf16_t*)(ws + WS_V), (const float*)(ws + WS_SSQ), (bf16_t*)(ws + WS_ATT));
            att::attn_unit(ring, bh, pr, (const bf16_t*)(ws + WS_Q), (const bf16_t*)(ws + WS_K), (const bf16_t*)(ws + WS_V), (const float*)(ws + WS_SSQ), (bf16_t*)(ws + WS_ATT));
        }
    } SEAM(4);

    if (IN(5)) {
        MixOrder S{F.G, (int)blockIdx.x, (unsigned)WS_ATT, (unsigned)WS_MIXED, (unsigned)WS_WAO, (unsigned)WS_WPO};
        EpiMix E{(bf16_t*)(ws + WS_MIX), (const bf16_t*)(ws + WS_GATES)};
        pg8::gemm_phase<EpiMix, MixOrder, true, true>(ring, rsrc, pg8::Shape{1024, 1024, 1024, 0, 0}, S, E);
    } SEAM(5);

    if (IN(6)) {
        DenseOrder S; S.init(64, 4, F.G, (int)blockIdx.x, WS_MIX, 1024, WS_WO, 1024);
        EpiRes E{args.in[I_X], args.out};
        pg8::gemm_phase<EpiRes, DenseOrder, true, true>(ring, rsrc, pg8::Shape{2048, 2048, 2048, 0, 0}, S, E);
    } SEAM(6);

    if (IN(7)) { p7_router(F, args); } SEAM(7);

    if (IN(8)) { p8_dispatch(F, args); } SEAM(8);

    if (IN(9)) {
        const int TM = build_tiles(F);
        MoeOrder S{F.G, (int)blockIdx.x, 3, TM * 8, (const LAS int*)(F.lds + TILE_E_OFF) + 64, (unsigned)WS_XS2, (unsigned)WS_WGU, 2048u * 1024u, 256u * 1024u};
        EpiSwiglu E{ws + WS_ACT, args.in[I_BGU]};
        pg8::gemm_phase<EpiSwiglu, MoeOrder, true, true, true>(ring, rsrc, pg8::Shape{1024, 1024, 1024, 0x7a7a7a7a, 0x7d7d7d7d}, S, E);
    } SEAM(9);

    if (IN(10)) {
        const int TM = build_tiles(F);
        MoeOrder S{F.G, (int)blockIdx.x, 2, TM * 4, (const LAS int*)(F.lds + TILE_E_OFF) + 64, (unsigned)WS_ACT, (unsigned)WS_WD, 1024u * 1024u, 256u * 1024u};
        EpiDown E{(bf16_t*)(ws + WS_XS), args.in[I_BD]};
        pg8::gemm_phase<EpiDown, MoeOrder, true, true, true>(ring, rsrc, pg8::Shape{1024, 1024, 1024, 0x7a7a7a7a, 0x7d7d7d7d}, S, E);
    } SEAM(10);

    if (IN(11)) { p11_combine(F, args); } SEAM(11);

    if (IN(12)) {
        DenseOrder S; S.init(64, 4, F.G, (int)blockIdx.x, WS_HN, 1024, WS_WPG, 1024);
        EpiPle E{args.out, (const bf16_t*)(ws + WS_E)};
        pg8::gemm_phase<EpiPle, DenseOrder, true, true>(ring, rsrc, pg8::Shape{2048, 2048, 2048, 0, 0}, S, E);
    }
#undef IN
#undef SEAM
}

extern "C" void kernel_launch(void* const* d_in, const int* in_sizes, int n_in, void* d_out, int out_size, void* d_ws, size_t ws_size, hipStream_t stream) {
    static int grid = 0;
    if (grid == 0) {
        if (n_in != 27 || out_size != T * DM || ws_size < WS_END) { fprintf(stderr, "kernel_launch: unexpected shapes (n_in %d, out %d, ws %zu)\n", n_in, out_size, ws_size); grid = -1; return; }
        int dev = 0, cus = 0;
        if (hipGetDevice(&dev) != hipSuccess || hipDeviceGetAttribute(&cus, hipDeviceAttributeMultiprocessorCount, dev) != hipSuccess) { grid = -1; return; }
        if (hipFuncSetAttribute((const void*)fwd_kernel, hipFuncAttributeMaxDynamicSharedMemorySize, LDS_BYTES) != hipSuccess) { fprintf(stderr, "kernel_launch: hipFuncSetAttribute failed\n"); grid = -1; return; }
        int per_cu = 0;
        if (hipOccupancyMaxActiveBlocksPerMultiprocessor(&per_cu, (const void*)fwd_kernel, NWAVES * 64, LDS_BYTES) != hipSuccess || per_cu < 1) fprintf(stderr, "kernel_launch: occupancy query says %d\n", per_cu);
        (void)hipGetLastError();
        grid = cus;
    }
    if (grid < 0) return;
    (void)hipMemsetAsync((char*)d_ws + WS_CTL, 0, CTL_ZERO_BYTES, stream);
    Args a{};
    for (int i = 0; i < 27; ++i) a.in[i] = (const float*)d_in[i];
    a.out = (float*)d_out; a.ws = (unsigned char*)d_ws;
#ifndef DUP_PHASE
    a.ph_lo = 0; a.ph_hi = N_PHASES; hipLaunchKernelGGL(fwd_kernel, dim3(grid), dim3(NWAVES * 64), LDS_BYTES, stream, a);
#else
    a.ph_lo = 0; a.ph_hi = DUP_PHASE + 1; hipLaunchKernelGGL(fwd_kernel, dim3(grid), dim3(NWAVES * 64), LDS_BYTES, stream, a);
    (void)hipMemsetAsync((char*)d_ws + WS_CTL + CW_BAR * 4, 0, XCD_BAR_WORDS * 4, stream);
    a.ph_lo = DUP_PHASE; a.ph_hi = N_PHASES; hipLaunchKernelGGL(fwd_kernel, dim3(grid), dim3(NWAVES * 64), LDS_BYTES, stream, a);
#endif
}
```

```cpp
#include <hip/hip_runtime.h>
#include <cstdio>
#include <cstdint>

#define LAS __attribute__((address_space(3)))
#define GAS __attribute__((address_space(1)))
typedef unsigned short bf16_t;
typedef short bf16x8 __attribute__((ext_vector_type(8)));
typedef short s16x4 __attribute__((ext_vector_type(4)));
typedef float f32x4 __attribute__((ext_vector_type(4)));
typedef float f32x2 __attribute__((ext_vector_type(2)));
typedef float f32x16 __attribute__((ext_vector_type(16)));
typedef unsigned u32x4 __attribute__((ext_vector_type(4)));
typedef unsigned u32x2 __attribute__((ext_vector_type(2)));

constexpr int NB = 4, SEQ = 4096, T = NB * SEQ, DM = 1024, NH = 8, DK = 96, DV = 64;
constexpr int NEXP = 32, TOPK = 4, DEXP = 1024, PLE = 256;
constexpr float EPS = 1e-6f;
constexpr int XS_ROWS = T * TOPK + NEXP * 256;

typedef __bf16 bf16x2_t __attribute__((ext_vector_type(2)));
__device__ __forceinline__ unsigned cvt_pk_bf16(float lo, float hi) { f32x2 v = {lo, hi}; return __builtin_bit_cast(unsigned, __builtin_convertvector(v, bf16x2_t)); }
__device__ __forceinline__ u32x2 cvt8_fp8(const f32x4 a, const f32x4 b, float sc) {
    int w0 = __builtin_amdgcn_cvt_pk_fp8_f32(a[0] * sc, a[1] * sc, 0, false); w0 = __builtin_amdgcn_cvt_pk_fp8_f32(a[2] * sc, a[3] * sc, w0, true);
    int w1 = __builtin_amdgcn_cvt_pk_fp8_f32(b[0] * sc, b[1] * sc, 0, false); w1 = __builtin_amdgcn_cvt_pk_fp8_f32(b[2] * sc, b[3] * sc, w1, true);
    u32x2 r; r.x = (unsigned)w0; r.y = (unsigned)w1; return r;
}
__device__ __forceinline__ float bf_lo(unsigned w) { return __uint_as_float(w << 16); }
__device__ __forceinline__ float bf_hi(unsigned w) { return __uint_as_float(w & 0xffff0000u); }
__device__ __forceinline__ float bf1(bf16_t h) { return __uint_as_float(((unsigned)h) << 16); }
__device__ __forceinline__ float fast_sigmoid(float v) { return __builtin_amdgcn_rcpf(1.0f + __builtin_amdgcn_exp2f(-1.4426950408889634f * v)); }
__device__ __forceinline__ int lane_id() { return (int)__builtin_amdgcn_mbcnt_hi(~0u, __builtin_amdgcn_mbcnt_lo(~0u, 0u)); }
__device__ __forceinline__ float wave_sum(float v) {
#pragma unroll
    for (int o = 1; o < 64; o <<= 1) v += __shfl_xor(v, o);
    return v;
}

namespace pg8 {
constexpr int BM = 256, BK = 64, HALF = 128, HTB = HALF * BK * 2, STAGE_BYTES = 8 * HTB;
__host__ __device__ __forceinline__ int lds_byte(int r, int c) { const int st = (r >> 4) * 2 + (c >> 5), rr = r & 15, cc = c & 31, ob = rr * 64 + cc * 2; return st * 1024 + (ob ^ (((ob >> 9) & 1) << 5)); }
__host__ __device__ __forceinline__ void stage_rc(int b, int& R, int& C) { const int st = b / 1024, sb = b % 1024, swz = sb ^ (((sb >> 9) & 1) << 5); R = (st >> 1) * 16 + swz / 64; C = (st & 1) * 32 + (swz % 64) / 2; }
__host__ __device__ __forceinline__ int perm32(int rho) { const int n = rho >> 4, i = rho & 15; return 8 * (i >> 2) + 4 * n + (i & 3); }

struct Unit { int pm, pn, aux; };
struct Shape { int Kb, lda, ldb, sw, sa; };
typedef int v8i_t __attribute__((ext_vector_type(8))); typedef int v4i_t __attribute__((ext_vector_type(4)));

template <class Epi, class Sched, bool ALIGN_EPI, bool SP2, bool MX = false>
__device__ __forceinline__ void gemm_phase(LAS unsigned char* lds, const __amdgpu_buffer_rsrc_t rsrc, const Shape g, const Sched& S, const Epi& E) {
    const int tid = threadIdx.x, wid = __builtin_amdgcn_readfirstlane(tid >> 6), lane = tid & 63, wr = wid >> 2, wc = wid & 3, fr = lane & 15, fq = lane >> 4;
    int nt = g.Kb / 128; asm volatile("" : "+s"(nt));
    unsigned voffA, voffB;
    { int R, C; stage_rc(tid * 16, R, C); const int Rb = Epi::PERM ? ((R & ~31) + perm32(R & 31)) : R;
      voffA = (unsigned)(R * g.lda + C * 2); voffB = (unsigned)(Rb * g.ldb + C * 2); }
    const unsigned p2A = 64u * (unsigned)g.lda, p2B = 64u * (unsigned)g.ldb;
    const unsigned kstep = 128u;
    const unsigned hstepA = (unsigned)HALF * g.lda, hstepB = (unsigned)HALF * g.ldb;
    const unsigned ldsw = (unsigned)wid * 1024u;
    const int aoff = lds_byte(wr * 64 + fr, fq * 8), boff = lds_byte(wc * 32 + fr, fq * 8);
#define PG8_SA(b, h) (((b) * 2 + (h)) * HTB)
#define PG8_SB(b, h) ((4 + (b) * 2 + (h)) * HTB)
#define PG8_STAGE(bufoff, gbase, voff) do { \
        __builtin_amdgcn_raw_ptr_buffer_load_lds(rsrc, (LAS void*)(lds + (bufoff) + ldsw), 16, voff, (gbase), 0, 0); \
        __builtin_amdgcn_raw_ptr_buffer_load_lds(rsrc, (LAS void*)(lds + (bufoff) + ldsw + 8192), 16, voff, (gbase) + p2##voff, 0, 0); } while (0)
#define p2voffA p2A
#define p2voffB p2B
#define PG8_LDA(dst, b, h) do { _Pragma("unroll") for (int m = 0; m < 4; ++m) _Pragma("unroll") for (int k = 0; k < 2; ++k) dst[m][k] = *(const LAS bf16x8*)(lds + PG8_SA(b, h) + aoff + m * 2048 + k * 1024); } while (0)
#define PG8_LDB(dst, b, h) do { _Pragma("unroll") for (int n = 0; n < 2; ++n) _Pragma("unroll") for (int k = 0; k < 2; ++k) dst[n][k] = *(const LAS bf16x8*)(lds + PG8_SB(b, h) + boff + n * 2048 + k * 1024); } while (0)
#define PG8_CAT(x, y) __builtin_shufflevector(__builtin_bit_cast(v4i_t, x), __builtin_bit_cast(v4i_t, y), 0, 1, 2, 3, 4, 5, 6, 7)
#define PG8_MMA(ai, bj, At, Bt) do { __builtin_amdgcn_s_setprio(1); if constexpr (MX) { _Pragma("unroll") for (int m = 0; m < 4; ++m) _Pragma("unroll") for (int n = 0; n < 2; ++n) \
        acc[ai][bj][m][n] = __builtin_amdgcn_mfma_scale_f32_16x16x128_f8f6f4(PG8_CAT(Bt[n][0], Bt[n][1]), PG8_CAT(At[m][0], At[m][1]), acc[ai][bj][m][n], 0, 0, 0, g.sw, 0, g.sa); } else { \
        _Pragma("unroll") for (int m = 0; m < 4; ++m) _Pragma("unroll") for (int n = 0; n < 2; ++n) _Pragma("unroll") for (int k = 0; k < 2; ++k) \
        acc[ai][bj][m][n] = __builtin_amdgcn_mfma_f32_16x16x32_bf16(Bt[n][k], At[m][k], acc[ai][bj][m][n], 0, 0, 0); } __builtin_amdgcn_s_setprio(0); } while (0)
#define PG8_WAIT_V(n) asm volatile("s_waitcnt vmcnt(" #n ")" ::: "memory")
#define PG8_WAIT_L(n) asm volatile("s_waitcnt lgkmcnt(" #n ")" ::: "memory")
#define PG8_BAR __builtin_amdgcn_s_barrier()
#define PG8_SCHED __builtin_amdgcn_sched_barrier(0)
    Unit cur, nxt; int ui = 0;
    if (!S.next(0, cur)) return;
    f32x4 acc[2][2][4][2];
#pragma unroll
    for (int a = 0; a < 2; ++a)
#pragma unroll
        for (int b = 0; b < 2; ++b)
#pragma unroll
            for (int m = 0; m < 4; ++m)
#pragma unroll
                for (int n = 0; n < 2; ++n) acc[a][b][m][n] = (f32x4){0.f, 0.f, 0.f, 0.f};
    bf16x8 At[4][2], B0[2][2], B1[2][2];
    unsigned cA = S.a_off(cur), cB = S.b_off(cur);
    if constexpr (SP2) {
        PG8_STAGE(PG8_SB(0, 0), cB, voffB); PG8_STAGE(PG8_SB(0, 1), cB + hstepB, voffB); PG8_STAGE(PG8_SA(0, 0), cA, voffA); PG8_STAGE(PG8_SA(0, 1), cA + hstepA, voffA);
        if (wr == 1) PG8_BAR;
        PG8_WAIT_V(2); PG8_BAR;
        PG8_STAGE(PG8_SB(1, 0), cB + kstep, voffB); PG8_STAGE(PG8_SA(1, 0), cA + kstep, voffA); PG8_STAGE(PG8_SB(1, 1), cB + hstepB + kstep, voffB);
        PG8_WAIT_V(6); PG8_BAR;
    } else {
        PG8_STAGE(PG8_SB(0, 0), cB, voffB); PG8_STAGE(PG8_SA(0, 0), cA, voffA); PG8_STAGE(PG8_SB(0, 1), cB + hstepB, voffB); PG8_STAGE(PG8_SA(0, 1), cA + hstepA, voffA);
        if (wr == 1) PG8_BAR;
        PG8_WAIT_V(4); PG8_BAR;
        PG8_STAGE(PG8_SB(1, 0), cB + kstep, voffB); PG8_STAGE(PG8_SA(1, 0), cA + kstep, voffA); PG8_STAGE(PG8_SB(1, 1), cB + hstepB + kstep, voffB);
        PG8_WAIT_V(6); PG8_BAR;
    }
    for (;;) {
        const bool has_next = S.next(ui + 1, nxt);
        const unsigned nA = has_next ? S.a_off(nxt) : cA, nB = has_next ? S.b_off(nxt) : cB;
#pragma nounroll
        for (int t = 0; t < nt; t += 2) {
            const bool last = (t == nt - 2);
            const unsigned a1 = cA + (unsigned)(t + 1) * kstep;
            const unsigned a2 = last ? nA : cA + (unsigned)(t + 2) * kstep, b2 = last ? nB : cB + (unsigned)(t + 2) * kstep;
            const unsigned a3 = a2 + kstep, b3 = b2 + kstep;
            if constexpr (SP2) {
            PG8_LDB(B0, 0, 0); PG8_LDB(B1, 0, 1); PG8_SCHED; PG8_LDA(At, 0, 0); PG8_STAGE(PG8_SA(1, 1), a1 + hstepA, voffA);
            PG8_WAIT_V(8); PG8_WAIT_L(0); PG8_BAR; PG8_MMA(0, 0, At, B0); PG8_MMA(0, 1, At, B1); PG8_BAR; PG8_SCHED;
            PG8_LDA(At, 0, 1); PG8_STAGE(PG8_SB(0, 0), b2, voffB); PG8_STAGE(PG8_SB(0, 1), b2 + hstepB, voffB); PG8_STAGE(PG8_SA(0, 0), a2, voffA);
            PG8_WAIT_V(8); PG8_WAIT_L(0); PG8_BAR; PG8_MMA(1, 0, At, B0); PG8_MMA(1, 1, At, B1); PG8_BAR; PG8_SCHED;
            PG8_LDB(B0, 1, 0); PG8_LDB(B1, 1, 1); PG8_SCHED; PG8_LDA(At, 1, 0); PG8_STAGE(PG8_SA(0, 1), a2 + hstepA, voffA);
            PG8_WAIT_V(8); PG8_WAIT_L(0); PG8_BAR; PG8_MMA(0, 0, At, B0); PG8_MMA(0, 1, At, B1); PG8_BAR; PG8_SCHED;
            PG8_LDA(At, 1, 1); PG8_STAGE(PG8_SB(1, 0), b3, voffB); PG8_STAGE(PG8_SB(1, 1), b3 + hstepB, voffB); PG8_STAGE(PG8_SA(1, 0), a3, voffA);
            PG8_WAIT_V(8); PG8_WAIT_L(0); PG8_BAR; PG8_MMA(1, 0, At, B0); PG8_MMA(1, 1, At, B1); PG8_BAR; PG8_SCHED;
            } else {
            PG8_LDB(B0, 0, 0); PG8_SCHED; PG8_LDA(At, 0, 0); PG8_STAGE(PG8_SA(1, 1), a1 + hstepA, voffA);
            PG8_WAIT_L(8); PG8_BAR; PG8_WAIT_L(0); PG8_MMA(0, 0, At, B0); PG8_BAR; PG8_SCHED;
            PG8_LDB(B1, 0, 1); PG8_STAGE(PG8_SB(0, 0), b2, voffB);
            PG8_BAR; PG8_WAIT_L(0); PG8_MMA(0, 1, At, B1); PG8_BAR;
            PG8_LDA(At, 0, 1); PG8_STAGE(PG8_SA(0, 0), a2, voffA);
            PG8_BAR; PG8_WAIT_L(0); PG8_MMA(1, 0, At, B0); PG8_BAR; PG8_SCHED;
            PG8_STAGE(PG8_SB(0, 1), b2 + hstepB, voffB);
            PG8_WAIT_V(6); PG8_BAR; PG8_MMA(1, 1, At, B1); PG8_BAR;
            PG8_LDB(B0, 1, 0); PG8_SCHED; PG8_LDA(At, 1, 0); PG8_STAGE(PG8_SA(0, 1), a2 + hstepA, voffA);
            PG8_WAIT_L(8); PG8_BAR; PG8_WAIT_L(0); PG8_MMA(0, 0, At, B0); PG8_BAR; PG8_SCHED;
            PG8_LDB(B1, 1, 1); PG8_STAGE(PG8_SB(1, 0), b3, voffB);
            PG8_BAR; PG8_WAIT_L(0); PG8_MMA(0, 1, At, B1); PG8_BAR;
            PG8_LDA(At, 1, 1); PG8_STAGE(PG8_SA(1, 0), a3, voffA);
            PG8_BAR; PG8_WAIT_L(0); PG8_MMA(1, 0, At, B0); PG8_BAR; PG8_SCHED;
            PG8_STAGE(PG8_SB(1, 1), b3 + hstepB, voffB);
            PG8_WAIT_V(6); PG8_BAR; PG8_MMA(1, 1, At, B1); PG8_BAR;
            }
        }
        if constexpr (ALIGN_EPI) { if (wr == 0) PG8_BAR; }
        { int fr_e = fr, fq_e = fq; asm volatile("" : "+v"(fr_e), "+v"(fq_e));
          E(acc, cur, wr, wc, fr_e, fq_e); }
        if (!has_next) break;
#pragma unroll
        for (int a = 0; a < 2; ++a)
#pragma unroll
            for (int b = 0; b < 2; ++b)
#pragma unroll
                for (int m = 0; m < 4; ++m)
#pragma unroll
                    for (int n = 0; n < 2; ++n) acc[a][b][m][n] = (f32x4){0.f, 0.f, 0.f, 0.f};
        cur = nxt; cA = nA; cB = nB; ++ui;
        if constexpr (ALIGN_EPI) { if (wr == 1) PG8_BAR; }
    }
    PG8_WAIT_V(0);
    if constexpr (!ALIGN_EPI) { if (wr == 0) PG8_BAR; }
    PG8_BAR;
#undef PG8_SA
#undef PG8_SB
#undef PG8_STAGE
#undef p2voffA
#undef p2voffB
#undef PG8_LDA
#undef PG8_LDB
#undef PG8_MMA
#undef PG8_CAT
#undef PG8_WAIT_V
#undef PG8_WAIT_L
#undef PG8_BAR
#undef PG8_SCHED
}
}
using pg8::Unit;

constexpr size_t MiB = 1u << 20;
constexpr size_t WS_CTL = 0, CTL_ZERO_BYTES = 1 * MiB;
constexpr size_t WS_WIN = 1 * MiB;
constexpr size_t WS_WQ = 7 * MiB;
constexpr size_t WS_WKV = WS_WQ + 512 * 1024;
constexpr size_t WS_WPOOL = 8 * MiB;
constexpr size_t WS_WAO = 9 * MiB;
constexpr size_t WS_WPO = 10 * MiB;
constexpr size_t WS_WO = 11 * MiB;
constexpr size_t WS_WPG = 13 * MiB;
constexpr size_t WS_WPLE = 15 * MiB;
constexpr size_t WS_WGU = 16 * MiB;
constexpr size_t WS_WD = 144 * MiB;
constexpr size_t WS_HN = 208 * MiB;
constexpr size_t WS_PROJ = 240 * MiB;
constexpr size_t WS_GATES = 272 * MiB;
constexpr size_t WS_A2 = 336 * MiB;
constexpr size_t WS_POOLED = 352 * MiB;
constexpr size_t WS_Q = 368 * MiB;
constexpr size_t WS_K = 392 * MiB;
constexpr size_t WS_V = 416 * MiB;
constexpr size_t WS_ATT = 432 * MiB;
constexpr size_t WS_MIXED = 448 * MiB;
constexpr size_t WS_MIX = 464 * MiB;
constexpr size_t WS_PB = 496 * MiB;
constexpr size_t WS_E = 504 * MiB;
constexpr size_t WS_SSQ = 536 * MiB;
constexpr size_t WS_COS = 537 * MiB;
constexpr size_t WS_SIN = 538 * MiB;
constexpr size_t WS_ROUTE = 539 * MiB;
constexpr size_t WS_XS = 544 * MiB;
constexpr size_t WS_ACT = 688 * MiB;
constexpr size_t WS_XS2 = 768 * MiB;
constexpr size_t WS_END = 848 * MiB;
constexpr int CW_BAR = 4096;
constexpr int CW_CNT = 1024;

constexpr int RING_BYTES = 131072;
constexpr int LDS_BYTES = 163840;
constexpr int MISC_OFF = LDS_BYTES - 512;
constexpr int TILE_E_OFF = LDS_BYTES - 4096;
constexpr int NWAVES = 8;

typedef GAS unsigned gu32;
#define RLX_AGENT __ATOMIC_RELAXED, __HIP_MEMORY_SCOPE_AGENT
#define XB_TMO      128
#define XB_XCNT(j)  (256  + 64 * (j))
#define XB_XSUB(j)  (1280 + 64 * (j))
#define XB_XGEN(j)  (2304 + 64 * (j))
#define XB_TOP      3328
#define XB_TOPGEN   3392
#define XCD_BAR_WORDS 3456
#define XB_SPIN_CAP (1u << 18)
__device__ __forceinline__ unsigned xb_ld(unsigned* p)              { return __hip_atomic_load(p, __ATOMIC_RELAXED, __HIP_MEMORY_SCOPE_AGENT); }
__device__ __forceinline__ unsigned xb_add(unsigned* p, unsigned v) { return __hip_atomic_fetch_add(p, v, __ATOMIC_RELAXED, __HIP_MEMORY_SCOPE_AGENT); }
__device__ __forceinline__ unsigned xb_xcc_id() { return (unsigned)__builtin_amdgcn_s_getreg((3 << 11) | 20) & 0xFu; }
#define XB_SPIN(cond, bar) do { unsigned _sp = 0; while (cond) { __builtin_amdgcn_s_sleep(1); \
    if ((++_sp & 255u) == 0u) { if (xb_ld(&(bar)[XB_TMO])) break; if (_sp > XB_SPIN_CAP) { atomicAdd(&(bar)[XB_TMO], 1u); break; } } } } while (0)
struct XcdBarrier { unsigned* bar; unsigned x; volatile LAS unsigned* st; };
__device__ __forceinline__ XcdBarrier xcd_barrier_post(unsigned* bar, volatile LAS unsigned* st) {
    XcdBarrier b; b.bar = bar; b.x = xb_xcc_id(); b.st = st;
    if (threadIdx.x == 0) (void)xb_add(&bar[XB_XCNT(b.x)], 1u);
    return b;
}
__device__ __forceinline__ void xcd_barrier_complete(unsigned* bar, unsigned x, unsigned& nloc, unsigned& nx) {
    const unsigned G = gridDim.x * gridDim.y * gridDim.z;
    unsigned sum, cnt, mine, sp = 0u;
    for (;;) {
        sum = 0u; cnt = 0u; mine = 0u;
#pragma unroll
        for (unsigned j = 0; j < 16; ++j) { const unsigned c = xb_ld(&bar[XB_XCNT(j)]); sum += c; cnt += (c > 0u) ? 1u : 0u; mine = (j == x) ? c : mine; }
        if (sum == G) break;
        __builtin_amdgcn_s_sleep(1);
        if ((++sp & 255u) == 0u) { if (xb_ld(&bar[XB_TMO])) break; if (sp > XB_SPIN_CAP) { atomicAdd(&bar[XB_TMO], 1u); break; } }
    }
    nloc = mine > 0u ? mine : 1u; nx = cnt > 0u ? cnt : 1u;
}
__device__ __forceinline__ void xcd_barrier(const XcdBarrier& b) {
    asm volatile("s_waitcnt vmcnt(0)" ::: "memory");
    __syncthreads();
    if (threadIdx.x == 0) {
        unsigned* bar = b.bar;
        __builtin_amdgcn_s_waitcnt(0);
        unsigned nloc = b.st[0], nx = b.st[1];
        if (nloc == 0u) { xcd_barrier_complete(bar, b.x, nloc, nx); b.st[0] = nloc; b.st[1] = nx; }
        const unsigned old = xb_add(&bar[XB_XSUB(b.x)], 1u);
        const unsigned gen = old / nloc;
        if (old + 1u == (gen + 1u) * nloc) {
            __builtin_amdgcn_fence(__ATOMIC_RELEASE, "agent");
            asm volatile("s_waitcnt vmcnt(0)" ::: "memory");
            const unsigned og = xb_add(&bar[XB_TOP], 1u);
            const unsigned tg = og / nx;
            if (og + 1u == (tg + 1u) * nx) xb_add(&bar[XB_TOPGEN], 1u);
            else XB_SPIN(xb_ld(&bar[XB_TOPGEN]) == tg, bar);
            __builtin_amdgcn_fence(__ATOMIC_ACQUIRE, "agent");
            xb_add(&bar[XB_XGEN(b.x)], 1u);
            asm volatile("s_waitcnt vmcnt(0)" ::: "memory");
        } else {
            XB_SPIN(xb_ld(&bar[XB_XGEN(b.x)]) == gen, bar);
            __builtin_amdgcn_fence(__ATOMIC_ACQUIRE, "agent");
            asm volatile("s_waitcnt vmcnt(0)" ::: "memory");
        }
    }
    __syncthreads();
}

struct Args {
    const float* in[27];
    float* out; unsigned char* ws;
    int ph_lo, ph_hi;
};
enum { I_X = 0, I_P, I_POS, I_GMIX, I_WIN, I_GQLAT, I_WQB, I_GKVLAT, I_WKVB, I_GQHEAD, I_GKNOPE, I_GKROPE, I_WPOOL, I_PSCALE, I_WAO, I_WPO, I_WO, I_GFFN,
       I_WR, I_BR, I_WGU, I_BGU, I_WD, I_BD, I_GPLE, I_WPG, I_WPLE };

enum { MAP_ID = 0, MAP_WIN, MAP_GU, MAP_QB, MAP_KVB };
__device__ __forceinline__ int map_row(int mode, int n) {
    switch (mode) {
    case MAP_WIN: return n < 416 ? n : n + 96;
    case MAP_GU: { const int j = n & 1023, up = n >> 10; return 256 * (j >> 7) + 128 * up + (j & 127); }
    case MAP_QB: { const int h = n / 96, d = n % 96;
        if (d < 64) return (h >> 2) * 256 + 128 * (d >> 5) + 32 * (h & 3) + (d & 31);
        const int dd = d - 64, half = dd >> 4, i = dd & 15; return 512 + 128 * (h & 1) + 32 * (h >> 1) + 8 * (i >> 2) + 4 * half + (i & 3); }
    case MAP_KVB: { const int h = n >> 7, c = n & 127, isv = c >> 6, d = c & 63; return (h >> 1) * 256 + 128 * (d >> 5) + 32 * (2 * isv + (h & 1)) + (d & 31); }
    default: return n;
    }
}
struct TJob { const float* W; int K, N; bf16_t* WT; int ldw, koff, mode, row_off; const float* gk; const float* gn; int nmat; size_t wstride, wtstride; int fp8; };
struct TItem { const float* src; bf16_t* dst; int n0, k0; float gnv; };
__device__ __forceinline__ TItem titem_setup(const TJob& J, int item, int lane) {
    const int nblk = J.N / 32, ipm = (J.K / 64) * nblk, mat = item / ipm, it = item - mat * ipm, kb = it / nblk, nb = it - kb * nblk;
    TItem I; I.k0 = 64 * kb; I.n0 = 32 * nb;
    I.src = J.W + (size_t)mat * J.wstride + (size_t)(I.k0 + (lane >> 5)) * J.N + I.n0 + (lane & 31);
    I.dst = (bf16_t*)((unsigned char*)J.WT + (size_t)mat * J.wtstride * (J.fp8 ? 1 : 2));
    I.gnv = J.gn ? J.gn[I.n0 + (lane & 31)] : 1.f;
    return I;
}
__device__ __forceinline__ void titem_load(const TJob& J, const TItem& I, float (&v)[32]) {
#pragma unroll
    for (int i = 0; i < 32; ++i) v[i] = I.src[(size_t)(2 * i) * J.N];
}
__device__ __forceinline__ void titem_store(const TJob& J, const TItem& I, float (&v)[32], LAS float* scr, int lane) {
#pragma unroll
    for (int i = 0; i < 32; ++i) { const int kk = 2 * i + (lane >> 5); float x = v[i] * I.gnv; if (J.gk) x *= J.gk[I.k0 + kk]; scr[kk * 33 + (lane & 31)] = x; }
    asm volatile("s_waitcnt lgkmcnt(0)" ::: "memory");
    const int c = lane & 7;
#pragma unroll
    for (int j = 0; j < 4; ++j) { const int n = (lane >> 3) + 8 * j; const LAS float* s = scr + (8 * c) * 33 + n;
        const size_t eo = (size_t)(J.row_off + map_row(J.mode, I.n0 + n)) * J.ldw + J.koff + I.k0 + 8 * c;
        if (J.fp8) { u32x2 o; int w = __builtin_amdgcn_cvt_pk_fp8_f32(s[0 * 33] * 8.f, s[1 * 33] * 8.f, 0, false); w = __builtin_amdgcn_cvt_pk_fp8_f32(s[2 * 33] * 8.f, s[3 * 33] * 8.f, w, true); o.x = (unsigned)w;
            w = __builtin_amdgcn_cvt_pk_fp8_f32(s[4 * 33] * 8.f, s[5 * 33] * 8.f, 0, false); w = __builtin_amdgcn_cvt_pk_fp8_f32(s[6 * 33] * 8.f, s[7 * 33] * 8.f, w, true); o.y = (unsigned)w;
            *(u32x2*)((unsigned char*)I.dst + eo) = o; }
        else { u32x4 o; o.x = cvt_pk_bf16(s[0 * 33], s[1 * 33]); o.y = cvt_pk_bf16(s[2 * 33], s[3 * 33]); o.z = cvt_pk_bf16(s[4 * 33], s[5 * 33]); o.w = cvt_pk_bf16(s[6 * 33], s[7 * 33]);
            *(u32x4*)(I.dst + eo) = o; } }
    asm volatile("s_waitcnt lgkmcnt(0)" ::: "memory");
}
__device__ __forceinline__ void run_job(const TJob& J, LAS float* scr, int gw, int NGW, int lane) {
    const int items = J.nmat * (J.K / 64) * (J.N / 32);
    for (int it = gw; it < items; it += 2 * NGW) {
        const bool two = (it + NGW) < items;
        const TItem I0 = titem_setup(J, it, lane); const TItem I1 = titem_setup(J, two ? it + NGW : it, lane);
        float v0[32], v1[32];
        titem_load(J, I0, v0); if (two) titem_load(J, I1, v1);
        titem_store(J, I0, v0, scr, lane); if (two) titem_store(J, I1, v1, scr, lane);
    }
}

struct Frame {
    LAS unsigned char* lds; volatile LAS unsigned* MISC; unsigned* ctl;
    int tid, lane, wave, vcu, G;
    float* out; unsigned char* ws;
};

__device__ __forceinline__ void p0_prologue(const Frame& F, const Args& a) {
    LAS float* scr = (LAS float*)(F.lds + F.wave * 16384);
    const int gw = F.vcu * NWAVES + F.wave, NGW = F.G * NWAVES;
    unsigned char* ws = F.ws;
#define RUN_JOB(...) do { const TJob J_ = TJob{__VA_ARGS__, 1, 0, 0, 0}; run_job(J_, scr, gw, NGW, F.lane); } while (0)
    RUN_JOB(a.in[I_WIN], 1024, 2976, (bf16_t*)(ws + WS_WIN), 1024, 0, MAP_WIN, 0, nullptr, nullptr);
    RUN_JOB(a.in[I_WQB], 256, 768, (bf16_t*)(ws + WS_WQ), 256, 0, MAP_QB, 0, a.in[I_GQLAT], nullptr);
    RUN_JOB(a.in[I_WKVB], 128, 1024, (bf16_t*)(ws + WS_WKV), 256, 0, MAP_KVB, 0, a.in[I_GKVLAT], nullptr);
    RUN_JOB(a.in[I_WAO], 512, 1024, (bf16_t*)(ws + WS_WAO), 512, 0, MAP_ID, 0, nullptr, nullptr);
    RUN_JOB(a.in[I_WPO], 512, 1024, (bf16_t*)(ws + WS_WPO), 512, 0, MAP_ID, 0, nullptr, nullptr);
    RUN_JOB(a.in[I_WO], 1024, 1024, (bf16_t*)(ws + WS_WO), 1024, 0, MAP_ID, 0, nullptr, nullptr);
    RUN_JOB(a.in[I_WPG], 1024, 1024, (bf16_t*)(ws + WS_WPG), 1024, 0, MAP_ID, 0, nullptr, nullptr);
    RUN_JOB(a.in[I_WPLE], 256, 1024, (bf16_t*)(ws + WS_WPLE), 256, 0, MAP_ID, 0, nullptr, nullptr);
    for (int g = 0; g < 4; ++g)
        RUN_JOB(a.in[I_WPOOL] + (size_t)g * 128 * 128, 128, 128, (bf16_t*)(ws + WS_WPOOL) + (size_t)(g >> 1) * 256 * 256, 256, 128 * (g & 1), MAP_ID, 128 * (g & 1), nullptr, a.in[I_PSCALE] + 128 * g);
    {
        const int gt = (F.vcu * NWAVES + F.wave) * 64 + F.lane, NGT = NGW * 64;
        const u32x4 z = {0u, 0u, 0u, 0u};
        u32x4* w0 = (u32x4*)((bf16_t*)(ws + WS_WIN) + (size_t)416 * 1024);
        for (int i = gt; i < 96 * 128; i += NGT) w0[i] = z;
        for (int i = gt; i < 1024 * 16; i += NGT) { const int r = i >> 4, c = i & 15; *(u32x4*)((bf16_t*)(ws + WS_WKV) + (size_t)r * 256 + 128 + 8 * c) = z; }
        for (int i = gt; i < 2 * 256 * 16; i += NGT) { const int p = i >> 12, r = (i >> 4) & 255, c = i & 15;
            const int k0 = (r < 128) ? 128 : 0; *(u32x4*)((bf16_t*)(ws + WS_WPOOL) + (size_t)p * 65536 + (size_t)r * 256 + k0 + 8 * c) = z; }
    }
    { const TJob J{a.in[I_WGU], 1024, 2048, (bf16_t*)(ws + WS_WGU), 1024, 0, MAP_GU, 0, nullptr, nullptr, NEXP, (size_t)1024 * 2048, (size_t)2048 * 1024, 1}; run_job(J, scr, gw, NGW, F.lane); }
    { const TJob J{a.in[I_WD], 1024, 1024, (bf16_t*)(ws + WS_WD), 1024, 0, MAP_ID, 0, nullptr, nullptr, NEXP, (size_t)1024 * 1024, (size_t)1024 * 1024, 1}; run_job(J, scr, gw, NGW, F.lane); }
    const float* x = a.in[I_X]; const float* gm = a.in[I_GMIX];
    f32x4 gv[4];
#pragma unroll
    for (int j = 0; j < 4; ++j) gv[j] = *(const f32x4*)(gm + 4 * F.lane + 256 * j);
    for (int m = gw; m < T; m += NGW) {
        const f32x4* xr = (const f32x4*)(x + (size_t)m * DM) + F.lane;
        f32x4 v[4]; float s = 0.f;
#pragma unroll
        for (int j = 0; j < 4; ++j) { v[j] = xr[64 * j]; s += (v[j].x * v[j].x + v[j].y * v[j].y) + (v[j].z * v[j].z + v[j].w * v[j].w); }
        const float rstd = 1.0f / sqrtf(wave_sum(s) * (1.f / DM) + EPS);
        u32x2* o8 = (u32x2*)((bf16_t*)(ws + WS_HN) + (size_t)m * DM) + F.lane;
#pragma unroll
        for (int j = 0; j < 4; ++j) { u32x2 w; w.x = cvt_pk_bf16(v[j].x * rstd * gv[j].x, v[j].y * rstd * gv[j].y); w.y = cvt_pk_bf16(v[j].z * rstd * gv[j].z, v[j].w * rstd * gv[j].w); o8[64 * j] = w; }
    }
    {
        const float* p = a.in[I_P];
        for (int m = gw; m < T; m += NGW) { const f32x4 v = *((const f32x4*)(p + (size_t)m * PLE) + F.lane); u32x2 w; w.x = cvt_pk_bf16(v.x, v.y); w.y = cvt_pk_bf16(v.z, v.w);
            *((u32x2*)((bf16_t*)(ws + WS_PB) + (size_t)m * PLE) + F.lane) = w; }
    }
}

struct DenseOrder {
    int nM, nN, nwg, G, c; unsigned A, B, tA, tB, aPn;
    __device__ void init(int nM_, int nN_, int G_, int c_, size_t A_, size_t lda, size_t B_, size_t ldb, unsigned aPn_ = 0) { nM = nM_; nN = nN_; nwg = nM * nN; G = G_; c = c_; A = (unsigned)A_; B = (unsigned)B_; tA = (unsigned)(256 * lda * 2); tB = (unsigned)(256 * ldb * 2); aPn = aPn_; }
    __device__ __forceinline__ bool next(int i, Unit& u) const {
        const long L = (long)i * G + c; if (L >= nwg) return false;
        int wgid = (int)L; { const int q = nwg / 8, r = nwg % 8, xcd = wgid % 8, off = wgid / 8; wgid = (xcd < r ? xcd * (q + 1) : r * (q + 1) + (xcd - r) * q) + off; }
        const int WGM = 8; const int nig = WGM * nN, gid = wgid / nig, fm = gid * WGM, gsz = (nM - fm) < WGM ? (nM - fm) : WGM;
        u.pm = fm + ((wgid % nig) % gsz); u.pn = (wgid % nig) / gsz; u.aux = 0; return true;
    }
    __device__ __forceinline__ unsigned a_off(const Unit& u) const { return A + (unsigned)u.pm * tA + (unsigned)u.pn * aPn; }
    __device__ __forceinline__ unsigned b_off(const Unit& u) const { return B + (unsigned)u.pn * tB; }
};

struct EpiBf16 {
    static constexpr bool PERM = true;
    bf16_t* O; int ldc;
    __device__ __forceinline__ void operator()(const f32x4 (&acc)[2][2][4][2], const Unit& u, int wr, int wc, int fr, int fq) const {
        const int row0 = u.pm * 256 + wr * 64 + fr, col0 = u.pn * 256 + wc * 32 + 8 * fq;
#pragma unroll
        for (int ai = 0; ai < 2; ++ai)
#pragma unroll
            for (int m = 0; m < 4; ++m) { bf16_t* rowp = O + (size_t)(row0 + ai * 128 + m * 16) * ldc + col0;
#pragma unroll
                for (int bj = 0; bj < 2; ++bj) { const f32x4 v0 = acc[ai][bj][m][0], v1 = acc[ai][bj][m][1];
                    u32x4 w; w.x = cvt_pk_bf16(v0[0], v0[1]); w.y = cvt_pk_bf16(v0[2], v0[3]); w.z = cvt_pk_bf16(v1[0], v1[1]); w.w = cvt_pk_bf16(v1[2], v1[3]);
                    *(u32x4*)(rowp + bj * 128) = w; } }
    }
};
struct EpiProj {
    static constexpr bool PERM = true;
    bf16_t* PROJ; bf16_t* GATES;
    __device__ __forceinline__ void operator()(const f32x4 (&acc)[2][2][4][2], const Unit& u, int wr, int wc, int fr, int fq) const {
        const int row0 = u.pm * 256 + wr * 64 + fr; const bool isg = u.pn >= 4;
        bf16_t* O = isg ? GATES : PROJ; const int ldc = isg ? 2048 : 1024; const int col0 = (isg ? u.pn - 4 : u.pn) * 256 + wc * 32 + 8 * fq;
#pragma unroll
        for (int ai = 0; ai < 2; ++ai)
#pragma unroll
            for (int m = 0; m < 4; ++m) { bf16_t* rowp = O + (size_t)(row0 + ai * 128 + m * 16) * ldc + col0;
#pragma unroll
                for (int bj = 0; bj < 2; ++bj) { f32x4 v0 = acc[ai][bj][m][0], v1 = acc[ai][bj][m][1];
                    if (isg) {
#pragma unroll
                        for (int e = 0; e < 4; ++e) { v0[e] = fast_sigmoid(v0[e]); v1[e] = fast_sigmoid(v1[e]); } }
                    u32x4 w; w.x = cvt_pk_bf16(v0[0], v0[1]); w.y = cvt_pk_bf16(v0[2], v0[3]); w.z = cvt_pk_bf16(v1[0], v1[1]); w.w = cvt_pk_bf16(v1[2], v1[3]);
                    *(u32x4*)(rowp + bj * 128) = w; } asm volatile("" ::: "memory"); }
    }
};

__device__ __forceinline__ void p2_rows(const Frame& F, const Args& a) {
    const int gw = F.vcu * NWAVES + F.wave, NGW = F.G * NWAVES, lane = F.lane;
    unsigned char* ws = F.ws;
    const bf16_t* PROJ = (const bf16_t*)(ws + WS_PROJ);
    bf16_t* A2 = (bf16_t*)(ws + WS_A2); bf16_t* POOLED = (bf16_t*)(ws + WS_POOLED); bf16_t* Kb = (bf16_t*)(ws + WS_K);
    float* COS = (float*)(ws + WS_COS); float* SIN = (float*)(ws + WS_SIN);
    const int* positions = (const int*)a.in[I_POS];
    const float gkr = (lane < 32) ? a.in[I_GKROPE][lane] : 0.f;
    const float inv_freq = __builtin_amdgcn_exp2f(-(float)(lane & 15) * (13.287712379549449f / 16.0f));
    const int w = 2 << (lane >> 4);
    for (int task = gw; task < T / 8; task += NGW) {
        const int t0 = task * 8, b = t0 / SEQ, s0 = t0 % SEQ;
        {
            const bf16_t* base = PROJ + (size_t)(b * SEQ) * 1024 + 512 + 8 * lane;
            float S[8];
#pragma unroll
            for (int j = 0; j < 8; ++j) S[j] = 0.f;
            for (int r = s0 - 15; r < s0; ++r) {
                if (r >= 0 && r >= s0 - w + 1) { const u32x4 v = *(const u32x4*)(base + (size_t)r * 1024);
                    S[0] += bf_lo(v.x); S[1] += bf_hi(v.x); S[2] += bf_lo(v.y); S[3] += bf_hi(v.y); S[4] += bf_lo(v.z); S[5] += bf_hi(v.z); S[6] += bf_lo(v.w); S[7] += bf_hi(v.w); }
            }
#pragma unroll
            for (int i = 0; i < 8; ++i) {
                const int s = s0 + i;
                const u32x4 v = *(const u32x4*)(base + (size_t)s * 1024);
                float uu[8] = {bf_lo(v.x), bf_hi(v.x), bf_lo(v.y), bf_hi(v.y), bf_lo(v.z), bf_hi(v.z), bf_lo(v.w), bf_hi(v.w)};
                const int cnt = (s + 1 < w) ? s + 1 : w; const float ic = 1.0f / (float)cnt;
                float o[8];
#pragma unroll
                for (int j = 0; j < 8; ++j) { S[j] += uu[j]; o[j] = S[j] * ic - uu[j]; }
                u32x4 wv; wv.x = cvt_pk_bf16(o[0], o[1]); wv.y = cvt_pk_bf16(o[2], o[3]); wv.z = cvt_pk_bf16(o[4], o[5]); wv.w = cvt_pk_bf16(o[6], o[7]);
                *(u32x4*)(POOLED + (size_t)(t0 + i) * 512 + 8 * lane) = wv;
                const int rr = s - w + 1;
                if (rr >= 0) { const u32x4 q = *(const u32x4*)(base + (size_t)rr * 1024);
                    S[0] -= bf_lo(q.x); S[1] -= bf_hi(q.x); S[2] -= bf_lo(q.y); S[3] -= bf_hi(q.y); S[4] -= bf_lo(q.z); S[5] -= bf_hi(q.z); S[6] -= bf_lo(q.w); S[7] -= bf_hi(q.w); }
            }
        }
        for (int i = 0; i < 8; ++i) {
            const int t = t0 + i, s = s0 + i;
            const bf16_t* pr = PROJ + (size_t)t * 1024;
            const u32x2 ql = *(const u32x2*)(pr + 4 * lane);
            const unsigned kvl = *(const unsigned*)(pr + 256 + 2 * lane);
            const float krv = (lane < 32) ? bf1(pr[384 + lane]) : 0.f;
            const float q0 = bf_lo(ql.x), q1 = bf_hi(ql.x), q2 = bf_lo(ql.y), q3 = bf_hi(ql.y);
            const float k0 = bf_lo(kvl), k1 = bf_hi(kvl);
            const float sq = wave_sum((q0 * q0 + q1 * q1) + (q2 * q2 + q3 * q3));
            const float sk = wave_sum(k0 * k0 + k1 * k1);
            const float sr = wave_sum(krv * krv);
            const float rq = 1.0f / sqrtf(sq * (1.f / 256.f) + EPS), rk = 1.0f / sqrtf(sk * (1.f / 128.f) + EPS), rr = 1.0f / sqrtf(sr * (1.f / 32.f) + EPS);
            u32x2 wq; wq.x = cvt_pk_bf16(q0 * rq, q1 * rq); wq.y = cvt_pk_bf16(q2 * rq, q3 * rq);
            *(u32x2*)(A2 + (size_t)t * 512 + 4 * lane) = wq;
            *(unsigned*)(A2 + (size_t)t * 512 + 256 + 2 * lane) = cvt_pk_bf16(k0 * rk, k1 * rk);
            *(unsigned*)(A2 + (size_t)t * 512 + 384 + 2 * lane) = 0u;
            const float pos = (float)positions[t];
            const float ang = pos * inv_freq;
            const float rev = ang * 0.15915494309189535f;
            const float fr_ = rev - floorf(rev);
            const float sn = __builtin_amdgcn_sinf(fr_), cs = __builtin_amdgcn_cosf(fr_);
            const float kn = krv * rr * gkr;
            const float other = __shfl_xor(kn, 16);
            const float ro = (lane & 16) ? (kn * cs + other * sn) : (kn * cs - other * sn);
            if (lane < 32) {
                const bf16_t rb = (bf16_t)(cvt_pk_bf16(ro, 0.f) & 0xffffu);
#pragma unroll
                for (int h = 0; h < NH; ++h) Kb[((size_t)(b * NH + h) * SEQ + s) * DK + 64 + lane] = rb;
            }
            if (lane < 16) { COS[(size_t)t * 16 + lane] = cs; SIN[(size_t)t * 16 + lane] = sn; }
        }
    }
}

#define EPI_FENCE() asm volatile("" ::: "memory")
struct EpiQ {
    static constexpr bool PERM = true;
    bf16_t* Q; float* SSQ; const float* COS; const float* SIN; const float* gq;
    __device__ __forceinline__ void operator()(const f32x4 (&acc)[2][2][4][2], const Unit& u, int wr, int wc, int fr, int fq) const {
        const int t0 = u.pm * 256 + wr * 64 + fr, b = (u.pm * 256) / SEQ, s0 = t0 - b * SEQ;
        if (u.pn < 2) {
            const int h = 4 * u.pn + wc;
            bf16_t* dst0 = Q + ((size_t)(b * NH + h) * SEQ + s0) * DK + 8 * fq;
            float* ssq0 = SSQ + ((size_t)t0 * NH + h) * 2;
#pragma unroll
            for (int ai = 0; ai < 2; ++ai)
#pragma unroll
                for (int m = 0; m < 4; ++m) {
                    const int dr = ai * 128 + m * 16;
                    float q = 0.f;
#pragma unroll
                    for (int bj = 0; bj < 2; ++bj)
#pragma unroll
                        for (int n = 0; n < 2; ++n) { const f32x4 v = acc[ai][bj][m][n]; q += (v[0] * v[0] + v[1] * v[1]) + (v[2] * v[2] + v[3] * v[3]); }
                    q += __shfl_xor(q, 16); q += __shfl_xor(q, 32);
                    if (fq == 0) ssq0[dr * NH * 2] = q;
#pragma unroll
                    for (int bj = 0; bj < 2; ++bj) { const f32x4 v0 = acc[ai][bj][m][0] * *(const f32x4*)(gq + 32 * bj + 8 * fq), v1 = acc[ai][bj][m][1] * *(const f32x4*)(gq + 32 * bj + 8 * fq + 4);
                        u32x4 w; w.x = cvt_pk_bf16(v0[0], v0[1]); w.y = cvt_pk_bf16(v0[2], v0[3]); w.z = cvt_pk_bf16(v1[0], v1[1]); w.w = cvt_pk_bf16(v1[2], v1[3]);
                        *(u32x4*)(dst0 + dr * DK + 32 * bj) = w; }
                    EPI_FENCE();
                }
        } else {
            const f32x4 g1 = *(const f32x4*)(gq + 64 + 4 * fq), g2 = *(const f32x4*)(gq + 80 + 4 * fq);
            const float* cs0 = COS + (size_t)t0 * 16 + 4 * fq; const float* sn0 = SIN + (size_t)t0 * 16 + 4 * fq;
            bf16_t* dst0 = Q + ((size_t)(b * NH + 2 * wc) * SEQ + s0) * DK + 64 + 4 * fq;
            float* ssq0 = SSQ + ((size_t)t0 * NH + 2 * wc) * 2 + 1;
#pragma unroll
            for (int ai = 0; ai < 2; ++ai)
#pragma unroll
                for (int m = 0; m < 4; ++m) {
                    const int dr = ai * 128 + m * 16;
                    const f32x4 cs = *(const f32x4*)(cs0 + dr * 16), sn = *(const f32x4*)(sn0 + dr * 16);
#pragma unroll
                    for (int bj = 0; bj < 2; ++bj) {
                        const f32x4 x1 = acc[ai][bj][m][0], x2 = acc[ai][bj][m][1];
                        float q = (x1[0] * x1[0] + x1[1] * x1[1]) + (x1[2] * x1[2] + x1[3] * x1[3]) + (x2[0] * x2[0] + x2[1] * x2[1]) + (x2[2] * x2[2] + x2[3] * x2[3]);
                        q += __shfl_xor(q, 16); q += __shfl_xor(q, 32);
                        if (fq == 0) ssq0[dr * NH * 2 + bj * 2] = q;
                        const f32x4 y1 = x1 * g1, y2 = x2 * g2;
                        const f32x4 o1 = y1 * cs - y2 * sn, o2 = y2 * cs + y1 * sn;
                        bf16_t* dst = dst0 + (size_t)bj * SEQ * DK + dr * DK;
                        u32x2 w1, w2; w1.x = cvt_pk_bf16(o1[0], o1[1]); w1.y = cvt_pk_bf16(o1[2], o1[3]); w2.x = cvt_pk_bf16(o2[0], o2[1]); w2.y = cvt_pk_bf16(o2[2], o2[3]);
                        *(u32x2*)(dst) = w1; *(u32x2*)(dst + 16) = w2;
                    }
                    EPI_FENCE();
                }
        }
    }
};
struct EpiKV {
    static constexpr bool PERM = true;
    bf16_t* K; bf16_t* V; const float* gk;
    __device__ __forceinline__ void operator()(const f32x4 (&acc)[2][2][4][2], const Unit& u, int wr, int wc, int fr, int fq) const {
        const int t0 = u.pm * 256 + wr * 64 + fr, b = (u.pm * 256) / SEQ, s0 = t0 - b * SEQ;
        const int h = 2 * u.pn + (wc & 1); const bool isv = wc >= 2;
        const int pitch = isv ? DV : DK;
        bf16_t* dst0 = (isv ? V : K) + ((size_t)(b * NH + h) * SEQ + s0) * pitch + 8 * fq;
#pragma unroll
        for (int ai = 0; ai < 2; ++ai)
#pragma unroll
            for (int m = 0; m < 4; ++m) {
                const int dr = ai * 128 + m * 16;
                float sc = 1.f;
                if (!isv) { float q = 0.f;
#pragma unroll
                    for (int bj = 0; bj < 2; ++bj)
#pragma unroll
                        for (int n = 0; n < 2; ++n) { const f32x4 v = acc[ai][bj][m][n]; q += (v[0] * v[0] + v[1] * v[1]) + (v[2] * v[2] + v[3] * v[3]); }
                    q += __shfl_xor(q, 16); q += __shfl_xor(q, 32);
                    sc = 1.0f / sqrtf(q * (1.f / 64.f) + EPS); }
#pragma unroll
                for (int bj = 0; bj < 2; ++bj) {
                    f32x4 v0 = acc[ai][bj][m][0] * sc, v1 = acc[ai][bj][m][1] * sc;
                    if (!isv) { v0 = v0 * *(const f32x4*)(gk + 32 * bj + 8 * fq); v1 = v1 * *(const f32x4*)(gk + 32 * bj + 8 * fq + 4); }
                    u32x4 w; w.x = cvt_pk_bf16(v0[0], v0[1]); w.y = cvt_pk_bf16(v0[2], v0[3]); w.z = cvt_pk_bf16(v1[0], v1[1]); w.w = cvt_pk_bf16(v1[2], v1[3]);
                    *(u32x4*)(dst0 + dr * pitch + 32 * bj) = w; }
                EPI_FENCE();
            }
    }
};

namespace att {
constexpr int KT_BYTES = 64 * 192, VT_BYTES = 64 * 128, SLOT_BYTES = KT_BYTES + VT_BYTES;
constexpr int NSLOT = 4, SCR_OFF = NSLOT * SLOT_BYTES;
__device__ __forceinline__ int crow(int r, int hi) { return (r & 3) + 8 * (r >> 2) + 4 * hi; }
__device__ __forceinline__ s16x4 vtr(const LAS unsigned char* p) { typedef short v4i16_t __attribute__((ext_vector_type(4)));
    return __builtin_bit_cast(s16x4, __builtin_amdgcn_ds_read_tr16_b64_v4i16((LAS v4i16_t*)p)); }
#define MFMA32(a, b, c) __builtin_amdgcn_mfma_f32_32x32x16_bf16(a, b, c, 0, 0, 0)
__device__ __forceinline__ float max3f(float a, float b, float c) { return __builtin_fmaxf(__builtin_fmaxf(a, b), c); }

__device__ __forceinline__ void attn_unit(LAS unsigned char* lds, const u32x4 srd, int bh, int qb, const bf16_t* Q, unsigned Koff, unsigned Voff, const float* SSQ, bf16_t* O) {
    const int tid = threadIdx.x, lane = tid & 63, r32 = lane & 31, hi = lane >> 5; const int wid = __builtin_amdgcn_readfirstlane(tid >> 6);
    const int b = bh / NH, h = bh % NH, q0 = qb * 256, qw = q0 + 32 * wid;
    LAS float* scr = (LAS float*)(lds + SCR_OFF) + wid * 64;
    const int NT = (q0 + 256) / 64;
    const unsigned kS = Koff + (unsigned)bh * (SEQ * DK * 2), vS = Voff + (unsigned)bh * (SEQ * DV * 2);
    const int kc2 = 8 + (wid & 3);
    const unsigned vK1 = (unsigned)(lane * 192 + wid * 16), vK2 = (unsigned)(lane * 192 + kc2 * 16);
    const int vkey = 8 * wid + (lane >> 3); const unsigned vV = (unsigned)(vkey * 128 + (((lane & 7) ^ (((vkey >> 1) & 1) * 4)) * 16));
    const unsigned lds0 = (unsigned)__builtin_amdgcn_readfirstlane((int)(unsigned)(unsigned long)lds);
    const unsigned dK1 = (unsigned)wid * 1024u, dK2 = (unsigned)kc2 * 1024u, dV = (unsigned)KT_BYTES + (unsigned)wid * 1024u;
#define ATT_DMA1(ldsaddr, voff, soff) asm volatile("s_nop 4\n\ts_mov_b32 m0, %0\n\ts_nop 0\n\tbuffer_load_dwordx4 %1, %2, %3 offen lds" :: "s"(ldsaddr), "v"(voff), "s"(srd), "s"(soff) : "m0", "memory")
#define ATT_DMA(t) do { const unsigned sp_ = lds0 + (unsigned)((t) & 3) * SLOT_BYTES; const unsigned ks_ = kS + (unsigned)(t) * (64 * 192), vs_ = vS + (unsigned)(t) * (64 * 128); \
        ATT_DMA1(sp_ + dK1, vK1, ks_); ATT_DMA1(sp_ + dK2, vK2, ks_); ATT_DMA1(sp_ + dV, vV, vs_); } while (0)
#define ATT_WAITBAR(N) asm volatile("s_waitcnt vmcnt(" #N ") lgkmcnt(0)\n\ts_barrier" ::: "memory")
    bf16x8 qr[6];
    { const float* sp = SSQ + ((size_t)(b * SEQ + qw + r32) * NH + h) * 2; const float ss = sp[0] + sp[1];
      const float cq = (1.0f / sqrtf(ss * (1.f / 96.f) + EPS)) * 0.10206207261596577f * 1.4426950408889634f;
      const bf16_t* qp = Q + ((size_t)bh * SEQ + qw + r32) * DK + 8 * hi;
      u32x4 qw_[6];
#pragma unroll
      for (int d0 = 0; d0 < 6; ++d0) qw_[d0] = *(const u32x4*)(qp + 16 * d0);
#pragma unroll
      for (int d0 = 0; d0 < 6; ++d0) { const u32x4 w = qw_[d0]; u32x4 o;
          o.x = cvt_pk_bf16(bf_lo(w.x) * cq, bf_hi(w.x) * cq); o.y = cvt_pk_bf16(bf_lo(w.y) * cq, bf_hi(w.y) * cq); o.z = cvt_pk_bf16(bf_lo(w.z) * cq, bf_hi(w.z) * cq); o.w = cvt_pk_bf16(bf_lo(w.w) * cq, bf_hi(w.w) * cq);
          qr[d0] = __builtin_bit_cast(bf16x8, o); } }
    ATT_DMA(0); ATT_DMA(1); ATT_DMA(2);
    const int kbase = hi * 1024 + r32 * 16;
    const int qq = (lane & 15) >> 2, pp = lane & 3, dblk = (lane >> 4) & 1, swz = ((qq >> 1) & 1) * 64;
    const int vrow0 = 4 * hi + qq;
    const int vb0 = KT_BYTES + vrow0 * 128 + ((32 * dblk + 8 * pp) ^ swz);
    const int vb1 = KT_BYTES + vrow0 * 128 + ((64 + 32 * dblk + 8 * pp) ^ swz);
    f32x16 o0 = {}, o1 = {};
    float m_run = 0.f, l_run = 0.f; f32x16 negm = {};
    const int qa = qw + r32;
#define ATT_QK(N0, N1, t) do { const LAS unsigned char* kp_ = lds + ((t) & 3) * SLOT_BYTES + kbase; \
        _Pragma("unroll") for (int d0 = 0; d0 < 6; ++d0) { const bf16x8 ka_ = *(const LAS bf16x8*)(kp_ + d0 * 2048), kb_ = *(const LAS bf16x8*)(kp_ + d0 * 2048 + 512); \
            if (d0 == 0) { N0 = MFMA32(ka_, qr[0], negm); N1 = MFMA32(kb_, qr[0], negm); } else { N0 = MFMA32(ka_, qr[d0], N0); N1 = MFMA32(kb_, qr[d0], N1); } } } while (0)
#define ATT_MASK(N0, N1, t) do { const int kb_ = 64 * (t); if (kb_ + 63 > qw) { _Pragma("unroll") for (int r = 0; r < 16; ++r) { const int ka_ = kb_ + crow(r, hi); \
        if (ka_ > qa) N0[r] = -__builtin_inff(); if (ka_ + 32 > qa) N1[r] = -__builtin_inff(); } } } while (0)
#define ATT_ROWMAX(N0, N1, PM) do { float a_ = max3f(N0[0], N0[1], N1[0]), b_ = max3f(N0[2], N0[3], N1[1]); a_ = max3f(a_, N1[2], N1[3]); \
        _Pragma("unroll") for (int r = 4; r < 16; r += 4) { a_ = max3f(a_, N0[r], N0[r + 1]); b_ = max3f(b_, N0[r + 2], N0[r + 3]); a_ = max3f(a_, N1[r], N1[r + 1]); b_ = max3f(b_, N1[r + 2], N1[r + 3]); } \
        a_ = max3f(a_, b_, b_); auto rr_ = __builtin_amdgcn_permlane32_swap(__float_as_uint(a_), __float_as_uint(a_), false, false); \
        PM = max3f(__uint_as_float(rr_[0]), __uint_as_float(rr_[1]), __uint_as_float(rr_[1])); } while (0)
#define ATT_DECIDE(PM, C0, C1, FORCE) do { if ((FORCE) || __any((PM) > 8.0f)) { const float dl_ = (FORCE) ? (PM) : fmaxf((PM), 0.f); const float al_ = __builtin_amdgcn_exp2f(-dl_); m_run += dl_; l_run *= al_; \
        _Pragma("unroll") for (int r = 0; r < 16; ++r) { C0[r] -= dl_; C1[r] -= dl_; } \
        _Pragma("unroll") for (int r = 0; r < 16; ++r) negm[r] = -m_run; \
        if (hi == 0) scr[r32] = al_; asm volatile("s_waitcnt lgkmcnt(0)" ::: "memory"); \
        _Pragma("unroll") for (int a4 = 0; a4 < 4; ++a4) { const f32x4 f_ = *(const LAS f32x4*)(scr + 8 * a4 + 4 * hi); \
            _Pragma("unroll") for (int e = 0; e < 4; ++e) { o0[4 * a4 + e] *= f_[e]; o1[4 * a4 + e] *= f_[e]; } } } } while (0)
#define ATT_SOFTMAX(C0, C1) do { float ps_ = 0.f; \
        _Pragma("unroll") for (int r = 0; r < 16; ++r) { C0[r] = __builtin_amdgcn_exp2f(C0[r]); C1[r] = __builtin_amdgcn_exp2f(C1[r]); ps_ += C0[r] + C1[r]; } \
        l_run += ps_; \
        _Pragma("unroll") for (int ks = 0; ks < 4; ++ks) { const f32x16& P_ = (ks < 2) ? C0 : C1; const int bs_ = 8 * (ks & 1); \
            u32x4 w_; w_.x = cvt_pk_bf16(P_[bs_ + 0], P_[bs_ + 1]); w_.y = cvt_pk_bf16(P_[bs_ + 2], P_[bs_ + 3]); w_.z = cvt_pk_bf16(P_[bs_ + 4], P_[bs_ + 5]); w_.w = cvt_pk_bf16(P_[bs_ + 6], P_[bs_ + 7]); \
            pa[ks] = __builtin_bit_cast(bf16x8, w_); } } while (0)
#define ATT_PV(t) do { const LAS unsigned char* vp0_ = lds + ((t) & 3) * SLOT_BYTES + vb0; const LAS unsigned char* vp1_ = lds + ((t) & 3) * SLOT_BYTES + vb1; \
        _Pragma("unroll") for (int ks = 0; ks < 4; ++ks) { \
            const s16x4 a0_ = vtr(vp0_ + ks * 16 * 128), a1_ = vtr(vp0_ + ks * 16 * 128 + 8 * 128), c0_ = vtr(vp1_ + ks * 16 * 128), c1_ = vtr(vp1_ + ks * 16 * 128 + 8 * 128); \
            const bf16x8 vf0_ = {a0_[0], a0_[1], a0_[2], a0_[3], a1_[0], a1_[1], a1_[2], a1_[3]}; const bf16x8 vf1_ = {c0_[0], c0_[1], c0_[2], c0_[3], c1_[0], c1_[1], c1_[2], c1_[3]}; \
            o0 = MFMA32(pa[ks], vf0_, o0); o1 = MFMA32(pa[ks], vf1_, o1); } } while (0)
#define ATT_STEP(C0, C1, PMC, N0, N1, PMN, j, MSK) do { \
        ATT_DECIDE(PMC, C0, C1, false); \
        ATT_QK(N0, N1, (j) + 1); ATT_SOFTMAX(C0, C1); \
        const bool dma_ = (j) + 3 < NT; if (dma_) ATT_DMA((j) + 3); \
        ATT_PV(j); if (MSK) ATT_MASK(N0, N1, (j) + 1); ATT_ROWMAX(N0, N1, PMN); \
        if (dma_) ATT_WAITBAR(3); else ATT_WAITBAR(0); } while (0)
    bf16x8 pa[4];
    f32x16 sA0, sA1, sB0, sB1; float pmA, pmB;
    ATT_WAITBAR(6);
    ATT_QK(sA0, sA1, 0); ATT_MASK(sA0, sA1, 0); ATT_ROWMAX(sA0, sA1, pmA);
    ATT_DECIDE(pmA, sA0, sA1, true); pmA = 0.f;
    ATT_WAITBAR(3);
    int j = 0;
    for (; j + 8 <= NT; j += 2) {
        ATT_STEP(sA0, sA1, pmA, sB0, sB1, pmB, j, false);
        ATT_STEP(sB0, sB1, pmB, sA0, sA1, pmA, j + 1, false);
    }
    for (; j < NT; j += 2) {
        ATT_STEP(sA0, sA1, pmA, sB0, sB1, pmB, j, true);
        ATT_STEP(sB0, sB1, pmB, sA0, sA1, pmA, j + 1, true);
    }
#undef ATT_DMA
#undef ATT_DMA1
#undef ATT_WAITBAR
#undef ATT_QK
#undef ATT_MASK
#undef ATT_ROWMAX
#undef ATT_DECIDE
#undef ATT_SOFTMAX
#undef ATT_PV
#undef ATT_STEP
    { auto rr = __builtin_amdgcn_permlane32_swap(__float_as_uint(l_run), __float_as_uint(l_run), false, false); l_run = __uint_as_float(rr[0]) + __uint_as_float(rr[1]); }
    if (hi == 0) scr[32 + r32] = 1.0f / l_run;
    asm volatile("s_waitcnt lgkmcnt(0)" ::: "memory");
    bf16_t* Ow = O + ((size_t)(b * SEQ + qw)) * 512 + h * 64 + r32;
#pragma unroll
    for (int a4 = 0; a4 < 4; ++a4) { const f32x4 f = *(const LAS f32x4*)(scr + 32 + 8 * a4 + 4 * hi);
#pragma unroll
        for (int e = 0; e < 4; ++e) { const int r = 4 * a4 + e; const int row = crow(r, hi);
            Ow[(size_t)row * 512] = (bf16_t)(cvt_pk_bf16(o0[r] * f[e], 0.f) & 0xffffu);
            Ow[(size_t)row * 512 + 32] = (bf16_t)(cvt_pk_bf16(o1[r] * f[e], 0.f) & 0xffffu); } }
    __syncthreads();
}
#undef MFMA32
}

struct MixOrder {
    int G, c; unsigned ATT, MIXED, WAO, WPO;
    __device__ __forceinline__ bool next(int i, Unit& u) const {
        const int tile = (i >> 1) * G + c; if (tile >= 256) return false;
        u.pm = tile >> 2; u.pn = tile & 3; u.aux = i & 1; return true;
    }
    __device__ __forceinline__ unsigned a_off(const Unit& u) const { return (u.aux ? MIXED : ATT) + (unsigned)u.pm * (256 * 512 * 2); }
    __device__ __forceinline__ unsigned b_off(const Unit& u) const { return (u.aux ? WPO : WAO) + (unsigned)u.pn * (256 * 512 * 2); }
};
struct EpiMix {
    static constexpr bool PERM = true;
    bf16_t* MIX; const bf16_t* GATES;
    __device__ __forceinline__ void operator()(const f32x4 (&acc)[2][2][4][2], const Unit& u, int wr, int wc, int fr, int fq) const {
        const int row0 = u.pm * 256 + wr * 64 + fr, col0 = u.pn * 256 + wc * 32 + 8 * fq;
#pragma unroll
        for (int ai = 0; ai < 2; ++ai)
#pragma unroll
            for (int m = 0; m < 4; ++m) { const size_t row = (size_t)(row0 + ai * 128 + m * 16);
#pragma unroll
                for (int bj = 0; bj < 2; ++bj) {
                    const u32x4 gw = *(const u32x4*)(GATES + row * 2048 + u.aux * 1024 + col0 + bj * 128);
                    const f32x4 v0 = acc[ai][bj][m][0], v1 = acc[ai][bj][m][1];
                    float r[8] = {v0[0] * bf_lo(gw.x), v0[1] * bf_hi(gw.x), v0[2] * bf_lo(gw.y), v0[3] * bf_hi(gw.y), v1[0] * bf_lo(gw.z), v1[1] * bf_hi(gw.z), v1[2] * bf_lo(gw.w), v1[3] * bf_hi(gw.w)};
                    bf16_t* dst = MIX + row * 1024 + col0 + bj * 128;
                    if (u.aux) { const u32x4 pw = *(const u32x4*)dst;
                        r[0] += bf_lo(pw.x); r[1] += bf_hi(pw.x); r[2] += bf_lo(pw.y); r[3] += bf_hi(pw.y); r[4] += bf_lo(pw.z); r[5] += bf_hi(pw.z); r[6] += bf_lo(pw.w); r[7] += bf_hi(pw.w); }
                    u32x4 w; w.x = cvt_pk_bf16(r[0], r[1]); w.y = cvt_pk_bf16(r[2], r[3]); w.z = cvt_pk_bf16(r[4], r[5]); w.w = cvt_pk_bf16(r[6], r[7]);
                    *(u32x4*)dst = w; } }
    }
};
struct EpiRes {
    static constexpr bool PERM = false;
    const float* base; float* out;
    __device__ __forceinline__ void operator()(const f32x4 (&acc)[2][2][4][2], const Unit& u, int wr, int wc, int fr, int fq) const {
        const int row0 = u.pm * 256 + wr * 64 + fr, col0 = u.pn * 256 + wc * 32 + 4 * fq;
#pragma unroll
        for (int ai = 0; ai < 2; ++ai)
#pragma unroll
            for (int m = 0; m < 4; ++m) { const size_t off = (size_t)(row0 + ai * 128 + m * 16) * DM + col0;
#pragma unroll
                for (int bj = 0; bj < 2; ++bj)
#pragma unroll
                    for (int n = 0; n < 2; ++n) *(f32x4*)(out + off + bj * 128 + n * 16) = *(const f32x4*)(base + off + bj * 128 + n * 16) + acc[ai][bj][m][n]; }
    }
};

constexpr int WR_PITCH = 1028;
constexpr int R_WR_OFF = 0, R_PART_OFF = 32 * WR_PITCH * 4, R_SSQ_OFF = R_PART_OFF + 2 * 64 * 33 * 4, R_CNT_OFF = R_SSQ_OFF + 2 * 64 * 4, R_BASE_OFF = R_CNT_OFF + 128, R_END = R_BASE_OFF + 128;
static_assert(R_END <= TILE_E_OFF, "router LDS map");
__device__ __forceinline__ void p7_router(const Frame& F, const Args& a) {
    LAS float* WR = (LAS float*)(F.lds + R_WR_OFF); LAS float* PART = (LAS float*)(F.lds + R_PART_OFF); LAS float* SSQP = (LAS float*)(F.lds + R_SSQ_OFF);
    LAS int* CNT = (LAS int*)(F.lds + R_CNT_OFF); LAS int* BASE = (LAS int*)(F.lds + R_BASE_OFF);
    const int tid = F.tid, lane = F.lane, wave = F.wave;
    const float* wr = a.in[I_WR]; const float* gf = a.in[I_GFFN];
    for (int i = tid; i < 1024 * 32; i += 512) { const int k = i >> 5, e = i & 31; WR[e * WR_PITCH + k] = wr[i] * gf[k]; }
    if (tid < 32) CNT[tid] = 0;
    __syncthreads();
    int* RE = (int*)(F.ws + WS_ROUTE); int* RP = RE + T * 4; float* RG = (float*)(RP + T * 4); float* RS = RG + T * 4;
    unsigned* gcnt = F.ctl + CW_CNT;
    const float* X1 = F.out;
    for (int blk = F.vcu; blk < T / 64; blk += F.G) {
        const int tb = blk * 64;
        {
            const int tg = wave & 3, kh = wave >> 2, r = lane & 15, kq = lane >> 4;
            const float* xp = X1 + (size_t)(tb + 16 * tg + r) * DM + 512 * kh + 4 * kq;
            const LAS float* w0 = WR + (lane & 15) * WR_PITCH + 512 * kh + 4 * kq; const LAS float* w1 = w0 + 16 * WR_PITCH;
            f32x4 acc0 = {0.f, 0.f, 0.f, 0.f}, acc1 = {0.f, 0.f, 0.f, 0.f}; float ss = 0.f;
#pragma unroll 4
            for (int i = 0; i < 32; ++i) {
                const f32x4 xv = *(const f32x4*)(xp + 16 * i);
                const f32x4 b0 = *(const LAS f32x4*)(w0 + 16 * i), b1 = *(const LAS f32x4*)(w1 + 16 * i);
                ss += (xv[0] * xv[0] + xv[1] * xv[1]) + (xv[2] * xv[2] + xv[3] * xv[3]);
#pragma unroll
                for (int j = 0; j < 4; ++j) { acc0 = __builtin_amdgcn_mfma_f32_16x16x4f32(xv[j], b0[j], acc0, 0, 0, 0); acc1 = __builtin_amdgcn_mfma_f32_16x16x4f32(xv[j], b1[j], acc1, 0, 0, 0); }
            }
            ss += __shfl_xor(ss, 16); ss += __shfl_xor(ss, 32);
            if (kq == 0) SSQP[kh * 64 + 16 * tg + r] = ss;
#pragma unroll
            for (int q = 0; q < 4; ++q) { const int tok = 16 * tg + 4 * kq + q; PART[(kh * 64 + tok) * 33 + (lane & 15)] = acc0[q]; PART[(kh * 64 + tok) * 33 + 16 + (lane & 15)] = acc1[q]; }
        }
        __syncthreads();
        int te[4] = {0, 0, 0, 0}, lp[4] = {0, 0, 0, 0}; float tv[4] = {-3e38f, -3e38f, -3e38f, -3e38f}; float rstd = 0.f;
        if (tid < 64) {
            const float ssq = SSQP[tid] + SSQP[64 + tid]; rstd = 1.0f / sqrtf(ssq * (1.f / DM) + EPS);
            const float* br = a.in[I_BR];
#pragma unroll
            for (int e = 0; e < 32; ++e) {
                float v = (PART[tid * 33 + e] + PART[(64 + tid) * 33 + e]) * rstd + br[e]; int id = e;
#pragma unroll
                for (int s = 0; s < 4; ++s) { const bool gt = v > tv[s]; const float ov = tv[s]; const int oi = te[s]; tv[s] = gt ? v : ov; te[s] = gt ? id : oi; v = gt ? ov : v; id = gt ? oi : id; }
            }
#pragma unroll
            for (int s = 0; s < 4; ++s) lp[s] = __hip_atomic_fetch_add(&CNT[te[s]], 1, __ATOMIC_RELAXED, __HIP_MEMORY_SCOPE_WORKGROUP);
        }
        __syncthreads();
        if (tid < 32) { const int c = CNT[tid]; BASE[tid] = c ? (int)atomicAdd(gcnt + tid, (unsigned)c) : 0; }
        __syncthreads();
        if (tid < 64) {
            const int t = tb + tid;
            const float e1 = __expf(tv[1] - tv[0]), e2 = __expf(tv[2] - tv[0]), e3 = __expf(tv[3] - tv[0]); const float inv = 1.0f / (1.0f + e1 + e2 + e3);
            const float gts[4] = {inv, e1 * inv, e2 * inv, e3 * inv};
#pragma unroll
            for (int s = 0; s < 4; ++s) { RE[t * 4 + s] = te[s]; RP[t * 4 + s] = BASE[te[s]] + lp[s]; RG[t * 4 + s] = gts[s]; }
            RS[t] = rstd;
        }
        __syncthreads();
        if (tid < 32) CNT[tid] = 0;
        __syncthreads();
    }
}

__device__ __forceinline__ int build_tiles(const Frame& F) {
    LAS int* TB = (LAS int*)(F.lds + TILE_E_OFF); LAS int* TE = TB + 64;
    if (F.tid == 0) { int acc = 0; for (int e = 0; e < NEXP; ++e) { TB[e] = acc; const int c = (int)__hip_atomic_load(F.ctl + CW_CNT + e, RLX_AGENT); acc += (c + 255) >> 8; } TB[NEXP] = acc; }
    __syncthreads();
    if (F.tid < NEXP) { for (int t = TB[F.tid]; t < TB[F.tid + 1]; ++t) TE[t] = F.tid; }
    __syncthreads();
    return TB[NEXP];
}

__device__ __forceinline__ void p8_dispatch(const Frame& F, const Args& a) {
    (void)build_tiles(F);
    const LAS int* TB = (const LAS int*)(F.lds + TILE_E_OFF);
    const int gw = F.vcu * NWAVES + F.wave, NGW = F.G * NWAVES, lane = F.lane;
    const int* RE = (const int*)(F.ws + WS_ROUTE); const int* RP = RE + T * 4; const float* RS = (const float*)(RP + T * 4) + T * 4; int* SL = (int*)(RS + T);
    const float* X1 = F.out; const float* gf = a.in[I_GFFN]; unsigned char* XS = F.ws + WS_XS2;
    f32x4 g[2][2];
#pragma unroll
    for (int j = 0; j < 2; ++j) { g[j][0] = *(const f32x4*)(gf + 512 * j + 8 * lane); g[j][1] = *(const f32x4*)(gf + 512 * j + 8 * lane + 4); }
    for (int t = gw; t < T; t += NGW) {
        const float rstd = RS[t];
        u32x2 w[2];
#pragma unroll
        for (int j = 0; j < 2; ++j) { const f32x4 v0 = *(const f32x4*)(X1 + (size_t)t * DM + 512 * j + 8 * lane) * g[j][0] * rstd, v1 = *(const f32x4*)(X1 + (size_t)t * DM + 512 * j + 8 * lane + 4) * g[j][1] * rstd;
            w[j] = cvt8_fp8(v0, v1, 8.0f); }
#pragma unroll
        for (int s = 0; s < 4; ++s) { const int e = RE[t * 4 + s], slot = TB[e] * 256 + RP[t * 4 + s];
            if (lane == 0) SL[t * 4 + s] = slot;
            unsigned char* dst = XS + (size_t)slot * DM + 8 * lane;
            *(u32x2*)dst = w[0]; *(u32x2*)(dst + 512) = w[1]; }
    }
}

struct MoeOrder {
    int G, c, ntn_shift, total; const LAS int* TE; unsigned A, Bw, bexp, btile;
    __device__ __forceinline__ bool next(int i, Unit& u) const {
        const int L = i * G + c; if (L >= total) return false;
        u.pm = L >> ntn_shift; u.pn = L & ((1 << ntn_shift) - 1); u.aux = __builtin_amdgcn_readfirstlane(TE[u.pm]); return true;
    }
    __device__ __forceinline__ unsigned a_off(const Unit& u) const { return A + (unsigned)u.pm * (256 * 1024); }
    __device__ __forceinline__ unsigned b_off(const Unit& u) const { return Bw + (unsigned)u.aux * bexp + (unsigned)u.pn * btile; }
};
struct EpiSwiglu {
    static constexpr bool PERM = true;
    unsigned char* ACT; const float* bgu;
    __device__ __forceinline__ void operator()(const f32x4 (&acc)[2][2][4][2], const Unit& u, int wr, int wc, int fr, int fq) const {
        const int row0 = u.pm * 256 + wr * 64 + fr, j0 = u.pn * 128 + wc * 32 + 8 * fq;
        const float* bb = bgu + (size_t)u.aux * 2048 + j0;
        unsigned char* dst0 = ACT + (size_t)row0 * DEXP + j0;
#pragma unroll
        for (int ai = 0; ai < 2; ++ai)
#pragma unroll
            for (int m = 0; m < 4; ++m) {
#pragma unroll
                for (int n = 0; n < 2; ++n) {
                    asm volatile("" : "+v"(bb));
                    const f32x4 g = acc[ai][0][m][n] + *(const f32x4*)(bb + 4 * n), up = acc[ai][1][m][n] + *(const f32x4*)(bb + 1024 + 4 * n);
                    float r[4];
#pragma unroll
                    for (int e = 0; e < 4; ++e) { const float gg = fminf(g[e], 7.0f), uu = fminf(fmaxf(up[e], -7.0f), 7.0f); r[e] = (uu + 1.0f) * gg * fast_sigmoid(1.702f * gg) * 8.0f; }
                    int w = __builtin_amdgcn_cvt_pk_fp8_f32(r[0], r[1], 0, false); w = __builtin_amdgcn_cvt_pk_fp8_f32(r[2], r[3], w, true);
                    *(int*)(dst0 + (size_t)(ai * 128 + m * 16) * DEXP + 4 * n) = w;
                }
                asm volatile("" ::: "memory");
            }
    }
};
struct EpiDown {
    static constexpr bool PERM = true;
    bf16_t* Y; const float* bd;
    __device__ __forceinline__ void operator()(const f32x4 (&acc)[2][2][4][2], const Unit& u, int wr, int wc, int fr, int fq) const {
        const int row0 = u.pm * 256 + wr * 64 + fr, col0 = u.pn * 256 + wc * 32 + 8 * fq;
        const float* bb = bd + (size_t)u.aux * DM + col0;
#pragma unroll
        for (int ai = 0; ai < 2; ++ai)
#pragma unroll
            for (int m = 0; m < 4; ++m) { bf16_t* rowp = Y + (size_t)(row0 + ai * 128 + m * 16) * DM + col0;
                asm volatile("" : "+v"(bb));
#pragma unroll
                for (int bj = 0; bj < 2; ++bj) { const f32x4 v0 = acc[ai][bj][m][0] + *(const f32x4*)(bb + bj * 128), v1 = acc[ai][bj][m][1] + *(const f32x4*)(bb + bj * 128 + 4);
                    u32x4 w; w.x = cvt_pk_bf16(v0[0], v0[1]); w.y = cvt_pk_bf16(v0[2], v0[3]); w.z = cvt_pk_bf16(v1[0], v1[1]); w.w = cvt_pk_bf16(v1[2], v1[3]);
                    *(u32x4*)(rowp + bj * 128) = w; } asm volatile("" ::: "memory"); }
    }
};

__device__ __forceinline__ void p11_combine(const Frame& F, const Args& a) {
    const int gw = F.vcu * NWAVES + F.wave, NGW = F.G * NWAVES, lane = F.lane;
    const int* RE = (const int*)(F.ws + WS_ROUTE); const float* RG = (const float*)(RE + T * 8); const int* SL = (const int*)(RG + T * 4 + T);
    const bf16_t* Y = (const bf16_t*)(F.ws + WS_XS); bf16_t* HP = (bf16_t*)(F.ws + WS_HN); float* X = F.out; const float* gp = a.in[I_GPLE];
    f32x4 g[2][2];
#pragma unroll
    for (int j = 0; j < 2; ++j) { g[j][0] = *(const f32x4*)(gp + 512 * j + 8 * lane); g[j][1] = *(const f32x4*)(gp + 512 * j + 8 * lane + 4); }
    for (int t = gw; t < T; t += NGW) {
        f32x4 v[2][2];
#pragma unroll
        for (int j = 0; j < 2; ++j) { v[j][0] = *(const f32x4*)(X + (size_t)t * DM + 512 * j + 8 * lane); v[j][1] = *(const f32x4*)(X + (size_t)t * DM + 512 * j + 8 * lane + 4); }
#pragma unroll
        for (int s = 0; s < 4; ++s) { const int slot = SL[t * 4 + s]; const float gt = RG[t * 4 + s];
#pragma unroll
            for (int j = 0; j < 2; ++j) { const u32x4 y = *(const u32x4*)(Y + (size_t)slot * DM + 512 * j + 8 * lane);
                v[j][0] += (f32x4){bf_lo(y.x), bf_hi(y.x), bf_lo(y.y), bf_hi(y.y)} * gt; v[j][1] += (f32x4){bf_lo(y.z), bf_hi(y.z), bf_lo(y.w), bf_hi(y.w)} * gt; } }
        float ss = 0.f;
#pragma unroll
        for (int j = 0; j < 2; ++j)
#pragma unroll
            for (int n = 0; n < 2; ++n) { const f32x4 q = v[j][n]; ss += (q[0] * q[0] + q[1] * q[1]) + (q[2] * q[2] + q[3] * q[3]); *(f32x4*)(X + (size_t)t * DM + 512 * j + 8 * lane + 4 * n) = q; }
        const float rstd = 1.0f / sqrtf(wave_sum(ss) * (1.f / DM) + EPS);
#pragma unroll
        for (int j = 0; j < 2; ++j) { const f32x4 q0 = v[j][0] * g[j][0] * rstd, q1 = v[j][1] * g[j][1] * rstd;
            u32x4 w; w.x = cvt_pk_bf16(q0[0], q0[1]); w.y = cvt_pk_bf16(q0[2], q0[3]); w.z = cvt_pk_bf16(q1[0], q1[1]); w.w = cvt_pk_bf16(q1[2], q1[3]);
            *(u32x4*)(HP + (size_t)t * DM + 512 * j + 8 * lane) = w; }
    }
}
struct EpiPle {
    static constexpr bool PERM = false;
    float* out; const bf16_t* E;
    __device__ __forceinline__ void operator()(const f32x4 (&acc)[2][2][4][2], const Unit& u, int wr, int wc, int fr, int fq) const {
        const int row0 = u.pm * 256 + wr * 64 + fr, col0 = u.pn * 256 + wc * 32 + 4 * fq;
#pragma unroll
        for (int ai = 0; ai < 2; ++ai)
#pragma unroll
            for (int m = 0; m < 4; ++m) { const size_t off = (size_t)(row0 + ai * 128 + m * 16) * DM + col0;
#pragma unroll
                for (int bj = 0; bj < 2; ++bj)
#pragma unroll
                    for (int n = 0; n < 2; ++n) { const size_t o = off + bj * 128 + n * 16; const u32x2 ev = *(const u32x2*)(E + o); const f32x4 a4 = acc[ai][bj][m][n];
                        f32x4 r = *(const f32x4*)(out + o);
                        r[0] += fast_sigmoid(a4[0]) * bf_lo(ev.x); r[1] += fast_sigmoid(a4[1]) * bf_hi(ev.x); r[2] += fast_sigmoid(a4[2]) * bf_lo(ev.y); r[3] += fast_sigmoid(a4[3]) * bf_hi(ev.y);
                        *(f32x4*)(out + o) = r; } }
    }
};

constexpr int N_PHASES = 13;
__global__ void __launch_bounds__(NWAVES * 64, 2) fwd_kernel(Args args) {
    extern __shared__ __attribute__((aligned(16))) unsigned char lds_raw[];
    Frame F;
    F.lds = (LAS unsigned char*)lds_raw; F.MISC = (volatile LAS unsigned*)(F.lds + MISC_OFF);
    F.tid = threadIdx.x; F.lane = F.tid & 63; F.wave = __builtin_amdgcn_readfirstlane(F.tid >> 6);
    F.G = gridDim.x; { const int bx = blockIdx.x; F.vcu = (F.G % 8 == 0) ? (bx % 8) * (F.G / 8) + bx / 8 : bx; }
    F.out = args.out; F.ws = args.ws; F.ctl = (unsigned*)(args.ws + WS_CTL);
    if (F.tid < 32) F.MISC[F.tid] = 0u;
    __syncthreads();
    const int lo = args.ph_lo, hi = args.ph_hi;
    const bool multi = (hi - lo) > 1;
    XcdBarrier bar; bar.bar = F.ctl + CW_BAR; bar.x = 0; bar.st = nullptr;
    if (multi) bar = xcd_barrier_post(F.ctl + CW_BAR, F.MISC);
#ifndef PH_MASK
#define PH_MASK 0x1fff
#endif
#define IN(k) ((((PH_MASK) >> (k)) & 1) && lo <= (k) && (k) < hi)
#define SEAM(k) do { if (IN(k) && IN((k) + 1)) xcd_barrier(bar); } while (0)
    unsigned char* ws = args.ws;
    LAS unsigned char* ring = F.lds;
    const __amdgpu_buffer_rsrc_t rsrc = __builtin_amdgcn_make_buffer_rsrc((void*)ws, 0, (int)WS_END, 0x00020000);

    if (IN(0)) { p0_prologue(F, args); } SEAM(0);

    if (IN(1)) {
        { DenseOrder S; S.init(64, 12, F.G, (int)blockIdx.x, WS_HN, 1024, WS_WIN, 1024);
          EpiProj E{(bf16_t*)(ws + WS_PROJ), (bf16_t*)(ws + WS_GATES)};
          pg8::gemm_phase<EpiProj, DenseOrder, true, true>(ring, rsrc, pg8::Shape{2048, 2048, 2048, 0, 0}, S, E); }
        { DenseOrder S; S.init(64, 4, F.G, (int)blockIdx.x, WS_PB, 256, WS_WPLE, 256);
          EpiBf16 E{(bf16_t*)(ws + WS_E), 1024};
          pg8::gemm_phase<EpiBf16, DenseOrder, true, true>(ring, rsrc, pg8::Shape{512, 512, 512, 0, 0}, S, E); }
    } SEAM(1);

    if (IN(2)) { p2_rows(F, args); } SEAM(2);

    if (IN(3)) {
#ifndef P3M
#define P3M 7
#endif
        if (P3M & 1) { DenseOrder S; S.init(64, 4, F.G, (int)blockIdx.x, WS_A2 + 512, 512, WS_WKV, 256);
          EpiKV E{(bf16_t*)(ws + WS_K), (bf16_t*)(ws + WS_V), args.in[I_GKNOPE]};
          pg8::gemm_phase<EpiKV, DenseOrder, true, true>(ring, rsrc, pg8::Shape{512, 1024, 512, 0, 0}, S, E); }
        if (P3M & 2) { DenseOrder S; S.init(64, 3, F.G, (int)blockIdx.x, WS_A2, 512, WS_WQ, 256);
          EpiQ E{(bf16_t*)(ws + WS_Q), (float*)(ws + WS_SSQ), (const float*)(ws + WS_COS), (const float*)(ws + WS_SIN), args.in[I_GQHEAD]};
          pg8::gemm_phase<EpiQ, DenseOrder, true, true>(ring, rsrc, pg8::Shape{512, 1024, 512, 0, 0}, S, E); }
        if (P3M & 4) { DenseOrder S; S.init(64, 2, F.G, (int)blockIdx.x, WS_POOLED, 512, WS_WPOOL, 256, 512);
          EpiBf16 E{(bf16_t*)(ws + WS_MIXED), 512};
          pg8::gemm_phase<EpiBf16, DenseOrder, true, true>(ring, rsrc, pg8::Shape{512, 1024, 512, 0, 0}, S, E); }
    } SEAM(3);

    if (IN(4)) {
        u32x4 srd; { const unsigned long wb = (unsigned long)ws; srd.x = (unsigned)__builtin_amdgcn_readfirstlane((int)(unsigned)wb); srd.y = (unsigned)__builtin_amdgcn_readfirstlane((int)(unsigned)(wb >> 32)); srd.z = (unsigned)WS_END; srd.w = 0x00020000u; }
        for (int it = F.vcu; it < 256; it += F.G) {
            const int bh = it >> 3, pr = it & 7;
            att::attn_unit(ring, srd, bh, 15 - pr, (const bf16_t*)(ws + WS_Q), (unsigned)WS_K, (unsigned)WS_V, (const float*)(ws + WS_SSQ), (bf16_t*)(ws + WS_ATT));
            att::attn_unit(ring, srd, bh, pr, (const bf16_t*)(ws + WS_Q), (unsigned)WS_K, (unsigned)WS_V, (const float*)(ws + WS_SSQ), (bf16_t*)(ws + WS_ATT));
        }
    } SEAM(4);

    if (IN(5)) {
        MixOrder S{F.G, F.vcu, (unsigned)WS_ATT, (unsigned)WS_MIXED, (unsigned)WS_WAO, (unsigned)WS_WPO};
        EpiMix E{(bf16_t*)(ws + WS_MIX), (const bf16_t*)(ws + WS_GATES)};
        pg8::gemm_phase<EpiMix, MixOrder, true, true>(ring, rsrc, pg8::Shape{1024, 1024, 1024, 0, 0}, S, E);
    } SEAM(5);

    if (IN(6)) {
        DenseOrder S; S.init(64, 4, F.G, (int)blockIdx.x, WS_MIX, 1024, WS_WO, 1024);
        EpiRes E{args.in[I_X], args.out};
        pg8::gemm_phase<EpiRes, DenseOrder, true, true>(ring, rsrc, pg8::Shape{2048, 2048, 2048, 0, 0}, S, E);
    } SEAM(6);

    if (IN(7)) { p7_router(F, args); } SEAM(7);

    if (IN(8)) { p8_dispatch(F, args); } SEAM(8);

    if (IN(9)) {
        const int TM = build_tiles(F);
        MoeOrder S{F.G, F.vcu, 3, TM * 8, (const LAS int*)(F.lds + TILE_E_OFF) + 64, (unsigned)WS_XS2, (unsigned)WS_WGU, 2048u * 1024u, 256u * 1024u};
        EpiSwiglu E{ws + WS_ACT, args.in[I_BGU]};
        pg8::gemm_phase<EpiSwiglu, MoeOrder, true, true, true>(ring, rsrc, pg8::Shape{1024, 1024, 1024, 0x7c7c7c7c, 0x7c7c7c7c}, S, E);
    } SEAM(9);

    if (IN(10)) {
        const int TM = build_tiles(F);
        MoeOrder S{F.G, F.vcu, 2, TM * 4, (const LAS int*)(F.lds + TILE_E_OFF) + 64, (unsigned)WS_ACT, (unsigned)WS_WD, 1024u * 1024u, 256u * 1024u};
        EpiDown E{(bf16_t*)(ws + WS_XS), args.in[I_BD]};
        pg8::gemm_phase<EpiDown, MoeOrder, true, true, true>(ring, rsrc, pg8::Shape{1024, 1024, 1024, 0x7c7c7c7c, 0x7c7c7c7c}, S, E);
    } SEAM(10);

    if (IN(11)) { p11_combine(F, args); } SEAM(11);

    if (IN(12)) {
        DenseOrder S; S.init(64, 4, F.G, (int)blockIdx.x, WS_HN, 1024, WS_WPG, 1024);
        EpiPle E{args.out, (const bf16_t*)(ws + WS_E)};
        pg8::gemm_phase<EpiPle, DenseOrder, true, true>(ring, rsrc, pg8::Shape{2048, 2048, 2048, 0, 0}, S, E);
    }
#undef IN
#undef SEAM
}

extern "C" void kernel_launch(void* const* d_in, const int* in_sizes, int n_in, void* d_out, int out_size, void* d_ws, size_t ws_size, hipStream_t stream) {
    static int grid = 0;
    if (grid == 0) {
        if (n_in != 27 || out_size != T * DM || ws_size < WS_END) { fprintf(stderr, "kernel_launch: unexpected shapes (n_in %d, out %d, ws %zu)\n", n_in, out_size, ws_size); grid = -1; return; }
        int dev = 0, cus = 0;
        if (hipGetDevice(&dev) != hipSuccess || hipDeviceGetAttribute(&cus, hipDeviceAttributeMultiprocessorCount, dev) != hipSuccess) { grid = -1; return; }
        if (hipFuncSetAttribute((const void*)fwd_kernel, hipFuncAttributeMaxDynamicSharedMemorySize, LDS_BYTES) != hipSuccess) { fprintf(stderr, "kernel_launch: hipFuncSetAttribute failed\n"); grid = -1; return; }
        int per_cu = 0;
        if (hipOccupancyMaxActiveBlocksPerMultiprocessor(&per_cu, (const void*)fwd_kernel, NWAVES * 64, LDS_BYTES) != hipSuccess || per_cu < 1) fprintf(stderr, "kernel_launch: occupancy query says %d\n", per_cu);
        (void)hipGetLastError();
        grid = cus;
    }
    if (grid < 0) return;
    (void)hipMemsetAsync((char*)d_ws + WS_CTL, 0, CTL_ZERO_BYTES, stream);
    Args a{};
    for (int i = 0; i < 27; ++i) a.in[i] = (const float*)d_in[i];
    a.out = (float*)d_out; a.ws = (unsigned char*)d_ws;
#ifndef DUP_PHASE
    a.ph_lo = 0; a.ph_hi = N_PHASES; hipLaunchKernelGGL(fwd_kernel, dim3(grid), dim3(NWAVES * 64), LDS_BYTES, stream, a);
#else
    a.ph_lo = 0; a.ph_hi = DUP_PHASE + 1; hipLaunchKernelGGL(fwd_kernel, dim3(grid), dim3(NWAVES * 64), LDS_BYTES, stream, a);
    (void)hipMemsetAsync((char*)d_ws + WS_CTL + CW_BAR * 4, 0, XCD_BAR_WORDS * 4, stream);
    a.ph_lo = DUP_PHASE; a.ph_hi = N_PHASES; hipLaunchKernelGGL(fwd_kernel, dim3(grid), dim3(NWAVES * 64), LDS_BYTES, stream, a);
#endif
}
```

```cpp
#include <hip/hip_runtime.h>
#include <cstdio>
#include <cstdint>

#define LAS __attribute__((address_space(3)))
#define GAS __attribute__((address_space(1)))
typedef unsigned short bf16_t;
typedef short bf16x8 __attribute__((ext_vector_type(8)));
typedef short s16x4 __attribute__((ext_vector_type(4)));
typedef float f32x4 __attribute__((ext_vector_type(4)));
typedef float f32x2 __attribute__((ext_vector_type(2)));
typedef float f32x16 __attribute__((ext_vector_type(16)));
typedef unsigned u32x4 __attribute__((ext_vector_type(4)));
typedef unsigned u32x2 __attribute__((ext_vector_type(2)));

constexpr int NB = 4, SEQ = 4096, T = NB * SEQ, DM = 1024, NH = 8, DK = 96, DV = 64;
constexpr int NEXP = 32, TOPK = 4, DEXP = 1024, PLE = 256;
constexpr float EPS = 1e-6f;
constexpr int XS_ROWS = T * TOPK + NEXP * 256;

typedef __bf16 bf16x2_t __attribute__((ext_vector_type(2)));
__device__ __forceinline__ unsigned cvt_pk_bf16(float lo, float hi) { f32x2 v = {lo, hi}; return __builtin_bit_cast(unsigned, __builtin_convertvector(v, bf16x2_t)); }
__device__ __forceinline__ u32x2 cvt8_fp8(const f32x4 a, const f32x4 b, float sc) {
    int w0 = __builtin_amdgcn_cvt_pk_fp8_f32(a[0] * sc, a[1] * sc, 0, false); w0 = __builtin_amdgcn_cvt_pk_fp8_f32(a[2] * sc, a[3] * sc, w0, true);
    int w1 = __builtin_amdgcn_cvt_pk_fp8_f32(b[0] * sc, b[1] * sc, 0, false); w1 = __builtin_amdgcn_cvt_pk_fp8_f32(b[2] * sc, b[3] * sc, w1, true);
    u32x2 r; r.x = (unsigned)w0; r.y = (unsigned)w1; return r;
}
__device__ __forceinline__ float bf_lo(unsigned w) { return __uint_as_float(w << 16); }
__device__ __forceinline__ float bf_hi(unsigned w) { return __uint_as_float(w & 0xffff0000u); }
__device__ __forceinline__ float bf1(bf16_t h) { return __uint_as_float(((unsigned)h) << 16); }
__device__ __forceinline__ float fast_sigmoid(float v) { return __builtin_amdgcn_rcpf(1.0f + __builtin_amdgcn_exp2f(-1.4426950408889634f * v)); }
__device__ __forceinline__ int lane_id() { return (int)__builtin_amdgcn_mbcnt_hi(~0u, __builtin_amdgcn_mbcnt_lo(~0u, 0u)); }
__device__ __forceinline__ int tid_local() { int t = threadIdx.x; asm volatile("" : "+v"(t)); return t; }
__device__ __forceinline__ float wave_sum(float v) {
#pragma unroll
    for (int o = 1; o < 64; o <<= 1) v += __shfl_xor(v, o);
    return v;
}

namespace pg8 {
constexpr int BM = 256, BK = 64, HALF = 128, HTB = HALF * BK * 2, STAGE_BYTES = 8 * HTB;
__host__ __device__ __forceinline__ int lds_byte(int r, int c) { const int st = (r >> 4) * 2 + (c >> 5), rr = r & 15, cc = c & 31, ob = rr * 64 + cc * 2; return st * 1024 + (ob ^ (((ob >> 9) & 1) << 5)); }
__host__ __device__ __forceinline__ void stage_rc(int b, int& R, int& C) { const int st = b / 1024, sb = b % 1024, swz = sb ^ (((sb >> 9) & 1) << 5); R = (st >> 1) * 16 + swz / 64; C = (st & 1) * 32 + (swz % 64) / 2; }
__host__ __device__ __forceinline__ int perm32(int rho) { const int n = rho >> 4, i = rho & 15; return 8 * (i >> 2) + 4 * n + (i & 3); }

struct Unit { int pm, pn, aux; };
struct Shape { int Kb, lda, ldb, sw, sa; };
typedef int v8i_t __attribute__((ext_vector_type(8))); typedef int v4i_t __attribute__((ext_vector_type(4)));

template <class Epi, class Sched, bool ALIGN_EPI, bool SP2, bool MX = false>
__device__ __forceinline__ void gemm_phase(LAS unsigned char* lds, const __amdgpu_buffer_rsrc_t rsrc, const Shape g, const Sched& S, const Epi& E) {
    const int tid = tid_local(), wid = __builtin_amdgcn_readfirstlane(tid >> 6), lane = tid & 63, wr = wid >> 2, wc = wid & 3, fr = lane & 15, fq = lane >> 4;
    int nt = g.Kb / 128; asm volatile("" : "+s"(nt));
    unsigned voffA, voffB;
    { int R, C; stage_rc(tid * 16, R, C); const int Rb = Epi::PERM ? ((R & ~31) + perm32(R & 31)) : R;
      voffA = (unsigned)(R * g.lda + C * 2); voffB = (unsigned)(Rb * g.ldb + C * 2); }
    const unsigned p2A = 64u * (unsigned)g.lda, p2B = 64u * (unsigned)g.ldb;
    const unsigned kstep = 128u;
    const unsigned hstepA = (unsigned)HALF * g.lda, hstepB = (unsigned)HALF * g.ldb;
    const unsigned ldsw = (unsigned)wid * 1024u;
    const int aoff = lds_byte(wr * 64 + fr, fq * 8), boff = lds_byte(wc * 32 + fr, fq * 8);
#define PG8_SA(b, h) (((b) * 2 + (h)) * HTB)
#define PG8_SB(b, h) ((4 + (b) * 2 + (h)) * HTB)
#define PG8_STAGE(bufoff, gbase, voff) do { \
        __builtin_amdgcn_raw_ptr_buffer_load_lds(rsrc, (LAS void*)(lds + (bufoff) + ldsw), 16, voff, (gbase), 0, 0); \
        __builtin_amdgcn_raw_ptr_buffer_load_lds(rsrc, (LAS void*)(lds + (bufoff) + ldsw + 8192), 16, voff, (gbase) + p2##voff, 0, 0); } while (0)
#define p2voffA p2A
#define p2voffB p2B
#define PG8_LDA(dst, b, h) do { _Pragma("unroll") for (int m = 0; m < 4; ++m) _Pragma("unroll") for (int k = 0; k < 2; ++k) dst[m][k] = *(const LAS bf16x8*)(lds + PG8_SA(b, h) + aoff + m * 2048 + k * 1024); } while (0)
#define PG8_LDB(dst, b, h) do { _Pragma("unroll") for (int n = 0; n < 2; ++n) _Pragma("unroll") for (int k = 0; k < 2; ++k) dst[n][k] = *(const LAS bf16x8*)(lds + PG8_SB(b, h) + boff + n * 2048 + k * 1024); } while (0)
#define PG8_CAT(x, y) __builtin_shufflevector(__builtin_bit_cast(v4i_t, x), __builtin_bit_cast(v4i_t, y), 0, 1, 2, 3, 4, 5, 6, 7)
#define PG8_MMA(ai, bj, At, Bt) do { __builtin_amdgcn_s_setprio(1); if constexpr (MX) { _Pragma("unroll") for (int m = 0; m < 4; ++m) _Pragma("unroll") for (int n = 0; n < 2; ++n) \
        acc[ai][bj][m][n] = __builtin_amdgcn_mfma_scale_f32_16x16x128_f8f6f4(PG8_CAT(Bt[n][0], Bt[n][1]), PG8_CAT(At[m][0], At[m][1]), acc[ai][bj][m][n], 0, 0, 0, g.sw, 0, g.sa); } else { \
        _Pragma("unroll") for (int m = 0; m < 4; ++m) _Pragma("unroll") for (int n = 0; n < 2; ++n) _Pragma("unroll") for (int k = 0; k < 2; ++k) \
        acc[ai][bj][m][n] = __builtin_amdgcn_mfma_f32_16x16x32_bf16(Bt[n][k], At[m][k], acc[ai][bj][m][n], 0, 0, 0); } __builtin_amdgcn_s_setprio(0); } while (0)
#define PG8_WAIT_V(n) asm volatile("s_waitcnt vmcnt(" #n ")" ::: "memory")
#define PG8_WAIT_L(n) asm volatile("s_waitcnt lgkmcnt(" #n ")" ::: "memory")
#define PG8_BAR __builtin_amdgcn_s_barrier()
#define PG8_SCHED __builtin_amdgcn_sched_barrier(0)
    Unit cur, nxt; int ui = 0;
    if (!S.next(0, cur)) return;
    f32x4 acc[2][2][4][2];
#pragma unroll
    for (int a = 0; a < 2; ++a)
#pragma unroll
        for (int b = 0; b < 2; ++b)
#pragma unroll
            for (int m = 0; m < 4; ++m)
#pragma unroll
                for (int n = 0; n < 2; ++n) acc[a][b][m][n] = (f32x4){0.f, 0.f, 0.f, 0.f};
    bf16x8 At[4][2], B0[2][2], B1[2][2];
    unsigned cA = S.a_off(cur), cB = S.b_off(cur);
    if constexpr (SP2) {
        PG8_STAGE(PG8_SB(0, 0), cB, voffB); PG8_STAGE(PG8_SB(0, 1), cB + hstepB, voffB); PG8_STAGE(PG8_SA(0, 0), cA, voffA); PG8_STAGE(PG8_SA(0, 1), cA + hstepA, voffA);
        if (wr == 1) PG8_BAR;
        PG8_WAIT_V(2); PG8_BAR;
        PG8_STAGE(PG8_SB(1, 0), cB + kstep, voffB); PG8_STAGE(PG8_SA(1, 0), cA + kstep, voffA); PG8_STAGE(PG8_SB(1, 1), cB + hstepB + kstep, voffB);
        PG8_WAIT_V(6); PG8_BAR;
    } else {
        PG8_STAGE(PG8_SB(0, 0), cB, voffB); PG8_STAGE(PG8_SA(0, 0), cA, voffA); PG8_STAGE(PG8_SB(0, 1), cB + hstepB, voffB); PG8_STAGE(PG8_SA(0, 1), cA + hstepA, voffA);
        if (wr == 1) PG8_BAR;
        PG8_WAIT_V(4); PG8_BAR;
        PG8_STAGE(PG8_SB(1, 0), cB + kstep, voffB); PG8_STAGE(PG8_SA(1, 0), cA + kstep, voffA); PG8_STAGE(PG8_SB(1, 1), cB + hstepB + kstep, voffB);
        PG8_WAIT_V(6); PG8_BAR;
    }
    for (;;) {
        const bool has_next = S.next(ui + 1, nxt);
        const unsigned nA = has_next ? S.a_off(nxt) : cA, nB = has_next ? S.b_off(nxt) : cB;
#pragma nounroll
        for (int t = 0; t < nt; t += 2) {
            const bool last = (t == nt - 2);
            const unsigned a1 = cA + (unsigned)(t + 1) * kstep;
            const unsigned a2 = last ? nA : cA + (unsigned)(t + 2) * kstep, b2 = last ? nB : cB + (unsigned)(t + 2) * kstep;
            const unsigned a3 = a2 + kstep, b3 = b2 + kstep;
            if constexpr (SP2) {
            PG8_LDB(B0, 0, 0); PG8_LDB(B1, 0, 1); PG8_SCHED; PG8_LDA(At, 0, 0); PG8_STAGE(PG8_SA(1, 1), a1 + hstepA, voffA);
            PG8_WAIT_V(8); PG8_WAIT_L(0); PG8_BAR; PG8_MMA(0, 0, At, B0); PG8_MMA(0, 1, At, B1); PG8_BAR; PG8_SCHED;
            PG8_LDA(At, 0, 1); PG8_STAGE(PG8_SB(0, 0), b2, voffB); PG8_STAGE(PG8_SB(0, 1), b2 + hstepB, voffB); PG8_STAGE(PG8_SA(0, 0), a2, voffA);
            PG8_WAIT_V(8); PG8_WAIT_L(0); PG8_BAR; PG8_MMA(1, 0, At, B0); PG8_MMA(1, 1, At, B1); PG8_BAR; PG8_SCHED;
            PG8_LDB(B0, 1, 0); PG8_LDB(B1, 1, 1); PG8_SCHED; PG8_LDA(At, 1, 0); PG8_STAGE(PG8_SA(0, 1), a2 + hstepA, voffA);
            PG8_WAIT_V(8); PG8_WAIT_L(0); PG8_BAR; PG8_MMA(0, 0, At, B0); PG8_MMA(0, 1, At, B1); PG8_BAR; PG8_SCHED;
            PG8_LDA(At, 1, 1); PG8_STAGE(PG8_SB(1, 0), b3, voffB); PG8_STAGE(PG8_SB(1, 1), b3 + hstepB, voffB); PG8_STAGE(PG8_SA(1, 0), a3, voffA);
            PG8_WAIT_V(8); PG8_WAIT_L(0); PG8_BAR; PG8_MMA(1, 0, At, B0); PG8_MMA(1, 1, At, B1); PG8_BAR; PG8_SCHED;
            } else {
            PG8_LDB(B0, 0, 0); PG8_SCHED; PG8_LDA(At, 0, 0); PG8_STAGE(PG8_SA(1, 1), a1 + hstepA, voffA);
            PG8_WAIT_L(8); PG8_BAR; PG8_WAIT_L(0); PG8_MMA(0, 0, At, B0); PG8_BAR; PG8_SCHED;
            PG8_LDB(B1, 0, 1); PG8_STAGE(PG8_SB(0, 0), b2, voffB);
            PG8_BAR; PG8_WAIT_L(0); PG8_MMA(0, 1, At, B1); PG8_BAR;
            PG8_LDA(At, 0, 1); PG8_STAGE(PG8_SA(0, 0), a2, voffA);
            PG8_BAR; PG8_WAIT_L(0); PG8_MMA(1, 0, At, B0); PG8_BAR; PG8_SCHED;
            PG8_STAGE(PG8_SB(0, 1), b2 + hstepB, voffB);
            PG8_WAIT_V(6); PG8_BAR; PG8_MMA(1, 1, At, B1); PG8_BAR;
            PG8_LDB(B0, 1, 0); PG8_SCHED; PG8_LDA(At, 1, 0); PG8_STAGE(PG8_SA(0, 1), a2 + hstepA, voffA);
            PG8_WAIT_L(8); PG8_BAR; PG8_WAIT_L(0); PG8_MMA(0, 0, At, B0); PG8_BAR; PG8_SCHED;
            PG8_LDB(B1, 1, 1); PG8_STAGE(PG8_SB(1, 0), b3, voffB);
            PG8_BAR; PG8_WAIT_L(0); PG8_MMA(0, 1, At, B1); PG8_BAR;
            PG8_LDA(At, 1, 1); PG8_STAGE(PG8_SA(1, 0), a3, voffA);
            PG8_BAR; PG8_WAIT_L(0); PG8_MMA(1, 0, At, B0); PG8_BAR; PG8_SCHED;
            PG8_STAGE(PG8_SB(1, 1), b3 + hstepB, voffB);
            PG8_WAIT_V(6); PG8_BAR; PG8_MMA(1, 1, At, B1); PG8_BAR;
            }
        }
        if constexpr (ALIGN_EPI) { if (wr == 0) PG8_BAR; }
        { int fr_e = fr, fq_e = fq; asm volatile("" : "+v"(fr_e), "+v"(fq_e));
          E(acc, cur, wr, wc, fr_e, fq_e); }
        if (!has_next) break;
#pragma unroll
        for (int a = 0; a < 2; ++a)
#pragma unroll
            for (int b = 0; b < 2; ++b)
#pragma unroll
                for (int m = 0; m < 4; ++m)
#pragma unroll
                    for (int n = 0; n < 2; ++n) acc[a][b][m][n] = (f32x4){0.f, 0.f, 0.f, 0.f};
        cur = nxt; cA = nA; cB = nB; ++ui;
        if constexpr (ALIGN_EPI) { if (wr == 1) PG8_BAR; }
    }
    PG8_WAIT_V(0);
    if constexpr (!ALIGN_EPI) { if (wr == 0) PG8_BAR; }
    PG8_BAR;
#undef PG8_SA
#undef PG8_SB
#undef PG8_STAGE
#undef p2voffA
#undef p2voffB
#undef PG8_LDA
#undef PG8_LDB
#undef PG8_MMA
#undef PG8_CAT
#undef PG8_WAIT_V
#undef PG8_WAIT_L
#undef PG8_BAR
#undef PG8_SCHED
}
}
using pg8::Unit;

constexpr size_t MiB = 1u << 20;
constexpr size_t WS_CTL = 0, CTL_ZERO_BYTES = 1 * MiB;
constexpr size_t WS_WIN = 1 * MiB;
constexpr size_t WS_WQ = 7 * MiB;
constexpr size_t WS_WKV = WS_WQ + 512 * 1024;
constexpr size_t WS_WPOOL = 8 * MiB;
constexpr size_t WS_WAO = 9 * MiB;
constexpr size_t WS_WPO = 10 * MiB;
constexpr size_t WS_WO = 11 * MiB;
constexpr size_t WS_WPG = 13 * MiB;
constexpr size_t WS_WPLE = 15 * MiB;
constexpr size_t WS_WGU = 16 * MiB;
constexpr size_t WS_WD = 144 * MiB;
constexpr size_t WS_HN = 208 * MiB;
constexpr size_t WS_PROJ = 240 * MiB;
constexpr size_t WS_GATES = 272 * MiB;
constexpr size_t WS_A2 = 336 * MiB;
constexpr size_t WS_POOLED = 352 * MiB;
constexpr size_t WS_Q = 368 * MiB;
constexpr size_t WS_K = 392 * MiB;
constexpr size_t WS_V = 416 * MiB;
constexpr size_t WS_ATT = 432 * MiB;
constexpr size_t WS_MIXED = 448 * MiB;
constexpr size_t WS_MIX = 464 * MiB;
constexpr size_t WS_PB = 496 * MiB;
constexpr size_t WS_E = 504 * MiB;
constexpr size_t WS_SSQ = 536 * MiB;
constexpr size_t WS_COS = 537 * MiB;
constexpr size_t WS_SIN = 538 * MiB;
constexpr size_t WS_ROUTE = 539 * MiB;
constexpr size_t WS_XS = 544 * MiB;
constexpr size_t WS_ACT = 688 * MiB;
constexpr size_t WS_XS2 = 768 * MiB;
constexpr size_t WS_END = 848 * MiB;
constexpr int CW_BAR = 4096;
constexpr int CW_CNT = 1024;

constexpr int RING_BYTES = 131072;
constexpr int LDS_BYTES = 163840;
constexpr int MISC_OFF = LDS_BYTES - 512;
constexpr int TILE_E_OFF = LDS_BYTES - 4096;
constexpr int NWAVES = 8;

typedef GAS unsigned gu32;
#define RLX_AGENT __ATOMIC_RELAXED, __HIP_MEMORY_SCOPE_AGENT
#define XB_TMO      128
#define XB_XCNT(j)  (256  + 64 * (j))
#define XB_XSUB(j)  (1280 + 64 * (j))
#define XB_XGEN(j)  (2304 + 64 * (j))
#define XB_TOP      3328
#define XB_TOPGEN   3392
#define XCD_BAR_WORDS 3456
#define XB_SPIN_CAP (1u << 18)
__device__ __forceinline__ unsigned xb_ld(unsigned* p)              { return __hip_atomic_load(p, __ATOMIC_RELAXED, __HIP_MEMORY_SCOPE_AGENT); }
__device__ __forceinline__ unsigned xb_add(unsigned* p, unsigned v) { return __hip_atomic_fetch_add(p, v, __ATOMIC_RELAXED, __HIP_MEMORY_SCOPE_AGENT); }
__device__ __forceinline__ unsigned xb_xcc_id() { return (unsigned)__builtin_amdgcn_s_getreg((3 << 11) | 20) & 0xFu; }
#define XB_SPIN(cond, bar) do { unsigned _sp = 0; while (cond) { __builtin_amdgcn_s_sleep(1); \
    if ((++_sp & 255u) == 0u) { if (xb_ld(&(bar)[XB_TMO])) break; if (_sp > XB_SPIN_CAP) { atomicAdd(&(bar)[XB_TMO], 1u); break; } } } } while (0)
struct XcdBarrier { unsigned* bar; unsigned x; volatile LAS unsigned* st; };
__device__ __forceinline__ XcdBarrier xcd_barrier_post(unsigned* bar, volatile LAS unsigned* st) {
    XcdBarrier b; b.bar = bar; b.x = xb_xcc_id(); b.st = st;
    if (threadIdx.x == 0) (void)xb_add(&bar[XB_XCNT(b.x)], 1u);
    return b;
}
__device__ __forceinline__ void xcd_barrier_complete(unsigned* bar, unsigned x, unsigned& nloc, unsigned& nx) {
    const unsigned G = gridDim.x * gridDim.y * gridDim.z;
    unsigned sum, cnt, mine, sp = 0u;
    for (;;) {
        sum = 0u; cnt = 0u; mine = 0u;
#pragma unroll
        for (unsigned j = 0; j < 16; ++j) { const unsigned c = xb_ld(&bar[XB_XCNT(j)]); sum += c; cnt += (c > 0u) ? 1u : 0u; mine = (j == x) ? c : mine; }
        if (sum == G) break;
        __builtin_amdgcn_s_sleep(1);
        if ((++sp & 255u) == 0u) { if (xb_ld(&bar[XB_TMO])) break; if (sp > XB_SPIN_CAP) { atomicAdd(&bar[XB_TMO], 1u); break; } }
    }
    nloc = mine > 0u ? mine : 1u; nx = cnt > 0u ? cnt : 1u;
}
__device__ __forceinline__ void xcd_barrier(const XcdBarrier& b) {
    asm volatile("s_waitcnt vmcnt(0)" ::: "memory");
    __syncthreads();
    if (threadIdx.x == 0) {
        unsigned* bar = b.bar;
        __builtin_amdgcn_s_waitcnt(0);
        unsigned nloc = b.st[0], nx = b.st[1];
        if (nloc == 0u) { xcd_barrier_complete(bar, b.x, nloc, nx); b.st[0] = nloc; b.st[1] = nx; }
        const unsigned old = xb_add(&bar[XB_XSUB(b.x)], 1u);
        const unsigned gen = old / nloc;
        if (old + 1u == (gen + 1u) * nloc) {
            __builtin_amdgcn_fence(__ATOMIC_RELEASE, "agent");
            asm volatile("s_waitcnt vmcnt(0)" ::: "memory");
            const unsigned og = xb_add(&bar[XB_TOP], 1u);
            const unsigned tg = og / nx;
            if (og + 1u == (tg + 1u) * nx) xb_add(&bar[XB_TOPGEN], 1u);
            else XB_SPIN(xb_ld(&bar[XB_TOPGEN]) == tg, bar);
            __builtin_amdgcn_fence(__ATOMIC_ACQUIRE, "agent");
            xb_add(&bar[XB_XGEN(b.x)], 1u);
            asm volatile("s_waitcnt vmcnt(0)" ::: "memory");
        } else {
            XB_SPIN(xb_ld(&bar[XB_XGEN(b.x)]) == gen, bar);
            __builtin_amdgcn_fence(__ATOMIC_ACQUIRE, "agent");
            asm volatile("s_waitcnt vmcnt(0)" ::: "memory");
        }
    }
    __syncthreads();
}

struct Args {
    const float* in[27];
    float* out; unsigned char* ws;
    int ph_lo, ph_hi;
};
typedef const __attribute__((address_space(4))) Args* KArgs;
__device__ __forceinline__ KArgs kargs() { KArgs p = (KArgs)__builtin_amdgcn_kernarg_segment_ptr(); asm volatile("" : "+s"(p)); return p; }
enum { I_X = 0, I_P, I_POS, I_GMIX, I_WIN, I_GQLAT, I_WQB, I_GKVLAT, I_WKVB, I_GQHEAD, I_GKNOPE, I_GKROPE, I_WPOOL, I_PSCALE, I_WAO, I_WPO, I_WO, I_GFFN,
       I_WR, I_BR, I_WGU, I_BGU, I_WD, I_BD, I_GPLE, I_WPG, I_WPLE };

enum { MAP_ID = 0, MAP_WIN, MAP_GU, MAP_QB, MAP_KVB };
__device__ __forceinline__ int map_row(int mode, int n) {
    switch (mode) {
    case MAP_WIN: return n < 416 ? n : n + 96;
    case MAP_GU: { const int j = n & 1023, up = n >> 10; return 256 * (j >> 7) + 128 * up + (j & 127); }
    case MAP_QB: { const int h = n / 96, d = n % 96;
        if (d < 64) return (h >> 2) * 256 + 128 * (d >> 5) + 32 * (h & 3) + (d & 31);
        const int dd = d - 64, half = dd >> 4, i = dd & 15; return 512 + 128 * (h & 1) + 32 * (h >> 1) + 8 * (i >> 2) + 4 * half + (i & 3); }
    case MAP_KVB: { const int h = n >> 7, c = n & 127, isv = c >> 6, d = c & 63; return (h >> 1) * 256 + 128 * (d >> 5) + 32 * (2 * isv + (h & 1)) + (d & 31); }
    default: return n;
    }
}
struct TJob { const float* W; int K, N; bf16_t* WT; int ldw, koff, mode, row_off; const float* gk; const float* gn; int nmat; size_t wstride, wtstride; int fp8; };
struct TItem { const float* src; bf16_t* dst; int n0, k0; float gnv; };
__device__ __forceinline__ TItem titem_setup(const TJob& J, int item, int lane) {
    const int nblk = J.N / 32, ipm = (J.K / 64) * nblk, mat = item / ipm, it = item - mat * ipm, kb = it / nblk, nb = it - kb * nblk;
    TItem I; I.k0 = 64 * kb; I.n0 = 32 * nb;
    I.src = J.W + (size_t)mat * J.wstride + (size_t)(I.k0 + (lane >> 5)) * J.N + I.n0 + (lane & 31);
    I.dst = (bf16_t*)((unsigned char*)J.WT + (size_t)mat * J.wtstride * (J.fp8 ? 1 : 2));
    I.gnv = J.gn ? J.gn[I.n0 + (lane & 31)] : 1.f;
    return I;
}
__device__ __forceinline__ void titem_load(const TJob& J, const TItem& I, float (&v)[32]) {
#pragma unroll
    for (int i = 0; i < 32; ++i) v[i] = I.src[(size_t)(2 * i) * J.N];
}
__device__ __forceinline__ void titem_store(const TJob& J, const TItem& I, float (&v)[32], LAS float* scr, int lane) {
#pragma unroll
    for (int i = 0; i < 32; ++i) { const int kk = 2 * i + (lane >> 5); float x = v[i] * I.gnv; if (J.gk) x *= J.gk[I.k0 + kk]; scr[kk * 33 + (lane & 31)] = x; }
    asm volatile("s_waitcnt lgkmcnt(0)" ::: "memory");
    const int c = lane & 7;
#pragma unroll
    for (int j = 0; j < 4; ++j) { const int n = (lane >> 3) + 8 * j; const LAS float* s = scr + (8 * c) * 33 + n;
        const size_t eo = (size_t)(J.row_off + map_row(J.mode, I.n0 + n)) * J.ldw + J.koff + I.k0 + 8 * c;
        if (J.fp8) { u32x2 o; int w = __builtin_amdgcn_cvt_pk_fp8_f32(s[0 * 33] * 8.f, s[1 * 33] * 8.f, 0, false); w = __builtin_amdgcn_cvt_pk_fp8_f32(s[2 * 33] * 8.f, s[3 * 33] * 8.f, w, true); o.x = (unsigned)w;
            w = __builtin_amdgcn_cvt_pk_fp8_f32(s[4 * 33] * 8.f, s[5 * 33] * 8.f, 0, false); w = __builtin_amdgcn_cvt_pk_fp8_f32(s[6 * 33] * 8.f, s[7 * 33] * 8.f, w, true); o.y = (unsigned)w;
            *(u32x2*)((unsigned char*)I.dst + eo) = o; }
        else { u32x4 o; o.x = cvt_pk_bf16(s[0 * 33], s[1 * 33]); o.y = cvt_pk_bf16(s[2 * 33], s[3 * 33]); o.z = cvt_pk_bf16(s[4 * 33], s[5 * 33]); o.w = cvt_pk_bf16(s[6 * 33], s[7 * 33]);
            *(u32x4*)(I.dst + eo) = o; } }
    asm volatile("s_waitcnt lgkmcnt(0)" ::: "memory");
}
__device__ __forceinline__ void run_job(const TJob& J, LAS float* scr, int gw, int NGW, int lane) {
    const int items = J.nmat * (J.K / 64) * (J.N / 32);
    for (int it = gw; it < items; it += 2 * NGW) {
        const bool two = (it + NGW) < items;
        const TItem I0 = titem_setup(J, it, lane); const TItem I1 = titem_setup(J, two ? it + NGW : it, lane);
        float v0[32], v1[32];
        titem_load(J, I0, v0); if (two) titem_load(J, I1, v1);
        titem_store(J, I0, v0, scr, lane); if (two) titem_store(J, I1, v1, scr, lane);
    }
}

struct Frame {
    LAS unsigned char* lds; volatile LAS unsigned* MISC; unsigned* ctl;
    int wave, vcu, G;
    float* out; unsigned char* ws;
};

__device__ __forceinline__ void p0_prologue(const Frame& F) {
    const int tid_l = tid_local(), lane_l = tid_l & 63; (void)tid_l; (void)lane_l;
    const KArgs a = kargs();
    LAS float* scr = (LAS float*)(F.lds + F.wave * 16384);
    const int gw = F.vcu * NWAVES + F.wave, NGW = F.G * NWAVES;
    unsigned char* ws = F.ws;
#define RUN_JOB(...) do { const TJob J_ = TJob{__VA_ARGS__, 1, 0, 0, 0}; run_job(J_, scr, gw, NGW, lane_l); } while (0)
    RUN_JOB(a->in[I_WIN], 1024, 2976, (bf16_t*)(ws + WS_WIN), 1024, 0, MAP_WIN, 0, nullptr, nullptr);
    RUN_JOB(a->in[I_WQB], 256, 768, (bf16_t*)(ws + WS_WQ), 256, 0, MAP_QB, 0, a->in[I_GQLAT], nullptr);
    RUN_JOB(a->in[I_WKVB], 128, 1024, (bf16_t*)(ws + WS_WKV), 256, 0, MAP_KVB, 0, a->in[I_GKVLAT], nullptr);
    RUN_JOB(a->in[I_WAO], 512, 1024, (bf16_t*)(ws + WS_WAO), 512, 0, MAP_ID, 0, nullptr, nullptr);
    RUN_JOB(a->in[I_WPO], 512, 1024, (bf16_t*)(ws + WS_WPO), 512, 0, MAP_ID, 0, nullptr, nullptr);
    RUN_JOB(a->in[I_WO], 1024, 1024, (bf16_t*)(ws + WS_WO), 1024, 0, MAP_ID, 0, nullptr, nullptr);
    RUN_JOB(a->in[I_WPG], 1024, 1024, (bf16_t*)(ws + WS_WPG), 1024, 0, MAP_ID, 0, nullptr, nullptr);
    RUN_JOB(a->in[I_WPLE], 256, 1024, (bf16_t*)(ws + WS_WPLE), 256, 0, MAP_ID, 0, nullptr, nullptr);
    for (int g = 0; g < 4; ++g)
        RUN_JOB(a->in[I_WPOOL] + (size_t)g * 128 * 128, 128, 128, (bf16_t*)(ws + WS_WPOOL) + (size_t)(g >> 1) * 256 * 256, 256, 128 * (g & 1), MAP_ID, 128 * (g & 1), nullptr, a->in[I_PSCALE] + 128 * g);
    {
        const int gt = (F.vcu * NWAVES + F.wave) * 64 + lane_l, NGT = NGW * 64;
        const u32x4 z = {0u, 0u, 0u, 0u};
        u32x4* w0 = (u32x4*)((bf16_t*)(ws + WS_WIN) + (size_t)416 * 1024);
        for (int i = gt; i < 96 * 128; i += NGT) w0[i] = z;
        for (int i = gt; i < 1024 * 16; i += NGT) { const int r = i >> 4, c = i & 15; *(u32x4*)((bf16_t*)(ws + WS_WKV) + (size_t)r * 256 + 128 + 8 * c) = z; }
        for (int i = gt; i < 2 * 256 * 16; i += NGT) { const int p = i >> 12, r = (i >> 4) & 255, c = i & 15;
            const int k0 = (r < 128) ? 128 : 0; *(u32x4*)((bf16_t*)(ws + WS_WPOOL) + (size_t)p * 65536 + (size_t)r * 256 + k0 + 8 * c) = z; }
    }
#ifndef CONV_IN_ATTN
#define CONV_IN_ATTN 1
#endif
    if (!CONV_IN_ATTN) {
    { const TJob J{a->in[I_WGU], 1024, 2048, (bf16_t*)(ws + WS_WGU), 1024, 0, MAP_GU, 0, nullptr, nullptr, NEXP, (size_t)1024 * 2048, (size_t)2048 * 1024, 1}; run_job(J, scr, gw, NGW, lane_l); }
    { const TJob J{a->in[I_WD], 1024, 1024, (bf16_t*)(ws + WS_WD), 1024, 0, MAP_ID, 0, nullptr, nullptr, NEXP, (size_t)1024 * 1024, (size_t)1024 * 1024, 1}; run_job(J, scr, gw, NGW, lane_l); }
    }
    const float* x = a->in[I_X]; const float* gm = a->in[I_GMIX];
    f32x4 gv[4];
#pragma unroll
    for (int j = 0; j < 4; ++j) gv[j] = *(const f32x4*)(gm + 4 * lane_l + 256 * j);
    for (int m = gw; m < T; m += NGW) {
        const f32x4* xr = (const f32x4*)(x + (size_t)m * DM) + lane_l;
        f32x4 v[4]; float s = 0.f;
#pragma unroll
        for (int j = 0; j < 4; ++j) { v[j] = xr[64 * j]; s += (v[j].x * v[j].x + v[j].y * v[j].y) + (v[j].z * v[j].z + v[j].w * v[j].w); }
        const float rstd = 1.0f / sqrtf(wave_sum(s) * (1.f / DM) + EPS);
        u32x2* o8 = (u32x2*)((bf16_t*)(ws + WS_HN) + (size_t)m * DM) + lane_l;
#pragma unroll
        for (int j = 0; j < 4; ++j) { u32x2 w; w.x = cvt_pk_bf16(v[j].x * rstd * gv[j].x, v[j].y * rstd * gv[j].y); w.y = cvt_pk_bf16(v[j].z * rstd * gv[j].z, v[j].w * rstd * gv[j].w); o8[64 * j] = w; }
    }
    {
        const float* p = a->in[I_P];
        for (int m = gw; m < T; m += NGW) { const f32x4 v = *((const f32x4*)(p + (size_t)m * PLE) + lane_l); u32x2 w; w.x = cvt_pk_bf16(v.x, v.y); w.y = cvt_pk_bf16(v.z, v.w);
            *((u32x2*)((bf16_t*)(ws + WS_PB) + (size_t)m * PLE) + lane_l) = w; }
    }
}

struct DenseOrder {
    int nM, nN, nwg, G, c; unsigned A, B, tA, tB, aPn;
    __device__ void init(int nM_, int nN_, int G_, int c_, size_t A_, size_t lda, size_t B_, size_t ldb, unsigned aPn_ = 0) { nM = nM_; nN = nN_; nwg = nM * nN; G = G_; c = c_; A = (unsigned)A_; B = (unsigned)B_; tA = (unsigned)(256 * lda * 2); tB = (unsigned)(256 * ldb * 2); aPn = aPn_; }
    __device__ __forceinline__ bool next(int i, Unit& u) const {
        const long L = (long)i * G + c; if (L >= nwg) return false;
        int wgid = (int)L; { const int q = nwg / 8, r = nwg % 8, xcd = wgid % 8, off = wgid / 8; wgid = (xcd < r ? xcd * (q + 1) : r * (q + 1) + (xcd - r) * q) + off; }
        const int WGM = 8; const int nig = WGM * nN, gid = wgid / nig, fm = gid * WGM, gsz = (nM - fm) < WGM ? (nM - fm) : WGM;
        u.pm = fm + ((wgid % nig) % gsz); u.pn = (wgid % nig) / gsz; u.aux = 0; return true;
    }
    __device__ __forceinline__ unsigned a_off(const Unit& u) const { return A + (unsigned)u.pm * tA + (unsigned)u.pn * aPn; }
    __device__ __forceinline__ unsigned b_off(const Unit& u) const { return B + (unsigned)u.pn * tB; }
};

struct EpiBf16 {
    static constexpr bool PERM = true;
    bf16_t* O; int ldc;
    __device__ __forceinline__ void operator()(const f32x4 (&acc)[2][2][4][2], const Unit& u, int wr, int wc, int fr, int fq) const {
        const int row0 = u.pm * 256 + wr * 64 + fr, col0 = u.pn * 256 + wc * 32 + 8 * fq;
#pragma unroll
        for (int ai = 0; ai < 2; ++ai)
#pragma unroll
            for (int m = 0; m < 4; ++m) { bf16_t* rowp = O + (size_t)(row0 + ai * 128 + m * 16) * ldc + col0;
#pragma unroll
                for (int bj = 0; bj < 2; ++bj) { const f32x4 v0 = acc[ai][bj][m][0], v1 = acc[ai][bj][m][1];
                    u32x4 w; w.x = cvt_pk_bf16(v0[0], v0[1]); w.y = cvt_pk_bf16(v0[2], v0[3]); w.z = cvt_pk_bf16(v1[0], v1[1]); w.w = cvt_pk_bf16(v1[2], v1[3]);
                    *(u32x4*)(rowp + bj * 128) = w; } }
    }
};
struct EpiProj {
    static constexpr bool PERM = true;
    bf16_t* PROJ; bf16_t* GATES;
    __device__ __forceinline__ void operator()(const f32x4 (&acc)[2][2][4][2], const Unit& u, int wr, int wc, int fr, int fq) const {
        const int row0 = u.pm * 256 + wr * 64 + fr; const bool isg = u.pn >= 4;
        bf16_t* O = isg ? GATES : PROJ; const int ldc = isg ? 2048 : 1024; const int col0 = (isg ? u.pn - 4 : u.pn) * 256 + wc * 32 + 8 * fq;
#pragma unroll
        for (int ai = 0; ai < 2; ++ai)
#pragma unroll
            for (int m = 0; m < 4; ++m) { bf16_t* rowp = O + (size_t)(row0 + ai * 128 + m * 16) * ldc + col0;
#pragma unroll
                for (int bj = 0; bj < 2; ++bj) { f32x4 v0 = acc[ai][bj][m][0], v1 = acc[ai][bj][m][1];
                    if (isg) {
#pragma unroll
                        for (int e = 0; e < 4; ++e) { v0[e] = fast_sigmoid(v0[e]); v1[e] = fast_sigmoid(v1[e]); } }
                    u32x4 w; w.x = cvt_pk_bf16(v0[0], v0[1]); w.y = cvt_pk_bf16(v0[2], v0[3]); w.z = cvt_pk_bf16(v1[0], v1[1]); w.w = cvt_pk_bf16(v1[2], v1[3]);
                    *(u32x4*)(rowp + bj * 128) = w; } asm volatile("" ::: "memory"); }
    }
};

__device__ __forceinline__ void p2_rows(const Frame& F) {
    const int tid_l = tid_local(), lane_l = tid_l & 63; (void)tid_l; (void)lane_l;
    const KArgs a = kargs();
    const int gw = F.vcu * NWAVES + F.wave, NGW = F.G * NWAVES, lane = lane_l;
    unsigned char* ws = F.ws;
    const bf16_t* PROJ = (const bf16_t*)(ws + WS_PROJ);
    bf16_t* A2 = (bf16_t*)(ws + WS_A2); bf16_t* POOLED = (bf16_t*)(ws + WS_POOLED); bf16_t* Kb = (bf16_t*)(ws + WS_K);
    float* COS = (float*)(ws + WS_COS); float* SIN = (float*)(ws + WS_SIN);
    const int* positions = (const int*)a->in[I_POS];
    const float gkr = (lane < 32) ? a->in[I_GKROPE][lane] : 0.f;
    const float inv_freq = __builtin_amdgcn_exp2f(-(float)(lane & 15) * (13.287712379549449f / 16.0f));
    const int w = 2 << (lane >> 4);
    for (int task = gw; task < T / 8; task += NGW) {
        const int t0 = task * 8, b = t0 / SEQ, s0 = t0 % SEQ;
        {
            const bf16_t* base = PROJ + (size_t)(b * SEQ) * 1024 + 512 + 8 * lane;
            float S[8];
#pragma unroll
            for (int j = 0; j < 8; ++j) S[j] = 0.f;
            for (int r = s0 - 15; r < s0; ++r) {
                if (r >= 0 && r >= s0 - w + 1) { const u32x4 v = *(const u32x4*)(base + (size_t)r * 1024);
                    S[0] += bf_lo(v.x); S[1] += bf_hi(v.x); S[2] += bf_lo(v.y); S[3] += bf_hi(v.y); S[4] += bf_lo(v.z); S[5] += bf_hi(v.z); S[6] += bf_lo(v.w); S[7] += bf_hi(v.w); }
            }
#pragma unroll
            for (int i = 0; i < 8; ++i) {
                const int s = s0 + i;
                const u32x4 v = *(const u32x4*)(base + (size_t)s * 1024);
                float uu[8] = {bf_lo(v.x), bf_hi(v.x), bf_lo(v.y), bf_hi(v.y), bf_lo(v.z), bf_hi(v.z), bf_lo(v.w), bf_hi(v.w)};
                const int cnt = (s + 1 < w) ? s + 1 : w; const float ic = 1.0f / (float)cnt;
                float o[8];
#pragma unroll
                for (int j = 0; j < 8; ++j) { S[j] += uu[j]; o[j] = S[j] * ic - uu[j]; }
                u32x4 wv; wv.x = cvt_pk_bf16(o[0], o[1]); wv.y = cvt_pk_bf16(o[2], o[3]); wv.z = cvt_pk_bf16(o[4], o[5]); wv.w = cvt_pk_bf16(o[6], o[7]);
                *(u32x4*)(POOLED + (size_t)(t0 + i) * 512 + 8 * lane) = wv;
                const int rr = s - w + 1;
                if (rr >= 0) { const u32x4 q = *(const u32x4*)(base + (size_t)rr * 1024);
                    S[0] -= bf_lo(q.x); S[1] -= bf_hi(q.x); S[2] -= bf_lo(q.y); S[3] -= bf_hi(q.y); S[4] -= bf_lo(q.z); S[5] -= bf_hi(q.z); S[6] -= bf_lo(q.w); S[7] -= bf_hi(q.w); }
            }
        }
        for (int i = 0; i < 8; ++i) {
            const int t = t0 + i, s = s0 + i;
            const bf16_t* pr = PROJ + (size_t)t * 1024;
            const u32x2 ql = *(const u32x2*)(pr + 4 * lane);
            const unsigned kvl = *(const unsigned*)(pr + 256 + 2 * lane);
            const float krv = (lane < 32) ? bf1(pr[384 + lane]) : 0.f;
            const float q0 = bf_lo(ql.x), q1 = bf_hi(ql.x), q2 = bf_lo(ql.y), q3 = bf_hi(ql.y);
            const float k0 = bf_lo(kvl), k1 = bf_hi(kvl);
            const float sq = wave_sum((q0 * q0 + q1 * q1) + (q2 * q2 + q3 * q3));
            const float sk = wave_sum(k0 * k0 + k1 * k1);
            const float sr = wave_sum(krv * krv);
            const float rq = 1.0f / sqrtf(sq * (1.f / 256.f) + EPS), rk = 1.0f / sqrtf(sk * (1.f / 128.f) + EPS), rr = 1.0f / sqrtf(sr * (1.f / 32.f) + EPS);
            u32x2 wq; wq.x = cvt_pk_bf16(q0 * rq, q1 * rq); wq.y = cvt_pk_bf16(q2 * rq, q3 * rq);
            *(u32x2*)(A2 + (size_t)t * 512 + 4 * lane) = wq;
            *(unsigned*)(A2 + (size_t)t * 512 + 256 + 2 * lane) = cvt_pk_bf16(k0 * rk, k1 * rk);
            *(unsigned*)(A2 + (size_t)t * 512 + 384 + 2 * lane) = 0u;
            const float pos = (float)positions[t];
            const float ang = pos * inv_freq;
            const float rev = ang * 0.15915494309189535f;
            const float fr_ = rev - floorf(rev);
            const float sn = __builtin_amdgcn_sinf(fr_), cs = __builtin_amdgcn_cosf(fr_);
            const float kn = krv * rr * gkr;
            const float other = __shfl_xor(kn, 16);
            const float ro = (lane & 16) ? (kn * cs + other * sn) : (kn * cs - other * sn);
            if (lane < 32) {
                const bf16_t rb = (bf16_t)(cvt_pk_bf16(ro, 0.f) & 0xffffu);
#pragma unroll
                for (int h = 0; h < NH; ++h) Kb[((size_t)(b * NH + h) * SEQ + s) * DK + 64 + lane] = rb;
            }
            if (lane < 16) { COS[(size_t)t * 16 + lane] = cs; SIN[(size_t)t * 16 + lane] = sn; }
        }
    }
}

#define EPI_FENCE() asm volatile("" ::: "memory")
struct EpiQ {
    static constexpr bool PERM = true;
    bf16_t* Q; float* SSQ; const float* COS; const float* SIN; const float* gq;
    __device__ __forceinline__ void operator()(const f32x4 (&acc)[2][2][4][2], const Unit& u, int wr, int wc, int fr, int fq) const {
        const int t0 = u.pm * 256 + wr * 64 + fr, b = (u.pm * 256) / SEQ, s0 = t0 - b * SEQ;
        if (u.pn < 2) {
            const int h = 4 * u.pn + wc;
            bf16_t* dst0 = Q + ((size_t)(b * NH + h) * SEQ + s0) * DK + 8 * fq;
            float* ssq0 = SSQ + ((size_t)t0 * NH + h) * 2;
#pragma unroll
            for (int ai = 0; ai < 2; ++ai)
#pragma unroll
                for (int m = 0; m < 4; ++m) {
                    const int dr = ai * 128 + m * 16;
                    float q = 0.f;
#pragma unroll
                    for (int bj = 0; bj < 2; ++bj)
#pragma unroll
                        for (int n = 0; n < 2; ++n) { const f32x4 v = acc[ai][bj][m][n]; q += (v[0] * v[0] + v[1] * v[1]) + (v[2] * v[2] + v[3] * v[3]); }
                    q += __shfl_xor(q, 16); q += __shfl_xor(q, 32);
                    if (fq == 0) ssq0[dr * NH * 2] = q;
#pragma unroll
                    for (int bj = 0; bj < 2; ++bj) { const f32x4 v0 = acc[ai][bj][m][0] * *(const f32x4*)(gq + 32 * bj + 8 * fq), v1 = acc[ai][bj][m][1] * *(const f32x4*)(gq + 32 * bj + 8 * fq + 4);
                        u32x4 w; w.x = cvt_pk_bf16(v0[0], v0[1]); w.y = cvt_pk_bf16(v0[2], v0[3]); w.z = cvt_pk_bf16(v1[0], v1[1]); w.w = cvt_pk_bf16(v1[2], v1[3]);
                        *(u32x4*)(dst0 + dr * DK + 32 * bj) = w; }
                    EPI_FENCE();
                }
        } else {
            const f32x4 g1 = *(const f32x4*)(gq + 64 + 4 * fq), g2 = *(const f32x4*)(gq + 80 + 4 * fq);
            const float* cs0 = COS + (size_t)t0 * 16 + 4 * fq; const float* sn0 = SIN + (size_t)t0 * 16 + 4 * fq;
            bf16_t* dst0 = Q + ((size_t)(b * NH + 2 * wc) * SEQ + s0) * DK + 64 + 4 * fq;
            float* ssq0 = SSQ + ((size_t)t0 * NH + 2 * wc) * 2 + 1;
#pragma unroll
            for (int ai = 0; ai < 2; ++ai)
#pragma unroll
                for (int m = 0; m < 4; ++m) {
                    const int dr = ai * 128 + m * 16;
                    const f32x4 cs = *(const f32x4*)(cs0 + dr * 16), sn = *(const f32x4*)(sn0 + dr * 16);
#pragma unroll
                    for (int bj = 0; bj < 2; ++bj) {
                        const f32x4 x1 = acc[ai][bj][m][0], x2 = acc[ai][bj][m][1];
                        float q = (x1[0] * x1[0] + x1[1] * x1[1]) + (x1[2] * x1[2] + x1[3] * x1[3]) + (x2[0] * x2[0] + x2[1] * x2[1]) + (x2[2] * x2[2] + x2[3] * x2[3]);
                        q += __shfl_xor(q, 16); q += __shfl_xor(q, 32);
                        if (fq == 0) ssq0[dr * NH * 2 + bj * 2] = q;
                        const f32x4 y1 = x1 * g1, y2 = x2 * g2;
                        const f32x4 o1 = y1 * cs - y2 * sn, o2 = y2 * cs + y1 * sn;
                        bf16_t* dst = dst0 + (size_t)bj * SEQ * DK + dr * DK;
                        u32x2 w1, w2; w1.x = cvt_pk_bf16(o1[0], o1[1]); w1.y = cvt_pk_bf16(o1[2], o1[3]); w2.x = cvt_pk_bf16(o2[0], o2[1]); w2.y = cvt_pk_bf16(o2[2], o2[3]);
                        *(u32x2*)(dst) = w1; *(u32x2*)(dst + 16) = w2;
                    }
                    EPI_FENCE();
                }
        }
    }
};
struct EpiKV {
    static constexpr bool PERM = true;
    bf16_t* K; bf16_t* V; const float* gk;
    __device__ __forceinline__ void operator()(const f32x4 (&acc)[2][2][4][2], const Unit& u, int wr, int wc, int fr, int fq) const {
        const int t0 = u.pm * 256 + wr * 64 + fr, b = (u.pm * 256) / SEQ, s0 = t0 - b * SEQ;
        const int h = 2 * u.pn + (wc & 1); const bool isv = wc >= 2;
        const int pitch = isv ? DV : DK;
        bf16_t* dst0 = (isv ? V : K) + ((size_t)(b * NH + h) * SEQ + s0) * pitch + 8 * fq;
#pragma unroll
        for (int ai = 0; ai < 2; ++ai)
#pragma unroll
            for (int m = 0; m < 4; ++m) {
                const int dr = ai * 128 + m * 16;
                float sc = 1.f;
                if (!isv) { float q = 0.f;
#pragma unroll
                    for (int bj = 0; bj < 2; ++bj)
#pragma unroll
                        for (int n = 0; n < 2; ++n) { const f32x4 v = acc[ai][bj][m][n]; q += (v[0] * v[0] + v[1] * v[1]) + (v[2] * v[2] + v[3] * v[3]); }
                    q += __shfl_xor(q, 16); q += __shfl_xor(q, 32);
                    sc = 1.0f / sqrtf(q * (1.f / 64.f) + EPS); }
#pragma unroll
                for (int bj = 0; bj < 2; ++bj) {
                    f32x4 v0 = acc[ai][bj][m][0] * sc, v1 = acc[ai][bj][m][1] * sc;
                    if (!isv) { v0 = v0 * *(const f32x4*)(gk + 32 * bj + 8 * fq); v1 = v1 * *(const f32x4*)(gk + 32 * bj + 8 * fq + 4); }
                    u32x4 w; w.x = cvt_pk_bf16(v0[0], v0[1]); w.y = cvt_pk_bf16(v0[2], v0[3]); w.z = cvt_pk_bf16(v1[0], v1[1]); w.w = cvt_pk_bf16(v1[2], v1[3]);
                    *(u32x4*)(dst0 + dr * pitch + 32 * bj) = w; }
                EPI_FENCE();
            }
    }
};

namespace att {
constexpr int KT_BYTES = 64 * 192, VT_BYTES = 64 * 128, SLOT_BYTES = KT_BYTES + VT_BYTES;
constexpr int NSLOT = 4, SCR_OFF = NSLOT * SLOT_BYTES;
__device__ __forceinline__ int crow(int r, int hi) { return (r & 3) + 8 * (r >> 2) + 4 * hi; }
__device__ __forceinline__ s16x4 vtr(const LAS unsigned char* p) { typedef short v4i16_t __attribute__((ext_vector_type(4)));
    return __builtin_bit_cast(s16x4, __builtin_amdgcn_ds_read_tr16_b64_v4i16((LAS v4i16_t*)p)); }
#define MFMA32(a, b, c) __builtin_amdgcn_mfma_f32_32x32x16_bf16(a, b, c, 0, 0, 0)
__device__ __forceinline__ float max3f(float a, float b, float c) { return __builtin_fmaxf(__builtin_fmaxf(a, b), c); }


constexpr int CONV_OFF = SCR_OFF + 8 * 256, CONV_BYTES = 8192;
constexpr int CV_GU_ITEMS = NEXP * 1024, CV_ITEMS = CV_GU_ITEMS + NEXP * 512;
struct ConvItem { const float* src; unsigned char* dst; int N, isgu, n0; };
__device__ __forceinline__ ConvItem cv_setup(int g, const float* wgu, const float* wd, unsigned char* wgu8, unsigned char* wd8) {
    ConvItem I;
    if (g < CV_GU_ITEMS) { const int e = g >> 10, it = g & 1023, kb = it >> 6, nb = it & 63; I.N = 2048; I.isgu = 1; I.n0 = 32 * nb;
        I.src = wgu + (size_t)e * 1024 * 2048 + (size_t)(64 * kb) * 2048 + 32 * nb; I.dst = wgu8 + (size_t)e * 2048 * 1024 + 64 * kb; }
    else { const int g2 = g - CV_GU_ITEMS, e = g2 >> 9, it = g2 & 511, kb = it >> 5, nb = it & 31; I.N = 1024; I.isgu = 0; I.n0 = 32 * nb;
        I.src = wd + (size_t)e * 1024 * 1024 + (size_t)(64 * kb) * 1024 + 32 * nb; I.dst = wd8 + (size_t)e * 1024 * 1024 + 64 * kb; }
    return I;
}
__device__ __forceinline__ void cv_dma(const ConvItem& I, unsigned ldsaddr, int lane) {
    const int kr = lane >> 3, sl = lane & 7;
#pragma unroll
    for (int q = 0; q < 8; ++q) { const unsigned voff = (unsigned)(((8 * q + kr) * I.N + 4 * (sl ^ ((kr ^ q) & 7))) * 4);
        asm volatile("s_nop 4\n\ts_mov_b32 m0, %0\n\ts_nop 0\n\tglobal_load_lds_dwordx4 %1, %2" :: "s"(ldsaddr + (unsigned)q * 1024u), "v"(voff), "s"(I.src) : "m0", "memory"); }
}
__device__ __forceinline__ void cv_out(const ConvItem& I, const LAS float* cb, int lane) {
    const int c = lane & 7;
#pragma unroll
    for (int j = 0; j < 4; ++j) { const int n = (lane >> 3) + 8 * j, nc = n >> 2, e = n & 3;
        float f[8];
#pragma unroll
        for (int kk = 0; kk < 8; ++kk) f[kk] = cb[(8 * c + kk) * 32 + ((nc ^ kk ^ c) & 7) * 4 + e];
        const int nn = I.n0 + n; const int row = I.isgu ? (256 * ((nn & 1023) >> 7) + 128 * (nn >> 10) + (nn & 127)) : nn;
        *(u32x2*)(I.dst + (size_t)row * 1024 + 8 * c) = cvt8_fp8((f32x4){f[0], f[1], f[2], f[3]}, (f32x4){f[4], f[5], f[6], f[7]}, 8.0f);
        asm volatile("" ::: "memory"); }
}
struct ConvState { int next, end, cur; };
__device__ __forceinline__ void attn_unit(LAS unsigned char* lds, const u32x4 srd, ConvState& CV, unsigned char* cvws, int bh, int qb, const bf16_t* Q, unsigned Koff, unsigned Voff, const float* SSQ, bf16_t* O) {
    const int tid = tid_local(), lane = tid & 63, r32 = lane & 31, hi = lane >> 5; const int wid = __builtin_amdgcn_readfirstlane(tid >> 6);
    const int b = bh / NH, h = bh % NH, q0 = qb * 256, qw = q0 + 32 * wid;
    LAS float* scr = (LAS float*)(lds + SCR_OFF) + wid * 64;
    const int NT = (q0 + 256) / 64;
    const unsigned kS = Koff + (unsigned)bh * (SEQ * DK * 2), vS = Voff + (unsigned)bh * (SEQ * DV * 2);
    const int kc2 = 8 + (wid & 3);
    const unsigned vK1 = (unsigned)(lane * 192 + wid * 16); const unsigned sK2 = (unsigned)((kc2 - wid) * 16);
    const int vkey = 8 * wid + (lane >> 3); const unsigned vV = (unsigned)(vkey * 128 + (((lane & 7) ^ (((vkey >> 1) & 1) * 4)) * 16));
    const unsigned lds0 = (unsigned)__builtin_amdgcn_readfirstlane((int)(unsigned)(unsigned long)lds);
    const unsigned dK1 = (unsigned)wid * 1024u, dK2 = (unsigned)kc2 * 1024u, dV = (unsigned)KT_BYTES + (unsigned)wid * 1024u;
#define ATT_DMA1(ldsaddr, voff, soff) asm volatile("s_nop 4\n\ts_mov_b32 m0, %0\n\ts_nop 0\n\tbuffer_load_dwordx4 %1, %2, %3 offen lds" :: "s"(ldsaddr), "v"(voff), "s"(srd), "s"(soff) : "m0", "memory")
#define ATT_DMA(t) do { const unsigned sp_ = lds0 + (unsigned)((t) & 3) * SLOT_BYTES; const unsigned ks_ = kS + (unsigned)(t) * (64 * 192), vs_ = vS + (unsigned)(t) * (64 * 128); \
        ATT_DMA1(sp_ + dK1, vK1, ks_); ATT_DMA1(sp_ + dK2, vK1, ks_ + sK2); ATT_DMA1(sp_ + dV, vV, vs_); } while (0)
#define ATT_WAITBAR(N) asm volatile("s_waitcnt vmcnt(" #N ") lgkmcnt(0)\n\ts_barrier" ::: "memory")
    bf16x8 qr[6];
    { const float* sp = SSQ + ((size_t)(b * SEQ + qw + r32) * NH + h) * 2; const float ss = sp[0] + sp[1];
      const float cq = (1.0f / sqrtf(ss * (1.f / 96.f) + EPS)) * 0.10206207261596577f * 1.4426950408889634f;
      const bf16_t* qp = Q + ((size_t)bh * SEQ + qw + r32) * DK + 8 * hi;
      u32x4 qw_[6];
#pragma unroll
      for (int d0 = 0; d0 < 6; ++d0) qw_[d0] = *(const u32x4*)(qp + 16 * d0);
#pragma unroll
      for (int d0 = 0; d0 < 6; ++d0) { const u32x4 w = qw_[d0]; u32x4 o;
          o.x = cvt_pk_bf16(bf_lo(w.x) * cq, bf_hi(w.x) * cq); o.y = cvt_pk_bf16(bf_lo(w.y) * cq, bf_hi(w.y) * cq); o.z = cvt_pk_bf16(bf_lo(w.z) * cq, bf_hi(w.z) * cq); o.w = cvt_pk_bf16(bf_lo(w.w) * cq, bf_hi(w.w) * cq);
          qr[d0] = __builtin_bit_cast(bf16x8, o); } }
    ATT_DMA(0); ATT_DMA(1); ATT_DMA(2);
    const int kbase = hi * 1024 + r32 * 16;
    const int qq = (lane & 15) >> 2, pp = lane & 3, dblk = (lane >> 4) & 1, swz = ((qq >> 1) & 1) * 64;
    const int vrow0 = 4 * hi + qq;
    const int vb0 = KT_BYTES + vrow0 * 128 + ((32 * dblk + 8 * pp) ^ swz);
    const int vb1 = KT_BYTES + vrow0 * 128 + ((64 + 32 * dblk + 8 * pp) ^ swz);
    f32x16 o0 = {}, o1 = {};
    float m_run = -1e30f, l_run = 0.f; const f32x16 zero16 = {};
    const int qa = qw + r32;
#define ATT_QK(N0, N1, t) do { const LAS unsigned char* kp_ = lds + ((t) & 3) * SLOT_BYTES + kbase; \
        _Pragma("unroll") for (int d0 = 0; d0 < 6; ++d0) { const bf16x8 ka_ = *(const LAS bf16x8*)(kp_ + d0 * 2048), kb_ = *(const LAS bf16x8*)(kp_ + d0 * 2048 + 512); \
            if (d0 == 0) { N0 = MFMA32(ka_, qr[0], zero16); N1 = MFMA32(kb_, qr[0], zero16); } else { N0 = MFMA32(ka_, qr[d0], N0); N1 = MFMA32(kb_, qr[d0], N1); } } } while (0)
#define ATT_MASK(N0, N1, t) do { const int kb_ = 64 * (t); if (kb_ + 63 > qw) { _Pragma("unroll") for (int r = 0; r < 16; ++r) { const int ka_ = kb_ + crow(r, hi); \
        if (ka_ > qa) N0[r] = -__builtin_inff(); if (ka_ + 32 > qa) N1[r] = -__builtin_inff(); } } } while (0)
#define ATT_ROWMAX(N0, N1, PM) do { float a_ = max3f(N0[0], N0[1], N1[0]), b_ = max3f(N0[2], N0[3], N1[1]); a_ = max3f(a_, N1[2], N1[3]); \
        _Pragma("unroll") for (int r = 4; r < 16; r += 4) { a_ = max3f(a_, N0[r], N0[r + 1]); b_ = max3f(b_, N0[r + 2], N0[r + 3]); a_ = max3f(a_, N1[r], N1[r + 1]); b_ = max3f(b_, N1[r + 2], N1[r + 3]); } \
        a_ = max3f(a_, b_, b_); auto rr_ = __builtin_amdgcn_permlane32_swap(__float_as_uint(a_), __float_as_uint(a_), false, false); \
        PM = max3f(__uint_as_float(rr_[0]), __uint_as_float(rr_[1]), __uint_as_float(rr_[1])); } while (0)
#define ATT_DECIDE(PM, C0, C1, FORCE) do { if ((FORCE) || __any((PM) > m_run + 8.0f)) { const float mn_ = fmaxf(m_run, (PM)); const float al_ = __builtin_amdgcn_exp2f(m_run - mn_); m_run = mn_; l_run *= al_; \
        if (hi == 0) scr[r32] = al_; asm volatile("s_waitcnt lgkmcnt(0)" ::: "memory"); \
        _Pragma("unroll") for (int a4 = 0; a4 < 4; ++a4) { const f32x4 f_ = *(const LAS f32x4*)(scr + 8 * a4 + 4 * hi); \
            _Pragma("unroll") for (int e = 0; e < 4; ++e) { o0[4 * a4 + e] *= f_[e]; o1[4 * a4 + e] *= f_[e]; } } } } while (0)
#define ATT_SOFTMAX(C0, C1) do { float ps_ = 0.f; \
        _Pragma("unroll") for (int r = 0; r < 16; ++r) { C0[r] = __builtin_amdgcn_exp2f(C0[r] - m_run); C1[r] = __builtin_amdgcn_exp2f(C1[r] - m_run); ps_ += C0[r] + C1[r]; } \
        l_run += ps_; \
        _Pragma("unroll") for (int ks = 0; ks < 4; ++ks) { const f32x16& P_ = (ks < 2) ? C0 : C1; const int bs_ = 8 * (ks & 1); \
            u32x4 w_; w_.x = cvt_pk_bf16(P_[bs_ + 0], P_[bs_ + 1]); w_.y = cvt_pk_bf16(P_[bs_ + 2], P_[bs_ + 3]); w_.z = cvt_pk_bf16(P_[bs_ + 4], P_[bs_ + 5]); w_.w = cvt_pk_bf16(P_[bs_ + 6], P_[bs_ + 7]); \
            pa[ks] = __builtin_bit_cast(bf16x8, w_); } } while (0)
#define ATT_PV(t) do { const LAS unsigned char* vp0_ = lds + ((t) & 3) * SLOT_BYTES + vb0; const LAS unsigned char* vp1_ = lds + ((t) & 3) * SLOT_BYTES + vb1; \
        _Pragma("unroll") for (int ks = 0; ks < 4; ++ks) { \
            const s16x4 a0_ = vtr(vp0_ + ks * 16 * 128), a1_ = vtr(vp0_ + ks * 16 * 128 + 8 * 128), c0_ = vtr(vp1_ + ks * 16 * 128), c1_ = vtr(vp1_ + ks * 16 * 128 + 8 * 128); \
            const bf16x8 vf0_ = {a0_[0], a0_[1], a0_[2], a0_[3], a1_[0], a1_[1], a1_[2], a1_[3]}; const bf16x8 vf1_ = {c0_[0], c0_[1], c0_[2], c0_[3], c1_[0], c1_[1], c1_[2], c1_[3]}; \
            o0 = MFMA32(pa[ks], vf0_, o0); o1 = MFMA32(pa[ks], vf1_, o1); } } while (0)
#define ATT_WB(N) asm volatile("s_waitcnt vmcnt(" #N ") lgkmcnt(0)\n\ts_barrier" ::: "memory")
#define ATT_STEP(C0, C1, PMC, N0, N1, PMN, j, MSK, CONV) do { \
        ATT_DECIDE(PMC, C0, C1, false); \
        ATT_QK(N0, N1, (j) + 1); ATT_SOFTMAX(C0, C1); \
        bool cvi_ = false; \
        if (CONV) { __builtin_amdgcn_sched_barrier(0); const LAS float* cb_ = (const LAS float*)(lds + CONV_OFF + wid * CONV_BYTES); \
            if (CV.cur >= 0) { const ConvItem I_ = cv_setup(CV.cur, kargs()->in[I_WGU], kargs()->in[I_WD], cvws + WS_WGU, cvws + WS_WD); cv_out(I_, cb_, lane); } \
            if (CV.next < CV.end) { const ConvItem I_ = cv_setup(CV.next, kargs()->in[I_WGU], kargs()->in[I_WD], cvws + WS_WGU, cvws + WS_WD); asm volatile("s_waitcnt lgkmcnt(0)" ::: "memory"); \
                cv_dma(I_, lds0 + (unsigned)(CONV_OFF + wid * CONV_BYTES), lane); CV.cur = CV.next; CV.next += 2048; cvi_ = true; } else CV.cur = -1; __builtin_amdgcn_sched_barrier(0); } \
        const bool dma_ = (j) + 3 < NT; if (dma_) ATT_DMA((j) + 3); \
        ATT_PV(j); if (MSK) ATT_MASK(N0, N1, (j) + 1); ATT_ROWMAX(N0, N1, PMN); \
        if (dma_) { if (cvi_) ATT_WB(11); else ATT_WB(3); } else { if (cvi_) ATT_WB(8); else ATT_WB(0); } } while (0)
    bf16x8 pa[4];
    f32x16 sA0, sA1, sB0, sB1; float pmA, pmB;
    ATT_WAITBAR(6);
    ATT_QK(sA0, sA1, 0); ATT_MASK(sA0, sA1, 0); ATT_ROWMAX(sA0, sA1, pmA);
    ATT_WAITBAR(3);
    int j = 0;
    for (; j + 8 <= NT; j += 2) {
        ATT_STEP(sA0, sA1, pmA, sB0, sB1, pmB, j, false, CONV_IN_ATTN);
        ATT_STEP(sB0, sB1, pmB, sA0, sA1, pmA, j + 1, false, false);
    }
    for (; j < NT; j += 2) {
        ATT_STEP(sA0, sA1, pmA, sB0, sB1, pmB, j, true, CONV_IN_ATTN);
        ATT_STEP(sB0, sB1, pmB, sA0, sA1, pmA, j + 1, true, false);
    }
#undef ATT_DMA
#undef ATT_DMA1
#undef ATT_WAITBAR
#undef ATT_QK
#undef ATT_MASK
#undef ATT_ROWMAX
#undef ATT_DECIDE
#undef ATT_SOFTMAX
#undef ATT_PV
#undef ATT_STEP
#undef ATT_WB
    { auto rr = __builtin_amdgcn_permlane32_swap(__float_as_uint(l_run), __float_as_uint(l_run), false, false); l_run = __uint_as_float(rr[0]) + __uint_as_float(rr[1]); }
    if (hi == 0) scr[32 + r32] = 1.0f / l_run;
    asm volatile("s_waitcnt lgkmcnt(0)" ::: "memory");
    bf16_t* Ow = O + ((size_t)(b * SEQ + qw)) * 512 + h * 64 + r32;
#pragma unroll
    for (int a4 = 0; a4 < 4; ++a4) { const f32x4 f = *(const LAS f32x4*)(scr + 32 + 8 * a4 + 4 * hi);
#pragma unroll
        for (int e = 0; e < 4; ++e) { const int r = 4 * a4 + e; const int row = crow(r, hi);
            Ow[(size_t)row * 512] = (bf16_t)(cvt_pk_bf16(o0[r] * f[e], 0.f) & 0xffffu);
            Ow[(size_t)row * 512 + 32] = (bf16_t)(cvt_pk_bf16(o1[r] * f[e], 0.f) & 0xffffu); } }
    __syncthreads();
}
#undef MFMA32
}

struct MixOrder {
    int G, c; unsigned ATT, MIXED, WAO, WPO;
    __device__ __forceinline__ bool next(int i, Unit& u) const {
        const int tile = (i >> 1) * G + c; if (tile >= 256) return false;
        u.pm = tile >> 2; u.pn = tile & 3; u.aux = i & 1; return true;
    }
    __device__ __forceinline__ unsigned a_off(const Unit& u) const { return (u.aux ? MIXED : ATT) + (unsigned)u.pm * (256 * 512 * 2); }
    __device__ __forceinline__ unsigned b_off(const Unit& u) const { return (u.aux ? WPO : WAO) + (unsigned)u.pn * (256 * 512 * 2); }
};
struct EpiMix {
    static constexpr bool PERM = true;
    bf16_t* MIX; const bf16_t* GATES;
    __device__ __forceinline__ void operator()(const f32x4 (&acc)[2][2][4][2], const Unit& u, int wr, int wc, int fr, int fq) const {
        const int row0 = u.pm * 256 + wr * 64 + fr, col0 = u.pn * 256 + wc * 32 + 8 * fq;
#pragma unroll
        for (int ai = 0; ai < 2; ++ai)
#pragma unroll
            for (int m = 0; m < 4; ++m) { const size_t row = (size_t)(row0 + ai * 128 + m * 16);
#pragma unroll
                for (int bj = 0; bj < 2; ++bj) {
                    const u32x4 gw = *(const u32x4*)(GATES + row * 2048 + u.aux * 1024 + col0 + bj * 128);
                    const f32x4 v0 = acc[ai][bj][m][0], v1 = acc[ai][bj][m][1];
                    float r[8] = {v0[0] * bf_lo(gw.x), v0[1] * bf_hi(gw.x), v0[2] * bf_lo(gw.y), v0[3] * bf_hi(gw.y), v1[0] * bf_lo(gw.z), v1[1] * bf_hi(gw.z), v1[2] * bf_lo(gw.w), v1[3] * bf_hi(gw.w)};
                    bf16_t* dst = MIX + row * 1024 + col0 + bj * 128;
                    if (u.aux) { const u32x4 pw = *(const u32x4*)dst;
                        r[0] += bf_lo(pw.x); r[1] += bf_hi(pw.x); r[2] += bf_lo(pw.y); r[3] += bf_hi(pw.y); r[4] += bf_lo(pw.z); r[5] += bf_hi(pw.z); r[6] += bf_lo(pw.w); r[7] += bf_hi(pw.w); }
                    u32x4 w; w.x = cvt_pk_bf16(r[0], r[1]); w.y = cvt_pk_bf16(r[2], r[3]); w.z = cvt_pk_bf16(r[4], r[5]); w.w = cvt_pk_bf16(r[6], r[7]);
                    *(u32x4*)dst = w; } }
    }
};
struct EpiRes {
    static constexpr bool PERM = false;
    const float* base; float* out;
    __device__ __forceinline__ void operator()(const f32x4 (&acc)[2][2][4][2], const Unit& u, int wr, int wc, int fr, int fq) const {
        const int row0 = u.pm * 256 + wr * 64 + fr, col0 = u.pn * 256 + wc * 32 + 4 * fq;
#pragma unroll
        for (int ai = 0; ai < 2; ++ai)
#pragma unroll
            for (int m = 0; m < 4; ++m) { const size_t off = (size_t)(row0 + ai * 128 + m * 16) * DM + col0;
#pragma unroll
                for (int bj = 0; bj < 2; ++bj)
#pragma unroll
                    for (int n = 0; n < 2; ++n) *(f32x4*)(out + off + bj * 128 + n * 16) = *(const f32x4*)(base + off + bj * 128 + n * 16) + acc[ai][bj][m][n]; }
    }
};

constexpr int WR_PITCH = 1028;
constexpr int R_WR_OFF = 0, R_PART_OFF = 32 * WR_PITCH * 4, R_SSQ_OFF = R_PART_OFF + 2 * 64 * 33 * 4, R_CNT_OFF = R_SSQ_OFF + 2 * 64 * 4, R_BASE_OFF = R_CNT_OFF + 128, R_END = R_BASE_OFF + 128;
static_assert(R_END <= TILE_E_OFF, "router LDS map");
__device__ __forceinline__ void p7_router(const Frame& F) {
    const int tid_l = tid_local(), lane_l = tid_l & 63; (void)tid_l; (void)lane_l;
    const KArgs a = kargs();
    LAS float* WR = (LAS float*)(F.lds + R_WR_OFF); LAS float* PART = (LAS float*)(F.lds + R_PART_OFF); LAS float* SSQP = (LAS float*)(F.lds + R_SSQ_OFF);
    LAS int* CNT = (LAS int*)(F.lds + R_CNT_OFF); LAS int* BASE = (LAS int*)(F.lds + R_BASE_OFF);
    const int tid = tid_l, lane = lane_l, wave = F.wave;
    const float* wr = a->in[I_WR]; const float* gf = a->in[I_GFFN];
    for (int i = tid; i < 1024 * 32; i += 512) { const int k = i >> 5, e = i & 31; WR[e * WR_PITCH + k] = wr[i] * gf[k]; }
    if (tid < 32) CNT[tid] = 0;
    __syncthreads();
    int* RE = (int*)(F.ws + WS_ROUTE); int* RP = RE + T * 4; float* RG = (float*)(RP + T * 4); float* RS = RG + T * 4;
    unsigned* gcnt = F.ctl + CW_CNT;
    const float* X1 = F.out;
    for (int blk = F.vcu; blk < T / 64; blk += F.G) {
        const int tb = blk * 64;
        {
            const int tg = wave & 3, kh = wave >> 2, r = lane & 15, kq = lane >> 4;
            const float* xp = X1 + (size_t)(tb + 16 * tg + r) * DM + 512 * kh + 4 * kq;
            const LAS float* w0 = WR + (lane & 15) * WR_PITCH + 512 * kh + 4 * kq; const LAS float* w1 = w0 + 16 * WR_PITCH;
            f32x4 acc0 = {0.f, 0.f, 0.f, 0.f}, acc1 = {0.f, 0.f, 0.f, 0.f}; float ss = 0.f;
#pragma unroll 4
            for (int i = 0; i < 32; ++i) {
                const f32x4 xv = *(const f32x4*)(xp + 16 * i);
                const f32x4 b0 = *(const LAS f32x4*)(w0 + 16 * i), b1 = *(const LAS f32x4*)(w1 + 16 * i);
                ss += (xv[0] * xv[0] + xv[1] * xv[1]) + (xv[2] * xv[2] + xv[3] * xv[3]);
#pragma unroll
                for (int j = 0; j < 4; ++j) { acc0 = __builtin_amdgcn_mfma_f32_16x16x4f32(xv[j], b0[j], acc0, 0, 0, 0); acc1 = __builtin_amdgcn_mfma_f32_16x16x4f32(xv[j], b1[j], acc1, 0, 0, 0); }
            }
            ss += __shfl_xor(ss, 16); ss += __shfl_xor(ss, 32);
            if (kq == 0) SSQP[kh * 64 + 16 * tg + r] = ss;
#pragma unroll
            for (int q = 0; q < 4; ++q) { const int tok = 16 * tg + 4 * kq + q; PART[(kh * 64 + tok) * 33 + (lane & 15)] = acc0[q]; PART[(kh * 64 + tok) * 33 + 16 + (lane & 15)] = acc1[q]; }
        }
        __syncthreads();
        int te[4] = {0, 0, 0, 0}, lp[4] = {0, 0, 0, 0}; float tv[4] = {-3e38f, -3e38f, -3e38f, -3e38f}; float rstd = 0.f;
        if (tid < 64) {
            const float ssq = SSQP[tid] + SSQP[64 + tid]; rstd = 1.0f / sqrtf(ssq * (1.f / DM) + EPS);
            const float* br = a->in[I_BR];
#pragma unroll
            for (int e = 0; e < 32; ++e) {
                float v = (PART[tid * 33 + e] + PART[(64 + tid) * 33 + e]) * rstd + br[e]; int id = e;
#pragma unroll
                for (int s = 0; s < 4; ++s) { const bool gt = v > tv[s]; const float ov = tv[s]; const int oi = te[s]; tv[s] = gt ? v : ov; te[s] = gt ? id : oi; v = gt ? ov : v; id = gt ? oi : id; }
            }
#pragma unroll
            for (int s = 0; s < 4; ++s) lp[s] = __hip_atomic_fetch_add(&CNT[te[s]], 1, __ATOMIC_RELAXED, __HIP_MEMORY_SCOPE_WORKGROUP);
        }
        __syncthreads();
        if (tid < 32) { const int c = CNT[tid]; BASE[tid] = c ? (int)atomicAdd(gcnt + tid, (unsigned)c) : 0; }
        __syncthreads();
        if (tid < 64) {
            const int t = tb + tid;
            const float e1 = __expf(tv[1] - tv[0]), e2 = __expf(tv[2] - tv[0]), e3 = __expf(tv[3] - tv[0]); const float inv = 1.0f / (1.0f + e1 + e2 + e3);
            const float gts[4] = {inv, e1 * inv, e2 * inv, e3 * inv};
#pragma unroll
            for (int s = 0; s < 4; ++s) { RE[t * 4 + s] = te[s]; RP[t * 4 + s] = BASE[te[s]] + lp[s]; RG[t * 4 + s] = gts[s]; }
            RS[t] = rstd;
        }
        __syncthreads();
        if (tid < 32) CNT[tid] = 0;
        __syncthreads();
    }
}

__device__ __forceinline__ int build_tiles(const Frame& F) {
    const int tid_l = tid_local(), lane_l = tid_l & 63; (void)tid_l; (void)lane_l;
    LAS int* TB = (LAS int*)(F.lds + TILE_E_OFF); LAS int* TE = TB + 64;
    if (tid_l == 0) { int acc = 0; for (int e = 0; e < NEXP; ++e) { TB[e] = acc; const int c = (int)__hip_atomic_load(F.ctl + CW_CNT + e, RLX_AGENT); acc += (c + 255) >> 8; } TB[NEXP] = acc; }
    __syncthreads();
    if (tid_l < NEXP) { for (int t = TB[tid_l]; t < TB[tid_l + 1]; ++t) TE[t] = tid_l; }
    __syncthreads();
    return TB[NEXP];
}

__device__ __forceinline__ void p8_dispatch(const Frame& F) {
    const int tid_l = tid_local(), lane_l = tid_l & 63; (void)tid_l; (void)lane_l;
    const KArgs a = kargs();
    (void)build_tiles(F);
    const LAS int* TB = (const LAS int*)(F.lds + TILE_E_OFF);
    const int gw = F.vcu * NWAVES + F.wave, NGW = F.G * NWAVES, lane = lane_l;
    const int* RE = (const int*)(F.ws + WS_ROUTE); const int* RP = RE + T * 4; const float* RS = (const float*)(RP + T * 4) + T * 4; int* SL = (int*)(RS + T);
    const float* X1 = F.out; const float* gf = a->in[I_GFFN]; unsigned char* XS = F.ws + WS_XS2;
    f32x4 g[2][2];
#pragma unroll
    for (int j = 0; j < 2; ++j) { g[j][0] = *(const f32x4*)(gf + 512 * j + 8 * lane); g[j][1] = *(const f32x4*)(gf + 512 * j + 8 * lane + 4); }
    for (int t = gw; t < T; t += NGW) {
        const float rstd = RS[t];
        u32x2 w[2];
#pragma unroll
        for (int j = 0; j < 2; ++j) { const f32x4 v0 = *(const f32x4*)(X1 + (size_t)t * DM + 512 * j + 8 * lane) * g[j][0] * rstd, v1 = *(const f32x4*)(X1 + (size_t)t * DM + 512 * j + 8 * lane + 4) * g[j][1] * rstd;
            w[j] = cvt8_fp8(v0, v1, 8.0f); }
#pragma unroll
        for (int s = 0; s < 4; ++s) { const int e = RE[t * 4 + s], slot = TB[e] * 256 + RP[t * 4 + s];
            if (lane == 0) SL[t * 4 + s] = slot;
            unsigned char* dst = XS + (size_t)slot * DM + 8 * lane;
            *(u32x2*)dst = w[0]; *(u32x2*)(dst + 512) = w[1]; }
    }
}

struct MoeOrder {
    int G, c, ntn_shift, total; const LAS int* TE; unsigned A, Bw, bexp, btile;
    __device__ __forceinline__ bool next(int i, Unit& u) const {
        const int L = i * G + c; if (L >= total) return false;
        u.pm = L >> ntn_shift; u.pn = L & ((1 << ntn_shift) - 1); u.aux = __builtin_amdgcn_readfirstlane(TE[u.pm]); return true;
    }
    __device__ __forceinline__ unsigned a_off(const Unit& u) const { return A + (unsigned)u.pm * (256 * 1024); }
    __device__ __forceinline__ unsigned b_off(const Unit& u) const { return Bw + (unsigned)u.aux * bexp + (unsigned)u.pn * btile; }
};
struct EpiSwiglu {
    static constexpr bool PERM = true;
    unsigned char* ACT; const float* bgu;
    __device__ __forceinline__ void operator()(const f32x4 (&acc)[2][2][4][2], const Unit& u, int wr, int wc, int fr, int fq) const {
        const int row0 = u.pm * 256 + wr * 64 + fr, j0 = u.pn * 128 + wc * 32 + 8 * fq;
        const float* bb = bgu + (size_t)u.aux * 2048 + j0;
        unsigned char* dst0 = ACT + (size_t)row0 * DEXP + j0;
#pragma unroll
        for (int ai = 0; ai < 2; ++ai)
#pragma unroll
            for (int m = 0; m < 4; ++m) {
#pragma unroll
                for (int n = 0; n < 2; ++n) {
                    asm volatile("" : "+v"(bb));
                    const f32x4 g = acc[ai][0][m][n] + *(const f32x4*)(bb + 4 * n), up = acc[ai][1][m][n] + *(const f32x4*)(bb + 1024 + 4 * n);
                    float r[4];
#pragma unroll
                    for (int e = 0; e < 4; ++e) { const float gg = fminf(g[e], 7.0f), uu = fminf(fmaxf(up[e], -7.0f), 7.0f); r[e] = (uu + 1.0f) * gg * fast_sigmoid(1.702f * gg) * 8.0f; }
                    int w = __builtin_amdgcn_cvt_pk_fp8_f32(r[0], r[1], 0, false); w = __builtin_amdgcn_cvt_pk_fp8_f32(r[2], r[3], w, true);
                    *(int*)(dst0 + (size_t)(ai * 128 + m * 16) * DEXP + 4 * n) = w;
                }
                asm volatile("" ::: "memory");
            }
    }
};
struct EpiDown {
    static constexpr bool PERM = true;
    bf16_t* Y; const float* bd;
    __device__ __forceinline__ void operator()(const f32x4 (&acc)[2][2][4][2], const Unit& u, int wr, int wc, int fr, int fq) const {
        const int row0 = u.pm * 256 + wr * 64 + fr, col0 = u.pn * 256 + wc * 32 + 8 * fq;
        const float* bb = bd + (size_t)u.aux * DM + col0;
#pragma unroll
        for (int ai = 0; ai < 2; ++ai)
#pragma unroll
            for (int m = 0; m < 4; ++m) { bf16_t* rowp = Y + (size_t)(row0 + ai * 128 + m * 16) * DM + col0;
                asm volatile("" : "+v"(bb));
#pragma unroll
                for (int bj = 0; bj < 2; ++bj) { const f32x4 v0 = acc[ai][bj][m][0] + *(const f32x4*)(bb + bj * 128), v1 = acc[ai][bj][m][1] + *(const f32x4*)(bb + bj * 128 + 4);
                    u32x4 w; w.x = cvt_pk_bf16(v0[0], v0[1]); w.y = cvt_pk_bf16(v0[2], v0[3]); w.z = cvt_pk_bf16(v1[0], v1[1]); w.w = cvt_pk_bf16(v1[2], v1[3]);
                    *(u32x4*)(rowp + bj * 128) = w; } asm volatile("" ::: "memory"); }
    }
};

__device__ __forceinline__ void p11_combine(const Frame& F) {
    const int tid_l = tid_local(), lane_l = tid_l & 63; (void)tid_l; (void)lane_l;
    const KArgs a = kargs();
    const int gw = F.vcu * NWAVES + F.wave, NGW = F.G * NWAVES, lane = lane_l;
    const int* RE = (const int*)(F.ws + WS_ROUTE); const float* RG = (const float*)(RE + T * 8); const int* SL = (const int*)(RG + T * 4 + T);
    const bf16_t* Y = (const bf16_t*)(F.ws + WS_XS); bf16_t* HP = (bf16_t*)(F.ws + WS_HN); float* X = F.out; const float* gp = a->in[I_GPLE];
    f32x4 g[2][2];
#pragma unroll
    for (int j = 0; j < 2; ++j) { g[j][0] = *(const f32x4*)(gp + 512 * j + 8 * lane); g[j][1] = *(const f32x4*)(gp + 512 * j + 8 * lane + 4); }
    for (int t = gw; t < T; t += NGW) {
        f32x4 v[2][2];
#pragma unroll
        for (int j = 0; j < 2; ++j) { v[j][0] = *(const f32x4*)(X + (size_t)t * DM + 512 * j + 8 * lane); v[j][1] = *(const f32x4*)(X + (size_t)t * DM + 512 * j + 8 * lane + 4); }
#pragma unroll
        for (int s = 0; s < 4; ++s) { const int slot = SL[t * 4 + s]; const float gt = RG[t * 4 + s];
#pragma unroll
            for (int j = 0; j < 2; ++j) { const u32x4 y = *(const u32x4*)(Y + (size_t)slot * DM + 512 * j + 8 * lane);
                v[j][0] += (f32x4){bf_lo(y.x), bf_hi(y.x), bf_lo(y.y), bf_hi(y.y)} * gt; v[j][1] += (f32x4){bf_lo(y.z), bf_hi(y.z), bf_lo(y.w), bf_hi(y.w)} * gt; } }
        float ss = 0.f;
#pragma unroll
        for (int j = 0; j < 2; ++j)
#pragma unroll
            for (int n = 0; n < 2; ++n) { const f32x4 q = v[j][n]; ss += (q[0] * q[0] + q[1] * q[1]) + (q[2] * q[2] + q[3] * q[3]); *(f32x4*)(X + (size_t)t * DM + 512 * j + 8 * lane + 4 * n) = q; }
        const float rstd = 1.0f / sqrtf(wave_sum(ss) * (1.f / DM) + EPS);
#pragma unroll
        for (int j = 0; j < 2; ++j) { const f32x4 q0 = v[j][0] * g[j][0] * rstd, q1 = v[j][1] * g[j][1] * rstd;
            u32x4 w; w.x = cvt_pk_bf16(q0[0], q0[1]); w.y = cvt_pk_bf16(q0[2], q0[3]); w.z = cvt_pk_bf16(q1[0], q1[1]); w.w = cvt_pk_bf16(q1[2], q1[3]);
            *(u32x4*)(HP + (size_t)t * DM + 512 * j + 8 * lane) = w; }
    }
}
struct EpiPle {
    static constexpr bool PERM = false;
    float* out; const bf16_t* E;
    __device__ __forceinline__ void operator()(const f32x4 (&acc)[2][2][4][2], const Unit& u, int wr, int wc, int fr, int fq) const {
        const int row0 = u.pm * 256 + wr * 64 + fr, col0 = u.pn * 256 + wc * 32 + 4 * fq;
#pragma unroll
        for (int ai = 0; ai < 2; ++ai)
#pragma unroll
            for (int m = 0; m < 4; ++m) { const size_t off = (size_t)(row0 + ai * 128 + m * 16) * DM + col0;
#pragma unroll
                for (int bj = 0; bj < 2; ++bj)
#pragma unroll
                    for (int n = 0; n < 2; ++n) { const size_t o = off + bj * 128 + n * 16; const u32x2 ev = *(const u32x2*)(E + o); const f32x4 a4 = acc[ai][bj][m][n];
                        f32x4 r = *(const f32x4*)(out + o);
                        r[0] += fast_sigmoid(a4[0]) * bf_lo(ev.x); r[1] += fast_sigmoid(a4[1]) * bf_hi(ev.x); r[2] += fast_sigmoid(a4[2]) * bf_lo(ev.y); r[3] += fast_sigmoid(a4[3]) * bf_hi(ev.y);
                        *(f32x4*)(out + o) = r; } }
    }
};

constexpr int N_PHASES = 13;
__global__ void __launch_bounds__(NWAVES * 64, 2) fwd_kernel(Args args) {
    extern __shared__ __attribute__((aligned(16))) unsigned char lds_raw[];
    Frame F;
    F.lds = (LAS unsigned char*)lds_raw; F.MISC = (volatile LAS unsigned*)(F.lds + MISC_OFF);
    F.wave = __builtin_amdgcn_readfirstlane(threadIdx.x >> 6);
    F.G = gridDim.x; { const int bx = blockIdx.x; F.vcu = (F.G % 8 == 0) ? (bx % 8) * (F.G / 8) + bx / 8 : bx; }
    { const KArgs ka = kargs(); F.out = ka->out; F.ws = ka->ws; F.ctl = (unsigned*)(ka->ws + WS_CTL); }
    { const int t0_ = tid_local(); if (t0_ < 32) F.MISC[t0_] = 0u; }
    __syncthreads();
    int lo, hi; { const KArgs ka = kargs(); lo = ka->ph_lo; hi = ka->ph_hi; }
    const bool multi = (hi - lo) > 1;
    XcdBarrier bar; bar.bar = F.ctl + CW_BAR; bar.x = 0; bar.st = nullptr;
    if (multi) bar = xcd_barrier_post(F.ctl + CW_BAR, F.MISC);
#ifndef PH_MASK
#define PH_MASK 0x1fff
#endif
#define IN(k) ((((PH_MASK) >> (k)) & 1) && lo <= (k) && (k) < hi)
#define SEAM(k) do { if (IN(k) && IN((k) + 1)) xcd_barrier(bar); } while (0)
    unsigned char* ws = F.ws;
    LAS unsigned char* ring = F.lds;
    const __amdgpu_buffer_rsrc_t rsrc = __builtin_amdgcn_make_buffer_rsrc((void*)ws, 0, (int)WS_END, 0x00020000);

    if (IN(0)) { p0_prologue(F); } SEAM(0);

    if (IN(1)) {
        { DenseOrder S; S.init(64, 12, F.G, (int)blockIdx.x, WS_HN, 1024, WS_WIN, 1024);
          EpiProj E{(bf16_t*)(ws + WS_PROJ), (bf16_t*)(ws + WS_GATES)};
          pg8::gemm_phase<EpiProj, DenseOrder, true, true>(ring, rsrc, pg8::Shape{2048, 2048, 2048, 0, 0}, S, E); }
        { DenseOrder S; S.init(64, 4, F.G, (int)blockIdx.x, WS_PB, 256, WS_WPLE, 256);
          EpiBf16 E{(bf16_t*)(ws + WS_E), 1024};
          pg8::gemm_phase<EpiBf16, DenseOrder, true, true>(ring, rsrc, pg8::Shape{512, 512, 512, 0, 0}, S, E); }
    } SEAM(1);

    if (IN(2)) { p2_rows(F); } SEAM(2);

    if (IN(3)) {
#ifndef P3M
#define P3M 7
#endif
        if (P3M & 1) { DenseOrder S; S.init(64, 4, F.G, (int)blockIdx.x, WS_A2 + 512, 512, WS_WKV, 256);
          EpiKV E{(bf16_t*)(ws + WS_K), (bf16_t*)(ws + WS_V), kargs()->in[I_GKNOPE]};
          pg8::gemm_phase<EpiKV, DenseOrder, true, true>(ring, rsrc, pg8::Shape{512, 1024, 512, 0, 0}, S, E); }
        if (P3M & 2) { DenseOrder S; S.init(64, 3, F.G, (int)blockIdx.x, WS_A2, 512, WS_WQ, 256);
          EpiQ E{(bf16_t*)(ws + WS_Q), (float*)(ws + WS_SSQ), (const float*)(ws + WS_COS), (const float*)(ws + WS_SIN), kargs()->in[I_GQHEAD]};
          pg8::gemm_phase<EpiQ, DenseOrder, true, true>(ring, rsrc, pg8::Shape{512, 1024, 512, 0, 0}, S, E); }
        if (P3M & 4) { DenseOrder S; S.init(64, 2, F.G, (int)blockIdx.x, WS_POOLED, 512, WS_WPOOL, 256, 512);
          EpiBf16 E{(bf16_t*)(ws + WS_MIXED), 512};
          pg8::gemm_phase<EpiBf16, DenseOrder, true, true>(ring, rsrc, pg8::Shape{512, 1024, 512, 0, 0}, S, E); }
    } SEAM(3);

    if (IN(4)) {
        u32x4 srd; { const unsigned long wb = (unsigned long)ws; srd.x = (unsigned)__builtin_amdgcn_readfirstlane((int)(unsigned)wb); srd.y = (unsigned)__builtin_amdgcn_readfirstlane((int)(unsigned)(wb >> 32)); srd.z = (unsigned)WS_END; srd.w = 0x00020000u; }
        att::ConvState CV; CV.next = __builtin_amdgcn_readfirstlane(F.vcu * NWAVES + F.wave); CV.end = CONV_IN_ATTN ? att::CV_ITEMS : 0; CV.cur = -1;
        for (int it = F.vcu; it < 256; it += F.G) {
            const int bh = it >> 3, pr = it & 7;
            att::attn_unit(ring, srd, CV, ws, bh, 15 - pr, (const bf16_t*)(ws + WS_Q), (unsigned)WS_K, (unsigned)WS_V, (const float*)(ws + WS_SSQ), (bf16_t*)(ws + WS_ATT));
            att::attn_unit(ring, srd, CV, ws, bh, pr, (const bf16_t*)(ws + WS_Q), (unsigned)WS_K, (unsigned)WS_V, (const float*)(ws + WS_SSQ), (bf16_t*)(ws + WS_ATT));
        }
        { const LAS float* cb = (const LAS float*)(F.lds + att::CONV_OFF + F.wave * att::CONV_BYTES);
          const unsigned cbaddr = (unsigned)__builtin_amdgcn_readfirstlane((int)(unsigned)(unsigned long)(F.lds + att::CONV_OFF + F.wave * att::CONV_BYTES));
          const int lane_l = tid_local() & 63;
          while (CV.cur >= 0 || CV.next < CV.end) {
            if (CV.cur >= 0) { asm volatile("s_waitcnt vmcnt(0)" ::: "memory"); const att::ConvItem I = att::cv_setup(CV.cur, kargs()->in[I_WGU], kargs()->in[I_WD], ws + WS_WGU, ws + WS_WD); att::cv_out(I, cb, lane_l); }
            if (CV.next < CV.end) { const att::ConvItem I = att::cv_setup(CV.next, kargs()->in[I_WGU], kargs()->in[I_WD], ws + WS_WGU, ws + WS_WD); asm volatile("s_waitcnt lgkmcnt(0)" ::: "memory"); att::cv_dma(I, cbaddr, lane_l); CV.cur = CV.next; CV.next += 2048; } else CV.cur = -1;
          } }
    } SEAM(4);

    if (IN(5)) {
        MixOrder S{F.G, F.vcu, (unsigned)WS_ATT, (unsigned)WS_MIXED, (unsigned)WS_WAO, (unsigned)WS_WPO};
        EpiMix E{(bf16_t*)(ws + WS_MIX), (const bf16_t*)(ws + WS_GATES)};
        pg8::gemm_phase<EpiMix, MixOrder, true, true>(ring, rsrc, pg8::Shape{1024, 1024, 1024, 0, 0}, S, E);
    } SEAM(5);

    if (IN(6)) {
        DenseOrder S; S.init(64, 4, F.G, (int)blockIdx.x, WS_MIX, 1024, WS_WO, 1024);
        EpiRes E{kargs()->in[I_X], F.out};
        pg8::gemm_phase<EpiRes, DenseOrder, true, true>(ring, rsrc, pg8::Shape{2048, 2048, 2048, 0, 0}, S, E);
    } SEAM(6);

    if (IN(7)) { p7_router(F); } SEAM(7);

    if (IN(8)) { p8_dispatch(F); } SEAM(8);

    if (IN(9)) {
        const int TM = build_tiles(F);
        MoeOrder S{F.G, F.vcu, 3, TM * 8, (const LAS int*)(F.lds + TILE_E_OFF) + 64, (unsigned)WS_XS2, (unsigned)WS_WGU, 2048u * 1024u, 256u * 1024u};
        EpiSwiglu E{ws + WS_ACT, kargs()->in[I_BGU]};
        pg8::gemm_phase<EpiSwiglu, MoeOrder, true, true, true>(ring, rsrc, pg8::Shape{1024, 1024, 1024, 0x7c7c7c7c, 0x7c7c7c7c}, S, E);
    } SEAM(9);

    if (IN(10)) {
        const int TM = build_tiles(F);
        MoeOrder S{F.G, F.vcu, 2, TM * 4, (const LAS int*)(F.lds + TILE_E_OFF) + 64, (unsigned)WS_ACT, (unsigned)WS_WD, 1024u * 1024u, 256u * 1024u};
        EpiDown E{(bf16_t*)(ws + WS_XS), kargs()->in[I_BD]};
        pg8::gemm_phase<EpiDown, MoeOrder, true, true, true>(ring, rsrc, pg8::Shape{1024, 1024, 1024, 0x7c7c7c7c, 0x7c7c7c7c}, S, E);
    } SEAM(10);

    if (IN(11)) { p11_combine(F); } SEAM(11);

    if (IN(12)) {
        DenseOrder S; S.init(64, 4, F.G, (int)blockIdx.x, WS_HN, 1024, WS_WPG, 1024);
        EpiPle E{F.out, (const bf16_t*)(ws + WS_E)};
        pg8::gemm_phase<EpiPle, DenseOrder, true, true>(ring, rsrc, pg8::Shape{2048, 2048, 2048, 0, 0}, S, E);
    }
#undef IN
#undef SEAM
}

extern "C" void kernel_launch(void* const* d_in, const int* in_sizes, int n_in, void* d_out, int out_size, void* d_ws, size_t ws_size, hipStream_t stream) {
    static int grid = 0;
    if (grid == 0) {
        if (n_in != 27 || out_size != T * DM || ws_size < WS_END) { fprintf(stderr, "kernel_launch: unexpected shapes (n_in %d, out %d, ws %zu)\n", n_in, out_size, ws_size); grid = -1; return; }
        int dev = 0, cus = 0;
        if (hipGetDevice(&dev) != hipSuccess || hipDeviceGetAttribute(&cus, hipDeviceAttributeMultiprocessorCount, dev) != hipSuccess) { grid = -1; return; }
        if (hipFuncSetAttribute((const void*)fwd_kernel, hipFuncAttributeMaxDynamicSharedMemorySize, LDS_BYTES) != hipSuccess) { fprintf(stderr, "kernel_launch: hipFuncSetAttribute failed\n"); grid = -1; return; }
        int per_cu = 0;
        if (hipOccupancyMaxActiveBlocksPerMultiprocessor(&per_cu, (const void*)fwd_kernel, NWAVES * 64, LDS_BYTES) != hipSuccess || per_cu < 1) fprintf(stderr, "kernel_launch: occupancy query says %d\n", per_cu);
        (void)hipGetLastError();
        grid = cus;
    }
    if (grid < 0) return;
    (void)hipMemsetAsync((char*)d_ws + WS_CTL, 0, CTL_ZERO_BYTES, stream);
    Args a{};
    for (int i = 0; i < 27; ++i) a.in[i] = (const float*)d_in[i];
    a.out = (float*)d_out; a.ws = (unsigned char*)d_ws;
#ifndef DUP_PHASE
    a.ph_lo = 0; a.ph_hi = N_PHASES; hipLaunchKernelGGL(fwd_kernel, dim3(grid), dim3(NWAVES * 64), LDS_BYTES, stream, a);
#else
    a.ph_lo = 0; a.ph_hi = DUP_PHASE + 1; hipLaunchKernelGGL(fwd_kernel, dim3(grid), dim3(NWAVES * 64), LDS_BYTES, stream, a);
    (void)hipMemsetAsync((char*)d_ws + WS_CTL + CW_BAR * 4, 0, XCD_BAR_WORDS * 4, stream);
    a.ph_lo = DUP_PHASE; a.ph_hi = N_PHASES; hipLaunchKernelGGL(fwd_kernel, dim3(grid), dim3(NWAVES * 64), LDS_BYTES, stream, a);
#endif
}
```

```cpp
#include <hip/hip_runtime.h>
#include <cstdio>
#include <cstdint>

#define LAS __attribute__((address_space(3)))
#define GAS __attribute__((address_space(1)))
typedef unsigned short bf16_t;
typedef short bf16x8 __attribute__((ext_vector_type(8)));
typedef short s16x4 __attribute__((ext_vector_type(4)));
typedef float f32x4 __attribute__((ext_vector_type(4)));
typedef float f32x2 __attribute__((ext_vector_type(2)));
typedef float f32x16 __attribute__((ext_vector_type(16)));
typedef unsigned u32x4 __attribute__((ext_vector_type(4)));
typedef unsigned u32x2 __attribute__((ext_vector_type(2)));

constexpr int NB = 4, SEQ = 4096, T = NB * SEQ, DM = 1024, NH = 8, DK = 96, DV = 64;
constexpr int NEXP = 32, TOPK = 4, DEXP = 1024, PLE = 256;
constexpr float EPS = 1e-6f;
constexpr int XS_ROWS = T * TOPK + NEXP * 256;

typedef __bf16 bf16x2_t __attribute__((ext_vector_type(2)));
__device__ __forceinline__ unsigned cvt_pk_bf16(float lo, float hi) { f32x2 v = {lo, hi}; return __builtin_bit_cast(unsigned, __builtin_convertvector(v, bf16x2_t)); }
__device__ __forceinline__ u32x2 cvt8_fp8(const f32x4 a, const f32x4 b, float sc) {
    int w0 = __builtin_amdgcn_cvt_pk_fp8_f32(a[0] * sc, a[1] * sc, 0, false); w0 = __builtin_amdgcn_cvt_pk_fp8_f32(a[2] * sc, a[3] * sc, w0, true);
    int w1 = __builtin_amdgcn_cvt_pk_fp8_f32(b[0] * sc, b[1] * sc, 0, false); w1 = __builtin_amdgcn_cvt_pk_fp8_f32(b[2] * sc, b[3] * sc, w1, true);
    u32x2 r; r.x = (unsigned)w0; r.y = (unsigned)w1; return r;
}
__device__ __forceinline__ float bf_lo(unsigned w) { return __uint_as_float(w << 16); }
__device__ __forceinline__ float bf_hi(unsigned w) { return __uint_as_float(w & 0xffff0000u); }
__device__ __forceinline__ float bf1(bf16_t h) { return __uint_as_float(((unsigned)h) << 16); }
__device__ __forceinline__ float fast_sigmoid(float v) { return __builtin_amdgcn_rcpf(1.0f + __builtin_amdgcn_exp2f(-1.4426950408889634f * v)); }
__device__ __forceinline__ int lane_id() { return (int)__builtin_amdgcn_mbcnt_hi(~0u, __builtin_amdgcn_mbcnt_lo(~0u, 0u)); }
__device__ __forceinline__ int tid_local() { int t = threadIdx.x; asm volatile("" : "+v"(t)); return t; }
__device__ __forceinline__ float wave_sum(float v) {
#pragma unroll
    for (int o = 1; o < 64; o <<= 1) v += __shfl_xor(v, o);
    return v;
}

namespace pg8 {
constexpr int BM = 256, BK = 64, HALF = 128, HTB = HALF * BK * 2, STAGE_BYTES = 8 * HTB;
__host__ __device__ __forceinline__ int lds_byte(int r, int c) { const int st = (r >> 4) * 2 + (c >> 5), rr = r & 15, cc = c & 31, ob = rr * 64 + cc * 2; return st * 1024 + (ob ^ (((ob >> 9) & 1) << 5)); }
__host__ __device__ __forceinline__ void stage_rc(int b, int& R, int& C) { const int st = b / 1024, sb = b % 1024, swz = sb ^ (((sb >> 9) & 1) << 5); R = (st >> 1) * 16 + swz / 64; C = (st & 1) * 32 + (swz % 64) / 2; }
__host__ __device__ __forceinline__ int perm32(int rho) { const int n = rho >> 4, i = rho & 15; return 8 * (i >> 2) + 4 * n + (i & 3); }

struct Unit { int pm, pn, aux; };
struct Shape { int Kb, lda, ldb, sw, sa; };
typedef int v8i_t __attribute__((ext_vector_type(8))); typedef int v4i_t __attribute__((ext_vector_type(4)));

template <class Epi, class Sched, bool ALIGN_EPI, bool SP2, bool MX = false>
__device__ __forceinline__ void gemm_phase(LAS unsigned char* lds, const __amdgpu_buffer_rsrc_t rsrc, const Shape g, const Sched& S, const Epi& E) {
    const int tid = tid_local(), wid = __builtin_amdgcn_readfirstlane(tid >> 6), lane = tid & 63, wr = wid >> 2, wc = wid & 3, fr = lane & 15, fq = lane >> 4;
    int nt = g.Kb / 128; asm volatile("" : "+s"(nt));
    unsigned voffA, voffB;
    { int R, C; stage_rc(tid * 16, R, C); const int Rb = Epi::PERM ? ((R & ~31) + perm32(R & 31)) : R;
      voffA = (unsigned)(R * g.lda + C * 2); voffB = (unsigned)(Rb * g.ldb + C * 2); }
    const unsigned p2A = 64u * (unsigned)g.lda, p2B = 64u * (unsigned)g.ldb;
    const unsigned kstep = 128u;
    const unsigned hstepA = (unsigned)HALF * g.lda, hstepB = (unsigned)HALF * g.ldb;
    const unsigned ldsw = (unsigned)wid * 1024u;
    const int aoff = lds_byte(wr * 64 + fr, fq * 8), boff = lds_byte(wc * 32 + fr, fq * 8);
#define PG8_SA(b, h) (((b) * 2 + (h)) * HTB)
#define PG8_SB(b, h) ((4 + (b) * 2 + (h)) * HTB)
#define PG8_STAGE(bufoff, gbase, voff) do { \
        __builtin_amdgcn_raw_ptr_buffer_load_lds(rsrc, (LAS void*)(lds + (bufoff) + ldsw), 16, voff, (gbase), 0, 0); \
        __builtin_amdgcn_raw_ptr_buffer_load_lds(rsrc, (LAS void*)(lds + (bufoff) + ldsw + 8192), 16, voff, (gbase) + p2##voff, 0, 0); } while (0)
#define p2voffA p2A
#define p2voffB p2B
#define PG8_LDA(dst, b, h) do { _Pragma("unroll") for (int m = 0; m < 4; ++m) _Pragma("unroll") for (int k = 0; k < 2; ++k) dst[m][k] = *(const LAS bf16x8*)(lds + PG8_SA(b, h) + aoff + m * 2048 + k * 1024); } while (0)
#define PG8_LDB(dst, b, h) do { _Pragma("unroll") for (int n = 0; n < 2; ++n) _Pragma("unroll") for (int k = 0; k < 2; ++k) dst[n][k] = *(const LAS bf16x8*)(lds + PG8_SB(b, h) + boff + n * 2048 + k * 1024); } while (0)
#define PG8_CAT(x, y) __builtin_shufflevector(__builtin_bit_cast(v4i_t, x), __builtin_bit_cast(v4i_t, y), 0, 1, 2, 3, 4, 5, 6, 7)
#define PG8_MMA(ai, bj, At, Bt) do { __builtin_amdgcn_s_setprio(1); if constexpr (MX) { _Pragma("unroll") for (int m = 0; m < 4; ++m) _Pragma("unroll") for (int n = 0; n < 2; ++n) \
        acc[ai][bj][m][n] = __builtin_amdgcn_mfma_scale_f32_16x16x128_f8f6f4(PG8_CAT(Bt[n][0], Bt[n][1]), PG8_CAT(At[m][0], At[m][1]), acc[ai][bj][m][n], 0, 0, 0, g.sw, 0, g.sa); } else { \
        _Pragma("unroll") for (int m = 0; m < 4; ++m) _Pragma("unroll") for (int n = 0; n < 2; ++n) _Pragma("unroll") for (int k = 0; k < 2; ++k) \
        acc[ai][bj][m][n] = __builtin_amdgcn_mfma_f32_16x16x32_bf16(Bt[n][k], At[m][k], acc[ai][bj][m][n], 0, 0, 0); } __builtin_amdgcn_s_setprio(0); } while (0)
#define PG8_WAIT_V(n) asm volatile("s_waitcnt vmcnt(" #n ")" ::: "memory")
#define PG8_WAIT_L(n) asm volatile("s_waitcnt lgkmcnt(" #n ")" ::: "memory")
#define PG8_BAR __builtin_amdgcn_s_barrier()
#define PG8_SCHED __builtin_amdgcn_sched_barrier(0)
    Unit cur, nxt; int ui = 0;
    if (!S.next(0, cur)) return;
    f32x4 acc[2][2][4][2];
#pragma unroll
    for (int a = 0; a < 2; ++a)
#pragma unroll
        for (int b = 0; b < 2; ++b)
#pragma unroll
            for (int m = 0; m < 4; ++m)
#pragma unroll
                for (int n = 0; n < 2; ++n) acc[a][b][m][n] = (f32x4){0.f, 0.f, 0.f, 0.f};
    bf16x8 At[4][2], B0[2][2], B1[2][2];
    unsigned cA = S.a_off(cur), cB = S.b_off(cur);
    if constexpr (SP2) {
        PG8_STAGE(PG8_SB(0, 0), cB, voffB); PG8_STAGE(PG8_SB(0, 1), cB + hstepB, voffB); PG8_STAGE(PG8_SA(0, 0), cA, voffA); PG8_STAGE(PG8_SA(0, 1), cA + hstepA, voffA);
        if (wr == 1) PG8_BAR;
        PG8_WAIT_V(2); PG8_BAR;
        PG8_STAGE(PG8_SB(1, 0), cB + kstep, voffB); PG8_STAGE(PG8_SA(1, 0), cA + kstep, voffA); PG8_STAGE(PG8_SB(1, 1), cB + hstepB + kstep, voffB);
        PG8_WAIT_V(6); PG8_BAR;
    } else {
        PG8_STAGE(PG8_SB(0, 0), cB, voffB); PG8_STAGE(PG8_SA(0, 0), cA, voffA); PG8_STAGE(PG8_SB(0, 1), cB + hstepB, voffB); PG8_STAGE(PG8_SA(0, 1), cA + hstepA, voffA);
        if (wr == 1) PG8_BAR;
        PG8_WAIT_V(4); PG8_BAR;
        PG8_STAGE(PG8_SB(1, 0), cB + kstep, voffB); PG8_STAGE(PG8_SA(1, 0), cA + kstep, voffA); PG8_STAGE(PG8_SB(1, 1), cB + hstepB + kstep, voffB);
        PG8_WAIT_V(6); PG8_BAR;
    }
    for (;;) {
        const bool has_next = S.next(ui + 1, nxt);
        const unsigned nA = has_next ? S.a_off(nxt) : cA, nB = has_next ? S.b_off(nxt) : cB;
#pragma nounroll
        for (int t = 0; t < nt; t += 2) {
            const bool last = (t == nt - 2);
            const unsigned a1 = cA + (unsigned)(t + 1) * kstep;
            const unsigned a2 = last ? nA : cA + (unsigned)(t + 2) * kstep, b2 = last ? nB : cB + (unsigned)(t + 2) * kstep;
            const unsigned a3 = a2 + kstep, b3 = b2 + kstep;
            if constexpr (SP2) {
            PG8_LDB(B0, 0, 0); PG8_LDB(B1, 0, 1); PG8_SCHED; PG8_LDA(At, 0, 0); PG8_STAGE(PG8_SA(1, 1), a1 + hstepA, voffA);
            PG8_WAIT_V(8); PG8_WAIT_L(0); PG8_BAR; PG8_MMA(0, 0, At, B0); PG8_MMA(0, 1, At, B1); PG8_BAR; PG8_SCHED;
            PG8_LDA(At, 0, 1); PG8_STAGE(PG8_SB(0, 0), b2, voffB); PG8_STAGE(PG8_SB(0, 1), b2 + hstepB, voffB); PG8_STAGE(PG8_SA(0, 0), a2, voffA);
            PG8_WAIT_V(8); PG8_WAIT_L(0); PG8_BAR; PG8_MMA(1, 0, At, B0); PG8_MMA(1, 1, At, B1); PG8_BAR; PG8_SCHED;
            PG8_LDB(B0, 1, 0); PG8_LDB(B1, 1, 1); PG8_SCHED; PG8_LDA(At, 1, 0); PG8_STAGE(PG8_SA(0, 1), a2 + hstepA, voffA);
            PG8_WAIT_V(8); PG8_WAIT_L(0); PG8_BAR; PG8_MMA(0, 0, At, B0); PG8_MMA(0, 1, At, B1); PG8_BAR; PG8_SCHED;
            PG8_LDA(At, 1, 1); PG8_STAGE(PG8_SB(1, 0), b3, voffB); PG8_STAGE(PG8_SB(1, 1), b3 + hstepB, voffB); PG8_STAGE(PG8_SA(1, 0), a3, voffA);
            PG8_WAIT_V(8); PG8_WAIT_L(0); PG8_BAR; PG8_MMA(1, 0, At, B0); PG8_MMA(1, 1, At, B1); PG8_BAR; PG8_SCHED;
            } else {
            PG8_LDB(B0, 0, 0); PG8_SCHED; PG8_LDA(At, 0, 0); PG8_STAGE(PG8_SA(1, 1), a1 + hstepA, voffA);
            PG8_WAIT_L(8); PG8_BAR; PG8_WAIT_L(0); PG8_MMA(0, 0, At, B0); PG8_BAR; PG8_SCHED;
            PG8_LDB(B1, 0, 1); PG8_STAGE(PG8_SB(0, 0), b2, voffB);
            PG8_BAR; PG8_WAIT_L(0); PG8_MMA(0, 1, At, B1); PG8_BAR;
            PG8_LDA(At, 0, 1); PG8_STAGE(PG8_SA(0, 0), a2, voffA);
            PG8_BAR; PG8_WAIT_L(0); PG8_MMA(1, 0, At, B0); PG8_BAR; PG8_SCHED;
            PG8_STAGE(PG8_SB(0, 1), b2 + hstepB, voffB);
            PG8_WAIT_V(6); PG8_BAR; PG8_MMA(1, 1, At, B1); PG8_BAR;
            PG8_LDB(B0, 1, 0); PG8_SCHED; PG8_LDA(At, 1, 0); PG8_STAGE(PG8_SA(0, 1), a2 + hstepA, voffA);
            PG8_WAIT_L(8); PG8_BAR; PG8_WAIT_L(0); PG8_MMA(0, 0, At, B0); PG8_BAR; PG8_SCHED;
            PG8_LDB(B1, 1, 1); PG8_STAGE(PG8_SB(1, 0), b3, voffB);
            PG8_BAR; PG8_WAIT_L(0); PG8_MMA(0, 1, At, B1); PG8_BAR;
            PG8_LDA(At, 1, 1); PG8_STAGE(PG8_SA(1, 0), a3, voffA);
            PG8_BAR; PG8_WAIT_L(0); PG8_MMA(1, 0, At, B0); PG8_BAR; PG8_SCHED;
            PG8_STAGE(PG8_SB(1, 1), b3 + hstepB, voffB);
            PG8_WAIT_V(6); PG8_BAR; PG8_MMA(1, 1, At, B1); PG8_BAR;
            }
        }
        if constexpr (ALIGN_EPI) { if (wr == 0) PG8_BAR; }
        { int fr_e = fr, fq_e = fq; asm volatile("" : "+v"(fr_e), "+v"(fq_e));
          E(acc, cur, wr, wc, fr_e, fq_e); }
        if (!has_next) break;
#pragma unroll
        for (int a = 0; a < 2; ++a)
#pragma unroll
            for (int b = 0; b < 2; ++b)
#pragma unroll
                for (int m = 0; m < 4; ++m)
#pragma unroll
                    for (int n = 0; n < 2; ++n) acc[a][b][m][n] = (f32x4){0.f, 0.f, 0.f, 0.f};
        cur = nxt; cA = nA; cB = nB; ++ui;
        if constexpr (ALIGN_EPI) { if (wr == 1) PG8_BAR; }
    }
    PG8_WAIT_V(0);
    if constexpr (!ALIGN_EPI) { if (wr == 0) PG8_BAR; }
    PG8_BAR;
#undef PG8_SA
#undef PG8_SB
#undef PG8_STAGE
#undef p2voffA
#undef p2voffB
#undef PG8_LDA
#undef PG8_LDB
#undef PG8_MMA
#undef PG8_CAT
#undef PG8_WAIT_V
#undef PG8_WAIT_L
#undef PG8_BAR
#undef PG8_SCHED
}
}
using pg8::Unit;

constexpr size_t MiB = 1u << 20;
constexpr size_t WS_CTL = 0, CTL_ZERO_BYTES = 1 * MiB;
constexpr size_t WS_WIN = 1 * MiB;
constexpr size_t WS_WQ = 7 * MiB;
constexpr size_t WS_WKV = WS_WQ + 512 * 1024;
constexpr size_t WS_WPOOL = 8 * MiB;
constexpr size_t WS_WAO = 9 * MiB;
constexpr size_t WS_WPO = 10 * MiB;
constexpr size_t WS_WO = 11 * MiB;
constexpr size_t WS_WPG = 13 * MiB;
constexpr size_t WS_WPLE = 15 * MiB;
constexpr size_t WS_WGU = 16 * MiB;
constexpr size_t WS_WD = 144 * MiB;
constexpr size_t WS_HN = 208 * MiB;
constexpr size_t WS_PROJ = 240 * MiB;
constexpr size_t WS_GATES = 272 * MiB;
constexpr size_t WS_A2 = 336 * MiB;
constexpr size_t WS_POOLED = 352 * MiB;
constexpr size_t WS_Q = 368 * MiB;
constexpr size_t WS_K = 392 * MiB;
constexpr size_t WS_V = 416 * MiB;
constexpr size_t WS_ATT = 432 * MiB;
constexpr size_t WS_MIXED = 448 * MiB;
constexpr size_t WS_MIX = 464 * MiB;
constexpr size_t WS_PB = 496 * MiB;
constexpr size_t WS_E = 504 * MiB;
constexpr size_t WS_SSQ = 536 * MiB;
constexpr size_t WS_COS = 537 * MiB;
constexpr size_t WS_SIN = 538 * MiB;
constexpr size_t WS_ROUTE = 539 * MiB;
constexpr size_t WS_XS = 544 * MiB;
constexpr size_t WS_ACT = 688 * MiB;
constexpr size_t WS_XS2 = 768 * MiB;
constexpr size_t WS_END = 848 * MiB;
constexpr int CW_BAR = 4096;
constexpr int CW_CNT = 1024;

constexpr int RING_BYTES = 131072;
constexpr int LDS_BYTES = 163840;
constexpr int MISC_OFF = LDS_BYTES - 512;
constexpr int TILE_E_OFF = LDS_BYTES - 4096;
constexpr int NWAVES = 8;

typedef GAS unsigned gu32;
#define RLX_AGENT __ATOMIC_RELAXED, __HIP_MEMORY_SCOPE_AGENT
#define XB_TMO      128
#define XB_XCNT(j)  (256  + 64 * (j))
#define XB_XSUB(j)  (1280 + 64 * (j))
#define XB_XGEN(j)  (2304 + 64 * (j))
#define XB_TOP      3328
#define XB_TOPGEN   3392
#define XCD_BAR_WORDS 3456
#define XB_SPIN_CAP (1u << 18)
__device__ __forceinline__ unsigned xb_ld(unsigned* p)              { return __hip_atomic_load(p, __ATOMIC_RELAXED, __HIP_MEMORY_SCOPE_AGENT); }
__device__ __forceinline__ unsigned xb_add(unsigned* p, unsigned v) { return __hip_atomic_fetch_add(p, v, __ATOMIC_RELAXED, __HIP_MEMORY_SCOPE_AGENT); }
__device__ __forceinline__ unsigned xb_xcc_id() { return (unsigned)__builtin_amdgcn_s_getreg((3 << 11) | 20) & 0xFu; }
#define XB_SPIN(cond, bar) do { unsigned _sp = 0; while (cond) { __builtin_amdgcn_s_sleep(1); \
    if ((++_sp & 255u) == 0u) { if (xb_ld(&(bar)[XB_TMO])) break; if (_sp > XB_SPIN_CAP) { atomicAdd(&(bar)[XB_TMO], 1u); break; } } } } while (0)
struct XcdBarrier { unsigned* bar; unsigned x; volatile LAS unsigned* st; };
__device__ __forceinline__ XcdBarrier xcd_barrier_post(unsigned* bar, volatile LAS unsigned* st) {
    XcdBarrier b; b.bar = bar; b.x = xb_xcc_id(); b.st = st;
    if (threadIdx.x == 0) (void)xb_add(&bar[XB_XCNT(b.x)], 1u);
    return b;
}
__device__ __forceinline__ void xcd_barrier_complete(unsigned* bar, unsigned x, unsigned& nloc, unsigned& nx) {
    const unsigned G = gridDim.x * gridDim.y * gridDim.z;
    unsigned sum, cnt, mine, sp = 0u;
    for (;;) {
        sum = 0u; cnt = 0u; mine = 0u;
#pragma unroll
        for (unsigned j = 0; j < 16; ++j) { const unsigned c = xb_ld(&bar[XB_XCNT(j)]); sum += c; cnt += (c > 0u) ? 1u : 0u; mine = (j == x) ? c : mine; }
        if (sum == G) break;
        __builtin_amdgcn_s_sleep(1);
        if ((++sp & 255u) == 0u) { if (xb_ld(&bar[XB_TMO])) break; if (sp > XB_SPIN_CAP) { atomicAdd(&bar[XB_TMO], 1u); break; } }
    }
    nloc = mine > 0u ? mine : 1u; nx = cnt > 0u ? cnt : 1u;
}
__device__ __forceinline__ void xcd_barrier(const XcdBarrier& b) {
    asm volatile("s_waitcnt vmcnt(0)" ::: "memory");
    __syncthreads();
    if (threadIdx.x == 0) {
        unsigned* bar = b.bar;
        __builtin_amdgcn_s_waitcnt(0);
        unsigned nloc = b.st[0], nx = b.st[1];
        if (nloc == 0u) { xcd_barrier_complete(bar, b.x, nloc, nx); b.st[0] = nloc; b.st[1] = nx; }
        const unsigned old = xb_add(&bar[XB_XSUB(b.x)], 1u);
        const unsigned gen = old / nloc;
        if (old + 1u == (gen + 1u) * nloc) {
            __builtin_amdgcn_fence(__ATOMIC_RELEASE, "agent");
            asm volatile("s_waitcnt vmcnt(0)" ::: "memory");
            const unsigned og = xb_add(&bar[XB_TOP], 1u);
            const unsigned tg = og / nx;
            if (og + 1u == (tg + 1u) * nx) xb_add(&bar[XB_TOPGEN], 1u);
            else XB_SPIN(xb_ld(&bar[XB_TOPGEN]) == tg, bar);
            __builtin_amdgcn_fence(__ATOMIC_ACQUIRE, "agent");
            xb_add(&bar[XB_XGEN(b.x)], 1u);
            asm volatile("s_waitcnt vmcnt(0)" ::: "memory");
        } else {
            XB_SPIN(xb_ld(&bar[XB_XGEN(b.x)]) == gen, bar);
            __builtin_amdgcn_fence(__ATOMIC_ACQUIRE, "agent");
            asm volatile("s_waitcnt vmcnt(0)" ::: "memory");
        }
    }
    __syncthreads();
}

struct Args {
    const float* in[27];
    float* out; unsigned char* ws;
    int ph_lo, ph_hi;
};
typedef const __attribute__((address_space(4))) Args* KArgs;
__device__ __forceinline__ KArgs kargs() { KArgs p = (KArgs)__builtin_amdgcn_kernarg_segment_ptr(); asm volatile("" : "+s"(p)); return p; }
enum { I_X = 0, I_P, I_POS, I_GMIX, I_WIN, I_GQLAT, I_WQB, I_GKVLAT, I_WKVB, I_GQHEAD, I_GKNOPE, I_GKROPE, I_WPOOL, I_PSCALE, I_WAO, I_WPO, I_WO, I_GFFN,
       I_WR, I_BR, I_WGU, I_BGU, I_WD, I_BD, I_GPLE, I_WPG, I_WPLE };

enum { MAP_ID = 0, MAP_WIN, MAP_GU, MAP_QB, MAP_KVB };
__device__ __forceinline__ int map_row(int mode, int n) {
    switch (mode) {
    case MAP_WIN: return n < 416 ? n : n + 96;
    case MAP_GU: { const int j = n & 1023, up = n >> 10; return 256 * (j >> 7) + 128 * up + (j & 127); }
    case MAP_QB: { const int h = n / 96, d = n % 96;
        if (d < 64) return (h >> 2) * 256 + 128 * (d >> 5) + 32 * (h & 3) + (d & 31);
        const int dd = d - 64, half = dd >> 4, i = dd & 15; return 512 + 128 * (h & 1) + 32 * (h >> 1) + 8 * (i >> 2) + 4 * half + (i & 3); }
    case MAP_KVB: { const int h = n >> 7, c = n & 127, isv = c >> 6, d = c & 63; return (h >> 1) * 256 + 128 * (d >> 5) + 32 * (2 * isv + (h & 1)) + (d & 31); }
    default: return n;
    }
}
struct TJob { const float* W; int K, N; bf16_t* WT; int ldw, koff, mode, row_off; const float* gk; const float* gn; int nmat; size_t wstride, wtstride; int fp8; };
struct TItem { const float* src; bf16_t* dst; int n0, k0; float gnv; };
__device__ __forceinline__ TItem titem_setup(const TJob& J, int item, int lane) {
    const int nblk = J.N / 32, ipm = (J.K / 64) * nblk, mat = item / ipm, it = item - mat * ipm, kb = it / nblk, nb = it - kb * nblk;
    TItem I; I.k0 = 64 * kb; I.n0 = 32 * nb;
    I.src = J.W + (size_t)mat * J.wstride + (size_t)(I.k0 + (lane >> 5)) * J.N + I.n0 + (lane & 31);
    I.dst = (bf16_t*)((unsigned char*)J.WT + (size_t)mat * J.wtstride * (J.fp8 ? 1 : 2));
    I.gnv = J.gn ? J.gn[I.n0 + (lane & 31)] : 1.f;
    return I;
}
__device__ __forceinline__ void titem_load(const TJob& J, const TItem& I, float (&v)[32]) {
#pragma unroll
    for (int i = 0; i < 32; ++i) v[i] = I.src[(size_t)(2 * i) * J.N];
}
__device__ __forceinline__ void titem_store(const TJob& J, const TItem& I, float (&v)[32], LAS float* scr, int lane) {
#pragma unroll
    for (int i = 0; i < 32; ++i) { const int kk = 2 * i + (lane >> 5); float x = v[i] * I.gnv; if (J.gk) x *= J.gk[I.k0 + kk]; scr[kk * 33 + (lane & 31)] = x; }
    asm volatile("s_waitcnt lgkmcnt(0)" ::: "memory");
    const int c = lane & 7;
#pragma unroll
    for (int j = 0; j < 4; ++j) { const int n = (lane >> 3) + 8 * j; const LAS float* s = scr + (8 * c) * 33 + n;
        const size_t eo = (size_t)(J.row_off + map_row(J.mode, I.n0 + n)) * J.ldw + J.koff + I.k0 + 8 * c;
        if (J.fp8) { u32x2 o; int w = __builtin_amdgcn_cvt_pk_fp8_f32(s[0 * 33] * 8.f, s[1 * 33] * 8.f, 0, false); w = __builtin_amdgcn_cvt_pk_fp8_f32(s[2 * 33] * 8.f, s[3 * 33] * 8.f, w, true); o.x = (unsigned)w;
            w = __builtin_amdgcn_cvt_pk_fp8_f32(s[4 * 33] * 8.f, s[5 * 33] * 8.f, 0, false); w = __builtin_amdgcn_cvt_pk_fp8_f32(s[6 * 33] * 8.f, s[7 * 33] * 8.f, w, true); o.y = (unsigned)w;
            *(u32x2*)((unsigned char*)I.dst + eo) = o; }
        else { u32x4 o; o.x = cvt_pk_bf16(s[0 * 33], s[1 * 33]); o.y = cvt_pk_bf16(s[2 * 33], s[3 * 33]); o.z = cvt_pk_bf16(s[4 * 33], s[5 * 33]); o.w = cvt_pk_bf16(s[6 * 33], s[7 * 33]);
            *(u32x4*)(I.dst + eo) = o; } }
    asm volatile("s_waitcnt lgkmcnt(0)" ::: "memory");
}
__device__ __forceinline__ void run_job(const TJob& J, LAS float* scr, int gw, int NGW, int lane) {
    const int items = J.nmat * (J.K / 64) * (J.N / 32);
    for (int it = gw; it < items; it += 2 * NGW) {
        const bool two = (it + NGW) < items;
        const TItem I0 = titem_setup(J, it, lane); const TItem I1 = titem_setup(J, two ? it + NGW : it, lane);
        float v0[32], v1[32];
        titem_load(J, I0, v0); if (two) titem_load(J, I1, v1);
        titem_store(J, I0, v0, scr, lane); if (two) titem_store(J, I1, v1, scr, lane);
    }
}

struct Frame {
    LAS unsigned char* lds; volatile LAS unsigned* MISC; unsigned* ctl;
    int wave, vcu, G;
    float* out; unsigned char* ws;
};

__device__ __forceinline__ void p0_prologue(const Frame& F) {
    const int tid_l = tid_local(), lane_l = tid_l & 63; (void)tid_l; (void)lane_l;
    const KArgs a = kargs();
    LAS float* scr = (LAS float*)(F.lds + F.wave * 16384);
    const int gw = F.vcu * NWAVES + F.wave, NGW = F.G * NWAVES;
    unsigned char* ws = F.ws;
#define RUN_JOB(...) do { const TJob J_ = TJob{__VA_ARGS__, 1, 0, 0, 0}; run_job(J_, scr, gw, NGW, lane_l); } while (0)
#ifndef P1_FP8
#define P1_FP8 0
#endif
    { const TJob J_{a->in[I_WIN], 1024, 2976, (bf16_t*)(ws + WS_WIN), 1024, 0, MAP_WIN, 0, nullptr, nullptr, 1, 0, 0, P1_FP8}; run_job(J_, scr, gw, NGW, lane_l); }
    RUN_JOB(a->in[I_WQB], 256, 768, (bf16_t*)(ws + WS_WQ), 256, 0, MAP_QB, 0, a->in[I_GQLAT], nullptr);
    RUN_JOB(a->in[I_WKVB], 128, 1024, (bf16_t*)(ws + WS_WKV), 256, 0, MAP_KVB, 0, a->in[I_GKVLAT], nullptr);
    RUN_JOB(a->in[I_WAO], 512, 1024, (bf16_t*)(ws + WS_WAO), 512, 0, MAP_ID, 0, nullptr, nullptr);
    RUN_JOB(a->in[I_WPO], 512, 1024, (bf16_t*)(ws + WS_WPO), 512, 0, MAP_ID, 0, nullptr, nullptr);
    RUN_JOB(a->in[I_WO], 1024, 1024, (bf16_t*)(ws + WS_WO), 1024, 0, MAP_ID, 0, nullptr, nullptr);
    RUN_JOB(a->in[I_WPG], 1024, 1024, (bf16_t*)(ws + WS_WPG), 1024, 0, MAP_ID, 0, nullptr, nullptr);
    RUN_JOB(a->in[I_WPLE], 256, 1024, (bf16_t*)(ws + WS_WPLE), 256, 0, MAP_ID, 0, nullptr, nullptr);
    for (int g = 0; g < 4; ++g)
        RUN_JOB(a->in[I_WPOOL] + (size_t)g * 128 * 128, 128, 128, (bf16_t*)(ws + WS_WPOOL) + (size_t)(g >> 1) * 256 * 256, 256, 128 * (g & 1), MAP_ID, 128 * (g & 1), nullptr, a->in[I_PSCALE] + 128 * g);
    {
        const int gt = (F.vcu * NWAVES + F.wave) * 64 + lane_l, NGT = NGW * 64;
        const u32x4 z = {0u, 0u, 0u, 0u};
        u32x4* w0 = (u32x4*)(ws + WS_WIN + (size_t)416 * 1024 * (P1_FP8 ? 1 : 2));
        for (int i = gt; i < 96 * (P1_FP8 ? 64 : 128); i += NGT) w0[i] = z;
        for (int i = gt; i < 1024 * 16; i += NGT) { const int r = i >> 4, c = i & 15; *(u32x4*)((bf16_t*)(ws + WS_WKV) + (size_t)r * 256 + 128 + 8 * c) = z; }
        for (int i = gt; i < 2 * 256 * 16; i += NGT) { const int p = i >> 12, r = (i >> 4) & 255, c = i & 15;
            const int k0 = (r < 128) ? 128 : 0; *(u32x4*)((bf16_t*)(ws + WS_WPOOL) + (size_t)p * 65536 + (size_t)r * 256 + k0 + 8 * c) = z; }
    }
#ifndef CONV_IN_ATTN
#define CONV_IN_ATTN 1
#endif
    if (!CONV_IN_ATTN) {
    { const TJob J{a->in[I_WGU], 1024, 2048, (bf16_t*)(ws + WS_WGU), 1024, 0, MAP_GU, 0, nullptr, nullptr, NEXP, (size_t)1024 * 2048, (size_t)2048 * 1024, 1}; run_job(J, scr, gw, NGW, lane_l); }
    { const TJob J{a->in[I_WD], 1024, 1024, (bf16_t*)(ws + WS_WD), 1024, 0, MAP_ID, 0, nullptr, nullptr, NEXP, (size_t)1024 * 1024, (size_t)1024 * 1024, 1}; run_job(J, scr, gw, NGW, lane_l); }
    }
    const float* x = a->in[I_X]; const float* gm = a->in[I_GMIX];
    f32x4 gv[4];
#pragma unroll
    for (int j = 0; j < 4; ++j) gv[j] = *(const f32x4*)(gm + 4 * lane_l + 256 * j);
    for (int m = gw; m < T; m += NGW) {
        const f32x4* xr = (const f32x4*)(x + (size_t)m * DM) + lane_l;
        f32x4 v[4]; float s = 0.f;
#pragma unroll
        for (int j = 0; j < 4; ++j) { v[j] = xr[64 * j]; s += (v[j].x * v[j].x + v[j].y * v[j].y) + (v[j].z * v[j].z + v[j].w * v[j].w); }
        const float rstd = 1.0f / sqrtf(wave_sum(s) * (1.f / DM) + EPS);
        if (P1_FP8) { int* o4 = (int*)(ws + WS_HN + (size_t)m * DM) + lane_l; const float r8 = rstd * 8.0f;
#pragma unroll
            for (int j = 0; j < 4; ++j) { int w = __builtin_amdgcn_cvt_pk_fp8_f32(v[j].x * r8 * gv[j].x, v[j].y * r8 * gv[j].y, 0, false); w = __builtin_amdgcn_cvt_pk_fp8_f32(v[j].z * r8 * gv[j].z, v[j].w * r8 * gv[j].w, w, true); o4[64 * j] = w; } }
        else { u32x2* o8 = (u32x2*)((bf16_t*)(ws + WS_HN) + (size_t)m * DM) + lane_l;
#pragma unroll
            for (int j = 0; j < 4; ++j) { u32x2 w; w.x = cvt_pk_bf16(v[j].x * rstd * gv[j].x, v[j].y * rstd * gv[j].y); w.y = cvt_pk_bf16(v[j].z * rstd * gv[j].z, v[j].w * rstd * gv[j].w); o8[64 * j] = w; } }
    }
    {
        const float* p = a->in[I_P];
        for (int m = gw; m < T; m += NGW) { const f32x4 v = *((const f32x4*)(p + (size_t)m * PLE) + lane_l); u32x2 w; w.x = cvt_pk_bf16(v.x, v.y); w.y = cvt_pk_bf16(v.z, v.w);
            *((u32x2*)((bf16_t*)(ws + WS_PB) + (size_t)m * PLE) + lane_l) = w; }
    }
}

struct DenseOrder {
    int nM, nN, nwg, G, c; unsigned A, B, tA, tB, aPn;
    __device__ void init(int nM_, int nN_, int G_, int c_, size_t A_, size_t lda, size_t B_, size_t ldb, unsigned aPn_ = 0) { nM = nM_; nN = nN_; nwg = nM * nN; G = G_; c = c_; A = (unsigned)A_; B = (unsigned)B_; tA = (unsigned)(256 * lda * 2); tB = (unsigned)(256 * ldb * 2); aPn = aPn_; }
    __device__ __forceinline__ bool next(int i, Unit& u) const {
        const long L = (long)i * G + c; if (L >= nwg) return false;
        int wgid = (int)L; { const int q = nwg / 8, r = nwg % 8, xcd = wgid % 8, off = wgid / 8; wgid = (xcd < r ? xcd * (q + 1) : r * (q + 1) + (xcd - r) * q) + off; }
        const int WGM = 8; const int nig = WGM * nN, gid = wgid / nig, fm = gid * WGM, gsz = (nM - fm) < WGM ? (nM - fm) : WGM;
        u.pm = fm + ((wgid % nig) % gsz); u.pn = (wgid % nig) / gsz; u.aux = 0; return true;
    }
    __device__ __forceinline__ unsigned a_off(const Unit& u) const { return A + (unsigned)u.pm * tA + (unsigned)u.pn * aPn; }
    __device__ __forceinline__ unsigned b_off(const Unit& u) const { return B + (unsigned)u.pn * tB; }
};

struct EpiBf16 {
    static constexpr bool PERM = true;
    bf16_t* O; int ldc;
    __device__ __forceinline__ void operator()(const f32x4 (&acc)[2][2][4][2], const Unit& u, int wr, int wc, int fr, int fq) const {
        const int row0 = u.pm * 256 + wr * 64 + fr, col0 = u.pn * 256 + wc * 32 + 8 * fq;
#pragma unroll
        for (int ai = 0; ai < 2; ++ai)
#pragma unroll
            for (int m = 0; m < 4; ++m) { bf16_t* rowp = O + (size_t)(row0 + ai * 128 + m * 16) * ldc + col0;
#pragma unroll
                for (int bj = 0; bj < 2; ++bj) { const f32x4 v0 = acc[ai][bj][m][0], v1 = acc[ai][bj][m][1];
                    u32x4 w; w.x = cvt_pk_bf16(v0[0], v0[1]); w.y = cvt_pk_bf16(v0[2], v0[3]); w.z = cvt_pk_bf16(v1[0], v1[1]); w.w = cvt_pk_bf16(v1[2], v1[3]);
                    *(u32x4*)(rowp + bj * 128) = w; } }
    }
};
struct EpiProj {
    static constexpr bool PERM = true;
    bf16_t* PROJ; bf16_t* GATES;
    __device__ __forceinline__ void operator()(const f32x4 (&acc)[2][2][4][2], const Unit& u, int wr, int wc, int fr, int fq) const {
        const int row0 = u.pm * 256 + wr * 64 + fr; const bool isg = u.pn >= 4;
        bf16_t* O = isg ? GATES : PROJ; const int ldc = isg ? 2048 : 1024; const int col0 = (isg ? u.pn - 4 : u.pn) * 256 + wc * 32 + 8 * fq;
#pragma unroll
        for (int ai = 0; ai < 2; ++ai)
#pragma unroll
            for (int m = 0; m < 4; ++m) { bf16_t* rowp = O + (size_t)(row0 + ai * 128 + m * 16) * ldc + col0;
#pragma unroll
                for (int bj = 0; bj < 2; ++bj) { f32x4 v0 = acc[ai][bj][m][0], v1 = acc[ai][bj][m][1];
                    if (isg) {
#pragma unroll
                        for (int e = 0; e < 4; ++e) { v0[e] = fast_sigmoid(v0[e]); v1[e] = fast_sigmoid(v1[e]); } }
                    u32x4 w; w.x = cvt_pk_bf16(v0[0], v0[1]); w.y = cvt_pk_bf16(v0[2], v0[3]); w.z = cvt_pk_bf16(v1[0], v1[1]); w.w = cvt_pk_bf16(v1[2], v1[3]);
                    *(u32x4*)(rowp + bj * 128) = w; } asm volatile("" ::: "memory"); }
    }
};

__device__ __forceinline__ void p2_rows(const Frame& F) {
    const int tid_l = tid_local(), lane_l = tid_l & 63; (void)tid_l; (void)lane_l;
    const KArgs a = kargs();
    const int gw = F.vcu * NWAVES + F.wave, NGW = F.G * NWAVES, lane = lane_l;
    unsigned char* ws = F.ws;
    const bf16_t* PROJ = (const bf16_t*)(ws + WS_PROJ);
    bf16_t* A2 = (bf16_t*)(ws + WS_A2); bf16_t* POOLED = (bf16_t*)(ws + WS_POOLED); bf16_t* Kb = (bf16_t*)(ws + WS_K);
    float* COS = (float*)(ws + WS_COS); float* SIN = (float*)(ws + WS_SIN);
    const int* positions = (const int*)a->in[I_POS];
    const float gkr = (lane < 32) ? a->in[I_GKROPE][lane] : 0.f;
    const float inv_freq = __builtin_amdgcn_exp2f(-(float)(lane & 15) * (13.287712379549449f / 16.0f));
    const int w = 2 << (lane >> 4);
    for (int task = gw; task < T / 8; task += NGW) {
        const int t0 = task * 8, b = t0 / SEQ, s0 = t0 % SEQ;
        {
            const bf16_t* base = PROJ + (size_t)(b * SEQ) * 1024 + 512 + 8 * lane;
            float S[8];
#pragma unroll
            for (int j = 0; j < 8; ++j) S[j] = 0.f;
            for (int r = s0 - 15; r < s0; ++r) {
                if (r >= 0 && r >= s0 - w + 1) { const u32x4 v = *(const u32x4*)(base + (size_t)r * 1024);
                    S[0] += bf_lo(v.x); S[1] += bf_hi(v.x); S[2] += bf_lo(v.y); S[3] += bf_hi(v.y); S[4] += bf_lo(v.z); S[5] += bf_hi(v.z); S[6] += bf_lo(v.w); S[7] += bf_hi(v.w); }
            }
#pragma unroll
            for (int i = 0; i < 8; ++i) {
                const int s = s0 + i;
                const u32x4 v = *(const u32x4*)(base + (size_t)s * 1024);
                float uu[8] = {bf_lo(v.x), bf_hi(v.x), bf_lo(v.y), bf_hi(v.y), bf_lo(v.z), bf_hi(v.z), bf_lo(v.w), bf_hi(v.w)};
                const int cnt = (s + 1 < w) ? s + 1 : w; const float ic = 1.0f / (float)cnt;
                float o[8];
#pragma unroll
                for (int j = 0; j < 8; ++j) { S[j] += uu[j]; o[j] = S[j] * ic - uu[j]; }
                u32x4 wv; wv.x = cvt_pk_bf16(o[0], o[1]); wv.y = cvt_pk_bf16(o[2], o[3]); wv.z = cvt_pk_bf16(o[4], o[5]); wv.w = cvt_pk_bf16(o[6], o[7]);
                *(u32x4*)(POOLED + (size_t)(t0 + i) * 512 + 8 * lane) = wv;
                const int rr = s - w + 1;
                if (rr >= 0) { const u32x4 q = *(const u32x4*)(base + (size_t)rr * 1024);
                    S[0] -= bf_lo(q.x); S[1] -= bf_hi(q.x); S[2] -= bf_lo(q.y); S[3] -= bf_hi(q.y); S[4] -= bf_lo(q.z); S[5] -= bf_hi(q.z); S[6] -= bf_lo(q.w); S[7] -= bf_hi(q.w); }
            }
        }
        for (int i = 0; i < 8; ++i) {
            const int t = t0 + i, s = s0 + i;
            const bf16_t* pr = PROJ + (size_t)t * 1024;
            const u32x2 ql = *(const u32x2*)(pr + 4 * lane);
            const unsigned kvl = *(const unsigned*)(pr + 256 + 2 * lane);
            const float krv = (lane < 32) ? bf1(pr[384 + lane]) : 0.f;
            const float q0 = bf_lo(ql.x), q1 = bf_hi(ql.x), q2 = bf_lo(ql.y), q3 = bf_hi(ql.y);
            const float k0 = bf_lo(kvl), k1 = bf_hi(kvl);
            const float sq = wave_sum((q0 * q0 + q1 * q1) + (q2 * q2 + q3 * q3));
            const float sk = wave_sum(k0 * k0 + k1 * k1);
            const float sr = wave_sum(krv * krv);
            const float rq = 1.0f / sqrtf(sq * (1.f / 256.f) + EPS), rk = 1.0f / sqrtf(sk * (1.f / 128.f) + EPS), rr = 1.0f / sqrtf(sr * (1.f / 32.f) + EPS);
            u32x2 wq; wq.x = cvt_pk_bf16(q0 * rq, q1 * rq); wq.y = cvt_pk_bf16(q2 * rq, q3 * rq);
            *(u32x2*)(A2 + (size_t)t * 512 + 4 * lane) = wq;
            *(unsigned*)(A2 + (size_t)t * 512 + 256 + 2 * lane) = cvt_pk_bf16(k0 * rk, k1 * rk);
            *(unsigned*)(A2 + (size_t)t * 512 + 384 + 2 * lane) = 0u;
            const float pos = (float)positions[t];
            const float ang = pos * inv_freq;
            const float rev = ang * 0.15915494309189535f;
            const float fr_ = rev - floorf(rev);
            const float sn = __builtin_amdgcn_sinf(fr_), cs = __builtin_amdgcn_cosf(fr_);
            const float kn = krv * rr * gkr;
            const float other = __shfl_xor(kn, 16);
            const float ro = (lane & 16) ? (kn * cs + other * sn) : (kn * cs - other * sn);
            if (lane < 32) {
                const bf16_t rb = (bf16_t)(cvt_pk_bf16(ro, 0.f) & 0xffffu);
#pragma unroll
                for (int h = 0; h < NH; ++h) Kb[((size_t)(b * NH + h) * SEQ + s) * DK + 64 + lane] = rb;
            }
            if (lane < 16) { COS[(size_t)t * 16 + lane] = cs; SIN[(size_t)t * 16 + lane] = sn; }
        }
    }
}

#define EPI_FENCE() asm volatile("" ::: "memory")
struct EpiQ {
    static constexpr bool PERM = true;
    bf16_t* Q; float* SSQ; const float* COS; const float* SIN; const float* gq;
    __device__ __forceinline__ void operator()(const f32x4 (&acc)[2][2][4][2], const Unit& u, int wr, int wc, int fr, int fq) const {
        const int t0 = u.pm * 256 + wr * 64 + fr, b = (u.pm * 256) / SEQ, s0 = t0 - b * SEQ;
        if (u.pn < 2) {
            const int h = 4 * u.pn + wc;
            bf16_t* dst0 = Q + ((size_t)(b * NH + h) * SEQ + s0) * DK + 8 * fq;
            float* ssq0 = SSQ + ((size_t)t0 * NH + h) * 2;
#pragma unroll
            for (int ai = 0; ai < 2; ++ai)
#pragma unroll
                for (int m = 0; m < 4; ++m) {
                    const int dr = ai * 128 + m * 16;
                    float q = 0.f;
#pragma unroll
                    for (int bj = 0; bj < 2; ++bj)
#pragma unroll
                        for (int n = 0; n < 2; ++n) { const f32x4 v = acc[ai][bj][m][n]; q += (v[0] * v[0] + v[1] * v[1]) + (v[2] * v[2] + v[3] * v[3]); }
                    q += __shfl_xor(q, 16); q += __shfl_xor(q, 32);
                    if (fq == 0) ssq0[dr * NH * 2] = q;
#pragma unroll
                    for (int bj = 0; bj < 2; ++bj) { const f32x4 v0 = acc[ai][bj][m][0] * *(const f32x4*)(gq + 32 * bj + 8 * fq), v1 = acc[ai][bj][m][1] * *(const f32x4*)(gq + 32 * bj + 8 * fq + 4);
                        u32x4 w; w.x = cvt_pk_bf16(v0[0], v0[1]); w.y = cvt_pk_bf16(v0[2], v0[3]); w.z = cvt_pk_bf16(v1[0], v1[1]); w.w = cvt_pk_bf16(v1[2], v1[3]);
                        *(u32x4*)(dst0 + dr * DK + 32 * bj) = w; }
                    EPI_FENCE();
                }
        } else {
            const f32x4 g1 = *(const f32x4*)(gq + 64 + 4 * fq), g2 = *(const f32x4*)(gq + 80 + 4 * fq);
            const float* cs0 = COS + (size_t)t0 * 16 + 4 * fq; const float* sn0 = SIN + (size_t)t0 * 16 + 4 * fq;
            bf16_t* dst0 = Q + ((size_t)(b * NH + 2 * wc) * SEQ + s0) * DK + 64 + 4 * fq;
            float* ssq0 = SSQ + ((size_t)t0 * NH + 2 * wc) * 2 + 1;
#pragma unroll
            for (int ai = 0; ai < 2; ++ai)
#pragma unroll
                for (int m = 0; m < 4; ++m) {
                    const int dr = ai * 128 + m * 16;
                    const f32x4 cs = *(const f32x4*)(cs0 + dr * 16), sn = *(const f32x4*)(sn0 + dr * 16);
#pragma unroll
                    for (int bj = 0; bj < 2; ++bj) {
                        const f32x4 x1 = acc[ai][bj][m][0], x2 = acc[ai][bj][m][1];
                        float q = (x1[0] * x1[0] + x1[1] * x1[1]) + (x1[2] * x1[2] + x1[3] * x1[3]) + (x2[0] * x2[0] + x2[1] * x2[1]) + (x2[2] * x2[2] + x2[3] * x2[3]);
                        q += __shfl_xor(q, 16); q += __shfl_xor(q, 32);
                        if (fq == 0) ssq0[dr * NH * 2 + bj * 2] = q;
                        const f32x4 y1 = x1 * g1, y2 = x2 * g2;
                        const f32x4 o1 = y1 * cs - y2 * sn, o2 = y2 * cs + y1 * sn;
                        bf16_t* dst = dst0 + (size_t)bj * SEQ * DK + dr * DK;
                        u32x2 w1, w2; w1.x = cvt_pk_bf16(o1[0], o1[1]); w1.y = cvt_pk_bf16(o1[2], o1[3]); w2.x = cvt_pk_bf16(o2[0], o2[1]); w2.y = cvt_pk_bf16(o2[2], o2[3]);
                        *(u32x2*)(dst) = w1; *(u32x2*)(dst + 16) = w2;
                    }
                    EPI_FENCE();
                }
        }
    }
};
struct EpiKV {
    static constexpr bool PERM = true;
    bf16_t* K; bf16_t* V; const float* gk;
    __device__ __forceinline__ void operator()(const f32x4 (&acc)[2][2][4][2], const Unit& u, int wr, int wc, int fr, int fq) const {
        const int t0 = u.pm * 256 + wr * 64 + fr, b = (u.pm * 256) / SEQ, s0 = t0 - b * SEQ;
        const int h = 2 * u.pn + (wc & 1); const bool isv = wc >= 2;
        const int pitch = isv ? DV : DK;
        bf16_t* dst0 = (isv ? V : K) + ((size_t)(b * NH + h) * SEQ + s0) * pitch + 8 * fq;
#pragma unroll
        for (int ai = 0; ai < 2; ++ai)
#pragma unroll
            for (int m = 0; m < 4; ++m) {
                const int dr = ai * 128 + m * 16;
                float sc = 1.f;
                if (!isv) { float q = 0.f;
#pragma unroll
                    for (int bj = 0; bj < 2; ++bj)
#pragma unroll
                        for (int n = 0; n < 2; ++n) { const f32x4 v = acc[ai][bj][m][n]; q += (v[0] * v[0] + v[1] * v[1]) + (v[2] * v[2] + v[3] * v[3]); }
                    q += __shfl_xor(q, 16); q += __shfl_xor(q, 32);
                    sc = 1.0f / sqrtf(q * (1.f / 64.f) + EPS); }
#pragma unroll
                for (int bj = 0; bj < 2; ++bj) {
                    f32x4 v0 = acc[ai][bj][m][0] * sc, v1 = acc[ai][bj][m][1] * sc;
                    if (!isv) { v0 = v0 * *(const f32x4*)(gk + 32 * bj + 8 * fq); v1 = v1 * *(const f32x4*)(gk + 32 * bj + 8 * fq + 4); }
                    u32x4 w; w.x = cvt_pk_bf16(v0[0], v0[1]); w.y = cvt_pk_bf16(v0[2], v0[3]); w.z = cvt_pk_bf16(v1[0], v1[1]); w.w = cvt_pk_bf16(v1[2], v1[3]);
                    *(u32x4*)(dst0 + dr * pitch + 32 * bj) = w; }
                EPI_FENCE();
            }
    }
};

namespace att {
constexpr int KT_BYTES = 64 * 192, VT_BYTES = 64 * 128, SLOT_BYTES = KT_BYTES + VT_BYTES;
constexpr int NSLOT = 4, SCR_OFF = NSLOT * SLOT_BYTES;
__device__ __forceinline__ int crow(int r, int hi) { return (r & 3) + 8 * (r >> 2) + 4 * hi; }
__device__ __forceinline__ s16x4 vtr(const LAS unsigned char* p) { typedef short v4i16_t __attribute__((ext_vector_type(4)));
    return __builtin_bit_cast(s16x4, __builtin_amdgcn_ds_read_tr16_b64_v4i16((LAS v4i16_t*)p)); }
#define MFMA32(a, b, c) __builtin_amdgcn_mfma_f32_32x32x16_bf16(a, b, c, 0, 0, 0)
__device__ __forceinline__ float max3f(float a, float b, float c) { return __builtin_fmaxf(__builtin_fmaxf(a, b), c); }


constexpr int CONV_OFF = SCR_OFF + 8 * 256, CONV_BYTES = 8192;
constexpr int CV_GU_ITEMS = NEXP * 1024, CV_ITEMS = CV_GU_ITEMS + NEXP * 512;
struct ConvItem { const float* src; unsigned char* dst; int N, isgu, n0; };
__device__ __forceinline__ ConvItem cv_setup(int g, const float* wgu, const float* wd, unsigned char* wgu8, unsigned char* wd8) {
    ConvItem I;
    if (g < CV_GU_ITEMS) { const int e = g >> 10, it = g & 1023, kb = it >> 6, nb = it & 63; I.N = 2048; I.isgu = 1; I.n0 = 32 * nb;
        I.src = wgu + (size_t)e * 1024 * 2048 + (size_t)(64 * kb) * 2048 + 32 * nb; I.dst = wgu8 + (size_t)e * 2048 * 1024 + 64 * kb; }
    else { const int g2 = g - CV_GU_ITEMS, e = g2 >> 9, it = g2 & 511, kb = it >> 5, nb = it & 31; I.N = 1024; I.isgu = 0; I.n0 = 32 * nb;
        I.src = wd + (size_t)e * 1024 * 1024 + (size_t)(64 * kb) * 1024 + 32 * nb; I.dst = wd8 + (size_t)e * 1024 * 1024 + 64 * kb; }
    return I;
}
__device__ __forceinline__ void cv_dma(const ConvItem& I, unsigned ldsaddr, int lane) {
    const int kr = lane >> 3, sl = lane & 7;
#pragma unroll
    for (int q = 0; q < 8; ++q) { const unsigned voff = (unsigned)(((8 * q + kr) * I.N + 4 * (sl ^ ((kr ^ q) & 7))) * 4);
        asm volatile("s_nop 4\n\ts_mov_b32 m0, %0\n\ts_nop 0\n\tglobal_load_lds_dwordx4 %1, %2" :: "s"(ldsaddr + (unsigned)q * 1024u), "v"(voff), "s"(I.src) : "m0", "memory"); }
}
__device__ __forceinline__ void cv_out(const ConvItem& I, const LAS float* cb, int lane) {
    const int c = lane & 7;
#pragma unroll
    for (int j = 0; j < 4; ++j) { const int n = (lane >> 3) + 8 * j, nc = n >> 2, e = n & 3;
        float f[8];
#pragma unroll
        for (int kk = 0; kk < 8; ++kk) f[kk] = cb[(8 * c + kk) * 32 + ((nc ^ kk ^ c) & 7) * 4 + e];
        const int nn = I.n0 + n; const int row = I.isgu ? (256 * ((nn & 1023) >> 7) + 128 * (nn >> 10) + (nn & 127)) : nn;
        *(u32x2*)(I.dst + (size_t)row * 1024 + 8 * c) = cvt8_fp8((f32x4){f[0], f[1], f[2], f[3]}, (f32x4){f[4], f[5], f[6], f[7]}, 8.0f);
        asm volatile("" ::: "memory"); }
}
struct ConvState { int next, end, cur; };
__device__ __forceinline__ void attn_unit(LAS unsigned char* lds, const u32x4 srd, ConvState& CV, unsigned char* cvws, int bh, int qb, const bf16_t* Q, unsigned Koff, unsigned Voff, const float* SSQ, bf16_t* O) {
    const int tid = tid_local(), lane = tid & 63, r32 = lane & 31, hi = lane >> 5; const int wid = __builtin_amdgcn_readfirstlane(tid >> 6);
    const int b = bh / NH, h = bh % NH, q0 = qb * 256, qw = q0 + 32 * wid;
    LAS float* scr = (LAS float*)(lds + SCR_OFF) + wid * 64;
    const int NT = (q0 + 256) / 64;
    const unsigned kS = Koff + (unsigned)bh * (SEQ * DK * 2), vS = Voff + (unsigned)bh * (SEQ * DV * 2);
    const int kc2 = 8 + (wid & 3);
    const unsigned vK1 = (unsigned)(lane * 192 + wid * 16); const unsigned sK2 = (unsigned)((kc2 - wid) * 16);
    const int vkey = 8 * wid + (lane >> 3); const unsigned vV = (unsigned)(vkey * 128 + (((lane & 7) ^ (((vkey >> 1) & 1) * 4)) * 16));
    const unsigned lds0 = (unsigned)__builtin_amdgcn_readfirstlane((int)(unsigned)(unsigned long)lds);
    const unsigned dK1 = (unsigned)wid * 1024u, dK2 = (unsigned)kc2 * 1024u, dV = (unsigned)KT_BYTES + (unsigned)wid * 1024u;
#define ATT_DMA1(ldsaddr, voff, soff) asm volatile("s_nop 4\n\ts_mov_b32 m0, %0\n\ts_nop 0\n\tbuffer_load_dwordx4 %1, %2, %3 offen lds" :: "s"(ldsaddr), "v"(voff), "s"(srd), "s"(soff) : "m0", "memory")
#define ATT_DMA(t) do { const unsigned sp_ = lds0 + (unsigned)((t) & 3) * SLOT_BYTES; const unsigned ks_ = kS + (unsigned)(t) * (64 * 192), vs_ = vS + (unsigned)(t) * (64 * 128); \
        ATT_DMA1(sp_ + dK1, vK1, ks_); ATT_DMA1(sp_ + dK2, vK1, ks_ + sK2); ATT_DMA1(sp_ + dV, vV, vs_); } while (0)
#define ATT_WAITBAR(N) asm volatile("s_waitcnt vmcnt(" #N ") lgkmcnt(0)\n\ts_barrier" ::: "memory")
    bf16x8 qr[6];
    { const float* sp = SSQ + ((size_t)(b * SEQ + qw + r32) * NH + h) * 2; const float ss = sp[0] + sp[1];
      const float cq = (1.0f / sqrtf(ss * (1.f / 96.f) + EPS)) * 0.10206207261596577f * 1.4426950408889634f;
      const bf16_t* qp = Q + ((size_t)bh * SEQ + qw + r32) * DK + 8 * hi;
      u32x4 qw_[6];
#pragma unroll
      for (int d0 = 0; d0 < 6; ++d0) qw_[d0] = *(const u32x4*)(qp + 16 * d0);
#pragma unroll
      for (int d0 = 0; d0 < 6; ++d0) { const u32x4 w = qw_[d0]; u32x4 o;
          o.x = cvt_pk_bf16(bf_lo(w.x) * cq, bf_hi(w.x) * cq); o.y = cvt_pk_bf16(bf_lo(w.y) * cq, bf_hi(w.y) * cq); o.z = cvt_pk_bf16(bf_lo(w.z) * cq, bf_hi(w.z) * cq); o.w = cvt_pk_bf16(bf_lo(w.w) * cq, bf_hi(w.w) * cq);
          qr[d0] = __builtin_bit_cast(bf16x8, o); } }
    ATT_DMA(0); ATT_DMA(1); ATT_DMA(2);
    const int kbase = hi * 1024 + r32 * 16;
    const int qq = (lane & 15) >> 2, pp = lane & 3, dblk = (lane >> 4) & 1, swz = ((qq >> 1) & 1) * 64;
    const int vrow0 = 4 * hi + qq;
    const int vb0 = KT_BYTES + vrow0 * 128 + ((32 * dblk + 8 * pp) ^ swz);
    const int vb1 = KT_BYTES + vrow0 * 128 + ((64 + 32 * dblk + 8 * pp) ^ swz);
    f32x16 o0 = {}, o1 = {};
    float m_run = -1e30f, l_run = 0.f; const f32x16 zero16 = {};
    const int qa = qw + r32;
#define ATT_QK(N0, N1, t) do { const LAS unsigned char* kp_ = lds + ((t) & 3) * SLOT_BYTES + kbase; \
        _Pragma("unroll") for (int d0 = 0; d0 < 6; ++d0) { const bf16x8 ka_ = *(const LAS bf16x8*)(kp_ + d0 * 2048), kb_ = *(const LAS bf16x8*)(kp_ + d0 * 2048 + 512); \
            if (d0 == 0) { N0 = MFMA32(ka_, qr[0], zero16); N1 = MFMA32(kb_, qr[0], zero16); } else { N0 = MFMA32(ka_, qr[d0], N0); N1 = MFMA32(kb_, qr[d0], N1); } } } while (0)
#define ATT_MASK(N0, N1, t) do { const int kb_ = 64 * (t); if (kb_ + 63 > qw) { _Pragma("unroll") for (int r = 0; r < 16; ++r) { const int ka_ = kb_ + crow(r, hi); \
        if (ka_ > qa) N0[r] = -__builtin_inff(); if (ka_ + 32 > qa) N1[r] = -__builtin_inff(); } } } while (0)
#define ATT_ROWMAX(N0, N1, PM) do { float a_ = max3f(N0[0], N0[1], N1[0]), b_ = max3f(N0[2], N0[3], N1[1]); a_ = max3f(a_, N1[2], N1[3]); \
        _Pragma("unroll") for (int r = 4; r < 16; r += 4) { a_ = max3f(a_, N0[r], N0[r + 1]); b_ = max3f(b_, N0[r + 2], N0[r + 3]); a_ = max3f(a_, N1[r], N1[r + 1]); b_ = max3f(b_, N1[r + 2], N1[r + 3]); } \
        a_ = max3f(a_, b_, b_); auto rr_ = __builtin_amdgcn_permlane32_swap(__float_as_uint(a_), __float_as_uint(a_), false, false); \
        PM = max3f(__uint_as_float(rr_[0]), __uint_as_float(rr_[1]), __uint_as_float(rr_[1])); } while (0)
#define ATT_DECIDE(PM, C0, C1, FORCE) do { if ((FORCE) || __any((PM) > m_run + 8.0f)) { const float mn_ = fmaxf(m_run, (PM)); const float al_ = __builtin_amdgcn_exp2f(m_run - mn_); m_run = mn_; l_run *= al_; \
        if (hi == 0) scr[r32] = al_; asm volatile("s_waitcnt lgkmcnt(0)" ::: "memory"); \
        _Pragma("unroll") for (int a4 = 0; a4 < 4; ++a4) { const f32x4 f_ = *(const LAS f32x4*)(scr + 8 * a4 + 4 * hi); \
            _Pragma("unroll") for (int e = 0; e < 4; ++e) { o0[4 * a4 + e] *= f_[e]; o1[4 * a4 + e] *= f_[e]; } } } } while (0)
#define ATT_SOFTMAX(C0, C1) do { float ps_ = 0.f; \
        _Pragma("unroll") for (int r = 0; r < 16; ++r) { C0[r] = __builtin_amdgcn_exp2f(C0[r] - m_run); C1[r] = __builtin_amdgcn_exp2f(C1[r] - m_run); ps_ += C0[r] + C1[r]; } \
        l_run += ps_; \
        _Pragma("unroll") for (int ks = 0; ks < 4; ++ks) { const f32x16& P_ = (ks < 2) ? C0 : C1; const int bs_ = 8 * (ks & 1); \
            u32x4 w_; w_.x = cvt_pk_bf16(P_[bs_ + 0], P_[bs_ + 1]); w_.y = cvt_pk_bf16(P_[bs_ + 2], P_[bs_ + 3]); w_.z = cvt_pk_bf16(P_[bs_ + 4], P_[bs_ + 5]); w_.w = cvt_pk_bf16(P_[bs_ + 6], P_[bs_ + 7]); \
            pa[ks] = __builtin_bit_cast(bf16x8, w_); } } while (0)
#define ATT_PV(t) do { const LAS unsigned char* vp0_ = lds + ((t) & 3) * SLOT_BYTES + vb0; const LAS unsigned char* vp1_ = lds + ((t) & 3) * SLOT_BYTES + vb1; \
        _Pragma("unroll") for (int ks = 0; ks < 4; ++ks) { \
            const s16x4 a0_ = vtr(vp0_ + ks * 16 * 128), a1_ = vtr(vp0_ + ks * 16 * 128 + 8 * 128), c0_ = vtr(vp1_ + ks * 16 * 128), c1_ = vtr(vp1_ + ks * 16 * 128 + 8 * 128); \
            const bf16x8 vf0_ = {a0_[0], a0_[1], a0_[2], a0_[3], a1_[0], a1_[1], a1_[2], a1_[3]}; const bf16x8 vf1_ = {c0_[0], c0_[1], c0_[2], c0_[3], c1_[0], c1_[1], c1_[2], c1_[3]}; \
            o0 = MFMA32(pa[ks], vf0_, o0); o1 = MFMA32(pa[ks], vf1_, o1); } } while (0)
#define ATT_WB(N) asm volatile("s_waitcnt vmcnt(" #N ") lgkmcnt(0)\n\ts_barrier" ::: "memory")
#define ATT_STEP(C0, C1, PMC, N0, N1, PMN, j, MSK, CONV) do { \
        ATT_DECIDE(PMC, C0, C1, false); \
        ATT_QK(N0, N1, (j) + 1); ATT_SOFTMAX(C0, C1); \
        bool cvi_ = false; \
        if (CONV) { __builtin_amdgcn_sched_barrier(0); const LAS float* cb_ = (const LAS float*)(lds + CONV_OFF + wid * CONV_BYTES); \
            if (CV.cur >= 0) { const ConvItem I_ = cv_setup(CV.cur, kargs()->in[I_WGU], kargs()->in[I_WD], cvws + WS_WGU, cvws + WS_WD); cv_out(I_, cb_, lane); } \
            if (CV.next < CV.end) { const ConvItem I_ = cv_setup(CV.next, kargs()->in[I_WGU], kargs()->in[I_WD], cvws + WS_WGU, cvws + WS_WD); asm volatile("s_waitcnt lgkmcnt(0)" ::: "memory"); \
                cv_dma(I_, lds0 + (unsigned)(CONV_OFF + wid * CONV_BYTES), lane); CV.cur = CV.next; CV.next += 2048; cvi_ = true; } else CV.cur = -1; __builtin_amdgcn_sched_barrier(0); } \
        const bool dma_ = (j) + 3 < NT; if (dma_) ATT_DMA((j) + 3); \
        ATT_PV(j); if (MSK) ATT_MASK(N0, N1, (j) + 1); ATT_ROWMAX(N0, N1, PMN); \
        if (dma_) { if (cvi_) ATT_WB(11); else ATT_WB(3); } else { if (cvi_) ATT_WB(8); else ATT_WB(0); } } while (0)
    bf16x8 pa[4];
    f32x16 sA0, sA1, sB0, sB1; float pmA, pmB;
    ATT_WAITBAR(6);
    ATT_QK(sA0, sA1, 0); ATT_MASK(sA0, sA1, 0); ATT_ROWMAX(sA0, sA1, pmA);
    ATT_WAITBAR(3);
    int j = 0;
    for (; j + 8 <= NT; j += 2) {
        ATT_STEP(sA0, sA1, pmA, sB0, sB1, pmB, j, false, CONV_IN_ATTN);
        ATT_STEP(sB0, sB1, pmB, sA0, sA1, pmA, j + 1, false, false);
    }
    for (; j < NT; j += 2) {
        ATT_STEP(sA0, sA1, pmA, sB0, sB1, pmB, j, true, CONV_IN_ATTN);
        ATT_STEP(sB0, sB1, pmB, sA0, sA1, pmA, j + 1, true, false);
    }
#undef ATT_DMA
#undef ATT_DMA1
#undef ATT_WAITBAR
#undef ATT_QK
#undef ATT_MASK
#undef ATT_ROWMAX
#undef ATT_DECIDE
#undef ATT_SOFTMAX
#undef ATT_PV
#undef ATT_STEP
#undef ATT_WB
    { auto rr = __builtin_amdgcn_permlane32_swap(__float_as_uint(l_run), __float_as_uint(l_run), false, false); l_run = __uint_as_float(rr[0]) + __uint_as_float(rr[1]); }
    if (hi == 0) scr[32 + r32] = 1.0f / l_run;
    asm volatile("s_waitcnt lgkmcnt(0)" ::: "memory");
    bf16_t* Ow = O + ((size_t)(b * SEQ + qw)) * 512 + h * 64 + r32;
#pragma unroll
    for (int a4 = 0; a4 < 4; ++a4) { const f32x4 f = *(const LAS f32x4*)(scr + 32 + 8 * a4 + 4 * hi);
#pragma unroll
        for (int e = 0; e < 4; ++e) { const int r = 4 * a4 + e; const int row = crow(r, hi);
            Ow[(size_t)row * 512] = (bf16_t)(cvt_pk_bf16(o0[r] * f[e], 0.f) & 0xffffu);
            Ow[(size_t)row * 512 + 32] = (bf16_t)(cvt_pk_bf16(o1[r] * f[e], 0.f) & 0xffffu); } }
    __syncthreads();
}
#undef MFMA32
}

struct MixOrder {
    int G, c; unsigned ATT, MIXED, WAO, WPO;
    __device__ __forceinline__ bool next(int i, Unit& u) const {
        const int tile = (i >> 1) * G + c; if (tile >= 256) return false;
        u.pm = tile >> 2; u.pn = tile & 3; u.aux = i & 1; return true;
    }
    __device__ __forceinline__ unsigned a_off(const Unit& u) const { return (u.aux ? MIXED : ATT) + (unsigned)u.pm * (256 * 512 * 2); }
    __device__ __forceinline__ unsigned b_off(const Unit& u) const { return (u.aux ? WPO : WAO) + (unsigned)u.pn * (256 * 512 * 2); }
};
struct EpiMix {
    static constexpr bool PERM = true;
    bf16_t* MIX; const bf16_t* GATES;
    __device__ __forceinline__ void operator()(const f32x4 (&acc)[2][2][4][2], const Unit& u, int wr, int wc, int fr, int fq) const {
        const int row0 = u.pm * 256 + wr * 64 + fr, col0 = u.pn * 256 + wc * 32 + 8 * fq;
#pragma unroll
        for (int ai = 0; ai < 2; ++ai)
#pragma unroll
            for (int m = 0; m < 4; ++m) { const size_t row = (size_t)(row0 + ai * 128 + m * 16);
#pragma unroll
                for (int bj = 0; bj < 2; ++bj) {
                    const u32x4 gw = *(const u32x4*)(GATES + row * 2048 + u.aux * 1024 + col0 + bj * 128);
                    const f32x4 v0 = acc[ai][bj][m][0], v1 = acc[ai][bj][m][1];
                    float r[8] = {v0[0] * bf_lo(gw.x), v0[1] * bf_hi(gw.x), v0[2] * bf_lo(gw.y), v0[3] * bf_hi(gw.y), v1[0] * bf_lo(gw.z), v1[1] * bf_hi(gw.z), v1[2] * bf_lo(gw.w), v1[3] * bf_hi(gw.w)};
                    bf16_t* dst = MIX + row * 1024 + col0 + bj * 128;
                    if (u.aux) { const u32x4 pw = *(const u32x4*)dst;
                        r[0] += bf_lo(pw.x); r[1] += bf_hi(pw.x); r[2] += bf_lo(pw.y); r[3] += bf_hi(pw.y); r[4] += bf_lo(pw.z); r[5] += bf_hi(pw.z); r[6] += bf_lo(pw.w); r[7] += bf_hi(pw.w); }
                    u32x4 w; w.x = cvt_pk_bf16(r[0], r[1]); w.y = cvt_pk_bf16(r[2], r[3]); w.z = cvt_pk_bf16(r[4], r[5]); w.w = cvt_pk_bf16(r[6], r[7]);
                    *(u32x4*)dst = w; } }
    }
};
struct EpiRes {
    static constexpr bool PERM = false;
    const float* base; float* out;
    __device__ __forceinline__ void operator()(const f32x4 (&acc)[2][2][4][2], const Unit& u, int wr, int wc, int fr, int fq) const {
        const int row0 = u.pm * 256 + wr * 64 + fr, col0 = u.pn * 256 + wc * 32 + 4 * fq;
#pragma unroll
        for (int ai = 0; ai < 2; ++ai)
#pragma unroll
            for (int m = 0; m < 4; ++m) { const size_t off = (size_t)(row0 + ai * 128 + m * 16) * DM + col0;
#pragma unroll
                for (int bj = 0; bj < 2; ++bj)
#pragma unroll
                    for (int n = 0; n < 2; ++n) *(f32x4*)(out + off + bj * 128 + n * 16) = *(const f32x4*)(base + off + bj * 128 + n * 16) + acc[ai][bj][m][n]; }
    }
};

constexpr int WR_PITCH = 1028;
constexpr int R_WR_OFF = 0, R_PART_OFF = 32 * WR_PITCH * 4, R_SSQ_OFF = R_PART_OFF + 2 * 64 * 33 * 4, R_CNT_OFF = R_SSQ_OFF + 2 * 64 * 4, R_BASE_OFF = R_CNT_OFF + 128, R_END = R_BASE_OFF + 128;
static_assert(R_END <= TILE_E_OFF, "router LDS map");
__device__ __forceinline__ void p7_router(const Frame& F) {
    const int tid_l = tid_local(), lane_l = tid_l & 63; (void)tid_l; (void)lane_l;
    const KArgs a = kargs();
    LAS float* WR = (LAS float*)(F.lds + R_WR_OFF); LAS float* PART = (LAS float*)(F.lds + R_PART_OFF); LAS float* SSQP = (LAS float*)(F.lds + R_SSQ_OFF);
    LAS int* CNT = (LAS int*)(F.lds + R_CNT_OFF); LAS int* BASE = (LAS int*)(F.lds + R_BASE_OFF);
    const int tid = tid_l, lane = lane_l, wave = F.wave;
    const float* wr = a->in[I_WR]; const float* gf = a->in[I_GFFN];
    for (int i = tid; i < 1024 * 32; i += 512) { const int k = i >> 5, e = i & 31; WR[e * WR_PITCH + k] = wr[i] * gf[k]; }
    if (tid < 32) CNT[tid] = 0;
    __syncthreads();
    int* RE = (int*)(F.ws + WS_ROUTE); int* RP = RE + T * 4; float* RG = (float*)(RP + T * 4); float* RS = RG + T * 4;
    unsigned* gcnt = F.ctl + CW_CNT;
    const float* X1 = F.out;
    for (int blk = F.vcu; blk < T / 64; blk += F.G) {
        const int tb = blk * 64;
        {
            const int tg = wave & 3, kh = wave >> 2, r = lane & 15, kq = lane >> 4;
            const float* xp = X1 + (size_t)(tb + 16 * tg + r) * DM + 512 * kh + 4 * kq;
            const LAS float* w0 = WR + (lane & 15) * WR_PITCH + 512 * kh + 4 * kq; const LAS float* w1 = w0 + 16 * WR_PITCH;
            f32x4 acc0 = {0.f, 0.f, 0.f, 0.f}, acc1 = {0.f, 0.f, 0.f, 0.f}; float ss = 0.f;
#pragma unroll 4
            for (int i = 0; i < 32; ++i) {
                const f32x4 xv = *(const f32x4*)(xp + 16 * i);
                const f32x4 b0 = *(const LAS f32x4*)(w0 + 16 * i), b1 = *(const LAS f32x4*)(w1 + 16 * i);
                ss += (xv[0] * xv[0] + xv[1] * xv[1]) + (xv[2] * xv[2] + xv[3] * xv[3]);
#pragma unroll
                for (int j = 0; j < 4; ++j) { acc0 = __builtin_amdgcn_mfma_f32_16x16x4f32(xv[j], b0[j], acc0, 0, 0, 0); acc1 = __builtin_amdgcn_mfma_f32_16x16x4f32(xv[j], b1[j], acc1, 0, 0, 0); }
            }
            ss += __shfl_xor(ss, 16); ss += __shfl_xor(ss, 32);
            if (kq == 0) SSQP[kh * 64 + 16 * tg + r] = ss;
#pragma unroll
            for (int q = 0; q < 4; ++q) { const int tok = 16 * tg + 4 * kq + q; PART[(kh * 64 + tok) * 33 + (lane & 15)] = acc0[q]; PART[(kh * 64 + tok) * 33 + 16 + (lane & 15)] = acc1[q]; }
        }
        __syncthreads();
        int te[4] = {0, 0, 0, 0}, lp[4] = {0, 0, 0, 0}; float tv[4] = {-3e38f, -3e38f, -3e38f, -3e38f}; float rstd = 0.f;
        if (tid < 64) {
            const float ssq = SSQP[tid] + SSQP[64 + tid]; rstd = 1.0f / sqrtf(ssq * (1.f / DM) + EPS);
            const float* br = a->in[I_BR];
#pragma unroll
            for (int e = 0; e < 32; ++e) {
                float v = (PART[tid * 33 + e] + PART[(64 + tid) * 33 + e]) * rstd + br[e]; int id = e;
#pragma unroll
                for (int s = 0; s < 4; ++s) { const bool gt = v > tv[s]; const float ov = tv[s]; const int oi = te[s]; tv[s] = gt ? v : ov; te[s] = gt ? id : oi; v = gt ? ov : v; id = gt ? oi : id; }
            }
#pragma unroll
            for (int s = 0; s < 4; ++s) lp[s] = __hip_atomic_fetch_add(&CNT[te[s]], 1, __ATOMIC_RELAXED, __HIP_MEMORY_SCOPE_WORKGROUP);
        }
        __syncthreads();
        if (tid < 32) { const int c = CNT[tid]; BASE[tid] = c ? (int)atomicAdd(gcnt + tid, (unsigned)c) : 0; }
        __syncthreads();
        if (tid < 64) {
            const int t = tb + tid;
            const float e1 = __expf(tv[1] - tv[0]), e2 = __expf(tv[2] - tv[0]), e3 = __expf(tv[3] - tv[0]); const float inv = 1.0f / (1.0f + e1 + e2 + e3);
            const float gts[4] = {inv, e1 * inv, e2 * inv, e3 * inv};
#pragma unroll
            for (int s = 0; s < 4; ++s) { RE[t * 4 + s] = te[s]; RP[t * 4 + s] = BASE[te[s]] + lp[s]; RG[t * 4 + s] = gts[s]; }
            RS[t] = rstd;
        }
        __syncthreads();
        if (tid < 32) CNT[tid] = 0;
        __syncthreads();
    }
}

__device__ __forceinline__ int build_tiles(const Frame& F) {
    const int tid_l = tid_local(), lane_l = tid_l & 63; (void)tid_l; (void)lane_l;
    LAS int* TB = (LAS int*)(F.lds + TILE_E_OFF); LAS int* TE = TB + 64;
    if (tid_l == 0) { int acc = 0; for (int e = 0; e < NEXP; ++e) { TB[e] = acc; const int c = (int)__hip_atomic_load(F.ctl + CW_CNT + e, RLX_AGENT); acc += (c + 255) >> 8; } TB[NEXP] = acc; }
    __syncthreads();
    if (tid_l < NEXP) { for (int t = TB[tid_l]; t < TB[tid_l + 1]; ++t) TE[t] = tid_l; }
    __syncthreads();
    return TB[NEXP];
}

__device__ __forceinline__ void p8_dispatch(const Frame& F) {
    const int tid_l = tid_local(), lane_l = tid_l & 63; (void)tid_l; (void)lane_l;
    const KArgs a = kargs();
    (void)build_tiles(F);
    const LAS int* TB = (const LAS int*)(F.lds + TILE_E_OFF);
    const int gw = F.vcu * NWAVES + F.wave, NGW = F.G * NWAVES, lane = lane_l;
    const int* RE = (const int*)(F.ws + WS_ROUTE); const int* RP = RE + T * 4; const float* RS = (const float*)(RP + T * 4) + T * 4; int* SL = (int*)(RS + T);
    const float* X1 = F.out; const float* gf = a->in[I_GFFN]; unsigned char* XS = F.ws + WS_XS2;
    f32x4 g[2][2];
#pragma unroll
    for (int j = 0; j < 2; ++j) { g[j][0] = *(const f32x4*)(gf + 512 * j + 8 * lane); g[j][1] = *(const f32x4*)(gf + 512 * j + 8 * lane + 4); }
    for (int t = gw; t < T; t += NGW) {
        const float rstd = RS[t];
        u32x2 w[2];
#pragma unroll
        for (int j = 0; j < 2; ++j) { const f32x4 v0 = *(const f32x4*)(X1 + (size_t)t * DM + 512 * j + 8 * lane) * g[j][0] * rstd, v1 = *(const f32x4*)(X1 + (size_t)t * DM + 512 * j + 8 * lane + 4) * g[j][1] * rstd;
            w[j] = cvt8_fp8(v0, v1, 8.0f); }
#pragma unroll
        for (int s = 0; s < 4; ++s) { const int e = RE[t * 4 + s], slot = TB[e] * 256 + RP[t * 4 + s];
            if (lane == 0) SL[t * 4 + s] = slot;
            unsigned char* dst = XS + (size_t)slot * DM + 8 * lane;
            *(u32x2*)dst = w[0]; *(u32x2*)(dst + 512) = w[1]; }
    }
}

struct MoeOrder {
    int G, c, ntn_shift, total; const LAS int* TE; unsigned A, Bw, bexp, btile;
    __device__ __forceinline__ bool next(int i, Unit& u) const {
        const int L = i * G + c; if (L >= total) return false;
        u.pm = L >> ntn_shift; u.pn = L & ((1 << ntn_shift) - 1); u.aux = __builtin_amdgcn_readfirstlane(TE[u.pm]); return true;
    }
    __device__ __forceinline__ unsigned a_off(const Unit& u) const { return A + (unsigned)u.pm * (256 * 1024); }
    __device__ __forceinline__ unsigned b_off(const Unit& u) const { return Bw + (unsigned)u.aux * bexp + (unsigned)u.pn * btile; }
};
struct EpiSwiglu {
    static constexpr bool PERM = true;
    unsigned char* ACT; const float* bgu;
    __device__ __forceinline__ void operator()(const f32x4 (&acc)[2][2][4][2], const Unit& u, int wr, int wc, int fr, int fq) const {
        const int row0 = u.pm * 256 + wr * 64 + fr, j0 = u.pn * 128 + wc * 32 + 8 * fq;
        const float* bb = bgu + (size_t)u.aux * 2048 + j0;
        unsigned char* dst0 = ACT + (size_t)row0 * DEXP + j0;
#pragma unroll
        for (int ai = 0; ai < 2; ++ai)
#pragma unroll
            for (int m = 0; m < 4; ++m) {
#pragma unroll
                for (int n = 0; n < 2; ++n) {
                    asm volatile("" : "+v"(bb));
                    const f32x4 g = acc[ai][0][m][n] + *(const f32x4*)(bb + 4 * n), up = acc[ai][1][m][n] + *(const f32x4*)(bb + 1024 + 4 * n);
                    float r[4];
#pragma unroll
                    for (int e = 0; e < 4; ++e) { const float gg = fminf(g[e], 7.0f), uu = fminf(fmaxf(up[e], -7.0f), 7.0f); r[e] = (uu + 1.0f) * gg * fast_sigmoid(1.702f * gg) * 8.0f; }
                    int w = __builtin_amdgcn_cvt_pk_fp8_f32(r[0], r[1], 0, false); w = __builtin_amdgcn_cvt_pk_fp8_f32(r[2], r[3], w, true);
                    *(int*)(dst0 + (size_t)(ai * 128 + m * 16) * DEXP + 4 * n) = w;
                }
                asm volatile("" ::: "memory");
            }
    }
};
struct EpiDown {
    static constexpr bool PERM = true;
    unsigned char* Y; const float* bd;
    __device__ __forceinline__ void operator()(const f32x4 (&acc)[2][2][4][2], const Unit& u, int wr, int wc, int fr, int fq) const {
        const int row0 = u.pm * 256 + wr * 64 + fr, col0 = u.pn * 256 + wc * 32 + 8 * fq;
        const float* bb = bd + (size_t)u.aux * DM + col0;
#pragma unroll
        for (int ai = 0; ai < 2; ++ai)
#pragma unroll
            for (int m = 0; m < 4; ++m) { unsigned char* rowp = Y + (size_t)(row0 + ai * 128 + m * 16) * DM + col0;
                asm volatile("" : "+v"(bb));
#pragma unroll
                for (int bj = 0; bj < 2; ++bj) { const f32x4 v0 = acc[ai][bj][m][0] + *(const f32x4*)(bb + bj * 128), v1 = acc[ai][bj][m][1] + *(const f32x4*)(bb + bj * 128 + 4);
                    *(u32x2*)(rowp + bj * 128) = cvt8_fp8(v0, v1, 8.0f); } asm volatile("" ::: "memory"); }
    }
};

__device__ __forceinline__ void p11_combine(const Frame& F) {
    const int tid_l = tid_local(), lane_l = tid_l & 63; (void)tid_l; (void)lane_l;
    const KArgs a = kargs();
    const int gw = F.vcu * NWAVES + F.wave, NGW = F.G * NWAVES, lane = lane_l;
    const int* RE = (const int*)(F.ws + WS_ROUTE); const float* RG = (const float*)(RE + T * 8); const int* SL = (const int*)(RG + T * 4 + T);
    const unsigned char* Y = F.ws + WS_XS; bf16_t* HP = (bf16_t*)(F.ws + WS_HN); float* X = F.out; const float* gp = a->in[I_GPLE];
    f32x4 g[2][2];
#pragma unroll
    for (int j = 0; j < 2; ++j) { g[j][0] = *(const f32x4*)(gp + 512 * j + 8 * lane); g[j][1] = *(const f32x4*)(gp + 512 * j + 8 * lane + 4); }
    for (int t = gw; t < T; t += NGW) {
        f32x4 v[2][2];
#pragma unroll
        for (int j = 0; j < 2; ++j) { v[j][0] = *(const f32x4*)(X + (size_t)t * DM + 512 * j + 8 * lane); v[j][1] = *(const f32x4*)(X + (size_t)t * DM + 512 * j + 8 * lane + 4); }
#pragma unroll
        for (int s = 0; s < 4; ++s) { const int slot = SL[t * 4 + s]; const float gt = RG[t * 4 + s] * 0.125f;
#pragma unroll
            for (int j = 0; j < 2; ++j) { const u32x2 y = *(const u32x2*)(Y + (size_t)slot * DM + 512 * j + 8 * lane);
                const f32x2 a0 = __builtin_amdgcn_cvt_pk_f32_fp8((int)y.x, false), a1 = __builtin_amdgcn_cvt_pk_f32_fp8((int)y.x, true), b0 = __builtin_amdgcn_cvt_pk_f32_fp8((int)y.y, false), b1 = __builtin_amdgcn_cvt_pk_f32_fp8((int)y.y, true);
                v[j][0] += (f32x4){a0[0], a0[1], a1[0], a1[1]} * gt; v[j][1] += (f32x4){b0[0], b0[1], b1[0], b1[1]} * gt; } }
        float ss = 0.f;
#pragma unroll
        for (int j = 0; j < 2; ++j)
#pragma unroll
            for (int n = 0; n < 2; ++n) { const f32x4 q = v[j][n]; ss += (q[0] * q[0] + q[1] * q[1]) + (q[2] * q[2] + q[3] * q[3]); *(f32x4*)(X + (size_t)t * DM + 512 * j + 8 * lane + 4 * n) = q; }
        const float rstd = 1.0f / sqrtf(wave_sum(ss) * (1.f / DM) + EPS);
#pragma unroll
        for (int j = 0; j < 2; ++j) { const f32x4 q0 = v[j][0] * g[j][0] * rstd, q1 = v[j][1] * g[j][1] * rstd;
            u32x4 w; w.x = cvt_pk_bf16(q0[0], q0[1]); w.y = cvt_pk_bf16(q0[2], q0[3]); w.z = cvt_pk_bf16(q1[0], q1[1]); w.w = cvt_pk_bf16(q1[2], q1[3]);
            *(u32x4*)(HP + (size_t)t * DM + 512 * j + 8 * lane) = w; }
    }
}
struct EpiPle {
    static constexpr bool PERM = false;
    float* out; const bf16_t* E;
    __device__ __forceinline__ void operator()(const f32x4 (&acc)[2][2][4][2], const Unit& u, int wr, int wc, int fr, int fq) const {
        const int row0 = u.pm * 256 + wr * 64 + fr, col0 = u.pn * 256 + wc * 32 + 4 * fq;
#pragma unroll
        for (int ai = 0; ai < 2; ++ai)
#pragma unroll
            for (int m = 0; m < 4; ++m) { const size_t off = (size_t)(row0 + ai * 128 + m * 16) * DM + col0;
#pragma unroll
                for (int bj = 0; bj < 2; ++bj)
#pragma unroll
                    for (int n = 0; n < 2; ++n) { const size_t o = off + bj * 128 + n * 16; const u32x2 ev = *(const u32x2*)(E + o); const f32x4 a4 = acc[ai][bj][m][n];
                        f32x4 r = *(const f32x4*)(out + o);
                        r[0] += fast_sigmoid(a4[0]) * bf_lo(ev.x); r[1] += fast_sigmoid(a4[1]) * bf_hi(ev.x); r[2] += fast_sigmoid(a4[2]) * bf_lo(ev.y); r[3] += fast_sigmoid(a4[3]) * bf_hi(ev.y);
                        *(f32x4*)(out + o) = r; } }
    }
};

constexpr int N_PHASES = 13;
__global__ void __launch_bounds__(NWAVES * 64, 2) fwd_kernel(Args args) {
    extern __shared__ __attribute__((aligned(16))) unsigned char lds_raw[];
    Frame F;
    F.lds = (LAS unsigned char*)lds_raw; F.MISC = (volatile LAS unsigned*)(F.lds + MISC_OFF);
    F.wave = __builtin_amdgcn_readfirstlane(threadIdx.x >> 6);
    F.G = gridDim.x; { const int bx = blockIdx.x; F.vcu = (F.G % 8 == 0) ? (bx % 8) * (F.G / 8) + bx / 8 : bx; }
    { const KArgs ka = kargs(); F.out = ka->out; F.ws = ka->ws; F.ctl = (unsigned*)(ka->ws + WS_CTL); }
    { const int t0_ = tid_local(); if (t0_ < 32) F.MISC[t0_] = 0u; }
    __syncthreads();
    int lo, hi; { const KArgs ka = kargs(); lo = ka->ph_lo; hi = ka->ph_hi; }
    const bool multi = (hi - lo) > 1;
    XcdBarrier bar; bar.bar = F.ctl + CW_BAR; bar.x = 0; bar.st = nullptr;
    if (multi) bar = xcd_barrier_post(F.ctl + CW_BAR, F.MISC);
#ifndef PH_MASK
#define PH_MASK 0x1fff
#endif
#define IN(k) ((((PH_MASK) >> (k)) & 1) && lo <= (k) && (k) < hi)
#define SEAM(k) do { if (IN(k) && IN((k) + 1)) xcd_barrier(bar); } while (0)
    unsigned char* ws = F.ws;
    LAS unsigned char* ring = F.lds;
    const __amdgpu_buffer_rsrc_t rsrc = __builtin_amdgcn_make_buffer_rsrc((void*)ws, 0, (int)WS_END, 0x00020000);

    if (IN(0)) { p0_prologue(F); } SEAM(0);

    if (IN(1)) {
        { DenseOrder S; S.init(64, 12, F.G, (int)blockIdx.x, WS_HN, P1_FP8 ? 512 : 1024, WS_WIN, P1_FP8 ? 512 : 1024);
          EpiProj E{(bf16_t*)(ws + WS_PROJ), (bf16_t*)(ws + WS_GATES)};
          if (P1_FP8) pg8::gemm_phase<EpiProj, DenseOrder, true, true, true>(ring, rsrc, pg8::Shape{1024, 1024, 1024, 0x7c7c7c7c, 0x7c7c7c7c}, S, E);
          else pg8::gemm_phase<EpiProj, DenseOrder, true, true>(ring, rsrc, pg8::Shape{2048, 2048, 2048, 0, 0}, S, E); }
        { DenseOrder S; S.init(64, 4, F.G, (int)blockIdx.x, WS_PB, 256, WS_WPLE, 256);
          EpiBf16 E{(bf16_t*)(ws + WS_E), 1024};
          pg8::gemm_phase<EpiBf16, DenseOrder, true, true>(ring, rsrc, pg8::Shape{512, 512, 512, 0, 0}, S, E); }
    } SEAM(1);

    if (IN(2)) { p2_rows(F); } SEAM(2);

    if (IN(3)) {
#ifndef P3M
#define P3M 7
#endif
        if (P3M & 1) { DenseOrder S; S.init(64, 4, F.G, (int)blockIdx.x, WS_A2 + 512, 512, WS_WKV, 256);
          EpiKV E{(bf16_t*)(ws + WS_K), (bf16_t*)(ws + WS_V), kargs()->in[I_GKNOPE]};
          pg8::gemm_phase<EpiKV, DenseOrder, true, true>(ring, rsrc, pg8::Shape{512, 1024, 512, 0, 0}, S, E); }
        if (P3M & 2) { DenseOrder S; S.init(64, 3, F.G, (int)blockIdx.x, WS_A2, 512, WS_WQ, 256);
          EpiQ E{(bf16_t*)(ws + WS_Q), (float*)(ws + WS_SSQ), (const float*)(ws + WS_COS), (const float*)(ws + WS_SIN), kargs()->in[I_GQHEAD]};
          pg8::gemm_phase<EpiQ, DenseOrder, true, true>(ring, rsrc, pg8::Shape{512, 1024, 512, 0, 0}, S, E); }
        if (P3M & 4) { DenseOrder S; S.init(64, 2, F.G, (int)blockIdx.x, WS_POOLED, 512, WS_WPOOL, 256, 512);
          EpiBf16 E{(bf16_t*)(ws + WS_MIXED), 512};
          pg8::gemm_phase<EpiBf16, DenseOrder, true, true>(ring, rsrc, pg8::Shape{512, 1024, 512, 0, 0}, S, E); }
    } SEAM(3);

    if (IN(4)) {
        u32x4 srd; { const unsigned long wb = (unsigned long)ws; srd.x = (unsigned)__builtin_amdgcn_readfirstlane((int)(unsigned)wb); srd.y = (unsigned)__builtin_amdgcn_readfirstlane((int)(unsigned)(wb >> 32)); srd.z = (unsigned)WS_END; srd.w = 0x00020000u; }
        att::ConvState CV; CV.next = __builtin_amdgcn_readfirstlane(F.vcu * NWAVES + F.wave); CV.end = CONV_IN_ATTN ? att::CV_ITEMS : 0; CV.cur = -1;
        for (int it = F.vcu; it < 256; it += F.G) {
            const int bh = it >> 3, pr = it & 7;
            att::attn_unit(ring, srd, CV, ws, bh, 15 - pr, (const bf16_t*)(ws + WS_Q), (unsigned)WS_K, (unsigned)WS_V, (const float*)(ws + WS_SSQ), (bf16_t*)(ws + WS_ATT));
            att::attn_unit(ring, srd, CV, ws, bh, pr, (const bf16_t*)(ws + WS_Q), (unsigned)WS_K, (unsigned)WS_V, (const float*)(ws + WS_SSQ), (bf16_t*)(ws + WS_ATT));
        }
        { const LAS float* cb = (const LAS float*)(F.lds + att::CONV_OFF + F.wave * att::CONV_BYTES);
          const unsigned cbaddr = (unsigned)__builtin_amdgcn_readfirstlane((int)(unsigned)(unsigned long)(F.lds + att::CONV_OFF + F.wave * att::CONV_BYTES));
          const int lane_l = tid_local() & 63;
          while (CV.cur >= 0 || CV.next < CV.end) {
            if (CV.cur >= 0) { asm volatile("s_waitcnt vmcnt(0)" ::: "memory"); const att::ConvItem I = att::cv_setup(CV.cur, kargs()->in[I_WGU], kargs()->in[I_WD], ws + WS_WGU, ws + WS_WD); att::cv_out(I, cb, lane_l); }
            if (CV.next < CV.end) { const att::ConvItem I = att::cv_setup(CV.next, kargs()->in[I_WGU], kargs()->in[I_WD], ws + WS_WGU, ws + WS_WD); asm volatile("s_waitcnt lgkmcnt(0)" ::: "memory"); att::cv_dma(I, cbaddr, lane_l); CV.cur = CV.next; CV.next += 2048; } else CV.cur = -1;
          } }
    } SEAM(4);

    if (IN(5)) {
        MixOrder S{F.G, F.vcu, (unsigned)WS_ATT, (unsigned)WS_MIXED, (unsigned)WS_WAO, (unsigned)WS_WPO};
        EpiMix E{(bf16_t*)(ws + WS_MIX), (const bf16_t*)(ws + WS_GATES)};
        pg8::gemm_phase<EpiMix, MixOrder, true, true>(ring, rsrc, pg8::Shape{1024, 1024, 1024, 0, 0}, S, E);
    } SEAM(5);

    if (IN(6)) {
        DenseOrder S; S.init(64, 4, F.G, (int)blockIdx.x, WS_MIX, 1024, WS_WO, 1024);
        EpiRes E{kargs()->in[I_X], F.out};
        pg8::gemm_phase<EpiRes, DenseOrder, true, true>(ring, rsrc, pg8::Shape{2048, 2048, 2048, 0, 0}, S, E);
    } SEAM(6);

    if (IN(7)) { p7_router(F); } SEAM(7);

    if (IN(8)) { p8_dispatch(F); } SEAM(8);

    if (IN(9)) {
        const int TM = build_tiles(F);
        MoeOrder S{F.G, F.vcu, 3, TM * 8, (const LAS int*)(F.lds + TILE_E_OFF) + 64, (unsigned)WS_XS2, (unsigned)WS_WGU, 2048u * 1024u, 256u * 1024u};
        EpiSwiglu E{ws + WS_ACT, kargs()->in[I_BGU]};
        pg8::gemm_phase<EpiSwiglu, MoeOrder, true, true, true>(ring, rsrc, pg8::Shape{1024, 1024, 1024, 0x7c7c7c7c, 0x7c7c7c7c}, S, E);
    } SEAM(9);

    if (IN(10)) {
        const int TM = build_tiles(F);
        MoeOrder S{F.G, F.vcu, 2, TM * 4, (const LAS int*)(F.lds + TILE_E_OFF) + 64, (unsigned)WS_ACT, (unsigned)WS_WD, 1024u * 1024u, 256u * 1024u};
        EpiDown E{ws + WS_XS, kargs()->in[I_BD]};
        pg8::gemm_phase<EpiDown, MoeOrder, true, true, true>(ring, rsrc, pg8::Shape{1024, 1024, 1024, 0x7c7c7c7c, 0x7c7c7c7c}, S, E);
    } SEAM(10);

    if (IN(11)) { p11_combine(F); } SEAM(11);

    if (IN(12)) {
        DenseOrder S; S.init(64, 4, F.G, (int)blockIdx.x, WS_HN, 1024, WS_WPG, 1024);
        EpiPle E{F.out, (const bf16_t*)(ws + WS_E)};
        pg8::gemm_phase<EpiPle, DenseOrder, true, true>(ring, rsrc, pg8::Shape{2048, 2048, 2048, 0, 0}, S, E);
    }
#undef IN
#undef SEAM
}

extern "C" void kernel_launch(void* const* d_in, const int* in_sizes, int n_in, void* d_out, int out_size, void* d_ws, size_t ws_size, hipStream_t stream) {
    static int grid = 0;
    if (grid == 0) {
        if (n_in != 27 || out_size != T * DM || ws_size < WS_END) { fprintf(stderr, "kernel_launch: unexpected shapes (n_in %d, out %d, ws %zu)\n", n_in, out_size, ws_size); grid = -1; return; }
        int dev = 0, cus = 0;
        if (hipGetDevice(&dev) != hipSuccess || hipDeviceGetAttribute(&cus, hipDeviceAttributeMultiprocessorCount, dev) != hipSuccess) { grid = -1; return; }
        if (hipFuncSetAttribute((const void*)fwd_kernel, hipFuncAttributeMaxDynamicSharedMemorySize, LDS_BYTES) != hipSuccess) { fprintf(stderr, "kernel_launch: hipFuncSetAttribute failed\n"); grid = -1; return; }
        int per_cu = 0;
        if (hipOccupancyMaxActiveBlocksPerMultiprocessor(&per_cu, (const void*)fwd_kernel, NWAVES * 64, LDS_BYTES) != hipSuccess || per_cu < 1) fprintf(stderr, "kernel_launch: occupancy query says %d\n", per_cu);
        (void)hipGetLastError();
        grid = cus;
    }
    if (grid < 0) return;
    (void)hipMemsetAsync((char*)d_ws + WS_CTL, 0, CTL_ZERO_BYTES, stream);
    Args a{};
    for (int i = 0; i < 27; ++i) a.in[i] = (const float*)d_in[i];
    a.out = (float*)d_out; a.ws = (unsigned char*)d_ws;
#ifndef DUP_PHASE
    a.ph_lo = 0; a.ph_hi = N_PHASES; hipLaunchKernelGGL(fwd_kernel, dim3(grid), dim3(NWAVES * 64), LDS_BYTES, stream, a);
#else
    a.ph_lo = 0; a.ph_hi = DUP_PHASE + 1; hipLaunchKernelGGL(fwd_kernel, dim3(grid), dim3(NWAVES * 64), LDS_BYTES, stream, a);
    (void)hipMemsetAsync((char*)d_ws + WS_CTL + CW_BAR * 4, 0, XCD_BAR_WORDS * 4, stream);
    a.ph_lo = DUP_PHASE; a.ph_hi = N_PHASES; hipLaunchKernelGGL(fwd_kernel, dim3(grid), dim3(NWAVES * 64), LDS_BYTES, stream, a);
#endif
}
```

```cpp
#include <hip/hip_runtime.h>
#include <cstdio>
#include <cstdint>

#define LAS __attribute__((address_space(3)))
#define GAS __attribute__((address_space(1)))
typedef unsigned short bf16_t;
typedef short bf16x8 __attribute__((ext_vector_type(8)));
typedef short s16x4 __attribute__((ext_vector_type(4)));
typedef float f32x4 __attribute__((ext_vector_type(4)));
typedef float f32x2 __attribute__((ext_vector_type(2)));
typedef float f32x16 __attribute__((ext_vector_type(16)));
typedef unsigned u32x4 __attribute__((ext_vector_type(4)));
typedef unsigned u32x2 __attribute__((ext_vector_type(2)));

constexpr int NB = 4, SEQ = 4096, T = NB * SEQ, DM = 1024, NH = 8, DK = 96, DV = 64;
constexpr int NEXP = 32, TOPK = 4, DEXP = 1024, PLE = 256;
constexpr float EPS = 1e-6f;
constexpr int XS_ROWS = T * TOPK + NEXP * 256;

typedef __bf16 bf16x2_t __attribute__((ext_vector_type(2)));
__device__ __forceinline__ unsigned cvt_pk_bf16(float lo, float hi) { f32x2 v = {lo, hi}; return __builtin_bit_cast(unsigned, __builtin_convertvector(v, bf16x2_t)); }
__device__ __forceinline__ u32x2 cvt8_fp8(const f32x4 a, const f32x4 b, float sc) {
    int w0 = __builtin_amdgcn_cvt_pk_fp8_f32(a[0] * sc, a[1] * sc, 0, false); w0 = __builtin_amdgcn_cvt_pk_fp8_f32(a[2] * sc, a[3] * sc, w0, true);
    int w1 = __builtin_amdgcn_cvt_pk_fp8_f32(b[0] * sc, b[1] * sc, 0, false); w1 = __builtin_amdgcn_cvt_pk_fp8_f32(b[2] * sc, b[3] * sc, w1, true);
    u32x2 r; r.x = (unsigned)w0; r.y = (unsigned)w1; return r;
}
__device__ __forceinline__ float bf_lo(unsigned w) { return __uint_as_float(w << 16); }
__device__ __forceinline__ float bf_hi(unsigned w) { return __uint_as_float(w & 0xffff0000u); }
__device__ __forceinline__ float bf1(bf16_t h) { return __uint_as_float(((unsigned)h) << 16); }
__device__ __forceinline__ float fast_sigmoid(float v) { return __builtin_amdgcn_rcpf(1.0f + __builtin_amdgcn_exp2f(-1.4426950408889634f * v)); }
__device__ __forceinline__ int lane_id() { return (int)__builtin_amdgcn_mbcnt_hi(~0u, __builtin_amdgcn_mbcnt_lo(~0u, 0u)); }
__device__ __forceinline__ int tid_local() { int t = threadIdx.x; asm volatile("" : "+v"(t)); return t; }
__device__ __forceinline__ float wave_sum(float v) {
#pragma unroll
    for (int o = 1; o < 64; o <<= 1) v += __shfl_xor(v, o);
    return v;
}

namespace pg8 {
constexpr int BM = 256, BK = 64, HALF = 128, HTB = HALF * BK * 2, STAGE_BYTES = 8 * HTB;
__host__ __device__ __forceinline__ int lds_byte(int r, int c) { const int st = (r >> 4) * 2 + (c >> 5), rr = r & 15, cc = c & 31, ob = rr * 64 + cc * 2; return st * 1024 + (ob ^ (((ob >> 9) & 1) << 5)); }
__host__ __device__ __forceinline__ void stage_rc(int b, int& R, int& C) { const int st = b / 1024, sb = b % 1024, swz = sb ^ (((sb >> 9) & 1) << 5); R = (st >> 1) * 16 + swz / 64; C = (st & 1) * 32 + (swz % 64) / 2; }
__host__ __device__ __forceinline__ int perm32(int rho) { const int n = rho >> 4, i = rho & 15; return 8 * (i >> 2) + 4 * n + (i & 3); }

struct Unit { int pm, pn, aux; };
struct Shape { int Kb, lda, ldb, sw, sa; };
typedef int v8i_t __attribute__((ext_vector_type(8))); typedef int v4i_t __attribute__((ext_vector_type(4)));

template <class Epi, class Sched, bool ALIGN_EPI, bool SP2, bool MX = false>
__device__ __forceinline__ void gemm_phase(LAS unsigned char* lds, const __amdgpu_buffer_rsrc_t rsrc, const Shape g, const Sched& S, const Epi& E) {
    const int tid = tid_local(), wid = __builtin_amdgcn_readfirstlane(tid >> 6), lane = tid & 63, wr = wid >> 2, wc = wid & 3, fr = lane & 15, fq = lane >> 4;
    int nt = g.Kb / 128; asm volatile("" : "+s"(nt));
    unsigned voffA, voffB;
    { int R, C; stage_rc(tid * 16, R, C); const int Rb = Epi::PERM ? ((R & ~31) + perm32(R & 31)) : R;
      voffA = (unsigned)(R * g.lda + C * 2); voffB = (unsigned)(Rb * g.ldb + C * 2); }
    const unsigned p2A = 64u * (unsigned)g.lda, p2B = 64u * (unsigned)g.ldb;
    const unsigned kstep = 128u;
    const unsigned hstepA = (unsigned)HALF * g.lda, hstepB = (unsigned)HALF * g.ldb;
    const unsigned ldsw = (unsigned)wid * 1024u;
    const int aoff = lds_byte(wr * 64 + fr, fq * 8), boff = lds_byte(wc * 32 + fr, fq * 8);
#define PG8_SA(b, h) (((b) * 2 + (h)) * HTB)
#define PG8_SB(b, h) ((4 + (b) * 2 + (h)) * HTB)
#define PG8_STAGE(bufoff, gbase, voff) do { \
        __builtin_amdgcn_raw_ptr_buffer_load_lds(rsrc, (LAS void*)(lds + (bufoff) + ldsw), 16, voff, (gbase), 0, 0); \
        __builtin_amdgcn_raw_ptr_buffer_load_lds(rsrc, (LAS void*)(lds + (bufoff) + ldsw + 8192), 16, voff, (gbase) + p2##voff, 0, 0); } while (0)
#define p2voffA p2A
#define p2voffB p2B
#define PG8_LDA(dst, b, h) do { _Pragma("unroll") for (int m = 0; m < 4; ++m) _Pragma("unroll") for (int k = 0; k < 2; ++k) dst[m][k] = *(const LAS bf16x8*)(lds + PG8_SA(b, h) + aoff + m * 2048 + k * 1024); } while (0)
#define PG8_LDB(dst, b, h) do { _Pragma("unroll") for (int n = 0; n < 2; ++n) _Pragma("unroll") for (int k = 0; k < 2; ++k) dst[n][k] = *(const LAS bf16x8*)(lds + PG8_SB(b, h) + boff + n * 2048 + k * 1024); } while (0)
#define PG8_CAT(x, y) __builtin_shufflevector(__builtin_bit_cast(v4i_t, x), __builtin_bit_cast(v4i_t, y), 0, 1, 2, 3, 4, 5, 6, 7)
#define PG8_MMA(ai, bj, At, Bt) do { __builtin_amdgcn_s_setprio(1); if constexpr (MX) { _Pragma("unroll") for (int m = 0; m < 4; ++m) _Pragma("unroll") for (int n = 0; n < 2; ++n) \
        acc[ai][bj][m][n] = __builtin_amdgcn_mfma_scale_f32_16x16x128_f8f6f4(PG8_CAT(Bt[n][0], Bt[n][1]), PG8_CAT(At[m][0], At[m][1]), acc[ai][bj][m][n], 0, 0, 0, g.sw, 0, g.sa); } else { \
        _Pragma("unroll") for (int m = 0; m < 4; ++m) _Pragma("unroll") for (int n = 0; n < 2; ++n) _Pragma("unroll") for (int k = 0; k < 2; ++k) \
        acc[ai][bj][m][n] = __builtin_amdgcn_mfma_f32_16x16x32_bf16(Bt[n][k], At[m][k], acc[ai][bj][m][n], 0, 0, 0); } __builtin_amdgcn_s_setprio(0); } while (0)
#define PG8_WAIT_V(n) asm volatile("s_waitcnt vmcnt(" #n ")" ::: "memory")
#define PG8_WAIT_L(n) asm volatile("s_waitcnt lgkmcnt(" #n ")" ::: "memory")
#define PG8_BAR __builtin_amdgcn_s_barrier()
#define PG8_SCHED __builtin_amdgcn_sched_barrier(0)
    Unit cur, nxt; int ui = 0;
    if (!S.next(0, cur)) return;
    f32x4 acc[2][2][4][2];
#pragma unroll
    for (int a = 0; a < 2; ++a)
#pragma unroll
        for (int b = 0; b < 2; ++b)
#pragma unroll
            for (int m = 0; m < 4; ++m)
#pragma unroll
                for (int n = 0; n < 2; ++n) acc[a][b][m][n] = (f32x4){0.f, 0.f, 0.f, 0.f};
    bf16x8 At[4][2], B0[2][2], B1[2][2];
    unsigned cA = S.a_off(cur), cB = S.b_off(cur);
    if constexpr (SP2) {
        PG8_STAGE(PG8_SB(0, 0), cB, voffB); PG8_STAGE(PG8_SB(0, 1), cB + hstepB, voffB); PG8_STAGE(PG8_SA(0, 0), cA, voffA); PG8_STAGE(PG8_SA(0, 1), cA + hstepA, voffA);
        if (wr == 1) PG8_BAR;
        PG8_WAIT_V(2); PG8_BAR;
        PG8_STAGE(PG8_SB(1, 0), cB + kstep, voffB); PG8_STAGE(PG8_SA(1, 0), cA + kstep, voffA); PG8_STAGE(PG8_SB(1, 1), cB + hstepB + kstep, voffB);
        PG8_WAIT_V(6); PG8_BAR;
    } else {
        PG8_STAGE(PG8_SB(0, 0), cB, voffB); PG8_STAGE(PG8_SA(0, 0), cA, voffA); PG8_STAGE(PG8_SB(0, 1), cB + hstepB, voffB); PG8_STAGE(PG8_SA(0, 1), cA + hstepA, voffA);
        if (wr == 1) PG8_BAR;
        PG8_WAIT_V(4); PG8_BAR;
        PG8_STAGE(PG8_SB(1, 0), cB + kstep, voffB); PG8_STAGE(PG8_SA(1, 0), cA + kstep, voffA); PG8_STAGE(PG8_SB(1, 1), cB + hstepB + kstep, voffB);
        PG8_WAIT_V(6); PG8_BAR;
    }
    for (;;) {
        const bool has_next = S.next(ui + 1, nxt);
        const unsigned nA = has_next ? S.a_off(nxt) : cA, nB = has_next ? S.b_off(nxt) : cB;
#pragma nounroll
        for (int t = 0; t < nt; t += 2) {
            const bool last = (t == nt - 2);
            const unsigned a1 = cA + (unsigned)(t + 1) * kstep;
            const unsigned a2 = last ? nA : cA + (unsigned)(t + 2) * kstep, b2 = last ? nB : cB + (unsigned)(t + 2) * kstep;
            const unsigned a3 = a2 + kstep, b3 = b2 + kstep;
            if constexpr (SP2) {
            PG8_LDB(B0, 0, 0); PG8_LDB(B1, 0, 1); PG8_SCHED; PG8_LDA(At, 0, 0); PG8_STAGE(PG8_SA(1, 1), a1 + hstepA, voffA);
            PG8_WAIT_V(8); PG8_WAIT_L(0); PG8_BAR; PG8_MMA(0, 0, At, B0); PG8_MMA(0, 1, At, B1); PG8_BAR; PG8_SCHED;
            PG8_LDA(At, 0, 1); PG8_STAGE(PG8_SB(0, 0), b2, voffB); PG8_STAGE(PG8_SB(0, 1), b2 + hstepB, voffB); PG8_STAGE(PG8_SA(0, 0), a2, voffA);
            PG8_WAIT_V(8); PG8_WAIT_L(0); PG8_BAR; PG8_MMA(1, 0, At, B0); PG8_MMA(1, 1, At, B1); PG8_BAR; PG8_SCHED;
            PG8_LDB(B0, 1, 0); PG8_LDB(B1, 1, 1); PG8_SCHED; PG8_LDA(At, 1, 0); PG8_STAGE(PG8_SA(0, 1), a2 + hstepA, voffA);
            PG8_WAIT_V(8); PG8_WAIT_L(0); PG8_BAR; PG8_MMA(0, 0, At, B0); PG8_MMA(0, 1, At, B1); PG8_BAR; PG8_SCHED;
            PG8_LDA(At, 1, 1); PG8_STAGE(PG8_SB(1, 0), b3, voffB); PG8_STAGE(PG8_SB(1, 1), b3 + hstepB, voffB); PG8_STAGE(PG8_SA(1, 0), a3, voffA);
            PG8_WAIT_V(8); PG8_WAIT_L(0); PG8_BAR; PG8_MMA(1, 0, At, B0); PG8_MMA(1, 1, At, B1); PG8_BAR; PG8_SCHED;
            } else {
            PG8_LDB(B0, 0, 0); PG8_SCHED; PG8_LDA(At, 0, 0); PG8_STAGE(PG8_SA(1, 1), a1 + hstepA, voffA);
            PG8_WAIT_L(8); PG8_BAR; PG8_WAIT_L(0); PG8_MMA(0, 0, At, B0); PG8_BAR; PG8_SCHED;
            PG8_LDB(B1, 0, 1); PG8_STAGE(PG8_SB(0, 0), b2, voffB);
            PG8_BAR; PG8_WAIT_L(0); PG8_MMA(0, 1, At, B1); PG8_BAR;
            PG8_LDA(At, 0, 1); PG8_STAGE(PG8_SA(0, 0), a2, voffA);
            PG8_BAR; PG8_WAIT_L(0); PG8_MMA(1, 0, At, B0); PG8_BAR; PG8_SCHED;
            PG8_STAGE(PG8_SB(0, 1), b2 + hstepB, voffB);
            PG8_WAIT_V(6); PG8_BAR; PG8_MMA(1, 1, At, B1); PG8_BAR;
            PG8_LDB(B0, 1, 0); PG8_SCHED; PG8_LDA(At, 1, 0); PG8_STAGE(PG8_SA(0, 1), a2 + hstepA, voffA);
            PG8_WAIT_L(8); PG8_BAR; PG8_WAIT_L(0); PG8_MMA(0, 0, At, B0); PG8_BAR; PG8_SCHED;
            PG8_LDB(B1, 1, 1); PG8_STAGE(PG8_SB(1, 0), b3, voffB);
            PG8_BAR; PG8_WAIT_L(0); PG8_MMA(0, 1, At, B1); PG8_BAR;
            PG8_LDA(At, 1, 1); PG8_STAGE(PG8_SA(1, 0), a3, voffA);
            PG8_BAR; PG8_WAIT_L(0); PG8_MMA(1, 0, At, B0); PG8_BAR; PG8_SCHED;
            PG8_STAGE(PG8_SB(1, 1), b3 + hstepB, voffB);
            PG8_WAIT_V(6); PG8_BAR; PG8_MMA(1, 1, At, B1); PG8_BAR;
            }
        }
        if constexpr (ALIGN_EPI) { if (wr == 0) PG8_BAR; }
        { int fr_e = fr, fq_e = fq; asm volatile("" : "+v"(fr_e), "+v"(fq_e));
          E(acc, cur, wr, wc, fr_e, fq_e); }
        if (!has_next) break;
#pragma unroll
        for (int a = 0; a < 2; ++a)
#pragma unroll
            for (int b = 0; b < 2; ++b)
#pragma unroll
                for (int m = 0; m < 4; ++m)
#pragma unroll
                    for (int n = 0; n < 2; ++n) acc[a][b][m][n] = (f32x4){0.f, 0.f, 0.f, 0.f};
        cur = nxt; cA = nA; cB = nB; ++ui;
        if constexpr (ALIGN_EPI) { if (wr == 1) PG8_BAR; }
    }
    PG8_WAIT_V(0);
    if constexpr (!ALIGN_EPI) { if (wr == 0) PG8_BAR; }
    PG8_BAR;
#undef PG8_SA
#undef PG8_SB
#undef PG8_STAGE
#undef p2voffA
#undef p2voffB
#undef PG8_LDA
#undef PG8_LDB
#undef PG8_MMA
#undef PG8_CAT
#undef PG8_WAIT_V
#undef PG8_WAIT_L
#undef PG8_BAR
#undef PG8_SCHED
}
}
using pg8::Unit;

constexpr size_t MiB = 1u << 20;
constexpr size_t WS_CTL = 0, CTL_ZERO_BYTES = 1 * MiB;
constexpr size_t WS_WIN = 1 * MiB;
constexpr size_t WS_WQ = 7 * MiB;
constexpr size_t WS_WKV = WS_WQ + 512 * 1024;
constexpr size_t WS_WPOOL = 8 * MiB;
constexpr size_t WS_WAO = 9 * MiB;
constexpr size_t WS_WPO = 10 * MiB;
constexpr size_t WS_WO = 11 * MiB;
constexpr size_t WS_WPG = 13 * MiB;
constexpr size_t WS_WPLE = 15 * MiB;
constexpr size_t WS_WGU = 16 * MiB;
constexpr size_t WS_WD = 144 * MiB;
constexpr size_t WS_HN = 208 * MiB;
constexpr size_t WS_PROJ = 240 * MiB;
constexpr size_t WS_GATES = 272 * MiB;
constexpr size_t WS_A2 = 336 * MiB;
constexpr size_t WS_POOLED = 352 * MiB;
constexpr size_t WS_Q = 368 * MiB;
constexpr size_t WS_K = 392 * MiB;
constexpr size_t WS_V = 416 * MiB;
constexpr size_t WS_ATT = 432 * MiB;
constexpr size_t WS_MIXED = 448 * MiB;
constexpr size_t WS_MIX = 464 * MiB;
constexpr size_t WS_PB = 496 * MiB;
constexpr size_t WS_E = 504 * MiB;
constexpr size_t WS_SSQ = 536 * MiB;
constexpr size_t WS_COS = 537 * MiB;
constexpr size_t WS_SIN = 538 * MiB;
constexpr size_t WS_ROUTE = 539 * MiB;
constexpr size_t WS_XS = 544 * MiB;
constexpr size_t WS_ACT = 688 * MiB;
constexpr size_t WS_XS2 = 768 * MiB;
constexpr size_t WS_END = 848 * MiB;
constexpr int CW_BAR = 4096;
constexpr int CW_CNT = 1024;

constexpr int RING_BYTES = 131072;
constexpr int LDS_BYTES = 163840;
constexpr int MISC_OFF = LDS_BYTES - 512;
constexpr int TILE_E_OFF = LDS_BYTES - 4096;
constexpr int NWAVES = 8;

typedef GAS unsigned gu32;
#define RLX_AGENT __ATOMIC_RELAXED, __HIP_MEMORY_SCOPE_AGENT
#define XB_TMO      128
#define XB_XCNT(j)  (256  + 64 * (j))
#define XB_XSUB(j)  (1280 + 64 * (j))
#define XB_XGEN(j)  (2304 + 64 * (j))
#define XB_TOP      3328
#define XB_TOPGEN   3392
#define XCD_BAR_WORDS 3456
#define XB_SPIN_CAP (1u << 18)
__device__ __forceinline__ unsigned xb_ld(unsigned* p)              { return __hip_atomic_load(p, __ATOMIC_RELAXED, __HIP_MEMORY_SCOPE_AGENT); }
__device__ __forceinline__ unsigned xb_add(unsigned* p, unsigned v) { return __hip_atomic_fetch_add(p, v, __ATOMIC_RELAXED, __HIP_MEMORY_SCOPE_AGENT); }
__device__ __forceinline__ unsigned xb_xcc_id() { return (unsigned)__builtin_amdgcn_s_getreg((3 << 11) | 20) & 0xFu; }
#define XB_SPIN(cond, bar) do { unsigned _sp = 0; while (cond) { __builtin_amdgcn_s_sleep(1); \
    if ((++_sp & 255u) == 0u) { if (xb_ld(&(bar)[XB_TMO])) break; if (_sp > XB_SPIN_CAP) { atomicAdd(&(bar)[XB_TMO], 1u); break; } } } } while (0)
struct XcdBarrier { unsigned* bar; unsigned x; volatile LAS unsigned* st; };
__device__ __forceinline__ XcdBarrier xcd_barrier_post(unsigned* bar, volatile LAS unsigned* st) {
    XcdBarrier b; b.bar = bar; b.x = xb_xcc_id(); b.st = st;
    if (threadIdx.x == 0) (void)xb_add(&bar[XB_XCNT(b.x)], 1u);
    return b;
}
__device__ __forceinline__ void xcd_barrier_complete(unsigned* bar, unsigned x, unsigned& nloc, unsigned& nx) {
    const unsigned G = gridDim.x * gridDim.y * gridDim.z;
    unsigned sum, cnt, mine, sp = 0u;
    for (;;) {
        sum = 0u; cnt = 0u; mine = 0u;
#pragma unroll
        for (unsigned j = 0; j < 16; ++j) { const unsigned c = xb_ld(&bar[XB_XCNT(j)]); sum += c; cnt += (c > 0u) ? 1u : 0u; mine = (j == x) ? c : mine; }
        if (sum == G) break;
        __builtin_amdgcn_s_sleep(1);
        if ((++sp & 255u) == 0u) { if (xb_ld(&bar[XB_TMO])) break; if (sp > XB_SPIN_CAP) { atomicAdd(&bar[XB_TMO], 1u); break; } }
    }
    nloc = mine > 0u ? mine : 1u; nx = cnt > 0u ? cnt : 1u;
}
__device__ __forceinline__ void xcd_barrier(const XcdBarrier& b) {
    asm volatile("s_waitcnt vmcnt(0)" ::: "memory");
    __syncthreads();
    if (threadIdx.x == 0) {
        unsigned* bar = b.bar;
        __builtin_amdgcn_s_waitcnt(0);
        unsigned nloc = b.st[0], nx = b.st[1];
        if (nloc == 0u) { xcd_barrier_complete(bar, b.x, nloc, nx); b.st[0] = nloc; b.st[1] = nx; }
        const unsigned old = xb_add(&bar[XB_XSUB(b.x)], 1u);
        const unsigned gen = old / nloc;
        if (old + 1u == (gen + 1u) * nloc) {
            __builtin_amdgcn_fence(__ATOMIC_RELEASE, "agent");
            asm volatile("s_waitcnt vmcnt(0)" ::: "memory");
            const unsigned og = xb_add(&bar[XB_TOP], 1u);
            const unsigned tg = og / nx;
            if (og + 1u == (tg + 1u) * nx) xb_add(&bar[XB_TOPGEN], 1u);
            else XB_SPIN(xb_ld(&bar[XB_TOPGEN]) == tg, bar);
            __builtin_amdgcn_fence(__ATOMIC_ACQUIRE, "agent");
            xb_add(&bar[XB_XGEN(b.x)], 1u);
            asm volatile("s_waitcnt vmcnt(0)" ::: "memory");
        } else {
            XB_SPIN(xb_ld(&bar[XB_XGEN(b.x)]) == gen, bar);
            __builtin_amdgcn_fence(__ATOMIC_ACQUIRE, "agent");
            asm volatile("s_waitcnt vmcnt(0)" ::: "memory");
        }
    }
    __syncthreads();
}

struct Args {
    const float* in[27];
    float* out; unsigned char* ws;
    int ph_lo, ph_hi;
};
typedef const __attribute__((address_space(4))) Args* KArgs;
__device__ __forceinline__ KArgs kargs() { KArgs p = (KArgs)__builtin_amdgcn_kernarg_segment_ptr(); asm volatile("" : "+s"(p)); return p; }
enum { I_X = 0, I_P, I_POS, I_GMIX, I_WIN, I_GQLAT, I_WQB, I_GKVLAT, I_WKVB, I_GQHEAD, I_GKNOPE, I_GKROPE, I_WPOOL, I_PSCALE, I_WAO, I_WPO, I_WO, I_GFFN,
       I_WR, I_BR, I_WGU, I_BGU, I_WD, I_BD, I_GPLE, I_WPG, I_WPLE };

enum { MAP_ID = 0, MAP_WIN, MAP_GU, MAP_QB, MAP_KVB };
__device__ __forceinline__ int map_row(int mode, int n) {
    switch (mode) {
    case MAP_WIN: return n < 416 ? n : n + 96;
    case MAP_GU: { const int j = n & 1023, up = n >> 10; return 256 * (j >> 7) + 128 * up + (j & 127); }
    case MAP_QB: { const int h = n / 96, d = n % 96;
        if (d < 64) return (h >> 2) * 256 + 128 * (d >> 5) + 32 * (h & 3) + (d & 31);
        const int dd = d - 64, half = dd >> 4, i = dd & 15; return 512 + 128 * (h & 1) + 32 * (h >> 1) + 8 * (i >> 2) + 4 * half + (i & 3); }
    case MAP_KVB: { const int h = n >> 7, c = n & 127, isv = c >> 6, d = c & 63; return (h >> 1) * 256 + 128 * (d >> 5) + 32 * (2 * isv + (h & 1)) + (d & 31); }
    default: return n;
    }
}
struct TJob { const float* W; int K, N; bf16_t* WT; int ldw, koff, mode, row_off; const float* gk; const float* gn; int nmat; size_t wstride, wtstride; int fp8; };
struct TItem { const float* src; bf16_t* dst; int n0, k0; float gnv; };
__device__ __forceinline__ TItem titem_setup(const TJob& J, int item, int lane) {
    const int nblk = J.N / 32, ipm = (J.K / 64) * nblk, mat = item / ipm, it = item - mat * ipm, kb = it / nblk, nb = it - kb * nblk;
    TItem I; I.k0 = 64 * kb; I.n0 = 32 * nb;
    I.src = J.W + (size_t)mat * J.wstride + (size_t)(I.k0 + (lane >> 5)) * J.N + I.n0 + (lane & 31);
    I.dst = (bf16_t*)((unsigned char*)J.WT + (size_t)mat * J.wtstride * (J.fp8 ? 1 : 2));
    I.gnv = J.gn ? J.gn[I.n0 + (lane & 31)] : 1.f;
    return I;
}
__device__ __forceinline__ void titem_load(const TJob& J, const TItem& I, float (&v)[32]) {
#pragma unroll
    for (int i = 0; i < 32; ++i) v[i] = I.src[(size_t)(2 * i) * J.N];
}
__device__ __forceinline__ void titem_store(const TJob& J, const TItem& I, float (&v)[32], LAS float* scr, int lane) {
#pragma unroll
    for (int i = 0; i < 32; ++i) { const int kk = 2 * i + (lane >> 5); float x = v[i] * I.gnv; if (J.gk) x *= J.gk[I.k0 + kk]; scr[kk * 33 + (lane & 31)] = x; }
    asm volatile("s_waitcnt lgkmcnt(0)" ::: "memory");
    const int c = lane & 7;
#pragma unroll
    for (int j = 0; j < 4; ++j) { const int n = (lane >> 3) + 8 * j; const LAS float* s = scr + (8 * c) * 33 + n;
        const size_t eo = (size_t)(J.row_off + map_row(J.mode, I.n0 + n)) * J.ldw + J.koff + I.k0 + 8 * c;
        if (J.fp8) { u32x2 o; int w = __builtin_amdgcn_cvt_pk_fp8_f32(s[0 * 33] * 8.f, s[1 * 33] * 8.f, 0, false); w = __builtin_amdgcn_cvt_pk_fp8_f32(s[2 * 33] * 8.f, s[3 * 33] * 8.f, w, true); o.x = (unsigned)w;
            w = __builtin_amdgcn_cvt_pk_fp8_f32(s[4 * 33] * 8.f, s[5 * 33] * 8.f, 0, false); w = __builtin_amdgcn_cvt_pk_fp8_f32(s[6 * 33] * 8.f, s[7 * 33] * 8.f, w, true); o.y = (unsigned)w;
            *(u32x2*)((unsigned char*)I.dst + eo) = o; }
        else { u32x4 o; o.x = cvt_pk_bf16(s[0 * 33], s[1 * 33]); o.y = cvt_pk_bf16(s[2 * 33], s[3 * 33]); o.z = cvt_pk_bf16(s[4 * 33], s[5 * 33]); o.w = cvt_pk_bf16(s[6 * 33], s[7 * 33]);
            *(u32x4*)(I.dst + eo) = o; } }
    asm volatile("s_waitcnt lgkmcnt(0)" ::: "memory");
}
__device__ __forceinline__ void run_job(const TJob& J, LAS float* scr, int gw, int NGW, int lane) {
    const int items = J.nmat * (J.K / 64) * (J.N / 32);
    for (int it = gw; it < items; it += 2 * NGW) {
        const bool two = (it + NGW) < items;
        const TItem I0 = titem_setup(J, it, lane); const TItem I1 = titem_setup(J, two ? it + NGW : it, lane);
        float v0[32], v1[32];
        titem_load(J, I0, v0); if (two) titem_load(J, I1, v1);
        titem_store(J, I0, v0, scr, lane); if (two) titem_store(J, I1, v1, scr, lane);
    }
}

struct Frame {
    LAS unsigned char* lds; volatile LAS unsigned* MISC; unsigned* ctl;
    int wave, vcu, G;
    float* out; unsigned char* ws;
};

__device__ __forceinline__ void p0_prologue(const Frame& F) {
    const int tid_l = tid_local(), lane_l = tid_l & 63; (void)tid_l; (void)lane_l;
    const KArgs a = kargs();
    LAS float* scr = (LAS float*)(F.lds + F.wave * 16384);
    const int gw = F.vcu * NWAVES + F.wave, NGW = F.G * NWAVES;
    unsigned char* ws = F.ws;
#define RUN_JOB(...) do { const TJob J_ = TJob{__VA_ARGS__, 1, 0, 0, 0}; run_job(J_, scr, gw, NGW, lane_l); } while (0)
#ifndef P1_FP8
#define P1_FP8 0
#endif
    { const TJob J_{a->in[I_WIN], 1024, 2976, (bf16_t*)(ws + WS_WIN), 1024, 0, MAP_WIN, 0, nullptr, nullptr, 1, 0, 0, P1_FP8}; run_job(J_, scr, gw, NGW, lane_l); }
    RUN_JOB(a->in[I_WQB], 256, 768, (bf16_t*)(ws + WS_WQ), 256, 0, MAP_QB, 0, a->in[I_GQLAT], nullptr);
    RUN_JOB(a->in[I_WKVB], 128, 1024, (bf16_t*)(ws + WS_WKV), 256, 0, MAP_KVB, 0, a->in[I_GKVLAT], nullptr);
    RUN_JOB(a->in[I_WAO], 512, 1024, (bf16_t*)(ws + WS_WAO), 512, 0, MAP_ID, 0, nullptr, nullptr);
    RUN_JOB(a->in[I_WPO], 512, 1024, (bf16_t*)(ws + WS_WPO), 512, 0, MAP_ID, 0, nullptr, nullptr);
    RUN_JOB(a->in[I_WO], 1024, 1024, (bf16_t*)(ws + WS_WO), 1024, 0, MAP_ID, 0, nullptr, nullptr);
    RUN_JOB(a->in[I_WPG], 1024, 1024, (bf16_t*)(ws + WS_WPG), 1024, 0, MAP_ID, 0, nullptr, nullptr);
    RUN_JOB(a->in[I_WPLE], 256, 1024, (bf16_t*)(ws + WS_WPLE), 256, 0, MAP_ID, 0, nullptr, nullptr);
    for (int g = 0; g < 4; ++g)
        RUN_JOB(a->in[I_WPOOL] + (size_t)g * 128 * 128, 128, 128, (bf16_t*)(ws + WS_WPOOL) + (size_t)(g >> 1) * 256 * 256, 256, 128 * (g & 1), MAP_ID, 128 * (g & 1), nullptr, a->in[I_PSCALE] + 128 * g);
    {
        const int gt = (F.vcu * NWAVES + F.wave) * 64 + lane_l, NGT = NGW * 64;
        const u32x4 z = {0u, 0u, 0u, 0u};
        u32x4* w0 = (u32x4*)(ws + WS_WIN + (size_t)416 * 1024 * (P1_FP8 ? 1 : 2));
        for (int i = gt; i < 96 * (P1_FP8 ? 64 : 128); i += NGT) w0[i] = z;
        for (int i = gt; i < 1024 * 16; i += NGT) { const int r = i >> 4, c = i & 15; *(u32x4*)((bf16_t*)(ws + WS_WKV) + (size_t)r * 256 + 128 + 8 * c) = z; }
        for (int i = gt; i < 2 * 256 * 16; i += NGT) { const int p = i >> 12, r = (i >> 4) & 255, c = i & 15;
            const int k0 = (r < 128) ? 128 : 0; *(u32x4*)((bf16_t*)(ws + WS_WPOOL) + (size_t)p * 65536 + (size_t)r * 256 + k0 + 8 * c) = z; }
    }
#ifndef CONV_IN_ATTN
#define CONV_IN_ATTN 1
#endif
    if (!CONV_IN_ATTN) {
    { const TJob J{a->in[I_WGU], 1024, 2048, (bf16_t*)(ws + WS_WGU), 1024, 0, MAP_GU, 0, nullptr, nullptr, NEXP, (size_t)1024 * 2048, (size_t)2048 * 1024, 1}; run_job(J, scr, gw, NGW, lane_l); }
    { const TJob J{a->in[I_WD], 1024, 1024, (bf16_t*)(ws + WS_WD), 1024, 0, MAP_ID, 0, nullptr, nullptr, NEXP, (size_t)1024 * 1024, (size_t)1024 * 1024, 1}; run_job(J, scr, gw, NGW, lane_l); }
    }
    const float* x = a->in[I_X]; const float* gm = a->in[I_GMIX];
    f32x4 gv[4];
#pragma unroll
    for (int j = 0; j < 4; ++j) gv[j] = *(const f32x4*)(gm + 4 * lane_l + 256 * j);
    for (int m = gw; m < T; m += NGW) {
        const f32x4* xr = (const f32x4*)(x + (size_t)m * DM) + lane_l;
        f32x4 v[4]; float s = 0.f;
#pragma unroll
        for (int j = 0; j < 4; ++j) { v[j] = xr[64 * j]; s += (v[j].x * v[j].x + v[j].y * v[j].y) + (v[j].z * v[j].z + v[j].w * v[j].w); }
        const float rstd = 1.0f / sqrtf(wave_sum(s) * (1.f / DM) + EPS);
        if (P1_FP8) { int* o4 = (int*)(ws + WS_HN + (size_t)m * DM) + lane_l; const float r8 = rstd * 8.0f;
#pragma unroll
            for (int j = 0; j < 4; ++j) { int w = __builtin_amdgcn_cvt_pk_fp8_f32(v[j].x * r8 * gv[j].x, v[j].y * r8 * gv[j].y, 0, false); w = __builtin_amdgcn_cvt_pk_fp8_f32(v[j].z * r8 * gv[j].z, v[j].w * r8 * gv[j].w, w, true); o4[64 * j] = w; } }
        else { u32x2* o8 = (u32x2*)((bf16_t*)(ws + WS_HN) + (size_t)m * DM) + lane_l;
#pragma unroll
            for (int j = 0; j < 4; ++j) { u32x2 w; w.x = cvt_pk_bf16(v[j].x * rstd * gv[j].x, v[j].y * rstd * gv[j].y); w.y = cvt_pk_bf16(v[j].z * rstd * gv[j].z, v[j].w * rstd * gv[j].w); o8[64 * j] = w; } }
    }
    {
        const float* p = a->in[I_P];
        for (int m = gw; m < T; m += NGW) { const f32x4 v = *((const f32x4*)(p + (size_t)m * PLE) + lane_l); u32x2 w; w.x = cvt_pk_bf16(v.x, v.y); w.y = cvt_pk_bf16(v.z, v.w);
            *((u32x2*)((bf16_t*)(ws + WS_PB) + (size_t)m * PLE) + lane_l) = w; }
    }
}

struct DenseOrder {
    int nM, nN, nwg, G, c; unsigned A, B, tA, tB, aPn;
    __device__ void init(int nM_, int nN_, int G_, int c_, size_t A_, size_t lda, size_t B_, size_t ldb, unsigned aPn_ = 0) { nM = nM_; nN = nN_; nwg = nM * nN; G = G_; c = c_; A = (unsigned)A_; B = (unsigned)B_; tA = (unsigned)(256 * lda * 2); tB = (unsigned)(256 * ldb * 2); aPn = aPn_; }
    __device__ __forceinline__ bool next(int i, Unit& u) const {
        const long L = (long)i * G + c; if (L >= nwg) return false;
        int wgid = (int)L; { const int q = nwg / 8, r = nwg % 8, xcd = wgid % 8, off = wgid / 8; wgid = (xcd < r ? xcd * (q + 1) : r * (q + 1) + (xcd - r) * q) + off; }
        const int WGM = 8; const int nig = WGM * nN, gid = wgid / nig, fm = gid * WGM, gsz = (nM - fm) < WGM ? (nM - fm) : WGM;
        u.pm = fm + ((wgid % nig) % gsz); u.pn = (wgid % nig) / gsz; u.aux = 0; return true;
    }
    __device__ __forceinline__ unsigned a_off(const Unit& u) const { return A + (unsigned)u.pm * tA + (unsigned)u.pn * aPn; }
    __device__ __forceinline__ unsigned b_off(const Unit& u) const { return B + (unsigned)u.pn * tB; }
};

struct EpiBf16 {
    static constexpr bool PERM = true;
    bf16_t* O; int ldc;
    __device__ __forceinline__ void operator()(const f32x4 (&acc)[2][2][4][2], const Unit& u, int wr, int wc, int fr, int fq) const {
        const int row0 = u.pm * 256 + wr * 64 + fr, col0 = u.pn * 256 + wc * 32 + 8 * fq;
#pragma unroll
        for (int ai = 0; ai < 2; ++ai)
#pragma unroll
            for (int m = 0; m < 4; ++m) { bf16_t* rowp = O + (size_t)(row0 + ai * 128 + m * 16) * ldc + col0;
#pragma unroll
                for (int bj = 0; bj < 2; ++bj) { const f32x4 v0 = acc[ai][bj][m][0], v1 = acc[ai][bj][m][1];
                    u32x4 w; w.x = cvt_pk_bf16(v0[0], v0[1]); w.y = cvt_pk_bf16(v0[2], v0[3]); w.z = cvt_pk_bf16(v1[0], v1[1]); w.w = cvt_pk_bf16(v1[2], v1[3]);
                    *(u32x4*)(rowp + bj * 128) = w; } }
    }
};
struct EpiProj {
    static constexpr bool PERM = true;
    bf16_t* PROJ; bf16_t* GATES;
    __device__ __forceinline__ void operator()(const f32x4 (&acc)[2][2][4][2], const Unit& u, int wr, int wc, int fr, int fq) const {
        const int row0 = u.pm * 256 + wr * 64 + fr; const bool isg = u.pn >= 4;
        bf16_t* O = isg ? GATES : PROJ; const int ldc = isg ? 2048 : 1024; const int col0 = (isg ? u.pn - 4 : u.pn) * 256 + wc * 32 + 8 * fq;
#pragma unroll
        for (int ai = 0; ai < 2; ++ai)
#pragma unroll
            for (int m = 0; m < 4; ++m) { bf16_t* rowp = O + (size_t)(row0 + ai * 128 + m * 16) * ldc + col0;
#pragma unroll
                for (int bj = 0; bj < 2; ++bj) { f32x4 v0 = acc[ai][bj][m][0], v1 = acc[ai][bj][m][1];
                    if (isg) {
#pragma unroll
                        for (int e = 0; e < 4; ++e) { v0[e] = fast_sigmoid(v0[e]); v1[e] = fast_sigmoid(v1[e]); } }
                    u32x4 w; w.x = cvt_pk_bf16(v0[0], v0[1]); w.y = cvt_pk_bf16(v0[2], v0[3]); w.z = cvt_pk_bf16(v1[0], v1[1]); w.w = cvt_pk_bf16(v1[2], v1[3]);
                    *(u32x4*)(rowp + bj * 128) = w; } asm volatile("" ::: "memory"); }
    }
};

__device__ __forceinline__ void p2_rows(const Frame& F) {
    const int tid_l = tid_local(), lane_l = tid_l & 63; (void)tid_l; (void)lane_l;
    const KArgs a = kargs();
    const int gw = F.vcu * NWAVES + F.wave, NGW = F.G * NWAVES, lane = lane_l;
    unsigned char* ws = F.ws;
    const bf16_t* PROJ = (const bf16_t*)(ws + WS_PROJ);
    bf16_t* A2 = (bf16_t*)(ws + WS_A2); bf16_t* POOLED = (bf16_t*)(ws + WS_POOLED); bf16_t* Kb = (bf16_t*)(ws + WS_K);
    float* COS = (float*)(ws + WS_COS); float* SIN = (float*)(ws + WS_SIN);
    const int* positions = (const int*)a->in[I_POS];
    const float gkr = (lane < 32) ? a->in[I_GKROPE][lane] : 0.f;
    const float inv_freq = __builtin_amdgcn_exp2f(-(float)(lane & 15) * (13.287712379549449f / 16.0f));
    const int w = 2 << (lane >> 4);
    for (int task = gw; task < T / 8; task += NGW) {
        const int t0 = task * 8, b = t0 / SEQ, s0 = t0 % SEQ;
        {
            const bf16_t* base = PROJ + (size_t)(b * SEQ) * 1024 + 512 + 8 * lane;
            float S[8];
#pragma unroll
            for (int j = 0; j < 8; ++j) S[j] = 0.f;
            for (int r = s0 - 15; r < s0; ++r) {
                if (r >= 0 && r >= s0 - w + 1) { const u32x4 v = *(const u32x4*)(base + (size_t)r * 1024);
                    S[0] += bf_lo(v.x); S[1] += bf_hi(v.x); S[2] += bf_lo(v.y); S[3] += bf_hi(v.y); S[4] += bf_lo(v.z); S[5] += bf_hi(v.z); S[6] += bf_lo(v.w); S[7] += bf_hi(v.w); }
            }
#pragma unroll
            for (int i = 0; i < 8; ++i) {
                const int s = s0 + i;
                const u32x4 v = *(const u32x4*)(base + (size_t)s * 1024);
                float uu[8] = {bf_lo(v.x), bf_hi(v.x), bf_lo(v.y), bf_hi(v.y), bf_lo(v.z), bf_hi(v.z), bf_lo(v.w), bf_hi(v.w)};
                const int cnt = (s + 1 < w) ? s + 1 : w; const float ic = 1.0f / (float)cnt;
                float o[8];
#pragma unroll
                for (int j = 0; j < 8; ++j) { S[j] += uu[j]; o[j] = S[j] * ic - uu[j]; }
                u32x4 wv; wv.x = cvt_pk_bf16(o[0], o[1]); wv.y = cvt_pk_bf16(o[2], o[3]); wv.z = cvt_pk_bf16(o[4], o[5]); wv.w = cvt_pk_bf16(o[6], o[7]);
                *(u32x4*)(POOLED + (size_t)(t0 + i) * 512 + 8 * lane) = wv;
                const int rr = s - w + 1;
                if (rr >= 0) { const u32x4 q = *(const u32x4*)(base + (size_t)rr * 1024);
                    S[0] -= bf_lo(q.x); S[1] -= bf_hi(q.x); S[2] -= bf_lo(q.y); S[3] -= bf_hi(q.y); S[4] -= bf_lo(q.z); S[5] -= bf_hi(q.z); S[6] -= bf_lo(q.w); S[7] -= bf_hi(q.w); }
            }
        }
        for (int i = 0; i < 8; ++i) {
            const int t = t0 + i, s = s0 + i;
            const bf16_t* pr = PROJ + (size_t)t * 1024;
            const u32x2 ql = *(const u32x2*)(pr + 4 * lane);
            const unsigned kvl = *(const unsigned*)(pr + 256 + 2 * lane);
            const float krv = (lane < 32) ? bf1(pr[384 + lane]) : 0.f;
            const float q0 = bf_lo(ql.x), q1 = bf_hi(ql.x), q2 = bf_lo(ql.y), q3 = bf_hi(ql.y);
            const float k0 = bf_lo(kvl), k1 = bf_hi(kvl);
            const float sq = wave_sum((q0 * q0 + q1 * q1) + (q2 * q2 + q3 * q3));
            const float sk = wave_sum(k0 * k0 + k1 * k1);
            const float sr = wave_sum(krv * krv);
            const float rq = 1.0f / sqrtf(sq * (1.f / 256.f) + EPS), rk = 1.0f / sqrtf(sk * (1.f / 128.f) + EPS), rr = 1.0f / sqrtf(sr * (1.f / 32.f) + EPS);
            u32x2 wq; wq.x = cvt_pk_bf16(q0 * rq, q1 * rq); wq.y = cvt_pk_bf16(q2 * rq, q3 * rq);
            *(u32x2*)(A2 + (size_t)t * 512 + 4 * lane) = wq;
            *(unsigned*)(A2 + (size_t)t * 512 + 256 + 2 * lane) = cvt_pk_bf16(k0 * rk, k1 * rk);
            *(unsigned*)(A2 + (size_t)t * 512 + 384 + 2 * lane) = 0u;
            const float pos = (float)positions[t];
            const float ang = pos * inv_freq;
            const float rev = ang * 0.15915494309189535f;
            const float fr_ = rev - floorf(rev);
            const float sn = __builtin_amdgcn_sinf(fr_), cs = __builtin_amdgcn_cosf(fr_);
            const float kn = krv * rr * gkr;
            const float other = __shfl_xor(kn, 16);
            const float ro = (lane & 16) ? (kn * cs + other * sn) : (kn * cs - other * sn);
            if (lane < 32) {
                const bf16_t rb = (bf16_t)(cvt_pk_bf16(ro, 0.f) & 0xffffu);
#pragma unroll
                for (int h = 0; h < NH; ++h) Kb[((size_t)(b * NH + h) * SEQ + s) * DK + 64 + lane] = rb;
            }
            if (lane < 16) { COS[(size_t)t * 16 + lane] = cs; SIN[(size_t)t * 16 + lane] = sn; }
        }
    }
}

#define EPI_FENCE() asm volatile("" ::: "memory")
struct EpiQ {
    static constexpr bool PERM = true;
    bf16_t* Q; float* SSQ; const float* COS; const float* SIN; const float* gq;
    __device__ __forceinline__ void operator()(const f32x4 (&acc)[2][2][4][2], const Unit& u, int wr, int wc, int fr, int fq) const {
        const int t0 = u.pm * 256 + wr * 64 + fr, b = (u.pm * 256) / SEQ, s0 = t0 - b * SEQ;
        if (u.pn < 2) {
            const int h = 4 * u.pn + wc;
            bf16_t* dst0 = Q + ((size_t)(b * NH + h) * SEQ + s0) * DK + 8 * fq;
            float* ssq0 = SSQ + ((size_t)t0 * NH + h) * 2;
#pragma unroll
            for (int ai = 0; ai < 2; ++ai)
#pragma unroll
                for (int m = 0; m < 4; ++m) {
                    const int dr = ai * 128 + m * 16;
                    float q = 0.f;
#pragma unroll
                    for (int bj = 0; bj < 2; ++bj)
#pragma unroll
                        for (int n = 0; n < 2; ++n) { const f32x4 v = acc[ai][bj][m][n]; q += (v[0] * v[0] + v[1] * v[1]) + (v[2] * v[2] + v[3] * v[3]); }
                    q += __shfl_xor(q, 16); q += __shfl_xor(q, 32);
                    if (fq == 0) ssq0[dr * NH * 2] = q;
#pragma unroll
                    for (int bj = 0; bj < 2; ++bj) { const f32x4 v0 = acc[ai][bj][m][0] * *(const f32x4*)(gq + 32 * bj + 8 * fq), v1 = acc[ai][bj][m][1] * *(const f32x4*)(gq + 32 * bj + 8 * fq + 4);
                        u32x4 w; w.x = cvt_pk_bf16(v0[0], v0[1]); w.y = cvt_pk_bf16(v0[2], v0[3]); w.z = cvt_pk_bf16(v1[0], v1[1]); w.w = cvt_pk_bf16(v1[2], v1[3]);
                        *(u32x4*)(dst0 + dr * DK + 32 * bj) = w; }
                    EPI_FENCE();
                }
        } else {
            const f32x4 g1 = *(const f32x4*)(gq + 64 + 4 * fq), g2 = *(const f32x4*)(gq + 80 + 4 * fq);
            const float* cs0 = COS + (size_t)t0 * 16 + 4 * fq; const float* sn0 = SIN + (size_t)t0 * 16 + 4 * fq;
            bf16_t* dst0 = Q + ((size_t)(b * NH + 2 * wc) * SEQ + s0) * DK + 64 + 4 * fq;
            float* ssq0 = SSQ + ((size_t)t0 * NH + 2 * wc) * 2 + 1;
#pragma unroll
            for (int ai = 0; ai < 2; ++ai)
#pragma unroll
                for (int m = 0; m < 4; ++m) {
                    const int dr = ai * 128 + m * 16;
                    const f32x4 cs = *(const f32x4*)(cs0 + dr * 16), sn = *(const f32x4*)(sn0 + dr * 16);
#pragma unroll
                    for (int bj = 0; bj < 2; ++bj) {
                        const f32x4 x1 = acc[ai][bj][m][0], x2 = acc[ai][bj][m][1];
                        float q = (x1[0] * x1[0] + x1[1] * x1[1]) + (x1[2] * x1[2] + x1[3] * x1[3]) + (x2[0] * x2[0] + x2[1] * x2[1]) + (x2[2] * x2[2] + x2[3] * x2[3]);
                        q += __shfl_xor(q, 16); q += __shfl_xor(q, 32);
                        if (fq == 0) ssq0[dr * NH * 2 + bj * 2] = q;
                        const f32x4 y1 = x1 * g1, y2 = x2 * g2;
                        const f32x4 o1 = y1 * cs - y2 * sn, o2 = y2 * cs + y1 * sn;
                        bf16_t* dst = dst0 + (size_t)bj * SEQ * DK + dr * DK;
                        u32x2 w1, w2; w1.x = cvt_pk_bf16(o1[0], o1[1]); w1.y = cvt_pk_bf16(o1[2], o1[3]); w2.x = cvt_pk_bf16(o2[0], o2[1]); w2.y = cvt_pk_bf16(o2[2], o2[3]);
                        *(u32x2*)(dst) = w1; *(u32x2*)(dst + 16) = w2;
                    }
                    EPI_FENCE();
                }
        }
    }
};
struct EpiKV {
    static constexpr bool PERM = true;
    bf16_t* K; bf16_t* V; const float* gk;
    __device__ __forceinline__ void operator()(const f32x4 (&acc)[2][2][4][2], const Unit& u, int wr, int wc, int fr, int fq) const {
        const int t0 = u.pm * 256 + wr * 64 + fr, b = (u.pm * 256) / SEQ, s0 = t0 - b * SEQ;
        const int h = 2 * u.pn + (wc & 1); const bool isv = wc >= 2;
        const int pitch = isv ? DV : DK;
        bf16_t* dst0 = (isv ? V : K) + ((size_t)(b * NH + h) * SEQ + s0) * pitch + 8 * fq;
#pragma unroll
        for (int ai = 0; ai < 2; ++ai)
#pragma unroll
            for (int m = 0; m < 4; ++m) {
                const int dr = ai * 128 + m * 16;
                float sc = 1.f;
                if (!isv) { float q = 0.f;
#pragma unroll
                    for (int bj = 0; bj < 2; ++bj)
#pragma unroll
                        for (int n = 0; n < 2; ++n) { const f32x4 v = acc[ai][bj][m][n]; q += (v[0] * v[0] + v[1] * v[1]) + (v[2] * v[2] + v[3] * v[3]); }
                    q += __shfl_xor(q, 16); q += __shfl_xor(q, 32);
                    sc = 1.0f / sqrtf(q * (1.f / 64.f) + EPS); }
#pragma unroll
                for (int bj = 0; bj < 2; ++bj) {
                    f32x4 v0 = acc[ai][bj][m][0] * sc, v1 = acc[ai][bj][m][1] * sc;
                    if (!isv) { v0 = v0 * *(const f32x4*)(gk + 32 * bj + 8 * fq); v1 = v1 * *(const f32x4*)(gk + 32 * bj + 8 * fq + 4); }
                    u32x4 w; w.x = cvt_pk_bf16(v0[0], v0[1]); w.y = cvt_pk_bf16(v0[2], v0[3]); w.z = cvt_pk_bf16(v1[0], v1[1]); w.w = cvt_pk_bf16(v1[2], v1[3]);
                    *(u32x4*)(dst0 + dr * pitch + 32 * bj) = w; }
                EPI_FENCE();
            }
    }
};

namespace att {
constexpr int KT_BYTES = 64 * 192, VT_BYTES = 64 * 128, SLOT_BYTES = KT_BYTES + VT_BYTES;
constexpr int NSLOT = 4, SCR_OFF = NSLOT * SLOT_BYTES;
__device__ __forceinline__ int crow(int r, int hi) { return (r & 3) + 8 * (r >> 2) + 4 * hi; }
__device__ __forceinline__ s16x4 vtr(const LAS unsigned char* p) { typedef short v4i16_t __attribute__((ext_vector_type(4)));
    return __builtin_bit_cast(s16x4, __builtin_amdgcn_ds_read_tr16_b64_v4i16((LAS v4i16_t*)p)); }
#define MFMA32(a, b, c) __builtin_amdgcn_mfma_f32_32x32x16_bf16(a, b, c, 0, 0, 0)
__device__ __forceinline__ float max3f(float a, float b, float c) { return __builtin_fmaxf(__builtin_fmaxf(a, b), c); }


constexpr int CONV_OFF = SCR_OFF + 8 * 256, CONV_BYTES = 8192;
constexpr int CV_GU_ITEMS = NEXP * 1024, CV_ITEMS = CV_GU_ITEMS + NEXP * 512;
struct ConvItem { const float* src; unsigned char* dst; int N, isgu, n0; };
__device__ __forceinline__ ConvItem cv_setup(int g, const float* wgu, const float* wd, unsigned char* wgu8, unsigned char* wd8) {
    ConvItem I;
    if (g < CV_GU_ITEMS) { const int e = g >> 10, it = g & 1023, kb = it >> 6, nb = it & 63; I.N = 2048; I.isgu = 1; I.n0 = 32 * nb;
        I.src = wgu + (size_t)e * 1024 * 2048 + (size_t)(64 * kb) * 2048 + 32 * nb; I.dst = wgu8 + (size_t)e * 2048 * 1024 + 64 * kb; }
    else { const int g2 = g - CV_GU_ITEMS, e = g2 >> 9, it = g2 & 511, kb = it >> 5, nb = it & 31; I.N = 1024; I.isgu = 0; I.n0 = 32 * nb;
        I.src = wd + (size_t)e * 1024 * 1024 + (size_t)(64 * kb) * 1024 + 32 * nb; I.dst = wd8 + (size_t)e * 1024 * 1024 + 64 * kb; }
    return I;
}
__device__ __forceinline__ void cv_dma(const ConvItem& I, unsigned ldsaddr, int lane) {
    const int kr = lane >> 3, sl = lane & 7;
#pragma unroll
    for (int q = 0; q < 8; ++q) { const unsigned voff = (unsigned)(((8 * q + kr) * I.N + 4 * (sl ^ ((kr ^ q) & 7))) * 4);
        asm volatile("s_nop 4\n\ts_mov_b32 m0, %0\n\ts_nop 0\n\tglobal_load_lds_dwordx4 %1, %2" :: "s"(ldsaddr + (unsigned)q * 1024u), "v"(voff), "s"(I.src) : "m0", "memory"); }
}
__device__ __forceinline__ void cv_out(const ConvItem& I, const LAS float* cb, int lane) {
    const int c = lane & 7;
#pragma unroll
    for (int j = 0; j < 4; ++j) { const int n = (lane >> 3) + 8 * j, nc = n >> 2, e = n & 3;
        float f[8];
#pragma unroll
        for (int kk = 0; kk < 8; ++kk) f[kk] = cb[(8 * c + kk) * 32 + ((nc ^ kk ^ c) & 7) * 4 + e];
        const int nn = I.n0 + n; const int row = I.isgu ? (256 * ((nn & 1023) >> 7) + 128 * (nn >> 10) + (nn & 127)) : nn;
        *(u32x2*)(I.dst + (size_t)row * 1024 + 8 * c) = cvt8_fp8((f32x4){f[0], f[1], f[2], f[3]}, (f32x4){f[4], f[5], f[6], f[7]}, 8.0f);
        asm volatile("" ::: "memory"); }
}
struct ConvState { int next, end, cur; };
__device__ __forceinline__ void attn_unit(LAS unsigned char* lds, const u32x4 srd, ConvState& CV, unsigned char* cvws, int bh, int qb, const bf16_t* Q, unsigned Koff, unsigned Voff, const float* SSQ, bf16_t* O) {
    const int tid = tid_local(), lane = tid & 63, r32 = lane & 31, hi = lane >> 5; const int wid = __builtin_amdgcn_readfirstlane(tid >> 6);
    const int b = bh / NH, h = bh % NH, q0 = qb * 256, qw = q0 + 32 * wid;
    LAS float* scr = (LAS float*)(lds + SCR_OFF) + wid * 64;
    const int NT = (q0 + 256) / 64;
    const unsigned kS = Koff + (unsigned)bh * (SEQ * DK * 2), vS = Voff + (unsigned)bh * (SEQ * DV * 2);
    const int kc2 = 8 + (wid & 3);
    const unsigned vK1 = (unsigned)(lane * 192 + wid * 16); const unsigned sK2 = (unsigned)((kc2 - wid) * 16);
    const int vkey = 8 * wid + (lane >> 3); const unsigned vV = (unsigned)(vkey * 128 + (((lane & 7) ^ (((vkey >> 1) & 1) * 4)) * 16));
    const unsigned lds0 = (unsigned)__builtin_amdgcn_readfirstlane((int)(unsigned)(unsigned long)lds);
    const unsigned dK1 = (unsigned)wid * 1024u, dK2 = (unsigned)kc2 * 1024u, dV = (unsigned)KT_BYTES + (unsigned)wid * 1024u;
#define ATT_DMA1(ldsaddr, voff, soff) asm volatile("s_nop 4\n\ts_mov_b32 m0, %0\n\ts_nop 0\n\tbuffer_load_dwordx4 %1, %2, %3 offen lds" :: "s"(ldsaddr), "v"(voff), "s"(srd), "s"(soff) : "m0", "memory")
#define ATT_DMA(t) do { const unsigned sp_ = lds0 + (unsigned)((t) & 3) * SLOT_BYTES; const unsigned ks_ = kS + (unsigned)(t) * (64 * 192), vs_ = vS + (unsigned)(t) * (64 * 128); \
        ATT_DMA1(sp_ + dK1, vK1, ks_); ATT_DMA1(sp_ + dK2, vK1, ks_ + sK2); ATT_DMA1(sp_ + dV, vV, vs_); } while (0)
#define ATT_WAITBAR(N) asm volatile("s_waitcnt vmcnt(" #N ") lgkmcnt(0)\n\ts_barrier" ::: "memory")
    bf16x8 qr[6];
    { const float* sp = SSQ + ((size_t)(b * SEQ + qw + r32) * NH + h) * 2; const float ss = sp[0] + sp[1];
      const float cq = (1.0f / sqrtf(ss * (1.f / 96.f) + EPS)) * 0.10206207261596577f * 1.4426950408889634f;
      const bf16_t* qp = Q + ((size_t)bh * SEQ + qw + r32) * DK + 8 * hi;
      u32x4 qw_[6];
#pragma unroll
      for (int d0 = 0; d0 < 6; ++d0) qw_[d0] = *(const u32x4*)(qp + 16 * d0);
#pragma unroll
      for (int d0 = 0; d0 < 6; ++d0) { const u32x4 w = qw_[d0]; u32x4 o;
          o.x = cvt_pk_bf16(bf_lo(w.x) * cq, bf_hi(w.x) * cq); o.y = cvt_pk_bf16(bf_lo(w.y) * cq, bf_hi(w.y) * cq); o.z = cvt_pk_bf16(bf_lo(w.z) * cq, bf_hi(w.z) * cq); o.w = cvt_pk_bf16(bf_lo(w.w) * cq, bf_hi(w.w) * cq);
          qr[d0] = __builtin_bit_cast(bf16x8, o); } }
    ATT_DMA(0); ATT_DMA(1); ATT_DMA(2);
    const int kbase = hi * 1024 + r32 * 16;
    const int qq = (lane & 15) >> 2, pp = lane & 3, dblk = (lane >> 4) & 1, swz = ((qq >> 1) & 1) * 64;
    const int vrow0 = 4 * hi + qq;
    const int vb0 = KT_BYTES + vrow0 * 128 + ((32 * dblk + 8 * pp) ^ swz);
    const int vb1 = KT_BYTES + vrow0 * 128 + ((64 + 32 * dblk + 8 * pp) ^ swz);
    f32x16 o0 = {}, o1 = {};
    float m_run = -1e30f, l_run = 0.f; const f32x16 zero16 = {};
    const int qa = qw + r32;
#define ATT_QK(N0, N1, t) do { const LAS unsigned char* kp_ = lds + ((t) & 3) * SLOT_BYTES + kbase; \
        _Pragma("unroll") for (int d0 = 0; d0 < 6; ++d0) { const bf16x8 ka_ = *(const LAS bf16x8*)(kp_ + d0 * 2048), kb_ = *(const LAS bf16x8*)(kp_ + d0 * 2048 + 512); \
            if (d0 == 0) { N0 = MFMA32(ka_, qr[0], zero16); N1 = MFMA32(kb_, qr[0], zero16); } else { N0 = MFMA32(ka_, qr[d0], N0); N1 = MFMA32(kb_, qr[d0], N1); } } } while (0)
#define ATT_MASK(N0, N1, t) do { const int kb_ = 64 * (t); if (kb_ + 63 > qw) { _Pragma("unroll") for (int r = 0; r < 16; ++r) { const int ka_ = kb_ + crow(r, hi); \
        if (ka_ > qa) N0[r] = -__builtin_inff(); if (ka_ + 32 > qa) N1[r] = -__builtin_inff(); } } } while (0)
#define ATT_ROWMAX(N0, N1, PM) do { float a_ = max3f(N0[0], N0[1], N1[0]), b_ = max3f(N0[2], N0[3], N1[1]); a_ = max3f(a_, N1[2], N1[3]); \
        _Pragma("unroll") for (int r = 4; r < 16; r += 4) { a_ = max3f(a_, N0[r], N0[r + 1]); b_ = max3f(b_, N0[r + 2], N0[r + 3]); a_ = max3f(a_, N1[r], N1[r + 1]); b_ = max3f(b_, N1[r + 2], N1[r + 3]); } \
        a_ = max3f(a_, b_, b_); auto rr_ = __builtin_amdgcn_permlane32_swap(__float_as_uint(a_), __float_as_uint(a_), false, false); \
        PM = max3f(__uint_as_float(rr_[0]), __uint_as_float(rr_[1]), __uint_as_float(rr_[1])); } while (0)
#define ATT_DECIDE(PM, C0, C1, FORCE) do { if ((FORCE) || __any((PM) > m_run + 8.0f)) { const float mn_ = fmaxf(m_run, (PM)); const float al_ = __builtin_amdgcn_exp2f(m_run - mn_); m_run = mn_; l_run *= al_; \
        if (hi == 0) scr[r32] = al_; asm volatile("s_waitcnt lgkmcnt(0)" ::: "memory"); \
        _Pragma("unroll") for (int a4 = 0; a4 < 4; ++a4) { const f32x4 f_ = *(const LAS f32x4*)(scr + 8 * a4 + 4 * hi); \
            _Pragma("unroll") for (int e = 0; e < 4; ++e) { o0[4 * a4 + e] *= f_[e]; o1[4 * a4 + e] *= f_[e]; } } } } while (0)
#define ATT_SOFTMAX(C0, C1) do { float ps_ = 0.f; \
        _Pragma("unroll") for (int r = 0; r < 16; ++r) { C0[r] = __builtin_amdgcn_exp2f(C0[r] - m_run); C1[r] = __builtin_amdgcn_exp2f(C1[r] - m_run); ps_ += C0[r] + C1[r]; } \
        l_run += ps_; \
        _Pragma("unroll") for (int ks = 0; ks < 4; ++ks) { const f32x16& P_ = (ks < 2) ? C0 : C1; const int bs_ = 8 * (ks & 1); \
            u32x4 w_; w_.x = cvt_pk_bf16(P_[bs_ + 0], P_[bs_ + 1]); w_.y = cvt_pk_bf16(P_[bs_ + 2], P_[bs_ + 3]); w_.z = cvt_pk_bf16(P_[bs_ + 4], P_[bs_ + 5]); w_.w = cvt_pk_bf16(P_[bs_ + 6], P_[bs_ + 7]); \
            pa[ks] = __builtin_bit_cast(bf16x8, w_); } } while (0)
#define ATT_PV(t) do { const LAS unsigned char* vp0_ = lds + ((t) & 3) * SLOT_BYTES + vb0; const LAS unsigned char* vp1_ = lds + ((t) & 3) * SLOT_BYTES + vb1; \
        _Pragma("unroll") for (int ks = 0; ks < 4; ++ks) { \
            const s16x4 a0_ = vtr(vp0_ + ks * 16 * 128), a1_ = vtr(vp0_ + ks * 16 * 128 + 8 * 128), c0_ = vtr(vp1_ + ks * 16 * 128), c1_ = vtr(vp1_ + ks * 16 * 128 + 8 * 128); \
            const bf16x8 vf0_ = {a0_[0], a0_[1], a0_[2], a0_[3], a1_[0], a1_[1], a1_[2], a1_[3]}; const bf16x8 vf1_ = {c0_[0], c0_[1], c0_[2], c0_[3], c1_[0], c1_[1], c1_[2], c1_[3]}; \
            o0 = MFMA32(pa[ks], vf0_, o0); o1 = MFMA32(pa[ks], vf1_, o1); } } while (0)
#define ATT_WB(N) asm volatile("s_waitcnt vmcnt(" #N ") lgkmcnt(0)\n\ts_barrier" ::: "memory")
#define ATT_STEP(C0, C1, PMC, N0, N1, PMN, j, MSK, CONV) do { \
        ATT_DECIDE(PMC, C0, C1, false); \
        ATT_QK(N0, N1, (j) + 1); ATT_SOFTMAX(C0, C1); \
        bool cvi_ = false; \
        if (CONV) { __builtin_amdgcn_sched_barrier(0); const LAS float* cb_ = (const LAS float*)(lds + CONV_OFF + wid * CONV_BYTES); \
            if (CV.cur >= 0) { const ConvItem I_ = cv_setup(CV.cur, kargs()->in[I_WGU], kargs()->in[I_WD], cvws + WS_WGU, cvws + WS_WD); cv_out(I_, cb_, lane); } \
            if (CV.next < CV.end) { const ConvItem I_ = cv_setup(CV.next, kargs()->in[I_WGU], kargs()->in[I_WD], cvws + WS_WGU, cvws + WS_WD); asm volatile("s_waitcnt lgkmcnt(0)" ::: "memory"); \
                cv_dma(I_, lds0 + (unsigned)(CONV_OFF + wid * CONV_BYTES), lane); CV.cur = CV.next; CV.next += 2048; cvi_ = true; } else CV.cur = -1; __builtin_amdgcn_sched_barrier(0); } \
        const bool dma_ = (j) + 3 < NT; if (dma_) ATT_DMA((j) + 3); \
        ATT_PV(j); if (MSK) ATT_MASK(N0, N1, (j) + 1); ATT_ROWMAX(N0, N1, PMN); \
        if (dma_) { if (cvi_) ATT_WB(11); else ATT_WB(3); } else { if (cvi_) ATT_WB(8); else ATT_WB(0); } } while (0)
    bf16x8 pa[4];
    f32x16 sA0, sA1, sB0, sB1; float pmA, pmB;
    ATT_WAITBAR(6);
    ATT_QK(sA0, sA1, 0); ATT_MASK(sA0, sA1, 0); ATT_ROWMAX(sA0, sA1, pmA);
    ATT_WAITBAR(3);
    int j = 0;
    for (; j + 8 <= NT; j += 2) {
        ATT_STEP(sA0, sA1, pmA, sB0, sB1, pmB, j, false, CONV_IN_ATTN);
        ATT_STEP(sB0, sB1, pmB, sA0, sA1, pmA, j + 1, false, false);
    }
    for (; j < NT; j += 2) {
        ATT_STEP(sA0, sA1, pmA, sB0, sB1, pmB, j, true, CONV_IN_ATTN);
        ATT_STEP(sB0, sB1, pmB, sA0, sA1, pmA, j + 1, true, false);
    }
#undef ATT_DMA
#undef ATT_DMA1
#undef ATT_WAITBAR
#undef ATT_QK
#undef ATT_MASK
#undef ATT_ROWMAX
#undef ATT_DECIDE
#undef ATT_SOFTMAX
#undef ATT_PV
#undef ATT_STEP
#undef ATT_WB
    { auto rr = __builtin_amdgcn_permlane32_swap(__float_as_uint(l_run), __float_as_uint(l_run), false, false); l_run = __uint_as_float(rr[0]) + __uint_as_float(rr[1]); }
    if (hi == 0) scr[32 + r32] = 1.0f / l_run;
    asm volatile("s_waitcnt lgkmcnt(0)" ::: "memory");
    bf16_t* Ow = O + ((size_t)(b * SEQ + qw)) * 512 + h * 64 + r32;
#pragma unroll
    for (int a4 = 0; a4 < 4; ++a4) { const f32x4 f = *(const LAS f32x4*)(scr + 32 + 8 * a4 + 4 * hi);
#pragma unroll
        for (int e = 0; e < 4; ++e) { const int r = 4 * a4 + e; const int row = crow(r, hi);
            Ow[(size_t)row * 512] = (bf16_t)(cvt_pk_bf16(o0[r] * f[e], 0.f) & 0xffffu);
            Ow[(size_t)row * 512 + 32] = (bf16_t)(cvt_pk_bf16(o1[r] * f[e], 0.f) & 0xffffu); } }
    __syncthreads();
}
#undef MFMA32
}

struct MixOrder {
    int G, c; unsigned ATT, MIXED, WAO, WPO;
    __device__ __forceinline__ bool next(int i, Unit& u) const {
        const int tile = (i >> 1) * G + c; if (tile >= 256) return false;
        u.pm = tile >> 2; u.pn = tile & 3; u.aux = i & 1; return true;
    }
    __device__ __forceinline__ unsigned a_off(const Unit& u) const { return (u.aux ? MIXED : ATT) + (unsigned)u.pm * (256 * 512 * 2); }
    __device__ __forceinline__ unsigned b_off(const Unit& u) const { return (u.aux ? WPO : WAO) + (unsigned)u.pn * (256 * 512 * 2); }
};
struct EpiMix {
    static constexpr bool PERM = true;
    bf16_t* MIX; const bf16_t* GATES;
    __device__ __forceinline__ void operator()(const f32x4 (&acc)[2][2][4][2], const Unit& u, int wr, int wc, int fr, int fq) const {
        const int row0 = u.pm * 256 + wr * 64 + fr, col0 = u.pn * 256 + wc * 32 + 8 * fq;
#pragma unroll
        for (int ai = 0; ai < 2; ++ai)
#pragma unroll
            for (int m = 0; m < 4; ++m) { const size_t row = (size_t)(row0 + ai * 128 + m * 16);
#pragma unroll
                for (int bj = 0; bj < 2; ++bj) {
                    const u32x4 gw = *(const u32x4*)(GATES + row * 2048 + u.aux * 1024 + col0 + bj * 128);
                    const f32x4 v0 = acc[ai][bj][m][0], v1 = acc[ai][bj][m][1];
                    float r[8] = {v0[0] * bf_lo(gw.x), v0[1] * bf_hi(gw.x), v0[2] * bf_lo(gw.y), v0[3] * bf_hi(gw.y), v1[0] * bf_lo(gw.z), v1[1] * bf_hi(gw.z), v1[2] * bf_lo(gw.w), v1[3] * bf_hi(gw.w)};
                    bf16_t* dst = MIX + row * 1024 + col0 + bj * 128;
                    if (u.aux) { const u32x4 pw = *(const u32x4*)dst;
                        r[0] += bf_lo(pw.x); r[1] += bf_hi(pw.x); r[2] += bf_lo(pw.y); r[3] += bf_hi(pw.y); r[4] += bf_lo(pw.z); r[5] += bf_hi(pw.z); r[6] += bf_lo(pw.w); r[7] += bf_hi(pw.w); }
                    u32x4 w; w.x = cvt_pk_bf16(r[0], r[1]); w.y = cvt_pk_bf16(r[2], r[3]); w.z = cvt_pk_bf16(r[4], r[5]); w.w = cvt_pk_bf16(r[6], r[7]);
                    *(u32x4*)dst = w; } }
    }
};
struct EpiRes {
    static constexpr bool PERM = false;
    const float* base; float* out;
    __device__ __forceinline__ void operator()(const f32x4 (&acc)[2][2][4][2], const Unit& u, int wr, int wc, int fr, int fq) const {
        const int row0 = u.pm * 256 + wr * 64 + fr, col0 = u.pn * 256 + wc * 32 + 4 * fq;
#pragma unroll
        for (int ai = 0; ai < 2; ++ai)
#pragma unroll
            for (int m = 0; m < 4; ++m) { const size_t off = (size_t)(row0 + ai * 128 + m * 16) * DM + col0;
#pragma unroll
                for (int bj = 0; bj < 2; ++bj)
#pragma unroll
                    for (int n = 0; n < 2; ++n) *(f32x4*)(out + off + bj * 128 + n * 16) = *(const f32x4*)(base + off + bj * 128 + n * 16) + acc[ai][bj][m][n]; }
    }
};

constexpr int WR_PITCH = 1028;
constexpr int R_WR_OFF = 0, R_PART_OFF = 32 * WR_PITCH * 4, R_SSQ_OFF = R_PART_OFF + 2 * 64 * 33 * 4, R_CNT_OFF = R_SSQ_OFF + 2 * 64 * 4, R_BASE_OFF = R_CNT_OFF + 128, R_END = R_BASE_OFF + 128;
static_assert(R_END <= TILE_E_OFF, "router LDS map");
__device__ __forceinline__ void p7_router(const Frame& F) {
    const int tid_l = tid_local(), lane_l = tid_l & 63; (void)tid_l; (void)lane_l;
    const KArgs a = kargs();
    LAS float* WR = (LAS float*)(F.lds + R_WR_OFF); LAS float* PART = (LAS float*)(F.lds + R_PART_OFF); LAS float* SSQP = (LAS float*)(F.lds + R_SSQ_OFF);
    LAS int* CNT = (LAS int*)(F.lds + R_CNT_OFF); LAS int* BASE = (LAS int*)(F.lds + R_BASE_OFF);
    const int tid = tid_l, lane = lane_l, wave = F.wave;
    const float* wr = a->in[I_WR]; const float* gf = a->in[I_GFFN];
    for (int i = tid; i < 1024 * 32; i += 512) { const int k = i >> 5, e = i & 31; WR[e * WR_PITCH + k] = wr[i] * gf[k]; }
    if (tid < 32) CNT[tid] = 0;
    __syncthreads();
    int* RE = (int*)(F.ws + WS_ROUTE); int* RP = RE + T * 4; float* RG = (float*)(RP + T * 4); float* RS = RG + T * 4;
    unsigned* gcnt = F.ctl + CW_CNT;
    const float* X1 = F.out;
    for (int blk = F.vcu; blk < T / 64; blk += F.G) {
        const int tb = blk * 64;
        {
            const int tg = wave & 3, kh = wave >> 2, r = lane & 15, kq = lane >> 4;
            const float* xp = X1 + (size_t)(tb + 16 * tg + r) * DM + 512 * kh + 4 * kq;
            const LAS float* w0 = WR + (lane & 15) * WR_PITCH + 512 * kh + 4 * kq; const LAS float* w1 = w0 + 16 * WR_PITCH;
            f32x4 acc0 = {0.f, 0.f, 0.f, 0.f}, acc1 = {0.f, 0.f, 0.f, 0.f}; float ss = 0.f;
#pragma unroll 4
            for (int i = 0; i < 32; ++i) {
                const f32x4 xv = *(const f32x4*)(xp + 16 * i);
                const f32x4 b0 = *(const LAS f32x4*)(w0 + 16 * i), b1 = *(const LAS f32x4*)(w1 + 16 * i);
                ss += (xv[0] * xv[0] + xv[1] * xv[1]) + (xv[2] * xv[2] + xv[3] * xv[3]);
#pragma unroll
                for (int j = 0; j < 4; ++j) { acc0 = __builtin_amdgcn_mfma_f32_16x16x4f32(xv[j], b0[j], acc0, 0, 0, 0); acc1 = __builtin_amdgcn_mfma_f32_16x16x4f32(xv[j], b1[j], acc1, 0, 0, 0); }
            }
            ss += __shfl_xor(ss, 16); ss += __shfl_xor(ss, 32);
            if (kq == 0) SSQP[kh * 64 + 16 * tg + r] = ss;
#pragma unroll
            for (int q = 0; q < 4; ++q) { const int tok = 16 * tg + 4 * kq + q; PART[(kh * 64 + tok) * 33 + (lane & 15)] = acc0[q]; PART[(kh * 64 + tok) * 33 + 16 + (lane & 15)] = acc1[q]; }
        }
        __syncthreads();
        int te[4] = {0, 0, 0, 0}, lp[4] = {0, 0, 0, 0}; float tv[4] = {-3e38f, -3e38f, -3e38f, -3e38f}; float rstd = 0.f;
        if (tid < 64) {
            const float ssq = SSQP[tid] + SSQP[64 + tid]; rstd = 1.0f / sqrtf(ssq * (1.f / DM) + EPS);
            const float* br = a->in[I_BR];
#pragma unroll
            for (int e = 0; e < 32; ++e) {
                float v = (PART[tid * 33 + e] + PART[(64 + tid) * 33 + e]) * rstd + br[e]; int id = e;
#pragma unroll
                for (int s = 0; s < 4; ++s) { const bool gt = v > tv[s]; const float ov = tv[s]; const int oi = te[s]; tv[s] = gt ? v : ov; te[s] = gt ? id : oi; v = gt ? ov : v; id = gt ? oi : id; }
            }
#pragma unroll
            for (int s = 0; s < 4; ++s) lp[s] = __hip_atomic_fetch_add(&CNT[te[s]], 1, __ATOMIC_RELAXED, __HIP_MEMORY_SCOPE_WORKGROUP);
        }
        __syncthreads();
        if (tid < 32) { const int c = CNT[tid]; BASE[tid] = c ? (int)atomicAdd(gcnt + tid, (unsigned)c) : 0; }
        __syncthreads();
        if (tid < 64) {
            const int t = tb + tid;
            const float e1 = __expf(tv[1] - tv[0]), e2 = __expf(tv[2] - tv[0]), e3 = __expf(tv[3] - tv[0]); const float inv = 1.0f / (1.0f + e1 + e2 + e3);
            const float gts[4] = {inv, e1 * inv, e2 * inv, e3 * inv};
#pragma unroll
            for (int s = 0; s < 4; ++s) { RE[t * 4 + s] = te[s]; RP[t * 4 + s] = BASE[te[s]] + lp[s]; RG[t * 4 + s] = gts[s]; }
            RS[t] = rstd;
        }
        __syncthreads();
        if (tid < 32) CNT[tid] = 0;
        __syncthreads();
    }
}

__device__ __forceinline__ int build_tiles(const Frame& F) {
    const int tid_l = tid_local(), lane_l = tid_l & 63; (void)tid_l; (void)lane_l;
    LAS int* TB = (LAS int*)(F.lds + TILE_E_OFF); LAS int* TE = TB + 64;
    if (tid_l == 0) { int acc = 0; for (int e = 0; e < NEXP; ++e) { TB[e] = acc; const int c = (int)__hip_atomic_load(F.ctl + CW_CNT + e, RLX_AGENT); acc += (c + 255) >> 8; } TB[NEXP] = acc; }
    __syncthreads();
    if (tid_l < NEXP) { for (int t = TB[tid_l]; t < TB[tid_l + 1]; ++t) TE[t] = tid_l; }
    __syncthreads();
    return TB[NEXP];
}

__device__ __forceinline__ void p8_dispatch(const Frame& F) {
    const int tid_l = tid_local(), lane_l = tid_l & 63; (void)tid_l; (void)lane_l;
    const KArgs a = kargs();
    (void)build_tiles(F);
    const LAS int* TB = (const LAS int*)(F.lds + TILE_E_OFF);
    const int gw = F.vcu * NWAVES + F.wave, NGW = F.G * NWAVES, lane = lane_l;
    const int* RE = (const int*)(F.ws + WS_ROUTE); const int* RP = RE + T * 4; const float* RS = (const float*)(RP + T * 4) + T * 4; int* SL = (int*)(RS + T);
    const float* X1 = F.out; const float* gf = a->in[I_GFFN]; unsigned char* XS = F.ws + WS_XS2;
    f32x4 g[2][2];
#pragma unroll
    for (int j = 0; j < 2; ++j) { g[j][0] = *(const f32x4*)(gf + 512 * j + 8 * lane); g[j][1] = *(const f32x4*)(gf + 512 * j + 8 * lane + 4); }
    for (int t = gw; t < T; t += NGW) {
        const float rstd = RS[t];
        u32x2 w[2];
#pragma unroll
        for (int j = 0; j < 2; ++j) { const f32x4 v0 = *(const f32x4*)(X1 + (size_t)t * DM + 512 * j + 8 * lane) * g[j][0] * rstd, v1 = *(const f32x4*)(X1 + (size_t)t * DM + 512 * j + 8 * lane + 4) * g[j][1] * rstd;
            w[j] = cvt8_fp8(v0, v1, 8.0f); }
#pragma unroll
        for (int s = 0; s < 4; ++s) { const int e = RE[t * 4 + s], slot = TB[e] * 256 + RP[t * 4 + s];
            if (lane == 0) SL[t * 4 + s] = slot;
            unsigned char* dst = XS + (size_t)slot * DM + 8 * lane;
            *(u32x2*)dst = w[0]; *(u32x2*)(dst + 512) = w[1]; }
    }
}

struct MoeOrder {
    int G, c, ntn_shift, total; const LAS int* TE; unsigned A, Bw, bexp, btile; int xbase, xcount;
    __device__ __forceinline__ void init_xcd(const LAS int* TB) {
        if (G == 256) { const int x = c >> 5; xbase = __builtin_amdgcn_readfirstlane(TB[4 * x]); xcount = (__builtin_amdgcn_readfirstlane(TB[4 * x + 4]) - xbase) << ntn_shift; } else { xbase = -1; xcount = 0; }
    }
    __device__ __forceinline__ bool next(int i, Unit& u) const {
        if (xbase >= 0) { const int L = i * 32 + (c & 31); if (L >= xcount) return false;
            u.pm = xbase + (L >> ntn_shift); u.pn = L & ((1 << ntn_shift) - 1); u.aux = __builtin_amdgcn_readfirstlane(TE[u.pm]); return true; }
        const int L = i * G + c; if (L >= total) return false;
        u.pm = L >> ntn_shift; u.pn = L & ((1 << ntn_shift) - 1); u.aux = __builtin_amdgcn_readfirstlane(TE[u.pm]); return true;
    }
    __device__ __forceinline__ unsigned a_off(const Unit& u) const { return A + (unsigned)u.pm * (256 * 1024); }
    __device__ __forceinline__ unsigned b_off(const Unit& u) const { return Bw + (unsigned)u.aux * bexp + (unsigned)u.pn * btile; }
};
struct EpiSwiglu {
    static constexpr bool PERM = true;
    unsigned char* ACT; const float* bgu;
    __device__ __forceinline__ void operator()(const f32x4 (&acc)[2][2][4][2], const Unit& u, int wr, int wc, int fr, int fq) const {
        const int row0 = u.pm * 256 + wr * 64 + fr, j0 = u.pn * 128 + wc * 32 + 8 * fq;
        const float* bb = bgu + (size_t)u.aux * 2048 + j0;
        unsigned char* dst0 = ACT + (size_t)row0 * DEXP + j0;
#pragma unroll
        for (int ai = 0; ai < 2; ++ai)
#pragma unroll
            for (int m = 0; m < 4; ++m) {
#pragma unroll
                for (int n = 0; n < 2; ++n) {
                    asm volatile("" : "+v"(bb));
                    const f32x4 g = acc[ai][0][m][n] + *(const f32x4*)(bb + 4 * n), up = acc[ai][1][m][n] + *(const f32x4*)(bb + 1024 + 4 * n);
                    float r[4];
#pragma unroll
                    for (int e = 0; e < 4; ++e) { const float gg = fminf(g[e], 7.0f), uu = fminf(fmaxf(up[e], -7.0f), 7.0f); r[e] = (uu + 1.0f) * gg * fast_sigmoid(1.702f * gg) * 8.0f; }
                    int w = __builtin_amdgcn_cvt_pk_fp8_f32(r[0], r[1], 0, false); w = __builtin_amdgcn_cvt_pk_fp8_f32(r[2], r[3], w, true);
                    *(int*)(dst0 + (size_t)(ai * 128 + m * 16) * DEXP + 4 * n) = w;
                }
                asm volatile("" ::: "memory");
            }
    }
};
struct EpiDown {
    static constexpr bool PERM = true;
    unsigned char* Y; const float* bd;
    __device__ __forceinline__ void operator()(const f32x4 (&acc)[2][2][4][2], const Unit& u, int wr, int wc, int fr, int fq) const {
        const int row0 = u.pm * 256 + wr * 64 + fr, col0 = u.pn * 256 + wc * 32 + 8 * fq;
        const float* bb = bd + (size_t)u.aux * DM + col0;
#pragma unroll
        for (int ai = 0; ai < 2; ++ai)
#pragma unroll
            for (int m = 0; m < 4; ++m) { unsigned char* rowp = Y + (size_t)(row0 + ai * 128 + m * 16) * DM + col0;
                asm volatile("" : "+v"(bb));
#pragma unroll
                for (int bj = 0; bj < 2; ++bj) { const f32x4 v0 = acc[ai][bj][m][0] + *(const f32x4*)(bb + bj * 128), v1 = acc[ai][bj][m][1] + *(const f32x4*)(bb + bj * 128 + 4);
                    *(u32x2*)(rowp + bj * 128) = cvt8_fp8(v0, v1, 8.0f); } asm volatile("" ::: "memory"); }
    }
};

__device__ __forceinline__ void p11_combine(const Frame& F) {
    const int tid_l = tid_local(), lane_l = tid_l & 63; (void)tid_l; (void)lane_l;
    const KArgs a = kargs();
    const int gw = F.vcu * NWAVES + F.wave, NGW = F.G * NWAVES, lane = lane_l;
    const int* RE = (const int*)(F.ws + WS_ROUTE); const float* RG = (const float*)(RE + T * 8); const int* SL = (const int*)(RG + T * 4 + T);
    const unsigned char* Y = F.ws + WS_XS; bf16_t* HP = (bf16_t*)(F.ws + WS_HN); float* X = F.out; const float* gp = a->in[I_GPLE];
    f32x4 g[2][2];
#pragma unroll
    for (int j = 0; j < 2; ++j) { g[j][0] = *(const f32x4*)(gp + 512 * j + 8 * lane); g[j][1] = *(const f32x4*)(gp + 512 * j + 8 * lane + 4); }
    for (int t = gw; t < T; t += NGW) {
        f32x4 v[2][2];
#pragma unroll
        for (int j = 0; j < 2; ++j) { v[j][0] = *(const f32x4*)(X + (size_t)t * DM + 512 * j + 8 * lane); v[j][1] = *(const f32x4*)(X + (size_t)t * DM + 512 * j + 8 * lane + 4); }
#pragma unroll
        for (int s = 0; s < 4; ++s) { const int slot = SL[t * 4 + s]; const float gt = RG[t * 4 + s] * 0.125f;
#pragma unroll
            for (int j = 0; j < 2; ++j) { const u32x2 y = *(const u32x2*)(Y + (size_t)slot * DM + 512 * j + 8 * lane);
                const f32x2 a0 = __builtin_amdgcn_cvt_pk_f32_fp8((int)y.x, false), a1 = __builtin_amdgcn_cvt_pk_f32_fp8((int)y.x, true), b0 = __builtin_amdgcn_cvt_pk_f32_fp8((int)y.y, false), b1 = __builtin_amdgcn_cvt_pk_f32_fp8((int)y.y, true);
                v[j][0] += (f32x4){a0[0], a0[1], a1[0], a1[1]} * gt; v[j][1] += (f32x4){b0[0], b0[1], b1[0], b1[1]} * gt; } }
        float ss = 0.f;
#pragma unroll
        for (int j = 0; j < 2; ++j)
#pragma unroll
            for (int n = 0; n < 2; ++n) { const f32x4 q = v[j][n]; ss += (q[0] * q[0] + q[1] * q[1]) + (q[2] * q[2] + q[3] * q[3]); *(f32x4*)(X + (size_t)t * DM + 512 * j + 8 * lane + 4 * n) = q; }
        const float rstd = 1.0f / sqrtf(wave_sum(ss) * (1.f / DM) + EPS);
#pragma unroll
        for (int j = 0; j < 2; ++j) { const f32x4 q0 = v[j][0] * g[j][0] * rstd, q1 = v[j][1] * g[j][1] * rstd;
            u32x4 w; w.x = cvt_pk_bf16(q0[0], q0[1]); w.y = cvt_pk_bf16(q0[2], q0[3]); w.z = cvt_pk_bf16(q1[0], q1[1]); w.w = cvt_pk_bf16(q1[2], q1[3]);
            *(u32x4*)(HP + (size_t)t * DM + 512 * j + 8 * lane) = w; }
    }
}
struct EpiPle {
    static constexpr bool PERM = false;
    float* out; const bf16_t* E;
    __device__ __forceinline__ void operator()(const f32x4 (&acc)[2][2][4][2], const Unit& u, int wr, int wc, int fr, int fq) const {
        const int row0 = u.pm * 256 + wr * 64 + fr, col0 = u.pn * 256 + wc * 32 + 4 * fq;
#pragma unroll
        for (int ai = 0; ai < 2; ++ai)
#pragma unroll
            for (int m = 0; m < 4; ++m) { const size_t off = (size_t)(row0 + ai * 128 + m * 16) * DM + col0;
#pragma unroll
                for (int bj = 0; bj < 2; ++bj)
#pragma unroll
                    for (int n = 0; n < 2; ++n) { const size_t o = off + bj * 128 + n * 16; const u32x2 ev = *(const u32x2*)(E + o); const f32x4 a4 = acc[ai][bj][m][n];
                        f32x4 r = *(const f32x4*)(out + o);
                        r[0] += fast_sigmoid(a4[0]) * bf_lo(ev.x); r[1] += fast_sigmoid(a4[1]) * bf_hi(ev.x); r[2] += fast_sigmoid(a4[2]) * bf_lo(ev.y); r[3] += fast_sigmoid(a4[3]) * bf_hi(ev.y);
                        *(f32x4*)(out + o) = r; } }
    }
};

constexpr int N_PHASES = 13;
__global__ void __launch_bounds__(NWAVES * 64, 2) fwd_kernel(Args args) {
    extern __shared__ __attribute__((aligned(16))) unsigned char lds_raw[];
    Frame F;
    F.lds = (LAS unsigned char*)lds_raw; F.MISC = (volatile LAS unsigned*)(F.lds + MISC_OFF);
    F.wave = __builtin_amdgcn_readfirstlane(threadIdx.x >> 6);
    F.G = gridDim.x; { const int bx = blockIdx.x; F.vcu = (F.G % 8 == 0) ? (bx % 8) * (F.G / 8) + bx / 8 : bx; }
    { const KArgs ka = kargs(); F.out = ka->out; F.ws = ka->ws; F.ctl = (unsigned*)(ka->ws + WS_CTL); }
    { const int t0_ = tid_local(); if (t0_ < 32) F.MISC[t0_] = 0u; }
    __syncthreads();
    int lo, hi; { const KArgs ka = kargs(); lo = ka->ph_lo; hi = ka->ph_hi; }
    const bool multi = (hi - lo) > 1;
    XcdBarrier bar; bar.bar = F.ctl + CW_BAR; bar.x = 0; bar.st = nullptr;
    if (multi) bar = xcd_barrier_post(F.ctl + CW_BAR, F.MISC);
#ifndef PH_MASK
#define PH_MASK 0x1fff
#endif
#define IN(k) ((((PH_MASK) >> (k)) & 1) && lo <= (k) && (k) < hi)
#define SEAM(k) do { if (IN(k) && IN((k) + 1)) xcd_barrier(bar); } while (0)
    unsigned char* ws = F.ws;
    LAS unsigned char* ring = F.lds;
    const __amdgpu_buffer_rsrc_t rsrc = __builtin_amdgcn_make_buffer_rsrc((void*)ws, 0, (int)WS_END, 0x00020000);

    if (IN(0)) { p0_prologue(F); } SEAM(0);

    if (IN(1)) {
        { DenseOrder S; S.init(64, 12, F.G, (int)blockIdx.x, WS_HN, P1_FP8 ? 512 : 1024, WS_WIN, P1_FP8 ? 512 : 1024);
          EpiProj E{(bf16_t*)(ws + WS_PROJ), (bf16_t*)(ws + WS_GATES)};
          if (P1_FP8) pg8::gemm_phase<EpiProj, DenseOrder, true, true, true>(ring, rsrc, pg8::Shape{1024, 1024, 1024, 0x7c7c7c7c, 0x7c7c7c7c}, S, E);
          else pg8::gemm_phase<EpiProj, DenseOrder, true, true>(ring, rsrc, pg8::Shape{2048, 2048, 2048, 0, 0}, S, E); }
        { DenseOrder S; S.init(64, 4, F.G, (int)blockIdx.x, WS_PB, 256, WS_WPLE, 256);
          EpiBf16 E{(bf16_t*)(ws + WS_E), 1024};
          pg8::gemm_phase<EpiBf16, DenseOrder, true, true>(ring, rsrc, pg8::Shape{512, 512, 512, 0, 0}, S, E); }
    } SEAM(1);

    if (IN(2)) { p2_rows(F); } SEAM(2);

    if (IN(3)) {
#ifndef P3M
#define P3M 7
#endif
        if (P3M & 1) { DenseOrder S; S.init(64, 4, F.G, (int)blockIdx.x, WS_A2 + 512, 512, WS_WKV, 256);
          EpiKV E{(bf16_t*)(ws + WS_K), (bf16_t*)(ws + WS_V), kargs()->in[I_GKNOPE]};
          pg8::gemm_phase<EpiKV, DenseOrder, true, true>(ring, rsrc, pg8::Shape{512, 1024, 512, 0, 0}, S, E); }
        if (P3M & 2) { DenseOrder S; S.init(64, 3, F.G, (int)blockIdx.x, WS_A2, 512, WS_WQ, 256);
          EpiQ E{(bf16_t*)(ws + WS_Q), (float*)(ws + WS_SSQ), (const float*)(ws + WS_COS), (const float*)(ws + WS_SIN), kargs()->in[I_GQHEAD]};
          pg8::gemm_phase<EpiQ, DenseOrder, true, true>(ring, rsrc, pg8::Shape{512, 1024, 512, 0, 0}, S, E); }
        if (P3M & 4) { DenseOrder S; S.init(64, 2, F.G, (int)blockIdx.x, WS_POOLED, 512, WS_WPOOL, 256, 512);
          EpiBf16 E{(bf16_t*)(ws + WS_MIXED), 512};
          pg8::gemm_phase<EpiBf16, DenseOrder, true, true>(ring, rsrc, pg8::Shape{512, 1024, 512, 0, 0}, S, E); }
    } SEAM(3);

    if (IN(4)) {
        u32x4 srd; { const unsigned long wb = (unsigned long)ws; srd.x = (unsigned)__builtin_amdgcn_readfirstlane((int)(unsigned)wb); srd.y = (unsigned)__builtin_amdgcn_readfirstlane((int)(unsigned)(wb >> 32)); srd.z = (unsigned)WS_END; srd.w = 0x00020000u; }
        att::ConvState CV; CV.next = __builtin_amdgcn_readfirstlane(F.vcu * NWAVES + F.wave); CV.end = CONV_IN_ATTN ? att::CV_ITEMS : 0; CV.cur = -1;
        for (int it = F.vcu; it < 256; it += F.G) {
            const int bh = it >> 3, pr = it & 7;
            att::attn_unit(ring, srd, CV, ws, bh, 15 - pr, (const bf16_t*)(ws + WS_Q), (unsigned)WS_K, (unsigned)WS_V, (const float*)(ws + WS_SSQ), (bf16_t*)(ws + WS_ATT));
            att::attn_unit(ring, srd, CV, ws, bh, pr, (const bf16_t*)(ws + WS_Q), (unsigned)WS_K, (unsigned)WS_V, (const float*)(ws + WS_SSQ), (bf16_t*)(ws + WS_ATT));
        }
        { const LAS float* cb = (const LAS float*)(F.lds + att::CONV_OFF + F.wave * att::CONV_BYTES);
          const unsigned cbaddr = (unsigned)__builtin_amdgcn_readfirstlane((int)(unsigned)(unsigned long)(F.lds + att::CONV_OFF + F.wave * att::CONV_BYTES));
          const int lane_l = tid_local() & 63;
          while (CV.cur >= 0 || CV.next < CV.end) {
            if (CV.cur >= 0) { asm volatile("s_waitcnt vmcnt(0)" ::: "memory"); const att::ConvItem I = att::cv_setup(CV.cur, kargs()->in[I_WGU], kargs()->in[I_WD], ws + WS_WGU, ws + WS_WD); att::cv_out(I, cb, lane_l); }
            if (CV.next < CV.end) { const att::ConvItem I = att::cv_setup(CV.next, kargs()->in[I_WGU], kargs()->in[I_WD], ws + WS_WGU, ws + WS_WD); asm volatile("s_waitcnt lgkmcnt(0)" ::: "memory"); att::cv_dma(I, cbaddr, lane_l); CV.cur = CV.next; CV.next += 2048; } else CV.cur = -1;
          } }
    } SEAM(4);

    if (IN(5)) {
        MixOrder S{F.G, F.vcu, (unsigned)WS_ATT, (unsigned)WS_MIXED, (unsigned)WS_WAO, (unsigned)WS_WPO};
        EpiMix E{(bf16_t*)(ws + WS_MIX), (const bf16_t*)(ws + WS_GATES)};
        pg8::gemm_phase<EpiMix, MixOrder, true, true>(ring, rsrc, pg8::Shape{1024, 1024, 1024, 0, 0}, S, E);
    } SEAM(5);

    if (IN(6)) {
        DenseOrder S; S.init(64, 4, F.G, (int)blockIdx.x, WS_MIX, 1024, WS_WO, 1024);
        EpiRes E{kargs()->in[I_X], F.out};
        pg8::gemm_phase<EpiRes, DenseOrder, true, true>(ring, rsrc, pg8::Shape{2048, 2048, 2048, 0, 0}, S, E);
    } SEAM(6);

    if (IN(7)) { p7_router(F); } SEAM(7);

    if (IN(8)) { p8_dispatch(F); } SEAM(8);

    if (IN(9)) {
        const int TM = build_tiles(F);
        MoeOrder S{F.G, F.vcu, 3, TM * 8, (const LAS int*)(F.lds + TILE_E_OFF) + 64, (unsigned)WS_XS2, (unsigned)WS_WGU, 2048u * 1024u, 256u * 1024u, 0, 0}; S.init_xcd((const LAS int*)(F.lds + TILE_E_OFF));
        EpiSwiglu E{ws + WS_ACT, kargs()->in[I_BGU]};
        pg8::gemm_phase<EpiSwiglu, MoeOrder, true, true, true>(ring, rsrc, pg8::Shape{1024, 1024, 1024, 0x7c7c7c7c, 0x7c7c7c7c}, S, E);
    } SEAM(9);

    if (IN(10)) {
        const int TM = build_tiles(F);
        MoeOrder S{F.G, F.vcu, 2, TM * 4, (const LAS int*)(F.lds + TILE_E_OFF) + 64, (unsigned)WS_ACT, (unsigned)WS_WD, 1024u * 1024u, 256u * 1024u, 0, 0}; S.init_xcd((const LAS int*)(F.lds + TILE_E_OFF));
        EpiDown E{ws + WS_XS, kargs()->in[I_BD]};
        pg8::gemm_phase<EpiDown, MoeOrder, true, true, true>(ring, rsrc, pg8::Shape{1024, 1024, 1024, 0x7c7c7c7c, 0x7c7c7c7c}, S, E);
    } SEAM(10);

    if (IN(11)) { p11_combine(F); } SEAM(11);

    if (IN(12)) {
        DenseOrder S; S.init(64, 4, F.G, (int)blockIdx.x, WS_HN, 1024, WS_WPG, 1024);
        EpiPle E{F.out, (const bf16_t*)(ws + WS_E)};
        pg8::gemm_phase<EpiPle, DenseOrder, true, true>(ring, rsrc, pg8::Shape{2048, 2048, 2048, 0, 0}, S, E);
    }
#undef IN
#undef SEAM
}

extern "C" void kernel_launch(void* const* d_in, const int* in_sizes, int n_in, void* d_out, int out_size, void* d_ws, size_t ws_size, hipStream_t stream) {
    static int grid = 0;
    if (grid == 0) {
        if (n_in != 27 || out_size != T * DM || ws_size < WS_END) { fprintf(stderr, "kernel_launch: unexpected shapes (n_in %d, out %d, ws %zu)\n", n_in, out_size, ws_size); grid = -1; return; }
        int dev = 0, cus = 0;
        if (hipGetDevice(&dev) != hipSuccess || hipDeviceGetAttribute(&cus, hipDeviceAttributeMultiprocessorCount, dev) != hipSuccess) { grid = -1; return; }
        if (hipFuncSetAttribute((const void*)fwd_kernel, hipFuncAttributeMaxDynamicSharedMemorySize, LDS_BYTES) != hipSuccess) { fprintf(stderr, "kernel_launch: hipFuncSetAttribute failed\n"); grid = -1; return; }
        int per_cu = 0;
        if (hipOccupancyMaxActiveBlocksPerMultiprocessor(&per_cu, (const void*)fwd_kernel, NWAVES * 64, LDS_BYTES) != hipSuccess || per_cu < 1) fprintf(stderr, "kernel_launch: occupancy query says %d\n", per_cu);
        (void)hipGetLastError();
        grid = cus;
    }
    if (grid < 0) return;
    (void)hipMemsetAsync((char*)d_ws + WS_CTL, 0, CTL_ZERO_BYTES, stream);
    Args a{};
    for (int i = 0; i < 27; ++i) a.in[i] = (const float*)d_in[i];
    a.out = (float*)d_out; a.ws = (unsigned char*)d_ws;
#ifndef DUP_PHASE
    a.ph_lo = 0; a.ph_hi = N_PHASES; hipLaunchKernelGGL(fwd_kernel, dim3(grid), dim3(NWAVES * 64), LDS_BYTES, stream, a);
#else
    a.ph_lo = 0; a.ph_hi = DUP_PHASE + 1; hipLaunchKernelGGL(fwd_kernel, dim3(grid), dim3(NWAVES * 64), LDS_BYTES, stream, a);
    (void)hipMemsetAsync((char*)d_ws + WS_CTL + CW_BAR * 4, 0, XCD_BAR_WORDS * 4, stream);
    a.ph_lo = DUP_PHASE; a.ph_hi = N_PHASES; hipLaunchKernelGGL(fwd_kernel, dim3(grid), dim3(NWAVES * 64), LDS_BYTES, stream, a);
#endif
}
```

```cpp
#include <hip/hip_runtime.h>
#include <cstdio>
#include <cstdint>

#define LAS __attribute__((address_space(3)))
#define GAS __attribute__((address_space(1)))
typedef unsigned short bf16_t;
typedef short bf16x8 __attribute__((ext_vector_type(8)));
typedef short s16x4 __attribute__((ext_vector_type(4)));
typedef float f32x4 __attribute__((ext_vector_type(4)));
typedef float f32x2 __attribute__((ext_vector_type(2)));
typedef float f32x16 __attribute__((ext_vector_type(16)));
typedef unsigned u32x4 __attribute__((ext_vector_type(4)));
typedef unsigned u32x2 __attribute__((ext_vector_type(2)));

constexpr int NB = 4, SEQ = 4096, T = NB * SEQ, DM = 1024, NH = 8, DK = 96, DV = 64;
constexpr int NEXP = 32, TOPK = 4, DEXP = 1024, PLE = 256;
constexpr float EPS = 1e-6f;
constexpr int XS_ROWS = T * TOPK + NEXP * 256;

typedef __bf16 bf16x2_t __attribute__((ext_vector_type(2)));
__device__ __forceinline__ unsigned cvt_pk_bf16(float lo, float hi) { f32x2 v = {lo, hi}; return __builtin_bit_cast(unsigned, __builtin_convertvector(v, bf16x2_t)); }
__device__ __forceinline__ u32x2 cvt8_fp8(const f32x4 a, const f32x4 b, float sc) {
    int w0 = __builtin_amdgcn_cvt_pk_fp8_f32(a[0] * sc, a[1] * sc, 0, false); w0 = __builtin_amdgcn_cvt_pk_fp8_f32(a[2] * sc, a[3] * sc, w0, true);
    int w1 = __builtin_amdgcn_cvt_pk_fp8_f32(b[0] * sc, b[1] * sc, 0, false); w1 = __builtin_amdgcn_cvt_pk_fp8_f32(b[2] * sc, b[3] * sc, w1, true);
    u32x2 r; r.x = (unsigned)w0; r.y = (unsigned)w1; return r;
}
__device__ __forceinline__ float bf_lo(unsigned w) { return __uint_as_float(w << 16); }
__device__ __forceinline__ float bf_hi(unsigned w) { return __uint_as_float(w & 0xffff0000u); }
__device__ __forceinline__ float bf1(bf16_t h) { return __uint_as_float(((unsigned)h) << 16); }
__device__ __forceinline__ float fast_sigmoid(float v) { return __builtin_amdgcn_rcpf(1.0f + __builtin_amdgcn_exp2f(-1.4426950408889634f * v)); }
__device__ __forceinline__ int lane_id() { return (int)__builtin_amdgcn_mbcnt_hi(~0u, __builtin_amdgcn_mbcnt_lo(~0u, 0u)); }
__device__ __forceinline__ int tid_local() { int t = threadIdx.x; asm volatile("" : "+v"(t)); return t; }
__device__ __forceinline__ float wave_sum(float v) {
#pragma unroll
    for (int o = 1; o < 64; o <<= 1) v += __shfl_xor(v, o);
    return v;
}

namespace pg8 {
constexpr int BM = 256, BK = 64, HALF = 128, HTB = HALF * BK * 2, STAGE_BYTES = 8 * HTB;
__host__ __device__ __forceinline__ int lds_byte(int r, int c) { const int st = (r >> 4) * 2 + (c >> 5), rr = r & 15, cc = c & 31, ob = rr * 64 + cc * 2; return st * 1024 + (ob ^ (((ob >> 9) & 1) << 5)); }
__host__ __device__ __forceinline__ void stage_rc(int b, int& R, int& C) { const int st = b / 1024, sb = b % 1024, swz = sb ^ (((sb >> 9) & 1) << 5); R = (st >> 1) * 16 + swz / 64; C = (st & 1) * 32 + (swz % 64) / 2; }
__host__ __device__ __forceinline__ int perm32(int rho) { const int n = rho >> 4, i = rho & 15; return 8 * (i >> 2) + 4 * n + (i & 3); }

struct Unit { int pm, pn, aux; };
struct Shape { int Kb, lda, ldb, sw, sa; };
typedef int v8i_t __attribute__((ext_vector_type(8))); typedef int v4i_t __attribute__((ext_vector_type(4)));

template <class Epi, class Sched, bool ALIGN_EPI, bool SP2, bool MX = false>
__device__ __forceinline__ void gemm_phase(LAS unsigned char* lds, const __amdgpu_buffer_rsrc_t rsrc, const Shape g, const Sched& S, const Epi& E) {
    const int tid = tid_local(), wid = __builtin_amdgcn_readfirstlane(tid >> 6), lane = tid & 63, wr = wid >> 2, wc = wid & 3, fr = lane & 15, fq = lane >> 4;
    int nt = g.Kb / 128; asm volatile("" : "+s"(nt));
    unsigned voffA, voffB;
    { int R, C; stage_rc(tid * 16, R, C); const int Rb = Epi::PERM ? ((R & ~31) + perm32(R & 31)) : R;
      voffA = (unsigned)(R * g.lda + C * 2); voffB = (unsigned)(Rb * g.ldb + C * 2); }
    const unsigned p2A = 64u * (unsigned)g.lda, p2B = 64u * (unsigned)g.ldb;
    const unsigned kstep = 128u;
    const unsigned hstepA = (unsigned)HALF * g.lda, hstepB = (unsigned)HALF * g.ldb;
    const unsigned ldsw = (unsigned)wid * 1024u;
    const int aoff = lds_byte(wr * 64 + fr, fq * 8), boff = lds_byte(wc * 32 + fr, fq * 8);
#define PG8_SA(b, h) (((b) * 2 + (h)) * HTB)
#define PG8_SB(b, h) ((4 + (b) * 2 + (h)) * HTB)
#define PG8_STAGE(bufoff, gbase, voff) do { \
        __builtin_amdgcn_raw_ptr_buffer_load_lds(rsrc, (LAS void*)(lds + (bufoff) + ldsw), 16, voff, (gbase), 0, 0); \
        __builtin_amdgcn_raw_ptr_buffer_load_lds(rsrc, (LAS void*)(lds + (bufoff) + ldsw + 8192), 16, voff, (gbase) + p2##voff, 0, 0); } while (0)
#define p2voffA p2A
#define p2voffB p2B
#define PG8_LDA(dst, b, h) do { _Pragma("unroll") for (int m = 0; m < 4; ++m) _Pragma("unroll") for (int k = 0; k < 2; ++k) dst[m][k] = *(const LAS bf16x8*)(lds + PG8_SA(b, h) + aoff + m * 2048 + k * 1024); } while (0)
#define PG8_LDB(dst, b, h) do { _Pragma("unroll") for (int n = 0; n < 2; ++n) _Pragma("unroll") for (int k = 0; k < 2; ++k) dst[n][k] = *(const LAS bf16x8*)(lds + PG8_SB(b, h) + boff + n * 2048 + k * 1024); } while (0)
#define PG8_CAT(x, y) __builtin_shufflevector(__builtin_bit_cast(v4i_t, x), __builtin_bit_cast(v4i_t, y), 0, 1, 2, 3, 4, 5, 6, 7)
#define PG8_MMA(ai, bj, At, Bt) do { __builtin_amdgcn_s_setprio(1); if constexpr (MX) { _Pragma("unroll") for (int m = 0; m < 4; ++m) _Pragma("unroll") for (int n = 0; n < 2; ++n) \
        acc[ai][bj][m][n] = __builtin_amdgcn_mfma_scale_f32_16x16x128_f8f6f4(PG8_CAT(Bt[n][0], Bt[n][1]), PG8_CAT(At[m][0], At[m][1]), acc[ai][bj][m][n], 0, 0, 0, g.sw, 0, g.sa); } else { \
        _Pragma("unroll") for (int m = 0; m < 4; ++m) _Pragma("unroll") for (int n = 0; n < 2; ++n) _Pragma("unroll") for (int k = 0; k < 2; ++k) \
        acc[ai][bj][m][n] = __builtin_amdgcn_mfma_f32_16x16x32_bf16(Bt[n][k], At[m][k], acc[ai][bj][m][n], 0, 0, 0); } __builtin_amdgcn_s_setprio(0); } while (0)
#define PG8_WAIT_V(n) asm volatile("s_waitcnt vmcnt(" #n ")" ::: "memory")
#define PG8_WAIT_L(n) asm volatile("s_waitcnt lgkmcnt(" #n ")" ::: "memory")
#define PG8_BAR __builtin_amdgcn_s_barrier()
#define PG8_SCHED __builtin_amdgcn_sched_barrier(0)
    Unit cur, nxt; int ui = 0;
    if (!S.next(0, cur)) return;
    f32x4 acc[2][2][4][2];
#pragma unroll
    for (int a = 0; a < 2; ++a)
#pragma unroll
        for (int b = 0; b < 2; ++b)
#pragma unroll
            for (int m = 0; m < 4; ++m)
#pragma unroll
                for (int n = 0; n < 2; ++n) acc[a][b][m][n] = (f32x4){0.f, 0.f, 0.f, 0.f};
    bf16x8 At[4][2], B0[2][2], B1[2][2];
    unsigned cA = S.a_off(cur), cB = S.b_off(cur);
    if constexpr (SP2) {
        PG8_STAGE(PG8_SB(0, 0), cB, voffB); PG8_STAGE(PG8_SB(0, 1), cB + hstepB, voffB); PG8_STAGE(PG8_SA(0, 0), cA, voffA); PG8_STAGE(PG8_SA(0, 1), cA + hstepA, voffA);
        if (wr == 1) PG8_BAR;
        PG8_WAIT_V(2); PG8_BAR;
        PG8_STAGE(PG8_SB(1, 0), cB + kstep, voffB); PG8_STAGE(PG8_SA(1, 0), cA + kstep, voffA); PG8_STAGE(PG8_SB(1, 1), cB + hstepB + kstep, voffB);
        PG8_WAIT_V(6); PG8_BAR;
    } else {
        PG8_STAGE(PG8_SB(0, 0), cB, voffB); PG8_STAGE(PG8_SA(0, 0), cA, voffA); PG8_STAGE(PG8_SB(0, 1), cB + hstepB, voffB); PG8_STAGE(PG8_SA(0, 1), cA + hstepA, voffA);
        if (wr == 1) PG8_BAR;
        PG8_WAIT_V(4); PG8_BAR;
        PG8_STAGE(PG8_SB(1, 0), cB + kstep, voffB); PG8_STAGE(PG8_SA(1, 0), cA + kstep, voffA); PG8_STAGE(PG8_SB(1, 1), cB + hstepB + kstep, voffB);
        PG8_WAIT_V(6); PG8_BAR;
    }
    for (;;) {
        const bool has_next = S.next(ui + 1, nxt);
        const unsigned nA = has_next ? S.a_off(nxt) : cA, nB = has_next ? S.b_off(nxt) : cB;
#pragma nounroll
        for (int t = 0; t < nt; t += 2) {
            const bool last = (t == nt - 2);
            const unsigned a1 = cA + (unsigned)(t + 1) * kstep;
            const unsigned a2 = last ? nA : cA + (unsigned)(t + 2) * kstep, b2 = last ? nB : cB + (unsigned)(t + 2) * kstep;
            const unsigned a3 = a2 + kstep, b3 = b2 + kstep;
            if constexpr (SP2) {
            PG8_LDB(B0, 0, 0); PG8_LDB(B1, 0, 1); PG8_SCHED; PG8_LDA(At, 0, 0); PG8_STAGE(PG8_SA(1, 1), a1 + hstepA, voffA);
            PG8_WAIT_V(8); PG8_WAIT_L(0); PG8_BAR; PG8_MMA(0, 0, At, B0); PG8_MMA(0, 1, At, B1); PG8_BAR; PG8_SCHED;
            PG8_LDA(At, 0, 1); PG8_STAGE(PG8_SB(0, 0), b2, voffB); PG8_STAGE(PG8_SB(0, 1), b2 + hstepB, voffB); PG8_STAGE(PG8_SA(0, 0), a2, voffA);
            PG8_WAIT_V(8); PG8_WAIT_L(0); PG8_BAR; PG8_MMA(1, 0, At, B0); PG8_MMA(1, 1, At, B1); PG8_BAR; PG8_SCHED;
            PG8_LDB(B0, 1, 0); PG8_LDB(B1, 1, 1); PG8_SCHED; PG8_LDA(At, 1, 0); PG8_STAGE(PG8_SA(0, 1), a2 + hstepA, voffA);
            PG8_WAIT_V(8); PG8_WAIT_L(0); PG8_BAR; PG8_MMA(0, 0, At, B0); PG8_MMA(0, 1, At, B1); PG8_BAR; PG8_SCHED;
            PG8_LDA(At, 1, 1); PG8_STAGE(PG8_SB(1, 0), b3, voffB); PG8_STAGE(PG8_SB(1, 1), b3 + hstepB, voffB); PG8_STAGE(PG8_SA(1, 0), a3, voffA);
            PG8_WAIT_V(8); PG8_WAIT_L(0); PG8_BAR; PG8_MMA(1, 0, At, B0); PG8_MMA(1, 1, At, B1); PG8_BAR; PG8_SCHED;
            } else {
            PG8_LDB(B0, 0, 0); PG8_SCHED; PG8_LDA(At, 0, 0); PG8_STAGE(PG8_SA(1, 1), a1 + hstepA, voffA);
            PG8_WAIT_L(8); PG8_BAR; PG8_WAIT_L(0); PG8_MMA(0, 0, At, B0); PG8_BAR; PG8_SCHED;
            PG8_LDB(B1, 0, 1); PG8_STAGE(PG8_SB(0, 0), b2, voffB);
            PG8_BAR; PG8_WAIT_L(0); PG8_MMA(0, 1, At, B1); PG8_BAR;
            PG8_LDA(At, 0, 1); PG8_STAGE(PG8_SA(0, 0), a2, voffA);
            PG8_BAR; PG8_WAIT_L(0); PG8_MMA(1, 0, At, B0); PG8_BAR; PG8_SCHED;
            PG8_STAGE(PG8_SB(0, 1), b2 + hstepB, voffB);
            PG8_WAIT_V(6); PG8_BAR; PG8_MMA(1, 1, At, B1); PG8_BAR;
            PG8_LDB(B0, 1, 0); PG8_SCHED; PG8_LDA(At, 1, 0); PG8_STAGE(PG8_SA(0, 1), a2 + hstepA, voffA);
            PG8_WAIT_L(8); PG8_BAR; PG8_WAIT_L(0); PG8_MMA(0, 0, At, B0); PG8_BAR; PG8_SCHED;
            PG8_LDB(B1, 1, 1); PG8_STAGE(PG8_SB(1, 0), b3, voffB);
            PG8_BAR; PG8_WAIT_L(0); PG8_MMA(0, 1, At, B1); PG8_BAR;
            PG8_LDA(At, 1, 1); PG8_STAGE(PG8_SA(1, 0), a3, voffA);
            PG8_BAR; PG8_WAIT_L(0); PG8_MMA(1, 0, At, B0); PG8_BAR; PG8_SCHED;
            PG8_STAGE(PG8_SB(1, 1), b3 + hstepB, voffB);
            PG8_WAIT_V(6); PG8_BAR; PG8_MMA(1, 1, At, B1); PG8_BAR;
            }
        }
        if constexpr (ALIGN_EPI) { if (wr == 0) PG8_BAR; }
        { int fr_e = fr, fq_e = fq; asm volatile("" : "+v"(fr_e), "+v"(fq_e));
          E(acc, cur, wr, wc, fr_e, fq_e); }
        if (!has_next) break;
#pragma unroll
        for (int a = 0; a < 2; ++a)
#pragma unroll
            for (int b = 0; b < 2; ++b)
#pragma unroll
                for (int m = 0; m < 4; ++m)
#pragma unroll
                    for (int n = 0; n < 2; ++n) acc[a][b][m][n] = (f32x4){0.f, 0.f, 0.f, 0.f};
        cur = nxt; cA = nA; cB = nB; ++ui;
        if constexpr (ALIGN_EPI) { if (wr == 1) PG8_BAR; }
    }
    PG8_WAIT_V(0);
    if constexpr (!ALIGN_EPI) { if (wr == 0) PG8_BAR; }
    PG8_BAR;
#undef PG8_SA
#undef PG8_SB
#undef PG8_STAGE
#undef p2voffA
#undef p2voffB
#undef PG8_LDA
#undef PG8_LDB
#undef PG8_MMA
#undef PG8_CAT
#undef PG8_WAIT_V
#undef PG8_WAIT_L
#undef PG8_BAR
#undef PG8_SCHED
}
}
using pg8::Unit;

constexpr size_t MiB = 1u << 20;
constexpr size_t WS_CTL = 0, CTL_ZERO_BYTES = 1 * MiB;
constexpr size_t WS_WIN = 1 * MiB;
constexpr size_t WS_WQ = 7 * MiB;
constexpr size_t WS_WKV = WS_WQ + 512 * 1024;
constexpr size_t WS_WPOOL = 8 * MiB;
constexpr size_t WS_WAO = 9 * MiB;
constexpr size_t WS_WPO = 10 * MiB;
constexpr size_t WS_WO = 11 * MiB;
constexpr size_t WS_WPG = 13 * MiB;
constexpr size_t WS_WPLE = 15 * MiB;
constexpr size_t WS_WGU = 16 * MiB;
constexpr size_t WS_WD = 144 * MiB;
constexpr size_t WS_HN = 208 * MiB;
constexpr size_t WS_PROJ = 240 * MiB;
constexpr size_t WS_GATES = 272 * MiB;
constexpr size_t WS_A2 = 336 * MiB;
constexpr size_t WS_POOLED = 352 * MiB;
constexpr size_t WS_Q = 368 * MiB;
constexpr size_t WS_K = 392 * MiB;
constexpr size_t WS_V = 416 * MiB;
constexpr size_t WS_ATT = 432 * MiB;
constexpr size_t WS_MIXED = 448 * MiB;
constexpr size_t WS_MIX = 464 * MiB;
constexpr size_t WS_PB = 496 * MiB;
constexpr size_t WS_E = 504 * MiB;
constexpr size_t WS_SSQ = 536 * MiB;
constexpr size_t WS_COS = 537 * MiB;
constexpr size_t WS_SIN = 538 * MiB;
constexpr size_t WS_ROUTE = 539 * MiB;
constexpr size_t WS_XS = 544 * MiB;
constexpr size_t WS_ACT = 688 * MiB;
constexpr size_t WS_XS2 = 768 * MiB;
constexpr size_t WS_WIN8 = 848 * MiB;
constexpr size_t WS_HN8 = 852 * MiB;
constexpr size_t WS_END = 868 * MiB;
constexpr size_t WS_X1B = WS_PROJ;
constexpr size_t WS_X2B = WS_MIX;
constexpr int CW_BAR = 4096;
constexpr int CW_CNT = 1024;

constexpr int RING_BYTES = 131072;
constexpr int LDS_BYTES = 163840;
constexpr int MISC_OFF = LDS_BYTES - 512;
constexpr int TILE_E_OFF = LDS_BYTES - 4096;
constexpr int NWAVES = 8;

typedef GAS unsigned gu32;
#define RLX_AGENT __ATOMIC_RELAXED, __HIP_MEMORY_SCOPE_AGENT
#define XB_TMO      128
#define XB_XCNT(j)  (256  + 64 * (j))
#define XB_XSUB(j)  (1280 + 64 * (j))
#define XB_XGEN(j)  (2304 + 64 * (j))
#define XB_TOP      3328
#define XB_TOPGEN   3392
#define XCD_BAR_WORDS 3456
#define XB_SPIN_CAP (1u << 18)
__device__ __forceinline__ unsigned xb_ld(unsigned* p)              { return __hip_atomic_load(p, __ATOMIC_RELAXED, __HIP_MEMORY_SCOPE_AGENT); }
__device__ __forceinline__ unsigned xb_add(unsigned* p, unsigned v) { return __hip_atomic_fetch_add(p, v, __ATOMIC_RELAXED, __HIP_MEMORY_SCOPE_AGENT); }
__device__ __forceinline__ unsigned xb_xcc_id() { return (unsigned)__builtin_amdgcn_s_getreg((3 << 11) | 20) & 0xFu; }
#define XB_SPIN(cond, bar) do { unsigned _sp = 0; while (cond) { __builtin_amdgcn_s_sleep(1); \
    if ((++_sp & 255u) == 0u) { if (xb_ld(&(bar)[XB_TMO])) break; if (_sp > XB_SPIN_CAP) { atomicAdd(&(bar)[XB_TMO], 1u); break; } } } } while (0)
struct XcdBarrier { unsigned* bar; unsigned x; volatile LAS unsigned* st; };
__device__ __forceinline__ XcdBarrier xcd_barrier_post(unsigned* bar, volatile LAS unsigned* st) {
    XcdBarrier b; b.bar = bar; b.x = xb_xcc_id(); b.st = st;
    if (threadIdx.x == 0) (void)xb_add(&bar[XB_XCNT(b.x)], 1u);
    return b;
}
__device__ __forceinline__ void xcd_barrier_complete(unsigned* bar, unsigned x, unsigned& nloc, unsigned& nx) {
    const unsigned G = gridDim.x * gridDim.y * gridDim.z;
    unsigned sum, cnt, mine, sp = 0u;
    for (;;) {
        sum = 0u; cnt = 0u; mine = 0u;
#pragma unroll
        for (unsigned j = 0; j < 16; ++j) { const unsigned c = xb_ld(&bar[XB_XCNT(j)]); sum += c; cnt += (c > 0u) ? 1u : 0u; mine = (j == x) ? c : mine; }
        if (sum == G) break;
        __builtin_amdgcn_s_sleep(1);
        if ((++sp & 255u) == 0u) { if (xb_ld(&bar[XB_TMO])) break; if (sp > XB_SPIN_CAP) { atomicAdd(&bar[XB_TMO], 1u); break; } }
    }
    nloc = mine > 0u ? mine : 1u; nx = cnt > 0u ? cnt : 1u;
}
__device__ __forceinline__ void xcd_barrier(const XcdBarrier& b) {
    asm volatile("s_waitcnt vmcnt(0)" ::: "memory");
    __syncthreads();
    if (threadIdx.x == 0) {
        unsigned* bar = b.bar;
        __builtin_amdgcn_s_waitcnt(0);
        unsigned nloc = b.st[0], nx = b.st[1];
        if (nloc == 0u) { xcd_barrier_complete(bar, b.x, nloc, nx); b.st[0] = nloc; b.st[1] = nx; }
        const unsigned old = xb_add(&bar[XB_XSUB(b.x)], 1u);
        const unsigned gen = old / nloc;
        if (old + 1u == (gen + 1u) * nloc) {
            __builtin_amdgcn_fence(__ATOMIC_RELEASE, "agent");
            asm volatile("s_waitcnt vmcnt(0)" ::: "memory");
            const unsigned og = xb_add(&bar[XB_TOP], 1u);
            const unsigned tg = og / nx;
            if (og + 1u == (tg + 1u) * nx) xb_add(&bar[XB_TOPGEN], 1u);
            else XB_SPIN(xb_ld(&bar[XB_TOPGEN]) == tg, bar);
            __builtin_amdgcn_fence(__ATOMIC_ACQUIRE, "agent");
            xb_add(&bar[XB_XGEN(b.x)], 1u);
            asm volatile("s_waitcnt vmcnt(0)" ::: "memory");
        } else {
            XB_SPIN(xb_ld(&bar[XB_XGEN(b.x)]) == gen, bar);
            __builtin_amdgcn_fence(__ATOMIC_ACQUIRE, "agent");
            asm volatile("s_waitcnt vmcnt(0)" ::: "memory");
        }
    }
    __syncthreads();
}

struct Args {
    const float* in[27];
    float* out; unsigned char* ws;
    int ph_lo, ph_hi;
};
typedef const __attribute__((address_space(4))) Args* KArgs;
__device__ __forceinline__ KArgs kargs() { KArgs p = (KArgs)__builtin_amdgcn_kernarg_segment_ptr(); asm volatile("" : "+s"(p)); return p; }
enum { I_X = 0, I_P, I_POS, I_GMIX, I_WIN, I_GQLAT, I_WQB, I_GKVLAT, I_WKVB, I_GQHEAD, I_GKNOPE, I_GKROPE, I_WPOOL, I_PSCALE, I_WAO, I_WPO, I_WO, I_GFFN,
       I_WR, I_BR, I_WGU, I_BGU, I_WD, I_BD, I_GPLE, I_WPG, I_WPLE };

enum { MAP_ID = 0, MAP_WIN, MAP_GU, MAP_QB, MAP_KVB };
__device__ __forceinline__ int map_row(int mode, int n) {
    switch (mode) {
    case MAP_WIN: return n < 416 ? n : n + 96;
    case MAP_GU: { const int j = n & 1023, up = n >> 10; return 256 * (j >> 7) + 128 * up + (j & 127); }
    case MAP_QB: { const int h = n / 96, d = n % 96;
        if (d < 64) return (h >> 2) * 256 + 128 * (d >> 5) + 32 * (h & 3) + (d & 31);
        const int dd = d - 64, half = dd >> 4, i = dd & 15; return 512 + 128 * (h & 1) + 32 * (h >> 1) + 8 * (i >> 2) + 4 * half + (i & 3); }
    case MAP_KVB: { const int h = n >> 7, c = n & 127, isv = c >> 6, d = c & 63; return (h >> 1) * 256 + 128 * (d >> 5) + 32 * (2 * isv + (h & 1)) + (d & 31); }
    default: return n;
    }
}
struct TJob { const float* W; int K, N; bf16_t* WT; int ldw, koff, mode, row_off; const float* gk; const float* gn; int nmat; size_t wstride, wtstride; int fp8; };
struct TItem { const float* src; bf16_t* dst; int n0, k0; float gnv; };
__device__ __forceinline__ TItem titem_setup(const TJob& J, int item, int lane) {
    const int nblk = J.N / 32, ipm = (J.K / 64) * nblk, mat = item / ipm, it = item - mat * ipm, kb = it / nblk, nb = it - kb * nblk;
    TItem I; I.k0 = 64 * kb; I.n0 = 32 * nb;
    I.src = J.W + (size_t)mat * J.wstride + (size_t)(I.k0 + (lane >> 5)) * J.N + I.n0 + (lane & 31);
    I.dst = (bf16_t*)((unsigned char*)J.WT + (size_t)mat * J.wtstride * (J.fp8 ? 1 : 2));
    I.gnv = J.gn ? J.gn[I.n0 + (lane & 31)] : 1.f;
    return I;
}
__device__ __forceinline__ void titem_load(const TJob& J, const TItem& I, float (&v)[32]) {
#pragma unroll
    for (int i = 0; i < 32; ++i) v[i] = I.src[(size_t)(2 * i) * J.N];
}
__device__ __forceinline__ void titem_store(const TJob& J, const TItem& I, float (&v)[32], LAS float* scr, int lane) {
#pragma unroll
    for (int i = 0; i < 32; ++i) { const int kk = 2 * i + (lane >> 5); float x = v[i] * I.gnv; if (J.gk) x *= J.gk[I.k0 + kk]; scr[kk * 33 + (lane & 31)] = x; }
    asm volatile("s_waitcnt lgkmcnt(0)" ::: "memory");
    const int c = lane & 7;
#pragma unroll
    for (int j = 0; j < 4; ++j) { const int n = (lane >> 3) + 8 * j; const LAS float* s = scr + (8 * c) * 33 + n;
        const size_t eo = (size_t)(J.row_off + map_row(J.mode, I.n0 + n)) * J.ldw + J.koff + I.k0 + 8 * c;
        if (J.fp8) { u32x2 o; int w = __builtin_amdgcn_cvt_pk_fp8_f32(s[0 * 33] * 8.f, s[1 * 33] * 8.f, 0, false); w = __builtin_amdgcn_cvt_pk_fp8_f32(s[2 * 33] * 8.f, s[3 * 33] * 8.f, w, true); o.x = (unsigned)w;
            w = __builtin_amdgcn_cvt_pk_fp8_f32(s[4 * 33] * 8.f, s[5 * 33] * 8.f, 0, false); w = __builtin_amdgcn_cvt_pk_fp8_f32(s[6 * 33] * 8.f, s[7 * 33] * 8.f, w, true); o.y = (unsigned)w;
            *(u32x2*)((unsigned char*)I.dst + eo) = o; }
        else { u32x4 o; o.x = cvt_pk_bf16(s[0 * 33], s[1 * 33]); o.y = cvt_pk_bf16(s[2 * 33], s[3 * 33]); o.z = cvt_pk_bf16(s[4 * 33], s[5 * 33]); o.w = cvt_pk_bf16(s[6 * 33], s[7 * 33]);
            *(u32x4*)(I.dst + eo) = o; } }
    asm volatile("s_waitcnt lgkmcnt(0)" ::: "memory");
}
__device__ __forceinline__ void run_job(const TJob& J, LAS float* scr, int gw, int NGW, int lane) {
    const int items = J.nmat * (J.K / 64) * (J.N / 32);
    for (int it = gw; it < items; it += 2 * NGW) {
        const bool two = (it + NGW) < items;
        const TItem I0 = titem_setup(J, it, lane); const TItem I1 = titem_setup(J, two ? it + NGW : it, lane);
        float v0[32], v1[32];
        titem_load(J, I0, v0); if (two) titem_load(J, I1, v1);
        titem_store(J, I0, v0, scr, lane); if (two) titem_store(J, I1, v1, scr, lane);
    }
}

struct Frame {
    LAS unsigned char* lds; volatile LAS unsigned* MISC; unsigned* ctl;
    int wave, vcu, G;
    float* out; unsigned char* ws;
};

__device__ __forceinline__ void p0_prologue(const Frame& F) {
    const int tid_l = tid_local(), lane_l = tid_l & 63; (void)tid_l; (void)lane_l;
    const KArgs a = kargs();
    LAS float* scr = (LAS float*)(F.lds + F.wave * 16384);
    const int gw = F.vcu * NWAVES + F.wave, NGW = F.G * NWAVES;
    unsigned char* ws = F.ws;
#define RUN_JOB(...) do { const TJob J_ = TJob{__VA_ARGS__, 1, 0, 0, 0}; run_job(J_, scr, gw, NGW, lane_l); } while (0)
#ifndef P1_FP8
#define P1_FP8 0
#endif
    { const TJob J_{a->in[I_WIN], 1024, 2976, (bf16_t*)(ws + WS_WIN), 1024, 0, MAP_WIN, 0, nullptr, nullptr, 1, 0, 0, P1_FP8}; run_job(J_, scr, gw, NGW, lane_l); }
#ifndef GATES_FP8
#define GATES_FP8 0
#endif
    if (GATES_FP8) { const TJob J_{a->in[I_WIN], 1024, 2976, (bf16_t*)(ws + WS_WIN8), 1024, 0, MAP_WIN, 0, nullptr, nullptr, 1, 0, 0, 1}; run_job(J_, scr, gw, NGW, lane_l); }
    RUN_JOB(a->in[I_WQB], 256, 768, (bf16_t*)(ws + WS_WQ), 256, 0, MAP_QB, 0, a->in[I_GQLAT], nullptr);
    RUN_JOB(a->in[I_WKVB], 128, 1024, (bf16_t*)(ws + WS_WKV), 256, 0, MAP_KVB, 0, a->in[I_GKVLAT], nullptr);
    RUN_JOB(a->in[I_WAO], 512, 1024, (bf16_t*)(ws + WS_WAO), 512, 0, MAP_ID, 0, nullptr, nullptr);
    RUN_JOB(a->in[I_WPO], 512, 1024, (bf16_t*)(ws + WS_WPO), 512, 0, MAP_ID, 0, nullptr, nullptr);
    RUN_JOB(a->in[I_WO], 1024, 1024, (bf16_t*)(ws + WS_WO), 1024, 0, MAP_ID, 0, nullptr, nullptr);
    RUN_JOB(a->in[I_WPG], 1024, 1024, (bf16_t*)(ws + WS_WPG), 1024, 0, MAP_ID, 0, nullptr, nullptr);
    RUN_JOB(a->in[I_WPLE], 256, 1024, (bf16_t*)(ws + WS_WPLE), 256, 0, MAP_ID, 0, nullptr, nullptr);
    for (int g = 0; g < 4; ++g)
        RUN_JOB(a->in[I_WPOOL] + (size_t)g * 128 * 128, 128, 128, (bf16_t*)(ws + WS_WPOOL) + (size_t)(g >> 1) * 256 * 256, 256, 128 * (g & 1), MAP_ID, 128 * (g & 1), nullptr, a->in[I_PSCALE] + 128 * g);
    {
        const int gt = (F.vcu * NWAVES + F.wave) * 64 + lane_l, NGT = NGW * 64;
        const u32x4 z = {0u, 0u, 0u, 0u};
        u32x4* w0 = (u32x4*)(ws + WS_WIN + (size_t)416 * 1024 * (P1_FP8 ? 1 : 2));
        for (int i = gt; i < 96 * (P1_FP8 ? 64 : 128); i += NGT) w0[i] = z;
        for (int i = gt; i < 1024 * 16; i += NGT) { const int r = i >> 4, c = i & 15; *(u32x4*)((bf16_t*)(ws + WS_WKV) + (size_t)r * 256 + 128 + 8 * c) = z; }
        for (int i = gt; i < 2 * 256 * 16; i += NGT) { const int p = i >> 12, r = (i >> 4) & 255, c = i & 15;
            const int k0 = (r < 128) ? 128 : 0; *(u32x4*)((bf16_t*)(ws + WS_WPOOL) + (size_t)p * 65536 + (size_t)r * 256 + k0 + 8 * c) = z; }
    }
#ifndef CONV_IN_ATTN
#define CONV_IN_ATTN 1
#endif
    if (!CONV_IN_ATTN) {
    { const TJob J{a->in[I_WGU], 1024, 2048, (bf16_t*)(ws + WS_WGU), 1024, 0, MAP_GU, 0, nullptr, nullptr, NEXP, (size_t)1024 * 2048, (size_t)2048 * 1024, 1}; run_job(J, scr, gw, NGW, lane_l); }
    { const TJob J{a->in[I_WD], 1024, 1024, (bf16_t*)(ws + WS_WD), 1024, 0, MAP_ID, 0, nullptr, nullptr, NEXP, (size_t)1024 * 1024, (size_t)1024 * 1024, 1}; run_job(J, scr, gw, NGW, lane_l); }
    }
    const float* x = a->in[I_X]; const float* gm = a->in[I_GMIX];
    f32x4 gv[4];
#pragma unroll
    for (int j = 0; j < 4; ++j) gv[j] = *(const f32x4*)(gm + 4 * lane_l + 256 * j);
    for (int m = gw; m < T; m += NGW) {
        const f32x4* xr = (const f32x4*)(x + (size_t)m * DM) + lane_l;
        f32x4 v[4]; float s = 0.f;
#pragma unroll
        for (int j = 0; j < 4; ++j) { v[j] = xr[64 * j]; s += (v[j].x * v[j].x + v[j].y * v[j].y) + (v[j].z * v[j].z + v[j].w * v[j].w); }
        const float rstd = 1.0f / sqrtf(wave_sum(s) * (1.f / DM) + EPS);
        if (P1_FP8) { int* o4 = (int*)(ws + WS_HN + (size_t)m * DM) + lane_l; const float r8 = rstd * 8.0f;
#pragma unroll
            for (int j = 0; j < 4; ++j) { int w = __builtin_amdgcn_cvt_pk_fp8_f32(v[j].x * r8 * gv[j].x, v[j].y * r8 * gv[j].y, 0, false); w = __builtin_amdgcn_cvt_pk_fp8_f32(v[j].z * r8 * gv[j].z, v[j].w * r8 * gv[j].w, w, true); o4[64 * j] = w; } }
        else { u32x2* o8 = (u32x2*)((bf16_t*)(ws + WS_HN) + (size_t)m * DM) + lane_l;
#pragma unroll
            for (int j = 0; j < 4; ++j) { u32x2 w; w.x = cvt_pk_bf16(v[j].x * rstd * gv[j].x, v[j].y * rstd * gv[j].y); w.y = cvt_pk_bf16(v[j].z * rstd * gv[j].z, v[j].w * rstd * gv[j].w); o8[64 * j] = w; }
            if (GATES_FP8) { int* o4 = (int*)(ws + WS_HN8 + (size_t)m * DM) + lane_l; const float r8 = rstd * 8.0f;
#pragma unroll
                for (int j = 0; j < 4; ++j) { int w = __builtin_amdgcn_cvt_pk_fp8_f32(v[j].x * r8 * gv[j].x, v[j].y * r8 * gv[j].y, 0, false); w = __builtin_amdgcn_cvt_pk_fp8_f32(v[j].z * r8 * gv[j].z, v[j].w * r8 * gv[j].w, w, true); o4[64 * j] = w; } } }
    }
    {
        const float* p = a->in[I_P];
        for (int m = gw; m < T; m += NGW) { const f32x4 v = *((const f32x4*)(p + (size_t)m * PLE) + lane_l); u32x2 w; w.x = cvt_pk_bf16(v.x, v.y); w.y = cvt_pk_bf16(v.z, v.w);
            *((u32x2*)((bf16_t*)(ws + WS_PB) + (size_t)m * PLE) + lane_l) = w; }
    }
}

struct DenseOrder {
    int nM, nN, nwg, G, c; unsigned A, B, tA, tB, aPn;
    __device__ void init(int nM_, int nN_, int G_, int c_, size_t A_, size_t lda, size_t B_, size_t ldb, unsigned aPn_ = 0) { nM = nM_; nN = nN_; nwg = nM * nN; G = G_; c = c_; A = (unsigned)A_; B = (unsigned)B_; tA = (unsigned)(256 * lda * 2); tB = (unsigned)(256 * ldb * 2); aPn = aPn_; }
    __device__ __forceinline__ bool next(int i, Unit& u) const {
        const long L = (long)i * G + c; if (L >= nwg) return false;
        int wgid = (int)L; { const int q = nwg / 8, r = nwg % 8, xcd = wgid % 8, off = wgid / 8; wgid = (xcd < r ? xcd * (q + 1) : r * (q + 1) + (xcd - r) * q) + off; }
        const int WGM = 8; const int nig = WGM * nN, gid = wgid / nig, fm = gid * WGM, gsz = (nM - fm) < WGM ? (nM - fm) : WGM;
        u.pm = fm + ((wgid % nig) % gsz); u.pn = (wgid % nig) / gsz; u.aux = 0; return true;
    }
    __device__ __forceinline__ unsigned a_off(const Unit& u) const { return A + (unsigned)u.pm * tA + (unsigned)u.pn * aPn; }
    __device__ __forceinline__ unsigned b_off(const Unit& u) const { return B + (unsigned)u.pn * tB; }
};

struct EpiBf16 {
    static constexpr bool PERM = true;
    bf16_t* O; int ldc;
    __device__ __forceinline__ void operator()(const f32x4 (&acc)[2][2][4][2], const Unit& u, int wr, int wc, int fr, int fq) const {
        const int row0 = u.pm * 256 + wr * 64 + fr, col0 = u.pn * 256 + wc * 32 + 8 * fq;
#pragma unroll
        for (int ai = 0; ai < 2; ++ai)
#pragma unroll
            for (int m = 0; m < 4; ++m) { bf16_t* rowp = O + (size_t)(row0 + ai * 128 + m * 16) * ldc + col0;
#pragma unroll
                for (int bj = 0; bj < 2; ++bj) { const f32x4 v0 = acc[ai][bj][m][0], v1 = acc[ai][bj][m][1];
                    u32x4 w; w.x = cvt_pk_bf16(v0[0], v0[1]); w.y = cvt_pk_bf16(v0[2], v0[3]); w.z = cvt_pk_bf16(v1[0], v1[1]); w.w = cvt_pk_bf16(v1[2], v1[3]);
                    *(u32x4*)(rowp + bj * 128) = w; } }
    }
};
struct EpiProj {
    static constexpr bool PERM = true;
    bf16_t* PROJ; bf16_t* GATES; int pn_off;
    __device__ __forceinline__ void operator()(const f32x4 (&acc)[2][2][4][2], const Unit& u, int wr, int wc, int fr, int fq) const {
        const int pn = u.pn + pn_off; const int row0 = u.pm * 256 + wr * 64 + fr; const bool isg = pn >= 4;
        bf16_t* O = isg ? GATES : PROJ; const int ldc = isg ? 2048 : 1024; const int col0 = (isg ? pn - 4 : pn) * 256 + wc * 32 + 8 * fq;
#pragma unroll
        for (int ai = 0; ai < 2; ++ai)
#pragma unroll
            for (int m = 0; m < 4; ++m) { bf16_t* rowp = O + (size_t)(row0 + ai * 128 + m * 16) * ldc + col0;
#pragma unroll
                for (int bj = 0; bj < 2; ++bj) { f32x4 v0 = acc[ai][bj][m][0], v1 = acc[ai][bj][m][1];
                    if (isg) {
#pragma unroll
                        for (int e = 0; e < 4; ++e) { v0[e] = fast_sigmoid(v0[e]); v1[e] = fast_sigmoid(v1[e]); } }
                    u32x4 w; w.x = cvt_pk_bf16(v0[0], v0[1]); w.y = cvt_pk_bf16(v0[2], v0[3]); w.z = cvt_pk_bf16(v1[0], v1[1]); w.w = cvt_pk_bf16(v1[2], v1[3]);
                    *(u32x4*)(rowp + bj * 128) = w; } asm volatile("" ::: "memory"); }
    }
};

__device__ __forceinline__ void p2_rows(const Frame& F) {
    const int tid_l = tid_local(), lane_l = tid_l & 63; (void)tid_l; (void)lane_l;
    const KArgs a = kargs();
    const int gw = F.vcu * NWAVES + F.wave, NGW = F.G * NWAVES, lane = lane_l;
    unsigned char* ws = F.ws;
    const bf16_t* PROJ = (const bf16_t*)(ws + WS_PROJ);
    bf16_t* A2 = (bf16_t*)(ws + WS_A2); bf16_t* POOLED = (bf16_t*)(ws + WS_POOLED); bf16_t* Kb = (bf16_t*)(ws + WS_K);
    float* COS = (float*)(ws + WS_COS); float* SIN = (float*)(ws + WS_SIN);
    const int* positions = (const int*)a->in[I_POS];
    const float gkr = (lane < 32) ? a->in[I_GKROPE][lane] : 0.f;
    const float inv_freq = __builtin_amdgcn_exp2f(-(float)(lane & 15) * (13.287712379549449f / 16.0f));
    const int w = 2 << (lane >> 4);
    for (int task = gw; task < T / 8; task += NGW) {
        const int t0 = task * 8, b = t0 / SEQ, s0 = t0 % SEQ;
        {
            const bf16_t* base = PROJ + (size_t)(b * SEQ) * 1024 + 512 + 8 * lane;
            float S[8];
#pragma unroll
            for (int j = 0; j < 8; ++j) S[j] = 0.f;
            for (int r = s0 - 15; r < s0; ++r) {
                if (r >= 0 && r >= s0 - w + 1) { const u32x4 v = *(const u32x4*)(base + (size_t)r * 1024);
                    S[0] += bf_lo(v.x); S[1] += bf_hi(v.x); S[2] += bf_lo(v.y); S[3] += bf_hi(v.y); S[4] += bf_lo(v.z); S[5] += bf_hi(v.z); S[6] += bf_lo(v.w); S[7] += bf_hi(v.w); }
            }
#pragma unroll
            for (int i = 0; i < 8; ++i) {
                const int s = s0 + i;
                const u32x4 v = *(const u32x4*)(base + (size_t)s * 1024);
                float uu[8] = {bf_lo(v.x), bf_hi(v.x), bf_lo(v.y), bf_hi(v.y), bf_lo(v.z), bf_hi(v.z), bf_lo(v.w), bf_hi(v.w)};
                const int cnt = (s + 1 < w) ? s + 1 : w; const float ic = 1.0f / (float)cnt;
                float o[8];
#pragma unroll
                for (int j = 0; j < 8; ++j) { S[j] += uu[j]; o[j] = S[j] * ic - uu[j]; }
                u32x4 wv; wv.x = cvt_pk_bf16(o[0], o[1]); wv.y = cvt_pk_bf16(o[2], o[3]); wv.z = cvt_pk_bf16(o[4], o[5]); wv.w = cvt_pk_bf16(o[6], o[7]);
                *(u32x4*)(POOLED + (size_t)(t0 + i) * 512 + 8 * lane) = wv;
                const int rr = s - w + 1;
                if (rr >= 0) { const u32x4 q = *(const u32x4*)(base + (size_t)rr * 1024);
                    S[0] -= bf_lo(q.x); S[1] -= bf_hi(q.x); S[2] -= bf_lo(q.y); S[3] -= bf_hi(q.y); S[4] -= bf_lo(q.z); S[5] -= bf_hi(q.z); S[6] -= bf_lo(q.w); S[7] -= bf_hi(q.w); }
            }
        }
        for (int i = 0; i < 8; ++i) {
            const int t = t0 + i, s = s0 + i;
            const bf16_t* pr = PROJ + (size_t)t * 1024;
            const u32x2 ql = *(const u32x2*)(pr + 4 * lane);
            const unsigned kvl = *(const unsigned*)(pr + 256 + 2 * lane);
            const float krv = (lane < 32) ? bf1(pr[384 + lane]) : 0.f;
            const float q0 = bf_lo(ql.x), q1 = bf_hi(ql.x), q2 = bf_lo(ql.y), q3 = bf_hi(ql.y);
            const float k0 = bf_lo(kvl), k1 = bf_hi(kvl);
            const float sq = wave_sum((q0 * q0 + q1 * q1) + (q2 * q2 + q3 * q3));
            const float sk = wave_sum(k0 * k0 + k1 * k1);
            const float sr = wave_sum(krv * krv);
            const float rq = 1.0f / sqrtf(sq * (1.f / 256.f) + EPS), rk = 1.0f / sqrtf(sk * (1.f / 128.f) + EPS), rr = 1.0f / sqrtf(sr * (1.f / 32.f) + EPS);
            u32x2 wq; wq.x = cvt_pk_bf16(q0 * rq, q1 * rq); wq.y = cvt_pk_bf16(q2 * rq, q3 * rq);
            *(u32x2*)(A2 + (size_t)t * 512 + 4 * lane) = wq;
            *(unsigned*)(A2 + (size_t)t * 512 + 256 + 2 * lane) = cvt_pk_bf16(k0 * rk, k1 * rk);
            *(unsigned*)(A2 + (size_t)t * 512 + 384 + 2 * lane) = 0u;
            const float pos = (float)positions[t];
            const float ang = pos * inv_freq;
            const float rev = ang * 0.15915494309189535f;
            const float fr_ = rev - floorf(rev);
            const float sn = __builtin_amdgcn_sinf(fr_), cs = __builtin_amdgcn_cosf(fr_);
            const float kn = krv * rr * gkr;
            const float other = __shfl_xor(kn, 16);
            const float ro = (lane & 16) ? (kn * cs + other * sn) : (kn * cs - other * sn);
            if (lane < 32) {
                const bf16_t rb = (bf16_t)(cvt_pk_bf16(ro, 0.f) & 0xffffu);
#pragma unroll
                for (int h = 0; h < NH; ++h) Kb[((size_t)(b * NH + h) * SEQ + s) * DK + 64 + lane] = rb;
            }
            if (lane < 16) { COS[(size_t)t * 16 + lane] = cs; SIN[(size_t)t * 16 + lane] = sn; }
        }
    }
}

#define EPI_FENCE() asm volatile("" ::: "memory")
struct EpiQ {
    static constexpr bool PERM = true;
    bf16_t* Q; float* SSQ; const float* COS; const float* SIN; const float* gq;
    __device__ __forceinline__ void operator()(const f32x4 (&acc)[2][2][4][2], const Unit& u, int wr, int wc, int fr, int fq) const {
        const int t0 = u.pm * 256 + wr * 64 + fr, b = (u.pm * 256) / SEQ, s0 = t0 - b * SEQ;
        if (u.pn < 2) {
            const int h = 4 * u.pn + wc;
            bf16_t* dst0 = Q + ((size_t)(b * NH + h) * SEQ + s0) * DK + 8 * fq;
            float* ssq0 = SSQ + ((size_t)t0 * NH + h) * 2;
#pragma unroll
            for (int ai = 0; ai < 2; ++ai)
#pragma unroll
                for (int m = 0; m < 4; ++m) {
                    const int dr = ai * 128 + m * 16;
                    float q = 0.f;
#pragma unroll
                    for (int bj = 0; bj < 2; ++bj)
#pragma unroll
                        for (int n = 0; n < 2; ++n) { const f32x4 v = acc[ai][bj][m][n]; q += (v[0] * v[0] + v[1] * v[1]) + (v[2] * v[2] + v[3] * v[3]); }
                    q += __shfl_xor(q, 16); q += __shfl_xor(q, 32);
                    if (fq == 0) ssq0[dr * NH * 2] = q;
#pragma unroll
                    for (int bj = 0; bj < 2; ++bj) { const f32x4 v0 = acc[ai][bj][m][0] * *(const f32x4*)(gq + 32 * bj + 8 * fq), v1 = acc[ai][bj][m][1] * *(const f32x4*)(gq + 32 * bj + 8 * fq + 4);
                        u32x4 w; w.x = cvt_pk_bf16(v0[0], v0[1]); w.y = cvt_pk_bf16(v0[2], v0[3]); w.z = cvt_pk_bf16(v1[0], v1[1]); w.w = cvt_pk_bf16(v1[2], v1[3]);
                        *(u32x4*)(dst0 + dr * DK + 32 * bj) = w; }
                    EPI_FENCE();
                }
        } else {
            const f32x4 g1 = *(const f32x4*)(gq + 64 + 4 * fq), g2 = *(const f32x4*)(gq + 80 + 4 * fq);
            const float* cs0 = COS + (size_t)t0 * 16 + 4 * fq; const float* sn0 = SIN + (size_t)t0 * 16 + 4 * fq;
            bf16_t* dst0 = Q + ((size_t)(b * NH + 2 * wc) * SEQ + s0) * DK + 64 + 4 * fq;
            float* ssq0 = SSQ + ((size_t)t0 * NH + 2 * wc) * 2 + 1;
#pragma unroll
            for (int ai = 0; ai < 2; ++ai)
#pragma unroll
                for (int m = 0; m < 4; ++m) {
                    const int dr = ai * 128 + m * 16;
                    const f32x4 cs = *(const f32x4*)(cs0 + dr * 16), sn = *(const f32x4*)(sn0 + dr * 16);
#pragma unroll
                    for (int bj = 0; bj < 2; ++bj) {
                        const f32x4 x1 = acc[ai][bj][m][0], x2 = acc[ai][bj][m][1];
                        float q = (x1[0] * x1[0] + x1[1] * x1[1]) + (x1[2] * x1[2] + x1[3] * x1[3]) + (x2[0] * x2[0] + x2[1] * x2[1]) + (x2[2] * x2[2] + x2[3] * x2[3]);
                        q += __shfl_xor(q, 16); q += __shfl_xor(q, 32);
                        if (fq == 0) ssq0[dr * NH * 2 + bj * 2] = q;
                        const f32x4 y1 = x1 * g1, y2 = x2 * g2;
                        const f32x4 o1 = y1 * cs - y2 * sn, o2 = y2 * cs + y1 * sn;
                        bf16_t* dst = dst0 + (size_t)bj * SEQ * DK + dr * DK;
                        u32x2 w1, w2; w1.x = cvt_pk_bf16(o1[0], o1[1]); w1.y = cvt_pk_bf16(o1[2], o1[3]); w2.x = cvt_pk_bf16(o2[0], o2[1]); w2.y = cvt_pk_bf16(o2[2], o2[3]);
                        *(u32x2*)(dst) = w1; *(u32x2*)(dst + 16) = w2;
                    }
                    EPI_FENCE();
                }
        }
    }
};
struct EpiKV {
    static constexpr bool PERM = true;
    bf16_t* K; bf16_t* V; const float* gk;
    __device__ __forceinline__ void operator()(const f32x4 (&acc)[2][2][4][2], const Unit& u, int wr, int wc, int fr, int fq) const {
        const int t0 = u.pm * 256 + wr * 64 + fr, b = (u.pm * 256) / SEQ, s0 = t0 - b * SEQ;
        const int h = 2 * u.pn + (wc & 1); const bool isv = wc >= 2;
        const int pitch = isv ? DV : DK;
        bf16_t* dst0 = (isv ? V : K) + ((size_t)(b * NH + h) * SEQ + s0) * pitch + 8 * fq;
#pragma unroll
        for (int ai = 0; ai < 2; ++ai)
#pragma unroll
            for (int m = 0; m < 4; ++m) {
                const int dr = ai * 128 + m * 16;
                float sc = 1.f;
                if (!isv) { float q = 0.f;
#pragma unroll
                    for (int bj = 0; bj < 2; ++bj)
#pragma unroll
                        for (int n = 0; n < 2; ++n) { const f32x4 v = acc[ai][bj][m][n]; q += (v[0] * v[0] + v[1] * v[1]) + (v[2] * v[2] + v[3] * v[3]); }
                    q += __shfl_xor(q, 16); q += __shfl_xor(q, 32);
                    sc = 1.0f / sqrtf(q * (1.f / 64.f) + EPS); }
#pragma unroll
                for (int bj = 0; bj < 2; ++bj) {
                    f32x4 v0 = acc[ai][bj][m][0] * sc, v1 = acc[ai][bj][m][1] * sc;
                    if (!isv) { v0 = v0 * *(const f32x4*)(gk + 32 * bj + 8 * fq); v1 = v1 * *(const f32x4*)(gk + 32 * bj + 8 * fq + 4); }
                    u32x4 w; w.x = cvt_pk_bf16(v0[0], v0[1]); w.y = cvt_pk_bf16(v0[2], v0[3]); w.z = cvt_pk_bf16(v1[0], v1[1]); w.w = cvt_pk_bf16(v1[2], v1[3]);
                    *(u32x4*)(dst0 + dr * pitch + 32 * bj) = w; }
                EPI_FENCE();
            }
    }
};

namespace att {
constexpr int KT_BYTES = 64 * 192, VT_BYTES = 64 * 128, SLOT_BYTES = KT_BYTES + VT_BYTES;
constexpr int NSLOT = 4, SCR_OFF = NSLOT * SLOT_BYTES;
__device__ __forceinline__ int crow(int r, int hi) { return (r & 3) + 8 * (r >> 2) + 4 * hi; }
__device__ __forceinline__ s16x4 vtr(const LAS unsigned char* p) { typedef short v4i16_t __attribute__((ext_vector_type(4)));
    return __builtin_bit_cast(s16x4, __builtin_amdgcn_ds_read_tr16_b64_v4i16((LAS v4i16_t*)p)); }
#define MFMA32(a, b, c) __builtin_amdgcn_mfma_f32_32x32x16_bf16(a, b, c, 0, 0, 0)
__device__ __forceinline__ float max3f(float a, float b, float c) { return __builtin_fmaxf(__builtin_fmaxf(a, b), c); }


constexpr int CONV_OFF = SCR_OFF + 8 * 256, CONV_BYTES = 8192;
constexpr int CV_GU_ITEMS = NEXP * 1024, CV_ITEMS = CV_GU_ITEMS + NEXP * 512;
struct ConvItem { const float* src; unsigned char* dst; int N, isgu, n0; };
__device__ __forceinline__ ConvItem cv_setup(int g, const float* wgu, const float* wd, unsigned char* wgu8, unsigned char* wd8) {
    ConvItem I;
    if (g < CV_GU_ITEMS) { const int e = g >> 10, it = g & 1023, kb = it >> 6, nb = it & 63; I.N = 2048; I.isgu = 1; I.n0 = 32 * nb;
        I.src = wgu + (size_t)e * 1024 * 2048 + (size_t)(64 * kb) * 2048 + 32 * nb; I.dst = wgu8 + (size_t)e * 2048 * 1024 + 64 * kb; }
    else { const int g2 = g - CV_GU_ITEMS, e = g2 >> 9, it = g2 & 511, kb = it >> 5, nb = it & 31; I.N = 1024; I.isgu = 0; I.n0 = 32 * nb;
        I.src = wd + (size_t)e * 1024 * 1024 + (size_t)(64 * kb) * 1024 + 32 * nb; I.dst = wd8 + (size_t)e * 1024 * 1024 + 64 * kb; }
    return I;
}
__device__ __forceinline__ void cv_dma(const ConvItem& I, unsigned ldsaddr, int lane) {
    const int kr = lane >> 3, sl = lane & 7;
#pragma unroll
    for (int q = 0; q < 8; ++q) { const unsigned voff = (unsigned)(((8 * q + kr) * I.N + 4 * (sl ^ ((kr ^ q) & 7))) * 4);
        asm volatile("s_nop 4\n\ts_mov_b32 m0, %0\n\ts_nop 0\n\tglobal_load_lds_dwordx4 %1, %2" :: "s"(ldsaddr + (unsigned)q * 1024u), "v"(voff), "s"(I.src) : "m0", "memory"); }
}
__device__ __forceinline__ void cv_out(const ConvItem& I, const LAS float* cb, int lane) {
    const int c = lane & 7;
#pragma unroll
    for (int j = 0; j < 4; ++j) { const int n = (lane >> 3) + 8 * j, nc = n >> 2, e = n & 3;
        float f[8];
#pragma unroll
        for (int kk = 0; kk < 8; ++kk) f[kk] = cb[(8 * c + kk) * 32 + ((nc ^ kk ^ c) & 7) * 4 + e];
        const int nn = I.n0 + n; const int row = I.isgu ? (256 * ((nn & 1023) >> 7) + 128 * (nn >> 10) + (nn & 127)) : nn;
        *(u32x2*)(I.dst + (size_t)row * 1024 + 8 * c) = cvt8_fp8((f32x4){f[0], f[1], f[2], f[3]}, (f32x4){f[4], f[5], f[6], f[7]}, 8.0f);
        asm volatile("" ::: "memory"); }
}
struct ConvState { int next, end, cur; };
__device__ __forceinline__ void attn_unit(LAS unsigned char* lds, const u32x4 srd, ConvState& CV, unsigned char* cvws, int bh, int qb, const bf16_t* Q, unsigned Koff, unsigned Voff, const float* SSQ, bf16_t* O) {
    const int tid = tid_local(), lane = tid & 63, r32 = lane & 31, hi = lane >> 5; const int wid = __builtin_amdgcn_readfirstlane(tid >> 6);
    const int b = bh / NH, h = bh % NH, q0 = qb * 256, qw = q0 + 32 * wid;
    LAS float* scr = (LAS float*)(lds + SCR_OFF) + wid * 64;
    const int NT = (q0 + 256) / 64;
    const unsigned kS = Koff + (unsigned)bh * (SEQ * DK * 2), vS = Voff + (unsigned)bh * (SEQ * DV * 2);
    const int kc2 = 8 + (wid & 3);
    const unsigned vK1 = (unsigned)(lane * 192 + wid * 16); const unsigned sK2 = (unsigned)((kc2 - wid) * 16);
    const int vkey = 8 * wid + (lane >> 3); const unsigned vV = (unsigned)(vkey * 128 + (((lane & 7) ^ (((vkey >> 1) & 1) * 4)) * 16));
    const unsigned lds0 = (unsigned)__builtin_amdgcn_readfirstlane((int)(unsigned)(unsigned long)lds);
    const unsigned dK1 = (unsigned)wid * 1024u, dK2 = (unsigned)kc2 * 1024u, dV = (unsigned)KT_BYTES + (unsigned)wid * 1024u;
#define ATT_DMA1(ldsaddr, voff, soff) asm volatile("s_nop 4\n\ts_mov_b32 m0, %0\n\ts_nop 0\n\tbuffer_load_dwordx4 %1, %2, %3 offen lds" :: "s"(ldsaddr), "v"(voff), "s"(srd), "s"(soff) : "m0", "memory")
#define ATT_DMA(t) do { const unsigned sp_ = lds0 + (unsigned)((t) & 3) * SLOT_BYTES; const unsigned ks_ = kS + (unsigned)(t) * (64 * 192), vs_ = vS + (unsigned)(t) * (64 * 128); \
        ATT_DMA1(sp_ + dK1, vK1, ks_); ATT_DMA1(sp_ + dK2, vK1, ks_ + sK2); ATT_DMA1(sp_ + dV, vV, vs_); } while (0)
#define ATT_WAITBAR(N) asm volatile("s_waitcnt vmcnt(" #N ") lgkmcnt(0)\n\ts_barrier" ::: "memory")
    bf16x8 qr[6];
    { const float* sp = SSQ + ((size_t)(b * SEQ + qw + r32) * NH + h) * 2; const float ss = sp[0] + sp[1];
      const float cq = (1.0f / sqrtf(ss * (1.f / 96.f) + EPS)) * 0.10206207261596577f * 1.4426950408889634f;
      const bf16_t* qp = Q + ((size_t)bh * SEQ + qw + r32) * DK + 8 * hi;
      u32x4 qw_[6];
#pragma unroll
      for (int d0 = 0; d0 < 6; ++d0) qw_[d0] = *(const u32x4*)(qp + 16 * d0);
#pragma unroll
      for (int d0 = 0; d0 < 6; ++d0) { const u32x4 w = qw_[d0]; u32x4 o;
          o.x = cvt_pk_bf16(bf_lo(w.x) * cq, bf_hi(w.x) * cq); o.y = cvt_pk_bf16(bf_lo(w.y) * cq, bf_hi(w.y) * cq); o.z = cvt_pk_bf16(bf_lo(w.z) * cq, bf_hi(w.z) * cq); o.w = cvt_pk_bf16(bf_lo(w.w) * cq, bf_hi(w.w) * cq);
          qr[d0] = __builtin_bit_cast(bf16x8, o); } }
    ATT_DMA(0); ATT_DMA(1); ATT_DMA(2);
    const int kbase = hi * 1024 + r32 * 16;
    const int qq = (lane & 15) >> 2, pp = lane & 3, dblk = (lane >> 4) & 1, swz = ((qq >> 1) & 1) * 64;
    const int vrow0 = 4 * hi + qq;
    const int vb0 = KT_BYTES + vrow0 * 128 + ((32 * dblk + 8 * pp) ^ swz);
    const int vb1 = KT_BYTES + vrow0 * 128 + ((64 + 32 * dblk + 8 * pp) ^ swz);
    f32x16 o0 = {}, o1 = {};
    float m_run = -1e30f, l_run = 0.f; const f32x16 zero16 = {};
    const int qa = qw + r32;
#define ATT_QK(N0, N1, t) do { const LAS unsigned char* kp_ = lds + ((t) & 3) * SLOT_BYTES + kbase; \
        _Pragma("unroll") for (int d0 = 0; d0 < 6; ++d0) { const bf16x8 ka_ = *(const LAS bf16x8*)(kp_ + d0 * 2048), kb_ = *(const LAS bf16x8*)(kp_ + d0 * 2048 + 512); \
            if (d0 == 0) { N0 = MFMA32(ka_, qr[0], zero16); N1 = MFMA32(kb_, qr[0], zero16); } else { N0 = MFMA32(ka_, qr[d0], N0); N1 = MFMA32(kb_, qr[d0], N1); } } } while (0)
#define ATT_MASK(N0, N1, t) do { const int kb_ = 64 * (t); if (kb_ + 63 > qw) { _Pragma("unroll") for (int r = 0; r < 16; ++r) { const int ka_ = kb_ + crow(r, hi); \
        if (ka_ > qa) N0[r] = -__builtin_inff(); if (ka_ + 32 > qa) N1[r] = -__builtin_inff(); } } } while (0)
#define ATT_ROWMAX(N0, N1, PM) do { float a_ = max3f(N0[0], N0[1], N1[0]), b_ = max3f(N0[2], N0[3], N1[1]); a_ = max3f(a_, N1[2], N1[3]); \
        _Pragma("unroll") for (int r = 4; r < 16; r += 4) { a_ = max3f(a_, N0[r], N0[r + 1]); b_ = max3f(b_, N0[r + 2], N0[r + 3]); a_ = max3f(a_, N1[r], N1[r + 1]); b_ = max3f(b_, N1[r + 2], N1[r + 3]); } \
        a_ = max3f(a_, b_, b_); auto rr_ = __builtin_amdgcn_permlane32_swap(__float_as_uint(a_), __float_as_uint(a_), false, false); \
        PM = max3f(__uint_as_float(rr_[0]), __uint_as_float(rr_[1]), __uint_as_float(rr_[1])); } while (0)
#define ATT_DECIDE(PM, C0, C1, FORCE) do { if ((FORCE) || __any((PM) > m_run + 8.0f)) { const float mn_ = fmaxf(m_run, (PM)); const float al_ = __builtin_amdgcn_exp2f(m_run - mn_); m_run = mn_; l_run *= al_; \
        if (hi == 0) scr[r32] = al_; asm volatile("s_waitcnt lgkmcnt(0)" ::: "memory"); \
        _Pragma("unroll") for (int a4 = 0; a4 < 4; ++a4) { const f32x4 f_ = *(const LAS f32x4*)(scr + 8 * a4 + 4 * hi); \
            _Pragma("unroll") for (int e = 0; e < 4; ++e) { o0[4 * a4 + e] *= f_[e]; o1[4 * a4 + e] *= f_[e]; } } } } while (0)
#define ATT_SOFTMAX(C0, C1) do { float ps_ = 0.f; \
        _Pragma("unroll") for (int r = 0; r < 16; ++r) { C0[r] = __builtin_amdgcn_exp2f(C0[r] - m_run); C1[r] = __builtin_amdgcn_exp2f(C1[r] - m_run); ps_ += C0[r] + C1[r]; } \
        l_run += ps_; \
        _Pragma("unroll") for (int ks = 0; ks < 4; ++ks) { const f32x16& P_ = (ks < 2) ? C0 : C1; const int bs_ = 8 * (ks & 1); \
            u32x4 w_; w_.x = cvt_pk_bf16(P_[bs_ + 0], P_[bs_ + 1]); w_.y = cvt_pk_bf16(P_[bs_ + 2], P_[bs_ + 3]); w_.z = cvt_pk_bf16(P_[bs_ + 4], P_[bs_ + 5]); w_.w = cvt_pk_bf16(P_[bs_ + 6], P_[bs_ + 7]); \
            pa[ks] = __builtin_bit_cast(bf16x8, w_); } } while (0)
#define ATT_PV(t) do { const LAS unsigned char* vp0_ = lds + ((t) & 3) * SLOT_BYTES + vb0; const LAS unsigned char* vp1_ = lds + ((t) & 3) * SLOT_BYTES + vb1; \
        _Pragma("unroll") for (int ks = 0; ks < 4; ++ks) { \
            const s16x4 a0_ = vtr(vp0_ + ks * 16 * 128), a1_ = vtr(vp0_ + ks * 16 * 128 + 8 * 128), c0_ = vtr(vp1_ + ks * 16 * 128), c1_ = vtr(vp1_ + ks * 16 * 128 + 8 * 128); \
            const bf16x8 vf0_ = {a0_[0], a0_[1], a0_[2], a0_[3], a1_[0], a1_[1], a1_[2], a1_[3]}; const bf16x8 vf1_ = {c0_[0], c0_[1], c0_[2], c0_[3], c1_[0], c1_[1], c1_[2], c1_[3]}; \
            o0 = MFMA32(pa[ks], vf0_, o0); o1 = MFMA32(pa[ks], vf1_, o1); } } while (0)
#define ATT_WB(N) asm volatile("s_waitcnt vmcnt(" #N ") lgkmcnt(0)\n\ts_barrier" ::: "memory")
#define ATT_STEP(C0, C1, PMC, N0, N1, PMN, j, MSK, CONV) do { \
        ATT_DECIDE(PMC, C0, C1, false); \
        ATT_QK(N0, N1, (j) + 1); ATT_SOFTMAX(C0, C1); \
        bool cvi_ = false; \
        if (CONV) { __builtin_amdgcn_sched_barrier(0); const LAS float* cb_ = (const LAS float*)(lds + CONV_OFF + wid * CONV_BYTES); \
            if (CV.cur >= 0) { const ConvItem I_ = cv_setup(CV.cur, kargs()->in[I_WGU], kargs()->in[I_WD], cvws + WS_WGU, cvws + WS_WD); cv_out(I_, cb_, lane); } \
            if (CV.next < CV.end) { const ConvItem I_ = cv_setup(CV.next, kargs()->in[I_WGU], kargs()->in[I_WD], cvws + WS_WGU, cvws + WS_WD); asm volatile("s_waitcnt lgkmcnt(0)" ::: "memory"); \
                cv_dma(I_, lds0 + (unsigned)(CONV_OFF + wid * CONV_BYTES), lane); CV.cur = CV.next; CV.next += 2048; cvi_ = true; } else CV.cur = -1; __builtin_amdgcn_sched_barrier(0); } \
        const bool dma_ = (j) + 3 < NT; if (dma_) ATT_DMA((j) + 3); \
        ATT_PV(j); if (MSK) ATT_MASK(N0, N1, (j) + 1); ATT_ROWMAX(N0, N1, PMN); \
        if (dma_) { if (cvi_) ATT_WB(11); else ATT_WB(3); } else { if (cvi_) ATT_WB(8); else ATT_WB(0); } } while (0)
    bf16x8 pa[4];
    f32x16 sA0, sA1, sB0, sB1; float pmA, pmB;
    ATT_WAITBAR(6);
    ATT_QK(sA0, sA1, 0); ATT_MASK(sA0, sA1, 0); ATT_ROWMAX(sA0, sA1, pmA);
    ATT_WAITBAR(3);
    int j = 0;
    for (; j + 8 <= NT; j += 2) {
        ATT_STEP(sA0, sA1, pmA, sB0, sB1, pmB, j, false, CONV_IN_ATTN);
        ATT_STEP(sB0, sB1, pmB, sA0, sA1, pmA, j + 1, false, false);
    }
    for (; j < NT; j += 2) {
        ATT_STEP(sA0, sA1, pmA, sB0, sB1, pmB, j, true, CONV_IN_ATTN);
        ATT_STEP(sB0, sB1, pmB, sA0, sA1, pmA, j + 1, true, false);
    }
#undef ATT_DMA
#undef ATT_DMA1
#undef ATT_WAITBAR
#undef ATT_QK
#undef ATT_MASK
#undef ATT_ROWMAX
#undef ATT_DECIDE
#undef ATT_SOFTMAX
#undef ATT_PV
#undef ATT_STEP
#undef ATT_WB
    { auto rr = __builtin_amdgcn_permlane32_swap(__float_as_uint(l_run), __float_as_uint(l_run), false, false); l_run = __uint_as_float(rr[0]) + __uint_as_float(rr[1]); }
    if (hi == 0) scr[32 + r32] = 1.0f / l_run;
    asm volatile("s_waitcnt lgkmcnt(0)" ::: "memory");
    bf16_t* Ow = O + ((size_t)(b * SEQ + qw)) * 512 + h * 64 + r32;
#pragma unroll
    for (int a4 = 0; a4 < 4; ++a4) { const f32x4 f = *(const LAS f32x4*)(scr + 32 + 8 * a4 + 4 * hi);
#pragma unroll
        for (int e = 0; e < 4; ++e) { const int r = 4 * a4 + e; const int row = crow(r, hi);
            Ow[(size_t)row * 512] = (bf16_t)(cvt_pk_bf16(o0[r] * f[e], 0.f) & 0xffffu);
            Ow[(size_t)row * 512 + 32] = (bf16_t)(cvt_pk_bf16(o1[r] * f[e], 0.f) & 0xffffu); } }
    __syncthreads();
}
#undef MFMA32
}

struct MixOrder {
    int G, c; unsigned ATT, MIXED, WAO, WPO;
    __device__ __forceinline__ bool next(int i, Unit& u) const {
        const int tile = (i >> 1) * G + c; if (tile >= 256) return false;
        u.pm = tile >> 2; u.pn = tile & 3; u.aux = i & 1; return true;
    }
    __device__ __forceinline__ unsigned a_off(const Unit& u) const { return (u.aux ? MIXED : ATT) + (unsigned)u.pm * (256 * 512 * 2); }
    __device__ __forceinline__ unsigned b_off(const Unit& u) const { return (u.aux ? WPO : WAO) + (unsigned)u.pn * (256 * 512 * 2); }
};
struct EpiMix {
    static constexpr bool PERM = true;
    bf16_t* MIX; const bf16_t* GATES;
    __device__ __forceinline__ void operator()(const f32x4 (&acc)[2][2][4][2], const Unit& u, int wr, int wc, int fr, int fq) const {
        const int row0 = u.pm * 256 + wr * 64 + fr, col0 = u.pn * 256 + wc * 32 + 8 * fq;
#pragma unroll
        for (int ai = 0; ai < 2; ++ai)
#pragma unroll
            for (int m = 0; m < 4; ++m) { const size_t row = (size_t)(row0 + ai * 128 + m * 16);
#pragma unroll
                for (int bj = 0; bj < 2; ++bj) {
                    const u32x4 gw = *(const u32x4*)(GATES + row * 2048 + u.aux * 1024 + col0 + bj * 128);
                    const f32x4 v0 = acc[ai][bj][m][0], v1 = acc[ai][bj][m][1];
                    float r[8] = {v0[0] * bf_lo(gw.x), v0[1] * bf_hi(gw.x), v0[2] * bf_lo(gw.y), v0[3] * bf_hi(gw.y), v1[0] * bf_lo(gw.z), v1[1] * bf_hi(gw.z), v1[2] * bf_lo(gw.w), v1[3] * bf_hi(gw.w)};
                    bf16_t* dst = MIX + row * 1024 + col0 + bj * 128;
                    if (u.aux) { const u32x4 pw = *(const u32x4*)dst;
                        r[0] += bf_lo(pw.x); r[1] += bf_hi(pw.x); r[2] += bf_lo(pw.y); r[3] += bf_hi(pw.y); r[4] += bf_lo(pw.z); r[5] += bf_hi(pw.z); r[6] += bf_lo(pw.w); r[7] += bf_hi(pw.w); }
                    u32x4 w; w.x = cvt_pk_bf16(r[0], r[1]); w.y = cvt_pk_bf16(r[2], r[3]); w.z = cvt_pk_bf16(r[4], r[5]); w.w = cvt_pk_bf16(r[6], r[7]);
                    *(u32x4*)dst = w; } }
    }
};
struct EpiRes {
    static constexpr bool PERM = false;
    const float* base; bf16_t* out;
    __device__ __forceinline__ void operator()(const f32x4 (&acc)[2][2][4][2], const Unit& u, int wr, int wc, int fr, int fq) const {
        const int row0 = u.pm * 256 + wr * 64 + fr, col0 = u.pn * 256 + wc * 32 + 4 * fq;
#pragma unroll
        for (int ai = 0; ai < 2; ++ai)
#pragma unroll
            for (int m = 0; m < 4; ++m) { const size_t off = (size_t)(row0 + ai * 128 + m * 16) * DM + col0;
#pragma unroll
                for (int bj = 0; bj < 2; ++bj)
#pragma unroll
                    for (int n = 0; n < 2; ++n) { const f32x4 r = *(const f32x4*)(base + off + bj * 128 + n * 16) + acc[ai][bj][m][n]; u32x2 w; w.x = cvt_pk_bf16(r[0], r[1]); w.y = cvt_pk_bf16(r[2], r[3]); *(u32x2*)(out + off + bj * 128 + n * 16) = w; } }
    }
};

constexpr int WR_PITCH = 1028;
constexpr int R_WR_OFF = 0, R_PART_OFF = 32 * WR_PITCH * 4, R_SSQ_OFF = R_PART_OFF + 2 * 64 * 33 * 4, R_CNT_OFF = R_SSQ_OFF + 2 * 64 * 4, R_BASE_OFF = R_CNT_OFF + 128, R_END = R_BASE_OFF + 128;
static_assert(R_END <= TILE_E_OFF, "router LDS map");
__device__ __forceinline__ void p7_router(const Frame& F) {
    const int tid_l = tid_local(), lane_l = tid_l & 63; (void)tid_l; (void)lane_l;
    const KArgs a = kargs();
    LAS float* WR = (LAS float*)(F.lds + R_WR_OFF); LAS float* PART = (LAS float*)(F.lds + R_PART_OFF); LAS float* SSQP = (LAS float*)(F.lds + R_SSQ_OFF);
    LAS int* CNT = (LAS int*)(F.lds + R_CNT_OFF); LAS int* BASE = (LAS int*)(F.lds + R_BASE_OFF);
    const int tid = tid_l, lane = lane_l, wave = F.wave;
    const float* wr = a->in[I_WR]; const float* gf = a->in[I_GFFN];
    for (int i = tid; i < 1024 * 32; i += 512) { const int k = i >> 5, e = i & 31; WR[e * WR_PITCH + k] = wr[i] * gf[k]; }
    if (tid < 32) CNT[tid] = 0;
    __syncthreads();
    int* RE = (int*)(F.ws + WS_ROUTE); int* RP = RE + T * 4; float* RG = (float*)(RP + T * 4); float* RS = RG + T * 4;
    unsigned* gcnt = F.ctl + CW_CNT;
    const bf16_t* X1 = (const bf16_t*)(F.ws + WS_X1B);
    for (int blk = F.vcu; blk < T / 64; blk += F.G) {
        const int tb = blk * 64;
        {
            const int tg = wave & 3, kh = wave >> 2, r = lane & 15, kq = lane >> 4;
            const bf16_t* xp = X1 + (size_t)(tb + 16 * tg + r) * DM + 512 * kh + 4 * kq;
            const LAS float* w0 = WR + (lane & 15) * WR_PITCH + 512 * kh + 4 * kq; const LAS float* w1 = w0 + 16 * WR_PITCH;
            f32x4 acc0 = {0.f, 0.f, 0.f, 0.f}, acc1 = {0.f, 0.f, 0.f, 0.f}; float ss = 0.f;
#pragma unroll 4
            for (int i = 0; i < 32; ++i) {
                const u32x2 xw = *(const u32x2*)(xp + 16 * i); const f32x4 xv = {bf_lo(xw.x), bf_hi(xw.x), bf_lo(xw.y), bf_hi(xw.y)};
                const f32x4 b0 = *(const LAS f32x4*)(w0 + 16 * i), b1 = *(const LAS f32x4*)(w1 + 16 * i);
                ss += (xv[0] * xv[0] + xv[1] * xv[1]) + (xv[2] * xv[2] + xv[3] * xv[3]);
#pragma unroll
                for (int j = 0; j < 4; ++j) { acc0 = __builtin_amdgcn_mfma_f32_16x16x4f32(xv[j], b0[j], acc0, 0, 0, 0); acc1 = __builtin_amdgcn_mfma_f32_16x16x4f32(xv[j], b1[j], acc1, 0, 0, 0); }
            }
            ss += __shfl_xor(ss, 16); ss += __shfl_xor(ss, 32);
            if (kq == 0) SSQP[kh * 64 + 16 * tg + r] = ss;
#pragma unroll
            for (int q = 0; q < 4; ++q) { const int tok = 16 * tg + 4 * kq + q; PART[(kh * 64 + tok) * 33 + (lane & 15)] = acc0[q]; PART[(kh * 64 + tok) * 33 + 16 + (lane & 15)] = acc1[q]; }
        }
        __syncthreads();
        int te[4] = {0, 0, 0, 0}, lp[4] = {0, 0, 0, 0}; float tv[4] = {-3e38f, -3e38f, -3e38f, -3e38f}; float rstd = 0.f;
        if (tid < 64) {
            const float ssq = SSQP[tid] + SSQP[64 + tid]; rstd = 1.0f / sqrtf(ssq * (1.f / DM) + EPS);
            const float* br = a->in[I_BR];
#pragma unroll
            for (int e = 0; e < 32; ++e) {
                float v = (PART[tid * 33 + e] + PART[(64 + tid) * 33 + e]) * rstd + br[e]; int id = e;
#pragma unroll
                for (int s = 0; s < 4; ++s) { const bool gt = v > tv[s]; const float ov = tv[s]; const int oi = te[s]; tv[s] = gt ? v : ov; te[s] = gt ? id : oi; v = gt ? ov : v; id = gt ? oi : id; }
            }
#pragma unroll
            for (int s = 0; s < 4; ++s) lp[s] = __hip_atomic_fetch_add(&CNT[te[s]], 1, __ATOMIC_RELAXED, __HIP_MEMORY_SCOPE_WORKGROUP);
        }
        __syncthreads();
        if (tid < 32) { const int c = CNT[tid]; BASE[tid] = c ? (int)atomicAdd(gcnt + tid, (unsigned)c) : 0; }
        __syncthreads();
        if (tid < 64) {
            const int t = tb + tid;
            const float e1 = __expf(tv[1] - tv[0]), e2 = __expf(tv[2] - tv[0]), e3 = __expf(tv[3] - tv[0]); const float inv = 1.0f / (1.0f + e1 + e2 + e3);
            const float gts[4] = {inv, e1 * inv, e2 * inv, e3 * inv};
#pragma unroll
            for (int s = 0; s < 4; ++s) { RE[t * 4 + s] = te[s]; RP[t * 4 + s] = BASE[te[s]] + lp[s]; RG[t * 4 + s] = gts[s]; }
            RS[t] = rstd;
        }
        __syncthreads();
        if (tid < 32) CNT[tid] = 0;
        __syncthreads();
    }
}

__device__ __forceinline__ int build_tiles(const Frame& F) {
    const int tid_l = tid_local(), lane_l = tid_l & 63; (void)tid_l; (void)lane_l;
    LAS int* TB = (LAS int*)(F.lds + TILE_E_OFF); LAS int* TE = TB + 64;
    if (tid_l == 0) { int acc = 0; for (int e = 0; e < NEXP; ++e) { TB[e] = acc; const int c = (int)__hip_atomic_load(F.ctl + CW_CNT + e, RLX_AGENT); acc += (c + 255) >> 8; } TB[NEXP] = acc; }
    __syncthreads();
    if (tid_l < NEXP) { for (int t = TB[tid_l]; t < TB[tid_l + 1]; ++t) TE[t] = tid_l; }
    __syncthreads();
    return TB[NEXP];
}

__device__ __forceinline__ void p8_dispatch(const Frame& F) {
    const int tid_l = tid_local(), lane_l = tid_l & 63; (void)tid_l; (void)lane_l;
    const KArgs a = kargs();
    (void)build_tiles(F);
    const LAS int* TB = (const LAS int*)(F.lds + TILE_E_OFF);
    const int gw = F.vcu * NWAVES + F.wave, NGW = F.G * NWAVES, lane = lane_l;
    const int* RE = (const int*)(F.ws + WS_ROUTE); const int* RP = RE + T * 4; const float* RS = (const float*)(RP + T * 4) + T * 4; int* SL = (int*)(RS + T);
    const bf16_t* X1 = (const bf16_t*)(F.ws + WS_X1B); const float* gf = a->in[I_GFFN]; unsigned char* XS = F.ws + WS_XS2;
    f32x4 g[2][2];
#pragma unroll
    for (int j = 0; j < 2; ++j) { g[j][0] = *(const f32x4*)(gf + 512 * j + 8 * lane); g[j][1] = *(const f32x4*)(gf + 512 * j + 8 * lane + 4); }
    for (int t = gw; t < T; t += NGW) {
        const float rstd = RS[t];
        u32x2 w[2];
#pragma unroll
        for (int j = 0; j < 2; ++j) { const u32x4 xw = *(const u32x4*)(X1 + (size_t)t * DM + 512 * j + 8 * lane);
            const f32x4 v0 = (f32x4){bf_lo(xw.x), bf_hi(xw.x), bf_lo(xw.y), bf_hi(xw.y)} * g[j][0] * rstd, v1 = (f32x4){bf_lo(xw.z), bf_hi(xw.z), bf_lo(xw.w), bf_hi(xw.w)} * g[j][1] * rstd;
            w[j] = cvt8_fp8(v0, v1, 8.0f); }
#pragma unroll
        for (int s = 0; s < 4; ++s) { const int e = RE[t * 4 + s], slot = TB[e] * 256 + RP[t * 4 + s];
            if (lane == 0) SL[t * 4 + s] = slot;
            unsigned char* dst = XS + (size_t)slot * DM + 8 * lane;
            *(u32x2*)dst = w[0]; *(u32x2*)(dst + 512) = w[1]; }
    }
}

struct MoeOrder {
    int G, c, ntn_shift, total; const LAS int* TE; unsigned A, Bw, bexp, btile; int xbase, xcount;
    __device__ __forceinline__ void init_xcd(const LAS int* TB) {
        if (G == 256) { const int x = c >> 5; xbase = __builtin_amdgcn_readfirstlane(TB[4 * x]); xcount = (__builtin_amdgcn_readfirstlane(TB[4 * x + 4]) - xbase) << ntn_shift; } else { xbase = -1; xcount = 0; }
    }
    __device__ __forceinline__ bool next(int i, Unit& u) const {
        if (xbase >= 0) { const int L = i * 32 + (c & 31); if (L >= xcount) return false;
            u.pm = xbase + (L >> ntn_shift); u.pn = L & ((1 << ntn_shift) - 1); u.aux = __builtin_amdgcn_readfirstlane(TE[u.pm]); return true; }
        const int L = i * G + c; if (L >= total) return false;
        u.pm = L >> ntn_shift; u.pn = L & ((1 << ntn_shift) - 1); u.aux = __builtin_amdgcn_readfirstlane(TE[u.pm]); return true;
    }
    __device__ __forceinline__ unsigned a_off(const Unit& u) const { return A + (unsigned)u.pm * (256 * 1024); }
    __device__ __forceinline__ unsigned b_off(const Unit& u) const { return Bw + (unsigned)u.aux * bexp + (unsigned)u.pn * btile; }
};
struct EpiSwiglu {
    static constexpr bool PERM = true;
    unsigned char* ACT; const float* bgu;
    __device__ __forceinline__ void operator()(const f32x4 (&acc)[2][2][4][2], const Unit& u, int wr, int wc, int fr, int fq) const {
        const int row0 = u.pm * 256 + wr * 64 + fr, j0 = u.pn * 128 + wc * 32 + 8 * fq;
        const float* bb = bgu + (size_t)u.aux * 2048 + j0;
        unsigned char* dst0 = ACT + (size_t)row0 * DEXP + j0;
#pragma unroll
        for (int ai = 0; ai < 2; ++ai)
#pragma unroll
            for (int m = 0; m < 4; ++m) {
#pragma unroll
                for (int n = 0; n < 2; ++n) {
                    asm volatile("" : "+v"(bb));
                    const f32x4 g = acc[ai][0][m][n] + *(const f32x4*)(bb + 4 * n), up = acc[ai][1][m][n] + *(const f32x4*)(bb + 1024 + 4 * n);
                    float r[4];
#pragma unroll
                    for (int e = 0; e < 4; ++e) { const float gg = fminf(g[e], 7.0f), uu = fminf(fmaxf(up[e], -7.0f), 7.0f); r[e] = (uu + 1.0f) * gg * fast_sigmoid(1.702f * gg) * 8.0f; }
                    int w = __builtin_amdgcn_cvt_pk_fp8_f32(r[0], r[1], 0, false); w = __builtin_amdgcn_cvt_pk_fp8_f32(r[2], r[3], w, true);
                    *(int*)(dst0 + (size_t)(ai * 128 + m * 16) * DEXP + 4 * n) = w;
                }
                asm volatile("" ::: "memory");
            }
    }
};
struct EpiDown {
    static constexpr bool PERM = true;
    unsigned char* Y; const float* bd;
    __device__ __forceinline__ void operator()(const f32x4 (&acc)[2][2][4][2], const Unit& u, int wr, int wc, int fr, int fq) const {
        const int row0 = u.pm * 256 + wr * 64 + fr, col0 = u.pn * 256 + wc * 32 + 8 * fq;
        const float* bb = bd + (size_t)u.aux * DM + col0;
#pragma unroll
        for (int ai = 0; ai < 2; ++ai)
#pragma unroll
            for (int m = 0; m < 4; ++m) { unsigned char* rowp = Y + (size_t)(row0 + ai * 128 + m * 16) * DM + col0;
                asm volatile("" : "+v"(bb));
#pragma unroll
                for (int bj = 0; bj < 2; ++bj) { const f32x4 v0 = acc[ai][bj][m][0] + *(const f32x4*)(bb + bj * 128), v1 = acc[ai][bj][m][1] + *(const f32x4*)(bb + bj * 128 + 4);
                    *(u32x2*)(rowp + bj * 128) = cvt8_fp8(v0, v1, 8.0f); } asm volatile("" ::: "memory"); }
    }
};

__device__ __forceinline__ void p11_combine(const Frame& F) {
    const int tid_l = tid_local(), lane_l = tid_l & 63; (void)tid_l; (void)lane_l;
    const KArgs a = kargs();
    const int gw = F.vcu * NWAVES + F.wave, NGW = F.G * NWAVES, lane = lane_l;
    const int* RE = (const int*)(F.ws + WS_ROUTE); const float* RG = (const float*)(RE + T * 8); const int* SL = (const int*)(RG + T * 4 + T);
    const unsigned char* Y = F.ws + WS_XS; bf16_t* HP = (bf16_t*)(F.ws + WS_HN); const bf16_t* X1 = (const bf16_t*)(F.ws + WS_X1B); bf16_t* X2 = (bf16_t*)(F.ws + WS_X2B); const float* gp = a->in[I_GPLE];
    f32x4 g[2][2];
#pragma unroll
    for (int j = 0; j < 2; ++j) { g[j][0] = *(const f32x4*)(gp + 512 * j + 8 * lane); g[j][1] = *(const f32x4*)(gp + 512 * j + 8 * lane + 4); }
    for (int t = gw; t < T; t += NGW) {
        f32x4 v[2][2];
#pragma unroll
        for (int j = 0; j < 2; ++j) { const u32x4 xw = *(const u32x4*)(X1 + (size_t)t * DM + 512 * j + 8 * lane); v[j][0] = (f32x4){bf_lo(xw.x), bf_hi(xw.x), bf_lo(xw.y), bf_hi(xw.y)}; v[j][1] = (f32x4){bf_lo(xw.z), bf_hi(xw.z), bf_lo(xw.w), bf_hi(xw.w)}; }
#pragma unroll
        for (int s = 0; s < 4; ++s) { const int slot = SL[t * 4 + s]; const float gt = RG[t * 4 + s] * 0.125f;
#pragma unroll
            for (int j = 0; j < 2; ++j) { const u32x2 y = *(const u32x2*)(Y + (size_t)slot * DM + 512 * j + 8 * lane);
                const f32x2 a0 = __builtin_amdgcn_cvt_pk_f32_fp8((int)y.x, false), a1 = __builtin_amdgcn_cvt_pk_f32_fp8((int)y.x, true), b0 = __builtin_amdgcn_cvt_pk_f32_fp8((int)y.y, false), b1 = __builtin_amdgcn_cvt_pk_f32_fp8((int)y.y, true);
                v[j][0] += (f32x4){a0[0], a0[1], a1[0], a1[1]} * gt; v[j][1] += (f32x4){b0[0], b0[1], b1[0], b1[1]} * gt; } }
        float ss = 0.f;
#pragma unroll
        for (int j = 0; j < 2; ++j)
#pragma unroll
            for (int n = 0; n < 2; ++n) { const f32x4 q = v[j][n]; ss += (q[0] * q[0] + q[1] * q[1]) + (q[2] * q[2] + q[3] * q[3]); u32x2 w; w.x = cvt_pk_bf16(q[0], q[1]); w.y = cvt_pk_bf16(q[2], q[3]); *(u32x2*)(X2 + (size_t)t * DM + 512 * j + 8 * lane + 4 * n) = w; }
        const float rstd = 1.0f / sqrtf(wave_sum(ss) * (1.f / DM) + EPS);
#pragma unroll
        for (int j = 0; j < 2; ++j) { const f32x4 q0 = v[j][0] * g[j][0] * rstd, q1 = v[j][1] * g[j][1] * rstd;
            u32x4 w; w.x = cvt_pk_bf16(q0[0], q0[1]); w.y = cvt_pk_bf16(q0[2], q0[3]); w.z = cvt_pk_bf16(q1[0], q1[1]); w.w = cvt_pk_bf16(q1[2], q1[3]);
            *(u32x4*)(HP + (size_t)t * DM + 512 * j + 8 * lane) = w; }
    }
}
struct EpiPle {
    static constexpr bool PERM = false;
    float* out; const bf16_t* E; const bf16_t* X2;
    __device__ __forceinline__ void operator()(const f32x4 (&acc)[2][2][4][2], const Unit& u, int wr, int wc, int fr, int fq) const {
        const int row0 = u.pm * 256 + wr * 64 + fr, col0 = u.pn * 256 + wc * 32 + 4 * fq;
#pragma unroll
        for (int ai = 0; ai < 2; ++ai)
#pragma unroll
            for (int m = 0; m < 4; ++m) { const size_t off = (size_t)(row0 + ai * 128 + m * 16) * DM + col0;
#pragma unroll
                for (int bj = 0; bj < 2; ++bj)
#pragma unroll
                    for (int n = 0; n < 2; ++n) { const size_t o = off + bj * 128 + n * 16; const u32x2 ev = *(const u32x2*)(E + o); const f32x4 a4 = acc[ai][bj][m][n];
                        const u32x2 xw = *(const u32x2*)(X2 + o); f32x4 r = {bf_lo(xw.x), bf_hi(xw.x), bf_lo(xw.y), bf_hi(xw.y)};
                        r[0] += fast_sigmoid(a4[0]) * bf_lo(ev.x); r[1] += fast_sigmoid(a4[1]) * bf_hi(ev.x); r[2] += fast_sigmoid(a4[2]) * bf_lo(ev.y); r[3] += fast_sigmoid(a4[3]) * bf_hi(ev.y);
                        *(f32x4*)(out + o) = r; } }
    }
};

constexpr int N_PHASES = 13;
__global__ void __launch_bounds__(NWAVES * 64, 2) fwd_kernel(Args args) {
    extern __shared__ __attribute__((aligned(16))) unsigned char lds_raw[];
    Frame F;
    F.lds = (LAS unsigned char*)lds_raw; F.MISC = (volatile LAS unsigned*)(F.lds + MISC_OFF);
    F.wave = __builtin_amdgcn_readfirstlane(threadIdx.x >> 6);
    F.G = gridDim.x; { const int bx = blockIdx.x; F.vcu = (F.G % 8 == 0) ? (bx % 8) * (F.G / 8) + bx / 8 : bx; }
    { const KArgs ka = kargs(); F.out = ka->out; F.ws = ka->ws; F.ctl = (unsigned*)(ka->ws + WS_CTL); }
    { const int t0_ = tid_local(); if (t0_ < 32) F.MISC[t0_] = 0u; }
    __syncthreads();
    int lo, hi; { const KArgs ka = kargs(); lo = ka->ph_lo; hi = ka->ph_hi; }
    const bool multi = (hi - lo) > 1;
    XcdBarrier bar; bar.bar = F.ctl + CW_BAR; bar.x = 0; bar.st = nullptr;
    if (multi) bar = xcd_barrier_post(F.ctl + CW_BAR, F.MISC);
#ifndef PH_MASK
#define PH_MASK 0x1fff
#endif
#define IN(k) ((((PH_MASK) >> (k)) & 1) && lo <= (k) && (k) < hi)
#define SEAM(k) do { if (IN(k) && IN((k) + 1)) xcd_barrier(bar); } while (0)
    unsigned char* ws = F.ws;
    LAS unsigned char* ring = F.lds;
    const __amdgpu_buffer_rsrc_t rsrc = __builtin_amdgcn_make_buffer_rsrc((void*)ws, 0, (int)WS_END, 0x00020000);

    if (IN(0)) { p0_prologue(F); } SEAM(0);

    if (IN(1)) {
        if (GATES_FP8 && !P1_FP8) {
          { DenseOrder S; S.init(64, 8, F.G, (int)blockIdx.x, WS_HN8, 512, WS_WIN8 + (size_t)1024 * 1024, 512);
            EpiProj E{(bf16_t*)(ws + WS_PROJ), (bf16_t*)(ws + WS_GATES), 4};
            pg8::gemm_phase<EpiProj, DenseOrder, true, true, true>(ring, rsrc, pg8::Shape{1024, 1024, 1024, 0x7c7c7c7c, 0x7c7c7c7c}, S, E); }
          { DenseOrder S; S.init(64, 4, F.G, (int)blockIdx.x, WS_HN, 1024, WS_WIN, 1024);
            EpiProj E{(bf16_t*)(ws + WS_PROJ), (bf16_t*)(ws + WS_GATES), 0};
            pg8::gemm_phase<EpiProj, DenseOrder, true, true>(ring, rsrc, pg8::Shape{2048, 2048, 2048, 0, 0}, S, E); }
        } else
        { DenseOrder S; S.init(64, 12, F.G, (int)blockIdx.x, WS_HN, P1_FP8 ? 512 : 1024, WS_WIN, P1_FP8 ? 512 : 1024);
          EpiProj E{(bf16_t*)(ws + WS_PROJ), (bf16_t*)(ws + WS_GATES), 0};
          if (P1_FP8) pg8::gemm_phase<EpiProj, DenseOrder, true, true, true>(ring, rsrc, pg8::Shape{1024, 1024, 1024, 0x7c7c7c7c, 0x7c7c7c7c}, S, E);
          else pg8::gemm_phase<EpiProj, DenseOrder, true, true>(ring, rsrc, pg8::Shape{2048, 2048, 2048, 0, 0}, S, E); }
        { DenseOrder S; S.init(64, 4, F.G, (int)blockIdx.x, WS_PB, 256, WS_WPLE, 256);
          EpiBf16 E{(bf16_t*)(ws + WS_E), 1024};
          pg8::gemm_phase<EpiBf16, DenseOrder, true, true>(ring, rsrc, pg8::Shape{512, 512, 512, 0, 0}, S, E); }
    } SEAM(1);

    if (IN(2)) { p2_rows(F); } SEAM(2);

    if (IN(3)) {
#ifndef P3M
#define P3M 7
#endif
        if (P3M & 1) { DenseOrder S; S.init(64, 4, F.G, (int)blockIdx.x, WS_A2 + 512, 512, WS_WKV, 256);
          EpiKV E{(bf16_t*)(ws + WS_K), (bf16_t*)(ws + WS_V), kargs()->in[I_GKNOPE]};
          pg8::gemm_phase<EpiKV, DenseOrder, true, true>(ring, rsrc, pg8::Shape{512, 1024, 512, 0, 0}, S, E); }
        if (P3M & 2) { DenseOrder S; S.init(64, 3, F.G, (int)blockIdx.x, WS_A2, 512, WS_WQ, 256);
          EpiQ E{(bf16_t*)(ws + WS_Q), (float*)(ws + WS_SSQ), (const float*)(ws + WS_COS), (const float*)(ws + WS_SIN), kargs()->in[I_GQHEAD]};
          pg8::gemm_phase<EpiQ, DenseOrder, true, true>(ring, rsrc, pg8::Shape{512, 1024, 512, 0, 0}, S, E); }
        if (P3M & 4) { DenseOrder S; S.init(64, 2, F.G, (int)blockIdx.x, WS_POOLED, 512, WS_WPOOL, 256, 512);
          EpiBf16 E{(bf16_t*)(ws + WS_MIXED), 512};
          pg8::gemm_phase<EpiBf16, DenseOrder, true, true>(ring, rsrc, pg8::Shape{512, 1024, 512, 0, 0}, S, E); }
    } SEAM(3);

    if (IN(4)) {
        u32x4 srd; { const unsigned long wb = (unsigned long)ws; srd.x = (unsigned)__builtin_amdgcn_readfirstlane((int)(unsigned)wb); srd.y = (unsigned)__builtin_amdgcn_readfirstlane((int)(unsigned)(wb >> 32)); srd.z = (unsigned)WS_END; srd.w = 0x00020000u; }
        att::ConvState CV; CV.next = __builtin_amdgcn_readfirstlane(F.vcu * NWAVES + F.wave); CV.end = CONV_IN_ATTN ? att::CV_ITEMS : 0; CV.cur = -1;
        for (int it = F.vcu; it < 256; it += F.G) {
            const int bh = it >> 3, pr = it & 7;
            att::attn_unit(ring, srd, CV, ws, bh, 15 - pr, (const bf16_t*)(ws + WS_Q), (unsigned)WS_K, (unsigned)WS_V, (const float*)(ws + WS_SSQ), (bf16_t*)(ws + WS_ATT));
            att::attn_unit(ring, srd, CV, ws, bh, pr, (const bf16_t*)(ws + WS_Q), (unsigned)WS_K, (unsigned)WS_V, (const float*)(ws + WS_SSQ), (bf16_t*)(ws + WS_ATT));
        }
        { const LAS float* cb = (const LAS float*)(F.lds + att::CONV_OFF + F.wave * att::CONV_BYTES);
          const unsigned cbaddr = (unsigned)__builtin_amdgcn_readfirstlane((int)(unsigned)(unsigned long)(F.lds + att::CONV_OFF + F.wave * att::CONV_BYTES));
          const int lane_l = tid_local() & 63;
          while (CV.cur >= 0 || CV.next < CV.end) {
            if (CV.cur >= 0) { asm volatile("s_waitcnt vmcnt(0)" ::: "memory"); const att::ConvItem I = att::cv_setup(CV.cur, kargs()->in[I_WGU], kargs()->in[I_WD], ws + WS_WGU, ws + WS_WD); att::cv_out(I, cb, lane_l); }
            if (CV.next < CV.end) { const att::ConvItem I = att::cv_setup(CV.next, kargs()->in[I_WGU], kargs()->in[I_WD], ws + WS_WGU, ws + WS_WD); asm volatile("s_waitcnt lgkmcnt(0)" ::: "memory"); att::cv_dma(I, cbaddr, lane_l); CV.cur = CV.next; CV.next += 2048; } else CV.cur = -1;
          } }
    } SEAM(4);

    if (IN(5)) {
        MixOrder S{F.G, F.vcu, (unsigned)WS_ATT, (unsigned)WS_MIXED, (unsigned)WS_WAO, (unsigned)WS_WPO};
        EpiMix E{(bf16_t*)(ws + WS_MIX), (const bf16_t*)(ws + WS_GATES)};
        pg8::gemm_phase<EpiMix, MixOrder, true, true>(ring, rsrc, pg8::Shape{1024, 1024, 1024, 0, 0}, S, E);
    } SEAM(5);

    if (IN(6)) {
        DenseOrder S; S.init(64, 4, F.G, (int)blockIdx.x, WS_MIX, 1024, WS_WO, 1024);
        EpiRes E{kargs()->in[I_X], (bf16_t*)(ws + WS_X1B)};
        pg8::gemm_phase<EpiRes, DenseOrder, true, true>(ring, rsrc, pg8::Shape{2048, 2048, 2048, 0, 0}, S, E);
    } SEAM(6);

    if (IN(7)) { p7_router(F); } SEAM(7);

    if (IN(8)) { p8_dispatch(F); } SEAM(8);

    if (IN(9)) {
        const int TM = build_tiles(F);
        MoeOrder S{F.G, F.vcu, 3, TM * 8, (const LAS int*)(F.lds + TILE_E_OFF) + 64, (unsigned)WS_XS2, (unsigned)WS_WGU, 2048u * 1024u, 256u * 1024u, 0, 0}; S.init_xcd((const LAS int*)(F.lds + TILE_E_OFF));
        EpiSwiglu E{ws + WS_ACT, kargs()->in[I_BGU]};
        pg8::gemm_phase<EpiSwiglu, MoeOrder, true, true, true>(ring, rsrc, pg8::Shape{1024, 1024, 1024, 0x7c7c7c7c, 0x7c7c7c7c}, S, E);
    } SEAM(9);

    if (IN(10)) {
        const int TM = build_tiles(F);
        MoeOrder S{F.G, F.vcu, 2, TM * 4, (const LAS int*)(F.lds + TILE_E_OFF) + 64, (unsigned)WS_ACT, (unsigned)WS_WD, 1024u * 1024u, 256u * 1024u, 0, 0}; S.init_xcd((const LAS int*)(F.lds + TILE_E_OFF));
        EpiDown E{ws + WS_XS, kargs()->in[I_BD]};
        pg8::gemm_phase<EpiDown, MoeOrder, true, true, true>(ring, rsrc, pg8::Shape{1024, 1024, 1024, 0x7c7c7c7c, 0x7c7c7c7c}, S, E);
    } SEAM(10);

    if (IN(11)) { p11_combine(F); } SEAM(11);

    if (IN(12)) {
        DenseOrder S; S.init(64, 4, F.G, (int)blockIdx.x, WS_HN, 1024, WS_WPG, 1024);
        EpiPle E{F.out, (const bf16_t*)(ws + WS_E), (const bf16_t*)(ws + WS_X2B)};
        pg8::gemm_phase<EpiPle, DenseOrder, true, true>(ring, rsrc, pg8::Shape{2048, 2048, 2048, 0, 0}, S, E);
    }
#undef IN
#undef SEAM
}

extern "C" void kernel_launch(void* const* d_in, const int* in_sizes, int n_in, void* d_out, int out_size, void* d_ws, size_t ws_size, hipStream_t stream) {
    static int grid = 0;
    if (grid == 0) {
        if (n_in != 27 || out_size != T * DM || ws_size < WS_END) { fprintf(stderr, "kernel_launch: unexpected shapes (n_in %d, out %d, ws %zu)\n", n_in, out_size, ws_size); grid = -1; return; }
        int dev = 0, cus = 0;
        if (hipGetDevice(&dev) != hipSuccess || hipDeviceGetAttribute(&cus, hipDeviceAttributeMultiprocessorCount, dev) != hipSuccess) { grid = -1; return; }
        if (hipFuncSetAttribute((const void*)fwd_kernel, hipFuncAttributeMaxDynamicSharedMemorySize, LDS_BYTES) != hipSuccess) { fprintf(stderr, "kernel_launch: hipFuncSetAttribute failed\n"); grid = -1; return; }
        int per_cu = 0;
        if (hipOccupancyMaxActiveBlocksPerMultiprocessor(&per_cu, (const void*)fwd_kernel, NWAVES * 64, LDS_BYTES) != hipSuccess || per_cu < 1) fprintf(stderr, "kernel_launch: occupancy query says %d\n", per_cu);
        (void)hipGetLastError();
        grid = cus;
    }
    if (grid < 0) return;
    (void)hipMemsetAsync((char*)d_ws + WS_CTL, 0, CTL_ZERO_BYTES, stream);
    Args a{};
    for (int i = 0; i < 27; ++i) a.in[i] = (const float*)d_in[i];
    a.out = (float*)d_out; a.ws = (unsigned char*)d_ws;
#ifndef DUP_PHASE
    a.ph_lo = 0; a.ph_hi = N_PHASES; hipLaunchKernelGGL(fwd_kernel, dim3(grid), dim3(NWAVES * 64), LDS_BYTES, stream, a);
#else
    a.ph_lo = 0; a.ph_hi = DUP_PHASE + 1; hipLaunchKernelGGL(fwd_kernel, dim3(grid), dim3(NWAVES * 64), LDS_BYTES, stream, a);
    (void)hipMemsetAsync((char*)d_ws + WS_CTL + CW_BAR * 4, 0, XCD_BAR_WORDS * 4, stream);
    a.ph_lo = DUP_PHASE; a.ph_hi = N_PHASES; hipLaunchKernelGGL(fwd_kernel, dim3(grid), dim3(NWAVES * 64), LDS_BYTES, stream, a);
#endif
}
```

```cpp
#include <hip/hip_runtime.h>
#include <cstdio>
#include <cstdint>

#define LAS __attribute__((address_space(3)))
#define GAS __attribute__((address_space(1)))
typedef unsigned short bf16_t;
typedef short bf16x8 __attribute__((ext_vector_type(8)));
typedef short s16x4 __attribute__((ext_vector_type(4)));
typedef float f32x4 __attribute__((ext_vector_type(4)));
typedef float f32x2 __attribute__((ext_vector_type(2)));
typedef float f32x16 __attribute__((ext_vector_type(16)));
typedef unsigned u32x4 __attribute__((ext_vector_type(4)));
typedef unsigned u32x2 __attribute__((ext_vector_type(2)));

constexpr int NB = 4, SEQ = 4096, T = NB * SEQ, DM = 1024, NH = 8, DK = 96, DV = 64;
constexpr int NEXP = 32, TOPK = 4, DEXP = 1024, PLE = 256;
constexpr float EPS = 1e-6f;
constexpr int XS_ROWS = T * TOPK + NEXP * 256;

typedef __bf16 bf16x2_t __attribute__((ext_vector_type(2)));
__device__ __forceinline__ unsigned cvt_pk_bf16(float lo, float hi) { f32x2 v = {lo, hi}; return __builtin_bit_cast(unsigned, __builtin_convertvector(v, bf16x2_t)); }
__device__ __forceinline__ u32x2 cvt8_fp8(const f32x4 a, const f32x4 b, float sc) {
    int w0 = __builtin_amdgcn_cvt_pk_fp8_f32(a[0] * sc, a[1] * sc, 0, false); w0 = __builtin_amdgcn_cvt_pk_fp8_f32(a[2] * sc, a[3] * sc, w0, true);
    int w1 = __builtin_amdgcn_cvt_pk_fp8_f32(b[0] * sc, b[1] * sc, 0, false); w1 = __builtin_amdgcn_cvt_pk_fp8_f32(b[2] * sc, b[3] * sc, w1, true);
    u32x2 r; r.x = (unsigned)w0; r.y = (unsigned)w1; return r;
}
__device__ __forceinline__ float bf_lo(unsigned w) { return __uint_as_float(w << 16); }
__device__ __forceinline__ float bf_hi(unsigned w) { return __uint_as_float(w & 0xffff0000u); }
__device__ __forceinline__ float bf1(bf16_t h) { return __uint_as_float(((unsigned)h) << 16); }
__device__ __forceinline__ float fast_sigmoid(float v) { return __builtin_amdgcn_rcpf(1.0f + __builtin_amdgcn_exp2f(-1.4426950408889634f * v)); }
__device__ __forceinline__ int lane_id() { return (int)__builtin_amdgcn_mbcnt_hi(~0u, __builtin_amdgcn_mbcnt_lo(~0u, 0u)); }
__device__ __forceinline__ int tid_local() { int t = threadIdx.x; asm volatile("" : "+v"(t)); return t; }
__device__ __forceinline__ float wave_sum(float v) {
#pragma unroll
    for (int o = 1; o < 64; o <<= 1) v += __shfl_xor(v, o);
    return v;
}

namespace pg8 {
constexpr int BM = 256, BK = 64, HALF = 128, HTB = HALF * BK * 2, STAGE_BYTES = 8 * HTB;
__host__ __device__ __forceinline__ int lds_byte(int r, int c) { const int st = (r >> 4) * 2 + (c >> 5), rr = r & 15, cc = c & 31, ob = rr * 64 + cc * 2; return st * 1024 + (ob ^ (((ob >> 9) & 1) << 5)); }
__host__ __device__ __forceinline__ void stage_rc(int b, int& R, int& C) { const int st = b / 1024, sb = b % 1024, swz = sb ^ (((sb >> 9) & 1) << 5); R = (st >> 1) * 16 + swz / 64; C = (st & 1) * 32 + (swz % 64) / 2; }
__host__ __device__ __forceinline__ int perm32(int rho) { const int n = rho >> 4, i = rho & 15; return 8 * (i >> 2) + 4 * n + (i & 3); }

struct Unit { int pm, pn, aux; };
struct Shape { int Kb, lda, ldb, sw, sa; };
typedef int v8i_t __attribute__((ext_vector_type(8))); typedef int v4i_t __attribute__((ext_vector_type(4)));

template <class Epi, class Sched, bool ALIGN_EPI, bool SP2, bool MX = false>
__device__ __forceinline__ void gemm_phase(LAS unsigned char* lds, const __amdgpu_buffer_rsrc_t rsrc, const Shape g, const Sched& S, const Epi& E) {
    const int tid = tid_local(), wid = __builtin_amdgcn_readfirstlane(tid >> 6), lane = tid & 63, wr = wid >> 2, wc = wid & 3, fr = lane & 15, fq = lane >> 4;
    int nt = g.Kb / 128; asm volatile("" : "+s"(nt));
    unsigned voffA, voffB;
    { int R, C; stage_rc(tid * 16, R, C); const int Rb = Epi::PERM ? ((R & ~31) + perm32(R & 31)) : R;
      voffA = (unsigned)(R * g.lda + C * 2); voffB = (unsigned)(Rb * g.ldb + C * 2); }
    const unsigned p2A = 64u * (unsigned)g.lda, p2B = 64u * (unsigned)g.ldb;
    const unsigned kstep = 128u;
    const unsigned hstepA = (unsigned)HALF * g.lda, hstepB = (unsigned)HALF * g.ldb;
    const unsigned ldsw = (unsigned)wid * 1024u;
    const int aoff = lds_byte(wr * 64 + fr, fq * 8), boff = lds_byte(wc * 32 + fr, fq * 8);
#define PG8_SA(b, h) (((b) * 2 + (h)) * HTB)
#define PG8_SB(b, h) ((4 + (b) * 2 + (h)) * HTB)
#define PG8_STAGE(bufoff, gbase, voff) do { \
        __builtin_amdgcn_raw_ptr_buffer_load_lds(rsrc, (LAS void*)(lds + (bufoff) + ldsw), 16, voff, (gbase), 0, 0); \
        __builtin_amdgcn_raw_ptr_buffer_load_lds(rsrc, (LAS void*)(lds + (bufoff) + ldsw + 8192), 16, voff, (gbase) + p2##voff, 0, 0); } while (0)
#define p2voffA p2A
#define p2voffB p2B
#define PG8_LDA(dst, b, h) do { _Pragma("unroll") for (int m = 0; m < 4; ++m) _Pragma("unroll") for (int k = 0; k < 2; ++k) dst[m][k] = *(const LAS bf16x8*)(lds + PG8_SA(b, h) + aoff + m * 2048 + k * 1024); } while (0)
#define PG8_LDB(dst, b, h) do { _Pragma("unroll") for (int n = 0; n < 2; ++n) _Pragma("unroll") for (int k = 0; k < 2; ++k) dst[n][k] = *(const LAS bf16x8*)(lds + PG8_SB(b, h) + boff + n * 2048 + k * 1024); } while (0)
#define PG8_CAT(x, y) __builtin_shufflevector(__builtin_bit_cast(v4i_t, x), __builtin_bit_cast(v4i_t, y), 0, 1, 2, 3, 4, 5, 6, 7)
#define PG8_MMA(ai, bj, At, Bt) do { __builtin_amdgcn_s_setprio(1); if constexpr (MX) { _Pragma("unroll") for (int m = 0; m < 4; ++m) _Pragma("unroll") for (int n = 0; n < 2; ++n) \
        acc[ai][bj][m][n] = __builtin_amdgcn_mfma_scale_f32_16x16x128_f8f6f4(PG8_CAT(Bt[n][0], Bt[n][1]), PG8_CAT(At[m][0], At[m][1]), acc[ai][bj][m][n], 0, 0, 0, g.sw, 0, g.sa); } else { \
        _Pragma("unroll") for (int m = 0; m < 4; ++m) _Pragma("unroll") for (int n = 0; n < 2; ++n) _Pragma("unroll") for (int k = 0; k < 2; ++k) \
        acc[ai][bj][m][n] = __builtin_amdgcn_mfma_f32_16x16x32_bf16(Bt[n][k], At[m][k], acc[ai][bj][m][n], 0, 0, 0); } __builtin_amdgcn_s_setprio(0); } while (0)
#define PG8_WAIT_V(n) asm volatile("s_waitcnt vmcnt(" #n ")" ::: "memory")
#define PG8_WAIT_L(n) asm volatile("s_waitcnt lgkmcnt(" #n ")" ::: "memory")
#define PG8_BAR __builtin_amdgcn_s_barrier()
#define PG8_SCHED __builtin_amdgcn_sched_barrier(0)
    Unit cur, nxt; int ui = 0;
    if (!S.next(0, cur)) return;
    f32x4 acc[2][2][4][2];
#pragma unroll
    for (int a = 0; a < 2; ++a)
#pragma unroll
        for (int b = 0; b < 2; ++b)
#pragma unroll
            for (int m = 0; m < 4; ++m)
#pragma unroll
                for (int n = 0; n < 2; ++n) acc[a][b][m][n] = (f32x4){0.f, 0.f, 0.f, 0.f};
    bf16x8 At[4][2], B0[2][2], B1[2][2];
    unsigned cA = S.a_off(cur), cB = S.b_off(cur);
    if constexpr (SP2) {
        PG8_STAGE(PG8_SB(0, 0), cB, voffB); PG8_STAGE(PG8_SB(0, 1), cB + hstepB, voffB); PG8_STAGE(PG8_SA(0, 0), cA, voffA); PG8_STAGE(PG8_SA(0, 1), cA + hstepA, voffA);
        if (wr == 1) PG8_BAR;
        PG8_WAIT_V(2); PG8_BAR;
        PG8_STAGE(PG8_SB(1, 0), cB + kstep, voffB); PG8_STAGE(PG8_SA(1, 0), cA + kstep, voffA); PG8_STAGE(PG8_SB(1, 1), cB + hstepB + kstep, voffB);
        PG8_WAIT_V(6); PG8_BAR;
    } else {
        PG8_STAGE(PG8_SB(0, 0), cB, voffB); PG8_STAGE(PG8_SA(0, 0), cA, voffA); PG8_STAGE(PG8_SB(0, 1), cB + hstepB, voffB); PG8_STAGE(PG8_SA(0, 1), cA + hstepA, voffA);
        if (wr == 1) PG8_BAR;
        PG8_WAIT_V(4); PG8_BAR;
        PG8_STAGE(PG8_SB(1, 0), cB + kstep, voffB); PG8_STAGE(PG8_SA(1, 0), cA + kstep, voffA); PG8_STAGE(PG8_SB(1, 1), cB + hstepB + kstep, voffB);
        PG8_WAIT_V(6); PG8_BAR;
    }
    for (;;) {
        const bool has_next = S.next(ui + 1, nxt);
        const unsigned nA = has_next ? S.a_off(nxt) : cA, nB = has_next ? S.b_off(nxt) : cB;
#pragma nounroll
        for (int t = 0; t < nt; t += 2) {
            const bool last = (t == nt - 2);
            const unsigned a1 = cA + (unsigned)(t + 1) * kstep;
            const unsigned a2 = last ? nA : cA + (unsigned)(t + 2) * kstep, b2 = last ? nB : cB + (unsigned)(t + 2) * kstep;
            const unsigned a3 = a2 + kstep, b3 = b2 + kstep;
            if constexpr (SP2) {
            PG8_LDB(B0, 0, 0); PG8_LDB(B1, 0, 1); PG8_SCHED; PG8_LDA(At, 0, 0); PG8_STAGE(PG8_SA(1, 1), a1 + hstepA, voffA);
            PG8_WAIT_V(8); PG8_WAIT_L(0); PG8_BAR; PG8_MMA(0, 0, At, B0); PG8_MMA(0, 1, At, B1); PG8_BAR; PG8_SCHED;
            PG8_LDA(At, 0, 1); PG8_STAGE(PG8_SB(0, 0), b2, voffB); PG8_STAGE(PG8_SB(0, 1), b2 + hstepB, voffB); PG8_STAGE(PG8_SA(0, 0), a2, voffA);
            PG8_WAIT_V(8); PG8_WAIT_L(0); PG8_BAR; PG8_MMA(1, 0, At, B0); PG8_MMA(1, 1, At, B1); PG8_BAR; PG8_SCHED;
            PG8_LDB(B0, 1, 0); PG8_LDB(B1, 1, 1); PG8_SCHED; PG8_LDA(At, 1, 0); PG8_STAGE(PG8_SA(0, 1), a2 + hstepA, voffA);
            PG8_WAIT_V(8); PG8_WAIT_L(0); PG8_BAR; PG8_MMA(0, 0, At, B0); PG8_MMA(0, 1, At, B1); PG8_BAR; PG8_SCHED;
            PG8_LDA(At, 1, 1); PG8_STAGE(PG8_SB(1, 0), b3, voffB); PG8_STAGE(PG8_SB(1, 1), b3 + hstepB, voffB); PG8_STAGE(PG8_SA(1, 0), a3, voffA);
            PG8_WAIT_V(8); PG8_WAIT_L(0); PG8_BAR; PG8_MMA(1, 0, At, B0); PG8_MMA(1, 1, At, B1); PG8_BAR; PG8_SCHED;
            } else {
            PG8_LDB(B0, 0, 0); PG8_SCHED; PG8_LDA(At, 0, 0); PG8_STAGE(PG8_SA(1, 1), a1 + hstepA, voffA);
            PG8_WAIT_L(8); PG8_BAR; PG8_WAIT_L(0); PG8_MMA(0, 0, At, B0); PG8_BAR; PG8_SCHED;
            PG8_LDB(B1, 0, 1); PG8_STAGE(PG8_SB(0, 0), b2, voffB);
            PG8_BAR; PG8_WAIT_L(0); PG8_MMA(0, 1, At, B1); PG8_BAR;
            PG8_LDA(At, 0, 1); PG8_STAGE(PG8_SA(0, 0), a2, voffA);
            PG8_BAR; PG8_WAIT_L(0); PG8_MMA(1, 0, At, B0); PG8_BAR; PG8_SCHED;
            PG8_STAGE(PG8_SB(0, 1), b2 + hstepB, voffB);
            PG8_WAIT_V(6); PG8_BAR; PG8_MMA(1, 1, At, B1); PG8_BAR;
            PG8_LDB(B0, 1, 0); PG8_SCHED; PG8_LDA(At, 1, 0); PG8_STAGE(PG8_SA(0, 1), a2 + hstepA, voffA);
            PG8_WAIT_L(8); PG8_BAR; PG8_WAIT_L(0); PG8_MMA(0, 0, At, B0); PG8_BAR; PG8_SCHED;
            PG8_LDB(B1, 1, 1); PG8_STAGE(PG8_SB(1, 0), b3, voffB);
            PG8_BAR; PG8_WAIT_L(0); PG8_MMA(0, 1, At, B1); PG8_BAR;
            PG8_LDA(At, 1, 1); PG8_STAGE(PG8_SA(1, 0), a3, voffA);
            PG8_BAR; PG8_WAIT_L(0); PG8_MMA(1, 0, At, B0); PG8_BAR; PG8_SCHED;
            PG8_STAGE(PG8_SB(1, 1), b3 + hstepB, voffB);
            PG8_WAIT_V(6); PG8_BAR; PG8_MMA(1, 1, At, B1); PG8_BAR;
            }
        }
        if constexpr (ALIGN_EPI) { if (wr == 0) PG8_BAR; }
        { int fr_e = fr, fq_e = fq; asm volatile("" : "+v"(fr_e), "+v"(fq_e));
          E(acc, cur, wr, wc, fr_e, fq_e); }
        if (!has_next) break;
#pragma unroll
        for (int a = 0; a < 2; ++a)
#pragma unroll
            for (int b = 0; b < 2; ++b)
#pragma unroll
                for (int m = 0; m < 4; ++m)
#pragma unroll
                    for (int n = 0; n < 2; ++n) acc[a][b][m][n] = (f32x4){0.f, 0.f, 0.f, 0.f};
        cur = nxt; cA = nA; cB = nB; ++ui;
        if constexpr (ALIGN_EPI) { if (wr == 1) PG8_BAR; }
    }
    PG8_WAIT_V(0);
    if constexpr (!ALIGN_EPI) { if (wr == 0) PG8_BAR; }
    PG8_BAR;
#undef PG8_SA
#undef PG8_SB
#undef PG8_STAGE
#undef p2voffA
#undef p2voffB
#undef PG8_LDA
#undef PG8_LDB
#undef PG8_MMA
#undef PG8_CAT
#undef PG8_WAIT_V
#undef PG8_WAIT_L
#undef PG8_BAR
#undef PG8_SCHED
}
}
using pg8::Unit;

constexpr size_t MiB = 1u << 20;
constexpr size_t WS_CTL = 0, CTL_ZERO_BYTES = 1 * MiB;
constexpr size_t WS_WIN = 1 * MiB;
constexpr size_t WS_WQ = 7 * MiB;
constexpr size_t WS_WKV = WS_WQ + 512 * 1024;
constexpr size_t WS_WPOOL = 8 * MiB;
constexpr size_t WS_WAO = 9 * MiB;
constexpr size_t WS_WPO = 10 * MiB;
constexpr size_t WS_WO = 11 * MiB;
constexpr size_t WS_WPG = 13 * MiB;
constexpr size_t WS_WPLE = 15 * MiB;
constexpr size_t WS_WGU = 16 * MiB;
constexpr size_t WS_WD = 144 * MiB;
constexpr size_t WS_HN = 208 * MiB;
constexpr size_t WS_PROJ = 240 * MiB;
constexpr size_t WS_GATES = 272 * MiB;
constexpr size_t WS_A2 = 336 * MiB;
constexpr size_t WS_POOLED = 352 * MiB;
constexpr size_t WS_Q = 368 * MiB;
constexpr size_t WS_K = 392 * MiB;
constexpr size_t WS_V = 416 * MiB;
constexpr size_t WS_ATT = 432 * MiB;
constexpr size_t WS_MIXED = 448 * MiB;
constexpr size_t WS_MIX = 464 * MiB;
constexpr size_t WS_PB = 496 * MiB;
constexpr size_t WS_E = 504 * MiB;
constexpr size_t WS_SSQ = 536 * MiB;
constexpr size_t WS_COS = 537 * MiB;
constexpr size_t WS_SIN = 538 * MiB;
constexpr size_t WS_ROUTE = 539 * MiB;
constexpr size_t WS_XS = 544 * MiB;
constexpr size_t WS_ACT = 688 * MiB;
constexpr size_t WS_XS2 = 768 * MiB;
constexpr size_t WS_WIN8 = 848 * MiB;
constexpr size_t WS_HN8 = 852 * MiB;
constexpr size_t WS_END = 868 * MiB;
constexpr size_t WS_X1B = WS_PROJ;
constexpr size_t WS_X2B = WS_MIX;
constexpr int CW_BAR = 4096;
constexpr int CW_CNT = 1024;

constexpr int RING_BYTES = 131072;
constexpr int LDS_BYTES = 163840;
constexpr int MISC_OFF = LDS_BYTES - 512;
constexpr int TILE_E_OFF = LDS_BYTES - 4096;
constexpr int NWAVES = 8;

typedef GAS unsigned gu32;
#define RLX_AGENT __ATOMIC_RELAXED, __HIP_MEMORY_SCOPE_AGENT
#define XB_TMO      128
#define XB_XCNT(j)  (256  + 64 * (j))
#define XB_XSUB(j)  (1280 + 64 * (j))
#define XB_XGEN(j)  (2304 + 64 * (j))
#define XB_TOP      3328
#define XB_TOPGEN   3392
#define XCD_BAR_WORDS 3456
#define XB_SPIN_CAP (1u << 18)
__device__ __forceinline__ unsigned xb_ld(unsigned* p)              { return __hip_atomic_load(p, __ATOMIC_RELAXED, __HIP_MEMORY_SCOPE_AGENT); }
__device__ __forceinline__ unsigned xb_add(unsigned* p, unsigned v) { return __hip_atomic_fetch_add(p, v, __ATOMIC_RELAXED, __HIP_MEMORY_SCOPE_AGENT); }
__device__ __forceinline__ unsigned xb_xcc_id() { return (unsigned)__builtin_amdgcn_s_getreg((3 << 11) | 20) & 0xFu; }
#define XB_SPIN(cond, bar) do { unsigned _sp = 0; while (cond) { __builtin_amdgcn_s_sleep(1); \
    if ((++_sp & 255u) == 0u) { if (xb_ld(&(bar)[XB_TMO])) break; if (_sp > XB_SPIN_CAP) { atomicAdd(&(bar)[XB_TMO], 1u); break; } } } } while (0)
struct XcdBarrier { unsigned* bar; unsigned x; volatile LAS unsigned* st; };
__device__ __forceinline__ XcdBarrier xcd_barrier_post(unsigned* bar, volatile LAS unsigned* st) {
    XcdBarrier b; b.bar = bar; b.x = xb_xcc_id(); b.st = st;
    if (threadIdx.x == 0) (void)xb_add(&bar[XB_XCNT(b.x)], 1u);
    return b;
}
__device__ __forceinline__ void xcd_barrier_complete(unsigned* bar, unsigned x, unsigned& nloc, unsigned& nx) {
    const unsigned G = gridDim.x * gridDim.y * gridDim.z;
    unsigned sum, cnt, mine, sp = 0u;
    for (;;) {
        sum = 0u; cnt = 0u; mine = 0u;
#pragma unroll
        for (unsigned j = 0; j < 16; ++j) { const unsigned c = xb_ld(&bar[XB_XCNT(j)]); sum += c; cnt += (c > 0u) ? 1u : 0u; mine = (j == x) ? c : mine; }
        if (sum == G) break;
        __builtin_amdgcn_s_sleep(1);
        if ((++sp & 255u) == 0u) { if (xb_ld(&bar[XB_TMO])) break; if (sp > XB_SPIN_CAP) { atomicAdd(&bar[XB_TMO], 1u); break; } }
    }
    nloc = mine > 0u ? mine : 1u; nx = cnt > 0u ? cnt : 1u;
}
__device__ __forceinline__ void xcd_barrier(const XcdBarrier& b) {
    asm volatile("s_waitcnt vmcnt(0)" ::: "memory");
    __syncthreads();
    if (threadIdx.x == 0) {
        unsigned* bar = b.bar;
        __builtin_amdgcn_s_waitcnt(0);
        unsigned nloc = b.st[0], nx = b.st[1];
        if (nloc == 0u) { xcd_barrier_complete(bar, b.x, nloc, nx); b.st[0] = nloc; b.st[1] = nx; }
        const unsigned old = xb_add(&bar[XB_XSUB(b.x)], 1u);
        const unsigned gen = old / nloc;
        if (old + 1u == (gen + 1u) * nloc) {
            __builtin_amdgcn_fence(__ATOMIC_RELEASE, "agent");
            asm volatile("s_waitcnt vmcnt(0)" ::: "memory");
            const unsigned og = xb_add(&bar[XB_TOP], 1u);
            const unsigned tg = og / nx;
            if (og + 1u == (tg + 1u) * nx) xb_add(&bar[XB_TOPGEN], 1u);
            else XB_SPIN(xb_ld(&bar[XB_TOPGEN]) == tg, bar);
            __builtin_amdgcn_fence(__ATOMIC_ACQUIRE, "agent");
            xb_add(&bar[XB_XGEN(b.x)], 1u);
            asm volatile("s_waitcnt vmcnt(0)" ::: "memory");
        } else {
            XB_SPIN(xb_ld(&bar[XB_XGEN(b.x)]) == gen, bar);
            __builtin_amdgcn_fence(__ATOMIC_ACQUIRE, "agent");
            asm volatile("s_waitcnt vmcnt(0)" ::: "memory");
        }
    }
    __syncthreads();
}

struct Args {
    const float* in[27];
    float* out; unsigned char* ws;
    int ph_lo, ph_hi;
};
typedef const __attribute__((address_space(4))) Args* KArgs;
__device__ __forceinline__ KArgs kargs() { KArgs p = (KArgs)__builtin_amdgcn_kernarg_segment_ptr(); asm volatile("" : "+s"(p)); return p; }
enum { I_X = 0, I_P, I_POS, I_GMIX, I_WIN, I_GQLAT, I_WQB, I_GKVLAT, I_WKVB, I_GQHEAD, I_GKNOPE, I_GKROPE, I_WPOOL, I_PSCALE, I_WAO, I_WPO, I_WO, I_GFFN,
       I_WR, I_BR, I_WGU, I_BGU, I_WD, I_BD, I_GPLE, I_WPG, I_WPLE };

enum { MAP_ID = 0, MAP_WIN, MAP_GU, MAP_QB, MAP_KVB };
__device__ __forceinline__ int map_row(int mode, int n) {
    switch (mode) {
    case MAP_WIN: return n < 416 ? n : n + 96;
    case MAP_GU: { const int j = n & 1023, up = n >> 10; return 256 * (j >> 7) + 128 * up + (j & 127); }
    case MAP_QB: { const int h = n / 96, d = n % 96;
        if (d < 64) return (h >> 2) * 256 + 128 * (d >> 5) + 32 * (h & 3) + (d & 31);
        const int dd = d - 64, half = dd >> 4, i = dd & 15; return 512 + 128 * (h & 1) + 32 * (h >> 1) + 8 * (i >> 2) + 4 * half + (i & 3); }
    case MAP_KVB: { const int h = n >> 7, c = n & 127, isv = c >> 6, d = c & 63; return (h >> 1) * 256 + 128 * (d >> 5) + 32 * (2 * isv + (h & 1)) + (d & 31); }
    default: return n;
    }
}
struct TJob { const float* W; int K, N; bf16_t* WT; int ldw, koff, mode, row_off; const float* gk; const float* gn; int nmat; size_t wstride, wtstride; int fp8; };
struct TItem { const float* src; bf16_t* dst; int n0, k0; float gnv; };
__device__ __forceinline__ TItem titem_setup(const TJob& J, int item, int lane) {
    const int nblk = J.N / 32, ipm = (J.K / 64) * nblk, mat = item / ipm, it = item - mat * ipm, kb = it / nblk, nb = it - kb * nblk;
    TItem I; I.k0 = 64 * kb; I.n0 = 32 * nb;
    I.src = J.W + (size_t)mat * J.wstride + (size_t)(I.k0 + (lane >> 5)) * J.N + I.n0 + (lane & 31);
    I.dst = (bf16_t*)((unsigned char*)J.WT + (size_t)mat * J.wtstride * (J.fp8 ? 1 : 2));
    I.gnv = J.gn ? J.gn[I.n0 + (lane & 31)] : 1.f;
    return I;
}
__device__ __forceinline__ void titem_load(const TJob& J, const TItem& I, float (&v)[32]) {
#pragma unroll
    for (int i = 0; i < 32; ++i) v[i] = I.src[(size_t)(2 * i) * J.N];
}
__device__ __forceinline__ void titem_store(const TJob& J, const TItem& I, float (&v)[32], LAS float* scr, int lane) {
#pragma unroll
    for (int i = 0; i < 32; ++i) { const int kk = 2 * i + (lane >> 5); float x = v[i] * I.gnv; if (J.gk) x *= J.gk[I.k0 + kk]; scr[kk * 33 + (lane & 31)] = x; }
    asm volatile("s_waitcnt lgkmcnt(0)" ::: "memory");
    const int c = lane & 7;
#pragma unroll
    for (int j = 0; j < 4; ++j) { const int n = (lane >> 3) + 8 * j; const LAS float* s = scr + (8 * c) * 33 + n;
        const size_t eo = (size_t)(J.row_off + map_row(J.mode, I.n0 + n)) * J.ldw + J.koff + I.k0 + 8 * c;
        if (J.fp8) { u32x2 o; int w = __builtin_amdgcn_cvt_pk_fp8_f32(s[0 * 33] * 8.f, s[1 * 33] * 8.f, 0, false); w = __builtin_amdgcn_cvt_pk_fp8_f32(s[2 * 33] * 8.f, s[3 * 33] * 8.f, w, true); o.x = (unsigned)w;
            w = __builtin_amdgcn_cvt_pk_fp8_f32(s[4 * 33] * 8.f, s[5 * 33] * 8.f, 0, false); w = __builtin_amdgcn_cvt_pk_fp8_f32(s[6 * 33] * 8.f, s[7 * 33] * 8.f, w, true); o.y = (unsigned)w;
            *(u32x2*)((unsigned char*)I.dst + eo) = o; }
        else { u32x4 o; o.x = cvt_pk_bf16(s[0 * 33], s[1 * 33]); o.y = cvt_pk_bf16(s[2 * 33], s[3 * 33]); o.z = cvt_pk_bf16(s[4 * 33], s[5 * 33]); o.w = cvt_pk_bf16(s[6 * 33], s[7 * 33]);
            *(u32x4*)(I.dst + eo) = o; } }
    asm volatile("s_waitcnt lgkmcnt(0)" ::: "memory");
}
__device__ __forceinline__ void run_job(const TJob& J, LAS float* scr, int gw, int NGW, int lane) {
    const int items = J.nmat * (J.K / 64) * (J.N / 32);
    for (int it = gw; it < items; it += 2 * NGW) {
        const bool two = (it + NGW) < items;
        const TItem I0 = titem_setup(J, it, lane); const TItem I1 = titem_setup(J, two ? it + NGW : it, lane);
        float v0[32], v1[32];
        titem_load(J, I0, v0); if (two) titem_load(J, I1, v1);
        titem_store(J, I0, v0, scr, lane); if (two) titem_store(J, I1, v1, scr, lane);
    }
}

struct Frame {
    LAS unsigned char* lds; volatile LAS unsigned* MISC; unsigned* ctl;
    int wave, vcu, G;
    float* out; unsigned char* ws;
};

__device__ __forceinline__ void p0_prologue(const Frame& F) {
    const int tid_l = tid_local(), lane_l = tid_l & 63; (void)tid_l; (void)lane_l;
    const KArgs a = kargs();
    LAS float* scr = (LAS float*)(F.lds + F.wave * 16384);
    const int gw = F.vcu * NWAVES + F.wave, NGW = F.G * NWAVES;
    unsigned char* ws = F.ws;
    int joff = 0;
#define RUN_JOB(...) do { const TJob J_ = TJob{__VA_ARGS__, 1, 0, 0, 0}; run_job(J_, scr, (gw + NGW - joff % NGW) % NGW, NGW, lane_l); joff += (J_.K / 64) * (J_.N / 32); } while (0)
#ifndef P1_FP8
#define P1_FP8 0
#endif
    { const TJob J_{a->in[I_WIN], 1024, 2976, (bf16_t*)(ws + WS_WIN), 1024, 0, MAP_WIN, 0, nullptr, nullptr, 1, 0, 0, P1_FP8}; run_job(J_, scr, gw, NGW, lane_l); joff += 16 * 93; }
#ifndef GATES_FP8
#define GATES_FP8 0
#endif
    if (GATES_FP8) { const TJob J_{a->in[I_WIN], 1024, 2976, (bf16_t*)(ws + WS_WIN8), 1024, 0, MAP_WIN, 0, nullptr, nullptr, 1, 0, 0, 1}; run_job(J_, scr, gw, NGW, lane_l); }
    RUN_JOB(a->in[I_WQB], 256, 768, (bf16_t*)(ws + WS_WQ), 256, 0, MAP_QB, 0, a->in[I_GQLAT], nullptr);
    RUN_JOB(a->in[I_WKVB], 128, 1024, (bf16_t*)(ws + WS_WKV), 256, 0, MAP_KVB, 0, a->in[I_GKVLAT], nullptr);
    RUN_JOB(a->in[I_WAO], 512, 1024, (bf16_t*)(ws + WS_WAO), 512, 0, MAP_ID, 0, nullptr, nullptr);
    RUN_JOB(a->in[I_WPO], 512, 1024, (bf16_t*)(ws + WS_WPO), 512, 0, MAP_ID, 0, nullptr, nullptr);
    RUN_JOB(a->in[I_WO], 1024, 1024, (bf16_t*)(ws + WS_WO), 1024, 0, MAP_ID, 0, nullptr, nullptr);
    RUN_JOB(a->in[I_WPG], 1024, 1024, (bf16_t*)(ws + WS_WPG), 1024, 0, MAP_ID, 0, nullptr, nullptr);
    RUN_JOB(a->in[I_WPLE], 256, 1024, (bf16_t*)(ws + WS_WPLE), 256, 0, MAP_ID, 0, nullptr, nullptr);
    for (int g = 0; g < 4; ++g)
        RUN_JOB(a->in[I_WPOOL] + (size_t)g * 128 * 128, 128, 128, (bf16_t*)(ws + WS_WPOOL) + (size_t)(g >> 1) * 256 * 256, 256, 128 * (g & 1), MAP_ID, 128 * (g & 1), nullptr, a->in[I_PSCALE] + 128 * g);
    {
        const int gt = (F.vcu * NWAVES + F.wave) * 64 + lane_l, NGT = NGW * 64;
        const u32x4 z = {0u, 0u, 0u, 0u};
        u32x4* w0 = (u32x4*)(ws + WS_WIN + (size_t)416 * 1024 * (P1_FP8 ? 1 : 2));
        for (int i = gt; i < 96 * (P1_FP8 ? 64 : 128); i += NGT) w0[i] = z;
        for (int i = gt; i < 1024 * 16; i += NGT) { const int r = i >> 4, c = i & 15; *(u32x4*)((bf16_t*)(ws + WS_WKV) + (size_t)r * 256 + 128 + 8 * c) = z; }
        for (int i = gt; i < 2 * 256 * 16; i += NGT) { const int p = i >> 12, r = (i >> 4) & 255, c = i & 15;
            const int k0 = (r < 128) ? 128 : 0; *(u32x4*)((bf16_t*)(ws + WS_WPOOL) + (size_t)p * 65536 + (size_t)r * 256 + k0 + 8 * c) = z; }
    }
#ifndef CONV_IN_ATTN
#define CONV_IN_ATTN 1
#endif
    if (!CONV_IN_ATTN) {
    { const TJob J{a->in[I_WGU], 1024, 2048, (bf16_t*)(ws + WS_WGU), 1024, 0, MAP_GU, 0, nullptr, nullptr, NEXP, (size_t)1024 * 2048, (size_t)2048 * 1024, 1}; run_job(J, scr, gw, NGW, lane_l); }
    { const TJob J{a->in[I_WD], 1024, 1024, (bf16_t*)(ws + WS_WD), 1024, 0, MAP_ID, 0, nullptr, nullptr, NEXP, (size_t)1024 * 1024, (size_t)1024 * 1024, 1}; run_job(J, scr, gw, NGW, lane_l); }
    }
    const float* x = a->in[I_X]; const float* gm = a->in[I_GMIX];
    f32x4 gv[4];
#pragma unroll
    for (int j = 0; j < 4; ++j) gv[j] = *(const f32x4*)(gm + 4 * lane_l + 256 * j);
    for (int m = gw; m < T; m += NGW) {
        const f32x4* xr = (const f32x4*)(x + (size_t)m * DM) + lane_l;
        f32x4 v[4]; float s = 0.f;
#pragma unroll
        for (int j = 0; j < 4; ++j) { v[j] = xr[64 * j]; s += (v[j].x * v[j].x + v[j].y * v[j].y) + (v[j].z * v[j].z + v[j].w * v[j].w); }
        const float rstd = 1.0f / sqrtf(wave_sum(s) * (1.f / DM) + EPS);
        if (P1_FP8) { int* o4 = (int*)(ws + WS_HN + (size_t)m * DM) + lane_l; const float r8 = rstd * 8.0f;
#pragma unroll
            for (int j = 0; j < 4; ++j) { int w = __builtin_amdgcn_cvt_pk_fp8_f32(v[j].x * r8 * gv[j].x, v[j].y * r8 * gv[j].y, 0, false); w = __builtin_amdgcn_cvt_pk_fp8_f32(v[j].z * r8 * gv[j].z, v[j].w * r8 * gv[j].w, w, true); o4[64 * j] = w; } }
        else { u32x2* o8 = (u32x2*)((bf16_t*)(ws + WS_HN) + (size_t)m * DM) + lane_l;
#pragma unroll
            for (int j = 0; j < 4; ++j) { u32x2 w; w.x = cvt_pk_bf16(v[j].x * rstd * gv[j].x, v[j].y * rstd * gv[j].y); w.y = cvt_pk_bf16(v[j].z * rstd * gv[j].z, v[j].w * rstd * gv[j].w); o8[64 * j] = w; }
            if (GATES_FP8) { int* o4 = (int*)(ws + WS_HN8 + (size_t)m * DM) + lane_l; const float r8 = rstd * 8.0f;
#pragma unroll
                for (int j = 0; j < 4; ++j) { int w = __builtin_amdgcn_cvt_pk_fp8_f32(v[j].x * r8 * gv[j].x, v[j].y * r8 * gv[j].y, 0, false); w = __builtin_amdgcn_cvt_pk_fp8_f32(v[j].z * r8 * gv[j].z, v[j].w * r8 * gv[j].w, w, true); o4[64 * j] = w; } } }
    }
    {
        const float* p = a->in[I_P];
        for (int m = gw; m < T; m += NGW) { const f32x4 v = *((const f32x4*)(p + (size_t)m * PLE) + lane_l); u32x2 w; w.x = cvt_pk_bf16(v.x, v.y); w.y = cvt_pk_bf16(v.z, v.w);
            *((u32x2*)((bf16_t*)(ws + WS_PB) + (size_t)m * PLE) + lane_l) = w; }
    }
}

struct DenseOrder {
    int nM, nN, nwg, G, c; unsigned A, B, tA, tB, aPn;
    __device__ void init(int nM_, int nN_, int G_, int c_, size_t A_, size_t lda, size_t B_, size_t ldb, unsigned aPn_ = 0) { nM = nM_; nN = nN_; nwg = nM * nN; G = G_; c = c_; A = (unsigned)A_; B = (unsigned)B_; tA = (unsigned)(256 * lda * 2); tB = (unsigned)(256 * ldb * 2); aPn = aPn_; }
    __device__ __forceinline__ bool next(int i, Unit& u) const {
        const long L = (long)i * G + c; if (L >= nwg) return false;
        int wgid = (int)L; { const int q = nwg / 8, r = nwg % 8, xcd = wgid % 8, off = wgid / 8; wgid = (xcd < r ? xcd * (q + 1) : r * (q + 1) + (xcd - r) * q) + off; }
        const int WGM = 8; const int nig = WGM * nN, gid = wgid / nig, fm = gid * WGM, gsz = (nM - fm) < WGM ? (nM - fm) : WGM;
        u.pm = fm + ((wgid % nig) % gsz); u.pn = (wgid % nig) / gsz; u.aux = 0; return true;
    }
    __device__ __forceinline__ unsigned a_off(const Unit& u) const { return A + (unsigned)u.pm * tA + (unsigned)u.pn * aPn; }
    __device__ __forceinline__ unsigned b_off(const Unit& u) const { return B + (unsigned)u.pn * tB; }
};

struct EpiBf16 {
    static constexpr bool PERM = true;
    bf16_t* O; int ldc;
    __device__ __forceinline__ void operator()(const f32x4 (&acc)[2][2][4][2], const Unit& u, int wr, int wc, int fr, int fq) const {
        const int row0 = u.pm * 256 + wr * 64 + fr, col0 = u.pn * 256 + wc * 32 + 8 * fq;
#pragma unroll
        for (int ai = 0; ai < 2; ++ai)
#pragma unroll
            for (int m = 0; m < 4; ++m) { bf16_t* rowp = O + (size_t)(row0 + ai * 128 + m * 16) * ldc + col0;
#pragma unroll
                for (int bj = 0; bj < 2; ++bj) { const f32x4 v0 = acc[ai][bj][m][0], v1 = acc[ai][bj][m][1];
                    u32x4 w; w.x = cvt_pk_bf16(v0[0], v0[1]); w.y = cvt_pk_bf16(v0[2], v0[3]); w.z = cvt_pk_bf16(v1[0], v1[1]); w.w = cvt_pk_bf16(v1[2], v1[3]);
                    *(u32x4*)(rowp + bj * 128) = w; } }
    }
};
struct EpiProj {
    static constexpr bool PERM = true;
    bf16_t* PROJ; bf16_t* GATES; int pn_off;
    __device__ __forceinline__ void operator()(const f32x4 (&acc)[2][2][4][2], const Unit& u, int wr, int wc, int fr, int fq) const {
        const int pn = u.pn + pn_off; const int row0 = u.pm * 256 + wr * 64 + fr; const bool isg = pn >= 4;
        bf16_t* O = isg ? GATES : PROJ; const int ldc = isg ? 2048 : 1024; const int col0 = (isg ? pn - 4 : pn) * 256 + wc * 32 + 8 * fq;
#pragma unroll
        for (int ai = 0; ai < 2; ++ai)
#pragma unroll
            for (int m = 0; m < 4; ++m) { bf16_t* rowp = O + (size_t)(row0 + ai * 128 + m * 16) * ldc + col0;
#pragma unroll
                for (int bj = 0; bj < 2; ++bj) { f32x4 v0 = acc[ai][bj][m][0], v1 = acc[ai][bj][m][1];
                    if (isg) {
#pragma unroll
                        for (int e = 0; e < 4; ++e) { v0[e] = fast_sigmoid(v0[e]); v1[e] = fast_sigmoid(v1[e]); } }
                    u32x4 w; w.x = cvt_pk_bf16(v0[0], v0[1]); w.y = cvt_pk_bf16(v0[2], v0[3]); w.z = cvt_pk_bf16(v1[0], v1[1]); w.w = cvt_pk_bf16(v1[2], v1[3]);
                    *(u32x4*)(rowp + bj * 128) = w; } asm volatile("" ::: "memory"); }
    }
};

__device__ __forceinline__ void p2_rows(const Frame& F) {
    const int tid_l = tid_local(), lane_l = tid_l & 63; (void)tid_l; (void)lane_l;
    const KArgs a = kargs();
    const int gw = F.vcu * NWAVES + F.wave, NGW = F.G * NWAVES, lane = lane_l;
    unsigned char* ws = F.ws;
    const bf16_t* PROJ = (const bf16_t*)(ws + WS_PROJ);
    bf16_t* A2 = (bf16_t*)(ws + WS_A2); bf16_t* POOLED = (bf16_t*)(ws + WS_POOLED); bf16_t* Kb = (bf16_t*)(ws + WS_K);
    float* COS = (float*)(ws + WS_COS); float* SIN = (float*)(ws + WS_SIN);
    const int* positions = (const int*)a->in[I_POS];
    const float gkr = (lane < 32) ? a->in[I_GKROPE][lane] : 0.f;
    const float inv_freq = __builtin_amdgcn_exp2f(-(float)(lane & 15) * (13.287712379549449f / 16.0f));
    const int w = 2 << (lane >> 4);
    for (int task = gw; task < T / 8; task += NGW) {
        const int t0 = task * 8, b = t0 / SEQ, s0 = t0 % SEQ;
        {
            const bf16_t* base = PROJ + (size_t)(b * SEQ) * 1024 + 512 + 8 * lane;
            float S[8];
#pragma unroll
            for (int j = 0; j < 8; ++j) S[j] = 0.f;
            for (int r = s0 - 15; r < s0; ++r) {
                if (r >= 0 && r >= s0 - w + 1) { const u32x4 v = *(const u32x4*)(base + (size_t)r * 1024);
                    S[0] += bf_lo(v.x); S[1] += bf_hi(v.x); S[2] += bf_lo(v.y); S[3] += bf_hi(v.y); S[4] += bf_lo(v.z); S[5] += bf_hi(v.z); S[6] += bf_lo(v.w); S[7] += bf_hi(v.w); }
            }
#pragma unroll
            for (int i = 0; i < 8; ++i) {
                const int s = s0 + i;
                const u32x4 v = *(const u32x4*)(base + (size_t)s * 1024);
                float uu[8] = {bf_lo(v.x), bf_hi(v.x), bf_lo(v.y), bf_hi(v.y), bf_lo(v.z), bf_hi(v.z), bf_lo(v.w), bf_hi(v.w)};
                const int cnt = (s + 1 < w) ? s + 1 : w; const float ic = 1.0f / (float)cnt;
                float o[8];
#pragma unroll
                for (int j = 0; j < 8; ++j) { S[j] += uu[j]; o[j] = S[j] * ic - uu[j]; }
                u32x4 wv; wv.x = cvt_pk_bf16(o[0], o[1]); wv.y = cvt_pk_bf16(o[2], o[3]); wv.z = cvt_pk_bf16(o[4], o[5]); wv.w = cvt_pk_bf16(o[6], o[7]);
                *(u32x4*)(POOLED + (size_t)(t0 + i) * 512 + 8 * lane) = wv;
                const int rr = s - w + 1;
                if (rr >= 0) { const u32x4 q = *(const u32x4*)(base + (size_t)rr * 1024);
                    S[0] -= bf_lo(q.x); S[1] -= bf_hi(q.x); S[2] -= bf_lo(q.y); S[3] -= bf_hi(q.y); S[4] -= bf_lo(q.z); S[5] -= bf_hi(q.z); S[6] -= bf_lo(q.w); S[7] -= bf_hi(q.w); }
            }
        }
        for (int i = 0; i < 8; ++i) {
            const int t = t0 + i, s = s0 + i;
            const bf16_t* pr = PROJ + (size_t)t * 1024;
            const u32x2 ql = *(const u32x2*)(pr + 4 * lane);
            const unsigned kvl = *(const unsigned*)(pr + 256 + 2 * lane);
            const float krv = (lane < 32) ? bf1(pr[384 + lane]) : 0.f;
            const float q0 = bf_lo(ql.x), q1 = bf_hi(ql.x), q2 = bf_lo(ql.y), q3 = bf_hi(ql.y);
            const float k0 = bf_lo(kvl), k1 = bf_hi(kvl);
            const float sq = wave_sum((q0 * q0 + q1 * q1) + (q2 * q2 + q3 * q3));
            const float sk = wave_sum(k0 * k0 + k1 * k1);
            const float sr = wave_sum(krv * krv);
            const float rq = 1.0f / sqrtf(sq * (1.f / 256.f) + EPS), rk = 1.0f / sqrtf(sk * (1.f / 128.f) + EPS), rr = 1.0f / sqrtf(sr * (1.f / 32.f) + EPS);
            u32x2 wq; wq.x = cvt_pk_bf16(q0 * rq, q1 * rq); wq.y = cvt_pk_bf16(q2 * rq, q3 * rq);
            *(u32x2*)(A2 + (size_t)t * 512 + 4 * lane) = wq;
            *(unsigned*)(A2 + (size_t)t * 512 + 256 + 2 * lane) = cvt_pk_bf16(k0 * rk, k1 * rk);
            *(unsigned*)(A2 + (size_t)t * 512 + 384 + 2 * lane) = 0u;
            const float pos = (float)positions[t];
            const float ang = pos * inv_freq;
            const float rev = ang * 0.15915494309189535f;
            const float fr_ = rev - floorf(rev);
            const float sn = __builtin_amdgcn_sinf(fr_), cs = __builtin_amdgcn_cosf(fr_);
            const float kn = krv * rr * gkr;
            const float other = __shfl_xor(kn, 16);
            const float ro = (lane & 16) ? (kn * cs + other * sn) : (kn * cs - other * sn);
            if (lane < 32) {
                const bf16_t rb = (bf16_t)(cvt_pk_bf16(ro, 0.f) & 0xffffu);
#pragma unroll
                for (int h = 0; h < NH; ++h) Kb[((size_t)(b * NH + h) * SEQ + s) * DK + 64 + lane] = rb;
            }
            if (lane < 16) { COS[(size_t)t * 16 + lane] = cs; SIN[(size_t)t * 16 + lane] = sn; }
        }
    }
}

#define EPI_FENCE() asm volatile("" ::: "memory")
struct EpiQ {
    static constexpr bool PERM = true;
    bf16_t* Q; float* SSQ; const float* COS; const float* SIN; const float* gq;
    __device__ __forceinline__ void operator()(const f32x4 (&acc)[2][2][4][2], const Unit& u, int wr, int wc, int fr, int fq) const {
        const int t0 = u.pm * 256 + wr * 64 + fr, b = (u.pm * 256) / SEQ, s0 = t0 - b * SEQ;
        if (u.pn < 2) {
            const int h = 4 * u.pn + wc;
            bf16_t* dst0 = Q + ((size_t)(b * NH + h) * SEQ + s0) * DK + 8 * fq;
            float* ssq0 = SSQ + ((size_t)t0 * NH + h) * 2;
#pragma unroll
            for (int ai = 0; ai < 2; ++ai)
#pragma unroll
                for (int m = 0; m < 4; ++m) {
                    const int dr = ai * 128 + m * 16;
                    float q = 0.f;
#pragma unroll
                    for (int bj = 0; bj < 2; ++bj)
#pragma unroll
                        for (int n = 0; n < 2; ++n) { const f32x4 v = acc[ai][bj][m][n]; q += (v[0] * v[0] + v[1] * v[1]) + (v[2] * v[2] + v[3] * v[3]); }
                    q += __shfl_xor(q, 16); q += __shfl_xor(q, 32);
                    if (fq == 0) ssq0[dr * NH * 2] = q;
#pragma unroll
                    for (int bj = 0; bj < 2; ++bj) { const f32x4 v0 = acc[ai][bj][m][0] * *(const f32x4*)(gq + 32 * bj + 8 * fq), v1 = acc[ai][bj][m][1] * *(const f32x4*)(gq + 32 * bj + 8 * fq + 4);
                        u32x4 w; w.x = cvt_pk_bf16(v0[0], v0[1]); w.y = cvt_pk_bf16(v0[2], v0[3]); w.z = cvt_pk_bf16(v1[0], v1[1]); w.w = cvt_pk_bf16(v1[2], v1[3]);
                        *(u32x4*)(dst0 + dr * DK + 32 * bj) = w; }
                    EPI_FENCE();
                }
        } else {
            const f32x4 g1 = *(const f32x4*)(gq + 64 + 4 * fq), g2 = *(const f32x4*)(gq + 80 + 4 * fq);
            const float* cs0 = COS + (size_t)t0 * 16 + 4 * fq; const float* sn0 = SIN + (size_t)t0 * 16 + 4 * fq;
            bf16_t* dst0 = Q + ((size_t)(b * NH + 2 * wc) * SEQ + s0) * DK + 64 + 4 * fq;
            float* ssq0 = SSQ + ((size_t)t0 * NH + 2 * wc) * 2 + 1;
#pragma unroll
            for (int ai = 0; ai < 2; ++ai)
#pragma unroll
                for (int m = 0; m < 4; ++m) {
                    const int dr = ai * 128 + m * 16;
                    const f32x4 cs = *(const f32x4*)(cs0 + dr * 16), sn = *(const f32x4*)(sn0 + dr * 16);
#pragma unroll
                    for (int bj = 0; bj < 2; ++bj) {
                        const f32x4 x1 = acc[ai][bj][m][0], x2 = acc[ai][bj][m][1];
                        float q = (x1[0] * x1[0] + x1[1] * x1[1]) + (x1[2] * x1[2] + x1[3] * x1[3]) + (x2[0] * x2[0] + x2[1] * x2[1]) + (x2[2] * x2[2] + x2[3] * x2[3]);
                        q += __shfl_xor(q, 16); q += __shfl_xor(q, 32);
                        if (fq == 0) ssq0[dr * NH * 2 + bj * 2] = q;
                        const f32x4 y1 = x1 * g1, y2 = x2 * g2;
                        const f32x4 o1 = y1 * cs - y2 * sn, o2 = y2 * cs + y1 * sn;
                        bf16_t* dst = dst0 + (size_t)bj * SEQ * DK + dr * DK;
                        u32x2 w1, w2; w1.x = cvt_pk_bf16(o1[0], o1[1]); w1.y = cvt_pk_bf16(o1[2], o1[3]); w2.x = cvt_pk_bf16(o2[0], o2[1]); w2.y = cvt_pk_bf16(o2[2], o2[3]);
                        *(u32x2*)(dst) = w1; *(u32x2*)(dst + 16) = w2;
                    }
                    EPI_FENCE();
                }
        }
    }
};
struct EpiKV {
    static constexpr bool PERM = true;
    bf16_t* K; bf16_t* V; const float* gk;
    __device__ __forceinline__ void operator()(const f32x4 (&acc)[2][2][4][2], const Unit& u, int wr, int wc, int fr, int fq) const {
        const int t0 = u.pm * 256 + wr * 64 + fr, b = (u.pm * 256) / SEQ, s0 = t0 - b * SEQ;
        const int h = 2 * u.pn + (wc & 1); const bool isv = wc >= 2;
        const int pitch = isv ? DV : DK;
        bf16_t* dst0 = (isv ? V : K) + ((size_t)(b * NH + h) * SEQ + s0) * pitch + 8 * fq;
#pragma unroll
        for (int ai = 0; ai < 2; ++ai)
#pragma unroll
            for (int m = 0; m < 4; ++m) {
                const int dr = ai * 128 + m * 16;
                float sc = 1.f;
                if (!isv) { float q = 0.f;
#pragma unroll
                    for (int bj = 0; bj < 2; ++bj)
#pragma unroll
                        for (int n = 0; n < 2; ++n) { const f32x4 v = acc[ai][bj][m][n]; q += (v[0] * v[0] + v[1] * v[1]) + (v[2] * v[2] + v[3] * v[3]); }
                    q += __shfl_xor(q, 16); q += __shfl_xor(q, 32);
                    sc = 1.0f / sqrtf(q * (1.f / 64.f) + EPS); }
#pragma unroll
                for (int bj = 0; bj < 2; ++bj) {
                    f32x4 v0 = acc[ai][bj][m][0] * sc, v1 = acc[ai][bj][m][1] * sc;
                    if (!isv) { v0 = v0 * *(const f32x4*)(gk + 32 * bj + 8 * fq); v1 = v1 * *(const f32x4*)(gk + 32 * bj + 8 * fq + 4); }
                    u32x4 w; w.x = cvt_pk_bf16(v0[0], v0[1]); w.y = cvt_pk_bf16(v0[2], v0[3]); w.z = cvt_pk_bf16(v1[0], v1[1]); w.w = cvt_pk_bf16(v1[2], v1[3]);
                    *(u32x4*)(dst0 + dr * pitch + 32 * bj) = w; }
                EPI_FENCE();
            }
    }
};

namespace att {
constexpr int KT_BYTES = 64 * 192, VT_BYTES = 64 * 128, SLOT_BYTES = KT_BYTES + VT_BYTES;
constexpr int NSLOT = 4, SCR_OFF = NSLOT * SLOT_BYTES;
__device__ __forceinline__ int crow(int r, int hi) { return (r & 3) + 8 * (r >> 2) + 4 * hi; }
__device__ __forceinline__ s16x4 vtr(const LAS unsigned char* p) { typedef short v4i16_t __attribute__((ext_vector_type(4)));
    return __builtin_bit_cast(s16x4, __builtin_amdgcn_ds_read_tr16_b64_v4i16((LAS v4i16_t*)p)); }
#define MFMA32(a, b, c) __builtin_amdgcn_mfma_f32_32x32x16_bf16(a, b, c, 0, 0, 0)
__device__ __forceinline__ float max3f(float a, float b, float c) { return __builtin_fmaxf(__builtin_fmaxf(a, b), c); }


constexpr int CONV_OFF = SCR_OFF + 8 * 256, CONV_BYTES = 8192;
constexpr int CV_GU_ITEMS = NEXP * 1024, CV_ITEMS = CV_GU_ITEMS + NEXP * 512;
struct ConvItem { const float* src; unsigned char* dst; int N, isgu, n0; };
__device__ __forceinline__ ConvItem cv_setup(int g, const float* wgu, const float* wd, unsigned char* wgu8, unsigned char* wd8) {
    ConvItem I;
    if (g < CV_GU_ITEMS) { const int e = g >> 10, it = g & 1023, kb = it >> 6, nb = it & 63; I.N = 2048; I.isgu = 1; I.n0 = 32 * nb;
        I.src = wgu + (size_t)e * 1024 * 2048 + (size_t)(64 * kb) * 2048 + 32 * nb; I.dst = wgu8 + (size_t)e * 2048 * 1024 + 64 * kb; }
    else { const int g2 = g - CV_GU_ITEMS, e = g2 >> 9, it = g2 & 511, kb = it >> 5, nb = it & 31; I.N = 1024; I.isgu = 0; I.n0 = 32 * nb;
        I.src = wd + (size_t)e * 1024 * 1024 + (size_t)(64 * kb) * 1024 + 32 * nb; I.dst = wd8 + (size_t)e * 1024 * 1024 + 64 * kb; }
    return I;
}
__device__ __forceinline__ void cv_dma(const ConvItem& I, unsigned ldsaddr, int lane) {
    const int kr = lane >> 3, sl = lane & 7;
#pragma unroll
    for (int q = 0; q < 8; ++q) { const unsigned voff = (unsigned)(((8 * q + kr) * I.N + 4 * (sl ^ ((kr ^ q) & 7))) * 4);
        asm volatile("s_nop 4\n\ts_mov_b32 m0, %0\n\ts_nop 0\n\tglobal_load_lds_dwordx4 %1, %2" :: "s"(ldsaddr + (unsigned)q * 1024u), "v"(voff), "s"(I.src) : "m0", "memory"); }
}
__device__ __forceinline__ void cv_out(const ConvItem& I, const LAS float* cb, int lane) {
    const int c = lane & 7;
#pragma unroll
    for (int j = 0; j < 4; ++j) { const int n = (lane >> 3) + 8 * j, nc = n >> 2, e = n & 3;
        float f[8];
#pragma unroll
        for (int kk = 0; kk < 8; ++kk) f[kk] = cb[(8 * c + kk) * 32 + ((nc ^ kk ^ c) & 7) * 4 + e];
        const int nn = I.n0 + n; const int row = I.isgu ? (256 * ((nn & 1023) >> 7) + 128 * (nn >> 10) + (nn & 127)) : nn;
        *(u32x2*)(I.dst + (size_t)row * 1024 + 8 * c) = cvt8_fp8((f32x4){f[0], f[1], f[2], f[3]}, (f32x4){f[4], f[5], f[6], f[7]}, 8.0f);
        asm volatile("" ::: "memory"); }
}
struct ConvState { int next, end, cur; };
__device__ __forceinline__ void attn_unit(LAS unsigned char* lds, const u32x4 srd, ConvState& CV, unsigned char* cvws, int bh, int qb, const bf16_t* Q, unsigned Koff, unsigned Voff, const float* SSQ, bf16_t* O) {
    const int tid = tid_local(), lane = tid & 63, r32 = lane & 31, hi = lane >> 5; const int wid = __builtin_amdgcn_readfirstlane(tid >> 6);
    const int b = bh / NH, h = bh % NH, q0 = qb * 256, qw = q0 + 32 * wid;
    LAS float* scr = (LAS float*)(lds + SCR_OFF) + wid * 64;
    const int NT = (q0 + 256) / 64;
    const unsigned kS = Koff + (unsigned)bh * (SEQ * DK * 2), vS = Voff + (unsigned)bh * (SEQ * DV * 2);
    const int kc2 = 8 + (wid & 3);
    const unsigned vK1 = (unsigned)(lane * 192 + wid * 16); const unsigned sK2 = (unsigned)((kc2 - wid) * 16);
    const int vkey = 8 * wid + (lane >> 3); const unsigned vV = (unsigned)(vkey * 128 + (((lane & 7) ^ (((vkey >> 1) & 1) * 4)) * 16));
    const unsigned lds0 = (unsigned)__builtin_amdgcn_readfirstlane((int)(unsigned)(unsigned long)lds);
    const unsigned dK1 = (unsigned)wid * 1024u, dK2 = (unsigned)kc2 * 1024u, dV = (unsigned)KT_BYTES + (unsigned)wid * 1024u;
#define ATT_DMA1(ldsaddr, voff, soff) asm volatile("s_nop 4\n\ts_mov_b32 m0, %0\n\ts_nop 0\n\tbuffer_load_dwordx4 %1, %2, %3 offen lds" :: "s"(ldsaddr), "v"(voff), "s"(srd), "s"(soff) : "m0", "memory")
#define ATT_DMA(t) do { const unsigned sp_ = lds0 + (unsigned)((t) & 3) * SLOT_BYTES; const unsigned ks_ = kS + (unsigned)(t) * (64 * 192), vs_ = vS + (unsigned)(t) * (64 * 128); \
        ATT_DMA1(sp_ + dK1, vK1, ks_); ATT_DMA1(sp_ + dK2, vK1, ks_ + sK2); ATT_DMA1(sp_ + dV, vV, vs_); } while (0)
#define ATT_WAITBAR(N) asm volatile("s_waitcnt vmcnt(" #N ") lgkmcnt(0)\n\ts_barrier" ::: "memory")
    bf16x8 qr[6];
    { const float* sp = SSQ + ((size_t)(b * SEQ + qw + r32) * NH + h) * 2; const float ss = sp[0] + sp[1];
      const float cq = (1.0f / sqrtf(ss * (1.f / 96.f) + EPS)) * 0.10206207261596577f * 1.4426950408889634f;
      const bf16_t* qp = Q + ((size_t)bh * SEQ + qw + r32) * DK + 8 * hi;
      u32x4 qw_[6];
#pragma unroll
      for (int d0 = 0; d0 < 6; ++d0) qw_[d0] = *(const u32x4*)(qp + 16 * d0);
#pragma unroll
      for (int d0 = 0; d0 < 6; ++d0) { const u32x4 w = qw_[d0]; u32x4 o;
          o.x = cvt_pk_bf16(bf_lo(w.x) * cq, bf_hi(w.x) * cq); o.y = cvt_pk_bf16(bf_lo(w.y) * cq, bf_hi(w.y) * cq); o.z = cvt_pk_bf16(bf_lo(w.z) * cq, bf_hi(w.z) * cq); o.w = cvt_pk_bf16(bf_lo(w.w) * cq, bf_hi(w.w) * cq);
          qr[d0] = __builtin_bit_cast(bf16x8, o); } }
    ATT_DMA(0); ATT_DMA(1); ATT_DMA(2);
    const int kbase = hi * 1024 + r32 * 16;
    const int qq = (lane & 15) >> 2, pp = lane & 3, dblk = (lane >> 4) & 1, swz = ((qq >> 1) & 1) * 64;
    const int vrow0 = 4 * hi + qq;
    const int vb0 = KT_BYTES + vrow0 * 128 + ((32 * dblk + 8 * pp) ^ swz);
    const int vb1 = KT_BYTES + vrow0 * 128 + ((64 + 32 * dblk + 8 * pp) ^ swz);
    f32x16 o0 = {}, o1 = {};
    float m_run = -1e30f, l_run = 0.f; const f32x16 zero16 = {};
    const int qa = qw + r32;
#define ATT_QK(N0, N1, t) do { const LAS unsigned char* kp_ = lds + ((t) & 3) * SLOT_BYTES + kbase; \
        _Pragma("unroll") for (int d0 = 0; d0 < 6; ++d0) { const bf16x8 ka_ = *(const LAS bf16x8*)(kp_ + d0 * 2048), kb_ = *(const LAS bf16x8*)(kp_ + d0 * 2048 + 512); \
            if (d0 == 0) { N0 = MFMA32(ka_, qr[0], zero16); N1 = MFMA32(kb_, qr[0], zero16); } else { N0 = MFMA32(ka_, qr[d0], N0); N1 = MFMA32(kb_, qr[d0], N1); } } } while (0)
#define ATT_MASK(N0, N1, t) do { const int kb_ = 64 * (t); if (kb_ + 63 > qw) { _Pragma("unroll") for (int r = 0; r < 16; ++r) { const int ka_ = kb_ + crow(r, hi); \
        if (ka_ > qa) N0[r] = -__builtin_inff(); if (ka_ + 32 > qa) N1[r] = -__builtin_inff(); } } } while (0)
#define ATT_ROWMAX(N0, N1, PM) do { float a_ = max3f(N0[0], N0[1], N1[0]), b_ = max3f(N0[2], N0[3], N1[1]); a_ = max3f(a_, N1[2], N1[3]); \
        _Pragma("unroll") for (int r = 4; r < 16; r += 4) { a_ = max3f(a_, N0[r], N0[r + 1]); b_ = max3f(b_, N0[r + 2], N0[r + 3]); a_ = max3f(a_, N1[r], N1[r + 1]); b_ = max3f(b_, N1[r + 2], N1[r + 3]); } \
        a_ = max3f(a_, b_, b_); auto rr_ = __builtin_amdgcn_permlane32_swap(__float_as_uint(a_), __float_as_uint(a_), false, false); \
        PM = max3f(__uint_as_float(rr_[0]), __uint_as_float(rr_[1]), __uint_as_float(rr_[1])); } while (0)
#define ATT_DECIDE(PM, C0, C1, FORCE) do { if ((FORCE) || __any((PM) > m_run + 8.0f)) { const float mn_ = fmaxf(m_run, (PM)); const float al_ = __builtin_amdgcn_exp2f(m_run - mn_); m_run = mn_; l_run *= al_; \
        if (hi == 0) scr[r32] = al_; asm volatile("s_waitcnt lgkmcnt(0)" ::: "memory"); \
        _Pragma("unroll") for (int a4 = 0; a4 < 4; ++a4) { const f32x4 f_ = *(const LAS f32x4*)(scr + 8 * a4 + 4 * hi); \
            _Pragma("unroll") for (int e = 0; e < 4; ++e) { o0[4 * a4 + e] *= f_[e]; o1[4 * a4 + e] *= f_[e]; } } } } while (0)
#define ATT_SOFTMAX(C0, C1) do { float ps_ = 0.f; \
        _Pragma("unroll") for (int r = 0; r < 16; ++r) { C0[r] = __builtin_amdgcn_exp2f(C0[r] - m_run); C1[r] = __builtin_amdgcn_exp2f(C1[r] - m_run); ps_ += C0[r] + C1[r]; } \
        l_run += ps_; \
        _Pragma("unroll") for (int ks = 0; ks < 4; ++ks) { const f32x16& P_ = (ks < 2) ? C0 : C1; const int bs_ = 8 * (ks & 1); \
            u32x4 w_; w_.x = cvt_pk_bf16(P_[bs_ + 0], P_[bs_ + 1]); w_.y = cvt_pk_bf16(P_[bs_ + 2], P_[bs_ + 3]); w_.z = cvt_pk_bf16(P_[bs_ + 4], P_[bs_ + 5]); w_.w = cvt_pk_bf16(P_[bs_ + 6], P_[bs_ + 7]); \
            pa[ks] = __builtin_bit_cast(bf16x8, w_); } } while (0)
#define ATT_PV(t) do { const LAS unsigned char* vp0_ = lds + ((t) & 3) * SLOT_BYTES + vb0; const LAS unsigned char* vp1_ = lds + ((t) & 3) * SLOT_BYTES + vb1; \
        _Pragma("unroll") for (int ks = 0; ks < 4; ++ks) { \
            const s16x4 a0_ = vtr(vp0_ + ks * 16 * 128), a1_ = vtr(vp0_ + ks * 16 * 128 + 8 * 128), c0_ = vtr(vp1_ + ks * 16 * 128), c1_ = vtr(vp1_ + ks * 16 * 128 + 8 * 128); \
            const bf16x8 vf0_ = {a0_[0], a0_[1], a0_[2], a0_[3], a1_[0], a1_[1], a1_[2], a1_[3]}; const bf16x8 vf1_ = {c0_[0], c0_[1], c0_[2], c0_[3], c1_[0], c1_[1], c1_[2], c1_[3]}; \
            o0 = MFMA32(pa[ks], vf0_, o0); o1 = MFMA32(pa[ks], vf1_, o1); } } while (0)
#define ATT_WB(N) asm volatile("s_waitcnt vmcnt(" #N ") lgkmcnt(0)\n\ts_barrier" ::: "memory")
#define ATT_STEP(C0, C1, PMC, N0, N1, PMN, j, MSK, CONV) do { \
        ATT_DECIDE(PMC, C0, C1, false); \
        ATT_QK(N0, N1, (j) + 1); ATT_SOFTMAX(C0, C1); \
        bool cvi_ = false; \
        if (CONV) { __builtin_amdgcn_sched_barrier(0); const LAS float* cb_ = (const LAS float*)(lds + CONV_OFF + wid * CONV_BYTES); \
            if (CV.cur >= 0) { const ConvItem I_ = cv_setup(CV.cur, kargs()->in[I_WGU], kargs()->in[I_WD], cvws + WS_WGU, cvws + WS_WD); cv_out(I_, cb_, lane); } \
            if (CV.next < CV.end) { const ConvItem I_ = cv_setup(CV.next, kargs()->in[I_WGU], kargs()->in[I_WD], cvws + WS_WGU, cvws + WS_WD); asm volatile("s_waitcnt lgkmcnt(0)" ::: "memory"); \
                cv_dma(I_, lds0 + (unsigned)(CONV_OFF + wid * CONV_BYTES), lane); CV.cur = CV.next; CV.next += 2048; cvi_ = true; } else CV.cur = -1; __builtin_amdgcn_sched_barrier(0); } \
        const bool dma_ = (j) + 3 < NT; if (dma_) ATT_DMA((j) + 3); \
        ATT_PV(j); if (MSK) ATT_MASK(N0, N1, (j) + 1); ATT_ROWMAX(N0, N1, PMN); \
        if (dma_) { if (cvi_) ATT_WB(11); else ATT_WB(3); } else { if (cvi_) ATT_WB(8); else ATT_WB(0); } } while (0)
    bf16x8 pa[4];
    f32x16 sA0, sA1, sB0, sB1; float pmA, pmB;
    ATT_WAITBAR(6);
    ATT_QK(sA0, sA1, 0); ATT_MASK(sA0, sA1, 0); ATT_ROWMAX(sA0, sA1, pmA);
    ATT_WAITBAR(3);
    int j = 0;
    for (; j + 8 <= NT; j += 2) {
        ATT_STEP(sA0, sA1, pmA, sB0, sB1, pmB, j, false, CONV_IN_ATTN);
        ATT_STEP(sB0, sB1, pmB, sA0, sA1, pmA, j + 1, false, false);
    }
    for (; j < NT; j += 2) {
        ATT_STEP(sA0, sA1, pmA, sB0, sB1, pmB, j, true, CONV_IN_ATTN);
        ATT_STEP(sB0, sB1, pmB, sA0, sA1, pmA, j + 1, true, false);
    }
#undef ATT_DMA
#undef ATT_DMA1
#undef ATT_WAITBAR
#undef ATT_QK
#undef ATT_MASK
#undef ATT_ROWMAX
#undef ATT_DECIDE
#undef ATT_SOFTMAX
#undef ATT_PV
#undef ATT_STEP
#undef ATT_WB
    { auto rr = __builtin_amdgcn_permlane32_swap(__float_as_uint(l_run), __float_as_uint(l_run), false, false); l_run = __uint_as_float(rr[0]) + __uint_as_float(rr[1]); }
    if (hi == 0) scr[32 + r32] = 1.0f / l_run;
    asm volatile("s_waitcnt lgkmcnt(0)" ::: "memory");
    bf16_t* Ow = O + ((size_t)(b * SEQ + qw)) * 512 + h * 64 + r32;
#pragma unroll
    for (int a4 = 0; a4 < 4; ++a4) { const f32x4 f = *(const LAS f32x4*)(scr + 32 + 8 * a4 + 4 * hi);
#pragma unroll
        for (int e = 0; e < 4; ++e) { const int r = 4 * a4 + e; const int row = crow(r, hi);
            Ow[(size_t)row * 512] = (bf16_t)(cvt_pk_bf16(o0[r] * f[e], 0.f) & 0xffffu);
            Ow[(size_t)row * 512 + 32] = (bf16_t)(cvt_pk_bf16(o1[r] * f[e], 0.f) & 0xffffu); } }
    __syncthreads();
}
#undef MFMA32
}

struct MixOrder {
    int G, c; unsigned ATT, MIXED, WAO, WPO;
    __device__ __forceinline__ bool next(int i, Unit& u) const {
        const int tile = (i >> 1) * G + c; if (tile >= 256) return false;
        u.pm = tile >> 2; u.pn = tile & 3; u.aux = i & 1; return true;
    }
    __device__ __forceinline__ unsigned a_off(const Unit& u) const { return (u.aux ? MIXED : ATT) + (unsigned)u.pm * (256 * 512 * 2); }
    __device__ __forceinline__ unsigned b_off(const Unit& u) const { return (u.aux ? WPO : WAO) + (unsigned)u.pn * (256 * 512 * 2); }
};
struct EpiMix {
    static constexpr bool PERM = true;
    bf16_t* MIX; const bf16_t* GATES;
    __device__ __forceinline__ void operator()(const f32x4 (&acc)[2][2][4][2], const Unit& u, int wr, int wc, int fr, int fq) const {
        const int row0 = u.pm * 256 + wr * 64 + fr, col0 = u.pn * 256 + wc * 32 + 8 * fq;
#pragma unroll
        for (int ai = 0; ai < 2; ++ai)
#pragma unroll
            for (int m = 0; m < 4; ++m) { const size_t row = (size_t)(row0 + ai * 128 + m * 16);
#pragma unroll
                for (int bj = 0; bj < 2; ++bj) {
                    const u32x4 gw = *(const u32x4*)(GATES + row * 2048 + u.aux * 1024 + col0 + bj * 128);
                    const f32x4 v0 = acc[ai][bj][m][0], v1 = acc[ai][bj][m][1];
                    float r[8] = {v0[0] * bf_lo(gw.x), v0[1] * bf_hi(gw.x), v0[2] * bf_lo(gw.y), v0[3] * bf_hi(gw.y), v1[0] * bf_lo(gw.z), v1[1] * bf_hi(gw.z), v1[2] * bf_lo(gw.w), v1[3] * bf_hi(gw.w)};
                    bf16_t* dst = MIX + row * 1024 + col0 + bj * 128;
                    if (u.aux) { const u32x4 pw = *(const u32x4*)dst;
                        r[0] += bf_lo(pw.x); r[1] += bf_hi(pw.x); r[2] += bf_lo(pw.y); r[3] += bf_hi(pw.y); r[4] += bf_lo(pw.z); r[5] += bf_hi(pw.z); r[6] += bf_lo(pw.w); r[7] += bf_hi(pw.w); }
                    u32x4 w; w.x = cvt_pk_bf16(r[0], r[1]); w.y = cvt_pk_bf16(r[2], r[3]); w.z = cvt_pk_bf16(r[4], r[5]); w.w = cvt_pk_bf16(r[6], r[7]);
                    *(u32x4*)dst = w; } }
    }
};
struct EpiRes {
    static constexpr bool PERM = false;
    const float* base; bf16_t* out;
    __device__ __forceinline__ void operator()(const f32x4 (&acc)[2][2][4][2], const Unit& u, int wr, int wc, int fr, int fq) const {
        const int row0 = u.pm * 256 + wr * 64 + fr, col0 = u.pn * 256 + wc * 32 + 4 * fq;
#pragma unroll
        for (int ai = 0; ai < 2; ++ai)
#pragma unroll
            for (int m = 0; m < 4; ++m) { const size_t off = (size_t)(row0 + ai * 128 + m * 16) * DM + col0;
#pragma unroll
                for (int bj = 0; bj < 2; ++bj)
#pragma unroll
                    for (int n = 0; n < 2; ++n) { const f32x4 r = *(const f32x4*)(base + off + bj * 128 + n * 16) + acc[ai][bj][m][n]; u32x2 w; w.x = cvt_pk_bf16(r[0], r[1]); w.y = cvt_pk_bf16(r[2], r[3]); *(u32x2*)(out + off + bj * 128 + n * 16) = w; } }
    }
};

constexpr int WR_PITCH = 1028;
constexpr int R_WR_OFF = 0, R_PART_OFF = 32 * WR_PITCH * 4, R_SSQ_OFF = R_PART_OFF + 2 * 64 * 33 * 4, R_CNT_OFF = R_SSQ_OFF + 2 * 64 * 4, R_BASE_OFF = R_CNT_OFF + 128, R_END = R_BASE_OFF + 128;
static_assert(R_END <= TILE_E_OFF, "router LDS map");
__device__ __forceinline__ void p7_router(const Frame& F) {
    const int tid_l = tid_local(), lane_l = tid_l & 63; (void)tid_l; (void)lane_l;
    const KArgs a = kargs();
    LAS float* WR = (LAS float*)(F.lds + R_WR_OFF); LAS float* PART = (LAS float*)(F.lds + R_PART_OFF); LAS float* SSQP = (LAS float*)(F.lds + R_SSQ_OFF);
    LAS int* CNT = (LAS int*)(F.lds + R_CNT_OFF); LAS int* BASE = (LAS int*)(F.lds + R_BASE_OFF);
    const int tid = tid_l, lane = lane_l, wave = F.wave;
    const float* wr = a->in[I_WR]; const float* gf = a->in[I_GFFN];
    for (int i = tid; i < 1024 * 32; i += 512) { const int k = i >> 5, e = i & 31; WR[e * WR_PITCH + k] = wr[i] * gf[k]; }
    if (tid < 32) CNT[tid] = 0;
    __syncthreads();
    int* RE = (int*)(F.ws + WS_ROUTE); int* RP = RE + T * 4; float* RG = (float*)(RP + T * 4); float* RS = RG + T * 4;
    unsigned* gcnt = F.ctl + CW_CNT;
    const bf16_t* X1 = (const bf16_t*)(F.ws + WS_X1B);
    for (int blk = F.vcu; blk < T / 64; blk += F.G) {
        const int tb = blk * 64;
        {
            const int tg = wave & 3, kh = wave >> 2, r = lane & 15, kq = lane >> 4;
            const bf16_t* xp = X1 + (size_t)(tb + 16 * tg + r) * DM + 512 * kh + 4 * kq;
            const LAS float* w0 = WR + (lane & 15) * WR_PITCH + 512 * kh + 4 * kq; const LAS float* w1 = w0 + 16 * WR_PITCH;
            f32x4 acc0 = {0.f, 0.f, 0.f, 0.f}, acc1 = {0.f, 0.f, 0.f, 0.f}; float ss = 0.f;
#pragma unroll 4
            for (int i = 0; i < 32; ++i) {
                const u32x2 xw = *(const u32x2*)(xp + 16 * i); const f32x4 xv = {bf_lo(xw.x), bf_hi(xw.x), bf_lo(xw.y), bf_hi(xw.y)};
                const f32x4 b0 = *(const LAS f32x4*)(w0 + 16 * i), b1 = *(const LAS f32x4*)(w1 + 16 * i);
                ss += (xv[0] * xv[0] + xv[1] * xv[1]) + (xv[2] * xv[2] + xv[3] * xv[3]);
#pragma unroll
                for (int j = 0; j < 4; ++j) { acc0 = __builtin_amdgcn_mfma_f32_16x16x4f32(xv[j], b0[j], acc0, 0, 0, 0); acc1 = __builtin_amdgcn_mfma_f32_16x16x4f32(xv[j], b1[j], acc1, 0, 0, 0); }
            }
            ss += __shfl_xor(ss, 16); ss += __shfl_xor(ss, 32);
            if (kq == 0) SSQP[kh * 64 + 16 * tg + r] = ss;
#pragma unroll
            for (int q = 0; q < 4; ++q) { const int tok = 16 * tg + 4 * kq + q; PART[(kh * 64 + tok) * 33 + (lane & 15)] = acc0[q]; PART[(kh * 64 + tok) * 33 + 16 + (lane & 15)] = acc1[q]; }
        }
        __syncthreads();
        int te[4] = {0, 0, 0, 0}, lp[4] = {0, 0, 0, 0}; float tv[4] = {-3e38f, -3e38f, -3e38f, -3e38f}; float rstd = 0.f;
        if (tid < 64) {
            const float ssq = SSQP[tid] + SSQP[64 + tid]; rstd = 1.0f / sqrtf(ssq * (1.f / DM) + EPS);
            const float* br = a->in[I_BR];
#pragma unroll
            for (int e = 0; e < 32; ++e) {
                float v = (PART[tid * 33 + e] + PART[(64 + tid) * 33 + e]) * rstd + br[e]; int id = e;
#pragma unroll
                for (int s = 0; s < 4; ++s) { const bool gt = v > tv[s]; const float ov = tv[s]; const int oi = te[s]; tv[s] = gt ? v : ov; te[s] = gt ? id : oi; v = gt ? ov : v; id = gt ? oi : id; }
            }
#pragma unroll
            for (int s = 0; s < 4; ++s) lp[s] = __hip_atomic_fetch_add(&CNT[te[s]], 1, __ATOMIC_RELAXED, __HIP_MEMORY_SCOPE_WORKGROUP);
        }
        __syncthreads();
        if (tid < 32) { const int c = CNT[tid]; BASE[tid] = c ? (int)atomicAdd(gcnt + tid, (unsigned)c) : 0; }
        __syncthreads();
        if (tid < 64) {
            const int t = tb + tid;
            const float e1 = __expf(tv[1] - tv[0]), e2 = __expf(tv[2] - tv[0]), e3 = __expf(tv[3] - tv[0]); const float inv = 1.0f / (1.0f + e1 + e2 + e3);
            const float gts[4] = {inv, e1 * inv, e2 * inv, e3 * inv};
#pragma unroll
            for (int s = 0; s < 4; ++s) { RE[t * 4 + s] = te[s]; RP[t * 4 + s] = BASE[te[s]] + lp[s]; RG[t * 4 + s] = gts[s]; }
            RS[t] = rstd;
        }
        __syncthreads();
        if (tid < 32) CNT[tid] = 0;
        __syncthreads();
    }
}

__device__ __forceinline__ int build_tiles(const Frame& F) {
    const int tid_l = tid_local(), lane_l = tid_l & 63; (void)tid_l; (void)lane_l;
    LAS int* TB = (LAS int*)(F.lds + TILE_E_OFF); LAS int* TE = TB + 64;
    if (tid_l == 0) { int acc = 0; for (int e = 0; e < NEXP; ++e) { TB[e] = acc; const int c = (int)__hip_atomic_load(F.ctl + CW_CNT + e, RLX_AGENT); acc += (c + 255) >> 8; } TB[NEXP] = acc; }
    __syncthreads();
    if (tid_l < NEXP) { for (int t = TB[tid_l]; t < TB[tid_l + 1]; ++t) TE[t] = tid_l; }
    __syncthreads();
    return TB[NEXP];
}

__device__ __forceinline__ void p8_dispatch(const Frame& F) {
    const int tid_l = tid_local(), lane_l = tid_l & 63; (void)tid_l; (void)lane_l;
    const KArgs a = kargs();
    (void)build_tiles(F);
    const LAS int* TB = (const LAS int*)(F.lds + TILE_E_OFF);
    const int gw = F.vcu * NWAVES + F.wave, NGW = F.G * NWAVES, lane = lane_l;
    const int* RE = (const int*)(F.ws + WS_ROUTE); const int* RP = RE + T * 4; const float* RS = (const float*)(RP + T * 4) + T * 4; int* SL = (int*)(RS + T);
    const bf16_t* X1 = (const bf16_t*)(F.ws + WS_X1B); const float* gf = a->in[I_GFFN]; unsigned char* XS = F.ws + WS_XS2;
    f32x4 g[2][2];
#pragma unroll
    for (int j = 0; j < 2; ++j) { g[j][0] = *(const f32x4*)(gf + 512 * j + 8 * lane); g[j][1] = *(const f32x4*)(gf + 512 * j + 8 * lane + 4); }
    for (int t = gw; t < T; t += NGW) {
        const float rstd = RS[t];
        u32x2 w[2];
#pragma unroll
        for (int j = 0; j < 2; ++j) { const u32x4 xw = *(const u32x4*)(X1 + (size_t)t * DM + 512 * j + 8 * lane);
            const f32x4 v0 = (f32x4){bf_lo(xw.x), bf_hi(xw.x), bf_lo(xw.y), bf_hi(xw.y)} * g[j][0] * rstd, v1 = (f32x4){bf_lo(xw.z), bf_hi(xw.z), bf_lo(xw.w), bf_hi(xw.w)} * g[j][1] * rstd;
            w[j] = cvt8_fp8(v0, v1, 8.0f); }
#pragma unroll
        for (int s = 0; s < 4; ++s) { const int e = RE[t * 4 + s], slot = TB[e] * 256 + RP[t * 4 + s];
            if (lane == 0) SL[t * 4 + s] = slot;
            unsigned char* dst = XS + (size_t)slot * DM + 8 * lane;
            *(u32x2*)dst = w[0]; *(u32x2*)(dst + 512) = w[1]; }
    }
}

struct MoeOrder {
    int G, c, ntn_shift, total; const LAS int* TE; unsigned A, Bw, bexp, btile; int xbase, xcount;
    __device__ __forceinline__ void init_xcd(const LAS int* TB) {
        if (G == 256) { const int x = c >> 5; xbase = __builtin_amdgcn_readfirstlane(TB[4 * x]); xcount = (__builtin_amdgcn_readfirstlane(TB[4 * x + 4]) - xbase) << ntn_shift; } else { xbase = -1; xcount = 0; }
    }
    __device__ __forceinline__ bool next(int i, Unit& u) const {
        if (xbase >= 0) { const int L = i * 32 + (c & 31); if (L >= xcount) return false;
            u.pm = xbase + (L >> ntn_shift); u.pn = L & ((1 << ntn_shift) - 1); u.aux = __builtin_amdgcn_readfirstlane(TE[u.pm]); return true; }
        const int L = i * G + c; if (L >= total) return false;
        u.pm = L >> ntn_shift; u.pn = L & ((1 << ntn_shift) - 1); u.aux = __builtin_amdgcn_readfirstlane(TE[u.pm]); return true;
    }
    __device__ __forceinline__ unsigned a_off(const Unit& u) const { return A + (unsigned)u.pm * (256 * 1024); }
    __device__ __forceinline__ unsigned b_off(const Unit& u) const { return Bw + (unsigned)u.aux * bexp + (unsigned)u.pn * btile; }
};
struct EpiSwiglu {
    static constexpr bool PERM = true;
    unsigned char* ACT; const float* bgu;
    __device__ __forceinline__ void operator()(const f32x4 (&acc)[2][2][4][2], const Unit& u, int wr, int wc, int fr, int fq) const {
        const int row0 = u.pm * 256 + wr * 64 + fr, j0 = u.pn * 128 + wc * 32 + 8 * fq;
        const float* bb = bgu + (size_t)u.aux * 2048 + j0;
        unsigned char* dst0 = ACT + (size_t)row0 * DEXP + j0;
#pragma unroll
        for (int ai = 0; ai < 2; ++ai)
#pragma unroll
            for (int m = 0; m < 4; ++m) {
#pragma unroll
                for (int n = 0; n < 2; ++n) {
                    asm volatile("" : "+v"(bb));
                    const f32x4 g = acc[ai][0][m][n] + *(const f32x4*)(bb + 4 * n), up = acc[ai][1][m][n] + *(const f32x4*)(bb + 1024 + 4 * n);
                    float r[4];
#pragma unroll
                    for (int e = 0; e < 4; ++e) { const float gg = fminf(g[e], 7.0f), uu = fminf(fmaxf(up[e], -7.0f), 7.0f); r[e] = (uu + 1.0f) * gg * fast_sigmoid(1.702f * gg) * 8.0f; }
                    int w = __builtin_amdgcn_cvt_pk_fp8_f32(r[0], r[1], 0, false); w = __builtin_amdgcn_cvt_pk_fp8_f32(r[2], r[3], w, true);
                    *(int*)(dst0 + (size_t)(ai * 128 + m * 16) * DEXP + 4 * n) = w;
                }
                asm volatile("" ::: "memory");
            }
    }
};
struct EpiDown {
    static constexpr bool PERM = true;
    unsigned char* Y; const float* bd;
    __device__ __forceinline__ void operator()(const f32x4 (&acc)[2][2][4][2], const Unit& u, int wr, int wc, int fr, int fq) const {
        const int row0 = u.pm * 256 + wr * 64 + fr, col0 = u.pn * 256 + wc * 32 + 8 * fq;
        const float* bb = bd + (size_t)u.aux * DM + col0;
#pragma unroll
        for (int ai = 0; ai < 2; ++ai)
#pragma unroll
            for (int m = 0; m < 4; ++m) { unsigned char* rowp = Y + (size_t)(row0 + ai * 128 + m * 16) * DM + col0;
                asm volatile("" : "+v"(bb));
#pragma unroll
                for (int bj = 0; bj < 2; ++bj) { const f32x4 v0 = acc[ai][bj][m][0] + *(const f32x4*)(bb + bj * 128), v1 = acc[ai][bj][m][1] + *(const f32x4*)(bb + bj * 128 + 4);
                    *(u32x2*)(rowp + bj * 128) = cvt8_fp8(v0, v1, 8.0f); } asm volatile("" ::: "memory"); }
    }
};

__device__ __forceinline__ void p11_combine(const Frame& F) {
    const int tid_l = tid_local(), lane_l = tid_l & 63; (void)tid_l; (void)lane_l;
    const KArgs a = kargs();
    const int gw = F.vcu * NWAVES + F.wave, NGW = F.G * NWAVES, lane = lane_l;
    const int* RE = (const int*)(F.ws + WS_ROUTE); const float* RG = (const float*)(RE + T * 8); const int* SL = (const int*)(RG + T * 4 + T);
    const unsigned char* Y = F.ws + WS_XS; bf16_t* HP = (bf16_t*)(F.ws + WS_HN); const bf16_t* X1 = (const bf16_t*)(F.ws + WS_X1B); bf16_t* X2 = (bf16_t*)(F.ws + WS_X2B); const float* gp = a->in[I_GPLE];
    f32x4 g[2][2];
#pragma unroll
    for (int j = 0; j < 2; ++j) { g[j][0] = *(const f32x4*)(gp + 512 * j + 8 * lane); g[j][1] = *(const f32x4*)(gp + 512 * j + 8 * lane + 4); }
    for (int t = gw; t < T; t += NGW) {
        f32x4 v[2][2];
#pragma unroll
        for (int j = 0; j < 2; ++j) { const u32x4 xw = *(const u32x4*)(X1 + (size_t)t * DM + 512 * j + 8 * lane); v[j][0] = (f32x4){bf_lo(xw.x), bf_hi(xw.x), bf_lo(xw.y), bf_hi(xw.y)}; v[j][1] = (f32x4){bf_lo(xw.z), bf_hi(xw.z), bf_lo(xw.w), bf_hi(xw.w)}; }
#pragma unroll
        for (int s = 0; s < 4; ++s) { const int slot = SL[t * 4 + s]; const float gt = RG[t * 4 + s] * 0.125f;
#pragma unroll
            for (int j = 0; j < 2; ++j) { const u32x2 y = *(const u32x2*)(Y + (size_t)slot * DM + 512 * j + 8 * lane);
                const f32x2 a0 = __builtin_amdgcn_cvt_pk_f32_fp8((int)y.x, false), a1 = __builtin_amdgcn_cvt_pk_f32_fp8((int)y.x, true), b0 = __builtin_amdgcn_cvt_pk_f32_fp8((int)y.y, false), b1 = __builtin_amdgcn_cvt_pk_f32_fp8((int)y.y, true);
                v[j][0] += (f32x4){a0[0], a0[1], a1[0], a1[1]} * gt; v[j][1] += (f32x4){b0[0], b0[1], b1[0], b1[1]} * gt; } }
        float ss = 0.f;
#pragma unroll
        for (int j = 0; j < 2; ++j)
#pragma unroll
            for (int n = 0; n < 2; ++n) { const f32x4 q = v[j][n]; ss += (q[0] * q[0] + q[1] * q[1]) + (q[2] * q[2] + q[3] * q[3]); u32x2 w; w.x = cvt_pk_bf16(q[0], q[1]); w.y = cvt_pk_bf16(q[2], q[3]); *(u32x2*)(X2 + (size_t)t * DM + 512 * j + 8 * lane + 4 * n) = w; }
        const float rstd = 1.0f / sqrtf(wave_sum(ss) * (1.f / DM) + EPS);
#pragma unroll
        for (int j = 0; j < 2; ++j) { const f32x4 q0 = v[j][0] * g[j][0] * rstd, q1 = v[j][1] * g[j][1] * rstd;
            u32x4 w; w.x = cvt_pk_bf16(q0[0], q0[1]); w.y = cvt_pk_bf16(q0[2], q0[3]); w.z = cvt_pk_bf16(q1[0], q1[1]); w.w = cvt_pk_bf16(q1[2], q1[3]);
            *(u32x4*)(HP + (size_t)t * DM + 512 * j + 8 * lane) = w; }
    }
}
struct EpiPle {
    static constexpr bool PERM = false;
    float* out; const bf16_t* E; const bf16_t* X2;
    __device__ __forceinline__ void operator()(const f32x4 (&acc)[2][2][4][2], const Unit& u, int wr, int wc, int fr, int fq) const {
        const int row0 = u.pm * 256 + wr * 64 + fr, col0 = u.pn * 256 + wc * 32 + 4 * fq;
#pragma unroll
        for (int ai = 0; ai < 2; ++ai)
#pragma unroll
            for (int m = 0; m < 4; ++m) { const size_t off = (size_t)(row0 + ai * 128 + m * 16) * DM + col0;
#pragma unroll
                for (int bj = 0; bj < 2; ++bj)
#pragma unroll
                    for (int n = 0; n < 2; ++n) { const size_t o = off + bj * 128 + n * 16; const u32x2 ev = *(const u32x2*)(E + o); const f32x4 a4 = acc[ai][bj][m][n];
                        const u32x2 xw = *(const u32x2*)(X2 + o); f32x4 r = {bf_lo(xw.x), bf_hi(xw.x), bf_lo(xw.y), bf_hi(xw.y)};
                        r[0] += fast_sigmoid(a4[0]) * bf_lo(ev.x); r[1] += fast_sigmoid(a4[1]) * bf_hi(ev.x); r[2] += fast_sigmoid(a4[2]) * bf_lo(ev.y); r[3] += fast_sigmoid(a4[3]) * bf_hi(ev.y);
                        *(f32x4*)(out + o) = r; } }
    }
};

constexpr int N_PHASES = 13;
__global__ void __launch_bounds__(NWAVES * 64, 2) fwd_kernel(Args args) {
    extern __shared__ __attribute__((aligned(16))) unsigned char lds_raw[];
    Frame F;
    F.lds = (LAS unsigned char*)lds_raw; F.MISC = (volatile LAS unsigned*)(F.lds + MISC_OFF);
    F.wave = __builtin_amdgcn_readfirstlane(threadIdx.x >> 6);
    F.G = gridDim.x; { const int bx = blockIdx.x; F.vcu = (F.G % 8 == 0) ? (bx % 8) * (F.G / 8) + bx / 8 : bx; }
    { const KArgs ka = kargs(); F.out = ka->out; F.ws = ka->ws; F.ctl = (unsigned*)(ka->ws + WS_CTL); }
    { const int t0_ = tid_local(); if (t0_ < 32) F.MISC[t0_] = 0u; }
    __syncthreads();
    int lo, hi; { const KArgs ka = kargs(); lo = ka->ph_lo; hi = ka->ph_hi; }
    const bool multi = (hi - lo) > 1;
    XcdBarrier bar; bar.bar = F.ctl + CW_BAR; bar.x = 0; bar.st = nullptr;
    if (multi) bar = xcd_barrier_post(F.ctl + CW_BAR, F.MISC);
#ifndef PH_MASK
#define PH_MASK 0x1fff
#endif
#define IN(k) ((((PH_MASK) >> (k)) & 1) && lo <= (k) && (k) < hi)
#define SEAM(k) do { if (IN(k) && IN((k) + 1)) xcd_barrier(bar); } while (0)
    unsigned char* ws = F.ws;
    LAS unsigned char* ring = F.lds;
    const __amdgpu_buffer_rsrc_t rsrc = __builtin_amdgcn_make_buffer_rsrc((void*)ws, 0, (int)WS_END, 0x00020000);

    if (IN(0)) { p0_prologue(F); } SEAM(0);

    if (IN(1)) {
        if (GATES_FP8 && !P1_FP8) {
          { DenseOrder S; S.init(64, 8, F.G, (int)blockIdx.x, WS_HN8, 512, WS_WIN8 + (size_t)1024 * 1024, 512);
            EpiProj E{(bf16_t*)(ws + WS_PROJ), (bf16_t*)(ws + WS_GATES), 4};
            pg8::gemm_phase<EpiProj, DenseOrder, true, true, true>(ring, rsrc, pg8::Shape{1024, 1024, 1024, 0x7c7c7c7c, 0x7c7c7c7c}, S, E); }
          { DenseOrder S; S.init(64, 4, F.G, (int)blockIdx.x, WS_HN, 1024, WS_WIN, 1024);
            EpiProj E{(bf16_t*)(ws + WS_PROJ), (bf16_t*)(ws + WS_GATES), 0};
            pg8::gemm_phase<EpiProj, DenseOrder, true, true>(ring, rsrc, pg8::Shape{2048, 2048, 2048, 0, 0}, S, E); }
        } else
        { DenseOrder S; S.init(64, 12, F.G, (int)blockIdx.x, WS_HN, P1_FP8 ? 512 : 1024, WS_WIN, P1_FP8 ? 512 : 1024);
          EpiProj E{(bf16_t*)(ws + WS_PROJ), (bf16_t*)(ws + WS_GATES), 0};
          if (P1_FP8) pg8::gemm_phase<EpiProj, DenseOrder, true, true, true>(ring, rsrc, pg8::Shape{1024, 1024, 1024, 0x7c7c7c7c, 0x7c7c7c7c}, S, E);
          else pg8::gemm_phase<EpiProj, DenseOrder, true, true>(ring, rsrc, pg8::Shape{2048, 2048, 2048, 0, 0}, S, E); }
        { DenseOrder S; S.init(64, 4, F.G, (int)blockIdx.x, WS_PB, 256, WS_WPLE, 256);
          EpiBf16 E{(bf16_t*)(ws + WS_E), 1024};
          pg8::gemm_phase<EpiBf16, DenseOrder, true, true>(ring, rsrc, pg8::Shape{512, 512, 512, 0, 0}, S, E); }
    } SEAM(1);

    if (IN(2)) { p2_rows(F); } SEAM(2);

    if (IN(3)) {
#ifndef P3M
#define P3M 7
#endif
        if (P3M & 1) { DenseOrder S; S.init(64, 4, F.G, (int)blockIdx.x, WS_A2 + 512, 512, WS_WKV, 256);
          EpiKV E{(bf16_t*)(ws + WS_K), (bf16_t*)(ws + WS_V), kargs()->in[I_GKNOPE]};
          pg8::gemm_phase<EpiKV, DenseOrder, true, true>(ring, rsrc, pg8::Shape{512, 1024, 512, 0, 0}, S, E); }
        if (P3M & 2) { DenseOrder S; S.init(64, 3, F.G, (int)blockIdx.x, WS_A2, 512, WS_WQ, 256);
          EpiQ E{(bf16_t*)(ws + WS_Q), (float*)(ws + WS_SSQ), (const float*)(ws + WS_COS), (const float*)(ws + WS_SIN), kargs()->in[I_GQHEAD]};
          pg8::gemm_phase<EpiQ, DenseOrder, true, true>(ring, rsrc, pg8::Shape{512, 1024, 512, 0, 0}, S, E); }
        if (P3M & 4) { DenseOrder S; S.init(64, 2, F.G, (int)blockIdx.x, WS_POOLED, 512, WS_WPOOL, 256, 512);
          EpiBf16 E{(bf16_t*)(ws + WS_MIXED), 512};
          pg8::gemm_phase<EpiBf16, DenseOrder, true, true>(ring, rsrc, pg8::Shape{512, 1024, 512, 0, 0}, S, E); }
    } SEAM(3);

    if (IN(4)) {
        u32x4 srd; { const unsigned long wb = (unsigned long)ws; srd.x = (unsigned)__builtin_amdgcn_readfirstlane((int)(unsigned)wb); srd.y = (unsigned)__builtin_amdgcn_readfirstlane((int)(unsigned)(wb >> 32)); srd.z = (unsigned)WS_END; srd.w = 0x00020000u; }
        att::ConvState CV; CV.next = __builtin_amdgcn_readfirstlane(F.vcu * NWAVES + F.wave); CV.end = CONV_IN_ATTN ? att::CV_ITEMS : 0; CV.cur = -1;
        for (int it = F.vcu; it < 256; it += F.G) {
            const int bh = it >> 3, pr = it & 7;
            att::attn_unit(ring, srd, CV, ws, bh, 15 - pr, (const bf16_t*)(ws + WS_Q), (unsigned)WS_K, (unsigned)WS_V, (const float*)(ws + WS_SSQ), (bf16_t*)(ws + WS_ATT));
            att::attn_unit(ring, srd, CV, ws, bh, pr, (const bf16_t*)(ws + WS_Q), (unsigned)WS_K, (unsigned)WS_V, (const float*)(ws + WS_SSQ), (bf16_t*)(ws + WS_ATT));
        }
        { const LAS float* cb = (const LAS float*)(F.lds + att::CONV_OFF + F.wave * att::CONV_BYTES);
          const unsigned cbaddr = (unsigned)__builtin_amdgcn_readfirstlane((int)(unsigned)(unsigned long)(F.lds + att::CONV_OFF + F.wave * att::CONV_BYTES));
          const int lane_l = tid_local() & 63;
          while (CV.cur >= 0 || CV.next < CV.end) {
            if (CV.cur >= 0) { asm volatile("s_waitcnt vmcnt(0)" ::: "memory"); const att::ConvItem I = att::cv_setup(CV.cur, kargs()->in[I_WGU], kargs()->in[I_WD], ws + WS_WGU, ws + WS_WD); att::cv_out(I, cb, lane_l); }
            if (CV.next < CV.end) { const att::ConvItem I = att::cv_setup(CV.next, kargs()->in[I_WGU], kargs()->in[I_WD], ws + WS_WGU, ws + WS_WD); asm volatile("s_waitcnt lgkmcnt(0)" ::: "memory"); att::cv_dma(I, cbaddr, lane_l); CV.cur = CV.next; CV.next += 2048; } else CV.cur = -1;
          } }
    } SEAM(4);

    if (IN(5)) {
        MixOrder S{F.G, F.vcu, (unsigned)WS_ATT, (unsigned)WS_MIXED, (unsigned)WS_WAO, (unsigned)WS_WPO};
        EpiMix E{(bf16_t*)(ws + WS_MIX), (const bf16_t*)(ws + WS_GATES)};
        pg8::gemm_phase<EpiMix, MixOrder, true, true>(ring, rsrc, pg8::Shape{1024, 1024, 1024, 0, 0}, S, E);
    } SEAM(5);

    if (IN(6)) {
        DenseOrder S; S.init(64, 4, F.G, (int)blockIdx.x, WS_MIX, 1024, WS_WO, 1024);
        EpiRes E{kargs()->in[I_X], (bf16_t*)(ws + WS_X1B)};
        pg8::gemm_phase<EpiRes, DenseOrder, true, true>(ring, rsrc, pg8::Shape{2048, 2048, 2048, 0, 0}, S, E);
    } SEAM(6);

    if (IN(7)) { p7_router(F); } SEAM(7);

    if (IN(8)) { p8_dispatch(F); } SEAM(8);

    if (IN(9)) {
        const int TM = build_tiles(F);
        MoeOrder S{F.G, F.vcu, 3, TM * 8, (const LAS int*)(F.lds + TILE_E_OFF) + 64, (unsigned)WS_XS2, (unsigned)WS_WGU, 2048u * 1024u, 256u * 1024u, 0, 0}; S.init_xcd((const LAS int*)(F.lds + TILE_E_OFF));
        EpiSwiglu E{ws + WS_ACT, kargs()->in[I_BGU]};
        pg8::gemm_phase<EpiSwiglu, MoeOrder, true, true, true>(ring, rsrc, pg8::Shape{1024, 1024, 1024, 0x7c7c7c7c, 0x7c7c7c7c}, S, E);
    } SEAM(9);

    if (IN(10)) {
        const int TM = build_tiles(F);
        MoeOrder S{F.G, F.vcu, 2, TM * 4, (const LAS int*)(F.lds + TILE_E_OFF) + 64, (unsigned)WS_ACT, (unsigned)WS_WD, 1024u * 1024u, 256u * 1024u, 0, 0}; S.init_xcd((const LAS int*)(F.lds + TILE_E_OFF));
        EpiDown E{ws + WS_XS, kargs()->in[I_BD]};
        pg8::gemm_phase<EpiDown, MoeOrder, true, true, true>(ring, rsrc, pg8::Shape{1024, 1024, 1024, 0x7c7c7c7c, 0x7c7c7c7c}, S, E);
    } SEAM(10);

    if (IN(11)) { p11_combine(F); } SEAM(11);

    if (IN(12)) {
        DenseOrder S; S.init(64, 4, F.G, (int)blockIdx.x, WS_HN, 1024, WS_WPG, 1024);
        EpiPle E{F.out, (const bf16_t*)(ws + WS_E), (const bf16_t*)(ws + WS_X2B)};
        pg8::gemm_phase<EpiPle, DenseOrder, true, true>(ring, rsrc, pg8::Shape{2048, 2048, 2048, 0, 0}, S, E);
    }
#undef IN
#undef SEAM
}

extern "C" void kernel_launch(void* const* d_in, const int* in_sizes, int n_in, void* d_out, int out_size, void* d_ws, size_t ws_size, hipStream_t stream) {
    static int grid = 0;
    if (grid == 0) {
        if (n_in != 27 || out_size != T * DM || ws_size < WS_END) { fprintf(stderr, "kernel_launch: unexpected shapes (n_in %d, out %d, ws %zu)\n", n_in, out_size, ws_size); grid = -1; return; }
        int dev = 0, cus = 0;
        if (hipGetDevice(&dev) != hipSuccess || hipDeviceGetAttribute(&cus, hipDeviceAttributeMultiprocessorCount, dev) != hipSuccess) { grid = -1; return; }
        if (hipFuncSetAttribute((const void*)fwd_kernel, hipFuncAttributeMaxDynamicSharedMemorySize, LDS_BYTES) != hipSuccess) { fprintf(stderr, "kernel_launch: hipFuncSetAttribute failed\n"); grid = -1; return; }
        int per_cu = 0;
        if (hipOccupancyMaxActiveBlocksPerMultiprocessor(&per_cu, (const void*)fwd_kernel, NWAVES * 64, LDS_BYTES) != hipSuccess || per_cu < 1) fprintf(stderr, "kernel_launch: occupancy query says %d\n", per_cu);
        (void)hipGetLastError();
        grid = cus;
    }
    if (grid < 0) return;
    (void)hipMemsetAsync((char*)d_ws + WS_CTL, 0, CTL_ZERO_BYTES, stream);
    Args a{};
    for (int i = 0; i < 27; ++i) a.in[i] = (const float*)d_in[i];
    a.out = (float*)d_out; a.ws = (unsigned char*)d_ws;
#ifndef DUP_PHASE
    a.ph_lo = 0; a.ph_hi = N_PHASES; hipLaunchKernelGGL(fwd_kernel, dim3(grid), dim3(NWAVES * 64), LDS_BYTES, stream, a);
#else
    a.ph_lo = 0; a.ph_hi = DUP_PHASE + 1; hipLaunchKernelGGL(fwd_kernel, dim3(grid), dim3(NWAVES * 64), LDS_BYTES, stream, a);
    (void)hipMemsetAsync((char*)d_ws + WS_CTL + CW_BAR * 4, 0, XCD_BAR_WORDS * 4, stream);
    a.ph_lo = DUP_PHASE; a.ph_hi = N_PHASES; hipLaunchKernelGGL(fwd_kernel, dim3(grid), dim3(NWAVES * 64), LDS_BYTES, stream, a);
#endif
}
```

```cpp
#include <hip/hip_runtime.h>
#include <cstdio>
#include <cstdint>

#define LAS __attribute__((address_space(3)))
#define GAS __attribute__((address_space(1)))
typedef unsigned short bf16_t;
typedef short bf16x8 __attribute__((ext_vector_type(8)));
typedef short s16x4 __attribute__((ext_vector_type(4)));
typedef float f32x4 __attribute__((ext_vector_type(4)));
typedef float f32x2 __attribute__((ext_vector_type(2)));
typedef float f32x16 __attribute__((ext_vector_type(16)));
typedef unsigned u32x4 __attribute__((ext_vector_type(4)));
typedef unsigned u32x2 __attribute__((ext_vector_type(2)));

constexpr int NB = 4, SEQ = 4096, T = NB * SEQ, DM = 1024, NH = 8, DK = 96, DV = 64;
constexpr int NEXP = 32, TOPK = 4, DEXP = 1024, PLE = 256;
constexpr float EPS = 1e-6f;
constexpr int XS_ROWS = T * TOPK + NEXP * 256;

typedef __bf16 bf16x2_t __attribute__((ext_vector_type(2)));
__device__ __forceinline__ unsigned cvt_pk_bf16(float lo, float hi) { f32x2 v = {lo, hi}; return __builtin_bit_cast(unsigned, __builtin_convertvector(v, bf16x2_t)); }
__device__ __forceinline__ u32x2 cvt8_fp8(const f32x4 a, const f32x4 b, float sc) {
    int w0 = __builtin_amdgcn_cvt_pk_fp8_f32(a[0] * sc, a[1] * sc, 0, false); w0 = __builtin_amdgcn_cvt_pk_fp8_f32(a[2] * sc, a[3] * sc, w0, true);
    int w1 = __builtin_amdgcn_cvt_pk_fp8_f32(b[0] * sc, b[1] * sc, 0, false); w1 = __builtin_amdgcn_cvt_pk_fp8_f32(b[2] * sc, b[3] * sc, w1, true);
    u32x2 r; r.x = (unsigned)w0; r.y = (unsigned)w1; return r;
}
__device__ __forceinline__ float bf_lo(unsigned w) { return __uint_as_float(w << 16); }
__device__ __forceinline__ float bf_hi(unsigned w) { return __uint_as_float(w & 0xffff0000u); }
__device__ __forceinline__ float bf1(bf16_t h) { return __uint_as_float(((unsigned)h) << 16); }
__device__ __forceinline__ float fast_sigmoid(float v) { return __builtin_amdgcn_rcpf(1.0f + __builtin_amdgcn_exp2f(-1.4426950408889634f * v)); }
__device__ __forceinline__ int lane_id() { return (int)__builtin_amdgcn_mbcnt_hi(~0u, __builtin_amdgcn_mbcnt_lo(~0u, 0u)); }
__device__ __forceinline__ int tid_local() { int t = threadIdx.x; asm volatile("" : "+v"(t)); return t; }
__device__ __forceinline__ float wave_sum(float v) {
#pragma unroll
    for (int o = 1; o < 64; o <<= 1) v += __shfl_xor(v, o);
    return v;
}

namespace pg8 {
constexpr int BM = 256, BK = 64, HALF = 128, HTB = HALF * BK * 2, STAGE_BYTES = 8 * HTB;
__host__ __device__ __forceinline__ int lds_byte(int r, int c) { const int st = (r >> 4) * 2 + (c >> 5), rr = r & 15, cc = c & 31, ob = rr * 64 + cc * 2; return st * 1024 + (ob ^ (((ob >> 9) & 1) << 5)); }
__host__ __device__ __forceinline__ void stage_rc(int b, int& R, int& C) { const int st = b / 1024, sb = b % 1024, swz = sb ^ (((sb >> 9) & 1) << 5); R = (st >> 1) * 16 + swz / 64; C = (st & 1) * 32 + (swz % 64) / 2; }
__host__ __device__ __forceinline__ int perm32(int rho) { const int n = rho >> 4, i = rho & 15; return 8 * (i >> 2) + 4 * n + (i & 3); }

struct Unit { int pm, pn, aux; };
struct Shape { int Kb, lda, ldb, sw, sa; };
typedef int v8i_t __attribute__((ext_vector_type(8))); typedef int v4i_t __attribute__((ext_vector_type(4)));

template <class Epi, class Sched, bool ALIGN_EPI, bool SP2, bool MX = false, bool GATHER = false>
__device__ __forceinline__ void gemm_phase(LAS unsigned char* lds, const __amdgpu_buffer_rsrc_t rsrc, const Shape g, const Sched& S, const Epi& E, unsigned long long* gp_out = nullptr) {
    const int tid = tid_local(), wid = __builtin_amdgcn_readfirstlane(tid >> 6), lane = tid & 63, wr = wid >> 2, wc = wid & 3, fr = lane & 15, fq = lane >> 4;
    int nt = g.Kb / 128; asm volatile("" : "+s"(nt));
    unsigned voffA, voffB;
    { int R, C; stage_rc(tid * 16, R, C); const int Rb = Epi::PERM ? ((R & ~31) + perm32(R & 31)) : R;
      voffA = GATHER ? (unsigned)(C * 2 + (R << 16)) : (unsigned)(R * g.lda + C * 2); voffB = (unsigned)(Rb * g.ldb + C * 2); }
    const unsigned p2A = 64u * (unsigned)g.lda, p2B = 64u * (unsigned)g.ldb;
    const unsigned kstep = 128u;
    const unsigned hstepA = (unsigned)HALF * g.lda, hstepB = (unsigned)HALF * g.ldb;
    const unsigned ldsw = (unsigned)wid * 1024u;
    const int aoff = lds_byte(wr * 64 + fr, fq * 8), boff = lds_byte(wc * 32 + fr, fq * 8);
#define PG8_SA(b, h) (((b) * 2 + (h)) * HTB)
#define PG8_SB(b, h) ((4 + (b) * 2 + (h)) * HTB)
#define PG8_STAGE(bufoff, gbase, voff) do { \
        __builtin_amdgcn_raw_ptr_buffer_load_lds(rsrc, (LAS void*)(lds + (bufoff) + ldsw), 16, voff, (gbase), 0, 0); \
        __builtin_amdgcn_raw_ptr_buffer_load_lds(rsrc, (LAS void*)(lds + (bufoff) + ldsw + 8192), 16, voff, (gbase) + p2##voff, 0, 0); } while (0)
#define p2voffA p2A
#define p2voffB p2B
#define PG8_STAGEA(bufoff, gk, h, tab) do { if constexpr (GATHER) { \
        const LAS int* tb_ = (const LAS int*)(lds + STAGE_BYTES) + (tab) * 256 + (h) * 128 + (int)(voffA >> 16); const unsigned cb_ = voffA & 0xffffu; \
        const unsigned i0_ = (unsigned)tb_[0], i1_ = (unsigned)tb_[64]; \
        __builtin_amdgcn_raw_ptr_buffer_load_lds(rsrc, (LAS void*)(lds + (bufoff) + ldsw), 16, i0_ * (unsigned)g.lda + cb_, (gk), 0, 0); \
        __builtin_amdgcn_raw_ptr_buffer_load_lds(rsrc, (LAS void*)(lds + (bufoff) + ldsw + 8192), 16, i1_ * (unsigned)g.lda + cb_, (gk), 0, 0); } \
      else { PG8_STAGE(bufoff, (gk) + (h) * hstepA, voffA); } } while (0)
#define PG8_LDA(dst, b, h) do { _Pragma("unroll") for (int m = 0; m < 4; ++m) _Pragma("unroll") for (int k = 0; k < 2; ++k) dst[m][k] = *(const LAS bf16x8*)(lds + PG8_SA(b, h) + aoff + m * 2048 + k * 1024); } while (0)
#define PG8_LDB(dst, b, h) do { _Pragma("unroll") for (int n = 0; n < 2; ++n) _Pragma("unroll") for (int k = 0; k < 2; ++k) dst[n][k] = *(const LAS bf16x8*)(lds + PG8_SB(b, h) + boff + n * 2048 + k * 1024); } while (0)
#define PG8_CAT(x, y) __builtin_shufflevector(__builtin_bit_cast(v4i_t, x), __builtin_bit_cast(v4i_t, y), 0, 1, 2, 3, 4, 5, 6, 7)
#define PG8_MMA(ai, bj, At, Bt) do { __builtin_amdgcn_s_setprio(1); if constexpr (MX) { _Pragma("unroll") for (int m = 0; m < 4; ++m) _Pragma("unroll") for (int n = 0; n < 2; ++n) \
        acc[ai][bj][m][n] = __builtin_amdgcn_mfma_scale_f32_16x16x128_f8f6f4(PG8_CAT(Bt[n][0], Bt[n][1]), PG8_CAT(At[m][0], At[m][1]), acc[ai][bj][m][n], 0, 0, 0, g.sw, 0, g.sa); } else { \
        _Pragma("unroll") for (int m = 0; m < 4; ++m) _Pragma("unroll") for (int n = 0; n < 2; ++n) _Pragma("unroll") for (int k = 0; k < 2; ++k) \
        acc[ai][bj][m][n] = __builtin_amdgcn_mfma_f32_16x16x32_bf16(Bt[n][k], At[m][k], acc[ai][bj][m][n], 0, 0, 0); } __builtin_amdgcn_s_setprio(0); } while (0)
#define PG8_WAIT_V(n) asm volatile("s_waitcnt vmcnt(" #n ")" ::: "memory")
#define PG8_WAIT_L(n) asm volatile("s_waitcnt lgkmcnt(" #n ")" ::: "memory")
#define PG8_BAR __builtin_amdgcn_s_barrier()
#define PG8_SCHED __builtin_amdgcn_sched_barrier(0)
#ifdef GP_PROBE
    unsigned long long gp_cycles = 0, gp_tiles = 0; const unsigned long long gp_p0 = __builtin_amdgcn_s_memtime(), gp_r0 = __builtin_amdgcn_s_memrealtime();
#endif
    Unit cur, nxt; int ui = 0;
    if (!S.next(0, cur)) return;
    f32x4 acc[2][2][4][2];
    E.init(acc, cur, wc, fq);
    bf16x8 At[4][2], B0[2][2], B1[2][2];
    unsigned cA = S.a_off(cur), cB = S.b_off(cur);
    int tab_c = 0; (void)tab_c;
    if constexpr (GATHER) {
        if (wid < 4) {
            const unsigned dst_ = (unsigned)__builtin_amdgcn_readfirstlane((int)(unsigned)(unsigned long)(lds + STAGE_BYTES + (wid * 64) * 4));
            const unsigned vo_ = (unsigned)((wid * 64 + lane) * 4); const unsigned so_ = S.tok_off(cur);
            asm volatile("s_nop 4\n\ts_mov_b32 m0, %0\n\ts_nop 0\n\tbuffer_load_dword %1, %2, %3 offen lds" :: "s"(dst_), "v"(vo_), "s"(rsrc), "s"(so_) : "m0", "memory"); }
        asm volatile("s_waitcnt vmcnt(0)" ::: "memory"); __syncthreads();
    }
    if constexpr (SP2) {
        PG8_STAGE(PG8_SB(0, 0), cB, voffB); PG8_STAGE(PG8_SB(0, 1), cB + hstepB, voffB); PG8_STAGEA(PG8_SA(0, 0), cA, 0, tab_c); PG8_STAGEA(PG8_SA(0, 1), cA, 1, tab_c);
        if (wr == 1) PG8_BAR;
        PG8_WAIT_V(2); PG8_BAR;
        PG8_STAGE(PG8_SB(1, 0), cB + kstep, voffB); PG8_STAGEA(PG8_SA(1, 0), cA + kstep, 0, tab_c); PG8_STAGE(PG8_SB(1, 1), cB + hstepB + kstep, voffB);
        PG8_WAIT_V(6); PG8_BAR;
    } else {
        PG8_STAGE(PG8_SB(0, 0), cB, voffB); PG8_STAGEA(PG8_SA(0, 0), cA, 0, tab_c); PG8_STAGE(PG8_SB(0, 1), cB + hstepB, voffB); PG8_STAGEA(PG8_SA(0, 1), cA, 1, tab_c);
        if (wr == 1) PG8_BAR;
        PG8_WAIT_V(4); PG8_BAR;
        PG8_STAGE(PG8_SB(1, 0), cB + kstep, voffB); PG8_STAGEA(PG8_SA(1, 0), cA + kstep, 0, tab_c); PG8_STAGE(PG8_SB(1, 1), cB + hstepB + kstep, voffB);
        PG8_WAIT_V(6); PG8_BAR;
    }
    for (;;) {
        const bool has_next = S.next(ui + 1, nxt);
        const unsigned nA = has_next ? S.a_off(nxt) : cA, nB = has_next ? S.b_off(nxt) : cB;
        if constexpr (GATHER) { if (has_next && wid < 4) {
            const unsigned dst_ = (unsigned)__builtin_amdgcn_readfirstlane((int)(unsigned)(unsigned long)(lds + STAGE_BYTES + ((tab_c ^ 1) * 256 + wid * 64) * 4));
            const unsigned vo_ = (unsigned)((wid * 64 + lane) * 4); const unsigned so_ = S.tok_off(nxt);
            asm volatile("s_nop 4\n\ts_mov_b32 m0, %0\n\ts_nop 0\n\tbuffer_load_dword %1, %2, %3 offen lds" :: "s"(dst_), "v"(vo_), "s"(rsrc), "s"(so_) : "m0", "memory"); } }
#ifdef GP_PROBE
        const unsigned long long gp_t0 = __builtin_amdgcn_s_memtime();
#endif
#pragma nounroll
        for (int t = 0; t < nt; t += 2) {
            const bool last = (t == nt - 2);
            const unsigned a1 = cA + (unsigned)(t + 1) * kstep;
            const unsigned a2 = last ? nA : cA + (unsigned)(t + 2) * kstep, b2 = last ? nB : cB + (unsigned)(t + 2) * kstep;
            const unsigned a3 = a2 + kstep, b3 = b2 + kstep; const int tab_2 = last ? (tab_c ^ 1) : tab_c; (void)tab_2;
            if constexpr (SP2) {
            PG8_LDB(B0, 0, 0); PG8_LDB(B1, 0, 1); PG8_SCHED; PG8_LDA(At, 0, 0); PG8_STAGEA(PG8_SA(1, 1), a1, 1, tab_c);
            PG8_WAIT_V(8); PG8_WAIT_L(0); PG8_BAR; PG8_MMA(0, 0, At, B0); PG8_MMA(0, 1, At, B1); PG8_BAR; PG8_SCHED;
            PG8_LDA(At, 0, 1); PG8_STAGE(PG8_SB(0, 0), b2, voffB); PG8_STAGE(PG8_SB(0, 1), b2 + hstepB, voffB); PG8_STAGEA(PG8_SA(0, 0), a2, 0, tab_2);
            PG8_WAIT_V(8); PG8_WAIT_L(0); PG8_BAR; PG8_MMA(1, 0, At, B0); PG8_MMA(1, 1, At, B1); PG8_BAR; PG8_SCHED;
            PG8_LDB(B0, 1, 0); PG8_LDB(B1, 1, 1); PG8_SCHED; PG8_LDA(At, 1, 0); PG8_STAGEA(PG8_SA(0, 1), a2, 1, tab_2);
            PG8_WAIT_V(8); PG8_WAIT_L(0); PG8_BAR; PG8_MMA(0, 0, At, B0); PG8_MMA(0, 1, At, B1); PG8_BAR; PG8_SCHED;
            PG8_LDA(At, 1, 1); PG8_STAGE(PG8_SB(1, 0), b3, voffB); PG8_STAGE(PG8_SB(1, 1), b3 + hstepB, voffB); PG8_STAGEA(PG8_SA(1, 0), a3, 0, tab_2);
            PG8_WAIT_V(8); PG8_WAIT_L(0); PG8_BAR; PG8_MMA(1, 0, At, B0); PG8_MMA(1, 1, At, B1); PG8_BAR; PG8_SCHED;
            } else {
            PG8_LDB(B0, 0, 0); PG8_SCHED; PG8_LDA(At, 0, 0); PG8_STAGEA(PG8_SA(1, 1), a1, 1, tab_c);
            PG8_WAIT_L(8); PG8_BAR; PG8_WAIT_L(0); PG8_MMA(0, 0, At, B0); PG8_BAR; PG8_SCHED;
            PG8_LDB(B1, 0, 1); PG8_STAGE(PG8_SB(0, 0), b2, voffB);
            PG8_BAR; PG8_WAIT_L(0); PG8_MMA(0, 1, At, B1); PG8_BAR;
            PG8_LDA(At, 0, 1); PG8_STAGEA(PG8_SA(0, 0), a2, 0, tab_2);
            PG8_BAR; PG8_WAIT_L(0); PG8_MMA(1, 0, At, B0); PG8_BAR; PG8_SCHED;
            PG8_STAGE(PG8_SB(0, 1), b2 + hstepB, voffB);
            PG8_WAIT_V(6); PG8_BAR; PG8_MMA(1, 1, At, B1); PG8_BAR;
            PG8_LDB(B0, 1, 0); PG8_SCHED; PG8_LDA(At, 1, 0); PG8_STAGEA(PG8_SA(0, 1), a2, 1, tab_2);
            PG8_WAIT_L(8); PG8_BAR; PG8_WAIT_L(0); PG8_MMA(0, 0, At, B0); PG8_BAR; PG8_SCHED;
            PG8_LDB(B1, 1, 1); PG8_STAGE(PG8_SB(1, 0), b3, voffB);
            PG8_BAR; PG8_WAIT_L(0); PG8_MMA(0, 1, At, B1); PG8_BAR;
            PG8_LDA(At, 1, 1); PG8_STAGEA(PG8_SA(1, 0), a3, 0, tab_2);
            PG8_BAR; PG8_WAIT_L(0); PG8_MMA(1, 0, At, B0); PG8_BAR; PG8_SCHED;
            PG8_STAGE(PG8_SB(1, 1), b3 + hstepB, voffB);
            PG8_WAIT_V(6); PG8_BAR; PG8_MMA(1, 1, At, B1); PG8_BAR;
            }
        }
#ifdef GP_PROBE
        if (gp_out) { gp_cycles += __builtin_amdgcn_s_memtime() - gp_t0; gp_tiles += nt; }
#endif
        if constexpr (ALIGN_EPI) { if (wr == 0) PG8_BAR; }
        if (has_next) S.prefetch(nxt, rsrc, lds, wid, lane);
        { int fr_e = fr, fq_e = fq; asm volatile("" : "+v"(fr_e), "+v"(fq_e));
          E(acc, cur, wr, wc, fr_e, fq_e); }
        if (!has_next) break;
        { int fq_i = fq; asm volatile("" : "+v"(fq_i)); E.init(acc, nxt, wc, fq_i); }
        cur = nxt; cA = nA; cB = nB; ++ui; tab_c ^= 1;
        if constexpr (ALIGN_EPI) { if (wr == 1) PG8_BAR; }
    }
    PG8_WAIT_V(0);
    if constexpr (!ALIGN_EPI) { if (wr == 0) PG8_BAR; }
    PG8_BAR;
#ifdef GP_PROBE
    if (gp_out && blockIdx.x == GP_BLOCK && tid == 0) { gp_out[0] = gp_cycles; gp_out[1] = gp_tiles; gp_out[2] = __builtin_amdgcn_s_memtime() - gp_p0; gp_out[3] = __builtin_amdgcn_s_memrealtime() - gp_r0; gp_out[4] = (unsigned long long)(ui + 1); }
#endif
#undef PG8_SA
#undef PG8_SB
#undef PG8_STAGE
#undef p2voffA
#undef PG8_STAGEA
#undef p2voffB
#undef PG8_LDA
#undef PG8_LDB
#undef PG8_MMA
#undef PG8_CAT
#undef PG8_WAIT_V
#undef PG8_WAIT_L
#undef PG8_BAR
#undef PG8_SCHED
}
}
using pg8::Unit;

constexpr size_t MiB = 1u << 20;
constexpr size_t WS_CTL = 0, CTL_ZERO_BYTES = 1 * MiB;
constexpr size_t WS_WIN = 1 * MiB;
constexpr size_t WS_WQ = 7 * MiB;
constexpr size_t WS_WKV = WS_WQ + 512 * 1024;
constexpr size_t WS_WPOOL = 8 * MiB;
constexpr size_t WS_WAO = 9 * MiB;
constexpr size_t WS_WPO = 10 * MiB;
constexpr size_t WS_WO = 11 * MiB;
constexpr size_t WS_WPG = 13 * MiB;
constexpr size_t WS_WPLE = 15 * MiB;
constexpr size_t WS_WGU = 16 * MiB;
constexpr size_t WS_WD = 144 * MiB;
constexpr size_t WS_HN = 208 * MiB;
constexpr size_t WS_PROJ = 240 * MiB;
constexpr size_t WS_GATES = 272 * MiB;
constexpr size_t WS_A2 = 336 * MiB;
constexpr size_t WS_POOLED = 352 * MiB;
constexpr size_t WS_Q = 368 * MiB;
constexpr size_t WS_K = 392 * MiB;
constexpr size_t WS_V = 416 * MiB;
constexpr size_t WS_ATT = 432 * MiB;
constexpr size_t WS_MIXED = 448 * MiB;
constexpr size_t WS_MIX = 464 * MiB;
constexpr size_t WS_PB = 496 * MiB;
constexpr size_t WS_E = 504 * MiB;
constexpr size_t WS_SSQ = 536 * MiB;
constexpr size_t WS_COS = 537 * MiB;
constexpr size_t WS_SIN = 538 * MiB;
constexpr size_t WS_ROUTE = 539 * MiB;
constexpr size_t WS_TOK = 541 * MiB;
constexpr size_t WS_XS = 544 * MiB;
constexpr size_t WS_ACT = 688 * MiB;
constexpr size_t WS_XS2 = 768 * MiB;
constexpr size_t WS_WIN8 = 848 * MiB;
constexpr size_t WS_HN8 = 852 * MiB;
constexpr size_t WS_END = 868 * MiB;
constexpr size_t WS_X1B = WS_PROJ;
constexpr size_t WS_X2B = WS_MIX;
constexpr int CW_BAR = 4096;
constexpr int CW_CNT = 1024;

constexpr int RING_BYTES = 131072;
constexpr int LDS_BYTES = 163840;
constexpr int MISC_OFF = LDS_BYTES - 512;
constexpr int TILE_E_OFF = LDS_BYTES - 4096;
constexpr int NWAVES = 8;

typedef GAS unsigned gu32;
#define RLX_AGENT __ATOMIC_RELAXED, __HIP_MEMORY_SCOPE_AGENT
#define XB_TMO      128
#define XB_XCNT(j)  (256  + 64 * (j))
#define XB_XSUB(j)  (1280 + 64 * (j))
#define XB_XGEN(j)  (2304 + 64 * (j))
#define XB_TOP      3328
#define XB_TOPGEN   3392
#define XCD_BAR_WORDS 3456
#define XB_SPIN_CAP (1u << 18)
__device__ __forceinline__ unsigned xb_ld(unsigned* p)              { return __hip_atomic_load(p, __ATOMIC_RELAXED, __HIP_MEMORY_SCOPE_AGENT); }
__device__ __forceinline__ unsigned xb_add(unsigned* p, unsigned v) { return __hip_atomic_fetch_add(p, v, __ATOMIC_RELAXED, __HIP_MEMORY_SCOPE_AGENT); }
__device__ __forceinline__ unsigned xb_xcc_id() { return (unsigned)__builtin_amdgcn_s_getreg((3 << 11) | 20) & 0xFu; }
#define XB_SPIN(cond, bar) do { unsigned _sp = 0; while (cond) { __builtin_amdgcn_s_sleep(1); \
    if ((++_sp & 255u) == 0u) { if (xb_ld(&(bar)[XB_TMO])) break; if (_sp > XB_SPIN_CAP) { atomicAdd(&(bar)[XB_TMO], 1u); break; } } } } while (0)
struct XcdBarrier { unsigned* bar; unsigned x; volatile LAS unsigned* st; };
__device__ __forceinline__ XcdBarrier xcd_barrier_post(unsigned* bar, volatile LAS unsigned* st) {
    XcdBarrier b; b.bar = bar; b.x = xb_xcc_id(); b.st = st;
    if (threadIdx.x == 0) (void)xb_add(&bar[XB_XCNT(b.x)], 1u);
    return b;
}
__device__ __forceinline__ void xcd_barrier_complete(unsigned* bar, unsigned x, unsigned& nloc, unsigned& nx) {
    const unsigned G = gridDim.x * gridDim.y * gridDim.z;
    unsigned sum, cnt, mine, sp = 0u;
    for (;;) {
        sum = 0u; cnt = 0u; mine = 0u;
#pragma unroll
        for (unsigned j = 0; j < 16; ++j) { const unsigned c = xb_ld(&bar[XB_XCNT(j)]); sum += c; cnt += (c > 0u) ? 1u : 0u; mine = (j == x) ? c : mine; }
        if (sum == G) break;
        __builtin_amdgcn_s_sleep(1);
        if ((++sp & 255u) == 0u) { if (xb_ld(&bar[XB_TMO])) break; if (sp > XB_SPIN_CAP) { atomicAdd(&bar[XB_TMO], 1u); break; } }
    }
    nloc = mine > 0u ? mine : 1u; nx = cnt > 0u ? cnt : 1u;
}
__device__ __forceinline__ void xcd_barrier(const XcdBarrier& b) {
    asm volatile("s_waitcnt vmcnt(0)" ::: "memory");
    __syncthreads();
    if (threadIdx.x == 0) {
        unsigned* bar = b.bar;
        __builtin_amdgcn_s_waitcnt(0);
        unsigned nloc = b.st[0], nx = b.st[1];
        if (nloc == 0u) { xcd_barrier_complete(bar, b.x, nloc, nx); b.st[0] = nloc; b.st[1] = nx; }
        const unsigned old = xb_add(&bar[XB_XSUB(b.x)], 1u);
        const unsigned gen = old / nloc;
        if (old + 1u == (gen + 1u) * nloc) {
            __builtin_amdgcn_fence(__ATOMIC_RELEASE, "agent");
            asm volatile("s_waitcnt vmcnt(0)" ::: "memory");
            const unsigned og = xb_add(&bar[XB_TOP], 1u);
            const unsigned tg = og / nx;
            if (og + 1u == (tg + 1u) * nx) xb_add(&bar[XB_TOPGEN], 1u);
            else XB_SPIN(xb_ld(&bar[XB_TOPGEN]) == tg, bar);
            __builtin_amdgcn_fence(__ATOMIC_ACQUIRE, "agent");
            xb_add(&bar[XB_XGEN(b.x)], 1u);
            asm volatile("s_waitcnt vmcnt(0)" ::: "memory");
        } else {
            XB_SPIN(xb_ld(&bar[XB_XGEN(b.x)]) == gen, bar);
            __builtin_amdgcn_fence(__ATOMIC_ACQUIRE, "agent");
            asm volatile("s_waitcnt vmcnt(0)" ::: "memory");
        }
    }
    __syncthreads();
}

#ifdef GP_PROBE
#define GP_AT(k) ((k) == GP_PHASE ? (unsigned long long*)(ws + WS_CTL + 65536) : nullptr)
#else
#define GP_AT(k) nullptr
#endif
struct Args {
    const float* in[27];
    float* out; unsigned char* ws;
    int ph_lo, ph_hi;
};
typedef const __attribute__((address_space(4))) Args* KArgs;
__device__ __forceinline__ KArgs kargs() { KArgs p = (KArgs)__builtin_amdgcn_kernarg_segment_ptr(); asm volatile("" : "+s"(p)); return p; }
enum { I_X = 0, I_P, I_POS, I_GMIX, I_WIN, I_GQLAT, I_WQB, I_GKVLAT, I_WKVB, I_GQHEAD, I_GKNOPE, I_GKROPE, I_WPOOL, I_PSCALE, I_WAO, I_WPO, I_WO, I_GFFN,
       I_WR, I_BR, I_WGU, I_BGU, I_WD, I_BD, I_GPLE, I_WPG, I_WPLE };

enum { MAP_ID = 0, MAP_WIN, MAP_GU, MAP_QB, MAP_KVB };
__device__ __forceinline__ int map_row(int mode, int n) {
    switch (mode) {
    case MAP_WIN: return n < 416 ? n : n + 96;
    case MAP_GU: { const int j = n & 1023, up = n >> 10; return 256 * (j >> 7) + 128 * up + (j & 127); }
    case MAP_QB: { const int h = n / 96, d = n % 96;
        if (d < 64) return (h >> 2) * 256 + 128 * (d >> 5) + 32 * (h & 3) + (d & 31);
        const int dd = d - 64, half = dd >> 4, i = dd & 15; return 512 + 128 * (h & 1) + 32 * (h >> 1) + 8 * (i >> 2) + 4 * half + (i & 3); }
    case MAP_KVB: { const int h = n >> 7, c = n & 127, isv = c >> 6, d = c & 63; return (h >> 1) * 256 + 128 * (d >> 5) + 32 * (2 * isv + (h & 1)) + (d & 31); }
    default: return n;
    }
}
struct TJob { const float* W; int K, N; bf16_t* WT; int ldw, koff, mode, row_off; const float* gk; const float* gn; int nmat; size_t wstride, wtstride; int fp8; };
struct TItem { const float* src; bf16_t* dst; int n0, k0; float gnv; };
__device__ __forceinline__ TItem titem_setup(const TJob& J, int item, int lane) {
    const int nblk = J.N / 32, ipm = (J.K / 64) * nblk, mat = item / ipm, it = item - mat * ipm, kb = it / nblk, nb = it - kb * nblk;
    TItem I; I.k0 = 64 * kb; I.n0 = 32 * nb;
    I.src = J.W + (size_t)mat * J.wstride + (size_t)(I.k0 + (lane >> 5)) * J.N + I.n0 + (lane & 31);
    I.dst = (bf16_t*)((unsigned char*)J.WT + (size_t)mat * J.wtstride * (J.fp8 ? 1 : 2));
    I.gnv = J.gn ? J.gn[I.n0 + (lane & 31)] : 1.f;
    return I;
}
__device__ __forceinline__ void titem_load(const TJob& J, const TItem& I, float (&v)[32]) {
#pragma unroll
    for (int i = 0; i < 32; ++i) v[i] = I.src[(size_t)(2 * i) * J.N];
}
__device__ __forceinline__ void titem_store(const TJob& J, const TItem& I, float (&v)[32], LAS float* scr, int lane) {
#pragma unroll
    for (int i = 0; i < 32; ++i) { const int kk = 2 * i + (lane >> 5); float x = v[i] * I.gnv; if (J.gk) x *= J.gk[I.k0 + kk]; scr[kk * 33 + (lane & 31)] = x; }
    asm volatile("s_waitcnt lgkmcnt(0)" ::: "memory");
    const int c = lane & 7;
#pragma unroll
    for (int j = 0; j < 4; ++j) { const int n = (lane >> 3) + 8 * j; const LAS float* s = scr + (8 * c) * 33 + n;
        const size_t eo = (size_t)(J.row_off + map_row(J.mode, I.n0 + n)) * J.ldw + J.koff + I.k0 + 8 * c;
        if (J.fp8) { u32x2 o; int w = __builtin_amdgcn_cvt_pk_fp8_f32(s[0 * 33] * 8.f, s[1 * 33] * 8.f, 0, false); w = __builtin_amdgcn_cvt_pk_fp8_f32(s[2 * 33] * 8.f, s[3 * 33] * 8.f, w, true); o.x = (unsigned)w;
            w = __builtin_amdgcn_cvt_pk_fp8_f32(s[4 * 33] * 8.f, s[5 * 33] * 8.f, 0, false); w = __builtin_amdgcn_cvt_pk_fp8_f32(s[6 * 33] * 8.f, s[7 * 33] * 8.f, w, true); o.y = (unsigned)w;
            *(u32x2*)((unsigned char*)I.dst + eo) = o; }
        else { u32x4 o; o.x = cvt_pk_bf16(s[0 * 33], s[1 * 33]); o.y = cvt_pk_bf16(s[2 * 33], s[3 * 33]); o.z = cvt_pk_bf16(s[4 * 33], s[5 * 33]); o.w = cvt_pk_bf16(s[6 * 33], s[7 * 33]);
            *(u32x4*)(I.dst + eo) = o; } }
    asm volatile("s_waitcnt lgkmcnt(0)" ::: "memory");
}
__device__ __forceinline__ void run_job(const TJob& J, LAS float* scr, int gw, int NGW, int lane) {
    const int items = J.nmat * (J.K / 64) * (J.N / 32);
    for (int it = gw; it < items; it += 2 * NGW) {
        const bool two = (it + NGW) < items;
        const TItem I0 = titem_setup(J, it, lane); const TItem I1 = titem_setup(J, two ? it + NGW : it, lane);
        float v0[32], v1[32];
        titem_load(J, I0, v0); if (two) titem_load(J, I1, v1);
        titem_store(J, I0, v0, scr, lane); if (two) titem_store(J, I1, v1, scr, lane);
    }
}

struct Frame {
    LAS unsigned char* lds; volatile LAS unsigned* MISC; unsigned* ctl;
    int wave, vcu, G;
    float* out; unsigned char* ws;
};

__device__ __forceinline__ void p0_prologue(const Frame& F) {
    const int tid_l = tid_local(), lane_l = tid_l & 63; (void)tid_l; (void)lane_l;
    const KArgs a = kargs();
    LAS float* scr = (LAS float*)(F.lds + F.wave * 16384);
    const int gw = F.vcu * NWAVES + F.wave, NGW = F.G * NWAVES;
    unsigned char* ws = F.ws;
    int joff = 0;
#define RUN_JOB(...) do { const TJob J_ = TJob{__VA_ARGS__, 1, 0, 0, 0}; run_job(J_, scr, (gw + NGW - joff % NGW) % NGW, NGW, lane_l); joff += (J_.K / 64) * (J_.N / 32); } while (0)
#ifndef P1_FP8
#define P1_FP8 0
#endif
    { const TJob J_{a->in[I_WIN], 1024, 2976, (bf16_t*)(ws + WS_WIN), 1024, 0, MAP_WIN, 0, nullptr, nullptr, 1, 0, 0, P1_FP8}; run_job(J_, scr, gw, NGW, lane_l); joff += 16 * 93; }
#ifndef GATES_FP8
#define GATES_FP8 0
#endif
    if (GATES_FP8) { const TJob J_{a->in[I_WIN], 1024, 2976, (bf16_t*)(ws + WS_WIN8), 1024, 0, MAP_WIN, 0, nullptr, nullptr, 1, 0, 0, 1}; run_job(J_, scr, gw, NGW, lane_l); }
    RUN_JOB(a->in[I_WQB], 256, 768, (bf16_t*)(ws + WS_WQ), 256, 0, MAP_QB, 0, a->in[I_GQLAT], nullptr);
    RUN_JOB(a->in[I_WKVB], 128, 1024, (bf16_t*)(ws + WS_WKV), 256, 0, MAP_KVB, 0, a->in[I_GKVLAT], nullptr);
    RUN_JOB(a->in[I_WAO], 512, 1024, (bf16_t*)(ws + WS_WAO), 512, 0, MAP_ID, 0, nullptr, nullptr);
    RUN_JOB(a->in[I_WPO], 512, 1024, (bf16_t*)(ws + WS_WPO), 512, 0, MAP_ID, 0, nullptr, nullptr);
    RUN_JOB(a->in[I_WO], 1024, 1024, (bf16_t*)(ws + WS_WO), 1024, 0, MAP_ID, 0, nullptr, nullptr);
#ifndef PLE_FP8
#define PLE_FP8 1
#endif
    { const TJob J_{a->in[I_WPG], 1024, 1024, (bf16_t*)(ws + WS_WPG), 1024, 0, MAP_ID, 0, nullptr, nullptr, 1, 0, 0, PLE_FP8}; run_job(J_, scr, (gw + NGW - joff % NGW) % NGW, NGW, lane_l); joff += 16 * 32; }
    RUN_JOB(a->in[I_WPLE], 256, 1024, (bf16_t*)(ws + WS_WPLE), 256, 0, MAP_ID, 0, nullptr, nullptr);
    for (int g = 0; g < 4; ++g)
        RUN_JOB(a->in[I_WPOOL] + (size_t)g * 128 * 128, 128, 128, (bf16_t*)(ws + WS_WPOOL) + (size_t)(g >> 1) * 256 * 256, 256, 128 * (g & 1), MAP_ID, 128 * (g & 1), nullptr, a->in[I_PSCALE] + 128 * g);
    {
        const int gt = (F.vcu * NWAVES + F.wave) * 64 + lane_l, NGT = NGW * 64;
        const u32x4 z = {0u, 0u, 0u, 0u};
        u32x4* w0 = (u32x4*)(ws + WS_WIN + (size_t)416 * 1024 * (P1_FP8 ? 1 : 2));
        for (int i = gt; i < 96 * (P1_FP8 ? 64 : 128); i += NGT) w0[i] = z;
        for (int i = gt; i < 1024 * 16; i += NGT) { const int r = i >> 4, c = i & 15; *(u32x4*)((bf16_t*)(ws + WS_WKV) + (size_t)r * 256 + 128 + 8 * c) = z; }
        for (int i = gt; i < 2 * 256 * 16; i += NGT) { const int p = i >> 12, r = (i >> 4) & 255, c = i & 15;
            const int k0 = (r < 128) ? 128 : 0; *(u32x4*)((bf16_t*)(ws + WS_WPOOL) + (size_t)p * 65536 + (size_t)r * 256 + k0 + 8 * c) = z; }
    }
#ifndef CONV_IN_ATTN
#define CONV_IN_ATTN 1
#endif
    if (!CONV_IN_ATTN) {
    { const TJob J{a->in[I_WGU], 1024, 2048, (bf16_t*)(ws + WS_WGU), 1024, 0, MAP_GU, 0, nullptr, nullptr, NEXP, (size_t)1024 * 2048, (size_t)2048 * 1024, 1}; run_job(J, scr, gw, NGW, lane_l); }
    { const TJob J{a->in[I_WD], 1024, 1024, (bf16_t*)(ws + WS_WD), 1024, 0, MAP_ID, 0, nullptr, nullptr, NEXP, (size_t)1024 * 1024, (size_t)1024 * 1024, 1}; run_job(J, scr, gw, NGW, lane_l); }
    }
    const float* x = a->in[I_X]; const float* gm = a->in[I_GMIX];
    f32x4 gv[4];
#pragma unroll
    for (int j = 0; j < 4; ++j) gv[j] = *(const f32x4*)(gm + 4 * lane_l + 256 * j);
    for (int m = gw; m < T; m += NGW) {
        const f32x4* xr = (const f32x4*)(x + (size_t)m * DM) + lane_l;
        f32x4 v[4]; float s = 0.f;
#pragma unroll
        for (int j = 0; j < 4; ++j) { v[j] = xr[64 * j]; s += (v[j].x * v[j].x + v[j].y * v[j].y) + (v[j].z * v[j].z + v[j].w * v[j].w); }
        const float rstd = 1.0f / sqrtf(wave_sum(s) * (1.f / DM) + EPS);
        if (P1_FP8) { int* o4 = (int*)(ws + WS_HN + (size_t)m * DM) + lane_l; const float r8 = rstd * 8.0f;
#pragma unroll
            for (int j = 0; j < 4; ++j) { int w = __builtin_amdgcn_cvt_pk_fp8_f32(v[j].x * r8 * gv[j].x, v[j].y * r8 * gv[j].y, 0, false); w = __builtin_amdgcn_cvt_pk_fp8_f32(v[j].z * r8 * gv[j].z, v[j].w * r8 * gv[j].w, w, true); o4[64 * j] = w; } }
        else { u32x2* o8 = (u32x2*)((bf16_t*)(ws + WS_HN) + (size_t)m * DM) + lane_l;
#pragma unroll
            for (int j = 0; j < 4; ++j) { u32x2 w; w.x = cvt_pk_bf16(v[j].x * rstd * gv[j].x, v[j].y * rstd * gv[j].y); w.y = cvt_pk_bf16(v[j].z * rstd * gv[j].z, v[j].w * rstd * gv[j].w); o8[64 * j] = w; }
            if (GATES_FP8) { int* o4 = (int*)(ws + WS_HN8 + (size_t)m * DM) + lane_l; const float r8 = rstd * 8.0f;
#pragma unroll
                for (int j = 0; j < 4; ++j) { int w = __builtin_amdgcn_cvt_pk_fp8_f32(v[j].x * r8 * gv[j].x, v[j].y * r8 * gv[j].y, 0, false); w = __builtin_amdgcn_cvt_pk_fp8_f32(v[j].z * r8 * gv[j].z, v[j].w * r8 * gv[j].w, w, true); o4[64 * j] = w; } } }
    }
    {
        const float* p = a->in[I_P];
        for (int m = gw; m < T; m += NGW) { const f32x4 v = *((const f32x4*)(p + (size_t)m * PLE) + lane_l); u32x2 w; w.x = cvt_pk_bf16(v.x, v.y); w.y = cvt_pk_bf16(v.z, v.w);
            *((u32x2*)((bf16_t*)(ws + WS_PB) + (size_t)m * PLE) + lane_l) = w; }
    }
}

struct DenseOrder {
    int nM, nN, nwg, G, c; unsigned A, B, tA, tB, aPn;
    __device__ void init(int nM_, int nN_, int G_, int c_, size_t A_, size_t lda, size_t B_, size_t ldb, unsigned aPn_ = 0) { nM = nM_; nN = nN_; nwg = nM * nN; G = G_; c = c_; A = (unsigned)A_; B = (unsigned)B_; tA = (unsigned)(256 * lda * 2); tB = (unsigned)(256 * ldb * 2); aPn = aPn_; }
    __device__ __forceinline__ bool next(int i, Unit& u) const {
        const long L = (long)i * G + c; if (L >= nwg) return false;
        int wgid = (int)L; { const int q = nwg / 8, r = nwg % 8, xcd = wgid % 8, off = wgid / 8; wgid = (xcd < r ? xcd * (q + 1) : r * (q + 1) + (xcd - r) * q) + off; }
        const int WGM = 8; const int nig = WGM * nN, gid = wgid / nig, fm = gid * WGM, gsz = (nM - fm) < WGM ? (nM - fm) : WGM;
        u.pm = fm + ((wgid % nig) % gsz); u.pn = (wgid % nig) / gsz; u.aux = 0; return true;
    }
    __device__ __forceinline__ void prefetch(const Unit&, const __amdgpu_buffer_rsrc_t, LAS unsigned char*, int, int) const {}
    __device__ __forceinline__ unsigned a_off(const Unit& u) const { return A + (unsigned)u.pm * tA + (unsigned)u.pn * aPn; }
    __device__ __forceinline__ unsigned b_off(const Unit& u) const { return B + (unsigned)u.pn * tB; }
};

struct EpiBf16 {
    static constexpr bool PERM = true;
    __device__ __forceinline__ void init(f32x4 (&acc)[2][2][4][2], const Unit&, int, int) const {
#pragma unroll
        for (int a = 0; a < 2; ++a)
#pragma unroll
            for (int b = 0; b < 2; ++b)
#pragma unroll
                for (int m = 0; m < 4; ++m)
#pragma unroll
                    for (int n = 0; n < 2; ++n) acc[a][b][m][n] = (f32x4){0.f, 0.f, 0.f, 0.f};
    }
    bf16_t* O; int ldc;
    __device__ __forceinline__ void operator()(const f32x4 (&acc)[2][2][4][2], const Unit& u, int wr, int wc, int fr, int fq) const {
        const int row0 = u.pm * 256 + wr * 64 + fr, col0 = u.pn * 256 + wc * 32 + 8 * fq;
#pragma unroll
        for (int ai = 0; ai < 2; ++ai)
#pragma unroll
            for (int m = 0; m < 4; ++m) { bf16_t* rowp = O + (size_t)(row0 + ai * 128 + m * 16) * ldc + col0;
#pragma unroll
                for (int bj = 0; bj < 2; ++bj) { const f32x4 v0 = acc[ai][bj][m][0], v1 = acc[ai][bj][m][1];
                    u32x4 w; w.x = cvt_pk_bf16(v0[0], v0[1]); w.y = cvt_pk_bf16(v0[2], v0[3]); w.z = cvt_pk_bf16(v1[0], v1[1]); w.w = cvt_pk_bf16(v1[2], v1[3]);
                    *(u32x4*)(rowp + bj * 128) = w; } }
    }
};
struct EpiProj {
    static constexpr bool PERM = true;
    __device__ __forceinline__ void init(f32x4 (&acc)[2][2][4][2], const Unit&, int, int) const {
#pragma unroll
        for (int a = 0; a < 2; ++a)
#pragma unroll
            for (int b = 0; b < 2; ++b)
#pragma unroll
                for (int m = 0; m < 4; ++m)
#pragma unroll
                    for (int n = 0; n < 2; ++n) acc[a][b][m][n] = (f32x4){0.f, 0.f, 0.f, 0.f};
    }
    bf16_t* PROJ; bf16_t* GATES; int pn_off;
    __device__ __forceinline__ void operator()(const f32x4 (&acc)[2][2][4][2], const Unit& u, int wr, int wc, int fr, int fq) const {
        const int pn = u.pn + pn_off; const int row0 = u.pm * 256 + wr * 64 + fr; const bool isg = pn >= 4;
        bf16_t* O = isg ? GATES : PROJ; const int ldc = isg ? 2048 : 1024; const int col0 = (isg ? pn - 4 : pn) * 256 + wc * 32 + 8 * fq;
#pragma unroll
        for (int ai = 0; ai < 2; ++ai)
#pragma unroll
            for (int m = 0; m < 4; ++m) { bf16_t* rowp = O + (size_t)(row0 + ai * 128 + m * 16) * ldc + col0;
#pragma unroll
                for (int bj = 0; bj < 2; ++bj) { f32x4 v0 = acc[ai][bj][m][0], v1 = acc[ai][bj][m][1];
                    if (isg) {
#pragma unroll
                        for (int e = 0; e < 4; ++e) { v0[e] = fast_sigmoid(v0[e]); v1[e] = fast_sigmoid(v1[e]); } }
                    u32x4 w; w.x = cvt_pk_bf16(v0[0], v0[1]); w.y = cvt_pk_bf16(v0[2], v0[3]); w.z = cvt_pk_bf16(v1[0], v1[1]); w.w = cvt_pk_bf16(v1[2], v1[3]);
                    *(u32x4*)(rowp + bj * 128) = w; } asm volatile("" ::: "memory"); }
    }
};

__device__ __forceinline__ void p2_rows(const Frame& F) {
    const int tid_l = tid_local(), lane_l = tid_l & 63; (void)tid_l; (void)lane_l;
    const KArgs a = kargs();
    const int gw = F.vcu * NWAVES + F.wave, NGW = F.G * NWAVES, lane = lane_l;
    unsigned char* ws = F.ws;
    const bf16_t* PROJ = (const bf16_t*)(ws + WS_PROJ);
    bf16_t* A2 = (bf16_t*)(ws + WS_A2); bf16_t* POOLED = (bf16_t*)(ws + WS_POOLED); bf16_t* Kb = (bf16_t*)(ws + WS_K);
    float* COS = (float*)(ws + WS_COS); float* SIN = (float*)(ws + WS_SIN);
    const int* positions = (const int*)a->in[I_POS];
    const float gkr = (lane < 32) ? a->in[I_GKROPE][lane] : 0.f;
    const float inv_freq = __builtin_amdgcn_exp2f(-(float)(lane & 15) * (13.287712379549449f / 16.0f));
    const int w = 2 << (lane >> 4);
    for (int task = gw; task < T / 8; task += NGW) {
        const int t0 = task * 8, b = t0 / SEQ, s0 = t0 % SEQ;
        u32x2 qlv[8]; unsigned kvv[8]; bf16_t krr[8]; int posv[8];
#pragma unroll
        for (int i = 0; i < 8; ++i) { const bf16_t* pr = PROJ + (size_t)(t0 + i) * 1024; qlv[i] = *(const u32x2*)(pr + 4 * lane); kvv[i] = *(const unsigned*)(pr + 256 + 2 * lane); krr[i] = pr[384 + (lane & 31)]; posv[i] = positions[t0 + i]; }
        {
            const bf16_t* base = PROJ + (size_t)(b * SEQ) * 1024 + 512 + 8 * lane;
            u32x4 I[15], C[8], L[8];
#pragma unroll
            for (int k = 0; k < 15; ++k) { const int r = s0 - 15 + k; I[k] = *(const u32x4*)(base + (size_t)(r < 0 ? 0 : r) * 1024); }
#pragma unroll
            for (int i = 0; i < 8; ++i) { C[i] = *(const u32x4*)(base + (size_t)(s0 + i) * 1024); const int rr = s0 + i - w + 1; L[i] = *(const u32x4*)(base + (size_t)(rr < 0 ? 0 : rr) * 1024); }
            float S[8];
#pragma unroll
            for (int j = 0; j < 8; ++j) S[j] = 0.f;
#pragma unroll
            for (int k = 0; k < 15; ++k) { const float mk = (s0 - 15 + k >= 0 && k >= 16 - w) ? 1.f : 0.f; const u32x4 v = I[k];
                S[0] += mk * bf_lo(v.x); S[1] += mk * bf_hi(v.x); S[2] += mk * bf_lo(v.y); S[3] += mk * bf_hi(v.y); S[4] += mk * bf_lo(v.z); S[5] += mk * bf_hi(v.z); S[6] += mk * bf_lo(v.w); S[7] += mk * bf_hi(v.w); }
#pragma unroll
            for (int i = 0; i < 8; ++i) {
                const int s = s0 + i;
                const u32x4 v = C[i];
                float uu[8] = {bf_lo(v.x), bf_hi(v.x), bf_lo(v.y), bf_hi(v.y), bf_lo(v.z), bf_hi(v.z), bf_lo(v.w), bf_hi(v.w)};
                const int cnt = (s + 1 < w) ? s + 1 : w; const float ic = 1.0f / (float)cnt;
                float o[8];
#pragma unroll
                for (int j = 0; j < 8; ++j) { S[j] += uu[j]; o[j] = S[j] * ic - uu[j]; }
                u32x4 wv; wv.x = cvt_pk_bf16(o[0], o[1]); wv.y = cvt_pk_bf16(o[2], o[3]); wv.z = cvt_pk_bf16(o[4], o[5]); wv.w = cvt_pk_bf16(o[6], o[7]);
                *(u32x4*)(POOLED + (size_t)(t0 + i) * 512 + 8 * lane) = wv;
                const float mq = (s - w + 1 >= 0) ? 1.f : 0.f; const u32x4 q = L[i];
                S[0] -= mq * bf_lo(q.x); S[1] -= mq * bf_hi(q.x); S[2] -= mq * bf_lo(q.y); S[3] -= mq * bf_hi(q.y); S[4] -= mq * bf_lo(q.z); S[5] -= mq * bf_hi(q.z); S[6] -= mq * bf_lo(q.w); S[7] -= mq * bf_hi(q.w);
            }
        }
#pragma unroll
        for (int i = 0; i < 8; ++i) {
            const int t = t0 + i, s = s0 + i;
            const u32x2 ql = qlv[i];
            const unsigned kvl = kvv[i];
            const float krv = (lane < 32) ? bf1(krr[i]) : 0.f;
            const float q0 = bf_lo(ql.x), q1 = bf_hi(ql.x), q2 = bf_lo(ql.y), q3 = bf_hi(ql.y);
            const float k0 = bf_lo(kvl), k1 = bf_hi(kvl);
            const float sq = wave_sum((q0 * q0 + q1 * q1) + (q2 * q2 + q3 * q3));
            const float sk = wave_sum(k0 * k0 + k1 * k1);
            const float sr = wave_sum(krv * krv);
            const float rq = 1.0f / sqrtf(sq * (1.f / 256.f) + EPS), rk = 1.0f / sqrtf(sk * (1.f / 128.f) + EPS), rr = 1.0f / sqrtf(sr * (1.f / 32.f) + EPS);
            u32x2 wq; wq.x = cvt_pk_bf16(q0 * rq, q1 * rq); wq.y = cvt_pk_bf16(q2 * rq, q3 * rq);
            *(u32x2*)(A2 + (size_t)t * 512 + 4 * lane) = wq;
            *(unsigned*)(A2 + (size_t)t * 512 + 256 + 2 * lane) = cvt_pk_bf16(k0 * rk, k1 * rk);
            *(unsigned*)(A2 + (size_t)t * 512 + 384 + 2 * lane) = 0u;
            const float pos = (float)posv[i];
            const float ang = pos * inv_freq;
            const float rev = ang * 0.15915494309189535f;
            const float fr_ = rev - floorf(rev);
            const float sn = __builtin_amdgcn_sinf(fr_), cs = __builtin_amdgcn_cosf(fr_);
            const float kn = krv * rr * gkr;
            const float other = __shfl_xor(kn, 16);
            const float ro = (lane & 16) ? (kn * cs + other * sn) : (kn * cs - other * sn);
            if (lane < 32) {
                const bf16_t rb = (bf16_t)(cvt_pk_bf16(ro, 0.f) & 0xffffu);
#pragma unroll
                for (int h = 0; h < NH; ++h) Kb[((size_t)(b * NH + h) * SEQ + s) * DK + 64 + lane] = rb;
            }
            if (lane < 16) { COS[(size_t)t * 16 + lane] = cs; SIN[(size_t)t * 16 + lane] = sn; }
        }
    }
}

#define EPI_FENCE() asm volatile("" ::: "memory")
struct EpiQ {
    static constexpr bool PERM = true;
    __device__ __forceinline__ void init(f32x4 (&acc)[2][2][4][2], const Unit&, int, int) const {
#pragma unroll
        for (int a = 0; a < 2; ++a)
#pragma unroll
            for (int b = 0; b < 2; ++b)
#pragma unroll
                for (int m = 0; m < 4; ++m)
#pragma unroll
                    for (int n = 0; n < 2; ++n) acc[a][b][m][n] = (f32x4){0.f, 0.f, 0.f, 0.f};
    }
    bf16_t* Q; float* SSQ; const float* COS; const float* SIN; const float* gq;
    __device__ __forceinline__ void operator()(const f32x4 (&acc)[2][2][4][2], const Unit& u, int wr, int wc, int fr, int fq) const {
        const int t0 = u.pm * 256 + wr * 64 + fr, b = (u.pm * 256) / SEQ, s0 = t0 - b * SEQ;
        if (u.pn < 2) {
            const int h = 4 * u.pn + wc;
            bf16_t* dst0 = Q + ((size_t)(b * NH + h) * SEQ + s0) * DK + 8 * fq;
            float* ssq0 = SSQ + ((size_t)t0 * NH + h) * 2;
#pragma unroll
            for (int ai = 0; ai < 2; ++ai)
#pragma unroll
                for (int m = 0; m < 4; ++m) {
                    const int dr = ai * 128 + m * 16;
                    float q = 0.f;
#pragma unroll
                    for (int bj = 0; bj < 2; ++bj)
#pragma unroll
                        for (int n = 0; n < 2; ++n) { const f32x4 v = acc[ai][bj][m][n]; q += (v[0] * v[0] + v[1] * v[1]) + (v[2] * v[2] + v[3] * v[3]); }
                    q += __shfl_xor(q, 16); q += __shfl_xor(q, 32);
                    if (fq == 0) ssq0[dr * NH * 2] = q;
#pragma unroll
                    for (int bj = 0; bj < 2; ++bj) { const f32x4 v0 = acc[ai][bj][m][0] * *(const f32x4*)(gq + 32 * bj + 8 * fq), v1 = acc[ai][bj][m][1] * *(const f32x4*)(gq + 32 * bj + 8 * fq + 4);
                        u32x4 w; w.x = cvt_pk_bf16(v0[0], v0[1]); w.y = cvt_pk_bf16(v0[2], v0[3]); w.z = cvt_pk_bf16(v1[0], v1[1]); w.w = cvt_pk_bf16(v1[2], v1[3]);
                        *(u32x4*)(dst0 + dr * DK + 32 * bj) = w; }
                    EPI_FENCE();
                }
        } else {
            const f32x4 g1 = *(const f32x4*)(gq + 64 + 4 * fq), g2 = *(const f32x4*)(gq + 80 + 4 * fq);
            const float* cs0 = COS + (size_t)t0 * 16 + 4 * fq; const float* sn0 = SIN + (size_t)t0 * 16 + 4 * fq;
            bf16_t* dst0 = Q + ((size_t)(b * NH + 2 * wc) * SEQ + s0) * DK + 64 + 4 * fq;
            float* ssq0 = SSQ + ((size_t)t0 * NH + 2 * wc) * 2 + 1;
#pragma unroll
            for (int ai = 0; ai < 2; ++ai)
#pragma unroll
                for (int m = 0; m < 4; ++m) {
                    const int dr = ai * 128 + m * 16;
                    const f32x4 cs = *(const f32x4*)(cs0 + dr * 16), sn = *(const f32x4*)(sn0 + dr * 16);
#pragma unroll
                    for (int bj = 0; bj < 2; ++bj) {
                        const f32x4 x1 = acc[ai][bj][m][0], x2 = acc[ai][bj][m][1];
                        float q = (x1[0] * x1[0] + x1[1] * x1[1]) + (x1[2] * x1[2] + x1[3] * x1[3]) + (x2[0] * x2[0] + x2[1] * x2[1]) + (x2[2] * x2[2] + x2[3] * x2[3]);
                        q += __shfl_xor(q, 16); q += __shfl_xor(q, 32);
                        if (fq == 0) ssq0[dr * NH * 2 + bj * 2] = q;
                        const f32x4 y1 = x1 * g1, y2 = x2 * g2;
                        const f32x4 o1 = y1 * cs - y2 * sn, o2 = y2 * cs + y1 * sn;
                        bf16_t* dst = dst0 + (size_t)bj * SEQ * DK + dr * DK;
                        u32x2 w1, w2; w1.x = cvt_pk_bf16(o1[0], o1[1]); w1.y = cvt_pk_bf16(o1[2], o1[3]); w2.x = cvt_pk_bf16(o2[0], o2[1]); w2.y = cvt_pk_bf16(o2[2], o2[3]);
                        *(u32x2*)(dst) = w1; *(u32x2*)(dst + 16) = w2;
                    }
                    EPI_FENCE();
                }
        }
    }
};
struct EpiKV {
    static constexpr bool PERM = true;
    __device__ __forceinline__ void init(f32x4 (&acc)[2][2][4][2], const Unit&, int, int) const {
#pragma unroll
        for (int a = 0; a < 2; ++a)
#pragma unroll
            for (int b = 0; b < 2; ++b)
#pragma unroll
                for (int m = 0; m < 4; ++m)
#pragma unroll
                    for (int n = 0; n < 2; ++n) acc[a][b][m][n] = (f32x4){0.f, 0.f, 0.f, 0.f};
    }
    bf16_t* K; bf16_t* V; const float* gk;
    __device__ __forceinline__ void operator()(const f32x4 (&acc)[2][2][4][2], const Unit& u, int wr, int wc, int fr, int fq) const {
        const int t0 = u.pm * 256 + wr * 64 + fr, b = (u.pm * 256) / SEQ, s0 = t0 - b * SEQ;
        const int h = 2 * u.pn + (wc & 1); const bool isv = wc >= 2;
        const int pitch = isv ? DV : DK;
        bf16_t* dst0 = (isv ? V : K) + ((size_t)(b * NH + h) * SEQ + s0) * pitch + 8 * fq;
#pragma unroll
        for (int ai = 0; ai < 2; ++ai)
#pragma unroll
            for (int m = 0; m < 4; ++m) {
                const int dr = ai * 128 + m * 16;
                float sc = 1.f;
                if (!isv) { float q = 0.f;
#pragma unroll
                    for (int bj = 0; bj < 2; ++bj)
#pragma unroll
                        for (int n = 0; n < 2; ++n) { const f32x4 v = acc[ai][bj][m][n]; q += (v[0] * v[0] + v[1] * v[1]) + (v[2] * v[2] + v[3] * v[3]); }
                    q += __shfl_xor(q, 16); q += __shfl_xor(q, 32);
                    sc = 1.0f / sqrtf(q * (1.f / 64.f) + EPS); }
#pragma unroll
                for (int bj = 0; bj < 2; ++bj) {
                    f32x4 v0 = acc[ai][bj][m][0] * sc, v1 = acc[ai][bj][m][1] * sc;
                    if (!isv) { v0 = v0 * *(const f32x4*)(gk + 32 * bj + 8 * fq); v1 = v1 * *(const f32x4*)(gk + 32 * bj + 8 * fq + 4); }
                    u32x4 w; w.x = cvt_pk_bf16(v0[0], v0[1]); w.y = cvt_pk_bf16(v0[2], v0[3]); w.z = cvt_pk_bf16(v1[0], v1[1]); w.w = cvt_pk_bf16(v1[2], v1[3]);
                    *(u32x4*)(dst0 + dr * pitch + 32 * bj) = w; }
                EPI_FENCE();
            }
    }
};

namespace att {
constexpr int KT_BYTES = 64 * 192, VT_BYTES = 64 * 128, SLOT_BYTES = KT_BYTES + VT_BYTES;
#ifndef ATT_PF
#define ATT_PF 3
#endif
constexpr int NSLOT = ATT_PF + 1, SCR_OFF = NSLOT * SLOT_BYTES;
__device__ __forceinline__ int crow(int r, int hi) { return (r & 3) + 8 * (r >> 2) + 4 * hi; }
__device__ __forceinline__ s16x4 vtr(const LAS unsigned char* p) { typedef short v4i16_t __attribute__((ext_vector_type(4)));
    return __builtin_bit_cast(s16x4, __builtin_amdgcn_ds_read_tr16_b64_v4i16((LAS v4i16_t*)p)); }
#define MFMA32(a, b, c) __builtin_amdgcn_mfma_f32_32x32x16_bf16(a, b, c, 0, 0, 0)
__device__ __forceinline__ float max3f(float a, float b, float c) { return __builtin_fmaxf(__builtin_fmaxf(a, b), c); }


constexpr int CONV_OFF = SCR_OFF + 8 * 256, CONV_BYTES = 8192;
constexpr int CV_GU_ITEMS = NEXP * 1024, CV_ITEMS = CV_GU_ITEMS + NEXP * 512;
struct ConvItem { const float* src; unsigned char* dst; int N, isgu, n0; };
__device__ __forceinline__ ConvItem cv_setup(int g, const float* wgu, const float* wd, unsigned char* wgu8, unsigned char* wd8) {
    ConvItem I;
    if (g < CV_GU_ITEMS) { const int e = g >> 10, it = g & 1023, kb = it >> 6, nb = it & 63; I.N = 2048; I.isgu = 1; I.n0 = 32 * nb;
        I.src = wgu + (size_t)e * 1024 * 2048 + (size_t)(64 * kb) * 2048 + 32 * nb; I.dst = wgu8 + (size_t)e * 2048 * 1024 + 64 * kb; }
    else { const int g2 = g - CV_GU_ITEMS, e = g2 >> 9, it = g2 & 511, kb = it >> 5, nb = it & 31; I.N = 1024; I.isgu = 0; I.n0 = 32 * nb;
        I.src = wd + (size_t)e * 1024 * 1024 + (size_t)(64 * kb) * 1024 + 32 * nb; I.dst = wd8 + (size_t)e * 1024 * 1024 + 64 * kb; }
    return I;
}
__device__ __forceinline__ void cv_dma(const ConvItem& I, unsigned ldsaddr, int lane) {
    const int kr = lane >> 3, sl = lane & 7;
#pragma unroll
    for (int q = 0; q < 8; ++q) { const unsigned voff = (unsigned)(((8 * q + kr) * I.N + 4 * (sl ^ ((kr ^ q) & 7))) * 4);
        asm volatile("s_nop 4\n\ts_mov_b32 m0, %0\n\ts_nop 0\n\tglobal_load_lds_dwordx4 %1, %2" :: "s"(ldsaddr + (unsigned)q * 1024u), "v"(voff), "s"(I.src) : "m0", "memory"); }
}
__device__ __forceinline__ void cv_out(const ConvItem& I, const LAS float* cb, int lane) {
    asm volatile("" : "+v"(lane));
    const int c = lane & 7;
#pragma unroll
    for (int j = 0; j < 4; ++j) { const int n = (lane >> 3) + 8 * j, nc = n >> 2, e = n & 3;
        float f[8];
#pragma unroll
        for (int kk = 0; kk < 8; ++kk) f[kk] = cb[(8 * c + kk) * 32 + ((nc ^ kk ^ c) & 7) * 4 + e];
        const int nn = I.n0 + n; const int row = I.isgu ? (256 * ((nn & 1023) >> 7) + 128 * (nn >> 10) + (nn & 127)) : nn;
        *(u32x2*)(I.dst + (size_t)row * 1024 + 8 * c) = cvt8_fp8((f32x4){f[0], f[1], f[2], f[3]}, (f32x4){f[4], f[5], f[6], f[7]}, 8.0f);
        asm volatile("" ::: "memory"); }
}
struct ConvState { int next, end, cur; };
__device__ __forceinline__ void attn_unit(LAS unsigned char* lds, const u32x4 srd, ConvState& CV, unsigned char* cvws, int bh, int qb, const bf16_t* Q_, unsigned Koff, unsigned Voff, const float* SSQ_, bf16_t* O_, const bool fast) {
    (void)Q_; (void)SSQ_; (void)O_;
    unsigned char* wl_ = cvws; asm volatile("" : "+s"(wl_));
    const bf16_t* Q = (const bf16_t*)(wl_ + WS_Q); const float* SSQ = (const float*)(wl_ + WS_SSQ); bf16_t* O = (bf16_t*)(wl_ + WS_ATT);
    const int tid = tid_local(), lane = tid & 63, r32 = lane & 31, hi = lane >> 5; const int wid = __builtin_amdgcn_readfirstlane(tid >> 6);
    const int b = bh / NH, h = bh % NH, q0 = qb * 256, qw = q0 + 32 * wid;
    LAS float* scr = (LAS float*)(lds + SCR_OFF) + wid * 64;
    const int NT = (q0 + 256) / 64;
    const unsigned kS = Koff + (unsigned)bh * (SEQ * DK * 2), vS = Voff + (unsigned)bh * (SEQ * DV * 2);
    const int kc2 = 8 + (wid & 3);
    const unsigned vK1 = (unsigned)(lane * 192 + wid * 16); const unsigned sK2 = (unsigned)((kc2 - wid) * 16);
    const int vkey = 8 * wid + (lane >> 3); const unsigned vV = (unsigned)(vkey * 128 + (((lane & 7) ^ (((vkey >> 1) & 1) * 4)) * 16));
    const unsigned lds0 = (unsigned)__builtin_amdgcn_readfirstlane((int)(unsigned)(unsigned long)lds);
    const unsigned dK1 = (unsigned)wid * 1024u, dK2 = (unsigned)kc2 * 1024u, dV = (unsigned)KT_BYTES + (unsigned)wid * 1024u;
#define ATT_DMA1(ldsaddr, voff, soff) asm volatile("s_nop 4\n\ts_mov_b32 m0, %0\n\ts_nop 0\n\tbuffer_load_dwordx4 %1, %2, %3 offen lds" :: "s"(ldsaddr), "v"(voff), "s"(srd), "s"(soff) : "m0", "memory")
#define ATT_DMA(t) do { const unsigned sp_ = lds0 + (unsigned)((t) % NSLOT) * SLOT_BYTES; const unsigned ks_ = kS + (unsigned)(t) * (64 * 192), vs_ = vS + (unsigned)(t) * (64 * 128); \
        ATT_DMA1(sp_ + dK1, vK1, ks_); ATT_DMA1(sp_ + dK2, vK1, ks_ + sK2); ATT_DMA1(sp_ + dV, vV, vs_); } while (0)
#define ATT_WAITBAR(N) asm volatile("s_waitcnt vmcnt(" #N ") lgkmcnt(0)\n\ts_barrier" ::: "memory")
    bf16x8 qr[6];
    { const float* sp = SSQ + ((size_t)(b * SEQ + qw + r32) * NH + h) * 2; const float ss = sp[0] + sp[1];
      const float cq = (1.0f / sqrtf(ss * (1.f / 96.f) + EPS)) * 0.10206207261596577f * 1.4426950408889634f;
      const bf16_t* qp = Q + ((size_t)bh * SEQ + qw + r32) * DK + 8 * hi;
      u32x4 qw_[6];
#pragma unroll
      for (int d0 = 0; d0 < 6; ++d0) qw_[d0] = *(const u32x4*)(qp + 16 * d0);
#pragma unroll
      for (int d0 = 0; d0 < 6; ++d0) { const u32x4 w = qw_[d0]; u32x4 o;
          o.x = cvt_pk_bf16(bf_lo(w.x) * cq, bf_hi(w.x) * cq); o.y = cvt_pk_bf16(bf_lo(w.y) * cq, bf_hi(w.y) * cq); o.z = cvt_pk_bf16(bf_lo(w.z) * cq, bf_hi(w.z) * cq); o.w = cvt_pk_bf16(bf_lo(w.w) * cq, bf_hi(w.w) * cq);
          qr[d0] = __builtin_bit_cast(bf16x8, o); } }
    ATT_DMA(0); ATT_DMA(1); ATT_DMA(2); if (ATT_PF == 4) ATT_DMA(3);
    const int kbase = hi * 1024 + r32 * 16;
    const int qq = (lane & 15) >> 2, pp = lane & 3, dblk = (lane >> 4) & 1, swz = ((qq >> 1) & 1) * 64;
    const int vrow0 = 4 * hi + qq;
    const int vb0 = KT_BYTES + vrow0 * 128 + ((32 * dblk + 8 * pp) ^ swz);
    const int vb1 = KT_BYTES + vrow0 * 128 + ((64 + 32 * dblk + 8 * pp) ^ swz);
    f32x16 o0 = {}, o1 = {};
    float m_run = -1e30f, l_run = 0.f; const f32x16 zero16 = {};
    const int qa = qw + r32;
#define ATT_QK(N0, N1, t) do { const LAS unsigned char* kp_ = lds + ((t) % NSLOT) * SLOT_BYTES + kbase; \
        _Pragma("unroll") for (int d0 = 0; d0 < 6; ++d0) { const bf16x8 ka_ = *(const LAS bf16x8*)(kp_ + d0 * 2048), kb_ = *(const LAS bf16x8*)(kp_ + d0 * 2048 + 512); \
            if (d0 == 0) { N0 = MFMA32(ka_, qr[0], zero16); N1 = MFMA32(kb_, qr[0], zero16); } else { N0 = MFMA32(ka_, qr[d0], N0); N1 = MFMA32(kb_, qr[d0], N1); } } } while (0)
#define ATT_MASK(N0, N1, t) do { const int kb_ = 64 * (t); if (kb_ + 63 > qw) { int d_ = qa - kb_ - 4 * hi; asm volatile("" : "+v"(d_));        \
        _Pragma("unroll") for (int r = 0; r < 16; ++r) { const int c_ = (r & 3) + 8 * (r >> 2); \
        if (c_ > d_) N0[r] = -__builtin_inff(); if (c_ + 32 > d_) N1[r] = -__builtin_inff(); } } } while (0)
#define ATT_ROWMAX(N0, N1, PM) do { float a_ = max3f(N0[0], N0[1], N1[0]), b_ = max3f(N0[2], N0[3], N1[1]); a_ = max3f(a_, N1[2], N1[3]); \
        _Pragma("unroll") for (int r = 4; r < 16; r += 4) { a_ = max3f(a_, N0[r], N0[r + 1]); b_ = max3f(b_, N0[r + 2], N0[r + 3]); a_ = max3f(a_, N1[r], N1[r + 1]); b_ = max3f(b_, N1[r + 2], N1[r + 3]); } \
        a_ = max3f(a_, b_, b_); auto rr_ = __builtin_amdgcn_permlane32_swap(__float_as_uint(a_), __float_as_uint(a_), false, false); \
        PM = max3f(__uint_as_float(rr_[0]), __uint_as_float(rr_[1]), __uint_as_float(rr_[1])); } while (0)
#define ATT_DECIDE(PM, C0, C1, FORCE) do { if ((FORCE) || __any((PM) > m_run + 8.0f)) { const float mn_ = fmaxf(m_run, (PM)); const float al_ = __builtin_amdgcn_exp2f(m_run - mn_); m_run = mn_; l_run *= al_; \
        if (hi == 0) scr[r32] = al_; asm volatile("s_waitcnt lgkmcnt(0)" ::: "memory"); \
        _Pragma("unroll") for (int a4 = 0; a4 < 4; ++a4) { const f32x4 f_ = *(const LAS f32x4*)(scr + 8 * a4 + 4 * hi); \
            _Pragma("unroll") for (int e = 0; e < 4; ++e) { o0[4 * a4 + e] *= f_[e]; o1[4 * a4 + e] *= f_[e]; } } } } while (0)
#define ATT_SM_HALF(P_, ks0, SUBM) do { _Pragma("unroll") for (int r = 0; r < 16; ++r) { P_[r] = __builtin_amdgcn_exp2f((SUBM) ? P_[r] - m_run : P_[r]); ps_ += P_[r]; } \
        _Pragma("unroll") for (int kq = 0; kq < 2; ++kq) { const int bs_ = 8 * kq; \
            u32x4 w_; w_.x = cvt_pk_bf16(P_[bs_ + 0], P_[bs_ + 1]); w_.y = cvt_pk_bf16(P_[bs_ + 2], P_[bs_ + 3]); w_.z = cvt_pk_bf16(P_[bs_ + 4], P_[bs_ + 5]); w_.w = cvt_pk_bf16(P_[bs_ + 6], P_[bs_ + 7]); \
            pa[(ks0) + kq] = __builtin_bit_cast(bf16x8, w_); } } while (0)
#define ATT_SOFTMAX(C0, C1) do { float ps_ = 0.f; ATT_SM_HALF(C0, 0, true); ATT_SM_HALF(C1, 2, true); l_run += ps_; } while (0)
#define ATT_SOFTMAX_F(C0, C1) do { float ps_ = 0.f; ATT_SM_HALF(C0, 0, false); ATT_SM_HALF(C1, 2, false); l_run += ps_; } while (0)
#define ATT_PV(t) do { const LAS unsigned char* vp0_ = lds + ((t) % NSLOT) * SLOT_BYTES + vb0; const LAS unsigned char* vp1_ = lds + ((t) % NSLOT) * SLOT_BYTES + vb1; \
        _Pragma("unroll") for (int ks = 0; ks < 4; ++ks) { \
            const s16x4 a0_ = vtr(vp0_ + ks * 16 * 128), a1_ = vtr(vp0_ + ks * 16 * 128 + 8 * 128), c0_ = vtr(vp1_ + ks * 16 * 128), c1_ = vtr(vp1_ + ks * 16 * 128 + 8 * 128); \
            const bf16x8 vf0_ = {a0_[0], a0_[1], a0_[2], a0_[3], a1_[0], a1_[1], a1_[2], a1_[3]}; const bf16x8 vf1_ = {c0_[0], c0_[1], c0_[2], c0_[3], c1_[0], c1_[1], c1_[2], c1_[3]}; \
            o0 = MFMA32(pa[ks], vf0_, o0); o1 = MFMA32(pa[ks], vf1_, o1); } } while (0)
#ifdef ATT_PROBE2
    unsigned long long ap_s[4] = {0, 0, 0, 0}, ap_acc[3] = {0, 0, 0};
#define AP_STAMP(k) do { __builtin_amdgcn_sched_barrier(0); asm volatile("s_memtime %0\n\ts_waitcnt lgkmcnt(0)" : "=s"(ap_s[k]) :: "memory"); __builtin_amdgcn_sched_barrier(0); if ((k) > 0) ap_acc[(k) - 1] += ap_s[k] - ap_s[(k) - 1]; } while (0)
#else
#define AP_STAMP(k) do {} while (0)
#endif
#define ATT_WB(N) asm volatile("s_waitcnt vmcnt(" #N ") lgkmcnt(0)\n\ts_barrier" ::: "memory")
#define ATT_RDK(d0) do { kf_[d0][0] = *(const LAS bf16x8*)(kp_ + (d0) * 2048); kf_[d0][1] = *(const LAS bf16x8*)(kp_ + (d0) * 2048 + 512); } while (0)
#define ATT_RDV(ks) do { vf_[ks][0] = vtr(vp0_ + (ks) * 16 * 128); vf_[ks][1] = vtr(vp0_ + (ks) * 16 * 128 + 8 * 128); vf_[ks][2] = vtr(vp1_ + (ks) * 16 * 128); vf_[ks][3] = vtr(vp1_ + (ks) * 16 * 128 + 8 * 128); } while (0)
#define ATT_MK(d0) do { if ((d0) == 0) { S0 = MFMA32(kf_[0][0], qr[0], zero16); S1 = MFMA32(kf_[0][1], qr[0], zero16); } else { S0 = MFMA32(kf_[d0][0], qr[d0], S0); S1 = MFMA32(kf_[d0][1], qr[d0], S1); } } while (0)
#define ATT_MV(ks) do { const bf16x8 v0_ = {vf_[ks][0][0], vf_[ks][0][1], vf_[ks][0][2], vf_[ks][0][3], vf_[ks][1][0], vf_[ks][1][1], vf_[ks][1][2], vf_[ks][1][3]}; \
        const bf16x8 v1_ = {vf_[ks][2][0], vf_[ks][2][1], vf_[ks][2][2], vf_[ks][2][3], vf_[ks][3][0], vf_[ks][3][1], vf_[ks][3][2], vf_[ks][3][3]}; \
        o0 = MFMA32(pa[ks], v0_, o0); o1 = MFMA32(pa[ks], v1_, o1); } while (0)
#define ATT_SB __builtin_amdgcn_sched_barrier(0)
#define ATT_SEGA(j, DODMA) do { \
        const LAS unsigned char* kp_ = lds + (((j) + 1) % NSLOT) * SLOT_BYTES + kbase; \
        const LAS unsigned char* vp0_ = lds + ((j) % NSLOT) * SLOT_BYTES + vb0; const LAS unsigned char* vp1_ = lds + ((j) % NSLOT) * SLOT_BYTES + vb1; \
        bf16x8 kf_[6][2]; s16x4 vf_[4][4]; \
        ATT_RDK(0); ATT_RDK(1); ATT_RDV(0); ATT_SB; \
        if (DODMA) { ATT_DMA((j) + ATT_PF); } ATT_SB; \
        ATT_MK(0); ATT_SB; ATT_RDK(2); ATT_SB; ATT_MK(1); ATT_SB; ATT_RDK(3); ATT_SB; ATT_MV(0); ATT_SB; ATT_RDV(1); ATT_SB; \
        ATT_MK(2); ATT_SB; ATT_RDK(4); ATT_SB; ATT_MK(3); ATT_SB; ATT_RDV(2); ATT_SB; ATT_MV(1); ATT_SB; ATT_RDK(5); ATT_SB; \
        ATT_MK(4); ATT_SB; ATT_MV(2); ATT_SB; ATT_RDV(3); ATT_SB; ATT_MK(5); ATT_MV(3); } while (0)
#define ATT_BARP asm volatile("s_waitcnt lgkmcnt(0)\n\ts_barrier" ::: "memory")
#define ATT_STEP(j, MSK, CONV, FAST) do { \
        if (MSK) ATT_MASK(S0, S1, (j)); \
        if (!(FAST)) { float pm_; ATT_ROWMAX(S0, S1, pm_); ATT_DECIDE(pm_, S0, S1, false); } \
        if (FAST) ATT_SOFTMAX_F(S0, S1); else ATT_SOFTMAX(S0, S1); \
        int infl_ = 0; \
        if (CONV) { __builtin_amdgcn_sched_barrier(0); const LAS float* cb_ = (const LAS float*)(lds + CONV_OFF + wid * CONV_BYTES); \
            if (CV.cur >= 0) { const ConvItem I_ = cv_setup(CV.cur, kargs()->in[I_WGU], kargs()->in[I_WD], cvws + WS_WGU, cvws + WS_WD); cv_out(I_, cb_, lane); infl_ += 4; } \
            if (CV.next < CV.end) { const ConvItem I_ = cv_setup(CV.next, kargs()->in[I_WGU], kargs()->in[I_WD], cvws + WS_WGU, cvws + WS_WD); asm volatile("s_waitcnt lgkmcnt(0)" ::: "memory"); \
                cv_dma(I_, lds0 + (unsigned)(CONV_OFF + wid * CONV_BYTES), lane); CV.cur = CV.next; CV.next += 2048; infl_ += 8; } else CV.cur = -1; } \
        __builtin_amdgcn_sched_barrier(0); ATT_BARP; __builtin_amdgcn_sched_barrier(0); \
        ATT_SEGA((j), ((j) + ATT_PF < NT)); if ((j) + ATT_PF < NT) infl_ += 3; \
        __builtin_amdgcn_sched_barrier(0); \
        if (!(CONV)) { if (infl_ == 3) ATT_WB(3); else ATT_WB(0); } \
        else switch (infl_) { case 15: ATT_WB(15); break; case 12: ATT_WB(12); break; case 11: ATT_WB(11); break; case 8: ATT_WB(8); break; case 7: ATT_WB(7); break; case 4: ATT_WB(4); break; case 3: ATT_WB(3); break; default: ATT_WB(0); break; } \
        __builtin_amdgcn_sched_barrier(0); } while (0)
    bf16x8 pa[4];
    f32x16 S0, S1;
    const bool grpY = wid >= 4;
    ATT_WAITBAR(6);
    if (grpY) ATT_BARP;
    __builtin_amdgcn_sched_barrier(0);
    ATT_QK(S0, S1, 0);
    __builtin_amdgcn_sched_barrier(0);
    ATT_WAITBAR(3);
    __builtin_amdgcn_sched_barrier(0);
    int j = 0;
    if (fast) {
        for (; j < NT - 4; j += 2) {
            ATT_STEP(j, false, CONV_IN_ATTN, true);
            ATT_STEP(j + 1, false, false, true);
        }
        for (; j < NT; j += 2) {
            ATT_STEP(j, true, CONV_IN_ATTN, true);
            ATT_STEP(j + 1, true, false, true);
        }
    } else {
        for (; j < NT - 4; j += 2) {
            ATT_STEP(j, false, CONV_IN_ATTN, false);
            ATT_STEP(j + 1, false, false, false);
        }
        for (; j < NT; j += 2) {
            ATT_STEP(j, true, CONV_IN_ATTN, false);
            ATT_STEP(j + 1, true, false, false);
        }
    }
    if (!grpY) ATT_BARP;
    __builtin_amdgcn_sched_barrier(0);
#ifdef ATT_PROBE2
    if (blockIdx.x == 17 && tid == 0) { unsigned long long* ap2 = (unsigned long long*)(cvws + WS_CTL + 65536 + 128); ap2[0] += ap_acc[0]; ap2[1] += ap_acc[1]; ap2[2] += ap_acc[2]; ap2[3] += (unsigned long long)NT; }
#endif
#ifdef ATT_PROBE
    if (blockIdx.x == 17 && tid == 0) { unsigned long long* ap = (unsigned long long*)(cvws + WS_CTL + 65536 + 64); ap[0] += __builtin_amdgcn_s_memtime() - ap_t0; ap[1] += (unsigned long long)NT; }
#endif
#undef ATT_DMA
#undef ATT_DMA1
#undef ATT_WAITBAR
#undef ATT_QK
#undef ATT_MASK
#undef ATT_ROWMAX
#undef ATT_DECIDE
#undef ATT_SOFTMAX
#undef ATT_SOFTMAX_F
#undef ATT_SM_HALF
#undef ATT_PV
#undef ATT_STEP
#undef ATT_WB
#undef ATT_BARP
#undef ATT_SEGA
#undef ATT_RDK
#undef ATT_RDV
#undef ATT_MK
#undef ATT_MV
#undef ATT_SB
#undef AP_STAMP
    { auto rr = __builtin_amdgcn_permlane32_swap(__float_as_uint(l_run), __float_as_uint(l_run), false, false); l_run = __uint_as_float(rr[0]) + __uint_as_float(rr[1]); }
    if (hi == 0) scr[32 + r32] = 1.0f / l_run;
    asm volatile("s_waitcnt lgkmcnt(0)" ::: "memory");
    bf16_t* Ow = O + ((size_t)(b * SEQ + qw)) * 512 + h * 64 + r32;
#pragma unroll
    for (int a4 = 0; a4 < 4; ++a4) { const f32x4 f = *(const LAS f32x4*)(scr + 32 + 8 * a4 + 4 * hi);
#pragma unroll
        for (int e = 0; e < 4; ++e) { const int r = 4 * a4 + e; const int row = crow(r, hi);
            Ow[(size_t)row * 512] = (bf16_t)(cvt_pk_bf16(o0[r] * f[e], 0.f) & 0xffffu);
            Ow[(size_t)row * 512 + 32] = (bf16_t)(cvt_pk_bf16(o1[r] * f[e], 0.f) & 0xffffu); } }
    __syncthreads();
}
#undef MFMA32
}

struct MixOrder {
    int G, c; unsigned ATT, MIXED, WAO, WPO;
    __device__ __forceinline__ bool next(int i, Unit& u) const {
        const int tile = (i >> 1) * G + c; if (tile >= 256) return false;
        u.pm = tile >> 2; u.pn = tile & 3; u.aux = i & 1; return true;
    }
    __device__ __forceinline__ void prefetch(const Unit&, const __amdgpu_buffer_rsrc_t, LAS unsigned char*, int, int) const {}
    __device__ __forceinline__ unsigned a_off(const Unit& u) const { return (u.aux ? MIXED : ATT) + (unsigned)u.pm * (256 * 512 * 2); }
    __device__ __forceinline__ unsigned b_off(const Unit& u) const { return (u.aux ? WPO : WAO) + (unsigned)u.pn * (256 * 512 * 2); }
};
struct EpiMix {
    static constexpr bool PERM = true;
    __device__ __forceinline__ void init(f32x4 (&acc)[2][2][4][2], const Unit& u, int, int) const {
        if (u.aux) return;
#pragma unroll
        for (int a = 0; a < 2; ++a)
#pragma unroll
            for (int b = 0; b < 2; ++b)
#pragma unroll
                for (int m = 0; m < 4; ++m)
#pragma unroll
                    for (int n = 0; n < 2; ++n) acc[a][b][m][n] = (f32x4){0.f, 0.f, 0.f, 0.f};
    }
    bf16_t* MIX; const bf16_t* GATES;
    __device__ __forceinline__ void operator()(f32x4 (&acc)[2][2][4][2], const Unit& u, int wr, int wc, int fr, int fq) const {
        const int row0 = u.pm * 256 + wr * 64 + fr, col0 = u.pn * 256 + wc * 32 + 8 * fq;
#pragma unroll
        for (int ai = 0; ai < 2; ++ai)
#pragma unroll
            for (int m = 0; m < 4; ++m) { const size_t row = (size_t)(row0 + ai * 128 + m * 16);
#pragma unroll
                for (int bj = 0; bj < 2; ++bj) {
                    const u32x4 gp = *(const u32x4*)(GATES + row * 2048 + 1024 + col0 + bj * 128);
                    const f32x4 p0 = {bf_lo(gp.x), bf_hi(gp.x), bf_lo(gp.y), bf_hi(gp.y)}, p1 = {bf_lo(gp.z), bf_hi(gp.z), bf_lo(gp.w), bf_hi(gp.w)};
                    if (u.aux == 0) {
                        const u32x4 ga = *(const u32x4*)(GATES + row * 2048 + col0 + bj * 128);
                        const f32x4 a0 = {bf_lo(ga.x), bf_hi(ga.x), bf_lo(ga.y), bf_hi(ga.y)}, a1 = {bf_lo(ga.z), bf_hi(ga.z), bf_lo(ga.w), bf_hi(ga.w)};
#pragma unroll
                        for (int e = 0; e < 4; ++e) { acc[ai][bj][m][0][e] *= a0[e] * __builtin_amdgcn_rcpf(p0[e]); acc[ai][bj][m][1][e] *= a1[e] * __builtin_amdgcn_rcpf(p1[e]); }
                    } else {
                        const f32x4 v0 = acc[ai][bj][m][0] * p0, v1 = acc[ai][bj][m][1] * p1;
                        u32x4 w; w.x = cvt_pk_bf16(v0[0], v0[1]); w.y = cvt_pk_bf16(v0[2], v0[3]); w.z = cvt_pk_bf16(v1[0], v1[1]); w.w = cvt_pk_bf16(v1[2], v1[3]);
                        *(u32x4*)(MIX + row * 1024 + col0 + bj * 128) = w; } } }
    }
};
struct EpiRes {
    static constexpr bool PERM = false;
    __device__ __forceinline__ void init(f32x4 (&acc)[2][2][4][2], const Unit&, int, int) const {
#pragma unroll
        for (int a = 0; a < 2; ++a)
#pragma unroll
            for (int b = 0; b < 2; ++b)
#pragma unroll
                for (int m = 0; m < 4; ++m)
#pragma unroll
                    for (int n = 0; n < 2; ++n) acc[a][b][m][n] = (f32x4){0.f, 0.f, 0.f, 0.f};
    }
    const float* base; bf16_t* out;
    __device__ __forceinline__ void operator()(const f32x4 (&acc)[2][2][4][2], const Unit& u, int wr, int wc, int fr, int fq) const {
        const int row0 = u.pm * 256 + wr * 64 + fr, col0 = u.pn * 256 + wc * 32 + 4 * fq;
#pragma unroll
        for (int ai = 0; ai < 2; ++ai)
#pragma unroll
            for (int m = 0; m < 4; ++m) { const size_t off = (size_t)(row0 + ai * 128 + m * 16) * DM + col0;
#pragma unroll
                for (int bj = 0; bj < 2; ++bj)
#pragma unroll
                    for (int n = 0; n < 2; ++n) { const f32x4 r = *(const f32x4*)(base + off + bj * 128 + n * 16) + acc[ai][bj][m][n]; u32x2 w; w.x = cvt_pk_bf16(r[0], r[1]); w.y = cvt_pk_bf16(r[2], r[3]); *(u32x2*)(out + off + bj * 128 + n * 16) = w; } }
    }
};

constexpr int WR_PITCH = 1028;
constexpr int R_WR_OFF = 0, R_PART_OFF = 32 * WR_PITCH * 4, R_SSQ_OFF = R_PART_OFF + 2 * 64 * 33 * 4, R_CNT_OFF = R_SSQ_OFF + 2 * 64 * 4, R_BASE_OFF = R_CNT_OFF + 128, R_RSTD_OFF = R_BASE_OFF + 128, R_END = R_RSTD_OFF + 256;
static_assert(R_END <= TILE_E_OFF, "router LDS map");
__device__ __forceinline__ void p7_router(const Frame& F) {
    const int tid_l = tid_local(), lane_l = tid_l & 63; (void)tid_l; (void)lane_l;
    const KArgs a = kargs();
    LAS float* WR = (LAS float*)(F.lds + R_WR_OFF); LAS float* PART = (LAS float*)(F.lds + R_PART_OFF); LAS float* SSQP = (LAS float*)(F.lds + R_SSQ_OFF);
    LAS int* CNT = (LAS int*)(F.lds + R_CNT_OFF); LAS int* BASE = (LAS int*)(F.lds + R_BASE_OFF); LAS float* RSTD_L = (LAS float*)(F.lds + R_RSTD_OFF);
    const int tid = tid_l, lane = lane_l, wave = F.wave;
    const float* wr = a->in[I_WR]; const float* gf = a->in[I_GFFN];
    {
        const f32x4* wr4 = (const f32x4*)wr; f32x4 w[16]; float g[16];
#pragma unroll
        for (int q = 0; q < 16; ++q) { const int idx = tid + 512 * q; w[q] = wr4[idx]; g[q] = gf[idx >> 3]; }
#pragma unroll
        for (int q = 0; q < 16; ++q) { const int idx = tid + 512 * q; const int k = idx >> 3, e0 = (idx & 7) * 4;
#pragma unroll
            for (int j = 0; j < 4; ++j) WR[(e0 + j) * WR_PITCH + k] = w[q][j] * g[q]; }
    }
    if (tid < 32) CNT[tid] = 0;
    __syncthreads();
    int* RE = (int*)(F.ws + WS_ROUTE); int* RP = RE + T * 4; float* RG = (float*)(RP + T * 4); float* RS = RG + T * 4; int* TOK = (int*)(F.ws + WS_TOK); unsigned char* H8 = F.ws + WS_XS2;
    unsigned* gcnt = F.ctl + CW_CNT;
    const bf16_t* X1 = (const bf16_t*)(F.ws + WS_X1B);
    for (int blk = F.vcu; blk < T / 64; blk += F.G) {
        const int tb = blk * 64;
        {
            const int tg = wave & 3, kh = wave >> 2, r = lane & 15, kq = lane >> 4;
            const bf16_t* xp = X1 + (size_t)(tb + 16 * tg + r) * DM + 512 * kh + 4 * kq;
            const LAS float* w0 = WR + (lane & 15) * WR_PITCH + 512 * kh + 4 * kq; const LAS float* w1 = w0 + 16 * WR_PITCH;
            f32x4 acc0 = {0.f, 0.f, 0.f, 0.f}, acc1 = {0.f, 0.f, 0.f, 0.f}; float ss = 0.f;
            u32x2 xall[32];
#pragma unroll
            for (int i = 0; i < 32; ++i) xall[i] = *(const u32x2*)(xp + 16 * i);
#pragma unroll
            for (int i = 0; i < 32; ++i) {
                const u32x2 xw = xall[i]; const f32x4 xv = {bf_lo(xw.x), bf_hi(xw.x), bf_lo(xw.y), bf_hi(xw.y)};
                const f32x4 b0 = *(const LAS f32x4*)(w0 + 16 * i), b1 = *(const LAS f32x4*)(w1 + 16 * i);
                ss += (xv[0] * xv[0] + xv[1] * xv[1]) + (xv[2] * xv[2] + xv[3] * xv[3]);
#pragma unroll
                for (int j = 0; j < 4; ++j) { acc0 = __builtin_amdgcn_mfma_f32_16x16x4f32(xv[j], b0[j], acc0, 0, 0, 0); acc1 = __builtin_amdgcn_mfma_f32_16x16x4f32(xv[j], b1[j], acc1, 0, 0, 0); }
            }
            ss += __shfl_xor(ss, 16); ss += __shfl_xor(ss, 32);
            if (kq == 0) SSQP[kh * 64 + 16 * tg + r] = ss;
#pragma unroll
            for (int q = 0; q < 4; ++q) { const int tok = 16 * tg + 4 * kq + q; PART[(kh * 64 + tok) * 33 + (lane & 15)] = acc0[q]; PART[(kh * 64 + tok) * 33 + 16 + (lane & 15)] = acc1[q]; }
        }
        __syncthreads();
        int te[4] = {0, 0, 0, 0}, lp[4] = {0, 0, 0, 0}; float tv[4] = {-3e38f, -3e38f, -3e38f, -3e38f}; float rstd = 0.f;
        if (tid < 64) {
            const float ssq = SSQP[tid] + SSQP[64 + tid]; rstd = 1.0f / sqrtf(ssq * (1.f / DM) + EPS);
            const float* br = a->in[I_BR];
#pragma unroll
            for (int e = 0; e < 32; ++e) {
                float v = (PART[tid * 33 + e] + PART[(64 + tid) * 33 + e]) * rstd + br[e]; int id = e;
#pragma unroll
                for (int s = 0; s < 4; ++s) { const bool gt = v > tv[s]; const float ov = tv[s]; const int oi = te[s]; tv[s] = gt ? v : ov; te[s] = gt ? id : oi; v = gt ? ov : v; id = gt ? oi : id; }
            }
#pragma unroll
            for (int s = 0; s < 4; ++s) lp[s] = __hip_atomic_fetch_add(&CNT[te[s]], 1, __ATOMIC_RELAXED, __HIP_MEMORY_SCOPE_WORKGROUP);
        }
        __syncthreads();
        if (tid < 32) { const int c = CNT[tid]; BASE[tid] = c ? (int)atomicAdd(gcnt + tid, (unsigned)c) : 0; }
        __syncthreads();
        if (tid < 64) {
            const int t = tb + tid;
            const float e1 = __expf(tv[1] - tv[0]), e2 = __expf(tv[2] - tv[0]), e3 = __expf(tv[3] - tv[0]); const float inv = 1.0f / (1.0f + e1 + e2 + e3);
            const float gts[4] = {inv, e1 * inv, e2 * inv, e3 * inv};
#pragma unroll
            for (int s = 0; s < 4; ++s) { const int p = BASE[te[s]] + lp[s]; RE[t * 4 + s] = te[s]; RP[t * 4 + s] = p; RG[t * 4 + s] = gts[s]; TOK[te[s] * 16384 + p] = t; }
            RS[t] = rstd; RSTD_L[tid] = rstd;
        }
        __syncthreads();
        if (tid < 32) CNT[tid] = 0;
        {
            f32x4 g[2][2];
#pragma unroll
            for (int j = 0; j < 2; ++j) { g[j][0] = *(const f32x4*)(gf + 512 * j + 8 * lane); g[j][1] = *(const f32x4*)(gf + 512 * j + 8 * lane + 4); }
#pragma unroll 4
            for (int i = 0; i < 8; ++i) {
                const int t = tb + 8 * wave + i; const float rs = RSTD_L[8 * wave + i];
#pragma unroll
                for (int j = 0; j < 2; ++j) { const u32x4 xw = *(const u32x4*)(X1 + (size_t)t * DM + 512 * j + 8 * lane);
                    const f32x4 v0 = (f32x4){bf_lo(xw.x), bf_hi(xw.x), bf_lo(xw.y), bf_hi(xw.y)} * g[j][0] * rs, v1 = (f32x4){bf_lo(xw.z), bf_hi(xw.z), bf_lo(xw.w), bf_hi(xw.w)} * g[j][1] * rs;
                    *(u32x2*)(H8 + (size_t)t * DM + 512 * j + 8 * lane) = cvt8_fp8(v0, v1, 8.0f); }
            }
        }
        __syncthreads();
    }
}

__device__ __forceinline__ int build_tiles(const Frame& F) {
    const int tid_l = tid_local(), lane_l = tid_l & 63; (void)tid_l; (void)lane_l;
    LAS int* TB = (LAS int*)(F.lds + TILE_E_OFF); LAS int* TE = TB + 64;
    if (tid_l < 64) {
        const int c = (tid_l < NEXP) ? (int)__hip_atomic_load(F.ctl + CW_CNT + tid_l, RLX_AGENT) : 0; const int nt = (c + 255) >> 8;
        int incl = nt;
#pragma unroll
        for (int o = 1; o < 32; o <<= 1) { const int v = __shfl_up(incl, o); if (lane_l >= o) incl += v; }
        if (tid_l < NEXP) TB[tid_l] = incl - nt;
        if (tid_l == NEXP - 1) TB[NEXP] = incl;
    }
    __syncthreads();
    if (tid_l < NEXP) { for (int t = TB[tid_l]; t < TB[tid_l + 1]; ++t) TE[t] = tid_l; }
    __syncthreads();
    return TB[NEXP];
}

__device__ __forceinline__ void p8_dispatch(const Frame& F) {
    const int tid_l = tid_local(), lane_l = tid_l & 63; (void)tid_l; (void)lane_l;
    const KArgs a = kargs();
    (void)build_tiles(F);
    const LAS int* TB = (const LAS int*)(F.lds + TILE_E_OFF);
    const int gw = F.vcu * NWAVES + F.wave, NGW = F.G * NWAVES, lane = lane_l;
    const int* RE = (const int*)(F.ws + WS_ROUTE); const int* RP = RE + T * 4; const float* RS = (const float*)(RP + T * 4) + T * 4; int* SL = (int*)(RS + T);
    const bf16_t* X1 = (const bf16_t*)(F.ws + WS_X1B); const float* gf = a->in[I_GFFN]; unsigned char* XS = F.ws + WS_XS2;
    f32x4 g[2][2];
#pragma unroll
    for (int j = 0; j < 2; ++j) { g[j][0] = *(const f32x4*)(gf + 512 * j + 8 * lane); g[j][1] = *(const f32x4*)(gf + 512 * j + 8 * lane + 4); }
    for (int t = gw; t < T; t += NGW) {
        const float rstd = RS[t];
        u32x2 w[2];
#pragma unroll
        for (int j = 0; j < 2; ++j) { const u32x4 xw = *(const u32x4*)(X1 + (size_t)t * DM + 512 * j + 8 * lane);
            const f32x4 v0 = (f32x4){bf_lo(xw.x), bf_hi(xw.x), bf_lo(xw.y), bf_hi(xw.y)} * g[j][0] * rstd, v1 = (f32x4){bf_lo(xw.z), bf_hi(xw.z), bf_lo(xw.w), bf_hi(xw.w)} * g[j][1] * rstd;
            w[j] = cvt8_fp8(v0, v1, 8.0f); }
#pragma unroll
        for (int s = 0; s < 4; ++s) { const int e = RE[t * 4 + s], slot = TB[e] * 256 + RP[t * 4 + s];
            if (lane == 0) SL[t * 4 + s] = slot;
            unsigned char* dst = XS + (size_t)slot * DM + 8 * lane;
            *(u32x2*)dst = w[0]; *(u32x2*)(dst + 512) = w[1]; }
    }
}

template <bool GATHER_A> struct MoeOrderT {
    int G, c, ntn_shift, total; const LAS int* TE; unsigned A, Bw, bexp, btile; int xbase, xcount;
    __device__ __forceinline__ void init_xcd(const LAS int* TB) {
        if (G == 256) { const int x = c >> 5; xbase = __builtin_amdgcn_readfirstlane(TB[4 * x]); xcount = (__builtin_amdgcn_readfirstlane(TB[4 * x + 4]) - xbase) << ntn_shift; } else { xbase = -1; xcount = 0; }
    }
    __device__ __forceinline__ bool next(int i, Unit& u) const {
        if (xbase >= 0) { const int L = i * 32 + (c & 31); if (L >= xcount) return false;
            u.pm = xbase + (L >> ntn_shift); u.pn = L & ((1 << ntn_shift) - 1); u.aux = __builtin_amdgcn_readfirstlane(TE[u.pm]); return true; }
        const int L = i * G + c; if (L >= total) return false;
        u.pm = L >> ntn_shift; u.pn = L & ((1 << ntn_shift) - 1); u.aux = __builtin_amdgcn_readfirstlane(TE[u.pm]); return true;
    }
#ifndef MOE_PREFETCH
#define MOE_PREFETCH 0
#endif
    __device__ __forceinline__ void prefetch(const Unit& u, const __amdgpu_buffer_rsrc_t rsrc, LAS unsigned char* lds, int wid, int lane) const {
        if (!MOE_PREFETCH) return;
        const unsigned ln_ = (unsigned)(tid_local() & 63);
        const unsigned line = (unsigned)(u.pn & 3) * 512u + (unsigned)wid * 64u + ln_;
        const unsigned voff = (line >> 3) * 1024u + (line & 7u) * 128u;
        const unsigned dst = (unsigned)__builtin_amdgcn_readfirstlane((int)(unsigned)(unsigned long)(lds + 131072 + wid * 256));
        const unsigned soff = a_off(u);
        asm volatile("s_nop 4\n\ts_mov_b32 m0, %0\n\ts_nop 0\n\tbuffer_load_dword %1, %2, %3 offen lds" :: "s"(dst), "v"(voff), "s"(rsrc), "s"(soff) : "m0", "memory");
    }
    unsigned TOK;
    __device__ __forceinline__ unsigned tok_off(const Unit& u) const { return TOK + ((unsigned)u.aux * 16384u + (unsigned)(u.pm - __builtin_amdgcn_readfirstlane(TE[u.aux - 64])) * 256u) * 4u; }
    __device__ __forceinline__ unsigned a_off(const Unit& u) const { return GATHER_A ? A : A + (unsigned)u.pm * (256 * 1024); }
    __device__ __forceinline__ unsigned b_off(const Unit& u) const { return Bw + (unsigned)u.aux * bexp + (unsigned)u.pn * btile; }
};
using MoeOrder = MoeOrderT<false>; using MoeGather = MoeOrderT<true>;
struct EpiSwiglu {
    static constexpr bool PERM = true;
    unsigned char* ACT; const float* bgu;
    __device__ __forceinline__ void init(f32x4 (&acc)[2][2][4][2], const Unit& u, int wc, int fq) const {
        const float* bb = bgu + (size_t)u.aux * 2048 + u.pn * 128 + wc * 32 + 8 * fq;
        const f32x4 g0 = *(const f32x4*)(bb), g1 = *(const f32x4*)(bb + 4), u0 = *(const f32x4*)(bb + 1024), u1 = *(const f32x4*)(bb + 1028);
#pragma unroll
        for (int a = 0; a < 2; ++a)
#pragma unroll
            for (int m = 0; m < 4; ++m) { acc[a][0][m][0] = g0; acc[a][0][m][1] = g1; acc[a][1][m][0] = u0; acc[a][1][m][1] = u1; }
    }
    __device__ __forceinline__ void operator()(const f32x4 (&acc)[2][2][4][2], const Unit& u, int wr, int wc, int fr, int fq) const {
        const int row0 = u.pm * 256 + wr * 64 + fr, j0 = u.pn * 128 + wc * 32 + 8 * fq;
        unsigned char* dst0 = ACT + (size_t)row0 * DEXP + j0;
#pragma unroll
        for (int ai = 0; ai < 2; ++ai)
#pragma unroll
            for (int m = 0; m < 4; ++m) {
                int w2[2];
#pragma unroll
                for (int n = 0; n < 2; ++n) {
                    const f32x4 g = acc[ai][0][m][n], up = acc[ai][1][m][n];
                    f32x2 r[2];
#pragma unroll
                    for (int h = 0; h < 2; ++h) {
                        const f32x2 gg = {__builtin_amdgcn_fmed3f(g[2 * h], -3.0e38f, 7.0f), __builtin_amdgcn_fmed3f(g[2 * h + 1], -3.0e38f, 7.0f)};
                        const f32x2 uu = {__builtin_amdgcn_fmed3f(up[2 * h], -7.0f, 7.0f), __builtin_amdgcn_fmed3f(up[2 * h + 1], -7.0f, 7.0f)};
                        const f32x2 x = gg * (f32x2){-1.702f * 1.4426950408889634f, -1.702f * 1.4426950408889634f};
                        const f32x2 den = (f32x2){__builtin_amdgcn_exp2f(x[0]), __builtin_amdgcn_exp2f(x[1])} + (f32x2){1.0f, 1.0f};
                        const f32x2 rc = {__builtin_amdgcn_rcpf(den[0]), __builtin_amdgcn_rcpf(den[1])};
                        r[h] = (uu * (f32x2){8.0f, 8.0f} + (f32x2){8.0f, 8.0f}) * gg * rc; }
                    int w = __builtin_amdgcn_cvt_pk_fp8_f32(r[0][0], r[0][1], 0, false); w2[n] = __builtin_amdgcn_cvt_pk_fp8_f32(r[1][0], r[1][1], w, true);
                }
                u32x2 o; o.x = (unsigned)w2[0]; o.y = (unsigned)w2[1];
                *(u32x2*)(dst0 + (size_t)(ai * 128 + m * 16) * DEXP) = o;
            }
    }
};
struct EpiDown {
    static constexpr bool PERM = true;
    unsigned char* Y; const float* bd;
    __device__ __forceinline__ void init(f32x4 (&acc)[2][2][4][2], const Unit& u, int wc, int fq) const {
        const float* bb = bd + (size_t)u.aux * DM + u.pn * 256 + wc * 32 + 8 * fq;
        const f32x4 b00 = *(const f32x4*)(bb), b01 = *(const f32x4*)(bb + 4), b10 = *(const f32x4*)(bb + 128), b11 = *(const f32x4*)(bb + 132);
#pragma unroll
        for (int a = 0; a < 2; ++a)
#pragma unroll
            for (int m = 0; m < 4; ++m) { acc[a][0][m][0] = b00; acc[a][0][m][1] = b01; acc[a][1][m][0] = b10; acc[a][1][m][1] = b11; }
    }
    __device__ __forceinline__ void operator()(const f32x4 (&acc)[2][2][4][2], const Unit& u, int wr, int wc, int fr, int fq) const {
        const int row0 = u.pm * 256 + wr * 64 + fr, col0 = u.pn * 256 + wc * 32 + 8 * fq;
#pragma unroll
        for (int ai = 0; ai < 2; ++ai)
#pragma unroll
            for (int m = 0; m < 4; ++m) { unsigned char* rowp = Y + (size_t)(row0 + ai * 128 + m * 16) * DM + col0;
#pragma unroll
                for (int bj = 0; bj < 2; ++bj) *(u32x2*)(rowp + bj * 128) = cvt8_fp8(acc[ai][bj][m][0], acc[ai][bj][m][1], 8.0f); }
    }
};

__device__ __forceinline__ void p11_combine(const Frame& F) {
    const int tid_l = tid_local(), lane_l = tid_l & 63; (void)tid_l; (void)lane_l;
    const KArgs a = kargs();
    const int gw = F.vcu * NWAVES + F.wave, NGW = F.G * NWAVES, lane = lane_l;
    (void)build_tiles(F); const LAS int* TB = (const LAS int*)(F.lds + TILE_E_OFF);
    const int* RE = (const int*)(F.ws + WS_ROUTE); const int* RP = RE + T * 4; const float* RG = (const float*)(RE + T * 8);
    const unsigned char* Y = F.ws + WS_XS; bf16_t* HP = (bf16_t*)(F.ws + WS_HN); const bf16_t* X1 = (const bf16_t*)(F.ws + WS_X1B); bf16_t* X2 = (bf16_t*)(F.ws + WS_X2B); const float* gp = a->in[I_GPLE];
    f32x4 g[2][2];
#pragma unroll
    for (int j = 0; j < 2; ++j) { g[j][0] = *(const f32x4*)(gp + 512 * j + 8 * lane); g[j][1] = *(const f32x4*)(gp + 512 * j + 8 * lane + 4); }
    for (int t = gw; t < T; t += NGW) {
        f32x4 v[2][2];
#pragma unroll
        for (int j = 0; j < 2; ++j) { const u32x4 xw = *(const u32x4*)(X1 + (size_t)t * DM + 512 * j + 8 * lane); v[j][0] = (f32x4){bf_lo(xw.x), bf_hi(xw.x), bf_lo(xw.y), bf_hi(xw.y)}; v[j][1] = (f32x4){bf_lo(xw.z), bf_hi(xw.z), bf_lo(xw.w), bf_hi(xw.w)}; }
#pragma unroll
        for (int s = 0; s < 4; ++s) { const int slot = TB[RE[t * 4 + s]] * 256 + RP[t * 4 + s]; const float gt = RG[t * 4 + s] * 0.125f;
#pragma unroll
            for (int j = 0; j < 2; ++j) { const u32x2 y = *(const u32x2*)(Y + (size_t)slot * DM + 512 * j + 8 * lane);
                const f32x2 a0 = __builtin_amdgcn_cvt_pk_f32_fp8((int)y.x, false), a1 = __builtin_amdgcn_cvt_pk_f32_fp8((int)y.x, true), b0 = __builtin_amdgcn_cvt_pk_f32_fp8((int)y.y, false), b1 = __builtin_amdgcn_cvt_pk_f32_fp8((int)y.y, true);
                v[j][0] += (f32x4){a0[0], a0[1], a1[0], a1[1]} * gt; v[j][1] += (f32x4){b0[0], b0[1], b1[0], b1[1]} * gt; } }
        float ss = 0.f;
#pragma unroll
        for (int j = 0; j < 2; ++j)
#pragma unroll
            for (int n = 0; n < 2; ++n) { const f32x4 q = v[j][n]; ss += (q[0] * q[0] + q[1] * q[1]) + (q[2] * q[2] + q[3] * q[3]); u32x2 w; w.x = cvt_pk_bf16(q[0], q[1]); w.y = cvt_pk_bf16(q[2], q[3]); *(u32x2*)(X2 + (size_t)t * DM + 512 * j + 8 * lane + 4 * n) = w; }
        const float rstd = 1.0f / sqrtf(wave_sum(ss) * (1.f / DM) + EPS);
#pragma unroll
        for (int j = 0; j < 2; ++j) { const f32x4 q0 = v[j][0] * g[j][0] * rstd, q1 = v[j][1] * g[j][1] * rstd;
            if (PLE_FP8) { *(u32x2*)((unsigned char*)HP + (size_t)t * DM + 512 * j + 8 * lane) = cvt8_fp8(q0, q1, 8.0f); }
            else { u32x4 w; w.x = cvt_pk_bf16(q0[0], q0[1]); w.y = cvt_pk_bf16(q0[2], q0[3]); w.z = cvt_pk_bf16(q1[0], q1[1]); w.w = cvt_pk_bf16(q1[2], q1[3]);
                *(u32x4*)(HP + (size_t)t * DM + 512 * j + 8 * lane) = w; } }
    }
}
struct EpiPle {
    static constexpr bool PERM = false;
    __device__ __forceinline__ void init(f32x4 (&acc)[2][2][4][2], const Unit&, int, int) const {
#pragma unroll
        for (int a = 0; a < 2; ++a)
#pragma unroll
            for (int b = 0; b < 2; ++b)
#pragma unroll
                for (int m = 0; m < 4; ++m)
#pragma unroll
                    for (int n = 0; n < 2; ++n) acc[a][b][m][n] = (f32x4){0.f, 0.f, 0.f, 0.f};
    }
    float* out; const bf16_t* E; const bf16_t* X2;
    __device__ __forceinline__ void operator()(const f32x4 (&acc)[2][2][4][2], const Unit& u, int wr, int wc, int fr, int fq) const {
        const int row0 = u.pm * 256 + wr * 64 + fr, col0 = u.pn * 256 + wc * 32 + 4 * fq;
#pragma unroll
        for (int ai = 0; ai < 2; ++ai)
#pragma unroll
            for (int m = 0; m < 4; ++m) { const size_t off = (size_t)(row0 + ai * 128 + m * 16) * DM + col0;
#pragma unroll
                for (int bj = 0; bj < 2; ++bj)
#pragma unroll
                    for (int n = 0; n < 2; ++n) { const size_t o = off + bj * 128 + n * 16; const u32x2 ev = *(const u32x2*)(E + o); const f32x4 a4 = acc[ai][bj][m][n];
                        const u32x2 xw = *(const u32x2*)(X2 + o); f32x4 r = {bf_lo(xw.x), bf_hi(xw.x), bf_lo(xw.y), bf_hi(xw.y)};
                        r[0] += fast_sigmoid(a4[0]) * bf_lo(ev.x); r[1] += fast_sigmoid(a4[1]) * bf_hi(ev.x); r[2] += fast_sigmoid(a4[2]) * bf_lo(ev.y); r[3] += fast_sigmoid(a4[3]) * bf_hi(ev.y);
                        *(f32x4*)(out + o) = r; } }
    }
};

constexpr int N_PHASES = 13;
__global__ void __launch_bounds__(NWAVES * 64, 2) fwd_kernel(Args args) {
    extern __shared__ __attribute__((aligned(16))) unsigned char lds_raw[];
    Frame F;
    F.lds = (LAS unsigned char*)lds_raw; F.MISC = (volatile LAS unsigned*)(F.lds + MISC_OFF);
    F.wave = __builtin_amdgcn_readfirstlane(threadIdx.x >> 6);
    F.G = gridDim.x; { const int bx = blockIdx.x; F.vcu = (F.G % 8 == 0) ? (bx % 8) * (F.G / 8) + bx / 8 : bx; }
    { const KArgs ka = kargs(); F.out = ka->out; F.ws = ka->ws; F.ctl = (unsigned*)(ka->ws + WS_CTL); }
    { const int t0_ = tid_local(); if (t0_ < 32) F.MISC[t0_] = 0u; }
    __syncthreads();
    int lo, hi; { const KArgs ka = kargs(); lo = ka->ph_lo; hi = ka->ph_hi; }
    const bool multi = (hi - lo) > 1;
    XcdBarrier bar; bar.bar = F.ctl + CW_BAR; bar.x = 0; bar.st = nullptr;
    if (multi) bar = xcd_barrier_post(F.ctl + CW_BAR, F.MISC);
#ifndef PH_MASK
#define PH_MASK 0x1fff
#endif
#define IN(k) ((((PH_MASK) >> (k)) & 1) && lo <= (k) && (k) < hi)
#define SEAM(k) do { if (IN(k) && IN((k) + 1)) xcd_barrier(bar); } while (0)
    unsigned char* ws = F.ws;
    LAS unsigned char* ring = F.lds;
    const __amdgpu_buffer_rsrc_t rsrc = __builtin_amdgcn_make_buffer_rsrc((void*)ws, 0, (int)WS_END, 0x00020000);

    if (IN(0)) { p0_prologue(F); } SEAM(0);

    if (IN(1)) {
        if (GATES_FP8 && !P1_FP8) {
          { DenseOrder S; S.init(64, 8, F.G, (int)blockIdx.x, WS_HN8, 512, WS_WIN8 + (size_t)1024 * 1024, 512);
            EpiProj E{(bf16_t*)(ws + WS_PROJ), (bf16_t*)(ws + WS_GATES), 4};
            pg8::gemm_phase<EpiProj, DenseOrder, true, true, true>(ring, rsrc, pg8::Shape{1024, 1024, 1024, 0x7c7c7c7c, 0x7c7c7c7c}, S, E); }
          { DenseOrder S; S.init(64, 4, F.G, (int)blockIdx.x, WS_HN, 1024, WS_WIN, 1024);
            EpiProj E{(bf16_t*)(ws + WS_PROJ), (bf16_t*)(ws + WS_GATES), 0};
            pg8::gemm_phase<EpiProj, DenseOrder, true, true>(ring, rsrc, pg8::Shape{2048, 2048, 2048, 0, 0}, S, E); }
        } else
        { DenseOrder S; S.init(64, 12, F.G, (int)blockIdx.x, WS_HN, P1_FP8 ? 512 : 1024, WS_WIN, P1_FP8 ? 512 : 1024);
          EpiProj E{(bf16_t*)(ws + WS_PROJ), (bf16_t*)(ws + WS_GATES), 0};
          if (P1_FP8) pg8::gemm_phase<EpiProj, DenseOrder, true, true, true>(ring, rsrc, pg8::Shape{1024, 1024, 1024, 0x7c7c7c7c, 0x7c7c7c7c}, S, E);
          else pg8::gemm_phase<EpiProj, DenseOrder, true, true>(ring, rsrc, pg8::Shape{2048, 2048, 2048, 0, 0}, S, E, GP_AT(1)); }
        { DenseOrder S; S.init(64, 4, F.G, (int)blockIdx.x, WS_PB, 256, WS_WPLE, 256);
          EpiBf16 E{(bf16_t*)(ws + WS_E), 1024};
          pg8::gemm_phase<EpiBf16, DenseOrder, true, true>(ring, rsrc, pg8::Shape{512, 512, 512, 0, 0}, S, E); }
    } SEAM(1);

    if (IN(2)) { p2_rows(F); } SEAM(2);

    if (IN(3)) {
#ifndef P3M
#define P3M 7
#endif
        if (P3M & 1) { DenseOrder S; S.init(64, 4, F.G, (int)blockIdx.x, WS_A2 + 512, 512, WS_WKV, 256);
          EpiKV E{(bf16_t*)(ws + WS_K), (bf16_t*)(ws + WS_V), kargs()->in[I_GKNOPE]};
          pg8::gemm_phase<EpiKV, DenseOrder, true, true>(ring, rsrc, pg8::Shape{512, 1024, 512, 0, 0}, S, E); }
        if (P3M & 2) { DenseOrder S; S.init(64, 3, F.G, (int)blockIdx.x, WS_A2, 512, WS_WQ, 256);
          EpiQ E{(bf16_t*)(ws + WS_Q), (float*)(ws + WS_SSQ), (const float*)(ws + WS_COS), (const float*)(ws + WS_SIN), kargs()->in[I_GQHEAD]};
          pg8::gemm_phase<EpiQ, DenseOrder, true, true>(ring, rsrc, pg8::Shape{512, 1024, 512, 0, 0}, S, E); }
        if (P3M & 4) { DenseOrder S; S.init(64, 2, F.G, (int)blockIdx.x, WS_POOLED, 512, WS_WPOOL, 256, 512);
          EpiBf16 E{(bf16_t*)(ws + WS_MIXED), 512};
          pg8::gemm_phase<EpiBf16, DenseOrder, true, true>(ring, rsrc, pg8::Shape{512, 1024, 512, 0, 0}, S, E); }
    } SEAM(3);

    if (IN(4)) {
        u32x4 srd; { const unsigned long wb = (unsigned long)ws; srd.x = (unsigned)__builtin_amdgcn_readfirstlane((int)(unsigned)wb); srd.y = (unsigned)__builtin_amdgcn_readfirstlane((int)(unsigned)(wb >> 32)); srd.z = (unsigned)WS_END; srd.w = 0x00020000u; }
        att::ConvState CV; CV.next = __builtin_amdgcn_readfirstlane(F.vcu * NWAVES + F.wave); CV.end = CONV_IN_ATTN ? att::CV_ITEMS : 0; CV.cur = -1;
        bool fast;
        { const int lane = tid_local() & 63; const float* gqh = kargs()->in[I_GQHEAD]; const float* gkn = kargs()->in[I_GKNOPE]; const float* gkr = kargs()->in[I_GKROPE];
          float a = fabsf(gqh[lane]); if (lane < 32) a = fmaxf(a, fabsf(gqh[64 + lane])); float bn = fabsf(gkn[lane]); float br = (lane < 32) ? fabsf(gkr[lane]) : 0.f;
#pragma unroll
          for (int o = 1; o < 64; o <<= 1) { a = fmaxf(a, __shfl_xor(a, o)); bn = fmaxf(bn, __shfl_xor(bn, o)); br = fmaxf(br, __shfl_xor(br, o)); }
          const float Mb = 1.4426950408889634f * 1.01f * a * sqrtf(64.f * bn * bn + 32.f * br * br);
          fast = __builtin_amdgcn_readfirstlane(Mb <= 60.0f ? 1 : 0) != 0; }
        for (int it = F.vcu; it < 256; it += F.G) {
            const int bh = it >> 3, pr = it & 7;
            att::attn_unit(ring, srd, CV, ws, bh, 15 - pr, (const bf16_t*)(ws + WS_Q), (unsigned)WS_K, (unsigned)WS_V, (const float*)(ws + WS_SSQ), (bf16_t*)(ws + WS_ATT), fast);
            att::attn_unit(ring, srd, CV, ws, bh, pr, (const bf16_t*)(ws + WS_Q), (unsigned)WS_K, (unsigned)WS_V, (const float*)(ws + WS_SSQ), (bf16_t*)(ws + WS_ATT), fast);
        }
        { const LAS float* cb = (const LAS float*)(F.lds + att::CONV_OFF + F.wave * att::CONV_BYTES);
          const unsigned cbaddr = (unsigned)__builtin_amdgcn_readfirstlane((int)(unsigned)(unsigned long)(F.lds + att::CONV_OFF + F.wave * att::CONV_BYTES));
          const int lane_l = tid_local() & 63;
          while (CV.cur >= 0 || CV.next < CV.end) {
            if (CV.cur >= 0) { asm volatile("s_waitcnt vmcnt(0)" ::: "memory"); const att::ConvItem I = att::cv_setup(CV.cur, kargs()->in[I_WGU], kargs()->in[I_WD], ws + WS_WGU, ws + WS_WD); att::cv_out(I, cb, lane_l); }
            if (CV.next < CV.end) { const att::ConvItem I = att::cv_setup(CV.next, kargs()->in[I_WGU], kargs()->in[I_WD], ws + WS_WGU, ws + WS_WD); asm volatile("s_waitcnt lgkmcnt(0)" ::: "memory"); att::cv_dma(I, cbaddr, lane_l); CV.cur = CV.next; CV.next += 2048; } else CV.cur = -1;
          } }
    } SEAM(4);

    if (IN(5)) {
        MixOrder S{F.G, F.vcu, (unsigned)WS_ATT, (unsigned)WS_MIXED, (unsigned)WS_WAO, (unsigned)WS_WPO};
        EpiMix E{(bf16_t*)(ws + WS_MIX), (const bf16_t*)(ws + WS_GATES)};
        pg8::gemm_phase<EpiMix, MixOrder, true, true>(ring, rsrc, pg8::Shape{1024, 1024, 1024, 0, 0}, S, E, GP_AT(5));
    } SEAM(5);

    if (IN(6)) {
        DenseOrder S; S.init(64, 4, F.G, (int)blockIdx.x, WS_MIX, 1024, WS_WO, 1024);
        EpiRes E{kargs()->in[I_X], (bf16_t*)(ws + WS_X1B)};
        pg8::gemm_phase<EpiRes, DenseOrder, true, true>(ring, rsrc, pg8::Shape{2048, 2048, 2048, 0, 0}, S, E, GP_AT(6));
    } SEAM(6);

    if (IN(7)) { p7_router(F); } SEAM(7);


    if (IN(9)) {
        const int TM = build_tiles(F);
        MoeGather S{F.G, F.vcu, 3, TM * 8, (const LAS int*)(F.lds + TILE_E_OFF) + 64, (unsigned)WS_XS2, (unsigned)WS_WGU, 2048u * 1024u, 256u * 1024u, 0, 0, (unsigned)WS_TOK}; S.init_xcd((const LAS int*)(F.lds + TILE_E_OFF));
        EpiSwiglu E{ws + WS_ACT, kargs()->in[I_BGU]};
        pg8::gemm_phase<EpiSwiglu, MoeGather, true, true, true, true>(ring, rsrc, pg8::Shape{1024, 1024, 1024, 0x7c7c7c7c, 0x7c7c7c7c}, S, E, GP_AT(9));
    } SEAM(9);

    if (IN(10)) {
        const int TM = build_tiles(F);
        MoeOrder S{F.G, F.vcu, 2, TM * 4, (const LAS int*)(F.lds + TILE_E_OFF) + 64, (unsigned)WS_ACT, (unsigned)WS_WD, 1024u * 1024u, 256u * 1024u, 0, 0}; S.init_xcd((const LAS int*)(F.lds + TILE_E_OFF));
        EpiDown E{ws + WS_XS, kargs()->in[I_BD]};
        pg8::gemm_phase<EpiDown, MoeOrder, true, true, true>(ring, rsrc, pg8::Shape{1024, 1024, 1024, 0x7c7c7c7c, 0x7c7c7c7c}, S, E, GP_AT(10));
    } SEAM(10);

    if (IN(11)) { p11_combine(F); } SEAM(11);

    if (IN(12)) {
        DenseOrder S; S.init(64, 4, F.G, (int)blockIdx.x, WS_HN, PLE_FP8 ? 512 : 1024, WS_WPG, PLE_FP8 ? 512 : 1024);
        EpiPle E{F.out, (const bf16_t*)(ws + WS_E), (const bf16_t*)(ws + WS_X2B)};
        if (PLE_FP8) pg8::gemm_phase<EpiPle, DenseOrder, true, true, true>(ring, rsrc, pg8::Shape{1024, 1024, 1024, 0x7c7c7c7c, 0x7c7c7c7c}, S, E, GP_AT(12));
        else pg8::gemm_phase<EpiPle, DenseOrder, true, true>(ring, rsrc, pg8::Shape{2048, 2048, 2048, 0, 0}, S, E, GP_AT(12));
    }
#ifdef ATT_PROBE
    if (blockIdx.x == 17 && tid_local() == 0) { const unsigned long long* ap = (const unsigned long long*)(ws + WS_CTL + 65536 + 64); const unsigned long long wait = (ap[0] / ap[1]) * 10; const unsigned long long r0 = __builtin_amdgcn_s_memrealtime(); while (__builtin_amdgcn_s_memrealtime() - r0 < wait) __builtin_amdgcn_s_sleep(8); }
#endif
#ifdef ATT_PROBE2
    if (blockIdx.x == 17 && tid_local() == 0) { const unsigned long long* ap = (const unsigned long long*)(ws + WS_CTL + 65536 + 128); const unsigned long long wait = (ap[ATT_PROBE2 - 1] / ap[3]) * 10; const unsigned long long r0 = __builtin_amdgcn_s_memrealtime(); while (__builtin_amdgcn_s_memrealtime() - r0 < wait) __builtin_amdgcn_s_sleep(8); }
#endif
#ifdef BAR_PROBE
    for (int i_ = 0; i_ < 20; ++i_) xcd_barrier(bar);
#endif
#ifdef GP_PROBE
    if (blockIdx.x == GP_BLOCK && tid_local() == 0) {
        unsigned long long* gp = (unsigned long long*)(ws + WS_CTL + 65536);
        const unsigned long long cyc = gp[0], tiles = gp[1], pc = gp[2], pr = gp[3], units = gp[4];
        unsigned long long wait = 0;
        if (GP_METRIC == 0) wait = (cyc / tiles) * 10;
        if (GP_METRIC == 1) wait = (pc * 100 / pr) * 10;
        if (GP_METRIC == 2) wait = ((pc - cyc) / units);
        const unsigned long long r0 = __builtin_amdgcn_s_memrealtime();
        while (__builtin_amdgcn_s_memrealtime() - r0 < wait) __builtin_amdgcn_s_sleep(8);
    }
#endif
#undef IN
#undef SEAM
}

extern "C" void kernel_launch(void* const* d_in, const int* in_sizes, int n_in, void* d_out, int out_size, void* d_ws, size_t ws_size, hipStream_t stream) {
    static int grid = 0;
    if (grid == 0) {
        if (n_in != 27 || out_size != T * DM || ws_size < WS_END) { fprintf(stderr, "kernel_launch: unexpected shapes (n_in %d, out %d, ws %zu)\n", n_in, out_size, ws_size); grid = -1; return; }
        int dev = 0, cus = 0;
        if (hipGetDevice(&dev) != hipSuccess || hipDeviceGetAttribute(&cus, hipDeviceAttributeMultiprocessorCount, dev) != hipSuccess) { grid = -1; return; }
        if (hipFuncSetAttribute((const void*)fwd_kernel, hipFuncAttributeMaxDynamicSharedMemorySize, LDS_BYTES) != hipSuccess) { fprintf(stderr, "kernel_launch: hipFuncSetAttribute failed\n"); grid = -1; return; }
        int per_cu = 0;
        if (hipOccupancyMaxActiveBlocksPerMultiprocessor(&per_cu, (const void*)fwd_kernel, NWAVES * 64, LDS_BYTES) != hipSuccess || per_cu < 1) fprintf(stderr, "kernel_launch: occupancy query says %d\n", per_cu);
        (void)hipGetLastError();
        grid = cus;
    }
    if (grid < 0) return;
    (void)hipMemsetAsync((char*)d_ws + WS_CTL, 0, CTL_ZERO_BYTES, stream);
    Args a{};
    for (int i = 0; i < 27; ++i) a.in[i] = (const float*)d_in[i];
    a.out = (float*)d_out; a.ws = (unsigned char*)d_ws;
#ifndef DUP_PHASE
    a.ph_lo = 0; a.ph_hi = N_PHASES; hipLaunchKernelGGL(fwd_kernel, dim3(grid), dim3(NWAVES * 64), LDS_BYTES, stream, a);
#else
    a.ph_lo = 0; a.ph_hi = DUP_PHASE + 1; hipLaunchKernelGGL(fwd_kernel, dim3(grid), dim3(NWAVES * 64), LDS_BYTES, stream, a);
    (void)hipMemsetAsync((char*)d_ws + WS_CTL + CW_BAR * 4, 0, XCD_BAR_WORDS * 4, stream);
    a.ph_lo = DUP_PHASE; a.ph_hi = N_PHASES; hipLaunchKernelGGL(fwd_kernel, dim3(grid), dim3(NWAVES * 64), LDS_BYTES, stream, a);
#endif
}
```

```cpp
#include <hip/hip_runtime.h>
#include <cstdio>
#include <cstdint>

#define LAS __attribute__((address_space(3)))
#define GAS __attribute__((address_space(1)))
typedef unsigned short bf16_t;
typedef short bf16x8 __attribute__((ext_vector_type(8)));
typedef short s16x4 __attribute__((ext_vector_type(4)));
typedef float f32x4 __attribute__((ext_vector_type(4)));
typedef float f32x2 __attribute__((ext_vector_type(2)));
typedef float f32x16 __attribute__((ext_vector_type(16)));
typedef unsigned u32x4 __attribute__((ext_vector_type(4)));
typedef unsigned u32x2 __attribute__((ext_vector_type(2)));

constexpr int NB = 4, SEQ = 4096, T = NB * SEQ, DM = 1024, NH = 8, DK = 96, DV = 64;
constexpr int NEXP = 32, TOPK = 4, DEXP = 1024, PLE = 256;
constexpr float EPS = 1e-6f;
constexpr int XS_ROWS = T * TOPK + NEXP * 256;

typedef __bf16 bf16x2_t __attribute__((ext_vector_type(2)));
__device__ __forceinline__ unsigned cvt_pk_bf16(float lo, float hi) { f32x2 v = {lo, hi}; return __builtin_bit_cast(unsigned, __builtin_convertvector(v, bf16x2_t)); }
__device__ __forceinline__ u32x2 cvt8_fp8(const f32x4 a, const f32x4 b, float sc) {
    int w0 = __builtin_amdgcn_cvt_pk_fp8_f32(a[0] * sc, a[1] * sc, 0, false); w0 = __builtin_amdgcn_cvt_pk_fp8_f32(a[2] * sc, a[3] * sc, w0, true);
    int w1 = __builtin_amdgcn_cvt_pk_fp8_f32(b[0] * sc, b[1] * sc, 0, false); w1 = __builtin_amdgcn_cvt_pk_fp8_f32(b[2] * sc, b[3] * sc, w1, true);
    u32x2 r; r.x = (unsigned)w0; r.y = (unsigned)w1; return r;
}
__device__ __forceinline__ float bf_lo(unsigned w) { return __uint_as_float(w << 16); }
__device__ __forceinline__ float bf_hi(unsigned w) { return __uint_as_float(w & 0xffff0000u); }
__device__ __forceinline__ float bf1(bf16_t h) { return __uint_as_float(((unsigned)h) << 16); }
__device__ __forceinline__ float fast_sigmoid(float v) { return __builtin_amdgcn_rcpf(1.0f + __builtin_amdgcn_exp2f(-1.4426950408889634f * v)); }
__device__ __forceinline__ int lane_id() { return (int)__builtin_amdgcn_mbcnt_hi(~0u, __builtin_amdgcn_mbcnt_lo(~0u, 0u)); }
__device__ __forceinline__ int tid_local() { int t = threadIdx.x; asm volatile("" : "+v"(t)); return t; }
__device__ __forceinline__ float wave_sum(float v) {
#pragma unroll
    for (int o = 1; o < 64; o <<= 1) v += __shfl_xor(v, o);
    return v;
}

namespace pg8 {
constexpr int BM = 256, BK = 64, HALF = 128, HTB = HALF * BK * 2, STAGE_BYTES = 8 * HTB;
__host__ __device__ __forceinline__ int lds_byte(int r, int c) { const int st = (r >> 4) * 2 + (c >> 5), rr = r & 15, cc = c & 31, ob = rr * 64 + cc * 2; return st * 1024 + (ob ^ (((ob >> 9) & 1) << 5)); }
__host__ __device__ __forceinline__ void stage_rc(int b, int& R, int& C) { const int st = b / 1024, sb = b % 1024, swz = sb ^ (((sb >> 9) & 1) << 5); R = (st >> 1) * 16 + swz / 64; C = (st & 1) * 32 + (swz % 64) / 2; }
__host__ __device__ __forceinline__ int perm32(int rho) { const int n = rho >> 4, i = rho & 15; return 8 * (i >> 2) + 4 * n + (i & 3); }

struct Unit { int pm, pn, aux; };
struct Shape { int Kb, lda, ldb, sw, sa; };
typedef int v8i_t __attribute__((ext_vector_type(8))); typedef int v4i_t __attribute__((ext_vector_type(4)));

template <class Epi, class Sched, bool ALIGN_EPI, bool SP2, bool MX = false, bool GATHER = false>
__device__ __forceinline__ void gemm_phase(LAS unsigned char* lds, const __amdgpu_buffer_rsrc_t rsrc, const Shape g, const Sched& S, const Epi& E, unsigned long long* gp_out = nullptr) {
    const int tid = tid_local(), wid = __builtin_amdgcn_readfirstlane(tid >> 6), lane = tid & 63, wr = wid >> 2, wc = wid & 3, fr = lane & 15, fq = lane >> 4;
    int nt = g.Kb / 128; asm volatile("" : "+s"(nt));
    unsigned voffA, voffB;
    { int R, C; stage_rc(tid * 16, R, C); const int Rb = Epi::PERM ? ((R & ~31) + perm32(R & 31)) : R;
      voffA = GATHER ? (unsigned)(C * 2 + (R << 16)) : (unsigned)(R * g.lda + C * 2); voffB = (unsigned)(Rb * g.ldb + C * 2); }
    const unsigned p2A = 64u * (unsigned)g.lda, p2B = 64u * (unsigned)g.ldb;
    const unsigned kstep = 128u;
    const unsigned hstepA = (unsigned)HALF * g.lda, hstepB = (unsigned)HALF * g.ldb;
    const unsigned ldsw = (unsigned)wid * 1024u;
    const int aoff = lds_byte(wr * 64 + fr, fq * 8), boff = lds_byte(wc * 32 + fr, fq * 8);
#define PG8_SA(b, h) (((b) * 2 + (h)) * HTB)
#define PG8_SB(b, h) ((4 + (b) * 2 + (h)) * HTB)
#define PG8_STAGE(bufoff, gbase, voff) do { \
        __builtin_amdgcn_raw_ptr_buffer_load_lds(rsrc, (LAS void*)(lds + (bufoff) + ldsw), 16, voff, (gbase), 0, 0); \
        __builtin_amdgcn_raw_ptr_buffer_load_lds(rsrc, (LAS void*)(lds + (bufoff) + ldsw + 8192), 16, voff, (gbase) + p2##voff, 0, 0); } while (0)
#define p2voffA p2A
#define p2voffB p2B
#define PG8_STAGEA(bufoff, gk, h, tab) do { if constexpr (GATHER) { \
        const LAS int* tb_ = (const LAS int*)(lds + STAGE_BYTES) + (tab) * 256 + (h) * 128 + (int)(voffA >> 16); const unsigned cb_ = voffA & 0xffffu; \
        const unsigned i0_ = (unsigned)tb_[0], i1_ = (unsigned)tb_[64]; \
        __builtin_amdgcn_raw_ptr_buffer_load_lds(rsrc, (LAS void*)(lds + (bufoff) + ldsw), 16, i0_ * (unsigned)g.lda + cb_, (gk), 0, 0); \
        __builtin_amdgcn_raw_ptr_buffer_load_lds(rsrc, (LAS void*)(lds + (bufoff) + ldsw + 8192), 16, i1_ * (unsigned)g.lda + cb_, (gk), 0, 0); } \
      else { PG8_STAGE(bufoff, (gk) + (h) * hstepA, voffA); } } while (0)
#define PG8_LDA(dst, b, h) do { _Pragma("unroll") for (int m = 0; m < 4; ++m) _Pragma("unroll") for (int k = 0; k < 2; ++k) dst[m][k] = *(const LAS bf16x8*)(lds + PG8_SA(b, h) + aoff + m * 2048 + k * 1024); } while (0)
#define PG8_LDB(dst, b, h) do { _Pragma("unroll") for (int n = 0; n < 2; ++n) _Pragma("unroll") for (int k = 0; k < 2; ++k) dst[n][k] = *(const LAS bf16x8*)(lds + PG8_SB(b, h) + boff + n * 2048 + k * 1024); } while (0)
#define PG8_CAT(x, y) __builtin_shufflevector(__builtin_bit_cast(v4i_t, x), __builtin_bit_cast(v4i_t, y), 0, 1, 2, 3, 4, 5, 6, 7)
#define PG8_MMA(ai, bj, At, Bt) do { __builtin_amdgcn_s_setprio(1); if constexpr (MX) { _Pragma("unroll") for (int m = 0; m < 4; ++m) _Pragma("unroll") for (int n = 0; n < 2; ++n) \
        acc[ai][bj][m][n] = __builtin_amdgcn_mfma_scale_f32_16x16x128_f8f6f4(PG8_CAT(Bt[n][0], Bt[n][1]), PG8_CAT(At[m][0], At[m][1]), acc[ai][bj][m][n], 0, 0, 0, g.sw, 0, g.sa); } else { \
        _Pragma("unroll") for (int m = 0; m < 4; ++m) _Pragma("unroll") for (int n = 0; n < 2; ++n) _Pragma("unroll") for (int k = 0; k < 2; ++k) \
        acc[ai][bj][m][n] = __builtin_amdgcn_mfma_f32_16x16x32_bf16(Bt[n][k], At[m][k], acc[ai][bj][m][n], 0, 0, 0); } __builtin_amdgcn_s_setprio(0); } while (0)
#define PG8_WAIT_V(n) asm volatile("s_waitcnt vmcnt(" #n ")" ::: "memory")
#define PG8_WAIT_L(n) asm volatile("s_waitcnt lgkmcnt(" #n ")" ::: "memory")
#define PG8_BAR __builtin_amdgcn_s_barrier()
#define PG8_SCHED __builtin_amdgcn_sched_barrier(0)
#ifdef GP_PROBE
    unsigned long long gp_cycles = 0, gp_tiles = 0; const unsigned long long gp_p0 = __builtin_amdgcn_s_memtime(), gp_r0 = __builtin_amdgcn_s_memrealtime();
#endif
    Unit cur, nxt; int ui = 0;
    if (!S.next(0, cur)) return;
    f32x4 acc[2][2][4][2];
    E.init(acc, cur, wc, fq);
    bf16x8 At[4][2], B0[2][2], B1[2][2];
    unsigned cA = S.a_off(cur), cB = S.b_off(cur);
    int tab_c = 0; (void)tab_c;
    if constexpr (GATHER) {
        if (wid < 4) {
            const unsigned dst_ = (unsigned)__builtin_amdgcn_readfirstlane((int)(unsigned)(unsigned long)(lds + STAGE_BYTES + (wid * 64) * 4));
            const unsigned vo_ = (unsigned)((wid * 64 + lane) * 4); const unsigned so_ = S.tok_off(cur);
            asm volatile("s_nop 4\n\ts_mov_b32 m0, %0\n\ts_nop 0\n\tbuffer_load_dword %1, %2, %3 offen lds" :: "s"(dst_), "v"(vo_), "s"(rsrc), "s"(so_) : "m0", "memory"); }
        asm volatile("s_waitcnt vmcnt(0)" ::: "memory"); __syncthreads();
    }
    if constexpr (SP2) {
        PG8_STAGE(PG8_SB(0, 0), cB, voffB); PG8_STAGE(PG8_SB(0, 1), cB + hstepB, voffB); PG8_STAGEA(PG8_SA(0, 0), cA, 0, tab_c); PG8_STAGEA(PG8_SA(0, 1), cA, 1, tab_c);
        if (wr == 1) PG8_BAR;
        PG8_WAIT_V(2); PG8_BAR;
        PG8_STAGE(PG8_SB(1, 0), cB + kstep, voffB); PG8_STAGEA(PG8_SA(1, 0), cA + kstep, 0, tab_c); PG8_STAGE(PG8_SB(1, 1), cB + hstepB + kstep, voffB);
        PG8_WAIT_V(6); PG8_BAR;
    } else {
        PG8_STAGE(PG8_SB(0, 0), cB, voffB); PG8_STAGEA(PG8_SA(0, 0), cA, 0, tab_c); PG8_STAGE(PG8_SB(0, 1), cB + hstepB, voffB); PG8_STAGEA(PG8_SA(0, 1), cA, 1, tab_c);
        if (wr == 1) PG8_BAR;
        PG8_WAIT_V(4); PG8_BAR;
        PG8_STAGE(PG8_SB(1, 0), cB + kstep, voffB); PG8_STAGEA(PG8_SA(1, 0), cA + kstep, 0, tab_c); PG8_STAGE(PG8_SB(1, 1), cB + hstepB + kstep, voffB);
        PG8_WAIT_V(6); PG8_BAR;
    }
    for (;;) {
        const bool has_next = S.next(ui + 1, nxt);
        const unsigned nA = has_next ? S.a_off(nxt) : cA, nB = has_next ? S.b_off(nxt) : cB;
        if constexpr (GATHER) { if (has_next && wid < 4) {
            const unsigned dst_ = (unsigned)__builtin_amdgcn_readfirstlane((int)(unsigned)(unsigned long)(lds + STAGE_BYTES + ((tab_c ^ 1) * 256 + wid * 64) * 4));
            const unsigned vo_ = (unsigned)((wid * 64 + lane) * 4); const unsigned so_ = S.tok_off(nxt);
            asm volatile("s_nop 4\n\ts_mov_b32 m0, %0\n\ts_nop 0\n\tbuffer_load_dword %1, %2, %3 offen lds" :: "s"(dst_), "v"(vo_), "s"(rsrc), "s"(so_) : "m0", "memory"); } }
#ifdef GP_PROBE
        const unsigned long long gp_t0 = __builtin_amdgcn_s_memtime();
#endif
#pragma nounroll
        for (int t = 0; t < nt; t += 2) {
            const bool last = (t == nt - 2);
            const unsigned a1 = cA + (unsigned)(t + 1) * kstep;
            const unsigned a2 = last ? nA : cA + (unsigned)(t + 2) * kstep, b2 = last ? nB : cB + (unsigned)(t + 2) * kstep;
            const unsigned a3 = a2 + kstep, b3 = b2 + kstep; const int tab_2 = last ? (tab_c ^ 1) : tab_c; (void)tab_2;
            if constexpr (SP2) {
            PG8_LDB(B0, 0, 0); PG8_LDB(B1, 0, 1); PG8_SCHED; PG8_LDA(At, 0, 0); PG8_STAGEA(PG8_SA(1, 1), a1, 1, tab_c);
            PG8_WAIT_V(8); PG8_WAIT_L(0); PG8_BAR; PG8_MMA(0, 0, At, B0); PG8_MMA(0, 1, At, B1); PG8_BAR; PG8_SCHED;
            PG8_LDA(At, 0, 1); PG8_STAGE(PG8_SB(0, 0), b2, voffB); PG8_STAGE(PG8_SB(0, 1), b2 + hstepB, voffB); PG8_STAGEA(PG8_SA(0, 0), a2, 0, tab_2);
            PG8_WAIT_V(8); PG8_WAIT_L(0); PG8_BAR; PG8_MMA(1, 0, At, B0); PG8_MMA(1, 1, At, B1); PG8_BAR; PG8_SCHED;
            PG8_LDB(B0, 1, 0); PG8_LDB(B1, 1, 1); PG8_SCHED; PG8_LDA(At, 1, 0); PG8_STAGEA(PG8_SA(0, 1), a2, 1, tab_2);
            PG8_WAIT_V(8); PG8_WAIT_L(0); PG8_BAR; PG8_MMA(0, 0, At, B0); PG8_MMA(0, 1, At, B1); PG8_BAR; PG8_SCHED;
            PG8_LDA(At, 1, 1); PG8_STAGE(PG8_SB(1, 0), b3, voffB); PG8_STAGE(PG8_SB(1, 1), b3 + hstepB, voffB); PG8_STAGEA(PG8_SA(1, 0), a3, 0, tab_2);
            PG8_WAIT_V(8); PG8_WAIT_L(0); PG8_BAR; PG8_MMA(1, 0, At, B0); PG8_MMA(1, 1, At, B1); PG8_BAR; PG8_SCHED;
            } else {
            PG8_LDB(B0, 0, 0); PG8_SCHED; PG8_LDA(At, 0, 0); PG8_STAGEA(PG8_SA(1, 1), a1, 1, tab_c);
            PG8_WAIT_L(8); PG8_BAR; PG8_WAIT_L(0); PG8_MMA(0, 0, At, B0); PG8_BAR; PG8_SCHED;
            PG8_LDB(B1, 0, 1); PG8_STAGE(PG8_SB(0, 0), b2, voffB);
            PG8_BAR; PG8_WAIT_L(0); PG8_MMA(0, 1, At, B1); PG8_BAR;
            PG8_LDA(At, 0, 1); PG8_STAGEA(PG8_SA(0, 0), a2, 0, tab_2);
            PG8_BAR; PG8_WAIT_L(0); PG8_MMA(1, 0, At, B0); PG8_BAR; PG8_SCHED;
            PG8_STAGE(PG8_SB(0, 1), b2 + hstepB, voffB);
            PG8_WAIT_V(6); PG8_BAR; PG8_MMA(1, 1, At, B1); PG8_BAR;
            PG8_LDB(B0, 1, 0); PG8_SCHED; PG8_LDA(At, 1, 0); PG8_STAGEA(PG8_SA(0, 1), a2, 1, tab_2);
            PG8_WAIT_L(8); PG8_BAR; PG8_WAIT_L(0); PG8_MMA(0, 0, At, B0); PG8_BAR; PG8_SCHED;
            PG8_LDB(B1, 1, 1); PG8_STAGE(PG8_SB(1, 0), b3, voffB);
            PG8_BAR; PG8_WAIT_L(0); PG8_MMA(0, 1, At, B1); PG8_BAR;
            PG8_LDA(At, 1, 1); PG8_STAGEA(PG8_SA(1, 0), a3, 0, tab_2);
            PG8_BAR; PG8_WAIT_L(0); PG8_MMA(1, 0, At, B0); PG8_BAR; PG8_SCHED;
            PG8_STAGE(PG8_SB(1, 1), b3 + hstepB, voffB);
            PG8_WAIT_V(6); PG8_BAR; PG8_MMA(1, 1, At, B1); PG8_BAR;
            }
        }
#ifdef GP_PROBE
        if (gp_out) { gp_cycles += __builtin_amdgcn_s_memtime() - gp_t0; gp_tiles += nt; }
#endif
        if constexpr (ALIGN_EPI) { if (wr == 0) PG8_BAR; }
        if (has_next) S.prefetch(nxt, rsrc, lds, wid, lane);
        { int fr_e = fr, fq_e = fq; asm volatile("" : "+v"(fr_e), "+v"(fq_e));
          E(acc, cur, wr, wc, fr_e, fq_e); }
        if (!has_next) break;
        { int fq_i = fq; asm volatile("" : "+v"(fq_i)); E.init(acc, nxt, wc, fq_i); }
        cur = nxt; cA = nA; cB = nB; ++ui; tab_c ^= 1;
        if constexpr (ALIGN_EPI) { if (wr == 1) PG8_BAR; }
    }
    PG8_WAIT_V(0);
    if constexpr (!ALIGN_EPI) { if (wr == 0) PG8_BAR; }
    PG8_BAR;
#ifdef GP_PROBE
    if (gp_out && blockIdx.x == GP_BLOCK && tid == 0) { gp_out[0] = gp_cycles; gp_out[1] = gp_tiles; gp_out[2] = __builtin_amdgcn_s_memtime() - gp_p0; gp_out[3] = __builtin_amdgcn_s_memrealtime() - gp_r0; gp_out[4] = (unsigned long long)(ui + 1); }
#endif
#undef PG8_SA
#undef PG8_SB
#undef PG8_STAGE
#undef p2voffA
#undef PG8_STAGEA
#undef p2voffB
#undef PG8_LDA
#undef PG8_LDB
#undef PG8_MMA
#undef PG8_CAT
#undef PG8_WAIT_V
#undef PG8_WAIT_L
#undef PG8_BAR
#undef PG8_SCHED
}
}
using pg8::Unit;

constexpr size_t MiB = 1u << 20;
constexpr size_t WS_CTL = 0, CTL_ZERO_BYTES = 1 * MiB;
constexpr size_t WS_WIN = 1 * MiB;
constexpr size_t WS_WQ = 7 * MiB;
constexpr size_t WS_WKV = WS_WQ + 512 * 1024;
constexpr size_t WS_WPOOL = 8 * MiB;
constexpr size_t WS_WAO = 9 * MiB;
constexpr size_t WS_WPO = 10 * MiB;
constexpr size_t WS_WO = 11 * MiB;
constexpr size_t WS_WPG = 13 * MiB;
constexpr size_t WS_WPLE = 15 * MiB;
constexpr size_t WS_WGU = 16 * MiB;
constexpr size_t WS_WD = 144 * MiB;
constexpr size_t WS_HN = 208 * MiB;
constexpr size_t WS_PROJ = 240 * MiB;
constexpr size_t WS_GATES = 272 * MiB;
constexpr size_t WS_A2 = 336 * MiB;
constexpr size_t WS_POOLED = 352 * MiB;
constexpr size_t WS_Q = 368 * MiB;
constexpr size_t WS_K = 392 * MiB;
constexpr size_t WS_V = 416 * MiB;
constexpr size_t WS_ATT = 432 * MiB;
constexpr size_t WS_MIXED = 448 * MiB;
constexpr size_t WS_MIX = 464 * MiB;
constexpr size_t WS_PB = 496 * MiB;
constexpr size_t WS_E = 504 * MiB;
constexpr size_t WS_SSQ = 536 * MiB;
constexpr size_t WS_COS = 537 * MiB;
constexpr size_t WS_SIN = 538 * MiB;
constexpr size_t WS_ROUTE = 539 * MiB;
constexpr size_t WS_TOK = 541 * MiB;
constexpr size_t WS_XS = 544 * MiB;
constexpr size_t WS_ACT = 688 * MiB;
constexpr size_t WS_XS2 = 768 * MiB;
constexpr size_t WS_WIN8 = 848 * MiB;
constexpr size_t WS_HN8 = 852 * MiB;
constexpr size_t WS_END = 868 * MiB;
constexpr size_t WS_X1B = WS_PROJ;
constexpr size_t WS_X2B = WS_MIX;
constexpr int CW_BAR = 4096;
constexpr int CW_CNT = 1024;

constexpr int RING_BYTES = 131072;
constexpr int LDS_BYTES = 163840;
constexpr int MISC_OFF = LDS_BYTES - 512;
constexpr int TILE_E_OFF = LDS_BYTES - 4096;
constexpr int NWAVES = 8;

typedef GAS unsigned gu32;
#define RLX_AGENT __ATOMIC_RELAXED, __HIP_MEMORY_SCOPE_AGENT
#define XB_TMO      128
#define XB_XCNT(j)  (256  + 64 * (j))
#define XB_XSUB(j)  (1280 + 64 * (j))
#define XB_XGEN(j)  (2304 + 64 * (j))
#define XB_TOP      3328
#define XB_TOPGEN   3392
#define XCD_BAR_WORDS 3456
#define XB_SPIN_CAP (1u << 18)
__device__ __forceinline__ unsigned xb_ld(unsigned* p)              { return __hip_atomic_load(p, __ATOMIC_RELAXED, __HIP_MEMORY_SCOPE_AGENT); }
__device__ __forceinline__ unsigned xb_add(unsigned* p, unsigned v) { return __hip_atomic_fetch_add(p, v, __ATOMIC_RELAXED, __HIP_MEMORY_SCOPE_AGENT); }
__device__ __forceinline__ unsigned xb_xcc_id() { return (unsigned)__builtin_amdgcn_s_getreg((3 << 11) | 20) & 0xFu; }
#define XB_SPIN(cond, bar) do { unsigned _sp = 0; while (cond) { __builtin_amdgcn_s_sleep(1); \
    if ((++_sp & 255u) == 0u) { if (xb_ld(&(bar)[XB_TMO])) break; if (_sp > XB_SPIN_CAP) { atomicAdd(&(bar)[XB_TMO], 1u); break; } } } } while (0)
struct XcdBarrier { unsigned* bar; unsigned x; volatile LAS unsigned* st; };
__device__ __forceinline__ XcdBarrier xcd_barrier_post(unsigned* bar, volatile LAS unsigned* st) {
    XcdBarrier b; b.bar = bar; b.x = xb_xcc_id(); b.st = st;
    if (threadIdx.x == 0) (void)xb_add(&bar[XB_XCNT(b.x)], 1u);
    return b;
}
__device__ __forceinline__ void xcd_barrier_complete(unsigned* bar, unsigned x, unsigned& nloc, unsigned& nx) {
    const unsigned G = gridDim.x * gridDim.y * gridDim.z;
    unsigned sum, cnt, mine, sp = 0u;
    for (;;) {
        sum = 0u; cnt = 0u; mine = 0u;
#pragma unroll
        for (unsigned j = 0; j < 16; ++j) { const unsigned c = xb_ld(&bar[XB_XCNT(j)]); sum += c; cnt += (c > 0u) ? 1u : 0u; mine = (j == x) ? c : mine; }
        if (sum == G) break;
        __builtin_amdgcn_s_sleep(1);
        if ((++sp & 255u) == 0u) { if (xb_ld(&bar[XB_TMO])) break; if (sp > XB_SPIN_CAP) { atomicAdd(&bar[XB_TMO], 1u); break; } }
    }
    nloc = mine > 0u ? mine : 1u; nx = cnt > 0u ? cnt : 1u;
}
__device__ __forceinline__ void xcd_barrier(const XcdBarrier& b) {
    asm volatile("s_waitcnt vmcnt(0)" ::: "memory");
    __syncthreads();
    if (threadIdx.x == 0) {
        unsigned* bar = b.bar;
        __builtin_amdgcn_s_waitcnt(0);
        unsigned nloc = b.st[0], nx = b.st[1];
        if (nloc == 0u) { xcd_barrier_complete(bar, b.x, nloc, nx); b.st[0] = nloc; b.st[1] = nx; }
        const unsigned old = xb_add(&bar[XB_XSUB(b.x)], 1u);
        const unsigned gen = old / nloc;
        if (old + 1u == (gen + 1u) * nloc) {
            __builtin_amdgcn_fence(__ATOMIC_RELEASE, "agent");
            asm volatile("s_waitcnt vmcnt(0)" ::: "memory");
            const unsigned og = xb_add(&bar[XB_TOP], 1u);
            const unsigned tg = og / nx;
            if (og + 1u == (tg + 1u) * nx) xb_add(&bar[XB_TOPGEN], 1u);
            else XB_SPIN(xb_ld(&bar[XB_TOPGEN]) == tg, bar);
            __builtin_amdgcn_fence(__ATOMIC_ACQUIRE, "agent");
            xb_add(&bar[XB_XGEN(b.x)], 1u);
            asm volatile("s_waitcnt vmcnt(0)" ::: "memory");
        } else {
            XB_SPIN(xb_ld(&bar[XB_XGEN(b.x)]) == gen, bar);
            __builtin_amdgcn_fence(__ATOMIC_ACQUIRE, "agent");
            asm volatile("s_waitcnt vmcnt(0)" ::: "memory");
        }
    }
    __syncthreads();
}

#ifdef GP_PROBE
#define GP_AT(k) ((k) == GP_PHASE ? (unsigned long long*)(ws + WS_CTL + 65536) : nullptr)
#else
#define GP_AT(k) nullptr
#endif
struct Args {
    const float* in[27];
    float* out; unsigned char* ws;
    int ph_lo, ph_hi;
};
typedef const __attribute__((address_space(4))) Args* KArgs;
__device__ __forceinline__ KArgs kargs() { KArgs p = (KArgs)__builtin_amdgcn_kernarg_segment_ptr(); asm volatile("" : "+s"(p)); return p; }
enum { I_X = 0, I_P, I_POS, I_GMIX, I_WIN, I_GQLAT, I_WQB, I_GKVLAT, I_WKVB, I_GQHEAD, I_GKNOPE, I_GKROPE, I_WPOOL, I_PSCALE, I_WAO, I_WPO, I_WO, I_GFFN,
       I_WR, I_BR, I_WGU, I_BGU, I_WD, I_BD, I_GPLE, I_WPG, I_WPLE };

enum { MAP_ID = 0, MAP_WIN, MAP_GU, MAP_QB, MAP_KVB };
__device__ __forceinline__ int map_row(int mode, int n) {
    switch (mode) {
    case MAP_WIN: return n < 416 ? n : n + 96;
    case MAP_GU: { const int j = n & 1023, up = n >> 10; return 256 * (j >> 7) + 128 * up + (j & 127); }
    case MAP_QB: { const int h = n / 96, d = n % 96;
        if (d < 64) return (h >> 2) * 256 + 128 * (d >> 5) + 32 * (h & 3) + (d & 31);
        const int dd = d - 64, half = dd >> 4, i = dd & 15; return 512 + 128 * (h & 1) + 32 * (h >> 1) + 8 * (i >> 2) + 4 * half + (i & 3); }
    case MAP_KVB: { const int h = n >> 7, c = n & 127, isv = c >> 6, d = c & 63; return (h >> 1) * 256 + 128 * (d >> 5) + 32 * (2 * isv + (h & 1)) + (d & 31); }
    default: return n;
    }
}
struct TJob { const float* W; int K, N; bf16_t* WT; int ldw, koff, mode, row_off; const float* gk; const float* gn; int nmat; size_t wstride, wtstride; int fp8; };
struct TItem { const float* src; bf16_t* dst; int n0, k0; float gnv; };
__device__ __forceinline__ TItem titem_setup(const TJob& J, int item, int lane) {
    const int nblk = J.N / 32, ipm = (J.K / 64) * nblk, mat = item / ipm, it = item - mat * ipm, kb = it / nblk, nb = it - kb * nblk;
    TItem I; I.k0 = 64 * kb; I.n0 = 32 * nb;
    I.src = J.W + (size_t)mat * J.wstride + (size_t)(I.k0 + (lane >> 5)) * J.N + I.n0 + (lane & 31);
    I.dst = (bf16_t*)((unsigned char*)J.WT + (size_t)mat * J.wtstride * (J.fp8 ? 1 : 2));
    I.gnv = J.gn ? J.gn[I.n0 + (lane & 31)] : 1.f;
    return I;
}
__device__ __forceinline__ void titem_load(const TJob& J, const TItem& I, float (&v)[32]) {
#pragma unroll
    for (int i = 0; i < 32; ++i) v[i] = I.src[(size_t)(2 * i) * J.N];
}
__device__ __forceinline__ void titem_store(const TJob& J, const TItem& I, float (&v)[32], LAS float* scr, int lane) {
#pragma unroll
    for (int i = 0; i < 32; ++i) { const int kk = 2 * i + (lane >> 5); float x = v[i] * I.gnv; if (J.gk) x *= J.gk[I.k0 + kk]; scr[kk * 33 + (lane & 31)] = x; }
    asm volatile("s_waitcnt lgkmcnt(0)" ::: "memory");
    const int c = lane & 7;
#pragma unroll
    for (int j = 0; j < 4; ++j) { const int n = (lane >> 3) + 8 * j; const LAS float* s = scr + (8 * c) * 33 + n;
        const size_t eo = (size_t)(J.row_off + map_row(J.mode, I.n0 + n)) * J.ldw + J.koff + I.k0 + 8 * c;
        if (J.fp8) { u32x2 o; int w = __builtin_amdgcn_cvt_pk_fp8_f32(s[0 * 33] * 8.f, s[1 * 33] * 8.f, 0, false); w = __builtin_amdgcn_cvt_pk_fp8_f32(s[2 * 33] * 8.f, s[3 * 33] * 8.f, w, true); o.x = (unsigned)w;
            w = __builtin_amdgcn_cvt_pk_fp8_f32(s[4 * 33] * 8.f, s[5 * 33] * 8.f, 0, false); w = __builtin_amdgcn_cvt_pk_fp8_f32(s[6 * 33] * 8.f, s[7 * 33] * 8.f, w, true); o.y = (unsigned)w;
            *(u32x2*)((unsigned char*)I.dst + eo) = o; }
        else { u32x4 o; o.x = cvt_pk_bf16(s[0 * 33], s[1 * 33]); o.y = cvt_pk_bf16(s[2 * 33], s[3 * 33]); o.z = cvt_pk_bf16(s[4 * 33], s[5 * 33]); o.w = cvt_pk_bf16(s[6 * 33], s[7 * 33]);
            *(u32x4*)(I.dst + eo) = o; } }
    asm volatile("s_waitcnt lgkmcnt(0)" ::: "memory");
}
__device__ __forceinline__ void run_job(const TJob& J, LAS float* scr, int gw, int NGW, int lane) {
    const int items = J.nmat * (J.K / 64) * (J.N / 32);
    for (int it = gw; it < items; it += 2 * NGW) {
        const bool two = (it + NGW) < items;
        const TItem I0 = titem_setup(J, it, lane); const TItem I1 = titem_setup(J, two ? it + NGW : it, lane);
        float v0[32], v1[32];
        titem_load(J, I0, v0); if (two) titem_load(J, I1, v1);
        titem_store(J, I0, v0, scr, lane); if (two) titem_store(J, I1, v1, scr, lane);
    }
}

struct Frame {
    LAS unsigned char* lds; volatile LAS unsigned* MISC; unsigned* ctl;
    int wave, vcu, G;
    float* out; unsigned char* ws;
};

__device__ __forceinline__ void p0_prologue(const Frame& F) {
    const int tid_l = tid_local(), lane_l = tid_l & 63; (void)tid_l; (void)lane_l;
    const KArgs a = kargs();
    LAS float* scr = (LAS float*)(F.lds + F.wave * 16384);
    const int gw = F.vcu * NWAVES + F.wave, NGW = F.G * NWAVES;
    unsigned char* ws = F.ws;
    int joff = 0;
#define RUN_JOB(...) do { const TJob J_ = TJob{__VA_ARGS__, 1, 0, 0, 0}; run_job(J_, scr, (gw + NGW - joff % NGW) % NGW, NGW, lane_l); joff += (J_.K / 64) * (J_.N / 32); } while (0)
#ifndef P1_FP8
#define P1_FP8 0
#endif
    { const TJob J_{a->in[I_WIN], 1024, 2976, (bf16_t*)(ws + WS_WIN), 1024, 0, MAP_WIN, 0, nullptr, nullptr, 1, 0, 0, P1_FP8}; run_job(J_, scr, gw, NGW, lane_l); joff += 16 * 93; }
#ifndef GATES_FP8
#define GATES_FP8 0
#endif
    if (GATES_FP8) { const TJob J_{a->in[I_WIN], 1024, 2976, (bf16_t*)(ws + WS_WIN8), 1024, 0, MAP_WIN, 0, nullptr, nullptr, 1, 0, 0, 1}; run_job(J_, scr, gw, NGW, lane_l); }
    RUN_JOB(a->in[I_WQB], 256, 768, (bf16_t*)(ws + WS_WQ), 256, 0, MAP_QB, 0, a->in[I_GQLAT], nullptr);
    RUN_JOB(a->in[I_WKVB], 128, 1024, (bf16_t*)(ws + WS_WKV), 256, 0, MAP_KVB, 0, a->in[I_GKVLAT], nullptr);
    RUN_JOB(a->in[I_WAO], 512, 1024, (bf16_t*)(ws + WS_WAO), 512, 0, MAP_ID, 0, nullptr, nullptr);
    RUN_JOB(a->in[I_WPO], 512, 1024, (bf16_t*)(ws + WS_WPO), 512, 0, MAP_ID, 0, nullptr, nullptr);
    RUN_JOB(a->in[I_WO], 1024, 1024, (bf16_t*)(ws + WS_WO), 1024, 0, MAP_ID, 0, nullptr, nullptr);
#ifndef PLE_FP8
#define PLE_FP8 1
#endif
    { const TJob J_{a->in[I_WPG], 1024, 1024, (bf16_t*)(ws + WS_WPG), 1024, 0, MAP_ID, 0, nullptr, nullptr, 1, 0, 0, PLE_FP8}; run_job(J_, scr, (gw + NGW - joff % NGW) % NGW, NGW, lane_l); joff += 16 * 32; }
    RUN_JOB(a->in[I_WPLE], 256, 1024, (bf16_t*)(ws + WS_WPLE), 256, 0, MAP_ID, 0, nullptr, nullptr);
    for (int g = 0; g < 4; ++g)
        RUN_JOB(a->in[I_WPOOL] + (size_t)g * 128 * 128, 128, 128, (bf16_t*)(ws + WS_WPOOL) + (size_t)(g >> 1) * 256 * 256, 256, 128 * (g & 1), MAP_ID, 128 * (g & 1), nullptr, a->in[I_PSCALE] + 128 * g);
    {
        const int gt = (F.vcu * NWAVES + F.wave) * 64 + lane_l, NGT = NGW * 64;
        const u32x4 z = {0u, 0u, 0u, 0u};
        u32x4* w0 = (u32x4*)(ws + WS_WIN + (size_t)416 * 1024 * (P1_FP8 ? 1 : 2));
        for (int i = gt; i < 96 * (P1_FP8 ? 64 : 128); i += NGT) w0[i] = z;
        for (int i = gt; i < 1024 * 16; i += NGT) { const int r = i >> 4, c = i & 15; *(u32x4*)((bf16_t*)(ws + WS_WKV) + (size_t)r * 256 + 128 + 8 * c) = z; }
        for (int i = gt; i < 2 * 256 * 16; i += NGT) { const int p = i >> 12, r = (i >> 4) & 255, c = i & 15;
            const int k0 = (r < 128) ? 128 : 0; *(u32x4*)((bf16_t*)(ws + WS_WPOOL) + (size_t)p * 65536 + (size_t)r * 256 + k0 + 8 * c) = z; }
    }
#ifndef CONV_IN_ATTN
#define CONV_IN_ATTN 1
#endif
    if (!CONV_IN_ATTN) {
    { const TJob J{a->in[I_WGU], 1024, 2048, (bf16_t*)(ws + WS_WGU), 1024, 0, MAP_GU, 0, nullptr, nullptr, NEXP, (size_t)1024 * 2048, (size_t)2048 * 1024, 1}; run_job(J, scr, gw, NGW, lane_l); }
    { const TJob J{a->in[I_WD], 1024, 1024, (bf16_t*)(ws + WS_WD), 1024, 0, MAP_ID, 0, nullptr, nullptr, NEXP, (size_t)1024 * 1024, (size_t)1024 * 1024, 1}; run_job(J, scr, gw, NGW, lane_l); }
    }
    const float* x = a->in[I_X]; const float* gm = a->in[I_GMIX];
    f32x4 gv[4];
#pragma unroll
    for (int j = 0; j < 4; ++j) gv[j] = *(const f32x4*)(gm + 4 * lane_l + 256 * j);
    for (int m = gw; m < T; m += NGW) {
        const f32x4* xr = (const f32x4*)(x + (size_t)m * DM) + lane_l;
        f32x4 v[4]; float s = 0.f;
#pragma unroll
        for (int j = 0; j < 4; ++j) { v[j] = xr[64 * j]; s += (v[j].x * v[j].x + v[j].y * v[j].y) + (v[j].z * v[j].z + v[j].w * v[j].w); }
        const float rstd = 1.0f / sqrtf(wave_sum(s) * (1.f / DM) + EPS);
        if (P1_FP8) { int* o4 = (int*)(ws + WS_HN + (size_t)m * DM) + lane_l; const float r8 = rstd * 8.0f;
#pragma unroll
            for (int j = 0; j < 4; ++j) { int w = __builtin_amdgcn_cvt_pk_fp8_f32(v[j].x * r8 * gv[j].x, v[j].y * r8 * gv[j].y, 0, false); w = __builtin_amdgcn_cvt_pk_fp8_f32(v[j].z * r8 * gv[j].z, v[j].w * r8 * gv[j].w, w, true); o4[64 * j] = w; } }
        else { u32x2* o8 = (u32x2*)((bf16_t*)(ws + WS_HN) + (size_t)m * DM) + lane_l;
#pragma unroll
            for (int j = 0; j < 4; ++j) { u32x2 w; w.x = cvt_pk_bf16(v[j].x * rstd * gv[j].x, v[j].y * rstd * gv[j].y); w.y = cvt_pk_bf16(v[j].z * rstd * gv[j].z, v[j].w * rstd * gv[j].w); o8[64 * j] = w; }
            if (GATES_FP8) { int* o4 = (int*)(ws + WS_HN8 + (size_t)m * DM) + lane_l; const float r8 = rstd * 8.0f;
#pragma unroll
                for (int j = 0; j < 4; ++j) { int w = __builtin_amdgcn_cvt_pk_fp8_f32(v[j].x * r8 * gv[j].x, v[j].y * r8 * gv[j].y, 0, false); w = __builtin_amdgcn_cvt_pk_fp8_f32(v[j].z * r8 * gv[j].z, v[j].w * r8 * gv[j].w, w, true); o4[64 * j] = w; } } }
    }
    {
        const float* p = a->in[I_P];
        for (int m = gw; m < T; m += NGW) { const f32x4 v = *((const f32x4*)(p + (size_t)m * PLE) + lane_l); u32x2 w; w.x = cvt_pk_bf16(v.x, v.y); w.y = cvt_pk_bf16(v.z, v.w);
            *((u32x2*)((bf16_t*)(ws + WS_PB) + (size_t)m * PLE) + lane_l) = w; }
    }
}

struct DenseOrder {
    int nM, nN, nwg, G, c; unsigned A, B, tA, tB, aPn;
    __device__ void init(int nM_, int nN_, int G_, int c_, size_t A_, size_t lda, size_t B_, size_t ldb, unsigned aPn_ = 0) { nM = nM_; nN = nN_; nwg = nM * nN; G = G_; c = c_; A = (unsigned)A_; B = (unsigned)B_; tA = (unsigned)(256 * lda * 2); tB = (unsigned)(256 * ldb * 2); aPn = aPn_; }
    __device__ __forceinline__ bool next(int i, Unit& u) const {
        const long L = (long)i * G + c; if (L >= nwg) return false;
        int wgid = (int)L; { const int q = nwg / 8, r = nwg % 8, xcd = wgid % 8, off = wgid / 8; wgid = (xcd < r ? xcd * (q + 1) : r * (q + 1) + (xcd - r) * q) + off; }
        const int WGM = 8; const int nig = WGM * nN, gid = wgid / nig, fm = gid * WGM, gsz = (nM - fm) < WGM ? (nM - fm) : WGM;
        u.pm = fm + ((wgid % nig) % gsz); u.pn = (wgid % nig) / gsz; u.aux = 0; return true;
    }
    __device__ __forceinline__ void prefetch(const Unit&, const __amdgpu_buffer_rsrc_t, LAS unsigned char*, int, int) const {}
    __device__ __forceinline__ unsigned a_off(const Unit& u) const { return A + (unsigned)u.pm * tA + (unsigned)u.pn * aPn; }
    __device__ __forceinline__ unsigned b_off(const Unit& u) const { return B + (unsigned)u.pn * tB; }
};

struct EpiBf16 {
    static constexpr bool PERM = true;
    __device__ __forceinline__ void init(f32x4 (&acc)[2][2][4][2], const Unit&, int, int) const {
#pragma unroll
        for (int a = 0; a < 2; ++a)
#pragma unroll
            for (int b = 0; b < 2; ++b)
#pragma unroll
                for (int m = 0; m < 4; ++m)
#pragma unroll
                    for (int n = 0; n < 2; ++n) acc[a][b][m][n] = (f32x4){0.f, 0.f, 0.f, 0.f};
    }
    bf16_t* O; int ldc;
    __device__ __forceinline__ void operator()(const f32x4 (&acc)[2][2][4][2], const Unit& u, int wr, int wc, int fr, int fq) const {
        const int row0 = u.pm * 256 + wr * 64 + fr, col0 = u.pn * 256 + wc * 32 + 8 * fq;
#pragma unroll
        for (int ai = 0; ai < 2; ++ai)
#pragma unroll
            for (int m = 0; m < 4; ++m) { bf16_t* rowp = O + (size_t)(row0 + ai * 128 + m * 16) * ldc + col0;
#pragma unroll
                for (int bj = 0; bj < 2; ++bj) { const f32x4 v0 = acc[ai][bj][m][0], v1 = acc[ai][bj][m][1];
                    u32x4 w; w.x = cvt_pk_bf16(v0[0], v0[1]); w.y = cvt_pk_bf16(v0[2], v0[3]); w.z = cvt_pk_bf16(v1[0], v1[1]); w.w = cvt_pk_bf16(v1[2], v1[3]);
                    *(u32x4*)(rowp + bj * 128) = w; } }
    }
};
struct EpiProj {
    static constexpr bool PERM = true;
    __device__ __forceinline__ void init(f32x4 (&acc)[2][2][4][2], const Unit&, int, int) const {
#pragma unroll
        for (int a = 0; a < 2; ++a)
#pragma unroll
            for (int b = 0; b < 2; ++b)
#pragma unroll
                for (int m = 0; m < 4; ++m)
#pragma unroll
                    for (int n = 0; n < 2; ++n) acc[a][b][m][n] = (f32x4){0.f, 0.f, 0.f, 0.f};
    }
    bf16_t* PROJ; bf16_t* GATES; int pn_off;
    __device__ __forceinline__ void operator()(const f32x4 (&acc)[2][2][4][2], const Unit& u, int wr, int wc, int fr, int fq) const {
        const int pn = u.pn + pn_off; const int row0 = u.pm * 256 + wr * 64 + fr; const bool isg = pn >= 4;
        bf16_t* O = isg ? GATES : PROJ; const int ldc = isg ? 2048 : 1024; const int col0 = (isg ? pn - 4 : pn) * 256 + wc * 32 + 8 * fq;
#pragma unroll
        for (int ai = 0; ai < 2; ++ai)
#pragma unroll
            for (int m = 0; m < 4; ++m) { bf16_t* rowp = O + (size_t)(row0 + ai * 128 + m * 16) * ldc + col0;
#pragma unroll
                for (int bj = 0; bj < 2; ++bj) { f32x4 v0 = acc[ai][bj][m][0], v1 = acc[ai][bj][m][1];
                    if (isg) {
#pragma unroll
                        for (int e = 0; e < 4; ++e) { v0[e] = fast_sigmoid(v0[e]); v1[e] = fast_sigmoid(v1[e]); } }
                    u32x4 w; w.x = cvt_pk_bf16(v0[0], v0[1]); w.y = cvt_pk_bf16(v0[2], v0[3]); w.z = cvt_pk_bf16(v1[0], v1[1]); w.w = cvt_pk_bf16(v1[2], v1[3]);
                    *(u32x4*)(rowp + bj * 128) = w; } asm volatile("" ::: "memory"); }
    }
};

__device__ __forceinline__ void p2_rows(const Frame& F) {
    const int tid_l = tid_local(), lane_l = tid_l & 63; (void)tid_l; (void)lane_l;
    const KArgs a = kargs();
    const int gw = F.vcu * NWAVES + F.wave, NGW = F.G * NWAVES, lane = lane_l;
    unsigned char* ws = F.ws;
    const bf16_t* PROJ = (const bf16_t*)(ws + WS_PROJ);
    bf16_t* A2 = (bf16_t*)(ws + WS_A2); bf16_t* POOLED = (bf16_t*)(ws + WS_POOLED); bf16_t* Kb = (bf16_t*)(ws + WS_K);
    float* COS = (float*)(ws + WS_COS); float* SIN = (float*)(ws + WS_SIN);
    const int* positions = (const int*)a->in[I_POS];
    const float gkr = (lane < 32) ? a->in[I_GKROPE][lane] : 0.f;
    const float inv_freq = __builtin_amdgcn_exp2f(-(float)(lane & 15) * (13.287712379549449f / 16.0f));
    const int w = 2 << (lane >> 4);
    for (int task = gw; task < T / 8; task += NGW) {
        const int t0 = task * 8, b = t0 / SEQ, s0 = t0 % SEQ;
        u32x2 qlv[8]; unsigned kvv[8]; bf16_t krr[8]; int posv[8];
#pragma unroll
        for (int i = 0; i < 8; ++i) { const bf16_t* pr = PROJ + (size_t)(t0 + i) * 1024; qlv[i] = *(const u32x2*)(pr + 4 * lane); kvv[i] = *(const unsigned*)(pr + 256 + 2 * lane); krr[i] = pr[384 + (lane & 31)]; posv[i] = positions[t0 + i]; }
        {
            const bf16_t* base = PROJ + (size_t)(b * SEQ) * 1024 + 512 + 8 * lane;
            u32x4 I[15], C[8], L[8];
#pragma unroll
            for (int k = 0; k < 15; ++k) { const int r = s0 - 15 + k; I[k] = *(const u32x4*)(base + (size_t)(r < 0 ? 0 : r) * 1024); }
#pragma unroll
            for (int i = 0; i < 8; ++i) { C[i] = *(const u32x4*)(base + (size_t)(s0 + i) * 1024); const int rr = s0 + i - w + 1; L[i] = *(const u32x4*)(base + (size_t)(rr < 0 ? 0 : rr) * 1024); }
            float S[8];
#pragma unroll
            for (int j = 0; j < 8; ++j) S[j] = 0.f;
#pragma unroll
            for (int k = 0; k < 15; ++k) { const float mk = (s0 - 15 + k >= 0 && k >= 16 - w) ? 1.f : 0.f; const u32x4 v = I[k];
                S[0] += mk * bf_lo(v.x); S[1] += mk * bf_hi(v.x); S[2] += mk * bf_lo(v.y); S[3] += mk * bf_hi(v.y); S[4] += mk * bf_lo(v.z); S[5] += mk * bf_hi(v.z); S[6] += mk * bf_lo(v.w); S[7] += mk * bf_hi(v.w); }
#pragma unroll
            for (int i = 0; i < 8; ++i) {
                const int s = s0 + i;
                const u32x4 v = C[i];
                float uu[8] = {bf_lo(v.x), bf_hi(v.x), bf_lo(v.y), bf_hi(v.y), bf_lo(v.z), bf_hi(v.z), bf_lo(v.w), bf_hi(v.w)};
                const int cnt = (s + 1 < w) ? s + 1 : w; const float ic = 1.0f / (float)cnt;
                float o[8];
#pragma unroll
                for (int j = 0; j < 8; ++j) { S[j] += uu[j]; o[j] = S[j] * ic - uu[j]; }
                u32x4 wv; wv.x = cvt_pk_bf16(o[0], o[1]); wv.y = cvt_pk_bf16(o[2], o[3]); wv.z = cvt_pk_bf16(o[4], o[5]); wv.w = cvt_pk_bf16(o[6], o[7]);
                *(u32x4*)(POOLED + (size_t)(t0 + i) * 512 + 8 * lane) = wv;
                const float mq = (s - w + 1 >= 0) ? 1.f : 0.f; const u32x4 q = L[i];
                S[0] -= mq * bf_lo(q.x); S[1] -= mq * bf_hi(q.x); S[2] -= mq * bf_lo(q.y); S[3] -= mq * bf_hi(q.y); S[4] -= mq * bf_lo(q.z); S[5] -= mq * bf_hi(q.z); S[6] -= mq * bf_lo(q.w); S[7] -= mq * bf_hi(q.w);
            }
        }
#pragma unroll
        for (int i = 0; i < 8; ++i) {
            const int t = t0 + i, s = s0 + i;
            const u32x2 ql = qlv[i];
            const unsigned kvl = kvv[i];
            const float krv = (lane < 32) ? bf1(krr[i]) : 0.f;
            const float q0 = bf_lo(ql.x), q1 = bf_hi(ql.x), q2 = bf_lo(ql.y), q3 = bf_hi(ql.y);
            const float k0 = bf_lo(kvl), k1 = bf_hi(kvl);
            const float sq = wave_sum((q0 * q0 + q1 * q1) + (q2 * q2 + q3 * q3));
            const float sk = wave_sum(k0 * k0 + k1 * k1);
            const float sr = wave_sum(krv * krv);
            const float rq = 1.0f / sqrtf(sq * (1.f / 256.f) + EPS), rk = 1.0f / sqrtf(sk * (1.f / 128.f) + EPS), rr = 1.0f / sqrtf(sr * (1.f / 32.f) + EPS);
            u32x2 wq; wq.x = cvt_pk_bf16(q0 * rq, q1 * rq); wq.y = cvt_pk_bf16(q2 * rq, q3 * rq);
            *(u32x2*)(A2 + (size_t)t * 512 + 4 * lane) = wq;
            *(unsigned*)(A2 + (size_t)t * 512 + 256 + 2 * lane) = cvt_pk_bf16(k0 * rk, k1 * rk);
            *(unsigned*)(A2 + (size_t)t * 512 + 384 + 2 * lane) = 0u;
            const float pos = (float)posv[i];
            const float ang = pos * inv_freq;
            const float rev = ang * 0.15915494309189535f;
            const float fr_ = rev - floorf(rev);
            const float sn = __builtin_amdgcn_sinf(fr_), cs = __builtin_amdgcn_cosf(fr_);
            const float kn = krv * rr * gkr;
            const float other = __shfl_xor(kn, 16);
            const float ro = (lane & 16) ? (kn * cs + other * sn) : (kn * cs - other * sn);
            if (lane < 32) {
                const bf16_t rb = (bf16_t)(cvt_pk_bf16(ro, 0.f) & 0xffffu);
#pragma unroll
                for (int h = 0; h < NH; ++h) Kb[((size_t)(b * NH + h) * SEQ + s) * DK + 64 + lane] = rb;
            }
            if (lane < 16) { COS[(size_t)t * 16 + lane] = cs; SIN[(size_t)t * 16 + lane] = sn; }
        }
    }
}

#define EPI_FENCE() asm volatile("" ::: "memory")
struct EpiQ {
    static constexpr bool PERM = true;
    __device__ __forceinline__ void init(f32x4 (&acc)[2][2][4][2], const Unit&, int, int) const {
#pragma unroll
        for (int a = 0; a < 2; ++a)
#pragma unroll
            for (int b = 0; b < 2; ++b)
#pragma unroll
                for (int m = 0; m < 4; ++m)
#pragma unroll
                    for (int n = 0; n < 2; ++n) acc[a][b][m][n] = (f32x4){0.f, 0.f, 0.f, 0.f};
    }
    bf16_t* Q; float* SSQ; const float* COS; const float* SIN; const float* gq;
    __device__ __forceinline__ void operator()(const f32x4 (&acc)[2][2][4][2], const Unit& u, int wr, int wc, int fr, int fq) const {
        const int t0 = u.pm * 256 + wr * 64 + fr, b = (u.pm * 256) / SEQ, s0 = t0 - b * SEQ;
        if (u.pn < 2) {
            const int h = 4 * u.pn + wc;
            bf16_t* dst0 = Q + ((size_t)(b * NH + h) * SEQ + s0) * DK + 8 * fq;
            float* ssq0 = SSQ + ((size_t)t0 * NH + h) * 2;
#pragma unroll
            for (int ai = 0; ai < 2; ++ai)
#pragma unroll
                for (int m = 0; m < 4; ++m) {
                    const int dr = ai * 128 + m * 16;
                    float q = 0.f;
#pragma unroll
                    for (int bj = 0; bj < 2; ++bj)
#pragma unroll
                        for (int n = 0; n < 2; ++n) { const f32x4 v = acc[ai][bj][m][n]; q += (v[0] * v[0] + v[1] * v[1]) + (v[2] * v[2] + v[3] * v[3]); }
                    q += __shfl_xor(q, 16); q += __shfl_xor(q, 32);
                    if (fq == 0) ssq0[dr * NH * 2] = q;
#pragma unroll
                    for (int bj = 0; bj < 2; ++bj) { const f32x4 v0 = acc[ai][bj][m][0] * *(const f32x4*)(gq + 32 * bj + 8 * fq), v1 = acc[ai][bj][m][1] * *(const f32x4*)(gq + 32 * bj + 8 * fq + 4);
                        u32x4 w; w.x = cvt_pk_bf16(v0[0], v0[1]); w.y = cvt_pk_bf16(v0[2], v0[3]); w.z = cvt_pk_bf16(v1[0], v1[1]); w.w = cvt_pk_bf16(v1[2], v1[3]);
                        *(u32x4*)(dst0 + dr * DK + 32 * bj) = w; }
                    EPI_FENCE();
                }
        } else {
            const f32x4 g1 = *(const f32x4*)(gq + 64 + 4 * fq), g2 = *(const f32x4*)(gq + 80 + 4 * fq);
            const float* cs0 = COS + (size_t)t0 * 16 + 4 * fq; const float* sn0 = SIN + (size_t)t0 * 16 + 4 * fq;
            bf16_t* dst0 = Q + ((size_t)(b * NH + 2 * wc) * SEQ + s0) * DK + 64 + 4 * fq;
            float* ssq0 = SSQ + ((size_t)t0 * NH + 2 * wc) * 2 + 1;
#pragma unroll
            for (int ai = 0; ai < 2; ++ai)
#pragma unroll
                for (int m = 0; m < 4; ++m) {
                    const int dr = ai * 128 + m * 16;
                    const f32x4 cs = *(const f32x4*)(cs0 + dr * 16), sn = *(const f32x4*)(sn0 + dr * 16);
#pragma unroll
                    for (int bj = 0; bj < 2; ++bj) {
                        const f32x4 x1 = acc[ai][bj][m][0], x2 = acc[ai][bj][m][1];
                        float q = (x1[0] * x1[0] + x1[1] * x1[1]) + (x1[2] * x1[2] + x1[3] * x1[3]) + (x2[0] * x2[0] + x2[1] * x2[1]) + (x2[2] * x2[2] + x2[3] * x2[3]);
                        q += __shfl_xor(q, 16); q += __shfl_xor(q, 32);
                        if (fq == 0) ssq0[dr * NH * 2 + bj * 2] = q;
                        const f32x4 y1 = x1 * g1, y2 = x2 * g2;
                        const f32x4 o1 = y1 * cs - y2 * sn, o2 = y2 * cs + y1 * sn;
                        bf16_t* dst = dst0 + (size_t)bj * SEQ * DK + dr * DK;
                        u32x2 w1, w2; w1.x = cvt_pk_bf16(o1[0], o1[1]); w1.y = cvt_pk_bf16(o1[2], o1[3]); w2.x = cvt_pk_bf16(o2[0], o2[1]); w2.y = cvt_pk_bf16(o2[2], o2[3]);
                        *(u32x2*)(dst) = w1; *(u32x2*)(dst + 16) = w2;
                    }
                    EPI_FENCE();
                }
        }
    }
};
struct EpiKV {
    static constexpr bool PERM = true;
    __device__ __forceinline__ void init(f32x4 (&acc)[2][2][4][2], const Unit&, int, int) const {
#pragma unroll
        for (int a = 0; a < 2; ++a)
#pragma unroll
            for (int b = 0; b < 2; ++b)
#pragma unroll
                for (int m = 0; m < 4; ++m)
#pragma unroll
                    for (int n = 0; n < 2; ++n) acc[a][b][m][n] = (f32x4){0.f, 0.f, 0.f, 0.f};
    }
    bf16_t* K; bf16_t* V; const float* gk;
    __device__ __forceinline__ void operator()(const f32x4 (&acc)[2][2][4][2], const Unit& u, int wr, int wc, int fr, int fq) const {
        const int t0 = u.pm * 256 + wr * 64 + fr, b = (u.pm * 256) / SEQ, s0 = t0 - b * SEQ;
        const int h = 2 * u.pn + (wc & 1); const bool isv = wc >= 2;
        const int pitch = isv ? DV : DK;
        bf16_t* dst0 = (isv ? V : K) + ((size_t)(b * NH + h) * SEQ + s0) * pitch + 8 * fq;
#pragma unroll
        for (int ai = 0; ai < 2; ++ai)
#pragma unroll
            for (int m = 0; m < 4; ++m) {
                const int dr = ai * 128 + m * 16;
                float sc = 1.f;
                if (!isv) { float q = 0.f;
#pragma unroll
                    for (int bj = 0; bj < 2; ++bj)
#pragma unroll
                        for (int n = 0; n < 2; ++n) { const f32x4 v = acc[ai][bj][m][n]; q += (v[0] * v[0] + v[1] * v[1]) + (v[2] * v[2] + v[3] * v[3]); }
                    q += __shfl_xor(q, 16); q += __shfl_xor(q, 32);
                    sc = 1.0f / sqrtf(q * (1.f / 64.f) + EPS); }
#pragma unroll
                for (int bj = 0; bj < 2; ++bj) {
                    f32x4 v0 = acc[ai][bj][m][0] * sc, v1 = acc[ai][bj][m][1] * sc;
                    if (!isv) { v0 = v0 * *(const f32x4*)(gk + 32 * bj + 8 * fq); v1 = v1 * *(const f32x4*)(gk + 32 * bj + 8 * fq + 4); }
                    u32x4 w; w.x = cvt_pk_bf16(v0[0], v0[1]); w.y = cvt_pk_bf16(v0[2], v0[3]); w.z = cvt_pk_bf16(v1[0], v1[1]); w.w = cvt_pk_bf16(v1[2], v1[3]);
                    *(u32x4*)(dst0 + dr * pitch + 32 * bj) = w; }
                EPI_FENCE();
            }
    }
};

namespace att {
constexpr int KT_BYTES = 64 * 192, VT_BYTES = 64 * 128, SLOT_BYTES = KT_BYTES + VT_BYTES;
#ifndef ATT_PF
#define ATT_PF 3
#endif
constexpr int NSLOT = ATT_PF + 1, SCR_OFF = NSLOT * SLOT_BYTES;
__device__ __forceinline__ int crow(int r, int hi) { return (r & 3) + 8 * (r >> 2) + 4 * hi; }
__device__ __forceinline__ s16x4 vtr(const LAS unsigned char* p) { typedef short v4i16_t __attribute__((ext_vector_type(4)));
    return __builtin_bit_cast(s16x4, __builtin_amdgcn_ds_read_tr16_b64_v4i16((LAS v4i16_t*)p)); }
#define MFMA32(a, b, c) __builtin_amdgcn_mfma_f32_32x32x16_bf16(a, b, c, 0, 0, 0)
__device__ __forceinline__ float max3f(float a, float b, float c) { return __builtin_fmaxf(__builtin_fmaxf(a, b), c); }


constexpr int CONV_OFF = SCR_OFF + 8 * 256, CONV_BYTES = 8192;
constexpr int CV_GU_ITEMS = NEXP * 1024, CV_ITEMS = CV_GU_ITEMS + NEXP * 512;
struct ConvItem { const float* src; unsigned char* dst; int N, isgu, n0; };
__device__ __forceinline__ ConvItem cv_setup(int g, const float* wgu, const float* wd, unsigned char* wgu8, unsigned char* wd8) {
    ConvItem I;
    if (g < CV_GU_ITEMS) { const int e = g >> 10, it = g & 1023, kb = it >> 6, nb = it & 63; I.N = 2048; I.isgu = 1; I.n0 = 32 * nb;
        I.src = wgu + (size_t)e * 1024 * 2048 + (size_t)(64 * kb) * 2048 + 32 * nb; I.dst = wgu8 + (size_t)e * 2048 * 1024 + 64 * kb; }
    else { const int g2 = g - CV_GU_ITEMS, e = g2 >> 9, it = g2 & 511, kb = it >> 5, nb = it & 31; I.N = 1024; I.isgu = 0; I.n0 = 32 * nb;
        I.src = wd + (size_t)e * 1024 * 1024 + (size_t)(64 * kb) * 1024 + 32 * nb; I.dst = wd8 + (size_t)e * 1024 * 1024 + 64 * kb; }
    return I;
}
__device__ __forceinline__ void cv_dma(const ConvItem& I, unsigned ldsaddr, int lane) {
    const int kr = lane >> 3, sl = lane & 7;
#pragma unroll
    for (int q = 0; q < 8; ++q) { const unsigned voff = (unsigned)(((8 * q + kr) * I.N + 4 * (sl ^ ((kr ^ q) & 7))) * 4);
        asm volatile("s_nop 4\n\ts_mov_b32 m0, %0\n\ts_nop 0\n\tglobal_load_lds_dwordx4 %1, %2" :: "s"(ldsaddr + (unsigned)q * 1024u), "v"(voff), "s"(I.src) : "m0", "memory"); }
}
__device__ __forceinline__ void cv_out(const ConvItem& I, const LAS float* cb, int lane) {
    asm volatile("" : "+v"(lane));
    const int c = lane & 7;
#pragma unroll
    for (int j = 0; j < 4; ++j) { const int n = (lane >> 3) + 8 * j, nc = n >> 2, e = n & 3;
        float f[8];
#pragma unroll
        for (int kk = 0; kk < 8; ++kk) f[kk] = cb[(8 * c + kk) * 32 + ((nc ^ kk ^ c) & 7) * 4 + e];
        const int nn = I.n0 + n; const int row = I.isgu ? (256 * ((nn & 1023) >> 7) + 128 * (nn >> 10) + (nn & 127)) : nn;
        *(u32x2*)(I.dst + (size_t)row * 1024 + 8 * c) = cvt8_fp8((f32x4){f[0], f[1], f[2], f[3]}, (f32x4){f[4], f[5], f[6], f[7]}, 8.0f);
        asm volatile("" ::: "memory"); }
}
struct ConvState { int next, end, cur; };
__device__ __forceinline__ void attn_unit(LAS unsigned char* lds, const u32x4 srd, ConvState& CV, unsigned char* cvws, int bh, int qb, const bf16_t* Q_, unsigned Koff, unsigned Voff, const float* SSQ_, bf16_t* O_, const bool fast) {
    (void)Q_; (void)SSQ_; (void)O_;
    unsigned char* wl_ = cvws; asm volatile("" : "+s"(wl_));
    const bf16_t* Q = (const bf16_t*)(wl_ + WS_Q); const float* SSQ = (const float*)(wl_ + WS_SSQ); bf16_t* O = (bf16_t*)(wl_ + WS_ATT);
    const int tid = tid_local(), lane = tid & 63, r32 = lane & 31, hi = lane >> 5; const int wid = __builtin_amdgcn_readfirstlane(tid >> 6);
    const int b = bh / NH, h = bh % NH, q0 = qb * 256, qw = q0 + 32 * wid;
    LAS float* scr = (LAS float*)(lds + SCR_OFF) + wid * 64;
    const int NT = (q0 + 256) / 64;
    const unsigned kS = Koff + (unsigned)bh * (SEQ * DK * 2), vS = Voff + (unsigned)bh * (SEQ * DV * 2);
    const int kc2 = 8 + (wid & 3);
    const unsigned vK1 = (unsigned)(lane * 192 + wid * 16); const unsigned sK2 = (unsigned)((kc2 - wid) * 16);
    const int vkey = 8 * wid + (lane >> 3); const unsigned vV = (unsigned)(vkey * 128 + (((lane & 7) ^ (((vkey >> 1) & 1) * 4)) * 16));
    const unsigned lds0 = (unsigned)__builtin_amdgcn_readfirstlane((int)(unsigned)(unsigned long)lds);
    const unsigned dK1 = (unsigned)wid * 1024u, dK2 = (unsigned)kc2 * 1024u, dV = (unsigned)KT_BYTES + (unsigned)wid * 1024u;
#define ATT_DMA1(ldsaddr, voff, soff) asm volatile("s_nop 4\n\ts_mov_b32 m0, %0\n\ts_nop 0\n\tbuffer_load_dwordx4 %1, %2, %3 offen lds" :: "s"(ldsaddr), "v"(voff), "s"(srd), "s"(soff) : "m0", "memory")
#define ATT_DMA(t) do { const unsigned sp_ = lds0 + (unsigned)((t) % NSLOT) * SLOT_BYTES; const unsigned ks_ = kS + (unsigned)(t) * (64 * 192), vs_ = vS + (unsigned)(t) * (64 * 128); \
        ATT_DMA1(sp_ + dK1, vK1, ks_); ATT_DMA1(sp_ + dK2, vK1, ks_ + sK2); ATT_DMA1(sp_ + dV, vV, vs_); } while (0)
#define ATT_WAITBAR(N) asm volatile("s_waitcnt vmcnt(" #N ") lgkmcnt(0)\n\ts_barrier" ::: "memory")
    bf16x8 qr[6];
    { const float* sp = SSQ + ((size_t)(b * SEQ + qw + r32) * NH + h) * 2; const float ss = sp[0] + sp[1];
      const float cq = (1.0f / sqrtf(ss * (1.f / 96.f) + EPS)) * 0.10206207261596577f * 1.4426950408889634f;
      const bf16_t* qp = Q + ((size_t)bh * SEQ + qw + r32) * DK + 8 * hi;
      u32x4 qw_[6];
#pragma unroll
      for (int d0 = 0; d0 < 6; ++d0) qw_[d0] = *(const u32x4*)(qp + 16 * d0);
#pragma unroll
      for (int d0 = 0; d0 < 6; ++d0) { const u32x4 w = qw_[d0]; u32x4 o;
          o.x = cvt_pk_bf16(bf_lo(w.x) * cq, bf_hi(w.x) * cq); o.y = cvt_pk_bf16(bf_lo(w.y) * cq, bf_hi(w.y) * cq); o.z = cvt_pk_bf16(bf_lo(w.z) * cq, bf_hi(w.z) * cq); o.w = cvt_pk_bf16(bf_lo(w.w) * cq, bf_hi(w.w) * cq);
          qr[d0] = __builtin_bit_cast(bf16x8, o); } }
    ATT_DMA(0); ATT_DMA(1); ATT_DMA(2); if (ATT_PF == 4) ATT_DMA(3);
    const int kbase = hi * 1024 + r32 * 16;
    const int qq = (lane & 15) >> 2, pp = lane & 3, dblk = (lane >> 4) & 1, swz = ((qq >> 1) & 1) * 64;
    const int vrow0 = 4 * hi + qq;
    const int vb0 = KT_BYTES + vrow0 * 128 + ((32 * dblk + 8 * pp) ^ swz);
    const int vb1 = KT_BYTES + vrow0 * 128 + ((64 + 32 * dblk + 8 * pp) ^ swz);
    f32x16 o0 = {}, o1 = {};
    float m_run = -1e30f, l_run = 0.f; const f32x16 zero16 = {};
    const int qa = qw + r32;
#define ATT_QK(N0, N1, t) do { const LAS unsigned char* kp_ = lds + ((t) % NSLOT) * SLOT_BYTES + kbase; \
        _Pragma("unroll") for (int d0 = 0; d0 < 6; ++d0) { const bf16x8 ka_ = *(const LAS bf16x8*)(kp_ + d0 * 2048), kb_ = *(const LAS bf16x8*)(kp_ + d0 * 2048 + 512); \
            if (d0 == 0) { N0 = MFMA32(ka_, qr[0], zero16); N1 = MFMA32(kb_, qr[0], zero16); } else { N0 = MFMA32(ka_, qr[d0], N0); N1 = MFMA32(kb_, qr[d0], N1); } } } while (0)
#define ATT_MASK(N0, N1, t) do { const int kb_ = 64 * (t); if (kb_ + 63 > qw) { int d_ = qa - kb_ - 4 * hi; asm volatile("" : "+v"(d_));        \
        _Pragma("unroll") for (int r = 0; r < 16; ++r) { const int c_ = (r & 3) + 8 * (r >> 2); \
        if (c_ > d_) N0[r] = -__builtin_inff(); if (c_ + 32 > d_) N1[r] = -__builtin_inff(); } } } while (0)
#define ATT_ROWMAX(N0, N1, PM) do { float a_ = max3f(N0[0], N0[1], N1[0]), b_ = max3f(N0[2], N0[3], N1[1]); a_ = max3f(a_, N1[2], N1[3]); \
        _Pragma("unroll") for (int r = 4; r < 16; r += 4) { a_ = max3f(a_, N0[r], N0[r + 1]); b_ = max3f(b_, N0[r + 2], N0[r + 3]); a_ = max3f(a_, N1[r], N1[r + 1]); b_ = max3f(b_, N1[r + 2], N1[r + 3]); } \
        a_ = max3f(a_, b_, b_); auto rr_ = __builtin_amdgcn_permlane32_swap(__float_as_uint(a_), __float_as_uint(a_), false, false); \
        PM = max3f(__uint_as_float(rr_[0]), __uint_as_float(rr_[1]), __uint_as_float(rr_[1])); } while (0)
#define ATT_DECIDE(PM, C0, C1, FORCE) do { if ((FORCE) || __any((PM) > m_run + 8.0f)) { const float mn_ = fmaxf(m_run, (PM)); const float al_ = __builtin_amdgcn_exp2f(m_run - mn_); m_run = mn_; l_run *= al_; \
        if (hi == 0) scr[r32] = al_; asm volatile("s_waitcnt lgkmcnt(0)" ::: "memory"); \
        _Pragma("unroll") for (int a4 = 0; a4 < 4; ++a4) { const f32x4 f_ = *(const LAS f32x4*)(scr + 8 * a4 + 4 * hi); \
            _Pragma("unroll") for (int e = 0; e < 4; ++e) { o0[4 * a4 + e] *= f_[e]; o1[4 * a4 + e] *= f_[e]; } } } } while (0)
#define ATT_SM_HALF(P_, ks0, SUBM) do { _Pragma("unroll") for (int r = 0; r < 16; ++r) { P_[r] = __builtin_amdgcn_exp2f((SUBM) ? P_[r] - m_run : P_[r]); ps_ += P_[r]; } \
        _Pragma("unroll") for (int kq = 0; kq < 2; ++kq) { const int bs_ = 8 * kq; \
            u32x4 w_; w_.x = cvt_pk_bf16(P_[bs_ + 0], P_[bs_ + 1]); w_.y = cvt_pk_bf16(P_[bs_ + 2], P_[bs_ + 3]); w_.z = cvt_pk_bf16(P_[bs_ + 4], P_[bs_ + 5]); w_.w = cvt_pk_bf16(P_[bs_ + 6], P_[bs_ + 7]); \
            pa[(ks0) + kq] = __builtin_bit_cast(bf16x8, w_); } } while (0)
#define ATT_SOFTMAX(C0, C1) do { float ps_ = 0.f; ATT_SM_HALF(C0, 0, true); ATT_SM_HALF(C1, 2, true); l_run += ps_; } while (0)
#define ATT_SOFTMAX_F(C0, C1) do { float ps_ = 0.f; ATT_SM_HALF(C0, 0, false); ATT_SM_HALF(C1, 2, false); l_run += ps_; } while (0)
#define ATT_PV(t) do { const LAS unsigned char* vp0_ = lds + ((t) % NSLOT) * SLOT_BYTES + vb0; const LAS unsigned char* vp1_ = lds + ((t) % NSLOT) * SLOT_BYTES + vb1; \
        _Pragma("unroll") for (int ks = 0; ks < 4; ++ks) { \
            const s16x4 a0_ = vtr(vp0_ + ks * 16 * 128), a1_ = vtr(vp0_ + ks * 16 * 128 + 8 * 128), c0_ = vtr(vp1_ + ks * 16 * 128), c1_ = vtr(vp1_ + ks * 16 * 128 + 8 * 128); \
            const bf16x8 vf0_ = {a0_[0], a0_[1], a0_[2], a0_[3], a1_[0], a1_[1], a1_[2], a1_[3]}; const bf16x8 vf1_ = {c0_[0], c0_[1], c0_[2], c0_[3], c1_[0], c1_[1], c1_[2], c1_[3]}; \
            o0 = MFMA32(pa[ks], vf0_, o0); o1 = MFMA32(pa[ks], vf1_, o1); } } while (0)
#ifdef ATT_PROBE2
    unsigned long long ap_s[4] = {0, 0, 0, 0}, ap_acc[3] = {0, 0, 0};
#define AP_STAMP(k) do { __builtin_amdgcn_sched_barrier(0); asm volatile("s_memtime %0\n\ts_waitcnt lgkmcnt(0)" : "=s"(ap_s[k]) :: "memory"); __builtin_amdgcn_sched_barrier(0); if ((k) > 0) ap_acc[(k) - 1] += ap_s[k] - ap_s[(k) - 1]; } while (0)
#else
#define AP_STAMP(k) do {} while (0)
#endif
#define ATT_WB(N) asm volatile("s_waitcnt vmcnt(" #N ") lgkmcnt(0)\n\ts_barrier" ::: "memory")
#define ATT_RDK(d0) do { kf_[d0][0] = *(const LAS bf16x8*)(kp_ + (d0) * 2048); kf_[d0][1] = *(const LAS bf16x8*)(kp_ + (d0) * 2048 + 512); } while (0)
#define ATT_RDV(ks) do { vf_[ks][0] = vtr(vp0_ + (ks) * 16 * 128); vf_[ks][1] = vtr(vp0_ + (ks) * 16 * 128 + 8 * 128); vf_[ks][2] = vtr(vp1_ + (ks) * 16 * 128); vf_[ks][3] = vtr(vp1_ + (ks) * 16 * 128 + 8 * 128); } while (0)
#define ATT_MK(d0) do { if ((d0) == 0) { S0 = MFMA32(kf_[0][0], qr[0], zero16); S1 = MFMA32(kf_[0][1], qr[0], zero16); } else { S0 = MFMA32(kf_[d0][0], qr[d0], S0); S1 = MFMA32(kf_[d0][1], qr[d0], S1); } } while (0)
#define ATT_MV(ks) do { const bf16x8 v0_ = {vf_[ks][0][0], vf_[ks][0][1], vf_[ks][0][2], vf_[ks][0][3], vf_[ks][1][0], vf_[ks][1][1], vf_[ks][1][2], vf_[ks][1][3]}; \
        const bf16x8 v1_ = {vf_[ks][2][0], vf_[ks][2][1], vf_[ks][2][2], vf_[ks][2][3], vf_[ks][3][0], vf_[ks][3][1], vf_[ks][3][2], vf_[ks][3][3]}; \
        o0 = MFMA32(pa[ks], v0_, o0); o1 = MFMA32(pa[ks], v1_, o1); } while (0)
#define ATT_SB __builtin_amdgcn_sched_barrier(0)
#define ATT_SEGA(j, DODMA) do { \
        const LAS unsigned char* kp_ = lds + (((j) + 1) % NSLOT) * SLOT_BYTES + kbase; \
        const LAS unsigned char* vp0_ = lds + ((j) % NSLOT) * SLOT_BYTES + vb0; const LAS unsigned char* vp1_ = lds + ((j) % NSLOT) * SLOT_BYTES + vb1; \
        bf16x8 kf_[6][2]; s16x4 vf_[4][4]; \
        ATT_RDK(0); ATT_RDK(1); ATT_RDV(0); ATT_SB; \
        if (DODMA) { ATT_DMA((j) + ATT_PF); } ATT_SB; \
        ATT_MK(0); ATT_SB; ATT_RDK(2); ATT_SB; ATT_MK(1); ATT_SB; ATT_RDK(3); ATT_SB; ATT_MV(0); ATT_SB; ATT_RDV(1); ATT_SB; \
        ATT_MK(2); ATT_SB; ATT_RDK(4); ATT_SB; ATT_MK(3); ATT_SB; ATT_RDV(2); ATT_SB; ATT_MV(1); ATT_SB; ATT_RDK(5); ATT_SB; \
        ATT_MK(4); ATT_SB; ATT_MV(2); ATT_SB; ATT_RDV(3); ATT_SB; ATT_MK(5); ATT_MV(3); } while (0)
#define ATT_BARP asm volatile("s_waitcnt lgkmcnt(0)\n\ts_barrier" ::: "memory")
#define ATT_STEP(j, MSK, CONV, FAST) do { \
        if (MSK) ATT_MASK(S0, S1, (j)); \
        if (!(FAST)) { float pm_; ATT_ROWMAX(S0, S1, pm_); ATT_DECIDE(pm_, S0, S1, false); } \
        if (FAST) ATT_SOFTMAX_F(S0, S1); else ATT_SOFTMAX(S0, S1); \
        int infl_ = 0; \
        if (CONV) { __builtin_amdgcn_sched_barrier(0); const LAS float* cb_ = (const LAS float*)(lds + CONV_OFF + wid * CONV_BYTES); \
            if (CV.cur >= 0) { const ConvItem I_ = cv_setup(CV.cur, kargs()->in[I_WGU], kargs()->in[I_WD], cvws + WS_WGU, cvws + WS_WD); cv_out(I_, cb_, lane); infl_ += 4; } \
            if (CV.next < CV.end) { const ConvItem I_ = cv_setup(CV.next, kargs()->in[I_WGU], kargs()->in[I_WD], cvws + WS_WGU, cvws + WS_WD); asm volatile("s_waitcnt lgkmcnt(0)" ::: "memory"); \
                cv_dma(I_, lds0 + (unsigned)(CONV_OFF + wid * CONV_BYTES), lane); CV.cur = CV.next; CV.next += 2048; infl_ += 8; } else CV.cur = -1; } \
        __builtin_amdgcn_sched_barrier(0); ATT_BARP; __builtin_amdgcn_sched_barrier(0); \
        ATT_SEGA((j), ((j) + ATT_PF < NT)); if ((j) + ATT_PF < NT) infl_ += 3; \
        __builtin_amdgcn_sched_barrier(0); \
        if (!(CONV)) { if (infl_ == 3) ATT_WB(3); else ATT_WB(0); } \
        else switch (infl_) { case 15: ATT_WB(15); break; case 12: ATT_WB(12); break; case 11: ATT_WB(11); break; case 8: ATT_WB(8); break; case 7: ATT_WB(7); break; case 4: ATT_WB(4); break; case 3: ATT_WB(3); break; default: ATT_WB(0); break; } \
        __builtin_amdgcn_sched_barrier(0); } while (0)
    bf16x8 pa[4];
    f32x16 S0, S1;
    const bool grpY = wid >= 4;
    ATT_WAITBAR(6);
    if (grpY) ATT_BARP;
    __builtin_amdgcn_sched_barrier(0);
    ATT_QK(S0, S1, 0);
    __builtin_amdgcn_sched_barrier(0);
    ATT_WAITBAR(3);
    __builtin_amdgcn_sched_barrier(0);
    int j = 0;
    if (fast) {
        for (; j < NT - 4; j += 2) {
            ATT_STEP(j, false, CONV_IN_ATTN, true);
            ATT_STEP(j + 1, false, false, true);
        }
        for (; j < NT; j += 2) {
            ATT_STEP(j, true, CONV_IN_ATTN, true);
            ATT_STEP(j + 1, true, false, true);
        }
    } else {
        for (; j < NT - 4; j += 2) {
            ATT_STEP(j, false, CONV_IN_ATTN, false);
            ATT_STEP(j + 1, false, false, false);
        }
        for (; j < NT; j += 2) {
            ATT_STEP(j, true, CONV_IN_ATTN, false);
            ATT_STEP(j + 1, true, false, false);
        }
    }
    if (!grpY) ATT_BARP;
    __builtin_amdgcn_sched_barrier(0);
#ifdef ATT_PROBE2
    if (blockIdx.x == 17 && tid == 0) { unsigned long long* ap2 = (unsigned long long*)(cvws + WS_CTL + 65536 + 128); ap2[0] += ap_acc[0]; ap2[1] += ap_acc[1]; ap2[2] += ap_acc[2]; ap2[3] += (unsigned long long)NT; }
#endif
#ifdef ATT_PROBE
    if (blockIdx.x == 17 && tid == 0) { unsigned long long* ap = (unsigned long long*)(cvws + WS_CTL + 65536 + 64); ap[0] += __builtin_amdgcn_s_memtime() - ap_t0; ap[1] += (unsigned long long)NT; }
#endif
#undef ATT_DMA
#undef ATT_DMA1
#undef ATT_WAITBAR
#undef ATT_QK
#undef ATT_MASK
#undef ATT_ROWMAX
#undef ATT_DECIDE
#undef ATT_SOFTMAX
#undef ATT_SOFTMAX_F
#undef ATT_SM_HALF
#undef ATT_PV
#undef ATT_STEP
#undef ATT_WB
#undef ATT_BARP
#undef ATT_SEGA
#undef ATT_RDK
#undef ATT_RDV
#undef ATT_MK
#undef ATT_MV
#undef ATT_SB
#undef AP_STAMP
    { auto rr = __builtin_amdgcn_permlane32_swap(__float_as_uint(l_run), __float_as_uint(l_run), false, false); l_run = __uint_as_float(rr[0]) + __uint_as_float(rr[1]); }
    if (hi == 0) scr[32 + r32] = 1.0f / l_run;
    asm volatile("s_waitcnt lgkmcnt(0)" ::: "memory");
    bf16_t* Ow = O + ((size_t)(b * SEQ + qw)) * 512 + h * 64 + r32;
#pragma unroll
    for (int a4 = 0; a4 < 4; ++a4) { const f32x4 f = *(const LAS f32x4*)(scr + 32 + 8 * a4 + 4 * hi);
#pragma unroll
        for (int e = 0; e < 4; ++e) { const int r = 4 * a4 + e; const int row = crow(r, hi);
            Ow[(size_t)row * 512] = (bf16_t)(cvt_pk_bf16(o0[r] * f[e], 0.f) & 0xffffu);
            Ow[(size_t)row * 512 + 32] = (bf16_t)(cvt_pk_bf16(o1[r] * f[e], 0.f) & 0xffffu); } }
    __syncthreads();
}
#undef MFMA32
}

struct MixOrder {
    int G, c; unsigned ATT, MIXED, WAO, WPO;
    __device__ __forceinline__ bool next(int i, Unit& u) const {
        const int tile = (i >> 1) * G + c; if (tile >= 256) return false;
        u.pm = tile >> 2; u.pn = tile & 3; u.aux = i & 1; return true;
    }
    __device__ __forceinline__ void prefetch(const Unit&, const __amdgpu_buffer_rsrc_t, LAS unsigned char*, int, int) const {}
    __device__ __forceinline__ unsigned a_off(const Unit& u) const { return (u.aux ? MIXED : ATT) + (unsigned)u.pm * (256 * 512 * 2); }
    __device__ __forceinline__ unsigned b_off(const Unit& u) const { return (u.aux ? WPO : WAO) + (unsigned)u.pn * (256 * 512 * 2); }
};
struct EpiMix {
    static constexpr bool PERM = true;
    __device__ __forceinline__ void init(f32x4 (&acc)[2][2][4][2], const Unit& u, int, int) const {
        if (u.aux) return;
#pragma unroll
        for (int a = 0; a < 2; ++a)
#pragma unroll
            for (int b = 0; b < 2; ++b)
#pragma unroll
                for (int m = 0; m < 4; ++m)
#pragma unroll
                    for (int n = 0; n < 2; ++n) acc[a][b][m][n] = (f32x4){0.f, 0.f, 0.f, 0.f};
    }
    bf16_t* MIX; const bf16_t* GATES;
    __device__ __forceinline__ void operator()(f32x4 (&acc)[2][2][4][2], const Unit& u, int wr, int wc, int fr, int fq) const {
        const int row0 = u.pm * 256 + wr * 64 + fr, col0 = u.pn * 256 + wc * 32 + 8 * fq;
#pragma unroll
        for (int ai = 0; ai < 2; ++ai)
#pragma unroll
            for (int m = 0; m < 4; ++m) { const size_t row = (size_t)(row0 + ai * 128 + m * 16);
#pragma unroll
                for (int bj = 0; bj < 2; ++bj) {
                    const u32x4 gp = *(const u32x4*)(GATES + row * 2048 + 1024 + col0 + bj * 128);
                    const f32x4 p0 = {bf_lo(gp.x), bf_hi(gp.x), bf_lo(gp.y), bf_hi(gp.y)}, p1 = {bf_lo(gp.z), bf_hi(gp.z), bf_lo(gp.w), bf_hi(gp.w)};
                    if (u.aux == 0) {
                        const u32x4 ga = *(const u32x4*)(GATES + row * 2048 + col0 + bj * 128);
                        const f32x4 a0 = {bf_lo(ga.x), bf_hi(ga.x), bf_lo(ga.y), bf_hi(ga.y)}, a1 = {bf_lo(ga.z), bf_hi(ga.z), bf_lo(ga.w), bf_hi(ga.w)};
#pragma unroll
                        for (int e = 0; e < 4; ++e) { acc[ai][bj][m][0][e] *= a0[e] * __builtin_amdgcn_rcpf(p0[e]); acc[ai][bj][m][1][e] *= a1[e] * __builtin_amdgcn_rcpf(p1[e]); }
                    } else {
                        const f32x4 v0 = acc[ai][bj][m][0] * p0, v1 = acc[ai][bj][m][1] * p1;
                        u32x4 w; w.x = cvt_pk_bf16(v0[0], v0[1]); w.y = cvt_pk_bf16(v0[2], v0[3]); w.z = cvt_pk_bf16(v1[0], v1[1]); w.w = cvt_pk_bf16(v1[2], v1[3]);
                        *(u32x4*)(MIX + row * 1024 + col0 + bj * 128) = w; } } }
    }
};
struct EpiRes {
    static constexpr bool PERM = false;
    __device__ __forceinline__ void init(f32x4 (&acc)[2][2][4][2], const Unit&, int, int) const {
#pragma unroll
        for (int a = 0; a < 2; ++a)
#pragma unroll
            for (int b = 0; b < 2; ++b)
#pragma unroll
                for (int m = 0; m < 4; ++m)
#pragma unroll
                    for (int n = 0; n < 2; ++n) acc[a][b][m][n] = (f32x4){0.f, 0.f, 0.f, 0.f};
    }
    const float* base; bf16_t* out;
    __device__ __forceinline__ void operator()(const f32x4 (&acc)[2][2][4][2], const Unit& u, int wr, int wc, int fr, int fq) const {
        const int row0 = u.pm * 256 + wr * 64 + fr, col0 = u.pn * 256 + wc * 32 + 4 * fq;
        const size_t off0 = (size_t)row0 * DM + col0;
        f32x4 buf[3][4];
#define ER_LD(g) do { const float* p_ = base + off0 + (size_t)(((g) >> 2) * 128 + ((g) & 3) * 16) * DM; \
        _Pragma("unroll") for (int q = 0; q < 4; ++q) buf[(g) % 3][q] = *(const f32x4*)(p_ + (q >> 1) * 128 + (q & 1) * 16); } while (0)
        ER_LD(0); ER_LD(1); ER_LD(2);
#pragma unroll
        for (int g = 0; g < 8; ++g) { const int ai = g >> 2, m = g & 3;
            __builtin_amdgcn_sched_barrier(0);
            bf16_t* o_ = out + off0 + (size_t)(ai * 128 + m * 16) * DM;
#pragma unroll
            for (int q = 0; q < 4; ++q) { const f32x4 r = buf[g % 3][q] + acc[ai][q >> 1][m][q & 1]; u32x2 w; w.x = cvt_pk_bf16(r[0], r[1]); w.y = cvt_pk_bf16(r[2], r[3]); *(u32x2*)(o_ + (q >> 1) * 128 + (q & 1) * 16) = w; }
            __builtin_amdgcn_sched_barrier(0);
            if (g + 3 < 8) ER_LD(g + 3);
        }
#undef ER_LD
    }
};

constexpr int WR_PITCH = 1028;
constexpr int R_WR_OFF = 0, R_PART_OFF = 32 * WR_PITCH * 4, R_SSQ_OFF = R_PART_OFF + 2 * 64 * 33 * 4, R_CNT_OFF = R_SSQ_OFF + 2 * 64 * 4, R_BASE_OFF = R_CNT_OFF + 128, R_RSTD_OFF = R_BASE_OFF + 128, R_END = R_RSTD_OFF + 256;
static_assert(R_END <= TILE_E_OFF, "router LDS map");
__device__ __forceinline__ void p7_router(const Frame& F) {
    const int tid_l = tid_local(), lane_l = tid_l & 63; (void)tid_l; (void)lane_l;
    const KArgs a = kargs();
    LAS float* WR = (LAS float*)(F.lds + R_WR_OFF); LAS float* PART = (LAS float*)(F.lds + R_PART_OFF); LAS float* SSQP = (LAS float*)(F.lds + R_SSQ_OFF);
    LAS int* CNT = (LAS int*)(F.lds + R_CNT_OFF); LAS int* BASE = (LAS int*)(F.lds + R_BASE_OFF); LAS float* RSTD_L = (LAS float*)(F.lds + R_RSTD_OFF);
    const int tid = tid_l, lane = lane_l, wave = F.wave;
    const float* wr = a->in[I_WR]; const float* gf = a->in[I_GFFN];
    {
        const f32x4* wr4 = (const f32x4*)wr; f32x4 w[16]; float g[16];
#pragma unroll
        for (int q = 0; q < 16; ++q) { const int idx = tid + 512 * q; w[q] = wr4[idx]; g[q] = gf[idx >> 3]; }
#pragma unroll
        for (int q = 0; q < 16; ++q) { const int idx = tid + 512 * q; const int k = idx >> 3, e0 = (idx & 7) * 4;
#pragma unroll
            for (int j = 0; j < 4; ++j) WR[(e0 + j) * WR_PITCH + k] = w[q][j] * g[q]; }
    }
    if (tid < 32) CNT[tid] = 0;
    __syncthreads();
    int* RE = (int*)(F.ws + WS_ROUTE); int* RP = RE + T * 4; float* RG = (float*)(RP + T * 4); float* RS = RG + T * 4; int* TOK = (int*)(F.ws + WS_TOK); unsigned char* H8 = F.ws + WS_XS2;
    unsigned* gcnt = F.ctl + CW_CNT;
    const bf16_t* X1 = (const bf16_t*)(F.ws + WS_X1B);
    for (int blk = F.vcu; blk < T / 64; blk += F.G) {
        const int tb = blk * 64;
        {
            const int tg = wave & 3, kh = wave >> 2, r = lane & 15, kq = lane >> 4;
            const bf16_t* xp = X1 + (size_t)(tb + 16 * tg + r) * DM + 512 * kh + 4 * kq;
            const LAS float* w0 = WR + (lane & 15) * WR_PITCH + 512 * kh + 4 * kq; const LAS float* w1 = w0 + 16 * WR_PITCH;
            f32x4 acc0 = {0.f, 0.f, 0.f, 0.f}, acc1 = {0.f, 0.f, 0.f, 0.f}; float ss = 0.f;
#pragma unroll 4
            for (int i = 0; i < 32; ++i) {
                const u32x2 xw = *(const u32x2*)(xp + 16 * i); const f32x4 xv = {bf_lo(xw.x), bf_hi(xw.x), bf_lo(xw.y), bf_hi(xw.y)};
                const f32x4 b0 = *(const LAS f32x4*)(w0 + 16 * i), b1 = *(const LAS f32x4*)(w1 + 16 * i);
                ss += (xv[0] * xv[0] + xv[1] * xv[1]) + (xv[2] * xv[2] + xv[3] * xv[3]);
#pragma unroll
                for (int j = 0; j < 4; ++j) { acc0 = __builtin_amdgcn_mfma_f32_16x16x4f32(xv[j], b0[j], acc0, 0, 0, 0); acc1 = __builtin_amdgcn_mfma_f32_16x16x4f32(xv[j], b1[j], acc1, 0, 0, 0); }
            }
            ss += __shfl_xor(ss, 16); ss += __shfl_xor(ss, 32);
            if (kq == 0) SSQP[kh * 64 + 16 * tg + r] = ss;
#pragma unroll
            for (int q = 0; q < 4; ++q) { const int tok = 16 * tg + 4 * kq + q; PART[(kh * 64 + tok) * 33 + (lane & 15)] = acc0[q]; PART[(kh * 64 + tok) * 33 + 16 + (lane & 15)] = acc1[q]; }
        }
        __syncthreads();
        int te[4] = {0, 0, 0, 0}, lp[4] = {0, 0, 0, 0}; float tv[4] = {-3e38f, -3e38f, -3e38f, -3e38f}; float rstd = 0.f;
        if (tid < 64) {
            const float ssq = SSQP[tid] + SSQP[64 + tid]; rstd = 1.0f / sqrtf(ssq * (1.f / DM) + EPS);
            const float* br = a->in[I_BR];
#pragma unroll
            for (int e = 0; e < 32; ++e) {
                float v = (PART[tid * 33 + e] + PART[(64 + tid) * 33 + e]) * rstd + br[e]; int id = e;
#pragma unroll
                for (int s = 0; s < 4; ++s) { const bool gt = v > tv[s]; const float ov = tv[s]; const int oi = te[s]; tv[s] = gt ? v : ov; te[s] = gt ? id : oi; v = gt ? ov : v; id = gt ? oi : id; }
            }
#pragma unroll
            for (int s = 0; s < 4; ++s) lp[s] = __hip_atomic_fetch_add(&CNT[te[s]], 1, __ATOMIC_RELAXED, __HIP_MEMORY_SCOPE_WORKGROUP);
        }
        __syncthreads();
        if (tid < 32) { const int c = CNT[tid]; BASE[tid] = c ? (int)atomicAdd(gcnt + tid, (unsigned)c) : 0; }
        __syncthreads();
        if (tid < 64) {
            const int t = tb + tid;
            const float e1 = __expf(tv[1] - tv[0]), e2 = __expf(tv[2] - tv[0]), e3 = __expf(tv[3] - tv[0]); const float inv = 1.0f / (1.0f + e1 + e2 + e3);
            const float gts[4] = {inv, e1 * inv, e2 * inv, e3 * inv};
#pragma unroll
            for (int s = 0; s < 4; ++s) { const int p = BASE[te[s]] + lp[s]; RE[t * 4 + s] = te[s]; RP[t * 4 + s] = p; RG[t * 4 + s] = gts[s]; TOK[te[s] * 16384 + p] = t; }
            RS[t] = rstd; RSTD_L[tid] = rstd;
        }
        __syncthreads();
        if (tid < 32) CNT[tid] = 0;
        {
            f32x4 g[2][2];
#pragma unroll
            for (int j = 0; j < 2; ++j) { g[j][0] = *(const f32x4*)(gf + 512 * j + 8 * lane); g[j][1] = *(const f32x4*)(gf + 512 * j + 8 * lane + 4); }
#pragma unroll 4
            for (int i = 0; i < 8; ++i) {
                const int t = tb + 8 * wave + i; const float rs = RSTD_L[8 * wave + i];
#pragma unroll
                for (int j = 0; j < 2; ++j) { const u32x4 xw = *(const u32x4*)(X1 + (size_t)t * DM + 512 * j + 8 * lane);
                    const f32x4 v0 = (f32x4){bf_lo(xw.x), bf_hi(xw.x), bf_lo(xw.y), bf_hi(xw.y)} * g[j][0] * rs, v1 = (f32x4){bf_lo(xw.z), bf_hi(xw.z), bf_lo(xw.w), bf_hi(xw.w)} * g[j][1] * rs;
                    *(u32x2*)(H8 + (size_t)t * DM + 512 * j + 8 * lane) = cvt8_fp8(v0, v1, 8.0f); }
            }
        }
        __syncthreads();
    }
}

__device__ __forceinline__ int build_tiles(const Frame& F) {
    const int tid_l = tid_local(), lane_l = tid_l & 63; (void)tid_l; (void)lane_l;
    LAS int* TB = (LAS int*)(F.lds + TILE_E_OFF); LAS int* TE = TB + 64;
    if (tid_l < 64) {
        const int c = (tid_l < NEXP) ? (int)__hip_atomic_load(F.ctl + CW_CNT + tid_l, RLX_AGENT) : 0; const int nt = (c + 255) >> 8;
        int incl = nt;
#pragma unroll
        for (int o = 1; o < 32; o <<= 1) { const int v = __shfl_up(incl, o); if (lane_l >= o) incl += v; }
        if (tid_l < NEXP) TB[tid_l] = incl - nt;
        if (tid_l == NEXP - 1) TB[NEXP] = incl;
    }
    __syncthreads();
    if (tid_l < NEXP) { for (int t = TB[tid_l]; t < TB[tid_l + 1]; ++t) TE[t] = tid_l; }
    __syncthreads();
    return TB[NEXP];
}

__device__ __forceinline__ void p8_dispatch(const Frame& F) {
    const int tid_l = tid_local(), lane_l = tid_l & 63; (void)tid_l; (void)lane_l;
    const KArgs a = kargs();
    (void)build_tiles(F);
    const LAS int* TB = (const LAS int*)(F.lds + TILE_E_OFF);
    const int gw = F.vcu * NWAVES + F.wave, NGW = F.G * NWAVES, lane = lane_l;
    const int* RE = (const int*)(F.ws + WS_ROUTE); const int* RP = RE + T * 4; const float* RS = (const float*)(RP + T * 4) + T * 4; int* SL = (int*)(RS + T);
    const bf16_t* X1 = (const bf16_t*)(F.ws + WS_X1B); const float* gf = a->in[I_GFFN]; unsigned char* XS = F.ws + WS_XS2;
    f32x4 g[2][2];
#pragma unroll
    for (int j = 0; j < 2; ++j) { g[j][0] = *(const f32x4*)(gf + 512 * j + 8 * lane); g[j][1] = *(const f32x4*)(gf + 512 * j + 8 * lane + 4); }
    for (int t = gw; t < T; t += NGW) {
        const float rstd = RS[t];
        u32x2 w[2];
#pragma unroll
        for (int j = 0; j < 2; ++j) { const u32x4 xw = *(const u32x4*)(X1 + (size_t)t * DM + 512 * j + 8 * lane);
            const f32x4 v0 = (f32x4){bf_lo(xw.x), bf_hi(xw.x), bf_lo(xw.y), bf_hi(xw.y)} * g[j][0] * rstd, v1 = (f32x4){bf_lo(xw.z), bf_hi(xw.z), bf_lo(xw.w), bf_hi(xw.w)} * g[j][1] * rstd;
            w[j] = cvt8_fp8(v0, v1, 8.0f); }
#pragma unroll
        for (int s = 0; s < 4; ++s) { const int e = RE[t * 4 + s], slot = TB[e] * 256 + RP[t * 4 + s];
            if (lane == 0) SL[t * 4 + s] = slot;
            unsigned char* dst = XS + (size_t)slot * DM + 8 * lane;
            *(u32x2*)dst = w[0]; *(u32x2*)(dst + 512) = w[1]; }
    }
}

template <bool GATHER_A> struct MoeOrderT {
    int G, c, ntn_shift, total; const LAS int* TE; unsigned A, Bw, bexp, btile; int xbase, xcount;
    __device__ __forceinline__ void init_xcd(const LAS int* TB) {
        if (G == 256) { const int x = c >> 5; xbase = __builtin_amdgcn_readfirstlane(TB[4 * x]); xcount = (__builtin_amdgcn_readfirstlane(TB[4 * x + 4]) - xbase) << ntn_shift; } else { xbase = -1; xcount = 0; }
    }
    __device__ __forceinline__ bool next(int i, Unit& u) const {
        if (xbase >= 0) { const int L = i * 32 + (c & 31); if (L >= xcount) return false;
            u.pm = xbase + (L >> ntn_shift); u.pn = L & ((1 << ntn_shift) - 1); u.aux = __builtin_amdgcn_readfirstlane(TE[u.pm]); return true; }
        const int L = i * G + c; if (L >= total) return false;
        u.pm = L >> ntn_shift; u.pn = L & ((1 << ntn_shift) - 1); u.aux = __builtin_amdgcn_readfirstlane(TE[u.pm]); return true;
    }
#ifndef MOE_PREFETCH
#define MOE_PREFETCH 0
#endif
    __device__ __forceinline__ void prefetch(const Unit& u, const __amdgpu_buffer_rsrc_t rsrc, LAS unsigned char* lds, int wid, int lane) const {
        if (!MOE_PREFETCH) return;
        const unsigned ln_ = (unsigned)(tid_local() & 63);
        const unsigned line = (unsigned)(u.pn & 3) * 512u + (unsigned)wid * 64u + ln_;
        const unsigned voff = (line >> 3) * 1024u + (line & 7u) * 128u;
        const unsigned dst = (unsigned)__builtin_amdgcn_readfirstlane((int)(unsigned)(unsigned long)(lds + 131072 + wid * 256));
        const unsigned soff = a_off(u);
        asm volatile("s_nop 4\n\ts_mov_b32 m0, %0\n\ts_nop 0\n\tbuffer_load_dword %1, %2, %3 offen lds" :: "s"(dst), "v"(voff), "s"(rsrc), "s"(soff) : "m0", "memory");
    }
    unsigned TOK;
    __device__ __forceinline__ unsigned tok_off(const Unit& u) const { return TOK + ((unsigned)u.aux * 16384u + (unsigned)(u.pm - __builtin_amdgcn_readfirstlane(TE[u.aux - 64])) * 256u) * 4u; }
    __device__ __forceinline__ unsigned a_off(const Unit& u) const { return GATHER_A ? A : A + (unsigned)u.pm * (256 * 1024); }
    __device__ __forceinline__ unsigned b_off(const Unit& u) const { return Bw + (unsigned)u.aux * bexp + (unsigned)u.pn * btile; }
};
using MoeOrder = MoeOrderT<false>; using MoeGather = MoeOrderT<true>;
struct EpiSwiglu {
    static constexpr bool PERM = true;
    unsigned char* ACT; const float* bgu;
    __device__ __forceinline__ void init(f32x4 (&acc)[2][2][4][2], const Unit& u, int wc, int fq) const {
        const float* bb = bgu + (size_t)u.aux * 2048 + u.pn * 128 + wc * 32 + 8 * fq;
        const f32x4 g0 = *(const f32x4*)(bb), g1 = *(const f32x4*)(bb + 4), u0 = *(const f32x4*)(bb + 1024), u1 = *(const f32x4*)(bb + 1028);
#pragma unroll
        for (int a = 0; a < 2; ++a)
#pragma unroll
            for (int m = 0; m < 4; ++m) { acc[a][0][m][0] = g0; acc[a][0][m][1] = g1; acc[a][1][m][0] = u0; acc[a][1][m][1] = u1; }
    }
    __device__ __forceinline__ void operator()(const f32x4 (&acc)[2][2][4][2], const Unit& u, int wr, int wc, int fr, int fq) const {
        const int row0 = u.pm * 256 + wr * 64 + fr, j0 = u.pn * 128 + wc * 32 + 8 * fq;
        unsigned char* dst0 = ACT + (size_t)row0 * DEXP + j0;
#pragma unroll
        for (int ai = 0; ai < 2; ++ai)
#pragma unroll
            for (int m = 0; m < 4; ++m) {
                int w2[2];
#pragma unroll
                for (int n = 0; n < 2; ++n) {
                    const f32x4 g = acc[ai][0][m][n], up = acc[ai][1][m][n];
                    f32x2 r[2];
#pragma unroll
                    for (int h = 0; h < 2; ++h) {
                        const f32x2 gg = {__builtin_amdgcn_fmed3f(g[2 * h], -3.0e38f, 7.0f), __builtin_amdgcn_fmed3f(g[2 * h + 1], -3.0e38f, 7.0f)};
                        const f32x2 uu = {__builtin_amdgcn_fmed3f(up[2 * h], -7.0f, 7.0f), __builtin_amdgcn_fmed3f(up[2 * h + 1], -7.0f, 7.0f)};
                        const f32x2 x = gg * (f32x2){-1.702f * 1.4426950408889634f, -1.702f * 1.4426950408889634f};
                        const f32x2 den = (f32x2){__builtin_amdgcn_exp2f(x[0]), __builtin_amdgcn_exp2f(x[1])} + (f32x2){1.0f, 1.0f};
                        const f32x2 rc = {__builtin_amdgcn_rcpf(den[0]), __builtin_amdgcn_rcpf(den[1])};
                        r[h] = (uu * (f32x2){8.0f, 8.0f} + (f32x2){8.0f, 8.0f}) * gg * rc; }
                    int w = __builtin_amdgcn_cvt_pk_fp8_f32(r[0][0], r[0][1], 0, false); w2[n] = __builtin_amdgcn_cvt_pk_fp8_f32(r[1][0], r[1][1], w, true);
                }
                u32x2 o; o.x = (unsigned)w2[0]; o.y = (unsigned)w2[1];
                *(u32x2*)(dst0 + (size_t)(ai * 128 + m * 16) * DEXP) = o;
            }
    }
};
struct EpiDown {
    static constexpr bool PERM = true;
    unsigned char* Y; const float* bd;
    __device__ __forceinline__ void init(f32x4 (&acc)[2][2][4][2], const Unit& u, int wc, int fq) const {
        const float* bb = bd + (size_t)u.aux * DM + u.pn * 256 + wc * 32 + 8 * fq;
        const f32x4 b00 = *(const f32x4*)(bb), b01 = *(const f32x4*)(bb + 4), b10 = *(const f32x4*)(bb + 128), b11 = *(const f32x4*)(bb + 132);
#pragma unroll
        for (int a = 0; a < 2; ++a)
#pragma unroll
            for (int m = 0; m < 4; ++m) { acc[a][0][m][0] = b00; acc[a][0][m][1] = b01; acc[a][1][m][0] = b10; acc[a][1][m][1] = b11; }
    }
    __device__ __forceinline__ void operator()(const f32x4 (&acc)[2][2][4][2], const Unit& u, int wr, int wc, int fr, int fq) const {
        const int row0 = u.pm * 256 + wr * 64 + fr, col0 = u.pn * 256 + wc * 32 + 8 * fq;
#pragma unroll
        for (int ai = 0; ai < 2; ++ai)
#pragma unroll
            for (int m = 0; m < 4; ++m) { unsigned char* rowp = Y + (size_t)(row0 + ai * 128 + m * 16) * DM + col0;
#pragma unroll
                for (int bj = 0; bj < 2; ++bj) *(u32x2*)(rowp + bj * 128) = cvt8_fp8(acc[ai][bj][m][0], acc[ai][bj][m][1], 8.0f); }
    }
};

__device__ __forceinline__ void p11_combine(const Frame& F) {
    const int tid_l = tid_local(), lane_l = tid_l & 63; (void)tid_l; (void)lane_l;
    const KArgs a = kargs();
    const int gw = F.vcu * NWAVES + F.wave, NGW = F.G * NWAVES, lane = lane_l;
    (void)build_tiles(F); const LAS int* TB = (const LAS int*)(F.lds + TILE_E_OFF);
    const int* RE = (const int*)(F.ws + WS_ROUTE); const int* RP = RE + T * 4; const float* RG = (const float*)(RE + T * 8);
    const unsigned char* Y = F.ws + WS_XS; bf16_t* HP = (bf16_t*)(F.ws + WS_HN); const bf16_t* X1 = (const bf16_t*)(F.ws + WS_X1B); bf16_t* X2 = (bf16_t*)(F.ws + WS_X2B); const float* gp = a->in[I_GPLE];
    f32x4 g[2][2];
#pragma unroll
    for (int j = 0; j < 2; ++j) { g[j][0] = *(const f32x4*)(gp + 512 * j + 8 * lane); g[j][1] = *(const f32x4*)(gp + 512 * j + 8 * lane + 4); }
    for (int t = gw; t < T; t += NGW) {
        f32x4 v[2][2];
#pragma unroll
        for (int j = 0; j < 2; ++j) { const u32x4 xw = *(const u32x4*)(X1 + (size_t)t * DM + 512 * j + 8 * lane); v[j][0] = (f32x4){bf_lo(xw.x), bf_hi(xw.x), bf_lo(xw.y), bf_hi(xw.y)}; v[j][1] = (f32x4){bf_lo(xw.z), bf_hi(xw.z), bf_lo(xw.w), bf_hi(xw.w)}; }
#pragma unroll
        for (int s = 0; s < 4; ++s) { const int slot = TB[RE[t * 4 + s]] * 256 + RP[t * 4 + s]; const float gt = RG[t * 4 + s] * 0.125f;
#pragma unroll
            for (int j = 0; j < 2; ++j) { const u32x2 y = *(const u32x2*)(Y + (size_t)slot * DM + 512 * j + 8 * lane);
                const f32x2 a0 = __builtin_amdgcn_cvt_pk_f32_fp8((int)y.x, false), a1 = __builtin_amdgcn_cvt_pk_f32_fp8((int)y.x, true), b0 = __builtin_amdgcn_cvt_pk_f32_fp8((int)y.y, false), b1 = __builtin_amdgcn_cvt_pk_f32_fp8((int)y.y, true);
                v[j][0] += (f32x4){a0[0], a0[1], a1[0], a1[1]} * gt; v[j][1] += (f32x4){b0[0], b0[1], b1[0], b1[1]} * gt; } }
        float ss = 0.f;
#pragma unroll
        for (int j = 0; j < 2; ++j)
#pragma unroll
            for (int n = 0; n < 2; ++n) { const f32x4 q = v[j][n]; ss += (q[0] * q[0] + q[1] * q[1]) + (q[2] * q[2] + q[3] * q[3]); u32x2 w; w.x = cvt_pk_bf16(q[0], q[1]); w.y = cvt_pk_bf16(q[2], q[3]); *(u32x2*)(X2 + (size_t)t * DM + 512 * j + 8 * lane + 4 * n) = w; }
        const float rstd = 1.0f / sqrtf(wave_sum(ss) * (1.f / DM) + EPS);
#pragma unroll
        for (int j = 0; j < 2; ++j) { const f32x4 q0 = v[j][0] * g[j][0] * rstd, q1 = v[j][1] * g[j][1] * rstd;
            if (PLE_FP8) { *(u32x2*)((unsigned char*)HP + (size_t)t * DM + 512 * j + 8 * lane) = cvt8_fp8(q0, q1, 8.0f); }
            else { u32x4 w; w.x = cvt_pk_bf16(q0[0], q0[1]); w.y = cvt_pk_bf16(q0[2], q0[3]); w.z = cvt_pk_bf16(q1[0], q1[1]); w.w = cvt_pk_bf16(q1[2], q1[3]);
                *(u32x4*)(HP + (size_t)t * DM + 512 * j + 8 * lane) = w; } }
    }
}
struct EpiPle {
    static constexpr bool PERM = false;
    __device__ __forceinline__ void init(f32x4 (&acc)[2][2][4][2], const Unit&, int, int) const {
#pragma unroll
        for (int a = 0; a < 2; ++a)
#pragma unroll
            for (int b = 0; b < 2; ++b)
#pragma unroll
                for (int m = 0; m < 4; ++m)
#pragma unroll
                    for (int n = 0; n < 2; ++n) acc[a][b][m][n] = (f32x4){0.f, 0.f, 0.f, 0.f};
    }
    float* out; const bf16_t* E; const bf16_t* X2;
    __device__ __forceinline__ void operator()(const f32x4 (&acc)[2][2][4][2], const Unit& u, int wr, int wc, int fr, int fq) const {
        const int row0 = u.pm * 256 + wr * 64 + fr, col0 = u.pn * 256 + wc * 32 + 4 * fq;
#pragma unroll
        for (int ai = 0; ai < 2; ++ai)
#pragma unroll
            for (int m = 0; m < 4; ++m) { const size_t off = (size_t)(row0 + ai * 128 + m * 16) * DM + col0;
#pragma unroll
                for (int bj = 0; bj < 2; ++bj)
#pragma unroll
                    for (int n = 0; n < 2; ++n) { const size_t o = off + bj * 128 + n * 16; const u32x2 ev = *(const u32x2*)(E + o); const f32x4 a4 = acc[ai][bj][m][n];
                        const u32x2 xw = *(const u32x2*)(X2 + o); f32x4 r = {bf_lo(xw.x), bf_hi(xw.x), bf_lo(xw.y), bf_hi(xw.y)};
                        r[0] += fast_sigmoid(a4[0]) * bf_lo(ev.x); r[1] += fast_sigmoid(a4[1]) * bf_hi(ev.x); r[2] += fast_sigmoid(a4[2]) * bf_lo(ev.y); r[3] += fast_sigmoid(a4[3]) * bf_hi(ev.y);
                        *(f32x4*)(out + o) = r; } }
    }
};

constexpr int N_PHASES = 13;
__global__ void __launch_bounds__(NWAVES * 64, 2) fwd_kernel(Args args) {
    extern __shared__ __attribute__((aligned(16))) unsigned char lds_raw[];
    Frame F;
    F.lds = (LAS unsigned char*)lds_raw; F.MISC = (volatile LAS unsigned*)(F.lds + MISC_OFF);
    F.wave = __builtin_amdgcn_readfirstlane(threadIdx.x >> 6);
    F.G = gridDim.x; { const int bx = blockIdx.x; F.vcu = (F.G % 8 == 0) ? (bx % 8) * (F.G / 8) + bx / 8 : bx; }
    { const KArgs ka = kargs(); F.out = ka->out; F.ws = ka->ws; F.ctl = (unsigned*)(ka->ws + WS_CTL); }
    { const int t0_ = tid_local(); if (t0_ < 32) F.MISC[t0_] = 0u; }
    __syncthreads();
    int lo, hi; { const KArgs ka = kargs(); lo = ka->ph_lo; hi = ka->ph_hi; }
    const bool multi = (hi - lo) > 1;
    XcdBarrier bar; bar.bar = F.ctl + CW_BAR; bar.x = 0; bar.st = nullptr;
    if (multi) bar = xcd_barrier_post(F.ctl + CW_BAR, F.MISC);
#ifndef PH_MASK
#define PH_MASK 0x1fff
#endif
#define IN(k) ((((PH_MASK) >> (k)) & 1) && lo <= (k) && (k) < hi)
#define SEAM(k) do { if (IN(k) && IN((k) + 1)) xcd_barrier(bar); } while (0)
    unsigned char* ws = F.ws;
    LAS unsigned char* ring = F.lds;
    const __amdgpu_buffer_rsrc_t rsrc = __builtin_amdgcn_make_buffer_rsrc((void*)ws, 0, (int)WS_END, 0x00020000);

    if (IN(0)) { p0_prologue(F); } SEAM(0);

    if (IN(1)) {
        if (GATES_FP8 && !P1_FP8) {
          { DenseOrder S; S.init(64, 8, F.G, (int)blockIdx.x, WS_HN8, 512, WS_WIN8 + (size_t)1024 * 1024, 512);
            EpiProj E{(bf16_t*)(ws + WS_PROJ), (bf16_t*)(ws + WS_GATES), 4};
            pg8::gemm_phase<EpiProj, DenseOrder, true, true, true>(ring, rsrc, pg8::Shape{1024, 1024, 1024, 0x7c7c7c7c, 0x7c7c7c7c}, S, E); }
          { DenseOrder S; S.init(64, 4, F.G, (int)blockIdx.x, WS_HN, 1024, WS_WIN, 1024);
            EpiProj E{(bf16_t*)(ws + WS_PROJ), (bf16_t*)(ws + WS_GATES), 0};
            pg8::gemm_phase<EpiProj, DenseOrder, true, true>(ring, rsrc, pg8::Shape{2048, 2048, 2048, 0, 0}, S, E); }
        } else
        { DenseOrder S; S.init(64, 12, F.G, (int)blockIdx.x, WS_HN, P1_FP8 ? 512 : 1024, WS_WIN, P1_FP8 ? 512 : 1024);
          EpiProj E{(bf16_t*)(ws + WS_PROJ), (bf16_t*)(ws + WS_GATES), 0};
          if (P1_FP8) pg8::gemm_phase<EpiProj, DenseOrder, true, true, true>(ring, rsrc, pg8::Shape{1024, 1024, 1024, 0x7c7c7c7c, 0x7c7c7c7c}, S, E);
          else pg8::gemm_phase<EpiProj, DenseOrder, true, true>(ring, rsrc, pg8::Shape{2048, 2048, 2048, 0, 0}, S, E, GP_AT(1)); }
        { DenseOrder S; S.init(64, 4, F.G, (int)blockIdx.x, WS_PB, 256, WS_WPLE, 256);
          EpiBf16 E{(bf16_t*)(ws + WS_E), 1024};
          pg8::gemm_phase<EpiBf16, DenseOrder, true, true>(ring, rsrc, pg8::Shape{512, 512, 512, 0, 0}, S, E); }
    } SEAM(1);

    if (IN(2)) { p2_rows(F); } SEAM(2);

    if (IN(3)) {
#ifndef P3M
#define P3M 7
#endif
        if (P3M & 1) { DenseOrder S; S.init(64, 4, F.G, (int)blockIdx.x, WS_A2 + 512, 512, WS_WKV, 256);
          EpiKV E{(bf16_t*)(ws + WS_K), (bf16_t*)(ws + WS_V), kargs()->in[I_GKNOPE]};
          pg8::gemm_phase<EpiKV, DenseOrder, true, true>(ring, rsrc, pg8::Shape{512, 1024, 512, 0, 0}, S, E); }
        if (P3M & 2) { DenseOrder S; S.init(64, 3, F.G, (int)blockIdx.x, WS_A2, 512, WS_WQ, 256);
          EpiQ E{(bf16_t*)(ws + WS_Q), (float*)(ws + WS_SSQ), (const float*)(ws + WS_COS), (const float*)(ws + WS_SIN), kargs()->in[I_GQHEAD]};
          pg8::gemm_phase<EpiQ, DenseOrder, true, true>(ring, rsrc, pg8::Shape{512, 1024, 512, 0, 0}, S, E); }
        if (P3M & 4) { DenseOrder S; S.init(64, 2, F.G, (int)blockIdx.x, WS_POOLED, 512, WS_WPOOL, 256, 512);
          EpiBf16 E{(bf16_t*)(ws + WS_MIXED), 512};
          pg8::gemm_phase<EpiBf16, DenseOrder, true, true>(ring, rsrc, pg8::Shape{512, 1024, 512, 0, 0}, S, E); }
    } SEAM(3);

    if (IN(4)) {
        u32x4 srd; { const unsigned long wb = (unsigned long)ws; srd.x = (unsigned)__builtin_amdgcn_readfirstlane((int)(unsigned)wb); srd.y = (unsigned)__builtin_amdgcn_readfirstlane((int)(unsigned)(wb >> 32)); srd.z = (unsigned)WS_END; srd.w = 0x00020000u; }
        att::ConvState CV; CV.next = __builtin_amdgcn_readfirstlane(F.vcu * NWAVES + F.wave); CV.end = CONV_IN_ATTN ? att::CV_ITEMS : 0; CV.cur = -1;
        bool fast;
        { const int lane = tid_local() & 63; const float* gqh = kargs()->in[I_GQHEAD]; const float* gkn = kargs()->in[I_GKNOPE]; const float* gkr = kargs()->in[I_GKROPE];
          float a = fabsf(gqh[lane]); if (lane < 32) a = fmaxf(a, fabsf(gqh[64 + lane])); float bn = fabsf(gkn[lane]); float br = (lane < 32) ? fabsf(gkr[lane]) : 0.f;
#pragma unroll
          for (int o = 1; o < 64; o <<= 1) { a = fmaxf(a, __shfl_xor(a, o)); bn = fmaxf(bn, __shfl_xor(bn, o)); br = fmaxf(br, __shfl_xor(br, o)); }
          const float Mb = 1.4426950408889634f * 1.01f * a * sqrtf(64.f * bn * bn + 32.f * br * br);
          fast = __builtin_amdgcn_readfirstlane(Mb <= 60.0f ? 1 : 0) != 0; }
        for (int it = F.vcu; it < 256; it += F.G) {
            const int bh = it >> 3, pr = it & 7;
            att::attn_unit(ring, srd, CV, ws, bh, 15 - pr, (const bf16_t*)(ws + WS_Q), (unsigned)WS_K, (unsigned)WS_V, (const float*)(ws + WS_SSQ), (bf16_t*)(ws + WS_ATT), fast);
            att::attn_unit(ring, srd, CV, ws, bh, pr, (const bf16_t*)(ws + WS_Q), (unsigned)WS_K, (unsigned)WS_V, (const float*)(ws + WS_SSQ), (bf16_t*)(ws + WS_ATT), fast);
        }
        { const LAS float* cb = (const LAS float*)(F.lds + att::CONV_OFF + F.wave * att::CONV_BYTES);
          const unsigned cbaddr = (unsigned)__builtin_amdgcn_readfirstlane((int)(unsigned)(unsigned long)(F.lds + att::CONV_OFF + F.wave * att::CONV_BYTES));
          const int lane_l = tid_local() & 63;
          while (CV.cur >= 0 || CV.next < CV.end) {
            if (CV.cur >= 0) { asm volatile("s_waitcnt vmcnt(0)" ::: "memory"); const att::ConvItem I = att::cv_setup(CV.cur, kargs()->in[I_WGU], kargs()->in[I_WD], ws + WS_WGU, ws + WS_WD); att::cv_out(I, cb, lane_l); }
            if (CV.next < CV.end) { const att::ConvItem I = att::cv_setup(CV.next, kargs()->in[I_WGU], kargs()->in[I_WD], ws + WS_WGU, ws + WS_WD); asm volatile("s_waitcnt lgkmcnt(0)" ::: "memory"); att::cv_dma(I, cbaddr, lane_l); CV.cur = CV.next; CV.next += 2048; } else CV.cur = -1;
          } }
    } SEAM(4);

    if (IN(5)) {
        MixOrder S{F.G, F.vcu, (unsigned)WS_ATT, (unsigned)WS_MIXED, (unsigned)WS_WAO, (unsigned)WS_WPO};
        EpiMix E{(bf16_t*)(ws + WS_MIX), (const bf16_t*)(ws + WS_GATES)};
        pg8::gemm_phase<EpiMix, MixOrder, true, true>(ring, rsrc, pg8::Shape{1024, 1024, 1024, 0, 0}, S, E, GP_AT(5));
    } SEAM(5);

    if (IN(6)) {
        DenseOrder S; S.init(64, 4, F.G, (int)blockIdx.x, WS_MIX, 1024, WS_WO, 1024);
        EpiRes E{kargs()->in[I_X], (bf16_t*)(ws + WS_X1B)};
        pg8::gemm_phase<EpiRes, DenseOrder, true, true>(ring, rsrc, pg8::Shape{2048, 2048, 2048, 0, 0}, S, E, GP_AT(6));
    } SEAM(6);

    if (IN(7)) { p7_router(F); } SEAM(7);


    if (IN(9)) {
        const int TM = build_tiles(F);
        MoeGather S{F.G, F.vcu, 3, TM * 8, (const LAS int*)(F.lds + TILE_E_OFF) + 64, (unsigned)WS_XS2, (unsigned)WS_WGU, 2048u * 1024u, 256u * 1024u, 0, 0, (unsigned)WS_TOK}; S.init_xcd((const LAS int*)(F.lds + TILE_E_OFF));
        EpiSwiglu E{ws + WS_ACT, kargs()->in[I_BGU]};
        pg8::gemm_phase<EpiSwiglu, MoeGather, true, true, true, true>(ring, rsrc, pg8::Shape{1024, 1024, 1024, 0x7c7c7c7c, 0x7c7c7c7c}, S, E, GP_AT(9));
    } SEAM(9);

    if (IN(10)) {
        const int TM = build_tiles(F);
        MoeOrder S{F.G, F.vcu, 2, TM * 4, (const LAS int*)(F.lds + TILE_E_OFF) + 64, (unsigned)WS_ACT, (unsigned)WS_WD, 1024u * 1024u, 256u * 1024u, 0, 0}; S.init_xcd((const LAS int*)(F.lds + TILE_E_OFF));
        EpiDown E{ws + WS_XS, kargs()->in[I_BD]};
        pg8::gemm_phase<EpiDown, MoeOrder, true, true, true>(ring, rsrc, pg8::Shape{1024, 1024, 1024, 0x7c7c7c7c, 0x7c7c7c7c}, S, E, GP_AT(10));
    } SEAM(10);

    if (IN(11)) { p11_combine(F); } SEAM(11);

    if (IN(12)) {
        DenseOrder S; S.init(64, 4, F.G, (int)blockIdx.x, WS_HN, PLE_FP8 ? 512 : 1024, WS_WPG, PLE_FP8 ? 512 : 1024);
        EpiPle E{F.out, (const bf16_t*)(ws + WS_E), (const bf16_t*)(ws + WS_X2B)};
        if (PLE_FP8) pg8::gemm_phase<EpiPle, DenseOrder, true, true, true>(ring, rsrc, pg8::Shape{1024, 1024, 1024, 0x7c7c7c7c, 0x7c7c7c7c}, S, E, GP_AT(12));
        else pg8::gemm_phase<EpiPle, DenseOrder, true, true>(ring, rsrc, pg8::Shape{2048, 2048, 2048, 0, 0}, S, E, GP_AT(12));
    }
#ifdef ATT_PROBE
    if (blockIdx.x == 17 && tid_local() == 0) { const unsigned long long* ap = (const unsigned long long*)(ws + WS_CTL + 65536 + 64); const unsigned long long wait = (ap[0] / ap[1]) * 10; const unsigned long long r0 = __builtin_amdgcn_s_memrealtime(); while (__builtin_amdgcn_s_memrealtime() - r0 < wait) __builtin_amdgcn_s_sleep(8); }
#endif
#ifdef ATT_PROBE2
    if (blockIdx.x == 17 && tid_local() == 0) { const unsigned long long* ap = (const unsigned long long*)(ws + WS_CTL + 65536 + 128); const unsigned long long wait = (ap[ATT_PROBE2 - 1] / ap[3]) * 10; const unsigned long long r0 = __builtin_amdgcn_s_memrealtime(); while (__builtin_amdgcn_s_memrealtime() - r0 < wait) __builtin_amdgcn_s_sleep(8); }
#endif
#ifdef BAR_PROBE
    for (int i_ = 0; i_ < 20; ++i_) xcd_barrier(bar);
#endif
#ifdef GP_PROBE
    if (blockIdx.x == GP_BLOCK && tid_local() == 0) {
        unsigned long long* gp = (unsigned long long*)(ws + WS_CTL + 65536);
        const unsigned long long cyc = gp[0], tiles = gp[1], pc = gp[2], pr = gp[3], units = gp[4];
        unsigned long long wait = 0;
        if (GP_METRIC == 0) wait = (cyc / tiles) * 10;
        if (GP_METRIC == 1) wait = (pc * 100 / pr) * 10;
        if (GP_METRIC == 2) wait = ((pc - cyc) / units);
        const unsigned long long r0 = __builtin_amdgcn_s_memrealtime();
        while (__builtin_amdgcn_s_memrealtime() - r0 < wait) __builtin_amdgcn_s_sleep(8);
    }
#endif
#undef IN
#undef SEAM
}

extern "C" void kernel_launch(void* const* d_in, const int* in_sizes, int n_in, void* d_out, int out_size, void* d_ws, size_t ws_size, hipStream_t stream) {
    static int grid = 0;
    if (grid == 0) {
        if (n_in != 27 || out_size != T * DM || ws_size < WS_END) { fprintf(stderr, "kernel_launch: unexpected shapes (n_in %d, out %d, ws %zu)\n", n_in, out_size, ws_size); grid = -1; return; }
        int dev = 0, cus = 0;
        if (hipGetDevice(&dev) != hipSuccess || hipDeviceGetAttribute(&cus, hipDeviceAttributeMultiprocessorCount, dev) != hipSuccess) { grid = -1; return; }
        if (hipFuncSetAttribute((const void*)fwd_kernel, hipFuncAttributeMaxDynamicSharedMemorySize, LDS_BYTES) != hipSuccess) { fprintf(stderr, "kernel_launch: hipFuncSetAttribute failed\n"); grid = -1; return; }
        int per_cu = 0;
        if (hipOccupancyMaxActiveBlocksPerMultiprocessor(&per_cu, (const void*)fwd_kernel, NWAVES * 64, LDS_BYTES) != hipSuccess || per_cu < 1) fprintf(stderr, "kernel_launch: occupancy query says %d\n", per_cu);
        (void)hipGetLastError();
        grid = cus;
    }
    if (grid < 0) return;
    (void)hipMemsetAsync((char*)d_ws + WS_CTL, 0, CTL_ZERO_BYTES, stream);
    Args a{};
    for (int i = 0; i < 27; ++i) a.in[i] = (const float*)d_in[i];
    a.out = (float*)d_out; a.ws = (unsigned char*)d_ws;
#ifndef DUP_PHASE
    a.ph_lo = 0; a.ph_hi = N_PHASES; hipLaunchKernelGGL(fwd_kernel, dim3(grid), dim3(NWAVES * 64), LDS_BYTES, stream, a);
#else
    a.ph_lo = 0; a.ph_hi = DUP_PHASE + 1; hipLaunchKernelGGL(fwd_kernel, dim3(grid), dim3(NWAVES * 64), LDS_BYTES, stream, a);
    (void)hipMemsetAsync((char*)d_ws + WS_CTL + CW_BAR * 4, 0, XCD_BAR_WORDS * 4, stream);
    a.ph_lo = DUP_PHASE; a.ph_hi = N_PHASES; hipLaunchKernelGGL(fwd_kernel, dim3(grid), dim3(NWAVES * 64), LDS_BYTES, stream, a);
#endif
}
```

```cpp
#include <hip/hip_runtime.h>
#ifndef GATE8
#define GATE8 0
#endif
#include <cstdio>
#include <cstdint>

#define LAS __attribute__((address_space(3)))
#define GAS __attribute__((address_space(1)))
typedef unsigned short bf16_t;
typedef short bf16x8 __attribute__((ext_vector_type(8)));
typedef short s16x4 __attribute__((ext_vector_type(4)));
typedef float f32x4 __attribute__((ext_vector_type(4)));
typedef float f32x2 __attribute__((ext_vector_type(2)));
typedef float f32x16 __attribute__((ext_vector_type(16)));
typedef unsigned u32x4 __attribute__((ext_vector_type(4)));
typedef unsigned u32x2 __attribute__((ext_vector_type(2)));

constexpr int NB = 4, SEQ = 4096, T = NB * SEQ, DM = 1024, NH = 8, DK = 96, DV = 64;
constexpr int NEXP = 32, TOPK = 4, DEXP = 1024, PLE = 256;
constexpr float EPS = 1e-6f;
constexpr int XS_ROWS = T * TOPK + NEXP * 256;

typedef __bf16 bf16x2_t __attribute__((ext_vector_type(2)));
__device__ __forceinline__ unsigned cvt_pk_bf16(float lo, float hi) { f32x2 v = {lo, hi}; return __builtin_bit_cast(unsigned, __builtin_convertvector(v, bf16x2_t)); }
__device__ __forceinline__ u32x2 cvt8_fp8(const f32x4 a, const f32x4 b, float sc) {
    int w0 = __builtin_amdgcn_cvt_pk_fp8_f32(a[0] * sc, a[1] * sc, 0, false); w0 = __builtin_amdgcn_cvt_pk_fp8_f32(a[2] * sc, a[3] * sc, w0, true);
    int w1 = __builtin_amdgcn_cvt_pk_fp8_f32(b[0] * sc, b[1] * sc, 0, false); w1 = __builtin_amdgcn_cvt_pk_fp8_f32(b[2] * sc, b[3] * sc, w1, true);
    u32x2 r; r.x = (unsigned)w0; r.y = (unsigned)w1; return r;
}
__device__ __forceinline__ float bf_lo(unsigned w) { return __uint_as_float(w << 16); }
__device__ __forceinline__ float bf_hi(unsigned w) { return __uint_as_float(w & 0xffff0000u); }
__device__ __forceinline__ float bf1(bf16_t h) { return __uint_as_float(((unsigned)h) << 16); }
__device__ __forceinline__ float fast_sigmoid(float v) { return __builtin_amdgcn_rcpf(1.0f + __builtin_amdgcn_exp2f(-1.4426950408889634f * v)); }
__device__ __forceinline__ int lane_id() { return (int)__builtin_amdgcn_mbcnt_hi(~0u, __builtin_amdgcn_mbcnt_lo(~0u, 0u)); }
__device__ __forceinline__ int tid_local() { int t = threadIdx.x; asm volatile("" : "+v"(t)); return t; }
__device__ __forceinline__ float wave_sum(float v) {
#pragma unroll
    for (int o = 1; o < 64; o <<= 1) v += __shfl_xor(v, o);
    return v;
}

namespace pg8 {
constexpr int BM = 256, BK = 64, HALF = 128, HTB = HALF * BK * 2, STAGE_BYTES = 8 * HTB;
__host__ __device__ __forceinline__ int lds_byte(int r, int c) { const int st = (r >> 4) * 2 + (c >> 5), rr = r & 15, cc = c & 31, ob = rr * 64 + cc * 2; return st * 1024 + (ob ^ (((ob >> 9) & 1) << 5)); }
__host__ __device__ __forceinline__ void stage_rc(int b, int& R, int& C) { const int st = b / 1024, sb = b % 1024, swz = sb ^ (((sb >> 9) & 1) << 5); R = (st >> 1) * 16 + swz / 64; C = (st & 1) * 32 + (swz % 64) / 2; }
__host__ __device__ __forceinline__ int perm32(int rho) { const int n = rho >> 4, i = rho & 15; return 8 * (i >> 2) + 4 * n + (i & 3); }

struct Unit { int pm, pn, aux; };
struct Shape { int Kb, lda, ldb, sw, sa; };
typedef int v8i_t __attribute__((ext_vector_type(8))); typedef int v4i_t __attribute__((ext_vector_type(4)));

template <class Epi, class Sched, bool ALIGN_EPI, bool SP2, bool MX = false, bool GATHER = false>
__device__ __forceinline__ void gemm_phase(LAS unsigned char* lds, const __amdgpu_buffer_rsrc_t rsrc, const Shape g, const Sched& S, const Epi& E, unsigned long long* gp_out = nullptr) {
    const int tid = tid_local(), wid = __builtin_amdgcn_readfirstlane(tid >> 6), lane = tid & 63, wr = wid >> 2, wc = wid & 3, fr = lane & 15, fq = lane >> 4;
    int nt = g.Kb / 128; asm volatile("" : "+s"(nt));
    unsigned voffA, voffB;
    { int R, C; stage_rc(tid * 16, R, C); const int Rb = Epi::PERM ? ((R & ~31) + perm32(R & 31)) : R;
      voffA = GATHER ? (unsigned)(C * 2 + (R << 16)) : (unsigned)(R * g.lda + C * 2); voffB = (unsigned)(Rb * g.ldb + C * 2); }
    const unsigned p2A = 64u * (unsigned)g.lda, p2B = 64u * (unsigned)g.ldb;
    const unsigned kstep = 128u;
    const unsigned hstepA = (unsigned)HALF * g.lda, hstepB = (unsigned)HALF * g.ldb;
    const unsigned ldsw = (unsigned)wid * 1024u;
    const int aoff = lds_byte(wr * 64 + fr, fq * 8), boff = lds_byte(wc * 32 + fr, fq * 8);
#define PG8_SA(b, h) (((b) * 2 + (h)) * HTB)
#define PG8_SB(b, h) ((4 + (b) * 2 + (h)) * HTB)
#define PG8_STAGE(bufoff, gbase, voff) do { \
        __builtin_amdgcn_raw_ptr_buffer_load_lds(rsrc, (LAS void*)(lds + (bufoff) + ldsw), 16, voff, (gbase), 0, 0); \
        __builtin_amdgcn_raw_ptr_buffer_load_lds(rsrc, (LAS void*)(lds + (bufoff) + ldsw + 8192), 16, voff, (gbase) + p2##voff, 0, 0); } while (0)
#define p2voffA p2A
#define p2voffB p2B
#define PG8_STAGEA(bufoff, gk, h, tab) do { if constexpr (GATHER) { \
        const LAS int* tb_ = (const LAS int*)(lds + STAGE_BYTES) + (tab) * 256 + (h) * 128 + (int)(voffA >> 16); const unsigned cb_ = voffA & 0xffffu; \
        const unsigned i0_ = (unsigned)tb_[0], i1_ = (unsigned)tb_[64]; \
        __builtin_amdgcn_raw_ptr_buffer_load_lds(rsrc, (LAS void*)(lds + (bufoff) + ldsw), 16, i0_ * (unsigned)g.lda + cb_, (gk), 0, 0); \
        __builtin_amdgcn_raw_ptr_buffer_load_lds(rsrc, (LAS void*)(lds + (bufoff) + ldsw + 8192), 16, i1_ * (unsigned)g.lda + cb_, (gk), 0, 0); } \
      else { PG8_STAGE(bufoff, (gk) + (h) * hstepA, voffA); } } while (0)
#define PG8_LDA(dst, b, h) do { _Pragma("unroll") for (int m = 0; m < 4; ++m) _Pragma("unroll") for (int k = 0; k < 2; ++k) dst[m][k] = *(const LAS bf16x8*)(lds + PG8_SA(b, h) + aoff + m * 2048 + k * 1024); } while (0)
#define PG8_LDB(dst, b, h) do { _Pragma("unroll") for (int n = 0; n < 2; ++n) _Pragma("unroll") for (int k = 0; k < 2; ++k) dst[n][k] = *(const LAS bf16x8*)(lds + PG8_SB(b, h) + boff + n * 2048 + k * 1024); } while (0)
#define PG8_CAT(x, y) __builtin_shufflevector(__builtin_bit_cast(v4i_t, x), __builtin_bit_cast(v4i_t, y), 0, 1, 2, 3, 4, 5, 6, 7)
#define PG8_MMA(ai, bj, At, Bt) do { __builtin_amdgcn_s_setprio(1); if constexpr (MX) { _Pragma("unroll") for (int m = 0; m < 4; ++m) _Pragma("unroll") for (int n = 0; n < 2; ++n) \
        acc[ai][bj][m][n] = __builtin_amdgcn_mfma_scale_f32_16x16x128_f8f6f4(PG8_CAT(Bt[n][0], Bt[n][1]), PG8_CAT(At[m][0], At[m][1]), acc[ai][bj][m][n], 0, 0, 0, g.sw, 0, g.sa); } else { \
        _Pragma("unroll") for (int m = 0; m < 4; ++m) _Pragma("unroll") for (int n = 0; n < 2; ++n) _Pragma("unroll") for (int k = 0; k < 2; ++k) \
        acc[ai][bj][m][n] = __builtin_amdgcn_mfma_f32_16x16x32_bf16(Bt[n][k], At[m][k], acc[ai][bj][m][n], 0, 0, 0); } __builtin_amdgcn_s_setprio(0); } while (0)
#define PG8_WAIT_V(n) asm volatile("s_waitcnt vmcnt(" #n ")" ::: "memory")
#define PG8_WAIT_L(n) asm volatile("s_waitcnt lgkmcnt(" #n ")" ::: "memory")
#define PG8_BAR __builtin_amdgcn_s_barrier()
#define PG8_SCHED __builtin_amdgcn_sched_barrier(0)
#ifdef GP_PROBE
    unsigned long long gp_cycles = 0, gp_tiles = 0; const unsigned long long gp_p0 = __builtin_amdgcn_s_memtime(), gp_r0 = __builtin_amdgcn_s_memrealtime();
#endif
    Unit cur, nxt; int ui = 0;
    if (!S.next(0, cur)) return;
    f32x4 acc[2][2][4][2];
    E.init(acc, cur, wc, fq);
    bf16x8 At[4][2], B0[2][2], B1[2][2];
    unsigned cA = S.a_off(cur), cB = S.b_off(cur);
    int tab_c = 0; (void)tab_c;
    if constexpr (GATHER) {
        if (wid < 4) {
            const unsigned dst_ = (unsigned)__builtin_amdgcn_readfirstlane((int)(unsigned)(unsigned long)(lds + STAGE_BYTES + (wid * 64) * 4));
            const unsigned vo_ = (unsigned)((wid * 64 + lane) * 4); const unsigned so_ = S.tok_off(cur);
            asm volatile("s_nop 4\n\ts_mov_b32 m0, %0\n\ts_nop 0\n\tbuffer_load_dword %1, %2, %3 offen lds" :: "s"(dst_), "v"(vo_), "s"(rsrc), "s"(so_) : "m0", "memory"); }
        asm volatile("s_waitcnt vmcnt(0)" ::: "memory"); __syncthreads();
    }
    if constexpr (SP2) {
        PG8_STAGE(PG8_SB(0, 0), cB, voffB); PG8_STAGE(PG8_SB(0, 1), cB + hstepB, voffB); PG8_STAGEA(PG8_SA(0, 0), cA, 0, tab_c); PG8_STAGEA(PG8_SA(0, 1), cA, 1, tab_c);
        if (wr == 1) PG8_BAR;
        PG8_WAIT_V(2); PG8_BAR;
        PG8_STAGE(PG8_SB(1, 0), cB + kstep, voffB); PG8_STAGEA(PG8_SA(1, 0), cA + kstep, 0, tab_c); PG8_STAGE(PG8_SB(1, 1), cB + hstepB + kstep, voffB);
        PG8_WAIT_V(6); PG8_BAR;
    } else {
        PG8_STAGE(PG8_SB(0, 0), cB, voffB); PG8_STAGEA(PG8_SA(0, 0), cA, 0, tab_c); PG8_STAGE(PG8_SB(0, 1), cB + hstepB, voffB); PG8_STAGEA(PG8_SA(0, 1), cA, 1, tab_c);
        if (wr == 1) PG8_BAR;
        PG8_WAIT_V(4); PG8_BAR;
        PG8_STAGE(PG8_SB(1, 0), cB + kstep, voffB); PG8_STAGEA(PG8_SA(1, 0), cA + kstep, 0, tab_c); PG8_STAGE(PG8_SB(1, 1), cB + hstepB + kstep, voffB);
        PG8_WAIT_V(6); PG8_BAR;
    }
    for (;;) {
        const bool has_next = S.next(ui + 1, nxt);
        const unsigned nA = has_next ? S.a_off(nxt) : cA, nB = has_next ? S.b_off(nxt) : cB;
        if constexpr (GATHER) { if (has_next && wid < 4) {
            const unsigned dst_ = (unsigned)__builtin_amdgcn_readfirstlane((int)(unsigned)(unsigned long)(lds + STAGE_BYTES + ((tab_c ^ 1) * 256 + wid * 64) * 4));
            const unsigned vo_ = (unsigned)((wid * 64 + lane) * 4); const unsigned so_ = S.tok_off(nxt);
            asm volatile("s_nop 4\n\ts_mov_b32 m0, %0\n\ts_nop 0\n\tbuffer_load_dword %1, %2, %3 offen lds" :: "s"(dst_), "v"(vo_), "s"(rsrc), "s"(so_) : "m0", "memory"); } }
#ifdef GP_PROBE
        const unsigned long long gp_t0 = __builtin_amdgcn_s_memtime();
#endif
#pragma nounroll
        for (int t = 0; t < nt; t += 2) {
            const bool last = (t == nt - 2);
            const unsigned a1 = cA + (unsigned)(t + 1) * kstep;
            const unsigned a2 = last ? nA : cA + (unsigned)(t + 2) * kstep, b2 = last ? nB : cB + (unsigned)(t + 2) * kstep;
            const unsigned a3 = a2 + kstep, b3 = b2 + kstep; const int tab_2 = last ? (tab_c ^ 1) : tab_c; (void)tab_2;
            if constexpr (SP2) {
            PG8_LDB(B0, 0, 0); PG8_LDB(B1, 0, 1); PG8_SCHED; PG8_LDA(At, 0, 0); PG8_STAGEA(PG8_SA(1, 1), a1, 1, tab_c);
            PG8_WAIT_V(8); PG8_WAIT_L(0); PG8_BAR; PG8_MMA(0, 0, At, B0); PG8_MMA(0, 1, At, B1); PG8_BAR; PG8_SCHED;
            PG8_LDA(At, 0, 1); PG8_STAGE(PG8_SB(0, 0), b2, voffB); PG8_STAGE(PG8_SB(0, 1), b2 + hstepB, voffB); PG8_STAGEA(PG8_SA(0, 0), a2, 0, tab_2);
            PG8_WAIT_V(8); PG8_WAIT_L(0); PG8_BAR; PG8_MMA(1, 0, At, B0); PG8_MMA(1, 1, At, B1); PG8_BAR; PG8_SCHED;
            PG8_LDB(B0, 1, 0); PG8_LDB(B1, 1, 1); PG8_SCHED; PG8_LDA(At, 1, 0); PG8_STAGEA(PG8_SA(0, 1), a2, 1, tab_2);
            PG8_WAIT_V(8); PG8_WAIT_L(0); PG8_BAR; PG8_MMA(0, 0, At, B0); PG8_MMA(0, 1, At, B1); PG8_BAR; PG8_SCHED;
            PG8_LDA(At, 1, 1); PG8_STAGE(PG8_SB(1, 0), b3, voffB); PG8_STAGE(PG8_SB(1, 1), b3 + hstepB, voffB); PG8_STAGEA(PG8_SA(1, 0), a3, 0, tab_2);
            PG8_WAIT_V(8); PG8_WAIT_L(0); PG8_BAR; PG8_MMA(1, 0, At, B0); PG8_MMA(1, 1, At, B1); PG8_BAR; PG8_SCHED;
            } else {
            PG8_LDB(B0, 0, 0); PG8_SCHED; PG8_LDA(At, 0, 0); PG8_STAGEA(PG8_SA(1, 1), a1, 1, tab_c);
            PG8_WAIT_L(8); PG8_BAR; PG8_WAIT_L(0); PG8_MMA(0, 0, At, B0); PG8_BAR; PG8_SCHED;
            PG8_LDB(B1, 0, 1); PG8_STAGE(PG8_SB(0, 0), b2, voffB);
            PG8_BAR; PG8_WAIT_L(0); PG8_MMA(0, 1, At, B1); PG8_BAR;
            PG8_LDA(At, 0, 1); PG8_STAGEA(PG8_SA(0, 0), a2, 0, tab_2);
            PG8_BAR; PG8_WAIT_L(0); PG8_MMA(1, 0, At, B0); PG8_BAR; PG8_SCHED;
            PG8_STAGE(PG8_SB(0, 1), b2 + hstepB, voffB);
            PG8_WAIT_V(6); PG8_BAR; PG8_MMA(1, 1, At, B1); PG8_BAR;
            PG8_LDB(B0, 1, 0); PG8_SCHED; PG8_LDA(At, 1, 0); PG8_STAGEA(PG8_SA(0, 1), a2, 1, tab_2);
            PG8_WAIT_L(8); PG8_BAR; PG8_WAIT_L(0); PG8_MMA(0, 0, At, B0); PG8_BAR; PG8_SCHED;
            PG8_LDB(B1, 1, 1); PG8_STAGE(PG8_SB(1, 0), b3, voffB);
            PG8_BAR; PG8_WAIT_L(0); PG8_MMA(0, 1, At, B1); PG8_BAR;
            PG8_LDA(At, 1, 1); PG8_STAGEA(PG8_SA(1, 0), a3, 0, tab_2);
            PG8_BAR; PG8_WAIT_L(0); PG8_MMA(1, 0, At, B0); PG8_BAR; PG8_SCHED;
            PG8_STAGE(PG8_SB(1, 1), b3 + hstepB, voffB);
            PG8_WAIT_V(6); PG8_BAR; PG8_MMA(1, 1, At, B1); PG8_BAR;
            }
        }
#ifdef GP_PROBE
        if (gp_out) { gp_cycles += __builtin_amdgcn_s_memtime() - gp_t0; gp_tiles += nt; }
#endif
        if constexpr (ALIGN_EPI) { if (wr == 0) PG8_BAR; }
        if (has_next) S.prefetch(nxt, rsrc, lds, wid, lane);
        { int fr_e = fr, fq_e = fq; asm volatile("" : "+v"(fr_e), "+v"(fq_e));
          E(acc, cur, wr, wc, fr_e, fq_e); }
        if (!has_next) break;
        { int fq_i = fq; asm volatile("" : "+v"(fq_i)); E.init(acc, nxt, wc, fq_i); }
        cur = nxt; cA = nA; cB = nB; ++ui; tab_c ^= 1;
        if constexpr (ALIGN_EPI) { if (wr == 1) PG8_BAR; }
    }
    PG8_WAIT_V(0);
    if constexpr (!ALIGN_EPI) { if (wr == 0) PG8_BAR; }
    PG8_BAR;
#ifdef GP_PROBE
    if (gp_out && blockIdx.x == GP_BLOCK && tid == 0) { gp_out[0] = gp_cycles; gp_out[1] = gp_tiles; gp_out[2] = __builtin_amdgcn_s_memtime() - gp_p0; gp_out[3] = __builtin_amdgcn_s_memrealtime() - gp_r0; gp_out[4] = (unsigned long long)(ui + 1); }
#endif
#undef PG8_SA
#undef PG8_SB
#undef PG8_STAGE
#undef p2voffA
#undef PG8_STAGEA
#undef p2voffB
#undef PG8_LDA
#undef PG8_LDB
#undef PG8_MMA
#undef PG8_CAT
#undef PG8_WAIT_V
#undef PG8_WAIT_L
#undef PG8_BAR
#undef PG8_SCHED
}
}
using pg8::Unit;

constexpr size_t MiB = 1u << 20;
constexpr size_t WS_CTL = 0, CTL_ZERO_BYTES = 1 * MiB;
constexpr size_t WS_WIN = 1 * MiB;
constexpr size_t WS_WQ = 7 * MiB;
constexpr size_t WS_WKV = WS_WQ + 512 * 1024;
constexpr size_t WS_WPOOL = 8 * MiB;
constexpr size_t WS_WAO = 9 * MiB;
constexpr size_t WS_WPO = 10 * MiB;
constexpr size_t WS_WO = 11 * MiB;
constexpr size_t WS_WPG = 13 * MiB;
constexpr size_t WS_WPLE = 15 * MiB;
constexpr size_t WS_WGU = 16 * MiB;
constexpr size_t WS_WD = 144 * MiB;
constexpr size_t WS_HN = 208 * MiB;
constexpr size_t WS_PROJ = 240 * MiB;
constexpr size_t WS_GATES = 272 * MiB;
constexpr size_t WS_A2 = 336 * MiB;
constexpr size_t WS_POOLED = 352 * MiB;
constexpr size_t WS_Q = 368 * MiB;
constexpr size_t WS_K = 392 * MiB;
constexpr size_t WS_V = 416 * MiB;
constexpr size_t WS_ATT = 432 * MiB;
constexpr size_t WS_MIXED = 448 * MiB;
constexpr size_t WS_MIX = 464 * MiB;
constexpr size_t WS_PB = 496 * MiB;
constexpr size_t WS_E = 504 * MiB;
constexpr size_t WS_SSQ = 536 * MiB;
constexpr size_t WS_COS = 537 * MiB;
constexpr size_t WS_SIN = 538 * MiB;
constexpr size_t WS_ROUTE = 539 * MiB;
constexpr size_t WS_TOK = 541 * MiB;
constexpr size_t WS_XS = 544 * MiB;
constexpr size_t WS_ACT = 688 * MiB;
constexpr size_t WS_XS2 = 768 * MiB;
constexpr size_t WS_WIN8 = 848 * MiB;
constexpr size_t WS_HN8 = 852 * MiB;
constexpr size_t WS_END = 868 * MiB;
constexpr size_t WS_X1B = WS_PROJ;
constexpr size_t WS_X2B = WS_MIX;
constexpr int CW_BAR = 4096;
constexpr int CW_CNT = 1024;

constexpr int RING_BYTES = 131072;
constexpr int LDS_BYTES = 163840;
constexpr int MISC_OFF = LDS_BYTES - 512;
constexpr int TILE_E_OFF = LDS_BYTES - 4096;
constexpr int NWAVES = 8;

typedef GAS unsigned gu32;
#define RLX_AGENT __ATOMIC_RELAXED, __HIP_MEMORY_SCOPE_AGENT
#define XB_TMO      128
#define XB_XCNT(j)  (256  + 64 * (j))
#define XB_XSUB(j)  (1280 + 64 * (j))
#define XB_XGEN(j)  (2304 + 64 * (j))
#define XB_TOP      3328
#define XB_TOPGEN   3392
#define XCD_BAR_WORDS 3456
#define XB_SPIN_CAP (1u << 18)
__device__ __forceinline__ unsigned xb_ld(unsigned* p)              { return __hip_atomic_load(p, __ATOMIC_RELAXED, __HIP_MEMORY_SCOPE_AGENT); }
__device__ __forceinline__ unsigned xb_add(unsigned* p, unsigned v) { return __hip_atomic_fetch_add(p, v, __ATOMIC_RELAXED, __HIP_MEMORY_SCOPE_AGENT); }
__device__ __forceinline__ unsigned xb_xcc_id() { return (unsigned)__builtin_amdgcn_s_getreg((3 << 11) | 20) & 0xFu; }
#define XB_SPIN(cond, bar) do { unsigned _sp = 0; while (cond) { __builtin_amdgcn_s_sleep(1); \
    if ((++_sp & 255u) == 0u) { if (xb_ld(&(bar)[XB_TMO])) break; if (_sp > XB_SPIN_CAP) { atomicAdd(&(bar)[XB_TMO], 1u); break; } } } } while (0)
struct XcdBarrier { unsigned* bar; unsigned x; volatile LAS unsigned* st; };
__device__ __forceinline__ XcdBarrier xcd_barrier_post(unsigned* bar, volatile LAS unsigned* st) {
    XcdBarrier b; b.bar = bar; b.x = xb_xcc_id(); b.st = st;
    if (threadIdx.x == 0) (void)xb_add(&bar[XB_XCNT(b.x)], 1u);
    return b;
}
__device__ __forceinline__ void xcd_barrier_complete(unsigned* bar, unsigned x, unsigned& nloc, unsigned& nx) {
    const unsigned G = gridDim.x * gridDim.y * gridDim.z;
    unsigned sum, cnt, mine, sp = 0u;
    for (;;) {
        sum = 0u; cnt = 0u; mine = 0u;
#pragma unroll
        for (unsigned j = 0; j < 16; ++j) { const unsigned c = xb_ld(&bar[XB_XCNT(j)]); sum += c; cnt += (c > 0u) ? 1u : 0u; mine = (j == x) ? c : mine; }
        if (sum == G) break;
        __builtin_amdgcn_s_sleep(1);
        if ((++sp & 255u) == 0u) { if (xb_ld(&bar[XB_TMO])) break; if (sp > XB_SPIN_CAP) { atomicAdd(&bar[XB_TMO], 1u); break; } }
    }
    nloc = mine > 0u ? mine : 1u; nx = cnt > 0u ? cnt : 1u;
}
__device__ __forceinline__ void xcd_barrier(const XcdBarrier& b) {
    asm volatile("s_waitcnt vmcnt(0)" ::: "memory");
    __syncthreads();
    if (threadIdx.x == 0) {
        unsigned* bar = b.bar;
        __builtin_amdgcn_s_waitcnt(0);
        unsigned nloc = b.st[0], nx = b.st[1];
        if (nloc == 0u) { xcd_barrier_complete(bar, b.x, nloc, nx); b.st[0] = nloc; b.st[1] = nx; }
        const unsigned old = xb_add(&bar[XB_XSUB(b.x)], 1u);
        const unsigned gen = old / nloc;
        if (old + 1u == (gen + 1u) * nloc) {
            __builtin_amdgcn_fence(__ATOMIC_RELEASE, "agent");
            asm volatile("s_waitcnt vmcnt(0)" ::: "memory");
            const unsigned og = xb_add(&bar[XB_TOP], 1u);
            const unsigned tg = og / nx;
            if (og + 1u == (tg + 1u) * nx) xb_add(&bar[XB_TOPGEN], 1u);
            else XB_SPIN(xb_ld(&bar[XB_TOPGEN]) == tg, bar);
            __builtin_amdgcn_fence(__ATOMIC_ACQUIRE, "agent");
            xb_add(&bar[XB_XGEN(b.x)], 1u);
            asm volatile("s_waitcnt vmcnt(0)" ::: "memory");
        } else {
            XB_SPIN(xb_ld(&bar[XB_XGEN(b.x)]) == gen, bar);
            __builtin_amdgcn_fence(__ATOMIC_ACQUIRE, "agent");
            asm volatile("s_waitcnt vmcnt(0)" ::: "memory");
        }
    }
    __syncthreads();
}

#ifdef GP_PROBE
#define GP_AT(k) ((k) == GP_PHASE ? (unsigned long long*)(ws + WS_CTL + 65536) : nullptr)
#else
#define GP_AT(k) nullptr
#endif
struct Args {
    const float* in[27];
    float* out; unsigned char* ws;
    int ph_lo, ph_hi;
};
typedef const __attribute__((address_space(4))) Args* KArgs;
__device__ __forceinline__ KArgs kargs() { KArgs p = (KArgs)__builtin_amdgcn_kernarg_segment_ptr(); asm volatile("" : "+s"(p)); return p; }
enum { I_X = 0, I_P, I_POS, I_GMIX, I_WIN, I_GQLAT, I_WQB, I_GKVLAT, I_WKVB, I_GQHEAD, I_GKNOPE, I_GKROPE, I_WPOOL, I_PSCALE, I_WAO, I_WPO, I_WO, I_GFFN,
       I_WR, I_BR, I_WGU, I_BGU, I_WD, I_BD, I_GPLE, I_WPG, I_WPLE };

enum { MAP_ID = 0, MAP_WIN, MAP_GU, MAP_QB, MAP_KVB };
__device__ __forceinline__ int map_row(int mode, int n) {
    switch (mode) {
    case MAP_WIN: return n < 416 ? n : n + 96;
    case MAP_GU: { const int j = n & 1023, up = n >> 10; return 256 * (j >> 7) + 128 * up + (j & 127); }
    case MAP_QB: { const int h = n / 96, d = n % 96;
        if (d < 64) return (h >> 2) * 256 + 128 * (d >> 5) + 32 * (h & 3) + (d & 31);
        const int dd = d - 64, half = dd >> 4, i = dd & 15; return 512 + 128 * (h & 1) + 32 * (h >> 1) + 8 * (i >> 2) + 4 * half + (i & 3); }
    case MAP_KVB: { const int h = n >> 7, c = n & 127, isv = c >> 6, d = c & 63; return (h >> 1) * 256 + 128 * (d >> 5) + 32 * (2 * isv + (h & 1)) + (d & 31); }
    default: return n;
    }
}
struct TJob { const float* W; int K, N; bf16_t* WT; int ldw, koff, mode, row_off; const float* gk; const float* gn; int nmat; size_t wstride, wtstride; int fp8; };
struct TItem { const float* src; bf16_t* dst; int n0, k0; float gnv; };
__device__ __forceinline__ TItem titem_setup(const TJob& J, int item, int lane) {
    const int nblk = J.N / 32, ipm = (J.K / 64) * nblk, mat = item / ipm, it = item - mat * ipm, kb = it / nblk, nb = it - kb * nblk;
    TItem I; I.k0 = 64 * kb; I.n0 = 32 * nb;
    I.src = J.W + (size_t)mat * J.wstride + (size_t)(I.k0 + (lane >> 5)) * J.N + I.n0 + (lane & 31);
    I.dst = (bf16_t*)((unsigned char*)J.WT + (size_t)mat * J.wtstride * (J.fp8 ? 1 : 2));
    I.gnv = J.gn ? J.gn[I.n0 + (lane & 31)] : 1.f;
    return I;
}
__device__ __forceinline__ void titem_load(const TJob& J, const TItem& I, float (&v)[32]) {
#pragma unroll
    for (int i = 0; i < 32; ++i) v[i] = I.src[(size_t)(2 * i) * J.N];
}
__device__ __forceinline__ void titem_store(const TJob& J, const TItem& I, float (&v)[32], LAS float* scr, int lane) {
#pragma unroll
    for (int i = 0; i < 32; ++i) { const int kk = 2 * i + (lane >> 5); float x = v[i] * I.gnv; if (J.gk) x *= J.gk[I.k0 + kk]; scr[kk * 33 + (lane & 31)] = x; }
    asm volatile("s_waitcnt lgkmcnt(0)" ::: "memory");
    const int c = lane & 7;
#pragma unroll
    for (int j = 0; j < 4; ++j) { const int n = (lane >> 3) + 8 * j; const LAS float* s = scr + (8 * c) * 33 + n;
        const size_t eo = (size_t)(J.row_off + map_row(J.mode, I.n0 + n)) * J.ldw + J.koff + I.k0 + 8 * c;
        if (J.fp8) { u32x2 o; int w = __builtin_amdgcn_cvt_pk_fp8_f32(s[0 * 33] * 8.f, s[1 * 33] * 8.f, 0, false); w = __builtin_amdgcn_cvt_pk_fp8_f32(s[2 * 33] * 8.f, s[3 * 33] * 8.f, w, true); o.x = (unsigned)w;
            w = __builtin_amdgcn_cvt_pk_fp8_f32(s[4 * 33] * 8.f, s[5 * 33] * 8.f, 0, false); w = __builtin_amdgcn_cvt_pk_fp8_f32(s[6 * 33] * 8.f, s[7 * 33] * 8.f, w, true); o.y = (unsigned)w;
            *(u32x2*)((unsigned char*)I.dst + eo) = o; }
        else { u32x4 o; o.x = cvt_pk_bf16(s[0 * 33], s[1 * 33]); o.y = cvt_pk_bf16(s[2 * 33], s[3 * 33]); o.z = cvt_pk_bf16(s[4 * 33], s[5 * 33]); o.w = cvt_pk_bf16(s[6 * 33], s[7 * 33]);
            *(u32x4*)(I.dst + eo) = o; } }
    asm volatile("s_waitcnt lgkmcnt(0)" ::: "memory");
}
__device__ __forceinline__ void run_job(const TJob& J, LAS float* scr, int gw, int NGW, int lane) {
    const int items = J.nmat * (J.K / 64) * (J.N / 32);
    for (int it = gw; it < items; it += 2 * NGW) {
        const bool two = (it + NGW) < items;
        const TItem I0 = titem_setup(J, it, lane); const TItem I1 = titem_setup(J, two ? it + NGW : it, lane);
        float v0[32], v1[32];
        titem_load(J, I0, v0); if (two) titem_load(J, I1, v1);
        titem_store(J, I0, v0, scr, lane); if (two) titem_store(J, I1, v1, scr, lane);
    }
}

struct Frame {
    LAS unsigned char* lds; volatile LAS unsigned* MISC; unsigned* ctl;
    int wave, vcu, G;
    float* out; unsigned char* ws;
};

__device__ __forceinline__ void p0_prologue(const Frame& F) {
    const int tid_l = tid_local(), lane_l = tid_l & 63; (void)tid_l; (void)lane_l;
    const KArgs a = kargs();
    LAS float* scr = (LAS float*)(F.lds + F.wave * 16384);
    const int gw = F.vcu * NWAVES + F.wave, NGW = F.G * NWAVES;
    unsigned char* ws = F.ws;
    int joff = 0;
#define RUN_JOB(...) do { const TJob J_ = TJob{__VA_ARGS__, 1, 0, 0, 0}; run_job(J_, scr, (gw + NGW - joff % NGW) % NGW, NGW, lane_l); joff += (J_.K / 64) * (J_.N / 32); } while (0)
#ifndef P1_FP8
#define P1_FP8 0
#endif
    { const TJob J_{a->in[I_WIN], 1024, 2976, (bf16_t*)(ws + WS_WIN), 1024, 0, MAP_WIN, 0, nullptr, nullptr, 1, 0, 0, P1_FP8}; run_job(J_, scr, gw, NGW, lane_l); joff += 16 * 93; }
#ifndef GATES_FP8
#define GATES_FP8 0
#endif
    if (GATES_FP8) { const TJob J_{a->in[I_WIN], 1024, 2976, (bf16_t*)(ws + WS_WIN8), 1024, 0, MAP_WIN, 0, nullptr, nullptr, 1, 0, 0, 1}; run_job(J_, scr, gw, NGW, lane_l); }
    RUN_JOB(a->in[I_WQB], 256, 768, (bf16_t*)(ws + WS_WQ), 256, 0, MAP_QB, 0, a->in[I_GQLAT], nullptr);
    RUN_JOB(a->in[I_WKVB], 128, 1024, (bf16_t*)(ws + WS_WKV), 256, 0, MAP_KVB, 0, a->in[I_GKVLAT], nullptr);
    RUN_JOB(a->in[I_WAO], 512, 1024, (bf16_t*)(ws + WS_WAO), 512, 0, MAP_ID, 0, nullptr, nullptr);
    RUN_JOB(a->in[I_WPO], 512, 1024, (bf16_t*)(ws + WS_WPO), 512, 0, MAP_ID, 0, nullptr, nullptr);
    RUN_JOB(a->in[I_WO], 1024, 1024, (bf16_t*)(ws + WS_WO), 1024, 0, MAP_ID, 0, nullptr, nullptr);
#ifndef PLE_FP8
#define PLE_FP8 1
#endif
    { const TJob J_{a->in[I_WPG], 1024, 1024, (bf16_t*)(ws + WS_WPG), 1024, 0, MAP_ID, 0, nullptr, nullptr, 1, 0, 0, PLE_FP8}; run_job(J_, scr, (gw + NGW - joff % NGW) % NGW, NGW, lane_l); joff += 16 * 32; }
    RUN_JOB(a->in[I_WPLE], 256, 1024, (bf16_t*)(ws + WS_WPLE), 256, 0, MAP_ID, 0, nullptr, nullptr);
    for (int g = 0; g < 4; ++g)
        RUN_JOB(a->in[I_WPOOL] + (size_t)g * 128 * 128, 128, 128, (bf16_t*)(ws + WS_WPOOL) + (size_t)(g >> 1) * 256 * 256, 256, 128 * (g & 1), MAP_ID, 128 * (g & 1), nullptr, a->in[I_PSCALE] + 128 * g);
    {
        const int gt = (F.vcu * NWAVES + F.wave) * 64 + lane_l, NGT = NGW * 64;
        const u32x4 z = {0u, 0u, 0u, 0u};
        u32x4* w0 = (u32x4*)(ws + WS_WIN + (size_t)416 * 1024 * (P1_FP8 ? 1 : 2));
        for (int i = gt; i < 96 * (P1_FP8 ? 64 : 128); i += NGT) w0[i] = z;
        for (int i = gt; i < 1024 * 16; i += NGT) { const int r = i >> 4, c = i & 15; *(u32x4*)((bf16_t*)(ws + WS_WKV) + (size_t)r * 256 + 128 + 8 * c) = z; }
        for (int i = gt; i < 2 * 256 * 16; i += NGT) { const int p = i >> 12, r = (i >> 4) & 255, c = i & 15;
            const int k0 = (r < 128) ? 128 : 0; *(u32x4*)((bf16_t*)(ws + WS_WPOOL) + (size_t)p * 65536 + (size_t)r * 256 + k0 + 8 * c) = z; }
    }
#ifndef CONV_IN_ATTN
#define CONV_IN_ATTN 1
#endif
    if (!CONV_IN_ATTN) {
    { const TJob J{a->in[I_WGU], 1024, 2048, (bf16_t*)(ws + WS_WGU), 1024, 0, MAP_GU, 0, nullptr, nullptr, NEXP, (size_t)1024 * 2048, (size_t)2048 * 1024, 1}; run_job(J, scr, gw, NGW, lane_l); }
    { const TJob J{a->in[I_WD], 1024, 1024, (bf16_t*)(ws + WS_WD), 1024, 0, MAP_ID, 0, nullptr, nullptr, NEXP, (size_t)1024 * 1024, (size_t)1024 * 1024, 1}; run_job(J, scr, gw, NGW, lane_l); }
    }
    const float* x = a->in[I_X]; const float* gm = a->in[I_GMIX];
    f32x4 gv[4];
#pragma unroll
    for (int j = 0; j < 4; ++j) gv[j] = *(const f32x4*)(gm + 4 * lane_l + 256 * j);
    for (int m = gw; m < T; m += NGW) {
        const f32x4* xr = (const f32x4*)(x + (size_t)m * DM) + lane_l;
        f32x4 v[4]; float s = 0.f;
#pragma unroll
        for (int j = 0; j < 4; ++j) { v[j] = xr[64 * j]; s += (v[j].x * v[j].x + v[j].y * v[j].y) + (v[j].z * v[j].z + v[j].w * v[j].w); }
        const float rstd = 1.0f / sqrtf(wave_sum(s) * (1.f / DM) + EPS);
        if (P1_FP8) { int* o4 = (int*)(ws + WS_HN + (size_t)m * DM) + lane_l; const float r8 = rstd * 8.0f;
#pragma unroll
            for (int j = 0; j < 4; ++j) { int w = __builtin_amdgcn_cvt_pk_fp8_f32(v[j].x * r8 * gv[j].x, v[j].y * r8 * gv[j].y, 0, false); w = __builtin_amdgcn_cvt_pk_fp8_f32(v[j].z * r8 * gv[j].z, v[j].w * r8 * gv[j].w, w, true); o4[64 * j] = w; } }
        else { u32x2* o8 = (u32x2*)((bf16_t*)(ws + WS_HN) + (size_t)m * DM) + lane_l;
#pragma unroll
            for (int j = 0; j < 4; ++j) { u32x2 w; w.x = cvt_pk_bf16(v[j].x * rstd * gv[j].x, v[j].y * rstd * gv[j].y); w.y = cvt_pk_bf16(v[j].z * rstd * gv[j].z, v[j].w * rstd * gv[j].w); o8[64 * j] = w; }
            if (GATES_FP8) { int* o4 = (int*)(ws + WS_HN8 + (size_t)m * DM) + lane_l; const float r8 = rstd * 8.0f;
#pragma unroll
                for (int j = 0; j < 4; ++j) { int w = __builtin_amdgcn_cvt_pk_fp8_f32(v[j].x * r8 * gv[j].x, v[j].y * r8 * gv[j].y, 0, false); w = __builtin_amdgcn_cvt_pk_fp8_f32(v[j].z * r8 * gv[j].z, v[j].w * r8 * gv[j].w, w, true); o4[64 * j] = w; } } }
    }
    {
        const float* p = a->in[I_P];
        for (int m = gw; m < T; m += NGW) { const f32x4 v = *((const f32x4*)(p + (size_t)m * PLE) + lane_l); u32x2 w; w.x = cvt_pk_bf16(v.x, v.y); w.y = cvt_pk_bf16(v.z, v.w);
            *((u32x2*)((bf16_t*)(ws + WS_PB) + (size_t)m * PLE) + lane_l) = w; }
    }
}

struct DenseOrder {
    int nM, nN, nwg, G, c; unsigned A, B, tA, tB, aPn;
    __device__ void init(int nM_, int nN_, int G_, int c_, size_t A_, size_t lda, size_t B_, size_t ldb, unsigned aPn_ = 0) { nM = nM_; nN = nN_; nwg = nM * nN; G = G_; c = c_; A = (unsigned)A_; B = (unsigned)B_; tA = (unsigned)(256 * lda * 2); tB = (unsigned)(256 * ldb * 2); aPn = aPn_; }
    __device__ __forceinline__ bool next(int i, Unit& u) const {
        const long L = (long)i * G + c; if (L >= nwg) return false;
        int wgid = (int)L; { const int q = nwg / 8, r = nwg % 8, xcd = wgid % 8, off = wgid / 8; wgid = (xcd < r ? xcd * (q + 1) : r * (q + 1) + (xcd - r) * q) + off; }
        const int WGM = 8; const int nig = WGM * nN, gid = wgid / nig, fm = gid * WGM, gsz = (nM - fm) < WGM ? (nM - fm) : WGM;
        u.pm = fm + ((wgid % nig) % gsz); u.pn = (wgid % nig) / gsz; u.aux = 0; return true;
    }
    __device__ __forceinline__ void prefetch(const Unit&, const __amdgpu_buffer_rsrc_t, LAS unsigned char*, int, int) const {}
    __device__ __forceinline__ unsigned a_off(const Unit& u) const { return A + (unsigned)u.pm * tA + (unsigned)u.pn * aPn; }
    __device__ __forceinline__ unsigned b_off(const Unit& u) const { return B + (unsigned)u.pn * tB; }
};

struct EpiBf16 {
    static constexpr bool PERM = true;
    __device__ __forceinline__ void init(f32x4 (&acc)[2][2][4][2], const Unit&, int, int) const {
#pragma unroll
        for (int a = 0; a < 2; ++a)
#pragma unroll
            for (int b = 0; b < 2; ++b)
#pragma unroll
                for (int m = 0; m < 4; ++m)
#pragma unroll
                    for (int n = 0; n < 2; ++n) acc[a][b][m][n] = (f32x4){0.f, 0.f, 0.f, 0.f};
    }
    bf16_t* O; int ldc;
    __device__ __forceinline__ void operator()(const f32x4 (&acc)[2][2][4][2], const Unit& u, int wr, int wc, int fr, int fq) const {
        const int row0 = u.pm * 256 + wr * 64 + fr, col0 = u.pn * 256 + wc * 32 + 8 * fq;
#pragma unroll
        for (int ai = 0; ai < 2; ++ai)
#pragma unroll
            for (int m = 0; m < 4; ++m) { bf16_t* rowp = O + (size_t)(row0 + ai * 128 + m * 16) * ldc + col0;
#pragma unroll
                for (int bj = 0; bj < 2; ++bj) { const f32x4 v0 = acc[ai][bj][m][0], v1 = acc[ai][bj][m][1];
                    u32x4 w; w.x = cvt_pk_bf16(v0[0], v0[1]); w.y = cvt_pk_bf16(v0[2], v0[3]); w.z = cvt_pk_bf16(v1[0], v1[1]); w.w = cvt_pk_bf16(v1[2], v1[3]);
                    *(u32x4*)(rowp + bj * 128) = w; } }
    }
};
struct EpiProj {
    static constexpr bool PERM = true;
    __device__ __forceinline__ void init(f32x4 (&acc)[2][2][4][2], const Unit&, int, int) const {
#pragma unroll
        for (int a = 0; a < 2; ++a)
#pragma unroll
            for (int b = 0; b < 2; ++b)
#pragma unroll
                for (int m = 0; m < 4; ++m)
#pragma unroll
                    for (int n = 0; n < 2; ++n) acc[a][b][m][n] = (f32x4){0.f, 0.f, 0.f, 0.f};
    }
    bf16_t* PROJ; bf16_t* GATES; int pn_off;
    __device__ __forceinline__ void operator()(const f32x4 (&acc)[2][2][4][2], const Unit& u, int wr, int wc, int fr, int fq) const {
        const int pn = u.pn + pn_off; const int row0 = u.pm * 256 + wr * 64 + fr; const bool isg = pn >= 4;
        bf16_t* O = isg ? GATES : PROJ; const int ldc = isg ? 2048 : 1024; const int col0 = (isg ? pn - 4 : pn) * 256 + wc * 32 + 8 * fq;
#pragma unroll
        for (int ai = 0; ai < 2; ++ai)
#pragma unroll
            for (int m = 0; m < 4; ++m) { bf16_t* rowp = O + (size_t)(row0 + ai * 128 + m * 16) * ldc + col0;
#pragma unroll
                for (int bj = 0; bj < 2; ++bj) { f32x4 v0 = acc[ai][bj][m][0], v1 = acc[ai][bj][m][1];
                    if (isg) {
#pragma unroll
                        for (int e = 0; e < 4; ++e) { v0[e] = fast_sigmoid(v0[e]); v1[e] = fast_sigmoid(v1[e]); }
                        if (GATE8) {
#pragma unroll
                            for (int e = 0; e < 4; ++e) { v0[e] = fmaxf(v0[e] * 256.0f, 0.002f); v1[e] = fmaxf(v1[e] * 256.0f, 0.002f); }
                            *(u32x2*)((unsigned char*)GATES + (size_t)(row0 + ai * 128 + m * 16) * 2048 + col0 + bj * 128) = cvt8_fp8(v0, v1, 1.0f); continue; } }
                    u32x4 w; w.x = cvt_pk_bf16(v0[0], v0[1]); w.y = cvt_pk_bf16(v0[2], v0[3]); w.z = cvt_pk_bf16(v1[0], v1[1]); w.w = cvt_pk_bf16(v1[2], v1[3]);
                    *(u32x4*)(rowp + bj * 128) = w; } asm volatile("" ::: "memory"); }
    }
};

__device__ __forceinline__ void p2_rows(const Frame& F) {
    const int tid_l = tid_local(), lane_l = tid_l & 63; (void)tid_l; (void)lane_l;
    const KArgs a = kargs();
    const int gw = F.vcu * NWAVES + F.wave, NGW = F.G * NWAVES, lane = lane_l;
    unsigned char* ws = F.ws;
    const bf16_t* PROJ = (const bf16_t*)(ws + WS_PROJ);
    bf16_t* A2 = (bf16_t*)(ws + WS_A2); bf16_t* POOLED = (bf16_t*)(ws + WS_POOLED); bf16_t* Kb = (bf16_t*)(ws + WS_K);
    float* COS = (float*)(ws + WS_COS); float* SIN = (float*)(ws + WS_SIN);
    const int* positions = (const int*)a->in[I_POS];
    const float gkr = (lane < 32) ? a->in[I_GKROPE][lane] : 0.f;
    const float inv_freq = __builtin_amdgcn_exp2f(-(float)(lane & 15) * (13.287712379549449f / 16.0f));
    const int w = 2 << (lane >> 4);
    for (int task = gw; task < T / 8; task += NGW) {
        const int t0 = task * 8, b = t0 / SEQ, s0 = t0 % SEQ;
        u32x2 qlv[8]; unsigned kvv[8]; bf16_t krr[8]; int posv[8];
#pragma unroll
        for (int i = 0; i < 8; ++i) { const bf16_t* pr = PROJ + (size_t)(t0 + i) * 1024; qlv[i] = *(const u32x2*)(pr + 4 * lane); kvv[i] = *(const unsigned*)(pr + 256 + 2 * lane); krr[i] = pr[384 + (lane & 31)]; posv[i] = positions[t0 + i]; }
        {
            const bf16_t* base = PROJ + (size_t)(b * SEQ) * 1024 + 512 + 8 * lane;
            u32x4 I[15], C[8], L[8];
#pragma unroll
            for (int k = 0; k < 15; ++k) { const int r = s0 - 15 + k; I[k] = *(const u32x4*)(base + (size_t)(r < 0 ? 0 : r) * 1024); }
#pragma unroll
            for (int i = 0; i < 8; ++i) { C[i] = *(const u32x4*)(base + (size_t)(s0 + i) * 1024); const int rr = s0 + i - w + 1; L[i] = *(const u32x4*)(base + (size_t)(rr < 0 ? 0 : rr) * 1024); }
            float S[8];
#pragma unroll
            for (int j = 0; j < 8; ++j) S[j] = 0.f;
#pragma unroll
            for (int k = 0; k < 15; ++k) { const float mk = (s0 - 15 + k >= 0 && k >= 16 - w) ? 1.f : 0.f; const u32x4 v = I[k];
                S[0] += mk * bf_lo(v.x); S[1] += mk * bf_hi(v.x); S[2] += mk * bf_lo(v.y); S[3] += mk * bf_hi(v.y); S[4] += mk * bf_lo(v.z); S[5] += mk * bf_hi(v.z); S[6] += mk * bf_lo(v.w); S[7] += mk * bf_hi(v.w); }
#pragma unroll
            for (int i = 0; i < 8; ++i) {
                const int s = s0 + i;
                const u32x4 v = C[i];
                float uu[8] = {bf_lo(v.x), bf_hi(v.x), bf_lo(v.y), bf_hi(v.y), bf_lo(v.z), bf_hi(v.z), bf_lo(v.w), bf_hi(v.w)};
                const int cnt = (s + 1 < w) ? s + 1 : w; const float ic = 1.0f / (float)cnt;
                float o[8];
#pragma unroll
                for (int j = 0; j < 8; ++j) { S[j] += uu[j]; o[j] = S[j] * ic - uu[j]; }
                u32x4 wv; wv.x = cvt_pk_bf16(o[0], o[1]); wv.y = cvt_pk_bf16(o[2], o[3]); wv.z = cvt_pk_bf16(o[4], o[5]); wv.w = cvt_pk_bf16(o[6], o[7]);
                *(u32x4*)(POOLED + (size_t)(t0 + i) * 512 + 8 * lane) = wv;
                const float mq = (s - w + 1 >= 0) ? 1.f : 0.f; const u32x4 q = L[i];
                S[0] -= mq * bf_lo(q.x); S[1] -= mq * bf_hi(q.x); S[2] -= mq * bf_lo(q.y); S[3] -= mq * bf_hi(q.y); S[4] -= mq * bf_lo(q.z); S[5] -= mq * bf_hi(q.z); S[6] -= mq * bf_lo(q.w); S[7] -= mq * bf_hi(q.w);
            }
        }
#pragma unroll
        for (int i = 0; i < 8; ++i) {
            const int t = t0 + i, s = s0 + i;
            const u32x2 ql = qlv[i];
            const unsigned kvl = kvv[i];
            const float krv = (lane < 32) ? bf1(krr[i]) : 0.f;
            const float q0 = bf_lo(ql.x), q1 = bf_hi(ql.x), q2 = bf_lo(ql.y), q3 = bf_hi(ql.y);
            const float k0 = bf_lo(kvl), k1 = bf_hi(kvl);
            const float sq = wave_sum((q0 * q0 + q1 * q1) + (q2 * q2 + q3 * q3));
            const float sk = wave_sum(k0 * k0 + k1 * k1);
            const float sr = wave_sum(krv * krv);
            const float rq = 1.0f / sqrtf(sq * (1.f / 256.f) + EPS), rk = 1.0f / sqrtf(sk * (1.f / 128.f) + EPS), rr = 1.0f / sqrtf(sr * (1.f / 32.f) + EPS);
            u32x2 wq; wq.x = cvt_pk_bf16(q0 * rq, q1 * rq); wq.y = cvt_pk_bf16(q2 * rq, q3 * rq);
            *(u32x2*)(A2 + (size_t)t * 512 + 4 * lane) = wq;
            *(unsigned*)(A2 + (size_t)t * 512 + 256 + 2 * lane) = cvt_pk_bf16(k0 * rk, k1 * rk);
            *(unsigned*)(A2 + (size_t)t * 512 + 384 + 2 * lane) = 0u;
            const float pos = (float)posv[i];
            const float ang = pos * inv_freq;
            const float rev = ang * 0.15915494309189535f;
            const float fr_ = rev - floorf(rev);
            const float sn = __builtin_amdgcn_sinf(fr_), cs = __builtin_amdgcn_cosf(fr_);
            const float kn = krv * rr * gkr;
            const float other = __shfl_xor(kn, 16);
            const float ro = (lane & 16) ? (kn * cs + other * sn) : (kn * cs - other * sn);
            if (lane < 32) {
                const bf16_t rb = (bf16_t)(cvt_pk_bf16(ro, 0.f) & 0xffffu);
#pragma unroll
                for (int h = 0; h < NH; ++h) Kb[((size_t)(b * NH + h) * SEQ + s) * DK + 64 + lane] = rb;
            }
            if (lane < 16) { COS[(size_t)t * 16 + lane] = cs; SIN[(size_t)t * 16 + lane] = sn; }
        }
    }
}

#define EPI_FENCE() asm volatile("" ::: "memory")
struct EpiQ {
    static constexpr bool PERM = true;
    __device__ __forceinline__ void init(f32x4 (&acc)[2][2][4][2], const Unit&, int, int) const {
#pragma unroll
        for (int a = 0; a < 2; ++a)
#pragma unroll
            for (int b = 0; b < 2; ++b)
#pragma unroll
                for (int m = 0; m < 4; ++m)
#pragma unroll
                    for (int n = 0; n < 2; ++n) acc[a][b][m][n] = (f32x4){0.f, 0.f, 0.f, 0.f};
    }
    bf16_t* Q; float* SSQ; const float* COS; const float* SIN; const float* gq;
    __device__ __forceinline__ void operator()(const f32x4 (&acc)[2][2][4][2], const Unit& u, int wr, int wc, int fr, int fq) const {
        const int t0 = u.pm * 256 + wr * 64 + fr, b = (u.pm * 256) / SEQ, s0 = t0 - b * SEQ;
        if (u.pn < 2) {
            const int h = 4 * u.pn + wc;
            bf16_t* dst0 = Q + ((size_t)(b * NH + h) * SEQ + s0) * DK + 8 * fq;
            float* ssq0 = SSQ + ((size_t)t0 * NH + h) * 2;
#pragma unroll
            for (int ai = 0; ai < 2; ++ai)
#pragma unroll
                for (int m = 0; m < 4; ++m) {
                    const int dr = ai * 128 + m * 16;
                    float q = 0.f;
#pragma unroll
                    for (int bj = 0; bj < 2; ++bj)
#pragma unroll
                        for (int n = 0; n < 2; ++n) { const f32x4 v = acc[ai][bj][m][n]; q += (v[0] * v[0] + v[1] * v[1]) + (v[2] * v[2] + v[3] * v[3]); }
                    q += __shfl_xor(q, 16); q += __shfl_xor(q, 32);
                    if (fq == 0) ssq0[dr * NH * 2] = q;
#pragma unroll
                    for (int bj = 0; bj < 2; ++bj) { const f32x4 v0 = acc[ai][bj][m][0] * *(const f32x4*)(gq + 32 * bj + 8 * fq), v1 = acc[ai][bj][m][1] * *(const f32x4*)(gq + 32 * bj + 8 * fq + 4);
                        u32x4 w; w.x = cvt_pk_bf16(v0[0], v0[1]); w.y = cvt_pk_bf16(v0[2], v0[3]); w.z = cvt_pk_bf16(v1[0], v1[1]); w.w = cvt_pk_bf16(v1[2], v1[3]);
                        *(u32x4*)(dst0 + dr * DK + 32 * bj) = w; }
                    EPI_FENCE();
                }
        } else {
            const f32x4 g1 = *(const f32x4*)(gq + 64 + 4 * fq), g2 = *(const f32x4*)(gq + 80 + 4 * fq);
            const float* cs0 = COS + (size_t)t0 * 16 + 4 * fq; const float* sn0 = SIN + (size_t)t0 * 16 + 4 * fq;
            bf16_t* dst0 = Q + ((size_t)(b * NH + 2 * wc) * SEQ + s0) * DK + 64 + 4 * fq;
            float* ssq0 = SSQ + ((size_t)t0 * NH + 2 * wc) * 2 + 1;
#pragma unroll
            for (int ai = 0; ai < 2; ++ai)
#pragma unroll
                for (int m = 0; m < 4; ++m) {
                    const int dr = ai * 128 + m * 16;
                    const f32x4 cs = *(const f32x4*)(cs0 + dr * 16), sn = *(const f32x4*)(sn0 + dr * 16);
#pragma unroll
                    for (int bj = 0; bj < 2; ++bj) {
                        const f32x4 x1 = acc[ai][bj][m][0], x2 = acc[ai][bj][m][1];
                        float q = (x1[0] * x1[0] + x1[1] * x1[1]) + (x1[2] * x1[2] + x1[3] * x1[3]) + (x2[0] * x2[0] + x2[1] * x2[1]) + (x2[2] * x2[2] + x2[3] * x2[3]);
                        q += __shfl_xor(q, 16); q += __shfl_xor(q, 32);
                        if (fq == 0) ssq0[dr * NH * 2 + bj * 2] = q;
                        const f32x4 y1 = x1 * g1, y2 = x2 * g2;
                        const f32x4 o1 = y1 * cs - y2 * sn, o2 = y2 * cs + y1 * sn;
                        bf16_t* dst = dst0 + (size_t)bj * SEQ * DK + dr * DK;
                        u32x2 w1, w2; w1.x = cvt_pk_bf16(o1[0], o1[1]); w1.y = cvt_pk_bf16(o1[2], o1[3]); w2.x = cvt_pk_bf16(o2[0], o2[1]); w2.y = cvt_pk_bf16(o2[2], o2[3]);
                        *(u32x2*)(dst) = w1; *(u32x2*)(dst + 16) = w2;
                    }
                    EPI_FENCE();
                }
        }
    }
};
struct EpiKV {
    static constexpr bool PERM = true;
    __device__ __forceinline__ void init(f32x4 (&acc)[2][2][4][2], const Unit&, int, int) const {
#pragma unroll
        for (int a = 0; a < 2; ++a)
#pragma unroll
            for (int b = 0; b < 2; ++b)
#pragma unroll
                for (int m = 0; m < 4; ++m)
#pragma unroll
                    for (int n = 0; n < 2; ++n) acc[a][b][m][n] = (f32x4){0.f, 0.f, 0.f, 0.f};
    }
    bf16_t* K; bf16_t* V; const float* gk;
    __device__ __forceinline__ void operator()(const f32x4 (&acc)[2][2][4][2], const Unit& u, int wr, int wc, int fr, int fq) const {
        const int t0 = u.pm * 256 + wr * 64 + fr, b = (u.pm * 256) / SEQ, s0 = t0 - b * SEQ;
        const int h = 2 * u.pn + (wc & 1); const bool isv = wc >= 2;
        const int pitch = isv ? DV : DK;
        bf16_t* dst0 = (isv ? V : K) + ((size_t)(b * NH + h) * SEQ + s0) * pitch + 8 * fq;
#pragma unroll
        for (int ai = 0; ai < 2; ++ai)
#pragma unroll
            for (int m = 0; m < 4; ++m) {
                const int dr = ai * 128 + m * 16;
                float sc = 1.f;
                if (!isv) { float q = 0.f;
#pragma unroll
                    for (int bj = 0; bj < 2; ++bj)
#pragma unroll
                        for (int n = 0; n < 2; ++n) { const f32x4 v = acc[ai][bj][m][n]; q += (v[0] * v[0] + v[1] * v[1]) + (v[2] * v[2] + v[3] * v[3]); }
                    q += __shfl_xor(q, 16); q += __shfl_xor(q, 32);
                    sc = 1.0f / sqrtf(q * (1.f / 64.f) + EPS); }
#pragma unroll
                for (int bj = 0; bj < 2; ++bj) {
                    f32x4 v0 = acc[ai][bj][m][0] * sc, v1 = acc[ai][bj][m][1] * sc;
                    if (!isv) { v0 = v0 * *(const f32x4*)(gk + 32 * bj + 8 * fq); v1 = v1 * *(const f32x4*)(gk + 32 * bj + 8 * fq + 4); }
                    u32x4 w; w.x = cvt_pk_bf16(v0[0], v0[1]); w.y = cvt_pk_bf16(v0[2], v0[3]); w.z = cvt_pk_bf16(v1[0], v1[1]); w.w = cvt_pk_bf16(v1[2], v1[3]);
                    *(u32x4*)(dst0 + dr * pitch + 32 * bj) = w; }
                EPI_FENCE();
            }
    }
};

namespace att {
constexpr int KT_BYTES = 64 * 192, VT_BYTES = 64 * 128, SLOT_BYTES = KT_BYTES + VT_BYTES;
#ifndef ATT_PF
#define ATT_PF 3
#endif
constexpr int NSLOT = ATT_PF + 1, SCR_OFF = NSLOT * SLOT_BYTES;
__device__ __forceinline__ int crow(int r, int hi) { return (r & 3) + 8 * (r >> 2) + 4 * hi; }
__device__ __forceinline__ s16x4 vtr(const LAS unsigned char* p) { typedef short v4i16_t __attribute__((ext_vector_type(4)));
    return __builtin_bit_cast(s16x4, __builtin_amdgcn_ds_read_tr16_b64_v4i16((LAS v4i16_t*)p)); }
#define MFMA32(a, b, c) __builtin_amdgcn_mfma_f32_32x32x16_bf16(a, b, c, 0, 0, 0)
__device__ __forceinline__ float max3f(float a, float b, float c) { return __builtin_fmaxf(__builtin_fmaxf(a, b), c); }


constexpr int CONV_OFF = SCR_OFF + 8 * 256, CONV_BYTES = 8192;
constexpr int CV_GU_ITEMS = NEXP * 1024, CV_ITEMS = CV_GU_ITEMS + NEXP * 512;
struct ConvItem { const float* src; unsigned char* dst; int N, isgu, n0; };
__device__ __forceinline__ ConvItem cv_setup(int g, const float* wgu, const float* wd, unsigned char* wgu8, unsigned char* wd8) {
    ConvItem I;
    if (g < CV_GU_ITEMS) { const int e = g >> 10, it = g & 1023, kb = it >> 6, nb = it & 63; I.N = 2048; I.isgu = 1; I.n0 = 32 * nb;
        I.src = wgu + (size_t)e * 1024 * 2048 + (size_t)(64 * kb) * 2048 + 32 * nb; I.dst = wgu8 + (size_t)e * 2048 * 1024 + 64 * kb; }
    else { const int g2 = g - CV_GU_ITEMS, e = g2 >> 9, it = g2 & 511, kb = it >> 5, nb = it & 31; I.N = 1024; I.isgu = 0; I.n0 = 32 * nb;
        I.src = wd + (size_t)e * 1024 * 1024 + (size_t)(64 * kb) * 1024 + 32 * nb; I.dst = wd8 + (size_t)e * 1024 * 1024 + 64 * kb; }
    return I;
}
__device__ __forceinline__ void cv_dma(const ConvItem& I, unsigned ldsaddr, int lane) {
    const int kr = lane >> 3, sl = lane & 7;
#pragma unroll
    for (int q = 0; q < 8; ++q) { const unsigned voff = (unsigned)(((8 * q + kr) * I.N + 4 * (sl ^ ((kr ^ q) & 7))) * 4);
        asm volatile("s_nop 4\n\ts_mov_b32 m0, %0\n\ts_nop 0\n\tglobal_load_lds_dwordx4 %1, %2" :: "s"(ldsaddr + (unsigned)q * 1024u), "v"(voff), "s"(I.src) : "m0", "memory"); }
}
__device__ __forceinline__ void cv_out(const ConvItem& I, const LAS float* cb, int lane) {
    asm volatile("" : "+v"(lane));
    const int c = lane & 7;
#pragma unroll
    for (int j = 0; j < 4; ++j) { const int n = (lane >> 3) + 8 * j, nc = n >> 2, e = n & 3;
        float f[8];
#pragma unroll
        for (int kk = 0; kk < 8; ++kk) f[kk] = cb[(8 * c + kk) * 32 + ((nc ^ kk ^ c) & 7) * 4 + e];
        const int nn = I.n0 + n; const int row = I.isgu ? (256 * ((nn & 1023) >> 7) + 128 * (nn >> 10) + (nn & 127)) : nn;
        *(u32x2*)(I.dst + (size_t)row * 1024 + 8 * c) = cvt8_fp8((f32x4){f[0], f[1], f[2], f[3]}, (f32x4){f[4], f[5], f[6], f[7]}, 8.0f);
        asm volatile("" ::: "memory"); }
}
struct ConvState { int next, end, cur; };
__device__ __forceinline__ void attn_unit(LAS unsigned char* lds, const u32x4 srd, ConvState& CV, unsigned char* cvws, int bh, int qb, const bf16_t* Q_, unsigned Koff, unsigned Voff, const float* SSQ_, bf16_t* O_, const bool fast) {
    (void)Q_; (void)SSQ_; (void)O_;
    unsigned char* wl_ = cvws; asm volatile("" : "+s"(wl_));
    const bf16_t* Q = (const bf16_t*)(wl_ + WS_Q); const float* SSQ = (const float*)(wl_ + WS_SSQ); bf16_t* O = (bf16_t*)(wl_ + WS_ATT);
    const int tid = tid_local(), lane = tid & 63, r32 = lane & 31, hi = lane >> 5; const int wid = __builtin_amdgcn_readfirstlane(tid >> 6);
    const int b = bh / NH, h = bh % NH, q0 = qb * 256, qw = q0 + 32 * wid;
    LAS float* scr = (LAS float*)(lds + SCR_OFF) + wid * 64;
    const int NT = (q0 + 256) / 64;
    const unsigned kS = Koff + (unsigned)bh * (SEQ * DK * 2), vS = Voff + (unsigned)bh * (SEQ * DV * 2);
    const int kc2 = 8 + (wid & 3);
    const unsigned vK1 = (unsigned)(lane * 192 + wid * 16); const unsigned sK2 = (unsigned)((kc2 - wid) * 16);
    const int vkey = 8 * wid + (lane >> 3); const unsigned vV = (unsigned)(vkey * 128 + (((lane & 7) ^ (((vkey >> 1) & 1) * 4)) * 16));
    const unsigned lds0 = (unsigned)__builtin_amdgcn_readfirstlane((int)(unsigned)(unsigned long)lds);
    const unsigned dK1 = (unsigned)wid * 1024u, dK2 = (unsigned)kc2 * 1024u, dV = (unsigned)KT_BYTES + (unsigned)wid * 1024u;
#define ATT_DMA1(ldsaddr, voff, soff) asm volatile("s_nop 4\n\ts_mov_b32 m0, %0\n\ts_nop 0\n\tbuffer_load_dwordx4 %1, %2, %3 offen lds" :: "s"(ldsaddr), "v"(voff), "s"(srd), "s"(soff) : "m0", "memory")
#define ATT_DMA(t) do { const unsigned sp_ = lds0 + (unsigned)((t) % NSLOT) * SLOT_BYTES; const unsigned ks_ = kS + (unsigned)(t) * (64 * 192), vs_ = vS + (unsigned)(t) * (64 * 128); \
        ATT_DMA1(sp_ + dK1, vK1, ks_); ATT_DMA1(sp_ + dK2, vK1, ks_ + sK2); ATT_DMA1(sp_ + dV, vV, vs_); } while (0)
#define ATT_WAITBAR(N) asm volatile("s_waitcnt vmcnt(" #N ") lgkmcnt(0)\n\ts_barrier" ::: "memory")
    bf16x8 qr[6];
    { const float* sp = SSQ + ((size_t)(b * SEQ + qw + r32) * NH + h) * 2; const float ss = sp[0] + sp[1];
      const float cq = (1.0f / sqrtf(ss * (1.f / 96.f) + EPS)) * 0.10206207261596577f * 1.4426950408889634f;
      const bf16_t* qp = Q + ((size_t)bh * SEQ + qw + r32) * DK + 8 * hi;
      u32x4 qw_[6];
#pragma unroll
      for (int d0 = 0; d0 < 6; ++d0) qw_[d0] = *(const u32x4*)(qp + 16 * d0);
#pragma unroll
      for (int d0 = 0; d0 < 6; ++d0) { const u32x4 w = qw_[d0]; u32x4 o;
          o.x = cvt_pk_bf16(bf_lo(w.x) * cq, bf_hi(w.x) * cq); o.y = cvt_pk_bf16(bf_lo(w.y) * cq, bf_hi(w.y) * cq); o.z = cvt_pk_bf16(bf_lo(w.z) * cq, bf_hi(w.z) * cq); o.w = cvt_pk_bf16(bf_lo(w.w) * cq, bf_hi(w.w) * cq);
          qr[d0] = __builtin_bit_cast(bf16x8, o); } }
    ATT_DMA(0); ATT_DMA(1); ATT_DMA(2); if (ATT_PF == 4) ATT_DMA(3);
    const int kbase = hi * 1024 + r32 * 16;
    const int qq = (lane & 15) >> 2, pp = lane & 3, dblk = (lane >> 4) & 1, swz = ((qq >> 1) & 1) * 64;
    const int vrow0 = 4 * hi + qq;
    const int vb0 = KT_BYTES + vrow0 * 128 + ((32 * dblk + 8 * pp) ^ swz);
    const int vb1 = KT_BYTES + vrow0 * 128 + ((64 + 32 * dblk + 8 * pp) ^ swz);
    f32x16 o0 = {}, o1 = {};
    float m_run = -1e30f, l_run = 0.f; const f32x16 zero16 = {};
    const int qa = qw + r32;
#define ATT_QK(N0, N1, t) do { const LAS unsigned char* kp_ = lds + ((t) % NSLOT) * SLOT_BYTES + kbase; \
        _Pragma("unroll") for (int d0 = 0; d0 < 6; ++d0) { const bf16x8 ka_ = *(const LAS bf16x8*)(kp_ + d0 * 2048), kb_ = *(const LAS bf16x8*)(kp_ + d0 * 2048 + 512); \
            if (d0 == 0) { N0 = MFMA32(ka_, qr[0], zero16); N1 = MFMA32(kb_, qr[0], zero16); } else { N0 = MFMA32(ka_, qr[d0], N0); N1 = MFMA32(kb_, qr[d0], N1); } } } while (0)
#define ATT_MASK(N0, N1, t) do { const int kb_ = 64 * (t); if (kb_ + 63 > qw) { int d_ = qa - kb_ - 4 * hi; asm volatile("" : "+v"(d_));        \
        _Pragma("unroll") for (int r = 0; r < 16; ++r) { const int c_ = (r & 3) + 8 * (r >> 2); \
        if (c_ > d_) N0[r] = -__builtin_inff(); if (c_ + 32 > d_) N1[r] = -__builtin_inff(); } } } while (0)
#define ATT_ROWMAX(N0, N1, PM) do { float a_ = max3f(N0[0], N0[1], N1[0]), b_ = max3f(N0[2], N0[3], N1[1]); a_ = max3f(a_, N1[2], N1[3]); \
        _Pragma("unroll") for (int r = 4; r < 16; r += 4) { a_ = max3f(a_, N0[r], N0[r + 1]); b_ = max3f(b_, N0[r + 2], N0[r + 3]); a_ = max3f(a_, N1[r], N1[r + 1]); b_ = max3f(b_, N1[r + 2], N1[r + 3]); } \
        a_ = max3f(a_, b_, b_); auto rr_ = __builtin_amdgcn_permlane32_swap(__float_as_uint(a_), __float_as_uint(a_), false, false); \
        PM = max3f(__uint_as_float(rr_[0]), __uint_as_float(rr_[1]), __uint_as_float(rr_[1])); } while (0)
#define ATT_DECIDE(PM, C0, C1, FORCE) do { if ((FORCE) || __any((PM) > m_run + 8.0f)) { const float mn_ = fmaxf(m_run, (PM)); const float al_ = __builtin_amdgcn_exp2f(m_run - mn_); m_run = mn_; l_run *= al_; \
        if (hi == 0) scr[r32] = al_; asm volatile("s_waitcnt lgkmcnt(0)" ::: "memory"); \
        _Pragma("unroll") for (int a4 = 0; a4 < 4; ++a4) { const f32x4 f_ = *(const LAS f32x4*)(scr + 8 * a4 + 4 * hi); \
            _Pragma("unroll") for (int e = 0; e < 4; ++e) { o0[4 * a4 + e] *= f_[e]; o1[4 * a4 + e] *= f_[e]; } } } } while (0)
#define ATT_SM_HALF(P_, ks0, SUBM) do { _Pragma("unroll") for (int r = 0; r < 16; ++r) { P_[r] = __builtin_amdgcn_exp2f((SUBM) ? P_[r] - m_run : P_[r]); ps_ += P_[r]; } \
        _Pragma("unroll") for (int kq = 0; kq < 2; ++kq) { const int bs_ = 8 * kq; \
            u32x4 w_; w_.x = cvt_pk_bf16(P_[bs_ + 0], P_[bs_ + 1]); w_.y = cvt_pk_bf16(P_[bs_ + 2], P_[bs_ + 3]); w_.z = cvt_pk_bf16(P_[bs_ + 4], P_[bs_ + 5]); w_.w = cvt_pk_bf16(P_[bs_ + 6], P_[bs_ + 7]); \
            pa[(ks0) + kq] = __builtin_bit_cast(bf16x8, w_); } } while (0)
#define ATT_SOFTMAX(C0, C1) do { float ps_ = 0.f; ATT_SM_HALF(C0, 0, true); ATT_SM_HALF(C1, 2, true); l_run += ps_; } while (0)
#define ATT_SOFTMAX_F(C0, C1) do { float ps_ = 0.f; ATT_SM_HALF(C0, 0, false); ATT_SM_HALF(C1, 2, false); l_run += ps_; } while (0)
#define ATT_PV(t) do { const LAS unsigned char* vp0_ = lds + ((t) % NSLOT) * SLOT_BYTES + vb0; const LAS unsigned char* vp1_ = lds + ((t) % NSLOT) * SLOT_BYTES + vb1; \
        _Pragma("unroll") for (int ks = 0; ks < 4; ++ks) { \
            const s16x4 a0_ = vtr(vp0_ + ks * 16 * 128), a1_ = vtr(vp0_ + ks * 16 * 128 + 8 * 128), c0_ = vtr(vp1_ + ks * 16 * 128), c1_ = vtr(vp1_ + ks * 16 * 128 + 8 * 128); \
            const bf16x8 vf0_ = {a0_[0], a0_[1], a0_[2], a0_[3], a1_[0], a1_[1], a1_[2], a1_[3]}; const bf16x8 vf1_ = {c0_[0], c0_[1], c0_[2], c0_[3], c1_[0], c1_[1], c1_[2], c1_[3]}; \
            o0 = MFMA32(pa[ks], vf0_, o0); o1 = MFMA32(pa[ks], vf1_, o1); } } while (0)
#ifdef ATT_PROBE2
    unsigned long long ap_s[4] = {0, 0, 0, 0}, ap_acc[3] = {0, 0, 0};
#define AP_STAMP(k) do { __builtin_amdgcn_sched_barrier(0); asm volatile("s_memtime %0\n\ts_waitcnt lgkmcnt(0)" : "=s"(ap_s[k]) :: "memory"); __builtin_amdgcn_sched_barrier(0); if ((k) > 0) ap_acc[(k) - 1] += ap_s[k] - ap_s[(k) - 1]; } while (0)
#else
#define AP_STAMP(k) do {} while (0)
#endif
#define ATT_WB(N) asm volatile("s_waitcnt vmcnt(" #N ") lgkmcnt(0)\n\ts_barrier" ::: "memory")
#define ATT_RDK(d0) do { kf_[d0][0] = *(const LAS bf16x8*)(kp_ + (d0) * 2048); kf_[d0][1] = *(const LAS bf16x8*)(kp_ + (d0) * 2048 + 512); } while (0)
#define ATT_RDV(ks) do { vf_[ks][0] = vtr(vp0_ + (ks) * 16 * 128); vf_[ks][1] = vtr(vp0_ + (ks) * 16 * 128 + 8 * 128); vf_[ks][2] = vtr(vp1_ + (ks) * 16 * 128); vf_[ks][3] = vtr(vp1_ + (ks) * 16 * 128 + 8 * 128); } while (0)
#define ATT_MK(d0) do { if ((d0) == 0) { S0 = MFMA32(kf_[0][0], qr[0], zero16); S1 = MFMA32(kf_[0][1], qr[0], zero16); } else { S0 = MFMA32(kf_[d0][0], qr[d0], S0); S1 = MFMA32(kf_[d0][1], qr[d0], S1); } } while (0)
#define ATT_MV(ks) do { const bf16x8 v0_ = {vf_[ks][0][0], vf_[ks][0][1], vf_[ks][0][2], vf_[ks][0][3], vf_[ks][1][0], vf_[ks][1][1], vf_[ks][1][2], vf_[ks][1][3]}; \
        const bf16x8 v1_ = {vf_[ks][2][0], vf_[ks][2][1], vf_[ks][2][2], vf_[ks][2][3], vf_[ks][3][0], vf_[ks][3][1], vf_[ks][3][2], vf_[ks][3][3]}; \
        o0 = MFMA32(pa[ks], v0_, o0); o1 = MFMA32(pa[ks], v1_, o1); } while (0)
#define ATT_SB __builtin_amdgcn_sched_barrier(0)
#define ATT_SEGA(j, DODMA) do { \
        const LAS unsigned char* kp_ = lds + (((j) + 1) % NSLOT) * SLOT_BYTES + kbase; \
        const LAS unsigned char* vp0_ = lds + ((j) % NSLOT) * SLOT_BYTES + vb0; const LAS unsigned char* vp1_ = lds + ((j) % NSLOT) * SLOT_BYTES + vb1; \
        bf16x8 kf_[6][2]; s16x4 vf_[4][4]; \
        ATT_RDK(0); ATT_RDK(1); ATT_RDV(0); ATT_SB; \
        if (DODMA) { ATT_DMA((j) + ATT_PF); } ATT_SB; \
        ATT_MK(0); ATT_SB; ATT_RDK(2); ATT_SB; ATT_MK(1); ATT_SB; ATT_RDK(3); ATT_SB; ATT_MV(0); ATT_SB; ATT_RDV(1); ATT_SB; \
        ATT_MK(2); ATT_SB; ATT_RDK(4); ATT_SB; ATT_MK(3); ATT_SB; ATT_RDV(2); ATT_SB; ATT_MV(1); ATT_SB; ATT_RDK(5); ATT_SB; \
        ATT_MK(4); ATT_SB; ATT_MV(2); ATT_SB; ATT_RDV(3); ATT_SB; ATT_MK(5); ATT_MV(3); } while (0)
#define ATT_BARP asm volatile("s_waitcnt lgkmcnt(0)\n\ts_barrier" ::: "memory")
#define ATT_STEP(j, MSK, CONV, FAST) do { \
        if (MSK) ATT_MASK(S0, S1, (j)); \
        if (!(FAST)) { float pm_; ATT_ROWMAX(S0, S1, pm_); ATT_DECIDE(pm_, S0, S1, false); } \
        if (FAST) ATT_SOFTMAX_F(S0, S1); else ATT_SOFTMAX(S0, S1); \
        int infl_ = 0; \
        if (CONV) { __builtin_amdgcn_sched_barrier(0); const LAS float* cb_ = (const LAS float*)(lds + CONV_OFF + wid * CONV_BYTES); \
            if (CV.cur >= 0) { const ConvItem I_ = cv_setup(CV.cur, kargs()->in[I_WGU], kargs()->in[I_WD], cvws + WS_WGU, cvws + WS_WD); cv_out(I_, cb_, lane); infl_ += 4; } \
            if (CV.next < CV.end) { const ConvItem I_ = cv_setup(CV.next, kargs()->in[I_WGU], kargs()->in[I_WD], cvws + WS_WGU, cvws + WS_WD); asm volatile("s_waitcnt lgkmcnt(0)" ::: "memory"); \
                cv_dma(I_, lds0 + (unsigned)(CONV_OFF + wid * CONV_BYTES), lane); CV.cur = CV.next; CV.next += 2048; infl_ += 8; } else CV.cur = -1; } \
        __builtin_amdgcn_sched_barrier(0); ATT_BARP; __builtin_amdgcn_sched_barrier(0); \
        ATT_SEGA((j), ((j) + ATT_PF < NT)); if ((j) + ATT_PF < NT) infl_ += 3; \
        __builtin_amdgcn_sched_barrier(0); \
        if (!(CONV)) { if (infl_ == 3) ATT_WB(3); else ATT_WB(0); } \
        else switch (infl_) { case 15: ATT_WB(15); break; case 12: ATT_WB(12); break; case 11: ATT_WB(11); break; case 8: ATT_WB(8); break; case 7: ATT_WB(7); break; case 4: ATT_WB(4); break; case 3: ATT_WB(3); break; default: ATT_WB(0); break; } \
        __builtin_amdgcn_sched_barrier(0); } while (0)
    bf16x8 pa[4];
    f32x16 S0, S1;
    const bool grpY = wid >= 4;
    ATT_WAITBAR(6);
    if (grpY) ATT_BARP;
    __builtin_amdgcn_sched_barrier(0);
    ATT_QK(S0, S1, 0);
    __builtin_amdgcn_sched_barrier(0);
    ATT_WAITBAR(3);
    __builtin_amdgcn_sched_barrier(0);
    int j = 0;
    if (fast) {
        for (; j < NT - 4; j += 2) {
            ATT_STEP(j, false, CONV_IN_ATTN, true);
            ATT_STEP(j + 1, false, false, true);
        }
        for (; j < NT; j += 2) {
            ATT_STEP(j, true, CONV_IN_ATTN, true);
            ATT_STEP(j + 1, true, false, true);
        }
    } else {
        for (; j < NT - 4; j += 2) {
            ATT_STEP(j, false, CONV_IN_ATTN, false);
            ATT_STEP(j + 1, false, false, false);
        }
        for (; j < NT; j += 2) {
            ATT_STEP(j, true, CONV_IN_ATTN, false);
            ATT_STEP(j + 1, true, false, false);
        }
    }
    if (!grpY) ATT_BARP;
    __builtin_amdgcn_sched_barrier(0);
#ifdef ATT_PROBE2
    if (blockIdx.x == 17 && tid == 0) { unsigned long long* ap2 = (unsigned long long*)(cvws + WS_CTL + 65536 + 128); ap2[0] += ap_acc[0]; ap2[1] += ap_acc[1]; ap2[2] += ap_acc[2]; ap2[3] += (unsigned long long)NT; }
#endif
#ifdef ATT_PROBE
    if (blockIdx.x == 17 && tid == 0) { unsigned long long* ap = (unsigned long long*)(cvws + WS_CTL + 65536 + 64); ap[0] += __builtin_amdgcn_s_memtime() - ap_t0; ap[1] += (unsigned long long)NT; }
#endif
#undef ATT_DMA
#undef ATT_DMA1
#undef ATT_WAITBAR
#undef ATT_QK
#undef ATT_MASK
#undef ATT_ROWMAX
#undef ATT_DECIDE
#undef ATT_SOFTMAX
#undef ATT_SOFTMAX_F
#undef ATT_SM_HALF
#undef ATT_PV
#undef ATT_STEP
#undef ATT_WB
#undef ATT_BARP
#undef ATT_SEGA
#undef ATT_RDK
#undef ATT_RDV
#undef ATT_MK
#undef ATT_MV
#undef ATT_SB
#undef AP_STAMP
    { auto rr = __builtin_amdgcn_permlane32_swap(__float_as_uint(l_run), __float_as_uint(l_run), false, false); l_run = __uint_as_float(rr[0]) + __uint_as_float(rr[1]); }
    if (hi == 0) scr[32 + r32] = 1.0f / l_run;
    asm volatile("s_waitcnt lgkmcnt(0)" ::: "memory");
    bf16_t* Ow = O + ((size_t)(b * SEQ + qw)) * 512 + h * 64 + r32;
#pragma unroll
    for (int a4 = 0; a4 < 4; ++a4) { const f32x4 f = *(const LAS f32x4*)(scr + 32 + 8 * a4 + 4 * hi);
#pragma unroll
        for (int e = 0; e < 4; ++e) { const int r = 4 * a4 + e; const int row = crow(r, hi);
            Ow[(size_t)row * 512] = (bf16_t)(cvt_pk_bf16(o0[r] * f[e], 0.f) & 0xffffu);
            Ow[(size_t)row * 512 + 32] = (bf16_t)(cvt_pk_bf16(o1[r] * f[e], 0.f) & 0xffffu); } }
    __syncthreads();
}
#undef MFMA32
}

struct MixOrder {
    int G, c; unsigned ATT, MIXED, WAO, WPO;
    __device__ __forceinline__ bool next(int i, Unit& u) const {
        const int tile = (i >> 1) * G + c; if (tile >= 256) return false;
        u.pm = tile >> 2; u.pn = tile & 3; u.aux = i & 1; return true;
    }
    __device__ __forceinline__ void prefetch(const Unit&, const __amdgpu_buffer_rsrc_t, LAS unsigned char*, int, int) const {}
    __device__ __forceinline__ unsigned a_off(const Unit& u) const { return (u.aux ? MIXED : ATT) + (unsigned)u.pm * (256 * 512 * 2); }
    __device__ __forceinline__ unsigned b_off(const Unit& u) const { return (u.aux ? WPO : WAO) + (unsigned)u.pn * (256 * 512 * 2); }
};
struct EpiMix {
    static constexpr bool PERM = true;
    __device__ __forceinline__ void init(f32x4 (&acc)[2][2][4][2], const Unit& u, int, int) const {
        if (u.aux) return;
#pragma unroll
        for (int a = 0; a < 2; ++a)
#pragma unroll
            for (int b = 0; b < 2; ++b)
#pragma unroll
                for (int m = 0; m < 4; ++m)
#pragma unroll
                    for (int n = 0; n < 2; ++n) acc[a][b][m][n] = (f32x4){0.f, 0.f, 0.f, 0.f};
    }
    bf16_t* MIX; const bf16_t* GATES;
    __device__ __forceinline__ void operator()(f32x4 (&acc)[2][2][4][2], const Unit& u, int wr, int wc, int fr, int fq) const {
        const int row0 = u.pm * 256 + wr * 64 + fr, col0 = u.pn * 256 + wc * 32 + 8 * fq;
        const bool p0_ = u.aux == 0;
#if GATE8
        typedef u32x2 gv_t; const unsigned char* gb_ = (const unsigned char*)GATES + (size_t)row0 * 2048 + col0;
#define EM_LD1(p) (*(const u32x2*)(p))
#define EM_DEC(GW_, lo, hi) do { const gv_t t_ = (GW_); const f32x2 a_ = __builtin_amdgcn_cvt_pk_f32_fp8((int)t_.x, false), b_ = __builtin_amdgcn_cvt_pk_f32_fp8((int)t_.x, true), c_ = __builtin_amdgcn_cvt_pk_f32_fp8((int)t_.y, false), d_ = __builtin_amdgcn_cvt_pk_f32_fp8((int)t_.y, true); \
        lo = (f32x4){a_[0], a_[1], b_[0], b_[1]}; hi = (f32x4){c_[0], c_[1], d_[0], d_[1]}; } while (0)
        constexpr size_t GROW = 2048, GHALF = 1024, GBJ = 128; constexpr float GSC = 1.0f / 256.0f;
#else
        typedef u32x4 gv_t; const bf16_t* gb_ = GATES + (size_t)row0 * 2048 + col0;
#define EM_LD1(p) (*(const u32x4*)(p))
#define EM_DEC(GW_, lo, hi) do { const gv_t t_ = (GW_); lo = (f32x4){bf_lo(t_.x), bf_hi(t_.x), bf_lo(t_.y), bf_hi(t_.y)}; hi = (f32x4){bf_lo(t_.z), bf_hi(t_.z), bf_lo(t_.w), bf_hi(t_.w)}; } while (0)
        constexpr size_t GROW = 2048, GHALF = 1024, GBJ = 128; constexpr float GSC = 1.0f;
#endif
        gv_t buf[3][4];
#define EM_LD(g) do { const auto* p_ = gb_ + (size_t)(((g) >> 2) * 128 + ((g) & 3) * 16) * GROW; \
        _Pragma("unroll") for (int bj = 0; bj < 2; ++bj) { buf[(g) % 3][2 * bj] = EM_LD1(p_ + GHALF + bj * GBJ); if (p0_) buf[(g) % 3][2 * bj + 1] = EM_LD1(p_ + bj * GBJ); } } while (0)
        EM_LD(0); EM_LD(1); EM_LD(2);
#pragma unroll
        for (int g = 0; g < 8; ++g) { const int ai = g >> 2, m = g & 3; const size_t row = (size_t)(row0 + ai * 128 + m * 16);
            __builtin_amdgcn_sched_barrier(0);
#pragma unroll
            for (int bj = 0; bj < 2; ++bj) { f32x4 p0, p1; EM_DEC(buf[g % 3][2 * bj], p0, p1);
                if (p0_) { f32x4 a0, a1; EM_DEC(buf[g % 3][2 * bj + 1], a0, a1);
#pragma unroll
                    for (int e = 0; e < 4; ++e) { acc[ai][bj][m][0][e] *= a0[e] * __builtin_amdgcn_rcpf(p0[e]); acc[ai][bj][m][1][e] *= a1[e] * __builtin_amdgcn_rcpf(p1[e]); }
                } else {
                    const f32x4 v0 = acc[ai][bj][m][0] * (p0 * GSC), v1 = acc[ai][bj][m][1] * (p1 * GSC);
                    u32x4 w; w.x = cvt_pk_bf16(v0[0], v0[1]); w.y = cvt_pk_bf16(v0[2], v0[3]); w.z = cvt_pk_bf16(v1[0], v1[1]); w.w = cvt_pk_bf16(v1[2], v1[3]);
                    *(u32x4*)(MIX + row * 1024 + col0 + bj * 128) = w; } }
            __builtin_amdgcn_sched_barrier(0);
            if (g + 3 < 8) EM_LD(g + 3);
        }
#undef EM_LD
#undef EM_LD1
#undef EM_DEC
    }
};
struct EpiRes {
    static constexpr bool PERM = false;
    __device__ __forceinline__ void init(f32x4 (&acc)[2][2][4][2], const Unit&, int, int) const {
#pragma unroll
        for (int a = 0; a < 2; ++a)
#pragma unroll
            for (int b = 0; b < 2; ++b)
#pragma unroll
                for (int m = 0; m < 4; ++m)
#pragma unroll
                    for (int n = 0; n < 2; ++n) acc[a][b][m][n] = (f32x4){0.f, 0.f, 0.f, 0.f};
    }
    const float* base; bf16_t* out;
    __device__ __forceinline__ void operator()(const f32x4 (&acc)[2][2][4][2], const Unit& u, int wr, int wc, int fr, int fq) const {
        const int row0 = u.pm * 256 + wr * 64 + fr, col0 = u.pn * 256 + wc * 32 + 4 * fq;
        const size_t off0 = (size_t)row0 * DM + col0;
        f32x4 buf[3][4];
#define ER_LD(g) do { const float* p_ = base + off0 + (size_t)(((g) >> 2) * 128 + ((g) & 3) * 16) * DM; \
        _Pragma("unroll") for (int q = 0; q < 4; ++q) buf[(g) % 3][q] = *(const f32x4*)(p_ + (q >> 1) * 128 + (q & 1) * 16); } while (0)
        ER_LD(0); ER_LD(1); ER_LD(2);
#pragma unroll
        for (int g = 0; g < 8; ++g) { const int ai = g >> 2, m = g & 3;
            __builtin_amdgcn_sched_barrier(0);
            bf16_t* o_ = out + off0 + (size_t)(ai * 128 + m * 16) * DM;
#pragma unroll
            for (int q = 0; q < 4; ++q) { const f32x4 r = buf[g % 3][q] + acc[ai][q >> 1][m][q & 1]; u32x2 w; w.x = cvt_pk_bf16(r[0], r[1]); w.y = cvt_pk_bf16(r[2], r[3]); *(u32x2*)(o_ + (q >> 1) * 128 + (q & 1) * 16) = w; }
            __builtin_amdgcn_sched_barrier(0);
            if (g + 3 < 8) ER_LD(g + 3);
        }
#undef ER_LD
    }
};

constexpr int WR_PITCH = 1028;
constexpr int R_WR_OFF = 0, R_PART_OFF = 32 * WR_PITCH * 4, R_SSQ_OFF = R_PART_OFF + 2 * 64 * 33 * 4, R_CNT_OFF = R_SSQ_OFF + 2 * 64 * 4, R_BASE_OFF = R_CNT_OFF + 128, R_RSTD_OFF = R_BASE_OFF + 128, R_END = R_RSTD_OFF + 256;
static_assert(R_END <= TILE_E_OFF, "router LDS map");
__device__ __forceinline__ void p7_router(const Frame& F) {
    const int tid_l = tid_local(), lane_l = tid_l & 63; (void)tid_l; (void)lane_l;
    const KArgs a = kargs();
    LAS float* WR = (LAS float*)(F.lds + R_WR_OFF); LAS float* PART = (LAS float*)(F.lds + R_PART_OFF); LAS float* SSQP = (LAS float*)(F.lds + R_SSQ_OFF);
    LAS int* CNT = (LAS int*)(F.lds + R_CNT_OFF); LAS int* BASE = (LAS int*)(F.lds + R_BASE_OFF); LAS float* RSTD_L = (LAS float*)(F.lds + R_RSTD_OFF);
    const int tid = tid_l, lane = lane_l, wave = F.wave;
    const float* wr = a->in[I_WR]; const float* gf = a->in[I_GFFN];
    {
        const f32x4* wr4 = (const f32x4*)wr; f32x4 w[16]; float g[16];
#pragma unroll
        for (int q = 0; q < 16; ++q) { const int idx = tid + 512 * q; w[q] = wr4[idx]; g[q] = gf[idx >> 3]; }
#pragma unroll
        for (int q = 0; q < 16; ++q) { const int idx = tid + 512 * q; const int k = idx >> 3, e0 = (idx & 7) * 4;
#pragma unroll
            for (int j = 0; j < 4; ++j) WR[(e0 + j) * WR_PITCH + k] = w[q][j] * g[q]; }
    }
    if (tid < 32) CNT[tid] = 0;
    __syncthreads();
    int* RE = (int*)(F.ws + WS_ROUTE); int* RP = RE + T * 4; float* RG = (float*)(RP + T * 4); float* RS = RG + T * 4; int* TOK = (int*)(F.ws + WS_TOK); unsigned char* H8 = F.ws + WS_XS2;
    unsigned* gcnt = F.ctl + CW_CNT;
    const bf16_t* X1 = (const bf16_t*)(F.ws + WS_X1B);
    for (int blk = F.vcu; blk < T / 64; blk += F.G) {
        const int tb = blk * 64;
        {
            const int tg = wave & 3, kh = wave >> 2, r = lane & 15, kq = lane >> 4;
            const bf16_t* xp = X1 + (size_t)(tb + 16 * tg + r) * DM + 512 * kh + 4 * kq;
            const LAS float* w0 = WR + (lane & 15) * WR_PITCH + 512 * kh + 4 * kq; const LAS float* w1 = w0 + 16 * WR_PITCH;
            f32x4 acc0 = {0.f, 0.f, 0.f, 0.f}, acc1 = {0.f, 0.f, 0.f, 0.f}; float ss = 0.f;
#pragma unroll 4
            for (int i = 0; i < 32; ++i) {
                const u32x2 xw = *(const u32x2*)(xp + 16 * i); const f32x4 xv = {bf_lo(xw.x), bf_hi(xw.x), bf_lo(xw.y), bf_hi(xw.y)};
                const f32x4 b0 = *(const LAS f32x4*)(w0 + 16 * i), b1 = *(const LAS f32x4*)(w1 + 16 * i);
                ss += (xv[0] * xv[0] + xv[1] * xv[1]) + (xv[2] * xv[2] + xv[3] * xv[3]);
#pragma unroll
                for (int j = 0; j < 4; ++j) { acc0 = __builtin_amdgcn_mfma_f32_16x16x4f32(xv[j], b0[j], acc0, 0, 0, 0); acc1 = __builtin_amdgcn_mfma_f32_16x16x4f32(xv[j], b1[j], acc1, 0, 0, 0); }
            }
            ss += __shfl_xor(ss, 16); ss += __shfl_xor(ss, 32);
            if (kq == 0) SSQP[kh * 64 + 16 * tg + r] = ss;
#pragma unroll
            for (int q = 0; q < 4; ++q) { const int tok = 16 * tg + 4 * kq + q; PART[(kh * 64 + tok) * 33 + (lane & 15)] = acc0[q]; PART[(kh * 64 + tok) * 33 + 16 + (lane & 15)] = acc1[q]; }
        }
        __syncthreads();
        int te[4] = {0, 0, 0, 0}, lp[4] = {0, 0, 0, 0}; float tv[4] = {-3e38f, -3e38f, -3e38f, -3e38f}; float rstd = 0.f;
        if (tid < 64) {
            const float ssq = SSQP[tid] + SSQP[64 + tid]; rstd = 1.0f / sqrtf(ssq * (1.f / DM) + EPS);
            const float* br = a->in[I_BR];
#pragma unroll
            for (int e = 0; e < 32; ++e) {
                float v = (PART[tid * 33 + e] + PART[(64 + tid) * 33 + e]) * rstd + br[e]; int id = e;
#pragma unroll
                for (int s = 0; s < 4; ++s) { const bool gt = v > tv[s]; const float ov = tv[s]; const int oi = te[s]; tv[s] = gt ? v : ov; te[s] = gt ? id : oi; v = gt ? ov : v; id = gt ? oi : id; }
            }
#pragma unroll
            for (int s = 0; s < 4; ++s) lp[s] = __hip_atomic_fetch_add(&CNT[te[s]], 1, __ATOMIC_RELAXED, __HIP_MEMORY_SCOPE_WORKGROUP);
        }
        __syncthreads();
        if (tid < 32) { const int c = CNT[tid]; BASE[tid] = c ? (int)atomicAdd(gcnt + tid, (unsigned)c) : 0; }
        __syncthreads();
        if (tid < 64) {
            const int t = tb + tid;
            const float e1 = __expf(tv[1] - tv[0]), e2 = __expf(tv[2] - tv[0]), e3 = __expf(tv[3] - tv[0]); const float inv = 1.0f / (1.0f + e1 + e2 + e3);
            const float gts[4] = {inv, e1 * inv, e2 * inv, e3 * inv};
#pragma unroll
            for (int s = 0; s < 4; ++s) { const int p = BASE[te[s]] + lp[s]; RE[t * 4 + s] = te[s]; RP[t * 4 + s] = p; RG[t * 4 + s] = gts[s]; TOK[te[s] * 16384 + p] = t; }
            RS[t] = rstd; RSTD_L[tid] = rstd;
        }
        __syncthreads();
        if (tid < 32) CNT[tid] = 0;
        {
            f32x4 g[2][2];
#pragma unroll
            for (int j = 0; j < 2; ++j) { g[j][0] = *(const f32x4*)(gf + 512 * j + 8 * lane); g[j][1] = *(const f32x4*)(gf + 512 * j + 8 * lane + 4); }
#pragma unroll 4
            for (int i = 0; i < 8; ++i) {
                const int t = tb + 8 * wave + i; const float rs = RSTD_L[8 * wave + i];
#pragma unroll
                for (int j = 0; j < 2; ++j) { const u32x4 xw = *(const u32x4*)(X1 + (size_t)t * DM + 512 * j + 8 * lane);
                    const f32x4 v0 = (f32x4){bf_lo(xw.x), bf_hi(xw.x), bf_lo(xw.y), bf_hi(xw.y)} * g[j][0] * rs, v1 = (f32x4){bf_lo(xw.z), bf_hi(xw.z), bf_lo(xw.w), bf_hi(xw.w)} * g[j][1] * rs;
                    *(u32x2*)(H8 + (size_t)t * DM + 512 * j + 8 * lane) = cvt8_fp8(v0, v1, 8.0f); }
            }
        }
        __syncthreads();
    }
}

__device__ __forceinline__ int build_tiles(const Frame& F) {
    const int tid_l = tid_local(), lane_l = tid_l & 63; (void)tid_l; (void)lane_l;
    LAS int* TB = (LAS int*)(F.lds + TILE_E_OFF); LAS int* TE = TB + 64;
    if (tid_l < 64) {
        const int c = (tid_l < NEXP) ? (int)__hip_atomic_load(F.ctl + CW_CNT + tid_l, RLX_AGENT) : 0; const int nt = (c + 255) >> 8;
        int incl = nt;
#pragma unroll
        for (int o = 1; o < 32; o <<= 1) { const int v = __shfl_up(incl, o); if (lane_l >= o) incl += v; }
        if (tid_l < NEXP) TB[tid_l] = incl - nt;
        if (tid_l == NEXP - 1) TB[NEXP] = incl;
    }
    __syncthreads();
    if (tid_l < NEXP) { for (int t = TB[tid_l]; t < TB[tid_l + 1]; ++t) TE[t] = tid_l; }
    __syncthreads();
    return TB[NEXP];
}

__device__ __forceinline__ void p8_dispatch(const Frame& F) {
    const int tid_l = tid_local(), lane_l = tid_l & 63; (void)tid_l; (void)lane_l;
    const KArgs a = kargs();
    (void)build_tiles(F);
    const LAS int* TB = (const LAS int*)(F.lds + TILE_E_OFF);
    const int gw = F.vcu * NWAVES + F.wave, NGW = F.G * NWAVES, lane = lane_l;
    const int* RE = (const int*)(F.ws + WS_ROUTE); const int* RP = RE + T * 4; const float* RS = (const float*)(RP + T * 4) + T * 4; int* SL = (int*)(RS + T);
    const bf16_t* X1 = (const bf16_t*)(F.ws + WS_X1B); const float* gf = a->in[I_GFFN]; unsigned char* XS = F.ws + WS_XS2;
    f32x4 g[2][2];
#pragma unroll
    for (int j = 0; j < 2; ++j) { g[j][0] = *(const f32x4*)(gf + 512 * j + 8 * lane); g[j][1] = *(const f32x4*)(gf + 512 * j + 8 * lane + 4); }
    for (int t = gw; t < T; t += NGW) {
        const float rstd = RS[t];
        u32x2 w[2];
#pragma unroll
        for (int j = 0; j < 2; ++j) { const u32x4 xw = *(const u32x4*)(X1 + (size_t)t * DM + 512 * j + 8 * lane);
            const f32x4 v0 = (f32x4){bf_lo(xw.x), bf_hi(xw.x), bf_lo(xw.y), bf_hi(xw.y)} * g[j][0] * rstd, v1 = (f32x4){bf_lo(xw.z), bf_hi(xw.z), bf_lo(xw.w), bf_hi(xw.w)} * g[j][1] * rstd;
            w[j] = cvt8_fp8(v0, v1, 8.0f); }
#pragma unroll
        for (int s = 0; s < 4; ++s) { const int e = RE[t * 4 + s], slot = TB[e] * 256 + RP[t * 4 + s];
            if (lane == 0) SL[t * 4 + s] = slot;
            unsigned char* dst = XS + (size_t)slot * DM + 8 * lane;
            *(u32x2*)dst = w[0]; *(u32x2*)(dst + 512) = w[1]; }
    }
}

template <bool GATHER_A> struct MoeOrderT {
    int G, c, ntn_shift, total; const LAS int* TE; unsigned A, Bw, bexp, btile; int xbase, xcount;
    __device__ __forceinline__ void init_xcd(const LAS int* TB) {
        if (G == 256) { const int x = c >> 5; xbase = __builtin_amdgcn_readfirstlane(TB[4 * x]); xcount = (__builtin_amdgcn_readfirstlane(TB[4 * x + 4]) - xbase) << ntn_shift; } else { xbase = -1; xcount = 0; }
    }
    __device__ __forceinline__ bool next(int i, Unit& u) const {
        if (xbase >= 0) { const int L = i * 32 + (c & 31); if (L >= xcount) return false;
            u.pm = xbase + (L >> ntn_shift); u.pn = L & ((1 << ntn_shift) - 1); u.aux = __builtin_amdgcn_readfirstlane(TE[u.pm]); return true; }
        const int L = i * G + c; if (L >= total) return false;
        u.pm = L >> ntn_shift; u.pn = L & ((1 << ntn_shift) - 1); u.aux = __builtin_amdgcn_readfirstlane(TE[u.pm]); return true;
    }
#ifndef MOE_PREFETCH
#define MOE_PREFETCH 0
#endif
    __device__ __forceinline__ void prefetch(const Unit& u, const __amdgpu_buffer_rsrc_t rsrc, LAS unsigned char* lds, int wid, int lane) const {
        if (!MOE_PREFETCH) return;
        const unsigned ln_ = (unsigned)(tid_local() & 63);
        const unsigned line = (unsigned)(u.pn & 3) * 512u + (unsigned)wid * 64u + ln_;
        const unsigned voff = (line >> 3) * 1024u + (line & 7u) * 128u;
        const unsigned dst = (unsigned)__builtin_amdgcn_readfirstlane((int)(unsigned)(unsigned long)(lds + 131072 + wid * 256));
        const unsigned soff = a_off(u);
        asm volatile("s_nop 4\n\ts_mov_b32 m0, %0\n\ts_nop 0\n\tbuffer_load_dword %1, %2, %3 offen lds" :: "s"(dst), "v"(voff), "s"(rsrc), "s"(soff) : "m0", "memory");
    }
    unsigned TOK;
    __device__ __forceinline__ unsigned tok_off(const Unit& u) const { return TOK + ((unsigned)u.aux * 16384u + (unsigned)(u.pm - __builtin_amdgcn_readfirstlane(TE[u.aux - 64])) * 256u) * 4u; }
    __device__ __forceinline__ unsigned a_off(const Unit& u) const { return GATHER_A ? A : A + (unsigned)u.pm * (256 * 1024); }
    __device__ __forceinline__ unsigned b_off(const Unit& u) const { return Bw + (unsigned)u.aux * bexp + (unsigned)u.pn * btile; }
};
using MoeOrder = MoeOrderT<false>; using MoeGather = MoeOrderT<true>;
struct EpiSwiglu {
    static constexpr bool PERM = true;
    unsigned char* ACT; const float* bgu;
    __device__ __forceinline__ void init(f32x4 (&acc)[2][2][4][2], const Unit& u, int wc, int fq) const {
        const float* bb = bgu + (size_t)u.aux * 2048 + u.pn * 128 + wc * 32 + 8 * fq;
        const f32x4 g0 = *(const f32x4*)(bb), g1 = *(const f32x4*)(bb + 4), u0 = *(const f32x4*)(bb + 1024), u1 = *(const f32x4*)(bb + 1028);
#pragma unroll
        for (int a = 0; a < 2; ++a)
#pragma unroll
            for (int m = 0; m < 4; ++m) { acc[a][0][m][0] = g0; acc[a][0][m][1] = g1; acc[a][1][m][0] = u0; acc[a][1][m][1] = u1; }
    }
    __device__ __forceinline__ void operator()(const f32x4 (&acc)[2][2][4][2], const Unit& u, int wr, int wc, int fr, int fq) const {
        const int row0 = u.pm * 256 + wr * 64 + fr, j0 = u.pn * 128 + wc * 32 + 8 * fq;
        unsigned char* dst0 = ACT + (size_t)row0 * DEXP + j0;
#pragma unroll
        for (int ai = 0; ai < 2; ++ai)
#pragma unroll
            for (int m = 0; m < 4; ++m) {
                int w2[2];
#pragma unroll
                for (int n = 0; n < 2; ++n) {
                    const f32x4 g = acc[ai][0][m][n], up = acc[ai][1][m][n];
                    f32x2 r[2];
#pragma unroll
                    for (int h = 0; h < 2; ++h) {
                        const f32x2 gg = {__builtin_amdgcn_fmed3f(g[2 * h], -3.0e38f, 7.0f), __builtin_amdgcn_fmed3f(g[2 * h + 1], -3.0e38f, 7.0f)};
                        const f32x2 uu = {__builtin_amdgcn_fmed3f(up[2 * h], -7.0f, 7.0f), __builtin_amdgcn_fmed3f(up[2 * h + 1], -7.0f, 7.0f)};
                        const f32x2 x = gg * (f32x2){-1.702f * 1.4426950408889634f, -1.702f * 1.4426950408889634f};
                        const f32x2 den = (f32x2){__builtin_amdgcn_exp2f(x[0]), __builtin_amdgcn_exp2f(x[1])} + (f32x2){1.0f, 1.0f};
                        const f32x2 rc = {__builtin_amdgcn_rcpf(den[0]), __builtin_amdgcn_rcpf(den[1])};
                        r[h] = (uu * (f32x2){8.0f, 8.0f} + (f32x2){8.0f, 8.0f}) * gg * rc; }
                    int w = __builtin_amdgcn_cvt_pk_fp8_f32(r[0][0], r[0][1], 0, false); w2[n] = __builtin_amdgcn_cvt_pk_fp8_f32(r[1][0], r[1][1], w, true);
                }
                u32x2 o; o.x = (unsigned)w2[0]; o.y = (unsigned)w2[1];
                *(u32x2*)(dst0 + (size_t)(ai * 128 + m * 16) * DEXP) = o;
            }
    }
};
struct EpiDown {
    static constexpr bool PERM = true;
    unsigned char* Y; const float* bd;
    __device__ __forceinline__ void init(f32x4 (&acc)[2][2][4][2], const Unit& u, int wc, int fq) const {
        const float* bb = bd + (size_t)u.aux * DM + u.pn * 256 + wc * 32 + 8 * fq;
        const f32x4 b00 = *(const f32x4*)(bb), b01 = *(const f32x4*)(bb + 4), b10 = *(const f32x4*)(bb + 128), b11 = *(const f32x4*)(bb + 132);
#pragma unroll
        for (int a = 0; a < 2; ++a)
#pragma unroll
            for (int m = 0; m < 4; ++m) { acc[a][0][m][0] = b00; acc[a][0][m][1] = b01; acc[a][1][m][0] = b10; acc[a][1][m][1] = b11; }
    }
    __device__ __forceinline__ void operator()(const f32x4 (&acc)[2][2][4][2], const Unit& u, int wr, int wc, int fr, int fq) const {
        const int row0 = u.pm * 256 + wr * 64 + fr, col0 = u.pn * 256 + wc * 32 + 8 * fq;
#pragma unroll
        for (int ai = 0; ai < 2; ++ai)
#pragma unroll
            for (int m = 0; m < 4; ++m) { unsigned char* rowp = Y + (size_t)(row0 + ai * 128 + m * 16) * DM + col0;
#pragma unroll
                for (int bj = 0; bj < 2; ++bj) *(u32x2*)(rowp + bj * 128) = cvt8_fp8(acc[ai][bj][m][0], acc[ai][bj][m][1], 8.0f); }
    }
};

__device__ __forceinline__ void p11_combine(const Frame& F) {
    const int tid_l = tid_local(), lane_l = tid_l & 63; (void)tid_l; (void)lane_l;
    const KArgs a = kargs();
    const int gw = F.vcu * NWAVES + F.wave, NGW = F.G * NWAVES, lane = lane_l;
    (void)build_tiles(F); const LAS int* TB = (const LAS int*)(F.lds + TILE_E_OFF);
    const int* RE = (const int*)(F.ws + WS_ROUTE); const int* RP = RE + T * 4; const float* RG = (const float*)(RE + T * 8);
    const unsigned char* Y = F.ws + WS_XS; bf16_t* HP = (bf16_t*)(F.ws + WS_HN); const bf16_t* X1 = (const bf16_t*)(F.ws + WS_X1B); bf16_t* X2 = (bf16_t*)(F.ws + WS_X2B); const float* gp = a->in[I_GPLE];
    f32x4 g[2][2];
#pragma unroll
    for (int j = 0; j < 2; ++j) { g[j][0] = *(const f32x4*)(gp + 512 * j + 8 * lane); g[j][1] = *(const f32x4*)(gp + 512 * j + 8 * lane + 4); }
    for (int t = gw; t < T; t += NGW) {
        f32x4 v[2][2];
#pragma unroll
        for (int j = 0; j < 2; ++j) { const u32x4 xw = *(const u32x4*)(X1 + (size_t)t * DM + 512 * j + 8 * lane); v[j][0] = (f32x4){bf_lo(xw.x), bf_hi(xw.x), bf_lo(xw.y), bf_hi(xw.y)}; v[j][1] = (f32x4){bf_lo(xw.z), bf_hi(xw.z), bf_lo(xw.w), bf_hi(xw.w)}; }
#pragma unroll
        for (int s = 0; s < 4; ++s) { const int slot = TB[RE[t * 4 + s]] * 256 + RP[t * 4 + s]; const float gt = RG[t * 4 + s] * 0.125f;
#pragma unroll
            for (int j = 0; j < 2; ++j) { const u32x2 y = *(const u32x2*)(Y + (size_t)slot * DM + 512 * j + 8 * lane);
                const f32x2 a0 = __builtin_amdgcn_cvt_pk_f32_fp8((int)y.x, false), a1 = __builtin_amdgcn_cvt_pk_f32_fp8((int)y.x, true), b0 = __builtin_amdgcn_cvt_pk_f32_fp8((int)y.y, false), b1 = __builtin_amdgcn_cvt_pk_f32_fp8((int)y.y, true);
                v[j][0] += (f32x4){a0[0], a0[1], a1[0], a1[1]} * gt; v[j][1] += (f32x4){b0[0], b0[1], b1[0], b1[1]} * gt; } }
        float ss = 0.f;
#pragma unroll
        for (int j = 0; j < 2; ++j)
#pragma unroll
            for (int n = 0; n < 2; ++n) { const f32x4 q = v[j][n]; ss += (q[0] * q[0] + q[1] * q[1]) + (q[2] * q[2] + q[3] * q[3]); u32x2 w; w.x = cvt_pk_bf16(q[0], q[1]); w.y = cvt_pk_bf16(q[2], q[3]); *(u32x2*)(X2 + (size_t)t * DM + 512 * j + 8 * lane + 4 * n) = w; }
        const float rstd = 1.0f / sqrtf(wave_sum(ss) * (1.f / DM) + EPS);
#pragma unroll
        for (int j = 0; j < 2; ++j) { const f32x4 q0 = v[j][0] * g[j][0] * rstd, q1 = v[j][1] * g[j][1] * rstd;
            if (PLE_FP8) { *(u32x2*)((unsigned char*)HP + (size_t)t * DM + 512 * j + 8 * lane) = cvt8_fp8(q0, q1, 8.0f); }
            else { u32x4 w; w.x = cvt_pk_bf16(q0[0], q0[1]); w.y = cvt_pk_bf16(q0[2], q0[3]); w.z = cvt_pk_bf16(q1[0], q1[1]); w.w = cvt_pk_bf16(q1[2], q1[3]);
                *(u32x4*)(HP + (size_t)t * DM + 512 * j + 8 * lane) = w; } }
    }
}
struct EpiPle {
    static constexpr bool PERM = false;
    __device__ __forceinline__ void init(f32x4 (&acc)[2][2][4][2], const Unit&, int, int) const {
#pragma unroll
        for (int a = 0; a < 2; ++a)
#pragma unroll
            for (int b = 0; b < 2; ++b)
#pragma unroll
                for (int m = 0; m < 4; ++m)
#pragma unroll
                    for (int n = 0; n < 2; ++n) acc[a][b][m][n] = (f32x4){0.f, 0.f, 0.f, 0.f};
    }
    float* out; const bf16_t* E; const bf16_t* X2;
    __device__ __forceinline__ void operator()(const f32x4 (&acc)[2][2][4][2], const Unit& u, int wr, int wc, int fr, int fq) const {
        const int row0 = u.pm * 256 + wr * 64 + fr, col0 = u.pn * 256 + wc * 32 + 4 * fq;
#pragma unroll
        for (int ai = 0; ai < 2; ++ai)
#pragma unroll
            for (int m = 0; m < 4; ++m) { const size_t off = (size_t)(row0 + ai * 128 + m * 16) * DM + col0;
#pragma unroll
                for (int bj = 0; bj < 2; ++bj)
#pragma unroll
                    for (int n = 0; n < 2; ++n) { const size_t o = off + bj * 128 + n * 16; const u32x2 ev = *(const u32x2*)(E + o); const f32x4 a4 = acc[ai][bj][m][n];
                        const u32x2 xw = *(const u32x2*)(X2 + o); f32x4 r = {bf_lo(xw.x), bf_hi(xw.x), bf_lo(xw.y), bf_hi(xw.y)};
                        r[0] += fast_sigmoid(a4[0]) * bf_lo(ev.x); r[1] += fast_sigmoid(a4[1]) * bf_hi(ev.x); r[2] += fast_sigmoid(a4[2]) * bf_lo(ev.y); r[3] += fast_sigmoid(a4[3]) * bf_hi(ev.y);
                        *(f32x4*)(out + o) = r; } }
    }
};

constexpr int N_PHASES = 13;
__global__ void __launch_bounds__(NWAVES * 64, 2) fwd_kernel(Args args) {
    extern __shared__ __attribute__((aligned(16))) unsigned char lds_raw[];
    Frame F;
    F.lds = (LAS unsigned char*)lds_raw; F.MISC = (volatile LAS unsigned*)(F.lds + MISC_OFF);
    F.wave = __builtin_amdgcn_readfirstlane(threadIdx.x >> 6);
    F.G = gridDim.x; { const int bx = blockIdx.x; F.vcu = (F.G % 8 == 0) ? (bx % 8) * (F.G / 8) + bx / 8 : bx; }
    { const KArgs ka = kargs(); F.out = ka->out; F.ws = ka->ws; F.ctl = (unsigned*)(ka->ws + WS_CTL); }
    { const int t0_ = tid_local(); if (t0_ < 32) F.MISC[t0_] = 0u; }
    __syncthreads();
    int lo, hi; { const KArgs ka = kargs(); lo = ka->ph_lo; hi = ka->ph_hi; }
    const bool multi = (hi - lo) > 1;
    XcdBarrier bar; bar.bar = F.ctl + CW_BAR; bar.x = 0; bar.st = nullptr;
    if (multi) bar = xcd_barrier_post(F.ctl + CW_BAR, F.MISC);
#ifndef PH_MASK
#define PH_MASK 0x1fff
#endif
#define IN(k) ((((PH_MASK) >> (k)) & 1) && lo <= (k) && (k) < hi)
#define SEAM(k) do { if (IN(k) && IN((k) + 1)) xcd_barrier(bar); } while (0)
    unsigned char* ws = F.ws;
    LAS unsigned char* ring = F.lds;
    const __amdgpu_buffer_rsrc_t rsrc = __builtin_amdgcn_make_buffer_rsrc((void*)ws, 0, (int)WS_END, 0x00020000);

    if (IN(0)) { p0_prologue(F); } SEAM(0);

    if (IN(1)) {
        if (GATES_FP8 && !P1_FP8) {
          { DenseOrder S; S.init(64, 8, F.G, (int)blockIdx.x, WS_HN8, 512, WS_WIN8 + (size_t)1024 * 1024, 512);
            EpiProj E{(bf16_t*)(ws + WS_PROJ), (bf16_t*)(ws + WS_GATES), 4};
            pg8::gemm_phase<EpiProj, DenseOrder, true, true, true>(ring, rsrc, pg8::Shape{1024, 1024, 1024, 0x7c7c7c7c, 0x7c7c7c7c}, S, E); }
          { DenseOrder S; S.init(64, 4, F.G, (int)blockIdx.x, WS_HN, 1024, WS_WIN, 1024);
            EpiProj E{(bf16_t*)(ws + WS_PROJ), (bf16_t*)(ws + WS_GATES), 0};
            pg8::gemm_phase<EpiProj, DenseOrder, true, true>(ring, rsrc, pg8::Shape{2048, 2048, 2048, 0, 0}, S, E); }
        } else
        { DenseOrder S; S.init(64, 12, F.G, (int)blockIdx.x, WS_HN, P1_FP8 ? 512 : 1024, WS_WIN, P1_FP8 ? 512 : 1024);
          EpiProj E{(bf16_t*)(ws + WS_PROJ), (bf16_t*)(ws + WS_GATES), 0};
          if (P1_FP8) pg8::gemm_phase<EpiProj, DenseOrder, true, true, true>(ring, rsrc, pg8::Shape{1024, 1024, 1024, 0x7c7c7c7c, 0x7c7c7c7c}, S, E);
          else pg8::gemm_phase<EpiProj, DenseOrder, true, true>(ring, rsrc, pg8::Shape{2048, 2048, 2048, 0, 0}, S, E, GP_AT(1)); }
        { DenseOrder S; S.init(64, 4, F.G, (int)blockIdx.x, WS_PB, 256, WS_WPLE, 256);
          EpiBf16 E{(bf16_t*)(ws + WS_E), 1024};
          pg8::gemm_phase<EpiBf16, DenseOrder, true, true>(ring, rsrc, pg8::Shape{512, 512, 512, 0, 0}, S, E); }
    } SEAM(1);

    if (IN(2)) { p2_rows(F); } SEAM(2);

    if (IN(3)) {
#ifndef P3M
#define P3M 7
#endif
        if (P3M & 1) { DenseOrder S; S.init(64, 4, F.G, (int)blockIdx.x, WS_A2 + 512, 512, WS_WKV, 256);
          EpiKV E{(bf16_t*)(ws + WS_K), (bf16_t*)(ws + WS_V), kargs()->in[I_GKNOPE]};
          pg8::gemm_phase<EpiKV, DenseOrder, true, true>(ring, rsrc, pg8::Shape{512, 1024, 512, 0, 0}, S, E); }
        if (P3M & 2) { DenseOrder S; S.init(64, 3, F.G, (int)blockIdx.x, WS_A2, 512, WS_WQ, 256);
          EpiQ E{(bf16_t*)(ws + WS_Q), (float*)(ws + WS_SSQ), (const float*)(ws + WS_COS), (const float*)(ws + WS_SIN), kargs()->in[I_GQHEAD]};
          pg8::gemm_phase<EpiQ, DenseOrder, true, true>(ring, rsrc, pg8::Shape{512, 1024, 512, 0, 0}, S, E); }
        if (P3M & 4) { DenseOrder S; S.init(64, 2, F.G, (int)blockIdx.x, WS_POOLED, 512, WS_WPOOL, 256, 512);
          EpiBf16 E{(bf16_t*)(ws + WS_MIXED), 512};
          pg8::gemm_phase<EpiBf16, DenseOrder, true, true>(ring, rsrc, pg8::Shape{512, 1024, 512, 0, 0}, S, E); }
    } SEAM(3);

    if (IN(4)) {
        u32x4 srd; { const unsigned long wb = (unsigned long)ws; srd.x = (unsigned)__builtin_amdgcn_readfirstlane((int)(unsigned)wb); srd.y = (unsigned)__builtin_amdgcn_readfirstlane((int)(unsigned)(wb >> 32)); srd.z = (unsigned)WS_END; srd.w = 0x00020000u; }
        att::ConvState CV; CV.next = __builtin_amdgcn_readfirstlane(F.vcu * NWAVES + F.wave); CV.end = CONV_IN_ATTN ? att::CV_ITEMS : 0; CV.cur = -1;
        bool fast;
        { const int lane = tid_local() & 63; const float* gqh = kargs()->in[I_GQHEAD]; const float* gkn = kargs()->in[I_GKNOPE]; const float* gkr = kargs()->in[I_GKROPE];
          float a = fabsf(gqh[lane]); if (lane < 32) a = fmaxf(a, fabsf(gqh[64 + lane])); float bn = fabsf(gkn[lane]); float br = (lane < 32) ? fabsf(gkr[lane]) : 0.f;
#pragma unroll
          for (int o = 1; o < 64; o <<= 1) { a = fmaxf(a, __shfl_xor(a, o)); bn = fmaxf(bn, __shfl_xor(bn, o)); br = fmaxf(br, __shfl_xor(br, o)); }
          const float Mb = 1.4426950408889634f * 1.01f * a * sqrtf(64.f * bn * bn + 32.f * br * br);
          fast = __builtin_amdgcn_readfirstlane(Mb <= 60.0f ? 1 : 0) != 0; }
        for (int it = F.vcu; it < 256; it += F.G) {
            const int bh = it >> 3, pr = it & 7;
            att::attn_unit(ring, srd, CV, ws, bh, 15 - pr, (const bf16_t*)(ws + WS_Q), (unsigned)WS_K, (unsigned)WS_V, (const float*)(ws + WS_SSQ), (bf16_t*)(ws + WS_ATT), fast);
            att::attn_unit(ring, srd, CV, ws, bh, pr, (const bf16_t*)(ws + WS_Q), (unsigned)WS_K, (unsigned)WS_V, (const float*)(ws + WS_SSQ), (bf16_t*)(ws + WS_ATT), fast);
        }
        { const LAS float* cb = (const LAS float*)(F.lds + att::CONV_OFF + F.wave * att::CONV_BYTES);
          const unsigned cbaddr = (unsigned)__builtin_amdgcn_readfirstlane((int)(unsigned)(unsigned long)(F.lds + att::CONV_OFF + F.wave * att::CONV_BYTES));
          const int lane_l = tid_local() & 63;
          while (CV.cur >= 0 || CV.next < CV.end) {
            if (CV.cur >= 0) { asm volatile("s_waitcnt vmcnt(0)" ::: "memory"); const att::ConvItem I = att::cv_setup(CV.cur, kargs()->in[I_WGU], kargs()->in[I_WD], ws + WS_WGU, ws + WS_WD); att::cv_out(I, cb, lane_l); }
            if (CV.next < CV.end) { const att::ConvItem I = att::cv_setup(CV.next, kargs()->in[I_WGU], kargs()->in[I_WD], ws + WS_WGU, ws + WS_WD); asm volatile("s_waitcnt lgkmcnt(0)" ::: "memory"); att::cv_dma(I, cbaddr, lane_l); CV.cur = CV.next; CV.next += 2048; } else CV.cur = -1;
          } }
    } SEAM(4);

    if (IN(5)) {
        MixOrder S{F.G, F.vcu, (unsigned)WS_ATT, (unsigned)WS_MIXED, (unsigned)WS_WAO, (unsigned)WS_WPO};
        EpiMix E{(bf16_t*)(ws + WS_MIX), (const bf16_t*)(ws + WS_GATES)};
        pg8::gemm_phase<EpiMix, MixOrder, true, true>(ring, rsrc, pg8::Shape{1024, 1024, 1024, 0, 0}, S, E, GP_AT(5));
    } SEAM(5);

    if (IN(6)) {
        DenseOrder S; S.init(64, 4, F.G, (int)blockIdx.x, WS_MIX, 1024, WS_WO, 1024);
        EpiRes E{kargs()->in[I_X], (bf16_t*)(ws + WS_X1B)};
        pg8::gemm_phase<EpiRes, DenseOrder, true, true>(ring, rsrc, pg8::Shape{2048, 2048, 2048, 0, 0}, S, E, GP_AT(6));
    } SEAM(6);

    if (IN(7)) { p7_router(F); } SEAM(7);


    if (IN(9)) {
        const int TM = build_tiles(F);
        MoeGather S{F.G, F.vcu, 3, TM * 8, (const LAS int*)(F.lds + TILE_E_OFF) + 64, (unsigned)WS_XS2, (unsigned)WS_WGU, 2048u * 1024u, 256u * 1024u, 0, 0, (unsigned)WS_TOK}; S.init_xcd((const LAS int*)(F.lds + TILE_E_OFF));
        EpiSwiglu E{ws + WS_ACT, kargs()->in[I_BGU]};
        pg8::gemm_phase<EpiSwiglu, MoeGather, true, true, true, true>(ring, rsrc, pg8::Shape{1024, 1024, 1024, 0x7c7c7c7c, 0x7c7c7c7c}, S, E, GP_AT(9));
    } SEAM(9);

    if (IN(10)) {
        const int TM = build_tiles(F);
        MoeOrder S{F.G, F.vcu, 2, TM * 4, (const LAS int*)(F.lds + TILE_E_OFF) + 64, (unsigned)WS_ACT, (unsigned)WS_WD, 1024u * 1024u, 256u * 1024u, 0, 0}; S.init_xcd((const LAS int*)(F.lds + TILE_E_OFF));
        EpiDown E{ws + WS_XS, kargs()->in[I_BD]};
        pg8::gemm_phase<EpiDown, MoeOrder, true, true, true>(ring, rsrc, pg8::Shape{1024, 1024, 1024, 0x7c7c7c7c, 0x7c7c7c7c}, S, E, GP_AT(10));
    } SEAM(10);

    if (IN(11)) { p11_combine(F); } SEAM(11);

    if (IN(12)) {
        DenseOrder S; S.init(64, 4, F.G, (int)blockIdx.x, WS_HN, PLE_FP8 ? 512 : 1024, WS_WPG, PLE_FP8 ? 512 : 1024);
        EpiPle E{F.out, (const bf16_t*)(ws + WS_E), (const bf16_t*)(ws + WS_X2B)};
        if (PLE_FP8) pg8::gemm_phase<EpiPle, DenseOrder, true, true, true>(ring, rsrc, pg8::Shape{1024, 1024, 1024, 0x7c7c7c7c, 0x7c7c7c7c}, S, E, GP_AT(12));
        else pg8::gemm_phase<EpiPle, DenseOrder, true, true>(ring, rsrc, pg8::Shape{2048, 2048, 2048, 0, 0}, S, E, GP_AT(12));
    }
#ifdef ATT_PROBE
    if (blockIdx.x == 17 && tid_local() == 0) { const unsigned long long* ap = (const unsigned long long*)(ws + WS_CTL + 65536 + 64); const unsigned long long wait = (ap[0] / ap[1]) * 10; const unsigned long long r0 = __builtin_amdgcn_s_memrealtime(); while (__builtin_amdgcn_s_memrealtime() - r0 < wait) __builtin_amdgcn_s_sleep(8); }
#endif
#ifdef ATT_PROBE2
    if (blockIdx.x == 17 && tid_local() == 0) { const unsigned long long* ap = (const unsigned long long*)(ws + WS_CTL + 65536 + 128); const unsigned long long wait = (ap[ATT_PROBE2 - 1] / ap[3]) * 10; const unsigned long long r0 = __builtin_amdgcn_s_memrealtime(); while (__builtin_amdgcn_s_memrealtime() - r0 < wait) __builtin_amdgcn_s_sleep(8); }
#endif
#ifdef BAR_PROBE
    for (int i_ = 0; i_ < 20; ++i_) xcd_barrier(bar);
#endif
#ifdef GP_PROBE
    if (blockIdx.x == GP_BLOCK && tid_local() == 0) {
        unsigned long long* gp = (unsigned long long*)(ws + WS_CTL + 65536);
        const unsigned long long cyc = gp[0], tiles = gp[1], pc = gp[2], pr = gp[3], units = gp[4];
        unsigned long long wait = 0;
        if (GP_METRIC == 0) wait = (cyc / tiles) * 10;
        if (GP_METRIC == 1) wait = (pc * 100 / pr) * 10;
        if (GP_METRIC == 2) wait = ((pc - cyc) / units);
        const unsigned long long r0 = __builtin_amdgcn_s_memrealtime();
        while (__builtin_amdgcn_s_memrealtime() - r0 < wait) __builtin_amdgcn_s_sleep(8);
    }
#endif
#undef IN
#undef SEAM
}

extern "C" void kernel_launch(void* const* d_in, const int* in_sizes, int n_in, void* d_out, int out_size, void* d_ws, size_t ws_size, hipStream_t stream) {
    static int grid = 0;
    if (grid == 0) {
        if (n_in != 27 || out_size != T * DM || ws_size < WS_END) { fprintf(stderr, "kernel_launch: unexpected shapes (n_in %d, out %d, ws %zu)\n", n_in, out_size, ws_size); grid = -1; return; }
        int dev = 0, cus = 0;
        if (hipGetDevice(&dev) != hipSuccess || hipDeviceGetAttribute(&cus, hipDeviceAttributeMultiprocessorCount, dev) != hipSuccess) { grid = -1; return; }
        if (hipFuncSetAttribute((const void*)fwd_kernel, hipFuncAttributeMaxDynamicSharedMemorySize, LDS_BYTES) != hipSuccess) { fprintf(stderr, "kernel_launch: hipFuncSetAttribute failed\n"); grid = -1; return; }
        int per_cu = 0;
        if (hipOccupancyMaxActiveBlocksPerMultiprocessor(&per_cu, (const void*)fwd_kernel, NWAVES * 64, LDS_BYTES) != hipSuccess || per_cu < 1) fprintf(stderr, "kernel_launch: occupancy query says %d\n", per_cu);
        (void)hipGetLastError();
        grid = cus;
    }
    if (grid < 0) return;
    (void)hipMemsetAsync((char*)d_ws + WS_CTL, 0, CTL_ZERO_BYTES, stream);
    Args a{};
    for (int i = 0; i < 27; ++i) a.in[i] = (const float*)d_in[i];
    a.out = (float*)d_out; a.ws = (unsigned char*)d_ws;
#ifndef DUP_PHASE
    a.ph_lo = 0; a.ph_hi = N_PHASES; hipLaunchKernelGGL(fwd_kernel, dim3(grid), dim3(NWAVES * 64), LDS_BYTES, stream, a);
#else
    a.ph_lo = 0; a.ph_hi = DUP_PHASE + 1; hipLaunchKernelGGL(fwd_kernel, dim3(grid), dim3(NWAVES * 64), LDS_BYTES, stream, a);
    (void)hipMemsetAsync((char*)d_ws + WS_CTL + CW_BAR * 4, 0, XCD_BAR_WORDS * 4, stream);
    a.ph_lo = DUP_PHASE; a.ph_hi = N_PHASES; hipLaunchKernelGGL(fwd_kernel, dim3(grid), dim3(NWAVES * 64), LDS_BYTES, stream, a);
#endif
}
```

```cpp
#include <hip/hip_runtime.h>
#ifndef GATE8
#define GATE8 0
#endif
#include <cstdio>
#include <cstdint>

#define LAS __attribute__((address_space(3)))
#define GAS __attribute__((address_space(1)))
typedef unsigned short bf16_t;
typedef short bf16x8 __attribute__((ext_vector_type(8)));
typedef short s16x4 __attribute__((ext_vector_type(4)));
typedef float f32x4 __attribute__((ext_vector_type(4)));
typedef float f32x2 __attribute__((ext_vector_type(2)));
typedef float f32x16 __attribute__((ext_vector_type(16)));
typedef unsigned u32x4 __attribute__((ext_vector_type(4)));
typedef unsigned u32x2 __attribute__((ext_vector_type(2)));

constexpr int NB = 4, SEQ = 4096, T = NB * SEQ, DM = 1024, NH = 8, DK = 96, DV = 64;
constexpr int NEXP = 32, TOPK = 4, DEXP = 1024, PLE = 256;
constexpr float EPS = 1e-6f;
constexpr int XS_ROWS = T * TOPK + NEXP * 256;

typedef __bf16 bf16x2_t __attribute__((ext_vector_type(2)));
__device__ __forceinline__ unsigned cvt_pk_bf16(float lo, float hi) { f32x2 v = {lo, hi}; return __builtin_bit_cast(unsigned, __builtin_convertvector(v, bf16x2_t)); }
__device__ __forceinline__ u32x2 cvt8_fp8(const f32x4 a, const f32x4 b, float sc) {
    int w0 = __builtin_amdgcn_cvt_pk_fp8_f32(a[0] * sc, a[1] * sc, 0, false); w0 = __builtin_amdgcn_cvt_pk_fp8_f32(a[2] * sc, a[3] * sc, w0, true);
    int w1 = __builtin_amdgcn_cvt_pk_fp8_f32(b[0] * sc, b[1] * sc, 0, false); w1 = __builtin_amdgcn_cvt_pk_fp8_f32(b[2] * sc, b[3] * sc, w1, true);
    u32x2 r; r.x = (unsigned)w0; r.y = (unsigned)w1; return r;
}
__device__ __forceinline__ float bf_lo(unsigned w) { return __uint_as_float(w << 16); }
__device__ __forceinline__ float bf_hi(unsigned w) { return __uint_as_float(w & 0xffff0000u); }
__device__ __forceinline__ float bf1(bf16_t h) { return __uint_as_float(((unsigned)h) << 16); }
__device__ __forceinline__ float fast_sigmoid(float v) { return __builtin_amdgcn_rcpf(1.0f + __builtin_amdgcn_exp2f(-1.4426950408889634f * v)); }
__device__ __forceinline__ int lane_id() { return (int)__builtin_amdgcn_mbcnt_hi(~0u, __builtin_amdgcn_mbcnt_lo(~0u, 0u)); }
__device__ __forceinline__ int tid_local() { int t = threadIdx.x; asm volatile("" : "+v"(t)); return t; }
__device__ __forceinline__ float wave_sum(float v) {
#pragma unroll
    for (int o = 1; o < 64; o <<= 1) v += __shfl_xor(v, o);
    return v;
}

namespace pg8 {
constexpr int BM = 256, BK = 64, HALF = 128, HTB = HALF * BK * 2, STAGE_BYTES = 8 * HTB;
__host__ __device__ __forceinline__ int lds_byte(int r, int c) { const int st = (r >> 4) * 2 + (c >> 5), rr = r & 15, cc = c & 31, ob = rr * 64 + cc * 2; return st * 1024 + (ob ^ (((ob >> 9) & 1) << 5)); }
__host__ __device__ __forceinline__ void stage_rc(int b, int& R, int& C) { const int st = b / 1024, sb = b % 1024, swz = sb ^ (((sb >> 9) & 1) << 5); R = (st >> 1) * 16 + swz / 64; C = (st & 1) * 32 + (swz % 64) / 2; }
__host__ __device__ __forceinline__ int perm32(int rho) { const int n = rho >> 4, i = rho & 15; return 8 * (i >> 2) + 4 * n + (i & 3); }

struct Unit { int pm, pn, aux; };
struct Shape { int Kb, lda, ldb, sw, sa; };
typedef int v8i_t __attribute__((ext_vector_type(8))); typedef int v4i_t __attribute__((ext_vector_type(4)));

template <class Epi, class Sched, bool ALIGN_EPI, bool SP2, bool MX = false, bool GATHER = false>
__device__ __forceinline__ void gemm_phase(LAS unsigned char* lds, const __amdgpu_buffer_rsrc_t rsrc, const Shape g, const Sched& S, const Epi& E, unsigned long long* gp_out = nullptr) {
    const int tid = tid_local(), wid = __builtin_amdgcn_readfirstlane(tid >> 6), lane = tid & 63, wr = wid >> 2, wc = wid & 3, fr = lane & 15, fq = lane >> 4;
    int nt = g.Kb / 128; asm volatile("" : "+s"(nt));
    unsigned voffA, voffB;
    { int R, C; stage_rc(tid * 16, R, C); const int Rb = Epi::PERM ? ((R & ~31) + perm32(R & 31)) : R;
      voffA = GATHER ? (unsigned)(C * 2 + (R << 16)) : (unsigned)(R * g.lda + C * 2); voffB = (unsigned)(Rb * g.ldb + C * 2); }
    const unsigned p2A = 64u * (unsigned)g.lda, p2B = 64u * (unsigned)g.ldb;
    const unsigned kstep = 128u;
    const unsigned hstepA = (unsigned)HALF * g.lda, hstepB = (unsigned)HALF * g.ldb;
    const unsigned ldsw = (unsigned)wid * 1024u;
    const int aoff = lds_byte(wr * 64 + fr, fq * 8), boff = lds_byte(wc * 32 + fr, fq * 8);
#define PG8_SA(b, h) (((b) * 2 + (h)) * HTB)
#define PG8_SB(b, h) ((4 + (b) * 2 + (h)) * HTB)
#define PG8_STAGE(bufoff, gbase, voff) do { \
        __builtin_amdgcn_raw_ptr_buffer_load_lds(rsrc, (LAS void*)(lds + (bufoff) + ldsw), 16, voff, (gbase), 0, 0); \
        __builtin_amdgcn_raw_ptr_buffer_load_lds(rsrc, (LAS void*)(lds + (bufoff) + ldsw + 8192), 16, voff, (gbase) + p2##voff, 0, 0); } while (0)
#define p2voffA p2A
#define p2voffB p2B
#define PG8_STAGEA(bufoff, gk, h, tab) do { if constexpr (GATHER) { \
        const LAS int* tb_ = (const LAS int*)(lds + STAGE_BYTES) + (tab) * 256 + (h) * 128 + (int)(voffA >> 16); const unsigned cb_ = voffA & 0xffffu; \
        const unsigned i0_ = (unsigned)tb_[0], i1_ = (unsigned)tb_[64]; \
        __builtin_amdgcn_raw_ptr_buffer_load_lds(rsrc, (LAS void*)(lds + (bufoff) + ldsw), 16, i0_ * (unsigned)g.lda + cb_, (gk), 0, 0); \
        __builtin_amdgcn_raw_ptr_buffer_load_lds(rsrc, (LAS void*)(lds + (bufoff) + ldsw + 8192), 16, i1_ * (unsigned)g.lda + cb_, (gk), 0, 0); } \
      else { PG8_STAGE(bufoff, (gk) + (h) * hstepA, voffA); } } while (0)
#define PG8_LDA(dst, b, h) do { _Pragma("unroll") for (int m = 0; m < 4; ++m) _Pragma("unroll") for (int k = 0; k < 2; ++k) dst[m][k] = *(const LAS bf16x8*)(lds + PG8_SA(b, h) + aoff + m * 2048 + k * 1024); } while (0)
#define PG8_LDB(dst, b, h) do { _Pragma("unroll") for (int n = 0; n < 2; ++n) _Pragma("unroll") for (int k = 0; k < 2; ++k) dst[n][k] = *(const LAS bf16x8*)(lds + PG8_SB(b, h) + boff + n * 2048 + k * 1024); } while (0)
#define PG8_CAT(x, y) __builtin_shufflevector(__builtin_bit_cast(v4i_t, x), __builtin_bit_cast(v4i_t, y), 0, 1, 2, 3, 4, 5, 6, 7)
#define PG8_MMA(ai, bj, At, Bt) do { __builtin_amdgcn_s_setprio(1); if constexpr (MX) { _Pragma("unroll") for (int m = 0; m < 4; ++m) _Pragma("unroll") for (int n = 0; n < 2; ++n) \
        acc[ai][bj][m][n] = __builtin_amdgcn_mfma_scale_f32_16x16x128_f8f6f4(PG8_CAT(Bt[n][0], Bt[n][1]), PG8_CAT(At[m][0], At[m][1]), acc[ai][bj][m][n], 0, 0, 0, g.sw, 0, g.sa); } else { \
        _Pragma("unroll") for (int m = 0; m < 4; ++m) _Pragma("unroll") for (int n = 0; n < 2; ++n) _Pragma("unroll") for (int k = 0; k < 2; ++k) \
        acc[ai][bj][m][n] = __builtin_amdgcn_mfma_f32_16x16x32_bf16(Bt[n][k], At[m][k], acc[ai][bj][m][n], 0, 0, 0); } __builtin_amdgcn_s_setprio(0); } while (0)
#define PG8_WAIT_V(n) asm volatile("s_waitcnt vmcnt(" #n ")" ::: "memory")
#define PG8_WAIT_L(n) asm volatile("s_waitcnt lgkmcnt(" #n ")" ::: "memory")
#define PG8_BAR __builtin_amdgcn_s_barrier()
#define PG8_SCHED __builtin_amdgcn_sched_barrier(0)
#ifdef GP_PROBE
    unsigned long long gp_cycles = 0, gp_tiles = 0; const unsigned long long gp_p0 = __builtin_amdgcn_s_memtime(), gp_r0 = __builtin_amdgcn_s_memrealtime();
#endif
    Unit cur, nxt; int ui = 0;
    if (!S.next(0, cur)) return;
    f32x4 acc[2][2][4][2];
    E.init(acc, cur, wc, fq);
    bf16x8 At[4][2], B0[2][2], B1[2][2];
    unsigned cA = S.a_off(cur), cB = S.b_off(cur);
    int tab_c = 0; (void)tab_c;
    if constexpr (GATHER) {
        if (wid < 4) {
            const unsigned dst_ = (unsigned)__builtin_amdgcn_readfirstlane((int)(unsigned)(unsigned long)(lds + STAGE_BYTES + (wid * 64) * 4));
            const unsigned vo_ = (unsigned)((wid * 64 + lane) * 4); const unsigned so_ = S.tok_off(cur);
            asm volatile("s_nop 4\n\ts_mov_b32 m0, %0\n\ts_nop 0\n\tbuffer_load_dword %1, %2, %3 offen lds" :: "s"(dst_), "v"(vo_), "s"(rsrc), "s"(so_) : "m0", "memory"); }
        asm volatile("s_waitcnt vmcnt(0)" ::: "memory"); __syncthreads();
    }
    if constexpr (SP2) {
        PG8_STAGE(PG8_SB(0, 0), cB, voffB); PG8_STAGE(PG8_SB(0, 1), cB + hstepB, voffB); PG8_STAGEA(PG8_SA(0, 0), cA, 0, tab_c); PG8_STAGEA(PG8_SA(0, 1), cA, 1, tab_c);
        if (wr == 1) PG8_BAR;
        PG8_WAIT_V(2); PG8_BAR;
        PG8_STAGE(PG8_SB(1, 0), cB + kstep, voffB); PG8_STAGEA(PG8_SA(1, 0), cA + kstep, 0, tab_c); PG8_STAGE(PG8_SB(1, 1), cB + hstepB + kstep, voffB);
        PG8_WAIT_V(6); PG8_BAR;
    } else {
        PG8_STAGE(PG8_SB(0, 0), cB, voffB); PG8_STAGEA(PG8_SA(0, 0), cA, 0, tab_c); PG8_STAGE(PG8_SB(0, 1), cB + hstepB, voffB); PG8_STAGEA(PG8_SA(0, 1), cA, 1, tab_c);
        if (wr == 1) PG8_BAR;
        PG8_WAIT_V(4); PG8_BAR;
        PG8_STAGE(PG8_SB(1, 0), cB + kstep, voffB); PG8_STAGEA(PG8_SA(1, 0), cA + kstep, 0, tab_c); PG8_STAGE(PG8_SB(1, 1), cB + hstepB + kstep, voffB);
        PG8_WAIT_V(6); PG8_BAR;
    }
    for (;;) {
        const bool has_next = S.next(ui + 1, nxt);
        const unsigned nA = has_next ? S.a_off(nxt) : cA, nB = has_next ? S.b_off(nxt) : cB;
        if constexpr (GATHER) { if (has_next && wid < 4) {
            const unsigned dst_ = (unsigned)__builtin_amdgcn_readfirstlane((int)(unsigned)(unsigned long)(lds + STAGE_BYTES + ((tab_c ^ 1) * 256 + wid * 64) * 4));
            const unsigned vo_ = (unsigned)((wid * 64 + lane) * 4); const unsigned so_ = S.tok_off(nxt);
            asm volatile("s_nop 4\n\ts_mov_b32 m0, %0\n\ts_nop 0\n\tbuffer_load_dword %1, %2, %3 offen lds" :: "s"(dst_), "v"(vo_), "s"(rsrc), "s"(so_) : "m0", "memory"); } }
#ifdef GP_PROBE
        const unsigned long long gp_t0 = __builtin_amdgcn_s_memtime();
#endif
#pragma nounroll
        for (int t = 0; t < nt; t += 2) {
            const bool last = (t == nt - 2);
            const unsigned a1 = cA + (unsigned)(t + 1) * kstep;
            const unsigned a2 = last ? nA : cA + (unsigned)(t + 2) * kstep, b2 = last ? nB : cB + (unsigned)(t + 2) * kstep;
            const unsigned a3 = a2 + kstep, b3 = b2 + kstep; const int tab_2 = last ? (tab_c ^ 1) : tab_c; (void)tab_2;
            if constexpr (SP2) {
            PG8_LDB(B0, 0, 0); PG8_LDB(B1, 0, 1); PG8_SCHED; PG8_LDA(At, 0, 0); PG8_STAGEA(PG8_SA(1, 1), a1, 1, tab_c);
            PG8_WAIT_V(8); PG8_WAIT_L(0); PG8_BAR; PG8_MMA(0, 0, At, B0); PG8_MMA(0, 1, At, B1); PG8_BAR; PG8_SCHED;
            PG8_LDA(At, 0, 1); PG8_STAGE(PG8_SB(0, 0), b2, voffB); PG8_STAGE(PG8_SB(0, 1), b2 + hstepB, voffB); PG8_STAGEA(PG8_SA(0, 0), a2, 0, tab_2);
            PG8_WAIT_V(8); PG8_WAIT_L(0); PG8_BAR; PG8_MMA(1, 0, At, B0); PG8_MMA(1, 1, At, B1); PG8_BAR; PG8_SCHED;
            PG8_LDB(B0, 1, 0); PG8_LDB(B1, 1, 1); PG8_SCHED; PG8_LDA(At, 1, 0); PG8_STAGEA(PG8_SA(0, 1), a2, 1, tab_2);
            PG8_WAIT_V(8); PG8_WAIT_L(0); PG8_BAR; PG8_MMA(0, 0, At, B0); PG8_MMA(0, 1, At, B1); PG8_BAR; PG8_SCHED;
            PG8_LDA(At, 1, 1); PG8_STAGE(PG8_SB(1, 0), b3, voffB); PG8_STAGE(PG8_SB(1, 1), b3 + hstepB, voffB); PG8_STAGEA(PG8_SA(1, 0), a3, 0, tab_2);
            PG8_WAIT_V(8); PG8_WAIT_L(0); PG8_BAR; PG8_MMA(1, 0, At, B0); PG8_MMA(1, 1, At, B1); PG8_BAR; PG8_SCHED;
            } else {
            PG8_LDB(B0, 0, 0); PG8_SCHED; PG8_LDA(At, 0, 0); PG8_STAGEA(PG8_SA(1, 1), a1, 1, tab_c);
            PG8_WAIT_L(8); PG8_BAR; PG8_WAIT_L(0); PG8_MMA(0, 0, At, B0); PG8_BAR; PG8_SCHED;
            PG8_LDB(B1, 0, 1); PG8_STAGE(PG8_SB(0, 0), b2, voffB);
            PG8_BAR; PG8_WAIT_L(0); PG8_MMA(0, 1, At, B1); PG8_BAR;
            PG8_LDA(At, 0, 1); PG8_STAGEA(PG8_SA(0, 0), a2, 0, tab_2);
            PG8_BAR; PG8_WAIT_L(0); PG8_MMA(1, 0, At, B0); PG8_BAR; PG8_SCHED;
            PG8_STAGE(PG8_SB(0, 1), b2 + hstepB, voffB);
            PG8_WAIT_V(6); PG8_BAR; PG8_MMA(1, 1, At, B1); PG8_BAR;
            PG8_LDB(B0, 1, 0); PG8_SCHED; PG8_LDA(At, 1, 0); PG8_STAGEA(PG8_SA(0, 1), a2, 1, tab_2);
            PG8_WAIT_L(8); PG8_BAR; PG8_WAIT_L(0); PG8_MMA(0, 0, At, B0); PG8_BAR; PG8_SCHED;
            PG8_LDB(B1, 1, 1); PG8_STAGE(PG8_SB(1, 0), b3, voffB);
            PG8_BAR; PG8_WAIT_L(0); PG8_MMA(0, 1, At, B1); PG8_BAR;
            PG8_LDA(At, 1, 1); PG8_STAGEA(PG8_SA(1, 0), a3, 0, tab_2);
            PG8_BAR; PG8_WAIT_L(0); PG8_MMA(1, 0, At, B0); PG8_BAR; PG8_SCHED;
            PG8_STAGE(PG8_SB(1, 1), b3 + hstepB, voffB);
            PG8_WAIT_V(6); PG8_BAR; PG8_MMA(1, 1, At, B1); PG8_BAR;
            }
        }
#ifdef GP_PROBE
        if (gp_out) { gp_cycles += __builtin_amdgcn_s_memtime() - gp_t0; gp_tiles += nt; }
#endif
        if constexpr (ALIGN_EPI) { if (wr == 0) PG8_BAR; }
        if (has_next) S.prefetch(nxt, rsrc, lds, wid, lane);
        { int fr_e = fr, fq_e = fq; asm volatile("" : "+v"(fr_e), "+v"(fq_e));
          E(acc, cur, wr, wc, fr_e, fq_e); }
        if (!has_next) break;
        { int fq_i = fq; asm volatile("" : "+v"(fq_i)); E.init(acc, nxt, wc, fq_i); }
        cur = nxt; cA = nA; cB = nB; ++ui; tab_c ^= 1;
        if constexpr (ALIGN_EPI) { if (wr == 1) PG8_BAR; }
    }
    PG8_WAIT_V(0);
    if constexpr (!ALIGN_EPI) { if (wr == 0) PG8_BAR; }
    PG8_BAR;
#ifdef GP_PROBE
    if (gp_out && blockIdx.x == GP_BLOCK && tid == 0) { gp_out[0] = gp_cycles; gp_out[1] = gp_tiles; gp_out[2] = __builtin_amdgcn_s_memtime() - gp_p0; gp_out[3] = __builtin_amdgcn_s_memrealtime() - gp_r0; gp_out[4] = (unsigned long long)(ui + 1); }
#endif
#undef PG8_SA
#undef PG8_SB
#undef PG8_STAGE
#undef p2voffA
#undef PG8_STAGEA
#undef p2voffB
#undef PG8_LDA
#undef PG8_LDB
#undef PG8_MMA
#undef PG8_CAT
#undef PG8_WAIT_V
#undef PG8_WAIT_L
#undef PG8_BAR
#undef PG8_SCHED
}
}
using pg8::Unit;

constexpr size_t MiB = 1u << 20;
constexpr size_t WS_CTL = 0, CTL_ZERO_BYTES = 1 * MiB;
constexpr size_t WS_WIN = 1 * MiB;
constexpr size_t WS_WQ = 7 * MiB;
constexpr size_t WS_WKV = WS_WQ + 512 * 1024;
constexpr size_t WS_WPOOL = 8 * MiB;
constexpr size_t WS_WAO = 9 * MiB;
constexpr size_t WS_WPO = 10 * MiB;
constexpr size_t WS_WO = 11 * MiB;
constexpr size_t WS_WPG = 13 * MiB;
constexpr size_t WS_WPLE = 15 * MiB;
constexpr size_t WS_WGU = 16 * MiB;
constexpr size_t WS_WD = 144 * MiB;
constexpr size_t WS_HN = 208 * MiB;
constexpr size_t WS_PROJ = 240 * MiB;
constexpr size_t WS_GATES = 272 * MiB;
constexpr size_t WS_A2 = 336 * MiB;
constexpr size_t WS_POOLED = 352 * MiB;
constexpr size_t WS_Q = 368 * MiB;
constexpr size_t WS_K = 392 * MiB;
constexpr size_t WS_V = 416 * MiB;
constexpr size_t WS_ATT = 432 * MiB;
constexpr size_t WS_MIXED = 448 * MiB;
constexpr size_t WS_MIX = 464 * MiB;
constexpr size_t WS_PB = 496 * MiB;
constexpr size_t WS_E = 504 * MiB;
constexpr size_t WS_SSQ = 536 * MiB;
constexpr size_t WS_COS = 537 * MiB;
constexpr size_t WS_SIN = 538 * MiB;
constexpr size_t WS_ROUTE = 539 * MiB;
constexpr size_t WS_TOK = 541 * MiB;
constexpr size_t WS_XS = 544 * MiB;
constexpr size_t WS_ACT = 688 * MiB;
constexpr size_t WS_XS2 = 768 * MiB;
constexpr size_t WS_WIN8 = 848 * MiB;
constexpr size_t WS_HN8 = 852 * MiB;
constexpr size_t WS_END = 868 * MiB;
constexpr size_t WS_X1B = WS_PROJ;
constexpr size_t WS_X2B = WS_MIX;
constexpr int CW_BAR = 4096;
constexpr int CW_CNT = 1024;

constexpr int RING_BYTES = 131072;
constexpr int LDS_BYTES = 163840;
constexpr int MISC_OFF = LDS_BYTES - 512;
constexpr int TILE_E_OFF = LDS_BYTES - 4096;
constexpr int NWAVES = 8;

typedef GAS unsigned gu32;
#define RLX_AGENT __ATOMIC_RELAXED, __HIP_MEMORY_SCOPE_AGENT
#define XB_TMO      128
#define XB_XCNT(j)  (256  + 64 * (j))
#define XB_XSUB(j)  (1280 + 64 * (j))
#define XB_XGEN(j)  (2304 + 64 * (j))
#define XB_TOP      3328
#define XB_TOPGEN   3392
#define XCD_BAR_WORDS 3456
#define XB_SPIN_CAP (1u << 18)
__device__ __forceinline__ unsigned xb_ld(unsigned* p)              { return __hip_atomic_load(p, __ATOMIC_RELAXED, __HIP_MEMORY_SCOPE_AGENT); }
__device__ __forceinline__ unsigned xb_add(unsigned* p, unsigned v) { return __hip_atomic_fetch_add(p, v, __ATOMIC_RELAXED, __HIP_MEMORY_SCOPE_AGENT); }
__device__ __forceinline__ unsigned xb_xcc_id() { return (unsigned)__builtin_amdgcn_s_getreg((3 << 11) | 20) & 0xFu; }
#define XB_SPIN(cond, bar) do { unsigned _sp = 0; while (cond) { __builtin_amdgcn_s_sleep(1); \
    if ((++_sp & 255u) == 0u) { if (xb_ld(&(bar)[XB_TMO])) break; if (_sp > XB_SPIN_CAP) { atomicAdd(&(bar)[XB_TMO], 1u); break; } } } } while (0)
struct XcdBarrier { unsigned* bar; unsigned x; volatile LAS unsigned* st; };
__device__ __forceinline__ XcdBarrier xcd_barrier_post(unsigned* bar, volatile LAS unsigned* st) {
    XcdBarrier b; b.bar = bar; b.x = xb_xcc_id(); b.st = st;
    if (threadIdx.x == 0) (void)xb_add(&bar[XB_XCNT(b.x)], 1u);
    return b;
}
__device__ __forceinline__ void xcd_barrier_complete(unsigned* bar, unsigned x, unsigned& nloc, unsigned& nx) {
    const unsigned G = gridDim.x * gridDim.y * gridDim.z;
    unsigned sum, cnt, mine, sp = 0u;
    for (;;) {
        sum = 0u; cnt = 0u; mine = 0u;
#pragma unroll
        for (unsigned j = 0; j < 16; ++j) { const unsigned c = xb_ld(&bar[XB_XCNT(j)]); sum += c; cnt += (c > 0u) ? 1u : 0u; mine = (j == x) ? c : mine; }
        if (sum == G) break;
        __builtin_amdgcn_s_sleep(1);
        if ((++sp & 255u) == 0u) { if (xb_ld(&bar[XB_TMO])) break; if (sp > XB_SPIN_CAP) { atomicAdd(&bar[XB_TMO], 1u); break; } }
    }
    nloc = mine > 0u ? mine : 1u; nx = cnt > 0u ? cnt : 1u;
}
__device__ __forceinline__ void xcd_barrier(const XcdBarrier& b) {
    asm volatile("s_waitcnt vmcnt(0)" ::: "memory");
    __syncthreads();
    if (threadIdx.x == 0) {
        unsigned* bar = b.bar;
        __builtin_amdgcn_s_waitcnt(0);
        unsigned nloc = b.st[0], nx = b.st[1];
        if (nloc == 0u) { xcd_barrier_complete(bar, b.x, nloc, nx); b.st[0] = nloc; b.st[1] = nx; }
        const unsigned old = xb_add(&bar[XB_XSUB(b.x)], 1u);
        const unsigned gen = old / nloc;
        if (old + 1u == (gen + 1u) * nloc) {
            __builtin_amdgcn_fence(__ATOMIC_RELEASE, "agent");
            asm volatile("s_waitcnt vmcnt(0)" ::: "memory");
            const unsigned og = xb_add(&bar[XB_TOP], 1u);
            const unsigned tg = og / nx;
            if (og + 1u == (tg + 1u) * nx) xb_add(&bar[XB_TOPGEN], 1u);
            else XB_SPIN(xb_ld(&bar[XB_TOPGEN]) == tg, bar);
            __builtin_amdgcn_fence(__ATOMIC_ACQUIRE, "agent");
            xb_add(&bar[XB_XGEN(b.x)], 1u);
            asm volatile("s_waitcnt vmcnt(0)" ::: "memory");
        } else {
            XB_SPIN(xb_ld(&bar[XB_XGEN(b.x)]) == gen, bar);
            __builtin_amdgcn_fence(__ATOMIC_ACQUIRE, "agent");
            asm volatile("s_waitcnt vmcnt(0)" ::: "memory");
        }
    }
    __syncthreads();
}

#ifdef GP_PROBE
#define GP_AT(k) ((k) == GP_PHASE ? (unsigned long long*)(ws + WS_CTL + 65536) : nullptr)
#else
#define GP_AT(k) nullptr
#endif
struct Args {
    const float* in[27];
    float* out; unsigned char* ws;
    int ph_lo, ph_hi;
};
typedef const __attribute__((address_space(4))) Args* KArgs;
__device__ __forceinline__ KArgs kargs() { KArgs p = (KArgs)__builtin_amdgcn_kernarg_segment_ptr(); asm volatile("" : "+s"(p)); return p; }
enum { I_X = 0, I_P, I_POS, I_GMIX, I_WIN, I_GQLAT, I_WQB, I_GKVLAT, I_WKVB, I_GQHEAD, I_GKNOPE, I_GKROPE, I_WPOOL, I_PSCALE, I_WAO, I_WPO, I_WO, I_GFFN,
       I_WR, I_BR, I_WGU, I_BGU, I_WD, I_BD, I_GPLE, I_WPG, I_WPLE };

enum { MAP_ID = 0, MAP_WIN, MAP_GU, MAP_QB, MAP_KVB };
__device__ __forceinline__ int map_row(int mode, int n) {
    switch (mode) {
    case MAP_WIN: return n < 416 ? n : n + 96;
    case MAP_GU: { const int j = n & 1023, up = n >> 10; return 256 * (j >> 7) + 128 * up + (j & 127); }
    case MAP_QB: { const int h = n / 96, d = n % 96;
        if (d < 64) return (h >> 2) * 256 + 128 * (d >> 5) + 32 * (h & 3) + (d & 31);
        const int dd = d - 64, half = dd >> 4, i = dd & 15; return 512 + 128 * (h & 1) + 32 * (h >> 1) + 8 * (i >> 2) + 4 * half + (i & 3); }
    case MAP_KVB: { const int h = n >> 7, c = n & 127, isv = c >> 6, d = c & 63; return (h >> 1) * 256 + 128 * (d >> 5) + 32 * (2 * isv + (h & 1)) + (d & 31); }
    default: return n;
    }
}
struct TJob { const float* W; int K, N; bf16_t* WT; int ldw, koff, mode, row_off; const float* gk; const float* gn; int nmat; size_t wstride, wtstride; int fp8; };
struct TItem { const float* src; bf16_t* dst; int n0, k0; float gnv; };
__device__ __forceinline__ TItem titem_setup(const TJob& J, int item, int lane) {
    const int nblk = J.N / 32, ipm = (J.K / 64) * nblk, mat = item / ipm, it = item - mat * ipm, kb = it / nblk, nb = it - kb * nblk;
    TItem I; I.k0 = 64 * kb; I.n0 = 32 * nb;
    I.src = J.W + (size_t)mat * J.wstride + (size_t)(I.k0 + (lane >> 5)) * J.N + I.n0 + (lane & 31);
    I.dst = (bf16_t*)((unsigned char*)J.WT + (size_t)mat * J.wtstride * (J.fp8 ? 1 : 2));
    I.gnv = J.gn ? J.gn[I.n0 + (lane & 31)] : 1.f;
    return I;
}
__device__ __forceinline__ void titem_load(const TJob& J, const TItem& I, float (&v)[32]) {
#pragma unroll
    for (int i = 0; i < 32; ++i) v[i] = I.src[(size_t)(2 * i) * J.N];
}
__device__ __forceinline__ void titem_store(const TJob& J, const TItem& I, float (&v)[32], LAS float* scr, int lane) {
#pragma unroll
    for (int i = 0; i < 32; ++i) { const int kk = 2 * i + (lane >> 5); float x = v[i] * I.gnv; if (J.gk) x *= J.gk[I.k0 + kk]; scr[kk * 33 + (lane & 31)] = x; }
    asm volatile("s_waitcnt lgkmcnt(0)" ::: "memory");
    const int c = lane & 7;
#pragma unroll
    for (int j = 0; j < 4; ++j) { const int n = (lane >> 3) + 8 * j; const LAS float* s = scr + (8 * c) * 33 + n;
        const size_t eo = (size_t)(J.row_off + map_row(J.mode, I.n0 + n)) * J.ldw + J.koff + I.k0 + 8 * c;
        if (J.fp8) { u32x2 o; int w = __builtin_amdgcn_cvt_pk_fp8_f32(s[0 * 33] * 8.f, s[1 * 33] * 8.f, 0, false); w = __builtin_amdgcn_cvt_pk_fp8_f32(s[2 * 33] * 8.f, s[3 * 33] * 8.f, w, true); o.x = (unsigned)w;
            w = __builtin_amdgcn_cvt_pk_fp8_f32(s[4 * 33] * 8.f, s[5 * 33] * 8.f, 0, false); w = __builtin_amdgcn_cvt_pk_fp8_f32(s[6 * 33] * 8.f, s[7 * 33] * 8.f, w, true); o.y = (unsigned)w;
            *(u32x2*)((unsigned char*)I.dst + eo) = o; }
        else { u32x4 o; o.x = cvt_pk_bf16(s[0 * 33], s[1 * 33]); o.y = cvt_pk_bf16(s[2 * 33], s[3 * 33]); o.z = cvt_pk_bf16(s[4 * 33], s[5 * 33]); o.w = cvt_pk_bf16(s[6 * 33], s[7 * 33]);
            *(u32x4*)(I.dst + eo) = o; } }
    asm volatile("s_waitcnt lgkmcnt(0)" ::: "memory");
}
__device__ __forceinline__ void run_job(const TJob& J, LAS float* scr, int gw, int NGW, int lane) {
    const int items = J.nmat * (J.K / 64) * (J.N / 32);
    for (int it = gw; it < items; it += 2 * NGW) {
        const bool two = (it + NGW) < items;
        const TItem I0 = titem_setup(J, it, lane); const TItem I1 = titem_setup(J, two ? it + NGW : it, lane);
        float v0[32], v1[32];
        titem_load(J, I0, v0); if (two) titem_load(J, I1, v1);
        titem_store(J, I0, v0, scr, lane); if (two) titem_store(J, I1, v1, scr, lane);
    }
}

struct Frame {
    LAS unsigned char* lds; volatile LAS unsigned* MISC; unsigned* ctl;
    int wave, vcu, G;
    float* out; unsigned char* ws;
};

__device__ __forceinline__ void p0_prologue(const Frame& F) {
    const int tid_l = tid_local(), lane_l = tid_l & 63; (void)tid_l; (void)lane_l;
    const KArgs a = kargs();
    LAS float* scr = (LAS float*)(F.lds + F.wave * 16384);
    const int gw = F.vcu * NWAVES + F.wave, NGW = F.G * NWAVES;
    unsigned char* ws = F.ws;
    int joff = 0;
#define RUN_JOB(...) do { const TJob J_ = TJob{__VA_ARGS__, 1, 0, 0, 0}; run_job(J_, scr, (gw + NGW - joff % NGW) % NGW, NGW, lane_l); joff += (J_.K / 64) * (J_.N / 32); } while (0)
#ifndef P1_FP8
#define P1_FP8 0
#endif
    { const TJob J_{a->in[I_WIN], 1024, 2976, (bf16_t*)(ws + WS_WIN), 1024, 0, MAP_WIN, 0, nullptr, nullptr, 1, 0, 0, P1_FP8}; run_job(J_, scr, gw, NGW, lane_l); joff += 16 * 93; }
#ifndef GATES_FP8
#define GATES_FP8 0
#endif
    if (GATES_FP8) { const TJob J_{a->in[I_WIN], 1024, 2976, (bf16_t*)(ws + WS_WIN8), 1024, 0, MAP_WIN, 0, nullptr, nullptr, 1, 0, 0, 1}; run_job(J_, scr, gw, NGW, lane_l); }
    RUN_JOB(a->in[I_WQB], 256, 768, (bf16_t*)(ws + WS_WQ), 256, 0, MAP_QB, 0, a->in[I_GQLAT], nullptr);
    RUN_JOB(a->in[I_WKVB], 128, 1024, (bf16_t*)(ws + WS_WKV), 256, 0, MAP_KVB, 0, a->in[I_GKVLAT], nullptr);
    RUN_JOB(a->in[I_WAO], 512, 1024, (bf16_t*)(ws + WS_WAO), 512, 0, MAP_ID, 0, nullptr, nullptr);
    RUN_JOB(a->in[I_WPO], 512, 1024, (bf16_t*)(ws + WS_WPO), 512, 0, MAP_ID, 0, nullptr, nullptr);
    RUN_JOB(a->in[I_WO], 1024, 1024, (bf16_t*)(ws + WS_WO), 1024, 0, MAP_ID, 0, nullptr, nullptr);
#ifndef PLE_FP8
#define PLE_FP8 1
#endif
    { const TJob J_{a->in[I_WPG], 1024, 1024, (bf16_t*)(ws + WS_WPG), 1024, 0, MAP_ID, 0, nullptr, nullptr, 1, 0, 0, PLE_FP8}; run_job(J_, scr, (gw + NGW - joff % NGW) % NGW, NGW, lane_l); joff += 16 * 32; }
    RUN_JOB(a->in[I_WPLE], 256, 1024, (bf16_t*)(ws + WS_WPLE), 256, 0, MAP_ID, 0, nullptr, nullptr);
    for (int g = 0; g < 4; ++g)
        RUN_JOB(a->in[I_WPOOL] + (size_t)g * 128 * 128, 128, 128, (bf16_t*)(ws + WS_WPOOL) + (size_t)(g >> 1) * 256 * 256, 256, 128 * (g & 1), MAP_ID, 128 * (g & 1), nullptr, a->in[I_PSCALE] + 128 * g);
    {
        const int gt = (F.vcu * NWAVES + F.wave) * 64 + lane_l, NGT = NGW * 64;
        const u32x4 z = {0u, 0u, 0u, 0u};
        u32x4* w0 = (u32x4*)(ws + WS_WIN + (size_t)416 * 1024 * (P1_FP8 ? 1 : 2));
        for (int i = gt; i < 96 * (P1_FP8 ? 64 : 128); i += NGT) w0[i] = z;
        for (int i = gt; i < 1024 * 16; i += NGT) { const int r = i >> 4, c = i & 15; *(u32x4*)((bf16_t*)(ws + WS_WKV) + (size_t)r * 256 + 128 + 8 * c) = z; }
        for (int i = gt; i < 2 * 256 * 16; i += NGT) { const int p = i >> 12, r = (i >> 4) & 255, c = i & 15;
            const int k0 = (r < 128) ? 128 : 0; *(u32x4*)((bf16_t*)(ws + WS_WPOOL) + (size_t)p * 65536 + (size_t)r * 256 + k0 + 8 * c) = z; }
    }
#ifndef CONV_IN_ATTN
#define CONV_IN_ATTN 1
#endif
    if (!CONV_IN_ATTN) {
    { const TJob J{a->in[I_WGU], 1024, 2048, (bf16_t*)(ws + WS_WGU), 1024, 0, MAP_GU, 0, nullptr, nullptr, NEXP, (size_t)1024 * 2048, (size_t)2048 * 1024, 1}; run_job(J, scr, gw, NGW, lane_l); }
    { const TJob J{a->in[I_WD], 1024, 1024, (bf16_t*)(ws + WS_WD), 1024, 0, MAP_ID, 0, nullptr, nullptr, NEXP, (size_t)1024 * 1024, (size_t)1024 * 1024, 1}; run_job(J, scr, gw, NGW, lane_l); }
    }
    const float* x = a->in[I_X]; const float* gm = a->in[I_GMIX];
    f32x4 gv[4];
#pragma unroll
    for (int j = 0; j < 4; ++j) gv[j] = *(const f32x4*)(gm + 4 * lane_l + 256 * j);
    for (int m = gw; m < T; m += NGW) {
        const f32x4* xr = (const f32x4*)(x + (size_t)m * DM) + lane_l;
        f32x4 v[4]; float s = 0.f;
#pragma unroll
        for (int j = 0; j < 4; ++j) { v[j] = xr[64 * j]; s += (v[j].x * v[j].x + v[j].y * v[j].y) + (v[j].z * v[j].z + v[j].w * v[j].w); }
        const float rstd = 1.0f / sqrtf(wave_sum(s) * (1.f / DM) + EPS);
        if (P1_FP8) { int* o4 = (int*)(ws + WS_HN + (size_t)m * DM) + lane_l; const float r8 = rstd * 8.0f;
#pragma unroll
            for (int j = 0; j < 4; ++j) { int w = __builtin_amdgcn_cvt_pk_fp8_f32(v[j].x * r8 * gv[j].x, v[j].y * r8 * gv[j].y, 0, false); w = __builtin_amdgcn_cvt_pk_fp8_f32(v[j].z * r8 * gv[j].z, v[j].w * r8 * gv[j].w, w, true); o4[64 * j] = w; } }
        else { u32x2* o8 = (u32x2*)((bf16_t*)(ws + WS_HN) + (size_t)m * DM) + lane_l;
#pragma unroll
            for (int j = 0; j < 4; ++j) { u32x2 w; w.x = cvt_pk_bf16(v[j].x * rstd * gv[j].x, v[j].y * rstd * gv[j].y); w.y = cvt_pk_bf16(v[j].z * rstd * gv[j].z, v[j].w * rstd * gv[j].w); o8[64 * j] = w; }
            if (GATES_FP8) { int* o4 = (int*)(ws + WS_HN8 + (size_t)m * DM) + lane_l; const float r8 = rstd * 8.0f;
#pragma unroll
                for (int j = 0; j < 4; ++j) { int w = __builtin_amdgcn_cvt_pk_fp8_f32(v[j].x * r8 * gv[j].x, v[j].y * r8 * gv[j].y, 0, false); w = __builtin_amdgcn_cvt_pk_fp8_f32(v[j].z * r8 * gv[j].z, v[j].w * r8 * gv[j].w, w, true); o4[64 * j] = w; } } }
    }
    {
        const float* p = a->in[I_P];
        for (int m = gw; m < T; m += NGW) { const f32x4 v = *((const f32x4*)(p + (size_t)m * PLE) + lane_l); u32x2 w; w.x = cvt_pk_bf16(v.x, v.y); w.y = cvt_pk_bf16(v.z, v.w);
            *((u32x2*)((bf16_t*)(ws + WS_PB) + (size_t)m * PLE) + lane_l) = w; }
    }
}

struct DenseOrder {
    int nM, nN, nwg, G, c; unsigned A, B, tA, tB, aPn;
    __device__ void init(int nM_, int nN_, int G_, int c_, size_t A_, size_t lda, size_t B_, size_t ldb, unsigned aPn_ = 0) { nM = nM_; nN = nN_; nwg = nM * nN; G = G_; c = c_; A = (unsigned)A_; B = (unsigned)B_; tA = (unsigned)(256 * lda * 2); tB = (unsigned)(256 * ldb * 2); aPn = aPn_; }
    __device__ __forceinline__ bool next(int i, Unit& u) const {
        const long L = (long)i * G + c; if (L >= nwg) return false;
        int wgid = (int)L; { const int q = nwg / 8, r = nwg % 8, xcd = wgid % 8, off = wgid / 8; wgid = (xcd < r ? xcd * (q + 1) : r * (q + 1) + (xcd - r) * q) + off; }
        const int WGM = 8; const int nig = WGM * nN, gid = wgid / nig, fm = gid * WGM, gsz = (nM - fm) < WGM ? (nM - fm) : WGM;
        u.pm = fm + ((wgid % nig) % gsz); u.pn = (wgid % nig) / gsz; u.aux = 0; return true;
    }
    __device__ __forceinline__ void prefetch(const Unit&, const __amdgpu_buffer_rsrc_t, LAS unsigned char*, int, int) const {}
    __device__ __forceinline__ unsigned a_off(const Unit& u) const { return A + (unsigned)u.pm * tA + (unsigned)u.pn * aPn; }
    __device__ __forceinline__ unsigned b_off(const Unit& u) const { return B + (unsigned)u.pn * tB; }
};

struct EpiBf16 {
    static constexpr bool PERM = true;
    __device__ __forceinline__ void init(f32x4 (&acc)[2][2][4][2], const Unit&, int, int) const {
#pragma unroll
        for (int a = 0; a < 2; ++a)
#pragma unroll
            for (int b = 0; b < 2; ++b)
#pragma unroll
                for (int m = 0; m < 4; ++m)
#pragma unroll
                    for (int n = 0; n < 2; ++n) acc[a][b][m][n] = (f32x4){0.f, 0.f, 0.f, 0.f};
    }
    bf16_t* O; int ldc;
    __device__ __forceinline__ void operator()(const f32x4 (&acc)[2][2][4][2], const Unit& u, int wr, int wc, int fr, int fq) const {
        const int row0 = u.pm * 256 + wr * 64 + fr, col0 = u.pn * 256 + wc * 32 + 8 * fq;
#pragma unroll
        for (int ai = 0; ai < 2; ++ai)
#pragma unroll
            for (int m = 0; m < 4; ++m) { bf16_t* rowp = O + (size_t)(row0 + ai * 128 + m * 16) * ldc + col0;
#pragma unroll
                for (int bj = 0; bj < 2; ++bj) { const f32x4 v0 = acc[ai][bj][m][0], v1 = acc[ai][bj][m][1];
                    u32x4 w; w.x = cvt_pk_bf16(v0[0], v0[1]); w.y = cvt_pk_bf16(v0[2], v0[3]); w.z = cvt_pk_bf16(v1[0], v1[1]); w.w = cvt_pk_bf16(v1[2], v1[3]);
                    *(u32x4*)(rowp + bj * 128) = w; } }
    }
};
struct EpiProj {
    static constexpr bool PERM = true;
    __device__ __forceinline__ void init(f32x4 (&acc)[2][2][4][2], const Unit&, int, int) const {
#pragma unroll
        for (int a = 0; a < 2; ++a)
#pragma unroll
            for (int b = 0; b < 2; ++b)
#pragma unroll
                for (int m = 0; m < 4; ++m)
#pragma unroll
                    for (int n = 0; n < 2; ++n) acc[a][b][m][n] = (f32x4){0.f, 0.f, 0.f, 0.f};
    }
    bf16_t* PROJ; bf16_t* GATES; int pn_off;
    __device__ __forceinline__ void operator()(const f32x4 (&acc)[2][2][4][2], const Unit& u, int wr, int wc, int fr, int fq) const {
        const int pn = u.pn + pn_off; const int row0 = u.pm * 256 + wr * 64 + fr; const bool isg = pn >= 4;
        bf16_t* O = isg ? GATES : PROJ; const int ldc = isg ? 2048 : 1024; const int col0 = (isg ? pn - 4 : pn) * 256 + wc * 32 + 8 * fq;
#pragma unroll
        for (int ai = 0; ai < 2; ++ai)
#pragma unroll
            for (int m = 0; m < 4; ++m) { bf16_t* rowp = O + (size_t)(row0 + ai * 128 + m * 16) * ldc + col0;
#pragma unroll
                for (int bj = 0; bj < 2; ++bj) { f32x4 v0 = acc[ai][bj][m][0], v1 = acc[ai][bj][m][1];
                    if (isg) {
#pragma unroll
                        for (int e = 0; e < 4; ++e) { v0[e] = fast_sigmoid(v0[e]); v1[e] = fast_sigmoid(v1[e]); }
                        if (GATE8) {
#pragma unroll
                            for (int e = 0; e < 4; ++e) { v0[e] = fmaxf(v0[e] * 256.0f, 0.002f); v1[e] = fmaxf(v1[e] * 256.0f, 0.002f); }
                            *(u32x2*)((unsigned char*)GATES + (size_t)(row0 + ai * 128 + m * 16) * 2048 + col0 + bj * 128) = cvt8_fp8(v0, v1, 1.0f); continue; } }
                    u32x4 w; w.x = cvt_pk_bf16(v0[0], v0[1]); w.y = cvt_pk_bf16(v0[2], v0[3]); w.z = cvt_pk_bf16(v1[0], v1[1]); w.w = cvt_pk_bf16(v1[2], v1[3]);
                    *(u32x4*)(rowp + bj * 128) = w; } asm volatile("" ::: "memory"); }
    }
};

__device__ __forceinline__ void p2_rows(const Frame& F) {
    const int tid_l = tid_local(), lane_l = tid_l & 63; (void)tid_l; (void)lane_l;
    const KArgs a = kargs();
    const int gw = F.vcu * NWAVES + F.wave, NGW = F.G * NWAVES, lane = lane_l;
    unsigned char* ws = F.ws;
    const bf16_t* PROJ = (const bf16_t*)(ws + WS_PROJ);
    bf16_t* A2 = (bf16_t*)(ws + WS_A2); bf16_t* POOLED = (bf16_t*)(ws + WS_POOLED); bf16_t* Kb = (bf16_t*)(ws + WS_K);
    float* COS = (float*)(ws + WS_COS); float* SIN = (float*)(ws + WS_SIN);
    const int* positions = (const int*)a->in[I_POS];
    const float gkr = (lane < 32) ? a->in[I_GKROPE][lane] : 0.f;
    const float inv_freq = __builtin_amdgcn_exp2f(-(float)(lane & 15) * (13.287712379549449f / 16.0f));
    const int w = 2 << (lane >> 4);
    for (int task = gw; task < T / 8; task += NGW) {
        const int t0 = task * 8, b = t0 / SEQ, s0 = t0 % SEQ;
        u32x2 qlv[8]; unsigned kvv[8]; bf16_t krr[8]; int posv[8];
#pragma unroll
        for (int i = 0; i < 8; ++i) { const bf16_t* pr = PROJ + (size_t)(t0 + i) * 1024; qlv[i] = *(const u32x2*)(pr + 4 * lane); kvv[i] = *(const unsigned*)(pr + 256 + 2 * lane); krr[i] = pr[384 + (lane & 31)]; posv[i] = positions[t0 + i]; }
        {
            const bf16_t* base = PROJ + (size_t)(b * SEQ) * 1024 + 512 + 8 * lane;
            u32x4 I[15], C[8], L[8];
#pragma unroll
            for (int k = 0; k < 15; ++k) { const int r = s0 - 15 + k; I[k] = *(const u32x4*)(base + (size_t)(r < 0 ? 0 : r) * 1024); }
#pragma unroll
            for (int i = 0; i < 8; ++i) { C[i] = *(const u32x4*)(base + (size_t)(s0 + i) * 1024); const int rr = s0 + i - w + 1; L[i] = *(const u32x4*)(base + (size_t)(rr < 0 ? 0 : rr) * 1024); }
            float S[8];
#pragma unroll
            for (int j = 0; j < 8; ++j) S[j] = 0.f;
#pragma unroll
            for (int k = 0; k < 15; ++k) { const float mk = (s0 - 15 + k >= 0 && k >= 16 - w) ? 1.f : 0.f; const u32x4 v = I[k];
                S[0] += mk * bf_lo(v.x); S[1] += mk * bf_hi(v.x); S[2] += mk * bf_lo(v.y); S[3] += mk * bf_hi(v.y); S[4] += mk * bf_lo(v.z); S[5] += mk * bf_hi(v.z); S[6] += mk * bf_lo(v.w); S[7] += mk * bf_hi(v.w); }
#pragma unroll
            for (int i = 0; i < 8; ++i) {
                const int s = s0 + i;
                const u32x4 v = C[i];
                float uu[8] = {bf_lo(v.x), bf_hi(v.x), bf_lo(v.y), bf_hi(v.y), bf_lo(v.z), bf_hi(v.z), bf_lo(v.w), bf_hi(v.w)};
                const int cnt = (s + 1 < w) ? s + 1 : w; const float ic = 1.0f / (float)cnt;
                float o[8];
#pragma unroll
                for (int j = 0; j < 8; ++j) { S[j] += uu[j]; o[j] = S[j] * ic - uu[j]; }
                u32x4 wv; wv.x = cvt_pk_bf16(o[0], o[1]); wv.y = cvt_pk_bf16(o[2], o[3]); wv.z = cvt_pk_bf16(o[4], o[5]); wv.w = cvt_pk_bf16(o[6], o[7]);
                *(u32x4*)(POOLED + (size_t)(t0 + i) * 512 + 8 * lane) = wv;
                const float mq = (s - w + 1 >= 0) ? 1.f : 0.f; const u32x4 q = L[i];
                S[0] -= mq * bf_lo(q.x); S[1] -= mq * bf_hi(q.x); S[2] -= mq * bf_lo(q.y); S[3] -= mq * bf_hi(q.y); S[4] -= mq * bf_lo(q.z); S[5] -= mq * bf_hi(q.z); S[6] -= mq * bf_lo(q.w); S[7] -= mq * bf_hi(q.w);
            }
        }
#pragma unroll
        for (int i = 0; i < 8; ++i) {
            const int t = t0 + i, s = s0 + i;
            const u32x2 ql = qlv[i];
            const unsigned kvl = kvv[i];
            const float krv = (lane < 32) ? bf1(krr[i]) : 0.f;
            const float q0 = bf_lo(ql.x), q1 = bf_hi(ql.x), q2 = bf_lo(ql.y), q3 = bf_hi(ql.y);
            const float k0 = bf_lo(kvl), k1 = bf_hi(kvl);
            const float sq = wave_sum((q0 * q0 + q1 * q1) + (q2 * q2 + q3 * q3));
            const float sk = wave_sum(k0 * k0 + k1 * k1);
            const float sr = wave_sum(krv * krv);
            const float rq = 1.0f / sqrtf(sq * (1.f / 256.f) + EPS), rk = 1.0f / sqrtf(sk * (1.f / 128.f) + EPS), rr = 1.0f / sqrtf(sr * (1.f / 32.f) + EPS);
            u32x2 wq; wq.x = cvt_pk_bf16(q0 * rq, q1 * rq); wq.y = cvt_pk_bf16(q2 * rq, q3 * rq);
            *(u32x2*)(A2 + (size_t)t * 512 + 4 * lane) = wq;
            *(unsigned*)(A2 + (size_t)t * 512 + 256 + 2 * lane) = cvt_pk_bf16(k0 * rk, k1 * rk);
            *(unsigned*)(A2 + (size_t)t * 512 + 384 + 2 * lane) = 0u;
            const float pos = (float)posv[i];
            const float ang = pos * inv_freq;
            const float rev = ang * 0.15915494309189535f;
            const float fr_ = rev - floorf(rev);
            const float sn = __builtin_amdgcn_sinf(fr_), cs = __builtin_amdgcn_cosf(fr_);
            const float kn = krv * rr * gkr;
            const float other = __shfl_xor(kn, 16);
            const float ro = (lane & 16) ? (kn * cs + other * sn) : (kn * cs - other * sn);
            if (lane < 32) {
                const bf16_t rb = (bf16_t)(cvt_pk_bf16(ro, 0.f) & 0xffffu);
#pragma unroll
                for (int h = 0; h < NH; ++h) Kb[((size_t)(b * NH + h) * SEQ + s) * DK + 64 + lane] = rb;
            }
            if (lane < 16) { COS[(size_t)t * 16 + lane] = cs; SIN[(size_t)t * 16 + lane] = sn; }
        }
    }
}

#define EPI_FENCE() asm volatile("" ::: "memory")
struct EpiQ {
    static constexpr bool PERM = true;
    __device__ __forceinline__ void init(f32x4 (&acc)[2][2][4][2], const Unit&, int, int) const {
#pragma unroll
        for (int a = 0; a < 2; ++a)
#pragma unroll
            for (int b = 0; b < 2; ++b)
#pragma unroll
                for (int m = 0; m < 4; ++m)
#pragma unroll
                    for (int n = 0; n < 2; ++n) acc[a][b][m][n] = (f32x4){0.f, 0.f, 0.f, 0.f};
    }
    bf16_t* Q; float* SSQ; const float* COS; const float* SIN; const float* gq;
    __device__ __forceinline__ void operator()(const f32x4 (&acc)[2][2][4][2], const Unit& u, int wr, int wc, int fr, int fq) const {
        const int t0 = u.pm * 256 + wr * 64 + fr, b = (u.pm * 256) / SEQ, s0 = t0 - b * SEQ;
        if (u.pn < 2) {
            const int h = 4 * u.pn + wc;
            bf16_t* dst0 = Q + ((size_t)(b * NH + h) * SEQ + s0) * DK + 8 * fq;
            float* ssq0 = SSQ + ((size_t)t0 * NH + h) * 2;
            f32x4 gqv[2][2];
#pragma unroll
            for (int bj = 0; bj < 2; ++bj) { gqv[bj][0] = *(const f32x4*)(gq + 32 * bj + 8 * fq); gqv[bj][1] = *(const f32x4*)(gq + 32 * bj + 8 * fq + 4); }
#pragma unroll
            for (int ai = 0; ai < 2; ++ai)
#pragma unroll
                for (int m = 0; m < 4; ++m) {
                    const int dr = ai * 128 + m * 16;
                    float q = 0.f;
#pragma unroll
                    for (int bj = 0; bj < 2; ++bj)
#pragma unroll
                        for (int n = 0; n < 2; ++n) { const f32x4 v = acc[ai][bj][m][n]; q += (v[0] * v[0] + v[1] * v[1]) + (v[2] * v[2] + v[3] * v[3]); }
                    q += __shfl_xor(q, 16); q += __shfl_xor(q, 32);
                    if (fq == 0) ssq0[dr * NH * 2] = q;
#pragma unroll
                    for (int bj = 0; bj < 2; ++bj) { const f32x4 v0 = acc[ai][bj][m][0] * gqv[bj][0], v1 = acc[ai][bj][m][1] * gqv[bj][1];
                        u32x4 w; w.x = cvt_pk_bf16(v0[0], v0[1]); w.y = cvt_pk_bf16(v0[2], v0[3]); w.z = cvt_pk_bf16(v1[0], v1[1]); w.w = cvt_pk_bf16(v1[2], v1[3]);
                        *(u32x4*)(dst0 + dr * DK + 32 * bj) = w; }
                    EPI_FENCE();
                }
        } else {
            const f32x4 g1 = *(const f32x4*)(gq + 64 + 4 * fq), g2 = *(const f32x4*)(gq + 80 + 4 * fq);
            const float* cs0 = COS + (size_t)t0 * 16 + 4 * fq; const float* sn0 = SIN + (size_t)t0 * 16 + 4 * fq;
            bf16_t* dst0 = Q + ((size_t)(b * NH + 2 * wc) * SEQ + s0) * DK + 64 + 4 * fq;
            float* ssq0 = SSQ + ((size_t)t0 * NH + 2 * wc) * 2 + 1;
            f32x4 csb[3][2];
#define EQ_LD(g) do { const int d_ = ((g) >> 2) * 128 + ((g) & 3) * 16; csb[(g) % 3][0] = *(const f32x4*)(cs0 + d_ * 16); csb[(g) % 3][1] = *(const f32x4*)(sn0 + d_ * 16); } while (0)
            EQ_LD(0); EQ_LD(1); EQ_LD(2);
#pragma unroll
            for (int g = 0; g < 8; ++g) { const int ai = g >> 2, m = g & 3; {
                    const int dr = ai * 128 + m * 16;
                    __builtin_amdgcn_sched_barrier(0);
                    const f32x4 cs = csb[g % 3][0], sn = csb[g % 3][1];
#pragma unroll
                    for (int bj = 0; bj < 2; ++bj) {
                        const f32x4 x1 = acc[ai][bj][m][0], x2 = acc[ai][bj][m][1];
                        float q = (x1[0] * x1[0] + x1[1] * x1[1]) + (x1[2] * x1[2] + x1[3] * x1[3]) + (x2[0] * x2[0] + x2[1] * x2[1]) + (x2[2] * x2[2] + x2[3] * x2[3]);
                        q += __shfl_xor(q, 16); q += __shfl_xor(q, 32);
                        if (fq == 0) ssq0[dr * NH * 2 + bj * 2] = q;
                        const f32x4 y1 = x1 * g1, y2 = x2 * g2;
                        const f32x4 o1 = y1 * cs - y2 * sn, o2 = y2 * cs + y1 * sn;
                        bf16_t* dst = dst0 + (size_t)bj * SEQ * DK + dr * DK;
                        u32x2 w1, w2; w1.x = cvt_pk_bf16(o1[0], o1[1]); w1.y = cvt_pk_bf16(o1[2], o1[3]); w2.x = cvt_pk_bf16(o2[0], o2[1]); w2.y = cvt_pk_bf16(o2[2], o2[3]);
                        *(u32x2*)(dst) = w1; *(u32x2*)(dst + 16) = w2;
                    }
                    __builtin_amdgcn_sched_barrier(0);
                    if (g + 3 < 8) EQ_LD(g + 3);
                } }
#undef EQ_LD
        }
    }
};
struct EpiKV {
    static constexpr bool PERM = true;
    __device__ __forceinline__ void init(f32x4 (&acc)[2][2][4][2], const Unit&, int, int) const {
#pragma unroll
        for (int a = 0; a < 2; ++a)
#pragma unroll
            for (int b = 0; b < 2; ++b)
#pragma unroll
                for (int m = 0; m < 4; ++m)
#pragma unroll
                    for (int n = 0; n < 2; ++n) acc[a][b][m][n] = (f32x4){0.f, 0.f, 0.f, 0.f};
    }
    bf16_t* K; bf16_t* V; const float* gk;
    __device__ __forceinline__ void operator()(const f32x4 (&acc)[2][2][4][2], const Unit& u, int wr, int wc, int fr, int fq) const {
        const int t0 = u.pm * 256 + wr * 64 + fr, b = (u.pm * 256) / SEQ, s0 = t0 - b * SEQ;
        const int h = 2 * u.pn + (wc & 1); const bool isv = wc >= 2;
        const int pitch = isv ? DV : DK;
        bf16_t* dst0 = (isv ? V : K) + ((size_t)(b * NH + h) * SEQ + s0) * pitch + 8 * fq;
        f32x4 gkv[2][2];
#pragma unroll
        for (int bj = 0; bj < 2; ++bj) { gkv[bj][0] = *(const f32x4*)(gk + 32 * bj + 8 * fq); gkv[bj][1] = *(const f32x4*)(gk + 32 * bj + 8 * fq + 4); }
#pragma unroll
        for (int ai = 0; ai < 2; ++ai)
#pragma unroll
            for (int m = 0; m < 4; ++m) {
                const int dr = ai * 128 + m * 16;
                float sc = 1.f;
                if (!isv) { float q = 0.f;
#pragma unroll
                    for (int bj = 0; bj < 2; ++bj)
#pragma unroll
                        for (int n = 0; n < 2; ++n) { const f32x4 v = acc[ai][bj][m][n]; q += (v[0] * v[0] + v[1] * v[1]) + (v[2] * v[2] + v[3] * v[3]); }
                    q += __shfl_xor(q, 16); q += __shfl_xor(q, 32);
                    sc = 1.0f / sqrtf(q * (1.f / 64.f) + EPS); }
#pragma unroll
                for (int bj = 0; bj < 2; ++bj) {
                    f32x4 v0 = acc[ai][bj][m][0] * sc, v1 = acc[ai][bj][m][1] * sc;
                    if (!isv) { v0 = v0 * gkv[bj][0]; v1 = v1 * gkv[bj][1]; }
                    u32x4 w; w.x = cvt_pk_bf16(v0[0], v0[1]); w.y = cvt_pk_bf16(v0[2], v0[3]); w.z = cvt_pk_bf16(v1[0], v1[1]); w.w = cvt_pk_bf16(v1[2], v1[3]);
                    *(u32x4*)(dst0 + dr * pitch + 32 * bj) = w; }
                EPI_FENCE();
            }
    }
};

namespace att {
constexpr int KT_BYTES = 64 * 192, VT_BYTES = 64 * 128, SLOT_BYTES = KT_BYTES + VT_BYTES;
#ifndef ATT_PF
#define ATT_PF 3
#endif
constexpr int NSLOT = ATT_PF + 1, SCR_OFF = NSLOT * SLOT_BYTES;
__device__ __forceinline__ int crow(int r, int hi) { return (r & 3) + 8 * (r >> 2) + 4 * hi; }
__device__ __forceinline__ s16x4 vtr(const LAS unsigned char* p) { typedef short v4i16_t __attribute__((ext_vector_type(4)));
    return __builtin_bit_cast(s16x4, __builtin_amdgcn_ds_read_tr16_b64_v4i16((LAS v4i16_t*)p)); }
#define MFMA32(a, b, c) __builtin_amdgcn_mfma_f32_32x32x16_bf16(a, b, c, 0, 0, 0)
__device__ __forceinline__ float max3f(float a, float b, float c) { return __builtin_fmaxf(__builtin_fmaxf(a, b), c); }


constexpr int CONV_OFF = SCR_OFF + 8 * 256, CONV_BYTES = 8192;
constexpr int CV_GU_ITEMS = NEXP * 1024, CV_ITEMS = CV_GU_ITEMS + NEXP * 512;
struct ConvItem { const float* src; unsigned char* dst; int N, isgu, n0; };
__device__ __forceinline__ ConvItem cv_setup(int g, const float* wgu, const float* wd, unsigned char* wgu8, unsigned char* wd8) {
    ConvItem I;
    if (g < CV_GU_ITEMS) { const int e = g >> 10, it = g & 1023, kb = it >> 6, nb = it & 63; I.N = 2048; I.isgu = 1; I.n0 = 32 * nb;
        I.src = wgu + (size_t)e * 1024 * 2048 + (size_t)(64 * kb) * 2048 + 32 * nb; I.dst = wgu8 + (size_t)e * 2048 * 1024 + 64 * kb; }
    else { const int g2 = g - CV_GU_ITEMS, e = g2 >> 9, it = g2 & 511, kb = it >> 5, nb = it & 31; I.N = 1024; I.isgu = 0; I.n0 = 32 * nb;
        I.src = wd + (size_t)e * 1024 * 1024 + (size_t)(64 * kb) * 1024 + 32 * nb; I.dst = wd8 + (size_t)e * 1024 * 1024 + 64 * kb; }
    return I;
}
__device__ __forceinline__ void cv_dma(const ConvItem& I, unsigned ldsaddr, int lane) {
    const int kr = lane >> 3, sl = lane & 7;
#pragma unroll
    for (int q = 0; q < 8; ++q) { const unsigned voff = (unsigned)(((8 * q + kr) * I.N + 4 * (sl ^ ((kr ^ q) & 7))) * 4);
        asm volatile("s_nop 4\n\ts_mov_b32 m0, %0\n\ts_nop 0\n\tglobal_load_lds_dwordx4 %1, %2" :: "s"(ldsaddr + (unsigned)q * 1024u), "v"(voff), "s"(I.src) : "m0", "memory"); }
}
__device__ __forceinline__ void cv_out(const ConvItem& I, const LAS float* cb, int lane) {
    asm volatile("" : "+v"(lane));
    const int c = lane & 7;
#pragma unroll
    for (int j = 0; j < 4; ++j) { const int n = (lane >> 3) + 8 * j, nc = n >> 2, e = n & 3;
        float f[8];
#pragma unroll
        for (int kk = 0; kk < 8; ++kk) f[kk] = cb[(8 * c + kk) * 32 + ((nc ^ kk ^ c) & 7) * 4 + e];
        const int nn = I.n0 + n; const int row = I.isgu ? (256 * ((nn & 1023) >> 7) + 128 * (nn >> 10) + (nn & 127)) : nn;
        *(u32x2*)(I.dst + (size_t)row * 1024 + 8 * c) = cvt8_fp8((f32x4){f[0], f[1], f[2], f[3]}, (f32x4){f[4], f[5], f[6], f[7]}, 8.0f);
        asm volatile("" ::: "memory"); }
}
struct ConvState { int next, end, cur; };
__device__ __forceinline__ void attn_unit(LAS unsigned char* lds, const u32x4 srd, ConvState& CV, unsigned char* cvws, int bh, int qb, const bf16_t* Q_, unsigned Koff, unsigned Voff, const float* SSQ_, bf16_t* O_, const bool fast) {
    (void)Q_; (void)SSQ_; (void)O_;
    unsigned char* wl_ = cvws; asm volatile("" : "+s"(wl_));
    const bf16_t* Q = (const bf16_t*)(wl_ + WS_Q); const float* SSQ = (const float*)(wl_ + WS_SSQ); bf16_t* O = (bf16_t*)(wl_ + WS_ATT);
    const int tid = tid_local(), lane = tid & 63, r32 = lane & 31, hi = lane >> 5; const int wid = __builtin_amdgcn_readfirstlane(tid >> 6);
    const int b = bh / NH, h = bh % NH, q0 = qb * 256, qw = q0 + 32 * wid;
    LAS float* scr = (LAS float*)(lds + SCR_OFF) + wid * 64;
    const int NT = (q0 + 256) / 64;
    const unsigned kS = Koff + (unsigned)bh * (SEQ * DK * 2), vS = Voff + (unsigned)bh * (SEQ * DV * 2);
    const int kc2 = 8 + (wid & 3);
    const unsigned vK1 = (unsigned)(lane * 192 + wid * 16); const unsigned sK2 = (unsigned)((kc2 - wid) * 16);
    const int vkey = 8 * wid + (lane >> 3); const unsigned vV = (unsigned)(vkey * 128 + (((lane & 7) ^ (((vkey >> 1) & 1) * 4)) * 16));
    const unsigned lds0 = (unsigned)__builtin_amdgcn_readfirstlane((int)(unsigned)(unsigned long)lds);
    const unsigned dK1 = (unsigned)wid * 1024u, dK2 = (unsigned)kc2 * 1024u, dV = (unsigned)KT_BYTES + (unsigned)wid * 1024u;
#define ATT_DMA1(ldsaddr, voff, soff) asm volatile("s_nop 4\n\ts_mov_b32 m0, %0\n\ts_nop 0\n\tbuffer_load_dwordx4 %1, %2, %3 offen lds" :: "s"(ldsaddr), "v"(voff), "s"(srd), "s"(soff) : "m0", "memory")
#define ATT_DMA(t) do { const unsigned sp_ = lds0 + (unsigned)((t) % NSLOT) * SLOT_BYTES; const unsigned ks_ = kS + (unsigned)(t) * (64 * 192), vs_ = vS + (unsigned)(t) * (64 * 128); \
        ATT_DMA1(sp_ + dK1, vK1, ks_); ATT_DMA1(sp_ + dK2, vK1, ks_ + sK2); ATT_DMA1(sp_ + dV, vV, vs_); } while (0)
#define ATT_WAITBAR(N) asm volatile("s_waitcnt vmcnt(" #N ") lgkmcnt(0)\n\ts_barrier" ::: "memory")
    bf16x8 qr[6];
    { const float* sp = SSQ + ((size_t)(b * SEQ + qw + r32) * NH + h) * 2; const float ss = sp[0] + sp[1];
      const float cq = (1.0f / sqrtf(ss * (1.f / 96.f) + EPS)) * 0.10206207261596577f * 1.4426950408889634f;
      const bf16_t* qp = Q + ((size_t)bh * SEQ + qw + r32) * DK + 8 * hi;
      u32x4 qw_[6];
#pragma unroll
      for (int d0 = 0; d0 < 6; ++d0) qw_[d0] = *(const u32x4*)(qp + 16 * d0);
#pragma unroll
      for (int d0 = 0; d0 < 6; ++d0) { const u32x4 w = qw_[d0]; u32x4 o;
          o.x = cvt_pk_bf16(bf_lo(w.x) * cq, bf_hi(w.x) * cq); o.y = cvt_pk_bf16(bf_lo(w.y) * cq, bf_hi(w.y) * cq); o.z = cvt_pk_bf16(bf_lo(w.z) * cq, bf_hi(w.z) * cq); o.w = cvt_pk_bf16(bf_lo(w.w) * cq, bf_hi(w.w) * cq);
          qr[d0] = __builtin_bit_cast(bf16x8, o); } }
    ATT_DMA(0); ATT_DMA(1); ATT_DMA(2); if (ATT_PF == 4) ATT_DMA(3);
    const int kbase = hi * 1024 + r32 * 16;
    const int qq = (lane & 15) >> 2, pp = lane & 3, dblk = (lane >> 4) & 1, swz = ((qq >> 1) & 1) * 64;
    const int vrow0 = 4 * hi + qq;
    const int vb0 = KT_BYTES + vrow0 * 128 + ((32 * dblk + 8 * pp) ^ swz);
    const int vb1 = KT_BYTES + vrow0 * 128 + ((64 + 32 * dblk + 8 * pp) ^ swz);
    f32x16 o0 = {}, o1 = {};
    float m_run = -1e30f, l_run = 0.f; const f32x16 zero16 = {};
    const int qa = qw + r32;
#define ATT_QK(N0, N1, t) do { const LAS unsigned char* kp_ = lds + ((t) % NSLOT) * SLOT_BYTES + kbase; \
        _Pragma("unroll") for (int d0 = 0; d0 < 6; ++d0) { const bf16x8 ka_ = *(const LAS bf16x8*)(kp_ + d0 * 2048), kb_ = *(const LAS bf16x8*)(kp_ + d0 * 2048 + 512); \
            if (d0 == 0) { N0 = MFMA32(ka_, qr[0], zero16); N1 = MFMA32(kb_, qr[0], zero16); } else { N0 = MFMA32(ka_, qr[d0], N0); N1 = MFMA32(kb_, qr[d0], N1); } } } while (0)
#define ATT_MASK(N0, N1, t) do { const int kb_ = 64 * (t); if (kb_ + 63 > qw) { int d_ = qa - kb_ - 4 * hi; asm volatile("" : "+v"(d_));        \
        _Pragma("unroll") for (int r = 0; r < 16; ++r) { const int c_ = (r & 3) + 8 * (r >> 2); \
        if (c_ > d_) N0[r] = -__builtin_inff(); if (c_ + 32 > d_) N1[r] = -__builtin_inff(); } } } while (0)
#define ATT_ROWMAX(N0, N1, PM) do { float a_ = max3f(N0[0], N0[1], N1[0]), b_ = max3f(N0[2], N0[3], N1[1]); a_ = max3f(a_, N1[2], N1[3]); \
        _Pragma("unroll") for (int r = 4; r < 16; r += 4) { a_ = max3f(a_, N0[r], N0[r + 1]); b_ = max3f(b_, N0[r + 2], N0[r + 3]); a_ = max3f(a_, N1[r], N1[r + 1]); b_ = max3f(b_, N1[r + 2], N1[r + 3]); } \
        a_ = max3f(a_, b_, b_); auto rr_ = __builtin_amdgcn_permlane32_swap(__float_as_uint(a_), __float_as_uint(a_), false, false); \
        PM = max3f(__uint_as_float(rr_[0]), __uint_as_float(rr_[1]), __uint_as_float(rr_[1])); } while (0)
#define ATT_DECIDE(PM, C0, C1, FORCE) do { if ((FORCE) || __any((PM) > m_run + 8.0f)) { const float mn_ = fmaxf(m_run, (PM)); const float al_ = __builtin_amdgcn_exp2f(m_run - mn_); m_run = mn_; l_run *= al_; \
        if (hi == 0) scr[r32] = al_; asm volatile("s_waitcnt lgkmcnt(0)" ::: "memory"); \
        _Pragma("unroll") for (int a4 = 0; a4 < 4; ++a4) { const f32x4 f_ = *(const LAS f32x4*)(scr + 8 * a4 + 4 * hi); \
            _Pragma("unroll") for (int e = 0; e < 4; ++e) { o0[4 * a4 + e] *= f_[e]; o1[4 * a4 + e] *= f_[e]; } } } } while (0)
#define ATT_SM_HALF(P_, ks0, SUBM) do { _Pragma("unroll") for (int r = 0; r < 16; ++r) { P_[r] = __builtin_amdgcn_exp2f((SUBM) ? P_[r] - m_run : P_[r]); ps_ += P_[r]; } \
        _Pragma("unroll") for (int kq = 0; kq < 2; ++kq) { const int bs_ = 8 * kq; \
            u32x4 w_; w_.x = cvt_pk_bf16(P_[bs_ + 0], P_[bs_ + 1]); w_.y = cvt_pk_bf16(P_[bs_ + 2], P_[bs_ + 3]); w_.z = cvt_pk_bf16(P_[bs_ + 4], P_[bs_ + 5]); w_.w = cvt_pk_bf16(P_[bs_ + 6], P_[bs_ + 7]); \
            pa[(ks0) + kq] = __builtin_bit_cast(bf16x8, w_); } } while (0)
#define ATT_SOFTMAX(C0, C1) do { float ps_ = 0.f; ATT_SM_HALF(C0, 0, true); ATT_SM_HALF(C1, 2, true); l_run += ps_; } while (0)
#define ATT_SOFTMAX_F(C0, C1) do { float ps_ = 0.f; ATT_SM_HALF(C0, 0, false); ATT_SM_HALF(C1, 2, false); l_run += ps_; } while (0)
#define ATT_PV(t) do { const LAS unsigned char* vp0_ = lds + ((t) % NSLOT) * SLOT_BYTES + vb0; const LAS unsigned char* vp1_ = lds + ((t) % NSLOT) * SLOT_BYTES + vb1; \
        _Pragma("unroll") for (int ks = 0; ks < 4; ++ks) { \
            const s16x4 a0_ = vtr(vp0_ + ks * 16 * 128), a1_ = vtr(vp0_ + ks * 16 * 128 + 8 * 128), c0_ = vtr(vp1_ + ks * 16 * 128), c1_ = vtr(vp1_ + ks * 16 * 128 + 8 * 128); \
            const bf16x8 vf0_ = {a0_[0], a0_[1], a0_[2], a0_[3], a1_[0], a1_[1], a1_[2], a1_[3]}; const bf16x8 vf1_ = {c0_[0], c0_[1], c0_[2], c0_[3], c1_[0], c1_[1], c1_[2], c1_[3]}; \
            o0 = MFMA32(pa[ks], vf0_, o0); o1 = MFMA32(pa[ks], vf1_, o1); } } while (0)
#ifdef ATT_PROBE2
    unsigned long long ap_s[4] = {0, 0, 0, 0}, ap_acc[3] = {0, 0, 0};
#define AP_STAMP(k) do { __builtin_amdgcn_sched_barrier(0); asm volatile("s_memtime %0\n\ts_waitcnt lgkmcnt(0)" : "=s"(ap_s[k]) :: "memory"); __builtin_amdgcn_sched_barrier(0); if ((k) > 0) ap_acc[(k) - 1] += ap_s[k] - ap_s[(k) - 1]; } while (0)
#else
#define AP_STAMP(k) do {} while (0)
#endif
#define ATT_WB(N) asm volatile("s_waitcnt vmcnt(" #N ") lgkmcnt(0)\n\ts_barrier" ::: "memory")
#define ATT_RDK(d0) do { kf_[d0][0] = *(const LAS bf16x8*)(kp_ + (d0) * 2048); kf_[d0][1] = *(const LAS bf16x8*)(kp_ + (d0) * 2048 + 512); } while (0)
#define ATT_RDV(ks) do { vf_[ks][0] = vtr(vp0_ + (ks) * 16 * 128); vf_[ks][1] = vtr(vp0_ + (ks) * 16 * 128 + 8 * 128); vf_[ks][2] = vtr(vp1_ + (ks) * 16 * 128); vf_[ks][3] = vtr(vp1_ + (ks) * 16 * 128 + 8 * 128); } while (0)
#define ATT_MK(d0) do { if ((d0) == 0) { S0 = MFMA32(kf_[0][0], qr[0], zero16); S1 = MFMA32(kf_[0][1], qr[0], zero16); } else { S0 = MFMA32(kf_[d0][0], qr[d0], S0); S1 = MFMA32(kf_[d0][1], qr[d0], S1); } } while (0)
#define ATT_MV(ks) do { const bf16x8 v0_ = {vf_[ks][0][0], vf_[ks][0][1], vf_[ks][0][2], vf_[ks][0][3], vf_[ks][1][0], vf_[ks][1][1], vf_[ks][1][2], vf_[ks][1][3]}; \
        const bf16x8 v1_ = {vf_[ks][2][0], vf_[ks][2][1], vf_[ks][2][2], vf_[ks][2][3], vf_[ks][3][0], vf_[ks][3][1], vf_[ks][3][2], vf_[ks][3][3]}; \
        o0 = MFMA32(pa[ks], v0_, o0); o1 = MFMA32(pa[ks], v1_, o1); } while (0)
#define ATT_SB __builtin_amdgcn_sched_barrier(0)
#define ATT_SEGA(j, DODMA) do { \
        const LAS unsigned char* kp_ = lds + (((j) + 1) % NSLOT) * SLOT_BYTES + kbase; \
        const LAS unsigned char* vp0_ = lds + ((j) % NSLOT) * SLOT_BYTES + vb0; const LAS unsigned char* vp1_ = lds + ((j) % NSLOT) * SLOT_BYTES + vb1; \
        bf16x8 kf_[6][2]; s16x4 vf_[4][4]; \
        ATT_RDK(0); ATT_RDK(1); ATT_RDV(0); ATT_SB; \
        if (DODMA) { ATT_DMA((j) + ATT_PF); } ATT_SB; \
        ATT_MK(0); ATT_SB; ATT_RDK(2); ATT_SB; ATT_MK(1); ATT_SB; ATT_RDK(3); ATT_SB; ATT_MV(0); ATT_SB; ATT_RDV(1); ATT_SB; \
        ATT_MK(2); ATT_SB; ATT_RDK(4); ATT_SB; ATT_MK(3); ATT_SB; ATT_RDV(2); ATT_SB; ATT_MV(1); ATT_SB; ATT_RDK(5); ATT_SB; \
        ATT_MK(4); ATT_SB; ATT_MV(2); ATT_SB; ATT_RDV(3); ATT_SB; ATT_MK(5); ATT_MV(3); } while (0)
#define ATT_BARP asm volatile("s_waitcnt lgkmcnt(0)\n\ts_barrier" ::: "memory")
#define ATT_STEP(j, MSK, CONV, FAST) do { \
        if (MSK) ATT_MASK(S0, S1, (j)); \
        if (!(FAST)) { float pm_; ATT_ROWMAX(S0, S1, pm_); ATT_DECIDE(pm_, S0, S1, false); } \
        if (FAST) ATT_SOFTMAX_F(S0, S1); else ATT_SOFTMAX(S0, S1); \
        int infl_ = 0; \
        if (CONV) { __builtin_amdgcn_sched_barrier(0); const LAS float* cb_ = (const LAS float*)(lds + CONV_OFF + wid * CONV_BYTES); \
            if (CV.cur >= 0) { const ConvItem I_ = cv_setup(CV.cur, kargs()->in[I_WGU], kargs()->in[I_WD], cvws + WS_WGU, cvws + WS_WD); cv_out(I_, cb_, lane); infl_ += 4; } \
            if (CV.next < CV.end) { const ConvItem I_ = cv_setup(CV.next, kargs()->in[I_WGU], kargs()->in[I_WD], cvws + WS_WGU, cvws + WS_WD); asm volatile("s_waitcnt lgkmcnt(0)" ::: "memory"); \
                cv_dma(I_, lds0 + (unsigned)(CONV_OFF + wid * CONV_BYTES), lane); CV.cur = CV.next; CV.next += 2048; infl_ += 8; } else CV.cur = -1; } \
        __builtin_amdgcn_sched_barrier(0); ATT_BARP; __builtin_amdgcn_sched_barrier(0); \
        ATT_SEGA((j), ((j) + ATT_PF < NT)); if ((j) + ATT_PF < NT) infl_ += 3; \
        __builtin_amdgcn_sched_barrier(0); \
        if (!(CONV)) { if (infl_ == 3) ATT_WB(3); else ATT_WB(0); } \
        else switch (infl_) { case 15: ATT_WB(15); break; case 12: ATT_WB(12); break; case 11: ATT_WB(11); break; case 8: ATT_WB(8); break; case 7: ATT_WB(7); break; case 4: ATT_WB(4); break; case 3: ATT_WB(3); break; default: ATT_WB(0); break; } \
        __builtin_amdgcn_sched_barrier(0); } while (0)
    bf16x8 pa[4];
    f32x16 S0, S1;
    const bool grpY = wid >= 4;
    ATT_WAITBAR(6);
    if (grpY) ATT_BARP;
    __builtin_amdgcn_sched_barrier(0);
    ATT_QK(S0, S1, 0);
    __builtin_amdgcn_sched_barrier(0);
    ATT_WAITBAR(3);
    __builtin_amdgcn_sched_barrier(0);
    int j = 0;
    if (fast) {
        for (; j < NT - 4; j += 2) {
            ATT_STEP(j, false, CONV_IN_ATTN, true);
            ATT_STEP(j + 1, false, false, true);
        }
        for (; j < NT; j += 2) {
            ATT_STEP(j, true, CONV_IN_ATTN, true);
            ATT_STEP(j + 1, true, false, true);
        }
    } else {
        for (; j < NT - 4; j += 2) {
            ATT_STEP(j, false, CONV_IN_ATTN, false);
            ATT_STEP(j + 1, false, false, false);
        }
        for (; j < NT; j += 2) {
            ATT_STEP(j, true, CONV_IN_ATTN, false);
            ATT_STEP(j + 1, true, false, false);
        }
    }
    if (!grpY) ATT_BARP;
    __builtin_amdgcn_sched_barrier(0);
#ifdef ATT_PROBE2
    if (blockIdx.x == 17 && tid == 0) { unsigned long long* ap2 = (unsigned long long*)(cvws + WS_CTL + 65536 + 128); ap2[0] += ap_acc[0]; ap2[1] += ap_acc[1]; ap2[2] += ap_acc[2]; ap2[3] += (unsigned long long)NT; }
#endif
#ifdef ATT_PROBE
    if (blockIdx.x == 17 && tid == 0) { unsigned long long* ap = (unsigned long long*)(cvws + WS_CTL + 65536 + 64); ap[0] += __builtin_amdgcn_s_memtime() - ap_t0; ap[1] += (unsigned long long)NT; }
#endif
#undef ATT_DMA
#undef ATT_DMA1
#undef ATT_WAITBAR
#undef ATT_QK
#undef ATT_MASK
#undef ATT_ROWMAX
#undef ATT_DECIDE
#undef ATT_SOFTMAX
#undef ATT_SOFTMAX_F
#undef ATT_SM_HALF
#undef ATT_PV
#undef ATT_STEP
#undef ATT_WB
#undef ATT_BARP
#undef ATT_SEGA
#undef ATT_RDK
#undef ATT_RDV
#undef ATT_MK
#undef ATT_MV
#undef ATT_SB
#undef AP_STAMP
    { auto rr = __builtin_amdgcn_permlane32_swap(__float_as_uint(l_run), __float_as_uint(l_run), false, false); l_run = __uint_as_float(rr[0]) + __uint_as_float(rr[1]); }
    if (hi == 0) scr[32 + r32] = 1.0f / l_run;
    asm volatile("s_waitcnt lgkmcnt(0)" ::: "memory");
    bf16_t* Ow = O + ((size_t)(b * SEQ + qw)) * 512 + h * 64 + r32;
#pragma unroll
    for (int a4 = 0; a4 < 4; ++a4) { const f32x4 f = *(const LAS f32x4*)(scr + 32 + 8 * a4 + 4 * hi);
#pragma unroll
        for (int e = 0; e < 4; ++e) { const int r = 4 * a4 + e; const int row = crow(r, hi);
            Ow[(size_t)row * 512] = (bf16_t)(cvt_pk_bf16(o0[r] * f[e], 0.f) & 0xffffu);
            Ow[(size_t)row * 512 + 32] = (bf16_t)(cvt_pk_bf16(o1[r] * f[e], 0.f) & 0xffffu); } }
    __syncthreads();
}
#undef MFMA32
}

struct MixOrder {
    int G, c; unsigned ATT, MIXED, WAO, WPO;
    __device__ __forceinline__ bool next(int i, Unit& u) const {
        const int tile = (i >> 1) * G + c; if (tile >= 256) return false;
        u.pm = tile >> 2; u.pn = tile & 3; u.aux = i & 1; return true;
    }
    __device__ __forceinline__ void prefetch(const Unit&, const __amdgpu_buffer_rsrc_t, LAS unsigned char*, int, int) const {}
    __device__ __forceinline__ unsigned a_off(const Unit& u) const { return (u.aux ? MIXED : ATT) + (unsigned)u.pm * (256 * 512 * 2); }
    __device__ __forceinline__ unsigned b_off(const Unit& u) const { return (u.aux ? WPO : WAO) + (unsigned)u.pn * (256 * 512 * 2); }
};
struct EpiMix {
    static constexpr bool PERM = true;
    __device__ __forceinline__ void init(f32x4 (&acc)[2][2][4][2], const Unit& u, int, int) const {
        if (u.aux) return;
#pragma unroll
        for (int a = 0; a < 2; ++a)
#pragma unroll
            for (int b = 0; b < 2; ++b)
#pragma unroll
                for (int m = 0; m < 4; ++m)
#pragma unroll
                    for (int n = 0; n < 2; ++n) acc[a][b][m][n] = (f32x4){0.f, 0.f, 0.f, 0.f};
    }
    bf16_t* MIX; const bf16_t* GATES;
    __device__ __forceinline__ void operator()(f32x4 (&acc)[2][2][4][2], const Unit& u, int wr, int wc, int fr, int fq) const {
        const int row0 = u.pm * 256 + wr * 64 + fr, col0 = u.pn * 256 + wc * 32 + 8 * fq;
        const bool p0_ = u.aux == 0;
#if GATE8
        typedef u32x2 gv_t; const unsigned char* gb_ = (const unsigned char*)GATES + (size_t)row0 * 2048 + col0;
#define EM_LD1(p) (*(const u32x2*)(p))
#define EM_DEC(GW_, lo, hi) do { const gv_t t_ = (GW_); const f32x2 a_ = __builtin_amdgcn_cvt_pk_f32_fp8((int)t_.x, false), b_ = __builtin_amdgcn_cvt_pk_f32_fp8((int)t_.x, true), c_ = __builtin_amdgcn_cvt_pk_f32_fp8((int)t_.y, false), d_ = __builtin_amdgcn_cvt_pk_f32_fp8((int)t_.y, true); \
        lo = (f32x4){a_[0], a_[1], b_[0], b_[1]}; hi = (f32x4){c_[0], c_[1], d_[0], d_[1]}; } while (0)
        constexpr size_t GROW = 2048, GHALF = 1024, GBJ = 128; constexpr float GSC = 1.0f / 256.0f;
#else
        typedef u32x4 gv_t; const bf16_t* gb_ = GATES + (size_t)row0 * 2048 + col0;
#define EM_LD1(p) (*(const u32x4*)(p))
#define EM_DEC(GW_, lo, hi) do { const gv_t t_ = (GW_); lo = (f32x4){bf_lo(t_.x), bf_hi(t_.x), bf_lo(t_.y), bf_hi(t_.y)}; hi = (f32x4){bf_lo(t_.z), bf_hi(t_.z), bf_lo(t_.w), bf_hi(t_.w)}; } while (0)
        constexpr size_t GROW = 2048, GHALF = 1024, GBJ = 128; constexpr float GSC = 1.0f;
#endif
        gv_t buf[3][4];
#define EM_LD(g) do { const auto* p_ = gb_ + (size_t)(((g) >> 2) * 128 + ((g) & 3) * 16) * GROW; \
        _Pragma("unroll") for (int bj = 0; bj < 2; ++bj) { buf[(g) % 3][2 * bj] = EM_LD1(p_ + GHALF + bj * GBJ); if (p0_) buf[(g) % 3][2 * bj + 1] = EM_LD1(p_ + bj * GBJ); } } while (0)
        EM_LD(0); EM_LD(1); EM_LD(2);
#pragma unroll
        for (int g = 0; g < 8; ++g) { const int ai = g >> 2, m = g & 3; const size_t row = (size_t)(row0 + ai * 128 + m * 16);
            __builtin_amdgcn_sched_barrier(0);
#pragma unroll
            for (int bj = 0; bj < 2; ++bj) { f32x4 p0, p1; EM_DEC(buf[g % 3][2 * bj], p0, p1);
                if (p0_) { f32x4 a0, a1; EM_DEC(buf[g % 3][2 * bj + 1], a0, a1);
#pragma unroll
                    for (int e = 0; e < 4; ++e) { acc[ai][bj][m][0][e] *= a0[e] * __builtin_amdgcn_rcpf(p0[e]); acc[ai][bj][m][1][e] *= a1[e] * __builtin_amdgcn_rcpf(p1[e]); }
                } else {
                    const f32x4 v0 = acc[ai][bj][m][0] * (p0 * GSC), v1 = acc[ai][bj][m][1] * (p1 * GSC);
                    u32x4 w; w.x = cvt_pk_bf16(v0[0], v0[1]); w.y = cvt_pk_bf16(v0[2], v0[3]); w.z = cvt_pk_bf16(v1[0], v1[1]); w.w = cvt_pk_bf16(v1[2], v1[3]);
                    *(u32x4*)(MIX + row * 1024 + col0 + bj * 128) = w; } }
            __builtin_amdgcn_sched_barrier(0);
            if (g + 3 < 8) EM_LD(g + 3);
        }
#undef EM_LD
#undef EM_LD1
#undef EM_DEC
    }
};
struct EpiRes {
    static constexpr bool PERM = false;
    __device__ __forceinline__ void init(f32x4 (&acc)[2][2][4][2], const Unit&, int, int) const {
#pragma unroll
        for (int a = 0; a < 2; ++a)
#pragma unroll
            for (int b = 0; b < 2; ++b)
#pragma unroll
                for (int m = 0; m < 4; ++m)
#pragma unroll
                    for (int n = 0; n < 2; ++n) acc[a][b][m][n] = (f32x4){0.f, 0.f, 0.f, 0.f};
    }
    const float* base; bf16_t* out;
    __device__ __forceinline__ void operator()(const f32x4 (&acc)[2][2][4][2], const Unit& u, int wr, int wc, int fr, int fq) const {
        const int row0 = u.pm * 256 + wr * 64 + fr, col0 = u.pn * 256 + wc * 32 + 4 * fq;
        const size_t off0 = (size_t)row0 * DM + col0;
        f32x4 buf[3][4];
#define ER_LD(g) do { const float* p_ = base + off0 + (size_t)(((g) >> 2) * 128 + ((g) & 3) * 16) * DM; \
        _Pragma("unroll") for (int q = 0; q < 4; ++q) buf[(g) % 3][q] = *(const f32x4*)(p_ + (q >> 1) * 128 + (q & 1) * 16); } while (0)
        ER_LD(0); ER_LD(1); ER_LD(2);
#pragma unroll
        for (int g = 0; g < 8; ++g) { const int ai = g >> 2, m = g & 3;
            __builtin_amdgcn_sched_barrier(0);
            bf16_t* o_ = out + off0 + (size_t)(ai * 128 + m * 16) * DM;
#pragma unroll
            for (int q = 0; q < 4; ++q) { const f32x4 r = buf[g % 3][q] + acc[ai][q >> 1][m][q & 1]; u32x2 w; w.x = cvt_pk_bf16(r[0], r[1]); w.y = cvt_pk_bf16(r[2], r[3]); *(u32x2*)(o_ + (q >> 1) * 128 + (q & 1) * 16) = w; }
            __builtin_amdgcn_sched_barrier(0);
            if (g + 3 < 8) ER_LD(g + 3);
        }
#undef ER_LD
    }
};

constexpr int WR_PITCH = 1028;
constexpr int R_WR_OFF = 0, R_PART_OFF = 32 * WR_PITCH * 4, R_SSQ_OFF = R_PART_OFF + 2 * 64 * 33 * 4, R_CNT_OFF = R_SSQ_OFF + 2 * 64 * 4, R_BASE_OFF = R_CNT_OFF + 128, R_RSTD_OFF = R_BASE_OFF + 128, R_END = R_RSTD_OFF + 256;
static_assert(R_END <= TILE_E_OFF, "router LDS map");
__device__ __forceinline__ void p7_router(const Frame& F) {
    const int tid_l = tid_local(), lane_l = tid_l & 63; (void)tid_l; (void)lane_l;
    const KArgs a = kargs();
    LAS float* WR = (LAS float*)(F.lds + R_WR_OFF); LAS float* PART = (LAS float*)(F.lds + R_PART_OFF); LAS float* SSQP = (LAS float*)(F.lds + R_SSQ_OFF);
    LAS int* CNT = (LAS int*)(F.lds + R_CNT_OFF); LAS int* BASE = (LAS int*)(F.lds + R_BASE_OFF); LAS float* RSTD_L = (LAS float*)(F.lds + R_RSTD_OFF);
    const int tid = tid_l, lane = lane_l, wave = F.wave;
    const float* wr = a->in[I_WR]; const float* gf = a->in[I_GFFN];
    {
        const f32x4* wr4 = (const f32x4*)wr; f32x4 w[16]; float g[16];
#pragma unroll
        for (int q = 0; q < 16; ++q) { const int idx = tid + 512 * q; w[q] = wr4[idx]; g[q] = gf[idx >> 3]; }
#pragma unroll
        for (int q = 0; q < 16; ++q) { const int idx = tid + 512 * q; const int k = idx >> 3, e0 = (idx & 7) * 4;
#pragma unroll
            for (int j = 0; j < 4; ++j) WR[(e0 + j) * WR_PITCH + k] = w[q][j] * g[q]; }
    }
    if (tid < 32) CNT[tid] = 0;
    __syncthreads();
    int* RE = (int*)(F.ws + WS_ROUTE); int* RP = RE + T * 4; float* RG = (float*)(RP + T * 4); float* RS = RG + T * 4; int* TOK = (int*)(F.ws + WS_TOK); unsigned char* H8 = F.ws + WS_XS2;
    unsigned* gcnt = F.ctl + CW_CNT;
    const bf16_t* X1 = (const bf16_t*)(F.ws + WS_X1B);
    for (int blk = F.vcu; blk < T / 64; blk += F.G) {
        const int tb = blk * 64;
        {
            const int tg = wave & 3, kh = wave >> 2, r = lane & 15, kq = lane >> 4;
            const bf16_t* xp = X1 + (size_t)(tb + 16 * tg + r) * DM + 512 * kh + 4 * kq;
            const LAS float* w0 = WR + (lane & 15) * WR_PITCH + 512 * kh + 4 * kq; const LAS float* w1 = w0 + 16 * WR_PITCH;
            f32x4 acc0 = {0.f, 0.f, 0.f, 0.f}, acc1 = {0.f, 0.f, 0.f, 0.f}; float ss = 0.f;
#pragma unroll 4
            for (int i = 0; i < 32; ++i) {
                const u32x2 xw = *(const u32x2*)(xp + 16 * i); const f32x4 xv = {bf_lo(xw.x), bf_hi(xw.x), bf_lo(xw.y), bf_hi(xw.y)};
                const f32x4 b0 = *(const LAS f32x4*)(w0 + 16 * i), b1 = *(const LAS f32x4*)(w1 + 16 * i);
                ss += (xv[0] * xv[0] + xv[1] * xv[1]) + (xv[2] * xv[2] + xv[3] * xv[3]);
#pragma unroll
                for (int j = 0; j < 4; ++j) { acc0 = __builtin_amdgcn_mfma_f32_16x16x4f32(xv[j], b0[j], acc0, 0, 0, 0); acc1 = __builtin_amdgcn_mfma_f32_16x16x4f32(xv[j], b1[j], acc1, 0, 0, 0); }
            }
            ss += __shfl_xor(ss, 16); ss += __shfl_xor(ss, 32);
            if (kq == 0) SSQP[kh * 64 + 16 * tg + r] = ss;
#pragma unroll
            for (int q = 0; q < 4; ++q) { const int tok = 16 * tg + 4 * kq + q; PART[(kh * 64 + tok) * 33 + (lane & 15)] = acc0[q]; PART[(kh * 64 + tok) * 33 + 16 + (lane & 15)] = acc1[q]; }
        }
        __syncthreads();
        int te[4] = {0, 0, 0, 0}, lp[4] = {0, 0, 0, 0}; float tv[4] = {-3e38f, -3e38f, -3e38f, -3e38f}; float rstd = 0.f;
        if (tid < 64) {
            const float ssq = SSQP[tid] + SSQP[64 + tid]; rstd = 1.0f / sqrtf(ssq * (1.f / DM) + EPS);
            const float* br = a->in[I_BR];
#pragma unroll
            for (int e = 0; e < 32; ++e) {
                float v = (PART[tid * 33 + e] + PART[(64 + tid) * 33 + e]) * rstd + br[e]; int id = e;
#pragma unroll
                for (int s = 0; s < 4; ++s) { const bool gt = v > tv[s]; const float ov = tv[s]; const int oi = te[s]; tv[s] = gt ? v : ov; te[s] = gt ? id : oi; v = gt ? ov : v; id = gt ? oi : id; }
            }
#pragma unroll
            for (int s = 0; s < 4; ++s) lp[s] = __hip_atomic_fetch_add(&CNT[te[s]], 1, __ATOMIC_RELAXED, __HIP_MEMORY_SCOPE_WORKGROUP);
        }
        __syncthreads();
        if (tid < 32) { const int c = CNT[tid]; BASE[tid] = c ? (int)atomicAdd(gcnt + tid, (unsigned)c) : 0; }
        __syncthreads();
        if (tid < 64) {
            const int t = tb + tid;
            const float e1 = __expf(tv[1] - tv[0]), e2 = __expf(tv[2] - tv[0]), e3 = __expf(tv[3] - tv[0]); const float inv = 1.0f / (1.0f + e1 + e2 + e3);
            const float gts[4] = {inv, e1 * inv, e2 * inv, e3 * inv};
#pragma unroll
            for (int s = 0; s < 4; ++s) { const int p = BASE[te[s]] + lp[s]; RE[t * 4 + s] = te[s]; RP[t * 4 + s] = p; RG[t * 4 + s] = gts[s]; TOK[te[s] * 16384 + p] = t; }
            RS[t] = rstd; RSTD_L[tid] = rstd;
        }
        __syncthreads();
        if (tid < 32) CNT[tid] = 0;
        {
            f32x4 g[2][2];
#pragma unroll
            for (int j = 0; j < 2; ++j) { g[j][0] = *(const f32x4*)(gf + 512 * j + 8 * lane); g[j][1] = *(const f32x4*)(gf + 512 * j + 8 * lane + 4); }
#pragma unroll 4
            for (int i = 0; i < 8; ++i) {
                const int t = tb + 8 * wave + i; const float rs = RSTD_L[8 * wave + i];
#pragma unroll
                for (int j = 0; j < 2; ++j) { const u32x4 xw = *(const u32x4*)(X1 + (size_t)t * DM + 512 * j + 8 * lane);
                    const f32x4 v0 = (f32x4){bf_lo(xw.x), bf_hi(xw.x), bf_lo(xw.y), bf_hi(xw.y)} * g[j][0] * rs, v1 = (f32x4){bf_lo(xw.z), bf_hi(xw.z), bf_lo(xw.w), bf_hi(xw.w)} * g[j][1] * rs;
                    *(u32x2*)(H8 + (size_t)t * DM + 512 * j + 8 * lane) = cvt8_fp8(v0, v1, 8.0f); }
            }
        }
        __syncthreads();
    }
}

__device__ __forceinline__ int build_tiles(const Frame& F) {
    const int tid_l = tid_local(), lane_l = tid_l & 63; (void)tid_l; (void)lane_l;
    LAS int* TB = (LAS int*)(F.lds + TILE_E_OFF); LAS int* TE = TB + 64;
    if (tid_l < 64) {
        const int c = (tid_l < NEXP) ? (int)__hip_atomic_load(F.ctl + CW_CNT + tid_l, RLX_AGENT) : 0; const int nt = (c + 255) >> 8;
        int incl = nt;
#pragma unroll
        for (int o = 1; o < 32; o <<= 1) { const int v = __shfl_up(incl, o); if (lane_l >= o) incl += v; }
        if (tid_l < NEXP) TB[tid_l] = incl - nt;
        if (tid_l == NEXP - 1) TB[NEXP] = incl;
    }
    __syncthreads();
    if (tid_l < NEXP) { for (int t = TB[tid_l]; t < TB[tid_l + 1]; ++t) TE[t] = tid_l; }
    __syncthreads();
    return TB[NEXP];
}

__device__ __forceinline__ void p8_dispatch(const Frame& F) {
    const int tid_l = tid_local(), lane_l = tid_l & 63; (void)tid_l; (void)lane_l;
    const KArgs a = kargs();
    (void)build_tiles(F);
    const LAS int* TB = (const LAS int*)(F.lds + TILE_E_OFF);
    const int gw = F.vcu * NWAVES + F.wave, NGW = F.G * NWAVES, lane = lane_l;
    const int* RE = (const int*)(F.ws + WS_ROUTE); const int* RP = RE + T * 4; const float* RS = (const float*)(RP + T * 4) + T * 4; int* SL = (int*)(RS + T);
    const bf16_t* X1 = (const bf16_t*)(F.ws + WS_X1B); const float* gf = a->in[I_GFFN]; unsigned char* XS = F.ws + WS_XS2;
    f32x4 g[2][2];
#pragma unroll
    for (int j = 0; j < 2; ++j) { g[j][0] = *(const f32x4*)(gf + 512 * j + 8 * lane); g[j][1] = *(const f32x4*)(gf + 512 * j + 8 * lane + 4); }
    for (int t = gw; t < T; t += NGW) {
        const float rstd = RS[t];
        u32x2 w[2];
#pragma unroll
        for (int j = 0; j < 2; ++j) { const u32x4 xw = *(const u32x4*)(X1 + (size_t)t * DM + 512 * j + 8 * lane);
            const f32x4 v0 = (f32x4){bf_lo(xw.x), bf_hi(xw.x), bf_lo(xw.y), bf_hi(xw.y)} * g[j][0] * rstd, v1 = (f32x4){bf_lo(xw.z), bf_hi(xw.z), bf_lo(xw.w), bf_hi(xw.w)} * g[j][1] * rstd;
            w[j] = cvt8_fp8(v0, v1, 8.0f); }
#pragma unroll
        for (int s = 0; s < 4; ++s) { const int e = RE[t * 4 + s], slot = TB[e] * 256 + RP[t * 4 + s];
            if (lane == 0) SL[t * 4 + s] = slot;
            unsigned char* dst = XS + (size_t)slot * DM + 8 * lane;
            *(u32x2*)dst = w[0]; *(u32x2*)(dst + 512) = w[1]; }
    }
}

template <bool GATHER_A> struct MoeOrderT {
    int G, c, ntn_shift, total; const LAS int* TE; unsigned A, Bw, bexp, btile; int xbase, xcount;
    __device__ __forceinline__ void init_xcd(const LAS int* TB) {
        if (G == 256) { const int x = c >> 5; xbase = __builtin_amdgcn_readfirstlane(TB[4 * x]); xcount = (__builtin_amdgcn_readfirstlane(TB[4 * x + 4]) - xbase) << ntn_shift; } else { xbase = -1; xcount = 0; }
    }
    __device__ __forceinline__ bool next(int i, Unit& u) const {
        if (xbase >= 0) { const int L = i * 32 + (c & 31); if (L >= xcount) return false;
            u.pm = xbase + (L >> ntn_shift); u.pn = L & ((1 << ntn_shift) - 1); u.aux = __builtin_amdgcn_readfirstlane(TE[u.pm]); return true; }
        const int L = i * G + c; if (L >= total) return false;
        u.pm = L >> ntn_shift; u.pn = L & ((1 << ntn_shift) - 1); u.aux = __builtin_amdgcn_readfirstlane(TE[u.pm]); return true;
    }
#ifndef MOE_PREFETCH
#define MOE_PREFETCH 0
#endif
    __device__ __forceinline__ void prefetch(const Unit& u, const __amdgpu_buffer_rsrc_t rsrc, LAS unsigned char* lds, int wid, int lane) const {
        if (!MOE_PREFETCH) return;
        const unsigned ln_ = (unsigned)(tid_local() & 63);
        const unsigned line = (unsigned)(u.pn & 3) * 512u + (unsigned)wid * 64u + ln_;
        const unsigned voff = (line >> 3) * 1024u + (line & 7u) * 128u;
        const unsigned dst = (unsigned)__builtin_amdgcn_readfirstlane((int)(unsigned)(unsigned long)(lds + 131072 + wid * 256));
        const unsigned soff = a_off(u);
        asm volatile("s_nop 4\n\ts_mov_b32 m0, %0\n\ts_nop 0\n\tbuffer_load_dword %1, %2, %3 offen lds" :: "s"(dst), "v"(voff), "s"(rsrc), "s"(soff) : "m0", "memory");
    }
    unsigned TOK;
    __device__ __forceinline__ unsigned tok_off(const Unit& u) const { return TOK + ((unsigned)u.aux * 16384u + (unsigned)(u.pm - __builtin_amdgcn_readfirstlane(TE[u.aux - 64])) * 256u) * 4u; }
    __device__ __forceinline__ unsigned a_off(const Unit& u) const { return GATHER_A ? A : A + (unsigned)u.pm * (256 * 1024); }
    __device__ __forceinline__ unsigned b_off(const Unit& u) const { return Bw + (unsigned)u.aux * bexp + (unsigned)u.pn * btile; }
};
using MoeOrder = MoeOrderT<false>; using MoeGather = MoeOrderT<true>;
struct EpiSwiglu {
    static constexpr bool PERM = true;
    unsigned char* ACT; const float* bgu;
    __device__ __forceinline__ void init(f32x4 (&acc)[2][2][4][2], const Unit& u, int wc, int fq) const {
        const float* bb = bgu + (size_t)u.aux * 2048 + u.pn * 128 + wc * 32 + 8 * fq;
        const f32x4 g0 = *(const f32x4*)(bb), g1 = *(const f32x4*)(bb + 4), u0 = *(const f32x4*)(bb + 1024), u1 = *(const f32x4*)(bb + 1028);
#pragma unroll
        for (int a = 0; a < 2; ++a)
#pragma unroll
            for (int m = 0; m < 4; ++m) { acc[a][0][m][0] = g0; acc[a][0][m][1] = g1; acc[a][1][m][0] = u0; acc[a][1][m][1] = u1; }
    }
    __device__ __forceinline__ void operator()(const f32x4 (&acc)[2][2][4][2], const Unit& u, int wr, int wc, int fr, int fq) const {
        const int row0 = u.pm * 256 + wr * 64 + fr, j0 = u.pn * 128 + wc * 32 + 8 * fq;
        unsigned char* dst0 = ACT + (size_t)row0 * DEXP + j0;
#pragma unroll
        for (int ai = 0; ai < 2; ++ai)
#pragma unroll
            for (int m = 0; m < 4; ++m) {
                int w2[2];
#pragma unroll
                for (int n = 0; n < 2; ++n) {
                    const f32x4 g = acc[ai][0][m][n], up = acc[ai][1][m][n];
                    f32x2 r[2];
#pragma unroll
                    for (int h = 0; h < 2; ++h) {
                        const f32x2 gg = {__builtin_amdgcn_fmed3f(g[2 * h], -3.0e38f, 7.0f), __builtin_amdgcn_fmed3f(g[2 * h + 1], -3.0e38f, 7.0f)};
                        const f32x2 uu = {__builtin_amdgcn_fmed3f(up[2 * h], -7.0f, 7.0f), __builtin_amdgcn_fmed3f(up[2 * h + 1], -7.0f, 7.0f)};
                        const f32x2 x = gg * (f32x2){-1.702f * 1.4426950408889634f, -1.702f * 1.4426950408889634f};
                        const f32x2 den = (f32x2){__builtin_amdgcn_exp2f(x[0]), __builtin_amdgcn_exp2f(x[1])} + (f32x2){1.0f, 1.0f};
                        const f32x2 rc = {__builtin_amdgcn_rcpf(den[0]), __builtin_amdgcn_rcpf(den[1])};
                        r[h] = (uu * (f32x2){8.0f, 8.0f} + (f32x2){8.0f, 8.0f}) * gg * rc; }
                    int w = __builtin_amdgcn_cvt_pk_fp8_f32(r[0][0], r[0][1], 0, false); w2[n] = __builtin_amdgcn_cvt_pk_fp8_f32(r[1][0], r[1][1], w, true);
                }
                u32x2 o; o.x = (unsigned)w2[0]; o.y = (unsigned)w2[1];
                *(u32x2*)(dst0 + (size_t)(ai * 128 + m * 16) * DEXP) = o;
            }
    }
};
struct EpiDown {
    static constexpr bool PERM = true;
    unsigned char* Y; const float* bd;
    __device__ __forceinline__ void init(f32x4 (&acc)[2][2][4][2], const Unit& u, int wc, int fq) const {
        const float* bb = bd + (size_t)u.aux * DM + u.pn * 256 + wc * 32 + 8 * fq;
        const f32x4 b00 = *(const f32x4*)(bb), b01 = *(const f32x4*)(bb + 4), b10 = *(const f32x4*)(bb + 128), b11 = *(const f32x4*)(bb + 132);
#pragma unroll
        for (int a = 0; a < 2; ++a)
#pragma unroll
            for (int m = 0; m < 4; ++m) { acc[a][0][m][0] = b00; acc[a][0][m][1] = b01; acc[a][1][m][0] = b10; acc[a][1][m][1] = b11; }
    }
    __device__ __forceinline__ void operator()(const f32x4 (&acc)[2][2][4][2], const Unit& u, int wr, int wc, int fr, int fq) const {
        const int row0 = u.pm * 256 + wr * 64 + fr, col0 = u.pn * 256 + wc * 32 + 8 * fq;
#pragma unroll
        for (int ai = 0; ai < 2; ++ai)
#pragma unroll
            for (int m = 0; m < 4; ++m) { unsigned char* rowp = Y + (size_t)(row0 + ai * 128 + m * 16) * DM + col0;
#pragma unroll
                for (int bj = 0; bj < 2; ++bj) *(u32x2*)(rowp + bj * 128) = cvt8_fp8(acc[ai][bj][m][0], acc[ai][bj][m][1], 8.0f); }
    }
};

__device__ __forceinline__ void p11_combine(const Frame& F) {
    const int tid_l = tid_local(), lane_l = tid_l & 63; (void)tid_l; (void)lane_l;
    const KArgs a = kargs();
    const int gw = F.vcu * NWAVES + F.wave, NGW = F.G * NWAVES, lane = lane_l;
    (void)build_tiles(F); const LAS int* TB = (const LAS int*)(F.lds + TILE_E_OFF);
    const int* RE = (const int*)(F.ws + WS_ROUTE); const int* RP = RE + T * 4; const float* RG = (const float*)(RE + T * 8);
    const unsigned char* Y = F.ws + WS_XS; bf16_t* HP = (bf16_t*)(F.ws + WS_HN); const bf16_t* X1 = (const bf16_t*)(F.ws + WS_X1B); bf16_t* X2 = (bf16_t*)(F.ws + WS_X2B); const float* gp = a->in[I_GPLE];
    f32x4 g[2][2];
#pragma unroll
    for (int j = 0; j < 2; ++j) { g[j][0] = *(const f32x4*)(gp + 512 * j + 8 * lane); g[j][1] = *(const f32x4*)(gp + 512 * j + 8 * lane + 4); }
    for (int t = gw; t < T; t += NGW) {
        f32x4 v[2][2];
#pragma unroll
        for (int j = 0; j < 2; ++j) { const u32x4 xw = *(const u32x4*)(X1 + (size_t)t * DM + 512 * j + 8 * lane); v[j][0] = (f32x4){bf_lo(xw.x), bf_hi(xw.x), bf_lo(xw.y), bf_hi(xw.y)}; v[j][1] = (f32x4){bf_lo(xw.z), bf_hi(xw.z), bf_lo(xw.w), bf_hi(xw.w)}; }
#pragma unroll
        for (int s = 0; s < 4; ++s) { const int slot = TB[RE[t * 4 + s]] * 256 + RP[t * 4 + s]; const float gt = RG[t * 4 + s] * 0.125f;
#pragma unroll
            for (int j = 0; j < 2; ++j) { const u32x2 y = *(const u32x2*)(Y + (size_t)slot * DM + 512 * j + 8 * lane);
                const f32x2 a0 = __builtin_amdgcn_cvt_pk_f32_fp8((int)y.x, false), a1 = __builtin_amdgcn_cvt_pk_f32_fp8((int)y.x, true), b0 = __builtin_amdgcn_cvt_pk_f32_fp8((int)y.y, false), b1 = __builtin_amdgcn_cvt_pk_f32_fp8((int)y.y, true);
                v[j][0] += (f32x4){a0[0], a0[1], a1[0], a1[1]} * gt; v[j][1] += (f32x4){b0[0], b0[1], b1[0], b1[1]} * gt; } }
        float ss = 0.f;
#pragma unroll
        for (int j = 0; j < 2; ++j)
#pragma unroll
            for (int n = 0; n < 2; ++n) { const f32x4 q = v[j][n]; ss += (q[0] * q[0] + q[1] * q[1]) + (q[2] * q[2] + q[3] * q[3]); u32x2 w; w.x = cvt_pk_bf16(q[0], q[1]); w.y = cvt_pk_bf16(q[2], q[3]); *(u32x2*)(X2 + (size_t)t * DM + 512 * j + 8 * lane + 4 * n) = w; }
        const float rstd = 1.0f / sqrtf(wave_sum(ss) * (1.f / DM) + EPS);
#pragma unroll
        for (int j = 0; j < 2; ++j) { const f32x4 q0 = v[j][0] * g[j][0] * rstd, q1 = v[j][1] * g[j][1] * rstd;
            if (PLE_FP8) { *(u32x2*)((unsigned char*)HP + (size_t)t * DM + 512 * j + 8 * lane) = cvt8_fp8(q0, q1, 8.0f); }
            else { u32x4 w; w.x = cvt_pk_bf16(q0[0], q0[1]); w.y = cvt_pk_bf16(q0[2], q0[3]); w.z = cvt_pk_bf16(q1[0], q1[1]); w.w = cvt_pk_bf16(q1[2], q1[3]);
                *(u32x4*)(HP + (size_t)t * DM + 512 * j + 8 * lane) = w; } }
    }
}
struct EpiPle {
    static constexpr bool PERM = false;
    __device__ __forceinline__ void init(f32x4 (&acc)[2][2][4][2], const Unit&, int, int) const {
#pragma unroll
        for (int a = 0; a < 2; ++a)
#pragma unroll
            for (int b = 0; b < 2; ++b)
#pragma unroll
                for (int m = 0; m < 4; ++m)
#pragma unroll
                    for (int n = 0; n < 2; ++n) acc[a][b][m][n] = (f32x4){0.f, 0.f, 0.f, 0.f};
    }
    float* out; const bf16_t* E; const bf16_t* X2;
    __device__ __forceinline__ void operator()(const f32x4 (&acc)[2][2][4][2], const Unit& u, int wr, int wc, int fr, int fq) const {
        const int row0 = u.pm * 256 + wr * 64 + fr, col0 = u.pn * 256 + wc * 32 + 4 * fq;
        const size_t off0 = (size_t)row0 * DM + col0;
        u32x2 eb[3][4], xb[3][4];
#define EP_LD(g) do { const size_t o_ = off0 + (size_t)(((g) >> 2) * 128 + ((g) & 3) * 16) * DM; \
        _Pragma("unroll") for (int q = 0; q < 4; ++q) { eb[(g) % 3][q] = *(const u32x2*)(E + o_ + (q >> 1) * 128 + (q & 1) * 16); xb[(g) % 3][q] = *(const u32x2*)(X2 + o_ + (q >> 1) * 128 + (q & 1) * 16); } } while (0)
        EP_LD(0); EP_LD(1); EP_LD(2);
#pragma unroll
        for (int g = 0; g < 8; ++g) { const int ai = g >> 2, m = g & 3; const size_t off = off0 + (size_t)(ai * 128 + m * 16) * DM;
            __builtin_amdgcn_sched_barrier(0);
#pragma unroll
            for (int q = 0; q < 4; ++q) { const u32x2 ev = eb[g % 3][q], xw = xb[g % 3][q]; const f32x4 a4 = acc[ai][q >> 1][m][q & 1];
                f32x4 r = {bf_lo(xw.x), bf_hi(xw.x), bf_lo(xw.y), bf_hi(xw.y)};
                r[0] += fast_sigmoid(a4[0]) * bf_lo(ev.x); r[1] += fast_sigmoid(a4[1]) * bf_hi(ev.x); r[2] += fast_sigmoid(a4[2]) * bf_lo(ev.y); r[3] += fast_sigmoid(a4[3]) * bf_hi(ev.y);
                *(f32x4*)(out + off + (q >> 1) * 128 + (q & 1) * 16) = r; }
            __builtin_amdgcn_sched_barrier(0);
            if (g + 3 < 8) EP_LD(g + 3);
        }
#undef EP_LD
    }
};

constexpr int N_PHASES = 13;
__global__ void __launch_bounds__(NWAVES * 64, 2) fwd_kernel(Args args) {
    extern __shared__ __attribute__((aligned(16))) unsigned char lds_raw[];
    Frame F;
    F.lds = (LAS unsigned char*)lds_raw; F.MISC = (volatile LAS unsigned*)(F.lds + MISC_OFF);
    F.wave = __builtin_amdgcn_readfirstlane(threadIdx.x >> 6);
    F.G = gridDim.x; { const int bx = blockIdx.x; F.vcu = (F.G % 8 == 0) ? (bx % 8) * (F.G / 8) + bx / 8 : bx; }
    { const KArgs ka = kargs(); F.out = ka->out; F.ws = ka->ws; F.ctl = (unsigned*)(ka->ws + WS_CTL); }
    { const int t0_ = tid_local(); if (t0_ < 32) F.MISC[t0_] = 0u; }
    __syncthreads();
    int lo, hi; { const KArgs ka = kargs(); lo = ka->ph_lo; hi = ka->ph_hi; }
    const bool multi = (hi - lo) > 1;
    XcdBarrier bar; bar.bar = F.ctl + CW_BAR; bar.x = 0; bar.st = nullptr;
    if (multi) bar = xcd_barrier_post(F.ctl + CW_BAR, F.MISC);
#ifndef PH_MASK
#define PH_MASK 0x1fff
#endif
#define IN(k) ((((PH_MASK) >> (k)) & 1) && lo <= (k) && (k) < hi)
#define SEAM(k) do { if (IN(k) && IN((k) + 1)) xcd_barrier(bar); } while (0)
    unsigned char* ws = F.ws;
    LAS unsigned char* ring = F.lds;
    const __amdgpu_buffer_rsrc_t rsrc = __builtin_amdgcn_make_buffer_rsrc((void*)ws, 0, (int)WS_END, 0x00020000);

    if (IN(0)) { p0_prologue(F); } SEAM(0);

    if (IN(1)) {
        if (GATES_FP8 && !P1_FP8) {
          { DenseOrder S; S.init(64, 8, F.G, (int)blockIdx.x, WS_HN8, 512, WS_WIN8 + (size_t)1024 * 1024, 512);
            EpiProj E{(bf16_t*)(ws + WS_PROJ), (bf16_t*)(ws + WS_GATES), 4};
            pg8::gemm_phase<EpiProj, DenseOrder, true, true, true>(ring, rsrc, pg8::Shape{1024, 1024, 1024, 0x7c7c7c7c, 0x7c7c7c7c}, S, E); }
          { DenseOrder S; S.init(64, 4, F.G, (int)blockIdx.x, WS_HN, 1024, WS_WIN, 1024);
            EpiProj E{(bf16_t*)(ws + WS_PROJ), (bf16_t*)(ws + WS_GATES), 0};
            pg8::gemm_phase<EpiProj, DenseOrder, true, true>(ring, rsrc, pg8::Shape{2048, 2048, 2048, 0, 0}, S, E); }
        } else
        { DenseOrder S; S.init(64, 12, F.G, (int)blockIdx.x, WS_HN, P1_FP8 ? 512 : 1024, WS_WIN, P1_FP8 ? 512 : 1024);
          EpiProj E{(bf16_t*)(ws + WS_PROJ), (bf16_t*)(ws + WS_GATES), 0};
          if (P1_FP8) pg8::gemm_phase<EpiProj, DenseOrder, true, true, true>(ring, rsrc, pg8::Shape{1024, 1024, 1024, 0x7c7c7c7c, 0x7c7c7c7c}, S, E);
          else pg8::gemm_phase<EpiProj, DenseOrder, true, true>(ring, rsrc, pg8::Shape{2048, 2048, 2048, 0, 0}, S, E, GP_AT(1)); }
        { DenseOrder S; S.init(64, 4, F.G, (int)blockIdx.x, WS_PB, 256, WS_WPLE, 256);
          EpiBf16 E{(bf16_t*)(ws + WS_E), 1024};
          pg8::gemm_phase<EpiBf16, DenseOrder, true, true>(ring, rsrc, pg8::Shape{512, 512, 512, 0, 0}, S, E); }
    } SEAM(1);

    if (IN(2)) { p2_rows(F); } SEAM(2);

    if (IN(3)) {
#ifndef P3M
#define P3M 7
#endif
        if (P3M & 1) { DenseOrder S; S.init(64, 4, F.G, (int)blockIdx.x, WS_A2 + 512, 512, WS_WKV, 256);
          EpiKV E{(bf16_t*)(ws + WS_K), (bf16_t*)(ws + WS_V), kargs()->in[I_GKNOPE]};
          pg8::gemm_phase<EpiKV, DenseOrder, true, true>(ring, rsrc, pg8::Shape{512, 1024, 512, 0, 0}, S, E); }
        if (P3M & 2) { DenseOrder S; S.init(64, 3, F.G, (int)blockIdx.x, WS_A2, 512, WS_WQ, 256);
          EpiQ E{(bf16_t*)(ws + WS_Q), (float*)(ws + WS_SSQ), (const float*)(ws + WS_COS), (const float*)(ws + WS_SIN), kargs()->in[I_GQHEAD]};
          pg8::gemm_phase<EpiQ, DenseOrder, true, true>(ring, rsrc, pg8::Shape{512, 1024, 512, 0, 0}, S, E); }
        if (P3M & 4) { DenseOrder S; S.init(64, 2, F.G, (int)blockIdx.x, WS_POOLED, 512, WS_WPOOL, 256, 512);
          EpiBf16 E{(bf16_t*)(ws + WS_MIXED), 512};
          pg8::gemm_phase<EpiBf16, DenseOrder, true, true>(ring, rsrc, pg8::Shape{512, 1024, 512, 0, 0}, S, E); }
    } SEAM(3);

    if (IN(4)) {
        u32x4 srd; { const unsigned long wb = (unsigned long)ws; srd.x = (unsigned)__builtin_amdgcn_readfirstlane((int)(unsigned)wb); srd.y = (unsigned)__builtin_amdgcn_readfirstlane((int)(unsigned)(wb >> 32)); srd.z = (unsigned)WS_END; srd.w = 0x00020000u; }
        att::ConvState CV; CV.next = __builtin_amdgcn_readfirstlane(F.vcu * NWAVES + F.wave); CV.end = CONV_IN_ATTN ? att::CV_ITEMS : 0; CV.cur = -1;
        bool fast;
        { const int lane = tid_local() & 63; const float* gqh = kargs()->in[I_GQHEAD]; const float* gkn = kargs()->in[I_GKNOPE]; const float* gkr = kargs()->in[I_GKROPE];
          float a = fabsf(gqh[lane]); if (lane < 32) a = fmaxf(a, fabsf(gqh[64 + lane])); float bn = fabsf(gkn[lane]); float br = (lane < 32) ? fabsf(gkr[lane]) : 0.f;
#pragma unroll
          for (int o = 1; o < 64; o <<= 1) { a = fmaxf(a, __shfl_xor(a, o)); bn = fmaxf(bn, __shfl_xor(bn, o)); br = fmaxf(br, __shfl_xor(br, o)); }
          const float Mb = 1.4426950408889634f * 1.01f * a * sqrtf(64.f * bn * bn + 32.f * br * br);
          fast = __builtin_amdgcn_readfirstlane(Mb <= 60.0f ? 1 : 0) != 0; }
        for (int it = F.vcu; it < 256; it += F.G) {
            const int bh = it >> 3, pr = it & 7;
            att::attn_unit(ring, srd, CV, ws, bh, 15 - pr, (const bf16_t*)(ws + WS_Q), (unsigned)WS_K, (unsigned)WS_V, (const float*)(ws + WS_SSQ), (bf16_t*)(ws + WS_ATT), fast);
            att::attn_unit(ring, srd, CV, ws, bh, pr, (const bf16_t*)(ws + WS_Q), (unsigned)WS_K, (unsigned)WS_V, (const float*)(ws + WS_SSQ), (bf16_t*)(ws + WS_ATT), fast);
        }
        { const LAS float* cb = (const LAS float*)(F.lds + att::CONV_OFF + F.wave * att::CONV_BYTES);
          const unsigned cbaddr = (unsigned)__builtin_amdgcn_readfirstlane((int)(unsigned)(unsigned long)(F.lds + att::CONV_OFF + F.wave * att::CONV_BYTES));
          const int lane_l = tid_local() & 63;
          while (CV.cur >= 0 || CV.next < CV.end) {
            if (CV.cur >= 0) { asm volatile("s_waitcnt vmcnt(0)" ::: "memory"); const att::ConvItem I = att::cv_setup(CV.cur, kargs()->in[I_WGU], kargs()->in[I_WD], ws + WS_WGU, ws + WS_WD); att::cv_out(I, cb, lane_l); }
            if (CV.next < CV.end) { const att::ConvItem I = att::cv_setup(CV.next, kargs()->in[I_WGU], kargs()->in[I_WD], ws + WS_WGU, ws + WS_WD); asm volatile("s_waitcnt lgkmcnt(0)" ::: "memory"); att::cv_dma(I, cbaddr, lane_l); CV.cur = CV.next; CV.next += 2048; } else CV.cur = -1;
          } }
    } SEAM(4);

    if (IN(5)) {
        MixOrder S{F.G, F.vcu, (unsigned)WS_ATT, (unsigned)WS_MIXED, (unsigned)WS_WAO, (unsigned)WS_WPO};
        EpiMix E{(bf16_t*)(ws + WS_MIX), (const bf16_t*)(ws + WS_GATES)};
        pg8::gemm_phase<EpiMix, MixOrder, true, true>(ring, rsrc, pg8::Shape{1024, 1024, 1024, 0, 0}, S, E, GP_AT(5));
    } SEAM(5);

    if (IN(6)) {
        DenseOrder S; S.init(64, 4, F.G, (int)blockIdx.x, WS_MIX, 1024, WS_WO, 1024);
        EpiRes E{kargs()->in[I_X], (bf16_t*)(ws + WS_X1B)};
        pg8::gemm_phase<EpiRes, DenseOrder, true, true>(ring, rsrc, pg8::Shape{2048, 2048, 2048, 0, 0}, S, E, GP_AT(6));
    } SEAM(6);

    if (IN(7)) { p7_router(F); } SEAM(7);


    if (IN(9)) {
        const int TM = build_tiles(F);
        MoeGather S{F.G, F.vcu, 3, TM * 8, (const LAS int*)(F.lds + TILE_E_OFF) + 64, (unsigned)WS_XS2, (unsigned)WS_WGU, 2048u * 1024u, 256u * 1024u, 0, 0, (unsigned)WS_TOK}; S.init_xcd((const LAS int*)(F.lds + TILE_E_OFF));
        EpiSwiglu E{ws + WS_ACT, kargs()->in[I_BGU]};
        pg8::gemm_phase<EpiSwiglu, MoeGather, true, true, true, true>(ring, rsrc, pg8::Shape{1024, 1024, 1024, 0x7c7c7c7c, 0x7c7c7c7c}, S, E, GP_AT(9));
    } SEAM(9);

    if (IN(10)) {
        const int TM = build_tiles(F);
        MoeOrder S{F.G, F.vcu, 2, TM * 4, (const LAS int*)(F.lds + TILE_E_OFF) + 64, (unsigned)WS_ACT, (unsigned)WS_WD, 1024u * 1024u, 256u * 1024u, 0, 0}; S.init_xcd((const LAS int*)(F.lds + TILE_E_OFF));
        EpiDown E{ws + WS_XS, kargs()->in[I_BD]};
        pg8::gemm_phase<EpiDown, MoeOrder, true, true, true>(ring, rsrc, pg8::Shape{1024, 1024, 1024, 0x7c7c7c7c, 0x7c7c7c7c}, S, E, GP_AT(10));
    } SEAM(10);

    if (IN(11)) { p11_combine(F); } SEAM(11);

    if (IN(12)) {
        DenseOrder S; S.init(64, 4, F.G, (int)blockIdx.x, WS_HN, PLE_FP8 ? 512 : 1024, WS_WPG, PLE_FP8 ? 512 : 1024);
        EpiPle E{F.out, (const bf16_t*)(ws + WS_E), (const bf16_t*)(ws + WS_X2B)};
        if (PLE_FP8) pg8::gemm_phase<EpiPle, DenseOrder, true, true, true>(ring, rsrc, pg8::Shape{1024, 1024, 1024, 0x7c7c7c7c, 0x7c7c7c7c}, S, E, GP_AT(12));
        else pg8::gemm_phase<EpiPle, DenseOrder, true, true>(ring, rsrc, pg8::Shape{2048, 2048, 2048, 0, 0}, S, E, GP_AT(12));
    }
#ifdef ATT_PROBE
    if (blockIdx.x == 17 && tid_local() == 0) { const unsigned long long* ap = (const unsigned long long*)(ws + WS_CTL + 65536 + 64); const unsigned long long wait = (ap[0] / ap[1]) * 10; const unsigned long long r0 = __builtin_amdgcn_s_memrealtime(); while (__builtin_amdgcn_s_memrealtime() - r0 < wait) __builtin_amdgcn_s_sleep(8); }
#endif
#ifdef ATT_PROBE2
    if (blockIdx.x == 17 && tid_local() == 0) { const unsigned long long* ap = (const unsigned long long*)(ws + WS_CTL + 65536 + 128); const unsigned long long wait = (ap[ATT_PROBE2 - 1] / ap[3]) * 10; const unsigned long long r0 = __builtin_amdgcn_s_memrealtime(); while (__builtin_amdgcn_s_memrealtime() - r0 < wait) __builtin_amdgcn_s_sleep(8); }
#endif
#ifdef BAR_PROBE
    for (int i_ = 0; i_ < 20; ++i_) xcd_barrier(bar);
#endif
#ifdef GP_PROBE
    if (blockIdx.x == GP_BLOCK && tid_local() == 0) {
        unsigned long long* gp = (unsigned long long*)(ws + WS_CTL + 65536);
        const unsigned long long cyc = gp[0], tiles = gp[1], pc = gp[2], pr = gp[3], units = gp[4];
        unsigned long long wait = 0;
        if (GP_METRIC == 0) wait = (cyc / tiles) * 10;
        if (GP_METRIC == 1) wait = (pc * 100 / pr) * 10;
        if (GP_METRIC == 2) wait = ((pc - cyc) / units);
        const unsigned long long r0 = __builtin_amdgcn_s_memrealtime();
        while (__builtin_amdgcn_s_memrealtime() - r0 < wait) __builtin_amdgcn_s_sleep(8);
    }
#endif
#undef IN
#undef SEAM
}

extern "C" void kernel_launch(void* const* d_in, const int* in_sizes, int n_in, void* d_out, int out_size, void* d_ws, size_t ws_size, hipStream_t stream) {
    static int grid = 0;
    if (grid == 0) {
        if (n_in != 27 || out_size != T * DM || ws_size < WS_END) { fprintf(stderr, "kernel_launch: unexpected shapes (n_in %d, out %d, ws %zu)\n", n_in, out_size, ws_size); grid = -1; return; }
        int dev = 0, cus = 0;
        if (hipGetDevice(&dev) != hipSuccess || hipDeviceGetAttribute(&cus, hipDeviceAttributeMultiprocessorCount, dev) != hipSuccess) { grid = -1; return; }
        if (hipFuncSetAttribute((const void*)fwd_kernel, hipFuncAttributeMaxDynamicSharedMemorySize, LDS_BYTES) != hipSuccess) { fprintf(stderr, "kernel_launch: hipFuncSetAttribute failed\n"); grid = -1; return; }
        int per_cu = 0;
        if (hipOccupancyMaxActiveBlocksPerMultiprocessor(&per_cu, (const void*)fwd_kernel, NWAVES * 64, LDS_BYTES) != hipSuccess || per_cu < 1) fprintf(stderr, "kernel_launch: occupancy query says %d\n", per_cu);
        (void)hipGetLastError();
        grid = cus;
    }
    if (grid < 0) return;
    (void)hipMemsetAsync((char*)d_ws + WS_CTL, 0, CTL_ZERO_BYTES, stream);
    Args a{};
    for (int i = 0; i < 27; ++i) a.in[i] = (const float*)d_in[i];
    a.out = (float*)d_out; a.ws = (unsigned char*)d_ws;
#ifndef DUP_PHASE
    a.ph_lo = 0; a.ph_hi = N_PHASES; hipLaunchKernelGGL(fwd_kernel, dim3(grid), dim3(NWAVES * 64), LDS_BYTES, stream, a);
#else
    a.ph_lo = 0; a.ph_hi = DUP_PHASE + 1; hipLaunchKernelGGL(fwd_kernel, dim3(grid), dim3(NWAVES * 64), LDS_BYTES, stream, a);
    (void)hipMemsetAsync((char*)d_ws + WS_CTL + CW_BAR * 4, 0, XCD_BAR_WORDS * 4, stream);
    a.ph_lo = DUP_PHASE; a.ph_hi = N_PHASES; hipLaunchKernelGGL(fwd_kernel, dim3(grid), dim3(NWAVES * 64), LDS_BYTES, stream, a);
#endif
}
```

```cpp
#define GATE8 2
#include <hip/hip_runtime.h>
#ifndef GATE8
#define GATE8 0
#endif
#include <cstdio>
#include <cstdint>

#define LAS __attribute__((address_space(3)))
#define GAS __attribute__((address_space(1)))
typedef unsigned short bf16_t;
typedef short bf16x8 __attribute__((ext_vector_type(8)));
typedef short s16x4 __attribute__((ext_vector_type(4)));
typedef float f32x4 __attribute__((ext_vector_type(4)));
typedef float f32x2 __attribute__((ext_vector_type(2)));
typedef float f32x16 __attribute__((ext_vector_type(16)));
typedef unsigned u32x4 __attribute__((ext_vector_type(4)));
typedef unsigned u32x2 __attribute__((ext_vector_type(2)));

constexpr int NB = 4, SEQ = 4096, T = NB * SEQ, DM = 1024, NH = 8, DK = 96, DV = 64;
constexpr int NEXP = 32, TOPK = 4, DEXP = 1024, PLE = 256;
constexpr float EPS = 1e-6f;
constexpr int XS_ROWS = T * TOPK + NEXP * 256;

typedef __bf16 bf16x2_t __attribute__((ext_vector_type(2)));
__device__ __forceinline__ unsigned cvt_pk_bf16(float lo, float hi) { f32x2 v = {lo, hi}; return __builtin_bit_cast(unsigned, __builtin_convertvector(v, bf16x2_t)); }
__device__ __forceinline__ u32x2 cvt8_fp8(const f32x4 a, const f32x4 b, float sc) {
    int w0 = __builtin_amdgcn_cvt_pk_fp8_f32(a[0] * sc, a[1] * sc, 0, false); w0 = __builtin_amdgcn_cvt_pk_fp8_f32(a[2] * sc, a[3] * sc, w0, true);
    int w1 = __builtin_amdgcn_cvt_pk_fp8_f32(b[0] * sc, b[1] * sc, 0, false); w1 = __builtin_amdgcn_cvt_pk_fp8_f32(b[2] * sc, b[3] * sc, w1, true);
    u32x2 r; r.x = (unsigned)w0; r.y = (unsigned)w1; return r;
}
__device__ __forceinline__ float bf_lo(unsigned w) { return __uint_as_float(w << 16); }
__device__ __forceinline__ float bf_hi(unsigned w) { return __uint_as_float(w & 0xffff0000u); }
__device__ __forceinline__ float bf1(bf16_t h) { return __uint_as_float(((unsigned)h) << 16); }
__device__ __forceinline__ float fast_sigmoid(float v) { return __builtin_amdgcn_rcpf(1.0f + __builtin_amdgcn_exp2f(-1.4426950408889634f * v)); }
__device__ __forceinline__ int lane_id() { return (int)__builtin_amdgcn_mbcnt_hi(~0u, __builtin_amdgcn_mbcnt_lo(~0u, 0u)); }
__device__ __forceinline__ int tid_local() { int t = threadIdx.x; asm volatile("" : "+v"(t)); return t; }
__device__ __forceinline__ float wave_sum(float v) {
#pragma unroll
    for (int o = 1; o < 64; o <<= 1) v += __shfl_xor(v, o);
    return v;
}

namespace pg8 {
constexpr int BM = 256, BK = 64, HALF = 128, HTB = HALF * BK * 2, STAGE_BYTES = 8 * HTB;
__host__ __device__ __forceinline__ int lds_byte(int r, int c) { const int st = (r >> 4) * 2 + (c >> 5), rr = r & 15, cc = c & 31, ob = rr * 64 + cc * 2; return st * 1024 + (ob ^ (((ob >> 9) & 1) << 5)); }
__host__ __device__ __forceinline__ void stage_rc(int b, int& R, int& C) { const int st = b / 1024, sb = b % 1024, swz = sb ^ (((sb >> 9) & 1) << 5); R = (st >> 1) * 16 + swz / 64; C = (st & 1) * 32 + (swz % 64) / 2; }
__host__ __device__ __forceinline__ int perm32(int rho) { const int n = rho >> 4, i = rho & 15; return 8 * (i >> 2) + 4 * n + (i & 3); }

struct Unit { int pm, pn, aux; };
struct Shape { int Kb, lda, ldb, sw, sa; };
typedef int v8i_t __attribute__((ext_vector_type(8))); typedef int v4i_t __attribute__((ext_vector_type(4)));

template <class Epi, class Sched, bool ALIGN_EPI, bool SP2, bool MX = false, bool GATHER = false>
__device__ __forceinline__ void gemm_phase(LAS unsigned char* lds, const __amdgpu_buffer_rsrc_t rsrc, const Shape g, const Sched& S, const Epi& E, unsigned long long* gp_out = nullptr) {
    const int tid = tid_local(), wid = __builtin_amdgcn_readfirstlane(tid >> 6), lane = tid & 63, wr = wid >> 2, wc = wid & 3, fr = lane & 15, fq = lane >> 4;
    int nt = g.Kb / 128; asm volatile("" : "+s"(nt));
    unsigned voffA, voffB;
    { int R, C; stage_rc(tid * 16, R, C); const int Rb = Epi::PERM ? ((R & ~31) + perm32(R & 31)) : R;
      voffA = GATHER ? (unsigned)(C * 2 + (R << 16)) : (unsigned)(R * g.lda + C * 2); voffB = (unsigned)(Rb * g.ldb + C * 2); }
    const unsigned p2A = 64u * (unsigned)g.lda, p2B = 64u * (unsigned)g.ldb;
    const unsigned kstep = 128u;
    const unsigned hstepA = (unsigned)HALF * g.lda, hstepB = (unsigned)HALF * g.ldb;
    const unsigned ldsw = (unsigned)wid * 1024u;
    const int aoff = lds_byte(wr * 64 + fr, fq * 8), boff = lds_byte(wc * 32 + fr, fq * 8);
#define PG8_SA(b, h) (((b) * 2 + (h)) * HTB)
#define PG8_SB(b, h) ((4 + (b) * 2 + (h)) * HTB)
#define PG8_STAGE(bufoff, gbase, voff) do { \
        __builtin_amdgcn_raw_ptr_buffer_load_lds(rsrc, (LAS void*)(lds + (bufoff) + ldsw), 16, voff, (gbase), 0, 0); \
        __builtin_amdgcn_raw_ptr_buffer_load_lds(rsrc, (LAS void*)(lds + (bufoff) + ldsw + 8192), 16, voff, (gbase) + p2##voff, 0, 0); } while (0)
#define p2voffA p2A
#define p2voffB p2B
#define PG8_STAGEA(bufoff, gk, h, tab) do { if constexpr (GATHER) { \
        const LAS int* tb_ = (const LAS int*)(lds + STAGE_BYTES) + (tab) * 256 + (h) * 128 + (int)(voffA >> 16); const unsigned cb_ = voffA & 0xffffu; \
        const unsigned i0_ = (unsigned)tb_[0], i1_ = (unsigned)tb_[64]; \
        __builtin_amdgcn_raw_ptr_buffer_load_lds(rsrc, (LAS void*)(lds + (bufoff) + ldsw), 16, i0_ * (unsigned)g.lda + cb_, (gk), 0, 0); \
        __builtin_amdgcn_raw_ptr_buffer_load_lds(rsrc, (LAS void*)(lds + (bufoff) + ldsw + 8192), 16, i1_ * (unsigned)g.lda + cb_, (gk), 0, 0); } \
      else { PG8_STAGE(bufoff, (gk) + (h) * hstepA, voffA); } } while (0)
#define PG8_LDA(dst, b, h) do { _Pragma("unroll") for (int m = 0; m < 4; ++m) _Pragma("unroll") for (int k = 0; k < 2; ++k) dst[m][k] = *(const LAS bf16x8*)(lds + PG8_SA(b, h) + aoff + m * 2048 + k * 1024); } while (0)
#define PG8_LDB(dst, b, h) do { _Pragma("unroll") for (int n = 0; n < 2; ++n) _Pragma("unroll") for (int k = 0; k < 2; ++k) dst[n][k] = *(const LAS bf16x8*)(lds + PG8_SB(b, h) + boff + n * 2048 + k * 1024); } while (0)
#define PG8_CAT(x, y) __builtin_shufflevector(__builtin_bit_cast(v4i_t, x), __builtin_bit_cast(v4i_t, y), 0, 1, 2, 3, 4, 5, 6, 7)
#define PG8_MMA(ai, bj, At, Bt) do { __builtin_amdgcn_s_setprio(1); if constexpr (MX) { _Pragma("unroll") for (int m = 0; m < 4; ++m) _Pragma("unroll") for (int n = 0; n < 2; ++n) \
        acc[ai][bj][m][n] = __builtin_amdgcn_mfma_scale_f32_16x16x128_f8f6f4(PG8_CAT(Bt[n][0], Bt[n][1]), PG8_CAT(At[m][0], At[m][1]), acc[ai][bj][m][n], 0, 0, 0, g.sw, 0, g.sa); } else { \
        _Pragma("unroll") for (int m = 0; m < 4; ++m) _Pragma("unroll") for (int n = 0; n < 2; ++n) _Pragma("unroll") for (int k = 0; k < 2; ++k) \
        acc[ai][bj][m][n] = __builtin_amdgcn_mfma_f32_16x16x32_bf16(Bt[n][k], At[m][k], acc[ai][bj][m][n], 0, 0, 0); } __builtin_amdgcn_s_setprio(0); } while (0)
#define PG8_WAIT_V(n) asm volatile("s_waitcnt vmcnt(" #n ")" ::: "memory")
#define PG8_WAIT_L(n) asm volatile("s_waitcnt lgkmcnt(" #n ")" ::: "memory")
#define PG8_BAR __builtin_amdgcn_s_barrier()
#define PG8_SCHED __builtin_amdgcn_sched_barrier(0)
#ifdef GP_PROBE
    unsigned long long gp_cycles = 0, gp_tiles = 0; const unsigned long long gp_p0 = __builtin_amdgcn_s_memtime(), gp_r0 = __builtin_amdgcn_s_memrealtime();
#endif
    Unit cur, nxt; int ui = 0;
    if (!S.next(0, cur)) return;
    f32x4 acc[2][2][4][2];
    E.init(acc, cur, wc, fq);
    bf16x8 At[4][2], B0[2][2], B1[2][2];
    unsigned cA = S.a_off(cur), cB = S.b_off(cur);
    int tab_c = 0; (void)tab_c;
    if constexpr (GATHER) {
        if (wid < 4) {
            const unsigned dst_ = (unsigned)__builtin_amdgcn_readfirstlane((int)(unsigned)(unsigned long)(lds + STAGE_BYTES + (wid * 64) * 4));
            const unsigned vo_ = (unsigned)((wid * 64 + lane) * 4); const unsigned so_ = S.tok_off(cur);
            asm volatile("s_nop 4\n\ts_mov_b32 m0, %0\n\ts_nop 0\n\tbuffer_load_dword %1, %2, %3 offen lds" :: "s"(dst_), "v"(vo_), "s"(rsrc), "s"(so_) : "m0", "memory"); }
        asm volatile("s_waitcnt vmcnt(0)" ::: "memory"); __syncthreads();
    }
    if constexpr (SP2) {
        PG8_STAGE(PG8_SB(0, 0), cB, voffB); PG8_STAGE(PG8_SB(0, 1), cB + hstepB, voffB); PG8_STAGEA(PG8_SA(0, 0), cA, 0, tab_c); PG8_STAGEA(PG8_SA(0, 1), cA, 1, tab_c);
        if (wr == 1) PG8_BAR;
        PG8_WAIT_V(2); PG8_BAR;
        PG8_STAGE(PG8_SB(1, 0), cB + kstep, voffB); PG8_STAGEA(PG8_SA(1, 0), cA + kstep, 0, tab_c); PG8_STAGE(PG8_SB(1, 1), cB + hstepB + kstep, voffB);
        PG8_WAIT_V(6); PG8_BAR;
    } else {
        PG8_STAGE(PG8_SB(0, 0), cB, voffB); PG8_STAGEA(PG8_SA(0, 0), cA, 0, tab_c); PG8_STAGE(PG8_SB(0, 1), cB + hstepB, voffB); PG8_STAGEA(PG8_SA(0, 1), cA, 1, tab_c);
        if (wr == 1) PG8_BAR;
        PG8_WAIT_V(4); PG8_BAR;
        PG8_STAGE(PG8_SB(1, 0), cB + kstep, voffB); PG8_STAGEA(PG8_SA(1, 0), cA + kstep, 0, tab_c); PG8_STAGE(PG8_SB(1, 1), cB + hstepB + kstep, voffB);
        PG8_WAIT_V(6); PG8_BAR;
    }
    for (;;) {
        const bool has_next = S.next(ui + 1, nxt);
        const unsigned nA = has_next ? S.a_off(nxt) : cA, nB = has_next ? S.b_off(nxt) : cB;
        if constexpr (GATHER) { if (has_next && wid < 4) {
            const unsigned dst_ = (unsigned)__builtin_amdgcn_readfirstlane((int)(unsigned)(unsigned long)(lds + STAGE_BYTES + ((tab_c ^ 1) * 256 + wid * 64) * 4));
            const unsigned vo_ = (unsigned)((wid * 64 + lane) * 4); const unsigned so_ = S.tok_off(nxt);
            asm volatile("s_nop 4\n\ts_mov_b32 m0, %0\n\ts_nop 0\n\tbuffer_load_dword %1, %2, %3 offen lds" :: "s"(dst_), "v"(vo_), "s"(rsrc), "s"(so_) : "m0", "memory"); } }
#ifdef GP_PROBE
        const unsigned long long gp_t0 = __builtin_amdgcn_s_memtime();
#endif
#pragma nounroll
        for (int t = 0; t < nt; t += 2) {
            const bool last = (t == nt - 2);
            const unsigned a1 = cA + (unsigned)(t + 1) * kstep;
            const unsigned a2 = last ? nA : cA + (unsigned)(t + 2) * kstep, b2 = last ? nB : cB + (unsigned)(t + 2) * kstep;
            const unsigned a3 = a2 + kstep, b3 = b2 + kstep; const int tab_2 = last ? (tab_c ^ 1) : tab_c; (void)tab_2;
            if constexpr (SP2) {
            PG8_LDB(B0, 0, 0); PG8_LDB(B1, 0, 1); PG8_SCHED; PG8_LDA(At, 0, 0); PG8_STAGEA(PG8_SA(1, 1), a1, 1, tab_c);
            PG8_WAIT_V(8); PG8_WAIT_L(0); PG8_BAR; PG8_MMA(0, 0, At, B0); PG8_MMA(0, 1, At, B1); PG8_BAR; PG8_SCHED;
            PG8_LDA(At, 0, 1); PG8_STAGE(PG8_SB(0, 0), b2, voffB); PG8_STAGE(PG8_SB(0, 1), b2 + hstepB, voffB); PG8_STAGEA(PG8_SA(0, 0), a2, 0, tab_2);
            PG8_WAIT_V(8); PG8_WAIT_L(0); PG8_BAR; PG8_MMA(1, 0, At, B0); PG8_MMA(1, 1, At, B1); PG8_BAR; PG8_SCHED;
            PG8_LDB(B0, 1, 0); PG8_LDB(B1, 1, 1); PG8_SCHED; PG8_LDA(At, 1, 0); PG8_STAGEA(PG8_SA(0, 1), a2, 1, tab_2);
            PG8_WAIT_V(8); PG8_WAIT_L(0); PG8_BAR; PG8_MMA(0, 0, At, B0); PG8_MMA(0, 1, At, B1); PG8_BAR; PG8_SCHED;
            PG8_LDA(At, 1, 1); PG8_STAGE(PG8_SB(1, 0), b3, voffB); PG8_STAGE(PG8_SB(1, 1), b3 + hstepB, voffB); PG8_STAGEA(PG8_SA(1, 0), a3, 0, tab_2);
            PG8_WAIT_V(8); PG8_WAIT_L(0); PG8_BAR; PG8_MMA(1, 0, At, B0); PG8_MMA(1, 1, At, B1); PG8_BAR; PG8_SCHED;
            } else {
            PG8_LDB(B0, 0, 0); PG8_SCHED; PG8_LDA(At, 0, 0); PG8_STAGEA(PG8_SA(1, 1), a1, 1, tab_c);
            PG8_WAIT_L(8); PG8_BAR; PG8_WAIT_L(0); PG8_MMA(0, 0, At, B0); PG8_BAR; PG8_SCHED;
            PG8_LDB(B1, 0, 1); PG8_STAGE(PG8_SB(0, 0), b2, voffB);
            PG8_BAR; PG8_WAIT_L(0); PG8_MMA(0, 1, At, B1); PG8_BAR;
            PG8_LDA(At, 0, 1); PG8_STAGEA(PG8_SA(0, 0), a2, 0, tab_2);
            PG8_BAR; PG8_WAIT_L(0); PG8_MMA(1, 0, At, B0); PG8_BAR; PG8_SCHED;
            PG8_STAGE(PG8_SB(0, 1), b2 + hstepB, voffB);
            PG8_WAIT_V(6); PG8_BAR; PG8_MMA(1, 1, At, B1); PG8_BAR;
            PG8_LDB(B0, 1, 0); PG8_SCHED; PG8_LDA(At, 1, 0); PG8_STAGEA(PG8_SA(0, 1), a2, 1, tab_2);
            PG8_WAIT_L(8); PG8_BAR; PG8_WAIT_L(0); PG8_MMA(0, 0, At, B0); PG8_BAR; PG8_SCHED;
            PG8_LDB(B1, 1, 1); PG8_STAGE(PG8_SB(1, 0), b3, voffB);
            PG8_BAR; PG8_WAIT_L(0); PG8_MMA(0, 1, At, B1); PG8_BAR;
            PG8_LDA(At, 1, 1); PG8_STAGEA(PG8_SA(1, 0), a3, 0, tab_2);
            PG8_BAR; PG8_WAIT_L(0); PG8_MMA(1, 0, At, B0); PG8_BAR; PG8_SCHED;
            PG8_STAGE(PG8_SB(1, 1), b3 + hstepB, voffB);
            PG8_WAIT_V(6); PG8_BAR; PG8_MMA(1, 1, At, B1); PG8_BAR;
            }
        }
#ifdef GP_PROBE
        if (gp_out) { gp_cycles += __builtin_amdgcn_s_memtime() - gp_t0; gp_tiles += nt; }
#endif
        if constexpr (ALIGN_EPI) { if (wr == 0) PG8_BAR; }
        if (has_next) S.prefetch(nxt, rsrc, lds, wid, lane);
        { int fr_e = fr, fq_e = fq; asm volatile("" : "+v"(fr_e), "+v"(fq_e));
          E(acc, cur, wr, wc, fr_e, fq_e); }
        if (!has_next) break;
        { int fq_i = fq; asm volatile("" : "+v"(fq_i)); E.init(acc, nxt, wc, fq_i); }
        cur = nxt; cA = nA; cB = nB; ++ui; tab_c ^= 1;
        if constexpr (ALIGN_EPI) { if (wr == 1) PG8_BAR; }
    }
    PG8_WAIT_V(0);
    if constexpr (!ALIGN_EPI) { if (wr == 0) PG8_BAR; }
    PG8_BAR;
#ifdef GP_PROBE
    if (gp_out && blockIdx.x == GP_BLOCK && tid == 0) { gp_out[0] = gp_cycles; gp_out[1] = gp_tiles; gp_out[2] = __builtin_amdgcn_s_memtime() - gp_p0; gp_out[3] = __builtin_amdgcn_s_memrealtime() - gp_r0; gp_out[4] = (unsigned long long)(ui + 1); }
#endif
#undef PG8_SA
#undef PG8_SB
#undef PG8_STAGE
#undef p2voffA
#undef PG8_STAGEA
#undef p2voffB
#undef PG8_LDA
#undef PG8_LDB
#undef PG8_MMA
#undef PG8_CAT
#undef PG8_WAIT_V
#undef PG8_WAIT_L
#undef PG8_BAR
#undef PG8_SCHED
}
}
using pg8::Unit;

constexpr size_t MiB = 1u << 20;
constexpr size_t WS_CTL = 0, CTL_ZERO_BYTES = 1 * MiB;
constexpr size_t WS_WIN = 1 * MiB;
constexpr size_t WS_WQ = 7 * MiB;
constexpr size_t WS_WKV = WS_WQ + 512 * 1024;
constexpr size_t WS_WPOOL = 8 * MiB;
constexpr size_t WS_WAO = 9 * MiB;
constexpr size_t WS_WPO = 10 * MiB;
constexpr size_t WS_WO = 11 * MiB;
constexpr size_t WS_WPG = 13 * MiB;
constexpr size_t WS_WPLE = 15 * MiB;
constexpr size_t WS_WGU = 16 * MiB;
constexpr size_t WS_WD = 144 * MiB;
constexpr size_t WS_HN = 208 * MiB;
constexpr size_t WS_PROJ = 240 * MiB;
constexpr size_t WS_GATES = 272 * MiB;
constexpr size_t WS_A2 = 336 * MiB;
constexpr size_t WS_POOLED = 352 * MiB;
constexpr size_t WS_Q = 368 * MiB;
constexpr size_t WS_K = 392 * MiB;
constexpr size_t WS_V = 416 * MiB;
constexpr size_t WS_ATT = 432 * MiB;
constexpr size_t WS_MIXED = 448 * MiB;
constexpr size_t WS_MIX = 464 * MiB;
constexpr size_t WS_PB = 496 * MiB;
constexpr size_t WS_E = 504 * MiB;
constexpr size_t WS_SSQ = 536 * MiB;
constexpr size_t WS_COS = 537 * MiB;
constexpr size_t WS_SIN = 538 * MiB;
constexpr size_t WS_ROUTE = 539 * MiB;
constexpr size_t WS_TOK = 541 * MiB;
constexpr size_t WS_XS = 544 * MiB;
constexpr size_t WS_ACT = 688 * MiB;
constexpr size_t WS_XS2 = 768 * MiB;
constexpr size_t WS_WIN8 = 848 * MiB;
constexpr size_t WS_HN8 = 852 * MiB;
constexpr size_t WS_END = 868 * MiB;
constexpr size_t WS_X1B = WS_PROJ;
constexpr size_t WS_X2B = WS_MIX;
constexpr int CW_BAR = 4096;
constexpr int CW_CNT = 1024;

constexpr int RING_BYTES = 131072;
constexpr int LDS_BYTES = 163840;
constexpr int MISC_OFF = LDS_BYTES - 512;
constexpr int TILE_E_OFF = LDS_BYTES - 4096;
constexpr int NWAVES = 8;

typedef GAS unsigned gu32;
#define RLX_AGENT __ATOMIC_RELAXED, __HIP_MEMORY_SCOPE_AGENT
#define XB_TMO      128
#define XB_XCNT(j)  (256  + 64 * (j))
#define XB_XSUB(j)  (1280 + 64 * (j))
#define XB_XGEN(j)  (2304 + 64 * (j))
#define XB_TOP      3328
#define XB_TOPGEN   3392
#define XCD_BAR_WORDS 3456
#define XB_SPIN_CAP (1u << 18)
__device__ __forceinline__ unsigned xb_ld(unsigned* p)              { return __hip_atomic_load(p, __ATOMIC_RELAXED, __HIP_MEMORY_SCOPE_AGENT); }
__device__ __forceinline__ unsigned xb_add(unsigned* p, unsigned v) { return __hip_atomic_fetch_add(p, v, __ATOMIC_RELAXED, __HIP_MEMORY_SCOPE_AGENT); }
__device__ __forceinline__ unsigned xb_xcc_id() { return (unsigned)__builtin_amdgcn_s_getreg((3 << 11) | 20) & 0xFu; }
#define XB_SPIN(cond, bar) do { unsigned _sp = 0; while (cond) { __builtin_amdgcn_s_sleep(1); \
    if ((++_sp & 255u) == 0u) { if (xb_ld(&(bar)[XB_TMO])) break; if (_sp > XB_SPIN_CAP) { atomicAdd(&(bar)[XB_TMO], 1u); break; } } } } while (0)
struct XcdBarrier { unsigned* bar; unsigned x; volatile LAS unsigned* st; };
__device__ __forceinline__ XcdBarrier xcd_barrier_post(unsigned* bar, volatile LAS unsigned* st) {
    XcdBarrier b; b.bar = bar; b.x = xb_xcc_id(); b.st = st;
    if (threadIdx.x == 0) (void)xb_add(&bar[XB_XCNT(b.x)], 1u);
    return b;
}
__device__ __forceinline__ void xcd_barrier_complete(unsigned* bar, unsigned x, unsigned& nloc, unsigned& nx) {
    const unsigned G = gridDim.x * gridDim.y * gridDim.z;
    unsigned sum, cnt, mine, sp = 0u;
    for (;;) {
        sum = 0u; cnt = 0u; mine = 0u;
#pragma unroll
        for (unsigned j = 0; j < 16; ++j) { const unsigned c = xb_ld(&bar[XB_XCNT(j)]); sum += c; cnt += (c > 0u) ? 1u : 0u; mine = (j == x) ? c : mine; }
        if (sum == G) break;
        __builtin_amdgcn_s_sleep(1);
        if ((++sp & 255u) == 0u) { if (xb_ld(&bar[XB_TMO])) break; if (sp > XB_SPIN_CAP) { atomicAdd(&bar[XB_TMO], 1u); break; } }
    }
    nloc = mine > 0u ? mine : 1u; nx = cnt > 0u ? cnt : 1u;
}
__device__ __forceinline__ void xcd_barrier(const XcdBarrier& b) {
    asm volatile("s_waitcnt vmcnt(0)" ::: "memory");
    __syncthreads();
    if (threadIdx.x == 0) {
        unsigned* bar = b.bar;
        __builtin_amdgcn_s_waitcnt(0);
        unsigned nloc = b.st[0], nx = b.st[1];
        if (nloc == 0u) { xcd_barrier_complete(bar, b.x, nloc, nx); b.st[0] = nloc; b.st[1] = nx; }
        const unsigned old = xb_add(&bar[XB_XSUB(b.x)], 1u);
        const unsigned gen = old / nloc;
        if (old + 1u == (gen + 1u) * nloc) {
            __builtin_amdgcn_fence(__ATOMIC_RELEASE, "agent");
            asm volatile("s_waitcnt vmcnt(0)" ::: "memory");
            const unsigned og = xb_add(&bar[XB_TOP], 1u);
            const unsigned tg = og / nx;
            if (og + 1u == (tg + 1u) * nx) xb_add(&bar[XB_TOPGEN], 1u);
            else XB_SPIN(xb_ld(&bar[XB_TOPGEN]) == tg, bar);
            __builtin_amdgcn_fence(__ATOMIC_ACQUIRE, "agent");
            xb_add(&bar[XB_XGEN(b.x)], 1u);
            asm volatile("s_waitcnt vmcnt(0)" ::: "memory");
        } else {
            XB_SPIN(xb_ld(&bar[XB_XGEN(b.x)]) == gen, bar);
            __builtin_amdgcn_fence(__ATOMIC_ACQUIRE, "agent");
            asm volatile("s_waitcnt vmcnt(0)" ::: "memory");
        }
    }
    __syncthreads();
}

#ifdef GP_PROBE
#define GP_AT(k) ((k) == GP_PHASE ? (unsigned long long*)(ws + WS_CTL + 65536) : nullptr)
#else
#define GP_AT(k) nullptr
#endif
struct Args {
    const float* in[27];
    float* out; unsigned char* ws;
    int ph_lo, ph_hi;
};
typedef const __attribute__((address_space(4))) Args* KArgs;
__device__ __forceinline__ KArgs kargs() { KArgs p = (KArgs)__builtin_amdgcn_kernarg_segment_ptr(); asm volatile("" : "+s"(p)); return p; }
enum { I_X = 0, I_P, I_POS, I_GMIX, I_WIN, I_GQLAT, I_WQB, I_GKVLAT, I_WKVB, I_GQHEAD, I_GKNOPE, I_GKROPE, I_WPOOL, I_PSCALE, I_WAO, I_WPO, I_WO, I_GFFN,
       I_WR, I_BR, I_WGU, I_BGU, I_WD, I_BD, I_GPLE, I_WPG, I_WPLE };

enum { MAP_ID = 0, MAP_WIN, MAP_GU, MAP_QB, MAP_KVB };
__device__ __forceinline__ int map_row(int mode, int n) {
    switch (mode) {
    case MAP_WIN: return n < 416 ? n : n + 96;
    case MAP_GU: { const int j = n & 1023, up = n >> 10; return 256 * (j >> 7) + 128 * up + (j & 127); }
    case MAP_QB: { const int h = n / 96, d = n % 96;
        if (d < 64) return (h >> 2) * 256 + 128 * (d >> 5) + 32 * (h & 3) + (d & 31);
        const int dd = d - 64, half = dd >> 4, i = dd & 15; return 512 + 128 * (h & 1) + 32 * (h >> 1) + 8 * (i >> 2) + 4 * half + (i & 3); }
    case MAP_KVB: { const int h = n >> 7, c = n & 127, isv = c >> 6, d = c & 63; return (h >> 1) * 256 + 128 * (d >> 5) + 32 * (2 * isv + (h & 1)) + (d & 31); }
    default: return n;
    }
}
struct TJob { const float* W; int K, N; bf16_t* WT; int ldw, koff, mode, row_off; const float* gk; const float* gn; int nmat; size_t wstride, wtstride; int fp8; };
struct TItem { const float* src; bf16_t* dst; int n0, k0; float gnv; };
__device__ __forceinline__ TItem titem_setup(const TJob& J, int item, int lane) {
    const int nblk = J.N / 32, ipm = (J.K / 64) * nblk, mat = item / ipm, it = item - mat * ipm, kb = it / nblk, nb = it - kb * nblk;
    TItem I; I.k0 = 64 * kb; I.n0 = 32 * nb;
    I.src = J.W + (size_t)mat * J.wstride + (size_t)(I.k0 + (lane >> 5)) * J.N + I.n0 + (lane & 31);
    I.dst = (bf16_t*)((unsigned char*)J.WT + (size_t)mat * J.wtstride * (J.fp8 ? 1 : 2));
    I.gnv = J.gn ? J.gn[I.n0 + (lane & 31)] : 1.f;
    return I;
}
__device__ __forceinline__ void titem_load(const TJob& J, const TItem& I, float (&v)[32]) {
#pragma unroll
    for (int i = 0; i < 32; ++i) v[i] = I.src[(size_t)(2 * i) * J.N];
}
__device__ __forceinline__ void titem_store(const TJob& J, const TItem& I, float (&v)[32], LAS float* scr, int lane) {
#pragma unroll
    for (int i = 0; i < 32; ++i) { const int kk = 2 * i + (lane >> 5); float x = v[i] * I.gnv; if (J.gk) x *= J.gk[I.k0 + kk]; scr[kk * 33 + (lane & 31)] = x; }
    asm volatile("s_waitcnt lgkmcnt(0)" ::: "memory");
    const int c = lane & 7;
#pragma unroll
    for (int j = 0; j < 4; ++j) { const int n = (lane >> 3) + 8 * j; const LAS float* s = scr + (8 * c) * 33 + n;
        const size_t eo = (size_t)(J.row_off + map_row(J.mode, I.n0 + n)) * J.ldw + J.koff + I.k0 + 8 * c;
        if (J.fp8) { u32x2 o; int w = __builtin_amdgcn_cvt_pk_fp8_f32(s[0 * 33] * 8.f, s[1 * 33] * 8.f, 0, false); w = __builtin_amdgcn_cvt_pk_fp8_f32(s[2 * 33] * 8.f, s[3 * 33] * 8.f, w, true); o.x = (unsigned)w;
            w = __builtin_amdgcn_cvt_pk_fp8_f32(s[4 * 33] * 8.f, s[5 * 33] * 8.f, 0, false); w = __builtin_amdgcn_cvt_pk_fp8_f32(s[6 * 33] * 8.f, s[7 * 33] * 8.f, w, true); o.y = (unsigned)w;
            *(u32x2*)((unsigned char*)I.dst + eo) = o; }
        else { u32x4 o; o.x = cvt_pk_bf16(s[0 * 33], s[1 * 33]); o.y = cvt_pk_bf16(s[2 * 33], s[3 * 33]); o.z = cvt_pk_bf16(s[4 * 33], s[5 * 33]); o.w = cvt_pk_bf16(s[6 * 33], s[7 * 33]);
            *(u32x4*)(I.dst + eo) = o; } }
    asm volatile("s_waitcnt lgkmcnt(0)" ::: "memory");
}
__device__ __forceinline__ void run_job(const TJob& J, LAS float* scr, int gw, int NGW, int lane) {
    const int items = J.nmat * (J.K / 64) * (J.N / 32);
    for (int it = gw; it < items; it += 2 * NGW) {
        const bool two = (it + NGW) < items;
        const TItem I0 = titem_setup(J, it, lane); const TItem I1 = titem_setup(J, two ? it + NGW : it, lane);
        float v0[32], v1[32];
        titem_load(J, I0, v0); if (two) titem_load(J, I1, v1);
        titem_store(J, I0, v0, scr, lane); if (two) titem_store(J, I1, v1, scr, lane);
    }
}

struct Frame {
    LAS unsigned char* lds; volatile LAS unsigned* MISC; unsigned* ctl;
    int wave, vcu, G;
    float* out; unsigned char* ws;
};

__device__ __forceinline__ void p0_prologue(const Frame& F) {
    const int tid_l = tid_local(), lane_l = tid_l & 63; (void)tid_l; (void)lane_l;
    const KArgs a = kargs();
    LAS float* scr = (LAS float*)(F.lds + F.wave * 16384);
    const int gw = F.vcu * NWAVES + F.wave, NGW = F.G * NWAVES;
    unsigned char* ws = F.ws;
    int joff = 0;
#define RUN_JOB(...) do { const TJob J_ = TJob{__VA_ARGS__, 1, 0, 0, 0}; run_job(J_, scr, (gw + NGW - joff % NGW) % NGW, NGW, lane_l); joff += (J_.K / 64) * (J_.N / 32); } while (0)
#ifndef P1_FP8
#define P1_FP8 0
#endif
    { const TJob J_{a->in[I_WIN], 1024, 2976, (bf16_t*)(ws + WS_WIN), 1024, 0, MAP_WIN, 0, nullptr, nullptr, 1, 0, 0, P1_FP8}; run_job(J_, scr, gw, NGW, lane_l); joff += 16 * 93; }
#ifndef GATES_FP8
#define GATES_FP8 0
#endif
    if (GATES_FP8) { const TJob J_{a->in[I_WIN], 1024, 2976, (bf16_t*)(ws + WS_WIN8), 1024, 0, MAP_WIN, 0, nullptr, nullptr, 1, 0, 0, 1}; run_job(J_, scr, gw, NGW, lane_l); }
    RUN_JOB(a->in[I_WQB], 256, 768, (bf16_t*)(ws + WS_WQ), 256, 0, MAP_QB, 0, a->in[I_GQLAT], nullptr);
    RUN_JOB(a->in[I_WKVB], 128, 1024, (bf16_t*)(ws + WS_WKV), 256, 0, MAP_KVB, 0, a->in[I_GKVLAT], nullptr);
    RUN_JOB(a->in[I_WAO], 512, 1024, (bf16_t*)(ws + WS_WAO), 512, 0, MAP_ID, 0, nullptr, nullptr);
    RUN_JOB(a->in[I_WPO], 512, 1024, (bf16_t*)(ws + WS_WPO), 512, 0, MAP_ID, 0, nullptr, nullptr);
    RUN_JOB(a->in[I_WO], 1024, 1024, (bf16_t*)(ws + WS_WO), 1024, 0, MAP_ID, 0, nullptr, nullptr);
#ifndef PLE_FP8
#define PLE_FP8 1
#endif
    { const TJob J_{a->in[I_WPG], 1024, 1024, (bf16_t*)(ws + WS_WPG), 1024, 0, MAP_ID, 0, nullptr, nullptr, 1, 0, 0, PLE_FP8}; run_job(J_, scr, (gw + NGW - joff % NGW) % NGW, NGW, lane_l); joff += 16 * 32; }
    RUN_JOB(a->in[I_WPLE], 256, 1024, (bf16_t*)(ws + WS_WPLE), 256, 0, MAP_ID, 0, nullptr, nullptr);
    for (int g = 0; g < 4; ++g)
        RUN_JOB(a->in[I_WPOOL] + (size_t)g * 128 * 128, 128, 128, (bf16_t*)(ws + WS_WPOOL) + (size_t)(g >> 1) * 256 * 256, 256, 128 * (g & 1), MAP_ID, 128 * (g & 1), nullptr, a->in[I_PSCALE] + 128 * g);
    {
        const int gt = (F.vcu * NWAVES + F.wave) * 64 + lane_l, NGT = NGW * 64;
        const u32x4 z = {0u, 0u, 0u, 0u};
        u32x4* w0 = (u32x4*)(ws + WS_WIN + (size_t)416 * 1024 * (P1_FP8 ? 1 : 2));
        for (int i = gt; i < 96 * (P1_FP8 ? 64 : 128); i += NGT) w0[i] = z;
        for (int i = gt; i < 1024 * 16; i += NGT) { const int r = i >> 4, c = i & 15; *(u32x4*)((bf16_t*)(ws + WS_WKV) + (size_t)r * 256 + 128 + 8 * c) = z; }
        for (int i = gt; i < 2 * 256 * 16; i += NGT) { const int p = i >> 12, r = (i >> 4) & 255, c = i & 15;
            const int k0 = (r < 128) ? 128 : 0; *(u32x4*)((bf16_t*)(ws + WS_WPOOL) + (size_t)p * 65536 + (size_t)r * 256 + k0 + 8 * c) = z; }
    }
#ifndef CONV_IN_ATTN
#define CONV_IN_ATTN 1
#endif
    if (!CONV_IN_ATTN) {
    { const TJob J{a->in[I_WGU], 1024, 2048, (bf16_t*)(ws + WS_WGU), 1024, 0, MAP_GU, 0, nullptr, nullptr, NEXP, (size_t)1024 * 2048, (size_t)2048 * 1024, 1}; run_job(J, scr, gw, NGW, lane_l); }
    { const TJob J{a->in[I_WD], 1024, 1024, (bf16_t*)(ws + WS_WD), 1024, 0, MAP_ID, 0, nullptr, nullptr, NEXP, (size_t)1024 * 1024, (size_t)1024 * 1024, 1}; run_job(J, scr, gw, NGW, lane_l); }
    }
    const float* x = a->in[I_X]; const float* gm = a->in[I_GMIX];
    f32x4 gv[4];
#pragma unroll
    for (int j = 0; j < 4; ++j) gv[j] = *(const f32x4*)(gm + 4 * lane_l + 256 * j);
    for (int m = gw; m < T; m += NGW) {
        const f32x4* xr = (const f32x4*)(x + (size_t)m * DM) + lane_l;
        f32x4 v[4]; float s = 0.f;
#pragma unroll
        for (int j = 0; j < 4; ++j) { v[j] = xr[64 * j]; s += (v[j].x * v[j].x + v[j].y * v[j].y) + (v[j].z * v[j].z + v[j].w * v[j].w); }
        const float rstd = 1.0f / sqrtf(wave_sum(s) * (1.f / DM) + EPS);
        if (P1_FP8) { int* o4 = (int*)(ws + WS_HN + (size_t)m * DM) + lane_l; const float r8 = rstd * 8.0f;
#pragma unroll
            for (int j = 0; j < 4; ++j) { int w = __builtin_amdgcn_cvt_pk_fp8_f32(v[j].x * r8 * gv[j].x, v[j].y * r8 * gv[j].y, 0, false); w = __builtin_amdgcn_cvt_pk_fp8_f32(v[j].z * r8 * gv[j].z, v[j].w * r8 * gv[j].w, w, true); o4[64 * j] = w; } }
        else { u32x2* o8 = (u32x2*)((bf16_t*)(ws + WS_HN) + (size_t)m * DM) + lane_l;
#pragma unroll
            for (int j = 0; j < 4; ++j) { u32x2 w; w.x = cvt_pk_bf16(v[j].x * rstd * gv[j].x, v[j].y * rstd * gv[j].y); w.y = cvt_pk_bf16(v[j].z * rstd * gv[j].z, v[j].w * rstd * gv[j].w); o8[64 * j] = w; }
            if (GATES_FP8) { int* o4 = (int*)(ws + WS_HN8 + (size_t)m * DM) + lane_l; const float r8 = rstd * 8.0f;
#pragma unroll
                for (int j = 0; j < 4; ++j) { int w = __builtin_amdgcn_cvt_pk_fp8_f32(v[j].x * r8 * gv[j].x, v[j].y * r8 * gv[j].y, 0, false); w = __builtin_amdgcn_cvt_pk_fp8_f32(v[j].z * r8 * gv[j].z, v[j].w * r8 * gv[j].w, w, true); o4[64 * j] = w; } } }
    }
    {
        const float* p = a->in[I_P];
        for (int m = gw; m < T; m += NGW) { const f32x4 v = *((const f32x4*)(p + (size_t)m * PLE) + lane_l); u32x2 w; w.x = cvt_pk_bf16(v.x, v.y); w.y = cvt_pk_bf16(v.z, v.w);
            *((u32x2*)((bf16_t*)(ws + WS_PB) + (size_t)m * PLE) + lane_l) = w; }
    }
}

struct DenseOrder {
    int nM, nN, nwg, G, c; unsigned A, B, tA, tB, aPn;
    __device__ void init(int nM_, int nN_, int G_, int c_, size_t A_, size_t lda, size_t B_, size_t ldb, unsigned aPn_ = 0) { nM = nM_; nN = nN_; nwg = nM * nN; G = G_; c = c_; A = (unsigned)A_; B = (unsigned)B_; tA = (unsigned)(256 * lda * 2); tB = (unsigned)(256 * ldb * 2); aPn = aPn_; }
    __device__ __forceinline__ bool next(int i, Unit& u) const {
        const long L = (long)i * G + c; if (L >= nwg) return false;
        int wgid = (int)L; { const int q = nwg / 8, r = nwg % 8, xcd = wgid % 8, off = wgid / 8; wgid = (xcd < r ? xcd * (q + 1) : r * (q + 1) + (xcd - r) * q) + off; }
        const int WGM = 8; const int nig = WGM * nN, gid = wgid / nig, fm = gid * WGM, gsz = (nM - fm) < WGM ? (nM - fm) : WGM;
        u.pm = fm + ((wgid % nig) % gsz); u.pn = (wgid % nig) / gsz; u.aux = 0; return true;
    }
    __device__ __forceinline__ void prefetch(const Unit&, const __amdgpu_buffer_rsrc_t, LAS unsigned char*, int, int) const {}
    __device__ __forceinline__ unsigned a_off(const Unit& u) const { return A + (unsigned)u.pm * tA + (unsigned)u.pn * aPn; }
    __device__ __forceinline__ unsigned b_off(const Unit& u) const { return B + (unsigned)u.pn * tB; }
};

struct EpiBf16 {
    static constexpr bool PERM = true;
    __device__ __forceinline__ void init(f32x4 (&acc)[2][2][4][2], const Unit&, int, int) const {
#pragma unroll
        for (int a = 0; a < 2; ++a)
#pragma unroll
            for (int b = 0; b < 2; ++b)
#pragma unroll
                for (int m = 0; m < 4; ++m)
#pragma unroll
                    for (int n = 0; n < 2; ++n) acc[a][b][m][n] = (f32x4){0.f, 0.f, 0.f, 0.f};
    }
    bf16_t* O; int ldc;
    __device__ __forceinline__ void operator()(const f32x4 (&acc)[2][2][4][2], const Unit& u, int wr, int wc, int fr, int fq) const {
        const int row0 = u.pm * 256 + wr * 64 + fr, col0 = u.pn * 256 + wc * 32 + 8 * fq;
#pragma unroll
        for (int ai = 0; ai < 2; ++ai)
#pragma unroll
            for (int m = 0; m < 4; ++m) { bf16_t* rowp = O + (size_t)(row0 + ai * 128 + m * 16) * ldc + col0;
#pragma unroll
                for (int bj = 0; bj < 2; ++bj) { const f32x4 v0 = acc[ai][bj][m][0], v1 = acc[ai][bj][m][1];
                    u32x4 w; w.x = cvt_pk_bf16(v0[0], v0[1]); w.y = cvt_pk_bf16(v0[2], v0[3]); w.z = cvt_pk_bf16(v1[0], v1[1]); w.w = cvt_pk_bf16(v1[2], v1[3]);
                    *(u32x4*)(rowp + bj * 128) = w; } }
    }
};
struct EpiProj {
    static constexpr bool PERM = true;
    __device__ __forceinline__ void init(f32x4 (&acc)[2][2][4][2], const Unit&, int, int) const {
#pragma unroll
        for (int a = 0; a < 2; ++a)
#pragma unroll
            for (int b = 0; b < 2; ++b)
#pragma unroll
                for (int m = 0; m < 4; ++m)
#pragma unroll
                    for (int n = 0; n < 2; ++n) acc[a][b][m][n] = (f32x4){0.f, 0.f, 0.f, 0.f};
    }
    bf16_t* PROJ; bf16_t* GATES; int pn_off;
    __device__ __forceinline__ void operator()(const f32x4 (&acc)[2][2][4][2], const Unit& u, int wr, int wc, int fr, int fq) const {
        const int pn = u.pn + pn_off; const int row0 = u.pm * 256 + wr * 64 + fr; const bool isg = pn >= 4;
        bf16_t* O = isg ? GATES : PROJ; const int ldc = isg ? 2048 : 1024; const int col0 = (isg ? pn - 4 : pn) * 256 + wc * 32 + 8 * fq;
#pragma unroll
        for (int ai = 0; ai < 2; ++ai)
#pragma unroll
            for (int m = 0; m < 4; ++m) { bf16_t* rowp = O + (size_t)(row0 + ai * 128 + m * 16) * ldc + col0;
#pragma unroll
                for (int bj = 0; bj < 2; ++bj) { f32x4 v0 = acc[ai][bj][m][0], v1 = acc[ai][bj][m][1];
                    if (isg) {
#pragma unroll
                        for (int e = 0; e < 4; ++e) { v0[e] = fast_sigmoid(v0[e]); v1[e] = fast_sigmoid(v1[e]); }
                        if (GATE8 == 2) {
                            unsigned w0_ = 0u, w1_ = 0u;
#pragma unroll
                            for (int e = 0; e < 4; ++e) { w0_ = __builtin_amdgcn_cvt_pk_u8_f32(fmaxf(__builtin_rintf(v0[e] * 255.0f), 1.0f), e, w0_); w1_ = __builtin_amdgcn_cvt_pk_u8_f32(fmaxf(__builtin_rintf(v1[e] * 255.0f), 1.0f), e, w1_); }
                            u32x2 w8_; w8_.x = w0_; w8_.y = w1_;
                            *(u32x2*)((unsigned char*)GATES + (size_t)(row0 + ai * 128 + m * 16) * 2048 + col0 + bj * 128) = w8_; continue; }
                        if (GATE8) {
#pragma unroll
                            for (int e = 0; e < 4; ++e) { v0[e] = fmaxf(v0[e] * 256.0f, 0.002f); v1[e] = fmaxf(v1[e] * 256.0f, 0.002f); }
                            *(u32x2*)((unsigned char*)GATES + (size_t)(row0 + ai * 128 + m * 16) * 2048 + col0 + bj * 128) = cvt8_fp8(v0, v1, 1.0f); continue; } }
                    u32x4 w; w.x = cvt_pk_bf16(v0[0], v0[1]); w.y = cvt_pk_bf16(v0[2], v0[3]); w.z = cvt_pk_bf16(v1[0], v1[1]); w.w = cvt_pk_bf16(v1[2], v1[3]);
                    *(u32x4*)(rowp + bj * 128) = w; } asm volatile("" ::: "memory"); }
    }
};

__device__ __forceinline__ void p2_rows(const Frame& F) {
    const int tid_l = tid_local(), lane_l = tid_l & 63; (void)tid_l; (void)lane_l;
    const KArgs a = kargs();
    const int gw = F.vcu * NWAVES + F.wave, NGW = F.G * NWAVES, lane = lane_l;
    unsigned char* ws = F.ws;
    const bf16_t* PROJ = (const bf16_t*)(ws + WS_PROJ);
    bf16_t* A2 = (bf16_t*)(ws + WS_A2); bf16_t* POOLED = (bf16_t*)(ws + WS_POOLED); bf16_t* Kb = (bf16_t*)(ws + WS_K);
    float* COS = (float*)(ws + WS_COS); float* SIN = (float*)(ws + WS_SIN);
    const int* positions = (const int*)a->in[I_POS];
    const float gkr = (lane < 32) ? a->in[I_GKROPE][lane] : 0.f;
    const float inv_freq = __builtin_amdgcn_exp2f(-(float)(lane & 15) * (13.287712379549449f / 16.0f));
    const int w = 2 << (lane >> 4);
    for (int task = gw; task < T / 8; task += NGW) {
        const int t0 = task * 8, b = t0 / SEQ, s0 = t0 % SEQ;
        u32x2 qlv[8]; unsigned kvv[8]; bf16_t krr[8]; int posv[8];
#pragma unroll
        for (int i = 0; i < 8; ++i) { const bf16_t* pr = PROJ + (size_t)(t0 + i) * 1024; qlv[i] = *(const u32x2*)(pr + 4 * lane); kvv[i] = *(const unsigned*)(pr + 256 + 2 * lane); krr[i] = pr[384 + (lane & 31)]; posv[i] = positions[t0 + i]; }
        {
            const bf16_t* base = PROJ + (size_t)(b * SEQ) * 1024 + 512 + 8 * lane;
            u32x4 I[15], C[8], L[8];
#pragma unroll
            for (int k = 0; k < 15; ++k) { const int r = s0 - 15 + k; I[k] = *(const u32x4*)(base + (size_t)(r < 0 ? 0 : r) * 1024); }
#pragma unroll
            for (int i = 0; i < 8; ++i) { C[i] = *(const u32x4*)(base + (size_t)(s0 + i) * 1024); const int rr = s0 + i - w + 1; L[i] = *(const u32x4*)(base + (size_t)(rr < 0 ? 0 : rr) * 1024); }
            float S[8];
#pragma unroll
            for (int j = 0; j < 8; ++j) S[j] = 0.f;
#pragma unroll
            for (int k = 0; k < 15; ++k) { const float mk = (s0 - 15 + k >= 0 && k >= 16 - w) ? 1.f : 0.f; const u32x4 v = I[k];
                S[0] += mk * bf_lo(v.x); S[1] += mk * bf_hi(v.x); S[2] += mk * bf_lo(v.y); S[3] += mk * bf_hi(v.y); S[4] += mk * bf_lo(v.z); S[5] += mk * bf_hi(v.z); S[6] += mk * bf_lo(v.w); S[7] += mk * bf_hi(v.w); }
#pragma unroll
            for (int i = 0; i < 8; ++i) {
                const int s = s0 + i;
                const u32x4 v = C[i];
                float uu[8] = {bf_lo(v.x), bf_hi(v.x), bf_lo(v.y), bf_hi(v.y), bf_lo(v.z), bf_hi(v.z), bf_lo(v.w), bf_hi(v.w)};
                const int cnt = (s + 1 < w) ? s + 1 : w; const float ic = 1.0f / (float)cnt;
                float o[8];
#pragma unroll
                for (int j = 0; j < 8; ++j) { S[j] += uu[j]; o[j] = S[j] * ic - uu[j]; }
                u32x4 wv; wv.x = cvt_pk_bf16(o[0], o[1]); wv.y = cvt_pk_bf16(o[2], o[3]); wv.z = cvt_pk_bf16(o[4], o[5]); wv.w = cvt_pk_bf16(o[6], o[7]);
                *(u32x4*)(POOLED + (size_t)(t0 + i) * 512 + 8 * lane) = wv;
                const float mq = (s - w + 1 >= 0) ? 1.f : 0.f; const u32x4 q = L[i];
                S[0] -= mq * bf_lo(q.x); S[1] -= mq * bf_hi(q.x); S[2] -= mq * bf_lo(q.y); S[3] -= mq * bf_hi(q.y); S[4] -= mq * bf_lo(q.z); S[5] -= mq * bf_hi(q.z); S[6] -= mq * bf_lo(q.w); S[7] -= mq * bf_hi(q.w);
            }
        }
#pragma unroll
        for (int i = 0; i < 8; ++i) {
            const int t = t0 + i, s = s0 + i;
            const u32x2 ql = qlv[i];
            const unsigned kvl = kvv[i];
            const float krv = (lane < 32) ? bf1(krr[i]) : 0.f;
            const float q0 = bf_lo(ql.x), q1 = bf_hi(ql.x), q2 = bf_lo(ql.y), q3 = bf_hi(ql.y);
            const float k0 = bf_lo(kvl), k1 = bf_hi(kvl);
            const float sq = wave_sum((q0 * q0 + q1 * q1) + (q2 * q2 + q3 * q3));
            const float sk = wave_sum(k0 * k0 + k1 * k1);
            const float sr = wave_sum(krv * krv);
            const float rq = 1.0f / sqrtf(sq * (1.f / 256.f) + EPS), rk = 1.0f / sqrtf(sk * (1.f / 128.f) + EPS), rr = 1.0f / sqrtf(sr * (1.f / 32.f) + EPS);
            u32x2 wq; wq.x = cvt_pk_bf16(q0 * rq, q1 * rq); wq.y = cvt_pk_bf16(q2 * rq, q3 * rq);
            *(u32x2*)(A2 + (size_t)t * 512 + 4 * lane) = wq;
            *(unsigned*)(A2 + (size_t)t * 512 + 256 + 2 * lane) = cvt_pk_bf16(k0 * rk, k1 * rk);
            *(unsigned*)(A2 + (size_t)t * 512 + 384 + 2 * lane) = 0u;
            const float pos = (float)posv[i];
            const float ang = pos * inv_freq;
            const float rev = ang * 0.15915494309189535f;
            const float fr_ = rev - floorf(rev);
            const float sn = __builtin_amdgcn_sinf(fr_), cs = __builtin_amdgcn_cosf(fr_);
            const float kn = krv * rr * gkr;
            const float other = __shfl_xor(kn, 16);
            const float ro = (lane & 16) ? (kn * cs + other * sn) : (kn * cs - other * sn);
            if (lane < 32) {
                const bf16_t rb = (bf16_t)(cvt_pk_bf16(ro, 0.f) & 0xffffu);
#pragma unroll
                for (int h = 0; h < NH; ++h) Kb[((size_t)(b * NH + h) * SEQ + s) * DK + 64 + lane] = rb;
            }
            if (lane < 16) { COS[(size_t)t * 16 + lane] = cs; SIN[(size_t)t * 16 + lane] = sn; }
        }
    }
}

#define EPI_FENCE() asm volatile("" ::: "memory")
struct EpiQ {
    static constexpr bool PERM = true;
    __device__ __forceinline__ void init(f32x4 (&acc)[2][2][4][2], const Unit&, int, int) const {
#pragma unroll
        for (int a = 0; a < 2; ++a)
#pragma unroll
            for (int b = 0; b < 2; ++b)
#pragma unroll
                for (int m = 0; m < 4; ++m)
#pragma unroll
                    for (int n = 0; n < 2; ++n) acc[a][b][m][n] = (f32x4){0.f, 0.f, 0.f, 0.f};
    }
    bf16_t* Q; float* SSQ; const float* COS; const float* SIN; const float* gq;
    __device__ __forceinline__ void operator()(const f32x4 (&acc)[2][2][4][2], const Unit& u, int wr, int wc, int fr, int fq) const {
        const int t0 = u.pm * 256 + wr * 64 + fr, b = (u.pm * 256) / SEQ, s0 = t0 - b * SEQ;
        if (u.pn < 2) {
            const int h = 4 * u.pn + wc;
            bf16_t* dst0 = Q + ((size_t)(b * NH + h) * SEQ + s0) * DK + 8 * fq;
            float* ssq0 = SSQ + ((size_t)t0 * NH + h) * 2;
            f32x4 gqv[2][2];
#pragma unroll
            for (int bj = 0; bj < 2; ++bj) { gqv[bj][0] = *(const f32x4*)(gq + 32 * bj + 8 * fq); gqv[bj][1] = *(const f32x4*)(gq + 32 * bj + 8 * fq + 4); }
#pragma unroll
            for (int ai = 0; ai < 2; ++ai)
#pragma unroll
                for (int m = 0; m < 4; ++m) {
                    const int dr = ai * 128 + m * 16;
                    float q = 0.f;
#pragma unroll
                    for (int bj = 0; bj < 2; ++bj)
#pragma unroll
                        for (int n = 0; n < 2; ++n) { const f32x4 v = acc[ai][bj][m][n]; q += (v[0] * v[0] + v[1] * v[1]) + (v[2] * v[2] + v[3] * v[3]); }
                    q += __shfl_xor(q, 16); q += __shfl_xor(q, 32);
                    if (fq == 0) ssq0[dr * NH * 2] = q;
#pragma unroll
                    for (int bj = 0; bj < 2; ++bj) { const f32x4 v0 = acc[ai][bj][m][0] * gqv[bj][0], v1 = acc[ai][bj][m][1] * gqv[bj][1];
                        u32x4 w; w.x = cvt_pk_bf16(v0[0], v0[1]); w.y = cvt_pk_bf16(v0[2], v0[3]); w.z = cvt_pk_bf16(v1[0], v1[1]); w.w = cvt_pk_bf16(v1[2], v1[3]);
                        *(u32x4*)(dst0 + dr * DK + 32 * bj) = w; }
                    EPI_FENCE();
                }
        } else {
            const f32x4 g1 = *(const f32x4*)(gq + 64 + 4 * fq), g2 = *(const f32x4*)(gq + 80 + 4 * fq);
            const float* cs0 = COS + (size_t)t0 * 16 + 4 * fq; const float* sn0 = SIN + (size_t)t0 * 16 + 4 * fq;
            bf16_t* dst0 = Q + ((size_t)(b * NH + 2 * wc) * SEQ + s0) * DK + 64 + 4 * fq;
            float* ssq0 = SSQ + ((size_t)t0 * NH + 2 * wc) * 2 + 1;
            f32x4 csb[3][2];
#define EQ_LD(g) do { const int d_ = ((g) >> 2) * 128 + ((g) & 3) * 16; csb[(g) % 3][0] = *(const f32x4*)(cs0 + d_ * 16); csb[(g) % 3][1] = *(const f32x4*)(sn0 + d_ * 16); } while (0)
            EQ_LD(0); EQ_LD(1); EQ_LD(2);
#pragma unroll
            for (int g = 0; g < 8; ++g) { const int ai = g >> 2, m = g & 3; {
                    const int dr = ai * 128 + m * 16;
                    __builtin_amdgcn_sched_barrier(0);
                    const f32x4 cs = csb[g % 3][0], sn = csb[g % 3][1];
#pragma unroll
                    for (int bj = 0; bj < 2; ++bj) {
                        const f32x4 x1 = acc[ai][bj][m][0], x2 = acc[ai][bj][m][1];
                        float q = (x1[0] * x1[0] + x1[1] * x1[1]) + (x1[2] * x1[2] + x1[3] * x1[3]) + (x2[0] * x2[0] + x2[1] * x2[1]) + (x2[2] * x2[2] + x2[3] * x2[3]);
                        q += __shfl_xor(q, 16); q += __shfl_xor(q, 32);
                        if (fq == 0) ssq0[dr * NH * 2 + bj * 2] = q;
                        const f32x4 y1 = x1 * g1, y2 = x2 * g2;
                        const f32x4 o1 = y1 * cs - y2 * sn, o2 = y2 * cs + y1 * sn;
                        bf16_t* dst = dst0 + (size_t)bj * SEQ * DK + dr * DK;
                        u32x2 w1, w2; w1.x = cvt_pk_bf16(o1[0], o1[1]); w1.y = cvt_pk_bf16(o1[2], o1[3]); w2.x = cvt_pk_bf16(o2[0], o2[1]); w2.y = cvt_pk_bf16(o2[2], o2[3]);
                        *(u32x2*)(dst) = w1; *(u32x2*)(dst + 16) = w2;
                    }
                    __builtin_amdgcn_sched_barrier(0);
                    if (g + 3 < 8) EQ_LD(g + 3);
                } }
#undef EQ_LD
        }
    }
};
struct EpiKV {
    static constexpr bool PERM = true;
    __device__ __forceinline__ void init(f32x4 (&acc)[2][2][4][2], const Unit&, int, int) const {
#pragma unroll
        for (int a = 0; a < 2; ++a)
#pragma unroll
            for (int b = 0; b < 2; ++b)
#pragma unroll
                for (int m = 0; m < 4; ++m)
#pragma unroll
                    for (int n = 0; n < 2; ++n) acc[a][b][m][n] = (f32x4){0.f, 0.f, 0.f, 0.f};
    }
    bf16_t* K; bf16_t* V; const float* gk;
    __device__ __forceinline__ void operator()(const f32x4 (&acc)[2][2][4][2], const Unit& u, int wr, int wc, int fr, int fq) const {
        const int t0 = u.pm * 256 + wr * 64 + fr, b = (u.pm * 256) / SEQ, s0 = t0 - b * SEQ;
        const int h = 2 * u.pn + (wc & 1); const bool isv = wc >= 2;
        const int pitch = isv ? DV : DK;
        bf16_t* dst0 = (isv ? V : K) + ((size_t)(b * NH + h) * SEQ + s0) * pitch + 8 * fq;
        f32x4 gkv[2][2];
#pragma unroll
        for (int bj = 0; bj < 2; ++bj) { gkv[bj][0] = *(const f32x4*)(gk + 32 * bj + 8 * fq); gkv[bj][1] = *(const f32x4*)(gk + 32 * bj + 8 * fq + 4); }
#pragma unroll
        for (int ai = 0; ai < 2; ++ai)
#pragma unroll
            for (int m = 0; m < 4; ++m) {
                const int dr = ai * 128 + m * 16;
                float sc = 1.f;
                if (!isv) { float q = 0.f;
#pragma unroll
                    for (int bj = 0; bj < 2; ++bj)
#pragma unroll
                        for (int n = 0; n < 2; ++n) { const f32x4 v = acc[ai][bj][m][n]; q += (v[0] * v[0] + v[1] * v[1]) + (v[2] * v[2] + v[3] * v[3]); }
                    q += __shfl_xor(q, 16); q += __shfl_xor(q, 32);
                    sc = 1.0f / sqrtf(q * (1.f / 64.f) + EPS); }
#pragma unroll
                for (int bj = 0; bj < 2; ++bj) {
                    f32x4 v0 = acc[ai][bj][m][0] * sc, v1 = acc[ai][bj][m][1] * sc;
                    if (!isv) { v0 = v0 * gkv[bj][0]; v1 = v1 * gkv[bj][1]; }
                    u32x4 w; w.x = cvt_pk_bf16(v0[0], v0[1]); w.y = cvt_pk_bf16(v0[2], v0[3]); w.z = cvt_pk_bf16(v1[0], v1[1]); w.w = cvt_pk_bf16(v1[2], v1[3]);
                    *(u32x4*)(dst0 + dr * pitch + 32 * bj) = w; }
                EPI_FENCE();
            }
    }
};

namespace att {
constexpr int KT_BYTES = 64 * 192, VT_BYTES = 64 * 128, SLOT_BYTES = KT_BYTES + VT_BYTES;
#ifndef ATT_PF
#define ATT_PF 3
#endif
constexpr int NSLOT = ATT_PF + 1, SCR_OFF = NSLOT * SLOT_BYTES;
__device__ __forceinline__ int crow(int r, int hi) { return (r & 3) + 8 * (r >> 2) + 4 * hi; }
__device__ __forceinline__ s16x4 vtr(const LAS unsigned char* p) { typedef short v4i16_t __attribute__((ext_vector_type(4)));
    return __builtin_bit_cast(s16x4, __builtin_amdgcn_ds_read_tr16_b64_v4i16((LAS v4i16_t*)p)); }
#define MFMA32(a, b, c) __builtin_amdgcn_mfma_f32_32x32x16_bf16(a, b, c, 0, 0, 0)
__device__ __forceinline__ float max3f(float a, float b, float c) { return __builtin_fmaxf(__builtin_fmaxf(a, b), c); }


constexpr int CONV_OFF = SCR_OFF + 8 * 256, CONV_BYTES = 8192;
constexpr int CV_GU_ITEMS = NEXP * 1024, CV_ITEMS = CV_GU_ITEMS + NEXP * 512;
struct ConvItem { const float* src; unsigned char* dst; int N, isgu, n0; };
__device__ __forceinline__ ConvItem cv_setup(int g, const float* wgu, const float* wd, unsigned char* wgu8, unsigned char* wd8) {
    ConvItem I;
    if (g < CV_GU_ITEMS) { const int e = g >> 10, it = g & 1023, kb = it >> 6, nb = it & 63; I.N = 2048; I.isgu = 1; I.n0 = 32 * nb;
        I.src = wgu + (size_t)e * 1024 * 2048 + (size_t)(64 * kb) * 2048 + 32 * nb; I.dst = wgu8 + (size_t)e * 2048 * 1024 + 64 * kb; }
    else { const int g2 = g - CV_GU_ITEMS, e = g2 >> 9, it = g2 & 511, kb = it >> 5, nb = it & 31; I.N = 1024; I.isgu = 0; I.n0 = 32 * nb;
        I.src = wd + (size_t)e * 1024 * 1024 + (size_t)(64 * kb) * 1024 + 32 * nb; I.dst = wd8 + (size_t)e * 1024 * 1024 + 64 * kb; }
    return I;
}
__device__ __forceinline__ void cv_dma(const ConvItem& I, unsigned ldsaddr, int lane) {
    const int kr = lane >> 3, sl = lane & 7;
#pragma unroll
    for (int q = 0; q < 8; ++q) { const unsigned voff = (unsigned)(((8 * q + kr) * I.N + 4 * (sl ^ ((kr ^ q) & 7))) * 4);
        asm volatile("s_nop 4\n\ts_mov_b32 m0, %0\n\ts_nop 0\n\tglobal_load_lds_dwordx4 %1, %2" :: "s"(ldsaddr + (unsigned)q * 1024u), "v"(voff), "s"(I.src) : "m0", "memory"); }
}
__device__ __forceinline__ void cv_out(const ConvItem& I, const LAS float* cb, int lane) {
    asm volatile("" : "+v"(lane));
    const int c = lane & 7;
#pragma unroll
    for (int j = 0; j < 4; ++j) { const int n = (lane >> 3) + 8 * j, nc = n >> 2, e = n & 3;
        float f[8];
#pragma unroll
        for (int kk = 0; kk < 8; ++kk) f[kk] = cb[(8 * c + kk) * 32 + ((nc ^ kk ^ c) & 7) * 4 + e];
        const int nn = I.n0 + n; const int row = I.isgu ? (256 * ((nn & 1023) >> 7) + 128 * (nn >> 10) + (nn & 127)) : nn;
        *(u32x2*)(I.dst + (size_t)row * 1024 + 8 * c) = cvt8_fp8((f32x4){f[0], f[1], f[2], f[3]}, (f32x4){f[4], f[5], f[6], f[7]}, 8.0f);
        asm volatile("" ::: "memory"); }
}
struct ConvState { int next, end, cur; };
__device__ __forceinline__ void attn_unit(LAS unsigned char* lds, const u32x4 srd, ConvState& CV, unsigned char* cvws, int bh, int qb, const bf16_t* Q_, unsigned Koff, unsigned Voff, const float* SSQ_, bf16_t* O_, const bool fast) {
    (void)Q_; (void)SSQ_; (void)O_;
    unsigned char* wl_ = cvws; asm volatile("" : "+s"(wl_));
    const bf16_t* Q = (const bf16_t*)(wl_ + WS_Q); const float* SSQ = (const float*)(wl_ + WS_SSQ); bf16_t* O = (bf16_t*)(wl_ + WS_ATT);
    const int tid = tid_local(), lane = tid & 63, r32 = lane & 31, hi = lane >> 5; const int wid = __builtin_amdgcn_readfirstlane(tid >> 6);
    const int b = bh / NH, h = bh % NH, q0 = qb * 256, qw = q0 + 32 * wid;
    LAS float* scr = (LAS float*)(lds + SCR_OFF) + wid * 64;
    const int NT = (q0 + 256) / 64;
    const unsigned kS = Koff + (unsigned)bh * (SEQ * DK * 2), vS = Voff + (unsigned)bh * (SEQ * DV * 2);
    const int kc2 = 8 + (wid & 3);
    const unsigned vK1 = (unsigned)(lane * 192 + wid * 16); const unsigned sK2 = (unsigned)((kc2 - wid) * 16);
    const int vkey = 8 * wid + (lane >> 3); const unsigned vV = (unsigned)(vkey * 128 + (((lane & 7) ^ (((vkey >> 1) & 1) * 4)) * 16));
    const unsigned lds0 = (unsigned)__builtin_amdgcn_readfirstlane((int)(unsigned)(unsigned long)lds);
    const unsigned dK1 = (unsigned)wid * 1024u, dK2 = (unsigned)kc2 * 1024u, dV = (unsigned)KT_BYTES + (unsigned)wid * 1024u;
#define ATT_DMA1(ldsaddr, voff, soff) asm volatile("s_nop 4\n\ts_mov_b32 m0, %0\n\ts_nop 0\n\tbuffer_load_dwordx4 %1, %2, %3 offen lds" :: "s"(ldsaddr), "v"(voff), "s"(srd), "s"(soff) : "m0", "memory")
#define ATT_DMA(t) do { const unsigned sp_ = lds0 + (unsigned)((t) % NSLOT) * SLOT_BYTES; const unsigned ks_ = kS + (unsigned)(t) * (64 * 192), vs_ = vS + (unsigned)(t) * (64 * 128); \
        ATT_DMA1(sp_ + dK1, vK1, ks_); ATT_DMA1(sp_ + dK2, vK1, ks_ + sK2); ATT_DMA1(sp_ + dV, vV, vs_); } while (0)
#define ATT_WAITBAR(N) asm volatile("s_waitcnt vmcnt(" #N ") lgkmcnt(0)\n\ts_barrier" ::: "memory")
    bf16x8 qr[6];
    { const float* sp = SSQ + ((size_t)(b * SEQ + qw + r32) * NH + h) * 2; const float ss = sp[0] + sp[1];
      const float cq = (1.0f / sqrtf(ss * (1.f / 96.f) + EPS)) * 0.10206207261596577f * 1.4426950408889634f;
      const bf16_t* qp = Q + ((size_t)bh * SEQ + qw + r32) * DK + 8 * hi;
      u32x4 qw_[6];
#pragma unroll
      for (int d0 = 0; d0 < 6; ++d0) qw_[d0] = *(const u32x4*)(qp + 16 * d0);
#pragma unroll
      for (int d0 = 0; d0 < 6; ++d0) { const u32x4 w = qw_[d0]; u32x4 o;
          o.x = cvt_pk_bf16(bf_lo(w.x) * cq, bf_hi(w.x) * cq); o.y = cvt_pk_bf16(bf_lo(w.y) * cq, bf_hi(w.y) * cq); o.z = cvt_pk_bf16(bf_lo(w.z) * cq, bf_hi(w.z) * cq); o.w = cvt_pk_bf16(bf_lo(w.w) * cq, bf_hi(w.w) * cq);
          qr[d0] = __builtin_bit_cast(bf16x8, o); } }
    ATT_DMA(0); ATT_DMA(1); ATT_DMA(2); if (ATT_PF == 4) ATT_DMA(3);
    const int kbase = hi * 1024 + r32 * 16;
    const int qq = (lane & 15) >> 2, pp = lane & 3, dblk = (lane >> 4) & 1, swz = ((qq >> 1) & 1) * 64;
    const int vrow0 = 4 * hi + qq;
    const int vb0 = KT_BYTES + vrow0 * 128 + ((32 * dblk + 8 * pp) ^ swz);
    const int vb1 = KT_BYTES + vrow0 * 128 + ((64 + 32 * dblk + 8 * pp) ^ swz);
    f32x16 o0 = {}, o1 = {};
    float m_run = -1e30f, l_run = 0.f; const f32x16 zero16 = {};
    const int qa = qw + r32;
#define ATT_QK(N0, N1, t) do { const LAS unsigned char* kp_ = lds + ((t) % NSLOT) * SLOT_BYTES + kbase; \
        _Pragma("unroll") for (int d0 = 0; d0 < 6; ++d0) { const bf16x8 ka_ = *(const LAS bf16x8*)(kp_ + d0 * 2048), kb_ = *(const LAS bf16x8*)(kp_ + d0 * 2048 + 512); \
            if (d0 == 0) { N0 = MFMA32(ka_, qr[0], zero16); N1 = MFMA32(kb_, qr[0], zero16); } else { N0 = MFMA32(ka_, qr[d0], N0); N1 = MFMA32(kb_, qr[d0], N1); } } } while (0)
#define ATT_MASK(N0, N1, t) do { const int kb_ = 64 * (t); if (kb_ + 63 > qw) { int d_ = qa - kb_ - 4 * hi; asm volatile("" : "+v"(d_));        \
        _Pragma("unroll") for (int r = 0; r < 16; ++r) { const int c_ = (r & 3) + 8 * (r >> 2); \
        if (c_ > d_) N0[r] = -__builtin_inff(); if (c_ + 32 > d_) N1[r] = -__builtin_inff(); } } } while (0)
#define ATT_ROWMAX(N0, N1, PM) do { float a_ = max3f(N0[0], N0[1], N1[0]), b_ = max3f(N0[2], N0[3], N1[1]); a_ = max3f(a_, N1[2], N1[3]); \
        _Pragma("unroll") for (int r = 4; r < 16; r += 4) { a_ = max3f(a_, N0[r], N0[r + 1]); b_ = max3f(b_, N0[r + 2], N0[r + 3]); a_ = max3f(a_, N1[r], N1[r + 1]); b_ = max3f(b_, N1[r + 2], N1[r + 3]); } \
        a_ = max3f(a_, b_, b_); auto rr_ = __builtin_amdgcn_permlane32_swap(__float_as_uint(a_), __float_as_uint(a_), false, false); \
        PM = max3f(__uint_as_float(rr_[0]), __uint_as_float(rr_[1]), __uint_as_float(rr_[1])); } while (0)
#define ATT_DECIDE(PM, C0, C1, FORCE) do { if ((FORCE) || __any((PM) > m_run + 8.0f)) { const float mn_ = fmaxf(m_run, (PM)); const float al_ = __builtin_amdgcn_exp2f(m_run - mn_); m_run = mn_; l_run *= al_; \
        if (hi == 0) scr[r32] = al_; asm volatile("s_waitcnt lgkmcnt(0)" ::: "memory"); \
        _Pragma("unroll") for (int a4 = 0; a4 < 4; ++a4) { const f32x4 f_ = *(const LAS f32x4*)(scr + 8 * a4 + 4 * hi); \
            _Pragma("unroll") for (int e = 0; e < 4; ++e) { o0[4 * a4 + e] *= f_[e]; o1[4 * a4 + e] *= f_[e]; } } } } while (0)
#define ATT_SM_HALF(P_, ks0, SUBM) do { _Pragma("unroll") for (int r = 0; r < 16; ++r) { P_[r] = __builtin_amdgcn_exp2f((SUBM) ? P_[r] - m_run : P_[r]); ps_ += P_[r]; } \
        _Pragma("unroll") for (int kq = 0; kq < 2; ++kq) { const int bs_ = 8 * kq; \
            u32x4 w_; w_.x = cvt_pk_bf16(P_[bs_ + 0], P_[bs_ + 1]); w_.y = cvt_pk_bf16(P_[bs_ + 2], P_[bs_ + 3]); w_.z = cvt_pk_bf16(P_[bs_ + 4], P_[bs_ + 5]); w_.w = cvt_pk_bf16(P_[bs_ + 6], P_[bs_ + 7]); \
            pa[(ks0) + kq] = __builtin_bit_cast(bf16x8, w_); } } while (0)
#define ATT_SOFTMAX(C0, C1) do { float ps_ = 0.f; ATT_SM_HALF(C0, 0, true); ATT_SM_HALF(C1, 2, true); l_run += ps_; } while (0)
#define ATT_SOFTMAX_F(C0, C1) do { float ps_ = 0.f; ATT_SM_HALF(C0, 0, false); ATT_SM_HALF(C1, 2, false); l_run += ps_; } while (0)
#define ATT_PV(t) do { const LAS unsigned char* vp0_ = lds + ((t) % NSLOT) * SLOT_BYTES + vb0; const LAS unsigned char* vp1_ = lds + ((t) % NSLOT) * SLOT_BYTES + vb1; \
        _Pragma("unroll") for (int ks = 0; ks < 4; ++ks) { \
            const s16x4 a0_ = vtr(vp0_ + ks * 16 * 128), a1_ = vtr(vp0_ + ks * 16 * 128 + 8 * 128), c0_ = vtr(vp1_ + ks * 16 * 128), c1_ = vtr(vp1_ + ks * 16 * 128 + 8 * 128); \
            const bf16x8 vf0_ = {a0_[0], a0_[1], a0_[2], a0_[3], a1_[0], a1_[1], a1_[2], a1_[3]}; const bf16x8 vf1_ = {c0_[0], c0_[1], c0_[2], c0_[3], c1_[0], c1_[1], c1_[2], c1_[3]}; \
            o0 = MFMA32(pa[ks], vf0_, o0); o1 = MFMA32(pa[ks], vf1_, o1); } } while (0)
#ifdef ATT_PROBE2
    unsigned long long ap_s[4] = {0, 0, 0, 0}, ap_acc[3] = {0, 0, 0};
#define AP_STAMP(k) do { __builtin_amdgcn_sched_barrier(0); asm volatile("s_memtime %0\n\ts_waitcnt lgkmcnt(0)" : "=s"(ap_s[k]) :: "memory"); __builtin_amdgcn_sched_barrier(0); if ((k) > 0) ap_acc[(k) - 1] += ap_s[k] - ap_s[(k) - 1]; } while (0)
#else
#define AP_STAMP(k) do {} while (0)
#endif
#define ATT_WB(N) asm volatile("s_waitcnt vmcnt(" #N ") lgkmcnt(0)\n\ts_barrier" ::: "memory")
#define ATT_RDK(d0) do { kf_[d0][0] = *(const LAS bf16x8*)(kp_ + (d0) * 2048); kf_[d0][1] = *(const LAS bf16x8*)(kp_ + (d0) * 2048 + 512); } while (0)
#define ATT_RDV(ks) do { vf_[ks][0] = vtr(vp0_ + (ks) * 16 * 128); vf_[ks][1] = vtr(vp0_ + (ks) * 16 * 128 + 8 * 128); vf_[ks][2] = vtr(vp1_ + (ks) * 16 * 128); vf_[ks][3] = vtr(vp1_ + (ks) * 16 * 128 + 8 * 128); } while (0)
#define ATT_MK(d0) do { if ((d0) == 0) { S0 = MFMA32(kf_[0][0], qr[0], zero16); S1 = MFMA32(kf_[0][1], qr[0], zero16); } else { S0 = MFMA32(kf_[d0][0], qr[d0], S0); S1 = MFMA32(kf_[d0][1], qr[d0], S1); } } while (0)
#define ATT_MV(ks) do { const bf16x8 v0_ = {vf_[ks][0][0], vf_[ks][0][1], vf_[ks][0][2], vf_[ks][0][3], vf_[ks][1][0], vf_[ks][1][1], vf_[ks][1][2], vf_[ks][1][3]}; \
        const bf16x8 v1_ = {vf_[ks][2][0], vf_[ks][2][1], vf_[ks][2][2], vf_[ks][2][3], vf_[ks][3][0], vf_[ks][3][1], vf_[ks][3][2], vf_[ks][3][3]}; \
        o0 = MFMA32(pa[ks], v0_, o0); o1 = MFMA32(pa[ks], v1_, o1); } while (0)
#define ATT_SB __builtin_amdgcn_sched_barrier(0)
#define ATT_SEGA(j, DODMA) do { \
        const LAS unsigned char* kp_ = lds + (((j) + 1) % NSLOT) * SLOT_BYTES + kbase; \
        const LAS unsigned char* vp0_ = lds + ((j) % NSLOT) * SLOT_BYTES + vb0; const LAS unsigned char* vp1_ = lds + ((j) % NSLOT) * SLOT_BYTES + vb1; \
        bf16x8 kf_[6][2]; s16x4 vf_[4][4]; \
        ATT_RDK(0); ATT_RDK(1); ATT_RDV(0); ATT_SB; \
        if (DODMA) { ATT_DMA((j) + ATT_PF); } ATT_SB; \
        ATT_MK(0); ATT_SB; ATT_RDK(2); ATT_SB; ATT_MK(1); ATT_SB; ATT_RDK(3); ATT_SB; ATT_MV(0); ATT_SB; ATT_RDV(1); ATT_SB; \
        ATT_MK(2); ATT_SB; ATT_RDK(4); ATT_SB; ATT_MK(3); ATT_SB; ATT_RDV(2); ATT_SB; ATT_MV(1); ATT_SB; ATT_RDK(5); ATT_SB; \
        ATT_MK(4); ATT_SB; ATT_MV(2); ATT_SB; ATT_RDV(3); ATT_SB; ATT_MK(5); ATT_MV(3); } while (0)
#define ATT_BARP asm volatile("s_waitcnt lgkmcnt(0)\n\ts_barrier" ::: "memory")
#define ATT_STEP(j, MSK, CONV, FAST) do { \
        if (MSK) ATT_MASK(S0, S1, (j)); \
        if (!(FAST)) { float pm_; ATT_ROWMAX(S0, S1, pm_); ATT_DECIDE(pm_, S0, S1, false); } \
        if (FAST) ATT_SOFTMAX_F(S0, S1); else ATT_SOFTMAX(S0, S1); \
        int infl_ = 0; \
        if (CONV) { __builtin_amdgcn_sched_barrier(0); const LAS float* cb_ = (const LAS float*)(lds + CONV_OFF + wid * CONV_BYTES); \
            if (CV.cur >= 0) { const ConvItem I_ = cv_setup(CV.cur, kargs()->in[I_WGU], kargs()->in[I_WD], cvws + WS_WGU, cvws + WS_WD); cv_out(I_, cb_, lane); infl_ += 4; } \
            if (CV.next < CV.end) { const ConvItem I_ = cv_setup(CV.next, kargs()->in[I_WGU], kargs()->in[I_WD], cvws + WS_WGU, cvws + WS_WD); asm volatile("s_waitcnt lgkmcnt(0)" ::: "memory"); \
                cv_dma(I_, lds0 + (unsigned)(CONV_OFF + wid * CONV_BYTES), lane); CV.cur = CV.next; CV.next += 2048; infl_ += 8; } else CV.cur = -1; } \
        __builtin_amdgcn_sched_barrier(0); ATT_BARP; __builtin_amdgcn_sched_barrier(0); \
        ATT_SEGA((j), ((j) + ATT_PF < NT)); if ((j) + ATT_PF < NT) infl_ += 3; \
        __builtin_amdgcn_sched_barrier(0); \
        if (!(CONV)) { if (infl_ == 3) ATT_WB(3); else ATT_WB(0); } \
        else switch (infl_) { case 15: ATT_WB(15); break; case 12: ATT_WB(12); break; case 11: ATT_WB(11); break; case 8: ATT_WB(8); break; case 7: ATT_WB(7); break; case 4: ATT_WB(4); break; case 3: ATT_WB(3); break; default: ATT_WB(0); break; } \
        __builtin_amdgcn_sched_barrier(0); } while (0)
    bf16x8 pa[4];
    f32x16 S0, S1;
    const bool grpY = wid >= 4;
    ATT_WAITBAR(6);
    if (grpY) ATT_BARP;
    __builtin_amdgcn_sched_barrier(0);
    ATT_QK(S0, S1, 0);
    __builtin_amdgcn_sched_barrier(0);
    ATT_WAITBAR(3);
    __builtin_amdgcn_sched_barrier(0);
    int j = 0;
    if (fast) {
        for (; j < NT - 4; j += 2) {
            ATT_STEP(j, false, CONV_IN_ATTN, true);
            ATT_STEP(j + 1, false, false, true);
        }
        for (; j < NT; j += 2) {
            ATT_STEP(j, true, CONV_IN_ATTN, true);
            ATT_STEP(j + 1, true, false, true);
        }
    } else {
        for (; j < NT - 4; j += 2) {
            ATT_STEP(j, false, CONV_IN_ATTN, false);
            ATT_STEP(j + 1, false, false, false);
        }
        for (; j < NT; j += 2) {
            ATT_STEP(j, true, CONV_IN_ATTN, false);
            ATT_STEP(j + 1, true, false, false);
        }
    }
    if (!grpY) ATT_BARP;
    __builtin_amdgcn_sched_barrier(0);
#ifdef ATT_PROBE2
    if (blockIdx.x == 17 && tid == 0) { unsigned long long* ap2 = (unsigned long long*)(cvws + WS_CTL + 65536 + 128); ap2[0] += ap_acc[0]; ap2[1] += ap_acc[1]; ap2[2] += ap_acc[2]; ap2[3] += (unsigned long long)NT; }
#endif
#ifdef ATT_PROBE
    if (blockIdx.x == 17 && tid == 0) { unsigned long long* ap = (unsigned long long*)(cvws + WS_CTL + 65536 + 64); ap[0] += __builtin_amdgcn_s_memtime() - ap_t0; ap[1] += (unsigned long long)NT; }
#endif
#undef ATT_DMA
#undef ATT_DMA1
#undef ATT_WAITBAR
#undef ATT_QK
#undef ATT_MASK
#undef ATT_ROWMAX
#undef ATT_DECIDE
#undef ATT_SOFTMAX
#undef ATT_SOFTMAX_F
#undef ATT_SM_HALF
#undef ATT_PV
#undef ATT_STEP
#undef ATT_WB
#undef ATT_BARP
#undef ATT_SEGA
#undef ATT_RDK
#undef ATT_RDV
#undef ATT_MK
#undef ATT_MV
#undef ATT_SB
#undef AP_STAMP
    { auto rr = __builtin_amdgcn_permlane32_swap(__float_as_uint(l_run), __float_as_uint(l_run), false, false); l_run = __uint_as_float(rr[0]) + __uint_as_float(rr[1]); }
    if (hi == 0) scr[32 + r32] = 1.0f / l_run;
    asm volatile("s_waitcnt lgkmcnt(0)" ::: "memory");
    bf16_t* Ow = O + ((size_t)(b * SEQ + qw)) * 512 + h * 64 + r32;
#pragma unroll
    for (int a4 = 0; a4 < 4; ++a4) { const f32x4 f = *(const LAS f32x4*)(scr + 32 + 8 * a4 + 4 * hi);
#pragma unroll
        for (int e = 0; e < 4; ++e) { const int r = 4 * a4 + e; const int row = crow(r, hi);
            Ow[(size_t)row * 512] = (bf16_t)(cvt_pk_bf16(o0[r] * f[e], 0.f) & 0xffffu);
            Ow[(size_t)row * 512 + 32] = (bf16_t)(cvt_pk_bf16(o1[r] * f[e], 0.f) & 0xffffu); } }
    __syncthreads();
}
#undef MFMA32
}

struct MixOrder {
    int G, c; unsigned ATT, MIXED, WAO, WPO;
    __device__ __forceinline__ bool next(int i, Unit& u) const {
        const int tile = (i >> 1) * G + c; if (tile >= 256) return false;
        u.pm = tile >> 2; u.pn = tile & 3; u.aux = i & 1; return true;
    }
    __device__ __forceinline__ void prefetch(const Unit&, const __amdgpu_buffer_rsrc_t, LAS unsigned char*, int, int) const {}
    __device__ __forceinline__ unsigned a_off(const Unit& u) const { return (u.aux ? MIXED : ATT) + (unsigned)u.pm * (256 * 512 * 2); }
    __device__ __forceinline__ unsigned b_off(const Unit& u) const { return (u.aux ? WPO : WAO) + (unsigned)u.pn * (256 * 512 * 2); }
};
struct EpiMix {
    static constexpr bool PERM = true;
    __device__ __forceinline__ void init(f32x4 (&acc)[2][2][4][2], const Unit& u, int, int) const {
        if (u.aux) return;
#pragma unroll
        for (int a = 0; a < 2; ++a)
#pragma unroll
            for (int b = 0; b < 2; ++b)
#pragma unroll
                for (int m = 0; m < 4; ++m)
#pragma unroll
                    for (int n = 0; n < 2; ++n) acc[a][b][m][n] = (f32x4){0.f, 0.f, 0.f, 0.f};
    }
    bf16_t* MIX; const bf16_t* GATES;
    __device__ __forceinline__ void operator()(f32x4 (&acc)[2][2][4][2], const Unit& u, int wr, int wc, int fr, int fq) const {
        const int row0 = u.pm * 256 + wr * 64 + fr, col0 = u.pn * 256 + wc * 32 + 8 * fq;
        const bool p0_ = u.aux == 0;
#if GATE8 == 2
        typedef u32x2 gv_t; const unsigned char* gb_ = (const unsigned char*)GATES + (size_t)row0 * 2048 + col0;
#define EM_LD1(p) (*(const u32x2*)(p))
#define EM_DEC(GW_, lo, hi) do { const gv_t t_ = (GW_); lo = (f32x4){(float)((t_.x >> 0) & 0xffu), (float)((t_.x >> 8) & 0xffu), (float)((t_.x >> 16) & 0xffu), (float)((t_.x >> 24) & 0xffu)}; \
        hi = (f32x4){(float)((t_.y >> 0) & 0xffu), (float)((t_.y >> 8) & 0xffu), (float)((t_.y >> 16) & 0xffu), (float)((t_.y >> 24) & 0xffu)}; } while (0)
        constexpr size_t GROW = 2048, GHALF = 1024, GBJ = 128; constexpr float GSC = 1.0f / 255.0f;
#elif GATE8
        typedef u32x2 gv_t; const unsigned char* gb_ = (const unsigned char*)GATES + (size_t)row0 * 2048 + col0;
#define EM_LD1(p) (*(const u32x2*)(p))
#define EM_DEC(GW_, lo, hi) do { const gv_t t_ = (GW_); const f32x2 a_ = __builtin_amdgcn_cvt_pk_f32_fp8((int)t_.x, false), b_ = __builtin_amdgcn_cvt_pk_f32_fp8((int)t_.x, true), c_ = __builtin_amdgcn_cvt_pk_f32_fp8((int)t_.y, false), d_ = __builtin_amdgcn_cvt_pk_f32_fp8((int)t_.y, true); \
        lo = (f32x4){a_[0], a_[1], b_[0], b_[1]}; hi = (f32x4){c_[0], c_[1], d_[0], d_[1]}; } while (0)
        constexpr size_t GROW = 2048, GHALF = 1024, GBJ = 128; constexpr float GSC = 1.0f / 256.0f;
#else
        typedef u32x4 gv_t; const bf16_t* gb_ = GATES + (size_t)row0 * 2048 + col0;
#define EM_LD1(p) (*(const u32x4*)(p))
#define EM_DEC(GW_, lo, hi) do { const gv_t t_ = (GW_); lo = (f32x4){bf_lo(t_.x), bf_hi(t_.x), bf_lo(t_.y), bf_hi(t_.y)}; hi = (f32x4){bf_lo(t_.z), bf_hi(t_.z), bf_lo(t_.w), bf_hi(t_.w)}; } while (0)
        constexpr size_t GROW = 2048, GHALF = 1024, GBJ = 128; constexpr float GSC = 1.0f;
#endif
        gv_t buf[3][4];
#define EM_LD(g) do { const auto* p_ = gb_ + (size_t)(((g) >> 2) * 128 + ((g) & 3) * 16) * GROW; \
        _Pragma("unroll") for (int bj = 0; bj < 2; ++bj) { buf[(g) % 3][2 * bj] = EM_LD1(p_ + GHALF + bj * GBJ); if (p0_) buf[(g) % 3][2 * bj + 1] = EM_LD1(p_ + bj * GBJ); } } while (0)
        EM_LD(0); EM_LD(1); EM_LD(2);
#pragma unroll
        for (int g = 0; g < 8; ++g) { const int ai = g >> 2, m = g & 3; const size_t row = (size_t)(row0 + ai * 128 + m * 16);
            __builtin_amdgcn_sched_barrier(0);
#pragma unroll
            for (int bj = 0; bj < 2; ++bj) { f32x4 p0, p1; EM_DEC(buf[g % 3][2 * bj], p0, p1);
                if (p0_) { f32x4 a0, a1; EM_DEC(buf[g % 3][2 * bj + 1], a0, a1);
#pragma unroll
                    for (int e = 0; e < 4; ++e) { acc[ai][bj][m][0][e] *= a0[e] * __builtin_amdgcn_rcpf(p0[e]); acc[ai][bj][m][1][e] *= a1[e] * __builtin_amdgcn_rcpf(p1[e]); }
                } else {
                    const f32x4 v0 = acc[ai][bj][m][0] * (p0 * GSC), v1 = acc[ai][bj][m][1] * (p1 * GSC);
                    u32x4 w; w.x = cvt_pk_bf16(v0[0], v0[1]); w.y = cvt_pk_bf16(v0[2], v0[3]); w.z = cvt_pk_bf16(v1[0], v1[1]); w.w = cvt_pk_bf16(v1[2], v1[3]);
                    *(u32x4*)(MIX + row * 1024 + col0 + bj * 128) = w; } }
            __builtin_amdgcn_sched_barrier(0);
            if (g + 3 < 8) EM_LD(g + 3);
        }
#undef EM_LD
#undef EM_LD1
#undef EM_DEC
    }
};
struct EpiRes {
    static constexpr bool PERM = false;
    __device__ __forceinline__ void init(f32x4 (&acc)[2][2][4][2], const Unit&, int, int) const {
#pragma unroll
        for (int a = 0; a < 2; ++a)
#pragma unroll
            for (int b = 0; b < 2; ++b)
#pragma unroll
                for (int m = 0; m < 4; ++m)
#pragma unroll
                    for (int n = 0; n < 2; ++n) acc[a][b][m][n] = (f32x4){0.f, 0.f, 0.f, 0.f};
    }
    const float* base; bf16_t* out;
    __device__ __forceinline__ void operator()(const f32x4 (&acc)[2][2][4][2], const Unit& u, int wr, int wc, int fr, int fq) const {
        const int row0 = u.pm * 256 + wr * 64 + fr, col0 = u.pn * 256 + wc * 32 + 4 * fq;
        const size_t off0 = (size_t)row0 * DM + col0;
        f32x4 buf[3][4];
#define ER_LD(g) do { const float* p_ = base + off0 + (size_t)(((g) >> 2) * 128 + ((g) & 3) * 16) * DM; \
        _Pragma("unroll") for (int q = 0; q < 4; ++q) buf[(g) % 3][q] = *(const f32x4*)(p_ + (q >> 1) * 128 + (q & 1) * 16); } while (0)
        ER_LD(0); ER_LD(1); ER_LD(2);
#pragma unroll
        for (int g = 0; g < 8; ++g) { const int ai = g >> 2, m = g & 3;
            __builtin_amdgcn_sched_barrier(0);
            bf16_t* o_ = out + off0 + (size_t)(ai * 128 + m * 16) * DM;
#pragma unroll
            for (int q = 0; q < 4; ++q) { const f32x4 r = buf[g % 3][q] + acc[ai][q >> 1][m][q & 1]; u32x2 w; w.x = cvt_pk_bf16(r[0], r[1]); w.y = cvt_pk_bf16(r[2], r[3]); *(u32x2*)(o_ + (q >> 1) * 128 + (q & 1) * 16) = w; }
            __builtin_amdgcn_sched_barrier(0);
            if (g + 3 < 8) ER_LD(g + 3);
        }
#undef ER_LD
    }
};

constexpr int WR_PITCH = 1028;
constexpr int R_WR_OFF = 0, R_PART_OFF = 32 * WR_PITCH * 4, R_SSQ_OFF = R_PART_OFF + 2 * 64 * 33 * 4, R_CNT_OFF = R_SSQ_OFF + 2 * 64 * 4, R_BASE_OFF = R_CNT_OFF + 128, R_RSTD_OFF = R_BASE_OFF + 128, R_END = R_RSTD_OFF + 256;
static_assert(R_END <= TILE_E_OFF, "router LDS map");
__device__ __forceinline__ void p7_router(const Frame& F) {
    const int tid_l = tid_local(), lane_l = tid_l & 63; (void)tid_l; (void)lane_l;
    const KArgs a = kargs();
    LAS float* WR = (LAS float*)(F.lds + R_WR_OFF); LAS float* PART = (LAS float*)(F.lds + R_PART_OFF); LAS float* SSQP = (LAS float*)(F.lds + R_SSQ_OFF);
    LAS int* CNT = (LAS int*)(F.lds + R_CNT_OFF); LAS int* BASE = (LAS int*)(F.lds + R_BASE_OFF); LAS float* RSTD_L = (LAS float*)(F.lds + R_RSTD_OFF);
    const int tid = tid_l, lane = lane_l, wave = F.wave;
    const float* wr = a->in[I_WR]; const float* gf = a->in[I_GFFN];
    {
        const f32x4* wr4 = (const f32x4*)wr; f32x4 w[16]; float g[16];
#pragma unroll
        for (int q = 0; q < 16; ++q) { const int idx = tid + 512 * q; w[q] = wr4[idx]; g[q] = gf[idx >> 3]; }
#pragma unroll
        for (int q = 0; q < 16; ++q) { const int idx = tid + 512 * q; const int k = idx >> 3, e0 = (idx & 7) * 4;
#pragma unroll
            for (int j = 0; j < 4; ++j) WR[(e0 + j) * WR_PITCH + k] = w[q][j] * g[q]; }
    }
    if (tid < 32) CNT[tid] = 0;
    __syncthreads();
    int* RE = (int*)(F.ws + WS_ROUTE); int* RP = RE + T * 4; float* RG = (float*)(RP + T * 4); float* RS = RG + T * 4; int* TOK = (int*)(F.ws + WS_TOK); unsigned char* H8 = F.ws + WS_XS2;
    unsigned* gcnt = F.ctl + CW_CNT;
    const bf16_t* X1 = (const bf16_t*)(F.ws + WS_X1B);
    for (int blk = F.vcu; blk < T / 64; blk += F.G) {
        const int tb = blk * 64;
        {
            const int tg = wave & 3, kh = wave >> 2, r = lane & 15, kq = lane >> 4;
            const bf16_t* xp = X1 + (size_t)(tb + 16 * tg + r) * DM + 512 * kh + 4 * kq;
            const LAS float* w0 = WR + (lane & 15) * WR_PITCH + 512 * kh + 4 * kq; const LAS float* w1 = w0 + 16 * WR_PITCH;
            f32x4 acc0 = {0.f, 0.f, 0.f, 0.f}, acc1 = {0.f, 0.f, 0.f, 0.f}; float ss = 0.f;
#pragma unroll 4
            for (int i = 0; i < 32; ++i) {
                const u32x2 xw = *(const u32x2*)(xp + 16 * i); const f32x4 xv = {bf_lo(xw.x), bf_hi(xw.x), bf_lo(xw.y), bf_hi(xw.y)};
                const f32x4 b0 = *(const LAS f32x4*)(w0 + 16 * i), b1 = *(const LAS f32x4*)(w1 + 16 * i);
                ss += (xv[0] * xv[0] + xv[1] * xv[1]) + (xv[2] * xv[2] + xv[3] * xv[3]);
#pragma unroll
                for (int j = 0; j < 4; ++j) { acc0 = __builtin_amdgcn_mfma_f32_16x16x4f32(xv[j], b0[j], acc0, 0, 0, 0); acc1 = __builtin_amdgcn_mfma_f32_16x16x4f32(xv[j], b1[j], acc1, 0, 0, 0); }
            }
            ss += __shfl_xor(ss, 16); ss += __shfl_xor(ss, 32);
            if (kq == 0) SSQP[kh * 64 + 16 * tg + r] = ss;
#pragma unroll
            for (int q = 0; q < 4; ++q) { const int tok = 16 * tg + 4 * kq + q; PART[(kh * 64 + tok) * 33 + (lane & 15)] = acc0[q]; PART[(kh * 64 + tok) * 33 + 16 + (lane & 15)] = acc1[q]; }
        }
        __syncthreads();
        int te[4] = {0, 0, 0, 0}, lp[4] = {0, 0, 0, 0}; float tv[4] = {-3e38f, -3e38f, -3e38f, -3e38f}; float rstd = 0.f;
        if (tid < 64) {
            const float ssq = SSQP[tid] + SSQP[64 + tid]; rstd = 1.0f / sqrtf(ssq * (1.f / DM) + EPS);
            const float* br = a->in[I_BR];
#pragma unroll
            for (int e = 0; e < 32; ++e) {
                float v = (PART[tid * 33 + e] + PART[(64 + tid) * 33 + e]) * rstd + br[e]; int id = e;
#pragma unroll
                for (int s = 0; s < 4; ++s) { const bool gt = v > tv[s]; const float ov = tv[s]; const int oi = te[s]; tv[s] = gt ? v : ov; te[s] = gt ? id : oi; v = gt ? ov : v; id = gt ? oi : id; }
            }
#pragma unroll
            for (int s = 0; s < 4; ++s) lp[s] = __hip_atomic_fetch_add(&CNT[te[s]], 1, __ATOMIC_RELAXED, __HIP_MEMORY_SCOPE_WORKGROUP);
        }
        __syncthreads();
        if (tid < 32) { const int c = CNT[tid]; BASE[tid] = c ? (int)atomicAdd(gcnt + tid, (unsigned)c) : 0; }
        __syncthreads();
        if (tid < 64) {
            const int t = tb + tid;
            const float e1 = __expf(tv[1] - tv[0]), e2 = __expf(tv[2] - tv[0]), e3 = __expf(tv[3] - tv[0]); const float inv = 1.0f / (1.0f + e1 + e2 + e3);
            const float gts[4] = {inv, e1 * inv, e2 * inv, e3 * inv};
#pragma unroll
            for (int s = 0; s < 4; ++s) { const int p = BASE[te[s]] + lp[s]; RE[t * 4 + s] = te[s]; RP[t * 4 + s] = p; RG[t * 4 + s] = gts[s]; TOK[te[s] * 16384 + p] = t; }
            RS[t] = rstd; RSTD_L[tid] = rstd;
        }
        __syncthreads();
        if (tid < 32) CNT[tid] = 0;
        {
            f32x4 g[2][2];
#pragma unroll
            for (int j = 0; j < 2; ++j) { g[j][0] = *(const f32x4*)(gf + 512 * j + 8 * lane); g[j][1] = *(const f32x4*)(gf + 512 * j + 8 * lane + 4); }
#pragma unroll 4
            for (int i = 0; i < 8; ++i) {
                const int t = tb + 8 * wave + i; const float rs = RSTD_L[8 * wave + i];
#pragma unroll
                for (int j = 0; j < 2; ++j) { const u32x4 xw = *(const u32x4*)(X1 + (size_t)t * DM + 512 * j + 8 * lane);
                    const f32x4 v0 = (f32x4){bf_lo(xw.x), bf_hi(xw.x), bf_lo(xw.y), bf_hi(xw.y)} * g[j][0] * rs, v1 = (f32x4){bf_lo(xw.z), bf_hi(xw.z), bf_lo(xw.w), bf_hi(xw.w)} * g[j][1] * rs;
                    *(u32x2*)(H8 + (size_t)t * DM + 512 * j + 8 * lane) = cvt8_fp8(v0, v1, 8.0f); }
            }
        }
        __syncthreads();
    }
}

__device__ __forceinline__ int build_tiles(const Frame& F) {
    const int tid_l = tid_local(), lane_l = tid_l & 63; (void)tid_l; (void)lane_l;
    LAS int* TB = (LAS int*)(F.lds + TILE_E_OFF); LAS int* TE = TB + 64;
    if (tid_l < 64) {
        const int c = (tid_l < NEXP) ? (int)__hip_atomic_load(F.ctl + CW_CNT + tid_l, RLX_AGENT) : 0; const int nt = (c + 255) >> 8;
        int incl = nt;
#pragma unroll
        for (int o = 1; o < 32; o <<= 1) { const int v = __shfl_up(incl, o); if (lane_l >= o) incl += v; }
        if (tid_l < NEXP) TB[tid_l] = incl - nt;
        if (tid_l == NEXP - 1) TB[NEXP] = incl;
    }
    __syncthreads();
    if (tid_l < NEXP) { for (int t = TB[tid_l]; t < TB[tid_l + 1]; ++t) TE[t] = tid_l; }
    __syncthreads();
    return TB[NEXP];
}

__device__ __forceinline__ void p8_dispatch(const Frame& F) {
    const int tid_l = tid_local(), lane_l = tid_l & 63; (void)tid_l; (void)lane_l;
    const KArgs a = kargs();
    (void)build_tiles(F);
    const LAS int* TB = (const LAS int*)(F.lds + TILE_E_OFF);
    const int gw = F.vcu * NWAVES + F.wave, NGW = F.G * NWAVES, lane = lane_l;
    const int* RE = (const int*)(F.ws + WS_ROUTE); const int* RP = RE + T * 4; const float* RS = (const float*)(RP + T * 4) + T * 4; int* SL = (int*)(RS + T);
    const bf16_t* X1 = (const bf16_t*)(F.ws + WS_X1B); const float* gf = a->in[I_GFFN]; unsigned char* XS = F.ws + WS_XS2;
    f32x4 g[2][2];
#pragma unroll
    for (int j = 0; j < 2; ++j) { g[j][0] = *(const f32x4*)(gf + 512 * j + 8 * lane); g[j][1] = *(const f32x4*)(gf + 512 * j + 8 * lane + 4); }
    for (int t = gw; t < T; t += NGW) {
        const float rstd = RS[t];
        u32x2 w[2];
#pragma unroll
        for (int j = 0; j < 2; ++j) { const u32x4 xw = *(const u32x4*)(X1 + (size_t)t * DM + 512 * j + 8 * lane);
            const f32x4 v0 = (f32x4){bf_lo(xw.x), bf_hi(xw.x), bf_lo(xw.y), bf_hi(xw.y)} * g[j][0] * rstd, v1 = (f32x4){bf_lo(xw.z), bf_hi(xw.z), bf_lo(xw.w), bf_hi(xw.w)} * g[j][1] * rstd;
            w[j] = cvt8_fp8(v0, v1, 8.0f); }
#pragma unroll
        for (int s = 0; s < 4; ++s) { const int e = RE[t * 4 + s], slot = TB[e] * 256 + RP[t * 4 + s];
            if (lane == 0) SL[t * 4 + s] = slot;
            unsigned char* dst = XS + (size_t)slot * DM + 8 * lane;
            *(u32x2*)dst = w[0]; *(u32x2*)(dst + 512) = w[1]; }
    }
}

template <bool GATHER_A> struct MoeOrderT {
    int G, c, ntn_shift, total; const LAS int* TE; unsigned A, Bw, bexp, btile; int xbase, xcount;
    __device__ __forceinline__ void init_xcd(const LAS int* TB) {
        if (G == 256) { const int x = c >> 5; xbase = __builtin_amdgcn_readfirstlane(TB[4 * x]); xcount = (__builtin_amdgcn_readfirstlane(TB[4 * x + 4]) - xbase) << ntn_shift; } else { xbase = -1; xcount = 0; }
    }
    __device__ __forceinline__ bool next(int i, Unit& u) const {
        if (xbase >= 0) { const int L = i * 32 + (c & 31); if (L >= xcount) return false;
            u.pm = xbase + (L >> ntn_shift); u.pn = L & ((1 << ntn_shift) - 1); u.aux = __builtin_amdgcn_readfirstlane(TE[u.pm]); return true; }
        const int L = i * G + c; if (L >= total) return false;
        u.pm = L >> ntn_shift; u.pn = L & ((1 << ntn_shift) - 1); u.aux = __builtin_amdgcn_readfirstlane(TE[u.pm]); return true;
    }
#ifndef MOE_PREFETCH
#define MOE_PREFETCH 0
#endif
    __device__ __forceinline__ void prefetch(const Unit& u, const __amdgpu_buffer_rsrc_t rsrc, LAS unsigned char* lds, int wid, int lane) const {
        if (!MOE_PREFETCH) return;
        const unsigned ln_ = (unsigned)(tid_local() & 63);
        const unsigned line = (unsigned)(u.pn & 3) * 512u + (unsigned)wid * 64u + ln_;
        const unsigned voff = (line >> 3) * 1024u + (line & 7u) * 128u;
        const unsigned dst = (unsigned)__builtin_amdgcn_readfirstlane((int)(unsigned)(unsigned long)(lds + 131072 + wid * 256));
        const unsigned soff = a_off(u);
        asm volatile("s_nop 4\n\ts_mov_b32 m0, %0\n\ts_nop 0\n\tbuffer_load_dword %1, %2, %3 offen lds" :: "s"(dst), "v"(voff), "s"(rsrc), "s"(soff) : "m0", "memory");
    }
    unsigned TOK;
    __device__ __forceinline__ unsigned tok_off(const Unit& u) const { return TOK + ((unsigned)u.aux * 16384u + (unsigned)(u.pm - __builtin_amdgcn_readfirstlane(TE[u.aux - 64])) * 256u) * 4u; }
    __device__ __forceinline__ unsigned a_off(const Unit& u) const { return GATHER_A ? A : A + (unsigned)u.pm * (256 * 1024); }
    __device__ __forceinline__ unsigned b_off(const Unit& u) const { return Bw + (unsigned)u.aux * bexp + (unsigned)u.pn * btile; }
};
using MoeOrder = MoeOrderT<false>; using MoeGather = MoeOrderT<true>;
struct EpiSwiglu {
    static constexpr bool PERM = true;
    unsigned char* ACT; const float* bgu;
    __device__ __forceinline__ void init(f32x4 (&acc)[2][2][4][2], const Unit& u, int wc, int fq) const {
        const float* bb = bgu + (size_t)u.aux * 2048 + u.pn * 128 + wc * 32 + 8 * fq;
        const f32x4 g0 = *(const f32x4*)(bb), g1 = *(const f32x4*)(bb + 4), u0 = *(const f32x4*)(bb + 1024), u1 = *(const f32x4*)(bb + 1028);
#pragma unroll
        for (int a = 0; a < 2; ++a)
#pragma unroll
            for (int m = 0; m < 4; ++m) { acc[a][0][m][0] = g0; acc[a][0][m][1] = g1; acc[a][1][m][0] = u0; acc[a][1][m][1] = u1; }
    }
    __device__ __forceinline__ void operator()(const f32x4 (&acc)[2][2][4][2], const Unit& u, int wr, int wc, int fr, int fq) const {
        const int row0 = u.pm * 256 + wr * 64 + fr, j0 = u.pn * 128 + wc * 32 + 8 * fq;
        unsigned char* dst0 = ACT + (size_t)row0 * DEXP + j0;
#pragma unroll
        for (int ai = 0; ai < 2; ++ai)
#pragma unroll
            for (int m = 0; m < 4; ++m) {
                int w2[2];
#pragma unroll
                for (int n = 0; n < 2; ++n) {
                    const f32x4 g = acc[ai][0][m][n], up = acc[ai][1][m][n];
                    f32x2 r[2];
#pragma unroll
                    for (int h = 0; h < 2; ++h) {
                        const f32x2 gg = {__builtin_amdgcn_fmed3f(g[2 * h], -3.0e38f, 7.0f), __builtin_amdgcn_fmed3f(g[2 * h + 1], -3.0e38f, 7.0f)};
                        const f32x2 uu = {__builtin_amdgcn_fmed3f(up[2 * h], -7.0f, 7.0f), __builtin_amdgcn_fmed3f(up[2 * h + 1], -7.0f, 7.0f)};
                        const f32x2 x = gg * (f32x2){-1.702f * 1.4426950408889634f, -1.702f * 1.4426950408889634f};
                        const f32x2 den = (f32x2){__builtin_amdgcn_exp2f(x[0]), __builtin_amdgcn_exp2f(x[1])} + (f32x2){1.0f, 1.0f};
                        const f32x2 rc = {__builtin_amdgcn_rcpf(den[0]), __builtin_amdgcn_rcpf(den[1])};
                        r[h] = (uu * (f32x2){8.0f, 8.0f} + (f32x2){8.0f, 8.0f}) * gg * rc; }
                    int w = __builtin_amdgcn_cvt_pk_fp8_f32(r[0][0], r[0][1], 0, false); w2[n] = __builtin_amdgcn_cvt_pk_fp8_f32(r[1][0], r[1][1], w, true);
                }
                u32x2 o; o.x = (unsigned)w2[0]; o.y = (unsigned)w2[1];
                *(u32x2*)(dst0 + (size_t)(ai * 128 + m * 16) * DEXP) = o;
            }
    }
};
struct EpiDown {
    static constexpr bool PERM = true;
    unsigned char* Y; const float* bd;
    __device__ __forceinline__ void init(f32x4 (&acc)[2][2][4][2], const Unit& u, int wc, int fq) const {
        const float* bb = bd + (size_t)u.aux * DM + u.pn * 256 + wc * 32 + 8 * fq;
        const f32x4 b00 = *(const f32x4*)(bb), b01 = *(const f32x4*)(bb + 4), b10 = *(const f32x4*)(bb + 128), b11 = *(const f32x4*)(bb + 132);
#pragma unroll
        for (int a = 0; a < 2; ++a)
#pragma unroll
            for (int m = 0; m < 4; ++m) { acc[a][0][m][0] = b00; acc[a][0][m][1] = b01; acc[a][1][m][0] = b10; acc[a][1][m][1] = b11; }
    }
    __device__ __forceinline__ void operator()(const f32x4 (&acc)[2][2][4][2], const Unit& u, int wr, int wc, int fr, int fq) const {
        const int row0 = u.pm * 256 + wr * 64 + fr, col0 = u.pn * 256 + wc * 32 + 8 * fq;
#pragma unroll
        for (int ai = 0; ai < 2; ++ai)
#pragma unroll
            for (int m = 0; m < 4; ++m) { unsigned char* rowp = Y + (size_t)(row0 + ai * 128 + m * 16) * DM + col0;
#pragma unroll
                for (int bj = 0; bj < 2; ++bj) *(u32x2*)(rowp + bj * 128) = cvt8_fp8(acc[ai][bj][m][0], acc[ai][bj][m][1], 8.0f); }
    }
};

__device__ __forceinline__ void p11_combine(const Frame& F) {
    const int tid_l = tid_local(), lane_l = tid_l & 63; (void)tid_l; (void)lane_l;
    const KArgs a = kargs();
    const int gw = F.vcu * NWAVES + F.wave, NGW = F.G * NWAVES, lane = lane_l;
    (void)build_tiles(F); const LAS int* TB = (const LAS int*)(F.lds + TILE_E_OFF);
    const int* RE = (const int*)(F.ws + WS_ROUTE); const int* RP = RE + T * 4; const float* RG = (const float*)(RE + T * 8);
    const unsigned char* Y = F.ws + WS_XS; bf16_t* HP = (bf16_t*)(F.ws + WS_HN); const bf16_t* X1 = (const bf16_t*)(F.ws + WS_X1B); bf16_t* X2 = (bf16_t*)(F.ws + WS_X2B); const float* gp = a->in[I_GPLE];
    f32x4 g[2][2];
#pragma unroll
    for (int j = 0; j < 2; ++j) { g[j][0] = *(const f32x4*)(gp + 512 * j + 8 * lane); g[j][1] = *(const f32x4*)(gp + 512 * j + 8 * lane + 4); }
    for (int t = gw; t < T; t += NGW) {
        f32x4 v[2][2];
#pragma unroll
        for (int j = 0; j < 2; ++j) { const u32x4 xw = *(const u32x4*)(X1 + (size_t)t * DM + 512 * j + 8 * lane); v[j][0] = (f32x4){bf_lo(xw.x), bf_hi(xw.x), bf_lo(xw.y), bf_hi(xw.y)}; v[j][1] = (f32x4){bf_lo(xw.z), bf_hi(xw.z), bf_lo(xw.w), bf_hi(xw.w)}; }
#pragma unroll
        for (int s = 0; s < 4; ++s) { const int slot = TB[RE[t * 4 + s]] * 256 + RP[t * 4 + s]; const float gt = RG[t * 4 + s] * 0.125f;
#pragma unroll
            for (int j = 0; j < 2; ++j) { const u32x2 y = *(const u32x2*)(Y + (size_t)slot * DM + 512 * j + 8 * lane);
                const f32x2 a0 = __builtin_amdgcn_cvt_pk_f32_fp8((int)y.x, false), a1 = __builtin_amdgcn_cvt_pk_f32_fp8((int)y.x, true), b0 = __builtin_amdgcn_cvt_pk_f32_fp8((int)y.y, false), b1 = __builtin_amdgcn_cvt_pk_f32_fp8((int)y.y, true);
                v[j][0] += (f32x4){a0[0], a0[1], a1[0], a1[1]} * gt; v[j][1] += (f32x4){b0[0], b0[1], b1[0], b1[1]} * gt; } }
        float ss = 0.f;
#pragma unroll
        for (int j = 0; j < 2; ++j)
#pragma unroll
            for (int n = 0; n < 2; ++n) { const f32x4 q = v[j][n]; ss += (q[0] * q[0] + q[1] * q[1]) + (q[2] * q[2] + q[3] * q[3]); u32x2 w; w.x = cvt_pk_bf16(q[0], q[1]); w.y = cvt_pk_bf16(q[2], q[3]); *(u32x2*)(X2 + (size_t)t * DM + 512 * j + 8 * lane + 4 * n) = w; }
        const float rstd = 1.0f / sqrtf(wave_sum(ss) * (1.f / DM) + EPS);
#pragma unroll
        for (int j = 0; j < 2; ++j) { const f32x4 q0 = v[j][0] * g[j][0] * rstd, q1 = v[j][1] * g[j][1] * rstd;
            if (PLE_FP8) { *(u32x2*)((unsigned char*)HP + (size_t)t * DM + 512 * j + 8 * lane) = cvt8_fp8(q0, q1, 8.0f); }
            else { u32x4 w; w.x = cvt_pk_bf16(q0[0], q0[1]); w.y = cvt_pk_bf16(q0[2], q0[3]); w.z = cvt_pk_bf16(q1[0], q1[1]); w.w = cvt_pk_bf16(q1[2], q1[3]);
                *(u32x4*)(HP + (size_t)t * DM + 512 * j + 8 * lane) = w; } }
    }
}
struct EpiPle {
    static constexpr bool PERM = false;
    __device__ __forceinline__ void init(f32x4 (&acc)[2][2][4][2], const Unit&, int, int) const {
#pragma unroll
        for (int a = 0; a < 2; ++a)
#pragma unroll
            for (int b = 0; b < 2; ++b)
#pragma unroll
                for (int m = 0; m < 4; ++m)
#pragma unroll
                    for (int n = 0; n < 2; ++n) acc[a][b][m][n] = (f32x4){0.f, 0.f, 0.f, 0.f};
    }
    float* out; const bf16_t* E; const bf16_t* X2;
    __device__ __forceinline__ void operator()(const f32x4 (&acc)[2][2][4][2], const Unit& u, int wr, int wc, int fr, int fq) const {
        const int row0 = u.pm * 256 + wr * 64 + fr, col0 = u.pn * 256 + wc * 32 + 4 * fq;
        const size_t off0 = (size_t)row0 * DM + col0;
        u32x2 eb[3][4], xb[3][4];
#define EP_LD(g) do { const size_t o_ = off0 + (size_t)(((g) >> 2) * 128 + ((g) & 3) * 16) * DM; \
        _Pragma("unroll") for (int q = 0; q < 4; ++q) { eb[(g) % 3][q] = *(const u32x2*)(E + o_ + (q >> 1) * 128 + (q & 1) * 16); xb[(g) % 3][q] = *(const u32x2*)(X2 + o_ + (q >> 1) * 128 + (q & 1) * 16); } } while (0)
        EP_LD(0); EP_LD(1); EP_LD(2);
#pragma unroll
        for (int g = 0; g < 8; ++g) { const int ai = g >> 2, m = g & 3; const size_t off = off0 + (size_t)(ai * 128 + m * 16) * DM;
            __builtin_amdgcn_sched_barrier(0);
#pragma unroll
            for (int q = 0; q < 4; ++q) { const u32x2 ev = eb[g % 3][q], xw = xb[g % 3][q]; const f32x4 a4 = acc[ai][q >> 1][m][q & 1];
                f32x4 r = {bf_lo(xw.x), bf_hi(xw.x), bf_lo(xw.y), bf_hi(xw.y)};
                r[0] += fast_sigmoid(a4[0]) * bf_lo(ev.x); r[1] += fast_sigmoid(a4[1]) * bf_hi(ev.x); r[2] += fast_sigmoid(a4[2]) * bf_lo(ev.y); r[3] += fast_sigmoid(a4[3]) * bf_hi(ev.y);
                *(f32x4*)(out + off + (q >> 1) * 128 + (q & 1) * 16) = r; }
            __builtin_amdgcn_sched_barrier(0);
            if (g + 3 < 8) EP_LD(g + 3);
        }
#undef EP_LD
    }
};

constexpr int N_PHASES = 13;
__global__ void __launch_bounds__(NWAVES * 64, 2) fwd_kernel(Args args) {
    extern __shared__ __attribute__((aligned(16))) unsigned char lds_raw[];
    Frame F;
    F.lds = (LAS unsigned char*)lds_raw; F.MISC = (volatile LAS unsigned*)(F.lds + MISC_OFF);
    F.wave = __builtin_amdgcn_readfirstlane(threadIdx.x >> 6);
    F.G = gridDim.x; { const int bx = blockIdx.x; F.vcu = (F.G % 8 == 0) ? (bx % 8) * (F.G / 8) + bx / 8 : bx; }
    { const KArgs ka = kargs(); F.out = ka->out; F.ws = ka->ws; F.ctl = (unsigned*)(ka->ws + WS_CTL); }
    { const int t0_ = tid_local(); if (t0_ < 32) F.MISC[t0_] = 0u; }
    __syncthreads();
    int lo, hi; { const KArgs ka = kargs(); lo = ka->ph_lo; hi = ka->ph_hi; }
    const bool multi = (hi - lo) > 1;
    XcdBarrier bar; bar.bar = F.ctl + CW_BAR; bar.x = 0; bar.st = nullptr;
    if (multi) bar = xcd_barrier_post(F.ctl + CW_BAR, F.MISC);
#ifndef PH_MASK
#define PH_MASK 0x1fff
#endif
#define IN(k) ((((PH_MASK) >> (k)) & 1) && lo <= (k) && (k) < hi)
#define SEAM(k) do { if (IN(k) && IN((k) + 1)) xcd_barrier(bar); } while (0)
    unsigned char* ws = F.ws;
    LAS unsigned char* ring = F.lds;
    const __amdgpu_buffer_rsrc_t rsrc = __builtin_amdgcn_make_buffer_rsrc((void*)ws, 0, (int)WS_END, 0x00020000);

    if (IN(0)) { p0_prologue(F); } SEAM(0);

    if (IN(1)) {
        if (GATES_FP8 && !P1_FP8) {
          { DenseOrder S; S.init(64, 8, F.G, (int)blockIdx.x, WS_HN8, 512, WS_WIN8 + (size_t)1024 * 1024, 512);
            EpiProj E{(bf16_t*)(ws + WS_PROJ), (bf16_t*)(ws + WS_GATES), 4};
            pg8::gemm_phase<EpiProj, DenseOrder, true, true, true>(ring, rsrc, pg8::Shape{1024, 1024, 1024, 0x7c7c7c7c, 0x7c7c7c7c}, S, E); }
          { DenseOrder S; S.init(64, 4, F.G, (int)blockIdx.x, WS_HN, 1024, WS_WIN, 1024);
            EpiProj E{(bf16_t*)(ws + WS_PROJ), (bf16_t*)(ws + WS_GATES), 0};
            pg8::gemm_phase<EpiProj, DenseOrder, true, true>(ring, rsrc, pg8::Shape{2048, 2048, 2048, 0, 0}, S, E); }
        } else
        { DenseOrder S; S.init(64, 12, F.G, (int)blockIdx.x, WS_HN, P1_FP8 ? 512 : 1024, WS_WIN, P1_FP8 ? 512 : 1024);
          EpiProj E{(bf16_t*)(ws + WS_PROJ), (bf16_t*)(ws + WS_GATES), 0};
          if (P1_FP8) pg8::gemm_phase<EpiProj, DenseOrder, true, true, true>(ring, rsrc, pg8::Shape{1024, 1024, 1024, 0x7c7c7c7c, 0x7c7c7c7c}, S, E);
          else pg8::gemm_phase<EpiProj, DenseOrder, true, true>(ring, rsrc, pg8::Shape{2048, 2048, 2048, 0, 0}, S, E, GP_AT(1)); }
        { DenseOrder S; S.init(64, 4, F.G, (int)blockIdx.x, WS_PB, 256, WS_WPLE, 256);
          EpiBf16 E{(bf16_t*)(ws + WS_E), 1024};
          pg8::gemm_phase<EpiBf16, DenseOrder, true, true>(ring, rsrc, pg8::Shape{512, 512, 512, 0, 0}, S, E); }
    } SEAM(1);

    if (IN(2)) { p2_rows(F); } SEAM(2);

    if (IN(3)) {
#ifndef P3M
#define P3M 7
#endif
        if (P3M & 1) { DenseOrder S; S.init(64, 4, F.G, (int)blockIdx.x, WS_A2 + 512, 512, WS_WKV, 256);
          EpiKV E{(bf16_t*)(ws + WS_K), (bf16_t*)(ws + WS_V), kargs()->in[I_GKNOPE]};
          pg8::gemm_phase<EpiKV, DenseOrder, true, true>(ring, rsrc, pg8::Shape{512, 1024, 512, 0, 0}, S, E); }
        if (P3M & 2) { DenseOrder S; S.init(64, 3, F.G, (int)blockIdx.x, WS_A2, 512, WS_WQ, 256);
          EpiQ E{(bf16_t*)(ws + WS_Q), (float*)(ws + WS_SSQ), (const float*)(ws + WS_COS), (const float*)(ws + WS_SIN), kargs()->in[I_GQHEAD]};
          pg8::gemm_phase<EpiQ, DenseOrder, true, true>(ring, rsrc, pg8::Shape{512, 1024, 512, 0, 0}, S, E); }
        if (P3M & 4) { DenseOrder S; S.init(64, 2, F.G, (int)blockIdx.x, WS_POOLED, 512, WS_WPOOL, 256, 512);
          EpiBf16 E{(bf16_t*)(ws + WS_MIXED), 512};
          pg8::gemm_phase<EpiBf16, DenseOrder, true, true>(ring, rsrc, pg8::Shape{512, 1024, 512, 0, 0}, S, E); }
    } SEAM(3);

    if (IN(4)) {
        u32x4 srd; { const unsigned long wb = (unsigned long)ws; srd.x = (unsigned)__builtin_amdgcn_readfirstlane((int)(unsigned)wb); srd.y = (unsigned)__builtin_amdgcn_readfirstlane((int)(unsigned)(wb >> 32)); srd.z = (unsigned)WS_END; srd.w = 0x00020000u; }
        att::ConvState CV; CV.next = __builtin_amdgcn_readfirstlane(F.vcu * NWAVES + F.wave); CV.end = CONV_IN_ATTN ? att::CV_ITEMS : 0; CV.cur = -1;
        bool fast;
        { const int lane = tid_local() & 63; const float* gqh = kargs()->in[I_GQHEAD]; const float* gkn = kargs()->in[I_GKNOPE]; const float* gkr = kargs()->in[I_GKROPE];
          float a = fabsf(gqh[lane]); if (lane < 32) a = fmaxf(a, fabsf(gqh[64 + lane])); float bn = fabsf(gkn[lane]); float br = (lane < 32) ? fabsf(gkr[lane]) : 0.f;
#pragma unroll
          for (int o = 1; o < 64; o <<= 1) { a = fmaxf(a, __shfl_xor(a, o)); bn = fmaxf(bn, __shfl_xor(bn, o)); br = fmaxf(br, __shfl_xor(br, o)); }
          const float Mb = 1.4426950408889634f * 1.01f * a * sqrtf(64.f * bn * bn + 32.f * br * br);
          fast = __builtin_amdgcn_readfirstlane(Mb <= 60.0f ? 1 : 0) != 0; }
        for (int it = F.vcu; it < 256; it += F.G) {
            const int bh = it >> 3, pr = it & 7;
            att::attn_unit(ring, srd, CV, ws, bh, 15 - pr, (const bf16_t*)(ws + WS_Q), (unsigned)WS_K, (unsigned)WS_V, (const float*)(ws + WS_SSQ), (bf16_t*)(ws + WS_ATT), fast);
            att::attn_unit(ring, srd, CV, ws, bh, pr, (const bf16_t*)(ws + WS_Q), (unsigned)WS_K, (unsigned)WS_V, (const float*)(ws + WS_SSQ), (bf16_t*)(ws + WS_ATT), fast);
        }
        { const LAS float* cb = (const LAS float*)(F.lds + att::CONV_OFF + F.wave * att::CONV_BYTES);
          const unsigned cbaddr = (unsigned)__builtin_amdgcn_readfirstlane((int)(unsigned)(unsigned long)(F.lds + att::CONV_OFF + F.wave * att::CONV_BYTES));
          const int lane_l = tid_local() & 63;
          while (CV.cur >= 0 || CV.next < CV.end) {
            if (CV.cur >= 0) { asm volatile("s_waitcnt vmcnt(0)" ::: "memory"); const att::ConvItem I = att::cv_setup(CV.cur, kargs()->in[I_WGU], kargs()->in[I_WD], ws + WS_WGU, ws + WS_WD); att::cv_out(I, cb, lane_l); }
            if (CV.next < CV.end) { const att::ConvItem I = att::cv_setup(CV.next, kargs()->in[I_WGU], kargs()->in[I_WD], ws + WS_WGU, ws + WS_WD); asm volatile("s_waitcnt lgkmcnt(0)" ::: "memory"); att::cv_dma(I, cbaddr, lane_l); CV.cur = CV.next; CV.next += 2048; } else CV.cur = -1;
          } }
    } SEAM(4);

    if (IN(5)) {
        MixOrder S{F.G, F.vcu, (unsigned)WS_ATT, (unsigned)WS_MIXED, (unsigned)WS_WAO, (unsigned)WS_WPO};
        EpiMix E{(bf16_t*)(ws + WS_MIX), (const bf16_t*)(ws + WS_GATES)};
        pg8::gemm_phase<EpiMix, MixOrder, true, true>(ring, rsrc, pg8::Shape{1024, 1024, 1024, 0, 0}, S, E, GP_AT(5));
    } SEAM(5);

    if (IN(6)) {
        DenseOrder S; S.init(64, 4, F.G, (int)blockIdx.x, WS_MIX, 1024, WS_WO, 1024);
        EpiRes E{kargs()->in[I_X], (bf16_t*)(ws + WS_X1B)};
        pg8::gemm_phase<EpiRes, DenseOrder, true, true>(ring, rsrc, pg8::Shape{2048, 2048, 2048, 0, 0}, S, E, GP_AT(6));
    } SEAM(6);

    if (IN(7)) { p7_router(F); } SEAM(7);


    if (IN(9)) {
        const int TM = build_tiles(F);
        MoeGather S{F.G, F.vcu, 3, TM * 8, (const LAS int*)(F.lds + TILE_E_OFF) + 64, (unsigned)WS_XS2, (unsigned)WS_WGU, 2048u * 1024u, 256u * 1024u, 0, 0, (unsigned)WS_TOK}; S.init_xcd((const LAS int*)(F.lds + TILE_E_OFF));
        EpiSwiglu E{ws + WS_ACT, kargs()->in[I_BGU]};
        pg8::gemm_phase<EpiSwiglu, MoeGather, true, true, true, true>(ring, rsrc, pg8::Shape{1024, 1024, 1024, 0x7c7c7c7c, 0x7c7c7c7c}, S, E, GP_AT(9));
    } SEAM(9);

    if (IN(10)) {
        const int TM = build_tiles(F);
        MoeOrder S{F.G, F.vcu, 2, TM * 4, (const LAS int*)(F.lds + TILE_E_OFF) + 64, (unsigned)WS_ACT, (unsigned)WS_WD, 1024u * 1024u, 256u * 1024u, 0, 0}; S.init_xcd((const LAS int*)(F.lds + TILE_E_OFF));
        EpiDown E{ws + WS_XS, kargs()->in[I_BD]};
        pg8::gemm_phase<EpiDown, MoeOrder, true, true, true>(ring, rsrc, pg8::Shape{1024, 1024, 1024, 0x7c7c7c7c, 0x7c7c7c7c}, S, E, GP_AT(10));
    } SEAM(10);

    if (IN(11)) { p11_combine(F); } SEAM(11);

    if (IN(12)) {
        DenseOrder S; S.init(64, 4, F.G, (int)blockIdx.x, WS_HN, PLE_FP8 ? 512 : 1024, WS_WPG, PLE_FP8 ? 512 : 1024);
        EpiPle E{F.out, (const bf16_t*)(ws + WS_E), (const bf16_t*)(ws + WS_X2B)};
        if (PLE_FP8) pg8::gemm_phase<EpiPle, DenseOrder, true, true, true>(ring, rsrc, pg8::Shape{1024, 1024, 1024, 0x7c7c7c7c, 0x7c7c7c7c}, S, E, GP_AT(12));
        else pg8::gemm_phase<EpiPle, DenseOrder, true, true>(ring, rsrc, pg8::Shape{2048, 2048, 2048, 0, 0}, S, E, GP_AT(12));
    }
#ifdef ATT_PROBE
    if (blockIdx.x == 17 && tid_local() == 0) { const unsigned long long* ap = (const unsigned long long*)(ws + WS_CTL + 65536 + 64); const unsigned long long wait = (ap[0] / ap[1]) * 10; const unsigned long long r0 = __builtin_amdgcn_s_memrealtime(); while (__builtin_amdgcn_s_memrealtime() - r0 < wait) __builtin_amdgcn_s_sleep(8); }
#endif
#ifdef ATT_PROBE2
    if (blockIdx.x == 17 && tid_local() == 0) { const unsigned long long* ap = (const unsigned long long*)(ws + WS_CTL + 65536 + 128); const unsigned long long wait = (ap[ATT_PROBE2 - 1] / ap[3]) * 10; const unsigned long long r0 = __builtin_amdgcn_s_memrealtime(); while (__builtin_amdgcn_s_memrealtime() - r0 < wait) __builtin_amdgcn_s_sleep(8); }
#endif
#ifdef BAR_PROBE
    for (int i_ = 0; i_ < 20; ++i_) xcd_barrier(bar);
#endif
#ifdef GP_PROBE
    if (blockIdx.x == GP_BLOCK && tid_local() == 0) {
        unsigned long long* gp = (unsigned long long*)(ws + WS_CTL + 65536);
        const unsigned long long cyc = gp[0], tiles = gp[1], pc = gp[2], pr = gp[3], units = gp[4];
        unsigned long long wait = 0;
        if (GP_METRIC == 0) wait = (cyc / tiles) * 10;
        if (GP_METRIC == 1) wait = (pc * 100 / pr) * 10;
        if (GP_METRIC == 2) wait = ((pc - cyc) / units);
        const unsigned long long r0 = __builtin_amdgcn_s_memrealtime();
        while (__builtin_amdgcn_s_memrealtime() - r0 < wait) __builtin_amdgcn_s_sleep(8);
    }
#endif
#undef IN
#undef SEAM
}

extern "C" void kernel_launch(void* const* d_in, const int* in_sizes, int n_in, void* d_out, int out_size, void* d_ws, size_t ws_size, hipStream_t stream) {
    static int grid = 0;
    if (grid == 0) {
        if (n_in != 27 || out_size != T * DM || ws_size < WS_END) { fprintf(stderr, "kernel_launch: unexpected shapes (n_in %d, out %d, ws %zu)\n", n_in, out_size, ws_size); grid = -1; return; }
        int dev = 0, cus = 0;
        if (hipGetDevice(&dev) != hipSuccess || hipDeviceGetAttribute(&cus, hipDeviceAttributeMultiprocessorCount, dev) != hipSuccess) { grid = -1; return; }
        if (hipFuncSetAttribute((const void*)fwd_kernel, hipFuncAttributeMaxDynamicSharedMemorySize, LDS_BYTES) != hipSuccess) { fprintf(stderr, "kernel_launch: hipFuncSetAttribute failed\n"); grid = -1; return; }
        int per_cu = 0;
        if (hipOccupancyMaxActiveBlocksPerMultiprocessor(&per_cu, (const void*)fwd_kernel, NWAVES * 64, LDS_BYTES) != hipSuccess || per_cu < 1) fprintf(stderr, "kernel_launch: occupancy query says %d\n", per_cu);
        (void)hipGetLastError();
        grid = cus;
    }
    if (grid < 0) return;
    (void)hipMemsetAsync((char*)d_ws + WS_CTL, 0, CTL_ZERO_BYTES, stream);
    Args a{};
    for (int i = 0; i < 27; ++i) a.in[i] = (const float*)d_in[i];
    a.out = (float*)d_out; a.ws = (unsigned char*)d_ws;
#ifndef DUP_PHASE
    a.ph_lo = 0; a.ph_hi = N_PHASES; hipLaunchKernelGGL(fwd_kernel, dim3(grid), dim3(NWAVES * 64), LDS_BYTES, stream, a);
#else
    a.ph_lo = 0; a.ph_hi = DUP_PHASE + 1; hipLaunchKernelGGL(fwd_kernel, dim3(grid), dim3(NWAVES * 64), LDS_BYTES, stream, a);
    (void)hipMemsetAsync((char*)d_ws + WS_CTL + CW_BAR * 4, 0, XCD_BAR_WORDS * 4, stream);
    a.ph_lo = DUP_PHASE; a.ph_hi = N_PHASES; hipLaunchKernelGGL(fwd_kernel, dim3(grid), dim3(NWAVES * 64), LDS_BYTES, stream, a);
#endif
}
```

```cpp
#include <hip/hip_runtime.h>
#ifndef GATE8
#define GATE8 2
#endif
#include <cstdio>
#include <cstdint>

#define LAS __attribute__((address_space(3)))
#define GAS __attribute__((address_space(1)))
typedef unsigned short bf16_t;
typedef short bf16x8 __attribute__((ext_vector_type(8)));
typedef short s16x4 __attribute__((ext_vector_type(4)));
typedef float f32x4 __attribute__((ext_vector_type(4)));
typedef float f32x2 __attribute__((ext_vector_type(2)));
typedef float f32x16 __attribute__((ext_vector_type(16)));
typedef unsigned u32x4 __attribute__((ext_vector_type(4)));
typedef unsigned u32x2 __attribute__((ext_vector_type(2)));

constexpr int NB = 4, SEQ = 4096, T = NB * SEQ, DM = 1024, NH = 8, DK = 96, DV = 64;
constexpr int NEXP = 32, TOPK = 4, DEXP = 1024, PLE = 256;
constexpr float EPS = 1e-6f;
constexpr int XS_ROWS = T * TOPK + NEXP * 256;

typedef __bf16 bf16x2_t __attribute__((ext_vector_type(2)));
__device__ __forceinline__ unsigned cvt_pk_bf16(float lo, float hi) { f32x2 v = {lo, hi}; return __builtin_bit_cast(unsigned, __builtin_convertvector(v, bf16x2_t)); }
__device__ __forceinline__ u32x2 cvt8_fp8(const f32x4 a, const f32x4 b, float sc) {
    int w0 = __builtin_amdgcn_cvt_pk_fp8_f32(a[0] * sc, a[1] * sc, 0, false); w0 = __builtin_amdgcn_cvt_pk_fp8_f32(a[2] * sc, a[3] * sc, w0, true);
    int w1 = __builtin_amdgcn_cvt_pk_fp8_f32(b[0] * sc, b[1] * sc, 0, false); w1 = __builtin_amdgcn_cvt_pk_fp8_f32(b[2] * sc, b[3] * sc, w1, true);
    u32x2 r; r.x = (unsigned)w0; r.y = (unsigned)w1; return r;
}
__device__ __forceinline__ float bf_lo(unsigned w) { return __uint_as_float(w << 16); }
__device__ __forceinline__ float bf_hi(unsigned w) { return __uint_as_float(w & 0xffff0000u); }
__device__ __forceinline__ float bf1(bf16_t h) { return __uint_as_float(((unsigned)h) << 16); }
__device__ __forceinline__ float fast_sigmoid(float v) { return __builtin_amdgcn_rcpf(1.0f + __builtin_amdgcn_exp2f(-1.4426950408889634f * v)); }
__device__ __forceinline__ int lane_id() { return (int)__builtin_amdgcn_mbcnt_hi(~0u, __builtin_amdgcn_mbcnt_lo(~0u, 0u)); }
__device__ __forceinline__ int tid_local() { int t = threadIdx.x; asm volatile("" : "+v"(t)); return t; }
__device__ __forceinline__ float wave_sum(float v) {
#pragma unroll
    for (int o = 1; o < 64; o <<= 1) v += __shfl_xor(v, o);
    return v;
}

namespace pg8 {
constexpr int BM = 256, BK = 64, HALF = 128, HTB = HALF * BK * 2, STAGE_BYTES = 8 * HTB;
__host__ __device__ __forceinline__ int lds_byte(int r, int c) { const int st = (r >> 4) * 2 + (c >> 5), rr = r & 15, cc = c & 31, ob = rr * 64 + cc * 2; return st * 1024 + (ob ^ (((ob >> 9) & 1) << 5)); }
__host__ __device__ __forceinline__ void stage_rc(int b, int& R, int& C) { const int st = b / 1024, sb = b % 1024, swz = sb ^ (((sb >> 9) & 1) << 5); R = (st >> 1) * 16 + swz / 64; C = (st & 1) * 32 + (swz % 64) / 2; }
__host__ __device__ __forceinline__ int perm32(int rho) { const int n = rho >> 4, i = rho & 15; return 8 * (i >> 2) + 4 * n + (i & 3); }

struct Unit { int pm, pn, aux; };
struct Shape { int Kb, lda, ldb, sw, sa; };
typedef int v8i_t __attribute__((ext_vector_type(8))); typedef int v4i_t __attribute__((ext_vector_type(4)));

template <class Epi, class Sched, bool ALIGN_EPI, bool SP2, bool MX = false, bool GATHER = false>
__device__ __forceinline__ void gemm_phase(LAS unsigned char* lds, const __amdgpu_buffer_rsrc_t rsrc, const Shape g, const Sched& S, const Epi& E, unsigned long long* gp_out = nullptr) {
    const int tid = tid_local(), wid = __builtin_amdgcn_readfirstlane(tid >> 6), lane = tid & 63, wr = wid >> 2, wc = wid & 3, fr = lane & 15, fq = lane >> 4;
    int nt = g.Kb / 128; asm volatile("" : "+s"(nt));
    unsigned voffA, voffB;
    { int R, C; stage_rc(tid * 16, R, C); const int Rb = Epi::PERM ? ((R & ~31) + perm32(R & 31)) : R;
      voffA = GATHER ? (unsigned)(C * 2 + (R << 16)) : (unsigned)(R * g.lda + C * 2); voffB = (unsigned)(Rb * g.ldb + C * 2); }
    const unsigned p2A = 64u * (unsigned)g.lda, p2B = 64u * (unsigned)g.ldb;
    const unsigned kstep = 128u;
    const unsigned hstepA = (unsigned)HALF * g.lda, hstepB = (unsigned)HALF * g.ldb;
    const unsigned ldsw = (unsigned)wid * 1024u;
    const int aoff = lds_byte(wr * 64 + fr, fq * 8), boff = lds_byte(wc * 32 + fr, fq * 8);
#define PG8_SA(b, h) (((b) * 2 + (h)) * HTB)
#define PG8_SB(b, h) ((4 + (b) * 2 + (h)) * HTB)
#define PG8_STAGE(bufoff, gbase, voff) do { \
        __builtin_amdgcn_raw_ptr_buffer_load_lds(rsrc, (LAS void*)(lds + (bufoff) + ldsw), 16, voff, (gbase), 0, 0); \
        __builtin_amdgcn_raw_ptr_buffer_load_lds(rsrc, (LAS void*)(lds + (bufoff) + ldsw + 8192), 16, voff, (gbase) + p2##voff, 0, 0); } while (0)
#define p2voffA p2A
#define p2voffB p2B
#define PG8_STAGEA(bufoff, gk, h, tab) do { if constexpr (GATHER) { \
        const LAS int* tb_ = (const LAS int*)(lds + STAGE_BYTES) + (tab) * 256 + (h) * 128 + (int)(voffA >> 16); const unsigned cb_ = voffA & 0xffffu; \
        const unsigned i0_ = (unsigned)tb_[0], i1_ = (unsigned)tb_[64]; \
        __builtin_amdgcn_raw_ptr_buffer_load_lds(rsrc, (LAS void*)(lds + (bufoff) + ldsw), 16, i0_ * (unsigned)g.lda + cb_, (gk), 0, 0); \
        __builtin_amdgcn_raw_ptr_buffer_load_lds(rsrc, (LAS void*)(lds + (bufoff) + ldsw + 8192), 16, i1_ * (unsigned)g.lda + cb_, (gk), 0, 0); } \
      else { PG8_STAGE(bufoff, (gk) + (h) * hstepA, voffA); } } while (0)
#define PG8_LDA(dst, b, h) do { _Pragma("unroll") for (int m = 0; m < 4; ++m) _Pragma("unroll") for (int k = 0; k < 2; ++k) dst[m][k] = *(const LAS bf16x8*)(lds + PG8_SA(b, h) + aoff + m * 2048 + k * 1024); } while (0)
#define PG8_LDB(dst, b, h) do { _Pragma("unroll") for (int n = 0; n < 2; ++n) _Pragma("unroll") for (int k = 0; k < 2; ++k) dst[n][k] = *(const LAS bf16x8*)(lds + PG8_SB(b, h) + boff + n * 2048 + k * 1024); } while (0)
#define PG8_CAT(x, y) __builtin_shufflevector(__builtin_bit_cast(v4i_t, x), __builtin_bit_cast(v4i_t, y), 0, 1, 2, 3, 4, 5, 6, 7)
#define PG8_MMA(ai, bj, At, Bt) do { __builtin_amdgcn_s_setprio(1); if constexpr (MX) { _Pragma("unroll") for (int m = 0; m < 4; ++m) _Pragma("unroll") for (int n = 0; n < 2; ++n) \
        acc[ai][bj][m][n] = __builtin_amdgcn_mfma_scale_f32_16x16x128_f8f6f4(PG8_CAT(Bt[n][0], Bt[n][1]), PG8_CAT(At[m][0], At[m][1]), acc[ai][bj][m][n], 0, 0, 0, g.sw, 0, g.sa); } else { \
        _Pragma("unroll") for (int m = 0; m < 4; ++m) _Pragma("unroll") for (int n = 0; n < 2; ++n) _Pragma("unroll") for (int k = 0; k < 2; ++k) \
        acc[ai][bj][m][n] = __builtin_amdgcn_mfma_f32_16x16x32_bf16(Bt[n][k], At[m][k], acc[ai][bj][m][n], 0, 0, 0); } __builtin_amdgcn_s_setprio(0); } while (0)
#define PG8_WAIT_V(n) asm volatile("s_waitcnt vmcnt(" #n ")" ::: "memory")
#define PG8_WAIT_L(n) asm volatile("s_waitcnt lgkmcnt(" #n ")" ::: "memory")
#define PG8_BAR __builtin_amdgcn_s_barrier()
#define PG8_SCHED __builtin_amdgcn_sched_barrier(0)
#ifdef GP_PROBE
    unsigned long long gp_cycles = 0, gp_tiles = 0; const unsigned long long gp_p0 = __builtin_amdgcn_s_memtime(), gp_r0 = __builtin_amdgcn_s_memrealtime();
#endif
    Unit cur, nxt; int ui = 0;
    if (!S.next(0, cur)) return;
    f32x4 acc[2][2][4][2];
    E.init(acc, cur, wc, fq);
    bf16x8 At[4][2], B0[2][2], B1[2][2];
    unsigned cA = S.a_off(cur), cB = S.b_off(cur);
    int tab_c = 0; (void)tab_c;
    if constexpr (GATHER) {
        if (wid < 4) {
            const unsigned dst_ = (unsigned)__builtin_amdgcn_readfirstlane((int)(unsigned)(unsigned long)(lds + STAGE_BYTES + (wid * 64) * 4));
            const unsigned vo_ = (unsigned)((wid * 64 + lane) * 4); const unsigned so_ = S.tok_off(cur);
            asm volatile("s_nop 4\n\ts_mov_b32 m0, %0\n\ts_nop 0\n\tbuffer_load_dword %1, %2, %3 offen lds" :: "s"(dst_), "v"(vo_), "s"(rsrc), "s"(so_) : "m0", "memory"); }
        asm volatile("s_waitcnt vmcnt(0)" ::: "memory"); __syncthreads();
    }
    if constexpr (SP2) {
        PG8_STAGE(PG8_SB(0, 0), cB, voffB); PG8_STAGE(PG8_SB(0, 1), cB + hstepB, voffB); PG8_STAGEA(PG8_SA(0, 0), cA, 0, tab_c); PG8_STAGEA(PG8_SA(0, 1), cA, 1, tab_c);
        if (wr == 1) PG8_BAR;
        PG8_WAIT_V(2); PG8_BAR;
        PG8_STAGE(PG8_SB(1, 0), cB + kstep, voffB); PG8_STAGEA(PG8_SA(1, 0), cA + kstep, 0, tab_c); PG8_STAGE(PG8_SB(1, 1), cB + hstepB + kstep, voffB);
        PG8_WAIT_V(6); PG8_BAR;
    } else {
        PG8_STAGE(PG8_SB(0, 0), cB, voffB); PG8_STAGEA(PG8_SA(0, 0), cA, 0, tab_c); PG8_STAGE(PG8_SB(0, 1), cB + hstepB, voffB); PG8_STAGEA(PG8_SA(0, 1), cA, 1, tab_c);
        if (wr == 1) PG8_BAR;
        PG8_WAIT_V(4); PG8_BAR;
        PG8_STAGE(PG8_SB(1, 0), cB + kstep, voffB); PG8_STAGEA(PG8_SA(1, 0), cA + kstep, 0, tab_c); PG8_STAGE(PG8_SB(1, 1), cB + hstepB + kstep, voffB);
        PG8_WAIT_V(6); PG8_BAR;
    }
    for (;;) {
        const bool has_next = S.next(ui + 1, nxt);
        const unsigned nA = has_next ? S.a_off(nxt) : cA, nB = has_next ? S.b_off(nxt) : cB;
        if constexpr (GATHER) { if (has_next && wid < 4) {
            const unsigned dst_ = (unsigned)__builtin_amdgcn_readfirstlane((int)(unsigned)(unsigned long)(lds + STAGE_BYTES + ((tab_c ^ 1) * 256 + wid * 64) * 4));
            const unsigned vo_ = (unsigned)((wid * 64 + lane) * 4); const unsigned so_ = S.tok_off(nxt);
            asm volatile("s_nop 4\n\ts_mov_b32 m0, %0\n\ts_nop 0\n\tbuffer_load_dword %1, %2, %3 offen lds" :: "s"(dst_), "v"(vo_), "s"(rsrc), "s"(so_) : "m0", "memory"); } }
#ifdef GP_PROBE
        const unsigned long long gp_t0 = __builtin_amdgcn_s_memtime();
#endif
#pragma nounroll
        for (int t = 0; t < nt; t += 2) {
            const bool last = (t == nt - 2);
            const unsigned a1 = cA + (unsigned)(t + 1) * kstep;
            const unsigned a2 = last ? nA : cA + (unsigned)(t + 2) * kstep, b2 = last ? nB : cB + (unsigned)(t + 2) * kstep;
            const unsigned a3 = a2 + kstep, b3 = b2 + kstep; const int tab_2 = last ? (tab_c ^ 1) : tab_c; (void)tab_2;
            if constexpr (SP2) {
            PG8_LDB(B0, 0, 0); PG8_LDB(B1, 0, 1); PG8_SCHED; PG8_LDA(At, 0, 0); PG8_STAGEA(PG8_SA(1, 1), a1, 1, tab_c);
            PG8_WAIT_V(8); PG8_WAIT_L(0); PG8_BAR; PG8_MMA(0, 0, At, B0); PG8_MMA(0, 1, At, B1); PG8_BAR; PG8_SCHED;
            PG8_LDA(At, 0, 1); PG8_STAGE(PG8_SB(0, 0), b2, voffB); PG8_STAGE(PG8_SB(0, 1), b2 + hstepB, voffB); PG8_STAGEA(PG8_SA(0, 0), a2, 0, tab_2);
            PG8_WAIT_V(8); PG8_WAIT_L(0); PG8_BAR; PG8_MMA(1, 0, At, B0); PG8_MMA(1, 1, At, B1); PG8_BAR; PG8_SCHED;
            PG8_LDB(B0, 1, 0); PG8_LDB(B1, 1, 1); PG8_SCHED; PG8_LDA(At, 1, 0); PG8_STAGEA(PG8_SA(0, 1), a2, 1, tab_2);
            PG8_WAIT_V(8); PG8_WAIT_L(0); PG8_BAR; PG8_MMA(0, 0, At, B0); PG8_MMA(0, 1, At, B1); PG8_BAR; PG8_SCHED;
            PG8_LDA(At, 1, 1); PG8_STAGE(PG8_SB(1, 0), b3, voffB); PG8_STAGE(PG8_SB(1, 1), b3 + hstepB, voffB); PG8_STAGEA(PG8_SA(1, 0), a3, 0, tab_2);
            PG8_WAIT_V(8); PG8_WAIT_L(0); PG8_BAR; PG8_MMA(1, 0, At, B0); PG8_MMA(1, 1, At, B1); PG8_BAR; PG8_SCHED;
            } else {
            PG8_LDB(B0, 0, 0); PG8_SCHED; PG8_LDA(At, 0, 0); PG8_STAGEA(PG8_SA(1, 1), a1, 1, tab_c);
            PG8_WAIT_L(8); PG8_BAR; PG8_WAIT_L(0); PG8_MMA(0, 0, At, B0); PG8_BAR; PG8_SCHED;
            PG8_LDB(B1, 0, 1); PG8_STAGE(PG8_SB(0, 0), b2, voffB);
            PG8_BAR; PG8_WAIT_L(0); PG8_MMA(0, 1, At, B1); PG8_BAR;
            PG8_LDA(At, 0, 1); PG8_STAGEA(PG8_SA(0, 0), a2, 0, tab_2);
            PG8_BAR; PG8_WAIT_L(0); PG8_MMA(1, 0, At, B0); PG8_BAR; PG8_SCHED;
            PG8_STAGE(PG8_SB(0, 1), b2 + hstepB, voffB);
            PG8_WAIT_V(6); PG8_BAR; PG8_MMA(1, 1, At, B1); PG8_BAR;
            PG8_LDB(B0, 1, 0); PG8_SCHED; PG8_LDA(At, 1, 0); PG8_STAGEA(PG8_SA(0, 1), a2, 1, tab_2);
            PG8_WAIT_L(8); PG8_BAR; PG8_WAIT_L(0); PG8_MMA(0, 0, At, B0); PG8_BAR; PG8_SCHED;
            PG8_LDB(B1, 1, 1); PG8_STAGE(PG8_SB(1, 0), b3, voffB);
            PG8_BAR; PG8_WAIT_L(0); PG8_MMA(0, 1, At, B1); PG8_BAR;
            PG8_LDA(At, 1, 1); PG8_STAGEA(PG8_SA(1, 0), a3, 0, tab_2);
            PG8_BAR; PG8_WAIT_L(0); PG8_MMA(1, 0, At, B0); PG8_BAR; PG8_SCHED;
            PG8_STAGE(PG8_SB(1, 1), b3 + hstepB, voffB);
            PG8_WAIT_V(6); PG8_BAR; PG8_MMA(1, 1, At, B1); PG8_BAR;
            }
        }
#ifdef GP_PROBE
        if (gp_out) { gp_cycles += __builtin_amdgcn_s_memtime() - gp_t0; gp_tiles += nt; }
#endif
        if constexpr (ALIGN_EPI) { if (wr == 0) PG8_BAR; }
        if (has_next) S.prefetch(nxt, rsrc, lds, wid, lane);
        { int fr_e = fr, fq_e = fq; asm volatile("" : "+v"(fr_e), "+v"(fq_e));
          E(acc, cur, wr, wc, fr_e, fq_e); }
        if (!has_next) break;
        { int fq_i = fq; asm volatile("" : "+v"(fq_i)); E.init(acc, nxt, wc, fq_i); }
        cur = nxt; cA = nA; cB = nB; ++ui; tab_c ^= 1;
        if constexpr (ALIGN_EPI) { if (wr == 1) PG8_BAR; }
    }
    PG8_WAIT_V(0);
    if constexpr (!ALIGN_EPI) { if (wr == 0) PG8_BAR; }
    PG8_BAR;
#ifdef GP_PROBE
    if (gp_out && blockIdx.x == GP_BLOCK && tid == 0) { gp_out[0] = gp_cycles; gp_out[1] = gp_tiles; gp_out[2] = __builtin_amdgcn_s_memtime() - gp_p0; gp_out[3] = __builtin_amdgcn_s_memrealtime() - gp_r0; gp_out[4] = (unsigned long long)(ui + 1); }
#endif
#undef PG8_SA
#undef PG8_SB
#undef PG8_STAGE
#undef p2voffA
#undef PG8_STAGEA
#undef p2voffB
#undef PG8_LDA
#undef PG8_LDB
#undef PG8_MMA
#undef PG8_CAT
#undef PG8_WAIT_V
#undef PG8_WAIT_L
#undef PG8_BAR
#undef PG8_SCHED
}
}
using pg8::Unit;

constexpr size_t MiB = 1u << 20;
constexpr size_t WS_CTL = 0, CTL_ZERO_BYTES = 1 * MiB;
constexpr size_t WS_WIN = 1 * MiB;
constexpr size_t WS_WQ = 7 * MiB;
constexpr size_t WS_WKV = WS_WQ + 512 * 1024;
constexpr size_t WS_WPOOL = 8 * MiB;
constexpr size_t WS_WAO = 9 * MiB;
constexpr size_t WS_WPO = 10 * MiB;
constexpr size_t WS_WO = 11 * MiB;
constexpr size_t WS_WPG = 13 * MiB;
constexpr size_t WS_WPLE = 15 * MiB;
constexpr size_t WS_WGU = 16 * MiB;
constexpr size_t WS_WD = 144 * MiB;
constexpr size_t WS_HN = 208 * MiB;
constexpr size_t WS_PROJ = 240 * MiB;
constexpr size_t WS_GATES = 272 * MiB;
constexpr size_t WS_A2 = 336 * MiB;
constexpr size_t WS_POOLED = 352 * MiB;
constexpr size_t WS_Q = 368 * MiB;
constexpr size_t WS_K = 392 * MiB;
constexpr size_t WS_V = 416 * MiB;
constexpr size_t WS_ATT = 432 * MiB;
constexpr size_t WS_MIXED = 448 * MiB;
constexpr size_t WS_MIX = 464 * MiB;
constexpr size_t WS_PB = 496 * MiB;
constexpr size_t WS_E = 504 * MiB;
constexpr size_t WS_SSQ = 536 * MiB;
constexpr size_t WS_COS = 537 * MiB;
constexpr size_t WS_SIN = 538 * MiB;
constexpr size_t WS_ROUTE = 539 * MiB;
constexpr size_t WS_TOK = 541 * MiB;
constexpr size_t WS_XS = 544 * MiB;
constexpr size_t WS_ACT = 688 * MiB;
constexpr size_t WS_XS2 = 768 * MiB;
constexpr size_t WS_WIN8 = 848 * MiB;
constexpr size_t WS_HN8 = 852 * MiB;
constexpr size_t WS_END = 868 * MiB;
constexpr size_t WS_X1B = WS_PROJ;
constexpr size_t WS_X2B = WS_MIX;
constexpr int CW_BAR = 4096;
constexpr int CW_CNT = 1024;

constexpr int RING_BYTES = 131072;
constexpr int LDS_BYTES = 163840;
constexpr int MISC_OFF = LDS_BYTES - 512;
constexpr int TILE_E_OFF = LDS_BYTES - 4096;
constexpr int NWAVES = 8;

typedef GAS unsigned gu32;
#define RLX_AGENT __ATOMIC_RELAXED, __HIP_MEMORY_SCOPE_AGENT
#define XB_TMO      128
#define XB_XCNT(j)  (256  + 64 * (j))
#define XB_XSUB(j)  (1280 + 64 * (j))
#define XB_XGEN(j)  (2304 + 64 * (j))
#define XB_TOP      3328
#define XB_TOPGEN   3392
#define XCD_BAR_WORDS 3456
#define XB_SPIN_CAP (1u << 18)
__device__ __forceinline__ unsigned xb_ld(unsigned* p)              { return __hip_atomic_load(p, __ATOMIC_RELAXED, __HIP_MEMORY_SCOPE_AGENT); }
__device__ __forceinline__ unsigned xb_add(unsigned* p, unsigned v) { return __hip_atomic_fetch_add(p, v, __ATOMIC_RELAXED, __HIP_MEMORY_SCOPE_AGENT); }
__device__ __forceinline__ unsigned xb_xcc_id() { return (unsigned)__builtin_amdgcn_s_getreg((3 << 11) | 20) & 0xFu; }
#define XB_SPIN(cond, bar) do { unsigned _sp = 0; while (cond) { __builtin_amdgcn_s_sleep(1); \
    if ((++_sp & 255u) == 0u) { if (xb_ld(&(bar)[XB_TMO])) break; if (_sp > XB_SPIN_CAP) { atomicAdd(&(bar)[XB_TMO], 1u); break; } } } } while (0)
struct XcdBarrier { unsigned* bar; unsigned x; volatile LAS unsigned* st; };
__device__ __forceinline__ XcdBarrier xcd_barrier_post(unsigned* bar, volatile LAS unsigned* st) {
    XcdBarrier b; b.bar = bar; b.x = xb_xcc_id(); b.st = st;
    if (threadIdx.x == 0) (void)xb_add(&bar[XB_XCNT(b.x)], 1u);
    return b;
}
__device__ __forceinline__ void xcd_barrier_complete(unsigned* bar, unsigned x, unsigned& nloc, unsigned& nx) {
    const unsigned G = gridDim.x * gridDim.y * gridDim.z;
    unsigned sum, cnt, mine, sp = 0u;
    for (;;) {
        sum = 0u; cnt = 0u; mine = 0u;
#pragma unroll
        for (unsigned j = 0; j < 16; ++j) { const unsigned c = xb_ld(&bar[XB_XCNT(j)]); sum += c; cnt += (c > 0u) ? 1u : 0u; mine = (j == x) ? c : mine; }
        if (sum == G) break;
        __builtin_amdgcn_s_sleep(1);
        if ((++sp & 255u) == 0u) { if (xb_ld(&bar[XB_TMO])) break; if (sp > XB_SPIN_CAP) { atomicAdd(&bar[XB_TMO], 1u); break; } }
    }
    nloc = mine > 0u ? mine : 1u; nx = cnt > 0u ? cnt : 1u;
}
__device__ __forceinline__ void xcd_barrier(const XcdBarrier& b) {
    asm volatile("s_waitcnt vmcnt(0)" ::: "memory");
    __syncthreads();
    if (threadIdx.x == 0) {
        unsigned* bar = b.bar;
        __builtin_amdgcn_s_waitcnt(0);
        unsigned nloc = b.st[0], nx = b.st[1];
        if (nloc == 0u) { xcd_barrier_complete(bar, b.x, nloc, nx); b.st[0] = nloc; b.st[1] = nx; }
        const unsigned old = xb_add(&bar[XB_XSUB(b.x)], 1u);
        const unsigned gen = old / nloc;
        if (old + 1u == (gen + 1u) * nloc) {
            __builtin_amdgcn_fence(__ATOMIC_RELEASE, "agent");
            asm volatile("s_waitcnt vmcnt(0)" ::: "memory");
            const unsigned og = xb_add(&bar[XB_TOP], 1u);
            const unsigned tg = og / nx;
            if (og + 1u == (tg + 1u) * nx) xb_add(&bar[XB_TOPGEN], 1u);
            else XB_SPIN(xb_ld(&bar[XB_TOPGEN]) == tg, bar);
            __builtin_amdgcn_fence(__ATOMIC_ACQUIRE, "agent");
            xb_add(&bar[XB_XGEN(b.x)], 1u);
            asm volatile("s_waitcnt vmcnt(0)" ::: "memory");
        } else {
            XB_SPIN(xb_ld(&bar[XB_XGEN(b.x)]) == gen, bar);
            __builtin_amdgcn_fence(__ATOMIC_ACQUIRE, "agent");
            asm volatile("s_waitcnt vmcnt(0)" ::: "memory");
        }
    }
    __syncthreads();
}

#ifdef GP_PROBE
#define GP_AT(k) ((k) == GP_PHASE ? (unsigned long long*)(ws + WS_CTL + 65536) : nullptr)
#else
#define GP_AT(k) nullptr
#endif
struct Args {
    const float* in[27];
    float* out; unsigned char* ws;
    int ph_lo, ph_hi;
};
typedef const __attribute__((address_space(4))) Args* KArgs;
__device__ __forceinline__ KArgs kargs() { KArgs p = (KArgs)__builtin_amdgcn_kernarg_segment_ptr(); asm volatile("" : "+s"(p)); return p; }
enum { I_X = 0, I_P, I_POS, I_GMIX, I_WIN, I_GQLAT, I_WQB, I_GKVLAT, I_WKVB, I_GQHEAD, I_GKNOPE, I_GKROPE, I_WPOOL, I_PSCALE, I_WAO, I_WPO, I_WO, I_GFFN,
       I_WR, I_BR, I_WGU, I_BGU, I_WD, I_BD, I_GPLE, I_WPG, I_WPLE };

enum { MAP_ID = 0, MAP_WIN, MAP_GU, MAP_QB, MAP_KVB };
__device__ __forceinline__ int map_row(int mode, int n) {
    switch (mode) {
    case MAP_WIN: return n < 416 ? n : n + 96;
    case MAP_GU: { const int j = n & 1023, up = n >> 10; return 256 * (j >> 7) + 128 * up + (j & 127); }
    case MAP_QB: { const int h = n / 96, d = n % 96;
        if (d < 64) return (h >> 2) * 256 + 128 * (d >> 5) + 32 * (h & 3) + (d & 31);
        const int dd = d - 64, half = dd >> 4, i = dd & 15; return 512 + 128 * (h & 1) + 32 * (h >> 1) + 8 * (i >> 2) + 4 * half + (i & 3); }
    case MAP_KVB: { const int h = n >> 7, c = n & 127, isv = c >> 6, d = c & 63; return (h >> 1) * 256 + 128 * (d >> 5) + 32 * (2 * isv + (h & 1)) + (d & 31); }
    default: return n;
    }
}
struct TJob { const float* W; int K, N; bf16_t* WT; int ldw, koff, mode, row_off; const float* gk; const float* gn; int nmat; size_t wstride, wtstride; int fp8; };
struct TItem { const float* src; bf16_t* dst; int n0, k0; float gnv; };
__device__ __forceinline__ TItem titem_setup(const TJob& J, int item, int lane) {
    const int nblk = J.N / 32, ipm = (J.K / 64) * nblk, mat = item / ipm, it = item - mat * ipm, kb = it / nblk, nb = it - kb * nblk;
    TItem I; I.k0 = 64 * kb; I.n0 = 32 * nb;
    I.src = J.W + (size_t)mat * J.wstride + (size_t)(I.k0 + (lane >> 5)) * J.N + I.n0 + (lane & 31);
    I.dst = (bf16_t*)((unsigned char*)J.WT + (size_t)mat * J.wtstride * (J.fp8 ? 1 : 2));
    I.gnv = J.gn ? J.gn[I.n0 + (lane & 31)] : 1.f;
    return I;
}
__device__ __forceinline__ void titem_load(const TJob& J, const TItem& I, float (&v)[32]) {
#pragma unroll
    for (int i = 0; i < 32; ++i) v[i] = I.src[(size_t)(2 * i) * J.N];
}
__device__ __forceinline__ void titem_store(const TJob& J, const TItem& I, float (&v)[32], LAS float* scr, int lane) {
#pragma unroll
    for (int i = 0; i < 32; ++i) { const int kk = 2 * i + (lane >> 5); float x = v[i] * I.gnv; if (J.gk) x *= J.gk[I.k0 + kk]; scr[kk * 33 + (lane & 31)] = x; }
    asm volatile("s_waitcnt lgkmcnt(0)" ::: "memory");
    const int c = lane & 7;
#pragma unroll
    for (int j = 0; j < 4; ++j) { const int n = (lane >> 3) + 8 * j; const LAS float* s = scr + (8 * c) * 33 + n;
        const size_t eo = (size_t)(J.row_off + map_row(J.mode, I.n0 + n)) * J.ldw + J.koff + I.k0 + 8 * c;
        if (J.fp8) { u32x2 o; int w = __builtin_amdgcn_cvt_pk_fp8_f32(s[0 * 33] * 8.f, s[1 * 33] * 8.f, 0, false); w = __builtin_amdgcn_cvt_pk_fp8_f32(s[2 * 33] * 8.f, s[3 * 33] * 8.f, w, true); o.x = (unsigned)w;
            w = __builtin_amdgcn_cvt_pk_fp8_f32(s[4 * 33] * 8.f, s[5 * 33] * 8.f, 0, false); w = __builtin_amdgcn_cvt_pk_fp8_f32(s[6 * 33] * 8.f, s[7 * 33] * 8.f, w, true); o.y = (unsigned)w;
            *(u32x2*)((unsigned char*)I.dst + eo) = o; }
        else { u32x4 o; o.x = cvt_pk_bf16(s[0 * 33], s[1 * 33]); o.y = cvt_pk_bf16(s[2 * 33], s[3 * 33]); o.z = cvt_pk_bf16(s[4 * 33], s[5 * 33]); o.w = cvt_pk_bf16(s[6 * 33], s[7 * 33]);
            *(u32x4*)(I.dst + eo) = o; } }
    asm volatile("s_waitcnt lgkmcnt(0)" ::: "memory");
}
__device__ __forceinline__ void run_job(const TJob& J, LAS float* scr, int gw, int NGW, int lane) {
    const int items = J.nmat * (J.K / 64) * (J.N / 32);
    for (int it = gw; it < items; it += 2 * NGW) {
        const bool two = (it + NGW) < items;
        const TItem I0 = titem_setup(J, it, lane); const TItem I1 = titem_setup(J, two ? it + NGW : it, lane);
        float v0[32], v1[32];
        titem_load(J, I0, v0); if (two) titem_load(J, I1, v1);
        titem_store(J, I0, v0, scr, lane); if (two) titem_store(J, I1, v1, scr, lane);
    }
}

struct Frame {
    LAS unsigned char* lds; volatile LAS unsigned* MISC; unsigned* ctl;
    int wave, vcu, G;
    float* out; unsigned char* ws;
};

__device__ __forceinline__ void p0_prologue(const Frame& F) {
    const int tid_l = tid_local(), lane_l = tid_l & 63; (void)tid_l; (void)lane_l;
    const KArgs a = kargs();
    LAS float* scr = (LAS float*)(F.lds + F.wave * 16384);
    const int gw = F.vcu * NWAVES + F.wave, NGW = F.G * NWAVES;
    unsigned char* ws = F.ws;
    int joff = 0;
#define RUN_JOB(...) do { const TJob J_ = TJob{__VA_ARGS__, 1, 0, 0, 0}; run_job(J_, scr, (gw + NGW - joff % NGW) % NGW, NGW, lane_l); joff += (J_.K / 64) * (J_.N / 32); } while (0)
#ifndef P1_FP8
#define P1_FP8 0
#endif
    { const TJob J_{a->in[I_WIN], 1024, 2976, (bf16_t*)(ws + WS_WIN), 1024, 0, MAP_WIN, 0, nullptr, nullptr, 1, 0, 0, P1_FP8}; run_job(J_, scr, gw, NGW, lane_l); joff += 16 * 93; }
#ifndef GATES_FP8
#define GATES_FP8 0
#endif
    if (GATES_FP8) { const TJob J_{a->in[I_WIN], 1024, 2976, (bf16_t*)(ws + WS_WIN8), 1024, 0, MAP_WIN, 0, nullptr, nullptr, 1, 0, 0, 1}; run_job(J_, scr, gw, NGW, lane_l); }
    RUN_JOB(a->in[I_WQB], 256, 768, (bf16_t*)(ws + WS_WQ), 256, 0, MAP_QB, 0, a->in[I_GQLAT], nullptr);
    RUN_JOB(a->in[I_WKVB], 128, 1024, (bf16_t*)(ws + WS_WKV), 256, 0, MAP_KVB, 0, a->in[I_GKVLAT], nullptr);
    RUN_JOB(a->in[I_WAO], 512, 1024, (bf16_t*)(ws + WS_WAO), 512, 0, MAP_ID, 0, nullptr, nullptr);
    RUN_JOB(a->in[I_WPO], 512, 1024, (bf16_t*)(ws + WS_WPO), 512, 0, MAP_ID, 0, nullptr, nullptr);
    RUN_JOB(a->in[I_WO], 1024, 1024, (bf16_t*)(ws + WS_WO), 1024, 0, MAP_ID, 0, nullptr, nullptr);
#ifndef PLE_FP8
#define PLE_FP8 1
#endif
    { const TJob J_{a->in[I_WPG], 1024, 1024, (bf16_t*)(ws + WS_WPG), 1024, 0, MAP_ID, 0, nullptr, nullptr, 1, 0, 0, PLE_FP8}; run_job(J_, scr, (gw + NGW - joff % NGW) % NGW, NGW, lane_l); joff += 16 * 32; }
    RUN_JOB(a->in[I_WPLE], 256, 1024, (bf16_t*)(ws + WS_WPLE), 256, 0, MAP_ID, 0, nullptr, nullptr);
    for (int g = 0; g < 4; ++g)
        RUN_JOB(a->in[I_WPOOL] + (size_t)g * 128 * 128, 128, 128, (bf16_t*)(ws + WS_WPOOL) + (size_t)(g >> 1) * 256 * 256, 256, 128 * (g & 1), MAP_ID, 128 * (g & 1), nullptr, a->in[I_PSCALE] + 128 * g);
    {
        const int gt = (F.vcu * NWAVES + F.wave) * 64 + lane_l, NGT = NGW * 64;
        const u32x4 z = {0u, 0u, 0u, 0u};
        u32x4* w0 = (u32x4*)(ws + WS_WIN + (size_t)416 * 1024 * (P1_FP8 ? 1 : 2));
        for (int i = gt; i < 96 * (P1_FP8 ? 64 : 128); i += NGT) w0[i] = z;
        for (int i = gt; i < 1024 * 16; i += NGT) { const int r = i >> 4, c = i & 15; *(u32x4*)((bf16_t*)(ws + WS_WKV) + (size_t)r * 256 + 128 + 8 * c) = z; }
        for (int i = gt; i < 2 * 256 * 16; i += NGT) { const int p = i >> 12, r = (i >> 4) & 255, c = i & 15;
            const int k0 = (r < 128) ? 128 : 0; *(u32x4*)((bf16_t*)(ws + WS_WPOOL) + (size_t)p * 65536 + (size_t)r * 256 + k0 + 8 * c) = z; }
    }
#ifndef CONV_IN_ATTN
#define CONV_IN_ATTN 1
#endif
    if (!CONV_IN_ATTN) {
    { const TJob J{a->in[I_WGU], 1024, 2048, (bf16_t*)(ws + WS_WGU), 1024, 0, MAP_GU, 0, nullptr, nullptr, NEXP, (size_t)1024 * 2048, (size_t)2048 * 1024, 1}; run_job(J, scr, gw, NGW, lane_l); }
    { const TJob J{a->in[I_WD], 1024, 1024, (bf16_t*)(ws + WS_WD), 1024, 0, MAP_ID, 0, nullptr, nullptr, NEXP, (size_t)1024 * 1024, (size_t)1024 * 1024, 1}; run_job(J, scr, gw, NGW, lane_l); }
    }
    const float* x = a->in[I_X]; const float* gm = a->in[I_GMIX];
    f32x4 gv[4];
#pragma unroll
    for (int j = 0; j < 4; ++j) gv[j] = *(const f32x4*)(gm + 4 * lane_l + 256 * j);
    for (int m = gw; m < T; m += NGW) {
        const f32x4* xr = (const f32x4*)(x + (size_t)m * DM) + lane_l;
        f32x4 v[4]; float s = 0.f;
#pragma unroll
        for (int j = 0; j < 4; ++j) { v[j] = xr[64 * j]; s += (v[j].x * v[j].x + v[j].y * v[j].y) + (v[j].z * v[j].z + v[j].w * v[j].w); }
        const float rstd = 1.0f / sqrtf(wave_sum(s) * (1.f / DM) + EPS);
        if (P1_FP8) { int* o4 = (int*)(ws + WS_HN + (size_t)m * DM) + lane_l; const float r8 = rstd * 8.0f;
#pragma unroll
            for (int j = 0; j < 4; ++j) { int w = __builtin_amdgcn_cvt_pk_fp8_f32(v[j].x * r8 * gv[j].x, v[j].y * r8 * gv[j].y, 0, false); w = __builtin_amdgcn_cvt_pk_fp8_f32(v[j].z * r8 * gv[j].z, v[j].w * r8 * gv[j].w, w, true); o4[64 * j] = w; } }
        else { u32x2* o8 = (u32x2*)((bf16_t*)(ws + WS_HN) + (size_t)m * DM) + lane_l;
#pragma unroll
            for (int j = 0; j < 4; ++j) { u32x2 w; w.x = cvt_pk_bf16(v[j].x * rstd * gv[j].x, v[j].y * rstd * gv[j].y); w.y = cvt_pk_bf16(v[j].z * rstd * gv[j].z, v[j].w * rstd * gv[j].w); o8[64 * j] = w; }
            if (GATES_FP8) { int* o4 = (int*)(ws + WS_HN8 + (size_t)m * DM) + lane_l; const float r8 = rstd * 8.0f;
#pragma unroll
                for (int j = 0; j < 4; ++j) { int w = __builtin_amdgcn_cvt_pk_fp8_f32(v[j].x * r8 * gv[j].x, v[j].y * r8 * gv[j].y, 0, false); w = __builtin_amdgcn_cvt_pk_fp8_f32(v[j].z * r8 * gv[j].z, v[j].w * r8 * gv[j].w, w, true); o4[64 * j] = w; } } }
    }
    {
        const float* p = a->in[I_P];
        for (int m = gw; m < T; m += NGW) { const f32x4 v = *((const f32x4*)(p + (size_t)m * PLE) + lane_l); u32x2 w; w.x = cvt_pk_bf16(v.x, v.y); w.y = cvt_pk_bf16(v.z, v.w);
            *((u32x2*)((bf16_t*)(ws + WS_PB) + (size_t)m * PLE) + lane_l) = w; }
    }
}

struct DenseOrder {
    int nM, nN, nwg, G, c; unsigned A, B, tA, tB, aPn;
    __device__ void init(int nM_, int nN_, int G_, int c_, size_t A_, size_t lda, size_t B_, size_t ldb, unsigned aPn_ = 0) { nM = nM_; nN = nN_; nwg = nM * nN; G = G_; c = c_; A = (unsigned)A_; B = (unsigned)B_; tA = (unsigned)(256 * lda * 2); tB = (unsigned)(256 * ldb * 2); aPn = aPn_; }
    __device__ __forceinline__ bool next(int i, Unit& u) const {
        const long L = (long)i * G + c; if (L >= nwg) return false;
        int wgid = (int)L; { const int q = nwg / 8, r = nwg % 8, xcd = wgid % 8, off = wgid / 8; wgid = (xcd < r ? xcd * (q + 1) : r * (q + 1) + (xcd - r) * q) + off; }
        const int WGM = 8; const int nig = WGM * nN, gid = wgid / nig, fm = gid * WGM, gsz = (nM - fm) < WGM ? (nM - fm) : WGM;
        u.pm = fm + ((wgid % nig) % gsz); u.pn = (wgid % nig) / gsz; u.aux = 0; return true;
    }
    __device__ __forceinline__ void prefetch(const Unit&, const __amdgpu_buffer_rsrc_t, LAS unsigned char*, int, int) const {}
    __device__ __forceinline__ unsigned a_off(const Unit& u) const { return A + (unsigned)u.pm * tA + (unsigned)u.pn * aPn; }
    __device__ __forceinline__ unsigned b_off(const Unit& u) const { return B + (unsigned)u.pn * tB; }
};

struct EpiBf16 {
    static constexpr bool PERM = true;
    __device__ __forceinline__ void init(f32x4 (&acc)[2][2][4][2], const Unit&, int, int) const {
#pragma unroll
        for (int a = 0; a < 2; ++a)
#pragma unroll
            for (int b = 0; b < 2; ++b)
#pragma unroll
                for (int m = 0; m < 4; ++m)
#pragma unroll
                    for (int n = 0; n < 2; ++n) acc[a][b][m][n] = (f32x4){0.f, 0.f, 0.f, 0.f};
    }
    bf16_t* O; int ldc;
    __device__ __forceinline__ void operator()(const f32x4 (&acc)[2][2][4][2], const Unit& u, int wr, int wc, int fr, int fq) const {
        const int row0 = u.pm * 256 + wr * 64 + fr, col0 = u.pn * 256 + wc * 32 + 8 * fq;
#pragma unroll
        for (int ai = 0; ai < 2; ++ai)
#pragma unroll
            for (int m = 0; m < 4; ++m) { bf16_t* rowp = O + (size_t)(row0 + ai * 128 + m * 16) * ldc + col0;
#pragma unroll
                for (int bj = 0; bj < 2; ++bj) { const f32x4 v0 = acc[ai][bj][m][0], v1 = acc[ai][bj][m][1];
                    u32x4 w; w.x = cvt_pk_bf16(v0[0], v0[1]); w.y = cvt_pk_bf16(v0[2], v0[3]); w.z = cvt_pk_bf16(v1[0], v1[1]); w.w = cvt_pk_bf16(v1[2], v1[3]);
                    *(u32x4*)(rowp + bj * 128) = w; } }
    }
};
struct EpiProj {
    static constexpr bool PERM = true;
    __device__ __forceinline__ void init(f32x4 (&acc)[2][2][4][2], const Unit&, int, int) const {
#pragma unroll
        for (int a = 0; a < 2; ++a)
#pragma unroll
            for (int b = 0; b < 2; ++b)
#pragma unroll
                for (int m = 0; m < 4; ++m)
#pragma unroll
                    for (int n = 0; n < 2; ++n) acc[a][b][m][n] = (f32x4){0.f, 0.f, 0.f, 0.f};
    }
    bf16_t* PROJ; bf16_t* GATES; int pn_off;
    __device__ __forceinline__ void operator()(const f32x4 (&acc)[2][2][4][2], const Unit& u, int wr, int wc, int fr, int fq) const {
        const int pn = u.pn + pn_off; const int row0 = u.pm * 256 + wr * 64 + fr; const bool isg = pn >= 4;
        bf16_t* O = isg ? GATES : PROJ; const int ldc = isg ? 2048 : 1024; const int col0 = (isg ? pn - 4 : pn) * 256 + wc * 32 + 8 * fq;
#pragma unroll
        for (int ai = 0; ai < 2; ++ai)
#pragma unroll
            for (int m = 0; m < 4; ++m) { bf16_t* rowp = O + (size_t)(row0 + ai * 128 + m * 16) * ldc + col0;
#pragma unroll
                for (int bj = 0; bj < 2; ++bj) { f32x4 v0 = acc[ai][bj][m][0], v1 = acc[ai][bj][m][1];
                    if (isg) {
#pragma unroll
                        for (int e = 0; e < 4; ++e) { v0[e] = fast_sigmoid(v0[e]); v1[e] = fast_sigmoid(v1[e]); }
                        if (GATE8 == 2) {
                            unsigned w0_ = 0u, w1_ = 0u;
#pragma unroll
                            for (int e = 0; e < 4; ++e) { w0_ = __builtin_amdgcn_cvt_pk_u8_f32(fmaxf(__builtin_rintf(v0[e] * 255.0f), 1.0f), e, w0_); w1_ = __builtin_amdgcn_cvt_pk_u8_f32(fmaxf(__builtin_rintf(v1[e] * 255.0f), 1.0f), e, w1_); }
                            u32x2 w8_; w8_.x = w0_; w8_.y = w1_;
                            *(u32x2*)((unsigned char*)GATES + (size_t)(row0 + ai * 128 + m * 16) * 2048 + col0 + bj * 128) = w8_; continue; }
                        if (GATE8) {
#pragma unroll
                            for (int e = 0; e < 4; ++e) { v0[e] = fmaxf(v0[e] * 256.0f, 0.002f); v1[e] = fmaxf(v1[e] * 256.0f, 0.002f); }
                            *(u32x2*)((unsigned char*)GATES + (size_t)(row0 + ai * 128 + m * 16) * 2048 + col0 + bj * 128) = cvt8_fp8(v0, v1, 1.0f); continue; } }
                    u32x4 w; w.x = cvt_pk_bf16(v0[0], v0[1]); w.y = cvt_pk_bf16(v0[2], v0[3]); w.z = cvt_pk_bf16(v1[0], v1[1]); w.w = cvt_pk_bf16(v1[2], v1[3]);
                    *(u32x4*)(rowp + bj * 128) = w; } asm volatile("" ::: "memory"); }
    }
};

__device__ __forceinline__ void p2_rows(const Frame& F) {
    const int tid_l = tid_local(), lane_l = tid_l & 63; (void)tid_l; (void)lane_l;
    const KArgs a = kargs();
    const int gw = F.vcu * NWAVES + F.wave, NGW = F.G * NWAVES, lane = lane_l;
    unsigned char* ws = F.ws;
    const bf16_t* PROJ = (const bf16_t*)(ws + WS_PROJ);
    bf16_t* A2 = (bf16_t*)(ws + WS_A2); bf16_t* POOLED = (bf16_t*)(ws + WS_POOLED); bf16_t* Kb = (bf16_t*)(ws + WS_K);
    float* COS = (float*)(ws + WS_COS); float* SIN = (float*)(ws + WS_SIN);
    const int* positions = (const int*)a->in[I_POS];
    const float gkr = (lane < 32) ? a->in[I_GKROPE][lane] : 0.f;
    const float inv_freq = __builtin_amdgcn_exp2f(-(float)(lane & 15) * (13.287712379549449f / 16.0f));
    const int w = 2 << (lane >> 4);
    for (int task = gw; task < T / 8; task += NGW) {
        const int t0 = task * 8, b = t0 / SEQ, s0 = t0 % SEQ;
        u32x2 qlv[8]; unsigned kvv[8]; bf16_t krr[8]; int posv[8];
#pragma unroll
        for (int i = 0; i < 8; ++i) { const bf16_t* pr = PROJ + (size_t)(t0 + i) * 1024; qlv[i] = *(const u32x2*)(pr + 4 * lane); kvv[i] = *(const unsigned*)(pr + 256 + 2 * lane); krr[i] = pr[384 + (lane & 31)]; posv[i] = positions[t0 + i]; }
        {
            const bf16_t* base = PROJ + (size_t)(b * SEQ) * 1024 + 512 + 8 * lane;
            u32x4 I[15], C[8], L[8];
#pragma unroll
            for (int k = 0; k < 15; ++k) { const int r = s0 - 15 + k; I[k] = *(const u32x4*)(base + (size_t)(r < 0 ? 0 : r) * 1024); }
#pragma unroll
            for (int i = 0; i < 8; ++i) { C[i] = *(const u32x4*)(base + (size_t)(s0 + i) * 1024); const int rr = s0 + i - w + 1; L[i] = *(const u32x4*)(base + (size_t)(rr < 0 ? 0 : rr) * 1024); }
            float S[8];
#pragma unroll
            for (int j = 0; j < 8; ++j) S[j] = 0.f;
#pragma unroll
            for (int k = 0; k < 15; ++k) { const float mk = (s0 - 15 + k >= 0 && k >= 16 - w) ? 1.f : 0.f; const u32x4 v = I[k];
                S[0] += mk * bf_lo(v.x); S[1] += mk * bf_hi(v.x); S[2] += mk * bf_lo(v.y); S[3] += mk * bf_hi(v.y); S[4] += mk * bf_lo(v.z); S[5] += mk * bf_hi(v.z); S[6] += mk * bf_lo(v.w); S[7] += mk * bf_hi(v.w); }
#pragma unroll
            for (int i = 0; i < 8; ++i) {
                const int s = s0 + i;
                const u32x4 v = C[i];
                float uu[8] = {bf_lo(v.x), bf_hi(v.x), bf_lo(v.y), bf_hi(v.y), bf_lo(v.z), bf_hi(v.z), bf_lo(v.w), bf_hi(v.w)};
                const int cnt = (s + 1 < w) ? s + 1 : w; const float ic = 1.0f / (float)cnt;
                float o[8];
#pragma unroll
                for (int j = 0; j < 8; ++j) { S[j] += uu[j]; o[j] = S[j] * ic - uu[j]; }
                u32x4 wv; wv.x = cvt_pk_bf16(o[0], o[1]); wv.y = cvt_pk_bf16(o[2], o[3]); wv.z = cvt_pk_bf16(o[4], o[5]); wv.w = cvt_pk_bf16(o[6], o[7]);
                *(u32x4*)(POOLED + (size_t)(t0 + i) * 512 + 8 * lane) = wv;
                const float mq = (s - w + 1 >= 0) ? 1.f : 0.f; const u32x4 q = L[i];
                S[0] -= mq * bf_lo(q.x); S[1] -= mq * bf_hi(q.x); S[2] -= mq * bf_lo(q.y); S[3] -= mq * bf_hi(q.y); S[4] -= mq * bf_lo(q.z); S[5] -= mq * bf_hi(q.z); S[6] -= mq * bf_lo(q.w); S[7] -= mq * bf_hi(q.w);
            }
        }
#pragma unroll
        for (int i = 0; i < 8; ++i) {
            const int t = t0 + i, s = s0 + i;
            const u32x2 ql = qlv[i];
            const unsigned kvl = kvv[i];
            const float krv = (lane < 32) ? bf1(krr[i]) : 0.f;
            const float q0 = bf_lo(ql.x), q1 = bf_hi(ql.x), q2 = bf_lo(ql.y), q3 = bf_hi(ql.y);
            const float k0 = bf_lo(kvl), k1 = bf_hi(kvl);
            const float sq = wave_sum((q0 * q0 + q1 * q1) + (q2 * q2 + q3 * q3));
            const float sk = wave_sum(k0 * k0 + k1 * k1);
            const float sr = wave_sum(krv * krv);
            const float rq = 1.0f / sqrtf(sq * (1.f / 256.f) + EPS), rk = 1.0f / sqrtf(sk * (1.f / 128.f) + EPS), rr = 1.0f / sqrtf(sr * (1.f / 32.f) + EPS);
            u32x2 wq; wq.x = cvt_pk_bf16(q0 * rq, q1 * rq); wq.y = cvt_pk_bf16(q2 * rq, q3 * rq);
            *(u32x2*)(A2 + (size_t)t * 512 + 4 * lane) = wq;
            *(unsigned*)(A2 + (size_t)t * 512 + 256 + 2 * lane) = cvt_pk_bf16(k0 * rk, k1 * rk);
            *(unsigned*)(A2 + (size_t)t * 512 + 384 + 2 * lane) = 0u;
            const float pos = (float)posv[i];
            const float ang = pos * inv_freq;
            const float rev = ang * 0.15915494309189535f;
            const float fr_ = rev - floorf(rev);
            const float sn = __builtin_amdgcn_sinf(fr_), cs = __builtin_amdgcn_cosf(fr_);
            const float kn = krv * rr * gkr;
            const float other = __shfl_xor(kn, 16);
            const float ro = (lane & 16) ? (kn * cs + other * sn) : (kn * cs - other * sn);
            if (lane < 32) {
                const bf16_t rb = (bf16_t)(cvt_pk_bf16(ro, 0.f) & 0xffffu);
#pragma unroll
                for (int h = 0; h < NH; ++h) Kb[((size_t)(b * NH + h) * SEQ + s) * DK + 64 + lane] = rb;
            }
            if (lane < 16) { COS[(size_t)t * 16 + lane] = cs; SIN[(size_t)t * 16 + lane] = sn; }
        }
    }
}

#define EPI_FENCE() asm volatile("" ::: "memory")
struct EpiQ {
    static constexpr bool PERM = true;
    __device__ __forceinline__ void init(f32x4 (&acc)[2][2][4][2], const Unit&, int, int) const {
#pragma unroll
        for (int a = 0; a < 2; ++a)
#pragma unroll
            for (int b = 0; b < 2; ++b)
#pragma unroll
                for (int m = 0; m < 4; ++m)
#pragma unroll
                    for (int n = 0; n < 2; ++n) acc[a][b][m][n] = (f32x4){0.f, 0.f, 0.f, 0.f};
    }
    bf16_t* Q; float* SSQ; const float* COS; const float* SIN; const float* gq;
    __device__ __forceinline__ void operator()(const f32x4 (&acc)[2][2][4][2], const Unit& u, int wr, int wc, int fr, int fq) const {
        const int t0 = u.pm * 256 + wr * 64 + fr, b = (u.pm * 256) / SEQ, s0 = t0 - b * SEQ;
        if (u.pn < 2) {
            const int h = 4 * u.pn + wc;
            bf16_t* dst0 = Q + ((size_t)(b * NH + h) * SEQ + s0) * DK + 8 * fq;
            float* ssq0 = SSQ + ((size_t)t0 * NH + h) * 2;
            f32x4 gqv[2][2];
#pragma unroll
            for (int bj = 0; bj < 2; ++bj) { gqv[bj][0] = *(const f32x4*)(gq + 32 * bj + 8 * fq); gqv[bj][1] = *(const f32x4*)(gq + 32 * bj + 8 * fq + 4); }
#pragma unroll
            for (int ai = 0; ai < 2; ++ai)
#pragma unroll
                for (int m = 0; m < 4; ++m) {
                    const int dr = ai * 128 + m * 16;
                    float q = 0.f;
#pragma unroll
                    for (int bj = 0; bj < 2; ++bj)
#pragma unroll
                        for (int n = 0; n < 2; ++n) { const f32x4 v = acc[ai][bj][m][n]; q += (v[0] * v[0] + v[1] * v[1]) + (v[2] * v[2] + v[3] * v[3]); }
                    q += __shfl_xor(q, 16); q += __shfl_xor(q, 32);
                    if (fq == 0) ssq0[dr * NH * 2] = q;
#pragma unroll
                    for (int bj = 0; bj < 2; ++bj) { const f32x4 v0 = acc[ai][bj][m][0] * gqv[bj][0], v1 = acc[ai][bj][m][1] * gqv[bj][1];
                        u32x4 w; w.x = cvt_pk_bf16(v0[0], v0[1]); w.y = cvt_pk_bf16(v0[2], v0[3]); w.z = cvt_pk_bf16(v1[0], v1[1]); w.w = cvt_pk_bf16(v1[2], v1[3]);
                        *(u32x4*)(dst0 + dr * DK + 32 * bj) = w; }
                    EPI_FENCE();
                }
        } else {
            const f32x4 g1 = *(const f32x4*)(gq + 64 + 4 * fq), g2 = *(const f32x4*)(gq + 80 + 4 * fq);
            const float* cs0 = COS + (size_t)t0 * 16 + 4 * fq; const float* sn0 = SIN + (size_t)t0 * 16 + 4 * fq;
            bf16_t* dst0 = Q + ((size_t)(b * NH + 2 * wc) * SEQ + s0) * DK + 64 + 4 * fq;
            float* ssq0 = SSQ + ((size_t)t0 * NH + 2 * wc) * 2 + 1;
            f32x4 csb[3][2];
#define EQ_LD(g) do { const int d_ = ((g) >> 2) * 128 + ((g) & 3) * 16; csb[(g) % 3][0] = *(const f32x4*)(cs0 + d_ * 16); csb[(g) % 3][1] = *(const f32x4*)(sn0 + d_ * 16); } while (0)
            EQ_LD(0); EQ_LD(1); EQ_LD(2);
#pragma unroll
            for (int g = 0; g < 8; ++g) { const int ai = g >> 2, m = g & 3; {
                    const int dr = ai * 128 + m * 16;
                    __builtin_amdgcn_sched_barrier(0);
                    const f32x4 cs = csb[g % 3][0], sn = csb[g % 3][1];
#pragma unroll
                    for (int bj = 0; bj < 2; ++bj) {
                        const f32x4 x1 = acc[ai][bj][m][0], x2 = acc[ai][bj][m][1];
                        float q = (x1[0] * x1[0] + x1[1] * x1[1]) + (x1[2] * x1[2] + x1[3] * x1[3]) + (x2[0] * x2[0] + x2[1] * x2[1]) + (x2[2] * x2[2] + x2[3] * x2[3]);
                        q += __shfl_xor(q, 16); q += __shfl_xor(q, 32);
                        if (fq == 0) ssq0[dr * NH * 2 + bj * 2] = q;
                        const f32x4 y1 = x1 * g1, y2 = x2 * g2;
                        const f32x4 o1 = y1 * cs - y2 * sn, o2 = y2 * cs + y1 * sn;
                        bf16_t* dst = dst0 + (size_t)bj * SEQ * DK + dr * DK;
                        u32x2 w1, w2; w1.x = cvt_pk_bf16(o1[0], o1[1]); w1.y = cvt_pk_bf16(o1[2], o1[3]); w2.x = cvt_pk_bf16(o2[0], o2[1]); w2.y = cvt_pk_bf16(o2[2], o2[3]);
                        *(u32x2*)(dst) = w1; *(u32x2*)(dst + 16) = w2;
                    }
                    __builtin_amdgcn_sched_barrier(0);
                    if (g + 3 < 8) EQ_LD(g + 3);
                } }
#undef EQ_LD
        }
    }
};
struct EpiKV {
    static constexpr bool PERM = true;
    __device__ __forceinline__ void init(f32x4 (&acc)[2][2][4][2], const Unit&, int, int) const {
#pragma unroll
        for (int a = 0; a < 2; ++a)
#pragma unroll
            for (int b = 0; b < 2; ++b)
#pragma unroll
                for (int m = 0; m < 4; ++m)
#pragma unroll
                    for (int n = 0; n < 2; ++n) acc[a][b][m][n] = (f32x4){0.f, 0.f, 0.f, 0.f};
    }
    bf16_t* K; bf16_t* V; const float* gk;
    __device__ __forceinline__ void operator()(const f32x4 (&acc)[2][2][4][2], const Unit& u, int wr, int wc, int fr, int fq) const {
        const int t0 = u.pm * 256 + wr * 64 + fr, b = (u.pm * 256) / SEQ, s0 = t0 - b * SEQ;
        const int h = 2 * u.pn + (wc & 1); const bool isv = wc >= 2;
        const int pitch = isv ? DV : DK;
        bf16_t* dst0 = (isv ? V : K) + ((size_t)(b * NH + h) * SEQ + s0) * pitch + 8 * fq;
        f32x4 gkv[2][2];
#pragma unroll
        for (int bj = 0; bj < 2; ++bj) { gkv[bj][0] = *(const f32x4*)(gk + 32 * bj + 8 * fq); gkv[bj][1] = *(const f32x4*)(gk + 32 * bj + 8 * fq + 4); }
#pragma unroll
        for (int ai = 0; ai < 2; ++ai)
#pragma unroll
            for (int m = 0; m < 4; ++m) {
                const int dr = ai * 128 + m * 16;
                float sc = 1.f;
                if (!isv) { float q = 0.f;
#pragma unroll
                    for (int bj = 0; bj < 2; ++bj)
#pragma unroll
                        for (int n = 0; n < 2; ++n) { const f32x4 v = acc[ai][bj][m][n]; q += (v[0] * v[0] + v[1] * v[1]) + (v[2] * v[2] + v[3] * v[3]); }
                    q += __shfl_xor(q, 16); q += __shfl_xor(q, 32);
                    sc = 1.0f / sqrtf(q * (1.f / 64.f) + EPS); }
#pragma unroll
                for (int bj = 0; bj < 2; ++bj) {
                    f32x4 v0 = acc[ai][bj][m][0] * sc, v1 = acc[ai][bj][m][1] * sc;
                    if (!isv) { v0 = v0 * gkv[bj][0]; v1 = v1 * gkv[bj][1]; }
                    u32x4 w; w.x = cvt_pk_bf16(v0[0], v0[1]); w.y = cvt_pk_bf16(v0[2], v0[3]); w.z = cvt_pk_bf16(v1[0], v1[1]); w.w = cvt_pk_bf16(v1[2], v1[3]);
                    *(u32x4*)(dst0 + dr * pitch + 32 * bj) = w; }
                EPI_FENCE();
            }
    }
};

namespace att {
constexpr int KT_BYTES = 64 * 192, VT_BYTES = 64 * 128, SLOT_BYTES = KT_BYTES + VT_BYTES;
#ifndef ATT_PF
#define ATT_PF 3
#endif
constexpr int NSLOT = ATT_PF + 1, SCR_OFF = NSLOT * SLOT_BYTES;
__device__ __forceinline__ int crow(int r, int hi) { return (r & 3) + 8 * (r >> 2) + 4 * hi; }
__device__ __forceinline__ s16x4 vtr(const LAS unsigned char* p) { typedef short v4i16_t __attribute__((ext_vector_type(4)));
    return __builtin_bit_cast(s16x4, __builtin_amdgcn_ds_read_tr16_b64_v4i16((LAS v4i16_t*)p)); }
#define MFMA32(a, b, c) __builtin_amdgcn_mfma_f32_32x32x16_bf16(a, b, c, 0, 0, 0)
__device__ __forceinline__ float max3f(float a, float b, float c) { return __builtin_fmaxf(__builtin_fmaxf(a, b), c); }


constexpr int CONV_OFF = SCR_OFF + 8 * 256, CONV_BYTES = 8192;
constexpr int CV_GU_ITEMS = NEXP * 1024, CV_ITEMS = CV_GU_ITEMS + NEXP * 512;
struct ConvItem { const float* src; unsigned char* dst; int N, isgu, n0; };
__device__ __forceinline__ ConvItem cv_setup(int g, const float* wgu, const float* wd, unsigned char* wgu8, unsigned char* wd8) {
    ConvItem I;
    if (g < CV_GU_ITEMS) { const int e = g >> 10, it = g & 1023, kb = it >> 6, nb = it & 63; I.N = 2048; I.isgu = 1; I.n0 = 32 * nb;
        I.src = wgu + (size_t)e * 1024 * 2048 + (size_t)(64 * kb) * 2048 + 32 * nb; I.dst = wgu8 + (size_t)e * 2048 * 1024 + 64 * kb; }
    else { const int g2 = g - CV_GU_ITEMS, e = g2 >> 9, it = g2 & 511, kb = it >> 5, nb = it & 31; I.N = 1024; I.isgu = 0; I.n0 = 32 * nb;
        I.src = wd + (size_t)e * 1024 * 1024 + (size_t)(64 * kb) * 1024 + 32 * nb; I.dst = wd8 + (size_t)e * 1024 * 1024 + 64 * kb; }
    return I;
}
__device__ __forceinline__ void cv_dma(const ConvItem& I, unsigned ldsaddr, int lane) {
    const int kr = lane >> 3, sl = lane & 7;
#pragma unroll
    for (int q = 0; q < 8; ++q) { const unsigned voff = (unsigned)(((8 * q + kr) * I.N + 4 * (sl ^ ((kr ^ q) & 7))) * 4);
        asm volatile("s_nop 4\n\ts_mov_b32 m0, %0\n\ts_nop 0\n\tglobal_load_lds_dwordx4 %1, %2" :: "s"(ldsaddr + (unsigned)q * 1024u), "v"(voff), "s"(I.src) : "m0", "memory"); }
}
__device__ __forceinline__ void cv_out(const ConvItem& I, const LAS float* cb, int lane) {
    asm volatile("" : "+v"(lane));
    const int c = lane & 7;
#pragma unroll
    for (int j = 0; j < 4; ++j) { const int n = (lane >> 3) + 8 * j, nc = n >> 2, e = n & 3;
        float f[8];
#pragma unroll
        for (int kk = 0; kk < 8; ++kk) f[kk] = cb[(8 * c + kk) * 32 + ((nc ^ kk ^ c) & 7) * 4 + e];
        const int nn = I.n0 + n; const int row = I.isgu ? (256 * ((nn & 1023) >> 7) + 128 * (nn >> 10) + (nn & 127)) : nn;
        *(u32x2*)(I.dst + (size_t)row * 1024 + 8 * c) = cvt8_fp8((f32x4){f[0], f[1], f[2], f[3]}, (f32x4){f[4], f[5], f[6], f[7]}, 8.0f);
        asm volatile("" ::: "memory"); }
}
struct ConvState { int next, end, cur; };
__device__ __forceinline__ void attn_unit(LAS unsigned char* lds, const u32x4 srd, ConvState& CV, unsigned char* cvws, int bh, int qb, const bf16_t* Q_, unsigned Koff, unsigned Voff, const float* SSQ_, bf16_t* O_, const bool fast) {
    (void)Q_; (void)SSQ_; (void)O_;
    unsigned char* wl_ = cvws; asm volatile("" : "+s"(wl_));
    const bf16_t* Q = (const bf16_t*)(wl_ + WS_Q); const float* SSQ = (const float*)(wl_ + WS_SSQ); bf16_t* O = (bf16_t*)(wl_ + WS_ATT);
    const int tid = tid_local(), lane = tid & 63, r32 = lane & 31, hi = lane >> 5; const int wid = __builtin_amdgcn_readfirstlane(tid >> 6);
    const int b = bh / NH, h = bh % NH, q0 = qb * 256, qw = q0 + 32 * wid;
    LAS float* scr = (LAS float*)(lds + SCR_OFF) + wid * 64;
    const int NT = (q0 + 256) / 64;
    const unsigned kS = Koff + (unsigned)bh * (SEQ * DK * 2), vS = Voff + (unsigned)bh * (SEQ * DV * 2);
    const int kc2 = 8 + (wid & 3);
    const unsigned vK1 = (unsigned)(lane * 192 + wid * 16); const unsigned sK2 = (unsigned)((kc2 - wid) * 16);
    const int vkey = 8 * wid + (lane >> 3); const unsigned vV = (unsigned)(vkey * 128 + (((lane & 7) ^ (((vkey >> 1) & 1) * 4)) * 16));
    const unsigned lds0 = (unsigned)__builtin_amdgcn_readfirstlane((int)(unsigned)(unsigned long)lds);
    const unsigned dK1 = (unsigned)wid * 1024u, dK2 = (unsigned)kc2 * 1024u, dV = (unsigned)KT_BYTES + (unsigned)wid * 1024u;
#define ATT_DMA1(ldsaddr, voff, soff) asm volatile("s_nop 4\n\ts_mov_b32 m0, %0\n\ts_nop 0\n\tbuffer_load_dwordx4 %1, %2, %3 offen lds" :: "s"(ldsaddr), "v"(voff), "s"(srd), "s"(soff) : "m0", "memory")
#define ATT_DMA(t) do { const unsigned sp_ = lds0 + (unsigned)((t) % NSLOT) * SLOT_BYTES; const unsigned ks_ = kS + (unsigned)(t) * (64 * 192), vs_ = vS + (unsigned)(t) * (64 * 128); \
        ATT_DMA1(sp_ + dK1, vK1, ks_); ATT_DMA1(sp_ + dK2, vK1, ks_ + sK2); ATT_DMA1(sp_ + dV, vV, vs_); } while (0)
#define ATT_WAITBAR(N) asm volatile("s_waitcnt vmcnt(" #N ") lgkmcnt(0)\n\ts_barrier" ::: "memory")
    bf16x8 qr[6];
    { const float* sp = SSQ + ((size_t)(b * SEQ + qw + r32) * NH + h) * 2; const float ss = sp[0] + sp[1];
      const float cq = (1.0f / sqrtf(ss * (1.f / 96.f) + EPS)) * 0.10206207261596577f * 1.4426950408889634f;
      const bf16_t* qp = Q + ((size_t)bh * SEQ + qw + r32) * DK + 8 * hi;
      u32x4 qw_[6];
#pragma unroll
      for (int d0 = 0; d0 < 6; ++d0) qw_[d0] = *(const u32x4*)(qp + 16 * d0);
#pragma unroll
      for (int d0 = 0; d0 < 6; ++d0) { const u32x4 w = qw_[d0]; u32x4 o;
          o.x = cvt_pk_bf16(bf_lo(w.x) * cq, bf_hi(w.x) * cq); o.y = cvt_pk_bf16(bf_lo(w.y) * cq, bf_hi(w.y) * cq); o.z = cvt_pk_bf16(bf_lo(w.z) * cq, bf_hi(w.z) * cq); o.w = cvt_pk_bf16(bf_lo(w.w) * cq, bf_hi(w.w) * cq);
          qr[d0] = __builtin_bit_cast(bf16x8, o); } }
    ATT_DMA(0); ATT_DMA(1); ATT_DMA(2); if (ATT_PF == 4) ATT_DMA(3);
    const int kbase = hi * 1024 + r32 * 16;
    const int qq = (lane & 15) >> 2, pp = lane & 3, dblk = (lane >> 4) & 1, swz = ((qq >> 1) & 1) * 64;
    const int vrow0 = 4 * hi + qq;
    const int vb0 = KT_BYTES + vrow0 * 128 + ((32 * dblk + 8 * pp) ^ swz);
    const int vb1 = KT_BYTES + vrow0 * 128 + ((64 + 32 * dblk + 8 * pp) ^ swz);
    f32x16 o0 = {}, o1 = {};
    float m_run = -1e30f, l_run = 0.f; const f32x16 zero16 = {};
    const int qa = qw + r32;
#define ATT_QK(N0, N1, t) do { const LAS unsigned char* kp_ = lds + ((t) % NSLOT) * SLOT_BYTES + kbase; \
        _Pragma("unroll") for (int d0 = 0; d0 < 6; ++d0) { const bf16x8 ka_ = *(const LAS bf16x8*)(kp_ + d0 * 2048), kb_ = *(const LAS bf16x8*)(kp_ + d0 * 2048 + 512); \
            if (d0 == 0) { N0 = MFMA32(ka_, qr[0], zero16); N1 = MFMA32(kb_, qr[0], zero16); } else { N0 = MFMA32(ka_, qr[d0], N0); N1 = MFMA32(kb_, qr[d0], N1); } } } while (0)
#define ATT_MASK(N0, N1, t) do { const int kb_ = 64 * (t); if (kb_ + 63 > qw) { int d_ = qa - kb_ - 4 * hi; asm volatile("" : "+v"(d_));        \
        _Pragma("unroll") for (int r = 0; r < 16; ++r) { const int c_ = (r & 3) + 8 * (r >> 2); \
        if (c_ > d_) N0[r] = -__builtin_inff(); if (c_ + 32 > d_) N1[r] = -__builtin_inff(); } } } while (0)
#define ATT_ROWMAX(N0, N1, PM) do { float a_ = max3f(N0[0], N0[1], N1[0]), b_ = max3f(N0[2], N0[3], N1[1]); a_ = max3f(a_, N1[2], N1[3]); \
        _Pragma("unroll") for (int r = 4; r < 16; r += 4) { a_ = max3f(a_, N0[r], N0[r + 1]); b_ = max3f(b_, N0[r + 2], N0[r + 3]); a_ = max3f(a_, N1[r], N1[r + 1]); b_ = max3f(b_, N1[r + 2], N1[r + 3]); } \
        a_ = max3f(a_, b_, b_); auto rr_ = __builtin_amdgcn_permlane32_swap(__float_as_uint(a_), __float_as_uint(a_), false, false); \
        PM = max3f(__uint_as_float(rr_[0]), __uint_as_float(rr_[1]), __uint_as_float(rr_[1])); } while (0)
#define ATT_DECIDE(PM, C0, C1, FORCE) do { if ((FORCE) || __any((PM) > m_run + 8.0f)) { const float mn_ = fmaxf(m_run, (PM)); const float al_ = __builtin_amdgcn_exp2f(m_run - mn_); m_run = mn_; l_run *= al_; \
        if (hi == 0) scr[r32] = al_; asm volatile("s_waitcnt lgkmcnt(0)" ::: "memory"); \
        _Pragma("unroll") for (int a4 = 0; a4 < 4; ++a4) { const f32x4 f_ = *(const LAS f32x4*)(scr + 8 * a4 + 4 * hi); \
            _Pragma("unroll") for (int e = 0; e < 4; ++e) { o0[4 * a4 + e] *= f_[e]; o1[4 * a4 + e] *= f_[e]; } } } } while (0)
#define ATT_SM_HALF(P_, ks0, SUBM) do { _Pragma("unroll") for (int r = 0; r < 16; ++r) { P_[r] = __builtin_amdgcn_exp2f((SUBM) ? P_[r] - m_run : P_[r]); ps_ += P_[r]; } \
        _Pragma("unroll") for (int kq = 0; kq < 2; ++kq) { const int bs_ = 8 * kq; \
            u32x4 w_; w_.x = cvt_pk_bf16(P_[bs_ + 0], P_[bs_ + 1]); w_.y = cvt_pk_bf16(P_[bs_ + 2], P_[bs_ + 3]); w_.z = cvt_pk_bf16(P_[bs_ + 4], P_[bs_ + 5]); w_.w = cvt_pk_bf16(P_[bs_ + 6], P_[bs_ + 7]); \
            pa[(ks0) + kq] = __builtin_bit_cast(bf16x8, w_); } } while (0)
#define ATT_SOFTMAX(C0, C1) do { float ps_ = 0.f; ATT_SM_HALF(C0, 0, true); ATT_SM_HALF(C1, 2, true); l_run += ps_; } while (0)
#define ATT_SOFTMAX_F(C0, C1) do { float ps_ = 0.f; ATT_SM_HALF(C0, 0, false); ATT_SM_HALF(C1, 2, false); l_run += ps_; } while (0)
#define ATT_PV(t) do { const LAS unsigned char* vp0_ = lds + ((t) % NSLOT) * SLOT_BYTES + vb0; const LAS unsigned char* vp1_ = lds + ((t) % NSLOT) * SLOT_BYTES + vb1; \
        _Pragma("unroll") for (int ks = 0; ks < 4; ++ks) { \
            const s16x4 a0_ = vtr(vp0_ + ks * 16 * 128), a1_ = vtr(vp0_ + ks * 16 * 128 + 8 * 128), c0_ = vtr(vp1_ + ks * 16 * 128), c1_ = vtr(vp1_ + ks * 16 * 128 + 8 * 128); \
            const bf16x8 vf0_ = {a0_[0], a0_[1], a0_[2], a0_[3], a1_[0], a1_[1], a1_[2], a1_[3]}; const bf16x8 vf1_ = {c0_[0], c0_[1], c0_[2], c0_[3], c1_[0], c1_[1], c1_[2], c1_[3]}; \
            o0 = MFMA32(pa[ks], vf0_, o0); o1 = MFMA32(pa[ks], vf1_, o1); } } while (0)
#ifdef ATT_PROBE2
    unsigned long long ap_s[4] = {0, 0, 0, 0}, ap_acc[3] = {0, 0, 0};
#define AP_STAMP(k) do { __builtin_amdgcn_sched_barrier(0); asm volatile("s_memtime %0\n\ts_waitcnt lgkmcnt(0)" : "=s"(ap_s[k]) :: "memory"); __builtin_amdgcn_sched_barrier(0); if ((k) > 0) ap_acc[(k) - 1] += ap_s[k] - ap_s[(k) - 1]; } while (0)
#else
#define AP_STAMP(k) do {} while (0)
#endif
#define ATT_WB(N) asm volatile("s_waitcnt vmcnt(" #N ") lgkmcnt(0)\n\ts_barrier" ::: "memory")
#define ATT_RDK(d0) do { kf_[d0][0] = *(const LAS bf16x8*)(kp_ + (d0) * 2048); kf_[d0][1] = *(const LAS bf16x8*)(kp_ + (d0) * 2048 + 512); } while (0)
#define ATT_RDV(ks) do { vf_[ks][0] = vtr(vp0_ + (ks) * 16 * 128); vf_[ks][1] = vtr(vp0_ + (ks) * 16 * 128 + 8 * 128); vf_[ks][2] = vtr(vp1_ + (ks) * 16 * 128); vf_[ks][3] = vtr(vp1_ + (ks) * 16 * 128 + 8 * 128); } while (0)
#define ATT_MK(d0) do { if ((d0) == 0) { S0 = MFMA32(kf_[0][0], qr[0], zero16); S1 = MFMA32(kf_[0][1], qr[0], zero16); } else { S0 = MFMA32(kf_[d0][0], qr[d0], S0); S1 = MFMA32(kf_[d0][1], qr[d0], S1); } } while (0)
#define ATT_MV(ks) do { const bf16x8 v0_ = {vf_[ks][0][0], vf_[ks][0][1], vf_[ks][0][2], vf_[ks][0][3], vf_[ks][1][0], vf_[ks][1][1], vf_[ks][1][2], vf_[ks][1][3]}; \
        const bf16x8 v1_ = {vf_[ks][2][0], vf_[ks][2][1], vf_[ks][2][2], vf_[ks][2][3], vf_[ks][3][0], vf_[ks][3][1], vf_[ks][3][2], vf_[ks][3][3]}; \
        o0 = MFMA32(pa[ks], v0_, o0); o1 = MFMA32(pa[ks], v1_, o1); } while (0)
#define ATT_SB __builtin_amdgcn_sched_barrier(0)
#define ATT_SEGA(j, DODMA) do { \
        const LAS unsigned char* kp_ = lds + (((j) + 1) % NSLOT) * SLOT_BYTES + kbase; \
        const LAS unsigned char* vp0_ = lds + ((j) % NSLOT) * SLOT_BYTES + vb0; const LAS unsigned char* vp1_ = lds + ((j) % NSLOT) * SLOT_BYTES + vb1; \
        bf16x8 kf_[6][2]; s16x4 vf_[4][4]; \
        ATT_RDK(0); ATT_RDK(1); ATT_RDV(0); ATT_SB; \
        if (DODMA) { ATT_DMA((j) + ATT_PF); } ATT_SB; \
        ATT_MK(0); ATT_SB; ATT_RDK(2); ATT_SB; ATT_MK(1); ATT_SB; ATT_RDK(3); ATT_SB; ATT_MV(0); ATT_SB; ATT_RDV(1); ATT_SB; \
        ATT_MK(2); ATT_SB; ATT_RDK(4); ATT_SB; ATT_MK(3); ATT_SB; ATT_RDV(2); ATT_SB; ATT_MV(1); ATT_SB; ATT_RDK(5); ATT_SB; \
        ATT_MK(4); ATT_SB; ATT_MV(2); ATT_SB; ATT_RDV(3); ATT_SB; ATT_MK(5); ATT_MV(3); } while (0)
#define ATT_BARP asm volatile("s_waitcnt lgkmcnt(0)\n\ts_barrier" ::: "memory")
#define ATT_STEP(j, MSK, CONV, FAST) do { \
        if (MSK) ATT_MASK(S0, S1, (j)); \
        if (!(FAST)) { float pm_; ATT_ROWMAX(S0, S1, pm_); ATT_DECIDE(pm_, S0, S1, false); } \
        if (FAST) ATT_SOFTMAX_F(S0, S1); else ATT_SOFTMAX(S0, S1); \
        int infl_ = 0; \
        if (CONV) { __builtin_amdgcn_sched_barrier(0); const LAS float* cb_ = (const LAS float*)(lds + CONV_OFF + wid * CONV_BYTES); \
            if (CV.cur >= 0) { const ConvItem I_ = cv_setup(CV.cur, kargs()->in[I_WGU], kargs()->in[I_WD], cvws + WS_WGU, cvws + WS_WD); cv_out(I_, cb_, lane); infl_ += 4; } \
            if (CV.next < CV.end) { const ConvItem I_ = cv_setup(CV.next, kargs()->in[I_WGU], kargs()->in[I_WD], cvws + WS_WGU, cvws + WS_WD); asm volatile("s_waitcnt lgkmcnt(0)" ::: "memory"); \
                cv_dma(I_, lds0 + (unsigned)(CONV_OFF + wid * CONV_BYTES), lane); CV.cur = CV.next; CV.next += 2048; infl_ += 8; } else CV.cur = -1; } \
        __builtin_amdgcn_sched_barrier(0); ATT_BARP; __builtin_amdgcn_sched_barrier(0); \
        ATT_SEGA((j), ((j) + ATT_PF < NT)); if ((j) + ATT_PF < NT) infl_ += 3; \
        __builtin_amdgcn_sched_barrier(0); \
        if (!(CONV)) { if (infl_ == 3) ATT_WB(3); else ATT_WB(0); } \
        else switch (infl_) { case 15: ATT_WB(15); break; case 12: ATT_WB(12); break; case 11: ATT_WB(11); break; case 8: ATT_WB(8); break; case 7: ATT_WB(7); break; case 4: ATT_WB(4); break; case 3: ATT_WB(3); break; default: ATT_WB(0); break; } \
        __builtin_amdgcn_sched_barrier(0); } while (0)
    bf16x8 pa[4];
    f32x16 S0, S1;
    const bool grpY = wid >= 4;
    ATT_WAITBAR(6);
    if (grpY) ATT_BARP;
    __builtin_amdgcn_sched_barrier(0);
    ATT_QK(S0, S1, 0);
    __builtin_amdgcn_sched_barrier(0);
    ATT_WAITBAR(3);
    __builtin_amdgcn_sched_barrier(0);
    int j = 0;
    if (fast) {
        for (; j < NT - 4; j += 2) {
            ATT_STEP(j, false, CONV_IN_ATTN, true);
            ATT_STEP(j + 1, false, false, true);
        }
        for (; j < NT; j += 2) {
            ATT_STEP(j, true, CONV_IN_ATTN, true);
            ATT_STEP(j + 1, true, false, true);
        }
    } else {
        for (; j < NT - 4; j += 2) {
            ATT_STEP(j, false, CONV_IN_ATTN, false);
            ATT_STEP(j + 1, false, false, false);
        }
        for (; j < NT; j += 2) {
            ATT_STEP(j, true, CONV_IN_ATTN, false);
            ATT_STEP(j + 1, true, false, false);
        }
    }
    if (!grpY) ATT_BARP;
    __builtin_amdgcn_sched_barrier(0);
#ifdef ATT_PROBE2
    if (blockIdx.x == 17 && tid == 0) { unsigned long long* ap2 = (unsigned long long*)(cvws + WS_CTL + 65536 + 128); ap2[0] += ap_acc[0]; ap2[1] += ap_acc[1]; ap2[2] += ap_acc[2]; ap2[3] += (unsigned long long)NT; }
#endif
#ifdef ATT_PROBE
    if (blockIdx.x == 17 && tid == 0) { unsigned long long* ap = (unsigned long long*)(cvws + WS_CTL + 65536 + 64); ap[0] += __builtin_amdgcn_s_memtime() - ap_t0; ap[1] += (unsigned long long)NT; }
#endif
#undef ATT_DMA
#undef ATT_DMA1
#undef ATT_WAITBAR
#undef ATT_QK
#undef ATT_MASK
#undef ATT_ROWMAX
#undef ATT_DECIDE
#undef ATT_SOFTMAX
#undef ATT_SOFTMAX_F
#undef ATT_SM_HALF
#undef ATT_PV
#undef ATT_STEP
#undef ATT_WB
#undef ATT_BARP
#undef ATT_SEGA
#undef ATT_RDK
#undef ATT_RDV
#undef ATT_MK
#undef ATT_MV
#undef ATT_SB
#undef AP_STAMP
    { auto rr = __builtin_amdgcn_permlane32_swap(__float_as_uint(l_run), __float_as_uint(l_run), false, false); l_run = __uint_as_float(rr[0]) + __uint_as_float(rr[1]); }
    if (hi == 0) scr[32 + r32] = 1.0f / l_run;
    asm volatile("s_waitcnt lgkmcnt(0)" ::: "memory");
    bf16_t* Ow = O + ((size_t)(b * SEQ + qw)) * 512 + h * 64 + r32;
#pragma unroll
    for (int a4 = 0; a4 < 4; ++a4) { const f32x4 f = *(const LAS f32x4*)(scr + 32 + 8 * a4 + 4 * hi);
#pragma unroll
        for (int e = 0; e < 4; ++e) { const int r = 4 * a4 + e; const int row = crow(r, hi);
            Ow[(size_t)row * 512] = (bf16_t)(cvt_pk_bf16(o0[r] * f[e], 0.f) & 0xffffu);
            Ow[(size_t)row * 512 + 32] = (bf16_t)(cvt_pk_bf16(o1[r] * f[e], 0.f) & 0xffffu); } }
    __syncthreads();
}
#undef MFMA32
}

struct MixOrder {
    int G, c; unsigned ATT, MIXED, WAO, WPO;
    __device__ __forceinline__ bool next(int i, Unit& u) const {
        const int tile = (i >> 1) * G + c; if (tile >= 256) return false;
        u.pm = tile >> 2; u.pn = tile & 3; u.aux = i & 1; return true;
    }
    __device__ __forceinline__ void prefetch(const Unit&, const __amdgpu_buffer_rsrc_t, LAS unsigned char*, int, int) const {}
    __device__ __forceinline__ unsigned a_off(const Unit& u) const { return (u.aux ? MIXED : ATT) + (unsigned)u.pm * (256 * 512 * 2); }
    __device__ __forceinline__ unsigned b_off(const Unit& u) const { return (u.aux ? WPO : WAO) + (unsigned)u.pn * (256 * 512 * 2); }
};
struct EpiMix {
    static constexpr bool PERM = true;
    __device__ __forceinline__ void init(f32x4 (&acc)[2][2][4][2], const Unit& u, int, int) const {
        if (u.aux) return;
#pragma unroll
        for (int a = 0; a < 2; ++a)
#pragma unroll
            for (int b = 0; b < 2; ++b)
#pragma unroll
                for (int m = 0; m < 4; ++m)
#pragma unroll
                    for (int n = 0; n < 2; ++n) acc[a][b][m][n] = (f32x4){0.f, 0.f, 0.f, 0.f};
    }
    bf16_t* MIX; const bf16_t* GATES;
    __device__ __forceinline__ void operator()(f32x4 (&acc)[2][2][4][2], const Unit& u, int wr, int wc, int fr, int fq) const {
        const int row0 = u.pm * 256 + wr * 64 + fr, col0 = u.pn * 256 + wc * 32 + 8 * fq;
        const bool p0_ = u.aux == 0;
#if GATE8 == 2
        typedef u32x2 gv_t; const unsigned char* gb_ = (const unsigned char*)GATES + (size_t)row0 * 2048 + col0;
#define EM_LD1(p) (*(const u32x2*)(p))
#define EM_DEC(GW_, lo, hi) do { const gv_t t_ = (GW_); lo = (f32x4){(float)((t_.x >> 0) & 0xffu), (float)((t_.x >> 8) & 0xffu), (float)((t_.x >> 16) & 0xffu), (float)((t_.x >> 24) & 0xffu)}; \
        hi = (f32x4){(float)((t_.y >> 0) & 0xffu), (float)((t_.y >> 8) & 0xffu), (float)((t_.y >> 16) & 0xffu), (float)((t_.y >> 24) & 0xffu)}; } while (0)
        constexpr size_t GROW = 2048, GHALF = 1024, GBJ = 128; constexpr float GSC = 1.0f / 255.0f;
#elif GATE8
        typedef u32x2 gv_t; const unsigned char* gb_ = (const unsigned char*)GATES + (size_t)row0 * 2048 + col0;
#define EM_LD1(p) (*(const u32x2*)(p))
#define EM_DEC(GW_, lo, hi) do { const gv_t t_ = (GW_); const f32x2 a_ = __builtin_amdgcn_cvt_pk_f32_fp8((int)t_.x, false), b_ = __builtin_amdgcn_cvt_pk_f32_fp8((int)t_.x, true), c_ = __builtin_amdgcn_cvt_pk_f32_fp8((int)t_.y, false), d_ = __builtin_amdgcn_cvt_pk_f32_fp8((int)t_.y, true); \
        lo = (f32x4){a_[0], a_[1], b_[0], b_[1]}; hi = (f32x4){c_[0], c_[1], d_[0], d_[1]}; } while (0)
        constexpr size_t GROW = 2048, GHALF = 1024, GBJ = 128; constexpr float GSC = 1.0f / 256.0f;
#else
        typedef u32x4 gv_t; const bf16_t* gb_ = GATES + (size_t)row0 * 2048 + col0;
#define EM_LD1(p) (*(const u32x4*)(p))
#define EM_DEC(GW_, lo, hi) do { const gv_t t_ = (GW_); lo = (f32x4){bf_lo(t_.x), bf_hi(t_.x), bf_lo(t_.y), bf_hi(t_.y)}; hi = (f32x4){bf_lo(t_.z), bf_hi(t_.z), bf_lo(t_.w), bf_hi(t_.w)}; } while (0)
        constexpr size_t GROW = 2048, GHALF = 1024, GBJ = 128; constexpr float GSC = 1.0f;
#endif
        gv_t buf[3][4];
#define EM_LD(g) do { const auto* p_ = gb_ + (size_t)(((g) >> 2) * 128 + ((g) & 3) * 16) * GROW; \
        _Pragma("unroll") for (int bj = 0; bj < 2; ++bj) { buf[(g) % 3][2 * bj] = EM_LD1(p_ + GHALF + bj * GBJ); if (p0_) buf[(g) % 3][2 * bj + 1] = EM_LD1(p_ + bj * GBJ); } } while (0)
        EM_LD(0); EM_LD(1); EM_LD(2);
#pragma unroll
        for (int g = 0; g < 8; ++g) { const int ai = g >> 2, m = g & 3; const size_t row = (size_t)(row0 + ai * 128 + m * 16);
            __builtin_amdgcn_sched_barrier(0);
#pragma unroll
            for (int bj = 0; bj < 2; ++bj) { f32x4 p0, p1; EM_DEC(buf[g % 3][2 * bj], p0, p1);
                if (p0_) { f32x4 a0, a1; EM_DEC(buf[g % 3][2 * bj + 1], a0, a1);
#pragma unroll
                    for (int e = 0; e < 4; ++e) { acc[ai][bj][m][0][e] *= a0[e] * __builtin_amdgcn_rcpf(p0[e]); acc[ai][bj][m][1][e] *= a1[e] * __builtin_amdgcn_rcpf(p1[e]); }
                } else {
                    const f32x4 v0 = acc[ai][bj][m][0] * (p0 * GSC), v1 = acc[ai][bj][m][1] * (p1 * GSC);
                    u32x4 w; w.x = cvt_pk_bf16(v0[0], v0[1]); w.y = cvt_pk_bf16(v0[2], v0[3]); w.z = cvt_pk_bf16(v1[0], v1[1]); w.w = cvt_pk_bf16(v1[2], v1[3]);
                    *(u32x4*)(MIX + row * 1024 + col0 + bj * 128) = w; } }
            __builtin_amdgcn_sched_barrier(0);
            if (g + 3 < 8) EM_LD(g + 3);
        }
#undef EM_LD
#undef EM_LD1
#undef EM_DEC
    }
};
struct EpiRes {
    static constexpr bool PERM = true;
    __device__ __forceinline__ void init(f32x4 (&acc)[2][2][4][2], const Unit&, int, int) const {
#pragma unroll
        for (int a = 0; a < 2; ++a)
#pragma unroll
            for (int b = 0; b < 2; ++b)
#pragma unroll
                for (int m = 0; m < 4; ++m)
#pragma unroll
                    for (int n = 0; n < 2; ++n) acc[a][b][m][n] = (f32x4){0.f, 0.f, 0.f, 0.f};
    }
    const float* base; bf16_t* out;
    __device__ __forceinline__ void operator()(const f32x4 (&acc)[2][2][4][2], const Unit& u, int wr, int wc, int fr, int fq) const {
        const int row0 = u.pm * 256 + wr * 64 + fr, col0 = u.pn * 256 + wc * 32 + 8 * fq;
        const size_t off0 = (size_t)row0 * DM + col0;
        f32x4 buf[3][4];
#define ER_LD(g) do { const float* p_ = base + off0 + (size_t)(((g) >> 2) * 128 + ((g) & 3) * 16) * DM; \
        _Pragma("unroll") for (int q = 0; q < 4; ++q) buf[(g) % 3][q] = *(const f32x4*)(p_ + (q >> 1) * 128 + (q & 1) * 4); } while (0)
        ER_LD(0); ER_LD(1); ER_LD(2);
#pragma unroll
        for (int g = 0; g < 8; ++g) { const int ai = g >> 2, m = g & 3;
            __builtin_amdgcn_sched_barrier(0);
            bf16_t* o_ = out + off0 + (size_t)(ai * 128 + m * 16) * DM;
#pragma unroll
            for (int bj = 0; bj < 2; ++bj) { const f32x4 r0 = buf[g % 3][2 * bj] + acc[ai][bj][m][0], r1 = buf[g % 3][2 * bj + 1] + acc[ai][bj][m][1];
                u32x4 w; w.x = cvt_pk_bf16(r0[0], r0[1]); w.y = cvt_pk_bf16(r0[2], r0[3]); w.z = cvt_pk_bf16(r1[0], r1[1]); w.w = cvt_pk_bf16(r1[2], r1[3]); *(u32x4*)(o_ + bj * 128) = w; }
            __builtin_amdgcn_sched_barrier(0);
            if (g + 3 < 8) ER_LD(g + 3);
        }
#undef ER_LD
    }
};

constexpr int WR_PITCH = 1028;
constexpr int R_WR_OFF = 0, R_PART_OFF = 32 * WR_PITCH * 4, R_SSQ_OFF = R_PART_OFF + 2 * 64 * 33 * 4, R_CNT_OFF = R_SSQ_OFF + 2 * 64 * 4, R_BASE_OFF = R_CNT_OFF + 128, R_RSTD_OFF = R_BASE_OFF + 128, R_END = R_RSTD_OFF + 256;
static_assert(R_END <= TILE_E_OFF, "router LDS map");
__device__ __forceinline__ void p7_router(const Frame& F) {
    const int tid_l = tid_local(), lane_l = tid_l & 63; (void)tid_l; (void)lane_l;
    const KArgs a = kargs();
    LAS float* WR = (LAS float*)(F.lds + R_WR_OFF); LAS float* PART = (LAS float*)(F.lds + R_PART_OFF); LAS float* SSQP = (LAS float*)(F.lds + R_SSQ_OFF);
    LAS int* CNT = (LAS int*)(F.lds + R_CNT_OFF); LAS int* BASE = (LAS int*)(F.lds + R_BASE_OFF); LAS float* RSTD_L = (LAS float*)(F.lds + R_RSTD_OFF);
    const int tid = tid_l, lane = lane_l, wave = F.wave;
    const float* wr = a->in[I_WR]; const float* gf = a->in[I_GFFN];
    {
        const f32x4* wr4 = (const f32x4*)wr; f32x4 w[16]; float g[16];
#pragma unroll
        for (int q = 0; q < 16; ++q) { const int idx = tid + 512 * q; w[q] = wr4[idx]; g[q] = gf[idx >> 3]; }
#pragma unroll
        for (int q = 0; q < 16; ++q) { const int idx = tid + 512 * q; const int k = idx >> 3, e0 = (idx & 7) * 4;
#pragma unroll
            for (int j = 0; j < 4; ++j) WR[(e0 + j) * WR_PITCH + k] = w[q][j] * g[q]; }
    }
    if (tid < 32) CNT[tid] = 0;
    __syncthreads();
    int* RE = (int*)(F.ws + WS_ROUTE); int* RP = RE + T * 4; float* RG = (float*)(RP + T * 4); float* RS = RG + T * 4; int* TOK = (int*)(F.ws + WS_TOK); unsigned char* H8 = F.ws + WS_XS2;
    unsigned* gcnt = F.ctl + CW_CNT;
    const bf16_t* X1 = (const bf16_t*)(F.ws + WS_X1B);
    for (int blk = F.vcu; blk < T / 64; blk += F.G) {
        const int tb = blk * 64;
        {
            const int tg = wave & 3, kh = wave >> 2, r = lane & 15, kq = lane >> 4;
            const bf16_t* xp = X1 + (size_t)(tb + 16 * tg + r) * DM + 512 * kh + 4 * kq;
            const LAS float* w0 = WR + (lane & 15) * WR_PITCH + 512 * kh + 4 * kq; const LAS float* w1 = w0 + 16 * WR_PITCH;
            f32x4 acc0 = {0.f, 0.f, 0.f, 0.f}, acc1 = {0.f, 0.f, 0.f, 0.f}; float ss = 0.f;
#pragma unroll 4
            for (int i = 0; i < 32; ++i) {
                const u32x2 xw = *(const u32x2*)(xp + 16 * i); const f32x4 xv = {bf_lo(xw.x), bf_hi(xw.x), bf_lo(xw.y), bf_hi(xw.y)};
                const f32x4 b0 = *(const LAS f32x4*)(w0 + 16 * i), b1 = *(const LAS f32x4*)(w1 + 16 * i);
                ss += (xv[0] * xv[0] + xv[1] * xv[1]) + (xv[2] * xv[2] + xv[3] * xv[3]);
#pragma unroll
                for (int j = 0; j < 4; ++j) { acc0 = __builtin_amdgcn_mfma_f32_16x16x4f32(xv[j], b0[j], acc0, 0, 0, 0); acc1 = __builtin_amdgcn_mfma_f32_16x16x4f32(xv[j], b1[j], acc1, 0, 0, 0); }
            }
            ss += __shfl_xor(ss, 16); ss += __shfl_xor(ss, 32);
            if (kq == 0) SSQP[kh * 64 + 16 * tg + r] = ss;
#pragma unroll
            for (int q = 0; q < 4; ++q) { const int tok = 16 * tg + 4 * kq + q; PART[(kh * 64 + tok) * 33 + (lane & 15)] = acc0[q]; PART[(kh * 64 + tok) * 33 + 16 + (lane & 15)] = acc1[q]; }
        }
        __syncthreads();
        int te[4] = {0, 0, 0, 0}, lp[4] = {0, 0, 0, 0}; float tv[4] = {-3e38f, -3e38f, -3e38f, -3e38f}; float rstd = 0.f;
        if (tid < 64) {
            const float ssq = SSQP[tid] + SSQP[64 + tid]; rstd = 1.0f / sqrtf(ssq * (1.f / DM) + EPS);
            const float* br = a->in[I_BR];
#pragma unroll
            for (int e = 0; e < 32; ++e) {
                float v = (PART[tid * 33 + e] + PART[(64 + tid) * 33 + e]) * rstd + br[e]; int id = e;
#pragma unroll
                for (int s = 0; s < 4; ++s) { const bool gt = v > tv[s]; const float ov = tv[s]; const int oi = te[s]; tv[s] = gt ? v : ov; te[s] = gt ? id : oi; v = gt ? ov : v; id = gt ? oi : id; }
            }
#pragma unroll
            for (int s = 0; s < 4; ++s) lp[s] = __hip_atomic_fetch_add(&CNT[te[s]], 1, __ATOMIC_RELAXED, __HIP_MEMORY_SCOPE_WORKGROUP);
        }
        __syncthreads();
        if (tid < 32) { const int c = CNT[tid]; BASE[tid] = c ? (int)atomicAdd(gcnt + tid, (unsigned)c) : 0; }
        __syncthreads();
        if (tid < 64) {
            const int t = tb + tid;
            const float e1 = __expf(tv[1] - tv[0]), e2 = __expf(tv[2] - tv[0]), e3 = __expf(tv[3] - tv[0]); const float inv = 1.0f / (1.0f + e1 + e2 + e3);
            const float gts[4] = {inv, e1 * inv, e2 * inv, e3 * inv};
#pragma unroll
            for (int s = 0; s < 4; ++s) { const int p = BASE[te[s]] + lp[s]; RE[t * 4 + s] = te[s]; RP[t * 4 + s] = p; RG[t * 4 + s] = gts[s]; TOK[te[s] * 16384 + p] = t; }
            RS[t] = rstd; RSTD_L[tid] = rstd;
        }
        __syncthreads();
        if (tid < 32) CNT[tid] = 0;
        {
            f32x4 g[2][2];
#pragma unroll
            for (int j = 0; j < 2; ++j) { g[j][0] = *(const f32x4*)(gf + 512 * j + 8 * lane); g[j][1] = *(const f32x4*)(gf + 512 * j + 8 * lane + 4); }
#pragma unroll 4
            for (int i = 0; i < 8; ++i) {
                const int t = tb + 8 * wave + i; const float rs = RSTD_L[8 * wave + i];
#pragma unroll
                for (int j = 0; j < 2; ++j) { const u32x4 xw = *(const u32x4*)(X1 + (size_t)t * DM + 512 * j + 8 * lane);
                    const f32x4 v0 = (f32x4){bf_lo(xw.x), bf_hi(xw.x), bf_lo(xw.y), bf_hi(xw.y)} * g[j][0] * rs, v1 = (f32x4){bf_lo(xw.z), bf_hi(xw.z), bf_lo(xw.w), bf_hi(xw.w)} * g[j][1] * rs;
                    *(u32x2*)(H8 + (size_t)t * DM + 512 * j + 8 * lane) = cvt8_fp8(v0, v1, 8.0f); }
            }
        }
        __syncthreads();
    }
}

__device__ __forceinline__ int build_tiles(const Frame& F) {
    const int tid_l = tid_local(), lane_l = tid_l & 63; (void)tid_l; (void)lane_l;
    LAS int* TB = (LAS int*)(F.lds + TILE_E_OFF); LAS int* TE = TB + 64;
    if (tid_l < 64) {
        const int c = (tid_l < NEXP) ? (int)__hip_atomic_load(F.ctl + CW_CNT + tid_l, RLX_AGENT) : 0; const int nt = (c + 255) >> 8;
        int incl = nt;
#pragma unroll
        for (int o = 1; o < 32; o <<= 1) { const int v = __shfl_up(incl, o); if (lane_l >= o) incl += v; }
        if (tid_l < NEXP) TB[tid_l] = incl - nt;
        if (tid_l == NEXP - 1) TB[NEXP] = incl;
    }
    __syncthreads();
    if (tid_l < NEXP) { for (int t = TB[tid_l]; t < TB[tid_l + 1]; ++t) TE[t] = tid_l; }
    __syncthreads();
    return TB[NEXP];
}

__device__ __forceinline__ void p8_dispatch(const Frame& F) {
    const int tid_l = tid_local(), lane_l = tid_l & 63; (void)tid_l; (void)lane_l;
    const KArgs a = kargs();
    (void)build_tiles(F);
    const LAS int* TB = (const LAS int*)(F.lds + TILE_E_OFF);
    const int gw = F.vcu * NWAVES + F.wave, NGW = F.G * NWAVES, lane = lane_l;
    const int* RE = (const int*)(F.ws + WS_ROUTE); const int* RP = RE + T * 4; const float* RS = (const float*)(RP + T * 4) + T * 4; int* SL = (int*)(RS + T);
    const bf16_t* X1 = (const bf16_t*)(F.ws + WS_X1B); const float* gf = a->in[I_GFFN]; unsigned char* XS = F.ws + WS_XS2;
    f32x4 g[2][2];
#pragma unroll
    for (int j = 0; j < 2; ++j) { g[j][0] = *(const f32x4*)(gf + 512 * j + 8 * lane); g[j][1] = *(const f32x4*)(gf + 512 * j + 8 * lane + 4); }
    for (int t = gw; t < T; t += NGW) {
        const float rstd = RS[t];
        u32x2 w[2];
#pragma unroll
        for (int j = 0; j < 2; ++j) { const u32x4 xw = *(const u32x4*)(X1 + (size_t)t * DM + 512 * j + 8 * lane);
            const f32x4 v0 = (f32x4){bf_lo(xw.x), bf_hi(xw.x), bf_lo(xw.y), bf_hi(xw.y)} * g[j][0] * rstd, v1 = (f32x4){bf_lo(xw.z), bf_hi(xw.z), bf_lo(xw.w), bf_hi(xw.w)} * g[j][1] * rstd;
            w[j] = cvt8_fp8(v0, v1, 8.0f); }
#pragma unroll
        for (int s = 0; s < 4; ++s) { const int e = RE[t * 4 + s], slot = TB[e] * 256 + RP[t * 4 + s];
            if (lane == 0) SL[t * 4 + s] = slot;
            unsigned char* dst = XS + (size_t)slot * DM + 8 * lane;
            *(u32x2*)dst = w[0]; *(u32x2*)(dst + 512) = w[1]; }
    }
}

template <bool GATHER_A> struct MoeOrderT {
    int G, c, ntn_shift, total; const LAS int* TE; unsigned A, Bw, bexp, btile; int xbase, xcount;
    __device__ __forceinline__ void init_xcd(const LAS int* TB) {
        if (G == 256) { const int x = c >> 5; xbase = __builtin_amdgcn_readfirstlane(TB[4 * x]); xcount = (__builtin_amdgcn_readfirstlane(TB[4 * x + 4]) - xbase) << ntn_shift; } else { xbase = -1; xcount = 0; }
    }
    __device__ __forceinline__ bool next(int i, Unit& u) const {
        if (xbase >= 0) { const int L = i * 32 + (c & 31); if (L >= xcount) return false;
            u.pm = xbase + (L >> ntn_shift); u.pn = L & ((1 << ntn_shift) - 1); u.aux = __builtin_amdgcn_readfirstlane(TE[u.pm]); return true; }
        const int L = i * G + c; if (L >= total) return false;
        u.pm = L >> ntn_shift; u.pn = L & ((1 << ntn_shift) - 1); u.aux = __builtin_amdgcn_readfirstlane(TE[u.pm]); return true;
    }
#ifndef MOE_PREFETCH
#define MOE_PREFETCH 0
#endif
    __device__ __forceinline__ void prefetch(const Unit& u, const __amdgpu_buffer_rsrc_t rsrc, LAS unsigned char* lds, int wid, int lane) const {
        if (!MOE_PREFETCH) return;
        const unsigned ln_ = (unsigned)(tid_local() & 63);
        const unsigned line = (unsigned)(u.pn & 3) * 512u + (unsigned)wid * 64u + ln_;
        const unsigned voff = (line >> 3) * 1024u + (line & 7u) * 128u;
        const unsigned dst = (unsigned)__builtin_amdgcn_readfirstlane((int)(unsigned)(unsigned long)(lds + 131072 + wid * 256));
        const unsigned soff = a_off(u);
        asm volatile("s_nop 4\n\ts_mov_b32 m0, %0\n\ts_nop 0\n\tbuffer_load_dword %1, %2, %3 offen lds" :: "s"(dst), "v"(voff), "s"(rsrc), "s"(soff) : "m0", "memory");
    }
    unsigned TOK;
    __device__ __forceinline__ unsigned tok_off(const Unit& u) const { return TOK + ((unsigned)u.aux * 16384u + (unsigned)(u.pm - __builtin_amdgcn_readfirstlane(TE[u.aux - 64])) * 256u) * 4u; }
    __device__ __forceinline__ unsigned a_off(const Unit& u) const { return GATHER_A ? A : A + (unsigned)u.pm * (256 * 1024); }
    __device__ __forceinline__ unsigned b_off(const Unit& u) const { return Bw + (unsigned)u.aux * bexp + (unsigned)u.pn * btile; }
};
using MoeOrder = MoeOrderT<false>; using MoeGather = MoeOrderT<true>;
struct EpiSwiglu {
    static constexpr bool PERM = true;
    unsigned char* ACT; const float* bgu;
    __device__ __forceinline__ void init(f32x4 (&acc)[2][2][4][2], const Unit& u, int wc, int fq) const {
        const float* bb = bgu + (size_t)u.aux * 2048 + u.pn * 128 + wc * 32 + 8 * fq;
        const f32x4 g0 = *(const f32x4*)(bb), g1 = *(const f32x4*)(bb + 4), u0 = *(const f32x4*)(bb + 1024), u1 = *(const f32x4*)(bb + 1028);
#pragma unroll
        for (int a = 0; a < 2; ++a)
#pragma unroll
            for (int m = 0; m < 4; ++m) { acc[a][0][m][0] = g0; acc[a][0][m][1] = g1; acc[a][1][m][0] = u0; acc[a][1][m][1] = u1; }
    }
    __device__ __forceinline__ void operator()(const f32x4 (&acc)[2][2][4][2], const Unit& u, int wr, int wc, int fr, int fq) const {
        const int row0 = u.pm * 256 + wr * 64 + fr, j0 = u.pn * 128 + wc * 32 + 8 * fq;
        unsigned char* dst0 = ACT + (size_t)row0 * DEXP + j0;
#pragma unroll
        for (int ai = 0; ai < 2; ++ai)
#pragma unroll
            for (int m = 0; m < 4; ++m) {
                int w2[2];
#pragma unroll
                for (int n = 0; n < 2; ++n) {
                    const f32x4 g = acc[ai][0][m][n], up = acc[ai][1][m][n];
                    f32x2 r[2];
#pragma unroll
                    for (int h = 0; h < 2; ++h) {
                        const f32x2 gg = {__builtin_amdgcn_fmed3f(g[2 * h], -3.0e38f, 7.0f), __builtin_amdgcn_fmed3f(g[2 * h + 1], -3.0e38f, 7.0f)};
                        const f32x2 uu = {__builtin_amdgcn_fmed3f(up[2 * h], -7.0f, 7.0f), __builtin_amdgcn_fmed3f(up[2 * h + 1], -7.0f, 7.0f)};
                        const f32x2 x = gg * (f32x2){-1.702f * 1.4426950408889634f, -1.702f * 1.4426950408889634f};
                        const f32x2 den = (f32x2){__builtin_amdgcn_exp2f(x[0]), __builtin_amdgcn_exp2f(x[1])} + (f32x2){1.0f, 1.0f};
                        const f32x2 rc = {__builtin_amdgcn_rcpf(den[0]), __builtin_amdgcn_rcpf(den[1])};
                        r[h] = (uu * (f32x2){8.0f, 8.0f} + (f32x2){8.0f, 8.0f}) * gg * rc; }
                    int w = __builtin_amdgcn_cvt_pk_fp8_f32(r[0][0], r[0][1], 0, false); w2[n] = __builtin_amdgcn_cvt_pk_fp8_f32(r[1][0], r[1][1], w, true);
                }
                u32x2 o; o.x = (unsigned)w2[0]; o.y = (unsigned)w2[1];
                *(u32x2*)(dst0 + (size_t)(ai * 128 + m * 16) * DEXP) = o;
            }
    }
};
struct EpiDown {
    static constexpr bool PERM = true;
    unsigned char* Y; const float* bd;
    __device__ __forceinline__ void init(f32x4 (&acc)[2][2][4][2], const Unit& u, int wc, int fq) const {
        const float* bb = bd + (size_t)u.aux * DM + u.pn * 256 + wc * 32 + 8 * fq;
        const f32x4 b00 = *(const f32x4*)(bb), b01 = *(const f32x4*)(bb + 4), b10 = *(const f32x4*)(bb + 128), b11 = *(const f32x4*)(bb + 132);
#pragma unroll
        for (int a = 0; a < 2; ++a)
#pragma unroll
            for (int m = 0; m < 4; ++m) { acc[a][0][m][0] = b00; acc[a][0][m][1] = b01; acc[a][1][m][0] = b10; acc[a][1][m][1] = b11; }
    }
    __device__ __forceinline__ void operator()(const f32x4 (&acc)[2][2][4][2], const Unit& u, int wr, int wc, int fr, int fq) const {
        const int row0 = u.pm * 256 + wr * 64 + fr, col0 = u.pn * 256 + wc * 32 + 8 * fq;
#pragma unroll
        for (int ai = 0; ai < 2; ++ai)
#pragma unroll
            for (int m = 0; m < 4; ++m) { unsigned char* rowp = Y + (size_t)(row0 + ai * 128 + m * 16) * DM + col0;
#pragma unroll
                for (int bj = 0; bj < 2; ++bj) *(u32x2*)(rowp + bj * 128) = cvt8_fp8(acc[ai][bj][m][0], acc[ai][bj][m][1], 8.0f); }
    }
};

__device__ __forceinline__ void p11_combine(const Frame& F) {
    const int tid_l = tid_local(), lane_l = tid_l & 63; (void)tid_l; (void)lane_l;
    const KArgs a = kargs();
    const int gw = F.vcu * NWAVES + F.wave, NGW = F.G * NWAVES, lane = lane_l;
    (void)build_tiles(F); const LAS int* TB = (const LAS int*)(F.lds + TILE_E_OFF);
    const int* RE = (const int*)(F.ws + WS_ROUTE); const int* RP = RE + T * 4; const float* RG = (const float*)(RE + T * 8);
    const unsigned char* Y = F.ws + WS_XS; bf16_t* HP = (bf16_t*)(F.ws + WS_HN); const bf16_t* X1 = (const bf16_t*)(F.ws + WS_X1B); bf16_t* X2 = (bf16_t*)(F.ws + WS_X2B); const float* gp = a->in[I_GPLE];
    f32x4 g[2][2];
#pragma unroll
    for (int j = 0; j < 2; ++j) { g[j][0] = *(const f32x4*)(gp + 512 * j + 8 * lane); g[j][1] = *(const f32x4*)(gp + 512 * j + 8 * lane + 4); }
    for (int t = gw; t < T; t += NGW) {
        f32x4 v[2][2];
#pragma unroll
        for (int j = 0; j < 2; ++j) { const u32x4 xw = *(const u32x4*)(X1 + (size_t)t * DM + 512 * j + 8 * lane); v[j][0] = (f32x4){bf_lo(xw.x), bf_hi(xw.x), bf_lo(xw.y), bf_hi(xw.y)}; v[j][1] = (f32x4){bf_lo(xw.z), bf_hi(xw.z), bf_lo(xw.w), bf_hi(xw.w)}; }
#pragma unroll
        for (int s = 0; s < 4; ++s) { const int slot = TB[RE[t * 4 + s]] * 256 + RP[t * 4 + s]; const float gt = RG[t * 4 + s] * 0.125f;
#pragma unroll
            for (int j = 0; j < 2; ++j) { const u32x2 y = *(const u32x2*)(Y + (size_t)slot * DM + 512 * j + 8 * lane);
                const f32x2 a0 = __builtin_amdgcn_cvt_pk_f32_fp8((int)y.x, false), a1 = __builtin_amdgcn_cvt_pk_f32_fp8((int)y.x, true), b0 = __builtin_amdgcn_cvt_pk_f32_fp8((int)y.y, false), b1 = __builtin_amdgcn_cvt_pk_f32_fp8((int)y.y, true);
                v[j][0] += (f32x4){a0[0], a0[1], a1[0], a1[1]} * gt; v[j][1] += (f32x4){b0[0], b0[1], b1[0], b1[1]} * gt; } }
        float ss = 0.f;
#pragma unroll
        for (int j = 0; j < 2; ++j)
#pragma unroll
            for (int n = 0; n < 2; ++n) { const f32x4 q = v[j][n]; ss += (q[0] * q[0] + q[1] * q[1]) + (q[2] * q[2] + q[3] * q[3]); u32x2 w; w.x = cvt_pk_bf16(q[0], q[1]); w.y = cvt_pk_bf16(q[2], q[3]); *(u32x2*)(X2 + (size_t)t * DM + 512 * j + 8 * lane + 4 * n) = w; }
        const float rstd = 1.0f / sqrtf(wave_sum(ss) * (1.f / DM) + EPS);
#pragma unroll
        for (int j = 0; j < 2; ++j) { const f32x4 q0 = v[j][0] * g[j][0] * rstd, q1 = v[j][1] * g[j][1] * rstd;
            if (PLE_FP8) { *(u32x2*)((unsigned char*)HP + (size_t)t * DM + 512 * j + 8 * lane) = cvt8_fp8(q0, q1, 8.0f); }
            else { u32x4 w; w.x = cvt_pk_bf16(q0[0], q0[1]); w.y = cvt_pk_bf16(q0[2], q0[3]); w.z = cvt_pk_bf16(q1[0], q1[1]); w.w = cvt_pk_bf16(q1[2], q1[3]);
                *(u32x4*)(HP + (size_t)t * DM + 512 * j + 8 * lane) = w; } }
    }
}
struct EpiPle {
    static constexpr bool PERM = true;
    __device__ __forceinline__ void init(f32x4 (&acc)[2][2][4][2], const Unit&, int, int) const {
#pragma unroll
        for (int a = 0; a < 2; ++a)
#pragma unroll
            for (int b = 0; b < 2; ++b)
#pragma unroll
                for (int m = 0; m < 4; ++m)
#pragma unroll
                    for (int n = 0; n < 2; ++n) acc[a][b][m][n] = (f32x4){0.f, 0.f, 0.f, 0.f};
    }
    float* out; const bf16_t* E; const bf16_t* X2;
    __device__ __forceinline__ void operator()(const f32x4 (&acc)[2][2][4][2], const Unit& u, int wr, int wc, int fr, int fq) const {
        const int row0 = u.pm * 256 + wr * 64 + fr, col0 = u.pn * 256 + wc * 32 + 8 * fq;
        const size_t off0 = (size_t)row0 * DM + col0;
        u32x4 eb[3][2], xb[3][2];
#define EP_LD(g) do { const size_t o_ = off0 + (size_t)(((g) >> 2) * 128 + ((g) & 3) * 16) * DM; \
        _Pragma("unroll") for (int bj = 0; bj < 2; ++bj) { eb[(g) % 3][bj] = *(const u32x4*)(E + o_ + bj * 128); xb[(g) % 3][bj] = *(const u32x4*)(X2 + o_ + bj * 128); } } while (0)
        EP_LD(0); EP_LD(1); EP_LD(2);
#pragma unroll
        for (int g = 0; g < 8; ++g) { const int ai = g >> 2, m = g & 3; const size_t off = off0 + (size_t)(ai * 128 + m * 16) * DM;
            __builtin_amdgcn_sched_barrier(0);
#pragma unroll
            for (int bj = 0; bj < 2; ++bj) { const u32x4 ev = eb[g % 3][bj], xw = xb[g % 3][bj]; const f32x4 a0 = acc[ai][bj][m][0], a1 = acc[ai][bj][m][1];
                f32x4 r0 = {bf_lo(xw.x), bf_hi(xw.x), bf_lo(xw.y), bf_hi(xw.y)}, r1 = {bf_lo(xw.z), bf_hi(xw.z), bf_lo(xw.w), bf_hi(xw.w)};
                r0[0] += fast_sigmoid(a0[0]) * bf_lo(ev.x); r0[1] += fast_sigmoid(a0[1]) * bf_hi(ev.x); r0[2] += fast_sigmoid(a0[2]) * bf_lo(ev.y); r0[3] += fast_sigmoid(a0[3]) * bf_hi(ev.y);
                r1[0] += fast_sigmoid(a1[0]) * bf_lo(ev.z); r1[1] += fast_sigmoid(a1[1]) * bf_hi(ev.z); r1[2] += fast_sigmoid(a1[2]) * bf_lo(ev.w); r1[3] += fast_sigmoid(a1[3]) * bf_hi(ev.w);
                *(f32x4*)(out + off + bj * 128) = r0; *(f32x4*)(out + off + bj * 128 + 4) = r1; }
            __builtin_amdgcn_sched_barrier(0);
            if (g + 3 < 8) EP_LD(g + 3);
        }
#undef EP_LD
    }
};

constexpr int N_PHASES = 13;
__global__ void __launch_bounds__(NWAVES * 64, 2) fwd_kernel(Args args) {
    extern __shared__ __attribute__((aligned(16))) unsigned char lds_raw[];
    Frame F;
    F.lds = (LAS unsigned char*)lds_raw; F.MISC = (volatile LAS unsigned*)(F.lds + MISC_OFF);
    F.wave = __builtin_amdgcn_readfirstlane(threadIdx.x >> 6);
    F.G = gridDim.x; { const int bx = blockIdx.x; F.vcu = (F.G % 8 == 0) ? (bx % 8) * (F.G / 8) + bx / 8 : bx; }
    { const KArgs ka = kargs(); F.out = ka->out; F.ws = ka->ws; F.ctl = (unsigned*)(ka->ws + WS_CTL); }
    { const int t0_ = tid_local(); if (t0_ < 32) F.MISC[t0_] = 0u; }
    __syncthreads();
    int lo, hi; { const KArgs ka = kargs(); lo = ka->ph_lo; hi = ka->ph_hi; }
    const bool multi = (hi - lo) > 1;
    XcdBarrier bar; bar.bar = F.ctl + CW_BAR; bar.x = 0; bar.st = nullptr;
    if (multi) bar = xcd_barrier_post(F.ctl + CW_BAR, F.MISC);
#ifndef PH_MASK
#define PH_MASK 0x1fff
#endif
#define IN(k) ((((PH_MASK) >> (k)) & 1) && lo <= (k) && (k) < hi)
#define SEAM(k) do { if (IN(k) && IN((k) + 1)) xcd_barrier(bar); } while (0)
    unsigned char* ws = F.ws;
    LAS unsigned char* ring = F.lds;
    const __amdgpu_buffer_rsrc_t rsrc = __builtin_amdgcn_make_buffer_rsrc((void*)ws, 0, (int)WS_END, 0x00020000);

    if (IN(0)) { p0_prologue(F); } SEAM(0);

    if (IN(1)) {
        if (GATES_FP8 && !P1_FP8) {
          { DenseOrder S; S.init(64, 8, F.G, (int)blockIdx.x, WS_HN8, 512, WS_WIN8 + (size_t)1024 * 1024, 512);
            EpiProj E{(bf16_t*)(ws + WS_PROJ), (bf16_t*)(ws + WS_GATES), 4};
            pg8::gemm_phase<EpiProj, DenseOrder, true, true, true>(ring, rsrc, pg8::Shape{1024, 1024, 1024, 0x7c7c7c7c, 0x7c7c7c7c}, S, E); }
          { DenseOrder S; S.init(64, 4, F.G, (int)blockIdx.x, WS_HN, 1024, WS_WIN, 1024);
            EpiProj E{(bf16_t*)(ws + WS_PROJ), (bf16_t*)(ws + WS_GATES), 0};
            pg8::gemm_phase<EpiProj, DenseOrder, true, true>(ring, rsrc, pg8::Shape{2048, 2048, 2048, 0, 0}, S, E); }
        } else
        { DenseOrder S; S.init(64, 12, F.G, (int)blockIdx.x, WS_HN, P1_FP8 ? 512 : 1024, WS_WIN, P1_FP8 ? 512 : 1024);
          EpiProj E{(bf16_t*)(ws + WS_PROJ), (bf16_t*)(ws + WS_GATES), 0};
          if (P1_FP8) pg8::gemm_phase<EpiProj, DenseOrder, true, true, true>(ring, rsrc, pg8::Shape{1024, 1024, 1024, 0x7c7c7c7c, 0x7c7c7c7c}, S, E);
          else pg8::gemm_phase<EpiProj, DenseOrder, true, true>(ring, rsrc, pg8::Shape{2048, 2048, 2048, 0, 0}, S, E, GP_AT(1)); }
        { DenseOrder S; S.init(64, 4, F.G, (int)blockIdx.x, WS_PB, 256, WS_WPLE, 256);
          EpiBf16 E{(bf16_t*)(ws + WS_E), 1024};
          pg8::gemm_phase<EpiBf16, DenseOrder, true, true>(ring, rsrc, pg8::Shape{512, 512, 512, 0, 0}, S, E); }
    } SEAM(1);

    if (IN(2)) { p2_rows(F); } SEAM(2);

    if (IN(3)) {
#ifndef P3M
#define P3M 7
#endif
        if (P3M & 1) { DenseOrder S; S.init(64, 4, F.G, (int)blockIdx.x, WS_A2 + 512, 512, WS_WKV, 256);
          EpiKV E{(bf16_t*)(ws + WS_K), (bf16_t*)(ws + WS_V), kargs()->in[I_GKNOPE]};
          pg8::gemm_phase<EpiKV, DenseOrder, true, true>(ring, rsrc, pg8::Shape{512, 1024, 512, 0, 0}, S, E); }
        if (P3M & 2) { DenseOrder S; S.init(64, 3, F.G, (int)blockIdx.x, WS_A2, 512, WS_WQ, 256);
          EpiQ E{(bf16_t*)(ws + WS_Q), (float*)(ws + WS_SSQ), (const float*)(ws + WS_COS), (const float*)(ws + WS_SIN), kargs()->in[I_GQHEAD]};
          pg8::gemm_phase<EpiQ, DenseOrder, true, true>(ring, rsrc, pg8::Shape{512, 1024, 512, 0, 0}, S, E); }
        if (P3M & 4) { DenseOrder S; S.init(64, 2, F.G, (int)blockIdx.x, WS_POOLED, 512, WS_WPOOL, 256, 512);
          EpiBf16 E{(bf16_t*)(ws + WS_MIXED), 512};
          pg8::gemm_phase<EpiBf16, DenseOrder, true, true>(ring, rsrc, pg8::Shape{512, 1024, 512, 0, 0}, S, E); }
    } SEAM(3);

    if (IN(4)) {
        u32x4 srd; { const unsigned long wb = (unsigned long)ws; srd.x = (unsigned)__builtin_amdgcn_readfirstlane((int)(unsigned)wb); srd.y = (unsigned)__builtin_amdgcn_readfirstlane((int)(unsigned)(wb >> 32)); srd.z = (unsigned)WS_END; srd.w = 0x00020000u; }
        att::ConvState CV; CV.next = __builtin_amdgcn_readfirstlane(F.vcu * NWAVES + F.wave); CV.end = CONV_IN_ATTN ? att::CV_ITEMS : 0; CV.cur = -1;
        bool fast;
        { const int lane = tid_local() & 63; const float* gqh = kargs()->in[I_GQHEAD]; const float* gkn = kargs()->in[I_GKNOPE]; const float* gkr = kargs()->in[I_GKROPE];
          float a = fabsf(gqh[lane]); if (lane < 32) a = fmaxf(a, fabsf(gqh[64 + lane])); float bn = fabsf(gkn[lane]); float br = (lane < 32) ? fabsf(gkr[lane]) : 0.f;
#pragma unroll
          for (int o = 1; o < 64; o <<= 1) { a = fmaxf(a, __shfl_xor(a, o)); bn = fmaxf(bn, __shfl_xor(bn, o)); br = fmaxf(br, __shfl_xor(br, o)); }
          const float Mb = 1.4426950408889634f * 1.01f * a * sqrtf(64.f * bn * bn + 32.f * br * br);
          fast = __builtin_amdgcn_readfirstlane(Mb <= 60.0f ? 1 : 0) != 0; }
        for (int it = F.vcu; it < 256; it += F.G) {
            const int bh = it >> 3, pr = it & 7;
            att::attn_unit(ring, srd, CV, ws, bh, 15 - pr, (const bf16_t*)(ws + WS_Q), (unsigned)WS_K, (unsigned)WS_V, (const float*)(ws + WS_SSQ), (bf16_t*)(ws + WS_ATT), fast);
            att::attn_unit(ring, srd, CV, ws, bh, pr, (const bf16_t*)(ws + WS_Q), (unsigned)WS_K, (unsigned)WS_V, (const float*)(ws + WS_SSQ), (bf16_t*)(ws + WS_ATT), fast);
        }
        { const LAS float* cb = (const LAS float*)(F.lds + att::CONV_OFF + F.wave * att::CONV_BYTES);
          const unsigned cbaddr = (unsigned)__builtin_amdgcn_readfirstlane((int)(unsigned)(unsigned long)(F.lds + att::CONV_OFF + F.wave * att::CONV_BYTES));
          const int lane_l = tid_local() & 63;
          while (CV.cur >= 0 || CV.next < CV.end) {
            if (CV.cur >= 0) { asm volatile("s_waitcnt vmcnt(0)" ::: "memory"); const att::ConvItem I = att::cv_setup(CV.cur, kargs()->in[I_WGU], kargs()->in[I_WD], ws + WS_WGU, ws + WS_WD); att::cv_out(I, cb, lane_l); }
            if (CV.next < CV.end) { const att::ConvItem I = att::cv_setup(CV.next, kargs()->in[I_WGU], kargs()->in[I_WD], ws + WS_WGU, ws + WS_WD); asm volatile("s_waitcnt lgkmcnt(0)" ::: "memory"); att::cv_dma(I, cbaddr, lane_l); CV.cur = CV.next; CV.next += 2048; } else CV.cur = -1;
          } }
    } SEAM(4);

    if (IN(5)) {
        MixOrder S{F.G, F.vcu, (unsigned)WS_ATT, (unsigned)WS_MIXED, (unsigned)WS_WAO, (unsigned)WS_WPO};
        EpiMix E{(bf16_t*)(ws + WS_MIX), (const bf16_t*)(ws + WS_GATES)};
        pg8::gemm_phase<EpiMix, MixOrder, true, true>(ring, rsrc, pg8::Shape{1024, 1024, 1024, 0, 0}, S, E, GP_AT(5));
    } SEAM(5);

    if (IN(6)) {
        DenseOrder S; S.init(64, 4, F.G, (int)blockIdx.x, WS_MIX, 1024, WS_WO, 1024);
        EpiRes E{kargs()->in[I_X], (bf16_t*)(ws + WS_X1B)};
        pg8::gemm_phase<EpiRes, DenseOrder, true, true>(ring, rsrc, pg8::Shape{2048, 2048, 2048, 0, 0}, S, E, GP_AT(6));
    } SEAM(6);

    if (IN(7)) { p7_router(F); } SEAM(7);


    if (IN(9)) {
        const int TM = build_tiles(F);
        MoeGather S{F.G, F.vcu, 3, TM * 8, (const LAS int*)(F.lds + TILE_E_OFF) + 64, (unsigned)WS_XS2, (unsigned)WS_WGU, 2048u * 1024u, 256u * 1024u, 0, 0, (unsigned)WS_TOK}; S.init_xcd((const LAS int*)(F.lds + TILE_E_OFF));
        EpiSwiglu E{ws + WS_ACT, kargs()->in[I_BGU]};
        pg8::gemm_phase<EpiSwiglu, MoeGather, true, true, true, true>(ring, rsrc, pg8::Shape{1024, 1024, 1024, 0x7c7c7c7c, 0x7c7c7c7c}, S, E, GP_AT(9));
    } SEAM(9);

    if (IN(10)) {
        const int TM = build_tiles(F);
        MoeOrder S{F.G, F.vcu, 2, TM * 4, (const LAS int*)(F.lds + TILE_E_OFF) + 64, (unsigned)WS_ACT, (unsigned)WS_WD, 1024u * 1024u, 256u * 1024u, 0, 0}; S.init_xcd((const LAS int*)(F.lds + TILE_E_OFF));
        EpiDown E{ws + WS_XS, kargs()->in[I_BD]};
        pg8::gemm_phase<EpiDown, MoeOrder, true, true, true>(ring, rsrc, pg8::Shape{1024, 1024, 1024, 0x7c7c7c7c, 0x7c7c7c7c}, S, E, GP_AT(10));
    } SEAM(10);

    if (IN(11)) { p11_combine(F); } SEAM(11);

    if (IN(12)) {
        DenseOrder S; S.init(64, 4, F.G, (int)blockIdx.x, WS_HN, PLE_FP8 ? 512 : 1024, WS_WPG, PLE_FP8 ? 512 : 1024);
        EpiPle E{F.out, (const bf16_t*)(ws + WS_E), (const bf16_t*)(ws + WS_X2B)};
        if (PLE_FP8) pg8::gemm_phase<EpiPle, DenseOrder, true, true, true>(ring, rsrc, pg8::Shape{1024, 1024, 1024, 0x7c7c7c7c, 0x7c7c7c7c}, S, E, GP_AT(12));
        else pg8::gemm_phase<EpiPle, DenseOrder, true, true>(ring, rsrc, pg8::Shape{2048, 2048, 2048, 0, 0}, S, E, GP_AT(12));
    }
#ifdef ATT_PROBE
    if (blockIdx.x == 17 && tid_local() == 0) { const unsigned long long* ap = (const unsigned long long*)(ws + WS_CTL + 65536 + 64); const unsigned long long wait = (ap[0] / ap[1]) * 10; const unsigned long long r0 = __builtin_amdgcn_s_memrealtime(); while (__builtin_amdgcn_s_memrealtime() - r0 < wait) __builtin_amdgcn_s_sleep(8); }
#endif
#ifdef ATT_PROBE2
    if (blockIdx.x == 17 && tid_local() == 0) { const unsigned long long* ap = (const unsigned long long*)(ws + WS_CTL + 65536 + 128); const unsigned long long wait = (ap[ATT_PROBE2 - 1] / ap[3]) * 10; const unsigned long long r0 = __builtin_amdgcn_s_memrealtime(); while (__builtin_amdgcn_s_memrealtime() - r0 < wait) __builtin_amdgcn_s_sleep(8); }
#endif
#ifdef BAR_PROBE
    for (int i_ = 0; i_ < 20; ++i_) xcd_barrier(bar);
#endif
#ifdef GP_PROBE
    if (blockIdx.x == GP_BLOCK && tid_local() == 0) {
        unsigned long long* gp = (unsigned long long*)(ws + WS_CTL + 65536);
        const unsigned long long cyc = gp[0], tiles = gp[1], pc = gp[2], pr = gp[3], units = gp[4];
        unsigned long long wait = 0;
        if (GP_METRIC == 0) wait = (cyc / tiles) * 10;
        if (GP_METRIC == 1) wait = (pc * 100 / pr) * 10;
        if (GP_METRIC == 2) wait = ((pc - cyc) / units);
        const unsigned long long r0 = __builtin_amdgcn_s_memrealtime();
        while (__builtin_amdgcn_s_memrealtime() - r0 < wait) __builtin_amdgcn_s_sleep(8);
    }
#endif
#undef IN
#undef SEAM
}

extern "C" void kernel_launch(void* const* d_in, const int* in_sizes, int n_in, void* d_out, int out_size, void* d_ws, size_t ws_size, hipStream_t stream) {
    static int grid = 0;
    if (grid == 0) {
        if (n_in != 27 || out_size != T * DM || ws_size < WS_END) { fprintf(stderr, "kernel_launch: unexpected shapes (n_in %d, out %d, ws %zu)\n", n_in, out_size, ws_size); grid = -1; return; }
        int dev = 0, cus = 0;
        if (hipGetDevice(&dev) != hipSuccess || hipDeviceGetAttribute(&cus, hipDeviceAttributeMultiprocessorCount, dev) != hipSuccess) { grid = -1; return; }
        if (hipFuncSetAttribute((const void*)fwd_kernel, hipFuncAttributeMaxDynamicSharedMemorySize, LDS_BYTES) != hipSuccess) { fprintf(stderr, "kernel_launch: hipFuncSetAttribute failed\n"); grid = -1; return; }
        int per_cu = 0;
        if (hipOccupancyMaxActiveBlocksPerMultiprocessor(&per_cu, (const void*)fwd_kernel, NWAVES * 64, LDS_BYTES) != hipSuccess || per_cu < 1) fprintf(stderr, "kernel_launch: occupancy query says %d\n", per_cu);
        (void)hipGetLastError();
        grid = cus;
    }
    if (grid < 0) return;
    (void)hipMemsetAsync((char*)d_ws + WS_CTL, 0, CTL_ZERO_BYTES, stream);
    Args a{};
    for (int i = 0; i < 27; ++i) a.in[i] = (const float*)d_in[i];
    a.out = (float*)d_out; a.ws = (unsigned char*)d_ws;
#ifndef DUP_PHASE
    a.ph_lo = 0; a.ph_hi = N_PHASES; hipLaunchKernelGGL(fwd_kernel, dim3(grid), dim3(NWAVES * 64), LDS_BYTES, stream, a);
#else
    a.ph_lo = 0; a.ph_hi = DUP_PHASE + 1; hipLaunchKernelGGL(fwd_kernel, dim3(grid), dim3(NWAVES * 64), LDS_BYTES, stream, a);
    (void)hipMemsetAsync((char*)d_ws + WS_CTL + CW_BAR * 4, 0, XCD_BAR_WORDS * 4, stream);
    a.ph_lo = DUP_PHASE; a.ph_hi = N_PHASES; hipLaunchKernelGGL(fwd_kernel, dim3(grid), dim3(NWAVES * 64), LDS_BYTES, stream, a);
#endif
}
```

```cpp
#include <hip/hip_runtime.h>
#ifndef GATE8
#define GATE8 2
#endif
#include <cstdio>
#include <cstdint>
#include <type_traits>

#define LAS __attribute__((address_space(3)))
#define GAS __attribute__((address_space(1)))
typedef unsigned short bf16_t;
typedef short bf16x8 __attribute__((ext_vector_type(8)));
typedef short s16x4 __attribute__((ext_vector_type(4)));
typedef float f32x4 __attribute__((ext_vector_type(4)));
typedef float f32x2 __attribute__((ext_vector_type(2)));
typedef float f32x16 __attribute__((ext_vector_type(16)));
typedef unsigned u32x4 __attribute__((ext_vector_type(4)));
typedef unsigned u32x2 __attribute__((ext_vector_type(2)));

constexpr int NB = 4, SEQ = 4096, T = NB * SEQ, DM = 1024, NH = 8, DK = 96, DV = 64;
constexpr int NEXP = 32, TOPK = 4, DEXP = 1024, PLE = 256;
constexpr float EPS = 1e-6f;
constexpr int XS_ROWS = T * TOPK + NEXP * 256;

typedef __bf16 bf16x2_t __attribute__((ext_vector_type(2)));
__device__ __forceinline__ unsigned cvt_pk_bf16(float lo, float hi) { f32x2 v = {lo, hi}; return __builtin_bit_cast(unsigned, __builtin_convertvector(v, bf16x2_t)); }
__device__ __forceinline__ u32x2 cvt8_fp8(const f32x4 a, const f32x4 b, float sc) {
    int w0 = __builtin_amdgcn_cvt_pk_fp8_f32(a[0] * sc, a[1] * sc, 0, false); w0 = __builtin_amdgcn_cvt_pk_fp8_f32(a[2] * sc, a[3] * sc, w0, true);
    int w1 = __builtin_amdgcn_cvt_pk_fp8_f32(b[0] * sc, b[1] * sc, 0, false); w1 = __builtin_amdgcn_cvt_pk_fp8_f32(b[2] * sc, b[3] * sc, w1, true);
    u32x2 r; r.x = (unsigned)w0; r.y = (unsigned)w1; return r;
}
__device__ __forceinline__ float bf_lo(unsigned w) { return __uint_as_float(w << 16); }
__device__ __forceinline__ float bf_hi(unsigned w) { return __uint_as_float(w & 0xffff0000u); }
__device__ __forceinline__ float bf1(bf16_t h) { return __uint_as_float(((unsigned)h) << 16); }
__device__ __forceinline__ float fast_sigmoid(float v) { return __builtin_amdgcn_rcpf(1.0f + __builtin_amdgcn_exp2f(-1.4426950408889634f * v)); }
__device__ __forceinline__ int lane_id() { return (int)__builtin_amdgcn_mbcnt_hi(~0u, __builtin_amdgcn_mbcnt_lo(~0u, 0u)); }
__device__ __forceinline__ int tid_local() { int t = threadIdx.x; asm volatile("" : "+v"(t)); return t; }
__device__ __forceinline__ float wave_sum(float v) {
#pragma unroll
    for (int o = 1; o < 64; o <<= 1) v += __shfl_xor(v, o);
    return v;
}

namespace pg8 {
constexpr int BM = 256, BK = 64, HALF = 128, HTB = HALF * BK * 2, STAGE_BYTES = 8 * HTB;
__host__ __device__ __forceinline__ int lds_byte(int r, int c) { const int st = (r >> 4) * 2 + (c >> 5), rr = r & 15, cc = c & 31, ob = rr * 64 + cc * 2; return st * 1024 + (ob ^ (((ob >> 9) & 1) << 5)); }
__host__ __device__ __forceinline__ void stage_rc(int b, int& R, int& C) { const int st = b / 1024, sb = b % 1024, swz = sb ^ (((sb >> 9) & 1) << 5); R = (st >> 1) * 16 + swz / 64; C = (st & 1) * 32 + (swz % 64) / 2; }
__host__ __device__ __forceinline__ int perm32(int rho) { const int n = rho >> 4, i = rho & 15; return 8 * (i >> 2) + 4 * n + (i & 3); }

struct Unit { int pm, pn, aux; };
template <class T, class = void> struct has_prefetch_init : std::false_type {};
template <class T> struct has_prefetch_init<T, std::void_t<decltype(&T::init_from)>> : std::true_type {};
struct Shape { int Kb, lda, ldb, sw, sa; };
typedef int v8i_t __attribute__((ext_vector_type(8))); typedef int v4i_t __attribute__((ext_vector_type(4)));

template <class Epi, class Sched, bool ALIGN_EPI, bool SP2, bool MX = false, bool GATHER = false>
__device__ __forceinline__ void gemm_phase(LAS unsigned char* lds, const __amdgpu_buffer_rsrc_t rsrc, const Shape g, const Sched& S, const Epi& E, unsigned long long* gp_out = nullptr) {
    const int tid = tid_local(), wid = __builtin_amdgcn_readfirstlane(tid >> 6), lane = tid & 63, wr = wid >> 2, wc = wid & 3, fr = lane & 15, fq = lane >> 4;
    int nt = g.Kb / 128; asm volatile("" : "+s"(nt));
    unsigned voffA, voffB;
    { int R, C; stage_rc(tid * 16, R, C); const int Rb = Epi::PERM ? ((R & ~31) + perm32(R & 31)) : R;
      voffA = GATHER ? (unsigned)(C * 2 + (R << 16)) : (unsigned)(R * g.lda + C * 2); voffB = (unsigned)(Rb * g.ldb + C * 2); }
    const unsigned p2A = 64u * (unsigned)g.lda, p2B = 64u * (unsigned)g.ldb;
    const unsigned kstep = 128u;
    const unsigned hstepA = (unsigned)HALF * g.lda, hstepB = (unsigned)HALF * g.ldb;
    const unsigned ldsw = (unsigned)wid * 1024u;
    const int aoff = lds_byte(wr * 64 + fr, fq * 8), boff = lds_byte(wc * 32 + fr, fq * 8);
#define PG8_SA(b, h) (((b) * 2 + (h)) * HTB)
#define PG8_SB(b, h) ((4 + (b) * 2 + (h)) * HTB)
#define PG8_STAGE(bufoff, gbase, voff) do { \
        __builtin_amdgcn_raw_ptr_buffer_load_lds(rsrc, (LAS void*)(lds + (bufoff) + ldsw), 16, voff, (gbase), 0, 0); \
        __builtin_amdgcn_raw_ptr_buffer_load_lds(rsrc, (LAS void*)(lds + (bufoff) + ldsw + 8192), 16, voff, (gbase) + p2##voff, 0, 0); } while (0)
#define p2voffA p2A
#define p2voffB p2B
#define PG8_STAGEA(bufoff, gk, h, tab) do { if constexpr (GATHER) { \
        const LAS int* tb_ = (const LAS int*)(lds + STAGE_BYTES) + (tab) * 256 + (h) * 128 + (int)(voffA >> 16); const unsigned cb_ = voffA & 0xffffu; \
        const unsigned i0_ = (unsigned)tb_[0], i1_ = (unsigned)tb_[64]; \
        __builtin_amdgcn_raw_ptr_buffer_load_lds(rsrc, (LAS void*)(lds + (bufoff) + ldsw), 16, i0_ * (unsigned)g.lda + cb_, (gk), 0, 0); \
        __builtin_amdgcn_raw_ptr_buffer_load_lds(rsrc, (LAS void*)(lds + (bufoff) + ldsw + 8192), 16, i1_ * (unsigned)g.lda + cb_, (gk), 0, 0); } \
      else { PG8_STAGE(bufoff, (gk) + (h) * hstepA, voffA); } } while (0)
#define PG8_LDA(dst, b, h) do { _Pragma("unroll") for (int m = 0; m < 4; ++m) _Pragma("unroll") for (int k = 0; k < 2; ++k) dst[m][k] = *(const LAS bf16x8*)(lds + PG8_SA(b, h) + aoff + m * 2048 + k * 1024); } while (0)
#define PG8_LDB(dst, b, h) do { _Pragma("unroll") for (int n = 0; n < 2; ++n) _Pragma("unroll") for (int k = 0; k < 2; ++k) dst[n][k] = *(const LAS bf16x8*)(lds + PG8_SB(b, h) + boff + n * 2048 + k * 1024); } while (0)
#define PG8_CAT(x, y) __builtin_shufflevector(__builtin_bit_cast(v4i_t, x), __builtin_bit_cast(v4i_t, y), 0, 1, 2, 3, 4, 5, 6, 7)
#define PG8_MMA(ai, bj, At, Bt) do { __builtin_amdgcn_s_setprio(1); if constexpr (MX) { _Pragma("unroll") for (int m = 0; m < 4; ++m) _Pragma("unroll") for (int n = 0; n < 2; ++n) \
        acc[ai][bj][m][n] = __builtin_amdgcn_mfma_scale_f32_16x16x128_f8f6f4(PG8_CAT(Bt[n][0], Bt[n][1]), PG8_CAT(At[m][0], At[m][1]), acc[ai][bj][m][n], 0, 0, 0, g.sw, 0, g.sa); } else { \
        _Pragma("unroll") for (int m = 0; m < 4; ++m) _Pragma("unroll") for (int n = 0; n < 2; ++n) _Pragma("unroll") for (int k = 0; k < 2; ++k) \
        acc[ai][bj][m][n] = __builtin_amdgcn_mfma_f32_16x16x32_bf16(Bt[n][k], At[m][k], acc[ai][bj][m][n], 0, 0, 0); } __builtin_amdgcn_s_setprio(0); } while (0)
#define PG8_WAIT_V(n) asm volatile("s_waitcnt vmcnt(" #n ")" ::: "memory")
#define PG8_WAIT_L(n) asm volatile("s_waitcnt lgkmcnt(" #n ")" ::: "memory")
#define PG8_BAR __builtin_amdgcn_s_barrier()
#define PG8_SCHED __builtin_amdgcn_sched_barrier(0)
#ifdef GP_PROBE
    unsigned long long gp_cycles = 0, gp_tiles = 0; const unsigned long long gp_p0 = __builtin_amdgcn_s_memtime(), gp_r0 = __builtin_amdgcn_s_memrealtime();
#endif
    Unit cur, nxt; int ui = 0;
    if (!S.next(0, cur)) return;
    f32x4 acc[2][2][4][2];
    E.init(acc, cur, wc, fq);
    bf16x8 At[4][2], B0[2][2], B1[2][2];
    unsigned cA = S.a_off(cur), cB = S.b_off(cur);
    int tab_c = 0; (void)tab_c;
    if constexpr (GATHER) {
        if (wid < 4) {
            const unsigned dst_ = (unsigned)__builtin_amdgcn_readfirstlane((int)(unsigned)(unsigned long)(lds + STAGE_BYTES + (wid * 64) * 4));
            const unsigned vo_ = (unsigned)((wid * 64 + lane) * 4); const unsigned so_ = S.tok_off(cur);
            asm volatile("s_nop 4\n\ts_mov_b32 m0, %0\n\ts_nop 0\n\tbuffer_load_dword %1, %2, %3 offen lds" :: "s"(dst_), "v"(vo_), "s"(rsrc), "s"(so_) : "m0", "memory"); }
        asm volatile("s_waitcnt vmcnt(0)" ::: "memory"); __syncthreads();
    }
    if constexpr (SP2) {
        PG8_STAGE(PG8_SB(0, 0), cB, voffB); PG8_STAGE(PG8_SB(0, 1), cB + hstepB, voffB); PG8_STAGEA(PG8_SA(0, 0), cA, 0, tab_c); PG8_STAGEA(PG8_SA(0, 1), cA, 1, tab_c);
        if (wr == 1) PG8_BAR;
        PG8_WAIT_V(2); PG8_BAR;
        PG8_STAGE(PG8_SB(1, 0), cB + kstep, voffB); PG8_STAGEA(PG8_SA(1, 0), cA + kstep, 0, tab_c); PG8_STAGE(PG8_SB(1, 1), cB + hstepB + kstep, voffB);
        PG8_WAIT_V(6); PG8_BAR;
    } else {
        PG8_STAGE(PG8_SB(0, 0), cB, voffB); PG8_STAGEA(PG8_SA(0, 0), cA, 0, tab_c); PG8_STAGE(PG8_SB(0, 1), cB + hstepB, voffB); PG8_STAGEA(PG8_SA(0, 1), cA, 1, tab_c);
        if (wr == 1) PG8_BAR;
        PG8_WAIT_V(4); PG8_BAR;
        PG8_STAGE(PG8_SB(1, 0), cB + kstep, voffB); PG8_STAGEA(PG8_SA(1, 0), cA + kstep, 0, tab_c); PG8_STAGE(PG8_SB(1, 1), cB + hstepB + kstep, voffB);
        PG8_WAIT_V(6); PG8_BAR;
    }
    for (;;) {
        const bool has_next = S.next(ui + 1, nxt);
        const unsigned nA = has_next ? S.a_off(nxt) : cA, nB = has_next ? S.b_off(nxt) : cB;
        if constexpr (GATHER) { if (has_next && wid < 4) {
            const unsigned dst_ = (unsigned)__builtin_amdgcn_readfirstlane((int)(unsigned)(unsigned long)(lds + STAGE_BYTES + ((tab_c ^ 1) * 256 + wid * 64) * 4));
            const unsigned vo_ = (unsigned)((wid * 64 + lane) * 4); const unsigned so_ = S.tok_off(nxt);
            asm volatile("s_nop 4\n\ts_mov_b32 m0, %0\n\ts_nop 0\n\tbuffer_load_dword %1, %2, %3 offen lds" :: "s"(dst_), "v"(vo_), "s"(rsrc), "s"(so_) : "m0", "memory"); } }
#ifdef GP_PROBE
        const unsigned long long gp_t0 = __builtin_amdgcn_s_memtime();
#endif
#pragma nounroll
        for (int t = 0; t < nt; t += 2) {
            const bool last = (t == nt - 2);
            const unsigned a1 = cA + (unsigned)(t + 1) * kstep;
            const unsigned a2 = last ? nA : cA + (unsigned)(t + 2) * kstep, b2 = last ? nB : cB + (unsigned)(t + 2) * kstep;
            const unsigned a3 = a2 + kstep, b3 = b2 + kstep; const int tab_2 = last ? (tab_c ^ 1) : tab_c; (void)tab_2;
            if constexpr (SP2) {
            PG8_LDB(B0, 0, 0); PG8_LDB(B1, 0, 1); PG8_SCHED; PG8_LDA(At, 0, 0); PG8_STAGEA(PG8_SA(1, 1), a1, 1, tab_c);
            PG8_WAIT_V(8); PG8_WAIT_L(0); PG8_BAR; PG8_MMA(0, 0, At, B0); PG8_MMA(0, 1, At, B1); PG8_BAR; PG8_SCHED;
            PG8_LDA(At, 0, 1); PG8_STAGE(PG8_SB(0, 0), b2, voffB); PG8_STAGE(PG8_SB(0, 1), b2 + hstepB, voffB); PG8_STAGEA(PG8_SA(0, 0), a2, 0, tab_2);
            PG8_WAIT_V(8); PG8_WAIT_L(0); PG8_BAR; PG8_MMA(1, 0, At, B0); PG8_MMA(1, 1, At, B1); PG8_BAR; PG8_SCHED;
            PG8_LDB(B0, 1, 0); PG8_LDB(B1, 1, 1); PG8_SCHED; PG8_LDA(At, 1, 0); PG8_STAGEA(PG8_SA(0, 1), a2, 1, tab_2);
            PG8_WAIT_V(8); PG8_WAIT_L(0); PG8_BAR; PG8_MMA(0, 0, At, B0); PG8_MMA(0, 1, At, B1); PG8_BAR; PG8_SCHED;
            PG8_LDA(At, 1, 1); PG8_STAGE(PG8_SB(1, 0), b3, voffB); PG8_STAGE(PG8_SB(1, 1), b3 + hstepB, voffB); PG8_STAGEA(PG8_SA(1, 0), a3, 0, tab_2);
            PG8_WAIT_V(8); PG8_WAIT_L(0); PG8_BAR; PG8_MMA(1, 0, At, B0); PG8_MMA(1, 1, At, B1); PG8_BAR; PG8_SCHED;
            } else {
            PG8_LDB(B0, 0, 0); PG8_SCHED; PG8_LDA(At, 0, 0); PG8_STAGEA(PG8_SA(1, 1), a1, 1, tab_c);
            PG8_WAIT_L(8); PG8_BAR; PG8_WAIT_L(0); PG8_MMA(0, 0, At, B0); PG8_BAR; PG8_SCHED;
            PG8_LDB(B1, 0, 1); PG8_STAGE(PG8_SB(0, 0), b2, voffB);
            PG8_BAR; PG8_WAIT_L(0); PG8_MMA(0, 1, At, B1); PG8_BAR;
            PG8_LDA(At, 0, 1); PG8_STAGEA(PG8_SA(0, 0), a2, 0, tab_2);
            PG8_BAR; PG8_WAIT_L(0); PG8_MMA(1, 0, At, B0); PG8_BAR; PG8_SCHED;
            PG8_STAGE(PG8_SB(0, 1), b2 + hstepB, voffB);
            PG8_WAIT_V(6); PG8_BAR; PG8_MMA(1, 1, At, B1); PG8_BAR;
            PG8_LDB(B0, 1, 0); PG8_SCHED; PG8_LDA(At, 1, 0); PG8_STAGEA(PG8_SA(0, 1), a2, 1, tab_2);
            PG8_WAIT_L(8); PG8_BAR; PG8_WAIT_L(0); PG8_MMA(0, 0, At, B0); PG8_BAR; PG8_SCHED;
            PG8_LDB(B1, 1, 1); PG8_STAGE(PG8_SB(1, 0), b3, voffB);
            PG8_BAR; PG8_WAIT_L(0); PG8_MMA(0, 1, At, B1); PG8_BAR;
            PG8_LDA(At, 1, 1); PG8_STAGEA(PG8_SA(1, 0), a3, 0, tab_2);
            PG8_BAR; PG8_WAIT_L(0); PG8_MMA(1, 0, At, B0); PG8_BAR; PG8_SCHED;
            PG8_STAGE(PG8_SB(1, 1), b3 + hstepB, voffB);
            PG8_WAIT_V(6); PG8_BAR; PG8_MMA(1, 1, At, B1); PG8_BAR;
            }
        }
#ifdef GP_PROBE
        if (gp_out) { gp_cycles += __builtin_amdgcn_s_memtime() - gp_t0; gp_tiles += nt; }
#endif
        if constexpr (ALIGN_EPI) { if (wr == 0) PG8_BAR; }
        if (has_next) S.prefetch(nxt, rsrc, lds, wid, lane);
        if constexpr (has_prefetch_init<Epi>::value) {
            f32x4 pb_[4]; { int fq_p = fq; asm volatile("" : "+v"(fq_p)); E.pre(pb_, has_next ? nxt.aux : cur.aux, has_next ? nxt.pn : cur.pn, wc, fq_p); }
            { int fr_e = fr, fq_e = fq; asm volatile("" : "+v"(fr_e), "+v"(fq_e)); E(acc, cur, wr, wc, fr_e, fq_e); }
            if (!has_next) break;
            E.init_from(acc, pb_);
        } else {
        { int fr_e = fr, fq_e = fq; asm volatile("" : "+v"(fr_e), "+v"(fq_e));
          E(acc, cur, wr, wc, fr_e, fq_e); }
        if (!has_next) break;
        { int fq_i = fq; asm volatile("" : "+v"(fq_i)); E.init(acc, nxt, wc, fq_i); }
        }
        cur = nxt; cA = nA; cB = nB; ++ui; tab_c ^= 1;
        if constexpr (ALIGN_EPI) { if (wr == 1) PG8_BAR; }
    }
    PG8_WAIT_V(0);
    if constexpr (!ALIGN_EPI) { if (wr == 0) PG8_BAR; }
    PG8_BAR;
#ifdef GP_PROBE
    if (gp_out && blockIdx.x == GP_BLOCK && tid == 0) { gp_out[0] = gp_cycles; gp_out[1] = gp_tiles; gp_out[2] = __builtin_amdgcn_s_memtime() - gp_p0; gp_out[3] = __builtin_amdgcn_s_memrealtime() - gp_r0; gp_out[4] = (unsigned long long)(ui + 1); }
#endif
#undef PG8_SA
#undef PG8_SB
#undef PG8_STAGE
#undef p2voffA
#undef PG8_STAGEA
#undef p2voffB
#undef PG8_LDA
#undef PG8_LDB
#undef PG8_MMA
#undef PG8_CAT
#undef PG8_WAIT_V
#undef PG8_WAIT_L
#undef PG8_BAR
#undef PG8_SCHED
}
}
using pg8::Unit;

constexpr size_t MiB = 1u << 20;
constexpr size_t WS_CTL = 0, CTL_ZERO_BYTES = 1 * MiB;
constexpr size_t WS_WIN = 1 * MiB;
constexpr size_t WS_WQ = 7 * MiB;
constexpr size_t WS_WKV = WS_WQ + 512 * 1024;
constexpr size_t WS_WPOOL = 8 * MiB;
constexpr size_t WS_WAO = 9 * MiB;
constexpr size_t WS_WPO = 10 * MiB;
constexpr size_t WS_WO = 11 * MiB;
constexpr size_t WS_WPG = 13 * MiB;
constexpr size_t WS_WPLE = 15 * MiB;
constexpr size_t WS_WGU = 16 * MiB;
constexpr size_t WS_WD = 144 * MiB;
constexpr size_t WS_HN = 208 * MiB;
constexpr size_t WS_PROJ = 240 * MiB;
constexpr size_t WS_GATES = 272 * MiB;
constexpr size_t WS_A2 = 336 * MiB;
constexpr size_t WS_POOLED = 352 * MiB;
constexpr size_t WS_Q = 368 * MiB;
constexpr size_t WS_K = 392 * MiB;
constexpr size_t WS_V = 416 * MiB;
constexpr size_t WS_ATT = 432 * MiB;
constexpr size_t WS_MIXED = 448 * MiB;
constexpr size_t WS_MIX = 464 * MiB;
constexpr size_t WS_PB = 496 * MiB;
constexpr size_t WS_E = 504 * MiB;
constexpr size_t WS_SSQ = 536 * MiB;
constexpr size_t WS_COS = 537 * MiB;
constexpr size_t WS_SIN = 538 * MiB;
constexpr size_t WS_ROUTE = 539 * MiB;
constexpr size_t WS_TOK = 541 * MiB;
constexpr size_t WS_XS = 544 * MiB;
constexpr size_t WS_ACT = 688 * MiB;
constexpr size_t WS_XS2 = 768 * MiB;
constexpr size_t WS_WIN8 = 848 * MiB;
constexpr size_t WS_HN8 = 852 * MiB;
constexpr size_t WS_END = 868 * MiB;
constexpr size_t WS_X1B = WS_PROJ;
constexpr size_t WS_X2B = WS_MIX;
constexpr int CW_BAR = 4096;
constexpr int CW_CNT = 1024;

constexpr int RING_BYTES = 131072;
constexpr int LDS_BYTES = 163840;
constexpr int MISC_OFF = LDS_BYTES - 512;
constexpr int TILE_E_OFF = LDS_BYTES - 4096;
constexpr int NWAVES = 8;

typedef GAS unsigned gu32;
#define RLX_AGENT __ATOMIC_RELAXED, __HIP_MEMORY_SCOPE_AGENT
#define XB_TMO      128
#define XB_XCNT(j)  (256  + 64 * (j))
#define XB_XSUB(j)  (1280 + 64 * (j))
#define XB_XGEN(j)  (2304 + 64 * (j))
#define XB_TOP      3328
#define XB_TOPGEN   3392
#define XCD_BAR_WORDS 3456
#define XB_SPIN_CAP (1u << 18)
__device__ __forceinline__ unsigned xb_ld(unsigned* p)              { return __hip_atomic_load(p, __ATOMIC_RELAXED, __HIP_MEMORY_SCOPE_AGENT); }
__device__ __forceinline__ unsigned xb_add(unsigned* p, unsigned v) { return __hip_atomic_fetch_add(p, v, __ATOMIC_RELAXED, __HIP_MEMORY_SCOPE_AGENT); }
__device__ __forceinline__ unsigned xb_xcc_id() { return (unsigned)__builtin_amdgcn_s_getreg((3 << 11) | 20) & 0xFu; }
#define XB_SPIN(cond, bar) do { unsigned _sp = 0; while (cond) { __builtin_amdgcn_s_sleep(1); \
    if ((++_sp & 255u) == 0u) { if (xb_ld(&(bar)[XB_TMO])) break; if (_sp > XB_SPIN_CAP) { atomicAdd(&(bar)[XB_TMO], 1u); break; } } } } while (0)
struct XcdBarrier { unsigned* bar; unsigned x; volatile LAS unsigned* st; };
__device__ __forceinline__ XcdBarrier xcd_barrier_post(unsigned* bar, volatile LAS unsigned* st) {
    XcdBarrier b; b.bar = bar; b.x = xb_xcc_id(); b.st = st;
    if (threadIdx.x == 0) (void)xb_add(&bar[XB_XCNT(b.x)], 1u);
    return b;
}
__device__ __forceinline__ void xcd_barrier_complete(unsigned* bar, unsigned x, unsigned& nloc, unsigned& nx) {
    const unsigned G = gridDim.x * gridDim.y * gridDim.z;
    unsigned sum, cnt, mine, sp = 0u;
    for (;;) {
        sum = 0u; cnt = 0u; mine = 0u;
#pragma unroll
        for (unsigned j = 0; j < 16; ++j) { const unsigned c = xb_ld(&bar[XB_XCNT(j)]); sum += c; cnt += (c > 0u) ? 1u : 0u; mine = (j == x) ? c : mine; }
        if (sum == G) break;
        __builtin_amdgcn_s_sleep(1);
        if ((++sp & 255u) == 0u) { if (xb_ld(&bar[XB_TMO])) break; if (sp > XB_SPIN_CAP) { atomicAdd(&bar[XB_TMO], 1u); break; } }
    }
    nloc = mine > 0u ? mine : 1u; nx = cnt > 0u ? cnt : 1u;
}
__device__ __forceinline__ void xcd_barrier(const XcdBarrier& b) {
    asm volatile("s_waitcnt vmcnt(0)" ::: "memory");
    __syncthreads();
    if (threadIdx.x == 0) {
        unsigned* bar = b.bar;
        __builtin_amdgcn_s_waitcnt(0);
        unsigned nloc = b.st[0], nx = b.st[1];
        if (nloc == 0u) { xcd_barrier_complete(bar, b.x, nloc, nx); b.st[0] = nloc; b.st[1] = nx; }
        const unsigned old = xb_add(&bar[XB_XSUB(b.x)], 1u);
        const unsigned gen = old / nloc;
        if (old + 1u == (gen + 1u) * nloc) {
            __builtin_amdgcn_fence(__ATOMIC_RELEASE, "agent");
            asm volatile("s_waitcnt vmcnt(0)" ::: "memory");
            const unsigned og = xb_add(&bar[XB_TOP], 1u);
            const unsigned tg = og / nx;
            if (og + 1u == (tg + 1u) * nx) xb_add(&bar[XB_TOPGEN], 1u);
            else XB_SPIN(xb_ld(&bar[XB_TOPGEN]) == tg, bar);
            __builtin_amdgcn_fence(__ATOMIC_ACQUIRE, "agent");
            xb_add(&bar[XB_XGEN(b.x)], 1u);
            asm volatile("s_waitcnt vmcnt(0)" ::: "memory");
        } else {
            XB_SPIN(xb_ld(&bar[XB_XGEN(b.x)]) == gen, bar);
            __builtin_amdgcn_fence(__ATOMIC_ACQUIRE, "agent");
            asm volatile("s_waitcnt vmcnt(0)" ::: "memory");
        }
    }
    __syncthreads();
}

#ifdef GP_PROBE
#define GP_AT(k) ((k) == GP_PHASE ? (unsigned long long*)(ws + WS_CTL + 65536) : nullptr)
#else
#define GP_AT(k) nullptr
#endif
struct Args {
    const float* in[27];
    float* out; unsigned char* ws;
    int ph_lo, ph_hi;
};
typedef const __attribute__((address_space(4))) Args* KArgs;
__device__ __forceinline__ KArgs kargs() { KArgs p = (KArgs)__builtin_amdgcn_kernarg_segment_ptr(); asm volatile("" : "+s"(p)); return p; }
enum { I_X = 0, I_P, I_POS, I_GMIX, I_WIN, I_GQLAT, I_WQB, I_GKVLAT, I_WKVB, I_GQHEAD, I_GKNOPE, I_GKROPE, I_WPOOL, I_PSCALE, I_WAO, I_WPO, I_WO, I_GFFN,
       I_WR, I_BR, I_WGU, I_BGU, I_WD, I_BD, I_GPLE, I_WPG, I_WPLE };

enum { MAP_ID = 0, MAP_WIN, MAP_GU, MAP_QB, MAP_KVB };
__device__ __forceinline__ int map_row(int mode, int n) {
    switch (mode) {
    case MAP_WIN: return n < 416 ? n : n + 96;
    case MAP_GU: { const int j = n & 1023, up = n >> 10; return 256 * (j >> 7) + 128 * up + (j & 127); }
    case MAP_QB: { const int h = n / 96, d = n % 96;
        if (d < 64) return (h >> 2) * 256 + 128 * (d >> 5) + 32 * (h & 3) + (d & 31);
        const int dd = d - 64, half = dd >> 4, i = dd & 15; return 512 + 128 * (h & 1) + 32 * (h >> 1) + 8 * (i >> 2) + 4 * half + (i & 3); }
    case MAP_KVB: { const int h = n >> 7, c = n & 127, isv = c >> 6, d = c & 63; return (h >> 1) * 256 + 128 * (d >> 5) + 32 * (2 * isv + (h & 1)) + (d & 31); }
    default: return n;
    }
}
struct TJob { const float* W; int K, N; bf16_t* WT; int ldw, koff, mode, row_off; const float* gk; const float* gn; int nmat; size_t wstride, wtstride; int fp8; int nb0 = 0, nbcnt = 0; };
struct TItem { const float* src; bf16_t* dst; int n0, k0; float gnv; };
__device__ __forceinline__ TItem titem_setup(const TJob& J, int item, int lane) {
    const int nblk = J.nbcnt ? J.nbcnt : J.N / 32, ipm = (J.K / 64) * nblk, mat = item / ipm, it = item - mat * ipm, kb = it / nblk, nb = J.nb0 + (it - kb * nblk);
    TItem I; I.k0 = 64 * kb; I.n0 = 32 * nb;
    I.src = J.W + (size_t)mat * J.wstride + (size_t)(I.k0 + (lane >> 5)) * J.N + I.n0 + (lane & 31);
    I.dst = (bf16_t*)((unsigned char*)J.WT + (size_t)mat * J.wtstride * (J.fp8 ? 1 : 2));
    I.gnv = J.gn ? J.gn[I.n0 + (lane & 31)] : 1.f;
    return I;
}
__device__ __forceinline__ void titem_load(const TJob& J, const TItem& I, float (&v)[32]) {
#pragma unroll
    for (int i = 0; i < 32; ++i) v[i] = I.src[(size_t)(2 * i) * J.N];
}
__device__ __forceinline__ void titem_store(const TJob& J, const TItem& I, float (&v)[32], LAS float* scr, int lane) {
#pragma unroll
    for (int i = 0; i < 32; ++i) { const int kk = 2 * i + (lane >> 5); float x = v[i] * I.gnv; if (J.gk) x *= J.gk[I.k0 + kk]; scr[kk * 33 + (lane & 31)] = x; }
    asm volatile("s_waitcnt lgkmcnt(0)" ::: "memory");
    const int c = lane & 7;
#pragma unroll
    for (int j = 0; j < 4; ++j) { const int n = (lane >> 3) + 8 * j; const LAS float* s = scr + (8 * c) * 33 + n;
        const size_t eo = (size_t)(J.row_off + map_row(J.mode, I.n0 + n)) * J.ldw + J.koff + I.k0 + 8 * c;
        if (J.fp8) { u32x2 o; int w = __builtin_amdgcn_cvt_pk_fp8_f32(s[0 * 33] * 8.f, s[1 * 33] * 8.f, 0, false); w = __builtin_amdgcn_cvt_pk_fp8_f32(s[2 * 33] * 8.f, s[3 * 33] * 8.f, w, true); o.x = (unsigned)w;
            w = __builtin_amdgcn_cvt_pk_fp8_f32(s[4 * 33] * 8.f, s[5 * 33] * 8.f, 0, false); w = __builtin_amdgcn_cvt_pk_fp8_f32(s[6 * 33] * 8.f, s[7 * 33] * 8.f, w, true); o.y = (unsigned)w;
            *(u32x2*)((unsigned char*)I.dst + eo) = o; }
        else { u32x4 o; o.x = cvt_pk_bf16(s[0 * 33], s[1 * 33]); o.y = cvt_pk_bf16(s[2 * 33], s[3 * 33]); o.z = cvt_pk_bf16(s[4 * 33], s[5 * 33]); o.w = cvt_pk_bf16(s[6 * 33], s[7 * 33]);
            *(u32x4*)(I.dst + eo) = o; } }
    asm volatile("s_waitcnt lgkmcnt(0)" ::: "memory");
}
__device__ __forceinline__ void run_job(const TJob& J, LAS float* scr, int gw, int NGW, int lane) {
    const int items = J.nmat * (J.K / 64) * (J.nbcnt ? J.nbcnt : J.N / 32);
    for (int it = gw; it < items; it += 2 * NGW) {
        const bool two = (it + NGW) < items;
        const TItem I0 = titem_setup(J, it, lane); const TItem I1 = titem_setup(J, two ? it + NGW : it, lane);
        float v0[32], v1[32];
        titem_load(J, I0, v0); if (two) titem_load(J, I1, v1);
        titem_store(J, I0, v0, scr, lane); if (two) titem_store(J, I1, v1, scr, lane);
    }
}

struct Frame {
    LAS unsigned char* lds; volatile LAS unsigned* MISC; unsigned* ctl;
    int wave, vcu, G;
    float* out; unsigned char* ws;
};

__device__ __forceinline__ void p0_prologue(const Frame& F) {
    const int tid_l = tid_local(), lane_l = tid_l & 63; (void)tid_l; (void)lane_l;
    const KArgs a = kargs();
    LAS float* scr = (LAS float*)(F.lds + F.wave * 16384);
    const int gw = F.vcu * NWAVES + F.wave, NGW = F.G * NWAVES;
    unsigned char* ws = F.ws;
    int joff = 0;
#define RUN_JOB(...) do { const TJob J_ = TJob{__VA_ARGS__, 1, 0, 0, 0}; run_job(J_, scr, (gw + NGW - joff % NGW) % NGW, NGW, lane_l); joff += (J_.K / 64) * (J_.N / 32); } while (0)
#ifndef P1_FP8
#define P1_FP8 0
#endif
#ifndef GATES_FP8
#define GATES_FP8 1
#endif
    if (GATES_FP8 && !P1_FP8) {
        { const TJob J_{a->in[I_WIN], 1024, 2976, (bf16_t*)(ws + WS_WIN), 1024, 0, MAP_WIN, 0, nullptr, nullptr, 1, 0, 0, 0, 0, 29}; run_job(J_, scr, gw, NGW, lane_l); joff += 16 * 29; }
        { const TJob J_{a->in[I_WIN], 1024, 2976, (bf16_t*)(ws + WS_WIN8), 1024, 0, MAP_WIN, 0, nullptr, nullptr, 1, 0, 0, 1, 29, 64}; run_job(J_, scr, (gw + NGW - joff % NGW) % NGW, NGW, lane_l); joff += 16 * 64; }
    } else
    { const TJob J_{a->in[I_WIN], 1024, 2976, (bf16_t*)(ws + WS_WIN), 1024, 0, MAP_WIN, 0, nullptr, nullptr, 1, 0, 0, P1_FP8}; run_job(J_, scr, gw, NGW, lane_l); joff += 16 * 93; }
    if (GATES_FP8 && P1_FP8) { const TJob J_{a->in[I_WIN], 1024, 2976, (bf16_t*)(ws + WS_WIN8), 1024, 0, MAP_WIN, 0, nullptr, nullptr, 1, 0, 0, 1}; run_job(J_, scr, gw, NGW, lane_l); }
    RUN_JOB(a->in[I_WQB], 256, 768, (bf16_t*)(ws + WS_WQ), 256, 0, MAP_QB, 0, a->in[I_GQLAT], nullptr);
    RUN_JOB(a->in[I_WKVB], 128, 1024, (bf16_t*)(ws + WS_WKV), 256, 0, MAP_KVB, 0, a->in[I_GKVLAT], nullptr);
    RUN_JOB(a->in[I_WAO], 512, 1024, (bf16_t*)(ws + WS_WAO), 512, 0, MAP_ID, 0, nullptr, nullptr);
    RUN_JOB(a->in[I_WPO], 512, 1024, (bf16_t*)(ws + WS_WPO), 512, 0, MAP_ID, 0, nullptr, nullptr);
    RUN_JOB(a->in[I_WO], 1024, 1024, (bf16_t*)(ws + WS_WO), 1024, 0, MAP_ID, 0, nullptr, nullptr);
#ifndef PLE_FP8
#define PLE_FP8 1
#endif
    { const TJob J_{a->in[I_WPG], 1024, 1024, (bf16_t*)(ws + WS_WPG), 1024, 0, MAP_ID, 0, nullptr, nullptr, 1, 0, 0, PLE_FP8}; run_job(J_, scr, (gw + NGW - joff % NGW) % NGW, NGW, lane_l); joff += 16 * 32; }
    RUN_JOB(a->in[I_WPLE], 256, 1024, (bf16_t*)(ws + WS_WPLE), 256, 0, MAP_ID, 0, nullptr, nullptr);
    for (int g = 0; g < 4; ++g)
        RUN_JOB(a->in[I_WPOOL] + (size_t)g * 128 * 128, 128, 128, (bf16_t*)(ws + WS_WPOOL) + (size_t)(g >> 1) * 256 * 256, 256, 128 * (g & 1), MAP_ID, 128 * (g & 1), nullptr, a->in[I_PSCALE] + 128 * g);
    {
        const int gt = (F.vcu * NWAVES + F.wave) * 64 + lane_l, NGT = NGW * 64;
        const u32x4 z = {0u, 0u, 0u, 0u};
        u32x4* w0 = (u32x4*)(ws + WS_WIN + (size_t)416 * 1024 * (P1_FP8 ? 1 : 2));
        for (int i = gt; i < 96 * (P1_FP8 ? 64 : 128); i += NGT) w0[i] = z;
        for (int i = gt; i < 1024 * 16; i += NGT) { const int r = i >> 4, c = i & 15; *(u32x4*)((bf16_t*)(ws + WS_WKV) + (size_t)r * 256 + 128 + 8 * c) = z; }
        for (int i = gt; i < 2 * 256 * 16; i += NGT) { const int p = i >> 12, r = (i >> 4) & 255, c = i & 15;
            const int k0 = (r < 128) ? 128 : 0; *(u32x4*)((bf16_t*)(ws + WS_WPOOL) + (size_t)p * 65536 + (size_t)r * 256 + k0 + 8 * c) = z; }
    }
#ifndef CONV_IN_ATTN
#define CONV_IN_ATTN 1
#endif
    static_assert(CONV_IN_ATTN, "the down weights get their x64 in the attention-phase conversion only");
    if (!CONV_IN_ATTN) {
    { const TJob J{a->in[I_WGU], 1024, 2048, (bf16_t*)(ws + WS_WGU), 1024, 0, MAP_GU, 0, nullptr, nullptr, NEXP, (size_t)1024 * 2048, (size_t)2048 * 1024, 1}; run_job(J, scr, gw, NGW, lane_l); }
    { const TJob J{a->in[I_WD], 1024, 1024, (bf16_t*)(ws + WS_WD), 1024, 0, MAP_ID, 0, nullptr, nullptr, NEXP, (size_t)1024 * 1024, (size_t)1024 * 1024, 1}; run_job(J, scr, gw, NGW, lane_l); }
    }
    const float* x = a->in[I_X]; const float* gm = a->in[I_GMIX];
    f32x4 gv[4];
#pragma unroll
    for (int j = 0; j < 4; ++j) gv[j] = *(const f32x4*)(gm + 4 * lane_l + 256 * j);
    for (int m = gw; m < T; m += NGW) {
        const f32x4* xr = (const f32x4*)(x + (size_t)m * DM) + lane_l;
        f32x4 v[4]; float s = 0.f;
#pragma unroll
        for (int j = 0; j < 4; ++j) { v[j] = xr[64 * j]; s += (v[j].x * v[j].x + v[j].y * v[j].y) + (v[j].z * v[j].z + v[j].w * v[j].w); }
        const float rstd = 1.0f / sqrtf(wave_sum(s) * (1.f / DM) + EPS);
        if (P1_FP8) { int* o4 = (int*)(ws + WS_HN + (size_t)m * DM) + lane_l; const float r8 = rstd * 8.0f;
#pragma unroll
            for (int j = 0; j < 4; ++j) { int w = __builtin_amdgcn_cvt_pk_fp8_f32(v[j].x * r8 * gv[j].x, v[j].y * r8 * gv[j].y, 0, false); w = __builtin_amdgcn_cvt_pk_fp8_f32(v[j].z * r8 * gv[j].z, v[j].w * r8 * gv[j].w, w, true); o4[64 * j] = w; } }
        else { u32x2* o8 = (u32x2*)((bf16_t*)(ws + WS_HN) + (size_t)m * DM) + lane_l;
#pragma unroll
            for (int j = 0; j < 4; ++j) { u32x2 w; w.x = cvt_pk_bf16(v[j].x * rstd * gv[j].x, v[j].y * rstd * gv[j].y); w.y = cvt_pk_bf16(v[j].z * rstd * gv[j].z, v[j].w * rstd * gv[j].w); o8[64 * j] = w; }
            if (GATES_FP8) { int* o4 = (int*)(ws + WS_HN8 + (size_t)m * DM) + lane_l; const float r8 = rstd * 8.0f;
#pragma unroll
                for (int j = 0; j < 4; ++j) { int w = __builtin_amdgcn_cvt_pk_fp8_f32(v[j].x * r8 * gv[j].x, v[j].y * r8 * gv[j].y, 0, false); w = __builtin_amdgcn_cvt_pk_fp8_f32(v[j].z * r8 * gv[j].z, v[j].w * r8 * gv[j].w, w, true); o4[64 * j] = w; } } }
    }
    {
        const float* p = a->in[I_P];
        for (int m0 = gw; m0 < T; m0 += 8 * NGW) {
            f32x4 v[8];
#pragma unroll
            for (int r = 0; r < 8; ++r) { const int m = m0 + r * NGW; v[r] = *((const f32x4*)(p + (size_t)(m < T ? m : m0) * PLE) + lane_l); }
#pragma unroll
            for (int r = 0; r < 8; ++r) { const int m = m0 + r * NGW; if (m < T) { u32x2 w; w.x = cvt_pk_bf16(v[r].x, v[r].y); w.y = cvt_pk_bf16(v[r].z, v[r].w);
                *((u32x2*)((bf16_t*)(ws + WS_PB) + (size_t)m * PLE) + lane_l) = w; } } }
    }
}

struct DenseOrder {
    int nM, nN, nwg, G, c; unsigned A, B, tA, tB, aPn;
    __device__ void init(int nM_, int nN_, int G_, int c_, size_t A_, size_t lda, size_t B_, size_t ldb, unsigned aPn_ = 0) { nM = nM_; nN = nN_; nwg = nM * nN; G = G_; c = c_; A = (unsigned)A_; B = (unsigned)B_; tA = (unsigned)(256 * lda * 2); tB = (unsigned)(256 * ldb * 2); aPn = aPn_; }
    __device__ __forceinline__ bool next(int i, Unit& u) const {
        const long L = (long)i * G + c; if (L >= nwg) return false;
        int wgid = (int)L; { const int q = nwg / 8, r = nwg % 8, xcd = wgid % 8, off = wgid / 8; wgid = (xcd < r ? xcd * (q + 1) : r * (q + 1) + (xcd - r) * q) + off; }
        const int WGM = 8; const int nig = WGM * nN, gid = wgid / nig, fm = gid * WGM, gsz = (nM - fm) < WGM ? (nM - fm) : WGM;
        u.pm = fm + ((wgid % nig) % gsz); u.pn = (wgid % nig) / gsz; u.aux = 0; return true;
    }
    __device__ __forceinline__ void prefetch(const Unit&, const __amdgpu_buffer_rsrc_t, LAS unsigned char*, int, int) const {}
    __device__ __forceinline__ unsigned a_off(const Unit& u) const { return A + (unsigned)u.pm * tA + (unsigned)u.pn * aPn; }
    __device__ __forceinline__ unsigned b_off(const Unit& u) const { return B + (unsigned)u.pn * tB; }
};

struct EpiBf16 {
    static constexpr bool PERM = true;
    __device__ __forceinline__ void init(f32x4 (&acc)[2][2][4][2], const Unit&, int, int) const {
#pragma unroll
        for (int a = 0; a < 2; ++a)
#pragma unroll
            for (int b = 0; b < 2; ++b)
#pragma unroll
                for (int m = 0; m < 4; ++m)
#pragma unroll
                    for (int n = 0; n < 2; ++n) acc[a][b][m][n] = (f32x4){0.f, 0.f, 0.f, 0.f};
    }
    bf16_t* O; int ldc;
    __device__ __forceinline__ void operator()(const f32x4 (&acc)[2][2][4][2], const Unit& u, int wr, int wc, int fr, int fq) const {
        const int row0 = u.pm * 256 + wr * 64 + fr, col0 = u.pn * 256 + wc * 32 + 8 * fq;
#pragma unroll
        for (int ai = 0; ai < 2; ++ai)
#pragma unroll
            for (int m = 0; m < 4; ++m) { bf16_t* rowp = O + (size_t)(row0 + ai * 128 + m * 16) * ldc + col0;
#pragma unroll
                for (int bj = 0; bj < 2; ++bj) { const f32x4 v0 = acc[ai][bj][m][0], v1 = acc[ai][bj][m][1];
                    u32x4 w; w.x = cvt_pk_bf16(v0[0], v0[1]); w.y = cvt_pk_bf16(v0[2], v0[3]); w.z = cvt_pk_bf16(v1[0], v1[1]); w.w = cvt_pk_bf16(v1[2], v1[3]);
                    *(u32x4*)(rowp + bj * 128) = w; } }
    }
};
struct EpiProj {
    static constexpr bool PERM = true;
    __device__ __forceinline__ void init(f32x4 (&acc)[2][2][4][2], const Unit&, int, int) const {
#pragma unroll
        for (int a = 0; a < 2; ++a)
#pragma unroll
            for (int b = 0; b < 2; ++b)
#pragma unroll
                for (int m = 0; m < 4; ++m)
#pragma unroll
                    for (int n = 0; n < 2; ++n) acc[a][b][m][n] = (f32x4){0.f, 0.f, 0.f, 0.f};
    }
    bf16_t* PROJ; bf16_t* GATES; int pn_off;
    __device__ __forceinline__ void operator()(const f32x4 (&acc)[2][2][4][2], const Unit& u, int wr, int wc, int fr, int fq) const {
        const int pn = u.pn + pn_off; const int row0 = u.pm * 256 + wr * 64 + fr; const bool isg = pn >= 4;
        bf16_t* O = isg ? GATES : PROJ; const int ldc = isg ? 2048 : 1024; const int col0 = (isg ? pn - 4 : pn) * 256 + wc * 32 + 8 * fq;
#pragma unroll
        for (int ai = 0; ai < 2; ++ai)
#pragma unroll
            for (int m = 0; m < 4; ++m) { bf16_t* rowp = O + (size_t)(row0 + ai * 128 + m * 16) * ldc + col0;
                if (GATE8 == 2 && isg) {
                    unsigned w_[4] = {0u, 0u, 0u, 0u};
#pragma unroll
                    for (int bj = 0; bj < 2; ++bj)
#pragma unroll
                        for (int n = 0; n < 2; ++n)
#pragma unroll
                            for (int h = 0; h < 2; ++h) { const f32x2 v_ = {acc[ai][bj][m][n][2 * h], acc[ai][bj][m][n][2 * h + 1]};
                                const f32x2 x_ = v_ * (f32x2){-1.4426950408889634f, -1.4426950408889634f} + (f32x2){-7.994353436858858f, -7.994353436858858f};
                                const f32x2 d_ = (f32x2){__builtin_amdgcn_exp2f(x_[0]), __builtin_amdgcn_exp2f(x_[1])} + (f32x2){1.0f / 255.0f, 1.0f / 255.0f};
                                w_[2 * bj + n] = __builtin_amdgcn_cvt_pk_u8_f32(fmaxf(__builtin_rintf(__builtin_amdgcn_rcpf(d_[0])), 1.0f), 2 * h, w_[2 * bj + n]);
                                w_[2 * bj + n] = __builtin_amdgcn_cvt_pk_u8_f32(fmaxf(__builtin_rintf(__builtin_amdgcn_rcpf(d_[1])), 1.0f), 2 * h + 1, w_[2 * bj + n]); }
                    const int gt_ = pn - 4; u32x4 w16; w16.x = w_[0]; w16.y = w_[1]; w16.z = w_[2]; w16.w = w_[3];
                    *(u32x4*)((unsigned char*)GATES + (size_t)(row0 + ai * 128 + m * 16) * 2048 + (gt_ >> 2) * 1024 + (gt_ & 3) * 256 + wc * 64 + fq * 16) = w16;
                    asm volatile("" ::: "memory"); continue; }
#pragma unroll
                for (int bj = 0; bj < 2; ++bj) { f32x4 v0 = acc[ai][bj][m][0], v1 = acc[ai][bj][m][1];
                    if (isg) {
#pragma unroll
                        for (int e = 0; e < 4; ++e) { v0[e] = fast_sigmoid(v0[e]); v1[e] = fast_sigmoid(v1[e]); }
                        if (GATE8) {
#pragma unroll
                            for (int e = 0; e < 4; ++e) { v0[e] = fmaxf(v0[e] * 256.0f, 0.002f); v1[e] = fmaxf(v1[e] * 256.0f, 0.002f); }
                            *(u32x2*)((unsigned char*)GATES + (size_t)(row0 + ai * 128 + m * 16) * 2048 + col0 + bj * 128) = cvt8_fp8(v0, v1, 1.0f); continue; } }
                    u32x4 w; w.x = cvt_pk_bf16(v0[0], v0[1]); w.y = cvt_pk_bf16(v0[2], v0[3]); w.z = cvt_pk_bf16(v1[0], v1[1]); w.w = cvt_pk_bf16(v1[2], v1[3]);
                    *(u32x4*)(rowp + bj * 128) = w; } asm volatile("" ::: "memory"); }
    }
};

__device__ __forceinline__ void p2_rows(const Frame& F) {
    const int tid_l = tid_local(), lane_l = tid_l & 63; (void)tid_l; (void)lane_l;
    const KArgs a = kargs();
    const int gw = F.vcu * NWAVES + F.wave, NGW = F.G * NWAVES, lane = lane_l;
    unsigned char* ws = F.ws;
    const bf16_t* PROJ = (const bf16_t*)(ws + WS_PROJ);
    bf16_t* A2 = (bf16_t*)(ws + WS_A2); bf16_t* POOLED = (bf16_t*)(ws + WS_POOLED); bf16_t* Kb = (bf16_t*)(ws + WS_K);
    float* COS = (float*)(ws + WS_COS); float* SIN = (float*)(ws + WS_SIN);
    const int* positions = (const int*)a->in[I_POS];
    const float gkr = (lane < 32) ? a->in[I_GKROPE][lane] : 0.f;
    const float inv_freq = __builtin_amdgcn_exp2f(-(float)(lane & 15) * (13.287712379549449f / 16.0f));
    const int w = 2 << (lane >> 4);
    LAS bf16_t* ropeL = (LAS bf16_t*)(F.lds + F.wave * 2048); LAS float* cosL = (LAS float*)(F.lds + F.wave * 2048 + 512); LAS float* sinL = cosL + 128;
    for (int task = gw; task < T / 8; task += NGW) {
        const int t0 = task * 8, b = t0 / SEQ, s0 = t0 % SEQ;
        u32x2 qlv[8]; unsigned kvv[8]; bf16_t krr[8]; int posv[8];
#pragma unroll
        for (int i = 0; i < 8; ++i) { const bf16_t* pr = PROJ + (size_t)(t0 + i) * 1024; qlv[i] = *(const u32x2*)(pr + 4 * lane); kvv[i] = *(const unsigned*)(pr + 256 + 2 * lane); krr[i] = pr[384 + (lane & 31)]; posv[i] = positions[t0 + i]; }
        {
            const bf16_t* base = PROJ + (size_t)(b * SEQ) * 1024 + 512 + 8 * lane;
            u32x4 I[15], C[8], L[8];
#pragma unroll
            for (int k = 0; k < 15; ++k) { const int r = s0 - 15 + k; I[k] = *(const u32x4*)(base + (size_t)(r < 0 ? 0 : r) * 1024); }
#pragma unroll
            for (int i = 0; i < 8; ++i) { C[i] = *(const u32x4*)(base + (size_t)(s0 + i) * 1024); const int rr = s0 + i - w + 1; L[i] = *(const u32x4*)(base + (size_t)(rr < 0 ? 0 : rr) * 1024); }
            float S[8];
#pragma unroll
            for (int j = 0; j < 8; ++j) S[j] = 0.f;
#pragma unroll
            for (int k = 0; k < 15; ++k) { const float mk = (s0 - 15 + k >= 0 && k >= 16 - w) ? 1.f : 0.f; const u32x4 v = I[k];
                S[0] += mk * bf_lo(v.x); S[1] += mk * bf_hi(v.x); S[2] += mk * bf_lo(v.y); S[3] += mk * bf_hi(v.y); S[4] += mk * bf_lo(v.z); S[5] += mk * bf_hi(v.z); S[6] += mk * bf_lo(v.w); S[7] += mk * bf_hi(v.w); }
#pragma unroll
            for (int i = 0; i < 8; ++i) {
                const int s = s0 + i;
                const u32x4 v = C[i];
                float uu[8] = {bf_lo(v.x), bf_hi(v.x), bf_lo(v.y), bf_hi(v.y), bf_lo(v.z), bf_hi(v.z), bf_lo(v.w), bf_hi(v.w)};
                const int cnt = (s + 1 < w) ? s + 1 : w; const float ic = 1.0f / (float)cnt;
                float o[8];
#pragma unroll
                for (int j = 0; j < 8; ++j) { S[j] += uu[j]; o[j] = S[j] * ic - uu[j]; }
                u32x4 wv; wv.x = cvt_pk_bf16(o[0], o[1]); wv.y = cvt_pk_bf16(o[2], o[3]); wv.z = cvt_pk_bf16(o[4], o[5]); wv.w = cvt_pk_bf16(o[6], o[7]);
                *(u32x4*)(POOLED + (size_t)(t0 + i) * 512 + 8 * lane) = wv;
                const float mq = (s - w + 1 >= 0) ? 1.f : 0.f; const u32x4 q = L[i];
                S[0] -= mq * bf_lo(q.x); S[1] -= mq * bf_hi(q.x); S[2] -= mq * bf_lo(q.y); S[3] -= mq * bf_hi(q.y); S[4] -= mq * bf_lo(q.z); S[5] -= mq * bf_hi(q.z); S[6] -= mq * bf_lo(q.w); S[7] -= mq * bf_hi(q.w);
            }
        }
#pragma unroll
        for (int i = 0; i < 8; ++i) {
            const int t = t0 + i, s = s0 + i;
            const u32x2 ql = qlv[i];
            const unsigned kvl = kvv[i];
            const float krv = (lane < 32) ? bf1(krr[i]) : 0.f;
            const float q0 = bf_lo(ql.x), q1 = bf_hi(ql.x), q2 = bf_lo(ql.y), q3 = bf_hi(ql.y);
            const float k0 = bf_lo(kvl), k1 = bf_hi(kvl);
            const float sq = wave_sum((q0 * q0 + q1 * q1) + (q2 * q2 + q3 * q3));
            const float sk = wave_sum(k0 * k0 + k1 * k1);
            const float sr = wave_sum(krv * krv);
            const float rq = 1.0f / sqrtf(sq * (1.f / 256.f) + EPS), rk = 1.0f / sqrtf(sk * (1.f / 128.f) + EPS), rr = 1.0f / sqrtf(sr * (1.f / 32.f) + EPS);
            u32x2 wq; wq.x = cvt_pk_bf16(q0 * rq, q1 * rq); wq.y = cvt_pk_bf16(q2 * rq, q3 * rq);
            *(u32x2*)(A2 + (size_t)t * 512 + 4 * lane) = wq;
            *(unsigned*)(A2 + (size_t)t * 512 + 256 + 2 * lane) = cvt_pk_bf16(k0 * rk, k1 * rk);
            *(unsigned*)(A2 + (size_t)t * 512 + 384 + 2 * lane) = 0u;
            const float pos = (float)posv[i];
            const float ang = pos * inv_freq;
            const float rev = ang * 0.15915494309189535f;
            const float fr_ = rev - floorf(rev);
            const float sn = __builtin_amdgcn_sinf(fr_), cs = __builtin_amdgcn_cosf(fr_);
            const float kn = krv * rr * gkr;
            const float other = __shfl_xor(kn, 16);
            const float ro = (lane & 16) ? (kn * cs + other * sn) : (kn * cs - other * sn);
            if (lane < 32) ropeL[i * 32 + lane] = (bf16_t)(cvt_pk_bf16(ro, 0.f) & 0xffffu);
            if (lane < 16) { cosL[i * 16 + lane] = cs; sinL[i * 16 + lane] = sn; }
        }
        asm volatile("s_waitcnt lgkmcnt(0)" ::: "memory");
        if (lane < 32) { const int tk = lane >> 2, ch = lane & 3; const u32x4 rv = *(const LAS u32x4*)(ropeL + tk * 32 + ch * 8);
#pragma unroll
            for (int h = 0; h < NH; ++h) *(u32x4*)(Kb + ((size_t)(b * NH + h) * SEQ + s0 + tk) * DK + 64 + ch * 8) = rv; }
        *(f32x2*)(COS + (size_t)t0 * 16 + 2 * lane) = *(const LAS f32x2*)(cosL + 2 * lane);
        *(f32x2*)(SIN + (size_t)t0 * 16 + 2 * lane) = *(const LAS f32x2*)(sinL + 2 * lane);
        asm volatile("s_waitcnt lgkmcnt(0)" ::: "memory");
    }
}

#define EPI_FENCE() asm volatile("" ::: "memory")
struct EpiQ {
    static constexpr bool PERM = true;
    __device__ __forceinline__ void init(f32x4 (&acc)[2][2][4][2], const Unit&, int, int) const {
#pragma unroll
        for (int a = 0; a < 2; ++a)
#pragma unroll
            for (int b = 0; b < 2; ++b)
#pragma unroll
                for (int m = 0; m < 4; ++m)
#pragma unroll
                    for (int n = 0; n < 2; ++n) acc[a][b][m][n] = (f32x4){0.f, 0.f, 0.f, 0.f};
    }
    bf16_t* Q; float* SSQ; const float* COS; const float* SIN; const float* gq;
    __device__ __forceinline__ void operator()(const f32x4 (&acc)[2][2][4][2], const Unit& u, int wr, int wc, int fr, int fq) const {
        const int t0 = u.pm * 256 + wr * 64 + fr, b = (u.pm * 256) / SEQ, s0 = t0 - b * SEQ;
        if (u.pn < 2) {
            const int h = 4 * u.pn + wc;
            bf16_t* dst0 = Q + ((size_t)(b * NH + h) * SEQ + s0) * DK + 8 * fq;
            float* ssq0 = SSQ + ((size_t)t0 * NH + h) * 2;
            f32x4 gqv[2][2];
#pragma unroll
            for (int bj = 0; bj < 2; ++bj) { gqv[bj][0] = *(const f32x4*)(gq + 32 * bj + 8 * fq); gqv[bj][1] = *(const f32x4*)(gq + 32 * bj + 8 * fq + 4); }
#pragma unroll
            for (int ai = 0; ai < 2; ++ai)
#pragma unroll
                for (int m = 0; m < 4; ++m) {
                    const int dr = ai * 128 + m * 16;
                    float q = 0.f;
#pragma unroll
                    for (int bj = 0; bj < 2; ++bj)
#pragma unroll
                        for (int n = 0; n < 2; ++n) { const f32x4 v = acc[ai][bj][m][n]; q += (v[0] * v[0] + v[1] * v[1]) + (v[2] * v[2] + v[3] * v[3]); }
                    q += __shfl_xor(q, 16); q += __shfl_xor(q, 32);
                    if (fq == 0) ssq0[dr * NH * 2] = q;
#pragma unroll
                    for (int bj = 0; bj < 2; ++bj) { const f32x4 v0 = acc[ai][bj][m][0] * gqv[bj][0], v1 = acc[ai][bj][m][1] * gqv[bj][1];
                        u32x4 w; w.x = cvt_pk_bf16(v0[0], v0[1]); w.y = cvt_pk_bf16(v0[2], v0[3]); w.z = cvt_pk_bf16(v1[0], v1[1]); w.w = cvt_pk_bf16(v1[2], v1[3]);
                        *(u32x4*)(dst0 + dr * DK + 32 * bj) = w; }
                    EPI_FENCE();
                }
        } else {
            const f32x4 g1 = *(const f32x4*)(gq + 64 + 4 * fq), g2 = *(const f32x4*)(gq + 80 + 4 * fq);
            const float* cs0 = COS + (size_t)t0 * 16 + 4 * fq; const float* sn0 = SIN + (size_t)t0 * 16 + 4 * fq;
            bf16_t* dst0 = Q + ((size_t)(b * NH + 2 * wc) * SEQ + s0) * DK + 64 + 4 * fq;
            float* ssq0 = SSQ + ((size_t)t0 * NH + 2 * wc) * 2 + 1;
            f32x4 csb[3][2];
#define EQ_LD(g) do { const int d_ = ((g) >> 2) * 128 + ((g) & 3) * 16; csb[(g) % 3][0] = *(const f32x4*)(cs0 + d_ * 16); csb[(g) % 3][1] = *(const f32x4*)(sn0 + d_ * 16); } while (0)
            EQ_LD(0); EQ_LD(1); EQ_LD(2);
#pragma unroll
            for (int g = 0; g < 8; ++g) { const int ai = g >> 2, m = g & 3; {
                    const int dr = ai * 128 + m * 16;
                    __builtin_amdgcn_sched_barrier(0);
                    const f32x4 cs = csb[g % 3][0], sn = csb[g % 3][1];
#pragma unroll
                    for (int bj = 0; bj < 2; ++bj) {
                        const f32x4 x1 = acc[ai][bj][m][0], x2 = acc[ai][bj][m][1];
                        float q = (x1[0] * x1[0] + x1[1] * x1[1]) + (x1[2] * x1[2] + x1[3] * x1[3]) + (x2[0] * x2[0] + x2[1] * x2[1]) + (x2[2] * x2[2] + x2[3] * x2[3]);
                        q += __shfl_xor(q, 16); q += __shfl_xor(q, 32);
                        if (fq == 0) ssq0[dr * NH * 2 + bj * 2] = q;
                        const f32x4 y1 = x1 * g1, y2 = x2 * g2;
                        const f32x4 o1 = y1 * cs - y2 * sn, o2 = y2 * cs + y1 * sn;
                        bf16_t* dst = dst0 + (size_t)bj * SEQ * DK + dr * DK;
                        u32x2 w1, w2; w1.x = cvt_pk_bf16(o1[0], o1[1]); w1.y = cvt_pk_bf16(o1[2], o1[3]); w2.x = cvt_pk_bf16(o2[0], o2[1]); w2.y = cvt_pk_bf16(o2[2], o2[3]);
                        *(u32x2*)(dst) = w1; *(u32x2*)(dst + 16) = w2;
                    }
                    __builtin_amdgcn_sched_barrier(0);
                    if (g + 3 < 8) EQ_LD(g + 3);
                } }
#undef EQ_LD
        }
    }
};
struct EpiKV {
    static constexpr bool PERM = true;
    __device__ __forceinline__ void init(f32x4 (&acc)[2][2][4][2], const Unit&, int, int) const {
#pragma unroll
        for (int a = 0; a < 2; ++a)
#pragma unroll
            for (int b = 0; b < 2; ++b)
#pragma unroll
                for (int m = 0; m < 4; ++m)
#pragma unroll
                    for (int n = 0; n < 2; ++n) acc[a][b][m][n] = (f32x4){0.f, 0.f, 0.f, 0.f};
    }
    bf16_t* K; bf16_t* V; const float* gk;
    __device__ __forceinline__ void operator()(const f32x4 (&acc)[2][2][4][2], const Unit& u, int wr, int wc, int fr, int fq) const {
        const int t0 = u.pm * 256 + wr * 64 + fr, b = (u.pm * 256) / SEQ, s0 = t0 - b * SEQ;
        const int h = 2 * u.pn + (wc & 1); const bool isv = wc >= 2;
        const int pitch = isv ? DV : DK;
        bf16_t* dst0 = (isv ? V : K) + ((size_t)(b * NH + h) * SEQ + s0) * pitch + 8 * fq;
        f32x4 gkv[2][2];
#pragma unroll
        for (int bj = 0; bj < 2; ++bj) { gkv[bj][0] = *(const f32x4*)(gk + 32 * bj + 8 * fq); gkv[bj][1] = *(const f32x4*)(gk + 32 * bj + 8 * fq + 4); }
#pragma unroll
        for (int ai = 0; ai < 2; ++ai)
#pragma unroll
            for (int m = 0; m < 4; ++m) {
                const int dr = ai * 128 + m * 16;
                float sc = 1.f;
                if (!isv) { float q = 0.f;
#pragma unroll
                    for (int bj = 0; bj < 2; ++bj)
#pragma unroll
                        for (int n = 0; n < 2; ++n) { const f32x4 v = acc[ai][bj][m][n]; q += (v[0] * v[0] + v[1] * v[1]) + (v[2] * v[2] + v[3] * v[3]); }
                    q += __shfl_xor(q, 16); q += __shfl_xor(q, 32);
                    sc = 1.0f / sqrtf(q * (1.f / 64.f) + EPS); }
#pragma unroll
                for (int bj = 0; bj < 2; ++bj) {
                    f32x4 v0 = acc[ai][bj][m][0] * sc, v1 = acc[ai][bj][m][1] * sc;
                    if (!isv) { v0 = v0 * gkv[bj][0]; v1 = v1 * gkv[bj][1]; }
                    u32x4 w; w.x = cvt_pk_bf16(v0[0], v0[1]); w.y = cvt_pk_bf16(v0[2], v0[3]); w.z = cvt_pk_bf16(v1[0], v1[1]); w.w = cvt_pk_bf16(v1[2], v1[3]);
                    *(u32x4*)(dst0 + dr * pitch + 32 * bj) = w; }
                EPI_FENCE();
            }
    }
};

namespace att {
constexpr int KT_BYTES = 64 * 192, VT_BYTES = 64 * 128, SLOT_BYTES = KT_BYTES + VT_BYTES;
#ifndef ATT_PF
#define ATT_PF 3
#endif
constexpr int NSLOT = ATT_PF + 1, SCR_OFF = NSLOT * SLOT_BYTES;
__device__ __forceinline__ int crow(int r, int hi) { return (r & 3) + 8 * (r >> 2) + 4 * hi; }
__device__ __forceinline__ s16x4 vtr(const LAS unsigned char* p) { typedef short v4i16_t __attribute__((ext_vector_type(4)));
    return __builtin_bit_cast(s16x4, __builtin_amdgcn_ds_read_tr16_b64_v4i16((LAS v4i16_t*)p)); }
#define MFMA32(a, b, c) __builtin_amdgcn_mfma_f32_32x32x16_bf16(a, b, c, 0, 0, 0)
__device__ __forceinline__ float max3f(float a, float b, float c) { return __builtin_fmaxf(__builtin_fmaxf(a, b), c); }


constexpr int CONV_OFF = SCR_OFF + 8 * 256, CONV_BYTES = 8192;
constexpr int CV_GU_ITEMS = NEXP * 1024, CV_ITEMS = CV_GU_ITEMS + NEXP * 512;
struct ConvItem { const float* src; unsigned char* dst; int N, isgu, n0; };
__device__ __forceinline__ ConvItem cv_setup(int g, const float* wgu, const float* wd, unsigned char* wgu8, unsigned char* wd8) {
    ConvItem I;
    if (g < CV_GU_ITEMS) { const int e = g >> 10, it = g & 1023, kb = it >> 6, nb = it & 63; I.N = 2048; I.isgu = 1; I.n0 = 32 * nb;
        I.src = wgu + (size_t)e * 1024 * 2048 + (size_t)(64 * kb) * 2048 + 32 * nb; I.dst = wgu8 + (size_t)e * 2048 * 1024 + 64 * kb; }
    else { const int g2 = g - CV_GU_ITEMS, e = g2 >> 9, it = g2 & 511, kb = it >> 5, nb = it & 31; I.N = 1024; I.isgu = 0; I.n0 = 32 * nb;
        I.src = wd + (size_t)e * 1024 * 1024 + (size_t)(64 * kb) * 1024 + 32 * nb; I.dst = wd8 + (size_t)e * 1024 * 1024 + 64 * kb; }
    return I;
}
__device__ __forceinline__ void cv_dma(const ConvItem& I, unsigned ldsaddr, int lane) {
    const int kr = lane >> 3, sl = lane & 7;
#pragma unroll
    for (int q = 0; q < 8; ++q) { const unsigned voff = (unsigned)(((8 * q + kr) * I.N + 4 * (sl ^ ((kr ^ q) & 7))) * 4);
        asm volatile("s_nop 4\n\ts_mov_b32 m0, %0\n\ts_nop 0\n\tglobal_load_lds_dwordx4 %1, %2 nt" :: "s"(ldsaddr + (unsigned)q * 1024u), "v"(voff), "s"(I.src) : "m0", "memory"); }
}
__device__ __forceinline__ void cv_out(const ConvItem& I, const LAS float* cb, int lane) {
    asm volatile("" : "+v"(lane));
    const int c = lane & 7, odd = c & 1;
    const float sc = I.isgu ? 8.0f : 64.0f;
#pragma unroll
    for (int jp = 0; jp < 2; ++jp) {
        u32x2 w[2];
#pragma unroll
        for (int q = 0; q < 2; ++q) { const int n = (lane >> 3) + 8 * (2 * jp + q), nc = n >> 2, e = n & 3;
            float f[8];
#pragma unroll
            for (int kk = 0; kk < 8; ++kk) f[kk] = cb[(8 * c + kk) * 32 + ((nc ^ kk ^ c) & 7) * 4 + e];
            w[q] = cvt8_fp8((f32x4){f[0], f[1], f[2], f[3]}, (f32x4){f[4], f[5], f[6], f[7]}, sc); }
        const unsigned sx = odd ? w[0].x : w[1].x, sy = odd ? w[0].y : w[1].y;
        const unsigned rx = (unsigned)__builtin_amdgcn_mov_dpp((int)sx, 0xB1, 0xF, 0xF, true), ry = (unsigned)__builtin_amdgcn_mov_dpp((int)sy, 0xB1, 0xF, 0xF, true);
        u32x4 o; o.x = odd ? rx : w[0].x; o.y = odd ? ry : w[0].y; o.z = odd ? w[1].x : rx; o.w = odd ? w[1].y : ry;
        const int n = (lane >> 3) + 8 * (2 * jp + odd); const int nn = I.n0 + n; const int row = I.isgu ? (256 * ((nn & 1023) >> 7) + 128 * (nn >> 10) + (nn & 127)) : nn;
        *(u32x4*)(I.dst + (size_t)row * 1024 + 8 * (c & ~1)) = o;
        asm volatile("" ::: "memory"); }
}
struct ConvState { int next, end, cur; };
__device__ __forceinline__ void attn_unit(LAS unsigned char* lds, const u32x4 srd, ConvState& CV, unsigned char* cvws, int bh, int qb, const bf16_t* Q_, unsigned Koff, unsigned Voff, const float* SSQ_, bf16_t* O_, const bool fast) {
    (void)Q_; (void)SSQ_; (void)O_;
    unsigned char* wl_ = cvws; asm volatile("" : "+s"(wl_));
    const bf16_t* Q = (const bf16_t*)(wl_ + WS_Q); const float* SSQ = (const float*)(wl_ + WS_SSQ); bf16_t* O = (bf16_t*)(wl_ + WS_ATT);
    const int tid = tid_local(), lane = tid & 63, r32 = lane & 31, hi = lane >> 5; const int wid = __builtin_amdgcn_readfirstlane(tid >> 6);
    const int b = bh / NH, h = bh % NH, q0 = qb * 256, qw = q0 + 32 * wid;
    LAS float* scr = (LAS float*)(lds + SCR_OFF) + wid * 64;
    const int NT = (q0 + 256) / 64;
    const unsigned kS = Koff + (unsigned)bh * (SEQ * DK * 2), vS = Voff + (unsigned)bh * (SEQ * DV * 2);
    const int kc2 = 8 + (wid & 3);
    const unsigned vK1 = (unsigned)(lane * 192 + wid * 16); const unsigned sK2 = (unsigned)((kc2 - wid) * 16);
    const int vkey = 8 * wid + (lane >> 3); const unsigned vV = (unsigned)(vkey * 128 + (((lane & 7) ^ (((vkey >> 1) & 1) * 4)) * 16));
    const unsigned lds0 = (unsigned)__builtin_amdgcn_readfirstlane((int)(unsigned)(unsigned long)lds);
    const unsigned dK1 = (unsigned)wid * 1024u, dK2 = (unsigned)kc2 * 1024u, dV = (unsigned)KT_BYTES + (unsigned)wid * 1024u;
#define ATT_DMA1(ldsaddr, voff, soff) asm volatile("s_nop 4\n\ts_mov_b32 m0, %0\n\ts_nop 0\n\tbuffer_load_dwordx4 %1, %2, %3 offen lds" :: "s"(ldsaddr), "v"(voff), "s"(srd), "s"(soff) : "m0", "memory")
#define ATT_DMA(t) do { const unsigned sp_ = lds0 + (unsigned)((t) % NSLOT) * SLOT_BYTES; const unsigned ks_ = kS + (unsigned)(t) * (64 * 192), vs_ = vS + (unsigned)(t) * (64 * 128); \
        ATT_DMA1(sp_ + dK1, vK1, ks_); ATT_DMA1(sp_ + dK2, vK1, ks_ + sK2); ATT_DMA1(sp_ + dV, vV, vs_); } while (0)
#define ATT_WAITBAR(N) asm volatile("s_waitcnt vmcnt(" #N ") lgkmcnt(0)\n\ts_barrier" ::: "memory")
    ATT_DMA(0); ATT_DMA(1); ATT_DMA(2);
    bf16x8 qr[6];
    { const float* sp = SSQ + ((size_t)(b * SEQ + qw + r32) * NH + h) * 2; const float ss = sp[0] + sp[1];
      const float cq = (1.0f / sqrtf(ss * (1.f / 96.f) + EPS)) * 0.10206207261596577f * 1.4426950408889634f;
      const bf16_t* qp = Q + ((size_t)bh * SEQ + qw + r32) * DK + 8 * hi;
      u32x4 qw_[6];
#pragma unroll
      for (int d0 = 0; d0 < 6; ++d0) qw_[d0] = *(const u32x4*)(qp + 16 * d0);
#pragma unroll
      for (int d0 = 0; d0 < 6; ++d0) { const u32x4 w = qw_[d0]; u32x4 o;
          o.x = cvt_pk_bf16(bf_lo(w.x) * cq, bf_hi(w.x) * cq); o.y = cvt_pk_bf16(bf_lo(w.y) * cq, bf_hi(w.y) * cq); o.z = cvt_pk_bf16(bf_lo(w.z) * cq, bf_hi(w.z) * cq); o.w = cvt_pk_bf16(bf_lo(w.w) * cq, bf_hi(w.w) * cq);
          qr[d0] = __builtin_bit_cast(bf16x8, o); } }
    const int kbase = hi * 1024 + r32 * 16;
    const int qq = (lane & 15) >> 2, pp = lane & 3, dblk = (lane >> 4) & 1, swz = ((qq >> 1) & 1) * 64;
    const int vrow0 = 4 * hi + qq;
    const int vb0 = KT_BYTES + vrow0 * 128 + ((32 * dblk + 8 * pp) ^ swz);
    const int vb1 = KT_BYTES + vrow0 * 128 + ((64 + 32 * dblk + 8 * pp) ^ swz);
    f32x16 o0 = {}, o1 = {};
    float m_run = -1e30f, l_run = 0.f; const f32x16 zero16 = {};
    const int qa = qw + r32;
#define ATT_QK(N0, N1, t) do { const LAS unsigned char* kp_ = lds + ((t) % NSLOT) * SLOT_BYTES + kbase; \
        _Pragma("unroll") for (int d0 = 0; d0 < 6; ++d0) { const bf16x8 ka_ = *(const LAS bf16x8*)(kp_ + d0 * 2048), kb_ = *(const LAS bf16x8*)(kp_ + d0 * 2048 + 512); \
            if (d0 == 0) { N0 = MFMA32(ka_, qr[0], zero16); N1 = MFMA32(kb_, qr[0], zero16); } else { N0 = MFMA32(ka_, qr[d0], N0); N1 = MFMA32(kb_, qr[d0], N1); } } } while (0)
#define ATT_MASK(N0, N1, t) do { const int kb_ = 64 * (t); if (kb_ + 63 > qw) { int d_ = qa - kb_ - 4 * hi; asm volatile("" : "+v"(d_));        \
        _Pragma("unroll") for (int r = 0; r < 16; ++r) { const int c_ = (r & 3) + 8 * (r >> 2); \
        if (c_ > d_) N0[r] = -__builtin_inff(); if (c_ + 32 > d_) N1[r] = -__builtin_inff(); } } } while (0)
#define ATT_ROWMAX(N0, N1, PM) do { float a_ = max3f(N0[0], N0[1], N1[0]), b_ = max3f(N0[2], N0[3], N1[1]); a_ = max3f(a_, N1[2], N1[3]); \
        _Pragma("unroll") for (int r = 4; r < 16; r += 4) { a_ = max3f(a_, N0[r], N0[r + 1]); b_ = max3f(b_, N0[r + 2], N0[r + 3]); a_ = max3f(a_, N1[r], N1[r + 1]); b_ = max3f(b_, N1[r + 2], N1[r + 3]); } \
        a_ = max3f(a_, b_, b_); auto rr_ = __builtin_amdgcn_permlane32_swap(__float_as_uint(a_), __float_as_uint(a_), false, false); \
        PM = max3f(__uint_as_float(rr_[0]), __uint_as_float(rr_[1]), __uint_as_float(rr_[1])); } while (0)
#define ATT_DECIDE(PM, C0, C1, FORCE) do { if ((FORCE) || __any((PM) > m_run + 8.0f)) { const float mn_ = fmaxf(m_run, (PM)); const float al_ = __builtin_amdgcn_exp2f(m_run - mn_); m_run = mn_; l_run *= al_; \
        if (hi == 0) scr[r32] = al_; asm volatile("s_waitcnt lgkmcnt(0)" ::: "memory"); \
        _Pragma("unroll") for (int a4 = 0; a4 < 4; ++a4) { const f32x4 f_ = *(const LAS f32x4*)(scr + 8 * a4 + 4 * hi); \
            _Pragma("unroll") for (int e = 0; e < 4; ++e) { o0[4 * a4 + e] *= f_[e]; o1[4 * a4 + e] *= f_[e]; } } } } while (0)
#define ATT_SM_HALF(P_, ks0, SUBM) do { _Pragma("unroll") for (int r = 0; r < 16; ++r) { P_[r] = __builtin_amdgcn_exp2f((SUBM) ? P_[r] - m_run : P_[r]); ps_ += P_[r]; } \
        _Pragma("unroll") for (int kq = 0; kq < 2; ++kq) { const int bs_ = 8 * kq; \
            u32x4 w_; w_.x = cvt_pk_bf16(P_[bs_ + 0], P_[bs_ + 1]); w_.y = cvt_pk_bf16(P_[bs_ + 2], P_[bs_ + 3]); w_.z = cvt_pk_bf16(P_[bs_ + 4], P_[bs_ + 5]); w_.w = cvt_pk_bf16(P_[bs_ + 6], P_[bs_ + 7]); \
            pa[(ks0) + kq] = __builtin_bit_cast(bf16x8, w_); } } while (0)
#define ATT_SOFTMAX(C0, C1) do { float ps_ = 0.f; ATT_SM_HALF(C0, 0, true); ATT_SM_HALF(C1, 2, true); l_run += ps_; } while (0)
#define ATT_SOFTMAX_F(C0, C1) do { float ps_ = 0.f; ATT_SM_HALF(C0, 0, false); ATT_SM_HALF(C1, 2, false); l_run += ps_; } while (0)
#define ATT_PV(t) do { const LAS unsigned char* vp0_ = lds + ((t) % NSLOT) * SLOT_BYTES + vb0; const LAS unsigned char* vp1_ = lds + ((t) % NSLOT) * SLOT_BYTES + vb1; \
        _Pragma("unroll") for (int ks = 0; ks < 4; ++ks) { \
            const s16x4 a0_ = vtr(vp0_ + ks * 16 * 128), a1_ = vtr(vp0_ + ks * 16 * 128 + 8 * 128), c0_ = vtr(vp1_ + ks * 16 * 128), c1_ = vtr(vp1_ + ks * 16 * 128 + 8 * 128); \
            const bf16x8 vf0_ = {a0_[0], a0_[1], a0_[2], a0_[3], a1_[0], a1_[1], a1_[2], a1_[3]}; const bf16x8 vf1_ = {c0_[0], c0_[1], c0_[2], c0_[3], c1_[0], c1_[1], c1_[2], c1_[3]}; \
            o0 = MFMA32(pa[ks], vf0_, o0); o1 = MFMA32(pa[ks], vf1_, o1); } } while (0)
#ifdef ATT_PROBE2
    unsigned long long ap_s[4] = {0, 0, 0, 0}, ap_acc[3] = {0, 0, 0};
#define AP_STAMP(k) do { __builtin_amdgcn_sched_barrier(0); asm volatile("s_memtime %0\n\ts_waitcnt lgkmcnt(0)" : "=s"(ap_s[k]) :: "memory"); __builtin_amdgcn_sched_barrier(0); if ((k) > 0) ap_acc[(k) - 1] += ap_s[k] - ap_s[(k) - 1]; } while (0)
#else
#define AP_STAMP(k) do {} while (0)
#endif
#define ATT_WB(N) asm volatile("s_waitcnt vmcnt(" #N ") lgkmcnt(0)\n\ts_barrier" ::: "memory")
#define ATT_RDK(d0) do { kf_[d0][0] = *(const LAS bf16x8*)(kp_ + (d0) * 2048); kf_[d0][1] = *(const LAS bf16x8*)(kp_ + (d0) * 2048 + 512); } while (0)
#define ATT_RDV(ks) do { vf_[ks][0] = vtr(vp0_ + (ks) * 16 * 128); vf_[ks][1] = vtr(vp0_ + (ks) * 16 * 128 + 8 * 128); vf_[ks][2] = vtr(vp1_ + (ks) * 16 * 128); vf_[ks][3] = vtr(vp1_ + (ks) * 16 * 128 + 8 * 128); } while (0)
#define ATT_MK(d0) do { if ((d0) == 0) { S0 = MFMA32(kf_[0][0], qr[0], zero16); S1 = MFMA32(kf_[0][1], qr[0], zero16); } else { S0 = MFMA32(kf_[d0][0], qr[d0], S0); S1 = MFMA32(kf_[d0][1], qr[d0], S1); } } while (0)
#define ATT_MV(ks) do { const bf16x8 v0_ = {vf_[ks][0][0], vf_[ks][0][1], vf_[ks][0][2], vf_[ks][0][3], vf_[ks][1][0], vf_[ks][1][1], vf_[ks][1][2], vf_[ks][1][3]}; \
        const bf16x8 v1_ = {vf_[ks][2][0], vf_[ks][2][1], vf_[ks][2][2], vf_[ks][2][3], vf_[ks][3][0], vf_[ks][3][1], vf_[ks][3][2], vf_[ks][3][3]}; \
        o0 = MFMA32(pa[ks], v0_, o0); o1 = MFMA32(pa[ks], v1_, o1); } while (0)
#define ATT_SB __builtin_amdgcn_sched_barrier(0)
#define ATT_SEGA(j, DODMA) do { \
        const LAS unsigned char* kp_ = lds + (((j) + 1) % NSLOT) * SLOT_BYTES + kbase; \
        const LAS unsigned char* vp0_ = lds + ((j) % NSLOT) * SLOT_BYTES + vb0; const LAS unsigned char* vp1_ = lds + ((j) % NSLOT) * SLOT_BYTES + vb1; \
        bf16x8 kf_[6][2]; s16x4 vf_[4][4]; \
        ATT_RDK(0); ATT_RDK(1); ATT_RDV(0); ATT_SB; \
        if (DODMA) { ATT_DMA((j) + ATT_PF); } ATT_SB; \
        ATT_MK(0); ATT_SB; ATT_RDK(2); ATT_SB; ATT_MK(1); ATT_SB; ATT_RDK(3); ATT_SB; ATT_MV(0); ATT_SB; ATT_RDV(1); ATT_SB; \
        ATT_MK(2); ATT_SB; ATT_RDK(4); ATT_SB; ATT_MK(3); ATT_SB; ATT_RDV(2); ATT_SB; ATT_MV(1); ATT_SB; ATT_RDK(5); ATT_SB; \
        ATT_MK(4); ATT_SB; ATT_MV(2); ATT_SB; ATT_RDV(3); ATT_SB; ATT_MK(5); ATT_MV(3); } while (0)
#define ATT_BARP asm volatile("s_waitcnt lgkmcnt(0)\n\ts_barrier" ::: "memory")
#define ATT_STEP(j, MSK, CONV, FAST) do { \
        if (MSK) ATT_MASK(S0, S1, (j)); \
        if (!(FAST)) { float pm_; ATT_ROWMAX(S0, S1, pm_); ATT_DECIDE(pm_, S0, S1, false); } \
        if (FAST) ATT_SOFTMAX_F(S0, S1); else ATT_SOFTMAX(S0, S1); \
        int infl_ = 0; \
        if (CONV) { __builtin_amdgcn_sched_barrier(0); const LAS float* cb_ = (const LAS float*)(lds + CONV_OFF + wid * CONV_BYTES); \
            if (CV.cur >= 0) { const ConvItem I_ = cv_setup(CV.cur, kargs()->in[I_WGU], kargs()->in[I_WD], cvws + WS_WGU, cvws + WS_WD); cv_out(I_, cb_, lane); infl_ += 2; } \
            if (CV.next < CV.end) { const ConvItem I_ = cv_setup(CV.next, kargs()->in[I_WGU], kargs()->in[I_WD], cvws + WS_WGU, cvws + WS_WD); asm volatile("s_waitcnt lgkmcnt(0)" ::: "memory"); \
                cv_dma(I_, lds0 + (unsigned)(CONV_OFF + wid * CONV_BYTES), lane); CV.cur = CV.next; CV.next += 2048; infl_ += 8; } else CV.cur = -1; } \
        __builtin_amdgcn_sched_barrier(0); ATT_BARP; __builtin_amdgcn_sched_barrier(0); \
        ATT_SEGA((j), ((j) + ATT_PF < NT)); if ((j) + ATT_PF < NT) infl_ += 3; \
        __builtin_amdgcn_sched_barrier(0); \
        if (!(CONV)) { if (infl_ == 3) ATT_WB(3); else ATT_WB(0); } \
        else switch (infl_) { case 13: ATT_WB(13); break; case 11: ATT_WB(11); break; case 10: ATT_WB(10); break; case 8: ATT_WB(8); break; case 5: ATT_WB(5); break; case 3: ATT_WB(3); break; case 2: ATT_WB(2); break; default: ATT_WB(0); break; } \
        __builtin_amdgcn_sched_barrier(0); } while (0)
    bf16x8 pa[4];
    f32x16 S0, S1;
    const bool grpY = wid >= 4;
    ATT_WAITBAR(6);
    if (grpY) ATT_BARP;
    __builtin_amdgcn_sched_barrier(0);
    ATT_QK(S0, S1, 0);
    __builtin_amdgcn_sched_barrier(0);
    ATT_WAITBAR(3);
    __builtin_amdgcn_sched_barrier(0);
    int j = 0;
    if (fast) {
        for (; j < NT - 4; j += 2) {
            ATT_STEP(j, false, CONV_IN_ATTN, true);
            ATT_STEP(j + 1, false, false, true);
        }
        for (; j < NT; j += 2) {
            ATT_STEP(j, true, CONV_IN_ATTN, true);
            ATT_STEP(j + 1, true, false, true);
        }
    } else {
        for (; j < NT - 4; j += 2) {
            ATT_STEP(j, false, CONV_IN_ATTN, false);
            ATT_STEP(j + 1, false, false, false);
        }
        for (; j < NT; j += 2) {
            ATT_STEP(j, true, CONV_IN_ATTN, false);
            ATT_STEP(j + 1, true, false, false);
        }
    }
    if (!grpY) ATT_BARP;
    __builtin_amdgcn_sched_barrier(0);
#ifdef ATT_PROBE2
    if (blockIdx.x == 17 && tid == 0) { unsigned long long* ap2 = (unsigned long long*)(cvws + WS_CTL + 65536 + 128); ap2[0] += ap_acc[0]; ap2[1] += ap_acc[1]; ap2[2] += ap_acc[2]; ap2[3] += (unsigned long long)NT; }
#endif
#ifdef ATT_PROBE
    if (blockIdx.x == 17 && tid == 0) { unsigned long long* ap = (unsigned long long*)(cvws + WS_CTL + 65536 + 64); ap[0] += __builtin_amdgcn_s_memtime() - ap_t0; ap[1] += (unsigned long long)NT; }
#endif
#undef ATT_DMA
#undef ATT_DMA1
#undef ATT_WAITBAR
#undef ATT_QK
#undef ATT_MASK
#undef ATT_ROWMAX
#undef ATT_DECIDE
#undef ATT_SOFTMAX
#undef ATT_SOFTMAX_F
#undef ATT_SM_HALF
#undef ATT_PV
#undef ATT_STEP
#undef ATT_WB
#undef ATT_BARP
#undef ATT_SEGA
#undef ATT_RDK
#undef ATT_RDV
#undef ATT_MK
#undef ATT_MV
#undef ATT_SB
#undef AP_STAMP
    { auto rr = __builtin_amdgcn_permlane32_swap(__float_as_uint(l_run), __float_as_uint(l_run), false, false); l_run = __uint_as_float(rr[0]) + __uint_as_float(rr[1]); }
    if (hi == 0) scr[32 + r32] = 1.0f / l_run;
    asm volatile("s_waitcnt lgkmcnt(0)" ::: "memory");
    { LAS bf16_t* ob = (LAS bf16_t*)(lds + wid * 4608);
#pragma unroll
      for (int a4 = 0; a4 < 4; ++a4) { const f32x4 f = *(const LAS f32x4*)(scr + 32 + 8 * a4 + 4 * hi);
#pragma unroll
          for (int e = 0; e < 4; ++e) { const int r = 4 * a4 + e; const int row = crow(r, hi);
              ob[row * 72 + r32] = (bf16_t)(cvt_pk_bf16(o0[r] * f[e], 0.f) & 0xffffu);
              ob[row * 72 + 32 + r32] = (bf16_t)(cvt_pk_bf16(o1[r] * f[e], 0.f) & 0xffffu); } }
      asm volatile("s_waitcnt lgkmcnt(0)" ::: "memory");
      bf16_t* Ow = O + ((size_t)(b * SEQ + qw)) * 512 + h * 64;
#pragma unroll
      for (int q = 0; q < 4; ++q) { const int row = 8 * q + (lane >> 3), ch = lane & 7;
          *(u32x4*)(Ow + (size_t)row * 512 + 8 * ch) = *(const LAS u32x4*)(ob + row * 72 + 8 * ch); } }
    __syncthreads();
}
#undef MFMA32
}

struct MixOrder {
    int G, c; unsigned ATT, MIXED, WAO, WPO;
    __device__ __forceinline__ bool next(int i, Unit& u) const {
        const int tile = (i >> 1) * G + c; if (tile >= 256) return false;
        u.pm = tile >> 2; u.pn = tile & 3; u.aux = i & 1; return true;
    }
    __device__ __forceinline__ void prefetch(const Unit&, const __amdgpu_buffer_rsrc_t, LAS unsigned char*, int, int) const {}
    __device__ __forceinline__ unsigned a_off(const Unit& u) const { return (u.aux ? MIXED : ATT) + (unsigned)u.pm * (256 * 512 * 2); }
    __device__ __forceinline__ unsigned b_off(const Unit& u) const { return (u.aux ? WPO : WAO) + (unsigned)u.pn * (256 * 512 * 2); }
};
struct EpiMix {
    static constexpr bool PERM = true;
    __device__ __forceinline__ void init(f32x4 (&acc)[2][2][4][2], const Unit& u, int, int) const {
        if (u.aux) return;
#pragma unroll
        for (int a = 0; a < 2; ++a)
#pragma unroll
            for (int b = 0; b < 2; ++b)
#pragma unroll
                for (int m = 0; m < 4; ++m)
#pragma unroll
                    for (int n = 0; n < 2; ++n) acc[a][b][m][n] = (f32x4){0.f, 0.f, 0.f, 0.f};
    }
    bf16_t* MIX; const bf16_t* GATES;
    __device__ __forceinline__ void operator()(f32x4 (&acc)[2][2][4][2], const Unit& u, int wr, int wc, int fr, int fq) const {
        const int row0 = u.pm * 256 + wr * 64 + fr, col0 = u.pn * 256 + wc * 32 + 8 * fq;
        const bool p0_ = u.aux == 0;
#if GATE8 == 2
        {
            const unsigned char* gb_ = (const unsigned char*)GATES + (size_t)row0 * 2048 + u.pn * 256 + wc * 64 + fq * 16;
            u32x4 gbuf[3][2];
#define EM8_LD(g) do { const unsigned char* p_ = gb_ + (size_t)(((g) >> 2) * 128 + ((g) & 3) * 16) * 2048; gbuf[(g) % 3][0] = *(const u32x4*)(p_ + 1024); if (p0_) gbuf[(g) % 3][1] = *(const u32x4*)(p_); } while (0)
#define EM8_DEC(wa, wb, lo, hi) do { lo = (f32x4){(float)((wa) & 0xffu), (float)(((wa) >> 8) & 0xffu), (float)(((wa) >> 16) & 0xffu), (float)((wa) >> 24)}; hi = (f32x4){(float)((wb) & 0xffu), (float)(((wb) >> 8) & 0xffu), (float)(((wb) >> 16) & 0xffu), (float)((wb) >> 24)}; } while (0)
            EM8_LD(0); EM8_LD(1); EM8_LD(2);
#pragma unroll
            for (int g = 0; g < 8; ++g) { const int ai = g >> 2, m = g & 3; const size_t row = (size_t)(row0 + ai * 128 + m * 16);
                __builtin_amdgcn_sched_barrier(0);
                const u32x4 gpw = gbuf[g % 3][0], gaw = gbuf[g % 3][1];
#pragma unroll
                for (int bj = 0; bj < 2; ++bj) { f32x4 p0, p1; EM8_DEC(bj ? gpw.z : gpw.x, bj ? gpw.w : gpw.y, p0, p1);
                    if (p0_) { f32x4 a0, a1; EM8_DEC(bj ? gaw.z : gaw.x, bj ? gaw.w : gaw.y, a0, a1);
#pragma unroll
                        for (int e = 0; e < 4; ++e) { acc[ai][bj][m][0][e] *= a0[e] * __builtin_amdgcn_rcpf(p0[e]); acc[ai][bj][m][1][e] *= a1[e] * __builtin_amdgcn_rcpf(p1[e]); }
                    } else {
                        const f32x4 v0 = acc[ai][bj][m][0] * (p0 * (1.0f / 255.0f)), v1 = acc[ai][bj][m][1] * (p1 * (1.0f / 255.0f));
                        u32x4 w; w.x = cvt_pk_bf16(v0[0], v0[1]); w.y = cvt_pk_bf16(v0[2], v0[3]); w.z = cvt_pk_bf16(v1[0], v1[1]); w.w = cvt_pk_bf16(v1[2], v1[3]);
                        *(u32x4*)(MIX + row * 1024 + col0 + bj * 128) = w; } }
                __builtin_amdgcn_sched_barrier(0);
                if (g + 3 < 8) EM8_LD(g + 3);
            }
#undef EM8_LD
#undef EM8_DEC
            return;
        }
        typedef u32x2 gv_t; const unsigned char* gb_ = (const unsigned char*)GATES + (size_t)row0 * 2048 + col0;
#define EM_LD1(p) (*(const u32x2*)(p))
#define EM_DEC(GW_, lo, hi) do { (void)(GW_); } while (0)
        constexpr size_t GROW = 2048, GHALF = 1024, GBJ = 128; constexpr float GSC = 1.0f / 255.0f;
#elif GATE8
        typedef u32x2 gv_t; const unsigned char* gb_ = (const unsigned char*)GATES + (size_t)row0 * 2048 + col0;
#define EM_LD1(p) (*(const u32x2*)(p))
#define EM_DEC(GW_, lo, hi) do { const gv_t t_ = (GW_); const f32x2 a_ = __builtin_amdgcn_cvt_pk_f32_fp8((int)t_.x, false), b_ = __builtin_amdgcn_cvt_pk_f32_fp8((int)t_.x, true), c_ = __builtin_amdgcn_cvt_pk_f32_fp8((int)t_.y, false), d_ = __builtin_amdgcn_cvt_pk_f32_fp8((int)t_.y, true); \
        lo = (f32x4){a_[0], a_[1], b_[0], b_[1]}; hi = (f32x4){c_[0], c_[1], d_[0], d_[1]}; } while (0)
        constexpr size_t GROW = 2048, GHALF = 1024, GBJ = 128; constexpr float GSC = 1.0f / 256.0f;
#else
        typedef u32x4 gv_t; const bf16_t* gb_ = GATES + (size_t)row0 * 2048 + col0;
#define EM_LD1(p) (*(const u32x4*)(p))
#define EM_DEC(GW_, lo, hi) do { const gv_t t_ = (GW_); lo = (f32x4){bf_lo(t_.x), bf_hi(t_.x), bf_lo(t_.y), bf_hi(t_.y)}; hi = (f32x4){bf_lo(t_.z), bf_hi(t_.z), bf_lo(t_.w), bf_hi(t_.w)}; } while (0)
        constexpr size_t GROW = 2048, GHALF = 1024, GBJ = 128; constexpr float GSC = 1.0f;
#endif
        gv_t buf[3][4];
#define EM_LD(g) do { const auto* p_ = gb_ + (size_t)(((g) >> 2) * 128 + ((g) & 3) * 16) * GROW; \
        _Pragma("unroll") for (int bj = 0; bj < 2; ++bj) { buf[(g) % 3][2 * bj] = EM_LD1(p_ + GHALF + bj * GBJ); if (p0_) buf[(g) % 3][2 * bj + 1] = EM_LD1(p_ + bj * GBJ); } } while (0)
        EM_LD(0); EM_LD(1); EM_LD(2);
#pragma unroll
        for (int g = 0; g < 8; ++g) { const int ai = g >> 2, m = g & 3; const size_t row = (size_t)(row0 + ai * 128 + m * 16);
            __builtin_amdgcn_sched_barrier(0);
#pragma unroll
            for (int bj = 0; bj < 2; ++bj) { f32x4 p0, p1; EM_DEC(buf[g % 3][2 * bj], p0, p1);
                if (p0_) { f32x4 a0, a1; EM_DEC(buf[g % 3][2 * bj + 1], a0, a1);
#pragma unroll
                    for (int e = 0; e < 4; ++e) { acc[ai][bj][m][0][e] *= a0[e] * __builtin_amdgcn_rcpf(p0[e]); acc[ai][bj][m][1][e] *= a1[e] * __builtin_amdgcn_rcpf(p1[e]); }
                } else {
                    const f32x4 v0 = acc[ai][bj][m][0] * (p0 * GSC), v1 = acc[ai][bj][m][1] * (p1 * GSC);
                    u32x4 w; w.x = cvt_pk_bf16(v0[0], v0[1]); w.y = cvt_pk_bf16(v0[2], v0[3]); w.z = cvt_pk_bf16(v1[0], v1[1]); w.w = cvt_pk_bf16(v1[2], v1[3]);
                    *(u32x4*)(MIX + row * 1024 + col0 + bj * 128) = w; } }
            __builtin_amdgcn_sched_barrier(0);
            if (g + 3 < 8) EM_LD(g + 3);
        }
#undef EM_LD
#undef EM_LD1
#undef EM_DEC
    }
};
struct EpiRes {
    static constexpr bool PERM = true;
    __device__ __forceinline__ void init(f32x4 (&acc)[2][2][4][2], const Unit&, int, int) const {
#pragma unroll
        for (int a = 0; a < 2; ++a)
#pragma unroll
            for (int b = 0; b < 2; ++b)
#pragma unroll
                for (int m = 0; m < 4; ++m)
#pragma unroll
                    for (int n = 0; n < 2; ++n) acc[a][b][m][n] = (f32x4){0.f, 0.f, 0.f, 0.f};
    }
    const float* base; bf16_t* out;
    __device__ __forceinline__ void operator()(const f32x4 (&acc)[2][2][4][2], const Unit& u, int wr, int wc, int fr, int fq) const {
        const int row0 = u.pm * 256 + wr * 64 + fr, col0 = u.pn * 256 + wc * 32 + 8 * fq;
        const size_t off0 = (size_t)row0 * DM + col0;
        f32x4 buf[3][4];
#define ER_LD(g) do { const float* p_ = base + off0 + (size_t)(((g) >> 2) * 128 + ((g) & 3) * 16) * DM; \
        _Pragma("unroll") for (int q = 0; q < 4; ++q) buf[(g) % 3][q] = *(const f32x4*)(p_ + (q >> 1) * 128 + (q & 1) * 4); } while (0)
        ER_LD(0); ER_LD(1); ER_LD(2);
#pragma unroll
        for (int g = 0; g < 8; ++g) { const int ai = g >> 2, m = g & 3;
            __builtin_amdgcn_sched_barrier(0);
            bf16_t* o_ = out + off0 + (size_t)(ai * 128 + m * 16) * DM;
#pragma unroll
            for (int bj = 0; bj < 2; ++bj) { const f32x4 r0 = buf[g % 3][2 * bj] + acc[ai][bj][m][0], r1 = buf[g % 3][2 * bj + 1] + acc[ai][bj][m][1];
                u32x4 w; w.x = cvt_pk_bf16(r0[0], r0[1]); w.y = cvt_pk_bf16(r0[2], r0[3]); w.z = cvt_pk_bf16(r1[0], r1[1]); w.w = cvt_pk_bf16(r1[2], r1[3]); *(u32x4*)(o_ + bj * 128) = w; }
            __builtin_amdgcn_sched_barrier(0);
            if (g + 3 < 8) ER_LD(g + 3);
        }
#undef ER_LD
    }
};

constexpr int WR_PITCH = 1028;
constexpr int R_WR_OFF = 0, R_PART_OFF = 32 * WR_PITCH * 4, R_SSQ_OFF = R_PART_OFF + 2 * 64 * 33 * 4, R_CNT_OFF = R_SSQ_OFF + 2 * 64 * 4, R_BASE_OFF = R_CNT_OFF + 128, R_RSTD_OFF = R_BASE_OFF + 128, R_END = R_RSTD_OFF + 256;
static_assert(R_END <= TILE_E_OFF, "router LDS map");
__device__ __forceinline__ void p7_router(const Frame& F) {
    const int tid_l = tid_local(), lane_l = tid_l & 63; (void)tid_l; (void)lane_l;
    const KArgs a = kargs();
    LAS float* WR = (LAS float*)(F.lds + R_WR_OFF); LAS float* PART = (LAS float*)(F.lds + R_PART_OFF); LAS float* SSQP = (LAS float*)(F.lds + R_SSQ_OFF);
    LAS int* CNT = (LAS int*)(F.lds + R_CNT_OFF); LAS int* BASE = (LAS int*)(F.lds + R_BASE_OFF); LAS float* RSTD_L = (LAS float*)(F.lds + R_RSTD_OFF);
    const int tid = tid_l, lane = lane_l, wave = F.wave;
    const float* wr = a->in[I_WR]; const float* gf = a->in[I_GFFN];
    {
        const f32x4* wr4 = (const f32x4*)wr; f32x4 w[16]; float g[16];
#pragma unroll
        for (int q = 0; q < 16; ++q) { const int idx = tid + 512 * q; w[q] = wr4[idx]; g[q] = gf[idx >> 3]; }
#pragma unroll
        for (int q = 0; q < 16; ++q) { const int idx = tid + 512 * q; const int k = idx >> 3, e0 = (idx & 7) * 4;
#pragma unroll
            for (int j = 0; j < 4; ++j) WR[(e0 + j) * WR_PITCH + k] = w[q][j] * g[q]; }
    }
    if (tid < 32) CNT[tid] = 0;
    __syncthreads();
    int* RE = (int*)(F.ws + WS_ROUTE); int* RP = RE + T * 4; float* RG = (float*)(RP + T * 4); float* RS = RG + T * 4; int* TOK = (int*)(F.ws + WS_TOK); unsigned char* H8 = F.ws + WS_XS2;
    unsigned* gcnt = F.ctl + CW_CNT;
    const bf16_t* X1 = (const bf16_t*)(F.ws + WS_X1B);
    for (int blk = F.vcu; blk < T / 64; blk += F.G) {
        const int tb = blk * 64;
        {
            const int tg = wave & 3, kh = wave >> 2, r = lane & 15, kq = lane >> 4;
            const bf16_t* xp = X1 + (size_t)(tb + 16 * tg + r) * DM + 512 * kh + 4 * kq;
            const LAS float* w0 = WR + (lane & 15) * WR_PITCH + 512 * kh + 4 * kq; const LAS float* w1 = w0 + 16 * WR_PITCH;
            f32x4 acc0 = {0.f, 0.f, 0.f, 0.f}, acc1 = {0.f, 0.f, 0.f, 0.f}; float ss = 0.f;
            u32x2 xall[32];
#pragma unroll
            for (int i = 0; i < 32; ++i) xall[i] = *(const u32x2*)(xp + 16 * i);
#pragma unroll
            for (int i = 0; i < 32; ++i) {
                const u32x2 xw = xall[i]; const f32x4 xv = {bf_lo(xw.x), bf_hi(xw.x), bf_lo(xw.y), bf_hi(xw.y)};
                const f32x4 b0 = *(const LAS f32x4*)(w0 + 16 * i), b1 = *(const LAS f32x4*)(w1 + 16 * i);
                ss += (xv[0] * xv[0] + xv[1] * xv[1]) + (xv[2] * xv[2] + xv[3] * xv[3]);
#pragma unroll
                for (int j = 0; j < 4; ++j) { acc0 = __builtin_amdgcn_mfma_f32_16x16x4f32(xv[j], b0[j], acc0, 0, 0, 0); acc1 = __builtin_amdgcn_mfma_f32_16x16x4f32(xv[j], b1[j], acc1, 0, 0, 0); }
            }
            ss += __shfl_xor(ss, 16); ss += __shfl_xor(ss, 32);
            if (kq == 0) SSQP[kh * 64 + 16 * tg + r] = ss;
#pragma unroll
            for (int q = 0; q < 4; ++q) { const int tok = 16 * tg + 4 * kq + q; PART[(kh * 64 + tok) * 33 + (lane & 15)] = acc0[q]; PART[(kh * 64 + tok) * 33 + 16 + (lane & 15)] = acc1[q]; }
        }
        __syncthreads();
        int te[4] = {0, 0, 0, 0}, lp[4] = {0, 0, 0, 0}; float tv[4] = {-3e38f, -3e38f, -3e38f, -3e38f}; float rstd = 0.f;
        if (tid < 64) {
            const float ssq = SSQP[tid] + SSQP[64 + tid]; rstd = 1.0f / sqrtf(ssq * (1.f / DM) + EPS);
            const float* br = a->in[I_BR];
#pragma unroll
            for (int e = 0; e < 32; ++e) {
                float v = (PART[tid * 33 + e] + PART[(64 + tid) * 33 + e]) * rstd + br[e]; int id = e;
#pragma unroll
                for (int s = 0; s < 4; ++s) { const bool gt = v > tv[s]; const float ov = tv[s]; const int oi = te[s]; tv[s] = gt ? v : ov; te[s] = gt ? id : oi; v = gt ? ov : v; id = gt ? oi : id; }
            }
#pragma unroll
            for (int s = 0; s < 4; ++s) lp[s] = __hip_atomic_fetch_add(&CNT[te[s]], 1, __ATOMIC_RELAXED, __HIP_MEMORY_SCOPE_WORKGROUP);
        }
        __syncthreads();
        if (tid < 32) { const int c = CNT[tid]; BASE[tid] = c ? (int)atomicAdd(gcnt + tid, (unsigned)c) : 0; }
        __syncthreads();
        if (tid < 64) {
            const int t = tb + tid;
            const float e1 = __expf(tv[1] - tv[0]), e2 = __expf(tv[2] - tv[0]), e3 = __expf(tv[3] - tv[0]); const float inv = 1.0f / (1.0f + e1 + e2 + e3);
            const float gts[4] = {inv, e1 * inv, e2 * inv, e3 * inv};
#pragma unroll
            for (int s = 0; s < 4; ++s) { const int p = BASE[te[s]] + lp[s]; RE[t * 4 + s] = te[s]; RP[t * 4 + s] = p; RG[t * 4 + s] = gts[s]; TOK[te[s] * 16384 + p] = t; }
            RS[t] = rstd; RSTD_L[tid] = rstd;
        }
        __syncthreads();
        if (tid < 32) CNT[tid] = 0;
        {
            f32x4 g[4];
#pragma unroll
            for (int k = 0; k < 4; ++k) g[k] = *(const f32x4*)(gf + 16 * lane + 4 * k);
#pragma unroll 4
            for (int i = 0; i < 8; ++i) {
                const int t = tb + 8 * wave + i; const float rs = RSTD_L[8 * wave + i];
                const u32x4 x0 = *(const u32x4*)(X1 + (size_t)t * DM + 16 * lane), x1 = *(const u32x4*)(X1 + (size_t)t * DM + 16 * lane + 8);
                const f32x4 v0 = (f32x4){bf_lo(x0.x), bf_hi(x0.x), bf_lo(x0.y), bf_hi(x0.y)} * g[0] * rs, v1 = (f32x4){bf_lo(x0.z), bf_hi(x0.z), bf_lo(x0.w), bf_hi(x0.w)} * g[1] * rs;
                const f32x4 v2 = (f32x4){bf_lo(x1.x), bf_hi(x1.x), bf_lo(x1.y), bf_hi(x1.y)} * g[2] * rs, v3 = (f32x4){bf_lo(x1.z), bf_hi(x1.z), bf_lo(x1.w), bf_hi(x1.w)} * g[3] * rs;
                const u32x2 w0 = cvt8_fp8(v0, v1, 8.0f), w1 = cvt8_fp8(v2, v3, 8.0f); u32x4 w; w.x = w0.x; w.y = w0.y; w.z = w1.x; w.w = w1.y;
                *(u32x4*)(H8 + (size_t)t * DM + 16 * lane) = w;
            }
        }
        __syncthreads();
    }
}

__device__ __forceinline__ int build_tiles(const Frame& F) {
    const int tid_l = tid_local(), lane_l = tid_l & 63; (void)tid_l; (void)lane_l;
    LAS int* TB = (LAS int*)(F.lds + TILE_E_OFF); LAS int* TE = TB + 64;
    if (tid_l < 64) {
        const int c = (tid_l < NEXP) ? (int)__hip_atomic_load(F.ctl + CW_CNT + tid_l, RLX_AGENT) : 0; const int nt = (c + 255) >> 8;
        int incl = nt;
#pragma unroll
        for (int o = 1; o < 32; o <<= 1) { const int v = __shfl_up(incl, o); if (lane_l >= o) incl += v; }
        if (tid_l < NEXP) TB[tid_l] = incl - nt;
        if (tid_l == NEXP - 1) TB[NEXP] = incl;
    }
    __syncthreads();
    if (tid_l < NEXP) { for (int t = TB[tid_l]; t < TB[tid_l + 1]; ++t) TE[t] = tid_l; }
    __syncthreads();
    return TB[NEXP];
}

__device__ __forceinline__ void p8_dispatch(const Frame& F) {
    const int tid_l = tid_local(), lane_l = tid_l & 63; (void)tid_l; (void)lane_l;
    const KArgs a = kargs();
    (void)build_tiles(F);
    const LAS int* TB = (const LAS int*)(F.lds + TILE_E_OFF);
    const int gw = F.vcu * NWAVES + F.wave, NGW = F.G * NWAVES, lane = lane_l;
    const int* RE = (const int*)(F.ws + WS_ROUTE); const int* RP = RE + T * 4; const float* RS = (const float*)(RP + T * 4) + T * 4; int* SL = (int*)(RS + T);
    const bf16_t* X1 = (const bf16_t*)(F.ws + WS_X1B); const float* gf = a->in[I_GFFN]; unsigned char* XS = F.ws + WS_XS2;
    f32x4 g[2][2];
#pragma unroll
    for (int j = 0; j < 2; ++j) { g[j][0] = *(const f32x4*)(gf + 512 * j + 8 * lane); g[j][1] = *(const f32x4*)(gf + 512 * j + 8 * lane + 4); }
    for (int t = gw; t < T; t += NGW) {
        const float rstd = RS[t];
        u32x2 w[2];
#pragma unroll
        for (int j = 0; j < 2; ++j) { const u32x4 xw = *(const u32x4*)(X1 + (size_t)t * DM + 512 * j + 8 * lane);
            const f32x4 v0 = (f32x4){bf_lo(xw.x), bf_hi(xw.x), bf_lo(xw.y), bf_hi(xw.y)} * g[j][0] * rstd, v1 = (f32x4){bf_lo(xw.z), bf_hi(xw.z), bf_lo(xw.w), bf_hi(xw.w)} * g[j][1] * rstd;
            w[j] = cvt8_fp8(v0, v1, 8.0f); }
#pragma unroll
        for (int s = 0; s < 4; ++s) { const int e = RE[t * 4 + s], slot = TB[e] * 256 + RP[t * 4 + s];
            if (lane == 0) SL[t * 4 + s] = slot;
            unsigned char* dst = XS + (size_t)slot * DM + 8 * lane;
            *(u32x2*)dst = w[0]; *(u32x2*)(dst + 512) = w[1]; }
    }
}

template <bool GATHER_A> struct MoeOrderT {
    int G, c, ntn_shift, total; const LAS int* TE; unsigned A, Bw, bexp, btile; int xbase, xcount;
    __device__ __forceinline__ void init_xcd(const LAS int* TB) {
        if (G == 256) { const int x = c >> 5; xbase = __builtin_amdgcn_readfirstlane(TB[4 * x]); xcount = (__builtin_amdgcn_readfirstlane(TB[4 * x + 4]) - xbase) << ntn_shift; } else { xbase = -1; xcount = 0; }
    }
    __device__ __forceinline__ bool next(int i, Unit& u) const {
        if (xbase >= 0) { const int L = i * 32 + (c & 31); if (L >= xcount) return false;
            u.pm = xbase + (L >> ntn_shift); u.pn = L & ((1 << ntn_shift) - 1); u.aux = __builtin_amdgcn_readfirstlane(TE[u.pm]); return true; }
        const int L = i * G + c; if (L >= total) return false;
        u.pm = L >> ntn_shift; u.pn = L & ((1 << ntn_shift) - 1); u.aux = __builtin_amdgcn_readfirstlane(TE[u.pm]); return true;
    }
#ifndef MOE_PREFETCH
#define MOE_PREFETCH 0
#endif
    __device__ __forceinline__ void prefetch(const Unit& u, const __amdgpu_buffer_rsrc_t rsrc, LAS unsigned char* lds, int wid, int lane) const {
        if (!MOE_PREFETCH) return;
        const unsigned ln_ = (unsigned)(tid_local() & 63);
        const unsigned line = (unsigned)(u.pn & 3) * 512u + (unsigned)wid * 64u + ln_;
        const unsigned voff = (line >> 3) * 1024u + (line & 7u) * 128u;
        const unsigned dst = (unsigned)__builtin_amdgcn_readfirstlane((int)(unsigned)(unsigned long)(lds + 131072 + wid * 256));
        const unsigned soff = a_off(u);
        asm volatile("s_nop 4\n\ts_mov_b32 m0, %0\n\ts_nop 0\n\tbuffer_load_dword %1, %2, %3 offen lds" :: "s"(dst), "v"(voff), "s"(rsrc), "s"(soff) : "m0", "memory");
    }
    unsigned TOK;
    __device__ __forceinline__ unsigned tok_off(const Unit& u) const { return TOK + ((unsigned)u.aux * 16384u + (unsigned)(u.pm - __builtin_amdgcn_readfirstlane(TE[u.aux - 64])) * 256u) * 4u; }
    __device__ __forceinline__ unsigned a_off(const Unit& u) const { return GATHER_A ? A : A + (unsigned)u.pm * (256 * 1024); }
    __device__ __forceinline__ unsigned b_off(const Unit& u) const { return Bw + (unsigned)u.aux * bexp + (unsigned)u.pn * btile; }
};
using MoeOrder = MoeOrderT<false>; using MoeGather = MoeOrderT<true>;
struct EpiSwiglu {
    static constexpr bool PERM = true;
    unsigned char* ACT; const float* bgu;
    __device__ __forceinline__ void pre(f32x4 (&pb)[4], int e, int pn, int wc, int fq) const {
        const float* bb = bgu + (size_t)e * 2048 + pn * 128 + wc * 32 + 8 * fq;
        pb[0] = *(const f32x4*)(bb); pb[1] = *(const f32x4*)(bb + 4); pb[2] = *(const f32x4*)(bb + 1024); pb[3] = *(const f32x4*)(bb + 1028);
    }
    __device__ __forceinline__ void init_from(f32x4 (&acc)[2][2][4][2], const f32x4 (&pb)[4]) const {
#pragma unroll
        for (int a = 0; a < 2; ++a)
#pragma unroll
            for (int m = 0; m < 4; ++m) { acc[a][0][m][0] = pb[0]; acc[a][0][m][1] = pb[1]; acc[a][1][m][0] = pb[2]; acc[a][1][m][1] = pb[3]; }
    }
    __device__ __forceinline__ void init(f32x4 (&acc)[2][2][4][2], const Unit& u, int wc, int fq) const {
        const float* bb = bgu + (size_t)u.aux * 2048 + u.pn * 128 + wc * 32 + 8 * fq;
        const f32x4 g0 = *(const f32x4*)(bb), g1 = *(const f32x4*)(bb + 4), u0 = *(const f32x4*)(bb + 1024), u1 = *(const f32x4*)(bb + 1028);
#pragma unroll
        for (int a = 0; a < 2; ++a)
#pragma unroll
            for (int m = 0; m < 4; ++m) { acc[a][0][m][0] = g0; acc[a][0][m][1] = g1; acc[a][1][m][0] = u0; acc[a][1][m][1] = u1; }
    }
    __device__ __forceinline__ void operator()(const f32x4 (&acc)[2][2][4][2], const Unit& u, int wr, int wc, int fr, int fq) const {
        const int fqo = fq & 1; const int row0 = u.pm * 256 + wr * 64 + fr + 16 * fqo, j0 = u.pn * 128 + wc * 32 + 8 * (fq & ~1);
        unsigned char* dst0 = ACT + (size_t)row0 * DEXP + j0;
        int keep_[2] = {0, 0};
#pragma unroll
        for (int ai = 0; ai < 2; ++ai)
#pragma unroll
            for (int m = 0; m < 4; ++m) {
                int w2[2];
#pragma unroll
                for (int n = 0; n < 2; ++n) {
                    const f32x4 g = acc[ai][0][m][n], up = acc[ai][1][m][n];
                    f32x2 r[2];
#pragma unroll
                    for (int h = 0; h < 2; ++h) {
                        const f32x2 gg = {__builtin_amdgcn_fmed3f(g[2 * h], -3.0e38f, 7.0f), __builtin_amdgcn_fmed3f(g[2 * h + 1], -3.0e38f, 7.0f)};
                        const f32x2 uu = {__builtin_amdgcn_fmed3f(up[2 * h], -7.0f, 7.0f), __builtin_amdgcn_fmed3f(up[2 * h + 1], -7.0f, 7.0f)};
                        const f32x2 x = gg * (f32x2){-1.702f * 1.4426950408889634f, -1.702f * 1.4426950408889634f};
                        const f32x2 den = (f32x2){__builtin_amdgcn_exp2f(x[0]), __builtin_amdgcn_exp2f(x[1])} + (f32x2){1.0f, 1.0f};
                        const f32x2 rc = {__builtin_amdgcn_rcpf(den[0]), __builtin_amdgcn_rcpf(den[1])};
                        r[h] = (uu * (f32x2){8.0f, 8.0f} + (f32x2){8.0f, 8.0f}) * gg * rc; }
                    int w = __builtin_amdgcn_cvt_pk_fp8_f32(r[0][0], r[0][1], 0, false); w2[n] = __builtin_amdgcn_cvt_pk_fp8_f32(r[1][0], r[1][1], w, true);
                }
                if ((m & 1) == 0) { keep_[0] = w2[0]; keep_[1] = w2[1]; }
                else { const auto r0 = __builtin_amdgcn_permlane16_swap((unsigned)keep_[0], (unsigned)w2[0], false, false), r1 = __builtin_amdgcn_permlane16_swap((unsigned)keep_[1], (unsigned)w2[1], false, false);
                    u32x4 o; o.x = r0[0]; o.y = r1[0]; o.z = r0[1]; o.w = r1[1];
                    *(u32x4*)(dst0 + (size_t)(ai * 128 + (m - 1) * 16) * DEXP) = o; }
            }
    }
};
struct EpiDown {
    static constexpr bool PERM = true;
    unsigned char* Y; const float* bd;
    __device__ __forceinline__ void pre(f32x4 (&pb)[4], int e, int pn, int wc, int fq) const {
        const float* bb = bd + (size_t)e * DM + pn * 256 + wc * 32 + 8 * fq;
        pb[0] = *(const f32x4*)(bb); pb[1] = *(const f32x4*)(bb + 4); pb[2] = *(const f32x4*)(bb + 128); pb[3] = *(const f32x4*)(bb + 132);
    }
    __device__ __forceinline__ void init_from(f32x4 (&acc)[2][2][4][2], const f32x4 (&pb)[4]) const {
        const f32x4 b00 = pb[0] * 8.0f, b01 = pb[1] * 8.0f, b10 = pb[2] * 8.0f, b11 = pb[3] * 8.0f;
#pragma unroll
        for (int a = 0; a < 2; ++a)
#pragma unroll
            for (int m = 0; m < 4; ++m) { acc[a][0][m][0] = b00; acc[a][0][m][1] = b01; acc[a][1][m][0] = b10; acc[a][1][m][1] = b11; }
    }
    __device__ __forceinline__ void init(f32x4 (&acc)[2][2][4][2], const Unit& u, int wc, int fq) const {
        const float* bb = bd + (size_t)u.aux * DM + u.pn * 256 + wc * 32 + 8 * fq;
        const f32x4 b00 = *(const f32x4*)(bb) * 8.0f, b01 = *(const f32x4*)(bb + 4) * 8.0f, b10 = *(const f32x4*)(bb + 128) * 8.0f, b11 = *(const f32x4*)(bb + 132) * 8.0f;
#pragma unroll
        for (int a = 0; a < 2; ++a)
#pragma unroll
            for (int m = 0; m < 4; ++m) { acc[a][0][m][0] = b00; acc[a][0][m][1] = b01; acc[a][1][m][0] = b10; acc[a][1][m][1] = b11; }
    }
    __device__ __forceinline__ void operator()(const f32x4 (&acc)[2][2][4][2], const Unit& u, int wr, int wc, int fr, int fq) const {
        const int fqo = fq & 1; const int row0 = u.pm * 256 + wr * 64 + fr + 16 * fqo, col0 = u.pn * 256 + wc * 32 + 8 * (fq & ~1);
#pragma unroll
        for (int ai = 0; ai < 2; ++ai)
#pragma unroll
            for (int p = 0; p < 2; ++p) { unsigned char* rowp = Y + (size_t)(row0 + ai * 128 + p * 32) * DM + col0;
#pragma unroll
                for (int bj = 0; bj < 2; ++bj) { const u32x2 a = cvt8_fp8(acc[ai][bj][2 * p][0], acc[ai][bj][2 * p][1], 1.0f), b = cvt8_fp8(acc[ai][bj][2 * p + 1][0], acc[ai][bj][2 * p + 1][1], 1.0f);
                    const auto r0 = __builtin_amdgcn_permlane16_swap(a.x, b.x, false, false), r1 = __builtin_amdgcn_permlane16_swap(a.y, b.y, false, false);
                    u32x4 w; w.x = r0[0]; w.y = r1[0]; w.z = r0[1]; w.w = r1[1]; *(u32x4*)(rowp + bj * 128) = w; } }
    }
};

__device__ __forceinline__ void p11_combine(const Frame& F) {
    const int tid_l = tid_local(), lane_l = tid_l & 63; (void)tid_l; (void)lane_l;
    const KArgs a = kargs();
    const int gw = F.vcu * NWAVES + F.wave, NGW = F.G * NWAVES, lane = lane_l;
#ifdef DUP_PHASE
    (void)build_tiles(F);
#endif
    const LAS int* TB = (const LAS int*)(F.lds + TILE_E_OFF);
    const int* RE = (const int*)(F.ws + WS_ROUTE); const int* RP = RE + T * 4; const float* RG = (const float*)(RE + T * 8);
    const unsigned char* Y = F.ws + WS_XS; bf16_t* HP = (bf16_t*)(F.ws + WS_HN); const bf16_t* X1 = (const bf16_t*)(F.ws + WS_X1B); bf16_t* X2 = (bf16_t*)(F.ws + WS_X2B); const float* gp = a->in[I_GPLE];
    f32x4 g[4];
#pragma unroll
    for (int k = 0; k < 4; ++k) g[k] = *(const f32x4*)(gp + 16 * lane + 4 * k);
    for (int t = gw; t < T; t += NGW) {
        f32x4 v[4];
        { const u32x4 x0 = *(const u32x4*)(X1 + (size_t)t * DM + 16 * lane), x1 = *(const u32x4*)(X1 + (size_t)t * DM + 16 * lane + 8);
          v[0] = (f32x4){bf_lo(x0.x), bf_hi(x0.x), bf_lo(x0.y), bf_hi(x0.y)}; v[1] = (f32x4){bf_lo(x0.z), bf_hi(x0.z), bf_lo(x0.w), bf_hi(x0.w)};
          v[2] = (f32x4){bf_lo(x1.x), bf_hi(x1.x), bf_lo(x1.y), bf_hi(x1.y)}; v[3] = (f32x4){bf_lo(x1.z), bf_hi(x1.z), bf_lo(x1.w), bf_hi(x1.w)}; }
#pragma unroll
        for (int s = 0; s < 4; ++s) { const int slot = TB[RE[t * 4 + s]] * 256 + RP[t * 4 + s]; const float gt = RG[t * 4 + s] * 0.125f;
            const u32x4 y = *(const u32x4*)(Y + (size_t)slot * DM + 16 * lane); const unsigned yw[4] = {y.x, y.y, y.z, y.w};
#pragma unroll
            for (int k = 0; k < 4; ++k) { const f32x2 a0 = __builtin_amdgcn_cvt_pk_f32_fp8((int)yw[k], false), a1 = __builtin_amdgcn_cvt_pk_f32_fp8((int)yw[k], true);
                v[k] += (f32x4){a0[0], a0[1], a1[0], a1[1]} * gt; } }
        float ss = 0.f;
#pragma unroll
        for (int k = 0; k < 4; ++k) { const f32x4 q = v[k]; ss += (q[0] * q[0] + q[1] * q[1]) + (q[2] * q[2] + q[3] * q[3]); }
#pragma unroll
        for (int h = 0; h < 2; ++h) { const f32x4 q0 = v[2 * h], q1 = v[2 * h + 1]; u32x4 w; w.x = cvt_pk_bf16(q0[0], q0[1]); w.y = cvt_pk_bf16(q0[2], q0[3]); w.z = cvt_pk_bf16(q1[0], q1[1]); w.w = cvt_pk_bf16(q1[2], q1[3]);
            *(u32x4*)(X2 + (size_t)t * DM + 16 * lane + 8 * h) = w; }
        const float rstd = 1.0f / sqrtf(wave_sum(ss) * (1.f / DM) + EPS);
        if (PLE_FP8) { const u32x2 w0 = cvt8_fp8(v[0] * g[0] * rstd, v[1] * g[1] * rstd, 8.0f), w1 = cvt8_fp8(v[2] * g[2] * rstd, v[3] * g[3] * rstd, 8.0f);
            u32x4 w; w.x = w0.x; w.y = w0.y; w.z = w1.x; w.w = w1.y; *(u32x4*)((unsigned char*)HP + (size_t)t * DM + 16 * lane) = w; }
        else {
#pragma unroll
            for (int h = 0; h < 2; ++h) { const f32x4 q0 = v[2 * h] * g[2 * h] * rstd, q1 = v[2 * h + 1] * g[2 * h + 1] * rstd; u32x4 w; w.x = cvt_pk_bf16(q0[0], q0[1]); w.y = cvt_pk_bf16(q0[2], q0[3]); w.z = cvt_pk_bf16(q1[0], q1[1]); w.w = cvt_pk_bf16(q1[2], q1[3]);
                *(u32x4*)(HP + (size_t)t * DM + 16 * lane + 8 * h) = w; } }
    }
}
struct EpiPle {
    static constexpr bool PERM = true;
    __device__ __forceinline__ void init(f32x4 (&acc)[2][2][4][2], const Unit&, int, int) const {
#pragma unroll
        for (int a = 0; a < 2; ++a)
#pragma unroll
            for (int b = 0; b < 2; ++b)
#pragma unroll
                for (int m = 0; m < 4; ++m)
#pragma unroll
                    for (int n = 0; n < 2; ++n) acc[a][b][m][n] = (f32x4){0.f, 0.f, 0.f, 0.f};
    }
    float* out; const bf16_t* E; const bf16_t* X2;
    __device__ __forceinline__ void operator()(const f32x4 (&acc)[2][2][4][2], const Unit& u, int wr, int wc, int fr, int fq) const {
        const int row0 = u.pm * 256 + wr * 64 + fr, col0 = u.pn * 256 + wc * 32 + 8 * fq;
        const size_t off0 = (size_t)row0 * DM + col0;
        u32x4 eb[3][2], xb[3][2];
#define EP_LD(g) do { const size_t o_ = off0 + (size_t)(((g) >> 2) * 128 + ((g) & 3) * 16) * DM; \
        _Pragma("unroll") for (int bj = 0; bj < 2; ++bj) { eb[(g) % 3][bj] = *(const u32x4*)(E + o_ + bj * 128); xb[(g) % 3][bj] = *(const u32x4*)(X2 + o_ + bj * 128); } } while (0)
        EP_LD(0); EP_LD(1); EP_LD(2);
#pragma unroll
        for (int g = 0; g < 8; ++g) { const int ai = g >> 2, m = g & 3; const size_t off = off0 + (size_t)(ai * 128 + m * 16) * DM;
            __builtin_amdgcn_sched_barrier(0);
#pragma unroll
            for (int bj = 0; bj < 2; ++bj) { const u32x4 ev = eb[g % 3][bj], xw = xb[g % 3][bj]; const f32x4 a0 = acc[ai][bj][m][0], a1 = acc[ai][bj][m][1];
                const unsigned xs_[4] = {xw.x, xw.y, xw.z, xw.w}, es_[4] = {ev.x, ev.y, ev.z, ev.w}; f32x2 rr_[4];
#pragma unroll
                for (int h = 0; h < 4; ++h) { const f32x4 a_ = (h < 2) ? a0 : a1; const f32x2 ap_ = {a_[2 * (h & 1)], a_[2 * (h & 1) + 1]};
                    const f32x2 x_ = ap_ * (f32x2){-1.4426950408889634f, -1.4426950408889634f};
                    const f32x2 d_ = (f32x2){__builtin_amdgcn_exp2f(x_[0]), __builtin_amdgcn_exp2f(x_[1])} + (f32x2){1.0f, 1.0f};
                    const f32x2 s_ = {__builtin_amdgcn_rcpf(d_[0]), __builtin_amdgcn_rcpf(d_[1])};
                    rr_[h] = s_ * (f32x2){bf_lo(es_[h]), bf_hi(es_[h])} + (f32x2){bf_lo(xs_[h]), bf_hi(xs_[h])}; }
                *(f32x4*)(out + off + bj * 128) = (f32x4){rr_[0][0], rr_[0][1], rr_[1][0], rr_[1][1]}; *(f32x4*)(out + off + bj * 128 + 4) = (f32x4){rr_[2][0], rr_[2][1], rr_[3][0], rr_[3][1]}; }
            __builtin_amdgcn_sched_barrier(0);
            if (g + 3 < 8) EP_LD(g + 3);
        }
#undef EP_LD
    }
};

constexpr int N_PHASES = 13;
__global__ void __launch_bounds__(NWAVES * 64, 2) fwd_kernel(Args args) {
    extern __shared__ __attribute__((aligned(16))) unsigned char lds_raw[];
    Frame F;
    F.lds = (LAS unsigned char*)lds_raw; F.MISC = (volatile LAS unsigned*)(F.lds + MISC_OFF);
    F.wave = __builtin_amdgcn_readfirstlane(threadIdx.x >> 6);
    F.G = gridDim.x; { const int bx = blockIdx.x; F.vcu = (F.G % 8 == 0) ? (bx % 8) * (F.G / 8) + bx / 8 : bx; }
    { const KArgs ka = kargs(); F.out = ka->out; F.ws = ka->ws; F.ctl = (unsigned*)(ka->ws + WS_CTL); }
    { const int t0_ = tid_local(); if (t0_ < 32) F.MISC[t0_] = 0u; }
    __syncthreads();
    int lo, hi; { const KArgs ka = kargs(); lo = ka->ph_lo; hi = ka->ph_hi; }
    const bool multi = (hi - lo) > 1;
    XcdBarrier bar; bar.bar = F.ctl + CW_BAR; bar.x = 0; bar.st = nullptr;
    if (multi) bar = xcd_barrier_post(F.ctl + CW_BAR, F.MISC);
#ifndef PH_MASK
#define PH_MASK 0x1fff
#endif
#define IN(k) ((((PH_MASK) >> (k)) & 1) && lo <= (k) && (k) < hi)
#define SEAM(k) do { if (IN(k) && IN((k) + 1)) xcd_barrier(bar); } while (0)
    unsigned char* ws = F.ws;
    LAS unsigned char* ring = F.lds;
    const __amdgpu_buffer_rsrc_t rsrc = __builtin_amdgcn_make_buffer_rsrc((void*)ws, 0, (int)WS_END, 0x00020000);

    if (IN(0)) { p0_prologue(F); } SEAM(0);

    if (IN(1)) {
        if (GATES_FP8 && !P1_FP8) {
          { DenseOrder S; S.init(64, 8, F.G, (int)blockIdx.x, WS_HN8, 512, WS_WIN8 + (size_t)1024 * 1024, 512);
            EpiProj E{(bf16_t*)(ws + WS_PROJ), (bf16_t*)(ws + WS_GATES), 4};
            pg8::gemm_phase<EpiProj, DenseOrder, true, true, true>(ring, rsrc, pg8::Shape{1024, 1024, 1024, 0x7c7c7c7c, 0x7c7c7c7c}, S, E); }
          { DenseOrder S; S.init(64, 4, F.G, (int)blockIdx.x, WS_HN, 1024, WS_WIN, 1024);
            EpiProj E{(bf16_t*)(ws + WS_PROJ), (bf16_t*)(ws + WS_GATES), 0};
            pg8::gemm_phase<EpiProj, DenseOrder, true, true>(ring, rsrc, pg8::Shape{2048, 2048, 2048, 0, 0}, S, E); }
        } else
        { DenseOrder S; S.init(64, 12, F.G, (int)blockIdx.x, WS_HN, P1_FP8 ? 512 : 1024, WS_WIN, P1_FP8 ? 512 : 1024);
          EpiProj E{(bf16_t*)(ws + WS_PROJ), (bf16_t*)(ws + WS_GATES), 0};
          if (P1_FP8) pg8::gemm_phase<EpiProj, DenseOrder, true, true, true>(ring, rsrc, pg8::Shape{1024, 1024, 1024, 0x7c7c7c7c, 0x7c7c7c7c}, S, E);
          else pg8::gemm_phase<EpiProj, DenseOrder, true, true>(ring, rsrc, pg8::Shape{2048, 2048, 2048, 0, 0}, S, E, GP_AT(1)); }
        { DenseOrder S; S.init(64, 4, F.G, (int)blockIdx.x, WS_PB, 256, WS_WPLE, 256);
          EpiBf16 E{(bf16_t*)(ws + WS_E), 1024};
          pg8::gemm_phase<EpiBf16, DenseOrder, true, true>(ring, rsrc, pg8::Shape{512, 512, 512, 0, 0}, S, E); }
    } SEAM(1);

    if (IN(2)) { p2_rows(F); } SEAM(2);

    if (IN(3)) {
#ifndef P3M
#define P3M 7
#endif
        if (P3M & 1) { DenseOrder S; S.init(64, 4, F.G, (int)blockIdx.x, WS_A2 + 512, 512, WS_WKV, 256);
          EpiKV E{(bf16_t*)(ws + WS_K), (bf16_t*)(ws + WS_V), kargs()->in[I_GKNOPE]};
          pg8::gemm_phase<EpiKV, DenseOrder, true, true>(ring, rsrc, pg8::Shape{256, 1024, 512, 0, 0}, S, E); }
        if (P3M & 2) { DenseOrder S; S.init(64, 3, F.G, (int)blockIdx.x, WS_A2, 512, WS_WQ, 256);
          EpiQ E{(bf16_t*)(ws + WS_Q), (float*)(ws + WS_SSQ), (const float*)(ws + WS_COS), (const float*)(ws + WS_SIN), kargs()->in[I_GQHEAD]};
          pg8::gemm_phase<EpiQ, DenseOrder, true, true>(ring, rsrc, pg8::Shape{512, 1024, 512, 0, 0}, S, E); }
        if (P3M & 4) { DenseOrder S; S.init(64, 2, F.G, (int)blockIdx.x, WS_POOLED, 512, WS_WPOOL, 256, 512);
          EpiBf16 E{(bf16_t*)(ws + WS_MIXED), 512};
          pg8::gemm_phase<EpiBf16, DenseOrder, true, true>(ring, rsrc, pg8::Shape{512, 1024, 512, 0, 0}, S, E); }
    } SEAM(3);

    if (IN(4)) {
        u32x4 srd; { const unsigned long wb = (unsigned long)ws; srd.x = (unsigned)__builtin_amdgcn_readfirstlane((int)(unsigned)wb); srd.y = (unsigned)__builtin_amdgcn_readfirstlane((int)(unsigned)(wb >> 32)); srd.z = (unsigned)WS_END; srd.w = 0x00020000u; }
        att::ConvState CV; CV.next = __builtin_amdgcn_readfirstlane(F.vcu * NWAVES + F.wave); CV.end = CONV_IN_ATTN ? att::CV_ITEMS : 0; CV.cur = -1;
        bool fast;
        { const int lane = tid_local() & 63; const float* gqh = kargs()->in[I_GQHEAD]; const float* gkn = kargs()->in[I_GKNOPE]; const float* gkr = kargs()->in[I_GKROPE];
          float a = fabsf(gqh[lane]); if (lane < 32) a = fmaxf(a, fabsf(gqh[64 + lane])); float bn = fabsf(gkn[lane]); float br = (lane < 32) ? fabsf(gkr[lane]) : 0.f;
#pragma unroll
          for (int o = 1; o < 64; o <<= 1) { a = fmaxf(a, __shfl_xor(a, o)); bn = fmaxf(bn, __shfl_xor(bn, o)); br = fmaxf(br, __shfl_xor(br, o)); }
          const float Mb = 1.4426950408889634f * 1.01f * a * sqrtf(64.f * bn * bn + 32.f * br * br);
          fast = __builtin_amdgcn_readfirstlane(Mb <= 60.0f ? 1 : 0) != 0; }
        for (int it = F.vcu; it < 256; it += F.G) {
            const int bh = it >> 3, pr = it & 7;
            att::attn_unit(ring, srd, CV, ws, bh, 15 - pr, (const bf16_t*)(ws + WS_Q), (unsigned)WS_K, (unsigned)WS_V, (const float*)(ws + WS_SSQ), (bf16_t*)(ws + WS_ATT), fast);
            att::attn_unit(ring, srd, CV, ws, bh, pr, (const bf16_t*)(ws + WS_Q), (unsigned)WS_K, (unsigned)WS_V, (const float*)(ws + WS_SSQ), (bf16_t*)(ws + WS_ATT), fast);
        }
        { const LAS float* cb = (const LAS float*)(F.lds + att::CONV_OFF + F.wave * att::CONV_BYTES);
          const unsigned cbaddr = (unsigned)__builtin_amdgcn_readfirstlane((int)(unsigned)(unsigned long)(F.lds + att::CONV_OFF + F.wave * att::CONV_BYTES));
          const int lane_l = tid_local() & 63;
          while (CV.cur >= 0 || CV.next < CV.end) {
            if (CV.cur >= 0) { asm volatile("s_waitcnt vmcnt(0)" ::: "memory"); const att::ConvItem I = att::cv_setup(CV.cur, kargs()->in[I_WGU], kargs()->in[I_WD], ws + WS_WGU, ws + WS_WD); att::cv_out(I, cb, lane_l); }
            if (CV.next < CV.end) { const att::ConvItem I = att::cv_setup(CV.next, kargs()->in[I_WGU], kargs()->in[I_WD], ws + WS_WGU, ws + WS_WD); asm volatile("s_waitcnt lgkmcnt(0)" ::: "memory"); att::cv_dma(I, cbaddr, lane_l); CV.cur = CV.next; CV.next += 2048; } else CV.cur = -1;
          } }
    } SEAM(4);

    if (IN(5)) {
        MixOrder S{F.G, F.vcu, (unsigned)WS_ATT, (unsigned)WS_MIXED, (unsigned)WS_WAO, (unsigned)WS_WPO};
        EpiMix E{(bf16_t*)(ws + WS_MIX), (const bf16_t*)(ws + WS_GATES)};
        pg8::gemm_phase<EpiMix, MixOrder, true, true>(ring, rsrc, pg8::Shape{1024, 1024, 1024, 0, 0}, S, E, GP_AT(5));
    } SEAM(5);

    if (IN(6)) {
        DenseOrder S; S.init(64, 4, F.G, (int)blockIdx.x, WS_MIX, 1024, WS_WO, 1024);
        EpiRes E{kargs()->in[I_X], (bf16_t*)(ws + WS_X1B)};
        pg8::gemm_phase<EpiRes, DenseOrder, true, true>(ring, rsrc, pg8::Shape{2048, 2048, 2048, 0, 0}, S, E, GP_AT(6));
    } SEAM(6);

    if (IN(7)) { p7_router(F); } SEAM(7);


    if (IN(9)) {
        const int TM = build_tiles(F);
        MoeGather S{F.G, F.vcu, 3, TM * 8, (const LAS int*)(F.lds + TILE_E_OFF) + 64, (unsigned)WS_XS2, (unsigned)WS_WGU, 2048u * 1024u, 256u * 1024u, 0, 0, (unsigned)WS_TOK}; S.init_xcd((const LAS int*)(F.lds + TILE_E_OFF));
        EpiSwiglu E{ws + WS_ACT, kargs()->in[I_BGU]};
        pg8::gemm_phase<EpiSwiglu, MoeGather, true, true, true, true>(ring, rsrc, pg8::Shape{1024, 1024, 1024, 0x7c7c7c7c, 0x7c7c7c7c}, S, E, GP_AT(9));
    } SEAM(9);

    if (IN(10)) {
#ifdef DUP_PHASE
        (void)build_tiles(F);
#endif
        const int TM = ((const LAS int*)(F.lds + TILE_E_OFF))[NEXP];
        MoeOrder S{F.G, F.vcu, 2, TM * 4, (const LAS int*)(F.lds + TILE_E_OFF) + 64, (unsigned)WS_ACT, (unsigned)WS_WD, 1024u * 1024u, 256u * 1024u, 0, 0}; S.init_xcd((const LAS int*)(F.lds + TILE_E_OFF));
        EpiDown E{ws + WS_XS, kargs()->in[I_BD]};
        pg8::gemm_phase<EpiDown, MoeOrder, true, true, true>(ring, rsrc, pg8::Shape{1024, 1024, 1024, 0x7c7c7c7c, 0x7c7c7c7c}, S, E, GP_AT(10));
    } SEAM(10);

    if (IN(11)) { p11_combine(F); } SEAM(11);

    if (IN(12)) {
        DenseOrder S; S.init(64, 4, F.G, (int)blockIdx.x, WS_HN, PLE_FP8 ? 512 : 1024, WS_WPG, PLE_FP8 ? 512 : 1024);
        EpiPle E{F.out, (const bf16_t*)(ws + WS_E), (const bf16_t*)(ws + WS_X2B)};
        if (PLE_FP8) pg8::gemm_phase<EpiPle, DenseOrder, true, true, true>(ring, rsrc, pg8::Shape{1024, 1024, 1024, 0x7c7c7c7c, 0x7c7c7c7c}, S, E, GP_AT(12));
        else pg8::gemm_phase<EpiPle, DenseOrder, true, true>(ring, rsrc, pg8::Shape{2048, 2048, 2048, 0, 0}, S, E, GP_AT(12));
    }
#ifdef ATT_PROBE
    if (blockIdx.x == 17 && tid_local() == 0) { const unsigned long long* ap = (const unsigned long long*)(ws + WS_CTL + 65536 + 64); const unsigned long long wait = (ap[0] / ap[1]) * 10; const unsigned long long r0 = __builtin_amdgcn_s_memrealtime(); while (__builtin_amdgcn_s_memrealtime() - r0 < wait) __builtin_amdgcn_s_sleep(8); }
#endif
#ifdef ATT_PROBE2
    if (blockIdx.x == 17 && tid_local() == 0) { const unsigned long long* ap = (const unsigned long long*)(ws + WS_CTL + 65536 + 128); const unsigned long long wait = (ap[ATT_PROBE2 - 1] / ap[3]) * 10; const unsigned long long r0 = __builtin_amdgcn_s_memrealtime(); while (__builtin_amdgcn_s_memrealtime() - r0 < wait) __builtin_amdgcn_s_sleep(8); }
#endif
#ifdef BAR_PROBE
    for (int i_ = 0; i_ < 20; ++i_) xcd_barrier(bar);
#endif
#ifdef GP_PROBE
    if (blockIdx.x == GP_BLOCK && tid_local() == 0) {
        unsigned long long* gp = (unsigned long long*)(ws + WS_CTL + 65536);
        const unsigned long long cyc = gp[0], tiles = gp[1], pc = gp[2], pr = gp[3], units = gp[4];
        unsigned long long wait = 0;
        if (GP_METRIC == 0) wait = (cyc / tiles) * 10;
        if (GP_METRIC == 1) wait = (pc * 100 / pr) * 10;
        if (GP_METRIC == 2) wait = ((pc - cyc) / units);
        const unsigned long long r0 = __builtin_amdgcn_s_memrealtime();
        while (__builtin_amdgcn_s_memrealtime() - r0 < wait) __builtin_amdgcn_s_sleep(8);
    }
#endif
#undef IN
#undef SEAM
}

extern "C" void kernel_launch(void* const* d_in, const int* in_sizes, int n_in, void* d_out, int out_size, void* d_ws, size_t ws_size, hipStream_t stream) {
    static int grid = 0;
    if (grid == 0) {
        if (n_in != 27 || out_size != T * DM || ws_size < WS_END) { fprintf(stderr, "kernel_launch: unexpected shapes (n_in %d, out %d, ws %zu)\n", n_in, out_size, ws_size); grid = -1; return; }
        int dev = 0, cus = 0;
        if (hipGetDevice(&dev) != hipSuccess || hipDeviceGetAttribute(&cus, hipDeviceAttributeMultiprocessorCount, dev) != hipSuccess) { grid = -1; return; }
        if (hipFuncSetAttribute((const void*)fwd_kernel, hipFuncAttributeMaxDynamicSharedMemorySize, LDS_BYTES) != hipSuccess) { fprintf(stderr, "kernel_launch: hipFuncSetAttribute failed\n"); grid = -1; return; }
        int per_cu = 0;
        if (hipOccupancyMaxActiveBlocksPerMultiprocessor(&per_cu, (const void*)fwd_kernel, NWAVES * 64, LDS_BYTES) != hipSuccess || per_cu < 1) fprintf(stderr, "kernel_launch: occupancy query says %d\n", per_cu);
        (void)hipGetLastError();
        grid = cus;
    }
    if (grid < 0) return;
    (void)hipMemsetAsync((char*)d_ws + WS_CTL, 0, CTL_ZERO_BYTES, stream);
    Args a{};
    for (int i = 0; i < 27; ++i) a.in[i] = (const float*)d_in[i];
    a.out = (float*)d_out; a.ws = (unsigned char*)d_ws;
#ifndef DUP_PHASE
    a.ph_lo = 0; a.ph_hi = N_PHASES; hipLaunchKernelGGL(fwd_kernel, dim3(grid), dim3(NWAVES * 64), LDS_BYTES, stream, a);
#else
    a.ph_lo = 0; a.ph_hi = DUP_PHASE + 1; hipLaunchKernelGGL(fwd_kernel, dim3(grid), dim3(NWAVES * 64), LDS_BYTES, stream, a);
    (void)hipMemsetAsync((char*)d_ws + WS_CTL + CW_BAR * 4, 0, XCD_BAR_WORDS * 4, stream);
    a.ph_lo = DUP_PHASE; a.ph_hi = N_PHASES; hipLaunchKernelGGL(fwd_kernel, dim3(grid), dim3(NWAVES * 64), LDS_BYTES, stream, a);
#endif
}
```
